# Optimizing an MI355X kernel written in HIP

```python
import math
import jax, jax.numpy as jnp
from jax import lax
import numpy as np

D_MODEL = 1024
BATCH = 2
SEQ = 8192
DEPTH = 2
DEC_BATCH = 32
DEC_SEQ = 4
PAST_LEN = 8192
PAGE_SIZE = 128

N_MIXERS = 2
N_ATTN_LAYERS = (DEPTH + 1) // 2
N_GLA_LAYERS = DEPTH // 2
DEEPNORM_ALPHA = (2.0 * DEPTH) ** 0.25
DEEPNORM_BETA = (8.0 * DEPTH) ** -0.25
LN_EPS = 1e-5

ATT_HEADS = 16
ATT_KV_HEADS = 4
ATT_HEAD_DIM = 64
ATT_GROUP = ATT_HEADS // ATT_KV_HEADS
IDX_HEADS = 8
IDX_DIM = 64
TOPK_MAX = 256
Q_BLOCK = 128
ATT_Q_DIM = ATT_HEADS * ATT_HEAD_DIM
ATT_KV_DIM = ATT_KV_HEADS * ATT_HEAD_DIM
ATT_SPLITS = [ATT_Q_DIM, ATT_Q_DIM + ATT_KV_DIM, ATT_Q_DIM + 2 * ATT_KV_DIM,
              ATT_Q_DIM + 2 * ATT_KV_DIM + IDX_HEADS * IDX_DIM,
              ATT_Q_DIM + 2 * ATT_KV_DIM + IDX_HEADS * IDX_DIM + IDX_DIM]
ATT_REST_DIM = IDX_HEADS * IDX_DIM + IDX_DIM + IDX_HEADS

GLA_HEADS = 4
GLA_DK = D_MODEL // 2 // GLA_HEADS
GLA_DV = D_MODEL // GLA_HEADS
GLA_GATE_RANK = 16
GLA_TAU = 16.0
GLA_CHUNK = 64
GLA_SPLITS = [GLA_HEADS * GLA_DK, 2 * GLA_HEADS * GLA_DK,
              2 * GLA_HEADS * GLA_DK + GLA_HEADS * GLA_DV,
              2 * GLA_HEADS * GLA_DK + GLA_HEADS * GLA_DV + GLA_GATE_RANK]

PEER_HEADS = 8
PEER_N_KEYS = 128
PEER_N_EXPERTS = PEER_N_KEYS * PEER_N_KEYS
PEER_D_KEY = 256
PEER_HALF = PEER_D_KEY // 2
PEER_TOPK = 16
PEER_BLOCK = 128

kernel_name = 'dsa_gla_peer_hybrid_step'


def layer_norm(x, g, b):
    xf = x.astype(jnp.float32)
    mu = jnp.mean(xf, axis=-1, keepdims=True)
    var = jnp.mean(jnp.square(xf - mu), axis=-1, keepdims=True)
    return ((xf - mu) * lax.rsqrt(var + LN_EPS) * g + b).astype(x.dtype)


def dsa_project(x, w_in):
    B, T, _ = x.shape
    q, k, v, qi, ki, wi = jnp.split(x @ w_in, ATT_SPLITS, axis=-1)
    q = q.reshape(B, T, ATT_KV_HEADS, ATT_GROUP, ATT_HEAD_DIM)
    k = k.reshape(B, T, ATT_KV_HEADS, ATT_HEAD_DIM)
    v = v.reshape(B, T, ATT_KV_HEADS, ATT_HEAD_DIM)
    qi = qi.reshape(B, T, IDX_HEADS, IDX_DIM)
    wi = wi * (IDX_HEADS ** -0.5)
    return q, k, v, qi, ki, wi


def indexer_scores(qi, wi, ki):
    dots = jnp.einsum('bqhd,bld->bqhl', qi, ki, preferred_element_type=jnp.float32) * (IDX_DIM ** -0.5)
    return jnp.einsum('bqhl,bqh->bql', jax.nn.relu(dots), wi.astype(jnp.float32))


def select_keys(scores, q_pos, n_sel):
    L = scores.shape[-1]
    adm = jnp.arange(L)[None, :] <= q_pos[:, None]
    masked = jnp.where(adm[None], scores, -jnp.inf)
    _, idx = lax.top_k(masked, n_sel)
    valid = idx <= q_pos[None, :, None]
    return idx, valid


def sparse_attend(q, k_sel, v_sel, valid):
    B, Q = q.shape[:2]
    s = jnp.einsum('bqngd,bqknd->bqngk', q, k_sel, preferred_element_type=jnp.float32) * (ATT_HEAD_DIM ** -0.5)
    s = jnp.where(valid[:, :, None, None, :], s, -jnp.inf)
    p = jax.nn.softmax(s, axis=-1)
    o = jnp.einsum('bqngk,bqknd->bqngd', p.astype(v_sel.dtype), v_sel)
    return o.reshape(B, Q, ATT_Q_DIM)


def dsa_prompt(x, w_in, w_out):
    B, T, _ = x.shape
    q, k, v, qi, ki, wi = dsa_project(x, w_in)
    n_sel = min(TOPK_MAX, T // 4)
    qb = min(Q_BLOCK, T)
    nb = T // qb

    def to_blocks(a):
        return a.reshape((B, nb, qb) + a.shape[2:]).swapaxes(0, 1)

    pos = jnp.arange(T).reshape(nb, qb)
    take = jax.vmap(lambda a, i: a[i])

    def block(args):
        q_b, qi_b, wi_b, pos_b = args
        idx, valid = select_keys(indexer_scores(qi_b, wi_b, ki), pos_b, n_sel)
        return sparse_attend(q_b, take(k, idx), take(v, idx), valid)

    o = lax.map(block, (to_blocks(q), to_blocks(qi), to_blocks(wi), pos))
    o = o.swapaxes(0, 1).reshape(B, T, ATT_Q_DIM)
    return o @ w_out, k, v, ki


def dsa_sample(x, cache_k, cache_v, cache_ki, page_table, w_in, w_out):
    B, T, _ = x.shape
    q, k, v, qi, ki, wi = dsa_project(x, w_in)
    past = page_table.shape[1] * PAGE_SIZE
    n_sel = min(TOPK_MAX, (past + T) // 4)
    ki_past = cache_ki[page_table].reshape(B, past, IDX_DIM)
    ki_all = jnp.concatenate([ki_past, ki.astype(ki_past.dtype)], axis=1)
    q_pos = past + jnp.arange(T)
    idx, valid = select_keys(indexer_scores(qi, wi, ki_all), q_pos, n_sel)
    in_past = idx < past
    pidx = jnp.minimum(idx, past - 1)
    phys = jax.vmap(lambda pt, i: pt[i])(page_table, pidx // PAGE_SIZE)
    off = pidx % PAGE_SIZE
    nidx = jnp.clip(idx - past, 0, T - 1)
    take = jax.vmap(lambda a, i: a[i])
    sel = in_past[..., None, None]
    k_sel = jnp.where(sel, cache_k[phys, off], take(k, nidx))
    v_sel = jnp.where(sel, cache_v[phys, off], take(v, nidx))
    o = sparse_attend(q, k_sel.astype(q.dtype), v_sel.astype(q.dtype), valid)
    return o @ w_out, k, v, ki


def gla_scan(q, k, v, log_a, S0):
    B, T, H, _ = q.shape
    C = math.gcd(T, GLA_CHUNK)
    n = T // C

    def chunks(a):
        return a.astype(jnp.float32).reshape((B, n, C, H) + a.shape[3:]).transpose(1, 0, 3, 2, 4)

    tri = jnp.tril(jnp.ones((C, C), dtype=bool))

    def step(S, inp):
        qc, kc, vc, gc = inp
        b = jnp.cumsum(gc, axis=2)
        diff = b[:, :, :, None, :] - b[:, :, None, :, :]
        decay = jnp.exp(jnp.where(tri[:, :, None], diff, -jnp.inf))
        A = jnp.einsum('bhtd,bhsd,bhtsd->bhts', qc, kc, decay)
        o = jnp.einsum('bhts,bhsv->bhtv', A, vc) + jnp.einsum('bhtd,bhdv->bhtv', qc * jnp.exp(b), S)
        bC = b[:, :, -1:, :]
        S_new = jnp.exp(bC[:, :, 0, :])[..., None] * S + jnp.einsum('bhsd,bhsv->bhdv', kc * jnp.exp(bC - b), vc)
        return S_new, o

    S_fin, o = lax.scan(step, S0.astype(jnp.float32), (chunks(q), chunks(k), chunks(v), chunks(log_a)))
    o = o.transpose(1, 0, 3, 2, 4).reshape(B, T, H, GLA_DV)
    return o, S_fin


def gla_mixer(x, S0, w_in, w_gate_up, b_gate, norm_g, w_out):
    B, T, _ = x.shape
    q, k, v, gd, r = jnp.split(x @ w_in, GLA_SPLITS, axis=-1)
    q = q.reshape(B, T, GLA_HEADS, GLA_DK) * (GLA_DK ** -0.5)
    k = k.reshape(B, T, GLA_HEADS, GLA_DK)
    v = v.reshape(B, T, GLA_HEADS, GLA_DV)
    glogit = (gd @ w_gate_up + b_gate).astype(jnp.float32)
    log_a = (jax.nn.log_sigmoid(glogit) / GLA_TAU).reshape(B, T, GLA_HEADS, GLA_DK)
    o, S_fin = gla_scan(q, k, v, log_a, S0)
    o = o * lax.rsqrt(jnp.mean(o * o, axis=-1, keepdims=True) + LN_EPS) * norm_g.astype(jnp.float32)
    o = o.reshape(B, T, GLA_HEADS * GLA_DV).astype(x.dtype) * jax.nn.silu(r)
    return o @ w_out, S_fin


def peer(x, w_q, keys1, keys2, u, v):
    shp = x.shape
    xf = x.reshape(-1, D_MODEL)
    n = xf.shape[0]
    pb = math.gcd(n, PEER_BLOCK)

    def block(xb):
        q = (xb @ w_q).reshape(pb, PEER_HEADS, PEER_D_KEY)
        s1 = jnp.einsum('nhd,kd->nhk', q[..., :PEER_HALF], keys1, preferred_element_type=jnp.float32)
        s2 = jnp.einsum('nhd,kd->nhk', q[..., PEER_HALF:], keys2, preferred_element_type=jnp.float32)
        t1, i1 = lax.top_k(s1, PEER_TOPK)
        t2, i2 = lax.top_k(s2, PEER_TOPK)
        cand = (t1[..., :, None] + t2[..., None, :]).reshape(pb, PEER_HEADS, PEER_TOPK * PEER_TOPK)
        cid = (i1[..., :, None] * PEER_N_KEYS + i2[..., None, :]).reshape(pb, PEER_HEADS, PEER_TOPK * PEER_TOPK)
        sc, pick = lax.top_k(cand, PEER_TOPK)
        eid = jnp.take_along_axis(cid, pick, axis=-1)
        g = jax.nn.softmax(sc, axis=-1)
        h = jax.nn.gelu(jnp.einsum('nd,nhkd->nhk', xb, u[eid], preferred_element_type=jnp.float32), approximate=False)
        return jnp.einsum('nhk,nhkd->nd', (g * h).astype(v.dtype), v[eid])

    y = lax.map(block, xf.reshape(n // pb, pb, D_MODEL))
    return y.reshape(shp).astype(x.dtype)


def setup_inputs(seed: int = 0) -> dict:
    key = jax.random.key(seed)
    ks = iter(jax.random.split(key, 32))

    def nrm(shape, scale):
        return jax.random.normal(next(ks), shape, jnp.float32) * scale

    n_pages = PAST_LEN // PAGE_SIZE
    used = DEC_BATCH * n_pages
    n_pool = used + max(1, used // 4)
    page_table = jax.random.permutation(next(ks), n_pool)[:used].reshape(DEC_BATCH, n_pages).astype(jnp.int32)
    s = D_MODEL ** -0.5
    beta = DEEPNORM_BETA
    x_prompt = nrm((BATCH, SEQ, D_MODEL), 1.0)
    x_sample = nrm((DEC_BATCH, DEC_SEQ, D_MODEL), 1.0)
    cache_k = nrm((N_ATTN_LAYERS, n_pool, PAGE_SIZE, ATT_KV_HEADS, ATT_HEAD_DIM), 1.0)
    cache_v = nrm((N_ATTN_LAYERS, n_pool, PAGE_SIZE, ATT_KV_HEADS, ATT_HEAD_DIM), beta)
    cache_kidx = nrm((N_ATTN_LAYERS, n_pool, PAGE_SIZE, IDX_DIM), 1.0)
    state_gla = nrm((N_GLA_LAYERS, DEC_BATCH, GLA_HEADS, GLA_DK, GLA_DV), 1.0)
    attn_w_in = jnp.concatenate([nrm((N_ATTN_LAYERS, D_MODEL, ATT_Q_DIM + ATT_KV_DIM), s),
                                 nrm((N_ATTN_LAYERS, D_MODEL, ATT_KV_DIM), s * beta),
                                 nrm((N_ATTN_LAYERS, D_MODEL, ATT_REST_DIM), s)], axis=-1)
    attn_w_out = nrm((N_ATTN_LAYERS, ATT_Q_DIM, D_MODEL), (ATT_Q_DIM ** -0.5) * beta)
    gla_w_in = jnp.concatenate([nrm((N_GLA_LAYERS, D_MODEL, 2 * GLA_HEADS * GLA_DK), s),
                                nrm((N_GLA_LAYERS, D_MODEL, GLA_HEADS * GLA_DV), s * beta),
                                nrm((N_GLA_LAYERS, D_MODEL, GLA_GATE_RANK + GLA_HEADS * GLA_DV), s)], axis=-1)
    gla_w_gate_up = nrm((N_GLA_LAYERS, GLA_GATE_RANK, GLA_HEADS * GLA_DK), GLA_GATE_RANK ** -0.5)
    gla_b_gate = nrm((N_GLA_LAYERS, GLA_HEADS * GLA_DK), 0.1)
    gla_norm_g = 1.0 + nrm((N_GLA_LAYERS, GLA_DV), 0.02)
    gla_w_out = nrm((N_GLA_LAYERS, GLA_HEADS * GLA_DV, D_MODEL), ((GLA_HEADS * GLA_DV) ** -0.5) * beta)
    peer_w_q = nrm((DEPTH, D_MODEL, PEER_HEADS * PEER_D_KEY), s)
    peer_keys1 = nrm((DEPTH, PEER_N_KEYS, PEER_HALF), PEER_HALF ** -0.5)
    peer_keys2 = nrm((DEPTH, PEER_N_KEYS, PEER_HALF), PEER_HALF ** -0.5)
    peer_u = nrm((DEPTH, PEER_N_EXPERTS, D_MODEL), s)
    peer_v = nrm((DEPTH, PEER_N_EXPERTS, D_MODEL), ((PEER_HEADS * PEER_TOPK) ** -0.5) * beta)
    ln1_g = 1.0 + nrm((DEPTH, D_MODEL), 0.02)
    ln1_b = nrm((DEPTH, D_MODEL), 0.02)
    ln2_g = 1.0 + nrm((DEPTH, D_MODEL), 0.02)
    ln2_b = nrm((DEPTH, D_MODEL), 0.02)
    return {'x_prompt': x_prompt, 'x_sample': x_sample, 'cache_k': cache_k, 'cache_v': cache_v,
            'cache_kidx': cache_kidx, 'state_gla': state_gla, 'page_table': page_table,
            'attn_w_in': attn_w_in, 'attn_w_out': attn_w_out, 'gla_w_in': gla_w_in,
            'gla_w_gate_up': gla_w_gate_up, 'gla_b_gate': gla_b_gate, 'gla_norm_g': gla_norm_g,
            'gla_w_out': gla_w_out, 'peer_w_q': peer_w_q, 'peer_keys1': peer_keys1,
            'peer_keys2': peer_keys2, 'peer_u': peer_u, 'peer_v': peer_v,
            'ln1_g': ln1_g, 'ln1_b': ln1_b, 'ln2_g': ln2_g, 'ln2_b': ln2_b}


def reference(x_prompt, x_sample, cache_k, cache_v, cache_kidx, state_gla, page_table,
              attn_w_in, attn_w_out, gla_w_in, gla_w_gate_up, gla_b_gate, gla_norm_g, gla_w_out,
              peer_w_q, peer_keys1, peer_keys2, peer_u, peer_v, ln1_g, ln1_b, ln2_g, ln2_b):
    hp, hs = x_prompt, x_sample
    kp_l, vp_l, kip_l, sp_l = [], [], [], []
    ks_l, vs_l, kis_l, ss_l = [], [], [], []
    for i in range(DEPTH):
        j = i // N_MIXERS
        if i % N_MIXERS == 0:
            yp, kp, vp, kip = dsa_prompt(hp, attn_w_in[j], attn_w_out[j])
            ys, ks_, vs_, kis = dsa_sample(hs, cache_k[j], cache_v[j], cache_kidx[j], page_table,
                                           attn_w_in[j], attn_w_out[j])
            kp_l.append(kp); vp_l.append(vp); kip_l.append(kip)
            ks_l.append(ks_); vs_l.append(vs_); kis_l.append(kis)
        else:
            S0 = jnp.zeros((hp.shape[0], GLA_HEADS, GLA_DK, GLA_DV), jnp.float32)
            yp, sp = gla_mixer(hp, S0, gla_w_in[j], gla_w_gate_up[j], gla_b_gate[j], gla_norm_g[j], gla_w_out[j])
            ys, ss = gla_mixer(hs, state_gla[j], gla_w_in[j], gla_w_gate_up[j], gla_b_gate[j], gla_norm_g[j], gla_w_out[j])
            sp_l.append(sp); ss_l.append(ss)
        hp = layer_norm(DEEPNORM_ALPHA * hp + yp, ln1_g[i], ln1_b[i])
        hs = layer_norm(DEEPNORM_ALPHA * hs + ys, ln1_g[i], ln1_b[i])
        hp = layer_norm(DEEPNORM_ALPHA * hp + peer(hp, peer_w_q[i], peer_keys1[i], peer_keys2[i], peer_u[i], peer_v[i]), ln2_g[i], ln2_b[i])
        hs = layer_norm(DEEPNORM_ALPHA * hs + peer(hs, peer_w_q[i], peer_keys1[i], peer_keys2[i], peer_u[i], peer_v[i]), ln2_g[i], ln2_b[i])
    return (hp, hs, jnp.stack(kp_l), jnp.stack(vp_l), jnp.stack(kip_l), jnp.stack(sp_l),
            jnp.stack(ks_l), jnp.stack(vs_l), jnp.stack(kis_l), jnp.stack(ss_l))
```

```cpp
#define HYBRID_K 11
#include <hip/hip_runtime.h>
#include <cstdio>
#include <cstdint>
#include <cmath>

constexpr int D = 1024;
constexpr int NBATCH = 2, SEQ = 8192, TP = NBATCH * SEQ;
constexpr int DB = 32, DS = 4, TS = DB * DS;
constexpr int TA = TP + TS;
constexpr int PAST = 8192, PAGE = 128, NPAGES = PAST / PAGE;
constexpr float ALPHA = 1.4142135623730951f;
constexpr float LN_EPS = 1e-5f;
constexpr int ATT_N = 2120;
constexpr int AQ = 0, AK = 1024, AV = 1280, AQI = 1536, AKI = 2048, AWI = 2112;
constexpr int TOPK = 256;
constexpr int GLA_N = 3088;
constexpr int GQ = 0, GK = 512, GV = 1024, GGD = 2048, GR = 2064;
constexpr int PEER_N = 2048;
constexpr int SCS_LD = 8256;

constexpr size_t OUT_Y = 0, OUT_KP = 16908288, OUT_VP = 21102592, OUT_KIP = 25296896, OUT_SP = 26345472,
                 OUT_KS = 26607616, OUT_VS = 26640384, OUT_KIS = 26673152, OUT_SS = 26681344, OUT_TOTAL = 30875648;


namespace nv {

__global__ void concat_x(const float* __restrict__ xp, const float* __restrict__ xs, float* __restrict__ X) {
    size_t i = (size_t)blockIdx.x * blockDim.x + threadIdx.x, n = (size_t)TA * D / 4, np = (size_t)TP * D / 4;
    for (; i < n; i += (size_t)gridDim.x * blockDim.x) ((float4*)X)[i] = i < np ? ((const float4*)xp)[i] : ((const float4*)xs)[i - np];
}

__global__ __launch_bounds__(256) void gemm_f32(const float* __restrict__ A, int lda, const float* __restrict__ W, int N, int K, float* __restrict__ C, int ldc, int M) {
    __shared__ float As[16][65];
    __shared__ float Ws[16][64];
    const int tx = threadIdx.x & 15, ty = threadIdx.x >> 4;
    const int m0 = blockIdx.y * 64, n0 = blockIdx.x * 64;
    float acc[4][4];
#pragma unroll
    for (int i = 0; i < 4; ++i)
#pragma unroll
        for (int j = 0; j < 4; ++j) acc[i][j] = 0.f;
    for (int k0 = 0; k0 < K; k0 += 16) {
#pragma unroll
        for (int i = 0; i < 4; ++i) { const int e = threadIdx.x + i * 256, r = e >> 4, kk = e & 15, gm = m0 + r; As[kk][r] = gm < M ? A[(size_t)gm * lda + k0 + kk] : 0.f; }
#pragma unroll
        for (int i = 0; i < 4; ++i) { const int e = threadIdx.x + i * 256, kk = e >> 6, c = e & 63, gn = n0 + c; Ws[kk][c] = gn < N ? W[(size_t)(k0 + kk) * N + gn] : 0.f; }
        __syncthreads();
#pragma unroll
        for (int kk = 0; kk < 16; ++kk) {
            float a[4], b[4];
#pragma unroll
            for (int i = 0; i < 4; ++i) { a[i] = As[kk][ty * 4 + i]; b[i] = Ws[kk][tx * 4 + i]; }
#pragma unroll
            for (int i = 0; i < 4; ++i)
#pragma unroll
                for (int j = 0; j < 4; ++j) acc[i][j] += a[i] * b[j];
        }
        __syncthreads();
    }
#pragma unroll
    for (int i = 0; i < 4; ++i) { const int gm = m0 + ty * 4 + i; if (gm < M) {
#pragma unroll
        for (int j = 0; j < 4; ++j) { const int gn = n0 + tx * 4 + j; if (gn < N) C[(size_t)gm * ldc + gn] = acc[i][j]; } } }
}

__global__ void scatter_kv(const float* __restrict__ P, float* __restrict__ out) {
    const int row = blockIdx.x;
    const float* p = P + (size_t)row * ATT_N;
    float *ok, *ov, *oki;
    if (row < TP) { ok = out + OUT_KP + (size_t)row * 256; ov = out + OUT_VP + (size_t)row * 256; oki = out + OUT_KIP + (size_t)row * 64; }
    else { const int r = row - TP; ok = out + OUT_KS + (size_t)r * 256; ov = out + OUT_VS + (size_t)r * 256; oki = out + OUT_KIS + (size_t)r * 64; }
    const int t = threadIdx.x;
    ok[t] = p[AK + t]; ov[t] = p[AV + t]; if (t < 64) oki[t] = p[AKI + t];
}

template <bool SAMPLE, int QT>
__global__ __launch_bounds__(256) void idx_scores(const float* __restrict__ P, const float* __restrict__ cache_ki, const int* __restrict__ page_table, float* __restrict__ SC) {
    __shared__ float qs[QT][512];
    __shared__ float ks[64][65];
    __shared__ float ws_[QT][8];
    const int b = blockIdx.z, q0 = blockIdx.y * QT, l0 = blockIdx.x * 64, tid = threadIdx.x;
    if (!SAMPLE && l0 > q0 + QT - 1) return;
    const int L = SAMPLE ? PAST + DS : SEQ;
    const size_t tok0 = SAMPLE ? (size_t)TP + b * DS + q0 : (size_t)b * SEQ + q0;
    for (int e = tid; e < QT * 512; e += 256) { const int r = e >> 9, c = e & 511; qs[r][c] = P[(tok0 + r) * ATT_N + AQI + c]; }
    for (int e = tid; e < QT * 8; e += 256) { const int r = e >> 3, c = e & 7; ws_[r][c] = P[(tok0 + r) * ATT_N + AWI + c] * 0.35355339059327373f; }
    for (int e = tid; e < 64 * 64; e += 256) {
        const int r = e >> 6, c = e & 63, l = l0 + r; float v = 0.f;
        if (l < L) {
            if (!SAMPLE) v = P[((size_t)b * SEQ + l) * ATT_N + AKI + c];
            else if (l < PAST) { const int phys = page_table[b * NPAGES + l / PAGE]; v = cache_ki[((size_t)phys * PAGE + (l % PAGE)) * 64 + c]; }
            else v = P[((size_t)TP + b * DS + (l - PAST)) * ATT_N + AKI + c];
        }
        ks[r][c] = v;
    }
    __syncthreads();
    constexpr int PER = QT * 64 / 256;
#pragma unroll
    for (int i = 0; i < PER; ++i) {
        const int e = tid + i * 256, r = e >> 6, c = e & 63, l = l0 + c;
        float s = 0.f;
        for (int h = 0; h < 8; ++h) { float d = 0.f;
#pragma unroll 8
            for (int k = 0; k < 64; ++k) d += qs[r][h * 64 + k] * ks[c][k];
            d *= 0.125f; s += fmaxf(d, 0.f) * ws_[r][h]; }
        if (l < L) { if (SAMPLE) SC[(size_t)(b * DS + q0 + r) * SCS_LD + l] = s; else SC[((size_t)b * SEQ + q0 + r) * SEQ + l] = s; }
    }
}

#define WAVE_LDS_FENCE() asm volatile("s_waitcnt vmcnt(0) lgkmcnt(0)" ::: "memory")

template <int CAP>
__device__ __forceinline__ void topk_wave(const float* __restrict__ row, int n, int* __restrict__ out, unsigned* hist, float* cv, int* ci, int lane) {
    if (n <= TOPK) { for (int i = lane; i < TOPK; i += 64) out[i] = i < n ? i : 0; return; }
    float mn = INFINITY, mx = -INFINITY;
    for (int i = lane; i < n; i += 64) { const float s = row[i]; mn = fminf(mn, s); mx = fmaxf(mx, s); }
#pragma unroll
    for (int o = 1; o < 64; o <<= 1) { mn = fminf(mn, __shfl_xor(mn, o)); mx = fmaxf(mx, __shfl_xor(mx, o)); }
    if (!(mx > mn)) { for (int i = lane; i < TOPK; i += 64) out[i] = i; return; }
    const float scale = 2048.0f / (mx - mn);
    for (int i = lane; i < 2048; i += 64) hist[i] = 0u;
    WAVE_LDS_FENCE();
    for (int i = lane; i < n; i += 64) { const float s = row[i]; int bn = (int)((s - mn) * scale); bn = bn > 2047 ? 2047 : bn; atomicAdd(&hist[bn], 1u); }
    WAVE_LDS_FENCE();
    unsigned mine = 0u;
    for (int j = 0; j < 32; ++j) mine += hist[lane * 32 + j];
    unsigned suf = mine;
#pragma unroll
    for (int o = 1; o < 64; o <<= 1) { const unsigned t = __shfl_down(suf, o); if (lane + o < 64) suf += t; }
    const unsigned long long bal = __ballot(suf >= (unsigned)TOPK);
    const int Lt = 63 - __builtin_clzll(bal);
    unsigned running = __shfl(suf, Lt) - __shfl(mine, Lt);
    int B = Lt * 32;
    for (int j = 31; j >= 0; --j) { const unsigned h = hist[Lt * 32 + j]; if (running + h >= (unsigned)TOPK) { B = Lt * 32 + j; break; } running += h; }
    const int cnt_gt = (int)running, r = TOPK - cnt_gt;
    int base_gt = 0, base_eq = 0;
    for (int i0 = 0; i0 < n; i0 += 64) {
        const int i = i0 + lane; bool gt = false, eq = false; float s = 0.f;
        if (i < n) { s = row[i]; int bn = (int)((s - mn) * scale); bn = bn > 2047 ? 2047 : bn; gt = bn > B; eq = bn == B; }
        const unsigned long long mg = __ballot(gt), me = __ballot(eq);
        const unsigned long long below = (1ull << lane) - 1ull;
        if (gt) out[base_gt + __builtin_popcountll(mg & below)] = i;
        if (eq) { const int p = base_eq + __builtin_popcountll(me & below); if (p < CAP) { cv[p] = s; ci[p] = i; } }
        base_gt += __builtin_popcountll(mg); base_eq += __builtin_popcountll(me);
    }
    WAVE_LDS_FENCE();
    const int m = base_eq < CAP ? base_eq : CAP;
    for (int c = lane; c < m; c += 64) {
        const float v = cv[c]; const int id = ci[c]; int rank = 0;
        for (int c2 = 0; c2 < m; ++c2) { const float v2 = cv[c2]; const int id2 = ci[c2]; rank += (v2 > v || (v2 == v && id2 < id)) ? 1 : 0; }
        if (rank < r) out[cnt_gt + rank] = id;
    }
    WAVE_LDS_FENCE();
}

__global__ __launch_bounds__(256) void topk_rows(const float* __restrict__ SCP, const float* __restrict__ SCS, int* __restrict__ IDX, int* __restrict__ CNT) {
    constexpr int CAP = 1024;
    __shared__ unsigned hist[4][2048];
    __shared__ float cv[4][CAP];
    __shared__ int ci[4][CAP];
    const int w = threadIdx.x >> 6, lane = threadIdx.x & 63;
    const int row = blockIdx.x * 4 + w;
    if (row >= TA) return;
    const float* rp; int n;
    if (row < TP) { rp = SCP + (size_t)row * SEQ; n = (row % SEQ) + 1; }
    else { const int r = row - TP; rp = SCS + (size_t)r * SCS_LD; n = PAST + (r % DS) + 1; }
    topk_wave<CAP>(rp, n, IDX + (size_t)row * TOPK, hist[w], cv[w], ci[w], lane);
    if (lane == 0) CNT[row] = n < TOPK ? n : TOPK;
}

template <bool SAMPLE>
__global__ __launch_bounds__(256) void attn_naive(const float* __restrict__ P, const int* __restrict__ IDX, const int* __restrict__ CNT, const float* __restrict__ cache_k, const float* __restrict__ cache_v,
                                                  const int* __restrict__ page_table, float* __restrict__ O) {
    __shared__ float qs[1024];
    __shared__ float ps[16][256];
    __shared__ const float* vptr[256];
    const int r = blockIdx.x, tid = threadIdx.x;
    const int row = SAMPLE ? TP + r : r;
    const int b = SAMPLE ? r / DS : r / SEQ;
    for (int e = tid; e < 1024; e += 256) qs[e] = P[(size_t)row * ATT_N + AQ + e];
    const int cnt = CNT[row];
    const bool valid = tid < cnt;
    const int idx = valid ? IDX[(size_t)row * TOPK + tid] : 0;
    const float *krow, *vrow;
    if (!SAMPLE) { krow = P + ((size_t)b * SEQ + idx) * ATT_N + AK; vrow = P + ((size_t)b * SEQ + idx) * ATT_N + AV; }
    else if (idx < PAST) { const int phys = page_table[b * NPAGES + idx / PAGE]; const size_t o = ((size_t)phys * PAGE + (idx % PAGE)) * 256; krow = cache_k + o; vrow = cache_v + o; }
    else { const size_t tk = (size_t)TP + b * DS + (idx - PAST); krow = P + tk * ATT_N + AK; vrow = P + tk * ATT_N + AV; }
    vptr[tid] = vrow;
    __syncthreads();
    for (int hh = 0; hh < 16; ++hh) { const int n = hh >> 2; float s = 0.f;
        for (int d = 0; d < 64; ++d) s += qs[hh * 64 + d] * krow[n * 64 + d];
        ps[hh][tid] = valid ? s * 0.125f : -INFINITY; }
    __syncthreads();
    { const int w = tid >> 6, lane = tid & 63;
      for (int hh = w * 4; hh < w * 4 + 4; ++hh) {
          float v[4]; float m = -INFINITY;
#pragma unroll
          for (int i = 0; i < 4; ++i) { v[i] = ps[hh][lane + 64 * i]; m = fmaxf(m, v[i]); }
#pragma unroll
          for (int o = 1; o < 64; o <<= 1) m = fmaxf(m, __shfl_xor(m, o));
          float sum = 0.f;
#pragma unroll
          for (int i = 0; i < 4; ++i) { v[i] = expf(v[i] - m); sum += v[i]; }
#pragma unroll
          for (int o = 1; o < 64; o <<= 1) sum += __shfl_xor(sum, o);
          const float inv = 1.f / sum;
#pragma unroll
          for (int i = 0; i < 4; ++i) ps[hh][lane + 64 * i] = v[i] * inv;
      } }
    __syncthreads();
#pragma unroll
    for (int c = 0; c < 4; ++c) { const int col = tid + 256 * c, hh = col >> 6, n = hh >> 2, d = col & 63; float o = 0.f;
        for (int j = 0; j < TOPK; ++j) o += ps[hh][j] * vptr[j][n * 64 + d];
        O[(size_t)row * 1024 + col] = o; }
}

__device__ __forceinline__ float block_sum_256(float v, float* red) {
#pragma unroll
    for (int o = 1; o < 64; o <<= 1) v += __shfl_xor(v, o);
    __syncthreads();
    if ((threadIdx.x & 63) == 0) red[threadIdx.x >> 6] = v;
    __syncthreads();
    return (red[0] + red[1]) + (red[2] + red[3]);
}

__global__ __launch_bounds__(256) void ln_res(const float* __restrict__ xin, const float* __restrict__ y, const float* __restrict__ g, const float* __restrict__ bt, float* __restrict__ out) {
    __shared__ float red[4];
    const int row = blockIdx.x, tid = threadIdx.x;
    float z[4]; float s = 0.f;
#pragma unroll
    for (int i = 0; i < 4; ++i) { const int c = tid + 256 * i; z[i] = ALPHA * xin[(size_t)row * D + c] + y[(size_t)row * D + c]; s += z[i]; }
    const float mean = block_sum_256(s, red) * (1.f / D);
    float q = 0.f;
#pragma unroll
    for (int i = 0; i < 4; ++i) { z[i] -= mean; q += z[i] * z[i]; }
    const float rstd = rsqrtf(block_sum_256(q, red) * (1.f / D) + LN_EPS);
#pragma unroll
    for (int i = 0; i < 4; ++i) { const int c = tid + 256 * i; out[(size_t)row * D + c] = z[i] * rstd * g[c] + bt[c]; }
}

__global__ __launch_bounds__(256) void peer_naive(const float* __restrict__ Hin, const float* __restrict__ PQ, const float* __restrict__ keys1, const float* __restrict__ keys2,
                                                  const float* __restrict__ U, const float* __restrict__ V, const float* __restrict__ g2, const float* __restrict__ b2, float* __restrict__ out) {
    __shared__ float sc[8][2][128];
    __shared__ float xs[1024];
    __shared__ float tv[8][2][16];
    __shared__ int ti[8][2][16];
    __shared__ unsigned char taken[8][256];
    __shared__ float wk[128];
    __shared__ int eid[128];
    __shared__ float red[4];
    const int t = blockIdx.x, tid = threadIdx.x;
    for (int e = tid; e < 1024; e += 256) xs[e] = Hin[(size_t)t * D + e];
    for (int e = tid; e < 2048; e += 256) { const int h = e >> 8, half = (e >> 7) & 1, k = e & 127;
        const float* q = PQ + (size_t)t * PEER_N + h * 256 + half * 128; const float* ky = (half ? keys2 : keys1) + (size_t)k * 128; float s = 0.f;
        for (int d = 0; d < 128; ++d) s += q[d] * ky[d];
        sc[h][half][k] = s; }
    for (int e = tid; e < 8 * 256; e += 256) taken[e >> 8][e & 255] = 0;
    __syncthreads();
    if (tid < 16) { const int h = tid >> 1, half = tid & 1;
        for (int it = 0; it < 16; ++it) { float best = -INFINITY; int bi = 0;
            for (int k = 0; k < 128; ++k) { const float v = sc[h][half][k]; if (v > best) { best = v; bi = k; } }
            tv[h][half][it] = best; ti[h][half][it] = bi; sc[h][half][bi] = -INFINITY; } }
    __syncthreads();
    if (tid < 8) { const int h = tid; float mx = 0.f, sum = 0.f;
        for (int it = 0; it < 16; ++it) { float best = -INFINITY; int bf = 0;
            for (int f = 0; f < 256; ++f) { if (taken[h][f]) continue; const float v = tv[h][0][f >> 4] + tv[h][1][f & 15]; if (v > best) { best = v; bf = f; } }
            taken[h][bf] = 1; if (it == 0) mx = best;
            const float ev = expf(best - mx); sum += ev; wk[h * 16 + it] = ev;
            eid[h * 16 + it] = ti[h][0][bf >> 4] * 128 + ti[h][1][bf & 15]; }
        const float inv = 1.f / sum;
        for (int it = 0; it < 16; ++it) wk[h * 16 + it] *= inv; }
    __syncthreads();
    { const int w = tid >> 6, lane = tid & 63;
      for (int e = w * 32; e < w * 32 + 32; ++e) { const float* u = U + (size_t)eid[e] * D; float s = 0.f;
#pragma unroll
          for (int i = 0; i < 16; ++i) s += xs[lane + 64 * i] * u[lane + 64 * i];
#pragma unroll
          for (int o = 1; o < 64; o <<= 1) s += __shfl_xor(s, o);
          if (lane == 0) { const float ge = 0.5f * s * (1.f + erff(s * 0.70710678118654752f)); wk[e] = wk[e] * ge; } } }
    __syncthreads();
    float y[4] = {0.f, 0.f, 0.f, 0.f};
    for (int e = 0; e < 128; ++e) { const float4 vv = *(const float4*)(V + (size_t)eid[e] * D + tid * 4); const float w = wk[e]; y[0] += w * vv.x; y[1] += w * vv.y; y[2] += w * vv.z; y[3] += w * vv.w; }
    float z[4]; float s = 0.f;
#pragma unroll
    for (int i = 0; i < 4; ++i) { z[i] = ALPHA * xs[tid * 4 + i] + y[i]; s += z[i]; }
    const float mean = block_sum_256(s, red) * (1.f / D);
    float q = 0.f;
#pragma unroll
    for (int i = 0; i < 4; ++i) { z[i] -= mean; q += z[i] * z[i]; }
    const float rstd = rsqrtf(block_sum_256(q, red) * (1.f / D) + LN_EPS);
#pragma unroll
    for (int i = 0; i < 4; ++i) { const int c = tid * 4 + i; out[(size_t)t * D + c] = z[i] * rstd * g2[c] + b2[c]; }
}

__global__ void gla_gate(const float* __restrict__ G, const float* __restrict__ Wg, const float* __restrict__ bg, float* __restrict__ LA) {
    const int t = blockIdx.x, c = threadIdx.x;
    float x = 0.f;
    for (int r = 0; r < 16; ++r) x += G[(size_t)t * GLA_N + GGD + r] * Wg[r * 512 + c];
    x += bg[c];
    const float ls = fminf(x, 0.f) - log1pf(expf(-fabsf(x)));
    LA[(size_t)t * 512 + c] = ls * (1.f / 16.f);
}

__global__ __launch_bounds__(256) void gla_rec(const float* __restrict__ G, const float* __restrict__ LA, const float* __restrict__ S0, int T, int tokbase, float* __restrict__ OG, float* __restrict__ Sout) {
    __shared__ float part[2][4][64];
    const int vg = blockIdx.x, h = blockIdx.y, b = blockIdx.z, lane = threadIdx.x & 63, dq = __builtin_amdgcn_readfirstlane(threadIdx.x >> 6);
    const int v = vg * 64 + lane, d0 = dq * 32;
    float S[32];
#pragma unroll
    for (int i = 0; i < 32; ++i) S[i] = S0 ? S0[(((size_t)b * 4 + h) * 128 + d0 + i) * 256 + v] : 0.f;
    for (int t = 0; t < T; ++t) {
        const size_t tok = (size_t)tokbase + (size_t)b * T + t;
        const float* g = G + tok * GLA_N;
        const float* la = LA + tok * 512 + h * 128 + d0;
        const float* qp = g + GQ + h * 128 + d0;
        const float* kp = g + GK + h * 128 + d0;
        const float vv = g[GV + h * 256 + v];
        float o = 0.f;
#pragma unroll
        for (int i = 0; i < 32; ++i) { const float a = expf(la[i]); S[i] = a * S[i] + kp[i] * vv; o += (qp[i] * 0.08838834764831845f) * S[i]; }
        part[t & 1][dq][lane] = o;
        __syncthreads();
        if (dq == 0) OG[tok * 1024 + h * 256 + v] = (part[t & 1][0][lane] + part[t & 1][1][lane]) + (part[t & 1][2][lane] + part[t & 1][3][lane]);
    }
#pragma unroll
    for (int i = 0; i < 32; ++i) Sout[(((size_t)b * 4 + h) * 128 + d0 + i) * 256 + v] = S[i];
}

__global__ __launch_bounds__(256) void gla_post(const float* __restrict__ OG, const float* __restrict__ G, const float* __restrict__ ng, float* __restrict__ OGN) {
    __shared__ float red[4];
    const int t = blockIdx.x, tid = threadIdx.x;
    for (int h = 0; h < 4; ++h) {
        const float o = OG[(size_t)t * 1024 + h * 256 + tid];
        const float ms = block_sum_256(o * o, red) * (1.f / 256.f);
        const float r = G[(size_t)t * GLA_N + GR + h * 256 + tid];
        const float sl = r / (1.f + expf(-r));
        OGN[(size_t)t * 1024 + h * 256 + tid] = o * rsqrtf(ms + LN_EPS) * ng[tid] * sl;
    }
}

}


namespace pg8 {
#define PG8_LAS __attribute__((address_space(3)))
typedef unsigned short bf16_t;
typedef short bf16x8 __attribute__((ext_vector_type(8)));
typedef float f32x4 __attribute__((ext_vector_type(4)));
typedef unsigned u32x4 __attribute__((ext_vector_type(4)));
constexpr int BM = 256, BK = 64, HALF = 128, HTB = HALF * BK * 2  , STAGE_BYTES = 8 * HTB, NXCD = 8, WGM = 8;

__host__ __device__ __forceinline__ int lds_byte(int r, int c) { const int st = (r >> 4) * 2 + (c >> 5), rr = r & 15, cc = c & 31, ob = rr * 64 + cc * 2; return st * 1024 + (ob ^ (((ob >> 9) & 1) << 5)); }
__host__ __device__ __forceinline__ void stage_rc(int b, int& R, int& C) { const int st = b / 1024, sb = b % 1024, swz = sb ^ (((sb >> 9) & 1) << 5); R = (st >> 1) * 16 + swz / 64; C = (st & 1) * 32 + (swz % 64) / 2; }
__host__ __device__ __forceinline__ int perm32(int rho) { const int n = rho >> 4, i = rho & 15; return 8 * (i >> 2) + 4 * n + (i & 3); }

struct Unit { int pm, pn; };
struct Gemm { const bf16_t* A; const bf16_t* Bt; int M, N, K; };

struct StaticOrder {
    int nM, nN, nwg, G, c;
    __host__ __device__ void init(int M, int N, int G_, int c_) { nM = M / BM; nN = N / BM; nwg = nM * nN; G = G_; c = c_; }
    __host__ __device__ bool next(int i, Unit& u) const {
        const long L = (long)i * G + c; if (L >= nwg) return false;
        int wgid = (int)L; { const int q = nwg / NXCD, r = nwg % NXCD, xcd = wgid % NXCD, off = wgid / NXCD; wgid = (xcd < r ? xcd * (q + 1) : r * (q + 1) + (xcd - r) * q) + off; }
        const int nig = WGM * nN, gid = wgid / nig, fm = gid * WGM, gsz = (nM - fm) < WGM ? (nM - fm) : WGM;
        u.pm = fm + ((wgid % nig) % gsz); u.pn = (wgid % nig) / gsz; return true;
    }
    __device__ __forceinline__ void a_ready(const Unit&) const {}
    __device__ __forceinline__ void done(const Unit&) const {}
};

__device__ __forceinline__ unsigned cvt_pk_bf16(float lo, float hi) { unsigned r; asm volatile("v_cvt_pk_bf16_f32 %0, %1, %2" : "=v"(r) : "v"(lo), "v"(hi)); return r; }
template <class F> struct EpiRow8 {
    static constexpr bool PERM = true, AFTER_DRAIN = false;
    F f;
    __device__ __forceinline__ void operator()(const f32x4 (&acc)[2][2][4][2], const Unit& u, int wr, int wc, int fr, int fq) const {
        const int row0 = u.pm * BM + wr * 64 + fr, col0 = u.pn * BM + wc * 32 + 8 * fq;
#pragma unroll
        for (int ai = 0; ai < 2; ++ai)
#pragma unroll
            for (int m = 0; m < 4; ++m)
#pragma unroll
                for (int bj = 0; bj < 2; ++bj) f.put8(row0 + ai * HALF + m * 16, col0 + bj * HALF, acc[ai][bj][m][0], acc[ai][bj][m][1]);
    }
};


template <class Epi, class Sched, bool ALIGN_EPI = false, bool SP2 = false>
__device__ __forceinline__ void gemm_phase(PG8_LAS unsigned char* lds, const Gemm g, const Sched& S, const Epi& E) {
    const int tid = threadIdx.x, wid = __builtin_amdgcn_readfirstlane(tid >> 6), lane = tid & 63, wr = wid >> 2, wc = wid & 3, fr = lane & 15, fq = lane >> 4;
    const int K = g.K, nt = K / BK;
    unsigned voffA[2], voffB[2];
#pragma unroll
    for (int i = 0; i < 2; ++i) { int R, C; stage_rc(tid * 16 + i * 8192, R, C); const int Rb = Epi::PERM ? ((R & ~31) + perm32(R & 31)) : R;
        voffA[i] = (unsigned)(R * K + C) * 2u; voffB[i] = (unsigned)(Rb * K + C) * 2u; }
    const size_t kstep = (size_t)(BK * 2);
    const size_t hstep = (size_t)HALF * K * 2;
    const size_t tstep = 2 * hstep;
    const unsigned ldsw = (unsigned)wid * 1024u;
    const int aoff = lds_byte(wr * 64 + fr, fq * 8), boff = lds_byte(wc * 32 + fr, fq * 8);
#define PG8_SA(b, h) (((b) * 2 + (h)) * HTB)
#define PG8_SB(b, h) ((4 + (b) * 2 + (h)) * HTB)
#define PG8_STAGE(bufoff, gbase, voff) do { _Pragma("unroll") for (int _i = 0; _i < 2; ++_i) \
        __builtin_amdgcn_global_load_lds((const unsigned*)((const char*)(gbase) + (voff)[_i]), (PG8_LAS unsigned*)(lds + (bufoff) + ldsw + _i * 8192), 16, 0, 0); } while (0)
#define PG8_LDA(dst, b, h) do { _Pragma("unroll") for (int m = 0; m < 4; ++m) _Pragma("unroll") for (int k = 0; k < 2; ++k) dst[m][k] = *(const PG8_LAS bf16x8*)(lds + PG8_SA(b, h) + aoff + m * 2048 + k * 1024); } while (0)
#define PG8_LDB(dst, b, h) do { _Pragma("unroll") for (int n = 0; n < 2; ++n) _Pragma("unroll") for (int k = 0; k < 2; ++k) dst[n][k] = *(const PG8_LAS bf16x8*)(lds + PG8_SB(b, h) + boff + n * 2048 + k * 1024); } while (0)
#define PG8_MMA(ai, bj, At, Bt) do { __builtin_amdgcn_s_setprio(1); _Pragma("unroll") for (int m = 0; m < 4; ++m) _Pragma("unroll") for (int n = 0; n < 2; ++n) _Pragma("unroll") for (int k = 0; k < 2; ++k) \
        acc[ai][bj][m][n] = __builtin_amdgcn_mfma_f32_16x16x32_bf16(Bt[n][k], At[m][k], acc[ai][bj][m][n], 0, 0, 0); __builtin_amdgcn_s_setprio(0); } while (0)
#define PG8_WAIT_V(n) asm volatile("s_waitcnt vmcnt(" #n ")" ::: "memory")
#define PG8_WAIT_L(n) asm volatile("s_waitcnt lgkmcnt(" #n ")" ::: "memory")
#define PG8_BAR __builtin_amdgcn_s_barrier()
#define PG8_SCHED __builtin_amdgcn_sched_barrier(0)
    Unit cur, nxt; int ui = 0;
    if (!S.next(0, cur)) return;
    f32x4 acc[2][2][4][2];
#pragma unroll
    for (int a = 0; a < 2; ++a)
#pragma unroll
        for (int b = 0; b < 2; ++b)
#pragma unroll
            for (int m = 0; m < 4; ++m)
#pragma unroll
                for (int n = 0; n < 2; ++n) acc[a][b][m][n] = (f32x4){0.f, 0.f, 0.f, 0.f};
    bf16x8 At[4][2], B0[2][2], B1[2][2];
    const char* cA = (const char*)g.A + (size_t)cur.pm * tstep; const char* cB = (const char*)g.Bt + (size_t)cur.pn * tstep;
    S.a_ready(cur);
    if constexpr (SP2) {
        PG8_STAGE(PG8_SB(0, 0), cB, voffB); PG8_STAGE(PG8_SB(0, 1), cB + hstep, voffB); PG8_STAGE(PG8_SA(0, 0), cA, voffA); PG8_STAGE(PG8_SA(0, 1), cA + hstep, voffA);
        if (wr == 1) PG8_BAR;
        PG8_WAIT_V(2); PG8_BAR;
        PG8_STAGE(PG8_SB(1, 0), cB + kstep, voffB); PG8_STAGE(PG8_SA(1, 0), cA + kstep, voffA); PG8_STAGE(PG8_SB(1, 1), cB + hstep + kstep, voffB);
        PG8_WAIT_V(6); PG8_BAR;
    } else {
        PG8_STAGE(PG8_SB(0, 0), cB, voffB); PG8_STAGE(PG8_SA(0, 0), cA, voffA); PG8_STAGE(PG8_SB(0, 1), cB + hstep, voffB); PG8_STAGE(PG8_SA(0, 1), cA + hstep, voffA);
        if (wr == 1) PG8_BAR;
        PG8_WAIT_V(4); PG8_BAR;
        PG8_STAGE(PG8_SB(1, 0), cB + kstep, voffB); PG8_STAGE(PG8_SA(1, 0), cA + kstep, voffA); PG8_STAGE(PG8_SB(1, 1), cB + hstep + kstep, voffB);
        PG8_WAIT_V(6); PG8_BAR;
    }
    for (;;) {
        const bool has_next = S.next(ui + 1, nxt);
        const char* nA = has_next ? (const char*)g.A + (size_t)nxt.pm * tstep : cA; const char* nB = has_next ? (const char*)g.Bt + (size_t)nxt.pn * tstep : cB;
        for (int t = 0; t < nt; t += 2) {
            const bool last = (t == nt - 2);
            const char* a1 = cA + (size_t)(t + 1) * kstep;
            const char* a2 = last ? nA : cA + (size_t)(t + 2) * kstep; const char* b2 = last ? nB : cB + (size_t)(t + 2) * kstep;
            const char* a3 = a2 + kstep; const char* b3 = b2 + kstep;
            if (last && has_next) S.a_ready(nxt);
            if constexpr (SP2) {
            PG8_LDB(B0, 0, 0); PG8_LDB(B1, 0, 1); PG8_SCHED; PG8_LDA(At, 0, 0); PG8_STAGE(PG8_SA(1, 1), a1 + hstep, voffA);
            PG8_WAIT_V(8); PG8_WAIT_L(0); PG8_BAR; PG8_MMA(0, 0, At, B0); PG8_MMA(0, 1, At, B1); PG8_BAR; PG8_SCHED;
            PG8_LDA(At, 0, 1); PG8_STAGE(PG8_SB(0, 0), b2, voffB); PG8_STAGE(PG8_SB(0, 1), b2 + hstep, voffB); PG8_STAGE(PG8_SA(0, 0), a2, voffA);
            PG8_WAIT_V(8); PG8_WAIT_L(0); PG8_BAR; PG8_MMA(1, 0, At, B0); PG8_MMA(1, 1, At, B1); PG8_BAR; PG8_SCHED;
            PG8_LDB(B0, 1, 0); PG8_LDB(B1, 1, 1); PG8_SCHED; PG8_LDA(At, 1, 0); PG8_STAGE(PG8_SA(0, 1), a2 + hstep, voffA);
            PG8_WAIT_V(8); PG8_WAIT_L(0); PG8_BAR; PG8_MMA(0, 0, At, B0); PG8_MMA(0, 1, At, B1); PG8_BAR; PG8_SCHED;
            PG8_LDA(At, 1, 1); PG8_STAGE(PG8_SB(1, 0), b3, voffB); PG8_STAGE(PG8_SB(1, 1), b3 + hstep, voffB); PG8_STAGE(PG8_SA(1, 0), a3, voffA);
            PG8_WAIT_V(8); PG8_WAIT_L(0); PG8_BAR; PG8_MMA(1, 0, At, B0); PG8_MMA(1, 1, At, B1); PG8_BAR; PG8_SCHED;
            } else {
            PG8_LDB(B0, 0, 0); PG8_SCHED; PG8_LDA(At, 0, 0); PG8_STAGE(PG8_SA(1, 1), a1 + hstep, voffA);
            PG8_WAIT_L(8); PG8_BAR; PG8_WAIT_L(0); PG8_MMA(0, 0, At, B0); PG8_BAR; PG8_SCHED;
            PG8_LDB(B1, 0, 1); PG8_STAGE(PG8_SB(0, 0), b2, voffB);
            PG8_BAR; PG8_WAIT_L(0); PG8_MMA(0, 1, At, B1); PG8_BAR;
            PG8_LDA(At, 0, 1); PG8_STAGE(PG8_SA(0, 0), a2, voffA);
            PG8_BAR; PG8_WAIT_L(0); PG8_MMA(1, 0, At, B0); PG8_BAR; PG8_SCHED;
            PG8_STAGE(PG8_SB(0, 1), b2 + hstep, voffB);
            PG8_WAIT_V(6); PG8_BAR; PG8_MMA(1, 1, At, B1); PG8_BAR;
            PG8_LDB(B0, 1, 0); PG8_SCHED; PG8_LDA(At, 1, 0); PG8_STAGE(PG8_SA(0, 1), a2 + hstep, voffA);
            PG8_WAIT_L(8); PG8_BAR; PG8_WAIT_L(0); PG8_MMA(0, 0, At, B0); PG8_BAR; PG8_SCHED;
            PG8_LDB(B1, 1, 1); PG8_STAGE(PG8_SB(1, 0), b3, voffB);
            PG8_BAR; PG8_WAIT_L(0); PG8_MMA(0, 1, At, B1); PG8_BAR;
            PG8_LDA(At, 1, 1); PG8_STAGE(PG8_SA(1, 0), a3, voffA);
            PG8_BAR; PG8_WAIT_L(0); PG8_MMA(1, 0, At, B0); PG8_BAR; PG8_SCHED;
            PG8_STAGE(PG8_SB(1, 1), b3 + hstep, voffB);
            PG8_WAIT_V(6); PG8_BAR; PG8_MMA(1, 1, At, B1); PG8_BAR;
            }
        }
        if constexpr (ALIGN_EPI) { if (wr == 0) PG8_BAR; }
        if constexpr (!Epi::AFTER_DRAIN) { E(acc, cur, wr, wc, fr, fq); S.done(cur); }
        if (!has_next) break;
#pragma unroll
        for (int a = 0; a < 2; ++a)
#pragma unroll
            for (int b = 0; b < 2; ++b)
#pragma unroll
                for (int m = 0; m < 4; ++m)
#pragma unroll
                    for (int n = 0; n < 2; ++n) acc[a][b][m][n] = (f32x4){0.f, 0.f, 0.f, 0.f};
        cur = nxt; cA = nA; cB = nB; ++ui;
        if constexpr (ALIGN_EPI) { if (wr == 1) PG8_BAR; }
    }
    PG8_WAIT_V(0);
    if constexpr (!ALIGN_EPI) { if (wr == 0) PG8_BAR; }
    PG8_BAR;
    if constexpr (Epi::AFTER_DRAIN) { E.fused(acc, cur, wr, wc, fr, fq, lds, wid, lane); S.done(cur); }
#undef PG8_SA
#undef PG8_SB
#undef PG8_STAGE
#undef PG8_LDA
#undef PG8_LDB
#undef PG8_MMA
#undef PG8_WAIT_V
#undef PG8_WAIT_L
#undef PG8_BAR
#undef PG8_SCHED
}
}

namespace mk {
#define GAS __attribute__((address_space(1)))
#define LAS __attribute__((address_space(3)))
typedef unsigned short bf16;
typedef unsigned v4u __attribute__((ext_vector_type(4)));
typedef float f32x4 __attribute__((ext_vector_type(4)));
typedef short bf16x8 __attribute__((ext_vector_type(8)));
typedef GAS unsigned gu32;
typedef GAS unsigned long long gu64;
#define RLX_AGENT __ATOMIC_RELAXED, __HIP_MEMORY_SCOPE_AGENT
#define LDS_WAIT() asm volatile("s_waitcnt lgkmcnt(0)" ::: "memory")
#define VM_WAIT() asm volatile("s_waitcnt vmcnt(0)" ::: "memory")
__device__ __forceinline__ unsigned long long rt() { return __builtin_amdgcn_s_memrealtime(); }
__device__ __forceinline__ unsigned f2bf(float f) { unsigned u = __builtin_bit_cast(unsigned, f); return (u + 0x7fffu + ((u >> 16) & 1u)) >> 16; }
__device__ __forceinline__ unsigned pk2(float lo, float hi) { return f2bf(lo) | (f2bf(hi) << 16); }

#define XB_TMO      128
#define XB_XCNT(j)  (256  + 64 * (j))
#define XB_XSUB(j)  (1280 + 64 * (j))
#define XB_XGEN(j)  (2304 + 64 * (j))
#define XB_TOP      3328
#define XB_TOPGEN   3392
#define XCD_BAR_WORDS 3456
#define XB_SPIN_CAP (1u << 18)

__device__ __forceinline__ unsigned xb_ld(unsigned* p)              { return __hip_atomic_load(p, __ATOMIC_RELAXED, __HIP_MEMORY_SCOPE_AGENT); }
__device__ __forceinline__ unsigned xb_add(unsigned* p, unsigned v) { return __hip_atomic_fetch_add(p, v, __ATOMIC_RELAXED, __HIP_MEMORY_SCOPE_AGENT); }
__device__ __forceinline__ unsigned xb_xcc_id() { return (unsigned)__builtin_amdgcn_s_getreg((3 << 11) | 20) & 0xFu; }
#define XB_SPIN(cond, bar) do { unsigned _sp = 0; while (cond) { __builtin_amdgcn_s_sleep(1); \
    if ((++_sp & 255u) == 0u) { if (xb_ld(&(bar)[XB_TMO])) break; if (_sp > XB_SPIN_CAP) { atomicAdd(&(bar)[XB_TMO], 1u); break; } } } } while (0)

struct XcdBarrier {
    unsigned* bar; unsigned x;
    volatile LAS unsigned* st;
};

__device__ __forceinline__ XcdBarrier xcd_barrier_post(unsigned* bar, volatile LAS unsigned* st) {
    XcdBarrier b; b.bar = bar; b.x = xb_xcc_id(); b.st = st;
    if (threadIdx.x == 0) (void)xb_add(&bar[XB_XCNT(b.x)], 1u);
    return b;
}
__device__ __forceinline__ void xcd_barrier_complete(unsigned* bar, unsigned x, unsigned& nloc, unsigned& nx) {
    const unsigned G = gridDim.x * gridDim.y * gridDim.z;
    unsigned sum, cnt, mine, sp = 0u;
    for (;;) {
        sum = 0u; cnt = 0u; mine = 0u;
#pragma unroll
        for (unsigned j = 0; j < 16; ++j) { const unsigned c = xb_ld(&bar[XB_XCNT(j)]); sum += c; cnt += (c > 0u) ? 1u : 0u; mine = (j == x) ? c : mine; }
        if (sum == G) break;
        __builtin_amdgcn_s_sleep(1);
        if ((++sp & 255u) == 0u) { if (xb_ld(&bar[XB_TMO])) break; if (sp > XB_SPIN_CAP) { atomicAdd(&bar[XB_TMO], 1u); break; } }
    }
    nloc = mine > 0u ? mine : 1u; nx = cnt > 0u ? cnt : 1u;
}

__device__ __forceinline__ void xcd_barrier(const XcdBarrier& b) {
    asm volatile("s_waitcnt vmcnt(0)" ::: "memory");
    __syncthreads();
    if (threadIdx.x == 0) {
        unsigned* bar = b.bar;
        __builtin_amdgcn_s_waitcnt(0);
        unsigned nloc = b.st[0], nx = b.st[1];
        if (nloc == 0u) { xcd_barrier_complete(bar, b.x, nloc, nx); b.st[0] = nloc; b.st[1] = nx; }
        const unsigned old = xb_add(&bar[XB_XSUB(b.x)], 1u);
        const unsigned gen = old / nloc;
        if (old + 1u == (gen + 1u) * nloc) {
            __builtin_amdgcn_fence(__ATOMIC_RELEASE, "agent");
            asm volatile("s_waitcnt vmcnt(0)" ::: "memory");
            const unsigned og = xb_add(&bar[XB_TOP], 1u);
            const unsigned tg = og / nx;
            if (og + 1u == (tg + 1u) * nx) xb_add(&bar[XB_TOPGEN], 1u);
            else XB_SPIN(xb_ld(&bar[XB_TOPGEN]) == tg, bar);
            __builtin_amdgcn_fence(__ATOMIC_ACQUIRE, "agent");
            xb_add(&bar[XB_XGEN(b.x)], 1u);
            asm volatile("s_waitcnt vmcnt(0)" ::: "memory");
        } else {
            XB_SPIN(xb_ld(&bar[XB_XGEN(b.x)]) == gen, bar);
            __builtin_amdgcn_fence(__ATOMIC_ACQUIRE, "agent");
            asm volatile("s_waitcnt vmcnt(0)" ::: "memory");
        }
    }
    __syncthreads();
}

}

namespace mk {
constexpr int NWAVES = 8, NTHREADS = 512;
constexpr size_t MiB = 1u << 20;
constexpr size_t WS_QIB = 325 * MiB, WS_KB = 342 * MiB, WS_VB = 351 * MiB, WS_KIB = 360 * MiB, WS_WIF = 363 * MiB;
constexpr size_t WS_OB = 390 * MiB, WS_GD = 423 * MiB;
constexpr size_t WS_IDX = 525 * MiB, WS_CNT = 542 * MiB, WS_SCS = 543 * MiB;
constexpr size_t WS_S = 548 * MiB;
constexpr size_t WS_SC = WS_S;
constexpr size_t WS_Z = WS_S, WS_H1F = WS_S + 65 * MiB, WS_H1B = WS_S + 130 * MiB, WS_PQB = WS_S + 163 * MiB, WS_H2F = WS_S + 228 * MiB, WS_H2B = WS_S + 293 * MiB;
constexpr size_t WS_GQ = WS_S + 326 * MiB, WS_GK = WS_S + 343 * MiB, WS_GV = WS_S + 360 * MiB, WS_GR = WS_S + 393 * MiB, WS_QT = WS_S + 426 * MiB, WS_DEC = WS_S + 442 * MiB,
                 WS_OGB = WS_S + 443 * MiB, WS_KT = WS_S + 476 * MiB;
constexpr size_t WS_DS = WS_S, WS_SPREV = WS_S + 128 * MiB;
constexpr size_t WS_CTL = 1060 * MiB, WS_WA = 1061 * MiB, WS_WO = 1066 * MiB, WS_WG = 1068 * MiB, WS_WGO = 1075 * MiB, WS_WPQ = 1077 * MiB, WS_PK = 1085 * MiB,
                 WS_UB = 1086 * MiB, WS_VBX = 1150 * MiB, WS_XB = 1214 * MiB, WS_QB = 1247 * MiB, WS_END = 1280 * MiB;
constexpr size_t CTL_ZERO_BYTES = 1 * MiB;
constexpr int CW_TMO = 0, CW_BAR = 4096;
constexpr int WA_ROWS = 2176, WG_ROWS = 3104;
constexpr int GN_Q = 0, GN_K = 512, GN_V = 1024, GN_R = 2048, GN_GD = 3072;

constexpr int RING_BYTES = 131072, LDSCTL_OFF = RING_BYTES, MISC_OFF = LDSCTL_OFF + 320, LDS_BYTES = 147456;

typedef unsigned u32x4 __attribute__((ext_vector_type(4)));
typedef unsigned u32x2 __attribute__((ext_vector_type(2)));
#define MK_LAS __attribute__((address_space(3)))
__device__ __forceinline__ float bf2f(unsigned short b) { return __builtin_bit_cast(float, (unsigned)b << 16); }
__device__ __forceinline__ u32x4 pack8(f32x4 a, f32x4 b) { u32x4 w; w.x = pk2(a[0], a[1]); w.y = pk2(a[2], a[3]); w.z = pk2(b[0], b[1]); w.w = pk2(b[2], b[3]); return w; }

template <int NCT> __device__ __forceinline__ void skinny_tile(const bf16* __restrict__ A, int lda, const bf16* __restrict__ Bt, int K, int row0, int col0, f32x4 (&acc)[NCT], int lane) {
    const int fr = lane & 15, fq = lane >> 4;
    const bf16* ap = A + (size_t)(row0 + fr) * lda + fq * 8;
    const bf16* bp = Bt + (size_t)(col0 + fr) * K + fq * 8;
#pragma unroll
    for (int ct = 0; ct < NCT; ++ct) acc[ct] = (f32x4){0.f, 0.f, 0.f, 0.f};
    for (int k0 = 0; k0 < K; k0 += 128) {
        bf16x8 a[4];
#pragma unroll
        for (int j = 0; j < 4; ++j) a[j] = *(const bf16x8*)(ap + k0 + j * 32);
#pragma unroll
        for (int ct = 0; ct < NCT; ++ct) {
            bf16x8 b[4];
#pragma unroll
            for (int j = 0; j < 4; ++j) b[j] = *(const bf16x8*)(bp + (size_t)ct * 16 * K + k0 + j * 32);
#pragma unroll
            for (int j = 0; j < 4; ++j) acc[ct] = __builtin_amdgcn_mfma_f32_16x16x32_bf16(b[j], a[j], acc[ct], 0, 0, 0);
        }
    }
}

__device__ __forceinline__ void p0_transpose_item(const float* __restrict__ W, int ldw, int K, bf16* __restrict__ WT, int dst_row0, int src_col0, int nvalid, int k0, MK_LAS float* scr, int lane) {
#pragma unroll 8
    for (int i = 0; i < 32; ++i) { const int kk = 2 * i + (lane >> 5), j = lane & 31; scr[kk * 33 + j] = j < nvalid ? W[(size_t)(k0 + kk) * ldw + src_col0 + j] : 0.f; }
    asm volatile("s_waitcnt lgkmcnt(0)" ::: "memory");
    const int c = lane & 7;
#pragma unroll
    for (int j = 0; j < 4; ++j) { const int n = (lane >> 3) + 8 * j; const MK_LAS float* s = scr + (8 * c) * 33 + n;
        u32x4 o; o.x = pk2(s[0 * 33], s[1 * 33]); o.y = pk2(s[2 * 33], s[3 * 33]); o.z = pk2(s[4 * 33], s[5 * 33]); o.w = pk2(s[6 * 33], s[7 * 33]);
        *(u32x4*)(WT + (size_t)(dst_row0 + n) * K + k0 + 8 * c) = o; }
    asm volatile("s_waitcnt lgkmcnt(0)" ::: "memory");
}
__device__ __forceinline__ void p0_convert(const float* __restrict__ src, bf16* __restrict__ dst, size_t n8, int gw, int ngw, int lane) {
    for (size_t i = (size_t)gw * 64 + lane; i < n8; i += (size_t)ngw * 64) {
        const f32x4 a = *(const f32x4*)(src + i * 8), b = *(const f32x4*)(src + i * 8 + 4);
        *(u32x4*)(dst + i * 8) = pack8(a, b);
    }
}

struct FAttnIn {
    bf16 *Qb, *Kb, *Vb, *QIb, *KIb; float* WIf; float* out;
    __device__ __forceinline__ float* okp(int row, size_t offp, size_t offs, int ld) const { return row < TP ? out + offp + (size_t)row * ld : out + offs + (size_t)(row - TP) * ld; }
    __device__ __forceinline__ void put8(int row, int col, f32x4 v0, f32x4 v1) const {
        const u32x4 w = pack8(v0, v1);
        if (col < AK) *(u32x4*)(Qb + (size_t)row * 1024 + col) = w;
        else if (col < AV) { *(u32x4*)(Kb + (size_t)row * 256 + (col - AK)) = w; float* o = okp(row, OUT_KP, OUT_KS, 256) + (col - AK); *(f32x4*)o = v0; *(f32x4*)(o + 4) = v1; }
        else if (col < AQI) { *(u32x4*)(Vb + (size_t)row * 256 + (col - AV)) = w; float* o = okp(row, OUT_VP, OUT_VS, 256) + (col - AV); *(f32x4*)o = v0; *(f32x4*)(o + 4) = v1; }
        else *(u32x4*)(QIb + (size_t)row * 512 + (col - AQI)) = w;
    }
    __device__ __forceinline__ void put4(int row, int col, f32x4 v) const {
        u32x2 w; w.x = pk2(v[0], v[1]); w.y = pk2(v[2], v[3]);
        if (col < AK) *(u32x2*)(Qb + (size_t)row * 1024 + col) = w;
        else if (col < AV) { *(u32x2*)(Kb + (size_t)row * 256 + (col - AK)) = w; *(f32x4*)(okp(row, OUT_KP, OUT_KS, 256) + (col - AK)) = v; }
        else if (col < AQI) { *(u32x2*)(Vb + (size_t)row * 256 + (col - AV)) = w; *(f32x4*)(okp(row, OUT_VP, OUT_VS, 256) + (col - AV)) = v; }
        else if (col < AKI) *(u32x2*)(QIb + (size_t)row * 512 + (col - AQI)) = w;
        else if (col < AWI) { *(u32x2*)(KIb + (size_t)row * 64 + (col - AKI)) = w; *(f32x4*)(okp(row, OUT_KIP, OUT_KIS, 64) + (col - AKI)) = v; }
        else if (col < ATT_N) *(f32x4*)(WIf + (size_t)row * 8 + (col - AWI)) = v * 0.04419417382415922f;
    }
};
}

namespace mk {
typedef float f32x16 __attribute__((ext_vector_type(16)));
typedef short s16x4 __attribute__((ext_vector_type(4)));
typedef short v4i16_t __attribute__((ext_vector_type(4)));

__device__ __forceinline__ void score_load_q(const bf16* __restrict__ QIb, const float* __restrict__ WIf, size_t tok0, int lane, bf16x8 (&afr)[4], f32x4 (&w4)[4]) {
    const int r = lane & 31, kq = lane >> 5;
    const bf16* ap = QIb + (tok0 + (r >> 3)) * 512 + (r & 7) * 64 + kq * 8;
#pragma unroll
    for (int ks = 0; ks < 4; ++ks) afr[ks] = *(const bf16x8*)(ap + ks * 16);
#pragma unroll
    for (int ql = 0; ql < 4; ++ql) w4[ql] = *(const f32x4*)(WIf + (tok0 + ql) * 8 + 4 * kq);
}
__device__ __forceinline__ void score_tile(const bf16x8 (&afr)[4], const bf16x8 (&bfr)[4], const f32x4 (&w4)[4], float (&s)[4]) {
    f32x16 acc;
#pragma unroll
    for (int j = 0; j < 16; ++j) acc[j] = 0.f;
#pragma unroll
    for (int ks = 0; ks < 4; ++ks) acc = __builtin_amdgcn_mfma_f32_32x32x16_bf16(afr[ks], bfr[ks], acc, 0, 0, 0);
#pragma unroll
    for (int ql = 0; ql < 4; ++ql) {
        float p = 0.f;
#pragma unroll
        for (int jj = 0; jj < 4; ++jj) p = fmaf(fmaxf(acc[ql * 4 + jj], 0.f), w4[ql][jj], p);
        s[ql] = p + __shfl_xor(p, 32);
    }
}

__device__ __forceinline__ void phase_score(const bf16* __restrict__ QIb, const bf16* __restrict__ KIb, const float* __restrict__ WIf, const float* __restrict__ cache_ki, const int* __restrict__ page_table,
                                            float* __restrict__ SC, float* __restrict__ SCS, int vcu, int G, int wave, int lane, int gw, int NGW) {
    const int c = lane & 31, kq = lane >> 5;
    for (int it = vcu; it < 512; it += G) {
        const int b = it >> 8, qt = b == 0 ? (it & 255) : 255 - (it & 255);
        const size_t tok0 = (size_t)b * SEQ + qt * 32 + wave * 4;
        bf16x8 afr[4]; f32x4 w4[4];
        score_load_q(QIb, WIf, tok0, lane, afr, w4);
        const bf16* kp = KIb + ((size_t)b * SEQ + c) * 64 + kq * 8;
        bf16x8 bcur[4], bnxt[4];
#pragma unroll
        for (int ks = 0; ks < 4; ++ks) bcur[ks] = *(const bf16x8*)(kp + ks * 16);
        for (int kt = 0; kt <= qt; ++kt) {
            const int ktn = kt < qt ? kt + 1 : kt;
#pragma unroll
            for (int ks = 0; ks < 4; ++ks) bnxt[ks] = *(const bf16x8*)(kp + (size_t)ktn * 32 * 64 + ks * 16);
            float s[4]; score_tile(afr, bcur, w4, s);
            float* o = SC + (tok0 + 2 * kq) * SEQ + kt * 32 + c;
            o[0] = kq ? s[2] : s[0]; o[SEQ] = kq ? s[3] : s[1];
#pragma unroll
            for (int ks = 0; ks < 4; ++ks) bcur[ks] = bnxt[ks];
        }
    }
    for (int it = gw; it < DB * NPAGES + DB; it += NGW) {
        const bool isnew = it >= DB * NPAGES;
        const int b = isnew ? it - DB * NPAGES : it / NPAGES, pg = isnew ? 0 : it % NPAGES;
        const size_t tok0 = (size_t)TP + b * DS;
        bf16x8 afr[4]; f32x4 w4[4];
        score_load_q(QIb, WIf, tok0, lane, afr, w4);
        if (!isnew) {
            const int phys = page_table[b * NPAGES + pg];
            for (int j = 0; j < 4; ++j) {
                const float* kp = cache_ki + ((size_t)phys * PAGE + j * 32 + c) * 64 + kq * 8;
                bf16x8 bfr[4];
#pragma unroll
                for (int ks = 0; ks < 4; ++ks) { const f32x4 x0 = *(const f32x4*)(kp + ks * 16), x1 = *(const f32x4*)(kp + ks * 16 + 4); const u32x4 w = pack8(x0, x1); bfr[ks] = __builtin_bit_cast(bf16x8, w); }
                float s[4]; score_tile(afr, bfr, w4, s);
                float* o = SCS + (size_t)(b * DS + 2 * kq) * SCS_LD + pg * PAGE + j * 32 + c;
                o[0] = kq ? s[2] : s[0]; o[SCS_LD] = kq ? s[3] : s[1];
            }
        } else {
            const bf16* kp = KIb + (tok0 + (c & 3)) * 64 + kq * 8;
            bf16x8 bfr[4];
#pragma unroll
            for (int ks = 0; ks < 4; ++ks) bfr[ks] = *(const bf16x8*)(kp + ks * 16);
            float s[4]; score_tile(afr, bfr, w4, s);
            if (c < 4) { float* o = SCS + (size_t)(b * DS + 2 * kq) * SCS_LD + PAST + c; o[0] = kq ? s[2] : s[0]; o[SCS_LD] = kq ? s[3] : s[1]; }
        }
    }
}

__device__ __forceinline__ void phase_topk(const float* __restrict__ SC, const float* __restrict__ SCS, int* __restrict__ IDX, int* __restrict__ CNT, LAS unsigned char* lds, int wave, int lane, int gw, int NGW) {
    constexpr int CAP = 1024;
    unsigned* hist = (unsigned*)(lds + wave * 16384);
    float* cv = (float*)(lds + wave * 16384 + 8192);
    int* ci = (int*)(lds + wave * 16384 + 12288);
    for (int j = gw; j < TA; j += NGW) {
        int row, n; const float* rp;
        if (j < TP) { const int b = j >> 13, jj = j & 8191, blk = jj >> 11; const int q = blk < 2 ? jj : blk * 2048 + 2047 - (jj & 2047);
            row = b * SEQ + q; n = q + 1; rp = SC + (size_t)row * SEQ; }
        else { const int r = j - TP; row = j; n = PAST + (r % DS) + 1; rp = SCS + (size_t)r * SCS_LD; }
        nv::topk_wave<CAP>(rp, n, IDX + (size_t)row * TOPK, hist, cv, ci, lane);
        if (lane == 0) CNT[row] = n < TOPK ? n : TOPK;
    }
}

constexpr int VST = 144;
__device__ __forceinline__ bf16x8 ld_frag8(const bf16* p) { return *(const bf16x8*)p; }
__device__ __forceinline__ bf16x8 ld_frag8(const float* p) { const f32x4 a = *(const f32x4*)p, b = *(const f32x4*)(p + 4); const u32x4 w = pack8(a, b); return __builtin_bit_cast(bf16x8, w); }
__device__ __forceinline__ s16x4 lds_tr(LAS unsigned char* p) { return __builtin_bit_cast(s16x4, __builtin_amdgcn_ds_read_tr16_b64_v4i16((LAS v4i16_t*)p)); }

template <bool SAMPLE>
__device__ __forceinline__ void attn_row(int row, const bf16* __restrict__ Qb, const int* __restrict__ IDX, const int* __restrict__ CNT,
                                         const bf16* __restrict__ Kb, const bf16* __restrict__ Vb, const float* __restrict__ cache_k, const float* __restrict__ cache_v,
                                         const float* __restrict__ newk, const float* __restrict__ newv, const int* __restrict__ page_table,
                                         bf16* __restrict__ Ob, LAS unsigned char* wl, int lane) {
    const int fr = lane & 15, fq = lane >> 4;
    LAS int* rid = (LAS int*)wl;
    LAS unsigned char* vt = wl + 1024;
    const int cnt = CNT[row];
    const int b = SAMPLE ? (row - TP) / DS : row / SEQ;
#pragma unroll
    for (int i = 0; i < 4; ++i) { const int slot = i * 64 + lane; int key = slot < cnt ? IDX[(size_t)row * TOPK + slot] : 0; int id;
        if (!SAMPLE) id = b * SEQ + key;
        else if (key < PAST) id = page_table[b * NPAGES + key / PAGE] * PAGE + (key % PAGE);
        else id = (int)0x80000000 | (b * DS + (key - PAST));
        rid[slot] = id; }
    asm volatile("s_waitcnt lgkmcnt(0)" ::: "memory");
    for (int n = 0; n < 4; ++n) {
        bf16x8 qf[2];
#pragma unroll
        for (int ks = 0; ks < 2; ++ks) qf[ks] = *(const bf16x8*)(Qb + (size_t)row * 1024 + (n * 4 + (fr & 3)) * 64 + ks * 32 + fq * 8);
        f32x4 st[16];
#pragma unroll
        for (int t = 0; t < 16; ++t) {
            const int id = rid[t * 16 + fr];
            bf16x8 kf[2];
            if (!SAMPLE) { const bf16* kp = Kb + (size_t)id * 256 + n * 64 + fq * 8; kf[0] = ld_frag8(kp); kf[1] = ld_frag8(kp + 32); }
            else { const float* kp = (id < 0 ? newk + (size_t)(id & 0x7fffffff) * 256 : cache_k + (size_t)id * 256) + n * 64 + fq * 8; kf[0] = ld_frag8(kp); kf[1] = ld_frag8(kp + 32); }
            f32x4 a = (f32x4){0.f, 0.f, 0.f, 0.f};
            a = __builtin_amdgcn_mfma_f32_16x16x32_bf16(kf[0], qf[0], a, 0, 0, 0);
            a = __builtin_amdgcn_mfma_f32_16x16x32_bf16(kf[1], qf[1], a, 0, 0, 0);
            st[t] = a;
        }
        float mx = -INFINITY;
#pragma unroll
        for (int t = 0; t < 16; ++t)
#pragma unroll
            for (int j = 0; j < 4; ++j) { const int slot = t * 16 + fq * 4 + j; const float v = slot < cnt ? st[t][j] * 0.125f : -INFINITY; st[t][j] = v; mx = fmaxf(mx, v); }
        mx = fmaxf(mx, __shfl_xor(mx, 16)); mx = fmaxf(mx, __shfl_xor(mx, 32));
        float sum = 0.f;
#pragma unroll
        for (int t = 0; t < 16; ++t)
#pragma unroll
            for (int j = 0; j < 4; ++j) { const float e = __expf(st[t][j] - mx); st[t][j] = e; sum += e; }
        sum += __shfl_xor(sum, 16); sum += __shfl_xor(sum, 32);
        f32x4 oacc[4];
#pragma unroll
        for (int dt = 0; dt < 4; ++dt) oacc[dt] = (f32x4){0.f, 0.f, 0.f, 0.f};
#pragma unroll
        for (int ch = 0; ch < 4; ++ch) {
#pragma unroll
            for (int i = 0; i < 8; ++i) {
                const int sl = i * 8 + (lane >> 3), chunk = lane & 7; const int id = rid[ch * 64 + sl];
                bf16x8 v;
                if (!SAMPLE) v = ld_frag8(Vb + (size_t)id * 256 + n * 64 + chunk * 8);
                else v = ld_frag8((id < 0 ? newv + (size_t)(id & 0x7fffffff) * 256 : cache_v + (size_t)id * 256) + n * 64 + chunk * 8);
                *(LAS bf16x8*)(vt + sl * VST + chunk * 16) = v;
            }
            asm volatile("s_waitcnt lgkmcnt(0)" ::: "memory");
#pragma unroll
            for (int s2 = 0; s2 < 2; ++s2) {
                const int t0 = ch * 4 + s2 * 2;
                const u32x4 pw = pack8(st[t0], st[t0 + 1]);
                const bf16x8 pf = __builtin_bit_cast(bf16x8, pw);
#pragma unroll
                for (int dt = 0; dt < 4; ++dt) {
                    LAS unsigned char* a0 = vt + (s2 * 32 + fq * 4 + (fr >> 2)) * VST + (dt * 16 + 4 * (fr & 3)) * 2;
                    const s16x4 v0 = lds_tr(a0), v1 = lds_tr(a0 + 16 * VST);
                    bf16x8 vf; vf[0] = v0[0]; vf[1] = v0[1]; vf[2] = v0[2]; vf[3] = v0[3]; vf[4] = v1[0]; vf[5] = v1[1]; vf[6] = v1[2]; vf[7] = v1[3];
                    oacc[dt] = __builtin_amdgcn_mfma_f32_16x16x32_bf16(pf, vf, oacc[dt], 0, 0, 0);
                }
            }
            asm volatile("s_waitcnt lgkmcnt(0)" ::: "memory");
        }
        const float i0 = 1.f / __shfl(sum, 0), i1 = 1.f / __shfl(sum, 1), i2 = 1.f / __shfl(sum, 2), i3 = 1.f / __shfl(sum, 3);
        if (fq == 0) {
#pragma unroll
            for (int dt = 0; dt < 4; ++dt) {
                bf16* o = Ob + (size_t)row * 1024 + (n * 4) * 64 + dt * 16 + fr;
                o[0] = (bf16)f2bf(oacc[dt][0] * i0); o[64] = (bf16)f2bf(oacc[dt][1] * i1); o[128] = (bf16)f2bf(oacc[dt][2] * i2); o[192] = (bf16)f2bf(oacc[dt][3] * i3);
            }
        }
    }
}

__device__ __forceinline__ void ln_row_wave(const float* __restrict__ zrow, const float* __restrict__ g, const float* __restrict__ bt, float* __restrict__ of, bf16* __restrict__ ob, int lane) {
    f32x4 v[4]; float s = 0.f;
#pragma unroll
    for (int j = 0; j < 4; ++j) { v[j] = *(const f32x4*)(zrow + 256 * j + 4 * lane); s += (v[j][0] + v[j][1]) + (v[j][2] + v[j][3]); }
#pragma unroll
    for (int o = 1; o < 64; o <<= 1) s += __shfl_xor(s, o);
    const float mean = s * (1.f / D); float q = 0.f;
#pragma unroll
    for (int j = 0; j < 4; ++j) { v[j] = v[j] - mean; q += (v[j][0] * v[j][0] + v[j][1] * v[j][1]) + (v[j][2] * v[j][2] + v[j][3] * v[j][3]); }
#pragma unroll
    for (int o = 1; o < 64; o <<= 1) q += __shfl_xor(q, o);
    const float rstd = rsqrtf(q * (1.f / D) + LN_EPS);
#pragma unroll
    for (int j = 0; j < 4; ++j) { const f32x4 gg = *(const f32x4*)(g + 256 * j + 4 * lane), bb = *(const f32x4*)(bt + 256 * j + 4 * lane); const f32x4 o = v[j] * rstd * gg + bb;
        *(f32x4*)(of + 256 * j + 4 * lane) = o; u32x2 w; w.x = pk2(o[0], o[1]); w.y = pk2(o[2], o[3]); *(u32x2*)(ob + 256 * j + 4 * lane) = w; }
}

struct FResid {
    const float* rp; const float* rs; float* Z;
    __device__ __forceinline__ const float* rrow(int row) const { return row < TP ? rp + (size_t)row * D : rs + (size_t)(row - TP) * D; }
    __device__ __forceinline__ void put8(int row, int col, f32x4 v0, f32x4 v1) const { const float* r = rrow(row) + col; float* z = Z + (size_t)row * D + col;
        *(f32x4*)z = v0 + ALPHA * *(const f32x4*)r; *(f32x4*)(z + 4) = v1 + ALPHA * *(const f32x4*)(r + 4); }
    __device__ __forceinline__ void put4(int row, int col, f32x4 v) const { *(f32x4*)(Z + (size_t)row * D + col) = v + ALPHA * *(const f32x4*)(rrow(row) + col); }
};
}

namespace mk {
using bf16x2_t = __attribute__((ext_vector_type(2))) __bf16;
__device__ __forceinline__ float dot2bf(unsigned a, unsigned b, float acc) { return __builtin_amdgcn_fdot2_f32_bf16(__builtin_bit_cast(bf16x2_t, a), __builtin_bit_cast(bf16x2_t, b), acc, false); }
__device__ __forceinline__ float bflo(unsigned w) { return __builtin_bit_cast(float, w << 16); }
__device__ __forceinline__ float bfhi(unsigned w) { return __builtin_bit_cast(float, w & 0xffff0000u); }

struct FStoreBf16 {
    bf16* O; int ld;
    __device__ __forceinline__ void put8(int row, int col, f32x4 v0, f32x4 v1) const { *(u32x4*)(O + (size_t)row * ld + col) = pack8(v0, v1); }
    __device__ __forceinline__ void put4(int row, int col, f32x4 v) const { u32x2 w; w.x = pk2(v[0], v[1]); w.y = pk2(v[2], v[3]); *(u32x2*)(O + (size_t)row * ld + col) = w; }
};

constexpr int PEER_TAB_OFF = LDSCTL_OFF + 1024;

__device__ __forceinline__ void phase_peer(const float* __restrict__ Hf, const bf16* __restrict__ Hb, const bf16* __restrict__ PQb, const bf16* __restrict__ K1, const bf16* __restrict__ K2,
                                           const bf16* __restrict__ U, const bf16* __restrict__ V, const float* __restrict__ g2, const float* __restrict__ b2,
                                           float* __restrict__ outf, bf16* __restrict__ outb, LAS unsigned char* lds, int vcu, int G, int wave, int lane) {
    const int fr = lane & 15, fq = lane >> 4;
    LAS float* sc = (LAS float*)(lds + wave * 16384);
    LAS unsigned short* teid = (LAS unsigned short*)(lds + PEER_TAB_OFF);
    LAS float* tgate = (LAS float*)(lds + PEER_TAB_OFF + 4096);
    for (int tile = vcu; tile < TA / 16; tile += G) {
        const int tok0 = tile * 16, h = wave;
        LAS float* tvl = sc + 2048; LAS int* til = (LAS int*)(sc + 2048 + 512);
        const int stok = lane >> 2, part = lane & 3;
#pragma unroll 1
        for (int half = 0; half < 2; ++half) {
            { const bf16* ap = PQb + (size_t)(tok0 + fr) * PEER_N + h * 256 + half * 128 + fq * 8;
              bf16x8 a[4];
#pragma unroll
              for (int ks = 0; ks < 4; ++ks) a[ks] = *(const bf16x8*)(ap + ks * 32);
              const bf16* kb = (half ? K2 : K1) + (size_t)fr * 128 + fq * 8;
#pragma unroll 1
              for (int ct = 0; ct < 8; ++ct) {
                  f32x4 acc = (f32x4){0.f, 0.f, 0.f, 0.f};
#pragma unroll
                  for (int ks = 0; ks < 4; ++ks) { const bf16x8 b = *(const bf16x8*)(kb + (size_t)ct * 16 * 128 + ks * 32); acc = __builtin_amdgcn_mfma_f32_16x16x32_bf16(b, a[ks], acc, 0, 0, 0); }
                  *(LAS f32x4*)(sc + fr * 128 + ct * 16 + 4 * fq) = acc;
              } }
            asm volatile("s_waitcnt lgkmcnt(0)" ::: "memory");
            LAS float* p = sc + stok * 128 + part * 32;
#pragma unroll 1
            for (int it = 0; it < 16; ++it) {
                float best = -INFINITY; int bi = 0;
#pragma unroll
                for (int k4 = 0; k4 < 8; ++k4) { const f32x4 v = *(LAS f32x4*)(p + k4 * 4);
#pragma unroll
                    for (int e = 0; e < 4; ++e) if (v[e] > best) { best = v[e]; bi = part * 32 + k4 * 4 + e; } }
#pragma unroll
                for (int o = 1; o < 4; o <<= 1) { const float vo = __shfl_xor(best, o); const int io = __shfl_xor(bi, o); if (vo > best || (vo == best && io < bi)) { best = vo; bi = io; } }
                if ((bi >> 5) == part) sc[stok * 128 + bi] = -INFINITY;
                if (part == 0) { tvl[(stok * 2 + half) * 16 + it] = best; til[(stok * 2 + half) * 16 + it] = bi; }
                asm volatile("s_waitcnt lgkmcnt(0)" ::: "memory");
            }
        }
        {
            const LAS float* t1 = tvl + (stok * 2) * 16; const LAS float* t2 = tvl + (stok * 2 + 1) * 16;
            const LAS int* i1 = til + (stok * 2) * 16; const LAS int* i2 = til + (stok * 2 + 1) * 16;
            unsigned taken = 0u; float mx = 0.f, sum = 0.f;
#pragma unroll 1
            for (int it = 0; it < 16; ++it) {
                float best = -INFINITY; int bf = 0x7fffffff, bc = 0, c = 0;
                for (int i = part; i < 16; i += 4) { const float a = t1[i]; const int nj = 16 / (i + 1);
                    for (int j = 0; j < nj; ++j, ++c) { const float v = a + t2[j]; if (!((taken >> c) & 1u) && v > best) { best = v; bf = i * 16 + j; bc = c; } } }
                const int mybf = bf;
#pragma unroll
                for (int o = 1; o < 4; o <<= 1) { const float vo = __shfl_xor(best, o); const int fo = __shfl_xor(bf, o); if (vo > best || (vo == best && fo < bf)) { best = vo; bf = fo; } }
                if (bf == mybf) taken |= 1u << bc;
                if (it == 0) mx = best;
                const float e = __expf(best - mx); sum += e;
                if (part == 0) { tgate[stok * 128 + h * 16 + it] = e; teid[stok * 128 + h * 16 + it] = (unsigned short)(i1[bf >> 4] * 128 + i2[bf & 15]); }
            }
            asm volatile("s_waitcnt lgkmcnt(0)" ::: "memory");
            const float inv = 1.f / sum;
            if (part == 0) {
#pragma unroll 1
                for (int it = 0; it < 16; ++it) tgate[stok * 128 + h * 16 + it] *= inv;
            }
        }
        asm volatile("s_waitcnt lgkmcnt(0)" ::: "memory");
        __syncthreads();
        for (int tt = 0; tt < 2; ++tt) {
            const int tl = 2 * wave + tt; const size_t tok = (size_t)tok0 + tl;
            const u32x4 x0 = *(const u32x4*)(Hb + tok * D + lane * 8), x1 = *(const u32x4*)(Hb + tok * D + 512 + lane * 8);
            float wreg0 = 0.f, wreg1 = 0.f;
            for (int e0 = 0; e0 < 128; e0 += 8) {
                u32x4 ua[8], ub[8];
#pragma unroll
                for (int i = 0; i < 8; ++i) { const int id = __builtin_amdgcn_readfirstlane((int)teid[tl * 128 + e0 + i]); const bf16* up = U + (size_t)id * D + lane * 8; ua[i] = *(const u32x4*)up; ub[i] = *(const u32x4*)(up + 512); }
#pragma unroll
                for (int i = 0; i < 8; ++i) {
                    float p = 0.f;
                    p = dot2bf(ua[i].x, x0.x, p); p = dot2bf(ua[i].y, x0.y, p); p = dot2bf(ua[i].z, x0.z, p); p = dot2bf(ua[i].w, x0.w, p);
                    p = dot2bf(ub[i].x, x1.x, p); p = dot2bf(ub[i].y, x1.y, p); p = dot2bf(ub[i].z, x1.z, p); p = dot2bf(ub[i].w, x1.w, p);
#pragma unroll
                    for (int o = 1; o < 64; o <<= 1) p += __shfl_xor(p, o);
                    const int e = e0 + i;
                    if (lane == (e & 63)) { const float ge = 0.5f * p * (1.f + erff(p * 0.70710678118654752f)) * tgate[tl * 128 + e]; if (e < 64) wreg0 = ge; else wreg1 = ge; }
                }
            }
            float y[16];
#pragma unroll
            for (int i = 0; i < 16; ++i) y[i] = 0.f;
            for (int e0 = 0; e0 < 128; e0 += 8) {
                u32x4 va[8], vb[8];
#pragma unroll
                for (int i = 0; i < 8; ++i) { const int id = __builtin_amdgcn_readfirstlane((int)teid[tl * 128 + e0 + i]); const bf16* vp = V + (size_t)id * D + lane * 8; va[i] = *(const u32x4*)vp; vb[i] = *(const u32x4*)(vp + 512); }
#pragma unroll
                for (int i = 0; i < 8; ++i) {
                    const int e = e0 + i; const float w = __shfl(e < 64 ? wreg0 : wreg1, e & 63);
                    y[0] = fmaf(w, bflo(va[i].x), y[0]); y[1] = fmaf(w, bfhi(va[i].x), y[1]); y[2] = fmaf(w, bflo(va[i].y), y[2]); y[3] = fmaf(w, bfhi(va[i].y), y[3]);
                    y[4] = fmaf(w, bflo(va[i].z), y[4]); y[5] = fmaf(w, bfhi(va[i].z), y[5]); y[6] = fmaf(w, bflo(va[i].w), y[6]); y[7] = fmaf(w, bfhi(va[i].w), y[7]);
                    y[8] = fmaf(w, bflo(vb[i].x), y[8]); y[9] = fmaf(w, bfhi(vb[i].x), y[9]); y[10] = fmaf(w, bflo(vb[i].y), y[10]); y[11] = fmaf(w, bfhi(vb[i].y), y[11]);
                    y[12] = fmaf(w, bflo(vb[i].z), y[12]); y[13] = fmaf(w, bfhi(vb[i].z), y[13]); y[14] = fmaf(w, bflo(vb[i].w), y[14]); y[15] = fmaf(w, bfhi(vb[i].w), y[15]);
                }
            }
            const float* hr = Hf + tok * D; float s = 0.f;
#pragma unroll
            for (int q = 0; q < 4; ++q) { const f32x4 r = *(const f32x4*)(hr + (q >> 1) * 512 + lane * 8 + (q & 1) * 4);
#pragma unroll
                for (int i = 0; i < 4; ++i) { y[q * 4 + i] = ALPHA * r[i] + y[q * 4 + i]; s += y[q * 4 + i]; } }
#pragma unroll
            for (int o = 1; o < 64; o <<= 1) s += __shfl_xor(s, o);
            const float mean = s * (1.f / D); float qq = 0.f;
#pragma unroll
            for (int i = 0; i < 16; ++i) { y[i] -= mean; qq += y[i] * y[i]; }
#pragma unroll
            for (int o = 1; o < 64; o <<= 1) qq += __shfl_xor(qq, o);
            const float rstd = rsqrtf(qq * (1.f / D) + LN_EPS);
#pragma unroll
            for (int q = 0; q < 4; ++q) { const int col = (q >> 1) * 512 + lane * 8 + (q & 1) * 4; const f32x4 gg = *(const f32x4*)(g2 + col), bb = *(const f32x4*)(b2 + col);
                f32x4 o;
#pragma unroll
                for (int i = 0; i < 4; ++i) o[i] = y[q * 4 + i] * rstd * gg[i] + bb[i];
                *(f32x4*)(outf + tok * D + col) = o;
                if (outb) { u32x2 w; w.x = pk2(o[0], o[1]); w.y = pk2(o[2], o[3]); *(u32x2*)(outb + tok * D + col) = w; } }
        }
        __syncthreads();
    }
}
}

namespace mk {
struct FGlaIn {
    bf16 *Gq, *Gk, *Gv, *Gr; float* GD;
    __device__ __forceinline__ static float silu(float r) { return r / (1.f + __expf(-r)); }
    __device__ __forceinline__ void put8(int row, int col, f32x4 v0, f32x4 v1) const {
        if (col < GN_K) *(u32x4*)(Gq + (size_t)row * 512 + col) = pack8(v0, v1);
        else if (col < GN_V) *(u32x4*)(Gk + (size_t)row * 512 + (col - GN_K)) = pack8(v0, v1);
        else if (col < GN_R) *(u32x4*)(Gv + (size_t)row * 1024 + (col - GN_V)) = pack8(v0, v1);
        else { f32x4 a, b;
#pragma unroll
            for (int i = 0; i < 4; ++i) { a[i] = silu(v0[i]); b[i] = silu(v1[i]); }
            *(u32x4*)(Gr + (size_t)row * 1024 + (col - GN_R)) = pack8(a, b); }
    }
    __device__ __forceinline__ void put4(int row, int col, f32x4 v) const {
        u32x2 w; w.x = pk2(v[0], v[1]); w.y = pk2(v[2], v[3]);
        if (col < GN_K) *(u32x2*)(Gq + (size_t)row * 512 + col) = w;
        else if (col < GN_V) *(u32x2*)(Gk + (size_t)row * 512 + (col - GN_K)) = w;
        else if (col < GN_R) *(u32x2*)(Gv + (size_t)row * 1024 + (col - GN_V)) = w;
        else if (col < GN_GD) { u32x2 s; s.x = pk2(silu(v[0]), silu(v[1])); s.y = pk2(silu(v[2]), silu(v[3])); *(u32x2*)(Gr + (size_t)row * 1024 + (col - GN_R)) = s; }
        else if (col < GN_GD + 16) *(f32x4*)(GD + (size_t)row * 16 + (col - GN_GD)) = v;
    }
};

__device__ __forceinline__ float log_sigmoid_f(float x) { return fminf(x, 0.f) - log1pf(__expf(-fabsf(x))); }
__device__ __forceinline__ bf16x8 tr8(LAS unsigned char* a0, LAS unsigned char* a1) { const s16x4 v0 = lds_tr(a0), v1 = lds_tr(a1); bf16x8 r; r[0] = v0[0]; r[1] = v0[1]; r[2] = v0[2]; r[3] = v0[3]; r[4] = v1[0]; r[5] = v1[1]; r[6] = v1[2]; r[7] = v1[3]; return r; }

constexpr int KD_ST = 272, V_ST = 528;
constexpr int GL_LB = 0, GL_TOT = 32768, GL_KD = 36864, GL_V = GL_KD + 64 * KD_ST  , GL_END = GL_V + 64 * V_ST;
static_assert(GL_END <= RING_BYTES, "GLA chunk LDS");

__device__ __forceinline__ void gla_chunk_item(int item, const bf16* __restrict__ Gq, const bf16* __restrict__ Gk, const bf16* __restrict__ Gv, const float* __restrict__ GD,
                                               const float* __restrict__ Wgu, const float* __restrict__ bg, bf16* __restrict__ QT, bf16* __restrict__ KT, float* __restrict__ DEC, float* __restrict__ DS,
                                               LAS unsigned char* lds, int tid, int wave, int lane) {
    const int h = item & 3, bc = item >> 2;
    const size_t tok0 = (size_t)bc * 64;
    LAS float* LB = (LAS float*)(lds + GL_LB);
    LAS float* TOT = (LAS float*)(lds + GL_TOT);
    const int d = tid & 127, tq = tid >> 7;
    float wg[16];
#pragma unroll
    for (int r = 0; r < 16; ++r) wg[r] = Wgu[r * 512 + h * 128 + d];
    const float bgd = bg[h * 128 + d];
    float pre[16]; float run = 0.f;
#pragma unroll
    for (int i = 0; i < 16; ++i) {
        const float* gd = GD + (tok0 + tq * 16 + i) * 16;
        const f32x4 g0 = *(const f32x4*)gd, g1 = *(const f32x4*)(gd + 4), g2 = *(const f32x4*)(gd + 8), g3 = *(const f32x4*)(gd + 12);
        float x = 0.f;
#pragma unroll
        for (int r = 0; r < 4; ++r) { x = fmaf(g0[r], wg[r], x); }
#pragma unroll
        for (int r = 0; r < 4; ++r) { x = fmaf(g1[r], wg[4 + r], x); }
#pragma unroll
        for (int r = 0; r < 4; ++r) { x = fmaf(g2[r], wg[8 + r], x); }
#pragma unroll
        for (int r = 0; r < 4; ++r) { x = fmaf(g3[r], wg[12 + r], x); }
        run += log_sigmoid_f(x + bgd) * (1.f / 16.f); pre[i] = run;
    }
    TOT[tq * 128 + d] = run;
    __syncthreads();
    float off = 0.f;
#pragma unroll
    for (int q = 0; q < 3; ++q) if (q < tq) off += TOT[q * 128 + d];
    const float bC = (TOT[d] + TOT[128 + d]) + (TOT[256 + d] + TOT[384 + d]);
#pragma unroll
    for (int i = 0; i < 16; ++i) {
        const int t = tq * 16 + i; const float b = pre[i] + off; const size_t tok = tok0 + t;
        const float q = bf2f(Gq[tok * 512 + h * 128 + d]), k = bf2f(Gk[tok * 512 + h * 128 + d]);
        QT[tok * 512 + h * 128 + d] = (bf16)f2bf(q * 0.08838834764831845f * __expf(b));
        KT[tok * 512 + h * 128 + d] = (bf16)f2bf(k * __expf(-b));
        *(LAS bf16*)(lds + GL_KD + t * KD_ST + d * 2) = (bf16)f2bf(k * __expf(bC - b));
    }
    if (tq == 0) DEC[(size_t)item * 128 + d] = __expf(bC);
#pragma unroll
    for (int p = 0; p < 4; ++p) { const int e = tid + p * 512, s = e >> 5, ch = e & 31;
        *(LAS u32x4*)(lds + GL_V + s * V_ST + ch * 16) = *(const u32x4*)(Gv + (tok0 + s) * 1024 + h * 256 + ch * 8); }
    __syncthreads();
    const int fr = lane & 15, fq = lane >> 4, dt = wave;
    bf16x8 af[2];
#pragma unroll
    for (int ks = 0; ks < 2; ++ks) { LAS unsigned char* a0 = lds + GL_KD + (ks * 32 + fq * 8 + (fr >> 2)) * KD_ST + (dt * 16 + 4 * (fr & 3)) * 2; af[ks] = tr8(a0, a0 + 4 * KD_ST); }
    float* dsb = DS + (size_t)item * 256 * 128;
#pragma unroll 4
    for (int vt = 0; vt < 16; ++vt) {
        f32x4 acc = (f32x4){0.f, 0.f, 0.f, 0.f};
#pragma unroll
        for (int ks = 0; ks < 2; ++ks) { LAS unsigned char* b0 = lds + GL_V + (ks * 32 + fq * 8 + (fr >> 2)) * V_ST + (vt * 16 + 4 * (fr & 3)) * 2; const bf16x8 bf = tr8(b0, b0 + 4 * V_ST);
            acc = __builtin_amdgcn_mfma_f32_16x16x32_bf16(af[ks], bf, acc, 0, 0, 0); }
        *(f32x4*)(dsb + (size_t)(vt * 16 + fr) * 128 + dt * 16 + fq * 4) = acc;
    }
    __syncthreads();
}

__device__ __forceinline__ void gla_sample_item(int item, const bf16* __restrict__ Gq, const bf16* __restrict__ Gk, const bf16* __restrict__ Gv, const bf16* __restrict__ Gr, const float* __restrict__ GD,
                                                const float* __restrict__ Wgu, const float* __restrict__ bg, const float* __restrict__ ng, const float* __restrict__ S0, float* __restrict__ Sout, bf16* __restrict__ OGb,
                                                LAS unsigned char* lds, int tid, int lane) {
    const int b = item >> 2, h = item & 3;
    LAS float* A = (LAS float*)lds;
    LAS float* Qs = A + 512; LAS float* Ks = Qs + 512;
    LAS float* PO = Ks + 512;
    LAS float* RS = PO + 4096;
    { const int t = tid >> 7, d = tid & 127; const size_t tok = (size_t)TP + b * DS + t;
      float x = bg[h * 128 + d]; const float* gd = GD + tok * 16; float xs = 0.f;
#pragma unroll
      for (int r = 0; r < 16; ++r) xs = fmaf(gd[r], Wgu[r * 512 + h * 128 + d], xs);
      x += xs;
      A[t * 128 + d] = __expf(log_sigmoid_f(x) * (1.f / 16.f));
      Qs[t * 128 + d] = bf2f(Gq[tok * 512 + h * 128 + d]) * 0.08838834764831845f; Ks[t * 128 + d] = bf2f(Gk[tok * 512 + h * 128 + d]); }
    __syncthreads();
    const int dq = tid >> 7, d0 = dq * 32;
#pragma unroll 1
    for (int vhalf = 0; vhalf < 2; ++vhalf) {
        const int v = vhalf * 128 + (tid & 127);
        float S[32];
#pragma unroll
        for (int i = 0; i < 32; ++i) S[i] = S0[(((size_t)b * 4 + h) * 128 + d0 + i) * 256 + v];
#pragma unroll 1
        for (int t = 0; t < 4; ++t) {
            const float vv = bf2f(Gv[((size_t)TP + b * DS + t) * 1024 + h * 256 + v]); float o = 0.f;
#pragma unroll
            for (int i = 0; i < 32; ++i) { S[i] = fmaf(A[t * 128 + d0 + i], S[i], Ks[t * 128 + d0 + i] * vv); o = fmaf(Qs[t * 128 + d0 + i], S[i], o); }
            PO[(dq * 4 + t) * 256 + v] = o;
        }
#pragma unroll
        for (int i = 0; i < 32; ++i) Sout[(((size_t)b * 4 + h) * 128 + d0 + i) * 256 + v] = S[i];
    }
    __syncthreads();
    { const int t = tid >> 7, vl = tid & 127; const float o0 = (PO[t * 256 + vl] + PO[(4 + t) * 256 + vl]) + (PO[(8 + t) * 256 + vl] + PO[(12 + t) * 256 + vl]), o1 = (PO[t * 256 + 128 + vl] + PO[(4 + t) * 256 + 128 + vl]) + (PO[(8 + t) * 256 + 128 + vl] + PO[(12 + t) * 256 + 128 + vl]);
      float ss = o0 * o0 + o1 * o1;
#pragma unroll
      for (int o = 1; o < 64; o <<= 1) ss += __shfl_xor(ss, o);
      if (lane == 0) RS[tid >> 6] = ss;
      __syncthreads();
      const float ms = (RS[2 * t] + RS[2 * t + 1]) * (1.f / 256.f), rstd = rsqrtf(ms + LN_EPS);
      const size_t tok = (size_t)TP + b * DS + t;
      OGb[tok * 1024 + h * 256 + vl] = (bf16)f2bf(o0 * rstd * ng[vl] * bf2f(Gr[tok * 1024 + h * 256 + vl]));
      OGb[tok * 1024 + h * 256 + 128 + vl] = (bf16)f2bf(o1 * rstd * ng[128 + vl] * bf2f(Gr[tok * 1024 + h * 256 + 128 + vl])); }
    __syncthreads();
}

__device__ __forceinline__ void gla_scan(const float* __restrict__ DS, const float* __restrict__ DEC, bf16* __restrict__ SP, float* __restrict__ Sout, int gtid, int gthreads) {
    typedef float f32x2 __attribute__((ext_vector_type(2)));
    for (int e = gtid; e < NBATCH * 4 * 256 * 64; e += gthreads) {
        const int d2 = e & 63, v = (e >> 6) & 255, h = (e >> 14) & 3, b = e >> 16;
        f32x2 S = (f32x2){0.f, 0.f};
        for (int c = 0; c < SEQ / 64; ++c) {
            const size_t item = ((size_t)b * (SEQ / 64) + c) * 4 + h;
            const f32x2 ds = *(const f32x2*)(DS + (item * 256 + v) * 128 + d2 * 2), dc = *(const f32x2*)(DEC + item * 128 + d2 * 2);
            *(unsigned*)(SP + (item * 256 + v) * 128 + d2 * 2) = pk2(S[0], S[1]);
            S = dc * S + ds;
        }
        float* so = Sout + (((size_t)b * 4 + h) * 128 + d2 * 2) * 256 + v; so[0] = S[0]; so[256] = S[1];
    }
}

__device__ __forceinline__ void gla_out_item(int item, const bf16* __restrict__ QT, const bf16* __restrict__ KT, const bf16* __restrict__ Gv, const bf16* __restrict__ Gr, const bf16* __restrict__ SP,
                                             const float* __restrict__ ng, bf16* __restrict__ OGb, LAS unsigned char* lds, int tid, int wave, int lane) {
    const int h = item & 3, bc = item >> 2; const size_t tok0 = (size_t)bc * 64;
    const int fr = lane & 15, fq = lane >> 4, tt = wave & 3, vh = wave >> 2;
    LAS float* RS = (LAS float*)(lds + 64 * V_ST);
#pragma unroll
    for (int p = 0; p < 4; ++p) { const int e = tid + p * 512, s = e >> 5, ch = e & 31;
        *(LAS u32x4*)(lds + s * V_ST + ch * 16) = *(const u32x4*)(Gv + (tok0 + s) * 1024 + h * 256 + ch * 8); }
    bf16x8 qf[4];
#pragma unroll
    for (int ks = 0; ks < 4; ++ks) qf[ks] = *(const bf16x8*)(QT + (tok0 + tt * 16 + fr) * 512 + h * 128 + ks * 32 + fq * 8);
    bf16x8 pf[2];
    {
        f32x4 at[4];
#pragma unroll
        for (int st = 0; st < 4; ++st) {
            f32x4 acc = (f32x4){0.f, 0.f, 0.f, 0.f};
#pragma unroll
            for (int ks = 0; ks < 4; ++ks) { const bf16x8 kf = *(const bf16x8*)(KT + (tok0 + st * 16 + fr) * 512 + h * 128 + ks * 32 + fq * 8); acc = __builtin_amdgcn_mfma_f32_16x16x32_bf16(kf, qf[ks], acc, 0, 0, 0); }
#pragma unroll
            for (int j = 0; j < 4; ++j) { const int s = st * 16 + fq * 4 + j, t = tt * 16 + fr; if (s > t) acc[j] = 0.f; }
            at[st] = acc;
        }
        const u32x4 w0 = pack8(at[0], at[1]), w1 = pack8(at[2], at[3]);
        pf[0] = __builtin_bit_cast(bf16x8, w0); pf[1] = __builtin_bit_cast(bf16x8, w1);
    }
    __syncthreads();
    const bf16* spb = SP + (size_t)item * 256 * 128;
    f32x4 oacc[8]; float ss = 0.f;
#pragma unroll
    for (int i = 0; i < 8; ++i) {
        const int vt = vh * 8 + i;
        f32x4 acc = (f32x4){0.f, 0.f, 0.f, 0.f};
#pragma unroll
        for (int k2 = 0; k2 < 2; ++k2) {
            LAS unsigned char* a0 = lds + (k2 * 32 + fq * 4 + (fr >> 2)) * V_ST + (vt * 16 + 4 * (fr & 3)) * 2;
            const bf16x8 vf = tr8(a0, a0 + 16 * V_ST);
            acc = __builtin_amdgcn_mfma_f32_16x16x32_bf16(vf, pf[k2], acc, 0, 0, 0);
        }
#pragma unroll
        for (int ks = 0; ks < 4; ++ks) { const bf16x8 sf = *(const bf16x8*)(spb + (size_t)(vt * 16 + fr) * 128 + ks * 32 + fq * 8); acc = __builtin_amdgcn_mfma_f32_16x16x32_bf16(sf, qf[ks], acc, 0, 0, 0); }
        oacc[i] = acc; ss += (acc[0] * acc[0] + acc[1] * acc[1]) + (acc[2] * acc[2] + acc[3] * acc[3]);
    }
    ss += __shfl_xor(ss, 16); ss += __shfl_xor(ss, 32);
    if (fq == 0) RS[wave * 16 + fr] = ss;
    __syncthreads();
    const float ms = (RS[tt * 16 + fr] + RS[(tt + 4) * 16 + fr]) * (1.f / 256.f), rstd = rsqrtf(ms + LN_EPS);
    const size_t tok = tok0 + tt * 16 + fr;
#pragma unroll
    for (int i = 0; i < 8; ++i) {
        const int v = (vh * 8 + i) * 16 + fq * 4;
        const u32x2 rw = *(const u32x2*)(Gr + tok * 1024 + h * 256 + v); const f32x4 g = *(const f32x4*)(ng + v);
        u32x2 w; w.x = pk2(oacc[i][0] * rstd * g[0] * bflo(rw.x), oacc[i][1] * rstd * g[1] * bfhi(rw.x)); w.y = pk2(oacc[i][2] * rstd * g[2] * bflo(rw.y), oacc[i][3] * rstd * g[3] * bfhi(rw.y));
        *(u32x2*)(OGb + tok * 1024 + h * 256 + v) = w;
    }
    __syncthreads();
}
}

namespace mk {
struct Args {
    const float* in[23]; const int* page_table; float* out; unsigned char* ws; int ph_lo, ph_hi;
};
enum Phase { P_PRO = 0, P_AIN = 1, P_SCORE = 2, P_TOPK = 3, P_ATTN = 4, P_AOUT = 5, P_LN1 = 6, P_PQ0 = 7, P_PEER0 = 8, P_GIN = 9, P_GCH = 10, P_GSC = 11, P_GOUT = 12, P_GPRJ = 13, P_LN1B = 14, P_PQ1 = 15, P_PEER1 = 16, P_COUNT = 17 };

__global__ void __launch_bounds__(NTHREADS, 2) mk_fwd(Args args) {
    extern __shared__ __attribute__((aligned(16))) unsigned char lds_raw[];
    LAS unsigned char* lds = (LAS unsigned char*)lds_raw;
    volatile LAS unsigned* MISC = (volatile LAS unsigned*)(lds + MISC_OFF);
    const int tid = threadIdx.x, lane = tid & 63, wave = __builtin_amdgcn_readfirstlane(tid >> 6);
    const int G = gridDim.x, bx = blockIdx.x;
    const int vcu = (G % 8 == 0) ? (bx % 8) * (G / 8) + bx / 8 : bx;
    const int gw = vcu * NWAVES + wave, NGW = G * NWAVES;
    unsigned char* ws = args.ws;
    gu32* ctl = (gu32*)(ws + WS_CTL);
    for (int u = tid; u < (LDS_BYTES - LDSCTL_OFF) / 4; u += NTHREADS) ((LAS unsigned*)(lds + LDSCTL_OFF))[u] = 0u;
    __syncthreads();
    XcdBarrier bar = xcd_barrier_post((unsigned*)(ctl + CW_BAR), MISC + 8);
    const int lo = args.ph_lo, hi = args.ph_hi;
#define IN(k) (lo <= (k) && (k) < hi)
#define SEAM(k) do { if (IN(k) && IN((k) + 1)) xcd_barrier(bar); } while (0)

    const float* x_prompt = args.in[0]; const float* x_sample = args.in[1];
    const float* attn_w_in = args.in[7]; const float* attn_w_out = args.in[8]; const float* gla_w_in = args.in[9]; const float* gla_w_out = args.in[13];
    const float* peer_w_q = args.in[14]; const float* peer_keys1 = args.in[15]; const float* peer_keys2 = args.in[16]; const float* peer_u = args.in[17]; const float* peer_v = args.in[18];
    bf16* Wa = (bf16*)(ws + WS_WA); bf16* Wo = (bf16*)(ws + WS_WO); bf16* Wg = (bf16*)(ws + WS_WG); bf16* Wgo = (bf16*)(ws + WS_WGO); bf16* Wpq = (bf16*)(ws + WS_WPQ); bf16* PK = (bf16*)(ws + WS_PK);
    bf16* Ub = (bf16*)(ws + WS_UB); bf16* Vbx = (bf16*)(ws + WS_VBX); bf16* Xb = (bf16*)(ws + WS_XB);
    bf16* Qb = (bf16*)(ws + WS_QB); bf16* QIb = (bf16*)(ws + WS_QIB); bf16* Kb = (bf16*)(ws + WS_KB); bf16* Vb = (bf16*)(ws + WS_VB); bf16* KIb = (bf16*)(ws + WS_KIB); float* WIf = (float*)(ws + WS_WIF);

    if (IN(P_PRO)) {
        LAS float* scr = (LAS float*)(lds + wave * 16384);
        constexpr int KB16 = D / 64;
        constexpr int I_WA = (WA_ROWS / 32) * KB16, I_WO = (D / 32) * KB16, I_WG = (WG_ROWS / 32) * KB16, I_WGO = (D / 32) * KB16, I_WPQ = 2 * (PEER_N / 32) * KB16;
        constexpr int NITEMS = I_WA + I_WO + I_WG + I_WGO + I_WPQ;
        for (int it = gw; it < NITEMS; it += NGW) {
            int r = it;
            if (r < I_WA) { const int nb = r / KB16, kb = r % KB16, d0 = nb * 32; const int nv = ATT_N - d0 < 0 ? 0 : (ATT_N - d0 > 32 ? 32 : ATT_N - d0);
                p0_transpose_item(attn_w_in, ATT_N, D, Wa, d0, d0, nv, kb * 64, scr, lane); continue; } r -= I_WA;
            if (r < I_WO) { const int nb = r / KB16, kb = r % KB16; p0_transpose_item(attn_w_out, D, D, Wo, nb * 32, nb * 32, 32, kb * 64, scr, lane); continue; } r -= I_WO;
            if (r < I_WG) { const int nb = r / KB16, kb = r % KB16, d0 = nb * 32; int s0, nv;
                if (d0 < GN_R) { s0 = d0; nv = 32; } else if (d0 < GN_GD) { s0 = GR + (d0 - GN_R); nv = 32; } else if (d0 == GN_GD) { s0 = GGD; nv = 16; } else { s0 = 0; nv = 0; }
                p0_transpose_item(gla_w_in, GLA_N, D, Wg, d0, s0, nv, kb * 64, scr, lane); continue; } r -= I_WG;
            if (r < I_WGO) { const int nb = r / KB16, kb = r % KB16; p0_transpose_item(gla_w_out, D, D, Wgo, nb * 32, nb * 32, 32, kb * 64, scr, lane); continue; } r -= I_WGO;
            { const int l = r / ((PEER_N / 32) * KB16), rr = r % ((PEER_N / 32) * KB16), nb = rr / KB16, kb = rr % KB16;
              p0_transpose_item(peer_w_q + (size_t)l * D * PEER_N, PEER_N, D, Wpq + (size_t)l * PEER_N * D, nb * 32, nb * 32, 32, kb * 64, scr, lane); }
        }
        p0_convert(peer_u, Ub, (size_t)2 * 16384 * D / 8, gw, NGW, lane);
        p0_convert(peer_v, Vbx, (size_t)2 * 16384 * D / 8, gw, NGW, lane);
        p0_convert(x_prompt, Xb, (size_t)TP * D / 8, gw, NGW, lane);
        p0_convert(x_sample, Xb + (size_t)TP * D, (size_t)TS * D / 8, gw, NGW, lane);
        p0_convert(peer_keys1, PK, (size_t)2 * 128 * 128 / 8, gw, NGW, lane);
        p0_convert(peer_keys2, PK + 2 * 128 * 128, (size_t)2 * 128 * 128 / 8, gw, NGW, lane);
    }
    SEAM(P_PRO);

    if (IN(P_AIN)) {
        FAttnIn F{Qb, Kb, Vb, QIb, KIb, WIf, args.out};
        { pg8::Gemm g{Xb, Wa, TP, 2048, D}; pg8::StaticOrder S; S.init(TP, 2048, G, bx);
          pg8::EpiRow8<FAttnIn> E{F};
          pg8::gemm_phase<pg8::EpiRow8<FAttnIn>, pg8::StaticOrder, true, true>(lds, g, S, E); }
        for (int it = gw; it < TP / 16; it += NGW) {
            f32x4 acc[5]; skinny_tile<5>(Xb, D, Wa, D, it * 16, 2048, acc, lane);
#pragma unroll
            for (int ct = 0; ct < 5; ++ct) F.put4(it * 16 + (lane & 15), 2048 + ct * 16 + 4 * (lane >> 4), acc[ct]);
        }
        for (int it = gw; it < 8 * 19; it += NGW) {
            const int rt = it % 8, cg = it / 8;
            f32x4 acc[7]; skinny_tile<7>(Xb, D, Wa, D, TP + rt * 16, cg * 112, acc, lane);
#pragma unroll
            for (int ct = 0; ct < 7; ++ct) F.put4(TP + rt * 16 + (lane & 15), cg * 112 + ct * 16 + 4 * (lane >> 4), acc[ct]);
        }
    }
    SEAM(P_AIN);

    float* SC = (float*)(ws + WS_SC); float* SCS = (float*)(ws + WS_SCS); int* IDX = (int*)(ws + WS_IDX); int* CNT = (int*)(ws + WS_CNT);
    bf16* Ob = (bf16*)(ws + WS_OB); float* Z = (float*)(ws + WS_Z); float* H1f = (float*)(ws + WS_H1F); bf16* H1b = (bf16*)(ws + WS_H1B);
    if (IN(P_SCORE)) phase_score(QIb, KIb, WIf, args.in[4], args.page_table, SC, SCS, vcu, G, wave, lane, gw, NGW);
    SEAM(P_SCORE);
    if (IN(P_TOPK)) phase_topk(SC, SCS, IDX, CNT, lds, wave, lane, gw, NGW);
    SEAM(P_TOPK);
    if (IN(P_ATTN)) {
        LAS unsigned char* wl = lds + wave * 16384;
        for (int r = gw; r < TP; r += NGW) attn_row<false>(r, Qb, IDX, CNT, Kb, Vb, nullptr, nullptr, nullptr, nullptr, nullptr, Ob, wl, lane);
        for (int r = TP + gw; r < TA; r += NGW) attn_row<true>(r, Qb, IDX, CNT, nullptr, nullptr, args.in[2], args.in[3], args.out + OUT_KS, args.out + OUT_VS, args.page_table, Ob, wl, lane);
    }
    SEAM(P_ATTN);
    if (IN(P_AOUT)) {
        FResid F{x_prompt, x_sample, Z};
        { pg8::Gemm g{Ob, Wo, TP, D, D}; pg8::StaticOrder S; S.init(TP, D, G, bx);
          pg8::EpiRow8<FResid> E{F};
          pg8::gemm_phase<pg8::EpiRow8<FResid>, pg8::StaticOrder, true, true>(lds, g, S, E); }
        for (int it = gw; it < 8 * 16; it += NGW) {
            const int rt = it % 8, cg = it / 8;
            f32x4 acc[4]; skinny_tile<4>(Ob, D, Wo, D, TP + rt * 16, cg * 64, acc, lane);
#pragma unroll
            for (int ct = 0; ct < 4; ++ct) F.put4(TP + rt * 16 + (lane & 15), cg * 64 + ct * 16 + 4 * (lane >> 4), acc[ct]);
        }
    }
    SEAM(P_AOUT);
    if (IN(P_LN1)) { for (int r = gw; r < TA; r += NGW) ln_row_wave(Z + (size_t)r * D, args.in[19], args.in[20], H1f + (size_t)r * D, H1b + (size_t)r * D, lane); }
    SEAM(P_LN1);

    bf16* PQb = (bf16*)(ws + WS_PQB); float* H2f = (float*)(ws + WS_H2F); bf16* H2b = (bf16*)(ws + WS_H2B);
    if (IN(P_PQ0)) {
        FStoreBf16 F{PQb, PEER_N};
        { pg8::Gemm g{H1b, Wpq, TP, PEER_N, D}; pg8::StaticOrder S; S.init(TP, PEER_N, G, bx);
          pg8::EpiRow8<FStoreBf16> E{F};
          pg8::gemm_phase<pg8::EpiRow8<FStoreBf16>, pg8::StaticOrder, true, true>(lds, g, S, E); }
        for (int it = gw; it < 8 * 16; it += NGW) {
            const int rt = it % 8, cg = it / 8;
            f32x4 acc[8]; skinny_tile<8>(H1b, D, Wpq, D, TP + rt * 16, cg * 128, acc, lane);
#pragma unroll
            for (int ct = 0; ct < 8; ++ct) F.put4(TP + rt * 16 + (lane & 15), cg * 128 + ct * 16 + 4 * (lane >> 4), acc[ct]);
        }
    }
    SEAM(P_PQ0);
    if (IN(P_PEER0)) phase_peer(H1f, H1b, PQb, PK, PK + 2 * 16384, Ub, Vbx, args.in[21], args.in[22], H2f, H2b, lds, vcu, G, wave, lane);
    SEAM(P_PEER0);

    bf16* Gq = (bf16*)(ws + WS_GQ); bf16* Gk = (bf16*)(ws + WS_GK); bf16* Gv = (bf16*)(ws + WS_GV); bf16* Gr = (bf16*)(ws + WS_GR); float* GD = (float*)(ws + WS_GD);
    bf16* QT = (bf16*)(ws + WS_QT); bf16* KT = (bf16*)(ws + WS_KT); float* DEC = (float*)(ws + WS_DEC); float* DSb = (float*)(ws + WS_DS); bf16* SPV = (bf16*)(ws + WS_SPREV); bf16* OGb = (bf16*)(ws + WS_OGB);
    if (IN(P_GIN)) {
        FGlaIn F{Gq, Gk, Gv, Gr, GD};
        { pg8::Gemm g{H2b, Wg, TP, 3072, D}; pg8::StaticOrder S; S.init(TP, 3072, G, bx);
          pg8::EpiRow8<FGlaIn> E{F};
          pg8::gemm_phase<pg8::EpiRow8<FGlaIn>, pg8::StaticOrder, true, true>(lds, g, S, E); }
        for (int it = gw; it < TP / 16; it += NGW) {
            f32x4 acc[1]; skinny_tile<1>(H2b, D, Wg, D, it * 16, GN_GD, acc, lane);
            F.put4(it * 16 + (lane & 15), GN_GD + 4 * (lane >> 4), acc[0]);
        }
        for (int it = gw; it < 8 * 97; it += NGW) {
            const int rt = it % 8, cg = it / 8;
            f32x4 acc[2]; skinny_tile<2>(H2b, D, Wg, D, TP + rt * 16, cg * 32, acc, lane);
#pragma unroll
            for (int ct = 0; ct < 2; ++ct) F.put4(TP + rt * 16 + (lane & 15), cg * 32 + ct * 16 + 4 * (lane >> 4), acc[ct]);
        }
    }
    SEAM(P_GIN);
    if (IN(P_GCH)) {
        for (int it = vcu; it < NBATCH * (SEQ / 64) * 4; it += G) gla_chunk_item(it, Gq, Gk, Gv, GD, args.in[10], args.in[11], QT, KT, DEC, DSb, lds, tid, wave, lane);
        for (int it = vcu; it < DB * 4; it += G) gla_sample_item(it, Gq, Gk, Gv, Gr, GD, args.in[10], args.in[11], args.in[12], args.in[5], args.out + OUT_SS, OGb, lds, tid, lane);
    }
    SEAM(P_GCH);
    if (IN(P_GSC)) gla_scan(DSb, DEC, SPV, args.out + OUT_SP, vcu * NTHREADS + tid, G * NTHREADS);
    SEAM(P_GSC);
    if (IN(P_GOUT)) { for (int it = vcu; it < NBATCH * (SEQ / 64) * 4; it += G) gla_out_item(it, QT, KT, Gv, Gr, SPV, args.in[12], OGb, lds, tid, wave, lane); }
    SEAM(P_GOUT);
    if (IN(P_GPRJ)) {
        FResid F{H2f, H2f + (size_t)TP * D, Z};
        { pg8::Gemm g{OGb, Wgo, TP, D, D}; pg8::StaticOrder S; S.init(TP, D, G, bx);
          pg8::EpiRow8<FResid> E{F};
          pg8::gemm_phase<pg8::EpiRow8<FResid>, pg8::StaticOrder, true, true>(lds, g, S, E); }
        for (int it = gw; it < 8 * 16; it += NGW) {
            const int rt = it % 8, cg = it / 8;
            f32x4 acc[4]; skinny_tile<4>(OGb, D, Wgo, D, TP + rt * 16, cg * 64, acc, lane);
#pragma unroll
            for (int ct = 0; ct < 4; ++ct) F.put4(TP + rt * 16 + (lane & 15), cg * 64 + ct * 16 + 4 * (lane >> 4), acc[ct]);
        }
    }
    SEAM(P_GPRJ);
    if (IN(P_LN1B)) { for (int r = gw; r < TA; r += NGW) ln_row_wave(Z + (size_t)r * D, args.in[19] + D, args.in[20] + D, H1f + (size_t)r * D, H1b + (size_t)r * D, lane); }
    SEAM(P_LN1B);
    if (IN(P_PQ1)) {
        FStoreBf16 F{PQb, PEER_N}; const bf16* W1 = Wpq + (size_t)PEER_N * D;
        { pg8::Gemm g{H1b, W1, TP, PEER_N, D}; pg8::StaticOrder S; S.init(TP, PEER_N, G, bx);
          pg8::EpiRow8<FStoreBf16> E{F};
          pg8::gemm_phase<pg8::EpiRow8<FStoreBf16>, pg8::StaticOrder, true, true>(lds, g, S, E); }
        for (int it = gw; it < 8 * 16; it += NGW) {
            const int rt = it % 8, cg = it / 8;
            f32x4 acc[8]; skinny_tile<8>(H1b, D, W1, D, TP + rt * 16, cg * 128, acc, lane);
#pragma unroll
            for (int ct = 0; ct < 8; ++ct) F.put4(TP + rt * 16 + (lane & 15), cg * 128 + ct * 16 + 4 * (lane >> 4), acc[ct]);
        }
    }
    SEAM(P_PQ1);
    if (IN(P_PEER1)) phase_peer(H1f, H1b, PQb, PK + 16384, PK + 3 * 16384, Ub + (size_t)16384 * D, Vbx + (size_t)16384 * D, args.in[21] + D, args.in[22] + D, args.out + OUT_Y, nullptr, lds, vcu, G, wave, lane);
#undef IN
#undef SEAM
}

__global__ void ad_attn_in(const bf16* Qb, const bf16* Kb, const bf16* Vb, const bf16* QIb, const bf16* KIb, const float* WIf, float* P) {
    const int row = blockIdx.x; float* p = P + (size_t)row * ATT_N;
    for (int c = threadIdx.x; c < ATT_N; c += blockDim.x) {
        float v;
        if (c < AK) v = bf2f(Qb[(size_t)row * 1024 + c]); else if (c < AV) v = bf2f(Kb[(size_t)row * 256 + c - AK]); else if (c < AQI) v = bf2f(Vb[(size_t)row * 256 + c - AV]);
        else if (c < AKI) v = bf2f(QIb[(size_t)row * 512 + c - AQI]); else if (c < AWI) v = bf2f(KIb[(size_t)row * 64 + c - AKI]); else v = WIf[(size_t)row * 8 + c - AWI] * 22.627416997969522f;
        p[c] = v;
    }
}
__global__ void ad_bf16_to_f32(const bf16* src, float* dst, size_t n) { size_t i = (size_t)blockIdx.x * blockDim.x + threadIdx.x; for (; i < n; i += (size_t)gridDim.x * blockDim.x) dst[i] = bf2f(src[i]); }
__global__ void ad_copy_f32(const float* src, float* dst, size_t n) { size_t i = (size_t)blockIdx.x * blockDim.x + threadIdx.x; for (; i < n; i += (size_t)gridDim.x * blockDim.x) dst[i] = src[i]; }
}

#ifndef HYBRID_K
#define HYBRID_K 1
#endif
extern "C" void kernel_launch(void* const* d_in, const int* in_sizes, int n_in, void* d_out, int out_size, void* d_ws, size_t ws_size, hipStream_t stream) {
    const float* x_prompt = (const float*)d_in[0];
    const float* x_sample = (const float*)d_in[1];
    const float* cache_k = (const float*)d_in[2];
    const float* cache_v = (const float*)d_in[3];
    const float* cache_ki = (const float*)d_in[4];
    const float* state_gla = (const float*)d_in[5];
    const int* page_table = (const int*)d_in[6];
    const float* attn_w_in = (const float*)d_in[7];
    const float* attn_w_out = (const float*)d_in[8];
    const float* gla_w_in = (const float*)d_in[9];
    const float* gla_w_gate_up = (const float*)d_in[10];
    const float* gla_b_gate = (const float*)d_in[11];
    const float* gla_norm_g = (const float*)d_in[12];
    const float* gla_w_out = (const float*)d_in[13];
    const float* peer_w_q = (const float*)d_in[14];
    const float* peer_keys1 = (const float*)d_in[15];
    const float* peer_keys2 = (const float*)d_in[16];
    const float* peer_u = (const float*)d_in[17];
    const float* peer_v = (const float*)d_in[18];
    const float* ln1_g = (const float*)d_in[19];
    const float* ln1_b = (const float*)d_in[20];
    const float* ln2_g = (const float*)d_in[21];
    const float* ln2_b = (const float*)d_in[22];
    float* out = (float*)d_out;

    constexpr size_t MiB = 1u << 20;
    constexpr size_t W_A0 = 0, W_A1 = 65 * MiB, W_A2 = 130 * MiB, W_A3 = 195 * MiB, W_A4 = 260 * MiB, W_A5 = 325 * MiB;
    constexpr size_t W_P = 390 * MiB, W_IDX = 525 * MiB, W_CNT = 542 * MiB, W_SCS = 543 * MiB, W_SC = 548 * MiB;
    constexpr size_t W_PQ = W_SC, W_G = W_SC + 130 * MiB, W_LA = W_SC + 326 * MiB;
    static_assert(W_IDX == mk::WS_IDX && W_CNT == mk::WS_CNT && W_SCS == mk::WS_SCS && W_SC == mk::WS_SC, "shared formats live at the same offsets");
    if (ws_size < mk::WS_END || n_in != 23 || (size_t)out_size != OUT_TOTAL) { fprintf(stderr, "kernel_launch: unexpected sizes ws %zu n_in %d out %d\n", ws_size, n_in, out_size); return; }
    char* ws = (char*)d_ws;
    float *X = (float*)(ws + W_A0), *O = (float*)(ws + W_A1), *Y = (float*)(ws + W_A2), *H1 = (float*)(ws + W_A3), *H2 = (float*)(ws + W_A4), *OGN = (float*)(ws + W_A5);
    float *P = (float*)(ws + W_P), *SC = (float*)(ws + W_SC), *SCS = (float*)(ws + W_SCS), *PQ = (float*)(ws + W_PQ), *G = (float*)(ws + W_G), *LA = (float*)(ws + W_LA);
    int *IDX = (int*)(ws + W_IDX), *CNT = (int*)(ws + W_CNT);
    float* OG = O; float* H3 = H1;

    static int grid = 0;
    if (grid == 0) {
        int dev = 0, cus = 0;
        if (hipGetDevice(&dev) != hipSuccess || hipDeviceGetAttribute(&cus, hipDeviceAttributeMultiprocessorCount, dev) != hipSuccess) { fprintf(stderr, "kernel_launch: device query failed\n"); grid = -1; return; }
        if (hipFuncSetAttribute((const void*)mk::mk_fwd, hipFuncAttributeMaxDynamicSharedMemorySize, mk::LDS_BYTES) != hipSuccess) { fprintf(stderr, "kernel_launch: hipFuncSetAttribute failed\n"); grid = -1; return; }
        int per_cu = 0;
        if (hipOccupancyMaxActiveBlocksPerMultiprocessor(&per_cu, (const void*)mk::mk_fwd, mk::NTHREADS, mk::LDS_BYTES) != hipSuccess || per_cu < 1) { fprintf(stderr, "kernel_launch: occupancy query says %d\n", per_cu); }
        (void)hipGetLastError();
        grid = cus;
    }
    if (grid < 0) return;
    (void)hipMemsetAsync(ws + mk::WS_CTL, 0, mk::CTL_ZERO_BYTES, stream);
    mk::Args a{};
    for (int i = 0; i < 23; ++i) a.in[i] = (const float*)d_in[i];
    a.page_table = page_table; a.out = out; a.ws = (unsigned char*)d_ws;
    auto run = [&](int lo, int hi) { a.ph_lo = lo; a.ph_hi = hi; hipLaunchKernelGGL(mk::mk_fwd, dim3(grid), dim3(mk::NTHREADS), mk::LDS_BYTES, stream, a); };

    auto gemm = [&](const float* A, int lda, const float* W, int N, int K, float* C, int ldc) {
        hipLaunchKernelGGL(nv::gemm_f32, dim3((N + 63) / 64, (TA + 63) / 64), dim3(256), 0, stream, A, lda, W, N, K, C, ldc, TA);
    };
    constexpr int HK = HYBRID_K;
#if HYBRID_K >= 11
    run(0, mk::P_COUNT);
    return;
#endif
    hipLaunchKernelGGL(nv::concat_x, dim3(2048), dim3(256), 0, stream, x_prompt, x_sample, X);
    if (HK >= 1) {
        run(mk::P_PRO, mk::P_PRO + 1); run(mk::P_AIN, mk::P_AIN + 1);
        hipLaunchKernelGGL(mk::ad_attn_in, dim3(TA), dim3(256), 0, stream, (const mk::bf16*)(ws + mk::WS_QB), (const mk::bf16*)(ws + mk::WS_KB), (const mk::bf16*)(ws + mk::WS_VB),
                           (const mk::bf16*)(ws + mk::WS_QIB), (const mk::bf16*)(ws + mk::WS_KIB), (const float*)(ws + mk::WS_WIF), P);
    } else {
        gemm(X, D, attn_w_in, ATT_N, D, P, ATT_N);
        hipLaunchKernelGGL(nv::scatter_kv, dim3(TA), dim3(256), 0, stream, (const float*)P, out);
    }
#if defined(DBG_KV) && DBG_KV
    if (HK >= 2) { gemm(X, D, attn_w_in, ATT_N, D, P, ATT_N); hipLaunchKernelGGL(nv::scatter_kv, dim3(TA), dim3(256), 0, stream, (const float*)P, out); }
#endif
    if (HK >= 2) run(mk::P_SCORE, mk::P_SCORE + 1);
    else {
    hipLaunchKernelGGL((nv::idx_scores<false, 16>), dim3(SEQ / 64, SEQ / 16, NBATCH), dim3(256), 0, stream, (const float*)P, cache_ki, page_table, SC);
    hipLaunchKernelGGL((nv::idx_scores<true, 4>), dim3((PAST + DS + 63) / 64, 1, DB), dim3(256), 0, stream, (const float*)P, cache_ki, page_table, SCS);
    }
    if (HK >= 3) run(mk::P_TOPK, mk::P_TOPK + 1);
    else hipLaunchKernelGGL(nv::topk_rows, dim3(TA / 4), dim3(256), 0, stream, (const float*)SC, (const float*)SCS, IDX, CNT);
    if (HK >= 4) { run(mk::P_ATTN, mk::P_ATTN + 1); if (HK < 5) hipLaunchKernelGGL(mk::ad_bf16_to_f32, dim3(2048), dim3(256), 0, stream, (const mk::bf16*)(ws + mk::WS_OB), O, (size_t)TA * D); }
    else {
    hipLaunchKernelGGL((nv::attn_naive<false>), dim3(TP), dim3(256), 0, stream, (const float*)P, (const int*)IDX, (const int*)CNT, cache_k, cache_v, page_table, O);
    hipLaunchKernelGGL((nv::attn_naive<true>), dim3(TS), dim3(256), 0, stream, (const float*)P, (const int*)IDX, (const int*)CNT, cache_k, cache_v, page_table, O);
    }
    if (HK >= 5) { run(mk::P_AOUT, mk::P_AOUT + 1); run(mk::P_LN1, mk::P_LN1 + 1); hipLaunchKernelGGL(mk::ad_copy_f32, dim3(2048), dim3(256), 0, stream, (const float*)(ws + mk::WS_H1F), H1, (size_t)TA * D); }
    else {
    gemm(O, D, attn_w_out, D, D, Y, D);
    hipLaunchKernelGGL(nv::ln_res, dim3(TA), dim3(256), 0, stream, (const float*)X, (const float*)Y, ln1_g, ln1_b, H1);
    }
    if (HK >= 6) { run(mk::P_PQ0, mk::P_PQ0 + 1); run(mk::P_PEER0, mk::P_PEER0 + 1); hipLaunchKernelGGL(mk::ad_copy_f32, dim3(2048), dim3(256), 0, stream, (const float*)(ws + mk::WS_H2F), H2, (size_t)TA * D); }
    else {
    gemm(H1, D, peer_w_q, PEER_N, D, PQ, PEER_N);
    hipLaunchKernelGGL(nv::peer_naive, dim3(TA), dim3(256), 0, stream, (const float*)H1, (const float*)PQ, peer_keys1, peer_keys2, peer_u, peer_v, ln2_g, ln2_b, H2);
    }
    if (HK >= 8) {
        run(mk::P_GIN, mk::P_GIN + 1); run(mk::P_GCH, mk::P_GCH + 1); run(mk::P_GSC, mk::P_GSC + 1); run(mk::P_GOUT, mk::P_GOUT + 1);
        if (HK < 9) hipLaunchKernelGGL(mk::ad_bf16_to_f32, dim3(2048), dim3(256), 0, stream, (const mk::bf16*)(ws + mk::WS_OGB), OGN, (size_t)TA * D);
    } else {
    gemm(H2, D, gla_w_in, GLA_N, D, G, GLA_N);
    hipLaunchKernelGGL(nv::gla_gate, dim3(TA), dim3(512), 0, stream, (const float*)G, gla_w_gate_up, gla_b_gate, LA);
    hipLaunchKernelGGL(nv::gla_rec, dim3(4, 4, NBATCH), dim3(256), 0, stream, (const float*)G, (const float*)LA, (const float*)nullptr, SEQ, 0, OG, out + OUT_SP);
    hipLaunchKernelGGL(nv::gla_rec, dim3(4, 4, DB), dim3(256), 0, stream, (const float*)G, (const float*)LA, state_gla, DS, TP, OG, out + OUT_SS);
    hipLaunchKernelGGL(nv::gla_post, dim3(TA), dim3(256), 0, stream, (const float*)OG, (const float*)G, gla_norm_g, OGN);
    }
    if (HK >= 9) { run(mk::P_GPRJ, mk::P_GPRJ + 1); run(mk::P_LN1B, mk::P_LN1B + 1); if (HK < 10) hipLaunchKernelGGL(mk::ad_copy_f32, dim3(2048), dim3(256), 0, stream, (const float*)(ws + mk::WS_H1F), H3, (size_t)TA * D); }
    else {
    gemm(OGN, D, gla_w_out, D, D, Y, D);
    hipLaunchKernelGGL(nv::ln_res, dim3(TA), dim3(256), 0, stream, (const float*)H2, (const float*)Y, ln1_g + D, ln1_b + D, H3);
    }
    if (HK >= 10) { run(mk::P_PQ1, mk::P_PQ1 + 1); run(mk::P_PEER1, mk::P_PEER1 + 1); }
    else {
    gemm(H3, D, peer_w_q + (size_t)D * PEER_N, PEER_N, D, PQ, PEER_N);
    hipLaunchKernelGGL(nv::peer_naive, dim3(TA), dim3(256), 0, stream, (const float*)H3, (const float*)PQ, peer_keys1 + 128 * 128, peer_keys2 + 128 * 128,
                       peer_u + (size_t)16384 * D, peer_v + (size_t)16384 * D, ln2_g + D, ln2_b + D, out + OUT_Y);
    }
}
```

```cpp
#include <hip/hip_runtime.h>
#include <cstdio>
#include <cstdint>
#include <cmath>

constexpr int D = 1024;
constexpr int NBATCH = 2, SEQ = 8192, TP = NBATCH * SEQ;
constexpr int DB = 32, DS = 4, TS = DB * DS;
constexpr int TA = TP + TS;
constexpr int PAST = 8192, PAGE = 128, NPAGES = PAST / PAGE;
constexpr float ALPHA = 1.4142135623730951f;
constexpr float LN_EPS = 1e-5f;
constexpr int ATT_N = 2120;
constexpr int AQ = 0, AK = 1024, AV = 1280, AQI = 1536, AKI = 2048, AWI = 2112;
constexpr int TOPK = 256;
constexpr int GLA_N = 3088;
constexpr int GQ = 0, GK = 512, GV = 1024, GGD = 2048, GR = 2064;
constexpr int PEER_N = 2048;
constexpr int SCS_LD = 8256;

constexpr size_t OUT_Y = 0, OUT_KP = 16908288, OUT_VP = 21102592, OUT_KIP = 25296896, OUT_SP = 26345472,
                 OUT_KS = 26607616, OUT_VS = 26640384, OUT_KIS = 26673152, OUT_SS = 26681344, OUT_TOTAL = 30875648;


namespace nv {

__global__ void concat_x(const float* __restrict__ xp, const float* __restrict__ xs, float* __restrict__ X) {
    size_t i = (size_t)blockIdx.x * blockDim.x + threadIdx.x, n = (size_t)TA * D / 4, np = (size_t)TP * D / 4;
    for (; i < n; i += (size_t)gridDim.x * blockDim.x) ((float4*)X)[i] = i < np ? ((const float4*)xp)[i] : ((const float4*)xs)[i - np];
}

__global__ __launch_bounds__(256) void gemm_f32(const float* __restrict__ A, int lda, const float* __restrict__ W, int N, int K, float* __restrict__ C, int ldc, int M) {
    __shared__ float As[16][65];
    __shared__ float Ws[16][64];
    const int tx = threadIdx.x & 15, ty = threadIdx.x >> 4;
    const int m0 = blockIdx.y * 64, n0 = blockIdx.x * 64;
    float acc[4][4];
#pragma unroll
    for (int i = 0; i < 4; ++i)
#pragma unroll
        for (int j = 0; j < 4; ++j) acc[i][j] = 0.f;
    for (int k0 = 0; k0 < K; k0 += 16) {
#pragma unroll
        for (int i = 0; i < 4; ++i) { const int e = threadIdx.x + i * 256, r = e >> 4, kk = e & 15, gm = m0 + r; As[kk][r] = gm < M ? A[(size_t)gm * lda + k0 + kk] : 0.f; }
#pragma unroll
        for (int i = 0; i < 4; ++i) { const int e = threadIdx.x + i * 256, kk = e >> 6, c = e & 63, gn = n0 + c; Ws[kk][c] = gn < N ? W[(size_t)(k0 + kk) * N + gn] : 0.f; }
        __syncthreads();
#pragma unroll
        for (int kk = 0; kk < 16; ++kk) {
            float a[4], b[4];
#pragma unroll
            for (int i = 0; i < 4; ++i) { a[i] = As[kk][ty * 4 + i]; b[i] = Ws[kk][tx * 4 + i]; }
#pragma unroll
            for (int i = 0; i < 4; ++i)
#pragma unroll
                for (int j = 0; j < 4; ++j) acc[i][j] += a[i] * b[j];
        }
        __syncthreads();
    }
#pragma unroll
    for (int i = 0; i < 4; ++i) { const int gm = m0 + ty * 4 + i; if (gm < M) {
#pragma unroll
        for (int j = 0; j < 4; ++j) { const int gn = n0 + tx * 4 + j; if (gn < N) C[(size_t)gm * ldc + gn] = acc[i][j]; } } }
}

__global__ void scatter_kv(const float* __restrict__ P, float* __restrict__ out) {
    const int row = blockIdx.x;
    const float* p = P + (size_t)row * ATT_N;
    float *ok, *ov, *oki;
    if (row < TP) { ok = out + OUT_KP + (size_t)row * 256; ov = out + OUT_VP + (size_t)row * 256; oki = out + OUT_KIP + (size_t)row * 64; }
    else { const int r = row - TP; ok = out + OUT_KS + (size_t)r * 256; ov = out + OUT_VS + (size_t)r * 256; oki = out + OUT_KIS + (size_t)r * 64; }
    const int t = threadIdx.x;
    ok[t] = p[AK + t]; ov[t] = p[AV + t]; if (t < 64) oki[t] = p[AKI + t];
}

template <bool SAMPLE, int QT>
__global__ __launch_bounds__(256) void idx_scores(const float* __restrict__ P, const float* __restrict__ cache_ki, const int* __restrict__ page_table, float* __restrict__ SC) {
    __shared__ float qs[QT][512];
    __shared__ float ks[64][65];
    __shared__ float ws_[QT][8];
    const int b = blockIdx.z, q0 = blockIdx.y * QT, l0 = blockIdx.x * 64, tid = threadIdx.x;
    if (!SAMPLE && l0 > q0 + QT - 1) return;
    const int L = SAMPLE ? PAST + DS : SEQ;
    const size_t tok0 = SAMPLE ? (size_t)TP + b * DS + q0 : (size_t)b * SEQ + q0;
    for (int e = tid; e < QT * 512; e += 256) { const int r = e >> 9, c = e & 511; qs[r][c] = P[(tok0 + r) * ATT_N + AQI + c]; }
    for (int e = tid; e < QT * 8; e += 256) { const int r = e >> 3, c = e & 7; ws_[r][c] = P[(tok0 + r) * ATT_N + AWI + c] * 0.35355339059327373f; }
    for (int e = tid; e < 64 * 64; e += 256) {
        const int r = e >> 6, c = e & 63, l = l0 + r; float v = 0.f;
        if (l < L) {
            if (!SAMPLE) v = P[((size_t)b * SEQ + l) * ATT_N + AKI + c];
            else if (l < PAST) { const int phys = page_table[b * NPAGES + l / PAGE]; v = cache_ki[((size_t)phys * PAGE + (l % PAGE)) * 64 + c]; }
            else v = P[((size_t)TP + b * DS + (l - PAST)) * ATT_N + AKI + c];
        }
        ks[r][c] = v;
    }
    __syncthreads();
    constexpr int PER = QT * 64 / 256;
#pragma unroll
    for (int i = 0; i < PER; ++i) {
        const int e = tid + i * 256, r = e >> 6, c = e & 63, l = l0 + c;
        float s = 0.f;
        for (int h = 0; h < 8; ++h) { float d = 0.f;
#pragma unroll 8
            for (int k = 0; k < 64; ++k) d += qs[r][h * 64 + k] * ks[c][k];
            d *= 0.125f; s += fmaxf(d, 0.f) * ws_[r][h]; }
        if (l < L) { if (SAMPLE) SC[(size_t)(b * DS + q0 + r) * SCS_LD + l] = s; else SC[((size_t)b * SEQ + q0 + r) * SEQ + l] = s; }
    }
}

#define WAVE_LDS_FENCE() asm volatile("s_waitcnt vmcnt(0) lgkmcnt(0)" ::: "memory")

template <int CAP>
__device__ __forceinline__ void topk_wave(const float* __restrict__ row, int n, int* __restrict__ out, unsigned* hist, float* cv, int* ci, int lane) {
    if (n <= TOPK) { for (int i = lane; i < TOPK; i += 64) out[i] = i < n ? i : 0; return; }
    float mn = INFINITY, mx = -INFINITY;
    for (int i = lane; i < n; i += 64) { const float s = row[i]; mn = fminf(mn, s); mx = fmaxf(mx, s); }
#pragma unroll
    for (int o = 1; o < 64; o <<= 1) { mn = fminf(mn, __shfl_xor(mn, o)); mx = fmaxf(mx, __shfl_xor(mx, o)); }
    if (!(mx > mn)) { for (int i = lane; i < TOPK; i += 64) out[i] = i; return; }
    const float scale = 2048.0f / (mx - mn);
    for (int i = lane; i < 2048; i += 64) hist[i] = 0u;
    WAVE_LDS_FENCE();
    for (int i = lane; i < n; i += 64) { const float s = row[i]; int bn = (int)((s - mn) * scale); bn = bn > 2047 ? 2047 : bn; atomicAdd(&hist[bn], 1u); }
    WAVE_LDS_FENCE();
    unsigned mine = 0u;
    for (int j = 0; j < 32; ++j) mine += hist[lane * 32 + j];
    unsigned suf = mine;
#pragma unroll
    for (int o = 1; o < 64; o <<= 1) { const unsigned t = __shfl_down(suf, o); if (lane + o < 64) suf += t; }
    const unsigned long long bal = __ballot(suf >= (unsigned)TOPK);
    const int Lt = 63 - __builtin_clzll(bal);
    unsigned running = __shfl(suf, Lt) - __shfl(mine, Lt);
    int B = Lt * 32;
    for (int j = 31; j >= 0; --j) { const unsigned h = hist[Lt * 32 + j]; if (running + h >= (unsigned)TOPK) { B = Lt * 32 + j; break; } running += h; }
    const int cnt_gt = (int)running, r = TOPK - cnt_gt;
    int base_gt = 0, base_eq = 0;
    for (int i0 = 0; i0 < n; i0 += 64) {
        const int i = i0 + lane; bool gt = false, eq = false; float s = 0.f;
        if (i < n) { s = row[i]; int bn = (int)((s - mn) * scale); bn = bn > 2047 ? 2047 : bn; gt = bn > B; eq = bn == B; }
        const unsigned long long mg = __ballot(gt), me = __ballot(eq);
        const unsigned long long below = (1ull << lane) - 1ull;
        if (gt) out[base_gt + __builtin_popcountll(mg & below)] = i;
        if (eq) { const int p = base_eq + __builtin_popcountll(me & below); if (p < CAP) { cv[p] = s; ci[p] = i; } }
        base_gt += __builtin_popcountll(mg); base_eq += __builtin_popcountll(me);
    }
    WAVE_LDS_FENCE();
    const int m = base_eq < CAP ? base_eq : CAP;
    for (int c = lane; c < m; c += 64) {
        const float v = cv[c]; const int id = ci[c]; int rank = 0;
        for (int c2 = 0; c2 < m; ++c2) { const float v2 = cv[c2]; const int id2 = ci[c2]; rank += (v2 > v || (v2 == v && id2 < id)) ? 1 : 0; }
        if (rank < r) out[cnt_gt + rank] = id;
    }
    WAVE_LDS_FENCE();
}

__global__ __launch_bounds__(256) void topk_rows(const float* __restrict__ SCP, const float* __restrict__ SCS, int* __restrict__ IDX, int* __restrict__ CNT) {
    constexpr int CAP = 1024;
    __shared__ unsigned hist[4][2048];
    __shared__ float cv[4][CAP];
    __shared__ int ci[4][CAP];
    const int w = threadIdx.x >> 6, lane = threadIdx.x & 63;
    const int row = blockIdx.x * 4 + w;
    if (row >= TA) return;
    const float* rp; int n;
    if (row < TP) { rp = SCP + (size_t)row * SEQ; n = (row % SEQ) + 1; }
    else { const int r = row - TP; rp = SCS + (size_t)r * SCS_LD; n = PAST + (r % DS) + 1; }
    topk_wave<CAP>(rp, n, IDX + (size_t)row * TOPK, hist[w], cv[w], ci[w], lane);
    if (lane == 0) CNT[row] = n < TOPK ? n : TOPK;
}

template <bool SAMPLE>
__global__ __launch_bounds__(256) void attn_naive(const float* __restrict__ P, const int* __restrict__ IDX, const int* __restrict__ CNT, const float* __restrict__ cache_k, const float* __restrict__ cache_v,
                                                  const int* __restrict__ page_table, float* __restrict__ O) {
    __shared__ float qs[1024];
    __shared__ float ps[16][256];
    __shared__ const float* vptr[256];
    const int r = blockIdx.x, tid = threadIdx.x;
    const int row = SAMPLE ? TP + r : r;
    const int b = SAMPLE ? r / DS : r / SEQ;
    for (int e = tid; e < 1024; e += 256) qs[e] = P[(size_t)row * ATT_N + AQ + e];
    const int cnt = CNT[row];
    const bool valid = tid < cnt;
    const int idx = valid ? IDX[(size_t)row * TOPK + tid] : 0;
    const float *krow, *vrow;
    if (!SAMPLE) { krow = P + ((size_t)b * SEQ + idx) * ATT_N + AK; vrow = P + ((size_t)b * SEQ + idx) * ATT_N + AV; }
    else if (idx < PAST) { const int phys = page_table[b * NPAGES + idx / PAGE]; const size_t o = ((size_t)phys * PAGE + (idx % PAGE)) * 256; krow = cache_k + o; vrow = cache_v + o; }
    else { const size_t tk = (size_t)TP + b * DS + (idx - PAST); krow = P + tk * ATT_N + AK; vrow = P + tk * ATT_N + AV; }
    vptr[tid] = vrow;
    __syncthreads();
    for (int hh = 0; hh < 16; ++hh) { const int n = hh >> 2; float s = 0.f;
        for (int d = 0; d < 64; ++d) s += qs[hh * 64 + d] * krow[n * 64 + d];
        ps[hh][tid] = valid ? s * 0.125f : -INFINITY; }
    __syncthreads();
    { const int w = tid >> 6, lane = tid & 63;
      for (int hh = w * 4; hh < w * 4 + 4; ++hh) {
          float v[4]; float m = -INFINITY;
#pragma unroll
          for (int i = 0; i < 4; ++i) { v[i] = ps[hh][lane + 64 * i]; m = fmaxf(m, v[i]); }
#pragma unroll
          for (int o = 1; o < 64; o <<= 1) m = fmaxf(m, __shfl_xor(m, o));
          float sum = 0.f;
#pragma unroll
          for (int i = 0; i < 4; ++i) { v[i] = expf(v[i] - m); sum += v[i]; }
#pragma unroll
          for (int o = 1; o < 64; o <<= 1) sum += __shfl_xor(sum, o);
          const float inv = 1.f / sum;
#pragma unroll
          for (int i = 0; i < 4; ++i) ps[hh][lane + 64 * i] = v[i] * inv;
      } }
    __syncthreads();
#pragma unroll
    for (int c = 0; c < 4; ++c) { const int col = tid + 256 * c, hh = col >> 6, n = hh >> 2, d = col & 63; float o = 0.f;
        for (int j = 0; j < TOPK; ++j) o += ps[hh][j] * vptr[j][n * 64 + d];
        O[(size_t)row * 1024 + col] = o; }
}

__device__ __forceinline__ float block_sum_256(float v, float* red) {
#pragma unroll
    for (int o = 1; o < 64; o <<= 1) v += __shfl_xor(v, o);
    __syncthreads();
    if ((threadIdx.x & 63) == 0) red[threadIdx.x >> 6] = v;
    __syncthreads();
    return (red[0] + red[1]) + (red[2] + red[3]);
}

__global__ __launch_bounds__(256) void ln_res(const float* __restrict__ xin, const float* __restrict__ y, const float* __restrict__ g, const float* __restrict__ bt, float* __restrict__ out) {
    __shared__ float red[4];
    const int row = blockIdx.x, tid = threadIdx.x;
    float z[4]; float s = 0.f;
#pragma unroll
    for (int i = 0; i < 4; ++i) { const int c = tid + 256 * i; z[i] = ALPHA * xin[(size_t)row * D + c] + y[(size_t)row * D + c]; s += z[i]; }
    const float mean = block_sum_256(s, red) * (1.f / D);
    float q = 0.f;
#pragma unroll
    for (int i = 0; i < 4; ++i) { z[i] -= mean; q += z[i] * z[i]; }
    const float rstd = rsqrtf(block_sum_256(q, red) * (1.f / D) + LN_EPS);
#pragma unroll
    for (int i = 0; i < 4; ++i) { const int c = tid + 256 * i; out[(size_t)row * D + c] = z[i] * rstd * g[c] + bt[c]; }
}

__global__ __launch_bounds__(256) void peer_naive(const float* __restrict__ Hin, const float* __restrict__ PQ, const float* __restrict__ keys1, const float* __restrict__ keys2,
                                                  const float* __restrict__ U, const float* __restrict__ V, const float* __restrict__ g2, const float* __restrict__ b2, float* __restrict__ out) {
    __shared__ float sc[8][2][128];
    __shared__ float xs[1024];
    __shared__ float tv[8][2][16];
    __shared__ int ti[8][2][16];
    __shared__ unsigned char taken[8][256];
    __shared__ float wk[128];
    __shared__ int eid[128];
    __shared__ float red[4];
    const int t = blockIdx.x, tid = threadIdx.x;
    for (int e = tid; e < 1024; e += 256) xs[e] = Hin[(size_t)t * D + e];
    for (int e = tid; e < 2048; e += 256) { const int h = e >> 8, half = (e >> 7) & 1, k = e & 127;
        const float* q = PQ + (size_t)t * PEER_N + h * 256 + half * 128; const float* ky = (half ? keys2 : keys1) + (size_t)k * 128; float s = 0.f;
        for (int d = 0; d < 128; ++d) s += q[d] * ky[d];
        sc[h][half][k] = s; }
    for (int e = tid; e < 8 * 256; e += 256) taken[e >> 8][e & 255] = 0;
    __syncthreads();
    if (tid < 16) { const int h = tid >> 1, half = tid & 1;
        for (int it = 0; it < 16; ++it) { float best = -INFINITY; int bi = 0;
            for (int k = 0; k < 128; ++k) { const float v = sc[h][half][k]; if (v > best) { best = v; bi = k; } }
            tv[h][half][it] = best; ti[h][half][it] = bi; sc[h][half][bi] = -INFINITY; } }
    __syncthreads();
    if (tid < 8) { const int h = tid; float mx = 0.f, sum = 0.f;
        for (int it = 0; it < 16; ++it) { float best = -INFINITY; int bf = 0;
            for (int f = 0; f < 256; ++f) { if (taken[h][f]) continue; const float v = tv[h][0][f >> 4] + tv[h][1][f & 15]; if (v > best) { best = v; bf = f; } }
            taken[h][bf] = 1; if (it == 0) mx = best;
            const float ev = expf(best - mx); sum += ev; wk[h * 16 + it] = ev;
            eid[h * 16 + it] = ti[h][0][bf >> 4] * 128 + ti[h][1][bf & 15]; }
        const float inv = 1.f / sum;
        for (int it = 0; it < 16; ++it) wk[h * 16 + it] *= inv; }
    __syncthreads();
    { const int w = tid >> 6, lane = tid & 63;
      for (int e = w * 32; e < w * 32 + 32; ++e) { const float* u = U + (size_t)eid[e] * D; float s = 0.f;
#pragma unroll
          for (int i = 0; i < 16; ++i) s += xs[lane + 64 * i] * u[lane + 64 * i];
#pragma unroll
          for (int o = 1; o < 64; o <<= 1) s += __shfl_xor(s, o);
          if (lane == 0) { const float ge = 0.5f * s * (1.f + erff(s * 0.70710678118654752f)); wk[e] = wk[e] * ge; } } }
    __syncthreads();
    float y[4] = {0.f, 0.f, 0.f, 0.f};
    for (int e = 0; e < 128; ++e) { const float4 vv = *(const float4*)(V + (size_t)eid[e] * D + tid * 4); const float w = wk[e]; y[0] += w * vv.x; y[1] += w * vv.y; y[2] += w * vv.z; y[3] += w * vv.w; }
    float z[4]; float s = 0.f;
#pragma unroll
    for (int i = 0; i < 4; ++i) { z[i] = ALPHA * xs[tid * 4 + i] + y[i]; s += z[i]; }
    const float mean = block_sum_256(s, red) * (1.f / D);
    float q = 0.f;
#pragma unroll
    for (int i = 0; i < 4; ++i) { z[i] -= mean; q += z[i] * z[i]; }
    const float rstd = rsqrtf(block_sum_256(q, red) * (1.f / D) + LN_EPS);
#pragma unroll
    for (int i = 0; i < 4; ++i) { const int c = tid * 4 + i; out[(size_t)t * D + c] = z[i] * rstd * g2[c] + b2[c]; }
}

__global__ void gla_gate(const float* __restrict__ G, const float* __restrict__ Wg, const float* __restrict__ bg, float* __restrict__ LA) {
    const int t = blockIdx.x, c = threadIdx.x;
    float x = 0.f;
    for (int r = 0; r < 16; ++r) x += G[(size_t)t * GLA_N + GGD + r] * Wg[r * 512 + c];
    x += bg[c];
    const float ls = fminf(x, 0.f) - log1pf(expf(-fabsf(x)));
    LA[(size_t)t * 512 + c] = ls * (1.f / 16.f);
}

__global__ __launch_bounds__(256) void gla_rec(const float* __restrict__ G, const float* __restrict__ LA, const float* __restrict__ S0, int T, int tokbase, float* __restrict__ OG, float* __restrict__ Sout) {
    __shared__ float part[2][4][64];
    const int vg = blockIdx.x, h = blockIdx.y, b = blockIdx.z, lane = threadIdx.x & 63, dq = __builtin_amdgcn_readfirstlane(threadIdx.x >> 6);
    const int v = vg * 64 + lane, d0 = dq * 32;
    float S[32];
#pragma unroll
    for (int i = 0; i < 32; ++i) S[i] = S0 ? S0[(((size_t)b * 4 + h) * 128 + d0 + i) * 256 + v] : 0.f;
    for (int t = 0; t < T; ++t) {
        const size_t tok = (size_t)tokbase + (size_t)b * T + t;
        const float* g = G + tok * GLA_N;
        const float* la = LA + tok * 512 + h * 128 + d0;
        const float* qp = g + GQ + h * 128 + d0;
        const float* kp = g + GK + h * 128 + d0;
        const float vv = g[GV + h * 256 + v];
        float o = 0.f;
#pragma unroll
        for (int i = 0; i < 32; ++i) { const float a = expf(la[i]); S[i] = a * S[i] + kp[i] * vv; o += (qp[i] * 0.08838834764831845f) * S[i]; }
        part[t & 1][dq][lane] = o;
        __syncthreads();
        if (dq == 0) OG[tok * 1024 + h * 256 + v] = (part[t & 1][0][lane] + part[t & 1][1][lane]) + (part[t & 1][2][lane] + part[t & 1][3][lane]);
    }
#pragma unroll
    for (int i = 0; i < 32; ++i) Sout[(((size_t)b * 4 + h) * 128 + d0 + i) * 256 + v] = S[i];
}

__global__ __launch_bounds__(256) void gla_post(const float* __restrict__ OG, const float* __restrict__ G, const float* __restrict__ ng, float* __restrict__ OGN) {
    __shared__ float red[4];
    const int t = blockIdx.x, tid = threadIdx.x;
    for (int h = 0; h < 4; ++h) {
        const float o = OG[(size_t)t * 1024 + h * 256 + tid];
        const float ms = block_sum_256(o * o, red) * (1.f / 256.f);
        const float r = G[(size_t)t * GLA_N + GR + h * 256 + tid];
        const float sl = r / (1.f + expf(-r));
        OGN[(size_t)t * 1024 + h * 256 + tid] = o * rsqrtf(ms + LN_EPS) * ng[tid] * sl;
    }
}

}


namespace pg8 {
#define PG8_LAS __attribute__((address_space(3)))
typedef unsigned short bf16_t;
typedef short bf16x8 __attribute__((ext_vector_type(8)));
typedef float f32x4 __attribute__((ext_vector_type(4)));
typedef unsigned u32x4 __attribute__((ext_vector_type(4)));
constexpr int BM = 256, BK = 64, HALF = 128, HTB = HALF * BK * 2  , STAGE_BYTES = 8 * HTB, NXCD = 8, WGM = 8;

__host__ __device__ __forceinline__ int lds_byte(int r, int c) { const int st = (r >> 4) * 2 + (c >> 5), rr = r & 15, cc = c & 31, ob = rr * 64 + cc * 2; return st * 1024 + (ob ^ (((ob >> 9) & 1) << 5)); }
__host__ __device__ __forceinline__ void stage_rc(int b, int& R, int& C) { const int st = b / 1024, sb = b % 1024, swz = sb ^ (((sb >> 9) & 1) << 5); R = (st >> 1) * 16 + swz / 64; C = (st & 1) * 32 + (swz % 64) / 2; }
__host__ __device__ __forceinline__ int perm32(int rho) { const int n = rho >> 4, i = rho & 15; return 8 * (i >> 2) + 4 * n + (i & 3); }

struct Unit { int pm, pn; };
struct Gemm { const bf16_t* A; const bf16_t* Bt; int M, N, K; };

struct StaticOrder {
    int nM, nN, nwg, G, c;
    __host__ __device__ void init(int M, int N, int G_, int c_) { nM = M / BM; nN = N / BM; nwg = nM * nN; G = G_; c = c_; }
    __host__ __device__ bool next(int i, Unit& u) const {
        const long L = (long)i * G + c; if (L >= nwg) return false;
        int wgid = (int)L; { const int q = nwg / NXCD, r = nwg % NXCD, xcd = wgid % NXCD, off = wgid / NXCD; wgid = (xcd < r ? xcd * (q + 1) : r * (q + 1) + (xcd - r) * q) + off; }
        const int nig = WGM * nN, gid = wgid / nig, fm = gid * WGM, gsz = (nM - fm) < WGM ? (nM - fm) : WGM;
        u.pm = fm + ((wgid % nig) % gsz); u.pn = (wgid % nig) / gsz; return true;
    }
    __device__ __forceinline__ void a_ready(const Unit&) const {}
    __device__ __forceinline__ void done(const Unit&) const {}
};

__device__ __forceinline__ unsigned cvt_pk_bf16(float lo, float hi) { unsigned r; asm volatile("v_cvt_pk_bf16_f32 %0, %1, %2" : "=v"(r) : "v"(lo), "v"(hi)); return r; }
template <class F> struct EpiRow8 {
    static constexpr bool PERM = true, AFTER_DRAIN = false;
    F f;
    __device__ __forceinline__ void operator()(const f32x4 (&acc)[2][2][4][2], const Unit& u, int wr, int wc, int fr, int fq) const {
        const int row0 = u.pm * BM + wr * 64 + fr, col0 = u.pn * BM + wc * 32 + 8 * fq;
#pragma unroll
        for (int ai = 0; ai < 2; ++ai)
#pragma unroll
            for (int m = 0; m < 4; ++m)
#pragma unroll
                for (int bj = 0; bj < 2; ++bj) f.put8(row0 + ai * HALF + m * 16, col0 + bj * HALF, acc[ai][bj][m][0], acc[ai][bj][m][1]);
    }
};


template <class Epi, class Sched, bool ALIGN_EPI = false, bool SP2 = false>
__device__ __forceinline__ void gemm_phase(PG8_LAS unsigned char* lds, const Gemm g, const Sched& S, const Epi& E) {
    const int tid = threadIdx.x, wid = __builtin_amdgcn_readfirstlane(tid >> 6), lane = tid & 63, wr = wid >> 2, wc = wid & 3, fr = lane & 15, fq = lane >> 4;
    const int K = g.K, nt = K / BK;
    unsigned voffA[2], voffB[2];
#pragma unroll
    for (int i = 0; i < 2; ++i) { int R, C; stage_rc(tid * 16 + i * 8192, R, C); const int Rb = Epi::PERM ? ((R & ~31) + perm32(R & 31)) : R;
        voffA[i] = (unsigned)(R * K + C) * 2u; voffB[i] = (unsigned)(Rb * K + C) * 2u; }
    const size_t kstep = (size_t)(BK * 2);
    const size_t hstep = (size_t)HALF * K * 2;
    const size_t tstep = 2 * hstep;
    const unsigned ldsw = (unsigned)wid * 1024u;
    const int aoff = lds_byte(wr * 64 + fr, fq * 8), boff = lds_byte(wc * 32 + fr, fq * 8);
#define PG8_SA(b, h) (((b) * 2 + (h)) * HTB)
#define PG8_SB(b, h) ((4 + (b) * 2 + (h)) * HTB)
#define PG8_STAGE(bufoff, gbase, voff) do { _Pragma("unroll") for (int _i = 0; _i < 2; ++_i) \
        __builtin_amdgcn_global_load_lds((const unsigned*)((const char*)(gbase) + (voff)[_i]), (PG8_LAS unsigned*)(lds + (bufoff) + ldsw + _i * 8192), 16, 0, 0); } while (0)
#define PG8_LDA(dst, b, h) do { _Pragma("unroll") for (int m = 0; m < 4; ++m) _Pragma("unroll") for (int k = 0; k < 2; ++k) dst[m][k] = *(const PG8_LAS bf16x8*)(lds + PG8_SA(b, h) + aoff + m * 2048 + k * 1024); } while (0)
#define PG8_LDB(dst, b, h) do { _Pragma("unroll") for (int n = 0; n < 2; ++n) _Pragma("unroll") for (int k = 0; k < 2; ++k) dst[n][k] = *(const PG8_LAS bf16x8*)(lds + PG8_SB(b, h) + boff + n * 2048 + k * 1024); } while (0)
#define PG8_MMA(ai, bj, At, Bt) do { __builtin_amdgcn_s_setprio(1); _Pragma("unroll") for (int m = 0; m < 4; ++m) _Pragma("unroll") for (int n = 0; n < 2; ++n) _Pragma("unroll") for (int k = 0; k < 2; ++k) \
        acc[ai][bj][m][n] = __builtin_amdgcn_mfma_f32_16x16x32_bf16(Bt[n][k], At[m][k], acc[ai][bj][m][n], 0, 0, 0); __builtin_amdgcn_s_setprio(0); } while (0)
#define PG8_WAIT_V(n) asm volatile("s_waitcnt vmcnt(" #n ")" ::: "memory")
#define PG8_WAIT_L(n) asm volatile("s_waitcnt lgkmcnt(" #n ")" ::: "memory")
#define PG8_BAR __builtin_amdgcn_s_barrier()
#define PG8_SCHED __builtin_amdgcn_sched_barrier(0)
    Unit cur, nxt; int ui = 0;
    if (!S.next(0, cur)) return;
    f32x4 acc[2][2][4][2];
#pragma unroll
    for (int a = 0; a < 2; ++a)
#pragma unroll
        for (int b = 0; b < 2; ++b)
#pragma unroll
            for (int m = 0; m < 4; ++m)
#pragma unroll
                for (int n = 0; n < 2; ++n) acc[a][b][m][n] = (f32x4){0.f, 0.f, 0.f, 0.f};
    bf16x8 At[4][2], B0[2][2], B1[2][2];
    const char* cA = (const char*)g.A + (size_t)cur.pm * tstep; const char* cB = (const char*)g.Bt + (size_t)cur.pn * tstep;
    S.a_ready(cur);
    if constexpr (SP2) {
        PG8_STAGE(PG8_SB(0, 0), cB, voffB); PG8_STAGE(PG8_SB(0, 1), cB + hstep, voffB); PG8_STAGE(PG8_SA(0, 0), cA, voffA); PG8_STAGE(PG8_SA(0, 1), cA + hstep, voffA);
        if (wr == 1) PG8_BAR;
        PG8_WAIT_V(2); PG8_BAR;
        PG8_STAGE(PG8_SB(1, 0), cB + kstep, voffB); PG8_STAGE(PG8_SA(1, 0), cA + kstep, voffA); PG8_STAGE(PG8_SB(1, 1), cB + hstep + kstep, voffB);
        PG8_WAIT_V(6); PG8_BAR;
    } else {
        PG8_STAGE(PG8_SB(0, 0), cB, voffB); PG8_STAGE(PG8_SA(0, 0), cA, voffA); PG8_STAGE(PG8_SB(0, 1), cB + hstep, voffB); PG8_STAGE(PG8_SA(0, 1), cA + hstep, voffA);
        if (wr == 1) PG8_BAR;
        PG8_WAIT_V(4); PG8_BAR;
        PG8_STAGE(PG8_SB(1, 0), cB + kstep, voffB); PG8_STAGE(PG8_SA(1, 0), cA + kstep, voffA); PG8_STAGE(PG8_SB(1, 1), cB + hstep + kstep, voffB);
        PG8_WAIT_V(6); PG8_BAR;
    }
    for (;;) {
        const bool has_next = S.next(ui + 1, nxt);
        const char* nA = has_next ? (const char*)g.A + (size_t)nxt.pm * tstep : cA; const char* nB = has_next ? (const char*)g.Bt + (size_t)nxt.pn * tstep : cB;
        for (int t = 0; t < nt; t += 2) {
            const bool last = (t == nt - 2);
            const char* a1 = cA + (size_t)(t + 1) * kstep;
            const char* a2 = last ? nA : cA + (size_t)(t + 2) * kstep; const char* b2 = last ? nB : cB + (size_t)(t + 2) * kstep;
            const char* a3 = a2 + kstep; const char* b3 = b2 + kstep;
            if (last && has_next) S.a_ready(nxt);
            if constexpr (SP2) {
            PG8_LDB(B0, 0, 0); PG8_LDB(B1, 0, 1); PG8_SCHED; PG8_LDA(At, 0, 0); PG8_STAGE(PG8_SA(1, 1), a1 + hstep, voffA);
            PG8_WAIT_V(8); PG8_WAIT_L(0); PG8_BAR; PG8_MMA(0, 0, At, B0); PG8_MMA(0, 1, At, B1); PG8_BAR; PG8_SCHED;
            PG8_LDA(At, 0, 1); PG8_STAGE(PG8_SB(0, 0), b2, voffB); PG8_STAGE(PG8_SB(0, 1), b2 + hstep, voffB); PG8_STAGE(PG8_SA(0, 0), a2, voffA);
            PG8_WAIT_V(8); PG8_WAIT_L(0); PG8_BAR; PG8_MMA(1, 0, At, B0); PG8_MMA(1, 1, At, B1); PG8_BAR; PG8_SCHED;
            PG8_LDB(B0, 1, 0); PG8_LDB(B1, 1, 1); PG8_SCHED; PG8_LDA(At, 1, 0); PG8_STAGE(PG8_SA(0, 1), a2 + hstep, voffA);
            PG8_WAIT_V(8); PG8_WAIT_L(0); PG8_BAR; PG8_MMA(0, 0, At, B0); PG8_MMA(0, 1, At, B1); PG8_BAR; PG8_SCHED;
            PG8_LDA(At, 1, 1); PG8_STAGE(PG8_SB(1, 0), b3, voffB); PG8_STAGE(PG8_SB(1, 1), b3 + hstep, voffB); PG8_STAGE(PG8_SA(1, 0), a3, voffA);
            PG8_WAIT_V(8); PG8_WAIT_L(0); PG8_BAR; PG8_MMA(1, 0, At, B0); PG8_MMA(1, 1, At, B1); PG8_BAR; PG8_SCHED;
            } else {
            PG8_LDB(B0, 0, 0); PG8_SCHED; PG8_LDA(At, 0, 0); PG8_STAGE(PG8_SA(1, 1), a1 + hstep, voffA);
            PG8_WAIT_L(8); PG8_BAR; PG8_WAIT_L(0); PG8_MMA(0, 0, At, B0); PG8_BAR; PG8_SCHED;
            PG8_LDB(B1, 0, 1); PG8_STAGE(PG8_SB(0, 0), b2, voffB);
            PG8_BAR; PG8_WAIT_L(0); PG8_MMA(0, 1, At, B1); PG8_BAR;
            PG8_LDA(At, 0, 1); PG8_STAGE(PG8_SA(0, 0), a2, voffA);
            PG8_BAR; PG8_WAIT_L(0); PG8_MMA(1, 0, At, B0); PG8_BAR; PG8_SCHED;
            PG8_STAGE(PG8_SB(0, 1), b2 + hstep, voffB);
            PG8_WAIT_V(6); PG8_BAR; PG8_MMA(1, 1, At, B1); PG8_BAR;
            PG8_LDB(B0, 1, 0); PG8_SCHED; PG8_LDA(At, 1, 0); PG8_STAGE(PG8_SA(0, 1), a2 + hstep, voffA);
            PG8_WAIT_L(8); PG8_BAR; PG8_WAIT_L(0); PG8_MMA(0, 0, At, B0); PG8_BAR; PG8_SCHED;
            PG8_LDB(B1, 1, 1); PG8_STAGE(PG8_SB(1, 0), b3, voffB);
            PG8_BAR; PG8_WAIT_L(0); PG8_MMA(0, 1, At, B1); PG8_BAR;
            PG8_LDA(At, 1, 1); PG8_STAGE(PG8_SA(1, 0), a3, voffA);
            PG8_BAR; PG8_WAIT_L(0); PG8_MMA(1, 0, At, B0); PG8_BAR; PG8_SCHED;
            PG8_STAGE(PG8_SB(1, 1), b3 + hstep, voffB);
            PG8_WAIT_V(6); PG8_BAR; PG8_MMA(1, 1, At, B1); PG8_BAR;
            }
        }
        if constexpr (ALIGN_EPI) { if (wr == 0) PG8_BAR; }
        if constexpr (!Epi::AFTER_DRAIN) { E(acc, cur, wr, wc, fr, fq); S.done(cur); }
        if (!has_next) break;
#pragma unroll
        for (int a = 0; a < 2; ++a)
#pragma unroll
            for (int b = 0; b < 2; ++b)
#pragma unroll
                for (int m = 0; m < 4; ++m)
#pragma unroll
                    for (int n = 0; n < 2; ++n) acc[a][b][m][n] = (f32x4){0.f, 0.f, 0.f, 0.f};
        cur = nxt; cA = nA; cB = nB; ++ui;
        if constexpr (ALIGN_EPI) { if (wr == 1) PG8_BAR; }
    }
    PG8_WAIT_V(0);
    if constexpr (!ALIGN_EPI) { if (wr == 0) PG8_BAR; }
    PG8_BAR;
    if constexpr (Epi::AFTER_DRAIN) { E.fused(acc, cur, wr, wc, fr, fq, lds, wid, lane); S.done(cur); }
#undef PG8_SA
#undef PG8_SB
#undef PG8_STAGE
#undef PG8_LDA
#undef PG8_LDB
#undef PG8_MMA
#undef PG8_WAIT_V
#undef PG8_WAIT_L
#undef PG8_BAR
#undef PG8_SCHED
}
}

namespace mk {
#define GAS __attribute__((address_space(1)))
#define LAS __attribute__((address_space(3)))
typedef unsigned short bf16;
typedef unsigned v4u __attribute__((ext_vector_type(4)));
typedef float f32x4 __attribute__((ext_vector_type(4)));
typedef short bf16x8 __attribute__((ext_vector_type(8)));
typedef GAS unsigned gu32;
typedef GAS unsigned long long gu64;
#define RLX_AGENT __ATOMIC_RELAXED, __HIP_MEMORY_SCOPE_AGENT
#define LDS_WAIT() asm volatile("s_waitcnt lgkmcnt(0)" ::: "memory")
#define VM_WAIT() asm volatile("s_waitcnt vmcnt(0)" ::: "memory")
__device__ __forceinline__ unsigned long long rt() { return __builtin_amdgcn_s_memrealtime(); }
__device__ __forceinline__ unsigned f2bf(float f) { unsigned u = __builtin_bit_cast(unsigned, f); return (u + 0x7fffu + ((u >> 16) & 1u)) >> 16; }
__device__ __forceinline__ unsigned pk2(float lo, float hi) {
    typedef __bf16 bf2_t __attribute__((ext_vector_type(2))); typedef float f2_t __attribute__((ext_vector_type(2)));
    const f2_t v = {lo, hi}; const bf2_t b = __builtin_convertvector(v, bf2_t); return __builtin_bit_cast(unsigned, b); }

#define XB_TMO      128
#define XB_XCNT(j)  (256  + 64 * (j))
#define XB_XSUB(j)  (1280 + 64 * (j))
#define XB_XGEN(j)  (2304 + 64 * (j))
#define XB_TOP      3328
#define XB_TOPGEN   3392
#define XCD_BAR_WORDS 3456
#define XB_SPIN_CAP (1u << 18)

__device__ __forceinline__ unsigned xb_ld(unsigned* p)              { return __hip_atomic_load(p, __ATOMIC_RELAXED, __HIP_MEMORY_SCOPE_AGENT); }
__device__ __forceinline__ unsigned xb_add(unsigned* p, unsigned v) { return __hip_atomic_fetch_add(p, v, __ATOMIC_RELAXED, __HIP_MEMORY_SCOPE_AGENT); }
__device__ __forceinline__ unsigned xb_xcc_id() { return (unsigned)__builtin_amdgcn_s_getreg((3 << 11) | 20) & 0xFu; }
#define XB_SPIN(cond, bar) do { unsigned _sp = 0; while (cond) { __builtin_amdgcn_s_sleep(1); \
    if ((++_sp & 255u) == 0u) { if (xb_ld(&(bar)[XB_TMO])) break; if (_sp > XB_SPIN_CAP) { atomicAdd(&(bar)[XB_TMO], 1u); break; } } } } while (0)

struct XcdBarrier {
    unsigned* bar; unsigned x;
    volatile LAS unsigned* st;
};

__device__ __forceinline__ XcdBarrier xcd_barrier_post(unsigned* bar, volatile LAS unsigned* st) {
    XcdBarrier b; b.bar = bar; b.x = xb_xcc_id(); b.st = st;
    if (threadIdx.x == 0) (void)xb_add(&bar[XB_XCNT(b.x)], 1u);
    return b;
}
__device__ __forceinline__ void xcd_barrier_complete(unsigned* bar, unsigned x, unsigned& nloc, unsigned& nx) {
    const unsigned G = gridDim.x * gridDim.y * gridDim.z;
    unsigned sum, cnt, mine, sp = 0u;
    for (;;) {
        sum = 0u; cnt = 0u; mine = 0u;
#pragma unroll
        for (unsigned j = 0; j < 16; ++j) { const unsigned c = xb_ld(&bar[XB_XCNT(j)]); sum += c; cnt += (c > 0u) ? 1u : 0u; mine = (j == x) ? c : mine; }
        if (sum == G) break;
        __builtin_amdgcn_s_sleep(1);
        if ((++sp & 255u) == 0u) { if (xb_ld(&bar[XB_TMO])) break; if (sp > XB_SPIN_CAP) { atomicAdd(&bar[XB_TMO], 1u); break; } }
    }
    nloc = mine > 0u ? mine : 1u; nx = cnt > 0u ? cnt : 1u;
}

__device__ __forceinline__ void xcd_barrier(const XcdBarrier& b) {
    asm volatile("s_waitcnt vmcnt(0)" ::: "memory");
    __syncthreads();
    if (threadIdx.x == 0) {
        unsigned* bar = b.bar;
        __builtin_amdgcn_s_waitcnt(0);
        unsigned nloc = b.st[0], nx = b.st[1];
        if (nloc == 0u) { xcd_barrier_complete(bar, b.x, nloc, nx); b.st[0] = nloc; b.st[1] = nx; }
        const unsigned old = xb_add(&bar[XB_XSUB(b.x)], 1u);
        const unsigned gen = old / nloc;
        if (old + 1u == (gen + 1u) * nloc) {
            __builtin_amdgcn_fence(__ATOMIC_RELEASE, "agent");
            asm volatile("s_waitcnt vmcnt(0)" ::: "memory");
            const unsigned og = xb_add(&bar[XB_TOP], 1u);
            const unsigned tg = og / nx;
            if (og + 1u == (tg + 1u) * nx) xb_add(&bar[XB_TOPGEN], 1u);
            else XB_SPIN(xb_ld(&bar[XB_TOPGEN]) == tg, bar);
            __builtin_amdgcn_fence(__ATOMIC_ACQUIRE, "agent");
            xb_add(&bar[XB_XGEN(b.x)], 1u);
            asm volatile("s_waitcnt vmcnt(0)" ::: "memory");
        } else {
            XB_SPIN(xb_ld(&bar[XB_XGEN(b.x)]) == gen, bar);
            __builtin_amdgcn_fence(__ATOMIC_ACQUIRE, "agent");
            asm volatile("s_waitcnt vmcnt(0)" ::: "memory");
        }
    }
    __syncthreads();
}

}

namespace mk {
constexpr int NWAVES = 8, NTHREADS = 512;
constexpr size_t MiB = 1u << 20;
constexpr size_t WS_QIB = 325 * MiB, WS_KB = 342 * MiB, WS_VB = 351 * MiB, WS_KIB = 360 * MiB, WS_WIF = 363 * MiB;
constexpr size_t WS_OB = 390 * MiB, WS_GD = 423 * MiB;
constexpr size_t WS_IDX = 525 * MiB, WS_CNT = 542 * MiB, WS_SCS = 543 * MiB;
constexpr size_t WS_S = 548 * MiB;
constexpr size_t WS_SC = WS_S;
constexpr size_t WS_Z = WS_S, WS_H1F = WS_S + 65 * MiB, WS_H1B = WS_S + 130 * MiB, WS_PQB = WS_S + 163 * MiB, WS_H2F = WS_S + 228 * MiB, WS_H2B = WS_S + 293 * MiB;
constexpr size_t WS_GQ = WS_S + 326 * MiB, WS_GK = WS_S + 343 * MiB, WS_GV = WS_S + 360 * MiB, WS_GR = WS_S + 393 * MiB, WS_QT = WS_S + 426 * MiB, WS_DEC = WS_S + 442 * MiB,
                 WS_OGB = WS_S + 443 * MiB, WS_KT = WS_S + 476 * MiB;
constexpr size_t WS_DS = WS_S, WS_SPREV = WS_S + 128 * MiB;
constexpr size_t WS_CTL = 1060 * MiB, WS_WA = 1061 * MiB, WS_WO = 1066 * MiB, WS_WG = 1068 * MiB, WS_WGO = 1075 * MiB, WS_WPQ = 1077 * MiB, WS_PK = 1085 * MiB,
                 WS_UB = 1086 * MiB, WS_VBX = 1150 * MiB, WS_USC = 1118 * MiB, WS_TEID = 1120 * MiB, WS_TGATE = 1125 * MiB, WS_HD = 1134 * MiB, WS_KV8 = 1134 * MiB, WS_XB = 1214 * MiB, WS_QB = 1247 * MiB, WS_END = 1280 * MiB;
constexpr size_t CTL_ZERO_BYTES = 1 * MiB;
constexpr int CW_TMO = 0, CW_AMAXK = 256, CW_AMAXV = 320, CW_Q1 = 512, CW_XC = 1024, CW_BAR = 4096;
constexpr int WA_ROWS = 2176, WG_ROWS = 3104;
constexpr int GN_Q = 0, GN_K = 512, GN_V = 1024, GN_R = 2048, GN_GD = 3072;

constexpr int RING_BYTES = 131072, LDSCTL_OFF = RING_BYTES, MISC_OFF = LDSCTL_OFF + 320, INPTAB_OFF = LDSCTL_OFF + 512, LDS_BYTES = 147456;

typedef unsigned u32x4 __attribute__((ext_vector_type(4)));
typedef unsigned u32x2 __attribute__((ext_vector_type(2)));
#define MK_LAS __attribute__((address_space(3)))
__device__ __forceinline__ float bflo(unsigned w) { return __builtin_bit_cast(float, w << 16); }
__device__ __forceinline__ float bfhi(unsigned w) { return __builtin_bit_cast(float, w & 0xffff0000u); }
__device__ __forceinline__ float bf2f(unsigned short b) { return __builtin_bit_cast(float, (unsigned)b << 16); }
__device__ __forceinline__ u32x4 pack8(f32x4 a, f32x4 b) { u32x4 w; w.x = pk2(a[0], a[1]); w.y = pk2(a[2], a[3]); w.z = pk2(b[0], b[1]); w.w = pk2(b[2], b[3]); return w; }

#if defined(PROBE_REGION)
__device__ unsigned long long g_probe_acc;
#define TPB(k) unsigned long long tpb_##k = (PROBE_REGION == k) ? __builtin_amdgcn_s_memtime() : 0ull
#define TPE(k) do { if (PROBE_REGION == k) { tacc += __builtin_amdgcn_s_memtime() - tpb_##k; } } while (0)
#else
#define TPB(k)
#define TPE(k)
#endif
template <int NCT> __device__ __forceinline__ void skinny_tile(const bf16* __restrict__ A, int lda, const bf16* __restrict__ Bt, int K, int row0, int col0, f32x4 (&acc)[NCT], int lane) {
    const int fr = lane & 15, fq = lane >> 4;
    const bf16* ap = A + (size_t)(row0 + fr) * lda + fq * 8;
    const bf16* bp = Bt + (size_t)(col0 + fr) * K + fq * 8;
#pragma unroll
    for (int ct = 0; ct < NCT; ++ct) acc[ct] = (f32x4){0.f, 0.f, 0.f, 0.f};
#pragma unroll 1
    for (int k0 = 0; k0 < K; k0 += 128) {
        bf16x8 a[4], b[NCT][4];
#pragma unroll
        for (int j = 0; j < 4; ++j) a[j] = *(const bf16x8*)(ap + k0 + j * 32);
#pragma unroll
        for (int ct = 0; ct < NCT; ++ct)
#pragma unroll
            for (int j = 0; j < 4; ++j) b[ct][j] = *(const bf16x8*)(bp + (size_t)ct * 16 * K + k0 + j * 32);
        asm volatile("" ::: "memory");
#pragma unroll
        for (int ct = 0; ct < NCT; ++ct)
#pragma unroll
            for (int j = 0; j < 4; ++j) acc[ct] = __builtin_amdgcn_mfma_f32_16x16x32_bf16(b[ct][j], a[j], acc[ct], 0, 0, 0);
    }
}

__device__ __forceinline__ void p0_transpose_item(const float* __restrict__ W, int ldw, int K, bf16* __restrict__ WT, int dst_row0, int src_col0, int nvalid, int k0, MK_LAS float* scr, int lane) {
#pragma unroll 8
    for (int i = 0; i < 32; ++i) { const int kk = 2 * i + (lane >> 5), j = lane & 31; scr[kk * 33 + j] = j < nvalid ? W[(size_t)(k0 + kk) * ldw + src_col0 + j] : 0.f; }
    asm volatile("s_waitcnt lgkmcnt(0)" ::: "memory");
    const int c = lane & 7;
#pragma unroll
    for (int j = 0; j < 4; ++j) { const int n = (lane >> 3) + 8 * j; const MK_LAS float* s = scr + (8 * c) * 33 + n;
        u32x4 o; o.x = pk2(s[0 * 33], s[1 * 33]); o.y = pk2(s[2 * 33], s[3 * 33]); o.z = pk2(s[4 * 33], s[5 * 33]); o.w = pk2(s[6 * 33], s[7 * 33]);
        *(u32x4*)(WT + (size_t)(dst_row0 + n) * K + k0 + 8 * c) = o; }
    asm volatile("s_waitcnt lgkmcnt(0)" ::: "memory");
}
__device__ __forceinline__ void p0_convert(const float* __restrict__ src, bf16* __restrict__ dst, size_t n8, int gw, int ngw, int lane) {
    for (size_t i = (size_t)gw * 64 + lane; i < n8; i += (size_t)ngw * 64) {
        const f32x4 a = *(const f32x4*)(src + i * 8), b = *(const f32x4*)(src + i * 8 + 4);
        *(u32x4*)(dst + i * 8) = pack8(a, b);
    }
}

__device__ __forceinline__ void p0_quant_row(const float* __restrict__ src, unsigned char* __restrict__ dst, float* __restrict__ scale, int lane) {
    f32x4 v[4]; float am = 0.f;
#pragma unroll
    for (int q = 0; q < 4; ++q) { v[q] = *(const f32x4*)(src + lane * 16 + q * 4); am = fmaxf(am, fmaxf(fmaxf(fabsf(v[q][0]), fabsf(v[q][1])), fmaxf(fabsf(v[q][2]), fabsf(v[q][3])))); }
#pragma unroll
    for (int o = 1; o < 64; o <<= 1) am = fmaxf(am, __shfl_xor(am, o));
    const float inv = am > 0.f ? 448.f / am : 0.f;
    u32x4 w;
#pragma unroll
    for (int q = 0; q < 4; ++q) { int x = __builtin_amdgcn_cvt_pk_fp8_f32(v[q][0] * inv, v[q][1] * inv, 0, false); x = __builtin_amdgcn_cvt_pk_fp8_f32(v[q][2] * inv, v[q][3] * inv, x, true); w[q] = (unsigned)x; }
    *(u32x4*)(dst + lane * 16) = w;
    if (lane == 0) *scale = am * (1.f / 448.f);
}

__device__ __forceinline__ void p0_quant_rows4(const float* __restrict__ src, unsigned char* __restrict__ dst, float* __restrict__ scale, int lane) {
    f32x4 v[4][4]; float am[4];
#pragma unroll
    for (int r = 0; r < 4; ++r)
#pragma unroll
        for (int q = 0; q < 4; ++q) v[r][q] = *(const f32x4*)(src + (size_t)r * D + lane * 16 + q * 4);
#pragma unroll
    for (int r = 0; r < 4; ++r) { float a = 0.f;
#pragma unroll
        for (int q = 0; q < 4; ++q) a = fmaxf(a, fmaxf(fmaxf(fabsf(v[r][q][0]), fabsf(v[r][q][1])), fmaxf(fabsf(v[r][q][2]), fabsf(v[r][q][3]))));
        am[r] = a; }
#pragma unroll
    for (int o = 1; o < 64; o <<= 1) {
#pragma unroll
        for (int r = 0; r < 4; ++r) am[r] = fmaxf(am[r], __shfl_xor(am[r], o)); }
#pragma unroll
    for (int r = 0; r < 4; ++r) {
        const float inv = am[r] > 0.f ? 448.f / am[r] : 0.f;
        u32x4 w;
#pragma unroll
        for (int q = 0; q < 4; ++q) { int x = __builtin_amdgcn_cvt_pk_fp8_f32(v[r][q][0] * inv, v[r][q][1] * inv, 0, false); x = __builtin_amdgcn_cvt_pk_fp8_f32(v[r][q][2] * inv, v[r][q][3] * inv, x, true); w[q] = (unsigned)x; }
        *(u32x4*)(dst + (size_t)r * D + lane * 16) = w;
        if (lane == 0) scale[r] = am[r] * (1.f / 448.f);
    }
}

struct FAttnIn {
    bf16 *Qb, *Kb, *Vb, *QIb, *KIb; float* WIf; float* out;
    mutable float kmax = 0.f, vmax = 0.f;
    __device__ __forceinline__ static float amax8(f32x4 a, f32x4 b) { return fmaxf(fmaxf(fmaxf(fabsf(a[0]), fabsf(a[1])), fmaxf(fabsf(a[2]), fabsf(a[3]))), fmaxf(fmaxf(fabsf(b[0]), fabsf(b[1])), fmaxf(fabsf(b[2]), fabsf(b[3])))); }
    __device__ __forceinline__ float* okp(int row, size_t offp, size_t offs, int ld) const { return row < TP ? out + offp + (size_t)row * ld : out + offs + (size_t)(row - TP) * ld; }
    __device__ __forceinline__ void put8(int row, int col, f32x4 v0, f32x4 v1) const {
        const u32x4 w = pack8(v0, v1);
        if (col < AK) *(u32x4*)(Qb + (size_t)row * 1024 + col) = w;
        else if (col < AV) { *(u32x4*)(Kb + (size_t)row * 256 + (col - AK)) = w; float* o = okp(row, OUT_KP, OUT_KS, 256) + (col - AK); *(f32x4*)o = v0; *(f32x4*)(o + 4) = v1; kmax = fmaxf(kmax, amax8(v0, v1)); }
        else if (col < AQI) { *(u32x4*)(Vb + (size_t)row * 256 + (col - AV)) = w; float* o = okp(row, OUT_VP, OUT_VS, 256) + (col - AV); *(f32x4*)o = v0; *(f32x4*)(o + 4) = v1; vmax = fmaxf(vmax, amax8(v0, v1)); }
        else *(u32x4*)(QIb + (size_t)row * 512 + (col - AQI)) = w;
    }
    __device__ __forceinline__ void put4(int row, int col, f32x4 v) const {
        u32x2 w; w.x = pk2(v[0], v[1]); w.y = pk2(v[2], v[3]);
        if (col < AK) *(u32x2*)(Qb + (size_t)row * 1024 + col) = w;
        else if (col < AV) { *(u32x2*)(Kb + (size_t)row * 256 + (col - AK)) = w; *(f32x4*)(okp(row, OUT_KP, OUT_KS, 256) + (col - AK)) = v; }
        else if (col < AQI) { *(u32x2*)(Vb + (size_t)row * 256 + (col - AV)) = w; *(f32x4*)(okp(row, OUT_VP, OUT_VS, 256) + (col - AV)) = v; }
        else if (col < AKI) *(u32x2*)(QIb + (size_t)row * 512 + (col - AQI)) = w;
        else if (col < AWI) { *(u32x2*)(KIb + (size_t)row * 64 + (col - AKI)) = w; *(f32x4*)(okp(row, OUT_KIP, OUT_KIS, 64) + (col - AKI)) = v; }
        else if (col < ATT_N) *(f32x4*)(WIf + (size_t)row * 8 + (col - AWI)) = v * 0.04419417382415922f;
    }
};
}

namespace mk {
typedef float f32x2v __attribute__((ext_vector_type(2)));
typedef float f32x16 __attribute__((ext_vector_type(16)));
typedef short s16x4 __attribute__((ext_vector_type(4)));
typedef short v4i16_t __attribute__((ext_vector_type(4)));

__device__ __forceinline__ void score_load_q(const bf16* __restrict__ QIb, const float* __restrict__ WIf, size_t tok0, int lane, bf16x8 (&afr)[4], f32x4 (&w4)[4]) {
    const int r = lane & 31, kq = lane >> 5;
    const bf16* ap = QIb + (tok0 + (r >> 3)) * 512 + (r & 7) * 64 + kq * 8;
#pragma unroll
    for (int ks = 0; ks < 4; ++ks) afr[ks] = *(const bf16x8*)(ap + ks * 16);
#pragma unroll
    for (int ql = 0; ql < 4; ++ql) w4[ql] = *(const f32x4*)(WIf + (tok0 + ql) * 8 + 4 * kq);
}
__device__ __forceinline__ void score_tile(const bf16x8 (&afr)[4], const bf16x8 (&bfr)[4], const f32x4 (&w4)[4], float (&s)[4]) {
    f32x16 acc;
#pragma unroll
    for (int j = 0; j < 16; ++j) acc[j] = 0.f;
#pragma unroll
    for (int ks = 0; ks < 4; ++ks) acc = __builtin_amdgcn_mfma_f32_32x32x16_bf16(afr[ks], bfr[ks], acc, 0, 0, 0);
#pragma unroll
    for (int ql = 0; ql < 4; ++ql) {
        float p = 0.f;
#pragma unroll
        for (int jj = 0; jj < 4; ++jj) p = fmaf(fmaxf(acc[ql * 4 + jj], 0.f), w4[ql][jj], p);
        s[ql] = p + __shfl_xor(p, 32);
    }
}

__device__ __forceinline__ void quant_issue(const float* __restrict__ src, f32x4 (&v)[4], int lane) {
#pragma unroll
    for (int q = 0; q < 4; ++q) v[q] = *(const f32x4*)(src + lane * 16 + q * 4);
}
__device__ __forceinline__ void quant_finish(const f32x4 (&v)[4], unsigned char* __restrict__ dst, float* __restrict__ scale, int lane) {
    float am = 0.f;
#pragma unroll
    for (int q = 0; q < 4; ++q) am = fmaxf(am, fmaxf(fmaxf(fabsf(v[q][0]), fabsf(v[q][1])), fmaxf(fabsf(v[q][2]), fabsf(v[q][3]))));
#pragma unroll
    for (int o = 1; o < 64; o <<= 1) am = fmaxf(am, __shfl_xor(am, o));
    const float inv = am > 0.f ? 448.f / am : 0.f;
    u32x4 w;
#pragma unroll
    for (int q = 0; q < 4; ++q) { int x = __builtin_amdgcn_cvt_pk_fp8_f32(v[q][0] * inv, v[q][1] * inv, 0, false); x = __builtin_amdgcn_cvt_pk_fp8_f32(v[q][2] * inv, v[q][3] * inv, x, true); w[q] = (unsigned)x; }
    *(u32x4*)(dst + lane * 16) = w;
    if (lane == 0) *scale = am * (1.f / 448.f);
}
struct QuantTabs { const float* pu; const float* pv; unsigned char* uq; unsigned char* vq; float* us; float* vs;
    __device__ __forceinline__ const float* src(int r) const { return r < 2 * 16384 ? pu + (size_t)r * D : pv + (size_t)(r - 2 * 16384) * D; }
    __device__ __forceinline__ unsigned char* dst(int r) const { return r < 2 * 16384 ? uq + (size_t)r * D : vq + (size_t)(r - 2 * 16384) * D; }
    __device__ __forceinline__ float* sc(int r) const { return r < 2 * 16384 ? us + r : vs + (r - 2 * 16384); } };

__device__ __forceinline__ void phase_score(const bf16* __restrict__ QIb, const bf16* __restrict__ KIb, const float* __restrict__ WIf, const float* __restrict__ cache_ki, const int* __restrict__ page_table,
                                            float* __restrict__ SC, float* __restrict__ SCS, const QuantTabs QT_, LAS unsigned char* lds, int vcu, int G, int wave, int lane, int gw, int NGW) {
    const int c = lane & 31, kq = lane >> 5;
    int qrow = gw;
    constexpr int KST = 144, KBUF = 256 * KST;
    const int tid = wave * 64 + lane;
    for (int it = vcu; it < 512; it += G) {
        const int b = it >> 8, qt = b == 0 ? (it & 255) : 255 - (it & 255);
        const size_t tok0 = (size_t)b * SEQ + qt * 32 + wave * 4;
        bf16x8 afr[4]; f32x4 w4[4];
        score_load_q(QIb, WIf, tok0, lane, afr, w4);
        const int nc = (qt >> 3) + 1;
        const bf16* kbase = KIb + (size_t)b * SEQ * 64;
        u32x4 st[4];
#pragma unroll
        for (int i = 0; i < 4; ++i) { const int p = tid + i * 512; st[i] = *(const u32x4*)(kbase + (size_t)(p >> 3) * 64 + (p & 7) * 8); }
#pragma unroll
        for (int i = 0; i < 4; ++i) { const int p = tid + i * 512; *(LAS u32x4*)(lds + (p >> 3) * KST + (p & 7) * 16) = st[i]; }
        __syncthreads();
        for (int ch = 0; ch < nc; ++ch) {
            const bool more = ch + 1 < nc;
            f32x4 qv[4]; const bool qdo = qrow < 4 * 16384;
            if (qdo) quant_issue(QT_.src(qrow), qv, lane);
            if (more) {
#pragma unroll
                for (int i = 0; i < 4; ++i) { const int p = tid + i * 512; st[i] = *(const u32x4*)(kbase + ((size_t)(ch + 1) * 256 + (p >> 3)) * 64 + (p & 7) * 8); }
            }
            LAS unsigned char* kb = lds + (ch & 1) * KBUF;
            const int ntile = more ? 8 : (qt & 7) + 1;
            for (int kt8 = 0; kt8 < ntile; ++kt8) {
                bf16x8 bfr[4];
#pragma unroll
                for (int ks = 0; ks < 4; ++ks) bfr[ks] = *(LAS bf16x8*)(kb + (kt8 * 32 + c) * KST + ks * 32 + kq * 16);
                float sv[4]; score_tile(afr, bfr, w4, sv);
                float* o = SC + (tok0 + 2 * kq) * SEQ + (ch * 8 + kt8) * 32 + c;
                o[0] = kq ? sv[2] : sv[0]; o[SEQ] = kq ? sv[3] : sv[1];
            }
            if (qdo) { quant_finish(qv, QT_.dst(qrow), QT_.sc(qrow), lane); qrow += NGW; }
            if (more) {
                LAS unsigned char* nb = lds + ((ch + 1) & 1) * KBUF;
#pragma unroll
                for (int i = 0; i < 4; ++i) { const int p = tid + i * 512; *(LAS u32x4*)(nb + (p >> 3) * KST + (p & 7) * 16) = st[i]; }
            }
            __syncthreads();
        }
    }
    for (; qrow < 4 * 16384; qrow += NGW) { f32x4 qv[4]; quant_issue(QT_.src(qrow), qv, lane); quant_finish(qv, QT_.dst(qrow), QT_.sc(qrow), lane); }
    for (int it = gw; it < DB * NPAGES + DB; it += NGW) {
        const bool isnew = it >= DB * NPAGES;
        const int b = isnew ? it - DB * NPAGES : it / NPAGES, pg = isnew ? 0 : it % NPAGES;
        const size_t tok0 = (size_t)TP + b * DS;
        bf16x8 afr[4]; f32x4 w4[4];
        score_load_q(QIb, WIf, tok0, lane, afr, w4);
        if (!isnew) {
            const int phys = page_table[b * NPAGES + pg];
            for (int j = 0; j < 4; ++j) {
                const float* kp = cache_ki + ((size_t)phys * PAGE + j * 32 + c) * 64 + kq * 8;
                bf16x8 bfr[4];
#pragma unroll
                for (int ks = 0; ks < 4; ++ks) { const f32x4 x0 = *(const f32x4*)(kp + ks * 16), x1 = *(const f32x4*)(kp + ks * 16 + 4); const u32x4 w = pack8(x0, x1); bfr[ks] = __builtin_bit_cast(bf16x8, w); }
                float s[4]; score_tile(afr, bfr, w4, s);
                float* o = SCS + (size_t)(b * DS + 2 * kq) * SCS_LD + pg * PAGE + j * 32 + c;
                o[0] = kq ? s[2] : s[0]; o[SCS_LD] = kq ? s[3] : s[1];
            }
        } else {
            const bf16* kp = KIb + (tok0 + (c & 3)) * 64 + kq * 8;
            bf16x8 bfr[4];
#pragma unroll
            for (int ks = 0; ks < 4; ++ks) bfr[ks] = *(const bf16x8*)(kp + ks * 16);
            float s[4]; score_tile(afr, bfr, w4, s);
            if (c < 4) { float* o = SCS + (size_t)(b * DS + 2 * kq) * SCS_LD + PAST + c; o[0] = kq ? s[2] : s[0]; o[SCS_LD] = kq ? s[3] : s[1]; }
        }
    }
}

__device__ __forceinline__ void phase_topk(const float* __restrict__ SC, const float* __restrict__ SCS, int* __restrict__ IDX, int* __restrict__ CNT, LAS unsigned char* lds, int wave, int lane, int gw, int NGW) {
    constexpr int CAP = 1024;
    unsigned* hist = (unsigned*)(lds + wave * 16384);
    float* cv = (float*)(lds + wave * 16384 + 8192);
    int* ci = (int*)(lds + wave * 16384 + 12288);
    for (int j = gw; j < TA; j += NGW) {
        int row, n; const float* rp;
        if (j < TP) { const int b = j >> 13, jj = j & 8191, blk = jj >> 11; const int q = blk < 2 ? jj : blk * 2048 + 2047 - (jj & 2047);
            row = b * SEQ + q; n = q + 1; rp = SC + (size_t)row * SEQ; }
        else { const int r = j - TP; row = j; n = PAST + (r % DS) + 1; rp = SCS + (size_t)r * SCS_LD; }
        nv::topk_wave<CAP>(rp, n, IDX + (size_t)row * TOPK, hist, cv, ci, lane);
        if (lane == 0) CNT[row] = n < TOPK ? n : TOPK;
    }
}

constexpr int VST = 144;
__device__ __forceinline__ bf16x8 ld_frag8(const bf16* p) { return *(const bf16x8*)p; }
__device__ __forceinline__ bf16x8 ld_frag8(const float* p) { const f32x4 a = *(const f32x4*)p, b = *(const f32x4*)(p + 4); const u32x4 w = pack8(a, b); return __builtin_bit_cast(bf16x8, w); }
__device__ __forceinline__ s16x4 lds_tr(LAS unsigned char* p) { return __builtin_bit_cast(s16x4, __builtin_amdgcn_ds_read_tr16_b64_v4i16((LAS v4i16_t*)p)); }

template <bool SAMPLE>
__device__ __forceinline__ void attn_row(int row, int n0, int n1, const bf16* __restrict__ Qb, const int* __restrict__ IDX, const int* __restrict__ CNT,
                                         const bf16* __restrict__ Kb, const bf16* __restrict__ Vb, const float* __restrict__ cache_k, const float* __restrict__ cache_v,
                                         const float* __restrict__ newk, const float* __restrict__ newv, const int* __restrict__ page_table,
                                         bf16* __restrict__ Ob, LAS unsigned char* wl, int lane) {
    const int fr = lane & 15, fq = lane >> 4;
    LAS int* rid = (LAS int*)wl;
    LAS unsigned char* vt = wl + 1024;
    const int cnt = CNT[row];
    const int b = SAMPLE ? (row - TP) / DS : row / SEQ;
#pragma unroll
    for (int i = 0; i < 4; ++i) { const int slot = i * 64 + lane; int key = slot < cnt ? IDX[(size_t)row * TOPK + slot] : 0; int id;
        if (!SAMPLE) id = b * SEQ + key;
        else if (key < PAST) id = page_table[b * NPAGES + key / PAGE] * PAGE + (key % PAGE);
        else id = (int)0x80000000 | (b * DS + (key - PAST));
        rid[slot] = id; }
    asm volatile("s_waitcnt lgkmcnt(0)" ::: "memory");
    for (int n = n0; n < n1; ++n) {
        bf16x8 qf[2];
#pragma unroll
        for (int ks = 0; ks < 2; ++ks) qf[ks] = *(const bf16x8*)(Qb + (size_t)row * 1024 + (n * 4 + (fr & 3)) * 64 + ks * 32 + fq * 8);
        f32x4 st[16];
        constexpr int TBN = SAMPLE ? 4 : 8;
#pragma unroll
        for (int tb = 0; tb < 16 / TBN; ++tb) {
            bf16x8 kf[TBN][2];
#pragma unroll
            for (int t = 0; t < TBN; ++t) {
                const int id = rid[(tb * TBN + t) * 16 + fr];
                if (!SAMPLE) { const bf16* kp = Kb + (size_t)id * 256 + n * 64 + fq * 8; kf[t][0] = ld_frag8(kp); kf[t][1] = ld_frag8(kp + 32); }
                else { const float* kp = (id < 0 ? newk + (size_t)(id & 0x7fffffff) * 256 : cache_k + (size_t)id * 256) + n * 64 + fq * 8; kf[t][0] = ld_frag8(kp); kf[t][1] = ld_frag8(kp + 32); }
            }
#pragma unroll
            for (int t = 0; t < TBN; ++t) {
                f32x4 a = (f32x4){0.f, 0.f, 0.f, 0.f};
                a = __builtin_amdgcn_mfma_f32_16x16x32_bf16(kf[t][0], qf[0], a, 0, 0, 0);
                a = __builtin_amdgcn_mfma_f32_16x16x32_bf16(kf[t][1], qf[1], a, 0, 0, 0);
                st[tb * TBN + t] = a;
            }
            asm volatile("" ::: "memory");
        }
        bf16x8 vreg[8];
#define ATT_VLOAD(ch_) do { _Pragma("unroll") for (int i = 0; i < 8; ++i) { const int sl = i * 8 + (lane >> 3), chunk = lane & 7; const int id = rid[(ch_) * 64 + sl]; \
            if (!SAMPLE) vreg[i] = ld_frag8(Vb + (size_t)id * 256 + n * 64 + chunk * 8); \
            else vreg[i] = ld_frag8((id < 0 ? newv + (size_t)(id & 0x7fffffff) * 256 : cache_v + (size_t)id * 256) + n * 64 + chunk * 8); } } while (0)
        ATT_VLOAD(0);
        float mx = -INFINITY;
#pragma unroll
        for (int t = 0; t < 16; ++t)
#pragma unroll
            for (int j = 0; j < 4; ++j) { const int slot = t * 16 + fq * 4 + j; const float v = slot < cnt ? st[t][j] * 0.125f : -INFINITY; st[t][j] = v; mx = fmaxf(mx, v); }
        mx = fmaxf(mx, __shfl_xor(mx, 16)); mx = fmaxf(mx, __shfl_xor(mx, 32));
        float sum = 0.f;
#pragma unroll
        for (int t = 0; t < 16; ++t)
#pragma unroll
            for (int j = 0; j < 4; ++j) { const float e = __expf(st[t][j] - mx); st[t][j] = e; sum += e; }
        sum += __shfl_xor(sum, 16); sum += __shfl_xor(sum, 32);
        f32x4 oacc[4];
#pragma unroll
        for (int dt = 0; dt < 4; ++dt) oacc[dt] = (f32x4){0.f, 0.f, 0.f, 0.f};
#pragma unroll
        for (int ch = 0; ch < 4; ++ch) {
#pragma unroll
            for (int i = 0; i < 8; ++i) { const int sl = i * 8 + (lane >> 3), chunk = lane & 7; *(LAS bf16x8*)(vt + sl * VST + chunk * 16) = vreg[i]; }
            asm volatile("s_waitcnt lgkmcnt(0)" ::: "memory");
            if (ch < 3) ATT_VLOAD(ch + 1);
#pragma unroll
            for (int s2 = 0; s2 < 2; ++s2) {
                const int t0 = ch * 4 + s2 * 2;
                const u32x4 pw = pack8(st[t0], st[t0 + 1]);
                const bf16x8 pf = __builtin_bit_cast(bf16x8, pw);
#pragma unroll
                for (int dt = 0; dt < 4; ++dt) {
                    LAS unsigned char* a0 = vt + (s2 * 32 + fq * 4 + (fr >> 2)) * VST + (dt * 16 + 4 * (fr & 3)) * 2;
                    const s16x4 v0 = lds_tr(a0), v1 = lds_tr(a0 + 16 * VST);
                    bf16x8 vf; vf[0] = v0[0]; vf[1] = v0[1]; vf[2] = v0[2]; vf[3] = v0[3]; vf[4] = v1[0]; vf[5] = v1[1]; vf[6] = v1[2]; vf[7] = v1[3];
                    oacc[dt] = __builtin_amdgcn_mfma_f32_16x16x32_bf16(pf, vf, oacc[dt], 0, 0, 0);
                }
            }
            asm volatile("s_waitcnt lgkmcnt(0)" ::: "memory");
        }
#undef ATT_VLOAD
        const float i0 = 1.f / __shfl(sum, 0), i1 = 1.f / __shfl(sum, 1), i2 = 1.f / __shfl(sum, 2), i3 = 1.f / __shfl(sum, 3);
        if (fq == 0) {
#pragma unroll
            for (int dt = 0; dt < 4; ++dt) {
                bf16* o = Ob + (size_t)row * 1024 + (n * 4) * 64 + dt * 16 + fr;
                o[0] = (bf16)f2bf(oacc[dt][0] * i0); o[64] = (bf16)f2bf(oacc[dt][1] * i1); o[128] = (bf16)f2bf(oacc[dt][2] * i2); o[192] = (bf16)f2bf(oacc[dt][3] * i3);
            }
        }
    }
    asm volatile("s_waitcnt lgkmcnt(0)" ::: "memory");
}

__device__ __forceinline__ void kv8_convert(const bf16* __restrict__ Kb, const bf16* __restrict__ Vb, unsigned char* __restrict__ KV8_, const unsigned* __restrict__ amaxk, const unsigned* __restrict__ amaxv, int gw, int NGW, int lane) {
    const float ak = __builtin_bit_cast(float, __hip_atomic_load(amaxk, __ATOMIC_RELAXED, __HIP_MEMORY_SCOPE_AGENT)), av = __builtin_bit_cast(float, __hip_atomic_load(amaxv, __ATOMIC_RELAXED, __HIP_MEMORY_SCOPE_AGENT));
    const bool isv = lane >= 32; const int l = lane & 31;
    const float sc = isv ? (av > 0.f ? 448.f / av : 0.f) : (ak > 0.f ? 448.f / ak : 0.f);
    for (int t = gw; t < TP; t += NGW) {
        const u32x4 w = *(const u32x4*)((isv ? Vb : Kb) + (size_t)t * 256 + l * 8);
        const float x0 = bflo(w.x) * sc, x1 = bfhi(w.x) * sc, x2 = bflo(w.y) * sc, x3 = bfhi(w.y) * sc, x4 = bflo(w.z) * sc, x5 = bfhi(w.z) * sc, x6 = bflo(w.w) * sc, x7 = bfhi(w.w) * sc;
        int p0 = __builtin_amdgcn_cvt_pk_fp8_f32(x0, x1, 0, false); p0 = __builtin_amdgcn_cvt_pk_fp8_f32(x2, x3, p0, true);
        int p1 = __builtin_amdgcn_cvt_pk_fp8_f32(x4, x5, 0, false); p1 = __builtin_amdgcn_cvt_pk_fp8_f32(x6, x7, p1, true);
        const int n = l >> 3, d0 = (l & 7) * 8;
        const int pos = isv ? 64 + d0 : ((d0 & 31) >> 3) * 16 + (d0 >> 5) * 8;
        u32x2 o; o.x = (unsigned)p0; o.y = (unsigned)p1;
        *(u32x2*)(KV8_ + (size_t)t * 512 + n * 128 + pos) = o;
    }
}
__device__ __forceinline__ void fp8x16_to_bf16(const u32x4 q, bf16x8& lo, bf16x8& hi) {
    u32x4 a, b;
#pragma unroll
    for (int w = 0; w < 4; ++w) { const f32x2v f0 = __builtin_amdgcn_cvt_pk_f32_fp8((int)q[w], false), f1 = __builtin_amdgcn_cvt_pk_f32_fp8((int)q[w], true);
        const unsigned u0 = pk2(f0[0], f0[1]), u1 = pk2(f1[0], f1[1]);
        if (w < 2) { a[2 * w] = u0; a[2 * w + 1] = u1; } else { b[2 * w - 4] = u0; b[2 * w - 3] = u1; } }
    lo = __builtin_bit_cast(bf16x8, a); hi = __builtin_bit_cast(bf16x8, b);
}
#ifndef KF1
#define KF1 10
#endif
__device__ __forceinline__ void attn_prompt_stream(int b, int n, int q0, int qstep, const bf16* __restrict__ Qb, const int* __restrict__ IDX, const unsigned char* __restrict__ KV8_, const unsigned* __restrict__ amaxk, const unsigned* __restrict__ amaxv,
                                                   bf16* __restrict__ Ob, LAS unsigned char* wl, int lane) {
    const float ak_ = __builtin_bit_cast(float, __hip_atomic_load(amaxk, __ATOMIC_RELAXED, __HIP_MEMORY_SCOPE_AGENT)), av_ = __builtin_bit_cast(float, __hip_atomic_load(amaxv, __ATOMIC_RELAXED, __HIP_MEMORY_SCOPE_AGENT));
    const float kinv = ak_ * (1.f / 448.f), vinv = av_ * (1.f / 448.f);
    const int fr = lane & 15, fq = lane >> 4;
    LAS int* ridb = (LAS int*)wl;
    LAS unsigned char* vt = wl + 2048;
    if (q0 >= SEQ) return;
    int vx[4];
    { const int row = b * SEQ + q0, cnt = q0 + 1 < TOPK ? q0 + 1 : TOPK;
#pragma unroll
      for (int i = 0; i < 4; ++i) { const int slot = i * 64 + lane; ridb[slot] = b * SEQ + (slot < cnt ? IDX[(size_t)row * TOPK + slot] : 0); } }
    int buf = 0;
    unsigned long long tacc = 0ull; TPB(14);
    for (int q = q0; q < SEQ; q += qstep, buf ^= 1) {
        TPB(10);
        const int row = b * SEQ + q, cnt = q + 1 < TOPK ? q + 1 : TOPK;
        LAS int* rid = ridb + buf * 256;
        asm volatile("s_waitcnt lgkmcnt(0)" ::: "memory");
        int kx[16];
#pragma unroll
        for (int t = 0; t < 16; ++t) kx[t] = rid[t * 16 + fr];
        bf16x8 qf[2];
#pragma unroll
        for (int ks = 0; ks < 2; ++ks) qf[ks] = *(const bf16x8*)(Qb + (size_t)row * 1024 + (n * 4 + (fr & 3)) * 64 + ks * 32 + fq * 8);
        u32x4 kraw[16];
#pragma unroll
        for (int t = 0; t < 16; ++t) kraw[t] = *(const u32x4*)(KV8_ + (size_t)kx[t] * 512 + n * 128 + fq * 16);
        asm volatile("s_waitcnt lgkmcnt(0)" ::: "memory");
        u32x4 vraw[4];
#define ATT_VLOAD2(ch_) do { _Pragma("unroll") for (int i = 0; i < 4; ++i) { const int sl = i * 16 + (lane >> 2), piece = lane & 3; const int id = rid[(ch_) * 64 + sl]; \
            vraw[i] = *(const u32x4*)(KV8_ + (size_t)id * 512 + n * 128 + 64 + piece * 16); } } while (0)
        f32x4 st[16];
#pragma unroll
        for (int t = 0; t < 16; ++t) {
            asm volatile("" : "+v"(kraw[t][0]), "+v"(kraw[t][1]), "+v"(kraw[t][2]), "+v"(kraw[t][3]));
            bf16x8 k0, k1; fp8x16_to_bf16(kraw[t], k0, k1);
            f32x4 a = (f32x4){0.f, 0.f, 0.f, 0.f};
            a = __builtin_amdgcn_mfma_f32_16x16x32_bf16(k0, qf[0], a, 0, 0, 0);
            a = __builtin_amdgcn_mfma_f32_16x16x32_bf16(k1, qf[1], a, 0, 0, 0);
            st[t] = a;
            asm volatile("" : "+v"(st[t][0]), "+v"(st[t][1]), "+v"(st[t][2]), "+v"(st[t][3]));
        }
        TPE(10); TPB(11);
        const int qn = q + qstep;
        if (qn < SEQ) { const int rown = b * SEQ + qn, cntn = qn + 1 < TOPK ? qn + 1 : TOPK;
#pragma unroll
            for (int i = 0; i < 4; ++i) { const int slot = i * 64 + lane; vx[i] = slot < cntn ? IDX[(size_t)rown * TOPK + slot] : 0; } }
        ATT_VLOAD2(0);
        float mx = -INFINITY;
        if (cnt < TOPK) {
#pragma unroll
            for (int t = 0; t < 16; ++t)
#pragma unroll
                for (int j = 0; j < 4; ++j) { const int slot = t * 16 + fq * 4 + j; st[t][j] = slot < cnt ? st[t][j] : -INFINITY; }
        }
#pragma unroll
        for (int t = 0; t < 16; ++t) mx = fmaxf(mx, fmaxf(fmaxf(st[t][0], st[t][1]), fmaxf(st[t][2], st[t][3])));
        mx = fmaxf(mx, __shfl_xor(mx, 16)); mx = fmaxf(mx, __shfl_xor(mx, 32));
        const float cs = 0.18033688011112042f * kinv, mb = -mx * cs;
        float sum = 0.f;
#pragma unroll
        for (int t = 0; t < 16; ++t)
#pragma unroll
            for (int j = 0; j < 4; ++j) { const float e = __builtin_amdgcn_exp2f(fmaf(st[t][j], cs, mb)); st[t][j] = e; sum += e; }
        sum += __shfl_xor(sum, 16); sum += __shfl_xor(sum, 32);
        TPE(11); TPB(12);
        f32x4 oacc[4];
#pragma unroll
        for (int dt = 0; dt < 4; ++dt) oacc[dt] = (f32x4){0.f, 0.f, 0.f, 0.f};
#pragma unroll
        for (int ch = 0; ch < 4; ++ch) {
#pragma unroll
            for (int i = 0; i < 4; ++i) { const int sl = i * 16 + (lane >> 2), piece = lane & 3; bf16x8 v0, v1; fp8x16_to_bf16(vraw[i], v0, v1);
                *(LAS bf16x8*)(vt + sl * VST + piece * 32) = v0; *(LAS bf16x8*)(vt + sl * VST + piece * 32 + 16) = v1; }
            asm volatile("s_waitcnt lgkmcnt(0)" ::: "memory");
            if (ch < 3) ATT_VLOAD2(ch + 1);
#pragma unroll
            for (int s2 = 0; s2 < 2; ++s2) {
                const int t0 = ch * 4 + s2 * 2;
                const u32x4 pw = pack8(st[t0], st[t0 + 1]);
                const bf16x8 pf = __builtin_bit_cast(bf16x8, pw);
#pragma unroll
                for (int dt = 0; dt < 4; ++dt) {
                    LAS unsigned char* a0 = vt + (s2 * 32 + fq * 4 + (fr >> 2)) * VST + (dt * 16 + 4 * (fr & 3)) * 2;
                    const s16x4 v0 = lds_tr(a0), v1 = lds_tr(a0 + 16 * VST);
                    bf16x8 vf; vf[0] = v0[0]; vf[1] = v0[1]; vf[2] = v0[2]; vf[3] = v0[3]; vf[4] = v1[0]; vf[5] = v1[1]; vf[6] = v1[2]; vf[7] = v1[3];
                    oacc[dt] = __builtin_amdgcn_mfma_f32_16x16x32_bf16(pf, vf, oacc[dt], 0, 0, 0);
                }
            }
            asm volatile("s_waitcnt lgkmcnt(0)" ::: "memory");
        }
#undef ATT_VLOAD2
        TPE(12); TPB(13);
        const float i0 = vinv / __shfl(sum, 0), i1 = vinv / __shfl(sum, 1), i2 = vinv / __shfl(sum, 2), i3 = vinv / __shfl(sum, 3);
        if (fq == 0) {
#pragma unroll
            for (int dt = 0; dt < 4; ++dt) {
                bf16* o = Ob + (size_t)row * 1024 + (n * 4) * 64 + dt * 16 + fr;
                o[0] = (bf16)f2bf(oacc[dt][0] * i0); o[64] = (bf16)f2bf(oacc[dt][1] * i1); o[128] = (bf16)f2bf(oacc[dt][2] * i2); o[192] = (bf16)f2bf(oacc[dt][3] * i3);
            }
        }
        if (qn < SEQ) {
#pragma unroll
            for (int i = 0; i < 4; ++i) ridb[(buf ^ 1) * 256 + i * 64 + lane] = vx[i] + b * SEQ;
        }
        TPE(13);
    }
    TPE(14);
#if defined(PROBE_REGION)
    if (PROBE_REGION >= 10 && PROBE_REGION <= 14 && q0 == PROBE_WAVE && lane == 0) g_probe_acc = tacc;
#endif
    asm volatile("s_waitcnt lgkmcnt(0)" ::: "memory");
}

__device__ __forceinline__ void ln_row_wave(const float* __restrict__ zrow, const float* __restrict__ g, const float* __restrict__ bt, float* __restrict__ of, bf16* __restrict__ ob, int lane) {
    f32x4 v[4]; float s = 0.f;
#pragma unroll
    for (int j = 0; j < 4; ++j) { v[j] = *(const f32x4*)(zrow + 256 * j + 4 * lane); s += (v[j][0] + v[j][1]) + (v[j][2] + v[j][3]); }
#pragma unroll
    for (int o = 1; o < 64; o <<= 1) s += __shfl_xor(s, o);
    const float mean = s * (1.f / D); float q = 0.f;
#pragma unroll
    for (int j = 0; j < 4; ++j) { v[j] = v[j] - mean; q += (v[j][0] * v[j][0] + v[j][1] * v[j][1]) + (v[j][2] * v[j][2] + v[j][3] * v[j][3]); }
#pragma unroll
    for (int o = 1; o < 64; o <<= 1) q += __shfl_xor(q, o);
    const float rstd = rsqrtf(q * (1.f / D) + LN_EPS);
#pragma unroll
    for (int j = 0; j < 4; ++j) { const f32x4 gg = *(const f32x4*)(g + 256 * j + 4 * lane), bb = *(const f32x4*)(bt + 256 * j + 4 * lane); const f32x4 o = v[j] * rstd * gg + bb;
        if (of) *(f32x4*)(of + 256 * j + 4 * lane) = o; u32x2 w; w.x = pk2(o[0], o[1]); w.y = pk2(o[2], o[3]); *(u32x2*)(ob + 256 * j + 4 * lane) = w; }
}

struct FResid {
    const float* rp; const float* rs; float* Z;
    __device__ __forceinline__ const float* rrow(int row) const { return row < TP ? rp + (size_t)row * D : rs + (size_t)(row - TP) * D; }
    __device__ __forceinline__ void put8(int row, int col, f32x4 v0, f32x4 v1) const { const float* r = rrow(row) + col; float* z = Z + (size_t)row * D + col;
        *(f32x4*)z = v0 + ALPHA * *(const f32x4*)r; *(f32x4*)(z + 4) = v1 + ALPHA * *(const f32x4*)(r + 4); }
    __device__ __forceinline__ void put4(int row, int col, f32x4 v) const { *(f32x4*)(Z + (size_t)row * D + col) = v + ALPHA * *(const f32x4*)(rrow(row) + col); }
};
}

namespace mk {
template <int CAP>
__device__ __forceinline__ void topk_wave_regs(const float* __restrict__ row, int n, int* __restrict__ out, LAS unsigned* hist, LAS float* cv, LAS int* ci, LAS unsigned char* lst, int lane, unsigned long long& tacc) {
    if (n <= TOPK) { for (int i = lane; i < TOPK; i += 64) out[i] = i < n ? i : 0; return; }
    TPB(1);
    constexpr int NCH = 32;
    const int nch = n > 8192 ? 32 : (n + 255) >> 8;
    float vx = (lane < 4 && 8192 + lane < n) ? row[8192 + lane] : -INFINITY;
    f32x4 v[NCH];
#pragma unroll
    for (int j = 0; j < NCH; ++j) {
        if (j < nch) v[j] = *(const f32x4*)(row + j * 256 + lane * 4);
        else v[j] = (f32x4){-INFINITY, -INFINITY, -INFINITY, -INFINITY};
    }
    float mn = INFINITY, mx = -INFINITY;
#pragma unroll
    for (int j = 0; j < NCH; ++j) {
        if (j < nch) {
            const int base = j * 256 + lane * 4;
#pragma unroll
            for (int e = 0; e < 4; ++e) { const bool ok = base + e < n; const float x = v[j][e]; v[j][e] = ok ? x : -INFINITY; mx = fmaxf(mx, ok ? x : -INFINITY); mn = fminf(mn, ok ? x : INFINITY); }
        }
    }
    if (vx != -INFINITY) { mx = fmaxf(mx, vx); mn = fminf(mn, vx); }
#pragma unroll
    for (int o = 1; o < 64; o <<= 1) { mn = fminf(mn, __shfl_xor(mn, o)); mx = fmaxf(mx, __shfl_xor(mx, o)); }
    if (!(mx > mn)) { for (int i = lane; i < TOPK; i += 64) out[i] = i; return; }
    const float scale = 2048.0f / (mx - mn);
    TPE(1); TPB(2);
#pragma unroll
    for (int i = 0; i < 8; ++i) *(LAS u32x4*)(hist + i * 256 + lane * 4) = (u32x4){0u, 0u, 0u, 0u};
    asm volatile("s_waitcnt lgkmcnt(0)" ::: "memory");
#pragma unroll
    for (int j = 0; j < NCH; ++j) {
        if (j < nch) {
            asm volatile("" : "+v"(v[j][0]), "+v"(v[j][1]), "+v"(v[j][2]), "+v"(v[j][3]));
#pragma unroll
            for (int e = 0; e < 4; ++e) { const float x = v[j][e]; int bn = (int)((x - mn) * scale); bn = bn > 2047 ? 2047 : bn; bn = x != -INFINITY ? bn : 2048;
                __hip_atomic_fetch_add(hist + bn, 1u, __ATOMIC_RELAXED, __HIP_MEMORY_SCOPE_WAVEFRONT); }
        }
    }
    if (vx != -INFINITY) { int bn = (int)((vx - mn) * scale); bn = bn > 2047 ? 2047 : bn; __hip_atomic_fetch_add(hist + bn, 1u, __ATOMIC_RELAXED, __HIP_MEMORY_SCOPE_WAVEFRONT); }
    asm volatile("s_waitcnt lgkmcnt(0)" ::: "memory");
    TPE(2); TPB(3);
    unsigned mine = 0u;
#pragma unroll
    for (int i = 0; i < 8; ++i) { const u32x4 h4 = *(LAS u32x4*)(hist + lane * 32 + i * 4); mine += (h4.x + h4.y) + (h4.z + h4.w); }
    unsigned suf = mine;
#pragma unroll
    for (int o = 1; o < 64; o <<= 1) { const unsigned t = __shfl_down(suf, o); if (lane + o < 64) suf += t; }
    const unsigned long long bal = __ballot(suf >= (unsigned)TOPK);
    const int Lt = 63 - __builtin_clzll(bal);
    const unsigned above = __shfl(suf, Lt) - __shfl(mine, Lt);
    const unsigned hb = hist[Lt * 32 + (lane & 31)];
    unsigned sfx = hb;
#pragma unroll
    for (int o = 1; o < 32; o <<= 1) { const unsigned t = __shfl_down(sfx, o); if ((lane & 31) + o < 32) sfx += t; }
    const unsigned long long okm = __ballot(above + sfx >= (unsigned)TOPK) & 0xFFFFFFFFull;
    const int jb = 63 - __builtin_clzll(okm);
    const int B = Lt * 32 + jb;
    const unsigned running = above + __shfl(sfx, jb) - __shfl(hb, jb);
    const int cnt_gt = (int)running, r = TOPK - cnt_gt;
    TPE(3); TPB(4);
    int base_gt = 0, base_eq = 0;
    const unsigned long long below = (1ull << lane) - 1ull;
    int lane4 = lane * 4; asm volatile("" : "+v"(lane4));
#pragma unroll
    for (int j = 0; j < NCH; ++j) {
        if (j < nch) {
#pragma unroll
            for (int e = 0; e < 4; ++e) {
                const float x = v[j][e]; int bn = (int)((x - mn) * scale); bn = bn > 2047 ? 2047 : bn; bn = x != -INFINITY ? bn : -1;
                const bool gt = bn > B, eq = bn == B;
                const unsigned long long mg = __ballot(gt), me = __ballot(eq);
                if (mg | me) {
                    const int idx = lane4 + (j * 256 + e);
                    if (gt) out[base_gt + __builtin_popcountll(mg & below)] = idx;
                    if (eq) { const int p = base_eq + __builtin_popcountll(me & below); if (p < CAP) { cv[p] = x; ci[p] = idx; } }
                    base_gt += __builtin_popcountll(mg); base_eq += __builtin_popcountll(me);
                }
            }
        }
    }
    if (n > 8192) {
        const float x = vx; bool gt = false, eq = false;
        if (x != -INFINITY) { int bn = (int)((x - mn) * scale); bn = bn > 2047 ? 2047 : bn; gt = bn > B; eq = bn == B; }
        const unsigned long long mg = __ballot(gt), me = __ballot(eq);
        const int idx = 8192 + lane;
        if (gt) out[base_gt + __builtin_popcountll(mg & below)] = idx;
        if (eq) { const int p = base_eq + __builtin_popcountll(me & below); if (p < CAP) { cv[p] = x; ci[p] = idx; } }
        base_gt += __builtin_popcountll(mg); base_eq += __builtin_popcountll(me);
    }
    asm volatile("s_waitcnt vmcnt(0) lgkmcnt(0)" ::: "memory");
    TPE(4); TPB(5);
    const int m = base_eq < CAP ? base_eq : CAP;
    if (m <= 64) {
        const float x = lane < m ? cv[lane] : -INFINITY; const int id = lane < m ? ci[lane] : 0x7fffffff; int rank = 0;
        for (int c2 = 0; c2 < m; ++c2) { const float x2 = __builtin_bit_cast(float, __builtin_amdgcn_readlane(__builtin_bit_cast(int, x), c2)); const int id2 = __builtin_amdgcn_readlane(id, c2);
            rank += (x2 > x || (x2 == x && id2 < id)) ? 1 : 0; }
        if (lane < m && rank < r) out[cnt_gt + rank] = id;
    } else {
        for (int c = lane; c < m; c += 64) {
            const float x = cv[c]; const int id = ci[c]; int rank = 0;
            for (int c2 = 0; c2 < m; ++c2) { const float x2 = cv[c2]; const int id2 = ci[c2]; rank += (x2 > x || (x2 == x && id2 < id)) ? 1 : 0; }
            if (rank < r) out[cnt_gt + rank] = id;
        }
    }
    asm volatile("s_waitcnt lgkmcnt(0)" ::: "memory");
    TPE(5);
}

__device__ __forceinline__ void phase_topk2(const float* __restrict__ SC, const float* __restrict__ SCS, int* __restrict__ IDX, int* __restrict__ CNT,
                                            const float* __restrict__ peer_u_, const float* __restrict__ peer_v_, unsigned char* __restrict__ Uq_, unsigned char* __restrict__ Vq_, float* __restrict__ Usc_, float* __restrict__ Vsc_,
                                            LAS unsigned char* lds, unsigned* qhead, int wave, int lane, int gw, int NGW, int jlo = 0, int jhi = TA) {
    constexpr int CAP = 1020;
    LAS unsigned* hist = (LAS unsigned*)(lds + wave * 16384);
    LAS float* cv = (LAS float*)(lds + wave * 16384 + 8208);
    LAS int* ci = (LAS int*)(lds + wave * 16384 + 8208 + 4080);
    LAS unsigned char* lst = nullptr;
    unsigned long long tacc = 0ull; TPB(7);
    for (int j = gw; j < TA; j += NGW) {
        if (j < jlo || j >= jhi) continue;
        int row, n; const float* rp;
        if (j < TP) { const int b = j >> 13, jj = j & 8191, blk = jj >> 11; const int q = blk < 2 ? jj : blk * 2048 + 2047 - (jj & 2047);
            row = b * SEQ + q; n = q + 1; rp = SC + (size_t)row * SEQ; }
        else { const int r = j - TP; row = j; n = PAST + (r % DS) + 1; rp = SCS + (size_t)r * SCS_LD; }
        TPB(6);
        topk_wave_regs<CAP>(rp, n, IDX + (size_t)row * TOPK, hist, cv, ci, lst, lane, tacc);
        TPE(6);
        if (lane == 0) CNT[row] = n < TOPK ? n : TOPK;
    }
    TPE(7);
#if defined(PROBE_REGION)
    if (PROBE_REGION >= 1 && PROBE_REGION <= 7 && gw == PROBE_WAVE && lane == 0) g_probe_acc = tacc;
#endif
}
}

namespace mk {
using bf16x2_t = __attribute__((ext_vector_type(2))) __bf16;
__device__ __forceinline__ float dot2bf(unsigned a, unsigned b, float acc) { return __builtin_amdgcn_fdot2_f32_bf16(__builtin_bit_cast(bf16x2_t, a), __builtin_bit_cast(bf16x2_t, b), acc, false); }

struct FStoreBf16 {
    bf16* O; int ld;
    __device__ __forceinline__ void put8(int row, int col, f32x4 v0, f32x4 v1) const { *(u32x4*)(O + (size_t)row * ld + col) = pack8(v0, v1); }
    __device__ __forceinline__ void put4(int row, int col, f32x4 v) const { u32x2 w; w.x = pk2(v[0], v[1]); w.y = pk2(v[2], v[3]); *(u32x2*)(O + (size_t)row * ld + col) = w; }
};

#ifndef PGS
#define PGS 8
#endif
constexpr int PEER_TAB_OFF = LDSCTL_OFF + 1024;

__device__ __forceinline__ void ce_desc(unsigned& a, unsigned& b) { const unsigned hi = a > b ? a : b, lo = a > b ? b : a; a = hi; b = lo; }
template <int N> __device__ __forceinline__ void bitonic_sort_desc(unsigned (&k)[N]) {
#pragma unroll
    for (int size = 2; size <= N; size <<= 1)
#pragma unroll
        for (int stride = size >> 1; stride > 0; stride >>= 1)
#pragma unroll
            for (int i = 0; i < N; ++i) { const int j = i ^ stride; if (j > i) { if ((i & size) == 0) ce_desc(k[i], k[j]); else ce_desc(k[j], k[i]); } }
}
template <int N> __device__ __forceinline__ void bitonic_merge_desc(unsigned (&k)[N]) {
#pragma unroll
    for (int stride = N >> 1; stride > 0; stride >>= 1)
#pragma unroll
        for (int i = 0; i < N; ++i) { const int j = i ^ stride; if (j > i) ce_desc(k[i], k[j]); }
}
__device__ __forceinline__ void top16_merge(unsigned (&a)[16], const unsigned (&b)[16]) {
#pragma unroll
    for (int i = 0; i < 16; ++i) a[i] = a[i] > b[15 - i] ? a[i] : b[15 - i];
    bitonic_merge_desc<16>(a);
}
__device__ __forceinline__ void top16_xlane(unsigned (&a)[16], int o) {
    unsigned b[16];
#pragma unroll
    for (int i = 0; i < 16; ++i) b[i] = (unsigned)__shfl_xor((int)a[i], o);
    top16_merge(a, b);
}
__device__ __forceinline__ unsigned f2ord(float f) { const unsigned u = __builtin_bit_cast(unsigned, f); return u ^ ((u >> 31) ? 0xFFFFFFFFu : 0x80000000u); }
__device__ __forceinline__ float ord2f(unsigned o) { const unsigned u = o ^ ((o >> 31) ? 0x80000000u : 0xFFFFFFFFu); return __builtin_bit_cast(float, u); }

__device__ __forceinline__ void phase_peer_select(const bf16* __restrict__ PQb, const bf16* __restrict__ K1, const bf16* __restrict__ K2, unsigned short* __restrict__ teid_g, float* __restrict__ tgate_g,
                                                  LAS unsigned char* lds, int vcu, int G, int wave, int lane) {
    const int fr = lane & 15, fq = lane >> 4, h = wave;
    LAS unsigned char* itab = lds + wave * 1024;
    for (int tile = vcu; tile < TA / 16; tile += G) {
        const int tok0 = tile * 16;
        unsigned tk[2][16];
#pragma unroll
        for (int half = 0; half < 2; ++half) {
            const bf16* ap = PQb + (size_t)(tok0 + fr) * PEER_N + h * 256 + half * 128 + fq * 8;
            bf16x8 a[4];
#pragma unroll
            for (int ks = 0; ks < 4; ++ks) a[ks] = *(const bf16x8*)(ap + ks * 32);
            const bf16* kb = (half ? K2 : K1) + (size_t)fr * 128 + fq * 8;
            unsigned k0[16], k1[16];
#pragma unroll
            for (int ct = 0; ct < 8; ++ct) {
                f32x4 acc = (f32x4){0.f, 0.f, 0.f, 0.f};
#pragma unroll
                for (int ks = 0; ks < 4; ++ks) { const bf16x8 b = *(const bf16x8*)(kb + (size_t)ct * 16 * 128 + ks * 32); acc = __builtin_amdgcn_mfma_f32_16x16x32_bf16(b, a[ks], acc, 0, 0, 0); }
#pragma unroll
                for (int j = 0; j < 4; ++j) { const unsigned key = (f2ord(acc[j]) & 0xFFFFFF80u) | (unsigned)(127 - (ct * 16 + 4 * fq + j));
                    if (ct < 4) k0[ct * 4 + j] = key; else k1[(ct - 4) * 4 + j] = key; }
                if (ct & 1) asm volatile("" ::: "memory");
            }
            bitonic_sort_desc<16>(k0); bitonic_sort_desc<16>(k1);
            top16_merge(k0, k1); top16_xlane(k0, 16); top16_xlane(k0, 32);
#pragma unroll
            for (int i = 0; i < 16; ++i) tk[half][i] = k0[i];
        }
        if (fq == 0) {
#pragma unroll
            for (int i = 0; i < 16; ++i) { itab[fr * 32 + i] = (unsigned char)(127 - (tk[0][i] & 0x7Fu)); itab[fr * 32 + 16 + i] = (unsigned char)(127 - (tk[1][i] & 0x7Fu)); }
        }
        unsigned ck[16];
        {
            float v1[16], v2[16];
#pragma unroll
            for (int i = 0; i < 16; ++i) { v1[i] = ord2f(tk[0][i] & 0xFFFFFF80u); v2[i] = ord2f(tk[1][i] & 0xFFFFFF80u); }
            int c = 0;
#pragma unroll
            for (int i = 0; i < 16; ++i)
#pragma unroll
                for (int j = 0; j < 16; ++j) {
                    if ((i + 1) * (j + 1) <= 16) {
                        const unsigned key = (f2ord(v1[i] + v2[j]) & 0xFFFFFF00u) | (unsigned)(255 - (i * 16 + j));
                        const int m = c >> 2, pt = c & 3;
                        if (pt == 0) ck[m] = key; else ck[m] = fq == pt ? key : ck[m];
                        ++c;
                    }
                }
            ck[12] = fq < 2 ? ck[12] : 0u; ck[13] = 0u; ck[14] = 0u; ck[15] = 0u;
        }
        bitonic_sort_desc<16>(ck); top16_xlane(ck, 16); top16_xlane(ck, 32);
        asm volatile("s_waitcnt lgkmcnt(0)" ::: "memory");
        float ev[16]; float sum = 0.f; const float mxv = ord2f(ck[0] & 0xFFFFFF00u);
#pragma unroll
        for (int k = 0; k < 16; ++k) { ev[k] = __expf(ord2f(ck[k] & 0xFFFFFF00u) - mxv); sum += ev[k]; }
        const float inv = 1.f / sum;
#pragma unroll
        for (int k = 0; k < 16; ++k) {
            if ((k >> 2) == fq) {
                const int f = 255 - (int)(ck[k] & 0xFFu); const int id = (int)itab[fr * 32 + (f >> 4)] * 128 + (int)itab[fr * 32 + 16 + (f & 15)];
                teid_g[(size_t)(tok0 + fr) * 128 + h * 16 + k] = (unsigned short)id; tgate_g[(size_t)(tok0 + fr) * 128 + h * 16 + k] = ev[k] * inv;
            }
        }
        asm volatile("s_waitcnt lgkmcnt(0)" ::: "memory");
    }
}

__device__ __forceinline__ void phase_peer_mix(const float* __restrict__ Zin, const float* __restrict__ g1, const float* __restrict__ b1, const unsigned short* __restrict__ teid, const float* __restrict__ tgate,
                                               const unsigned char* __restrict__ U, const unsigned char* __restrict__ V, const float* __restrict__ Us, const float* __restrict__ Vs, const float* __restrict__ g2, const float* __restrict__ b2,
                                               float* __restrict__ outf, bf16* __restrict__ outb, int gw, int NGW, int lane) {
    unsigned long long tacc = 0ull; TPB(24);
    for (int j = gw; j < TP + TS * 16; j += NGW) {
        size_t tok;
        if (j < TP) tok = (size_t)j;
        else { const int s = j - TP; if ((s & 15) != 0) continue; tok = (size_t)TP + (s >> 4); }
        {
            float xf[16];
            { float s1 = 0.f;
#pragma unroll
              for (int q = 0; q < 4; ++q) { const f32x4 r = *(const f32x4*)(Zin + tok * D + lane * 16 + q * 4); xf[q * 4] = r[0]; xf[q * 4 + 1] = r[1]; xf[q * 4 + 2] = r[2]; xf[q * 4 + 3] = r[3]; s1 += (r[0] + r[1]) + (r[2] + r[3]); }
#pragma unroll
              for (int o = 1; o < 64; o <<= 1) s1 += __shfl_xor(s1, o);
              const float mean1 = s1 * (1.f / D); float q1 = 0.f;
#pragma unroll
              for (int i = 0; i < 16; ++i) { xf[i] -= mean1; q1 += xf[i] * xf[i]; }
#pragma unroll
              for (int o = 1; o < 64; o <<= 1) q1 += __shfl_xor(q1, o);
              const float rstd1 = rsqrtf(q1 * (1.f / D) + LN_EPS);
#pragma unroll
              for (int q = 0; q < 4; ++q) { const f32x4 gg = *(const f32x4*)(g1 + lane * 16 + q * 4), bb = *(const f32x4*)(b1 + lane * 16 + q * 4);
#pragma unroll
                  for (int i = 0; i < 4; ++i) xf[q * 4 + i] = xf[q * 4 + i] * rstd1 * gg[i] + bb[i]; } }
            float wv0 = 0.f, wv1 = 0.f;
#pragma unroll 1
            for (int bt = 0; bt < 2; ++bt) {
                const int eidv = (int)teid[tok * 128 + bt * 64 + lane];
                float p[64];
                TPB(20);
                u32x4 qb[2][PGS];
#pragma unroll
                for (int i = 0; i < PGS; ++i) { const int id = __builtin_amdgcn_readlane(eidv, i); qb[0][i] = *(const u32x4*)(U + (size_t)id * D + lane * 16); }
#pragma unroll
                for (int g = 0; g < 64 / PGS; ++g) {
                    if (g < 64 / PGS - 1) {
#pragma unroll
                        for (int i = 0; i < PGS; ++i) { const int id = __builtin_amdgcn_readlane(eidv, (g + 1) * PGS + i); qb[(g + 1) & 1][i] = *(const u32x4*)(U + (size_t)id * D + lane * 16); }
                    }
                    asm volatile("" ::: "memory");
#pragma unroll
                    for (int i = 0; i < PGS; ++i) {
                        float a = 0.f;
#pragma unroll
                        for (int w = 0; w < 4; ++w) { const f32x2v lo = __builtin_amdgcn_cvt_pk_f32_fp8((int)qb[g & 1][i][w], false), hi = __builtin_amdgcn_cvt_pk_f32_fp8((int)qb[g & 1][i][w], true);
                            a = fmaf(lo[0], xf[w * 4], a); a = fmaf(lo[1], xf[w * 4 + 1], a); a = fmaf(hi[0], xf[w * 4 + 2], a); a = fmaf(hi[1], xf[w * 4 + 3], a); }
                        p[g * PGS + i] = a;
                        __builtin_amdgcn_sched_barrier(0);
                    }
                }
                TPE(20); TPB(21);
#pragma unroll
                for (int o = 32; o >= 1; o >>= 1) {
                    const bool up = (lane & o) != 0;
#pragma unroll
                    for (int i = 0; i < o; ++i) { const float keep = up ? p[i + o] : p[i], send = up ? p[i] : p[i + o]; p[i] = keep + __shfl_xor(send, o); }
                }
                const float hdot = p[0] * Us[eidv];
                const float wv = 0.5f * hdot * (1.f + erff(hdot * 0.70710678118654752f)) * tgate[tok * 128 + bt * 64 + lane] * Vs[eidv];
                if (bt == 0) wv0 = wv; else wv1 = wv;
                TPE(21);
            }
            TPB(22);
            float y[16];
#pragma unroll
            for (int i = 0; i < 16; ++i) y[i] = 0.f;
#pragma unroll 1
            for (int bt = 0; bt < 2; ++bt) {
                const int eidv = (int)teid[tok * 128 + bt * 64 + lane]; const float wvv = bt == 0 ? wv0 : wv1;
                u32x4 qb[2][PGS];
#pragma unroll
                for (int i = 0; i < PGS; ++i) { const int id = __builtin_amdgcn_readlane(eidv, i); qb[0][i] = *(const u32x4*)(V + (size_t)id * D + lane * 16); }
#pragma unroll
                for (int g = 0; g < 64 / PGS; ++g) {
                    if (g < 64 / PGS - 1) {
#pragma unroll
                        for (int i = 0; i < PGS; ++i) { const int id = __builtin_amdgcn_readlane(eidv, (g + 1) * PGS + i); qb[(g + 1) & 1][i] = *(const u32x4*)(V + (size_t)id * D + lane * 16); }
                    }
                    asm volatile("" ::: "memory");
#pragma unroll
                    for (int i = 0; i < PGS; ++i) {
                        const float w = __builtin_bit_cast(float, __builtin_amdgcn_readlane(__builtin_bit_cast(int, wvv), g * PGS + i));
                        asm volatile("" : "+v"(qb[g & 1][i][0]), "+v"(qb[g & 1][i][1]), "+v"(qb[g & 1][i][2]), "+v"(qb[g & 1][i][3]));
#pragma unroll
                        for (int k = 0; k < 4; ++k) { const f32x2v lo = __builtin_amdgcn_cvt_pk_f32_fp8((int)qb[g & 1][i][k], false), hi = __builtin_amdgcn_cvt_pk_f32_fp8((int)qb[g & 1][i][k], true);
                            y[k * 4] = fmaf(w, lo[0], y[k * 4]); y[k * 4 + 1] = fmaf(w, lo[1], y[k * 4 + 1]); y[k * 4 + 2] = fmaf(w, hi[0], y[k * 4 + 2]); y[k * 4 + 3] = fmaf(w, hi[1], y[k * 4 + 3]); }
                        asm volatile("" : "+v"(y[0]), "+v"(y[1]), "+v"(y[2]), "+v"(y[3]), "+v"(y[4]), "+v"(y[5]), "+v"(y[6]), "+v"(y[7]), "+v"(y[8]), "+v"(y[9]), "+v"(y[10]), "+v"(y[11]), "+v"(y[12]), "+v"(y[13]), "+v"(y[14]), "+v"(y[15]));
                    }
                }
            }
            TPE(22); TPB(23);
            float s = 0.f;
#pragma unroll
            for (int i = 0; i < 16; ++i) { y[i] = ALPHA * xf[i] + y[i]; s += y[i]; }
#pragma unroll
            for (int o = 1; o < 64; o <<= 1) s += __shfl_xor(s, o);
            const float mean = s * (1.f / D); float qq = 0.f;
#pragma unroll
            for (int i = 0; i < 16; ++i) { y[i] -= mean; qq += y[i] * y[i]; }
#pragma unroll
            for (int o = 1; o < 64; o <<= 1) qq += __shfl_xor(qq, o);
            const float rstd = rsqrtf(qq * (1.f / D) + LN_EPS);
            u32x4 ob0, ob1;
#pragma unroll
            for (int q = 0; q < 4; ++q) { const int col = lane * 16 + q * 4; const f32x4 gg = *(const f32x4*)(g2 + col), bb = *(const f32x4*)(b2 + col);
                f32x4 o;
#pragma unroll
                for (int i = 0; i < 4; ++i) o[i] = y[q * 4 + i] * rstd * gg[i] + bb[i];
                *(f32x4*)(outf + tok * D + col) = o;
                const unsigned w0 = pk2(o[0], o[1]), w1 = pk2(o[2], o[3]);
                if (q == 0) { ob0.x = w0; ob0.y = w1; } else if (q == 1) { ob0.z = w0; ob0.w = w1; } else if (q == 2) { ob1.x = w0; ob1.y = w1; } else { ob1.z = w0; ob1.w = w1; } }
            if (outb) { *(u32x4*)(outb + tok * D + lane * 16) = ob0; *(u32x4*)(outb + tok * D + lane * 16 + 8) = ob1; }
            TPE(23);
        }
    }
    TPE(24);
#if defined(PROBE_REGION)
    if (PROBE_REGION >= 20 && PROBE_REGION <= 24 && gw == PROBE_WAVE && lane == 0 && outb != nullptr) g_probe_acc = tacc;
#endif
}

__device__ __forceinline__ float peer_reduce16(float (&p)[16], int lane) {
#pragma unroll
    for (int o = 8; o >= 1; o >>= 1) { const bool up = (lane & (o * 4)) != 0;
#pragma unroll
        for (int k = 0; k < o; ++k) { const float keep = up ? p[k + o] : p[k], send = up ? p[k] : p[k + o]; p[k] = keep + __shfl_xor(send, o * 4); } }
    float tot = p[0];
    tot += __shfl_xor(tot, 2); tot += __shfl_xor(tot, 1);
    return tot;
}
__device__ __forceinline__ unsigned cvtpk_bf16_(float lo, float hi) { typedef __bf16 bf2 __attribute__((ext_vector_type(2))); f32x2v v = {lo, hi}; bf2 b = __builtin_convertvector(v, bf2); return __builtin_bit_cast(unsigned, b); }
__device__ __forceinline__ float peer_dot16b(const u32x4 q, const u32x4 x0, const u32x4 x1) {
    float a = 0.f;
#pragma unroll
    for (int w = 0; w < 4; ++w) { const f32x2v lo = __builtin_amdgcn_cvt_pk_f32_fp8((int)q[w], false), hi = __builtin_amdgcn_cvt_pk_f32_fp8((int)q[w], true);
        const unsigned xa = w < 2 ? x0[2 * w] : x1[2 * w - 4], xb = w < 2 ? x0[2 * w + 1] : x1[2 * w - 3];
        a = dot2bf(cvtpk_bf16_(lo[0], lo[1]), xa, a); a = dot2bf(cvtpk_bf16_(hi[0], hi[1]), xb, a); }
    return a;
}

__device__ __forceinline__ void peer_u_slice(int sl, int t_first, int t_step, const bf16* __restrict__ Hb, const unsigned short* __restrict__ teid, const unsigned char* __restrict__ U, const float* __restrict__ Us,
                                             float* __restrict__ HD, LAS unsigned char* wl, int lane) {
    LAS unsigned short* lst_e = (LAS unsigned short*)wl;
    LAS unsigned char* lst_s = wl + 256;
    const unsigned long long below = (1ull << lane) - 1ull;
    const int kk = (lane >> 2) & 15;
    if (t_first >= TA) return;
    int e0 = teid[(size_t)t_first * 128 + lane], e1 = teid[(size_t)t_first * 128 + 64 + lane];
    u32x4 x0 = *(const u32x4*)(Hb + (size_t)t_first * D + lane * 16), x1 = *(const u32x4*)(Hb + (size_t)t_first * D + lane * 16 + 8);
    for (int t = t_first; t < TA; t += t_step) {
        const bool a0 = (e0 >> 11) == sl, a1 = (e1 >> 11) == sl;
        const unsigned long long m0 = __ballot(a0), m1 = __ballot(a1);
        const int c0 = __builtin_popcountll(m0), cn = c0 + __builtin_popcountll(m1);
        if (a0) { const int p = __builtin_popcountll(m0 & below); lst_e[p] = (unsigned short)e0; lst_s[p] = (unsigned char)lane; }
        if (a1) { const int p = c0 + __builtin_popcountll(m1 & below); lst_e[p] = (unsigned short)e1; lst_s[p] = (unsigned char)(64 + lane); }
        const u32x4 xc0 = x0, xc1 = x1;
        const int tn = t + t_step;
        if (tn < TA) { e0 = teid[(size_t)tn * 128 + lane]; e1 = teid[(size_t)tn * 128 + 64 + lane]; x0 = *(const u32x4*)(Hb + (size_t)tn * D + lane * 16); x1 = *(const u32x4*)(Hb + (size_t)tn * D + lane * 16 + 8); }
        asm volatile("s_waitcnt lgkmcnt(0)" ::: "memory");
#pragma unroll 1
        for (int p0 = 0; p0 < cn; p0 += 16) {
            u32x4 q[16];
#pragma unroll
            for (int k = 0; k < 16; ++k) { if (p0 + k < cn) { const int id = __builtin_amdgcn_readfirstlane((int)lst_e[p0 + k]); q[k] = *(const u32x4*)(U + (size_t)id * D + lane * 16); } }
            float pr[16];
#pragma unroll
            for (int k = 0; k < 16; ++k) pr[k] = p0 + k < cn ? peer_dot16b(q[k], xc0, xc1) : 0.f;
            const float tot = peer_reduce16(pr, lane);
            if (p0 + kk < cn && (lane & 3) == 0) { const int id = lst_e[p0 + kk]; HD[(size_t)t * 128 + lst_s[p0 + kk]] = tot * Us[id]; }
        }
        asm volatile("s_waitcnt lgkmcnt(0)" ::: "memory");
    }
}

__device__ __forceinline__ void phase_peer_mixv(const float* __restrict__ Hf, const unsigned short* __restrict__ teid, const float* __restrict__ tgate, const float* __restrict__ HD,
                                                const unsigned char* __restrict__ V, const float* __restrict__ Vs, const float* __restrict__ g2, const float* __restrict__ b2,
                                                float* __restrict__ outf, bf16* __restrict__ outb, int gw, int NGW, int lane) {
    for (int j = gw; j < TP + TS * 16; j += NGW) {
        size_t tok;
        if (j < TP) tok = (size_t)j;
        else { const int s = j - TP; if ((s & 15) != 0) continue; tok = (size_t)TP + (s >> 4); }
        float xf[16];
#pragma unroll
        for (int q = 0; q < 4; ++q) { const f32x4 r = *(const f32x4*)(Hf + tok * D + lane * 16 + q * 4); xf[q * 4] = r[0]; xf[q * 4 + 1] = r[1]; xf[q * 4 + 2] = r[2]; xf[q * 4 + 3] = r[3]; }
        float y[16];
#pragma unroll
        for (int i = 0; i < 16; ++i) y[i] = 0.f;
#pragma unroll 1
        for (int bt = 0; bt < 2; ++bt) {
            const int eidv = (int)teid[tok * 128 + bt * 64 + lane];
            const float hd = HD[tok * 128 + bt * 64 + lane];
            const float wvv = 0.5f * hd * (1.f + erff(hd * 0.70710678118654752f)) * tgate[tok * 128 + bt * 64 + lane] * Vs[eidv];
            u32x4 qb[2][PGS];
#pragma unroll
            for (int i = 0; i < PGS; ++i) { const int id = __builtin_amdgcn_readlane(eidv, i); qb[0][i] = *(const u32x4*)(V + (size_t)id * D + lane * 16); }
#pragma unroll
            for (int g = 0; g < 64 / PGS; ++g) {
                if (g < 64 / PGS - 1) {
#pragma unroll
                    for (int i = 0; i < PGS; ++i) { const int id = __builtin_amdgcn_readlane(eidv, (g + 1) * PGS + i); qb[(g + 1) & 1][i] = *(const u32x4*)(V + (size_t)id * D + lane * 16); }
                }
                asm volatile("" ::: "memory");
#pragma unroll
                for (int i = 0; i < PGS; ++i) {
                    const float w = __builtin_bit_cast(float, __builtin_amdgcn_readlane(__builtin_bit_cast(int, wvv), g * PGS + i));
                    asm volatile("" : "+v"(qb[g & 1][i][0]), "+v"(qb[g & 1][i][1]), "+v"(qb[g & 1][i][2]), "+v"(qb[g & 1][i][3]));
#pragma unroll
                    for (int k = 0; k < 4; ++k) { const f32x2v lo = __builtin_amdgcn_cvt_pk_f32_fp8((int)qb[g & 1][i][k], false), hi = __builtin_amdgcn_cvt_pk_f32_fp8((int)qb[g & 1][i][k], true);
                        y[k * 4] = fmaf(w, lo[0], y[k * 4]); y[k * 4 + 1] = fmaf(w, lo[1], y[k * 4 + 1]); y[k * 4 + 2] = fmaf(w, hi[0], y[k * 4 + 2]); y[k * 4 + 3] = fmaf(w, hi[1], y[k * 4 + 3]); }
                    asm volatile("" : "+v"(y[0]), "+v"(y[1]), "+v"(y[2]), "+v"(y[3]), "+v"(y[4]), "+v"(y[5]), "+v"(y[6]), "+v"(y[7]), "+v"(y[8]), "+v"(y[9]), "+v"(y[10]), "+v"(y[11]), "+v"(y[12]), "+v"(y[13]), "+v"(y[14]), "+v"(y[15]));
                }
            }
        }
        float s = 0.f;
#pragma unroll
        for (int i = 0; i < 16; ++i) { y[i] = ALPHA * xf[i] + y[i]; s += y[i]; }
#pragma unroll
        for (int o = 1; o < 64; o <<= 1) s += __shfl_xor(s, o);
        const float mean = s * (1.f / D); float qq = 0.f;
#pragma unroll
        for (int i = 0; i < 16; ++i) { y[i] -= mean; qq += y[i] * y[i]; }
#pragma unroll
        for (int o = 1; o < 64; o <<= 1) qq += __shfl_xor(qq, o);
        const float rstd = rsqrtf(qq * (1.f / D) + LN_EPS);
        u32x4 ob0, ob1;
#pragma unroll
        for (int q = 0; q < 4; ++q) { const int col = lane * 16 + q * 4; const f32x4 gg = *(const f32x4*)(g2 + col), bb = *(const f32x4*)(b2 + col);
            f32x4 o;
#pragma unroll
            for (int i = 0; i < 4; ++i) o[i] = y[q * 4 + i] * rstd * gg[i] + bb[i];
            *(f32x4*)(outf + tok * D + col) = o;
            const unsigned w0 = pk2(o[0], o[1]), w1 = pk2(o[2], o[3]);
            if (q == 0) { ob0.x = w0; ob0.y = w1; } else if (q == 1) { ob0.z = w0; ob0.w = w1; } else if (q == 2) { ob1.x = w0; ob1.y = w1; } else { ob1.z = w0; ob1.w = w1; } }
        if (outb) { *(u32x4*)(outb + tok * D + lane * 16) = ob0; *(u32x4*)(outb + tok * D + lane * 16 + 8) = ob1; }
    }
}
}

namespace mk {
__device__ __forceinline__ unsigned cvtpk_bf16(float lo, float hi) { typedef __bf16 bf2 __attribute__((ext_vector_type(2))); f32x2v v = {lo, hi}; bf2 b = __builtin_convertvector(v, bf2); return __builtin_bit_cast(unsigned, b); }
__device__ __forceinline__ float peer_dot16(const u32x4 q, const unsigned (&xp)[8]) {
    float a = 0.f;
#pragma unroll
    for (int w = 0; w < 4; ++w) { const f32x2v lo = __builtin_amdgcn_cvt_pk_f32_fp8((int)q[w], false), hi = __builtin_amdgcn_cvt_pk_f32_fp8((int)q[w], true);
        a = dot2bf(cvtpk_bf16(lo[0], lo[1]), xp[2 * w], a); a = dot2bf(cvtpk_bf16(hi[0], hi[1]), xp[2 * w + 1], a); }
    return a;
}
__device__ __forceinline__ void peer_axpy16(const u32x4 q, float w, float (&y)[16]) {
#pragma unroll
    for (int k = 0; k < 4; ++k) { const f32x2v lo = __builtin_amdgcn_cvt_pk_f32_fp8((int)q[k], false), hi = __builtin_amdgcn_cvt_pk_f32_fp8((int)q[k], true);
        y[k * 4] = fmaf(w, lo[0], y[k * 4]); y[k * 4 + 1] = fmaf(w, lo[1], y[k * 4 + 1]); y[k * 4 + 2] = fmaf(w, hi[0], y[k * 4 + 2]); y[k * 4 + 3] = fmaf(w, hi[1], y[k * 4 + 3]); }
}
constexpr int NTB = 4;
constexpr int PCH = 4, PNC = 6;

__device__ __forceinline__ float peer_reduce4(float (&p)[4], int lane) {
#pragma unroll
    for (int o = 2; o >= 1; o >>= 1) { const bool up = (lane & (o * 16)) != 0;
#pragma unroll
        for (int k = 0; k < o; ++k) { const float keep = up ? p[k + o] : p[k], send = up ? p[k] : p[k + o]; p[k] = keep + __shfl_xor(send, o * 16); } }
    float tot = p[0];
    tot += __shfl_xor(tot, 8); tot += __shfl_xor(tot, 4); tot += __shfl_xor(tot, 2); tot += __shfl_xor(tot, 1);
    return tot;
}

__device__ __forceinline__ void peer_mix_batch(size_t t0, size_t tstride, int nt, const float* __restrict__ Hf, const bf16* __restrict__ Hb, const unsigned short* __restrict__ teid, const float* __restrict__ tgate,
                                               const unsigned char* __restrict__ U, const unsigned char* __restrict__ V, const float* __restrict__ Us, const float* __restrict__ Vs,
                                               const float* __restrict__ g2, const float* __restrict__ b2, float* __restrict__ outf, bf16* __restrict__ outb, LAS unsigned char* wl, int lane) {
    LAS unsigned short* seid = (LAS unsigned short*)wl;
    LAS float* gv = (LAS float*)(wl + 2048);
    LAS float* hs = (LAS float*)(wl + 6144);
    LAS int* goff = (LAS int*)(wl + 10240);
    const unsigned long long below = (1ull << lane) - 1ull;
    const int kk = (lane >> 4) & 3;
    for (int i = 0; i < nt; ++i) {
        const size_t tok = t0 + (size_t)i * tstride;
        const int e0 = teid[tok * 128 + lane], e1 = teid[tok * 128 + 64 + lane];
        const float g0 = tgate[tok * 128 + lane] * Vs[e0], g1 = tgate[tok * 128 + 64 + lane] * Vs[e1], u0 = Us[e0], u1 = Us[e1];
        int base = 0;
        if (lane == 0) goff[i * 12] = 0;
#pragma unroll
        for (int g = 0; g < 8; ++g) {
            const bool a0 = (e0 >> 11) == g, a1 = (e1 >> 11) == g;
            const unsigned long long m0 = __ballot(a0), m1 = __ballot(a1);
            if (a0) { const int p = base + __builtin_popcountll(m0 & below); seid[i * 128 + p] = (unsigned short)e0; gv[i * 128 + p] = g0; hs[i * 128 + p] = u0; }
            base += __builtin_popcountll(m0);
            if (a1) { const int p = base + __builtin_popcountll(m1 & below); seid[i * 128 + p] = (unsigned short)e1; gv[i * 128 + p] = g1; hs[i * 128 + p] = u1; }
            base += __builtin_popcountll(m1);
            if (lane == 0) goff[i * 12 + g + 1] = base;
        }
    }
    asm volatile("s_waitcnt lgkmcnt(0)" ::: "memory");
    {
        unsigned xf[NTB][8];
#pragma unroll
        for (int i = 0; i < NTB; ++i) {
            if (i < nt) { const bf16* xr = Hb + (t0 + (size_t)i * tstride) * D + lane * 16; const u32x4 r0 = *(const u32x4*)xr, r1 = *(const u32x4*)(xr + 8);
                xf[i][0] = r0.x; xf[i][1] = r0.y; xf[i][2] = r0.z; xf[i][3] = r0.w; xf[i][4] = r1.x; xf[i][5] = r1.y; xf[i][6] = r1.z; xf[i][7] = r1.w; }
            else {
#pragma unroll
                for (int q = 0; q < 8; ++q) xf[i][q] = 0u; }
        }
#pragma unroll 1
        for (int g = 0; g < 8; ++g) {
            int sg[NTB], eg[NTB];
#pragma unroll
            for (int i = 0; i < NTB; ++i) { sg[i] = __builtin_amdgcn_readfirstlane(goff[i * 12 + g]); eg[i] = i < nt ? __builtin_amdgcn_readfirstlane(goff[i * 12 + g + 1]) : sg[i]; }
            u32x4 qb[2][PCH];
#define PM_ULOAD(par, i, pos0) do { _Pragma("unroll") for (int k = 0; k < PCH; ++k) { if ((pos0) + k < eg[i]) { const int id = __builtin_amdgcn_readfirstlane((int)seid[(i) * 128 + (pos0) + k]); qb[par][k] = *(const u32x4*)(U + (size_t)id * D + lane * 16); } } } while (0)
#define PM_UCOMP(par, i, pos0) do { if ((pos0) < eg[i]) { float p[PCH]; _Pragma("unroll") for (int k = 0; k < PCH; ++k) p[k] = (pos0) + k < eg[i] ? peer_dot16(qb[par][k], xf[i]) : 0.f; \
            const float tot = peer_reduce4(p, lane); if ((pos0) + kk < eg[i] && (lane & 15) == 0) hs[(i) * 128 + (pos0) + kk] *= tot; } } while (0)
            PM_ULOAD(0, 0, sg[0]);
#define PM_UTOKEN(I) do { _Pragma("unroll") for (int c = 0; c < PNC; ++c) { \
                if (c + 1 < PNC) PM_ULOAD(((I) * PNC + c + 1) & 1, (I), sg[(I)] + (c + 1) * PCH); else if ((I) + 1 < NTB) PM_ULOAD(((I) * PNC + c + 1) & 1, ((I) + 1) % NTB, sg[((I) + 1) % NTB]); \
                asm volatile("" ::: "memory"); PM_UCOMP(((I) * PNC + c) & 1, (I), sg[(I)] + c * PCH); } } while (0)
            PM_UTOKEN(0); PM_UTOKEN(1); PM_UTOKEN(2); PM_UTOKEN(3);
#undef PM_UTOKEN
#pragma unroll
            for (int i = 0; i < NTB; ++i) {
#pragma unroll 1
                for (int pos = sg[i] + PNC * PCH; pos < eg[i]; pos += PCH) { PM_ULOAD(0, i, pos); PM_UCOMP(0, i, pos); }
            }
#undef PM_ULOAD
#undef PM_UCOMP
        }
    }
    asm volatile("s_waitcnt lgkmcnt(0)" ::: "memory");
    for (int i = 0; i < nt; ++i) {
#pragma unroll
        for (int hlf = 0; hlf < 2; ++hlf) { const int p = i * 128 + hlf * 64 + lane; const float hd = hs[p]; gv[p] *= 0.5f * hd * (1.f + erff(hd * 0.70710678118654752f)); }
    }
    asm volatile("s_waitcnt lgkmcnt(0)" ::: "memory");
    float y[NTB][16];
#pragma unroll
    for (int i = 0; i < NTB; ++i)
#pragma unroll
        for (int q = 0; q < 16; ++q) y[i][q] = 0.f;
#pragma unroll 1
    for (int g = 0; g < 8; ++g) {
        int sg[NTB], eg[NTB];
#pragma unroll
        for (int i = 0; i < NTB; ++i) { sg[i] = __builtin_amdgcn_readfirstlane(goff[i * 12 + g]); eg[i] = i < nt ? __builtin_amdgcn_readfirstlane(goff[i * 12 + g + 1]) : sg[i]; }
        u32x4 qb[2][PCH];
#define PM_VLOAD(par, i, pos0) do { _Pragma("unroll") for (int k = 0; k < PCH; ++k) { if ((pos0) + k < eg[i]) { const int id = __builtin_amdgcn_readfirstlane((int)seid[(i) * 128 + (pos0) + k]); qb[par][k] = *(const u32x4*)(V + (size_t)id * D + lane * 16); } } } while (0)
#define PM_VCOMP(par, i, pos0) do { _Pragma("unroll") for (int k = 0; k < PCH; ++k) { if ((pos0) + k < eg[i]) { const float w = __builtin_bit_cast(float, __builtin_amdgcn_readfirstlane(__builtin_bit_cast(int, gv[(i) * 128 + (pos0) + k]))); \
            asm volatile("" : "+v"(qb[par][k][0]), "+v"(qb[par][k][1]), "+v"(qb[par][k][2]), "+v"(qb[par][k][3])); peer_axpy16(qb[par][k], w, y[i]); } } } while (0)
        PM_VLOAD(0, 0, sg[0]);
#define PM_VTOKEN(I) do { _Pragma("unroll") for (int c = 0; c < PNC; ++c) { \
            if (c + 1 < PNC) PM_VLOAD(((I) * PNC + c + 1) & 1, (I), sg[(I)] + (c + 1) * PCH); else if ((I) + 1 < NTB) PM_VLOAD(((I) * PNC + c + 1) & 1, ((I) + 1) % NTB, sg[((I) + 1) % NTB]); \
            asm volatile("" ::: "memory"); PM_VCOMP(((I) * PNC + c) & 1, (I), sg[(I)] + c * PCH); } } while (0)
        PM_VTOKEN(0); PM_VTOKEN(1); PM_VTOKEN(2); PM_VTOKEN(3);
#undef PM_VTOKEN
#pragma unroll
        for (int i = 0; i < NTB; ++i) {
#pragma unroll 1
            for (int pos = sg[i] + PNC * PCH; pos < eg[i]; pos += PCH) { PM_VLOAD(0, i, pos); PM_VCOMP(0, i, pos); }
        }
#undef PM_VLOAD
#undef PM_VCOMP
    }
#pragma unroll
    for (int i = 0; i < NTB; ++i) {
        if (i < nt) {
            const size_t tok = t0 + (size_t)i * tstride; const float* xr = Hf + tok * D + lane * 16; float s = 0.f;
#pragma unroll
            for (int q = 0; q < 4; ++q) { const f32x4 r = *(const f32x4*)(xr + q * 4);
#pragma unroll
                for (int c = 0; c < 4; ++c) { y[i][q * 4 + c] = ALPHA * r[c] + y[i][q * 4 + c]; s += y[i][q * 4 + c]; } }
#pragma unroll
            for (int o = 1; o < 64; o <<= 1) s += __shfl_xor(s, o);
            const float mean = s * (1.f / D); float qq = 0.f;
#pragma unroll
            for (int c = 0; c < 16; ++c) { y[i][c] -= mean; qq += y[i][c] * y[i][c]; }
#pragma unroll
            for (int o = 1; o < 64; o <<= 1) qq += __shfl_xor(qq, o);
            const float rstd = rsqrtf(qq * (1.f / D) + LN_EPS);
            u32x4 ob0, ob1;
#pragma unroll
            for (int q = 0; q < 4; ++q) { const int col = lane * 16 + q * 4; const f32x4 gg = *(const f32x4*)(g2 + col), bb = *(const f32x4*)(b2 + col);
                f32x4 o;
#pragma unroll
                for (int c = 0; c < 4; ++c) o[c] = y[i][q * 4 + c] * rstd * gg[c] + bb[c];
                *(f32x4*)(outf + tok * D + col) = o;
                const unsigned w0 = pk2(o[0], o[1]), w1 = pk2(o[2], o[3]);
                if (q == 0) { ob0.x = w0; ob0.y = w1; } else if (q == 1) { ob0.z = w0; ob0.w = w1; } else if (q == 2) { ob1.x = w0; ob1.y = w1; } else { ob1.z = w0; ob1.w = w1; } }
            if (outb) { *(u32x4*)(outb + tok * D + lane * 16) = ob0; *(u32x4*)(outb + tok * D + lane * 16 + 8) = ob1; }
        }
    }
    asm volatile("s_waitcnt lgkmcnt(0)" ::: "memory");
}

__device__ __forceinline__ void phase_peer_mix2(const float* __restrict__ Hf, const bf16* __restrict__ Hb, const unsigned short* __restrict__ teid, const float* __restrict__ tgate,
                                                const unsigned char* __restrict__ U, const unsigned char* __restrict__ V, const float* __restrict__ Us, const float* __restrict__ Vs, const float* __restrict__ g2, const float* __restrict__ b2,
                                                float* __restrict__ outf, bf16* __restrict__ outb, LAS unsigned char* lds, int wave, int gw, int NGW, int lane) {
    LAS unsigned char* wl = lds + wave * 16384;
    for (size_t t0 = (size_t)gw; t0 < (size_t)TP; t0 += (size_t)NTB * NGW) {
        const size_t left = ((size_t)TP - t0 + NGW - 1) / NGW; const int nt = left < NTB ? (int)left : NTB;
        peer_mix_batch(t0, (size_t)NGW, nt, Hf, Hb, teid, tgate, U, V, Us, Vs, g2, b2, outf, outb, wl, lane);
    }
    for (int s = gw; s < TS * 16; s += NGW) {
        if ((s & 15) == 0) peer_mix_batch((size_t)TP + (s >> 4), 0, 1, Hf, Hb, teid, tgate, U, V, Us, Vs, g2, b2, outf, outb, wl, lane);
    }
}
}

namespace mk {
struct FGlaIn {
    bf16 *Gq, *Gk, *Gv, *Gr; float* GD;
    __device__ __forceinline__ static float silu(float r) { return r / (1.f + __expf(-r)); }
    __device__ __forceinline__ void put8(int row, int col, f32x4 v0, f32x4 v1) const {
        if (col < GN_K) *(u32x4*)(Gq + (size_t)row * 512 + col) = pack8(v0, v1);
        else if (col < GN_V) *(u32x4*)(Gk + (size_t)row * 512 + (col - GN_K)) = pack8(v0, v1);
        else if (col < GN_R) *(u32x4*)(Gv + (size_t)row * 1024 + (col - GN_V)) = pack8(v0, v1);
        else { f32x4 a, b;
#pragma unroll
            for (int i = 0; i < 4; ++i) { a[i] = silu(v0[i]); b[i] = silu(v1[i]); }
            *(u32x4*)(Gr + (size_t)row * 1024 + (col - GN_R)) = pack8(a, b); }
    }
    __device__ __forceinline__ void put4(int row, int col, f32x4 v) const {
        u32x2 w; w.x = pk2(v[0], v[1]); w.y = pk2(v[2], v[3]);
        if (col < GN_K) *(u32x2*)(Gq + (size_t)row * 512 + col) = w;
        else if (col < GN_V) *(u32x2*)(Gk + (size_t)row * 512 + (col - GN_K)) = w;
        else if (col < GN_R) *(u32x2*)(Gv + (size_t)row * 1024 + (col - GN_V)) = w;
        else if (col < GN_GD) { u32x2 s; s.x = pk2(silu(v[0]), silu(v[1])); s.y = pk2(silu(v[2]), silu(v[3])); *(u32x2*)(Gr + (size_t)row * 1024 + (col - GN_R)) = s; }
        else if (col < GN_GD + 16) *(f32x4*)(GD + (size_t)row * 16 + (col - GN_GD)) = v;
    }
};

__device__ __forceinline__ float log_sigmoid_f(float x) { return fminf(x, 0.f) - log1pf(__expf(-fabsf(x))); }
__device__ __forceinline__ bf16x8 tr8(LAS unsigned char* a0, LAS unsigned char* a1) { const s16x4 v0 = lds_tr(a0), v1 = lds_tr(a1); bf16x8 r; r[0] = v0[0]; r[1] = v0[1]; r[2] = v0[2]; r[3] = v0[3]; r[4] = v1[0]; r[5] = v1[1]; r[6] = v1[2]; r[7] = v1[3]; return r; }

constexpr int KD_ST = 272, V_ST = 528;
constexpr int GL_LB = 0, GL_TOT = 32768, GL_KD = 36864, GL_V = GL_KD + 64 * KD_ST  , GL_END = GL_V + 64 * V_ST;
static_assert(GL_END <= RING_BYTES, "GLA chunk LDS");

__device__ __forceinline__ void gla_chunk_item(int item, const bf16* __restrict__ Gq, const bf16* __restrict__ Gk, const bf16* __restrict__ Gv, const float* __restrict__ GD,
                                               const float* __restrict__ Wgu, const float* __restrict__ bg, bf16* __restrict__ QT, bf16* __restrict__ KT, float* __restrict__ DEC, float* __restrict__ DS,
                                               LAS unsigned char* lds, int tid, int wave, int lane) {
    const int h = item & 3, bc = item >> 2;
    const size_t tok0 = (size_t)bc * 64;
    LAS float* LB = (LAS float*)(lds + GL_LB);
    LAS float* TOT = (LAS float*)(lds + GL_TOT);
    const int d = tid & 127, tq = tid >> 7;
    float wg[16];
#pragma unroll
    for (int r = 0; r < 16; ++r) wg[r] = Wgu[r * 512 + h * 128 + d];
    const float bgd = bg[h * 128 + d];
    float pre[16]; float run = 0.f;
#pragma unroll
    for (int i = 0; i < 16; ++i) {
        const float* gd = GD + (tok0 + tq * 16 + i) * 16;
        const f32x4 g0 = *(const f32x4*)gd, g1 = *(const f32x4*)(gd + 4), g2 = *(const f32x4*)(gd + 8), g3 = *(const f32x4*)(gd + 12);
        float x = 0.f;
#pragma unroll
        for (int r = 0; r < 4; ++r) { x = fmaf(g0[r], wg[r], x); }
#pragma unroll
        for (int r = 0; r < 4; ++r) { x = fmaf(g1[r], wg[4 + r], x); }
#pragma unroll
        for (int r = 0; r < 4; ++r) { x = fmaf(g2[r], wg[8 + r], x); }
#pragma unroll
        for (int r = 0; r < 4; ++r) { x = fmaf(g3[r], wg[12 + r], x); }
        run += log_sigmoid_f(x + bgd) * (1.f / 16.f); pre[i] = run;
    }
    TOT[tq * 128 + d] = run;
    __syncthreads();
    float off = 0.f;
#pragma unroll
    for (int q = 0; q < 3; ++q) if (q < tq) off += TOT[q * 128 + d];
    const float bC = (TOT[d] + TOT[128 + d]) + (TOT[256 + d] + TOT[384 + d]);
#pragma unroll
    for (int i = 0; i < 16; ++i) {
        const int t = tq * 16 + i; const float b = pre[i] + off; const size_t tok = tok0 + t;
        const float q = bf2f(Gq[tok * 512 + h * 128 + d]), k = bf2f(Gk[tok * 512 + h * 128 + d]);
        QT[tok * 512 + h * 128 + d] = (bf16)f2bf(q * 0.08838834764831845f * __expf(b));
        KT[tok * 512 + h * 128 + d] = (bf16)f2bf(k * __expf(-b));
        *(LAS bf16*)(lds + GL_KD + t * KD_ST + d * 2) = (bf16)f2bf(k * __expf(bC - b));
    }
    if (tq == 0) DEC[(size_t)item * 128 + d] = __expf(bC);
#pragma unroll
    for (int p = 0; p < 4; ++p) { const int e = tid + p * 512, s = e >> 5, ch = e & 31;
        *(LAS u32x4*)(lds + GL_V + s * V_ST + ch * 16) = *(const u32x4*)(Gv + (tok0 + s) * 1024 + h * 256 + ch * 8); }
    __syncthreads();
    const int fr = lane & 15, fq = lane >> 4, dt = wave;
    bf16x8 af[2];
#pragma unroll
    for (int ks = 0; ks < 2; ++ks) { LAS unsigned char* a0 = lds + GL_KD + (ks * 32 + fq * 8 + (fr >> 2)) * KD_ST + (dt * 16 + 4 * (fr & 3)) * 2; af[ks] = tr8(a0, a0 + 4 * KD_ST); }
    float* dsb = DS + (size_t)item * 256 * 128;
#pragma unroll 4
    for (int vt = 0; vt < 16; ++vt) {
        f32x4 acc = (f32x4){0.f, 0.f, 0.f, 0.f};
#pragma unroll
        for (int ks = 0; ks < 2; ++ks) { LAS unsigned char* b0 = lds + GL_V + (ks * 32 + fq * 8 + (fr >> 2)) * V_ST + (vt * 16 + 4 * (fr & 3)) * 2; const bf16x8 bf = tr8(b0, b0 + 4 * V_ST);
            acc = __builtin_amdgcn_mfma_f32_16x16x32_bf16(af[ks], bf, acc, 0, 0, 0); }
        *(f32x4*)(dsb + (size_t)(vt * 16 + fr) * 128 + dt * 16 + fq * 4) = acc;
    }
    __syncthreads();
}

__device__ __forceinline__ void gla_sample_item(int item, const bf16* __restrict__ Gq, const bf16* __restrict__ Gk, const bf16* __restrict__ Gv, const bf16* __restrict__ Gr, const float* __restrict__ GD,
                                                const float* __restrict__ Wgu, const float* __restrict__ bg, const float* __restrict__ ng, const float* __restrict__ S0, float* __restrict__ Sout, bf16* __restrict__ OGb,
                                                LAS unsigned char* lds, int tid, int lane) {
    const int b = item >> 2, h = item & 3;
    LAS float* A = (LAS float*)lds;
    LAS float* Qs = A + 512; LAS float* Ks = Qs + 512;
    LAS float* PO = Ks + 512;
    LAS float* RS = PO + 4096;
    { const int t = tid >> 7, d = tid & 127; const size_t tok = (size_t)TP + b * DS + t;
      float x = bg[h * 128 + d]; const float* gd = GD + tok * 16; float xs = 0.f;
#pragma unroll
      for (int r = 0; r < 16; ++r) xs = fmaf(gd[r], Wgu[r * 512 + h * 128 + d], xs);
      x += xs;
      A[t * 128 + d] = __expf(log_sigmoid_f(x) * (1.f / 16.f));
      Qs[t * 128 + d] = bf2f(Gq[tok * 512 + h * 128 + d]) * 0.08838834764831845f; Ks[t * 128 + d] = bf2f(Gk[tok * 512 + h * 128 + d]); }
    __syncthreads();
    const int dq = tid >> 7, d0 = dq * 32;
#pragma unroll 1
    for (int vhalf = 0; vhalf < 2; ++vhalf) {
        const int v = vhalf * 128 + (tid & 127);
        float S[32];
#pragma unroll
        for (int i = 0; i < 32; ++i) S[i] = S0[(((size_t)b * 4 + h) * 128 + d0 + i) * 256 + v];
#pragma unroll 1
        for (int t = 0; t < 4; ++t) {
            const float vv = bf2f(Gv[((size_t)TP + b * DS + t) * 1024 + h * 256 + v]); float o = 0.f;
#pragma unroll
            for (int i = 0; i < 32; ++i) { S[i] = fmaf(A[t * 128 + d0 + i], S[i], Ks[t * 128 + d0 + i] * vv); o = fmaf(Qs[t * 128 + d0 + i], S[i], o); }
            PO[(dq * 4 + t) * 256 + v] = o;
        }
#pragma unroll
        for (int i = 0; i < 32; ++i) Sout[(((size_t)b * 4 + h) * 128 + d0 + i) * 256 + v] = S[i];
    }
    __syncthreads();
    { const int t = tid >> 7, vl = tid & 127; const float o0 = (PO[t * 256 + vl] + PO[(4 + t) * 256 + vl]) + (PO[(8 + t) * 256 + vl] + PO[(12 + t) * 256 + vl]), o1 = (PO[t * 256 + 128 + vl] + PO[(4 + t) * 256 + 128 + vl]) + (PO[(8 + t) * 256 + 128 + vl] + PO[(12 + t) * 256 + 128 + vl]);
      float ss = o0 * o0 + o1 * o1;
#pragma unroll
      for (int o = 1; o < 64; o <<= 1) ss += __shfl_xor(ss, o);
      if (lane == 0) RS[tid >> 6] = ss;
      __syncthreads();
      const float ms = (RS[2 * t] + RS[2 * t + 1]) * (1.f / 256.f), rstd = rsqrtf(ms + LN_EPS);
      const size_t tok = (size_t)TP + b * DS + t;
      OGb[tok * 1024 + h * 256 + vl] = (bf16)f2bf(o0 * rstd * ng[vl] * bf2f(Gr[tok * 1024 + h * 256 + vl]));
      OGb[tok * 1024 + h * 256 + 128 + vl] = (bf16)f2bf(o1 * rstd * ng[128 + vl] * bf2f(Gr[tok * 1024 + h * 256 + 128 + vl])); }
    __syncthreads();
}

__device__ __forceinline__ void gla_scan(const float* __restrict__ DS, const float* __restrict__ DEC, bf16* __restrict__ SP, float* __restrict__ Sout, int gtid, int gthreads) {
    typedef float f32x2 __attribute__((ext_vector_type(2)));
    for (int e = gtid; e < NBATCH * 4 * 256 * 64; e += gthreads) {
        const int d2 = e & 63, v = (e >> 6) & 255, h = (e >> 14) & 3, b = e >> 16;
        f32x2 S = (f32x2){0.f, 0.f};
        for (int c = 0; c < SEQ / 64; ++c) {
            const size_t item = ((size_t)b * (SEQ / 64) + c) * 4 + h;
            const f32x2 ds = *(const f32x2*)(DS + (item * 256 + v) * 128 + d2 * 2), dc = *(const f32x2*)(DEC + item * 128 + d2 * 2);
            *(unsigned*)(SP + (item * 256 + v) * 128 + d2 * 2) = pk2(S[0], S[1]);
            S = dc * S + ds;
        }
        float* so = Sout + (((size_t)b * 4 + h) * 128 + d2 * 2) * 256 + v; so[0] = S[0]; so[256] = S[1];
    }
}

__device__ __forceinline__ void gla_out_item(int item, const bf16* __restrict__ QT, const bf16* __restrict__ KT, const bf16* __restrict__ Gv, const bf16* __restrict__ Gr, const bf16* __restrict__ SP,
                                             const float* __restrict__ ng, bf16* __restrict__ OGb, LAS unsigned char* lds, int tid, int wave, int lane) {
    const int h = item & 3, bc = item >> 2; const size_t tok0 = (size_t)bc * 64;
    const int fr = lane & 15, fq = lane >> 4, tt = wave & 3, vh = wave >> 2;
    LAS float* RS = (LAS float*)(lds + 64 * V_ST);
#pragma unroll
    for (int p = 0; p < 4; ++p) { const int e = tid + p * 512, s = e >> 5, ch = e & 31;
        *(LAS u32x4*)(lds + s * V_ST + ch * 16) = *(const u32x4*)(Gv + (tok0 + s) * 1024 + h * 256 + ch * 8); }
    bf16x8 qf[4];
#pragma unroll
    for (int ks = 0; ks < 4; ++ks) qf[ks] = *(const bf16x8*)(QT + (tok0 + tt * 16 + fr) * 512 + h * 128 + ks * 32 + fq * 8);
    bf16x8 pf[2];
    {
        f32x4 at[4];
#pragma unroll
        for (int st = 0; st < 4; ++st) {
            f32x4 acc = (f32x4){0.f, 0.f, 0.f, 0.f};
#pragma unroll
            for (int ks = 0; ks < 4; ++ks) { const bf16x8 kf = *(const bf16x8*)(KT + (tok0 + st * 16 + fr) * 512 + h * 128 + ks * 32 + fq * 8); acc = __builtin_amdgcn_mfma_f32_16x16x32_bf16(kf, qf[ks], acc, 0, 0, 0); }
#pragma unroll
            for (int j = 0; j < 4; ++j) { const int s = st * 16 + fq * 4 + j, t = tt * 16 + fr; if (s > t) acc[j] = 0.f; }
            at[st] = acc;
        }
        const u32x4 w0 = pack8(at[0], at[1]), w1 = pack8(at[2], at[3]);
        pf[0] = __builtin_bit_cast(bf16x8, w0); pf[1] = __builtin_bit_cast(bf16x8, w1);
    }
    __syncthreads();
    const bf16* spb = SP + (size_t)item * 256 * 128;
    f32x4 oacc[8]; float ss = 0.f;
#pragma unroll
    for (int i = 0; i < 8; ++i) {
        const int vt = vh * 8 + i;
        f32x4 acc = (f32x4){0.f, 0.f, 0.f, 0.f};
#pragma unroll
        for (int k2 = 0; k2 < 2; ++k2) {
            LAS unsigned char* a0 = lds + (k2 * 32 + fq * 4 + (fr >> 2)) * V_ST + (vt * 16 + 4 * (fr & 3)) * 2;
            const bf16x8 vf = tr8(a0, a0 + 16 * V_ST);
            acc = __builtin_amdgcn_mfma_f32_16x16x32_bf16(vf, pf[k2], acc, 0, 0, 0);
        }
#pragma unroll
        for (int ks = 0; ks < 4; ++ks) { const bf16x8 sf = *(const bf16x8*)(spb + (size_t)(vt * 16 + fr) * 128 + ks * 32 + fq * 8); acc = __builtin_amdgcn_mfma_f32_16x16x32_bf16(sf, qf[ks], acc, 0, 0, 0); }
        oacc[i] = acc; ss += (acc[0] * acc[0] + acc[1] * acc[1]) + (acc[2] * acc[2] + acc[3] * acc[3]);
    }
    ss += __shfl_xor(ss, 16); ss += __shfl_xor(ss, 32);
    if (fq == 0) RS[wave * 16 + fr] = ss;
    __syncthreads();
    const float ms = (RS[tt * 16 + fr] + RS[(tt + 4) * 16 + fr]) * (1.f / 256.f), rstd = rsqrtf(ms + LN_EPS);
    const size_t tok = tok0 + tt * 16 + fr;
#pragma unroll
    for (int i = 0; i < 8; ++i) {
        const int v = (vh * 8 + i) * 16 + fq * 4;
        const u32x2 rw = *(const u32x2*)(Gr + tok * 1024 + h * 256 + v); const f32x4 g = *(const f32x4*)(ng + v);
        u32x2 w; w.x = pk2(oacc[i][0] * rstd * g[0] * bflo(rw.x), oacc[i][1] * rstd * g[1] * bfhi(rw.x)); w.y = pk2(oacc[i][2] * rstd * g[2] * bflo(rw.y), oacc[i][3] * rstd * g[3] * bfhi(rw.y));
        *(u32x2*)(OGb + tok * 1024 + h * 256 + v) = w;
    }
    __syncthreads();
}
}

namespace mk {
#ifndef MIX_V2
#define MIX_V1 1
#endif
#if defined(MIX_V1)
#define MIXSEL(Hf, te, tg, U, V, Us, Vs, g2, b2, of, ob, lds, wave, gw, NGW, lane) phase_peer_mix(Hf, te, tg, U, V, Us, Vs, g2, b2, of, ob, gw, NGW, lane)
#define MIX_FROM_Z 1
#else
#define MIXSEL(Hf, te, tg, U, V, Us, Vs, g2, b2, of, ob, lds, wave, gw, NGW, lane) phase_peer_mix2(Hf, H1b, te, tg, U, V, Us, Vs, g2, b2, of, ob, lds, wave, gw, NGW, lane)
#endif
#define PEER_USLICE(Hb_, U_, Us_) do { if (G % 8 == 0) { const int per_ = G / 8; peer_u_slice(vcu / per_, (vcu % per_) * NWAVES + wave, per_ * NWAVES, Hb_, TEID, U_, Us_, HDB, lds + wave * 16384, lane); } \
        else { for (int sl_ = 0; sl_ < 8; ++sl_) peer_u_slice(sl_, gw, NGW, Hb_, TEID, U_, Us_, HDB, lds + wave * 16384, lane); } } while (0)
struct Args {
    const float* in[23]; const int* page_table; float* out; unsigned char* ws; int ph_lo, ph_hi;
};
enum Phase { P_PRO = 0, P_AIN = 1, P_SCORE = 2, P_TOPK = 3, P_ATTN = 4, P_AOUT = 5, P_LN1 = 6, P_PQ0 = 7, P_PEER0 = 8, P_GIN = 9, P_GCH = 10, P_GSC = 11, P_GOUT = 12, P_GPRJ = 13, P_LN1B = 14, P_PQ1 = 15, P_PEER1 = 16, P_COUNT = 17 };

#define Wa ((bf16*)(ws + WS_WA))
#define Wo ((bf16*)(ws + WS_WO))
#define Wg ((bf16*)(ws + WS_WG))
#define Wgo ((bf16*)(ws + WS_WGO))
#define Wpq ((bf16*)(ws + WS_WPQ))
#define PK ((bf16*)(ws + WS_PK))
#define Usc ((float*)(ws + WS_USC))
#define Xb ((bf16*)(ws + WS_XB))
#define Qb ((bf16*)(ws + WS_QB))
#define QIb ((bf16*)(ws + WS_QIB))
#define Kb ((bf16*)(ws + WS_KB))
#define Vb ((bf16*)(ws + WS_VB))
#define KIb ((bf16*)(ws + WS_KIB))
#define WIf ((float*)(ws + WS_WIF))
#define SC ((float*)(ws + WS_SC))
#define SCS ((float*)(ws + WS_SCS))
#define IDX ((int*)(ws + WS_IDX))
#define CNT ((int*)(ws + WS_CNT))
#define Ob ((bf16*)(ws + WS_OB))
#define Z ((float*)(ws + WS_Z))
#define H1f ((float*)(ws + WS_H1F))
#define H1b ((bf16*)(ws + WS_H1B))
#define PQb ((bf16*)(ws + WS_PQB))
#define H2f ((float*)(ws + WS_H2F))
#define H2b ((bf16*)(ws + WS_H2B))
#define TEID ((unsigned short*)(ws + WS_TEID))
#define TGATE ((float*)(ws + WS_TGATE))
#define Gq ((bf16*)(ws + WS_GQ))
#define Gk ((bf16*)(ws + WS_GK))
#define Gv ((bf16*)(ws + WS_GV))
#define Gr ((bf16*)(ws + WS_GR))
#define GD ((float*)(ws + WS_GD))
#define QT ((bf16*)(ws + WS_QT))
#define KT ((bf16*)(ws + WS_KT))
#define DEC ((float*)(ws + WS_DEC))
#define DSb ((float*)(ws + WS_DS))
#define SPV ((bf16*)(ws + WS_SPREV))
#define OGb ((bf16*)(ws + WS_OGB))
#define HDB ((float*)(ws + WS_HD))
#define KV8 ((unsigned char*)(ws + WS_KV8))
#define Uq (ws + WS_UB)
#define Vq (ws + WS_VBX)
#define Usc ((float*)(ws + WS_USC))
#define Vsc ((float*)(ws + WS_USC) + 2 * 16384)
#define x_prompt (INP(0))
#define x_sample (INP(1))
#define attn_w_in (INP(7))
#define attn_w_out (INP(8))
#define gla_w_in (INP(9))
#define gla_w_out (INP(13))
#define peer_w_q (INP(14))
#define peer_keys1 (INP(15))
#define peer_keys2 (INP(16))
#define peer_u (INP(17))
#define peer_v (INP(18))
__device__ __forceinline__ unsigned char* launder_ptr(unsigned char* p) { asm volatile("" : "+s"(p)); return p; }
#if defined(LOWSGPR)
#define ws (launder_ptr(args.ws))
#define INP(k) ((const float*)inp_ptr(lds, (k)))
#else
#define ws (args.ws)
#define INP(k) (args.in[k])
#endif
__device__ __forceinline__ const void* inp_ptr(LAS unsigned char* lds, int k) {
    const unsigned long long v = *(LAS unsigned long long*)(lds + INPTAB_OFF + 8 * k);
    const unsigned lo = __builtin_amdgcn_readfirstlane((unsigned)v), hi = __builtin_amdgcn_readfirstlane((unsigned)(v >> 32));
    return (const void*)(((unsigned long long)hi << 32) | lo);
}
__global__ void __launch_bounds__(NTHREADS, 2) mk_fwd(Args args) {
    extern __shared__ __attribute__((aligned(16))) unsigned char lds_raw[];
    LAS unsigned char* lds = (LAS unsigned char*)lds_raw;
    volatile LAS unsigned* MISC = (volatile LAS unsigned*)(lds + MISC_OFF);
    const int tid = threadIdx.x, lane = tid & 63, wave = __builtin_amdgcn_readfirstlane(tid >> 6);
    const int G = gridDim.x, bx = blockIdx.x;
    const int vcu = (G % 8 == 0) ? (bx % 8) * (G / 8) + bx / 8 : bx;
    const int gw = vcu * NWAVES + wave, NGW = G * NWAVES;
    gu32* ctl = (gu32*)(ws + WS_CTL);
    for (int u = tid; u < (LDS_BYTES - LDSCTL_OFF) / 4; u += NTHREADS) ((LAS unsigned*)(lds + LDSCTL_OFF))[u] = 0u;
    __syncthreads();
    if (tid == 0) {
#define PUTIN(k) *(LAS unsigned long long*)(lds + INPTAB_OFF + 8 * (k)) = (unsigned long long)args.in[k]
        PUTIN(0); PUTIN(1); PUTIN(2); PUTIN(3); PUTIN(4); PUTIN(5); PUTIN(6); PUTIN(7); PUTIN(8); PUTIN(9); PUTIN(10); PUTIN(11); PUTIN(12); PUTIN(13); PUTIN(14); PUTIN(15);
        PUTIN(16); PUTIN(17); PUTIN(18); PUTIN(19); PUTIN(20); PUTIN(21); PUTIN(22);
#undef PUTIN
    }
    __syncthreads();
    XcdBarrier bar = xcd_barrier_post((unsigned*)(ctl + CW_BAR), MISC + 8);
    if (tid == 0) { const unsigned xme = xb_xcc_id(); MISC[13] = xme; MISC[12] = __hip_atomic_fetch_add((unsigned*)(ctl + CW_XC + 64 * xme), 1u, __ATOMIC_RELAXED, __HIP_MEMORY_SCOPE_AGENT); }
    const int lo = args.ph_lo, hi = args.ph_hi;
#define IN(k) (lo <= (k) && (k) < hi)
#define SEAM(k) do { if (IN(k) && IN((k) + 1)) xcd_barrier(bar); } while (0)
#ifndef REPEAT_PHASE
#define REPEAT_PHASE -1
#endif
#ifndef REPEAT_N
#define REPEAT_N 2
#endif
#define REP(k) for (int rep_ = 0; rep_ < (REPEAT_PHASE == (k) ? REPEAT_N : 1); ++rep_)


    if (IN(P_PRO)) {
        LAS float* scr = (LAS float*)(lds + wave * 16384);
        constexpr int KB16 = D / 64;
        constexpr int I_WA = (WA_ROWS / 32) * KB16, I_WO = (D / 32) * KB16, I_WG = (WG_ROWS / 32) * KB16, I_WGO = (D / 32) * KB16, I_WPQ = 2 * (PEER_N / 32) * KB16;
        constexpr int NITEMS = I_WA + I_WO + I_WG + I_WGO + I_WPQ;
        for (int it = gw; it < NITEMS; it += NGW) {
            int r = it;
            if (r < I_WA) { const int nb = r / KB16, kb = r % KB16, d0 = nb * 32; const int nv = ATT_N - d0 < 0 ? 0 : (ATT_N - d0 > 32 ? 32 : ATT_N - d0);
                p0_transpose_item(attn_w_in, ATT_N, D, Wa, d0, d0, nv, kb * 64, scr, lane); continue; } r -= I_WA;
            if (r < I_WO) { const int nb = r / KB16, kb = r % KB16; p0_transpose_item(attn_w_out, D, D, Wo, nb * 32, nb * 32, 32, kb * 64, scr, lane); continue; } r -= I_WO;
            if (r < I_WG) { const int nb = r / KB16, kb = r % KB16, d0 = nb * 32; int s0, nv;
                if (d0 < GN_R) { s0 = d0; nv = 32; } else if (d0 < GN_GD) { s0 = GR + (d0 - GN_R); nv = 32; } else if (d0 == GN_GD) { s0 = GGD; nv = 16; } else { s0 = 0; nv = 0; }
                p0_transpose_item(gla_w_in, GLA_N, D, Wg, d0, s0, nv, kb * 64, scr, lane); continue; } r -= I_WG;
            if (r < I_WGO) { const int nb = r / KB16, kb = r % KB16; p0_transpose_item(gla_w_out, D, D, Wgo, nb * 32, nb * 32, 32, kb * 64, scr, lane); continue; } r -= I_WGO;
            { const int l = r / ((PEER_N / 32) * KB16), rr = r % ((PEER_N / 32) * KB16), nb = rr / KB16, kb = rr % KB16;
              p0_transpose_item(peer_w_q + (size_t)l * D * PEER_N, PEER_N, D, Wpq + (size_t)l * PEER_N * D, nb * 32, nb * 32, 32, kb * 64, scr, lane); }
        }
        p0_convert(x_prompt, Xb, (size_t)TP * D / 8, gw, NGW, lane);
        p0_convert(x_sample, Xb + (size_t)TP * D, (size_t)TS * D / 8, gw, NGW, lane);
        p0_convert(peer_keys1, PK, (size_t)2 * 128 * 128 / 8, gw, NGW, lane);
        p0_convert(peer_keys2, PK + 2 * 128 * 128, (size_t)2 * 128 * 128 / 8, gw, NGW, lane);
    }
    SEAM(P_PRO);

    if (IN(P_AIN)) {
        FAttnIn F{Qb, Kb, Vb, QIb, KIb, WIf, args.out};
        { pg8::Gemm g{Xb, Wa, TP, 2048, D}; pg8::StaticOrder S; S.init(TP, 2048, G, bx);
          pg8::EpiRow8<FAttnIn> E{F};
          pg8::gemm_phase<pg8::EpiRow8<FAttnIn>, pg8::StaticOrder, true, true>(lds, g, S, E);
          float km = E.f.kmax, vm = E.f.vmax;
#pragma unroll
          for (int o = 1; o < 64; o <<= 1) { km = fmaxf(km, __shfl_xor(km, o)); vm = fmaxf(vm, __shfl_xor(vm, o)); }
          if (lane == 0) { if (km > 0.f) atomicMax((unsigned*)(ctl + CW_AMAXK), __builtin_bit_cast(unsigned, km)); if (vm > 0.f) atomicMax((unsigned*)(ctl + CW_AMAXV), __builtin_bit_cast(unsigned, vm)); } }
        for (int it = gw; it < TP / 16 + 8 * 34; it += NGW) {
            if (it < TP / 16) {
                f32x4 acc[5]; skinny_tile<5>(Xb, D, Wa, D, it * 16, 2048, acc, lane);
#pragma unroll
                for (int ct = 0; ct < 5; ++ct) F.put4(it * 16 + (lane & 15), 2048 + ct * 16 + 4 * (lane >> 4), acc[ct]);
            } else {
                const int r = it - TP / 16, rt = r % 8, cg = r / 8;
                f32x4 acc[4]; skinny_tile<4>(Xb, D, Wa, D, TP + rt * 16, cg * 64, acc, lane);
#pragma unroll
                for (int ct = 0; ct < 4; ++ct) F.put4(TP + rt * 16 + (lane & 15), cg * 64 + ct * 16 + 4 * (lane >> 4), acc[ct]);
            }
        }
    }
    SEAM(P_AIN);

            if (IN(P_SCORE)) { kv8_convert(Kb, Vb, KV8, (const unsigned*)(ctl + CW_AMAXK), (const unsigned*)(ctl + CW_AMAXV), gw, NGW, lane);
        phase_score(QIb, KIb, WIf, INP(4), args.page_table, SC, SCS, QuantTabs{peer_u, peer_v, Uq, Vq, Usc, Vsc}, lds, vcu, G, wave, lane, gw, NGW); }
    SEAM(P_SCORE);
    if (IN(P_TOPK)) {
#if defined(PROBE_TOPK_ROWS)
        const int jlo_ = (lo == P_TOPK) ? (PROBE_TOPK_ROWS == 1 ? 0 : TP) : 0, jhi_ = (lo == P_TOPK) ? (PROBE_TOPK_ROWS == 1 ? TP : TA) : TA;
#else
        const int jlo_ = 0, jhi_ = TA;
#endif
        phase_topk2(SC, SCS, IDX, CNT, peer_u, peer_v, Uq, Vq, Usc, Vsc, lds, (unsigned*)(ctl + CW_Q1), wave, lane, gw, NGW, jlo_, jhi_); }
    SEAM(P_TOPK);
    if (IN(P_ATTN)) {
        LAS unsigned char* wl = lds + wave * 16384;
        {
            if (tid == 0) { unsigned np = 0, mi = 0, mycnt = 1; const unsigned xme = MISC[13];
                for (unsigned j = 0; j < 16; ++j) { const unsigned c = __hip_atomic_load((unsigned*)(ctl + CW_XC + 64 * j), __ATOMIC_RELAXED, __HIP_MEMORY_SCOPE_AGENT); if (c > 0u) { if (j < xme) ++mi; ++np; } if (j == xme) mycnt = c > 0u ? c : 1u; }
                MISC[14] = np > 0u ? np : 1u; MISC[15] = mi; MISC[16] = mycnt; }
            __syncthreads();
            const int np = (int)MISC[14], mi = (int)MISC[15], mycnt = (int)MISC[16], rank = (int)MISC[12];
            for (int u = 0; u < NBATCH * 4; ++u) if (u % np == mi) attn_prompt_stream(u >> 2, u & 3, rank * NWAVES + wave, mycnt * NWAVES, Qb, IDX, KV8, (const unsigned*)(ctl + CW_AMAXK), (const unsigned*)(ctl + CW_AMAXV), Ob, wl, lane);
        }
        {
            const float* ck_ = INP(2); const float* cv_ = INP(3); float* o_ = args.out; const int* pt_ = args.page_table; int gws_ = gw; int lane_s = lane;
            asm volatile("" : "+s"(ck_), "+s"(cv_), "+s"(o_), "+s"(pt_), "+s"(gws_), "+v"(lane_s));
            for (int su = gws_; su < TS * 4 * 4; su += NGW) {
                if ((su & 3) == 0) { const int un = su >> 2, r = un >> 2, n = un & 3; attn_row<true>(TP + r, n, n + 1, Qb, IDX, CNT, nullptr, nullptr, ck_, cv_, o_ + OUT_KS, o_ + OUT_VS, pt_, Ob, wl, lane_s); }
            }
        }
    }
    SEAM(P_ATTN);
    if (IN(P_AOUT)) {
        FResid F{x_prompt, x_sample, Z};
        { pg8::Gemm g{Ob, Wo, TP, D, D}; pg8::StaticOrder S; S.init(TP, D, G, bx);
          pg8::EpiRow8<FResid> E{F};
          pg8::gemm_phase<pg8::EpiRow8<FResid>, pg8::StaticOrder, true, true>(lds, g, S, E); }
        for (int it = gw; it < 8 * 16; it += NGW) {
            const int rt = it % 8, cg = it / 8;
            f32x4 acc[4]; skinny_tile<4>(Ob, D, Wo, D, TP + rt * 16, cg * 64, acc, lane);
#pragma unroll
            for (int ct = 0; ct < 4; ++ct) F.put4(TP + rt * 16 + (lane & 15), cg * 64 + ct * 16 + 4 * (lane >> 4), acc[ct]);
        }
    }
    SEAM(P_AOUT);
    if (IN(P_LN1)) { for (int r = gw; r < TA; r += NGW) ln_row_wave(Z + (size_t)r * D, INP(19), INP(20), (float*)nullptr, H1b + (size_t)r * D, lane); }
    SEAM(P_LN1);

        if (IN(P_PQ0)) {
        FStoreBf16 F{PQb, PEER_N};
        { pg8::Gemm g{H1b, Wpq, TP, PEER_N, D}; pg8::StaticOrder S; S.init(TP, PEER_N, G, bx);
          pg8::EpiRow8<FStoreBf16> E{F};
          pg8::gemm_phase<pg8::EpiRow8<FStoreBf16>, pg8::StaticOrder, true, true>(lds, g, S, E); }
#if defined(PROBE_DUP_GEMM)
        { pg8::Gemm g{H1b, Wpq, TP, PEER_N, D}; pg8::StaticOrder S; S.init(TP, PEER_N, G, bx);
          pg8::EpiRow8<FStoreBf16> E{F};
          pg8::gemm_phase<pg8::EpiRow8<FStoreBf16>, pg8::StaticOrder, true, true>(lds, g, S, E); }
#endif
        for (int it = gw; it < 8 * 32; it += NGW) {
            const int rt = it % 8, cg = it / 8;
            f32x4 acc[4]; skinny_tile<4>(H1b, D, Wpq, D, TP + rt * 16, cg * 64, acc, lane);
#pragma unroll
            for (int ct = 0; ct < 4; ++ct) F.put4(TP + rt * 16 + (lane & 15), cg * 64 + ct * 16 + 4 * (lane >> 4), acc[ct]);
        }
#if 0
        for (int it = gw; it < 8 * 16; it += NGW) {
            const int rt = it % 8, cg = it / 8;
            f32x4 acc[8]; skinny_tile<8>(H1b, D, Wpq, D, TP + rt * 16, cg * 128, acc, lane);
#pragma unroll
            for (int ct = 0; ct < 8; ++ct) F.put4(TP + rt * 16 + (lane & 15), cg * 128 + ct * 16 + 4 * (lane >> 4), acc[ct]);
        }
#endif
    }
    SEAM(P_PQ0);
        if (IN(P_PEER0)) {
        phase_peer_select(PQb, PK, PK + 2 * 16384, TEID, TGATE, lds, vcu, G, wave, lane);
#if defined(PROBE_DUP_SELECT)
        xcd_barrier(bar);
        phase_peer_select(PQb, PK, PK + 2 * 16384, TEID, TGATE, lds, vcu, G, wave, lane);
#endif
        xcd_barrier(bar);
#if defined(U_SLICED)
        PEER_USLICE(H1b, Uq, Usc);
        xcd_barrier(bar);
        phase_peer_mixv(H1f, TEID, TGATE, HDB, Vq, Vsc, INP(21), INP(22), H2f, H2b, gw, NGW, lane);
#else
#if defined(MIX_FROM_Z)
        phase_peer_mix(Z, INP(19), INP(20), TEID, TGATE, Uq, Vq, Usc, Vsc, INP(21), INP(22), H2f, H2b, gw, NGW, lane);
#else
        MIXSEL(H1f, TEID, TGATE, Uq, Vq, Usc, Vsc, INP(21), INP(22), H2f, H2b, lds, wave, gw, NGW, lane);
#endif
#endif
    }
    SEAM(P_PEER0);

            if (IN(P_GIN)) {
        FGlaIn F{Gq, Gk, Gv, Gr, GD};
        { pg8::Gemm g{H2b, Wg, TP, 3072, D}; pg8::StaticOrder S; S.init(TP, 3072, G, bx);
          pg8::EpiRow8<FGlaIn> E{F};
          pg8::gemm_phase<pg8::EpiRow8<FGlaIn>, pg8::StaticOrder, true, true>(lds, g, S, E); }
        for (int it = gw; it < TP / 16 + 8 * 97; it += NGW) {
            if (it < TP / 16) {
                f32x4 acc[1]; skinny_tile<1>(H2b, D, Wg, D, it * 16, GN_GD, acc, lane);
                F.put4(it * 16 + (lane & 15), GN_GD + 4 * (lane >> 4), acc[0]);
            } else {
                const int r = it - TP / 16, rt = r % 8, cg = r / 8;
                f32x4 acc[2]; skinny_tile<2>(H2b, D, Wg, D, TP + rt * 16, cg * 32, acc, lane);
#pragma unroll
                for (int ct = 0; ct < 2; ++ct) F.put4(TP + rt * 16 + (lane & 15), cg * 32 + ct * 16 + 4 * (lane >> 4), acc[ct]);
            }
        }
    }
    SEAM(P_GIN);
    if (IN(P_GCH)) {
        for (int it = vcu; it < NBATCH * (SEQ / 64) * 4; it += G) gla_chunk_item(it, Gq, Gk, Gv, GD, INP(10), INP(11), QT, KT, DEC, DSb, lds, tid, wave, lane);
        for (int it = vcu; it < DB * 4; it += G) gla_sample_item(it, Gq, Gk, Gv, Gr, GD, INP(10), INP(11), INP(12), INP(5), args.out + OUT_SS, OGb, lds, tid, lane);
    }
    SEAM(P_GCH);
    if (IN(P_GSC)) gla_scan(DSb, DEC, SPV, args.out + OUT_SP, vcu * NTHREADS + tid, G * NTHREADS);
    SEAM(P_GSC);
    if (IN(P_GOUT)) { for (int it = vcu; it < NBATCH * (SEQ / 64) * 4; it += G) gla_out_item(it, QT, KT, Gv, Gr, SPV, INP(12), OGb, lds, tid, wave, lane); }
    SEAM(P_GOUT);
    if (IN(P_GPRJ)) {
        FResid F{H2f, H2f + (size_t)TP * D, Z};
        { pg8::Gemm g{OGb, Wgo, TP, D, D}; pg8::StaticOrder S; S.init(TP, D, G, bx);
          pg8::EpiRow8<FResid> E{F};
          pg8::gemm_phase<pg8::EpiRow8<FResid>, pg8::StaticOrder, true, true>(lds, g, S, E); }
        for (int it = gw; it < 8 * 16; it += NGW) {
            const int rt = it % 8, cg = it / 8;
            f32x4 acc[4]; skinny_tile<4>(OGb, D, Wgo, D, TP + rt * 16, cg * 64, acc, lane);
#pragma unroll
            for (int ct = 0; ct < 4; ++ct) F.put4(TP + rt * 16 + (lane & 15), cg * 64 + ct * 16 + 4 * (lane >> 4), acc[ct]);
        }
    }
    SEAM(P_GPRJ);
    if (IN(P_LN1B)) { for (int r = gw; r < TA; r += NGW) ln_row_wave(Z + (size_t)r * D, INP(19) + D, INP(20) + D, (float*)nullptr, H1b + (size_t)r * D, lane); }
    SEAM(P_LN1B);
    if (IN(P_PQ1)) {
        FStoreBf16 F{PQb, PEER_N}; const bf16* W1 = Wpq + (size_t)PEER_N * D;
        { pg8::Gemm g{H1b, W1, TP, PEER_N, D}; pg8::StaticOrder S; S.init(TP, PEER_N, G, bx);
          pg8::EpiRow8<FStoreBf16> E{F};
          pg8::gemm_phase<pg8::EpiRow8<FStoreBf16>, pg8::StaticOrder, true, true>(lds, g, S, E); }
        for (int it = gw; it < 8 * 32; it += NGW) {
            const int rt = it % 8, cg = it / 8;
            f32x4 acc[4]; skinny_tile<4>(H1b, D, W1, D, TP + rt * 16, cg * 64, acc, lane);
#pragma unroll
            for (int ct = 0; ct < 4; ++ct) F.put4(TP + rt * 16 + (lane & 15), cg * 64 + ct * 16 + 4 * (lane >> 4), acc[ct]);
        }
    }
    SEAM(P_PQ1);
    if (IN(P_PEER1)) {
        phase_peer_select(PQb, PK + 16384, PK + 3 * 16384, TEID, TGATE, lds, vcu, G, wave, lane);
        xcd_barrier(bar);
#if defined(U_SLICED)
        PEER_USLICE(H1b, Uq + (size_t)16384 * D, Usc + 16384);
        xcd_barrier(bar);
        phase_peer_mixv(H1f, TEID, TGATE, HDB, Vq + (size_t)16384 * D, Vsc + 16384, INP(21) + D, INP(22) + D, args.out + OUT_Y, nullptr, gw, NGW, lane);
#else
#if defined(MIX_FROM_Z)
        phase_peer_mix(Z, INP(19) + D, INP(20) + D, TEID, TGATE, Uq + (size_t)16384 * D, Vq + (size_t)16384 * D, Usc + 16384, Vsc + 16384, INP(21) + D, INP(22) + D, args.out + OUT_Y, nullptr, gw, NGW, lane);
#else
        MIXSEL(H1f, TEID, TGATE, Uq + (size_t)16384 * D, Vq + (size_t)16384 * D, Usc + 16384, Vsc + 16384, INP(21) + D, INP(22) + D, args.out + OUT_Y, nullptr, lds, wave, gw, NGW, lane);
#endif
#endif
    }
#if defined(PROBE_REGION)
    if (IN(P_PEER1)) { xcd_barrier(bar);
        const float eps = sqrtf((float)g_probe_acc * 1e-8f);
        for (int i = vcu * NTHREADS + tid; i < TS * D; i += G * NTHREADS) args.out[OUT_Y + (size_t)TP * D + i] *= (1.f + eps); }
#endif
#undef IN
#undef SEAM
}
#undef ws
#undef INP
#undef Wa
#undef Wo
#undef Wg
#undef Wgo
#undef Wpq
#undef PK
#undef Usc
#undef Xb
#undef Qb
#undef QIb
#undef Kb
#undef Vb
#undef KIb
#undef WIf
#undef SC
#undef SCS
#undef IDX
#undef CNT
#undef Ob
#undef Z
#undef H1f
#undef H1b
#undef PQb
#undef H2f
#undef H2b
#undef TEID
#undef TGATE
#undef Gq
#undef Gk
#undef Gv
#undef Gr
#undef GD
#undef QT
#undef KT
#undef DEC
#undef DSb
#undef SPV
#undef OGb
#undef Uq
#undef HDB
#undef KV8
#undef Vq
#undef Usc
#undef Vsc
#undef x_prompt
#undef x_sample
#undef attn_w_in
#undef attn_w_out
#undef gla_w_in
#undef gla_w_out
#undef peer_w_q
#undef peer_keys1
#undef peer_keys2
#undef peer_u
#undef peer_v


__global__ void ad_attn_in(const bf16* Qb, const bf16* Kb, const bf16* Vb, const bf16* QIb, const bf16* KIb, const float* WIf, float* P) {
    const int row = blockIdx.x; float* p = P + (size_t)row * ATT_N;
    for (int c = threadIdx.x; c < ATT_N; c += blockDim.x) {
        float v;
        if (c < AK) v = bf2f(Qb[(size_t)row * 1024 + c]); else if (c < AV) v = bf2f(Kb[(size_t)row * 256 + c - AK]); else if (c < AQI) v = bf2f(Vb[(size_t)row * 256 + c - AV]);
        else if (c < AKI) v = bf2f(QIb[(size_t)row * 512 + c - AQI]); else if (c < AWI) v = bf2f(KIb[(size_t)row * 64 + c - AKI]); else v = WIf[(size_t)row * 8 + c - AWI] * 22.627416997969522f;
        p[c] = v;
    }
}
__global__ void ad_bf16_to_f32(const bf16* src, float* dst, size_t n) { size_t i = (size_t)blockIdx.x * blockDim.x + threadIdx.x; for (; i < n; i += (size_t)gridDim.x * blockDim.x) dst[i] = bf2f(src[i]); }
__global__ void ad_copy_f32(const float* src, float* dst, size_t n) { size_t i = (size_t)blockIdx.x * blockDim.x + threadIdx.x; for (; i < n; i += (size_t)gridDim.x * blockDim.x) dst[i] = src[i]; }
}

#ifndef HYBRID_K
#define HYBRID_K 11
#endif
extern "C" void kernel_launch(void* const* d_in, const int* in_sizes, int n_in, void* d_out, int out_size, void* d_ws, size_t ws_size, hipStream_t stream) {
    const float* x_prompt = (const float*)d_in[0];
    const float* x_sample = (const float*)d_in[1];
    const float* cache_k = (const float*)d_in[2];
    const float* cache_v = (const float*)d_in[3];
    const float* cache_ki = (const float*)d_in[4];
    const float* state_gla = (const float*)d_in[5];
    const int* page_table = (const int*)d_in[6];
    const float* attn_w_in = (const float*)d_in[7];
    const float* attn_w_out = (const float*)d_in[8];
    const float* gla_w_in = (const float*)d_in[9];
    const float* gla_w_gate_up = (const float*)d_in[10];
    const float* gla_b_gate = (const float*)d_in[11];
    const float* gla_norm_g = (const float*)d_in[12];
    const float* gla_w_out = (const float*)d_in[13];
    const float* peer_w_q = (const float*)d_in[14];
    const float* peer_keys1 = (const float*)d_in[15];
    const float* peer_keys2 = (const float*)d_in[16];
    const float* peer_u = (const float*)d_in[17];
    const float* peer_v = (const float*)d_in[18];
    const float* ln1_g = (const float*)d_in[19];
    const float* ln1_b = (const float*)d_in[20];
    const float* ln2_g = (const float*)d_in[21];
    const float* ln2_b = (const float*)d_in[22];
    float* out = (float*)d_out;

    constexpr size_t MiB = 1u << 20;
    constexpr size_t W_A0 = 0, W_A1 = 65 * MiB, W_A2 = 130 * MiB, W_A3 = 195 * MiB, W_A4 = 260 * MiB, W_A5 = 325 * MiB;
    constexpr size_t W_P = 390 * MiB, W_IDX = 525 * MiB, W_CNT = 542 * MiB, W_SCS = 543 * MiB, W_SC = 548 * MiB;
    constexpr size_t W_PQ = W_SC, W_G = W_SC + 130 * MiB, W_LA = W_SC + 326 * MiB;
    static_assert(W_IDX == mk::WS_IDX && W_CNT == mk::WS_CNT && W_SCS == mk::WS_SCS && W_SC == mk::WS_SC, "shared formats live at the same offsets");
    if (ws_size < mk::WS_END || n_in != 23 || (size_t)out_size != OUT_TOTAL) { fprintf(stderr, "kernel_launch: unexpected sizes ws %zu n_in %d out %d\n", ws_size, n_in, out_size); return; }
    char* ws = (char*)d_ws;
    float *X = (float*)(ws + W_A0), *O = (float*)(ws + W_A1), *Y = (float*)(ws + W_A2), *H1 = (float*)(ws + W_A3), *H2 = (float*)(ws + W_A4), *OGN = (float*)(ws + W_A5);
    float *P = (float*)(ws + W_P), *SC = (float*)(ws + W_SC), *SCS = (float*)(ws + W_SCS), *PQ = (float*)(ws + W_PQ), *G = (float*)(ws + W_G), *LA = (float*)(ws + W_LA);
    int *IDX = (int*)(ws + W_IDX), *CNT = (int*)(ws + W_CNT);
    float* OG = O; float* H3 = H1;

    static int grid = 0;
    if (grid == 0) {
        int dev = 0, cus = 0;
        if (hipGetDevice(&dev) != hipSuccess || hipDeviceGetAttribute(&cus, hipDeviceAttributeMultiprocessorCount, dev) != hipSuccess) { fprintf(stderr, "kernel_launch: device query failed\n"); grid = -1; return; }
        if (hipFuncSetAttribute((const void*)mk::mk_fwd, hipFuncAttributeMaxDynamicSharedMemorySize, mk::LDS_BYTES) != hipSuccess) { fprintf(stderr, "kernel_launch: hipFuncSetAttribute failed\n"); grid = -1; return; }
        int per_cu = 0;
        if (hipOccupancyMaxActiveBlocksPerMultiprocessor(&per_cu, (const void*)mk::mk_fwd, mk::NTHREADS, mk::LDS_BYTES) != hipSuccess || per_cu < 1) { fprintf(stderr, "kernel_launch: occupancy query says %d\n", per_cu); }
        (void)hipGetLastError();
        grid = cus;
    }
    if (grid < 0) return;
    (void)hipMemsetAsync(ws + mk::WS_CTL, 0, mk::CTL_ZERO_BYTES, stream);
    mk::Args a{};
    for (int i = 0; i < 23; ++i) a.in[i] = (const float*)d_in[i];
    a.page_table = page_table; a.out = out; a.ws = (unsigned char*)d_ws;
    auto run = [&](int lo, int hi) { a.ph_lo = lo; a.ph_hi = hi; hipLaunchKernelGGL(mk::mk_fwd, dim3(grid), dim3(mk::NTHREADS), mk::LDS_BYTES, stream, a); };

    auto gemm = [&](const float* A, int lda, const float* W, int N, int K, float* C, int ldc) {
        hipLaunchKernelGGL(nv::gemm_f32, dim3((N + 63) / 64, (TA + 63) / 64), dim3(256), 0, stream, A, lda, W, N, K, C, ldc, TA);
    };
    constexpr int HK = HYBRID_K;
#if HYBRID_K >= 11
#if defined(PROBE_SPLIT)
    run(0, PROBE_SPLIT + 1); (void)hipMemsetAsync(ws + mk::WS_CTL, 0, mk::CTL_ZERO_BYTES, stream); run(PROBE_SPLIT, mk::P_COUNT);
#else
    run(0, mk::P_COUNT);
#endif
    return;
#endif
    hipLaunchKernelGGL(nv::concat_x, dim3(2048), dim3(256), 0, stream, x_prompt, x_sample, X);
    if (HK >= 1) {
        run(mk::P_PRO, mk::P_PRO + 1); run(mk::P_AIN, mk::P_AIN + 1);
        hipLaunchKernelGGL(mk::ad_attn_in, dim3(TA), dim3(256), 0, stream, (const mk::bf16*)(ws + mk::WS_QB), (const mk::bf16*)(ws + mk::WS_KB), (const mk::bf16*)(ws + mk::WS_VB),
                           (const mk::bf16*)(ws + mk::WS_QIB), (const mk::bf16*)(ws + mk::WS_KIB), (const float*)(ws + mk::WS_WIF), P);
    } else {
        gemm(X, D, attn_w_in, ATT_N, D, P, ATT_N);
        hipLaunchKernelGGL(nv::scatter_kv, dim3(TA), dim3(256), 0, stream, (const float*)P, out);
    }
#if defined(DBG_KV) && DBG_KV
    if (HK >= 2) { gemm(X, D, attn_w_in, ATT_N, D, P, ATT_N); hipLaunchKernelGGL(nv::scatter_kv, dim3(TA), dim3(256), 0, stream, (const float*)P, out); }
#endif
    if (HK >= 2) run(mk::P_SCORE, mk::P_SCORE + 1);
    else {
    hipLaunchKernelGGL((nv::idx_scores<false, 16>), dim3(SEQ / 64, SEQ / 16, NBATCH), dim3(256), 0, stream, (const float*)P, cache_ki, page_table, SC);
    hipLaunchKernelGGL((nv::idx_scores<true, 4>), dim3((PAST + DS + 63) / 64, 1, DB), dim3(256), 0, stream, (const float*)P, cache_ki, page_table, SCS);
    }
    if (HK >= 3) run(mk::P_TOPK, mk::P_TOPK + 1);
    else hipLaunchKernelGGL(nv::topk_rows, dim3(TA / 4), dim3(256), 0, stream, (const float*)SC, (const float*)SCS, IDX, CNT);
    if (HK >= 4) { run(mk::P_ATTN, mk::P_ATTN + 1); if (HK < 5) hipLaunchKernelGGL(mk::ad_bf16_to_f32, dim3(2048), dim3(256), 0, stream, (const mk::bf16*)(ws + mk::WS_OB), O, (size_t)TA * D); }
    else {
    hipLaunchKernelGGL((nv::attn_naive<false>), dim3(TP), dim3(256), 0, stream, (const float*)P, (const int*)IDX, (const int*)CNT, cache_k, cache_v, page_table, O);
    hipLaunchKernelGGL((nv::attn_naive<true>), dim3(TS), dim3(256), 0, stream, (const float*)P, (const int*)IDX, (const int*)CNT, cache_k, cache_v, page_table, O);
    }
    if (HK >= 5) { run(mk::P_AOUT, mk::P_AOUT + 1); run(mk::P_LN1, mk::P_LN1 + 1); hipLaunchKernelGGL(mk::ad_copy_f32, dim3(2048), dim3(256), 0, stream, (const float*)(ws + mk::WS_H1F), H1, (size_t)TA * D); }
    else {
    gemm(O, D, attn_w_out, D, D, Y, D);
    hipLaunchKernelGGL(nv::ln_res, dim3(TA), dim3(256), 0, stream, (const float*)X, (const float*)Y, ln1_g, ln1_b, H1);
    }
    if (HK >= 6) { run(mk::P_PQ0, mk::P_PQ0 + 1); run(mk::P_PEER0, mk::P_PEER0 + 1); hipLaunchKernelGGL(mk::ad_copy_f32, dim3(2048), dim3(256), 0, stream, (const float*)(ws + mk::WS_H2F), H2, (size_t)TA * D); }
    else {
    gemm(H1, D, peer_w_q, PEER_N, D, PQ, PEER_N);
    hipLaunchKernelGGL(nv::peer_naive, dim3(TA), dim3(256), 0, stream, (const float*)H1, (const float*)PQ, peer_keys1, peer_keys2, peer_u, peer_v, ln2_g, ln2_b, H2);
    }
    if (HK >= 8) {
        run(mk::P_GIN, mk::P_GIN + 1); run(mk::P_GCH, mk::P_GCH + 1); run(mk::P_GSC, mk::P_GSC + 1); run(mk::P_GOUT, mk::P_GOUT + 1);
        if (HK < 9) hipLaunchKernelGGL(mk::ad_bf16_to_f32, dim3(2048), dim3(256), 0, stream, (const mk::bf16*)(ws + mk::WS_OGB), OGN, (size_t)TA * D);
    } else {
    gemm(H2, D, gla_w_in, GLA_N, D, G, GLA_N);
    hipLaunchKernelGGL(nv::gla_gate, dim3(TA), dim3(512), 0, stream, (const float*)G, gla_w_gate_up, gla_b_gate, LA);
    hipLaunchKernelGGL(nv::gla_rec, dim3(4, 4, NBATCH), dim3(256), 0, stream, (const float*)G, (const float*)LA, (const float*)nullptr, SEQ, 0, OG, out + OUT_SP);
    hipLaunchKernelGGL(nv::gla_rec, dim3(4, 4, DB), dim3(256), 0, stream, (const float*)G, (const float*)LA, state_gla, DS, TP, OG, out + OUT_SS);
    hipLaunchKernelGGL(nv::gla_post, dim3(TA), dim3(256), 0, stream, (const float*)OG, (const float*)G, gla_norm_g, OGN);
    }
    if (HK >= 9) { run(mk::P_GPRJ, mk::P_GPRJ + 1); run(mk::P_LN1B, mk::P_LN1B + 1); if (HK < 10) hipLaunchKernelGGL(mk::ad_copy_f32, dim3(2048), dim3(256), 0, stream, (const float*)(ws + mk::WS_H1F), H3, (size_t)TA * D); }
    else {
    gemm(OGN, D, gla_w_out, D, D, Y, D);
    hipLaunchKernelGGL(nv::ln_res, dim3(TA), dim3(256), 0, stream, (const float*)H2, (const float*)Y, ln1_g + D, ln1_b + D, H3);
    }
    if (HK >= 10) { run(mk::P_PQ1, mk::P_PQ1 + 1); run(mk::P_PEER1, mk::P_PEER1 + 1); }
    else {
    gemm(H3, D, peer_w_q + (size_t)D * PEER_N, PEER_N, D, PQ, PEER_N);
    hipLaunchKernelGGL(nv::peer_naive, dim3(TA), dim3(256), 0, stream, (const float*)H3, (const float*)PQ, peer_keys1 + 128 * 128, peer_keys2 + 128 * 128,
                       peer_u + (size_t)16384 * D, peer_v + (size_t)16384 * D, ln2_g + D, ln2_b + D, out + OUT_Y);
    }
}
```

```cpp
#include <hip/hip_runtime.h>
#include <cstdio>
#include <cstdint>
#include <cmath>

constexpr int D = 1024;
constexpr int NBATCH = 2, SEQ = 8192, TP = NBATCH * SEQ;
constexpr int DB = 32, DS = 4, TS = DB * DS;
constexpr int TA = TP + TS;
constexpr int PAST = 8192, PAGE = 128, NPAGES = PAST / PAGE;
constexpr float ALPHA = 1.4142135623730951f;
constexpr float LN_EPS = 1e-5f;
constexpr int ATT_N = 2120;
constexpr int AQ = 0, AK = 1024, AV = 1280, AQI = 1536, AKI = 2048, AWI = 2112;
constexpr int TOPK = 256;
constexpr int GLA_N = 3088;
constexpr int GQ = 0, GK = 512, GV = 1024, GGD = 2048, GR = 2064;
constexpr int PEER_N = 2048;
constexpr int SCS_LD = 8256;

constexpr size_t OUT_Y = 0, OUT_KP = 16908288, OUT_VP = 21102592, OUT_KIP = 25296896, OUT_SP = 26345472,
                 OUT_KS = 26607616, OUT_VS = 26640384, OUT_KIS = 26673152, OUT_SS = 26681344, OUT_TOTAL = 30875648;


namespace pg8 {
#define PG8_LAS __attribute__((address_space(3)))
typedef unsigned short bf16_t;
typedef short bf16x8 __attribute__((ext_vector_type(8)));
typedef float f32x4 __attribute__((ext_vector_type(4)));
typedef unsigned u32x4 __attribute__((ext_vector_type(4)));
constexpr int BM = 256, BK = 64, HALF = 128, HTB = HALF * BK * 2  , STAGE_BYTES = 8 * HTB, NXCD = 8, WGM = 8;

__host__ __device__ __forceinline__ int lds_byte(int r, int c) { const int st = (r >> 4) * 2 + (c >> 5), rr = r & 15, cc = c & 31, ob = rr * 64 + cc * 2; return st * 1024 + (ob ^ (((ob >> 9) & 1) << 5)); }
__host__ __device__ __forceinline__ void stage_rc(int b, int& R, int& C) { const int st = b / 1024, sb = b % 1024, swz = sb ^ (((sb >> 9) & 1) << 5); R = (st >> 1) * 16 + swz / 64; C = (st & 1) * 32 + (swz % 64) / 2; }
__host__ __device__ __forceinline__ int perm32(int rho) { const int n = rho >> 4, i = rho & 15; return 8 * (i >> 2) + 4 * n + (i & 3); }

struct Unit { int pm, pn; };
struct Gemm { const bf16_t* A; const bf16_t* Bt; int M, N, K; };

struct StaticOrder {
    int nM, nN, nwg, G, c;
    __host__ __device__ void init(int M, int N, int G_, int c_) { nM = M / BM; nN = N / BM; nwg = nM * nN; G = G_; c = c_; }
    __host__ __device__ bool next(int i, Unit& u) const {
        const long L = (long)i * G + c; if (L >= nwg) return false;
        int wgid = (int)L; { const int q = nwg / NXCD, r = nwg % NXCD, xcd = wgid % NXCD, off = wgid / NXCD; wgid = (xcd < r ? xcd * (q + 1) : r * (q + 1) + (xcd - r) * q) + off; }
        const int nig = WGM * nN, gid = wgid / nig, fm = gid * WGM, gsz = (nM - fm) < WGM ? (nM - fm) : WGM;
        u.pm = fm + ((wgid % nig) % gsz); u.pn = (wgid % nig) / gsz; return true;
    }
    __device__ __forceinline__ void a_ready(const Unit&) const {}
    __device__ __forceinline__ void done(const Unit&) const {}
};

__device__ __forceinline__ unsigned cvt_pk_bf16(float lo, float hi) { unsigned r; asm volatile("v_cvt_pk_bf16_f32 %0, %1, %2" : "=v"(r) : "v"(lo), "v"(hi)); return r; }
template <class F> struct EpiRow8 {
    static constexpr bool PERM = true, AFTER_DRAIN = false;
    F f;
    __device__ __forceinline__ void operator()(const f32x4 (&acc)[2][2][4][2], const Unit& u, int wr, int wc, int fr, int fq) const {
        const int row0 = u.pm * BM + wr * 64 + fr, col0 = u.pn * BM + wc * 32 + 8 * fq;
#pragma unroll
        for (int ai = 0; ai < 2; ++ai)
#pragma unroll
            for (int m = 0; m < 4; ++m)
#pragma unroll
                for (int bj = 0; bj < 2; ++bj) f.put8(row0 + ai * HALF + m * 16, col0 + bj * HALF, acc[ai][bj][m][0], acc[ai][bj][m][1]);
    }
};


template <class Epi, class Sched, bool ALIGN_EPI = false, bool SP2 = false>
__device__ __forceinline__ void gemm_phase(PG8_LAS unsigned char* lds, const Gemm g, const Sched& S, const Epi& E) {
    const int tid = threadIdx.x, wid = __builtin_amdgcn_readfirstlane(tid >> 6), lane = tid & 63, wr = wid >> 2, wc = wid & 3, fr = lane & 15, fq = lane >> 4;
    const int K = g.K, nt = K / BK;
    unsigned voffA[2], voffB[2];
#pragma unroll
    for (int i = 0; i < 2; ++i) { int R, C; stage_rc(tid * 16 + i * 8192, R, C); const int Rb = Epi::PERM ? ((R & ~31) + perm32(R & 31)) : R;
        voffA[i] = (unsigned)(R * K + C) * 2u; voffB[i] = (unsigned)(Rb * K + C) * 2u; }
    const size_t kstep = (size_t)(BK * 2);
    const size_t hstep = (size_t)HALF * K * 2;
    const size_t tstep = 2 * hstep;
    const unsigned ldsw = (unsigned)wid * 1024u;
    const int aoff = lds_byte(wr * 64 + fr, fq * 8), boff = lds_byte(wc * 32 + fr, fq * 8);
#define PG8_SA(b, h) (((b) * 2 + (h)) * HTB)
#define PG8_SB(b, h) ((4 + (b) * 2 + (h)) * HTB)
#define PG8_STAGE(bufoff, gbase, voff) do { _Pragma("unroll") for (int _i = 0; _i < 2; ++_i) \
        __builtin_amdgcn_global_load_lds((const unsigned*)((const char*)(gbase) + (voff)[_i]), (PG8_LAS unsigned*)(lds + (bufoff) + ldsw + _i * 8192), 16, 0, 0); } while (0)
#define PG8_LDA(dst, b, h) do { _Pragma("unroll") for (int m = 0; m < 4; ++m) _Pragma("unroll") for (int k = 0; k < 2; ++k) dst[m][k] = *(const PG8_LAS bf16x8*)(lds + PG8_SA(b, h) + aoff + m * 2048 + k * 1024); } while (0)
#define PG8_LDB(dst, b, h) do { _Pragma("unroll") for (int n = 0; n < 2; ++n) _Pragma("unroll") for (int k = 0; k < 2; ++k) dst[n][k] = *(const PG8_LAS bf16x8*)(lds + PG8_SB(b, h) + boff + n * 2048 + k * 1024); } while (0)
#define PG8_MMA(ai, bj, At, Bt) do { __builtin_amdgcn_s_setprio(1); _Pragma("unroll") for (int m = 0; m < 4; ++m) _Pragma("unroll") for (int n = 0; n < 2; ++n) _Pragma("unroll") for (int k = 0; k < 2; ++k) \
        acc[ai][bj][m][n] = __builtin_amdgcn_mfma_f32_16x16x32_bf16(Bt[n][k], At[m][k], acc[ai][bj][m][n], 0, 0, 0); __builtin_amdgcn_s_setprio(0); } while (0)
#define PG8_WAIT_V(n) asm volatile("s_waitcnt vmcnt(" #n ")" ::: "memory")
#define PG8_WAIT_L(n) asm volatile("s_waitcnt lgkmcnt(" #n ")" ::: "memory")
#define PG8_BAR __builtin_amdgcn_s_barrier()
#define PG8_SCHED __builtin_amdgcn_sched_barrier(0)
    Unit cur, nxt; int ui = 0;
    if (!S.next(0, cur)) return;
    f32x4 acc[2][2][4][2];
#pragma unroll
    for (int a = 0; a < 2; ++a)
#pragma unroll
        for (int b = 0; b < 2; ++b)
#pragma unroll
            for (int m = 0; m < 4; ++m)
#pragma unroll
                for (int n = 0; n < 2; ++n) acc[a][b][m][n] = (f32x4){0.f, 0.f, 0.f, 0.f};
    bf16x8 At[4][2], B0[2][2], B1[2][2];
    const char* cA = (const char*)g.A + (size_t)cur.pm * tstep; const char* cB = (const char*)g.Bt + (size_t)cur.pn * tstep;
    S.a_ready(cur);
    if constexpr (SP2) {
        PG8_STAGE(PG8_SB(0, 0), cB, voffB); PG8_STAGE(PG8_SB(0, 1), cB + hstep, voffB); PG8_STAGE(PG8_SA(0, 0), cA, voffA); PG8_STAGE(PG8_SA(0, 1), cA + hstep, voffA);
        if (wr == 1) PG8_BAR;
        PG8_WAIT_V(2); PG8_BAR;
        PG8_STAGE(PG8_SB(1, 0), cB + kstep, voffB); PG8_STAGE(PG8_SA(1, 0), cA + kstep, voffA); PG8_STAGE(PG8_SB(1, 1), cB + hstep + kstep, voffB);
        PG8_WAIT_V(6); PG8_BAR;
    } else {
        PG8_STAGE(PG8_SB(0, 0), cB, voffB); PG8_STAGE(PG8_SA(0, 0), cA, voffA); PG8_STAGE(PG8_SB(0, 1), cB + hstep, voffB); PG8_STAGE(PG8_SA(0, 1), cA + hstep, voffA);
        if (wr == 1) PG8_BAR;
        PG8_WAIT_V(4); PG8_BAR;
        PG8_STAGE(PG8_SB(1, 0), cB + kstep, voffB); PG8_STAGE(PG8_SA(1, 0), cA + kstep, voffA); PG8_STAGE(PG8_SB(1, 1), cB + hstep + kstep, voffB);
        PG8_WAIT_V(6); PG8_BAR;
    }
    for (;;) {
        const bool has_next = S.next(ui + 1, nxt);
        const char* nA = has_next ? (const char*)g.A + (size_t)nxt.pm * tstep : cA; const char* nB = has_next ? (const char*)g.Bt + (size_t)nxt.pn * tstep : cB;
        for (int t = 0; t < nt; t += 2) {
            const bool last = (t == nt - 2);
            const char* a1 = cA + (size_t)(t + 1) * kstep;
            const char* a2 = last ? nA : cA + (size_t)(t + 2) * kstep; const char* b2 = last ? nB : cB + (size_t)(t + 2) * kstep;
            const char* a3 = a2 + kstep; const char* b3 = b2 + kstep;
            if (last && has_next) S.a_ready(nxt);
            if constexpr (SP2) {
            PG8_LDB(B0, 0, 0); PG8_LDB(B1, 0, 1); PG8_SCHED; PG8_LDA(At, 0, 0); PG8_STAGE(PG8_SA(1, 1), a1 + hstep, voffA);
            PG8_WAIT_V(8); PG8_WAIT_L(0); PG8_BAR; PG8_MMA(0, 0, At, B0); PG8_MMA(0, 1, At, B1); PG8_BAR; PG8_SCHED;
            PG8_LDA(At, 0, 1); PG8_STAGE(PG8_SB(0, 0), b2, voffB); PG8_STAGE(PG8_SB(0, 1), b2 + hstep, voffB); PG8_STAGE(PG8_SA(0, 0), a2, voffA);
            PG8_WAIT_V(8); PG8_WAIT_L(0); PG8_BAR; PG8_MMA(1, 0, At, B0); PG8_MMA(1, 1, At, B1); PG8_BAR; PG8_SCHED;
            PG8_LDB(B0, 1, 0); PG8_LDB(B1, 1, 1); PG8_SCHED; PG8_LDA(At, 1, 0); PG8_STAGE(PG8_SA(0, 1), a2 + hstep, voffA);
            PG8_WAIT_V(8); PG8_WAIT_L(0); PG8_BAR; PG8_MMA(0, 0, At, B0); PG8_MMA(0, 1, At, B1); PG8_BAR; PG8_SCHED;
            PG8_LDA(At, 1, 1); PG8_STAGE(PG8_SB(1, 0), b3, voffB); PG8_STAGE(PG8_SB(1, 1), b3 + hstep, voffB); PG8_STAGE(PG8_SA(1, 0), a3, voffA);
            PG8_WAIT_V(8); PG8_WAIT_L(0); PG8_BAR; PG8_MMA(1, 0, At, B0); PG8_MMA(1, 1, At, B1); PG8_BAR; PG8_SCHED;
            } else {
            PG8_LDB(B0, 0, 0); PG8_SCHED; PG8_LDA(At, 0, 0); PG8_STAGE(PG8_SA(1, 1), a1 + hstep, voffA);
            PG8_WAIT_L(8); PG8_BAR; PG8_WAIT_L(0); PG8_MMA(0, 0, At, B0); PG8_BAR; PG8_SCHED;
            PG8_LDB(B1, 0, 1); PG8_STAGE(PG8_SB(0, 0), b2, voffB);
            PG8_BAR; PG8_WAIT_L(0); PG8_MMA(0, 1, At, B1); PG8_BAR;
            PG8_LDA(At, 0, 1); PG8_STAGE(PG8_SA(0, 0), a2, voffA);
            PG8_BAR; PG8_WAIT_L(0); PG8_MMA(1, 0, At, B0); PG8_BAR; PG8_SCHED;
            PG8_STAGE(PG8_SB(0, 1), b2 + hstep, voffB);
            PG8_WAIT_V(6); PG8_BAR; PG8_MMA(1, 1, At, B1); PG8_BAR;
            PG8_LDB(B0, 1, 0); PG8_SCHED; PG8_LDA(At, 1, 0); PG8_STAGE(PG8_SA(0, 1), a2 + hstep, voffA);
            PG8_WAIT_L(8); PG8_BAR; PG8_WAIT_L(0); PG8_MMA(0, 0, At, B0); PG8_BAR; PG8_SCHED;
            PG8_LDB(B1, 1, 1); PG8_STAGE(PG8_SB(1, 0), b3, voffB);
            PG8_BAR; PG8_WAIT_L(0); PG8_MMA(0, 1, At, B1); PG8_BAR;
            PG8_LDA(At, 1, 1); PG8_STAGE(PG8_SA(1, 0), a3, voffA);
            PG8_BAR; PG8_WAIT_L(0); PG8_MMA(1, 0, At, B0); PG8_BAR; PG8_SCHED;
            PG8_STAGE(PG8_SB(1, 1), b3 + hstep, voffB);
            PG8_WAIT_V(6); PG8_BAR; PG8_MMA(1, 1, At, B1); PG8_BAR;
            }
        }
        if constexpr (ALIGN_EPI) { if (wr == 0) PG8_BAR; }
        if constexpr (!Epi::AFTER_DRAIN) { E(acc, cur, wr, wc, fr, fq); S.done(cur); }
        if (!has_next) break;
#pragma unroll
        for (int a = 0; a < 2; ++a)
#pragma unroll
            for (int b = 0; b < 2; ++b)
#pragma unroll
                for (int m = 0; m < 4; ++m)
#pragma unroll
                    for (int n = 0; n < 2; ++n) acc[a][b][m][n] = (f32x4){0.f, 0.f, 0.f, 0.f};
        cur = nxt; cA = nA; cB = nB; ++ui;
        if constexpr (ALIGN_EPI) { if (wr == 1) PG8_BAR; }
    }
    PG8_WAIT_V(0);
    if constexpr (!ALIGN_EPI) { if (wr == 0) PG8_BAR; }
    PG8_BAR;
    if constexpr (Epi::AFTER_DRAIN) { E.fused(acc, cur, wr, wc, fr, fq, lds, wid, lane); S.done(cur); }
#undef PG8_SA
#undef PG8_SB
#undef PG8_STAGE
#undef PG8_LDA
#undef PG8_LDB
#undef PG8_MMA
#undef PG8_WAIT_V
#undef PG8_WAIT_L
#undef PG8_BAR
#undef PG8_SCHED
}
}

namespace mk {
#define GAS __attribute__((address_space(1)))
#define LAS __attribute__((address_space(3)))
typedef unsigned short bf16;
typedef unsigned v4u __attribute__((ext_vector_type(4)));
typedef float f32x4 __attribute__((ext_vector_type(4)));
typedef short bf16x8 __attribute__((ext_vector_type(8)));
typedef GAS unsigned gu32;
typedef GAS unsigned long long gu64;
#define RLX_AGENT __ATOMIC_RELAXED, __HIP_MEMORY_SCOPE_AGENT
#define LDS_WAIT() asm volatile("s_waitcnt lgkmcnt(0)" ::: "memory")
#define VM_WAIT() asm volatile("s_waitcnt vmcnt(0)" ::: "memory")
__device__ __forceinline__ unsigned long long rt() { return __builtin_amdgcn_s_memrealtime(); }
__device__ __forceinline__ unsigned f2bf(float f) { unsigned u = __builtin_bit_cast(unsigned, f); return (u + 0x7fffu + ((u >> 16) & 1u)) >> 16; }
__device__ __forceinline__ unsigned pk2(float lo, float hi) {
    typedef __bf16 bf2_t __attribute__((ext_vector_type(2))); typedef float f2_t __attribute__((ext_vector_type(2)));
    const f2_t v = {lo, hi}; const bf2_t b = __builtin_convertvector(v, bf2_t); return __builtin_bit_cast(unsigned, b); }

#define XB_TMO      128
#define XB_XCNT(j)  (256  + 64 * (j))
#define XB_XSUB(j)  (1280 + 64 * (j))
#define XB_XGEN(j)  (2304 + 64 * (j))
#define XB_TOP      3328
#define XB_TOPGEN   3392
#define XCD_BAR_WORDS 3456
#define XB_SPIN_CAP (1u << 18)

__device__ __forceinline__ unsigned xb_ld(unsigned* p)              { return __hip_atomic_load(p, __ATOMIC_RELAXED, __HIP_MEMORY_SCOPE_AGENT); }
__device__ __forceinline__ unsigned xb_add(unsigned* p, unsigned v) { return __hip_atomic_fetch_add(p, v, __ATOMIC_RELAXED, __HIP_MEMORY_SCOPE_AGENT); }
__device__ __forceinline__ unsigned xb_xcc_id() { return (unsigned)__builtin_amdgcn_s_getreg((3 << 11) | 20) & 0xFu; }
#define XB_SPIN(cond, bar) do { unsigned _sp = 0; while (cond) { __builtin_amdgcn_s_sleep(1); \
    if ((++_sp & 255u) == 0u) { if (xb_ld(&(bar)[XB_TMO])) break; if (_sp > XB_SPIN_CAP) { atomicAdd(&(bar)[XB_TMO], 1u); break; } } } } while (0)

struct XcdBarrier {
    unsigned* bar; unsigned x;
    volatile LAS unsigned* st;
};

__device__ __forceinline__ XcdBarrier xcd_barrier_post(unsigned* bar, volatile LAS unsigned* st) {
    XcdBarrier b; b.bar = bar; b.x = xb_xcc_id(); b.st = st;
    if (threadIdx.x == 0) (void)xb_add(&bar[XB_XCNT(b.x)], 1u);
    return b;
}
__device__ __forceinline__ void xcd_barrier_complete(unsigned* bar, unsigned x, unsigned& nloc, unsigned& nx) {
    const unsigned G = gridDim.x * gridDim.y * gridDim.z;
    unsigned sum, cnt, mine, sp = 0u;
    for (;;) {
        sum = 0u; cnt = 0u; mine = 0u;
#pragma unroll
        for (unsigned j = 0; j < 16; ++j) { const unsigned c = xb_ld(&bar[XB_XCNT(j)]); sum += c; cnt += (c > 0u) ? 1u : 0u; mine = (j == x) ? c : mine; }
        if (sum == G) break;
        __builtin_amdgcn_s_sleep(1);
        if ((++sp & 255u) == 0u) { if (xb_ld(&bar[XB_TMO])) break; if (sp > XB_SPIN_CAP) { atomicAdd(&bar[XB_TMO], 1u); break; } }
    }
    nloc = mine > 0u ? mine : 1u; nx = cnt > 0u ? cnt : 1u;
}

__device__ __forceinline__ void xcd_barrier(const XcdBarrier& b) {
    asm volatile("s_waitcnt vmcnt(0)" ::: "memory");
    __syncthreads();
    if (threadIdx.x == 0) {
        unsigned* bar = b.bar;
        __builtin_amdgcn_s_waitcnt(0);
        unsigned nloc = b.st[0], nx = b.st[1];
        if (nloc == 0u) { xcd_barrier_complete(bar, b.x, nloc, nx); b.st[0] = nloc; b.st[1] = nx; }
        const unsigned old = xb_add(&bar[XB_XSUB(b.x)], 1u);
        const unsigned gen = old / nloc;
        if (old + 1u == (gen + 1u) * nloc) {
            __builtin_amdgcn_fence(__ATOMIC_RELEASE, "agent");
            asm volatile("s_waitcnt vmcnt(0)" ::: "memory");
            const unsigned og = xb_add(&bar[XB_TOP], 1u);
            const unsigned tg = og / nx;
            if (og + 1u == (tg + 1u) * nx) xb_add(&bar[XB_TOPGEN], 1u);
            else XB_SPIN(xb_ld(&bar[XB_TOPGEN]) == tg, bar);
            __builtin_amdgcn_fence(__ATOMIC_ACQUIRE, "agent");
            xb_add(&bar[XB_XGEN(b.x)], 1u);
            asm volatile("s_waitcnt vmcnt(0)" ::: "memory");
        } else {
            XB_SPIN(xb_ld(&bar[XB_XGEN(b.x)]) == gen, bar);
            __builtin_amdgcn_fence(__ATOMIC_ACQUIRE, "agent");
            asm volatile("s_waitcnt vmcnt(0)" ::: "memory");
        }
    }
    __syncthreads();
}

}

namespace mk {
constexpr int NWAVES = 8, NTHREADS = 512;
constexpr size_t MiB = 1u << 20;
constexpr size_t WS_QIB = 325 * MiB, WS_KB = 342 * MiB, WS_VB = 351 * MiB, WS_KIB = 360 * MiB, WS_WIF = 363 * MiB;
constexpr size_t WS_OB = 390 * MiB, WS_GD = 423 * MiB;
constexpr size_t WS_IDX = 525 * MiB, WS_CNT = 542 * MiB, WS_SCS = 543 * MiB;
constexpr size_t WS_S = 548 * MiB;
constexpr size_t WS_SC = WS_S;
constexpr size_t WS_Z = WS_S, WS_H1F = WS_S + 65 * MiB, WS_H1B = WS_S + 130 * MiB, WS_PQB = WS_S + 163 * MiB, WS_H2F = WS_S + 228 * MiB, WS_H2B = WS_S + 293 * MiB;
constexpr size_t WS_GQ = WS_S + 326 * MiB, WS_GK = WS_S + 343 * MiB, WS_GV = WS_S + 360 * MiB, WS_GR = WS_S + 393 * MiB, WS_QT = WS_S + 426 * MiB, WS_DEC = WS_S + 442 * MiB,
                 WS_OGB = WS_S + 443 * MiB, WS_KT = WS_S + 476 * MiB;
constexpr size_t WS_DS = WS_S, WS_SPREV = WS_S + 128 * MiB;
constexpr size_t WS_CTL = 1060 * MiB, WS_WA = 1061 * MiB, WS_WO = 1066 * MiB, WS_WG = 1068 * MiB, WS_WGO = 1075 * MiB, WS_WPQ = 1077 * MiB, WS_PK = 1085 * MiB,
                 WS_UB = 1086 * MiB, WS_VBX = 1150 * MiB, WS_USC = 1118 * MiB, WS_TEID = 1120 * MiB, WS_TGATE = 1125 * MiB, WS_HD = 1134 * MiB, WS_KV8 = 1134 * MiB, WS_XB = 1214 * MiB, WS_QB = 1247 * MiB, WS_END = 1280 * MiB;
constexpr size_t CTL_ZERO_BYTES = 1 * MiB;
constexpr int CW_TMO = 0, CW_AMAXK = 256, CW_AMAXV = 320, CW_Q1 = 512, CW_XC = 1024, CW_BAR = 4096;
constexpr int WA_ROWS = 2176, WG_ROWS = 3104;
constexpr int GN_Q = 0, GN_K = 512, GN_V = 1024, GN_R = 2048, GN_GD = 3072;

constexpr int RING_BYTES = 131072, LDSCTL_OFF = RING_BYTES, MISC_OFF = LDSCTL_OFF + 320, INPTAB_OFF = LDSCTL_OFF + 512, LDS_BYTES = 147456;

typedef unsigned u32x4 __attribute__((ext_vector_type(4)));
typedef unsigned u32x2 __attribute__((ext_vector_type(2)));
#define MK_LAS __attribute__((address_space(3)))
__device__ __forceinline__ float bflo(unsigned w) { return __builtin_bit_cast(float, w << 16); }
__device__ __forceinline__ float bfhi(unsigned w) { return __builtin_bit_cast(float, w & 0xffff0000u); }
__device__ __forceinline__ float bf2f(unsigned short b) { return __builtin_bit_cast(float, (unsigned)b << 16); }
__device__ __forceinline__ u32x4 pack8(f32x4 a, f32x4 b) { u32x4 w; w.x = pk2(a[0], a[1]); w.y = pk2(a[2], a[3]); w.z = pk2(b[0], b[1]); w.w = pk2(b[2], b[3]); return w; }

#if defined(PROBE_REGION)
__device__ unsigned long long g_probe_acc;
#define TPB(k) unsigned long long tpb_##k = (PROBE_REGION == k) ? __builtin_amdgcn_s_memtime() : 0ull
#define TPE(k) do { if (PROBE_REGION == k) { tacc += __builtin_amdgcn_s_memtime() - tpb_##k; } } while (0)
#else
#define TPB(k)
#define TPE(k)
#endif
template <int NCT> __device__ __forceinline__ void skinny_tile(const bf16* __restrict__ A, int lda, const bf16* __restrict__ Bt, int K, int row0, int col0, f32x4 (&acc)[NCT], int lane) {
    const int fr = lane & 15, fq = lane >> 4;
    const bf16* ap = A + (size_t)(row0 + fr) * lda + fq * 8;
    const bf16* bp = Bt + (size_t)(col0 + fr) * K + fq * 8;
#pragma unroll
    for (int ct = 0; ct < NCT; ++ct) acc[ct] = (f32x4){0.f, 0.f, 0.f, 0.f};
#pragma unroll 1
    for (int k0 = 0; k0 < K; k0 += 128) {
        bf16x8 a[4], b[NCT][4];
#pragma unroll
        for (int j = 0; j < 4; ++j) a[j] = *(const bf16x8*)(ap + k0 + j * 32);
#pragma unroll
        for (int ct = 0; ct < NCT; ++ct)
#pragma unroll
            for (int j = 0; j < 4; ++j) b[ct][j] = *(const bf16x8*)(bp + (size_t)ct * 16 * K + k0 + j * 32);
        asm volatile("" ::: "memory");
#pragma unroll
        for (int ct = 0; ct < NCT; ++ct)
#pragma unroll
            for (int j = 0; j < 4; ++j) acc[ct] = __builtin_amdgcn_mfma_f32_16x16x32_bf16(b[ct][j], a[j], acc[ct], 0, 0, 0);
    }
}

__device__ __forceinline__ void p0_transpose_item(const float* __restrict__ W, int ldw, int K, bf16* __restrict__ WT, int dst_row0, int src_col0, int nvalid, int k0, MK_LAS float* scr, int lane) {
#pragma unroll 8
    for (int i = 0; i < 32; ++i) { const int kk = 2 * i + (lane >> 5), j = lane & 31; scr[kk * 33 + j] = j < nvalid ? W[(size_t)(k0 + kk) * ldw + src_col0 + j] : 0.f; }
    asm volatile("s_waitcnt lgkmcnt(0)" ::: "memory");
    const int c = lane & 7;
#pragma unroll
    for (int j = 0; j < 4; ++j) { const int n = (lane >> 3) + 8 * j; const MK_LAS float* s = scr + (8 * c) * 33 + n;
        u32x4 o; o.x = pk2(s[0 * 33], s[1 * 33]); o.y = pk2(s[2 * 33], s[3 * 33]); o.z = pk2(s[4 * 33], s[5 * 33]); o.w = pk2(s[6 * 33], s[7 * 33]);
        *(u32x4*)(WT + (size_t)(dst_row0 + n) * K + k0 + 8 * c) = o; }
    asm volatile("s_waitcnt lgkmcnt(0)" ::: "memory");
}
__device__ __forceinline__ void p0_convert(const float* __restrict__ src, bf16* __restrict__ dst, size_t n8, int gw, int ngw, int lane) {
    for (size_t i = (size_t)gw * 64 + lane; i < n8; i += (size_t)ngw * 64) {
        const f32x4 a = *(const f32x4*)(src + i * 8), b = *(const f32x4*)(src + i * 8 + 4);
        *(u32x4*)(dst + i * 8) = pack8(a, b);
    }
}

__device__ __forceinline__ void p0_quant_row(const float* __restrict__ src, unsigned char* __restrict__ dst, float* __restrict__ scale, int lane) {
    f32x4 v[4]; float am = 0.f;
#pragma unroll
    for (int q = 0; q < 4; ++q) { v[q] = *(const f32x4*)(src + lane * 16 + q * 4); am = fmaxf(am, fmaxf(fmaxf(fabsf(v[q][0]), fabsf(v[q][1])), fmaxf(fabsf(v[q][2]), fabsf(v[q][3])))); }
#pragma unroll
    for (int o = 1; o < 64; o <<= 1) am = fmaxf(am, __shfl_xor(am, o));
    const float inv = am > 0.f ? 448.f / am : 0.f;
    u32x4 w;
#pragma unroll
    for (int q = 0; q < 4; ++q) { int x = __builtin_amdgcn_cvt_pk_fp8_f32(v[q][0] * inv, v[q][1] * inv, 0, false); x = __builtin_amdgcn_cvt_pk_fp8_f32(v[q][2] * inv, v[q][3] * inv, x, true); w[q] = (unsigned)x; }
    *(u32x4*)(dst + lane * 16) = w;
    if (lane == 0) *scale = am * (1.f / 448.f);
}

__device__ __forceinline__ void p0_quant_rows4(const float* __restrict__ src, unsigned char* __restrict__ dst, float* __restrict__ scale, int lane) {
    f32x4 v[4][4]; float am[4];
#pragma unroll
    for (int r = 0; r < 4; ++r)
#pragma unroll
        for (int q = 0; q < 4; ++q) v[r][q] = *(const f32x4*)(src + (size_t)r * D + lane * 16 + q * 4);
#pragma unroll
    for (int r = 0; r < 4; ++r) { float a = 0.f;
#pragma unroll
        for (int q = 0; q < 4; ++q) a = fmaxf(a, fmaxf(fmaxf(fabsf(v[r][q][0]), fabsf(v[r][q][1])), fmaxf(fabsf(v[r][q][2]), fabsf(v[r][q][3]))));
        am[r] = a; }
#pragma unroll
    for (int o = 1; o < 64; o <<= 1) {
#pragma unroll
        for (int r = 0; r < 4; ++r) am[r] = fmaxf(am[r], __shfl_xor(am[r], o)); }
#pragma unroll
    for (int r = 0; r < 4; ++r) {
        const float inv = am[r] > 0.f ? 448.f / am[r] : 0.f;
        u32x4 w;
#pragma unroll
        for (int q = 0; q < 4; ++q) { int x = __builtin_amdgcn_cvt_pk_fp8_f32(v[r][q][0] * inv, v[r][q][1] * inv, 0, false); x = __builtin_amdgcn_cvt_pk_fp8_f32(v[r][q][2] * inv, v[r][q][3] * inv, x, true); w[q] = (unsigned)x; }
        *(u32x4*)(dst + (size_t)r * D + lane * 16) = w;
        if (lane == 0) scale[r] = am[r] * (1.f / 448.f);
    }
}

struct FAttnIn {
    bf16 *Qb, *Kb, *Vb, *QIb, *KIb; float* WIf; float* out;
    mutable float kmax = 0.f, vmax = 0.f;
    __device__ __forceinline__ static float amax8(f32x4 a, f32x4 b) { return fmaxf(fmaxf(fmaxf(fabsf(a[0]), fabsf(a[1])), fmaxf(fabsf(a[2]), fabsf(a[3]))), fmaxf(fmaxf(fabsf(b[0]), fabsf(b[1])), fmaxf(fabsf(b[2]), fabsf(b[3])))); }
    __device__ __forceinline__ float* okp(int row, size_t offp, size_t offs, int ld) const { return row < TP ? out + offp + (size_t)row * ld : out + offs + (size_t)(row - TP) * ld; }
    __device__ __forceinline__ void put8(int row, int col, f32x4 v0, f32x4 v1) const {
        const u32x4 w = pack8(v0, v1);
        if (col < AK) *(u32x4*)(Qb + (size_t)row * 1024 + col) = w;
        else if (col < AV) { *(u32x4*)(Kb + (size_t)row * 256 + (col - AK)) = w; float* o = okp(row, OUT_KP, OUT_KS, 256) + (col - AK); *(f32x4*)o = v0; *(f32x4*)(o + 4) = v1; kmax = fmaxf(kmax, amax8(v0, v1)); }
        else if (col < AQI) { *(u32x4*)(Vb + (size_t)row * 256 + (col - AV)) = w; float* o = okp(row, OUT_VP, OUT_VS, 256) + (col - AV); *(f32x4*)o = v0; *(f32x4*)(o + 4) = v1; vmax = fmaxf(vmax, amax8(v0, v1)); }
        else *(u32x4*)(QIb + (size_t)row * 512 + (col - AQI)) = w;
    }
    __device__ __forceinline__ void put4(int row, int col, f32x4 v) const {
        u32x2 w; w.x = pk2(v[0], v[1]); w.y = pk2(v[2], v[3]);
        if (col < AK) *(u32x2*)(Qb + (size_t)row * 1024 + col) = w;
        else if (col < AV) { *(u32x2*)(Kb + (size_t)row * 256 + (col - AK)) = w; *(f32x4*)(okp(row, OUT_KP, OUT_KS, 256) + (col - AK)) = v; }
        else if (col < AQI) { *(u32x2*)(Vb + (size_t)row * 256 + (col - AV)) = w; *(f32x4*)(okp(row, OUT_VP, OUT_VS, 256) + (col - AV)) = v; }
        else if (col < AKI) *(u32x2*)(QIb + (size_t)row * 512 + (col - AQI)) = w;
        else if (col < AWI) { *(u32x2*)(KIb + (size_t)row * 64 + (col - AKI)) = w; *(f32x4*)(okp(row, OUT_KIP, OUT_KIS, 64) + (col - AKI)) = v; }
        else if (col < ATT_N) *(f32x4*)(WIf + (size_t)row * 8 + (col - AWI)) = v * 0.04419417382415922f;
    }
};
}

namespace mk {
typedef float f32x2v __attribute__((ext_vector_type(2)));
typedef float f32x16 __attribute__((ext_vector_type(16)));
typedef short s16x4 __attribute__((ext_vector_type(4)));
typedef short v4i16_t __attribute__((ext_vector_type(4)));

__device__ __forceinline__ void score_load_q(const bf16* __restrict__ QIb, const float* __restrict__ WIf, size_t tok0, int lane, bf16x8 (&afr)[4], f32x4 (&w4)[4]) {
    const int r = lane & 31, kq = lane >> 5;
    const bf16* ap = QIb + (tok0 + (r >> 3)) * 512 + (r & 7) * 64 + kq * 8;
#pragma unroll
    for (int ks = 0; ks < 4; ++ks) afr[ks] = *(const bf16x8*)(ap + ks * 16);
#pragma unroll
    for (int ql = 0; ql < 4; ++ql) w4[ql] = *(const f32x4*)(WIf + (tok0 + ql) * 8 + 4 * kq);
}
__device__ __forceinline__ void score_tile(const bf16x8 (&afr)[4], const bf16x8 (&bfr)[4], const f32x4 (&w4)[4], float (&s)[4]) {
    f32x16 acc;
#pragma unroll
    for (int j = 0; j < 16; ++j) acc[j] = 0.f;
#pragma unroll
    for (int ks = 0; ks < 4; ++ks) acc = __builtin_amdgcn_mfma_f32_32x32x16_bf16(afr[ks], bfr[ks], acc, 0, 0, 0);
#pragma unroll
    for (int ql = 0; ql < 4; ++ql) {
        float p = 0.f;
#pragma unroll
        for (int jj = 0; jj < 4; ++jj) p = fmaf(fmaxf(acc[ql * 4 + jj], 0.f), w4[ql][jj], p);
        s[ql] = p + __shfl_xor(p, 32);
    }
}

__device__ __forceinline__ void quant_issue(const float* __restrict__ src, f32x4 (&v)[4], int lane) {
#pragma unroll
    for (int q = 0; q < 4; ++q) v[q] = *(const f32x4*)(src + lane * 16 + q * 4);
}
__device__ __forceinline__ void quant_finish(const f32x4 (&v)[4], unsigned char* __restrict__ dst, float* __restrict__ scale, int lane) {
    float am = 0.f;
#pragma unroll
    for (int q = 0; q < 4; ++q) am = fmaxf(am, fmaxf(fmaxf(fabsf(v[q][0]), fabsf(v[q][1])), fmaxf(fabsf(v[q][2]), fabsf(v[q][3]))));
#pragma unroll
    for (int o = 1; o < 64; o <<= 1) am = fmaxf(am, __shfl_xor(am, o));
    const float inv = am > 0.f ? 448.f / am : 0.f;
    u32x4 w;
#pragma unroll
    for (int q = 0; q < 4; ++q) { int x = __builtin_amdgcn_cvt_pk_fp8_f32(v[q][0] * inv, v[q][1] * inv, 0, false); x = __builtin_amdgcn_cvt_pk_fp8_f32(v[q][2] * inv, v[q][3] * inv, x, true); w[q] = (unsigned)x; }
    *(u32x4*)(dst + lane * 16) = w;
    if (lane == 0) *scale = am * (1.f / 448.f);
}
struct QuantTabs { const float* pu; const float* pv; unsigned char* uq; unsigned char* vq; float* us; float* vs;
    __device__ __forceinline__ const float* src(int r) const { return r < 2 * 16384 ? pu + (size_t)r * D : pv + (size_t)(r - 2 * 16384) * D; }
    __device__ __forceinline__ unsigned char* dst(int r) const { return r < 2 * 16384 ? uq + (size_t)r * D : vq + (size_t)(r - 2 * 16384) * D; }
    __device__ __forceinline__ float* sc(int r) const { return r < 2 * 16384 ? us + r : vs + (r - 2 * 16384); } };

__device__ __forceinline__ void phase_score(const bf16* __restrict__ QIb, const bf16* __restrict__ KIb, const float* __restrict__ WIf, const float* __restrict__ cache_ki, const int* __restrict__ page_table,
                                            float* __restrict__ SC, float* __restrict__ SCS, const QuantTabs QT_, LAS unsigned char* lds, int vcu, int G, int wave, int lane, int gw, int NGW) {
    const int c = lane & 31, kq = lane >> 5;
    int qrow = gw;
    constexpr int KST = 144, KBUF = 256 * KST;
    const int tid = wave * 64 + lane;
    for (int it = vcu; it < 512; it += G) {
        const int b = it >> 8, qt = b == 0 ? (it & 255) : 255 - (it & 255);
        const size_t tok0 = (size_t)b * SEQ + qt * 32 + wave * 4;
        bf16x8 afr[4]; f32x4 w4[4];
        score_load_q(QIb, WIf, tok0, lane, afr, w4);
        const int nc = (qt >> 3) + 1;
        const bf16* kbase = KIb + (size_t)b * SEQ * 64;
        u32x4 st[4];
#pragma unroll
        for (int i = 0; i < 4; ++i) { const int p = tid + i * 512; st[i] = *(const u32x4*)(kbase + (size_t)(p >> 3) * 64 + (p & 7) * 8); }
#pragma unroll
        for (int i = 0; i < 4; ++i) { const int p = tid + i * 512; *(LAS u32x4*)(lds + (p >> 3) * KST + (p & 7) * 16) = st[i]; }
        __syncthreads();
        for (int ch = 0; ch < nc; ++ch) {
            const bool more = ch + 1 < nc;
            f32x4 qv[4]; const bool qdo = qrow < 4 * 16384;
            if (qdo) quant_issue(QT_.src(qrow), qv, lane);
            if (more) {
#pragma unroll
                for (int i = 0; i < 4; ++i) { const int p = tid + i * 512; st[i] = *(const u32x4*)(kbase + ((size_t)(ch + 1) * 256 + (p >> 3)) * 64 + (p & 7) * 8); }
            }
            LAS unsigned char* kb = lds + (ch & 1) * KBUF;
            const int ntile = more ? 8 : (qt & 7) + 1;
            for (int kt8 = 0; kt8 < ntile; ++kt8) {
                bf16x8 bfr[4];
#pragma unroll
                for (int ks = 0; ks < 4; ++ks) bfr[ks] = *(LAS bf16x8*)(kb + (kt8 * 32 + c) * KST + ks * 32 + kq * 16);
                float sv[4]; score_tile(afr, bfr, w4, sv);
                float* o = SC + (tok0 + 2 * kq) * SEQ + (ch * 8 + kt8) * 32 + c;
                o[0] = kq ? sv[2] : sv[0]; o[SEQ] = kq ? sv[3] : sv[1];
            }
            if (qdo) { quant_finish(qv, QT_.dst(qrow), QT_.sc(qrow), lane); qrow += NGW; }
            if (more) {
                LAS unsigned char* nb = lds + ((ch + 1) & 1) * KBUF;
#pragma unroll
                for (int i = 0; i < 4; ++i) { const int p = tid + i * 512; *(LAS u32x4*)(nb + (p >> 3) * KST + (p & 7) * 16) = st[i]; }
            }
            __syncthreads();
        }
    }
    for (; qrow < 4 * 16384; qrow += NGW) { f32x4 qv[4]; quant_issue(QT_.src(qrow), qv, lane); quant_finish(qv, QT_.dst(qrow), QT_.sc(qrow), lane); }
    for (int it = gw; it < DB * NPAGES + DB; it += NGW) {
        const bool isnew = it >= DB * NPAGES;
        const int b = isnew ? it - DB * NPAGES : it / NPAGES, pg = isnew ? 0 : it % NPAGES;
        const size_t tok0 = (size_t)TP + b * DS;
        bf16x8 afr[4]; f32x4 w4[4];
        score_load_q(QIb, WIf, tok0, lane, afr, w4);
        if (!isnew) {
            const int phys = page_table[b * NPAGES + pg];
            for (int j = 0; j < 4; ++j) {
                const float* kp = cache_ki + ((size_t)phys * PAGE + j * 32 + c) * 64 + kq * 8;
                bf16x8 bfr[4];
#pragma unroll
                for (int ks = 0; ks < 4; ++ks) { const f32x4 x0 = *(const f32x4*)(kp + ks * 16), x1 = *(const f32x4*)(kp + ks * 16 + 4); const u32x4 w = pack8(x0, x1); bfr[ks] = __builtin_bit_cast(bf16x8, w); }
                float s[4]; score_tile(afr, bfr, w4, s);
                float* o = SCS + (size_t)(b * DS + 2 * kq) * SCS_LD + pg * PAGE + j * 32 + c;
                o[0] = kq ? s[2] : s[0]; o[SCS_LD] = kq ? s[3] : s[1];
            }
        } else {
            const bf16* kp = KIb + (tok0 + (c & 3)) * 64 + kq * 8;
            bf16x8 bfr[4];
#pragma unroll
            for (int ks = 0; ks < 4; ++ks) bfr[ks] = *(const bf16x8*)(kp + ks * 16);
            float s[4]; score_tile(afr, bfr, w4, s);
            if (c < 4) { float* o = SCS + (size_t)(b * DS + 2 * kq) * SCS_LD + PAST + c; o[0] = kq ? s[2] : s[0]; o[SCS_LD] = kq ? s[3] : s[1]; }
        }
    }
}

constexpr int VST = 144;
__device__ __forceinline__ bf16x8 ld_frag8(const bf16* p) { return *(const bf16x8*)p; }
__device__ __forceinline__ bf16x8 ld_frag8(const float* p) { const f32x4 a = *(const f32x4*)p, b = *(const f32x4*)(p + 4); const u32x4 w = pack8(a, b); return __builtin_bit_cast(bf16x8, w); }
__device__ __forceinline__ s16x4 lds_tr(LAS unsigned char* p) { return __builtin_bit_cast(s16x4, __builtin_amdgcn_ds_read_tr16_b64_v4i16((LAS v4i16_t*)p)); }

template <bool SAMPLE>
__device__ __forceinline__ void attn_row(int row, int n0, int n1, const bf16* __restrict__ Qb, const int* __restrict__ IDX, const int* __restrict__ CNT,
                                         const bf16* __restrict__ Kb, const bf16* __restrict__ Vb, const float* __restrict__ cache_k, const float* __restrict__ cache_v,
                                         const float* __restrict__ newk, const float* __restrict__ newv, const int* __restrict__ page_table,
                                         bf16* __restrict__ Ob, LAS unsigned char* wl, int lane) {
    const int fr = lane & 15, fq = lane >> 4;
    LAS int* rid = (LAS int*)wl;
    LAS unsigned char* vt = wl + 1024;
    const int cnt = CNT[row];
    const int b = SAMPLE ? (row - TP) / DS : row / SEQ;
#pragma unroll
    for (int i = 0; i < 4; ++i) { const int slot = i * 64 + lane; int key = slot < cnt ? IDX[(size_t)row * TOPK + slot] : 0; int id;
        if (!SAMPLE) id = b * SEQ + key;
        else if (key < PAST) id = page_table[b * NPAGES + key / PAGE] * PAGE + (key % PAGE);
        else id = (int)0x80000000 | (b * DS + (key - PAST));
        rid[slot] = id; }
    asm volatile("s_waitcnt lgkmcnt(0)" ::: "memory");
    for (int n = n0; n < n1; ++n) {
        bf16x8 qf[2];
#pragma unroll
        for (int ks = 0; ks < 2; ++ks) qf[ks] = *(const bf16x8*)(Qb + (size_t)row * 1024 + (n * 4 + (fr & 3)) * 64 + ks * 32 + fq * 8);
        f32x4 st[16];
        constexpr int TBN = SAMPLE ? 4 : 8;
#pragma unroll
        for (int tb = 0; tb < 16 / TBN; ++tb) {
            bf16x8 kf[TBN][2];
#pragma unroll
            for (int t = 0; t < TBN; ++t) {
                const int id = rid[(tb * TBN + t) * 16 + fr];
                if (!SAMPLE) { const bf16* kp = Kb + (size_t)id * 256 + n * 64 + fq * 8; kf[t][0] = ld_frag8(kp); kf[t][1] = ld_frag8(kp + 32); }
                else { const float* kp = (id < 0 ? newk + (size_t)(id & 0x7fffffff) * 256 : cache_k + (size_t)id * 256) + n * 64 + fq * 8; kf[t][0] = ld_frag8(kp); kf[t][1] = ld_frag8(kp + 32); }
            }
#pragma unroll
            for (int t = 0; t < TBN; ++t) {
                f32x4 a = (f32x4){0.f, 0.f, 0.f, 0.f};
                a = __builtin_amdgcn_mfma_f32_16x16x32_bf16(kf[t][0], qf[0], a, 0, 0, 0);
                a = __builtin_amdgcn_mfma_f32_16x16x32_bf16(kf[t][1], qf[1], a, 0, 0, 0);
                st[tb * TBN + t] = a;
            }
            asm volatile("" ::: "memory");
        }
        bf16x8 vreg[8];
#define ATT_VLOAD(ch_) do { _Pragma("unroll") for (int i = 0; i < 8; ++i) { const int sl = i * 8 + (lane >> 3), chunk = lane & 7; const int id = rid[(ch_) * 64 + sl]; \
            if (!SAMPLE) vreg[i] = ld_frag8(Vb + (size_t)id * 256 + n * 64 + chunk * 8); \
            else vreg[i] = ld_frag8((id < 0 ? newv + (size_t)(id & 0x7fffffff) * 256 : cache_v + (size_t)id * 256) + n * 64 + chunk * 8); } } while (0)
        ATT_VLOAD(0);
        float mx = -INFINITY;
#pragma unroll
        for (int t = 0; t < 16; ++t)
#pragma unroll
            for (int j = 0; j < 4; ++j) { const int slot = t * 16 + fq * 4 + j; const float v = slot < cnt ? st[t][j] * 0.125f : -INFINITY; st[t][j] = v; mx = fmaxf(mx, v); }
        mx = fmaxf(mx, __shfl_xor(mx, 16)); mx = fmaxf(mx, __shfl_xor(mx, 32));
        float sum = 0.f;
#pragma unroll
        for (int t = 0; t < 16; ++t)
#pragma unroll
            for (int j = 0; j < 4; ++j) { const float e = __expf(st[t][j] - mx); st[t][j] = e; sum += e; }
        sum += __shfl_xor(sum, 16); sum += __shfl_xor(sum, 32);
        f32x4 oacc[4];
#pragma unroll
        for (int dt = 0; dt < 4; ++dt) oacc[dt] = (f32x4){0.f, 0.f, 0.f, 0.f};
#pragma unroll
        for (int ch = 0; ch < 4; ++ch) {
#pragma unroll
            for (int i = 0; i < 8; ++i) { const int sl = i * 8 + (lane >> 3), chunk = lane & 7; *(LAS bf16x8*)(vt + sl * VST + chunk * 16) = vreg[i]; }
            asm volatile("s_waitcnt lgkmcnt(0)" ::: "memory");
            if (ch < 3) ATT_VLOAD(ch + 1);
#pragma unroll
            for (int s2 = 0; s2 < 2; ++s2) {
                const int t0 = ch * 4 + s2 * 2;
                const u32x4 pw = pack8(st[t0], st[t0 + 1]);
                const bf16x8 pf = __builtin_bit_cast(bf16x8, pw);
#pragma unroll
                for (int dt = 0; dt < 4; ++dt) {
                    LAS unsigned char* a0 = vt + (s2 * 32 + fq * 4 + (fr >> 2)) * VST + (dt * 16 + 4 * (fr & 3)) * 2;
                    const s16x4 v0 = lds_tr(a0), v1 = lds_tr(a0 + 16 * VST);
                    bf16x8 vf; vf[0] = v0[0]; vf[1] = v0[1]; vf[2] = v0[2]; vf[3] = v0[3]; vf[4] = v1[0]; vf[5] = v1[1]; vf[6] = v1[2]; vf[7] = v1[3];
                    oacc[dt] = __builtin_amdgcn_mfma_f32_16x16x32_bf16(pf, vf, oacc[dt], 0, 0, 0);
                }
            }
            asm volatile("s_waitcnt lgkmcnt(0)" ::: "memory");
        }
#undef ATT_VLOAD
        const float i0 = 1.f / __shfl(sum, 0), i1 = 1.f / __shfl(sum, 1), i2 = 1.f / __shfl(sum, 2), i3 = 1.f / __shfl(sum, 3);
        if (fq == 0) {
#pragma unroll
            for (int dt = 0; dt < 4; ++dt) {
                bf16* o = Ob + (size_t)row * 1024 + (n * 4) * 64 + dt * 16 + fr;
                o[0] = (bf16)f2bf(oacc[dt][0] * i0); o[64] = (bf16)f2bf(oacc[dt][1] * i1); o[128] = (bf16)f2bf(oacc[dt][2] * i2); o[192] = (bf16)f2bf(oacc[dt][3] * i3);
            }
        }
    }
    asm volatile("s_waitcnt lgkmcnt(0)" ::: "memory");
}

__device__ __forceinline__ void kv8_convert(const bf16* __restrict__ Kb, const bf16* __restrict__ Vb, unsigned char* __restrict__ KV8_, const unsigned* __restrict__ amaxk, const unsigned* __restrict__ amaxv, int gw, int NGW, int lane) {
    const float ak = __builtin_bit_cast(float, __hip_atomic_load(amaxk, __ATOMIC_RELAXED, __HIP_MEMORY_SCOPE_AGENT)), av = __builtin_bit_cast(float, __hip_atomic_load(amaxv, __ATOMIC_RELAXED, __HIP_MEMORY_SCOPE_AGENT));
    const bool isv = lane >= 32; const int l = lane & 31;
    const float sc = isv ? (av > 0.f ? 448.f / av : 0.f) : (ak > 0.f ? 448.f / ak : 0.f);
    for (int t = gw; t < TP; t += NGW) {
        const u32x4 w = *(const u32x4*)((isv ? Vb : Kb) + (size_t)t * 256 + l * 8);
        const float x0 = bflo(w.x) * sc, x1 = bfhi(w.x) * sc, x2 = bflo(w.y) * sc, x3 = bfhi(w.y) * sc, x4 = bflo(w.z) * sc, x5 = bfhi(w.z) * sc, x6 = bflo(w.w) * sc, x7 = bfhi(w.w) * sc;
        int p0 = __builtin_amdgcn_cvt_pk_fp8_f32(x0, x1, 0, false); p0 = __builtin_amdgcn_cvt_pk_fp8_f32(x2, x3, p0, true);
        int p1 = __builtin_amdgcn_cvt_pk_fp8_f32(x4, x5, 0, false); p1 = __builtin_amdgcn_cvt_pk_fp8_f32(x6, x7, p1, true);
        const int n = l >> 3, d0 = (l & 7) * 8;
        const int pos = isv ? 64 + d0 : ((d0 & 31) >> 3) * 16 + (d0 >> 5) * 8;
        u32x2 o; o.x = (unsigned)p0; o.y = (unsigned)p1;
        *(u32x2*)(KV8_ + (size_t)t * 512 + n * 128 + pos) = o;
    }
}
__device__ __forceinline__ void fp8x16_to_bf16(const u32x4 q, bf16x8& lo, bf16x8& hi) {
    u32x4 a, b;
#pragma unroll
    for (int w = 0; w < 4; ++w) { const f32x2v f0 = __builtin_amdgcn_cvt_pk_f32_fp8((int)q[w], false), f1 = __builtin_amdgcn_cvt_pk_f32_fp8((int)q[w], true);
        const unsigned u0 = pk2(f0[0], f0[1]), u1 = pk2(f1[0], f1[1]);
        if (w < 2) { a[2 * w] = u0; a[2 * w + 1] = u1; } else { b[2 * w - 4] = u0; b[2 * w - 3] = u1; } }
    lo = __builtin_bit_cast(bf16x8, a); hi = __builtin_bit_cast(bf16x8, b);
}
#ifndef KF1
#define KF1 10
#endif
__device__ __forceinline__ void attn_prompt_stream(int b, int n, int q0, int qstep, const bf16* __restrict__ Qb, const int* __restrict__ IDX, const unsigned char* __restrict__ KV8_, const unsigned* __restrict__ amaxk, const unsigned* __restrict__ amaxv,
                                                   bf16* __restrict__ Ob, LAS unsigned char* wl, int lane) {
    const float ak_ = __builtin_bit_cast(float, __hip_atomic_load(amaxk, __ATOMIC_RELAXED, __HIP_MEMORY_SCOPE_AGENT)), av_ = __builtin_bit_cast(float, __hip_atomic_load(amaxv, __ATOMIC_RELAXED, __HIP_MEMORY_SCOPE_AGENT));
    const float kinv = ak_ * (1.f / 448.f), vinv = av_ * (1.f / 448.f);
    const int fr = lane & 15, fq = lane >> 4;
    LAS int* ridb = (LAS int*)wl;
    LAS unsigned char* vt = wl + 2048;
    if (q0 >= SEQ) return;
    int vx[4];
    { const int row = b * SEQ + q0, cnt = q0 + 1 < TOPK ? q0 + 1 : TOPK;
#pragma unroll
      for (int i = 0; i < 4; ++i) { const int slot = i * 64 + lane; ridb[slot] = b * SEQ + (slot < cnt ? IDX[(size_t)row * TOPK + slot] : 0); } }
    int buf = 0;
    unsigned long long tacc = 0ull; TPB(14);
    for (int q = q0; q < SEQ; q += qstep, buf ^= 1) {
        TPB(10);
        const int row = b * SEQ + q, cnt = q + 1 < TOPK ? q + 1 : TOPK;
        LAS int* rid = ridb + buf * 256;
        asm volatile("s_waitcnt lgkmcnt(0)" ::: "memory");
        int kx[16];
#pragma unroll
        for (int t = 0; t < 16; ++t) kx[t] = rid[t * 16 + fr];
        bf16x8 qf[2];
#pragma unroll
        for (int ks = 0; ks < 2; ++ks) qf[ks] = *(const bf16x8*)(Qb + (size_t)row * 1024 + (n * 4 + (fr & 3)) * 64 + ks * 32 + fq * 8);
        u32x4 kraw[16];
#pragma unroll
        for (int t = 0; t < 16; ++t) kraw[t] = *(const u32x4*)(KV8_ + (size_t)kx[t] * 512 + n * 128 + fq * 16);
        asm volatile("s_waitcnt lgkmcnt(0)" ::: "memory");
        u32x4 vraw[4];
#define ATT_VLOAD2(ch_) do { _Pragma("unroll") for (int i = 0; i < 4; ++i) { const int sl = i * 16 + (lane >> 2), piece = lane & 3; const int id = rid[(ch_) * 64 + sl]; \
            vraw[i] = *(const u32x4*)(KV8_ + (size_t)id * 512 + n * 128 + 64 + piece * 16); } } while (0)
        f32x4 st[16];
#pragma unroll
        for (int t = 0; t < 16; ++t) {
            asm volatile("" : "+v"(kraw[t][0]), "+v"(kraw[t][1]), "+v"(kraw[t][2]), "+v"(kraw[t][3]));
            bf16x8 k0, k1; fp8x16_to_bf16(kraw[t], k0, k1);
            f32x4 a = (f32x4){0.f, 0.f, 0.f, 0.f};
            a = __builtin_amdgcn_mfma_f32_16x16x32_bf16(k0, qf[0], a, 0, 0, 0);
            a = __builtin_amdgcn_mfma_f32_16x16x32_bf16(k1, qf[1], a, 0, 0, 0);
            st[t] = a;
            asm volatile("" : "+v"(st[t][0]), "+v"(st[t][1]), "+v"(st[t][2]), "+v"(st[t][3]));
        }
        TPE(10); TPB(11);
        const int qn = q + qstep;
        if (qn < SEQ) { const int rown = b * SEQ + qn, cntn = qn + 1 < TOPK ? qn + 1 : TOPK;
#pragma unroll
            for (int i = 0; i < 4; ++i) { const int slot = i * 64 + lane; vx[i] = slot < cntn ? IDX[(size_t)rown * TOPK + slot] : 0; } }
        ATT_VLOAD2(0);
        float mx = -INFINITY;
        if (cnt < TOPK) {
#pragma unroll
            for (int t = 0; t < 16; ++t)
#pragma unroll
                for (int j = 0; j < 4; ++j) { const int slot = t * 16 + fq * 4 + j; st[t][j] = slot < cnt ? st[t][j] : -INFINITY; }
        }
#pragma unroll
        for (int t = 0; t < 16; ++t) mx = fmaxf(mx, fmaxf(fmaxf(st[t][0], st[t][1]), fmaxf(st[t][2], st[t][3])));
        mx = fmaxf(mx, __shfl_xor(mx, 16)); mx = fmaxf(mx, __shfl_xor(mx, 32));
        const float cs = 0.18033688011112042f * kinv, mb = -mx * cs;
        float sum = 0.f;
#pragma unroll
        for (int t = 0; t < 16; ++t)
#pragma unroll
            for (int j = 0; j < 4; ++j) { const float e = __builtin_amdgcn_exp2f(fmaf(st[t][j], cs, mb)); st[t][j] = e; sum += e; }
        sum += __shfl_xor(sum, 16); sum += __shfl_xor(sum, 32);
        TPE(11); TPB(12);
        f32x4 oacc[4];
#pragma unroll
        for (int dt = 0; dt < 4; ++dt) oacc[dt] = (f32x4){0.f, 0.f, 0.f, 0.f};
#pragma unroll
        for (int ch = 0; ch < 4; ++ch) {
#pragma unroll
            for (int i = 0; i < 4; ++i) { const int sl = i * 16 + (lane >> 2), piece = lane & 3; bf16x8 v0, v1; fp8x16_to_bf16(vraw[i], v0, v1);
                *(LAS bf16x8*)(vt + sl * VST + piece * 32) = v0; *(LAS bf16x8*)(vt + sl * VST + piece * 32 + 16) = v1; }
            asm volatile("s_waitcnt lgkmcnt(0)" ::: "memory");
            if (ch < 3) ATT_VLOAD2(ch + 1);
#pragma unroll
            for (int s2 = 0; s2 < 2; ++s2) {
                const int t0 = ch * 4 + s2 * 2;
                const u32x4 pw = pack8(st[t0], st[t0 + 1]);
                const bf16x8 pf = __builtin_bit_cast(bf16x8, pw);
#pragma unroll
                for (int dt = 0; dt < 4; ++dt) {
                    LAS unsigned char* a0 = vt + (s2 * 32 + fq * 4 + (fr >> 2)) * VST + (dt * 16 + 4 * (fr & 3)) * 2;
                    const s16x4 v0 = lds_tr(a0), v1 = lds_tr(a0 + 16 * VST);
                    bf16x8 vf; vf[0] = v0[0]; vf[1] = v0[1]; vf[2] = v0[2]; vf[3] = v0[3]; vf[4] = v1[0]; vf[5] = v1[1]; vf[6] = v1[2]; vf[7] = v1[3];
                    oacc[dt] = __builtin_amdgcn_mfma_f32_16x16x32_bf16(pf, vf, oacc[dt], 0, 0, 0);
                }
            }
            asm volatile("s_waitcnt lgkmcnt(0)" ::: "memory");
        }
#undef ATT_VLOAD2
        TPE(12); TPB(13);
        const float i0 = vinv / __shfl(sum, 0), i1 = vinv / __shfl(sum, 1), i2 = vinv / __shfl(sum, 2), i3 = vinv / __shfl(sum, 3);
        if (fq == 0) {
#pragma unroll
            for (int dt = 0; dt < 4; ++dt) {
                bf16* o = Ob + (size_t)row * 1024 + (n * 4) * 64 + dt * 16 + fr;
                o[0] = (bf16)f2bf(oacc[dt][0] * i0); o[64] = (bf16)f2bf(oacc[dt][1] * i1); o[128] = (bf16)f2bf(oacc[dt][2] * i2); o[192] = (bf16)f2bf(oacc[dt][3] * i3);
            }
        }
        if (qn < SEQ) {
#pragma unroll
            for (int i = 0; i < 4; ++i) ridb[(buf ^ 1) * 256 + i * 64 + lane] = vx[i] + b * SEQ;
        }
        TPE(13);
    }
    TPE(14);
#if defined(PROBE_REGION)
    if (PROBE_REGION >= 10 && PROBE_REGION <= 14 && q0 == PROBE_WAVE && lane == 0) g_probe_acc = tacc;
#endif
    asm volatile("s_waitcnt lgkmcnt(0)" ::: "memory");
}

__device__ __forceinline__ void ln_row_wave(const float* __restrict__ zrow, const float* __restrict__ g, const float* __restrict__ bt, float* __restrict__ of, bf16* __restrict__ ob, int lane) {
    f32x4 v[4]; float s = 0.f;
#pragma unroll
    for (int j = 0; j < 4; ++j) { v[j] = *(const f32x4*)(zrow + 256 * j + 4 * lane); s += (v[j][0] + v[j][1]) + (v[j][2] + v[j][3]); }
#pragma unroll
    for (int o = 1; o < 64; o <<= 1) s += __shfl_xor(s, o);
    const float mean = s * (1.f / D); float q = 0.f;
#pragma unroll
    for (int j = 0; j < 4; ++j) { v[j] = v[j] - mean; q += (v[j][0] * v[j][0] + v[j][1] * v[j][1]) + (v[j][2] * v[j][2] + v[j][3] * v[j][3]); }
#pragma unroll
    for (int o = 1; o < 64; o <<= 1) q += __shfl_xor(q, o);
    const float rstd = rsqrtf(q * (1.f / D) + LN_EPS);
#pragma unroll
    for (int j = 0; j < 4; ++j) { const f32x4 gg = *(const f32x4*)(g + 256 * j + 4 * lane), bb = *(const f32x4*)(bt + 256 * j + 4 * lane); const f32x4 o = v[j] * rstd * gg + bb;
        if (of) *(f32x4*)(of + 256 * j + 4 * lane) = o; u32x2 w; w.x = pk2(o[0], o[1]); w.y = pk2(o[2], o[3]); *(u32x2*)(ob + 256 * j + 4 * lane) = w; }
}

struct FResid {
    const float* rp; const float* rs; float* Z;
    __device__ __forceinline__ const float* rrow(int row) const { return row < TP ? rp + (size_t)row * D : rs + (size_t)(row - TP) * D; }
    __device__ __forceinline__ void put8(int row, int col, f32x4 v0, f32x4 v1) const { const float* r = rrow(row) + col; float* z = Z + (size_t)row * D + col;
        *(f32x4*)z = v0 + ALPHA * *(const f32x4*)r; *(f32x4*)(z + 4) = v1 + ALPHA * *(const f32x4*)(r + 4); }
    __device__ __forceinline__ void put4(int row, int col, f32x4 v) const { *(f32x4*)(Z + (size_t)row * D + col) = v + ALPHA * *(const f32x4*)(rrow(row) + col); }
};
}

namespace mk {
template <int CAP>
__device__ __forceinline__ void topk_wave_regs(const float* __restrict__ row, int n, int* __restrict__ out, LAS unsigned* hist, LAS float* cv, LAS int* ci, LAS unsigned char* lst, int lane, unsigned long long& tacc) {
    if (n <= TOPK) { for (int i = lane; i < TOPK; i += 64) out[i] = i < n ? i : 0; return; }
    TPB(1);
    constexpr int NCH = 32;
    const int nch = n > 8192 ? 32 : (n + 255) >> 8;
    float vx = (lane < 4 && 8192 + lane < n) ? row[8192 + lane] : -INFINITY;
    f32x4 v[NCH];
#pragma unroll
    for (int j = 0; j < NCH; ++j) {
        if (j < nch) v[j] = *(const f32x4*)(row + j * 256 + lane * 4);
        else v[j] = (f32x4){-INFINITY, -INFINITY, -INFINITY, -INFINITY};
    }
    float mn = INFINITY, mx = -INFINITY;
#pragma unroll
    for (int j = 0; j < NCH; ++j) {
        if (j < nch) {
            const int base = j * 256 + lane * 4;
#pragma unroll
            for (int e = 0; e < 4; ++e) { const bool ok = base + e < n; const float x = v[j][e]; v[j][e] = ok ? x : -INFINITY; mx = fmaxf(mx, ok ? x : -INFINITY); mn = fminf(mn, ok ? x : INFINITY); }
        }
    }
    if (vx != -INFINITY) { mx = fmaxf(mx, vx); mn = fminf(mn, vx); }
#pragma unroll
    for (int o = 1; o < 64; o <<= 1) { mn = fminf(mn, __shfl_xor(mn, o)); mx = fmaxf(mx, __shfl_xor(mx, o)); }
    if (!(mx > mn)) { for (int i = lane; i < TOPK; i += 64) out[i] = i; return; }
    const float scale = 2048.0f / (mx - mn);
    TPE(1); TPB(2);
#pragma unroll
    for (int i = 0; i < 8; ++i) *(LAS u32x4*)(hist + i * 256 + lane * 4) = (u32x4){0u, 0u, 0u, 0u};
    asm volatile("s_waitcnt lgkmcnt(0)" ::: "memory");
#pragma unroll
    for (int j = 0; j < NCH; ++j) {
        if (j < nch) {
            asm volatile("" : "+v"(v[j][0]), "+v"(v[j][1]), "+v"(v[j][2]), "+v"(v[j][3]));
#pragma unroll
            for (int e = 0; e < 4; ++e) { const float x = v[j][e]; int bn = (int)((x - mn) * scale); bn = bn > 2047 ? 2047 : bn; bn = x != -INFINITY ? bn : 2048;
                __hip_atomic_fetch_add(hist + bn, 1u, __ATOMIC_RELAXED, __HIP_MEMORY_SCOPE_WAVEFRONT); }
        }
    }
    if (vx != -INFINITY) { int bn = (int)((vx - mn) * scale); bn = bn > 2047 ? 2047 : bn; __hip_atomic_fetch_add(hist + bn, 1u, __ATOMIC_RELAXED, __HIP_MEMORY_SCOPE_WAVEFRONT); }
    asm volatile("s_waitcnt lgkmcnt(0)" ::: "memory");
    TPE(2); TPB(3);
    unsigned mine = 0u;
#pragma unroll
    for (int i = 0; i < 8; ++i) { const u32x4 h4 = *(LAS u32x4*)(hist + lane * 32 + i * 4); mine += (h4.x + h4.y) + (h4.z + h4.w); }
    unsigned suf = mine;
#pragma unroll
    for (int o = 1; o < 64; o <<= 1) { const unsigned t = __shfl_down(suf, o); if (lane + o < 64) suf += t; }
    const unsigned long long bal = __ballot(suf >= (unsigned)TOPK);
    const int Lt = 63 - __builtin_clzll(bal);
    const unsigned above = __shfl(suf, Lt) - __shfl(mine, Lt);
    const unsigned hb = hist[Lt * 32 + (lane & 31)];
    unsigned sfx = hb;
#pragma unroll
    for (int o = 1; o < 32; o <<= 1) { const unsigned t = __shfl_down(sfx, o); if ((lane & 31) + o < 32) sfx += t; }
    const unsigned long long okm = __ballot(above + sfx >= (unsigned)TOPK) & 0xFFFFFFFFull;
    const int jb = 63 - __builtin_clzll(okm);
    const int B = Lt * 32 + jb;
    const unsigned running = above + __shfl(sfx, jb) - __shfl(hb, jb);
    const int cnt_gt = (int)running, r = TOPK - cnt_gt;
    TPE(3); TPB(4);
    int base_gt = 0, base_eq = 0;
    const unsigned long long below = (1ull << lane) - 1ull;
    int lane4 = lane * 4; asm volatile("" : "+v"(lane4));
#pragma unroll
    for (int j = 0; j < NCH; ++j) {
        if (j < nch) {
#pragma unroll
            for (int e = 0; e < 4; ++e) {
                const float x = v[j][e]; int bn = (int)((x - mn) * scale); bn = bn > 2047 ? 2047 : bn; bn = x != -INFINITY ? bn : -1;
                const bool gt = bn > B, eq = bn == B;
                const unsigned long long mg = __ballot(gt), me = __ballot(eq);
                if (mg | me) {
                    const int idx = lane4 + (j * 256 + e);
                    if (gt) out[base_gt + __builtin_popcountll(mg & below)] = idx;
                    if (eq) { const int p = base_eq + __builtin_popcountll(me & below); if (p < CAP) { cv[p] = x; ci[p] = idx; } }
                    base_gt += __builtin_popcountll(mg); base_eq += __builtin_popcountll(me);
                }
            }
        }
    }
    if (n > 8192) {
        const float x = vx; bool gt = false, eq = false;
        if (x != -INFINITY) { int bn = (int)((x - mn) * scale); bn = bn > 2047 ? 2047 : bn; gt = bn > B; eq = bn == B; }
        const unsigned long long mg = __ballot(gt), me = __ballot(eq);
        const int idx = 8192 + lane;
        if (gt) out[base_gt + __builtin_popcountll(mg & below)] = idx;
        if (eq) { const int p = base_eq + __builtin_popcountll(me & below); if (p < CAP) { cv[p] = x; ci[p] = idx; } }
        base_gt += __builtin_popcountll(mg); base_eq += __builtin_popcountll(me);
    }
    asm volatile("s_waitcnt vmcnt(0) lgkmcnt(0)" ::: "memory");
    TPE(4); TPB(5);
    const int m = base_eq < CAP ? base_eq : CAP;
    if (m <= 64) {
        const float x = lane < m ? cv[lane] : -INFINITY; const int id = lane < m ? ci[lane] : 0x7fffffff; int rank = 0;
        for (int c2 = 0; c2 < m; ++c2) { const float x2 = __builtin_bit_cast(float, __builtin_amdgcn_readlane(__builtin_bit_cast(int, x), c2)); const int id2 = __builtin_amdgcn_readlane(id, c2);
            rank += (x2 > x || (x2 == x && id2 < id)) ? 1 : 0; }
        if (lane < m && rank < r) out[cnt_gt + rank] = id;
    } else {
        for (int c = lane; c < m; c += 64) {
            const float x = cv[c]; const int id = ci[c]; int rank = 0;
            for (int c2 = 0; c2 < m; ++c2) { const float x2 = cv[c2]; const int id2 = ci[c2]; rank += (x2 > x || (x2 == x && id2 < id)) ? 1 : 0; }
            if (rank < r) out[cnt_gt + rank] = id;
        }
    }
    asm volatile("s_waitcnt lgkmcnt(0)" ::: "memory");
    TPE(5);
}

__device__ __forceinline__ void phase_topk2(const float* __restrict__ SC, const float* __restrict__ SCS, int* __restrict__ IDX, int* __restrict__ CNT,
                                            const float* __restrict__ peer_u_, const float* __restrict__ peer_v_, unsigned char* __restrict__ Uq_, unsigned char* __restrict__ Vq_, float* __restrict__ Usc_, float* __restrict__ Vsc_,
                                            LAS unsigned char* lds, unsigned* qhead, int wave, int lane, int gw, int NGW, int jlo = 0, int jhi = TA) {
    constexpr int CAP = 1020;
    LAS unsigned* hist = (LAS unsigned*)(lds + wave * 16384);
    LAS float* cv = (LAS float*)(lds + wave * 16384 + 8208);
    LAS int* ci = (LAS int*)(lds + wave * 16384 + 8208 + 4080);
    LAS unsigned char* lst = nullptr;
    unsigned long long tacc = 0ull; TPB(7);
    for (int j = gw; j < TA; j += NGW) {
        if (j < jlo || j >= jhi) continue;
        int row, n; const float* rp;
        if (j < TP) { const int b = j >> 13, jj = j & 8191, blk = jj >> 11; const int q = blk < 2 ? jj : blk * 2048 + 2047 - (jj & 2047);
            row = b * SEQ + q; n = q + 1; rp = SC + (size_t)row * SEQ; }
        else { const int r = j - TP; row = j; n = PAST + (r % DS) + 1; rp = SCS + (size_t)r * SCS_LD; }
        TPB(6);
        topk_wave_regs<CAP>(rp, n, IDX + (size_t)row * TOPK, hist, cv, ci, lst, lane, tacc);
        TPE(6);
        if (lane == 0) CNT[row] = n < TOPK ? n : TOPK;
    }
    TPE(7);
#if defined(PROBE_REGION)
    if (PROBE_REGION >= 1 && PROBE_REGION <= 7 && gw == PROBE_WAVE && lane == 0) g_probe_acc = tacc;
#endif
}
}

namespace mk {
using bf16x2_t = __attribute__((ext_vector_type(2))) __bf16;
__device__ __forceinline__ float dot2bf(unsigned a, unsigned b, float acc) { return __builtin_amdgcn_fdot2_f32_bf16(__builtin_bit_cast(bf16x2_t, a), __builtin_bit_cast(bf16x2_t, b), acc, false); }

struct FStoreBf16 {
    bf16* O; int ld;
    __device__ __forceinline__ void put8(int row, int col, f32x4 v0, f32x4 v1) const { *(u32x4*)(O + (size_t)row * ld + col) = pack8(v0, v1); }
    __device__ __forceinline__ void put4(int row, int col, f32x4 v) const { u32x2 w; w.x = pk2(v[0], v[1]); w.y = pk2(v[2], v[3]); *(u32x2*)(O + (size_t)row * ld + col) = w; }
};

#ifndef PGS
#define PGS 8
#endif
constexpr int PEER_TAB_OFF = LDSCTL_OFF + 1024;

__device__ __forceinline__ void ce_desc(unsigned& a, unsigned& b) { const unsigned hi = a > b ? a : b, lo = a > b ? b : a; a = hi; b = lo; }
template <int N> __device__ __forceinline__ void bitonic_sort_desc(unsigned (&k)[N]) {
#pragma unroll
    for (int size = 2; size <= N; size <<= 1)
#pragma unroll
        for (int stride = size >> 1; stride > 0; stride >>= 1)
#pragma unroll
            for (int i = 0; i < N; ++i) { const int j = i ^ stride; if (j > i) { if ((i & size) == 0) ce_desc(k[i], k[j]); else ce_desc(k[j], k[i]); } }
}
template <int N> __device__ __forceinline__ void bitonic_merge_desc(unsigned (&k)[N]) {
#pragma unroll
    for (int stride = N >> 1; stride > 0; stride >>= 1)
#pragma unroll
        for (int i = 0; i < N; ++i) { const int j = i ^ stride; if (j > i) ce_desc(k[i], k[j]); }
}
__device__ __forceinline__ void top16_merge(unsigned (&a)[16], const unsigned (&b)[16]) {
#pragma unroll
    for (int i = 0; i < 16; ++i) a[i] = a[i] > b[15 - i] ? a[i] : b[15 - i];
    bitonic_merge_desc<16>(a);
}
__device__ __forceinline__ void top16_xlane(unsigned (&a)[16], int o) {
    unsigned b[16];
#pragma unroll
    for (int i = 0; i < 16; ++i) b[i] = (unsigned)__shfl_xor((int)a[i], o);
    top16_merge(a, b);
}
__device__ __forceinline__ unsigned f2ord(float f) { const unsigned u = __builtin_bit_cast(unsigned, f); return u ^ ((u >> 31) ? 0xFFFFFFFFu : 0x80000000u); }
__device__ __forceinline__ float ord2f(unsigned o) { const unsigned u = o ^ ((o >> 31) ? 0x80000000u : 0xFFFFFFFFu); return __builtin_bit_cast(float, u); }

__device__ __forceinline__ void phase_peer_select(const bf16* __restrict__ PQb, const bf16* __restrict__ K1, const bf16* __restrict__ K2, unsigned short* __restrict__ teid_g, float* __restrict__ tgate_g,
                                                  LAS unsigned char* lds, int vcu, int G, int wave, int lane) {
    const int fr = lane & 15, fq = lane >> 4, h = wave;
    LAS unsigned char* itab = lds + wave * 1024;
    for (int tile = vcu; tile < TA / 16; tile += G) {
        const int tok0 = tile * 16;
        unsigned tk[2][16];
#pragma unroll
        for (int half = 0; half < 2; ++half) {
            const bf16* ap = PQb + (size_t)(tok0 + fr) * PEER_N + h * 256 + half * 128 + fq * 8;
            bf16x8 a[4];
#pragma unroll
            for (int ks = 0; ks < 4; ++ks) a[ks] = *(const bf16x8*)(ap + ks * 32);
            const bf16* kb = (half ? K2 : K1) + (size_t)fr * 128 + fq * 8;
            unsigned k0[16], k1[16];
#pragma unroll
            for (int ct = 0; ct < 8; ++ct) {
                f32x4 acc = (f32x4){0.f, 0.f, 0.f, 0.f};
#pragma unroll
                for (int ks = 0; ks < 4; ++ks) { const bf16x8 b = *(const bf16x8*)(kb + (size_t)ct * 16 * 128 + ks * 32); acc = __builtin_amdgcn_mfma_f32_16x16x32_bf16(b, a[ks], acc, 0, 0, 0); }
#pragma unroll
                for (int j = 0; j < 4; ++j) { const unsigned key = (f2ord(acc[j]) & 0xFFFFFF80u) | (unsigned)(127 - (ct * 16 + 4 * fq + j));
                    if (ct < 4) k0[ct * 4 + j] = key; else k1[(ct - 4) * 4 + j] = key; }
                if (ct & 1) asm volatile("" ::: "memory");
            }
            bitonic_sort_desc<16>(k0); bitonic_sort_desc<16>(k1);
            top16_merge(k0, k1); top16_xlane(k0, 16); top16_xlane(k0, 32);
#pragma unroll
            for (int i = 0; i < 16; ++i) tk[half][i] = k0[i];
        }
        if (fq == 0) {
#pragma unroll
            for (int i = 0; i < 16; ++i) { itab[fr * 32 + i] = (unsigned char)(127 - (tk[0][i] & 0x7Fu)); itab[fr * 32 + 16 + i] = (unsigned char)(127 - (tk[1][i] & 0x7Fu)); }
        }
        unsigned ck[16];
        {
            float v1[16], v2[16];
#pragma unroll
            for (int i = 0; i < 16; ++i) { v1[i] = ord2f(tk[0][i] & 0xFFFFFF80u); v2[i] = ord2f(tk[1][i] & 0xFFFFFF80u); }
            int c = 0;
#pragma unroll
            for (int i = 0; i < 16; ++i)
#pragma unroll
                for (int j = 0; j < 16; ++j) {
                    if ((i + 1) * (j + 1) <= 16) {
                        const unsigned key = (f2ord(v1[i] + v2[j]) & 0xFFFFFF00u) | (unsigned)(255 - (i * 16 + j));
                        const int m = c >> 2, pt = c & 3;
                        if (pt == 0) ck[m] = key; else ck[m] = fq == pt ? key : ck[m];
                        ++c;
                    }
                }
            ck[12] = fq < 2 ? ck[12] : 0u; ck[13] = 0u; ck[14] = 0u; ck[15] = 0u;
        }
        bitonic_sort_desc<16>(ck); top16_xlane(ck, 16); top16_xlane(ck, 32);
        asm volatile("s_waitcnt lgkmcnt(0)" ::: "memory");
        float ev[16]; float sum = 0.f; const float mxv = ord2f(ck[0] & 0xFFFFFF00u);
#pragma unroll
        for (int k = 0; k < 16; ++k) { ev[k] = __expf(ord2f(ck[k] & 0xFFFFFF00u) - mxv); sum += ev[k]; }
        const float inv = 1.f / sum;
#pragma unroll
        for (int k = 0; k < 16; ++k) {
            if ((k >> 2) == fq) {
                const int f = 255 - (int)(ck[k] & 0xFFu); const int id = (int)itab[fr * 32 + (f >> 4)] * 128 + (int)itab[fr * 32 + 16 + (f & 15)];
                teid_g[(size_t)(tok0 + fr) * 128 + h * 16 + k] = (unsigned short)id; tgate_g[(size_t)(tok0 + fr) * 128 + h * 16 + k] = ev[k] * inv;
            }
        }
        asm volatile("s_waitcnt lgkmcnt(0)" ::: "memory");
    }
}

__device__ __forceinline__ void phase_peer_mix(const float* __restrict__ Zin, const float* __restrict__ g1, const float* __restrict__ b1, const unsigned short* __restrict__ teid, const float* __restrict__ tgate,
                                               const unsigned char* __restrict__ U, const unsigned char* __restrict__ V, const float* __restrict__ Us, const float* __restrict__ Vs, const float* __restrict__ g2, const float* __restrict__ b2,
                                               float* __restrict__ outf, bf16* __restrict__ outb, int gw, int NGW, int lane) {
    unsigned long long tacc = 0ull; TPB(24);
    for (int j = gw; j < TP + TS * 16; j += NGW) {
        size_t tok;
        if (j < TP) tok = (size_t)j;
        else { const int s = j - TP; if ((s & 15) != 0) continue; tok = (size_t)TP + (s >> 4); }
        {
            float xf[16];
            { float s1 = 0.f;
#pragma unroll
              for (int q = 0; q < 4; ++q) { const f32x4 r = *(const f32x4*)(Zin + tok * D + lane * 16 + q * 4); xf[q * 4] = r[0]; xf[q * 4 + 1] = r[1]; xf[q * 4 + 2] = r[2]; xf[q * 4 + 3] = r[3]; s1 += (r[0] + r[1]) + (r[2] + r[3]); }
#pragma unroll
              for (int o = 1; o < 64; o <<= 1) s1 += __shfl_xor(s1, o);
              const float mean1 = s1 * (1.f / D); float q1 = 0.f;
#pragma unroll
              for (int i = 0; i < 16; ++i) { xf[i] -= mean1; q1 += xf[i] * xf[i]; }
#pragma unroll
              for (int o = 1; o < 64; o <<= 1) q1 += __shfl_xor(q1, o);
              const float rstd1 = rsqrtf(q1 * (1.f / D) + LN_EPS);
#pragma unroll
              for (int q = 0; q < 4; ++q) { const f32x4 gg = *(const f32x4*)(g1 + lane * 16 + q * 4), bb = *(const f32x4*)(b1 + lane * 16 + q * 4);
#pragma unroll
                  for (int i = 0; i < 4; ++i) xf[q * 4 + i] = xf[q * 4 + i] * rstd1 * gg[i] + bb[i]; } }
            float wv0 = 0.f, wv1 = 0.f;
#pragma unroll 1
            for (int bt = 0; bt < 2; ++bt) {
                const int eidv = (int)teid[tok * 128 + bt * 64 + lane];
                float p[64];
                TPB(20);
                u32x4 qb[2][PGS];
#pragma unroll
                for (int i = 0; i < PGS; ++i) { const int id = __builtin_amdgcn_readlane(eidv, i); qb[0][i] = *(const u32x4*)(U + (size_t)id * D + lane * 16); }
#pragma unroll
                for (int g = 0; g < 64 / PGS; ++g) {
                    if (g < 64 / PGS - 1) {
#pragma unroll
                        for (int i = 0; i < PGS; ++i) { const int id = __builtin_amdgcn_readlane(eidv, (g + 1) * PGS + i); qb[(g + 1) & 1][i] = *(const u32x4*)(U + (size_t)id * D + lane * 16); }
                    }
                    asm volatile("" ::: "memory");
#pragma unroll
                    for (int i = 0; i < PGS; ++i) {
                        float a = 0.f;
#pragma unroll
                        for (int w = 0; w < 4; ++w) { const f32x2v lo = __builtin_amdgcn_cvt_pk_f32_fp8((int)qb[g & 1][i][w], false), hi = __builtin_amdgcn_cvt_pk_f32_fp8((int)qb[g & 1][i][w], true);
                            a = fmaf(lo[0], xf[w * 4], a); a = fmaf(lo[1], xf[w * 4 + 1], a); a = fmaf(hi[0], xf[w * 4 + 2], a); a = fmaf(hi[1], xf[w * 4 + 3], a); }
                        p[g * PGS + i] = a;
                        __builtin_amdgcn_sched_barrier(0);
                    }
                }
                TPE(20); TPB(21);
#pragma unroll
                for (int o = 32; o >= 1; o >>= 1) {
                    const bool up = (lane & o) != 0;
#pragma unroll
                    for (int i = 0; i < o; ++i) { const float keep = up ? p[i + o] : p[i], send = up ? p[i] : p[i + o]; p[i] = keep + __shfl_xor(send, o); }
                }
                const float hdot = p[0] * Us[eidv];
                const float wv = 0.5f * hdot * (1.f + erff(hdot * 0.70710678118654752f)) * tgate[tok * 128 + bt * 64 + lane] * Vs[eidv];
                if (bt == 0) wv0 = wv; else wv1 = wv;
                TPE(21);
            }
            TPB(22);
            float y[16];
#pragma unroll
            for (int i = 0; i < 16; ++i) y[i] = 0.f;
#pragma unroll 1
            for (int bt = 0; bt < 2; ++bt) {
                const int eidv = (int)teid[tok * 128 + bt * 64 + lane]; const float wvv = bt == 0 ? wv0 : wv1;
                u32x4 qb[2][PGS];
#pragma unroll
                for (int i = 0; i < PGS; ++i) { const int id = __builtin_amdgcn_readlane(eidv, i); qb[0][i] = *(const u32x4*)(V + (size_t)id * D + lane * 16); }
#pragma unroll
                for (int g = 0; g < 64 / PGS; ++g) {
                    if (g < 64 / PGS - 1) {
#pragma unroll
                        for (int i = 0; i < PGS; ++i) { const int id = __builtin_amdgcn_readlane(eidv, (g + 1) * PGS + i); qb[(g + 1) & 1][i] = *(const u32x4*)(V + (size_t)id * D + lane * 16); }
                    }
                    asm volatile("" ::: "memory");
#pragma unroll
                    for (int i = 0; i < PGS; ++i) {
                        const float w = __builtin_bit_cast(float, __builtin_amdgcn_readlane(__builtin_bit_cast(int, wvv), g * PGS + i));
                        asm volatile("" : "+v"(qb[g & 1][i][0]), "+v"(qb[g & 1][i][1]), "+v"(qb[g & 1][i][2]), "+v"(qb[g & 1][i][3]));
#pragma unroll
                        for (int k = 0; k < 4; ++k) { const f32x2v lo = __builtin_amdgcn_cvt_pk_f32_fp8((int)qb[g & 1][i][k], false), hi = __builtin_amdgcn_cvt_pk_f32_fp8((int)qb[g & 1][i][k], true);
                            y[k * 4] = fmaf(w, lo[0], y[k * 4]); y[k * 4 + 1] = fmaf(w, lo[1], y[k * 4 + 1]); y[k * 4 + 2] = fmaf(w, hi[0], y[k * 4 + 2]); y[k * 4 + 3] = fmaf(w, hi[1], y[k * 4 + 3]); }
                        asm volatile("" : "+v"(y[0]), "+v"(y[1]), "+v"(y[2]), "+v"(y[3]), "+v"(y[4]), "+v"(y[5]), "+v"(y[6]), "+v"(y[7]), "+v"(y[8]), "+v"(y[9]), "+v"(y[10]), "+v"(y[11]), "+v"(y[12]), "+v"(y[13]), "+v"(y[14]), "+v"(y[15]));
                    }
                }
            }
            TPE(22); TPB(23);
            float s = 0.f;
#pragma unroll
            for (int i = 0; i < 16; ++i) { y[i] = ALPHA * xf[i] + y[i]; s += y[i]; }
#pragma unroll
            for (int o = 1; o < 64; o <<= 1) s += __shfl_xor(s, o);
            const float mean = s * (1.f / D); float qq = 0.f;
#pragma unroll
            for (int i = 0; i < 16; ++i) { y[i] -= mean; qq += y[i] * y[i]; }
#pragma unroll
            for (int o = 1; o < 64; o <<= 1) qq += __shfl_xor(qq, o);
            const float rstd = rsqrtf(qq * (1.f / D) + LN_EPS);
            u32x4 ob0, ob1;
#pragma unroll
            for (int q = 0; q < 4; ++q) { const int col = lane * 16 + q * 4; const f32x4 gg = *(const f32x4*)(g2 + col), bb = *(const f32x4*)(b2 + col);
                f32x4 o;
#pragma unroll
                for (int i = 0; i < 4; ++i) o[i] = y[q * 4 + i] * rstd * gg[i] + bb[i];
                *(f32x4*)(outf + tok * D + col) = o;
                const unsigned w0 = pk2(o[0], o[1]), w1 = pk2(o[2], o[3]);
                if (q == 0) { ob0.x = w0; ob0.y = w1; } else if (q == 1) { ob0.z = w0; ob0.w = w1; } else if (q == 2) { ob1.x = w0; ob1.y = w1; } else { ob1.z = w0; ob1.w = w1; } }
            if (outb) { *(u32x4*)(outb + tok * D + lane * 16) = ob0; *(u32x4*)(outb + tok * D + lane * 16 + 8) = ob1; }
            TPE(23);
        }
    }
    TPE(24);
#if defined(PROBE_REGION)
    if (PROBE_REGION >= 20 && PROBE_REGION <= 24 && gw == PROBE_WAVE && lane == 0 && outb != nullptr) g_probe_acc = tacc;
#endif
}

__device__ __forceinline__ float peer_reduce16(float (&p)[16], int lane) {
#pragma unroll
    for (int o = 8; o >= 1; o >>= 1) { const bool up = (lane & (o * 4)) != 0;
#pragma unroll
        for (int k = 0; k < o; ++k) { const float keep = up ? p[k + o] : p[k], send = up ? p[k] : p[k + o]; p[k] = keep + __shfl_xor(send, o * 4); } }
    float tot = p[0];
    tot += __shfl_xor(tot, 2); tot += __shfl_xor(tot, 1);
    return tot;
}
__device__ __forceinline__ unsigned cvtpk_bf16_(float lo, float hi) { typedef __bf16 bf2 __attribute__((ext_vector_type(2))); f32x2v v = {lo, hi}; bf2 b = __builtin_convertvector(v, bf2); return __builtin_bit_cast(unsigned, b); }
__device__ __forceinline__ float peer_dot16b(const u32x4 q, const u32x4 x0, const u32x4 x1) {
    float a = 0.f;
#pragma unroll
    for (int w = 0; w < 4; ++w) { const f32x2v lo = __builtin_amdgcn_cvt_pk_f32_fp8((int)q[w], false), hi = __builtin_amdgcn_cvt_pk_f32_fp8((int)q[w], true);
        const unsigned xa = w < 2 ? x0[2 * w] : x1[2 * w - 4], xb = w < 2 ? x0[2 * w + 1] : x1[2 * w - 3];
        a = dot2bf(cvtpk_bf16_(lo[0], lo[1]), xa, a); a = dot2bf(cvtpk_bf16_(hi[0], hi[1]), xb, a); }
    return a;
}

__device__ __forceinline__ void peer_u_slice(int sl, int t_first, int t_step, const bf16* __restrict__ Hb, const unsigned short* __restrict__ teid, const unsigned char* __restrict__ U,
                                             float* __restrict__ HD, LAS unsigned char* wl, int lane) {
    LAS unsigned short* lst_e = (LAS unsigned short*)wl;
    LAS unsigned char* lst_s = wl + 512;
    const unsigned long long below = (1ull << lane) - 1ull;
    const int kk = (lane >> 2) & 15;
    if (t_first >= TA) return;
#define PU_BUILD(bsel, e0_, e1_, cnt_) do { const bool a0_ = ((e0_) >> 11) == sl, a1_ = ((e1_) >> 11) == sl; const unsigned long long m0_ = __ballot(a0_), m1_ = __ballot(a1_); \
        const int c0_ = __builtin_popcountll(m0_); cnt_ = c0_ + __builtin_popcountll(m1_); \
        if (a0_) { const int p_ = __builtin_popcountll(m0_ & below); lst_e[(bsel) * 128 + p_] = (unsigned short)(e0_); lst_s[(bsel) * 128 + p_] = (unsigned char)lane; } \
        if (a1_) { const int p_ = c0_ + __builtin_popcountll(m1_ & below); lst_e[(bsel) * 128 + p_] = (unsigned short)(e1_); lst_s[(bsel) * 128 + p_] = (unsigned char)(64 + lane); } } while (0)
#define PU_LOAD(bsel, cnt_, q_) do { _Pragma("unroll") for (int k = 0; k < 16; ++k) { if (k < (cnt_)) { const int id_ = __builtin_amdgcn_readfirstlane((int)lst_e[(bsel) * 128 + k]); q_[k] = *(const u32x4*)(U + (size_t)id_ * D + lane * 16); } } } while (0)
    int e0 = __builtin_nontemporal_load(teid + (size_t)t_first * 128 + lane), e1 = __builtin_nontemporal_load(teid + (size_t)t_first * 128 + 64 + lane);
    u32x4 xa0 = __builtin_nontemporal_load((const u32x4*)(Hb + (size_t)t_first * D + lane * 16)), xa1 = __builtin_nontemporal_load((const u32x4*)(Hb + (size_t)t_first * D + lane * 16 + 8));
    int cnt; PU_BUILD(0, e0, e1, cnt);
    asm volatile("s_waitcnt lgkmcnt(0)" ::: "memory");
    u32x4 q[16];
    PU_LOAD(0, cnt, q);
    int buf = 0;
    unsigned long long tacc = 0ull; TPB(40);
    for (int t = t_first; t < TA; t += t_step, buf ^= 1) {
        const int tn = t + t_step; const bool hasn = tn < TA;
        u32x4 xb0 = xa0, xb1 = xa1; int f0 = 0, f1 = 0;
        if (hasn) { f0 = __builtin_nontemporal_load(teid + (size_t)tn * 128 + lane); f1 = __builtin_nontemporal_load(teid + (size_t)tn * 128 + 64 + lane);
            xb0 = __builtin_nontemporal_load((const u32x4*)(Hb + (size_t)tn * D + lane * 16)); xb1 = __builtin_nontemporal_load((const u32x4*)(Hb + (size_t)tn * D + lane * 16 + 8)); }
        TPB(41);
        float pr[16];
#pragma unroll
        for (int k = 0; k < 16; ++k) pr[k] = k < cnt ? peer_dot16b(q[k], xa0, xa1) : 0.f;
        TPE(41); TPB(44);
#pragma unroll 1
        for (int p0 = 16; p0 < cnt; p0 += 16) {
            u32x4 q2[16];
#pragma unroll
            for (int k = 0; k < 16; ++k) { if (p0 + k < cnt) { const int id_ = __builtin_amdgcn_readfirstlane((int)lst_e[buf * 128 + p0 + k]); q2[k] = *(const u32x4*)(U + (size_t)id_ * D + lane * 16); } }
            float pr2[16];
#pragma unroll
            for (int k = 0; k < 16; ++k) pr2[k] = p0 + k < cnt ? peer_dot16b(q2[k], xa0, xa1) : 0.f;
            const float tot2 = peer_reduce16(pr2, lane);
            if (p0 + kk < cnt && (lane & 3) == 0) __builtin_nontemporal_store(tot2, HD + (size_t)t * 128 + lst_s[buf * 128 + p0 + kk]);
        }
        TPE(44); TPB(42);
        int cntn = 0;
        if (hasn) { PU_BUILD(buf ^ 1, f0, f1, cntn); }
        asm volatile("s_waitcnt lgkmcnt(0)" ::: "memory");
        if (hasn) PU_LOAD(buf ^ 1, cntn, q);
        TPE(42); TPB(43);
        const float tot = peer_reduce16(pr, lane);
        if (kk < cnt && (lane & 3) == 0) __builtin_nontemporal_store(tot, HD + (size_t)t * 128 + lst_s[buf * 128 + kk]);
        xa0 = xb0; xa1 = xb1; cnt = cntn;
        TPE(43);
    }
    TPE(40);
#if defined(PROBE_REGION)
    if (PROBE_REGION >= 40 && PROBE_REGION <= 44 && t_first == PROBE_WAVE && lane == 0) g_probe_acc = tacc;
#endif
#undef PU_BUILD
#undef PU_LOAD
}

__device__ __forceinline__ void phase_peer_mixv(const float* __restrict__ Zin, const float* __restrict__ g1, const float* __restrict__ b1, const unsigned short* __restrict__ teid, const float* __restrict__ tgate, const float* __restrict__ HD,
                                                const unsigned char* __restrict__ V, const float* __restrict__ Us, const float* __restrict__ Vs, const float* __restrict__ g2, const float* __restrict__ b2,
                                                float* __restrict__ outf, bf16* __restrict__ outb, int gw, int NGW, int lane) {
    for (int j = gw; j < TP + TS * 16; j += NGW) {
        size_t tok;
        if (j < TP) tok = (size_t)j;
        else { const int s = j - TP; if ((s & 15) != 0) continue; tok = (size_t)TP + (s >> 4); }
        float xf[16];
        { float s1 = 0.f;
#pragma unroll
          for (int q = 0; q < 4; ++q) { const f32x4 r = *(const f32x4*)(Zin + tok * D + lane * 16 + q * 4); xf[q * 4] = r[0]; xf[q * 4 + 1] = r[1]; xf[q * 4 + 2] = r[2]; xf[q * 4 + 3] = r[3]; s1 += (r[0] + r[1]) + (r[2] + r[3]); }
#pragma unroll
          for (int o = 1; o < 64; o <<= 1) s1 += __shfl_xor(s1, o);
          const float mean1 = s1 * (1.f / D); float q1 = 0.f;
#pragma unroll
          for (int i = 0; i < 16; ++i) { xf[i] -= mean1; q1 += xf[i] * xf[i]; }
#pragma unroll
          for (int o = 1; o < 64; o <<= 1) q1 += __shfl_xor(q1, o);
          const float rstd1 = rsqrtf(q1 * (1.f / D) + LN_EPS);
#pragma unroll
          for (int q = 0; q < 4; ++q) { const f32x4 gg = *(const f32x4*)(g1 + lane * 16 + q * 4), bb = *(const f32x4*)(b1 + lane * 16 + q * 4);
#pragma unroll
              for (int i = 0; i < 4; ++i) xf[q * 4 + i] = xf[q * 4 + i] * rstd1 * gg[i] + bb[i]; } }
        float y[16];
#pragma unroll
        for (int i = 0; i < 16; ++i) y[i] = 0.f;
#pragma unroll 1
        for (int bt = 0; bt < 2; ++bt) {
            const int eidv = (int)teid[tok * 128 + bt * 64 + lane];
            const float hd = HD[tok * 128 + bt * 64 + lane] * Us[eidv];
            const float wvv = 0.5f * hd * (1.f + erff(hd * 0.70710678118654752f)) * tgate[tok * 128 + bt * 64 + lane] * Vs[eidv];
            u32x4 qb[2][PGS];
#pragma unroll
            for (int i = 0; i < PGS; ++i) { const int id = __builtin_amdgcn_readlane(eidv, i); qb[0][i] = *(const u32x4*)(V + (size_t)id * D + lane * 16); }
#pragma unroll
            for (int g = 0; g < 64 / PGS; ++g) {
                if (g < 64 / PGS - 1) {
#pragma unroll
                    for (int i = 0; i < PGS; ++i) { const int id = __builtin_amdgcn_readlane(eidv, (g + 1) * PGS + i); qb[(g + 1) & 1][i] = *(const u32x4*)(V + (size_t)id * D + lane * 16); }
                }
                asm volatile("" ::: "memory");
#pragma unroll
                for (int i = 0; i < PGS; ++i) {
                    const float w = __builtin_bit_cast(float, __builtin_amdgcn_readlane(__builtin_bit_cast(int, wvv), g * PGS + i));
                    asm volatile("" : "+v"(qb[g & 1][i][0]), "+v"(qb[g & 1][i][1]), "+v"(qb[g & 1][i][2]), "+v"(qb[g & 1][i][3]));
#pragma unroll
                    for (int k = 0; k < 4; ++k) { const f32x2v lo = __builtin_amdgcn_cvt_pk_f32_fp8((int)qb[g & 1][i][k], false), hi = __builtin_amdgcn_cvt_pk_f32_fp8((int)qb[g & 1][i][k], true);
                        y[k * 4] = fmaf(w, lo[0], y[k * 4]); y[k * 4 + 1] = fmaf(w, lo[1], y[k * 4 + 1]); y[k * 4 + 2] = fmaf(w, hi[0], y[k * 4 + 2]); y[k * 4 + 3] = fmaf(w, hi[1], y[k * 4 + 3]); }
                    asm volatile("" : "+v"(y[0]), "+v"(y[1]), "+v"(y[2]), "+v"(y[3]), "+v"(y[4]), "+v"(y[5]), "+v"(y[6]), "+v"(y[7]), "+v"(y[8]), "+v"(y[9]), "+v"(y[10]), "+v"(y[11]), "+v"(y[12]), "+v"(y[13]), "+v"(y[14]), "+v"(y[15]));
                }
            }
        }
        float s = 0.f;
#pragma unroll
        for (int i = 0; i < 16; ++i) { y[i] = ALPHA * xf[i] + y[i]; s += y[i]; }
#pragma unroll
        for (int o = 1; o < 64; o <<= 1) s += __shfl_xor(s, o);
        const float mean = s * (1.f / D); float qq = 0.f;
#pragma unroll
        for (int i = 0; i < 16; ++i) { y[i] -= mean; qq += y[i] * y[i]; }
#pragma unroll
        for (int o = 1; o < 64; o <<= 1) qq += __shfl_xor(qq, o);
        const float rstd = rsqrtf(qq * (1.f / D) + LN_EPS);
        u32x4 ob0, ob1;
#pragma unroll
        for (int q = 0; q < 4; ++q) { const int col = lane * 16 + q * 4; const f32x4 gg = *(const f32x4*)(g2 + col), bb = *(const f32x4*)(b2 + col);
            f32x4 o;
#pragma unroll
            for (int i = 0; i < 4; ++i) o[i] = y[q * 4 + i] * rstd * gg[i] + bb[i];
            *(f32x4*)(outf + tok * D + col) = o;
            const unsigned w0 = pk2(o[0], o[1]), w1 = pk2(o[2], o[3]);
            if (q == 0) { ob0.x = w0; ob0.y = w1; } else if (q == 1) { ob0.z = w0; ob0.w = w1; } else if (q == 2) { ob1.x = w0; ob1.y = w1; } else { ob1.z = w0; ob1.w = w1; } }
        if (outb) { *(u32x4*)(outb + tok * D + lane * 16) = ob0; *(u32x4*)(outb + tok * D + lane * 16 + 8) = ob1; }
    }
}
}

namespace mk {
struct FGlaIn {
    bf16 *Gq, *Gk, *Gv, *Gr; float* GD;
    __device__ __forceinline__ static float silu(float r) { return r / (1.f + __expf(-r)); }
    __device__ __forceinline__ void put8(int row, int col, f32x4 v0, f32x4 v1) const {
        if (col < GN_K) *(u32x4*)(Gq + (size_t)row * 512 + col) = pack8(v0, v1);
        else if (col < GN_V) *(u32x4*)(Gk + (size_t)row * 512 + (col - GN_K)) = pack8(v0, v1);
        else if (col < GN_R) *(u32x4*)(Gv + (size_t)row * 1024 + (col - GN_V)) = pack8(v0, v1);
        else { f32x4 a, b;
#pragma unroll
            for (int i = 0; i < 4; ++i) { a[i] = silu(v0[i]); b[i] = silu(v1[i]); }
            *(u32x4*)(Gr + (size_t)row * 1024 + (col - GN_R)) = pack8(a, b); }
    }
    __device__ __forceinline__ void put4(int row, int col, f32x4 v) const {
        u32x2 w; w.x = pk2(v[0], v[1]); w.y = pk2(v[2], v[3]);
        if (col < GN_K) *(u32x2*)(Gq + (size_t)row * 512 + col) = w;
        else if (col < GN_V) *(u32x2*)(Gk + (size_t)row * 512 + (col - GN_K)) = w;
        else if (col < GN_R) *(u32x2*)(Gv + (size_t)row * 1024 + (col - GN_V)) = w;
        else if (col < GN_GD) { u32x2 s; s.x = pk2(silu(v[0]), silu(v[1])); s.y = pk2(silu(v[2]), silu(v[3])); *(u32x2*)(Gr + (size_t)row * 1024 + (col - GN_R)) = s; }
        else if (col < GN_GD + 16) *(f32x4*)(GD + (size_t)row * 16 + (col - GN_GD)) = v;
    }
};

__device__ __forceinline__ float log_sigmoid_f(float x) { return fminf(x, 0.f) - log1pf(__expf(-fabsf(x))); }
__device__ __forceinline__ bf16x8 tr8(LAS unsigned char* a0, LAS unsigned char* a1) { const s16x4 v0 = lds_tr(a0), v1 = lds_tr(a1); bf16x8 r; r[0] = v0[0]; r[1] = v0[1]; r[2] = v0[2]; r[3] = v0[3]; r[4] = v1[0]; r[5] = v1[1]; r[6] = v1[2]; r[7] = v1[3]; return r; }

constexpr int KD_ST = 272, V_ST = 528;
constexpr int GL_LB = 0, GL_TOT = 32768, GL_KD = 36864, GL_V = GL_KD + 64 * KD_ST  , GL_END = GL_V + 64 * V_ST;
static_assert(GL_END <= RING_BYTES, "GLA chunk LDS");

__device__ __forceinline__ void gla_chunk_item(int item, const bf16* __restrict__ Gq, const bf16* __restrict__ Gk, const bf16* __restrict__ Gv, const float* __restrict__ GD,
                                               const float* __restrict__ Wgu, const float* __restrict__ bg, bf16* __restrict__ QT, bf16* __restrict__ KT, float* __restrict__ DEC, float* __restrict__ DS,
                                               LAS unsigned char* lds, int tid, int wave, int lane) {
    const int h = item & 3, bc = item >> 2;
    const size_t tok0 = (size_t)bc * 64;
    LAS float* LB = (LAS float*)(lds + GL_LB);
    LAS float* TOT = (LAS float*)(lds + GL_TOT);
    const int d = tid & 127, tq = tid >> 7;
    float wg[16];
#pragma unroll
    for (int r = 0; r < 16; ++r) wg[r] = Wgu[r * 512 + h * 128 + d];
    const float bgd = bg[h * 128 + d];
    float pre[16]; float run = 0.f;
#pragma unroll
    for (int i = 0; i < 16; ++i) {
        const float* gd = GD + (tok0 + tq * 16 + i) * 16;
        const f32x4 g0 = *(const f32x4*)gd, g1 = *(const f32x4*)(gd + 4), g2 = *(const f32x4*)(gd + 8), g3 = *(const f32x4*)(gd + 12);
        float x = 0.f;
#pragma unroll
        for (int r = 0; r < 4; ++r) { x = fmaf(g0[r], wg[r], x); }
#pragma unroll
        for (int r = 0; r < 4; ++r) { x = fmaf(g1[r], wg[4 + r], x); }
#pragma unroll
        for (int r = 0; r < 4; ++r) { x = fmaf(g2[r], wg[8 + r], x); }
#pragma unroll
        for (int r = 0; r < 4; ++r) { x = fmaf(g3[r], wg[12 + r], x); }
        run += log_sigmoid_f(x + bgd) * (1.f / 16.f); pre[i] = run;
    }
    TOT[tq * 128 + d] = run;
    __syncthreads();
    float off = 0.f;
#pragma unroll
    for (int q = 0; q < 3; ++q) if (q < tq) off += TOT[q * 128 + d];
    const float bC = (TOT[d] + TOT[128 + d]) + (TOT[256 + d] + TOT[384 + d]);
#pragma unroll
    for (int i = 0; i < 16; ++i) {
        const int t = tq * 16 + i; const float b = pre[i] + off; const size_t tok = tok0 + t;
        const float q = bf2f(Gq[tok * 512 + h * 128 + d]), k = bf2f(Gk[tok * 512 + h * 128 + d]);
        QT[tok * 512 + h * 128 + d] = (bf16)f2bf(q * 0.08838834764831845f * __expf(b));
        KT[tok * 512 + h * 128 + d] = (bf16)f2bf(k * __expf(-b));
        *(LAS bf16*)(lds + GL_KD + t * KD_ST + d * 2) = (bf16)f2bf(k * __expf(bC - b));
    }
    if (tq == 0) DEC[(size_t)item * 128 + d] = __expf(bC);
#pragma unroll
    for (int p = 0; p < 4; ++p) { const int e = tid + p * 512, s = e >> 5, ch = e & 31;
        *(LAS u32x4*)(lds + GL_V + s * V_ST + ch * 16) = *(const u32x4*)(Gv + (tok0 + s) * 1024 + h * 256 + ch * 8); }
    __syncthreads();
    const int fr = lane & 15, fq = lane >> 4, dt = wave;
    bf16x8 af[2];
#pragma unroll
    for (int ks = 0; ks < 2; ++ks) { LAS unsigned char* a0 = lds + GL_KD + (ks * 32 + fq * 8 + (fr >> 2)) * KD_ST + (dt * 16 + 4 * (fr & 3)) * 2; af[ks] = tr8(a0, a0 + 4 * KD_ST); }
    float* dsb = DS + (size_t)item * 256 * 128;
#pragma unroll 4
    for (int vt = 0; vt < 16; ++vt) {
        f32x4 acc = (f32x4){0.f, 0.f, 0.f, 0.f};
#pragma unroll
        for (int ks = 0; ks < 2; ++ks) { LAS unsigned char* b0 = lds + GL_V + (ks * 32 + fq * 8 + (fr >> 2)) * V_ST + (vt * 16 + 4 * (fr & 3)) * 2; const bf16x8 bf = tr8(b0, b0 + 4 * V_ST);
            acc = __builtin_amdgcn_mfma_f32_16x16x32_bf16(af[ks], bf, acc, 0, 0, 0); }
        *(f32x4*)(dsb + (size_t)(vt * 16 + fr) * 128 + dt * 16 + fq * 4) = acc;
    }
    __syncthreads();
}

__device__ __forceinline__ void gla_sample_item(int item, const bf16* __restrict__ Gq, const bf16* __restrict__ Gk, const bf16* __restrict__ Gv, const bf16* __restrict__ Gr, const float* __restrict__ GD,
                                                const float* __restrict__ Wgu, const float* __restrict__ bg, const float* __restrict__ ng, const float* __restrict__ S0, float* __restrict__ Sout, bf16* __restrict__ OGb,
                                                LAS unsigned char* lds, int tid, int lane) {
    const int b = item >> 2, h = item & 3;
    LAS float* A = (LAS float*)lds;
    LAS float* Qs = A + 512; LAS float* Ks = Qs + 512;
    LAS float* PO = Ks + 512;
    LAS float* RS = PO + 4096;
    { const int t = tid >> 7, d = tid & 127; const size_t tok = (size_t)TP + b * DS + t;
      float x = bg[h * 128 + d]; const float* gd = GD + tok * 16; float xs = 0.f;
#pragma unroll
      for (int r = 0; r < 16; ++r) xs = fmaf(gd[r], Wgu[r * 512 + h * 128 + d], xs);
      x += xs;
      A[t * 128 + d] = __expf(log_sigmoid_f(x) * (1.f / 16.f));
      Qs[t * 128 + d] = bf2f(Gq[tok * 512 + h * 128 + d]) * 0.08838834764831845f; Ks[t * 128 + d] = bf2f(Gk[tok * 512 + h * 128 + d]); }
    __syncthreads();
    const int dq = tid >> 7, d0 = dq * 32;
#pragma unroll 1
    for (int vhalf = 0; vhalf < 2; ++vhalf) {
        const int v = vhalf * 128 + (tid & 127);
        float S[32];
#pragma unroll
        for (int i = 0; i < 32; ++i) S[i] = S0[(((size_t)b * 4 + h) * 128 + d0 + i) * 256 + v];
#pragma unroll 1
        for (int t = 0; t < 4; ++t) {
            const float vv = bf2f(Gv[((size_t)TP + b * DS + t) * 1024 + h * 256 + v]); float o = 0.f;
#pragma unroll
            for (int i = 0; i < 32; ++i) { S[i] = fmaf(A[t * 128 + d0 + i], S[i], Ks[t * 128 + d0 + i] * vv); o = fmaf(Qs[t * 128 + d0 + i], S[i], o); }
            PO[(dq * 4 + t) * 256 + v] = o;
        }
#pragma unroll
        for (int i = 0; i < 32; ++i) Sout[(((size_t)b * 4 + h) * 128 + d0 + i) * 256 + v] = S[i];
    }
    __syncthreads();
    { const int t = tid >> 7, vl = tid & 127; const float o0 = (PO[t * 256 + vl] + PO[(4 + t) * 256 + vl]) + (PO[(8 + t) * 256 + vl] + PO[(12 + t) * 256 + vl]), o1 = (PO[t * 256 + 128 + vl] + PO[(4 + t) * 256 + 128 + vl]) + (PO[(8 + t) * 256 + 128 + vl] + PO[(12 + t) * 256 + 128 + vl]);
      float ss = o0 * o0 + o1 * o1;
#pragma unroll
      for (int o = 1; o < 64; o <<= 1) ss += __shfl_xor(ss, o);
      if (lane == 0) RS[tid >> 6] = ss;
      __syncthreads();
      const float ms = (RS[2 * t] + RS[2 * t + 1]) * (1.f / 256.f), rstd = rsqrtf(ms + LN_EPS);
      const size_t tok = (size_t)TP + b * DS + t;
      OGb[tok * 1024 + h * 256 + vl] = (bf16)f2bf(o0 * rstd * ng[vl] * bf2f(Gr[tok * 1024 + h * 256 + vl]));
      OGb[tok * 1024 + h * 256 + 128 + vl] = (bf16)f2bf(o1 * rstd * ng[128 + vl] * bf2f(Gr[tok * 1024 + h * 256 + 128 + vl])); }
    __syncthreads();
}

__device__ __forceinline__ void gla_scan(const float* __restrict__ DS, const float* __restrict__ DEC, bf16* __restrict__ SP, float* __restrict__ Sout, int gtid, int gthreads) {
    typedef float f32x2 __attribute__((ext_vector_type(2)));
    for (int e = gtid; e < NBATCH * 4 * 256 * 64; e += gthreads) {
        const int d2 = e & 63, v = (e >> 6) & 255, h = (e >> 14) & 3, b = e >> 16;
        f32x2 S = (f32x2){0.f, 0.f};
        for (int c = 0; c < SEQ / 64; ++c) {
            const size_t item = ((size_t)b * (SEQ / 64) + c) * 4 + h;
            const f32x2 ds = *(const f32x2*)(DS + (item * 256 + v) * 128 + d2 * 2), dc = *(const f32x2*)(DEC + item * 128 + d2 * 2);
            *(unsigned*)(SP + (item * 256 + v) * 128 + d2 * 2) = pk2(S[0], S[1]);
            S = dc * S + ds;
        }
        float* so = Sout + (((size_t)b * 4 + h) * 128 + d2 * 2) * 256 + v; so[0] = S[0]; so[256] = S[1];
    }
}

__device__ __forceinline__ void gla_out_item(int item, const bf16* __restrict__ QT, const bf16* __restrict__ KT, const bf16* __restrict__ Gv, const bf16* __restrict__ Gr, const bf16* __restrict__ SP,
                                             const float* __restrict__ ng, bf16* __restrict__ OGb, LAS unsigned char* lds, int tid, int wave, int lane) {
    const int h = item & 3, bc = item >> 2; const size_t tok0 = (size_t)bc * 64;
    const int fr = lane & 15, fq = lane >> 4, tt = wave & 3, vh = wave >> 2;
    LAS float* RS = (LAS float*)(lds + 64 * V_ST);
#pragma unroll
    for (int p = 0; p < 4; ++p) { const int e = tid + p * 512, s = e >> 5, ch = e & 31;
        *(LAS u32x4*)(lds + s * V_ST + ch * 16) = *(const u32x4*)(Gv + (tok0 + s) * 1024 + h * 256 + ch * 8); }
    bf16x8 qf[4];
#pragma unroll
    for (int ks = 0; ks < 4; ++ks) qf[ks] = *(const bf16x8*)(QT + (tok0 + tt * 16 + fr) * 512 + h * 128 + ks * 32 + fq * 8);
    bf16x8 pf[2];
    {
        f32x4 at[4];
#pragma unroll
        for (int st = 0; st < 4; ++st) {
            f32x4 acc = (f32x4){0.f, 0.f, 0.f, 0.f};
#pragma unroll
            for (int ks = 0; ks < 4; ++ks) { const bf16x8 kf = *(const bf16x8*)(KT + (tok0 + st * 16 + fr) * 512 + h * 128 + ks * 32 + fq * 8); acc = __builtin_amdgcn_mfma_f32_16x16x32_bf16(kf, qf[ks], acc, 0, 0, 0); }
#pragma unroll
            for (int j = 0; j < 4; ++j) { const int s = st * 16 + fq * 4 + j, t = tt * 16 + fr; if (s > t) acc[j] = 0.f; }
            at[st] = acc;
        }
        const u32x4 w0 = pack8(at[0], at[1]), w1 = pack8(at[2], at[3]);
        pf[0] = __builtin_bit_cast(bf16x8, w0); pf[1] = __builtin_bit_cast(bf16x8, w1);
    }
    __syncthreads();
    const bf16* spb = SP + (size_t)item * 256 * 128;
    f32x4 oacc[8]; float ss = 0.f;
#pragma unroll
    for (int i = 0; i < 8; ++i) {
        const int vt = vh * 8 + i;
        f32x4 acc = (f32x4){0.f, 0.f, 0.f, 0.f};
#pragma unroll
        for (int k2 = 0; k2 < 2; ++k2) {
            LAS unsigned char* a0 = lds + (k2 * 32 + fq * 4 + (fr >> 2)) * V_ST + (vt * 16 + 4 * (fr & 3)) * 2;
            const bf16x8 vf = tr8(a0, a0 + 16 * V_ST);
            acc = __builtin_amdgcn_mfma_f32_16x16x32_bf16(vf, pf[k2], acc, 0, 0, 0);
        }
#pragma unroll
        for (int ks = 0; ks < 4; ++ks) { const bf16x8 sf = *(const bf16x8*)(spb + (size_t)(vt * 16 + fr) * 128 + ks * 32 + fq * 8); acc = __builtin_amdgcn_mfma_f32_16x16x32_bf16(sf, qf[ks], acc, 0, 0, 0); }
        oacc[i] = acc; ss += (acc[0] * acc[0] + acc[1] * acc[1]) + (acc[2] * acc[2] + acc[3] * acc[3]);
    }
    ss += __shfl_xor(ss, 16); ss += __shfl_xor(ss, 32);
    if (fq == 0) RS[wave * 16 + fr] = ss;
    __syncthreads();
    const float ms = (RS[tt * 16 + fr] + RS[(tt + 4) * 16 + fr]) * (1.f / 256.f), rstd = rsqrtf(ms + LN_EPS);
    const size_t tok = tok0 + tt * 16 + fr;
#pragma unroll
    for (int i = 0; i < 8; ++i) {
        const int v = (vh * 8 + i) * 16 + fq * 4;
        const u32x2 rw = *(const u32x2*)(Gr + tok * 1024 + h * 256 + v); const f32x4 g = *(const f32x4*)(ng + v);
        u32x2 w; w.x = pk2(oacc[i][0] * rstd * g[0] * bflo(rw.x), oacc[i][1] * rstd * g[1] * bfhi(rw.x)); w.y = pk2(oacc[i][2] * rstd * g[2] * bflo(rw.y), oacc[i][3] * rstd * g[3] * bfhi(rw.y));
        *(u32x2*)(OGb + tok * 1024 + h * 256 + v) = w;
    }
    __syncthreads();
}
}

namespace mk {
#ifndef MIX_V2
#define MIX_V1 1
#endif
#if defined(MIX_V1)
#define MIXSEL(Hf, te, tg, U, V, Us, Vs, g2, b2, of, ob, lds, wave, gw, NGW, lane) phase_peer_mix(Hf, te, tg, U, V, Us, Vs, g2, b2, of, ob, gw, NGW, lane)
#define MIX_FROM_Z 1
#else
#define MIXSEL(Hf, te, tg, U, V, Us, Vs, g2, b2, of, ob, lds, wave, gw, NGW, lane) phase_peer_mix2(Hf, H1b, te, tg, U, V, Us, Vs, g2, b2, of, ob, lds, wave, gw, NGW, lane)
#endif
#define PEER_USLICE(Hb_, U_, Us_) do { if (G % 8 == 0) { const int per_ = G / 8; peer_u_slice(vcu / per_, (vcu % per_) * NWAVES + wave, per_ * NWAVES, Hb_, TEID, U_, HDB, lds + wave * 16384, lane); } \
        else { for (int sl_ = 0; sl_ < 8; ++sl_) peer_u_slice(sl_, gw, NGW, Hb_, TEID, U_, HDB, lds + wave * 16384, lane); } } while (0)
struct Args {
    const float* in[23]; const int* page_table; float* out; unsigned char* ws; int ph_lo, ph_hi;
};
enum Phase { P_PRO = 0, P_AIN = 1, P_SCORE = 2, P_TOPK = 3, P_ATTN = 4, P_AOUT = 5, P_LN1 = 6, P_PQ0 = 7, P_PEER0 = 8, P_GIN = 9, P_GCH = 10, P_GSC = 11, P_GOUT = 12, P_GPRJ = 13, P_LN1B = 14, P_PQ1 = 15, P_PEER1 = 16, P_COUNT = 17 };

#define Wa ((bf16*)(ws + WS_WA))
#define Wo ((bf16*)(ws + WS_WO))
#define Wg ((bf16*)(ws + WS_WG))
#define Wgo ((bf16*)(ws + WS_WGO))
#define Wpq ((bf16*)(ws + WS_WPQ))
#define PK ((bf16*)(ws + WS_PK))
#define Usc ((float*)(ws + WS_USC))
#define Xb ((bf16*)(ws + WS_XB))
#define Qb ((bf16*)(ws + WS_QB))
#define QIb ((bf16*)(ws + WS_QIB))
#define Kb ((bf16*)(ws + WS_KB))
#define Vb ((bf16*)(ws + WS_VB))
#define KIb ((bf16*)(ws + WS_KIB))
#define WIf ((float*)(ws + WS_WIF))
#define SC ((float*)(ws + WS_SC))
#define SCS ((float*)(ws + WS_SCS))
#define IDX ((int*)(ws + WS_IDX))
#define CNT ((int*)(ws + WS_CNT))
#define Ob ((bf16*)(ws + WS_OB))
#define Z ((float*)(ws + WS_Z))
#define H1f ((float*)(ws + WS_H1F))
#define H1b ((bf16*)(ws + WS_H1B))
#define PQb ((bf16*)(ws + WS_PQB))
#define H2f ((float*)(ws + WS_H2F))
#define H2b ((bf16*)(ws + WS_H2B))
#define TEID ((unsigned short*)(ws + WS_TEID))
#define TGATE ((float*)(ws + WS_TGATE))
#define Gq ((bf16*)(ws + WS_GQ))
#define Gk ((bf16*)(ws + WS_GK))
#define Gv ((bf16*)(ws + WS_GV))
#define Gr ((bf16*)(ws + WS_GR))
#define GD ((float*)(ws + WS_GD))
#define QT ((bf16*)(ws + WS_QT))
#define KT ((bf16*)(ws + WS_KT))
#define DEC ((float*)(ws + WS_DEC))
#define DSb ((float*)(ws + WS_DS))
#define SPV ((bf16*)(ws + WS_SPREV))
#define OGb ((bf16*)(ws + WS_OGB))
#define HDB ((float*)(ws + WS_HD))
#define KV8 ((unsigned char*)(ws + WS_KV8))
#define Uq (ws + WS_UB)
#define Vq (ws + WS_VBX)
#define Usc ((float*)(ws + WS_USC))
#define Vsc ((float*)(ws + WS_USC) + 2 * 16384)
#define x_prompt (INP(0))
#define x_sample (INP(1))
#define attn_w_in (INP(7))
#define attn_w_out (INP(8))
#define gla_w_in (INP(9))
#define gla_w_out (INP(13))
#define peer_w_q (INP(14))
#define peer_keys1 (INP(15))
#define peer_keys2 (INP(16))
#define peer_u (INP(17))
#define peer_v (INP(18))
__device__ __forceinline__ unsigned char* launder_ptr(unsigned char* p) { asm volatile("" : "+s"(p)); return p; }
#if defined(LOWSGPR)
#define ws (launder_ptr(args.ws))
#define INP(k) ((const float*)inp_ptr(lds, (k)))
#else
#define ws (args.ws)
#define INP(k) (args.in[k])
#endif
__device__ __forceinline__ const void* inp_ptr(LAS unsigned char* lds, int k) {
    const unsigned long long v = *(LAS unsigned long long*)(lds + INPTAB_OFF + 8 * k);
    const unsigned lo = __builtin_amdgcn_readfirstlane((unsigned)v), hi = __builtin_amdgcn_readfirstlane((unsigned)(v >> 32));
    return (const void*)(((unsigned long long)hi << 32) | lo);
}
__global__ void __launch_bounds__(NTHREADS, 2) mk_fwd(Args args) {
    extern __shared__ __attribute__((aligned(16))) unsigned char lds_raw[];
    LAS unsigned char* lds = (LAS unsigned char*)lds_raw;
    volatile LAS unsigned* MISC = (volatile LAS unsigned*)(lds + MISC_OFF);
    const int tid = threadIdx.x, lane = tid & 63, wave = __builtin_amdgcn_readfirstlane(tid >> 6);
    const int G = gridDim.x, bx = blockIdx.x;
    const int vcu = (G % 8 == 0) ? (bx % 8) * (G / 8) + bx / 8 : bx;
    const int gw = vcu * NWAVES + wave, NGW = G * NWAVES;
    gu32* ctl = (gu32*)(ws + WS_CTL);
    for (int u = tid; u < (LDS_BYTES - LDSCTL_OFF) / 4; u += NTHREADS) ((LAS unsigned*)(lds + LDSCTL_OFF))[u] = 0u;
    __syncthreads();
    if (tid == 0) {
#define PUTIN(k) *(LAS unsigned long long*)(lds + INPTAB_OFF + 8 * (k)) = (unsigned long long)args.in[k]
        PUTIN(0); PUTIN(1); PUTIN(2); PUTIN(3); PUTIN(4); PUTIN(5); PUTIN(6); PUTIN(7); PUTIN(8); PUTIN(9); PUTIN(10); PUTIN(11); PUTIN(12); PUTIN(13); PUTIN(14); PUTIN(15);
        PUTIN(16); PUTIN(17); PUTIN(18); PUTIN(19); PUTIN(20); PUTIN(21); PUTIN(22);
#undef PUTIN
    }
    __syncthreads();
    XcdBarrier bar = xcd_barrier_post((unsigned*)(ctl + CW_BAR), MISC + 8);
    if (tid == 0) { const unsigned xme = xb_xcc_id(); MISC[13] = xme; MISC[12] = __hip_atomic_fetch_add((unsigned*)(ctl + CW_XC + 64 * xme), 1u, __ATOMIC_RELAXED, __HIP_MEMORY_SCOPE_AGENT); }
    const int lo = args.ph_lo, hi = args.ph_hi;
#define IN(k) (lo <= (k) && (k) < hi)
#define SEAM(k) do { if (IN(k) && IN((k) + 1)) xcd_barrier(bar); } while (0)
#ifndef REPEAT_PHASE
#define REPEAT_PHASE -1
#endif
#ifndef REPEAT_N
#define REPEAT_N 2
#endif
#define REP(k) for (int rep_ = 0; rep_ < (REPEAT_PHASE == (k) ? REPEAT_N : 1); ++rep_)


    if (IN(P_PRO)) {
        LAS float* scr = (LAS float*)(lds + wave * 16384);
        constexpr int KB16 = D / 64;
        constexpr int I_WA = (WA_ROWS / 32) * KB16, I_WO = (D / 32) * KB16, I_WG = (WG_ROWS / 32) * KB16, I_WGO = (D / 32) * KB16, I_WPQ = 2 * (PEER_N / 32) * KB16;
        constexpr int NITEMS = I_WA + I_WO + I_WG + I_WGO + I_WPQ;
        for (int it = gw; it < NITEMS; it += NGW) {
            int r = it;
            if (r < I_WA) { const int nb = r / KB16, kb = r % KB16, d0 = nb * 32; const int nv = ATT_N - d0 < 0 ? 0 : (ATT_N - d0 > 32 ? 32 : ATT_N - d0);
                p0_transpose_item(attn_w_in, ATT_N, D, Wa, d0, d0, nv, kb * 64, scr, lane); continue; } r -= I_WA;
            if (r < I_WO) { const int nb = r / KB16, kb = r % KB16; p0_transpose_item(attn_w_out, D, D, Wo, nb * 32, nb * 32, 32, kb * 64, scr, lane); continue; } r -= I_WO;
            if (r < I_WG) { const int nb = r / KB16, kb = r % KB16, d0 = nb * 32; int s0, nv;
                if (d0 < GN_R) { s0 = d0; nv = 32; } else if (d0 < GN_GD) { s0 = GR + (d0 - GN_R); nv = 32; } else if (d0 == GN_GD) { s0 = GGD; nv = 16; } else { s0 = 0; nv = 0; }
                p0_transpose_item(gla_w_in, GLA_N, D, Wg, d0, s0, nv, kb * 64, scr, lane); continue; } r -= I_WG;
            if (r < I_WGO) { const int nb = r / KB16, kb = r % KB16; p0_transpose_item(gla_w_out, D, D, Wgo, nb * 32, nb * 32, 32, kb * 64, scr, lane); continue; } r -= I_WGO;
            { const int l = r / ((PEER_N / 32) * KB16), rr = r % ((PEER_N / 32) * KB16), nb = rr / KB16, kb = rr % KB16;
              p0_transpose_item(peer_w_q + (size_t)l * D * PEER_N, PEER_N, D, Wpq + (size_t)l * PEER_N * D, nb * 32, nb * 32, 32, kb * 64, scr, lane); }
        }
        p0_convert(x_prompt, Xb, (size_t)TP * D / 8, gw, NGW, lane);
        p0_convert(x_sample, Xb + (size_t)TP * D, (size_t)TS * D / 8, gw, NGW, lane);
        p0_convert(peer_keys1, PK, (size_t)2 * 128 * 128 / 8, gw, NGW, lane);
        p0_convert(peer_keys2, PK + 2 * 128 * 128, (size_t)2 * 128 * 128 / 8, gw, NGW, lane);
    }
    SEAM(P_PRO);

    if (IN(P_AIN)) {
        FAttnIn F{Qb, Kb, Vb, QIb, KIb, WIf, args.out};
        { pg8::Gemm g{Xb, Wa, TP, 2048, D}; pg8::StaticOrder S; S.init(TP, 2048, G, bx);
          pg8::EpiRow8<FAttnIn> E{F};
          pg8::gemm_phase<pg8::EpiRow8<FAttnIn>, pg8::StaticOrder, true, true>(lds, g, S, E);
          float km = E.f.kmax, vm = E.f.vmax;
#pragma unroll
          for (int o = 1; o < 64; o <<= 1) { km = fmaxf(km, __shfl_xor(km, o)); vm = fmaxf(vm, __shfl_xor(vm, o)); }
          if (lane == 0) { if (km > 0.f) atomicMax((unsigned*)(ctl + CW_AMAXK), __builtin_bit_cast(unsigned, km)); if (vm > 0.f) atomicMax((unsigned*)(ctl + CW_AMAXV), __builtin_bit_cast(unsigned, vm)); } }
        for (int it = gw; it < TP / 16 + 8 * 34; it += NGW) {
            if (it < TP / 16) {
                f32x4 acc[5]; skinny_tile<5>(Xb, D, Wa, D, it * 16, 2048, acc, lane);
#pragma unroll
                for (int ct = 0; ct < 5; ++ct) F.put4(it * 16 + (lane & 15), 2048 + ct * 16 + 4 * (lane >> 4), acc[ct]);
            } else {
                const int r = it - TP / 16, rt = r % 8, cg = r / 8;
                f32x4 acc[4]; skinny_tile<4>(Xb, D, Wa, D, TP + rt * 16, cg * 64, acc, lane);
#pragma unroll
                for (int ct = 0; ct < 4; ++ct) F.put4(TP + rt * 16 + (lane & 15), cg * 64 + ct * 16 + 4 * (lane >> 4), acc[ct]);
            }
        }
    }
    SEAM(P_AIN);

            if (IN(P_SCORE)) { kv8_convert(Kb, Vb, KV8, (const unsigned*)(ctl + CW_AMAXK), (const unsigned*)(ctl + CW_AMAXV), gw, NGW, lane);
        phase_score(QIb, KIb, WIf, INP(4), args.page_table, SC, SCS, QuantTabs{peer_u, peer_v, Uq, Vq, Usc, Vsc}, lds, vcu, G, wave, lane, gw, NGW); }
    SEAM(P_SCORE);
    if (IN(P_TOPK)) {
#if defined(PROBE_TOPK_ROWS)
        const int jlo_ = (lo == P_TOPK) ? (PROBE_TOPK_ROWS == 1 ? 0 : TP) : 0, jhi_ = (lo == P_TOPK) ? (PROBE_TOPK_ROWS == 1 ? TP : TA) : TA;
#else
        const int jlo_ = 0, jhi_ = TA;
#endif
        phase_topk2(SC, SCS, IDX, CNT, peer_u, peer_v, Uq, Vq, Usc, Vsc, lds, (unsigned*)(ctl + CW_Q1), wave, lane, gw, NGW, jlo_, jhi_); }
    SEAM(P_TOPK);
    if (IN(P_ATTN)) {
        LAS unsigned char* wl = lds + wave * 16384;
        {
            if (tid == 0) { unsigned np = 0, mi = 0, mycnt = 1; const unsigned xme = MISC[13];
                for (unsigned j = 0; j < 16; ++j) { const unsigned c = __hip_atomic_load((unsigned*)(ctl + CW_XC + 64 * j), __ATOMIC_RELAXED, __HIP_MEMORY_SCOPE_AGENT); if (c > 0u) { if (j < xme) ++mi; ++np; } if (j == xme) mycnt = c > 0u ? c : 1u; }
                MISC[14] = np > 0u ? np : 1u; MISC[15] = mi; MISC[16] = mycnt; }
            __syncthreads();
            const int np = (int)MISC[14], mi = (int)MISC[15], mycnt = (int)MISC[16], rank = (int)MISC[12];
            for (int u = 0; u < NBATCH * 4; ++u) if (u % np == mi) attn_prompt_stream(u >> 2, u & 3, rank * NWAVES + wave, mycnt * NWAVES, Qb, IDX, KV8, (const unsigned*)(ctl + CW_AMAXK), (const unsigned*)(ctl + CW_AMAXV), Ob, wl, lane);
        }
        {
            const float* ck_ = INP(2); const float* cv_ = INP(3); float* o_ = args.out; const int* pt_ = args.page_table; int gws_ = gw; int lane_s = lane;
            asm volatile("" : "+s"(ck_), "+s"(cv_), "+s"(o_), "+s"(pt_), "+s"(gws_), "+v"(lane_s));
            for (int su = gws_; su < TS * 4 * 4; su += NGW) {
                if ((su & 3) == 0) { const int un = su >> 2, r = un >> 2, n = un & 3; attn_row<true>(TP + r, n, n + 1, Qb, IDX, CNT, nullptr, nullptr, ck_, cv_, o_ + OUT_KS, o_ + OUT_VS, pt_, Ob, wl, lane_s); }
            }
        }
    }
    SEAM(P_ATTN);
    if (IN(P_AOUT)) {
        FResid F{x_prompt, x_sample, Z};
        { pg8::Gemm g{Ob, Wo, TP, D, D}; pg8::StaticOrder S; S.init(TP, D, G, bx);
          pg8::EpiRow8<FResid> E{F};
          pg8::gemm_phase<pg8::EpiRow8<FResid>, pg8::StaticOrder, true, true>(lds, g, S, E); }
        for (int it = gw; it < 8 * 16; it += NGW) {
            const int rt = it % 8, cg = it / 8;
            f32x4 acc[4]; skinny_tile<4>(Ob, D, Wo, D, TP + rt * 16, cg * 64, acc, lane);
#pragma unroll
            for (int ct = 0; ct < 4; ++ct) F.put4(TP + rt * 16 + (lane & 15), cg * 64 + ct * 16 + 4 * (lane >> 4), acc[ct]);
        }
    }
    SEAM(P_AOUT);
    if (IN(P_LN1)) { for (int r = gw; r < TA; r += NGW) ln_row_wave(Z + (size_t)r * D, INP(19), INP(20), (float*)nullptr, H1b + (size_t)r * D, lane); }
    SEAM(P_LN1);

        if (IN(P_PQ0)) {
        FStoreBf16 F{PQb, PEER_N};
        { pg8::Gemm g{H1b, Wpq, TP, PEER_N, D}; pg8::StaticOrder S; S.init(TP, PEER_N, G, bx);
          pg8::EpiRow8<FStoreBf16> E{F};
          pg8::gemm_phase<pg8::EpiRow8<FStoreBf16>, pg8::StaticOrder, true, true>(lds, g, S, E); }
#if defined(PROBE_DUP_GEMM)
        { pg8::Gemm g{H1b, Wpq, TP, PEER_N, D}; pg8::StaticOrder S; S.init(TP, PEER_N, G, bx);
          pg8::EpiRow8<FStoreBf16> E{F};
          pg8::gemm_phase<pg8::EpiRow8<FStoreBf16>, pg8::StaticOrder, true, true>(lds, g, S, E); }
#endif
        for (int it = gw; it < 8 * 32; it += NGW) {
            const int rt = it % 8, cg = it / 8;
            f32x4 acc[4]; skinny_tile<4>(H1b, D, Wpq, D, TP + rt * 16, cg * 64, acc, lane);
#pragma unroll
            for (int ct = 0; ct < 4; ++ct) F.put4(TP + rt * 16 + (lane & 15), cg * 64 + ct * 16 + 4 * (lane >> 4), acc[ct]);
        }
#if 0
        for (int it = gw; it < 8 * 16; it += NGW) {
            const int rt = it % 8, cg = it / 8;
            f32x4 acc[8]; skinny_tile<8>(H1b, D, Wpq, D, TP + rt * 16, cg * 128, acc, lane);
#pragma unroll
            for (int ct = 0; ct < 8; ++ct) F.put4(TP + rt * 16 + (lane & 15), cg * 128 + ct * 16 + 4 * (lane >> 4), acc[ct]);
        }
#endif
    }
    SEAM(P_PQ0);
        if (IN(P_PEER0)) {
        phase_peer_select(PQb, PK, PK + 2 * 16384, TEID, TGATE, lds, vcu, G, wave, lane);
#if defined(PROBE_DUP_SELECT)
        xcd_barrier(bar);
        phase_peer_select(PQb, PK, PK + 2 * 16384, TEID, TGATE, lds, vcu, G, wave, lane);
#endif
        xcd_barrier(bar);
#if defined(U_SLICED)
        PEER_USLICE(H1b, Uq, Usc);
        xcd_barrier(bar);
        phase_peer_mixv(Z, INP(19), INP(20), TEID, TGATE, HDB, Vq, Usc, Vsc, INP(21), INP(22), H2f, H2b, gw, NGW, lane);
#else
#if defined(MIX_FROM_Z)
        phase_peer_mix(Z, INP(19), INP(20), TEID, TGATE, Uq, Vq, Usc, Vsc, INP(21), INP(22), H2f, H2b, gw, NGW, lane);
#else
        MIXSEL(H1f, TEID, TGATE, Uq, Vq, Usc, Vsc, INP(21), INP(22), H2f, H2b, lds, wave, gw, NGW, lane);
#endif
#endif
    }
    SEAM(P_PEER0);

            if (IN(P_GIN)) {
        FGlaIn F{Gq, Gk, Gv, Gr, GD};
        { pg8::Gemm g{H2b, Wg, TP, 3072, D}; pg8::StaticOrder S; S.init(TP, 3072, G, bx);
          pg8::EpiRow8<FGlaIn> E{F};
          pg8::gemm_phase<pg8::EpiRow8<FGlaIn>, pg8::StaticOrder, true, true>(lds, g, S, E); }
        for (int it = gw; it < TP / 16 + 8 * 97; it += NGW) {
            if (it < TP / 16) {
                f32x4 acc[1]; skinny_tile<1>(H2b, D, Wg, D, it * 16, GN_GD, acc, lane);
                F.put4(it * 16 + (lane & 15), GN_GD + 4 * (lane >> 4), acc[0]);
            } else {
                const int r = it - TP / 16, rt = r % 8, cg = r / 8;
                f32x4 acc[2]; skinny_tile<2>(H2b, D, Wg, D, TP + rt * 16, cg * 32, acc, lane);
#pragma unroll
                for (int ct = 0; ct < 2; ++ct) F.put4(TP + rt * 16 + (lane & 15), cg * 32 + ct * 16 + 4 * (lane >> 4), acc[ct]);
            }
        }
    }
    SEAM(P_GIN);
    if (IN(P_GCH)) {
        for (int it = vcu; it < NBATCH * (SEQ / 64) * 4; it += G) gla_chunk_item(it, Gq, Gk, Gv, GD, INP(10), INP(11), QT, KT, DEC, DSb, lds, tid, wave, lane);
        for (int it = vcu; it < DB * 4; it += G) gla_sample_item(it, Gq, Gk, Gv, Gr, GD, INP(10), INP(11), INP(12), INP(5), args.out + OUT_SS, OGb, lds, tid, lane);
    }
    SEAM(P_GCH);
    if (IN(P_GSC)) gla_scan(DSb, DEC, SPV, args.out + OUT_SP, vcu * NTHREADS + tid, G * NTHREADS);
    SEAM(P_GSC);
    if (IN(P_GOUT)) { for (int it = vcu; it < NBATCH * (SEQ / 64) * 4; it += G) gla_out_item(it, QT, KT, Gv, Gr, SPV, INP(12), OGb, lds, tid, wave, lane); }
    SEAM(P_GOUT);
    if (IN(P_GPRJ)) {
        FResid F{H2f, H2f + (size_t)TP * D, Z};
        { pg8::Gemm g{OGb, Wgo, TP, D, D}; pg8::StaticOrder S; S.init(TP, D, G, bx);
          pg8::EpiRow8<FResid> E{F};
          pg8::gemm_phase<pg8::EpiRow8<FResid>, pg8::StaticOrder, true, true>(lds, g, S, E); }
        for (int it = gw; it < 8 * 16; it += NGW) {
            const int rt = it % 8, cg = it / 8;
            f32x4 acc[4]; skinny_tile<4>(OGb, D, Wgo, D, TP + rt * 16, cg * 64, acc, lane);
#pragma unroll
            for (int ct = 0; ct < 4; ++ct) F.put4(TP + rt * 16 + (lane & 15), cg * 64 + ct * 16 + 4 * (lane >> 4), acc[ct]);
        }
    }
    SEAM(P_GPRJ);
    if (IN(P_LN1B)) { for (int r = gw; r < TA; r += NGW) ln_row_wave(Z + (size_t)r * D, INP(19) + D, INP(20) + D, (float*)nullptr, H1b + (size_t)r * D, lane); }
    SEAM(P_LN1B);
    if (IN(P_PQ1)) {
        FStoreBf16 F{PQb, PEER_N}; const bf16* W1 = Wpq + (size_t)PEER_N * D;
        { pg8::Gemm g{H1b, W1, TP, PEER_N, D}; pg8::StaticOrder S; S.init(TP, PEER_N, G, bx);
          pg8::EpiRow8<FStoreBf16> E{F};
          pg8::gemm_phase<pg8::EpiRow8<FStoreBf16>, pg8::StaticOrder, true, true>(lds, g, S, E); }
        for (int it = gw; it < 8 * 32; it += NGW) {
            const int rt = it % 8, cg = it / 8;
            f32x4 acc[4]; skinny_tile<4>(H1b, D, W1, D, TP + rt * 16, cg * 64, acc, lane);
#pragma unroll
            for (int ct = 0; ct < 4; ++ct) F.put4(TP + rt * 16 + (lane & 15), cg * 64 + ct * 16 + 4 * (lane >> 4), acc[ct]);
        }
    }
    SEAM(P_PQ1);
    if (IN(P_PEER1)) {
        phase_peer_select(PQb, PK + 16384, PK + 3 * 16384, TEID, TGATE, lds, vcu, G, wave, lane);
        xcd_barrier(bar);
#if defined(U_SLICED)
        PEER_USLICE(H1b, Uq + (size_t)16384 * D, Usc + 16384);
        xcd_barrier(bar);
        phase_peer_mixv(Z, INP(19) + D, INP(20) + D, TEID, TGATE, HDB, Vq + (size_t)16384 * D, Usc + 16384, Vsc + 16384, INP(21) + D, INP(22) + D, args.out + OUT_Y, nullptr, gw, NGW, lane);
#else
#if defined(MIX_FROM_Z)
        phase_peer_mix(Z, INP(19) + D, INP(20) + D, TEID, TGATE, Uq + (size_t)16384 * D, Vq + (size_t)16384 * D, Usc + 16384, Vsc + 16384, INP(21) + D, INP(22) + D, args.out + OUT_Y, nullptr, gw, NGW, lane);
#else
        MIXSEL(H1f, TEID, TGATE, Uq + (size_t)16384 * D, Vq + (size_t)16384 * D, Usc + 16384, Vsc + 16384, INP(21) + D, INP(22) + D, args.out + OUT_Y, nullptr, lds, wave, gw, NGW, lane);
#endif
#endif
    }
#if defined(PROBE_REGION)
    if (IN(P_PEER1)) { xcd_barrier(bar);
        const float eps = sqrtf((float)g_probe_acc * 1e-8f);
        for (int i = vcu * NTHREADS + tid; i < TS * D; i += G * NTHREADS) args.out[OUT_Y + (size_t)TP * D + i] *= (1.f + eps); }
#endif
#undef IN
#undef SEAM
}
#undef ws
#undef INP
#undef Wa
#undef Wo
#undef Wg
#undef Wgo
#undef Wpq
#undef PK
#undef Usc
#undef Xb
#undef Qb
#undef QIb
#undef Kb
#undef Vb
#undef KIb
#undef WIf
#undef SC
#undef SCS
#undef IDX
#undef CNT
#undef Ob
#undef Z
#undef H1f
#undef H1b
#undef PQb
#undef H2f
#undef H2b
#undef TEID
#undef TGATE
#undef Gq
#undef Gk
#undef Gv
#undef Gr
#undef GD
#undef QT
#undef KT
#undef DEC
#undef DSb
#undef SPV
#undef OGb
#undef Uq
#undef HDB
#undef KV8
#undef Vq
#undef Usc
#undef Vsc
#undef x_prompt
#undef x_sample
#undef attn_w_in
#undef attn_w_out
#undef gla_w_in
#undef gla_w_out
#undef peer_w_q
#undef peer_keys1
#undef peer_keys2
#undef peer_u
#undef peer_v


}

extern "C" void kernel_launch(void* const* d_in, const int* in_sizes, int n_in, void* d_out, int out_size, void* d_ws, size_t ws_size, hipStream_t stream) {
    if (ws_size < mk::WS_END || n_in != 23 || (size_t)out_size != OUT_TOTAL) { fprintf(stderr, "kernel_launch: unexpected sizes ws %zu n_in %d out %d\n", ws_size, n_in, out_size); return; }
    static int grid = 0;
    if (grid == 0) {
        int dev = 0, cus = 0;
        if (hipGetDevice(&dev) != hipSuccess || hipDeviceGetAttribute(&cus, hipDeviceAttributeMultiprocessorCount, dev) != hipSuccess) { fprintf(stderr, "kernel_launch: device query failed\n"); grid = -1; return; }
        if (hipFuncSetAttribute((const void*)mk::mk_fwd, hipFuncAttributeMaxDynamicSharedMemorySize, mk::LDS_BYTES) != hipSuccess) { fprintf(stderr, "kernel_launch: hipFuncSetAttribute failed\n"); grid = -1; return; }
        int per_cu = 0;
        if (hipOccupancyMaxActiveBlocksPerMultiprocessor(&per_cu, (const void*)mk::mk_fwd, mk::NTHREADS, mk::LDS_BYTES) != hipSuccess || per_cu < 1) fprintf(stderr, "kernel_launch: occupancy query says %d\n", per_cu);
        (void)hipGetLastError();
        grid = cus;
    }
    if (grid < 0) return;
    (void)hipMemsetAsync((char*)d_ws + mk::WS_CTL, 0, mk::CTL_ZERO_BYTES, stream);
    mk::Args a{};
    for (int i = 0; i < 23; ++i) a.in[i] = (const float*)d_in[i];
    a.page_table = (const int*)d_in[6]; a.out = (float*)d_out; a.ws = (unsigned char*)d_ws; a.ph_lo = 0; a.ph_hi = mk::P_COUNT;
    hipLaunchKernelGGL(mk::mk_fwd, dim3(grid), dim3(mk::NTHREADS), mk::LDS_BYTES, stream, a);
}
```

```cpp
#include <hip/hip_runtime.h>
#include <cstdio>
#include <cstdint>
#include <cmath>

constexpr int D = 1024;
constexpr int NBATCH = 2, SEQ = 8192, TP = NBATCH * SEQ;
constexpr int DB = 32, DS = 4, TS = DB * DS;
constexpr int TA = TP + TS;
constexpr int PAST = 8192, PAGE = 128, NPAGES = PAST / PAGE;
constexpr float ALPHA = 1.4142135623730951f;
constexpr float LN_EPS = 1e-5f;
constexpr int ATT_N = 2120;
constexpr int AQ = 0, AK = 1024, AV = 1280, AQI = 1536, AKI = 2048, AWI = 2112;
constexpr int TOPK = 256;
constexpr int GLA_N = 3088;
constexpr int GQ = 0, GK = 512, GV = 1024, GGD = 2048, GR = 2064;
constexpr int PEER_N = 2048;
constexpr int SCS_LD = 8256;

constexpr size_t OUT_Y = 0, OUT_KP = 16908288, OUT_VP = 21102592, OUT_KIP = 25296896, OUT_SP = 26345472,
                 OUT_KS = 26607616, OUT_VS = 26640384, OUT_KIS = 26673152, OUT_SS = 26681344, OUT_TOTAL = 30875648;


namespace pg8 {
#define PG8_LAS __attribute__((address_space(3)))
typedef unsigned short bf16_t;
typedef short bf16x8 __attribute__((ext_vector_type(8)));
typedef float f32x4 __attribute__((ext_vector_type(4)));
typedef unsigned u32x4 __attribute__((ext_vector_type(4)));
constexpr int BM = 256, BK = 64, HALF = 128, HTB = HALF * BK * 2  , STAGE_BYTES = 8 * HTB, NXCD = 8, WGM = 8;

__host__ __device__ __forceinline__ int lds_byte(int r, int c) { const int st = (r >> 4) * 2 + (c >> 5), rr = r & 15, cc = c & 31, ob = rr * 64 + cc * 2; return st * 1024 + (ob ^ (((ob >> 9) & 1) << 5)); }
__host__ __device__ __forceinline__ void stage_rc(int b, int& R, int& C) { const int st = b / 1024, sb = b % 1024, swz = sb ^ (((sb >> 9) & 1) << 5); R = (st >> 1) * 16 + swz / 64; C = (st & 1) * 32 + (swz % 64) / 2; }
__host__ __device__ __forceinline__ int perm32(int rho) { const int n = rho >> 4, i = rho & 15; return 8 * (i >> 2) + 4 * n + (i & 3); }

struct Unit { int pm, pn; };
struct Gemm { const bf16_t* A; const bf16_t* Bt; int M, N, K; };

struct StaticOrder {
    int nM, nN, nwg, G, c;
    __host__ __device__ void init(int M, int N, int G_, int c_) { nM = M / BM; nN = N / BM; nwg = nM * nN; G = G_; c = c_; }
    __host__ __device__ bool next(int i, Unit& u) const {
        const long L = (long)i * G + c; if (L >= nwg) return false;
        int wgid = (int)L; { const int q = nwg / NXCD, r = nwg % NXCD, xcd = wgid % NXCD, off = wgid / NXCD; wgid = (xcd < r ? xcd * (q + 1) : r * (q + 1) + (xcd - r) * q) + off; }
        const int nig = WGM * nN, gid = wgid / nig, fm = gid * WGM, gsz = (nM - fm) < WGM ? (nM - fm) : WGM;
        u.pm = fm + ((wgid % nig) % gsz); u.pn = (wgid % nig) / gsz; return true;
    }
    __device__ __forceinline__ void a_ready(const Unit&) const {}
    __device__ __forceinline__ void done(const Unit&) const {}
};

__device__ __forceinline__ unsigned cvt_pk_bf16(float lo, float hi) { unsigned r; asm volatile("v_cvt_pk_bf16_f32 %0, %1, %2" : "=v"(r) : "v"(lo), "v"(hi)); return r; }
template <class F> struct EpiRow8 {
    static constexpr bool PERM = true, AFTER_DRAIN = false;
    F f;
    __device__ __forceinline__ void operator()(const f32x4 (&acc)[2][2][4][2], const Unit& u, int wr, int wc, int fr, int fq) const {
        const int row0 = u.pm * BM + wr * 64 + fr, col0 = u.pn * BM + wc * 32 + 8 * fq;
#pragma unroll
        for (int ai = 0; ai < 2; ++ai)
#pragma unroll
            for (int m = 0; m < 4; ++m)
#pragma unroll
                for (int bj = 0; bj < 2; ++bj) f.put8(row0 + ai * HALF + m * 16, col0 + bj * HALF, acc[ai][bj][m][0], acc[ai][bj][m][1]);
    }
};


template <class Epi, class Sched, bool ALIGN_EPI = false, bool SP2 = false>
__device__ __forceinline__ void gemm_phase(PG8_LAS unsigned char* lds, const Gemm g, const Sched& S, const Epi& E) {
    const int tid = threadIdx.x, wid = __builtin_amdgcn_readfirstlane(tid >> 6), lane = tid & 63, wr = wid >> 2, wc = wid & 3, fr = lane & 15, fq = lane >> 4;
    const int K = g.K, nt = K / BK;
    unsigned voffA[2], voffB[2];
#pragma unroll
    for (int i = 0; i < 2; ++i) { int R, C; stage_rc(tid * 16 + i * 8192, R, C); const int Rb = Epi::PERM ? ((R & ~31) + perm32(R & 31)) : R;
        voffA[i] = (unsigned)(R * K + C) * 2u; voffB[i] = (unsigned)(Rb * K + C) * 2u; }
    const size_t kstep = (size_t)(BK * 2);
    const size_t hstep = (size_t)HALF * K * 2;
    const size_t tstep = 2 * hstep;
    const unsigned ldsw = (unsigned)wid * 1024u;
    const int aoff = lds_byte(wr * 64 + fr, fq * 8), boff = lds_byte(wc * 32 + fr, fq * 8);
#define PG8_SA(b, h) (((b) * 2 + (h)) * HTB)
#define PG8_SB(b, h) ((4 + (b) * 2 + (h)) * HTB)
#define PG8_STAGE(bufoff, gbase, voff) do { _Pragma("unroll") for (int _i = 0; _i < 2; ++_i) \
        __builtin_amdgcn_global_load_lds((const unsigned*)((const char*)(gbase) + (voff)[_i]), (PG8_LAS unsigned*)(lds + (bufoff) + ldsw + _i * 8192), 16, 0, 0); } while (0)
#define PG8_LDA(dst, b, h) do { _Pragma("unroll") for (int m = 0; m < 4; ++m) _Pragma("unroll") for (int k = 0; k < 2; ++k) dst[m][k] = *(const PG8_LAS bf16x8*)(lds + PG8_SA(b, h) + aoff + m * 2048 + k * 1024); } while (0)
#define PG8_LDB(dst, b, h) do { _Pragma("unroll") for (int n = 0; n < 2; ++n) _Pragma("unroll") for (int k = 0; k < 2; ++k) dst[n][k] = *(const PG8_LAS bf16x8*)(lds + PG8_SB(b, h) + boff + n * 2048 + k * 1024); } while (0)
#define PG8_MMA(ai, bj, At, Bt) do { __builtin_amdgcn_s_setprio(1); _Pragma("unroll") for (int m = 0; m < 4; ++m) _Pragma("unroll") for (int n = 0; n < 2; ++n) _Pragma("unroll") for (int k = 0; k < 2; ++k) \
        acc[ai][bj][m][n] = __builtin_amdgcn_mfma_f32_16x16x32_bf16(Bt[n][k], At[m][k], acc[ai][bj][m][n], 0, 0, 0); __builtin_amdgcn_s_setprio(0); } while (0)
#define PG8_WAIT_V(n) asm volatile("s_waitcnt vmcnt(" #n ")" ::: "memory")
#define PG8_WAIT_L(n) asm volatile("s_waitcnt lgkmcnt(" #n ")" ::: "memory")
#define PG8_BAR __builtin_amdgcn_s_barrier()
#define PG8_SCHED __builtin_amdgcn_sched_barrier(0)
    Unit cur, nxt; int ui = 0;
    if (!S.next(0, cur)) return;
    f32x4 acc[2][2][4][2];
#pragma unroll
    for (int a = 0; a < 2; ++a)
#pragma unroll
        for (int b = 0; b < 2; ++b)
#pragma unroll
            for (int m = 0; m < 4; ++m)
#pragma unroll
                for (int n = 0; n < 2; ++n) acc[a][b][m][n] = (f32x4){0.f, 0.f, 0.f, 0.f};
    bf16x8 At[4][2], B0[2][2], B1[2][2];
    const char* cA = (const char*)g.A + (size_t)cur.pm * tstep; const char* cB = (const char*)g.Bt + (size_t)cur.pn * tstep;
    S.a_ready(cur);
    if constexpr (SP2) {
        PG8_STAGE(PG8_SB(0, 0), cB, voffB); PG8_STAGE(PG8_SB(0, 1), cB + hstep, voffB); PG8_STAGE(PG8_SA(0, 0), cA, voffA); PG8_STAGE(PG8_SA(0, 1), cA + hstep, voffA);
        if (wr == 1) PG8_BAR;
        PG8_WAIT_V(2); PG8_BAR;
        PG8_STAGE(PG8_SB(1, 0), cB + kstep, voffB); PG8_STAGE(PG8_SA(1, 0), cA + kstep, voffA); PG8_STAGE(PG8_SB(1, 1), cB + hstep + kstep, voffB);
        PG8_WAIT_V(6); PG8_BAR;
    } else {
        PG8_STAGE(PG8_SB(0, 0), cB, voffB); PG8_STAGE(PG8_SA(0, 0), cA, voffA); PG8_STAGE(PG8_SB(0, 1), cB + hstep, voffB); PG8_STAGE(PG8_SA(0, 1), cA + hstep, voffA);
        if (wr == 1) PG8_BAR;
        PG8_WAIT_V(4); PG8_BAR;
        PG8_STAGE(PG8_SB(1, 0), cB + kstep, voffB); PG8_STAGE(PG8_SA(1, 0), cA + kstep, voffA); PG8_STAGE(PG8_SB(1, 1), cB + hstep + kstep, voffB);
        PG8_WAIT_V(6); PG8_BAR;
    }
    for (;;) {
        const bool has_next = S.next(ui + 1, nxt);
        const char* nA = has_next ? (const char*)g.A + (size_t)nxt.pm * tstep : cA; const char* nB = has_next ? (const char*)g.Bt + (size_t)nxt.pn * tstep : cB;
        for (int t = 0; t < nt; t += 2) {
            const bool last = (t == nt - 2);
            const char* a1 = cA + (size_t)(t + 1) * kstep;
            const char* a2 = last ? nA : cA + (size_t)(t + 2) * kstep; const char* b2 = last ? nB : cB + (size_t)(t + 2) * kstep;
            const char* a3 = a2 + kstep; const char* b3 = b2 + kstep;
            if (last && has_next) S.a_ready(nxt);
            if constexpr (SP2) {
            PG8_LDB(B0, 0, 0); PG8_LDB(B1, 0, 1); PG8_SCHED; PG8_LDA(At, 0, 0); PG8_STAGE(PG8_SA(1, 1), a1 + hstep, voffA);
            PG8_WAIT_V(8); PG8_WAIT_L(0); PG8_BAR; PG8_MMA(0, 0, At, B0); PG8_MMA(0, 1, At, B1); PG8_BAR; PG8_SCHED;
            PG8_LDA(At, 0, 1); PG8_STAGE(PG8_SB(0, 0), b2, voffB); PG8_STAGE(PG8_SB(0, 1), b2 + hstep, voffB); PG8_STAGE(PG8_SA(0, 0), a2, voffA);
            PG8_WAIT_V(8); PG8_WAIT_L(0); PG8_BAR; PG8_MMA(1, 0, At, B0); PG8_MMA(1, 1, At, B1); PG8_BAR; PG8_SCHED;
            PG8_LDB(B0, 1, 0); PG8_LDB(B1, 1, 1); PG8_SCHED; PG8_LDA(At, 1, 0); PG8_STAGE(PG8_SA(0, 1), a2 + hstep, voffA);
            PG8_WAIT_V(8); PG8_WAIT_L(0); PG8_BAR; PG8_MMA(0, 0, At, B0); PG8_MMA(0, 1, At, B1); PG8_BAR; PG8_SCHED;
            PG8_LDA(At, 1, 1); PG8_STAGE(PG8_SB(1, 0), b3, voffB); PG8_STAGE(PG8_SB(1, 1), b3 + hstep, voffB); PG8_STAGE(PG8_SA(1, 0), a3, voffA);
            PG8_WAIT_V(8); PG8_WAIT_L(0); PG8_BAR; PG8_MMA(1, 0, At, B0); PG8_MMA(1, 1, At, B1); PG8_BAR; PG8_SCHED;
            } else {
            PG8_LDB(B0, 0, 0); PG8_SCHED; PG8_LDA(At, 0, 0); PG8_STAGE(PG8_SA(1, 1), a1 + hstep, voffA);
            PG8_WAIT_L(8); PG8_BAR; PG8_WAIT_L(0); PG8_MMA(0, 0, At, B0); PG8_BAR; PG8_SCHED;
            PG8_LDB(B1, 0, 1); PG8_STAGE(PG8_SB(0, 0), b2, voffB);
            PG8_BAR; PG8_WAIT_L(0); PG8_MMA(0, 1, At, B1); PG8_BAR;
            PG8_LDA(At, 0, 1); PG8_STAGE(PG8_SA(0, 0), a2, voffA);
            PG8_BAR; PG8_WAIT_L(0); PG8_MMA(1, 0, At, B0); PG8_BAR; PG8_SCHED;
            PG8_STAGE(PG8_SB(0, 1), b2 + hstep, voffB);
            PG8_WAIT_V(6); PG8_BAR; PG8_MMA(1, 1, At, B1); PG8_BAR;
            PG8_LDB(B0, 1, 0); PG8_SCHED; PG8_LDA(At, 1, 0); PG8_STAGE(PG8_SA(0, 1), a2 + hstep, voffA);
            PG8_WAIT_L(8); PG8_BAR; PG8_WAIT_L(0); PG8_MMA(0, 0, At, B0); PG8_BAR; PG8_SCHED;
            PG8_LDB(B1, 1, 1); PG8_STAGE(PG8_SB(1, 0), b3, voffB);
            PG8_BAR; PG8_WAIT_L(0); PG8_MMA(0, 1, At, B1); PG8_BAR;
            PG8_LDA(At, 1, 1); PG8_STAGE(PG8_SA(1, 0), a3, voffA);
            PG8_BAR; PG8_WAIT_L(0); PG8_MMA(1, 0, At, B0); PG8_BAR; PG8_SCHED;
            PG8_STAGE(PG8_SB(1, 1), b3 + hstep, voffB);
            PG8_WAIT_V(6); PG8_BAR; PG8_MMA(1, 1, At, B1); PG8_BAR;
            }
        }
        if constexpr (ALIGN_EPI) { if (wr == 0) PG8_BAR; }
        if constexpr (!Epi::AFTER_DRAIN) { E(acc, cur, wr, wc, fr, fq); S.done(cur); }
        if (!has_next) break;
#pragma unroll
        for (int a = 0; a < 2; ++a)
#pragma unroll
            for (int b = 0; b < 2; ++b)
#pragma unroll
                for (int m = 0; m < 4; ++m)
#pragma unroll
                    for (int n = 0; n < 2; ++n) acc[a][b][m][n] = (f32x4){0.f, 0.f, 0.f, 0.f};
        cur = nxt; cA = nA; cB = nB; ++ui;
        if constexpr (ALIGN_EPI) { if (wr == 1) PG8_BAR; }
    }
    PG8_WAIT_V(0);
    if constexpr (!ALIGN_EPI) { if (wr == 0) PG8_BAR; }
    PG8_BAR;
    if constexpr (Epi::AFTER_DRAIN) { E.fused(acc, cur, wr, wc, fr, fq, lds, wid, lane); S.done(cur); }
#undef PG8_SA
#undef PG8_SB
#undef PG8_STAGE
#undef PG8_LDA
#undef PG8_LDB
#undef PG8_MMA
#undef PG8_WAIT_V
#undef PG8_WAIT_L
#undef PG8_BAR
#undef PG8_SCHED
}
}

namespace mk {
#define GAS __attribute__((address_space(1)))
#define LAS __attribute__((address_space(3)))
typedef unsigned short bf16;
typedef unsigned v4u __attribute__((ext_vector_type(4)));
typedef float f32x4 __attribute__((ext_vector_type(4)));
typedef short bf16x8 __attribute__((ext_vector_type(8)));
typedef GAS unsigned gu32;
typedef GAS unsigned long long gu64;
#define RLX_AGENT __ATOMIC_RELAXED, __HIP_MEMORY_SCOPE_AGENT
#define LDS_WAIT() asm volatile("s_waitcnt lgkmcnt(0)" ::: "memory")
#define VM_WAIT() asm volatile("s_waitcnt vmcnt(0)" ::: "memory")
__device__ __forceinline__ unsigned long long rt() { return __builtin_amdgcn_s_memrealtime(); }
__device__ __forceinline__ unsigned f2bf(float f) { unsigned u = __builtin_bit_cast(unsigned, f); return (u + 0x7fffu + ((u >> 16) & 1u)) >> 16; }
__device__ __forceinline__ unsigned pk2(float lo, float hi) {
    typedef __bf16 bf2_t __attribute__((ext_vector_type(2))); typedef float f2_t __attribute__((ext_vector_type(2)));
    const f2_t v = {lo, hi}; const bf2_t b = __builtin_convertvector(v, bf2_t); return __builtin_bit_cast(unsigned, b); }

#define XB_TMO      128
#define XB_XCNT(j)  (256  + 64 * (j))
#define XB_XSUB(j)  (1280 + 64 * (j))
#define XB_XGEN(j)  (2304 + 64 * (j))
#define XB_TOP      3328
#define XB_TOPGEN   3392
#define XCD_BAR_WORDS 3456
#define XB_SPIN_CAP (1u << 18)

__device__ __forceinline__ unsigned xb_ld(unsigned* p)              { return __hip_atomic_load(p, __ATOMIC_RELAXED, __HIP_MEMORY_SCOPE_AGENT); }
__device__ __forceinline__ unsigned xb_add(unsigned* p, unsigned v) { return __hip_atomic_fetch_add(p, v, __ATOMIC_RELAXED, __HIP_MEMORY_SCOPE_AGENT); }
__device__ __forceinline__ unsigned xb_xcc_id() { return (unsigned)__builtin_amdgcn_s_getreg((3 << 11) | 20) & 0xFu; }
#define XB_SPIN(cond, bar) do { unsigned _sp = 0; while (cond) { __builtin_amdgcn_s_sleep(1); \
    if ((++_sp & 255u) == 0u) { if (xb_ld(&(bar)[XB_TMO])) break; if (_sp > XB_SPIN_CAP) { atomicAdd(&(bar)[XB_TMO], 1u); break; } } } } while (0)

struct XcdBarrier {
    unsigned* bar; unsigned x;
    volatile LAS unsigned* st;
};

__device__ __forceinline__ XcdBarrier xcd_barrier_post(unsigned* bar, volatile LAS unsigned* st) {
    XcdBarrier b; b.bar = bar; b.x = xb_xcc_id(); b.st = st;
    if (threadIdx.x == 0) (void)xb_add(&bar[XB_XCNT(b.x)], 1u);
    return b;
}
__device__ __forceinline__ void xcd_barrier_complete(unsigned* bar, unsigned x, unsigned& nloc, unsigned& nx) {
    const unsigned G = gridDim.x * gridDim.y * gridDim.z;
    unsigned sum, cnt, mine, sp = 0u;
    for (;;) {
        sum = 0u; cnt = 0u; mine = 0u;
#pragma unroll
        for (unsigned j = 0; j < 16; ++j) { const unsigned c = xb_ld(&bar[XB_XCNT(j)]); sum += c; cnt += (c > 0u) ? 1u : 0u; mine = (j == x) ? c : mine; }
        if (sum == G) break;
        __builtin_amdgcn_s_sleep(1);
        if ((++sp & 255u) == 0u) { if (xb_ld(&bar[XB_TMO])) break; if (sp > XB_SPIN_CAP) { atomicAdd(&bar[XB_TMO], 1u); break; } }
    }
    nloc = mine > 0u ? mine : 1u; nx = cnt > 0u ? cnt : 1u;
}

__device__ __forceinline__ void xcd_barrier(const XcdBarrier& b) {
    asm volatile("s_waitcnt vmcnt(0)" ::: "memory");
    __syncthreads();
    if (threadIdx.x == 0) {
        unsigned* bar = b.bar;
        __builtin_amdgcn_s_waitcnt(0);
        unsigned nloc = b.st[0], nx = b.st[1];
        if (nloc == 0u) { xcd_barrier_complete(bar, b.x, nloc, nx); b.st[0] = nloc; b.st[1] = nx; }
        const unsigned old = xb_add(&bar[XB_XSUB(b.x)], 1u);
        const unsigned gen = old / nloc;
        if (old + 1u == (gen + 1u) * nloc) {
            __builtin_amdgcn_fence(__ATOMIC_RELEASE, "agent");
            asm volatile("s_waitcnt vmcnt(0)" ::: "memory");
            const unsigned og = xb_add(&bar[XB_TOP], 1u);
            const unsigned tg = og / nx;
            if (og + 1u == (tg + 1u) * nx) xb_add(&bar[XB_TOPGEN], 1u);
            else XB_SPIN(xb_ld(&bar[XB_TOPGEN]) == tg, bar);
            __builtin_amdgcn_fence(__ATOMIC_ACQUIRE, "agent");
            xb_add(&bar[XB_XGEN(b.x)], 1u);
            asm volatile("s_waitcnt vmcnt(0)" ::: "memory");
        } else {
            XB_SPIN(xb_ld(&bar[XB_XGEN(b.x)]) == gen, bar);
            __builtin_amdgcn_fence(__ATOMIC_ACQUIRE, "agent");
            asm volatile("s_waitcnt vmcnt(0)" ::: "memory");
        }
    }
    __syncthreads();
}

}

namespace mk {
constexpr int NWAVES = 8, NTHREADS = 512;
constexpr size_t MiB = 1u << 20;
constexpr size_t WS_QIB = 325 * MiB, WS_KB = 342 * MiB, WS_VB = 351 * MiB, WS_KIB = 360 * MiB, WS_WIF = 363 * MiB;
constexpr size_t WS_OB = 390 * MiB, WS_GD = 423 * MiB;
constexpr size_t WS_IDX = 525 * MiB, WS_CNT = 542 * MiB, WS_SCS = 543 * MiB;
constexpr size_t WS_S = 548 * MiB;
constexpr size_t WS_SC = WS_S;
constexpr size_t WS_Z = WS_S, WS_H1F = WS_S + 65 * MiB, WS_H1B = WS_S + 130 * MiB, WS_PQB = WS_S + 163 * MiB, WS_H2F = WS_S + 228 * MiB, WS_H2B = WS_S + 293 * MiB;
constexpr size_t WS_GQ = WS_S + 326 * MiB, WS_GK = WS_S + 343 * MiB, WS_GV = WS_S + 360 * MiB, WS_GR = WS_S + 393 * MiB, WS_QT = WS_S + 426 * MiB, WS_DEC = WS_S + 442 * MiB,
                 WS_OGB = WS_S + 443 * MiB, WS_KT = WS_S + 476 * MiB;
constexpr size_t WS_DS = WS_S, WS_SPREV = WS_S + 128 * MiB;
constexpr size_t WS_CTL = 1060 * MiB, WS_WA = 1061 * MiB, WS_WO = 1066 * MiB, WS_WG = 1068 * MiB, WS_WGO = 1075 * MiB, WS_WPQ = 1077 * MiB, WS_PK = 1085 * MiB,
                 WS_UB = 1086 * MiB, WS_VBX = 1150 * MiB, WS_USC = 1118 * MiB, WS_TEID = 1120 * MiB, WS_TGATE = 1125 * MiB, WS_HD = 1134 * MiB, WS_KV8 = 1134 * MiB, WS_XB = 1214 * MiB, WS_QB = 1247 * MiB, WS_END = 1280 * MiB;
constexpr size_t CTL_ZERO_BYTES = 1 * MiB;
constexpr int CW_TMO = 0, CW_AMAXK = 256, CW_AMAXV = 320, CW_Q1 = 512, CW_XC = 1024, CW_BAR = 4096;
constexpr int WA_ROWS = 2176, WG_ROWS = 3104;
constexpr int GN_Q = 0, GN_K = 512, GN_V = 1024, GN_R = 2048, GN_GD = 3072;

constexpr int RING_BYTES = 131072, LDSCTL_OFF = RING_BYTES, MISC_OFF = LDSCTL_OFF + 320, INPTAB_OFF = LDSCTL_OFF + 512, LDS_BYTES = 147456;

typedef unsigned u32x4 __attribute__((ext_vector_type(4)));
typedef unsigned u32x2 __attribute__((ext_vector_type(2)));
#define MK_LAS __attribute__((address_space(3)))
__device__ __forceinline__ float bflo(unsigned w) { return __builtin_bit_cast(float, w << 16); }
__device__ __forceinline__ float bfhi(unsigned w) { return __builtin_bit_cast(float, w & 0xffff0000u); }
__device__ __forceinline__ float bf2f(unsigned short b) { return __builtin_bit_cast(float, (unsigned)b << 16); }
__device__ __forceinline__ u32x4 pack8(f32x4 a, f32x4 b) { u32x4 w; w.x = pk2(a[0], a[1]); w.y = pk2(a[2], a[3]); w.z = pk2(b[0], b[1]); w.w = pk2(b[2], b[3]); return w; }

#define TPB(k)
#define TPE(k)
template <int NCT> __device__ __forceinline__ void skinny_tile(const bf16* __restrict__ A, int lda, const bf16* __restrict__ Bt, int K, int row0, int col0, f32x4 (&acc)[NCT], int lane) {
    const int fr = lane & 15, fq = lane >> 4;
    const bf16* ap = A + (size_t)(row0 + fr) * lda + fq * 8;
    const bf16* bp = Bt + (size_t)(col0 + fr) * K + fq * 8;
#pragma unroll
    for (int ct = 0; ct < NCT; ++ct) acc[ct] = (f32x4){0.f, 0.f, 0.f, 0.f};
#pragma unroll 1
    for (int k0 = 0; k0 < K; k0 += 128) {
        bf16x8 a[4], b[NCT][4];
#pragma unroll
        for (int j = 0; j < 4; ++j) a[j] = *(const bf16x8*)(ap + k0 + j * 32);
#pragma unroll
        for (int ct = 0; ct < NCT; ++ct)
#pragma unroll
            for (int j = 0; j < 4; ++j) b[ct][j] = *(const bf16x8*)(bp + (size_t)ct * 16 * K + k0 + j * 32);
        asm volatile("" ::: "memory");
#pragma unroll
        for (int ct = 0; ct < NCT; ++ct)
#pragma unroll
            for (int j = 0; j < 4; ++j) acc[ct] = __builtin_amdgcn_mfma_f32_16x16x32_bf16(b[ct][j], a[j], acc[ct], 0, 0, 0);
    }
}

__device__ __forceinline__ void p0_transpose_item(const float* __restrict__ W, int ldw, int K, bf16* __restrict__ WT, int dst_row0, int src_col0, int nvalid, int k0, MK_LAS float* scr, int lane) {
#pragma unroll 8
    for (int i = 0; i < 32; ++i) { const int kk = 2 * i + (lane >> 5), j = lane & 31; scr[kk * 33 + j] = j < nvalid ? W[(size_t)(k0 + kk) * ldw + src_col0 + j] : 0.f; }
    asm volatile("s_waitcnt lgkmcnt(0)" ::: "memory");
    const int c = lane & 7;
#pragma unroll
    for (int j = 0; j < 4; ++j) { const int n = (lane >> 3) + 8 * j; const MK_LAS float* s = scr + (8 * c) * 33 + n;
        u32x4 o; o.x = pk2(s[0 * 33], s[1 * 33]); o.y = pk2(s[2 * 33], s[3 * 33]); o.z = pk2(s[4 * 33], s[5 * 33]); o.w = pk2(s[6 * 33], s[7 * 33]);
        *(u32x4*)(WT + (size_t)(dst_row0 + n) * K + k0 + 8 * c) = o; }
    asm volatile("s_waitcnt lgkmcnt(0)" ::: "memory");
}
__device__ __forceinline__ void p0_convert(const float* __restrict__ src, bf16* __restrict__ dst, size_t n8, int gw, int ngw, int lane) {
    for (size_t i = (size_t)gw * 64 + lane; i < n8; i += (size_t)ngw * 64) {
        const f32x4 a = *(const f32x4*)(src + i * 8), b = *(const f32x4*)(src + i * 8 + 4);
        *(u32x4*)(dst + i * 8) = pack8(a, b);
    }
}

__device__ __forceinline__ void p0_quant_row(const float* __restrict__ src, unsigned char* __restrict__ dst, float* __restrict__ scale, int lane) {
    f32x4 v[4]; float am = 0.f;
#pragma unroll
    for (int q = 0; q < 4; ++q) { v[q] = *(const f32x4*)(src + lane * 16 + q * 4); am = fmaxf(am, fmaxf(fmaxf(fabsf(v[q][0]), fabsf(v[q][1])), fmaxf(fabsf(v[q][2]), fabsf(v[q][3])))); }
#pragma unroll
    for (int o = 1; o < 64; o <<= 1) am = fmaxf(am, __shfl_xor(am, o));
    const float inv = am > 0.f ? 448.f / am : 0.f;
    u32x4 w;
#pragma unroll
    for (int q = 0; q < 4; ++q) { int x = __builtin_amdgcn_cvt_pk_fp8_f32(v[q][0] * inv, v[q][1] * inv, 0, false); x = __builtin_amdgcn_cvt_pk_fp8_f32(v[q][2] * inv, v[q][3] * inv, x, true); w[q] = (unsigned)x; }
    *(u32x4*)(dst + lane * 16) = w;
    if (lane == 0) *scale = am * (1.f / 448.f);
}

__device__ __forceinline__ void p0_quant_rows4(const float* __restrict__ src, unsigned char* __restrict__ dst, float* __restrict__ scale, int lane) {
    f32x4 v[4][4]; float am[4];
#pragma unroll
    for (int r = 0; r < 4; ++r)
#pragma unroll
        for (int q = 0; q < 4; ++q) v[r][q] = *(const f32x4*)(src + (size_t)r * D + lane * 16 + q * 4);
#pragma unroll
    for (int r = 0; r < 4; ++r) { float a = 0.f;
#pragma unroll
        for (int q = 0; q < 4; ++q) a = fmaxf(a, fmaxf(fmaxf(fabsf(v[r][q][0]), fabsf(v[r][q][1])), fmaxf(fabsf(v[r][q][2]), fabsf(v[r][q][3]))));
        am[r] = a; }
#pragma unroll
    for (int o = 1; o < 64; o <<= 1) {
#pragma unroll
        for (int r = 0; r < 4; ++r) am[r] = fmaxf(am[r], __shfl_xor(am[r], o)); }
#pragma unroll
    for (int r = 0; r < 4; ++r) {
        const float inv = am[r] > 0.f ? 448.f / am[r] : 0.f;
        u32x4 w;
#pragma unroll
        for (int q = 0; q < 4; ++q) { int x = __builtin_amdgcn_cvt_pk_fp8_f32(v[r][q][0] * inv, v[r][q][1] * inv, 0, false); x = __builtin_amdgcn_cvt_pk_fp8_f32(v[r][q][2] * inv, v[r][q][3] * inv, x, true); w[q] = (unsigned)x; }
        *(u32x4*)(dst + (size_t)r * D + lane * 16) = w;
        if (lane == 0) scale[r] = am[r] * (1.f / 448.f);
    }
}

struct FAttnIn {
    bf16 *Qb, *Kb, *Vb, *QIb, *KIb; float* WIf; float* out;
    mutable float kmax = 0.f, vmax = 0.f;
    __device__ __forceinline__ static float amax8(f32x4 a, f32x4 b) { return fmaxf(fmaxf(fmaxf(fabsf(a[0]), fabsf(a[1])), fmaxf(fabsf(a[2]), fabsf(a[3]))), fmaxf(fmaxf(fabsf(b[0]), fabsf(b[1])), fmaxf(fabsf(b[2]), fabsf(b[3])))); }
    __device__ __forceinline__ float* okp(int row, size_t offp, size_t offs, int ld) const { return row < TP ? out + offp + (size_t)row * ld : out + offs + (size_t)(row - TP) * ld; }
    __device__ __forceinline__ void put8(int row, int col, f32x4 v0, f32x4 v1) const {
        const u32x4 w = pack8(v0, v1);
        if (col < AK) *(u32x4*)(Qb + (size_t)row * 1024 + col) = w;
        else if (col < AV) { *(u32x4*)(Kb + (size_t)row * 256 + (col - AK)) = w; float* o = okp(row, OUT_KP, OUT_KS, 256) + (col - AK); *(f32x4*)o = v0; *(f32x4*)(o + 4) = v1; kmax = fmaxf(kmax, amax8(v0, v1)); }
        else if (col < AQI) { *(u32x4*)(Vb + (size_t)row * 256 + (col - AV)) = w; float* o = okp(row, OUT_VP, OUT_VS, 256) + (col - AV); *(f32x4*)o = v0; *(f32x4*)(o + 4) = v1; vmax = fmaxf(vmax, amax8(v0, v1)); }
        else *(u32x4*)(QIb + (size_t)row * 512 + (col - AQI)) = w;
    }
    __device__ __forceinline__ void put4(int row, int col, f32x4 v) const {
        u32x2 w; w.x = pk2(v[0], v[1]); w.y = pk2(v[2], v[3]);
        if (col < AK) *(u32x2*)(Qb + (size_t)row * 1024 + col) = w;
        else if (col < AV) { *(u32x2*)(Kb + (size_t)row * 256 + (col - AK)) = w; *(f32x4*)(okp(row, OUT_KP, OUT_KS, 256) + (col - AK)) = v; }
        else if (col < AQI) { *(u32x2*)(Vb + (size_t)row * 256 + (col - AV)) = w; *(f32x4*)(okp(row, OUT_VP, OUT_VS, 256) + (col - AV)) = v; }
        else if (col < AKI) *(u32x2*)(QIb + (size_t)row * 512 + (col - AQI)) = w;
        else if (col < AWI) { *(u32x2*)(KIb + (size_t)row * 64 + (col - AKI)) = w; *(f32x4*)(okp(row, OUT_KIP, OUT_KIS, 64) + (col - AKI)) = v; }
        else if (col < ATT_N) *(f32x4*)(WIf + (size_t)row * 8 + (col - AWI)) = v * 0.04419417382415922f;
    }
};
}

namespace mk {
typedef float f32x2v __attribute__((ext_vector_type(2)));
typedef float f32x16 __attribute__((ext_vector_type(16)));
typedef short s16x4 __attribute__((ext_vector_type(4)));
typedef short v4i16_t __attribute__((ext_vector_type(4)));

__device__ __forceinline__ void score_load_q(const bf16* __restrict__ QIb, const float* __restrict__ WIf, size_t tok0, int lane, bf16x8 (&afr)[4], f32x4 (&w4)[4]) {
    const int r = lane & 31, kq = lane >> 5;
    const bf16* ap = QIb + (tok0 + (r >> 3)) * 512 + (r & 7) * 64 + kq * 8;
#pragma unroll
    for (int ks = 0; ks < 4; ++ks) afr[ks] = *(const bf16x8*)(ap + ks * 16);
#pragma unroll
    for (int ql = 0; ql < 4; ++ql) w4[ql] = *(const f32x4*)(WIf + (tok0 + ql) * 8 + 4 * kq);
}
__device__ __forceinline__ void score_tile(const bf16x8 (&afr)[4], const bf16x8 (&bfr)[4], const f32x4 (&w4)[4], float (&s)[4]) {
    f32x16 acc;
#pragma unroll
    for (int j = 0; j < 16; ++j) acc[j] = 0.f;
#pragma unroll
    for (int ks = 0; ks < 4; ++ks) acc = __builtin_amdgcn_mfma_f32_32x32x16_bf16(afr[ks], bfr[ks], acc, 0, 0, 0);
#pragma unroll
    for (int ql = 0; ql < 4; ++ql) {
        float p = 0.f;
#pragma unroll
        for (int jj = 0; jj < 4; ++jj) p = fmaf(fmaxf(acc[ql * 4 + jj], 0.f), w4[ql][jj], p);
        s[ql] = p + __shfl_xor(p, 32);
    }
}

__device__ __forceinline__ void quant_issue(const float* __restrict__ src, f32x4 (&v)[4], int lane) {
#pragma unroll
    for (int q = 0; q < 4; ++q) v[q] = *(const f32x4*)(src + lane * 16 + q * 4);
}
__device__ __forceinline__ void quant_finish(const f32x4 (&v)[4], unsigned char* __restrict__ dst, float* __restrict__ scale, int lane) {
    float am = 0.f;
#pragma unroll
    for (int q = 0; q < 4; ++q) am = fmaxf(am, fmaxf(fmaxf(fabsf(v[q][0]), fabsf(v[q][1])), fmaxf(fabsf(v[q][2]), fabsf(v[q][3]))));
#pragma unroll
    for (int o = 1; o < 64; o <<= 1) am = fmaxf(am, __shfl_xor(am, o));
    const float inv = am > 0.f ? 448.f / am : 0.f;
    u32x4 w;
#pragma unroll
    for (int q = 0; q < 4; ++q) { int x = __builtin_amdgcn_cvt_pk_fp8_f32(v[q][0] * inv, v[q][1] * inv, 0, false); x = __builtin_amdgcn_cvt_pk_fp8_f32(v[q][2] * inv, v[q][3] * inv, x, true); w[q] = (unsigned)x; }
    *(u32x4*)(dst + lane * 16) = w;
    if (lane == 0) *scale = am * (1.f / 448.f);
}
struct QuantTabs { const float* pu; const float* pv; unsigned char* uq; unsigned char* vq; float* us; float* vs;
    __device__ __forceinline__ const float* src(int r) const { return r < 2 * 16384 ? pu + (size_t)r * D : pv + (size_t)(r - 2 * 16384) * D; }
    __device__ __forceinline__ unsigned char* dst(int r) const { return r < 2 * 16384 ? uq + (size_t)r * D : vq + (size_t)(r - 2 * 16384) * D; }
    __device__ __forceinline__ float* sc(int r) const { return r < 2 * 16384 ? us + r : vs + (r - 2 * 16384); } };

__device__ __forceinline__ void phase_score(const bf16* __restrict__ QIb, const bf16* __restrict__ KIb, const float* __restrict__ WIf, const float* __restrict__ cache_ki, const int* __restrict__ page_table,
                                            float* __restrict__ SC, float* __restrict__ SCS, const QuantTabs QT_, LAS unsigned char* lds, int vcu, int G, int wave, int lane, int gw, int NGW) {
    const int c = lane & 31, kq = lane >> 5;
    int qrow = gw;
    constexpr int KST = 144, KBUF = 256 * KST;
    const int tid = wave * 64 + lane;
    for (int it = vcu; it < 512; it += G) {
        const int b = it >> 8, qt = b == 0 ? (it & 255) : 255 - (it & 255);
        const size_t tok0 = (size_t)b * SEQ + qt * 32 + wave * 4;
        bf16x8 afr[4]; f32x4 w4[4];
        score_load_q(QIb, WIf, tok0, lane, afr, w4);
        const int nc = (qt >> 3) + 1;
        const bf16* kbase = KIb + (size_t)b * SEQ * 64;
        u32x4 st[4];
#pragma unroll
        for (int i = 0; i < 4; ++i) { const int p = tid + i * 512; st[i] = *(const u32x4*)(kbase + (size_t)(p >> 3) * 64 + (p & 7) * 8); }
#pragma unroll
        for (int i = 0; i < 4; ++i) { const int p = tid + i * 512; *(LAS u32x4*)(lds + (p >> 3) * KST + (p & 7) * 16) = st[i]; }
        __syncthreads();
        for (int ch = 0; ch < nc; ++ch) {
            const bool more = ch + 1 < nc;
            f32x4 qv[4]; const bool qdo = qrow < 4 * 16384;
            if (qdo) quant_issue(QT_.src(qrow), qv, lane);
            if (more) {
#pragma unroll
                for (int i = 0; i < 4; ++i) { const int p = tid + i * 512; st[i] = *(const u32x4*)(kbase + ((size_t)(ch + 1) * 256 + (p >> 3)) * 64 + (p & 7) * 8); }
            }
            LAS unsigned char* kb = lds + (ch & 1) * KBUF;
            const int ntile = more ? 8 : (qt & 7) + 1;
            for (int kt8 = 0; kt8 < ntile; ++kt8) {
                bf16x8 bfr[4];
#pragma unroll
                for (int ks = 0; ks < 4; ++ks) bfr[ks] = *(LAS bf16x8*)(kb + (kt8 * 32 + c) * KST + ks * 32 + kq * 16);
                float sv[4]; score_tile(afr, bfr, w4, sv);
                float* o = SC + (tok0 + 2 * kq) * SEQ + (ch * 8 + kt8) * 32 + c;
                o[0] = kq ? sv[2] : sv[0]; o[SEQ] = kq ? sv[3] : sv[1];
            }
            if (qdo) { quant_finish(qv, QT_.dst(qrow), QT_.sc(qrow), lane); qrow += NGW; }
            if (more) {
                LAS unsigned char* nb = lds + ((ch + 1) & 1) * KBUF;
#pragma unroll
                for (int i = 0; i < 4; ++i) { const int p = tid + i * 512; *(LAS u32x4*)(nb + (p >> 3) * KST + (p & 7) * 16) = st[i]; }
            }
            __syncthreads();
        }
    }
    for (; qrow < 4 * 16384; qrow += NGW) { f32x4 qv[4]; quant_issue(QT_.src(qrow), qv, lane); quant_finish(qv, QT_.dst(qrow), QT_.sc(qrow), lane); }
    for (int it = gw; it < DB * NPAGES + DB; it += NGW) {
        const bool isnew = it >= DB * NPAGES;
        const int b = isnew ? it - DB * NPAGES : it / NPAGES, pg = isnew ? 0 : it % NPAGES;
        const size_t tok0 = (size_t)TP + b * DS;
        bf16x8 afr[4]; f32x4 w4[4];
        score_load_q(QIb, WIf, tok0, lane, afr, w4);
        if (!isnew) {
            const int phys = page_table[b * NPAGES + pg];
            for (int j = 0; j < 4; ++j) {
                const float* kp = cache_ki + ((size_t)phys * PAGE + j * 32 + c) * 64 + kq * 8;
                bf16x8 bfr[4];
#pragma unroll
                for (int ks = 0; ks < 4; ++ks) { const f32x4 x0 = *(const f32x4*)(kp + ks * 16), x1 = *(const f32x4*)(kp + ks * 16 + 4); const u32x4 w = pack8(x0, x1); bfr[ks] = __builtin_bit_cast(bf16x8, w); }
                float s[4]; score_tile(afr, bfr, w4, s);
                float* o = SCS + (size_t)(b * DS + 2 * kq) * SCS_LD + pg * PAGE + j * 32 + c;
                o[0] = kq ? s[2] : s[0]; o[SCS_LD] = kq ? s[3] : s[1];
            }
        } else {
            const bf16* kp = KIb + (tok0 + (c & 3)) * 64 + kq * 8;
            bf16x8 bfr[4];
#pragma unroll
            for (int ks = 0; ks < 4; ++ks) bfr[ks] = *(const bf16x8*)(kp + ks * 16);
            float s[4]; score_tile(afr, bfr, w4, s);
            if (c < 4) { float* o = SCS + (size_t)(b * DS + 2 * kq) * SCS_LD + PAST + c; o[0] = kq ? s[2] : s[0]; o[SCS_LD] = kq ? s[3] : s[1]; }
        }
    }
}

constexpr int VST = 144;
__device__ __forceinline__ bf16x8 ld_frag8(const bf16* p) { return *(const bf16x8*)p; }
__device__ __forceinline__ bf16x8 ld_frag8(const float* p) { const f32x4 a = *(const f32x4*)p, b = *(const f32x4*)(p + 4); const u32x4 w = pack8(a, b); return __builtin_bit_cast(bf16x8, w); }
__device__ __forceinline__ s16x4 lds_tr(LAS unsigned char* p) { return __builtin_bit_cast(s16x4, __builtin_amdgcn_ds_read_tr16_b64_v4i16((LAS v4i16_t*)p)); }

template <bool SAMPLE>
__device__ __forceinline__ void attn_row(int row, int n0, int n1, const bf16* __restrict__ Qb, const int* __restrict__ IDX, const int* __restrict__ CNT,
                                         const bf16* __restrict__ Kb, const bf16* __restrict__ Vb, const float* __restrict__ cache_k, const float* __restrict__ cache_v,
                                         const float* __restrict__ newk, const float* __restrict__ newv, const int* __restrict__ page_table,
                                         bf16* __restrict__ Ob, LAS unsigned char* wl, int lane) {
    const int fr = lane & 15, fq = lane >> 4;
    LAS int* rid = (LAS int*)wl;
    LAS unsigned char* vt = wl + 1024;
    const int cnt = CNT[row];
    const int b = SAMPLE ? (row - TP) / DS : row / SEQ;
#pragma unroll
    for (int i = 0; i < 4; ++i) { const int slot = i * 64 + lane; int key = slot < cnt ? IDX[(size_t)row * TOPK + slot] : 0; int id;
        if (!SAMPLE) id = b * SEQ + key;
        else if (key < PAST) id = page_table[b * NPAGES + key / PAGE] * PAGE + (key % PAGE);
        else id = (int)0x80000000 | (b * DS + (key - PAST));
        rid[slot] = id; }
    asm volatile("s_waitcnt lgkmcnt(0)" ::: "memory");
    for (int n = n0; n < n1; ++n) {
        bf16x8 qf[2];
#pragma unroll
        for (int ks = 0; ks < 2; ++ks) qf[ks] = *(const bf16x8*)(Qb + (size_t)row * 1024 + (n * 4 + (fr & 3)) * 64 + ks * 32 + fq * 8);
        f32x4 st[16];
        constexpr int TBN = SAMPLE ? 4 : 8;
#pragma unroll
        for (int tb = 0; tb < 16 / TBN; ++tb) {
            bf16x8 kf[TBN][2];
#pragma unroll
            for (int t = 0; t < TBN; ++t) {
                const int id = rid[(tb * TBN + t) * 16 + fr];
                if (!SAMPLE) { const bf16* kp = Kb + (size_t)id * 256 + n * 64 + fq * 8; kf[t][0] = ld_frag8(kp); kf[t][1] = ld_frag8(kp + 32); }
                else { const float* kp = (id < 0 ? newk + (size_t)(id & 0x7fffffff) * 256 : cache_k + (size_t)id * 256) + n * 64 + fq * 8; kf[t][0] = ld_frag8(kp); kf[t][1] = ld_frag8(kp + 32); }
            }
#pragma unroll
            for (int t = 0; t < TBN; ++t) {
                f32x4 a = (f32x4){0.f, 0.f, 0.f, 0.f};
                a = __builtin_amdgcn_mfma_f32_16x16x32_bf16(kf[t][0], qf[0], a, 0, 0, 0);
                a = __builtin_amdgcn_mfma_f32_16x16x32_bf16(kf[t][1], qf[1], a, 0, 0, 0);
                st[tb * TBN + t] = a;
            }
            asm volatile("" ::: "memory");
        }
        bf16x8 vreg[8];
#define ATT_VLOAD(ch_) do { _Pragma("unroll") for (int i = 0; i < 8; ++i) { const int sl = i * 8 + (lane >> 3), chunk = lane & 7; const int id = rid[(ch_) * 64 + sl]; \
            if (!SAMPLE) vreg[i] = ld_frag8(Vb + (size_t)id * 256 + n * 64 + chunk * 8); \
            else vreg[i] = ld_frag8((id < 0 ? newv + (size_t)(id & 0x7fffffff) * 256 : cache_v + (size_t)id * 256) + n * 64 + chunk * 8); } } while (0)
        ATT_VLOAD(0);
        float mx = -INFINITY;
#pragma unroll
        for (int t = 0; t < 16; ++t)
#pragma unroll
            for (int j = 0; j < 4; ++j) { const int slot = t * 16 + fq * 4 + j; const float v = slot < cnt ? st[t][j] * 0.125f : -INFINITY; st[t][j] = v; mx = fmaxf(mx, v); }
        mx = fmaxf(mx, __shfl_xor(mx, 16)); mx = fmaxf(mx, __shfl_xor(mx, 32));
        float sum = 0.f;
#pragma unroll
        for (int t = 0; t < 16; ++t)
#pragma unroll
            for (int j = 0; j < 4; ++j) { const float e = __expf(st[t][j] - mx); st[t][j] = e; sum += e; }
        sum += __shfl_xor(sum, 16); sum += __shfl_xor(sum, 32);
        f32x4 oacc[4];
#pragma unroll
        for (int dt = 0; dt < 4; ++dt) oacc[dt] = (f32x4){0.f, 0.f, 0.f, 0.f};
#pragma unroll
        for (int ch = 0; ch < 4; ++ch) {
#pragma unroll
            for (int i = 0; i < 8; ++i) { const int sl = i * 8 + (lane >> 3), chunk = lane & 7; *(LAS bf16x8*)(vt + sl * VST + chunk * 16) = vreg[i]; }
            asm volatile("s_waitcnt lgkmcnt(0)" ::: "memory");
            if (ch < 3) ATT_VLOAD(ch + 1);
#pragma unroll
            for (int s2 = 0; s2 < 2; ++s2) {
                const int t0 = ch * 4 + s2 * 2;
                const u32x4 pw = pack8(st[t0], st[t0 + 1]);
                const bf16x8 pf = __builtin_bit_cast(bf16x8, pw);
#pragma unroll
                for (int dt = 0; dt < 4; ++dt) {
                    LAS unsigned char* a0 = vt + (s2 * 32 + fq * 4 + (fr >> 2)) * VST + (dt * 16 + 4 * (fr & 3)) * 2;
                    const s16x4 v0 = lds_tr(a0), v1 = lds_tr(a0 + 16 * VST);
                    bf16x8 vf; vf[0] = v0[0]; vf[1] = v0[1]; vf[2] = v0[2]; vf[3] = v0[3]; vf[4] = v1[0]; vf[5] = v1[1]; vf[6] = v1[2]; vf[7] = v1[3];
                    oacc[dt] = __builtin_amdgcn_mfma_f32_16x16x32_bf16(pf, vf, oacc[dt], 0, 0, 0);
                }
            }
            asm volatile("s_waitcnt lgkmcnt(0)" ::: "memory");
        }
#undef ATT_VLOAD
        const float i0 = 1.f / __shfl(sum, 0), i1 = 1.f / __shfl(sum, 1), i2 = 1.f / __shfl(sum, 2), i3 = 1.f / __shfl(sum, 3);
        if (fq == 0) {
#pragma unroll
            for (int dt = 0; dt < 4; ++dt) {
                bf16* o = Ob + (size_t)row * 1024 + (n * 4) * 64 + dt * 16 + fr;
                o[0] = (bf16)f2bf(oacc[dt][0] * i0); o[64] = (bf16)f2bf(oacc[dt][1] * i1); o[128] = (bf16)f2bf(oacc[dt][2] * i2); o[192] = (bf16)f2bf(oacc[dt][3] * i3);
            }
        }
    }
    asm volatile("s_waitcnt lgkmcnt(0)" ::: "memory");
}

__device__ __forceinline__ void kv8_convert(const bf16* __restrict__ Kb, const bf16* __restrict__ Vb, unsigned char* __restrict__ KV8_, const unsigned* __restrict__ amaxk, const unsigned* __restrict__ amaxv, int gw, int NGW, int lane) {
    const float ak = __builtin_bit_cast(float, __hip_atomic_load(amaxk, __ATOMIC_RELAXED, __HIP_MEMORY_SCOPE_AGENT)), av = __builtin_bit_cast(float, __hip_atomic_load(amaxv, __ATOMIC_RELAXED, __HIP_MEMORY_SCOPE_AGENT));
    const bool isv = lane >= 32; const int l = lane & 31;
    const float sc = isv ? (av > 0.f ? 448.f / av : 0.f) : (ak > 0.f ? 448.f / ak : 0.f);
    for (int t = gw; t < TP; t += NGW) {
        const u32x4 w = *(const u32x4*)((isv ? Vb : Kb) + (size_t)t * 256 + l * 8);
        const float x0 = bflo(w.x) * sc, x1 = bfhi(w.x) * sc, x2 = bflo(w.y) * sc, x3 = bfhi(w.y) * sc, x4 = bflo(w.z) * sc, x5 = bfhi(w.z) * sc, x6 = bflo(w.w) * sc, x7 = bfhi(w.w) * sc;
        int p0 = __builtin_amdgcn_cvt_pk_fp8_f32(x0, x1, 0, false); p0 = __builtin_amdgcn_cvt_pk_fp8_f32(x2, x3, p0, true);
        int p1 = __builtin_amdgcn_cvt_pk_fp8_f32(x4, x5, 0, false); p1 = __builtin_amdgcn_cvt_pk_fp8_f32(x6, x7, p1, true);
        const int n = l >> 3, d0 = (l & 7) * 8;
        const int pos = isv ? 64 + d0 : ((d0 & 31) >> 3) * 16 + (d0 >> 5) * 8;
        u32x2 o; o.x = (unsigned)p0; o.y = (unsigned)p1;
        *(u32x2*)(KV8_ + (size_t)t * 512 + n * 128 + pos) = o;
    }
}
__device__ __forceinline__ void fp8x16_to_bf16(const u32x4 q, bf16x8& lo, bf16x8& hi) {
    u32x4 a, b;
#pragma unroll
    for (int w = 0; w < 4; ++w) { const f32x2v f0 = __builtin_amdgcn_cvt_pk_f32_fp8((int)q[w], false), f1 = __builtin_amdgcn_cvt_pk_f32_fp8((int)q[w], true);
        const unsigned u0 = pk2(f0[0], f0[1]), u1 = pk2(f1[0], f1[1]);
        if (w < 2) { a[2 * w] = u0; a[2 * w + 1] = u1; } else { b[2 * w - 4] = u0; b[2 * w - 3] = u1; } }
    lo = __builtin_bit_cast(bf16x8, a); hi = __builtin_bit_cast(bf16x8, b);
}
#ifndef KF1
#define KF1 10
#endif
__device__ __forceinline__ void attn_prompt_stream(int b, int n, int q0, int qstep, const bf16* __restrict__ Qb, const int* __restrict__ IDX, const unsigned char* __restrict__ KV8_, const unsigned* __restrict__ amaxk, const unsigned* __restrict__ amaxv,
                                                   bf16* __restrict__ Ob, LAS unsigned char* wl, int lane) {
    const float ak_ = __builtin_bit_cast(float, __hip_atomic_load(amaxk, __ATOMIC_RELAXED, __HIP_MEMORY_SCOPE_AGENT)), av_ = __builtin_bit_cast(float, __hip_atomic_load(amaxv, __ATOMIC_RELAXED, __HIP_MEMORY_SCOPE_AGENT));
    const float kinv = ak_ * (1.f / 448.f), vinv = av_ * (1.f / 448.f);
    const int fr = lane & 15, fq = lane >> 4;
    LAS int* ridb = (LAS int*)wl;
    LAS unsigned char* vt = wl + 2048;
    if (q0 >= SEQ) return;
    int vx[4];
    { const int row = b * SEQ + q0, cnt = q0 + 1 < TOPK ? q0 + 1 : TOPK;
#pragma unroll
      for (int i = 0; i < 4; ++i) { const int slot = i * 64 + lane; ridb[slot] = b * SEQ + (slot < cnt ? IDX[(size_t)row * TOPK + slot] : 0); } }
    int buf = 0;

    for (int q = q0; q < SEQ; q += qstep, buf ^= 1) {

        const int row = b * SEQ + q, cnt = q + 1 < TOPK ? q + 1 : TOPK;
        LAS int* rid = ridb + buf * 256;
        asm volatile("s_waitcnt lgkmcnt(0)" ::: "memory");
        int kx[16];
#pragma unroll
        for (int t = 0; t < 16; ++t) kx[t] = rid[t * 16 + fr];
        bf16x8 qf[2];
#pragma unroll
        for (int ks = 0; ks < 2; ++ks) qf[ks] = *(const bf16x8*)(Qb + (size_t)row * 1024 + (n * 4 + (fr & 3)) * 64 + ks * 32 + fq * 8);
        u32x4 kraw[16];
#pragma unroll
        for (int t = 0; t < 16; ++t) kraw[t] = *(const u32x4*)(KV8_ + (size_t)kx[t] * 512 + n * 128 + fq * 16);
        asm volatile("s_waitcnt lgkmcnt(0)" ::: "memory");
        u32x4 vraw[4];
#define ATT_VLOAD2(ch_) do { _Pragma("unroll") for (int i = 0; i < 4; ++i) { const int sl = i * 16 + (lane >> 2), piece = lane & 3; const int id = rid[(ch_) * 64 + sl]; \
            vraw[i] = *(const u32x4*)(KV8_ + (size_t)id * 512 + n * 128 + 64 + piece * 16); } } while (0)
        f32x4 st[16];
#pragma unroll
        for (int t = 0; t < 16; ++t) {
            asm volatile("" : "+v"(kraw[t][0]), "+v"(kraw[t][1]), "+v"(kraw[t][2]), "+v"(kraw[t][3]));
            bf16x8 k0, k1; fp8x16_to_bf16(kraw[t], k0, k1);
            f32x4 a = (f32x4){0.f, 0.f, 0.f, 0.f};
            a = __builtin_amdgcn_mfma_f32_16x16x32_bf16(k0, qf[0], a, 0, 0, 0);
            a = __builtin_amdgcn_mfma_f32_16x16x32_bf16(k1, qf[1], a, 0, 0, 0);
            st[t] = a;
            asm volatile("" : "+v"(st[t][0]), "+v"(st[t][1]), "+v"(st[t][2]), "+v"(st[t][3]));
        }

        const int qn = q + qstep;
        if (qn < SEQ) { const int rown = b * SEQ + qn, cntn = qn + 1 < TOPK ? qn + 1 : TOPK;
#pragma unroll
            for (int i = 0; i < 4; ++i) { const int slot = i * 64 + lane; vx[i] = slot < cntn ? IDX[(size_t)rown * TOPK + slot] : 0; } }
        ATT_VLOAD2(0);
        float mx = -INFINITY;
        if (cnt < TOPK) {
#pragma unroll
            for (int t = 0; t < 16; ++t)
#pragma unroll
                for (int j = 0; j < 4; ++j) { const int slot = t * 16 + fq * 4 + j; st[t][j] = slot < cnt ? st[t][j] : -INFINITY; }
        }
#pragma unroll
        for (int t = 0; t < 16; ++t) mx = fmaxf(mx, fmaxf(fmaxf(st[t][0], st[t][1]), fmaxf(st[t][2], st[t][3])));
        mx = fmaxf(mx, __shfl_xor(mx, 16)); mx = fmaxf(mx, __shfl_xor(mx, 32));
        const float cs = 0.18033688011112042f * kinv, mb = -mx * cs;
        float sum = 0.f;
#pragma unroll
        for (int t = 0; t < 16; ++t)
#pragma unroll
            for (int j = 0; j < 4; ++j) { const float e = __builtin_amdgcn_exp2f(fmaf(st[t][j], cs, mb)); st[t][j] = e; sum += e; }
        sum += __shfl_xor(sum, 16); sum += __shfl_xor(sum, 32);

        f32x4 oacc[4];
#pragma unroll
        for (int dt = 0; dt < 4; ++dt) oacc[dt] = (f32x4){0.f, 0.f, 0.f, 0.f};
#pragma unroll
        for (int ch = 0; ch < 4; ++ch) {
#pragma unroll
            for (int i = 0; i < 4; ++i) { const int sl = i * 16 + (lane >> 2), piece = lane & 3; bf16x8 v0, v1; fp8x16_to_bf16(vraw[i], v0, v1);
                *(LAS bf16x8*)(vt + sl * VST + piece * 32) = v0; *(LAS bf16x8*)(vt + sl * VST + piece * 32 + 16) = v1; }
            asm volatile("s_waitcnt lgkmcnt(0)" ::: "memory");
            if (ch < 3) ATT_VLOAD2(ch + 1);
#pragma unroll
            for (int s2 = 0; s2 < 2; ++s2) {
                const int t0 = ch * 4 + s2 * 2;
                const u32x4 pw = pack8(st[t0], st[t0 + 1]);
                const bf16x8 pf = __builtin_bit_cast(bf16x8, pw);
#pragma unroll
                for (int dt = 0; dt < 4; ++dt) {
                    LAS unsigned char* a0 = vt + (s2 * 32 + fq * 4 + (fr >> 2)) * VST + (dt * 16 + 4 * (fr & 3)) * 2;
                    const s16x4 v0 = lds_tr(a0), v1 = lds_tr(a0 + 16 * VST);
                    bf16x8 vf; vf[0] = v0[0]; vf[1] = v0[1]; vf[2] = v0[2]; vf[3] = v0[3]; vf[4] = v1[0]; vf[5] = v1[1]; vf[6] = v1[2]; vf[7] = v1[3];
                    oacc[dt] = __builtin_amdgcn_mfma_f32_16x16x32_bf16(pf, vf, oacc[dt], 0, 0, 0);
                }
            }
            asm volatile("s_waitcnt lgkmcnt(0)" ::: "memory");
        }
#undef ATT_VLOAD2

        const float i0 = vinv / __shfl(sum, 0), i1 = vinv / __shfl(sum, 1), i2 = vinv / __shfl(sum, 2), i3 = vinv / __shfl(sum, 3);
        if (fq == 0) {
#pragma unroll
            for (int dt = 0; dt < 4; ++dt) {
                bf16* o = Ob + (size_t)row * 1024 + (n * 4) * 64 + dt * 16 + fr;
                o[0] = (bf16)f2bf(oacc[dt][0] * i0); o[64] = (bf16)f2bf(oacc[dt][1] * i1); o[128] = (bf16)f2bf(oacc[dt][2] * i2); o[192] = (bf16)f2bf(oacc[dt][3] * i3);
            }
        }
        if (qn < SEQ) {
#pragma unroll
            for (int i = 0; i < 4; ++i) ridb[(buf ^ 1) * 256 + i * 64 + lane] = vx[i] + b * SEQ;
        }

    }

    asm volatile("s_waitcnt lgkmcnt(0)" ::: "memory");
}

__device__ __forceinline__ void ln_row_wave(const float* __restrict__ zrow, const float* __restrict__ g, const float* __restrict__ bt, float* __restrict__ of, bf16* __restrict__ ob, int lane) {
    f32x4 v[4]; float s = 0.f;
#pragma unroll
    for (int j = 0; j < 4; ++j) { v[j] = *(const f32x4*)(zrow + 256 * j + 4 * lane); s += (v[j][0] + v[j][1]) + (v[j][2] + v[j][3]); }
#pragma unroll
    for (int o = 1; o < 64; o <<= 1) s += __shfl_xor(s, o);
    const float mean = s * (1.f / D); float q = 0.f;
#pragma unroll
    for (int j = 0; j < 4; ++j) { v[j] = v[j] - mean; q += (v[j][0] * v[j][0] + v[j][1] * v[j][1]) + (v[j][2] * v[j][2] + v[j][3] * v[j][3]); }
#pragma unroll
    for (int o = 1; o < 64; o <<= 1) q += __shfl_xor(q, o);
    const float rstd = rsqrtf(q * (1.f / D) + LN_EPS);
#pragma unroll
    for (int j = 0; j < 4; ++j) { const f32x4 gg = *(const f32x4*)(g + 256 * j + 4 * lane), bb = *(const f32x4*)(bt + 256 * j + 4 * lane); const f32x4 o = v[j] * rstd * gg + bb;
        if (of) *(f32x4*)(of + 256 * j + 4 * lane) = o; u32x2 w; w.x = pk2(o[0], o[1]); w.y = pk2(o[2], o[3]); *(u32x2*)(ob + 256 * j + 4 * lane) = w; }
}

struct FResid {
    const float* rp; const float* rs; float* Z;
    __device__ __forceinline__ const float* rrow(int row) const { return row < TP ? rp + (size_t)row * D : rs + (size_t)(row - TP) * D; }
    __device__ __forceinline__ void put8(int row, int col, f32x4 v0, f32x4 v1) const { const float* r = rrow(row) + col; float* z = Z + (size_t)row * D + col;
        *(f32x4*)z = v0 + ALPHA * *(const f32x4*)r; *(f32x4*)(z + 4) = v1 + ALPHA * *(const f32x4*)(r + 4); }
    __device__ __forceinline__ void put4(int row, int col, f32x4 v) const { *(f32x4*)(Z + (size_t)row * D + col) = v + ALPHA * *(const f32x4*)(rrow(row) + col); }
};
}

namespace mk {
template <int CAP>
__device__ __forceinline__ void topk_wave_regs(const float* __restrict__ row, int n, int* __restrict__ out, LAS unsigned* hist, LAS float* cv, LAS int* ci, LAS unsigned char* lst, int lane) {
    if (n <= TOPK) { for (int i = lane; i < TOPK; i += 64) out[i] = i < n ? i : 0; return; }

    constexpr int NCH = 32;
    const int nch = n > 8192 ? 32 : (n + 255) >> 8;
    float vx = (lane < 4 && 8192 + lane < n) ? row[8192 + lane] : -INFINITY;
    f32x4 v[NCH];
#pragma unroll
    for (int j = 0; j < NCH; ++j) {
        if (j < nch) v[j] = *(const f32x4*)(row + j * 256 + lane * 4);
        else v[j] = (f32x4){-INFINITY, -INFINITY, -INFINITY, -INFINITY};
    }
    float mn = INFINITY, mx = -INFINITY;
#pragma unroll
    for (int j = 0; j < NCH; ++j) {
        if (j < nch) {
            const int base = j * 256 + lane * 4;
#pragma unroll
            for (int e = 0; e < 4; ++e) { const bool ok = base + e < n; const float x = v[j][e]; v[j][e] = ok ? x : -INFINITY; mx = fmaxf(mx, ok ? x : -INFINITY); mn = fminf(mn, ok ? x : INFINITY); }
        }
    }
    if (vx != -INFINITY) { mx = fmaxf(mx, vx); mn = fminf(mn, vx); }
#pragma unroll
    for (int o = 1; o < 64; o <<= 1) { mn = fminf(mn, __shfl_xor(mn, o)); mx = fmaxf(mx, __shfl_xor(mx, o)); }
    if (!(mx > mn)) { for (int i = lane; i < TOPK; i += 64) out[i] = i; return; }
    const float scale = 2048.0f / (mx - mn);

#pragma unroll
    for (int i = 0; i < 8; ++i) *(LAS u32x4*)(hist + i * 256 + lane * 4) = (u32x4){0u, 0u, 0u, 0u};
    asm volatile("s_waitcnt lgkmcnt(0)" ::: "memory");
#pragma unroll
    for (int j = 0; j < NCH; ++j) {
        if (j < nch) {
            asm volatile("" : "+v"(v[j][0]), "+v"(v[j][1]), "+v"(v[j][2]), "+v"(v[j][3]));
#pragma unroll
            for (int e = 0; e < 4; ++e) { const float x = v[j][e]; int bn = (int)((x - mn) * scale); bn = bn > 2047 ? 2047 : bn; bn = x != -INFINITY ? bn : 2048;
                __hip_atomic_fetch_add(hist + bn, 1u, __ATOMIC_RELAXED, __HIP_MEMORY_SCOPE_WAVEFRONT); }
        }
    }
    if (vx != -INFINITY) { int bn = (int)((vx - mn) * scale); bn = bn > 2047 ? 2047 : bn; __hip_atomic_fetch_add(hist + bn, 1u, __ATOMIC_RELAXED, __HIP_MEMORY_SCOPE_WAVEFRONT); }
    asm volatile("s_waitcnt lgkmcnt(0)" ::: "memory");

    unsigned mine = 0u;
#pragma unroll
    for (int i = 0; i < 8; ++i) { const u32x4 h4 = *(LAS u32x4*)(hist + lane * 32 + i * 4); mine += (h4.x + h4.y) + (h4.z + h4.w); }
    unsigned suf = mine;
#pragma unroll
    for (int o = 1; o < 64; o <<= 1) { const unsigned t = __shfl_down(suf, o); if (lane + o < 64) suf += t; }
    const unsigned long long bal = __ballot(suf >= (unsigned)TOPK);
    const int Lt = 63 - __builtin_clzll(bal);
    const unsigned above = __shfl(suf, Lt) - __shfl(mine, Lt);
    const unsigned hb = hist[Lt * 32 + (lane & 31)];
    unsigned sfx = hb;
#pragma unroll
    for (int o = 1; o < 32; o <<= 1) { const unsigned t = __shfl_down(sfx, o); if ((lane & 31) + o < 32) sfx += t; }
    const unsigned long long okm = __ballot(above + sfx >= (unsigned)TOPK) & 0xFFFFFFFFull;
    const int jb = 63 - __builtin_clzll(okm);
    const int B = Lt * 32 + jb;
    const unsigned running = above + __shfl(sfx, jb) - __shfl(hb, jb);
    const int cnt_gt = (int)running, r = TOPK - cnt_gt;

    int base_gt = 0, base_eq = 0;
    const unsigned long long below = (1ull << lane) - 1ull;
    int lane4 = lane * 4; asm volatile("" : "+v"(lane4));
#pragma unroll
    for (int j = 0; j < NCH; ++j) {
        if (j < nch) {
#pragma unroll
            for (int e = 0; e < 4; ++e) {
                const float x = v[j][e]; int bn = (int)((x - mn) * scale); bn = bn > 2047 ? 2047 : bn; bn = x != -INFINITY ? bn : -1;
                const bool gt = bn > B, eq = bn == B;
                const unsigned long long mg = __ballot(gt), me = __ballot(eq);
                if (mg | me) {
                    const int idx = lane4 + (j * 256 + e);
                    if (gt) out[base_gt + __builtin_popcountll(mg & below)] = idx;
                    if (eq) { const int p = base_eq + __builtin_popcountll(me & below); if (p < CAP) { cv[p] = x; ci[p] = idx; } }
                    base_gt += __builtin_popcountll(mg); base_eq += __builtin_popcountll(me);
                }
            }
        }
    }
    if (n > 8192) {
        const float x = vx; bool gt = false, eq = false;
        if (x != -INFINITY) { int bn = (int)((x - mn) * scale); bn = bn > 2047 ? 2047 : bn; gt = bn > B; eq = bn == B; }
        const unsigned long long mg = __ballot(gt), me = __ballot(eq);
        const int idx = 8192 + lane;
        if (gt) out[base_gt + __builtin_popcountll(mg & below)] = idx;
        if (eq) { const int p = base_eq + __builtin_popcountll(me & below); if (p < CAP) { cv[p] = x; ci[p] = idx; } }
        base_gt += __builtin_popcountll(mg); base_eq += __builtin_popcountll(me);
    }
    asm volatile("s_waitcnt vmcnt(0) lgkmcnt(0)" ::: "memory");

    const int m = base_eq < CAP ? base_eq : CAP;
    if (m <= 64) {
        const float x = lane < m ? cv[lane] : -INFINITY; const int id = lane < m ? ci[lane] : 0x7fffffff; int rank = 0;
        for (int c2 = 0; c2 < m; ++c2) { const float x2 = __builtin_bit_cast(float, __builtin_amdgcn_readlane(__builtin_bit_cast(int, x), c2)); const int id2 = __builtin_amdgcn_readlane(id, c2);
            rank += (x2 > x || (x2 == x && id2 < id)) ? 1 : 0; }
        if (lane < m && rank < r) out[cnt_gt + rank] = id;
    } else {
        for (int c = lane; c < m; c += 64) {
            const float x = cv[c]; const int id = ci[c]; int rank = 0;
            for (int c2 = 0; c2 < m; ++c2) { const float x2 = cv[c2]; const int id2 = ci[c2]; rank += (x2 > x || (x2 == x && id2 < id)) ? 1 : 0; }
            if (rank < r) out[cnt_gt + rank] = id;
        }
    }
    asm volatile("s_waitcnt lgkmcnt(0)" ::: "memory");

}

__device__ __forceinline__ void phase_topk2(const float* __restrict__ SC, const float* __restrict__ SCS, int* __restrict__ IDX, int* __restrict__ CNT,
                                            const float* __restrict__ peer_u_, const float* __restrict__ peer_v_, unsigned char* __restrict__ Uq_, unsigned char* __restrict__ Vq_, float* __restrict__ Usc_, float* __restrict__ Vsc_,
                                            LAS unsigned char* lds, unsigned* qhead, int wave, int lane, int gw, int NGW, int jlo = 0, int jhi = TA) {
    constexpr int CAP = 1020;
    LAS unsigned* hist = (LAS unsigned*)(lds + wave * 16384);
    LAS float* cv = (LAS float*)(lds + wave * 16384 + 8208);
    LAS int* ci = (LAS int*)(lds + wave * 16384 + 8208 + 4080);
    LAS unsigned char* lst = nullptr;

    for (int j = gw; j < TA; j += NGW) {
        if (j < jlo || j >= jhi) continue;
        int row, n; const float* rp;
        if (j < TP) { const int b = j >> 13, jj = j & 8191, blk = jj >> 11; const int q = blk < 2 ? jj : blk * 2048 + 2047 - (jj & 2047);
            row = b * SEQ + q; n = q + 1; rp = SC + (size_t)row * SEQ; }
        else { const int r = j - TP; row = j; n = PAST + (r % DS) + 1; rp = SCS + (size_t)r * SCS_LD; }

        topk_wave_regs<CAP>(rp, n, IDX + (size_t)row * TOPK, hist, cv, ci, lst, lane);

        if (lane == 0) CNT[row] = n < TOPK ? n : TOPK;
    }

}
}

namespace mk {
using bf16x2_t = __attribute__((ext_vector_type(2))) __bf16;
__device__ __forceinline__ float dot2bf(unsigned a, unsigned b, float acc) { return __builtin_amdgcn_fdot2_f32_bf16(__builtin_bit_cast(bf16x2_t, a), __builtin_bit_cast(bf16x2_t, b), acc, false); }

struct FStoreBf16 {
    bf16* O; int ld;
    __device__ __forceinline__ void put8(int row, int col, f32x4 v0, f32x4 v1) const { *(u32x4*)(O + (size_t)row * ld + col) = pack8(v0, v1); }
    __device__ __forceinline__ void put4(int row, int col, f32x4 v) const { u32x2 w; w.x = pk2(v[0], v[1]); w.y = pk2(v[2], v[3]); *(u32x2*)(O + (size_t)row * ld + col) = w; }
};

#ifndef PGS
#define PGS 8
#endif
constexpr int PEER_TAB_OFF = LDSCTL_OFF + 1024;

__device__ __forceinline__ void ce_desc(unsigned& a, unsigned& b) { const unsigned hi = a > b ? a : b, lo = a > b ? b : a; a = hi; b = lo; }
template <int N> __device__ __forceinline__ void bitonic_sort_desc(unsigned (&k)[N]) {
#pragma unroll
    for (int size = 2; size <= N; size <<= 1)
#pragma unroll
        for (int stride = size >> 1; stride > 0; stride >>= 1)
#pragma unroll
            for (int i = 0; i < N; ++i) { const int j = i ^ stride; if (j > i) { if ((i & size) == 0) ce_desc(k[i], k[j]); else ce_desc(k[j], k[i]); } }
}
template <int N> __device__ __forceinline__ void bitonic_merge_desc(unsigned (&k)[N]) {
#pragma unroll
    for (int stride = N >> 1; stride > 0; stride >>= 1)
#pragma unroll
        for (int i = 0; i < N; ++i) { const int j = i ^ stride; if (j > i) ce_desc(k[i], k[j]); }
}
__device__ __forceinline__ void top16_merge(unsigned (&a)[16], const unsigned (&b)[16]) {
#pragma unroll
    for (int i = 0; i < 16; ++i) a[i] = a[i] > b[15 - i] ? a[i] : b[15 - i];
    bitonic_merge_desc<16>(a);
}
__device__ __forceinline__ void top16_xlane(unsigned (&a)[16], int o) {
    unsigned b[16];
#pragma unroll
    for (int i = 0; i < 16; ++i) b[i] = (unsigned)__shfl_xor((int)a[i], o);
    top16_merge(a, b);
}
__device__ __forceinline__ unsigned f2ord(float f) { const unsigned u = __builtin_bit_cast(unsigned, f); return u ^ ((u >> 31) ? 0xFFFFFFFFu : 0x80000000u); }
__device__ __forceinline__ float ord2f(unsigned o) { const unsigned u = o ^ ((o >> 31) ? 0x80000000u : 0xFFFFFFFFu); return __builtin_bit_cast(float, u); }

__device__ __forceinline__ void phase_peer_select(const bf16* __restrict__ PQb, const bf16* __restrict__ K1, const bf16* __restrict__ K2, unsigned short* __restrict__ teid_g, float* __restrict__ tgate_g,
                                                  LAS unsigned char* lds, int vcu, int G, int wave, int lane) {
    const int fr = lane & 15, fq = lane >> 4, h = wave;
    LAS unsigned char* itab = lds + wave * 1024;
    for (int tile = vcu; tile < TA / 16; tile += G) {
        const int tok0 = tile * 16;
        unsigned tk[2][16];
#pragma unroll
        for (int half = 0; half < 2; ++half) {
            const bf16* ap = PQb + (size_t)(tok0 + fr) * PEER_N + h * 256 + half * 128 + fq * 8;
            bf16x8 a[4];
#pragma unroll
            for (int ks = 0; ks < 4; ++ks) a[ks] = *(const bf16x8*)(ap + ks * 32);
            const bf16* kb = (half ? K2 : K1) + (size_t)fr * 128 + fq * 8;
            unsigned k0[16], k1[16];
#pragma unroll
            for (int ct = 0; ct < 8; ++ct) {
                f32x4 acc = (f32x4){0.f, 0.f, 0.f, 0.f};
#pragma unroll
                for (int ks = 0; ks < 4; ++ks) { const bf16x8 b = *(const bf16x8*)(kb + (size_t)ct * 16 * 128 + ks * 32); acc = __builtin_amdgcn_mfma_f32_16x16x32_bf16(b, a[ks], acc, 0, 0, 0); }
#pragma unroll
                for (int j = 0; j < 4; ++j) { const unsigned key = (f2ord(acc[j]) & 0xFFFFFF80u) | (unsigned)(127 - (ct * 16 + 4 * fq + j));
                    if (ct < 4) k0[ct * 4 + j] = key; else k1[(ct - 4) * 4 + j] = key; }
                if (ct & 1) asm volatile("" ::: "memory");
            }
            bitonic_sort_desc<16>(k0); bitonic_sort_desc<16>(k1);
            top16_merge(k0, k1); top16_xlane(k0, 16); top16_xlane(k0, 32);
#pragma unroll
            for (int i = 0; i < 16; ++i) tk[half][i] = k0[i];
        }
        if (fq == 0) {
#pragma unroll
            for (int i = 0; i < 16; ++i) { itab[fr * 32 + i] = (unsigned char)(127 - (tk[0][i] & 0x7Fu)); itab[fr * 32 + 16 + i] = (unsigned char)(127 - (tk[1][i] & 0x7Fu)); }
        }
        unsigned ck[16];
        {
            float v1[16], v2[16];
#pragma unroll
            for (int i = 0; i < 16; ++i) { v1[i] = ord2f(tk[0][i] & 0xFFFFFF80u); v2[i] = ord2f(tk[1][i] & 0xFFFFFF80u); }
            int c = 0;
#pragma unroll
            for (int i = 0; i < 16; ++i)
#pragma unroll
                for (int j = 0; j < 16; ++j) {
                    if ((i + 1) * (j + 1) <= 16) {
                        const unsigned key = (f2ord(v1[i] + v2[j]) & 0xFFFFFF00u) | (unsigned)(255 - (i * 16 + j));
                        const int m = c >> 2, pt = c & 3;
                        if (pt == 0) ck[m] = key; else ck[m] = fq == pt ? key : ck[m];
                        ++c;
                    }
                }
            ck[12] = fq < 2 ? ck[12] : 0u; ck[13] = 0u; ck[14] = 0u; ck[15] = 0u;
        }
        bitonic_sort_desc<16>(ck); top16_xlane(ck, 16); top16_xlane(ck, 32);
        asm volatile("s_waitcnt lgkmcnt(0)" ::: "memory");
        float ev[16]; float sum = 0.f; const float mxv = ord2f(ck[0] & 0xFFFFFF00u);
#pragma unroll
        for (int k = 0; k < 16; ++k) { ev[k] = __expf(ord2f(ck[k] & 0xFFFFFF00u) - mxv); sum += ev[k]; }
        const float inv = 1.f / sum;
#pragma unroll
        for (int k = 0; k < 16; ++k) {
            if ((k >> 2) == fq) {
                const int f = 255 - (int)(ck[k] & 0xFFu); const int id = (int)itab[fr * 32 + (f >> 4)] * 128 + (int)itab[fr * 32 + 16 + (f & 15)];
                teid_g[(size_t)(tok0 + fr) * 128 + h * 16 + k] = (unsigned short)id; tgate_g[(size_t)(tok0 + fr) * 128 + h * 16 + k] = ev[k] * inv;
            }
        }
        asm volatile("s_waitcnt lgkmcnt(0)" ::: "memory");
    }
}

__device__ __forceinline__ void phase_peer_mix(const float* __restrict__ Zin, const float* __restrict__ g1, const float* __restrict__ b1, const unsigned short* __restrict__ teid, const float* __restrict__ tgate,
                                               const unsigned char* __restrict__ U, const unsigned char* __restrict__ V, const float* __restrict__ Us, const float* __restrict__ Vs, const float* __restrict__ g2, const float* __restrict__ b2,
                                               float* __restrict__ outf, bf16* __restrict__ outb, int gw, int NGW, int lane) {

    for (int j = gw; j < TP + TS * 16; j += NGW) {
        size_t tok;
        if (j < TP) tok = (size_t)j;
        else { const int s = j - TP; if ((s & 15) != 0) continue; tok = (size_t)TP + (s >> 4); }
        {
            float xf[16];
            { float s1 = 0.f;
#pragma unroll
              for (int q = 0; q < 4; ++q) { const f32x4 r = *(const f32x4*)(Zin + tok * D + lane * 16 + q * 4); xf[q * 4] = r[0]; xf[q * 4 + 1] = r[1]; xf[q * 4 + 2] = r[2]; xf[q * 4 + 3] = r[3]; s1 += (r[0] + r[1]) + (r[2] + r[3]); }
#pragma unroll
              for (int o = 1; o < 64; o <<= 1) s1 += __shfl_xor(s1, o);
              const float mean1 = s1 * (1.f / D); float q1 = 0.f;
#pragma unroll
              for (int i = 0; i < 16; ++i) { xf[i] -= mean1; q1 += xf[i] * xf[i]; }
#pragma unroll
              for (int o = 1; o < 64; o <<= 1) q1 += __shfl_xor(q1, o);
              const float rstd1 = rsqrtf(q1 * (1.f / D) + LN_EPS);
#pragma unroll
              for (int q = 0; q < 4; ++q) { const f32x4 gg = *(const f32x4*)(g1 + lane * 16 + q * 4), bb = *(const f32x4*)(b1 + lane * 16 + q * 4);
#pragma unroll
                  for (int i = 0; i < 4; ++i) xf[q * 4 + i] = xf[q * 4 + i] * rstd1 * gg[i] + bb[i]; } }
            float wv0 = 0.f, wv1 = 0.f;
#pragma unroll 1
            for (int bt = 0; bt < 2; ++bt) {
                const int eidv = (int)teid[tok * 128 + bt * 64 + lane];
                float p[64];

                u32x4 qb[2][PGS];
#pragma unroll
                for (int i = 0; i < PGS; ++i) { const int id = __builtin_amdgcn_readlane(eidv, i); qb[0][i] = *(const u32x4*)(U + (size_t)id * D + lane * 16); }
#pragma unroll
                for (int g = 0; g < 64 / PGS; ++g) {
                    if (g < 64 / PGS - 1) {
#pragma unroll
                        for (int i = 0; i < PGS; ++i) { const int id = __builtin_amdgcn_readlane(eidv, (g + 1) * PGS + i); qb[(g + 1) & 1][i] = *(const u32x4*)(U + (size_t)id * D + lane * 16); }
                    }
                    asm volatile("" ::: "memory");
#pragma unroll
                    for (int i = 0; i < PGS; ++i) {
                        float a = 0.f;
#pragma unroll
                        for (int w = 0; w < 4; ++w) { const f32x2v lo = __builtin_amdgcn_cvt_pk_f32_fp8((int)qb[g & 1][i][w], false), hi = __builtin_amdgcn_cvt_pk_f32_fp8((int)qb[g & 1][i][w], true);
                            a = fmaf(lo[0], xf[w * 4], a); a = fmaf(lo[1], xf[w * 4 + 1], a); a = fmaf(hi[0], xf[w * 4 + 2], a); a = fmaf(hi[1], xf[w * 4 + 3], a); }
                        p[g * PGS + i] = a;
                        __builtin_amdgcn_sched_barrier(0);
                    }
                }

#pragma unroll
                for (int o = 32; o >= 1; o >>= 1) {
                    const bool up = (lane & o) != 0;
#pragma unroll
                    for (int i = 0; i < o; ++i) { const float keep = up ? p[i + o] : p[i], send = up ? p[i] : p[i + o]; p[i] = keep + __shfl_xor(send, o); }
                }
                const float hdot = p[0] * Us[eidv];
                const float wv = 0.5f * hdot * (1.f + erff(hdot * 0.70710678118654752f)) * tgate[tok * 128 + bt * 64 + lane] * Vs[eidv];
                if (bt == 0) wv0 = wv; else wv1 = wv;

            }

            float y[16];
#pragma unroll
            for (int i = 0; i < 16; ++i) y[i] = 0.f;
#pragma unroll 1
            for (int bt = 0; bt < 2; ++bt) {
                const int eidv = (int)teid[tok * 128 + bt * 64 + lane]; const float wvv = bt == 0 ? wv0 : wv1;
                u32x4 qb[2][PGS];
#pragma unroll
                for (int i = 0; i < PGS; ++i) { const int id = __builtin_amdgcn_readlane(eidv, i); qb[0][i] = *(const u32x4*)(V + (size_t)id * D + lane * 16); }
#pragma unroll
                for (int g = 0; g < 64 / PGS; ++g) {
                    if (g < 64 / PGS - 1) {
#pragma unroll
                        for (int i = 0; i < PGS; ++i) { const int id = __builtin_amdgcn_readlane(eidv, (g + 1) * PGS + i); qb[(g + 1) & 1][i] = *(const u32x4*)(V + (size_t)id * D + lane * 16); }
                    }
                    asm volatile("" ::: "memory");
#pragma unroll
                    for (int i = 0; i < PGS; ++i) {
                        const float w = __builtin_bit_cast(float, __builtin_amdgcn_readlane(__builtin_bit_cast(int, wvv), g * PGS + i));
                        asm volatile("" : "+v"(qb[g & 1][i][0]), "+v"(qb[g & 1][i][1]), "+v"(qb[g & 1][i][2]), "+v"(qb[g & 1][i][3]));
#pragma unroll
                        for (int k = 0; k < 4; ++k) { const f32x2v lo = __builtin_amdgcn_cvt_pk_f32_fp8((int)qb[g & 1][i][k], false), hi = __builtin_amdgcn_cvt_pk_f32_fp8((int)qb[g & 1][i][k], true);
                            y[k * 4] = fmaf(w, lo[0], y[k * 4]); y[k * 4 + 1] = fmaf(w, lo[1], y[k * 4 + 1]); y[k * 4 + 2] = fmaf(w, hi[0], y[k * 4 + 2]); y[k * 4 + 3] = fmaf(w, hi[1], y[k * 4 + 3]); }
                        asm volatile("" : "+v"(y[0]), "+v"(y[1]), "+v"(y[2]), "+v"(y[3]), "+v"(y[4]), "+v"(y[5]), "+v"(y[6]), "+v"(y[7]), "+v"(y[8]), "+v"(y[9]), "+v"(y[10]), "+v"(y[11]), "+v"(y[12]), "+v"(y[13]), "+v"(y[14]), "+v"(y[15]));
                    }
                }
            }

            float s = 0.f;
#pragma unroll
            for (int i = 0; i < 16; ++i) { y[i] = ALPHA * xf[i] + y[i]; s += y[i]; }
#pragma unroll
            for (int o = 1; o < 64; o <<= 1) s += __shfl_xor(s, o);
            const float mean = s * (1.f / D); float qq = 0.f;
#pragma unroll
            for (int i = 0; i < 16; ++i) { y[i] -= mean; qq += y[i] * y[i]; }
#pragma unroll
            for (int o = 1; o < 64; o <<= 1) qq += __shfl_xor(qq, o);
            const float rstd = rsqrtf(qq * (1.f / D) + LN_EPS);
            u32x4 ob0, ob1;
#pragma unroll
            for (int q = 0; q < 4; ++q) { const int col = lane * 16 + q * 4; const f32x4 gg = *(const f32x4*)(g2 + col), bb = *(const f32x4*)(b2 + col);
                f32x4 o;
#pragma unroll
                for (int i = 0; i < 4; ++i) o[i] = y[q * 4 + i] * rstd * gg[i] + bb[i];
                *(f32x4*)(outf + tok * D + col) = o;
                const unsigned w0 = pk2(o[0], o[1]), w1 = pk2(o[2], o[3]);
                if (q == 0) { ob0.x = w0; ob0.y = w1; } else if (q == 1) { ob0.z = w0; ob0.w = w1; } else if (q == 2) { ob1.x = w0; ob1.y = w1; } else { ob1.z = w0; ob1.w = w1; } }
            if (outb) { *(u32x4*)(outb + tok * D + lane * 16) = ob0; *(u32x4*)(outb + tok * D + lane * 16 + 8) = ob1; }

        }
    }

}

__device__ __forceinline__ float peer_reduce16(float (&p)[16], int lane) {
#pragma unroll
    for (int o = 8; o >= 1; o >>= 1) { const bool up = (lane & (o * 4)) != 0;
#pragma unroll
        for (int k = 0; k < o; ++k) { const float keep = up ? p[k + o] : p[k], send = up ? p[k] : p[k + o]; p[k] = keep + __shfl_xor(send, o * 4); } }
    float tot = p[0];
    tot += __shfl_xor(tot, 2); tot += __shfl_xor(tot, 1);
    return tot;
}
__device__ __forceinline__ unsigned cvtpk_bf16_(float lo, float hi) { typedef __bf16 bf2 __attribute__((ext_vector_type(2))); f32x2v v = {lo, hi}; bf2 b = __builtin_convertvector(v, bf2); return __builtin_bit_cast(unsigned, b); }
__device__ __forceinline__ float peer_dot16b(const u32x4 q, const u32x4 x0, const u32x4 x1) {
    float a = 0.f;
#pragma unroll
    for (int w = 0; w < 4; ++w) { const f32x2v lo = __builtin_amdgcn_cvt_pk_f32_fp8((int)q[w], false), hi = __builtin_amdgcn_cvt_pk_f32_fp8((int)q[w], true);
        const unsigned xa = w < 2 ? x0[2 * w] : x1[2 * w - 4], xb = w < 2 ? x0[2 * w + 1] : x1[2 * w - 3];
        a = dot2bf(cvtpk_bf16_(lo[0], lo[1]), xa, a); a = dot2bf(cvtpk_bf16_(hi[0], hi[1]), xb, a); }
    return a;
}

__device__ __forceinline__ void peer_u_slice(int sl, int t_first, int t_step, const bf16* __restrict__ Hb, const unsigned short* __restrict__ teid, const unsigned char* __restrict__ U,
                                             float* __restrict__ HD, LAS unsigned char* wl, int lane) {
    LAS unsigned short* lst_e = (LAS unsigned short*)wl;
    LAS unsigned char* lst_s = wl + 512;
    const unsigned long long below = (1ull << lane) - 1ull;
    const int kk = (lane >> 2) & 15;
    if (t_first >= TA) return;
#define PU_BUILD(bsel, e0_, e1_, cnt_) do { const bool a0_ = ((e0_) >> 11) == sl, a1_ = ((e1_) >> 11) == sl; const unsigned long long m0_ = __ballot(a0_), m1_ = __ballot(a1_); \
        const int c0_ = __builtin_popcountll(m0_); cnt_ = c0_ + __builtin_popcountll(m1_); \
        if (a0_) { const int p_ = __builtin_popcountll(m0_ & below); lst_e[(bsel) * 128 + p_] = (unsigned short)(e0_); lst_s[(bsel) * 128 + p_] = (unsigned char)lane; } \
        if (a1_) { const int p_ = c0_ + __builtin_popcountll(m1_ & below); lst_e[(bsel) * 128 + p_] = (unsigned short)(e1_); lst_s[(bsel) * 128 + p_] = (unsigned char)(64 + lane); } } while (0)
#define PU_LOAD(bsel, cnt_, q_) do { _Pragma("unroll") for (int k = 0; k < 16; ++k) { if (k < (cnt_)) { const int id_ = __builtin_amdgcn_readfirstlane((int)lst_e[(bsel) * 128 + k]); q_[k] = *(const u32x4*)(U + (size_t)id_ * D + lane * 16); } } } while (0)
    int e0 = __builtin_nontemporal_load(teid + (size_t)t_first * 128 + lane), e1 = __builtin_nontemporal_load(teid + (size_t)t_first * 128 + 64 + lane);
    u32x4 xa0 = __builtin_nontemporal_load((const u32x4*)(Hb + (size_t)t_first * D + lane * 16)), xa1 = __builtin_nontemporal_load((const u32x4*)(Hb + (size_t)t_first * D + lane * 16 + 8));
    int cnt; PU_BUILD(0, e0, e1, cnt);
    asm volatile("s_waitcnt lgkmcnt(0)" ::: "memory");
    u32x4 q[16];
    PU_LOAD(0, cnt, q);
    int buf = 0;

    for (int t = t_first; t < TA; t += t_step, buf ^= 1) {
        const int tn = t + t_step; const bool hasn = tn < TA;
        u32x4 xb0 = xa0, xb1 = xa1; int f0 = 0, f1 = 0;
        if (hasn) { f0 = __builtin_nontemporal_load(teid + (size_t)tn * 128 + lane); f1 = __builtin_nontemporal_load(teid + (size_t)tn * 128 + 64 + lane);
            xb0 = __builtin_nontemporal_load((const u32x4*)(Hb + (size_t)tn * D + lane * 16)); xb1 = __builtin_nontemporal_load((const u32x4*)(Hb + (size_t)tn * D + lane * 16 + 8)); }

        float pr[16];
#pragma unroll
        for (int k = 0; k < 16; ++k) pr[k] = k < cnt ? peer_dot16b(q[k], xa0, xa1) : 0.f;

#pragma unroll 1
        for (int p0 = 16; p0 < cnt; p0 += 16) {
            u32x4 q2[16];
#pragma unroll
            for (int k = 0; k < 16; ++k) { if (p0 + k < cnt) { const int id_ = __builtin_amdgcn_readfirstlane((int)lst_e[buf * 128 + p0 + k]); q2[k] = *(const u32x4*)(U + (size_t)id_ * D + lane * 16); } }
            float pr2[16];
#pragma unroll
            for (int k = 0; k < 16; ++k) pr2[k] = p0 + k < cnt ? peer_dot16b(q2[k], xa0, xa1) : 0.f;
            const float tot2 = peer_reduce16(pr2, lane);
            if (p0 + kk < cnt && (lane & 3) == 0) __builtin_nontemporal_store(tot2, HD + (size_t)t * 128 + lst_s[buf * 128 + p0 + kk]);
        }

        int cntn = 0;
        if (hasn) { PU_BUILD(buf ^ 1, f0, f1, cntn); }
        asm volatile("s_waitcnt lgkmcnt(0)" ::: "memory");
        if (hasn) PU_LOAD(buf ^ 1, cntn, q);

        const float tot = peer_reduce16(pr, lane);
        if (kk < cnt && (lane & 3) == 0) __builtin_nontemporal_store(tot, HD + (size_t)t * 128 + lst_s[buf * 128 + kk]);
        xa0 = xb0; xa1 = xb1; cnt = cntn;

    }

#undef PU_BUILD
#undef PU_LOAD
}

__device__ __forceinline__ void phase_peer_mixv(const float* __restrict__ Zin, const float* __restrict__ g1, const float* __restrict__ b1, const unsigned short* __restrict__ teid, const float* __restrict__ tgate, const float* __restrict__ HD,
                                                const unsigned char* __restrict__ V, const float* __restrict__ Us, const float* __restrict__ Vs, const float* __restrict__ g2, const float* __restrict__ b2,
                                                float* __restrict__ outf, bf16* __restrict__ outb, int gw, int NGW, int lane) {
    for (int j = gw; j < TP + TS * 16; j += NGW) {
        size_t tok;
        if (j < TP) tok = (size_t)j;
        else { const int s = j - TP; if ((s & 15) != 0) continue; tok = (size_t)TP + (s >> 4); }
        float xf[16];
        { float s1 = 0.f;
#pragma unroll
          for (int q = 0; q < 4; ++q) { const f32x4 r = *(const f32x4*)(Zin + tok * D + lane * 16 + q * 4); xf[q * 4] = r[0]; xf[q * 4 + 1] = r[1]; xf[q * 4 + 2] = r[2]; xf[q * 4 + 3] = r[3]; s1 += (r[0] + r[1]) + (r[2] + r[3]); }
#pragma unroll
          for (int o = 1; o < 64; o <<= 1) s1 += __shfl_xor(s1, o);
          const float mean1 = s1 * (1.f / D); float q1 = 0.f;
#pragma unroll
          for (int i = 0; i < 16; ++i) { xf[i] -= mean1; q1 += xf[i] * xf[i]; }
#pragma unroll
          for (int o = 1; o < 64; o <<= 1) q1 += __shfl_xor(q1, o);
          const float rstd1 = rsqrtf(q1 * (1.f / D) + LN_EPS);
#pragma unroll
          for (int q = 0; q < 4; ++q) { const f32x4 gg = *(const f32x4*)(g1 + lane * 16 + q * 4), bb = *(const f32x4*)(b1 + lane * 16 + q * 4);
#pragma unroll
              for (int i = 0; i < 4; ++i) xf[q * 4 + i] = xf[q * 4 + i] * rstd1 * gg[i] + bb[i]; } }
        float y[16];
#pragma unroll
        for (int i = 0; i < 16; ++i) y[i] = 0.f;
#pragma unroll 1
        for (int bt = 0; bt < 2; ++bt) {
            const int eidv = (int)teid[tok * 128 + bt * 64 + lane];
            const float hd = HD[tok * 128 + bt * 64 + lane] * Us[eidv];
            const float wvv = 0.5f * hd * (1.f + erff(hd * 0.70710678118654752f)) * tgate[tok * 128 + bt * 64 + lane] * Vs[eidv];
            u32x4 qb[2][PGS];
#pragma unroll
            for (int i = 0; i < PGS; ++i) { const int id = __builtin_amdgcn_readlane(eidv, i); qb[0][i] = *(const u32x4*)(V + (size_t)id * D + lane * 16); }
#pragma unroll
            for (int g = 0; g < 64 / PGS; ++g) {
                if (g < 64 / PGS - 1) {
#pragma unroll
                    for (int i = 0; i < PGS; ++i) { const int id = __builtin_amdgcn_readlane(eidv, (g + 1) * PGS + i); qb[(g + 1) & 1][i] = *(const u32x4*)(V + (size_t)id * D + lane * 16); }
                }
                asm volatile("" ::: "memory");
#pragma unroll
                for (int i = 0; i < PGS; ++i) {
                    const float w = __builtin_bit_cast(float, __builtin_amdgcn_readlane(__builtin_bit_cast(int, wvv), g * PGS + i));
                    asm volatile("" : "+v"(qb[g & 1][i][0]), "+v"(qb[g & 1][i][1]), "+v"(qb[g & 1][i][2]), "+v"(qb[g & 1][i][3]));
#pragma unroll
                    for (int k = 0; k < 4; ++k) { const f32x2v lo = __builtin_amdgcn_cvt_pk_f32_fp8((int)qb[g & 1][i][k], false), hi = __builtin_amdgcn_cvt_pk_f32_fp8((int)qb[g & 1][i][k], true);
                        y[k * 4] = fmaf(w, lo[0], y[k * 4]); y[k * 4 + 1] = fmaf(w, lo[1], y[k * 4 + 1]); y[k * 4 + 2] = fmaf(w, hi[0], y[k * 4 + 2]); y[k * 4 + 3] = fmaf(w, hi[1], y[k * 4 + 3]); }
                    asm volatile("" : "+v"(y[0]), "+v"(y[1]), "+v"(y[2]), "+v"(y[3]), "+v"(y[4]), "+v"(y[5]), "+v"(y[6]), "+v"(y[7]), "+v"(y[8]), "+v"(y[9]), "+v"(y[10]), "+v"(y[11]), "+v"(y[12]), "+v"(y[13]), "+v"(y[14]), "+v"(y[15]));
                }
            }
        }
        float s = 0.f;
#pragma unroll
        for (int i = 0; i < 16; ++i) { y[i] = ALPHA * xf[i] + y[i]; s += y[i]; }
#pragma unroll
        for (int o = 1; o < 64; o <<= 1) s += __shfl_xor(s, o);
        const float mean = s * (1.f / D); float qq = 0.f;
#pragma unroll
        for (int i = 0; i < 16; ++i) { y[i] -= mean; qq += y[i] * y[i]; }
#pragma unroll
        for (int o = 1; o < 64; o <<= 1) qq += __shfl_xor(qq, o);
        const float rstd = rsqrtf(qq * (1.f / D) + LN_EPS);
        u32x4 ob0, ob1;
#pragma unroll
        for (int q = 0; q < 4; ++q) { const int col = lane * 16 + q * 4; const f32x4 gg = *(const f32x4*)(g2 + col), bb = *(const f32x4*)(b2 + col);
            f32x4 o;
#pragma unroll
            for (int i = 0; i < 4; ++i) o[i] = y[q * 4 + i] * rstd * gg[i] + bb[i];
            *(f32x4*)(outf + tok * D + col) = o;
            const unsigned w0 = pk2(o[0], o[1]), w1 = pk2(o[2], o[3]);
            if (q == 0) { ob0.x = w0; ob0.y = w1; } else if (q == 1) { ob0.z = w0; ob0.w = w1; } else if (q == 2) { ob1.x = w0; ob1.y = w1; } else { ob1.z = w0; ob1.w = w1; } }
        if (outb) { *(u32x4*)(outb + tok * D + lane * 16) = ob0; *(u32x4*)(outb + tok * D + lane * 16 + 8) = ob1; }
    }
}
}

namespace mk {
struct FGlaIn {
    bf16 *Gq, *Gk, *Gv, *Gr; float* GD;
    __device__ __forceinline__ static float silu(float r) { return r / (1.f + __expf(-r)); }
    __device__ __forceinline__ void put8(int row, int col, f32x4 v0, f32x4 v1) const {
        if (col < GN_K) *(u32x4*)(Gq + (size_t)row * 512 + col) = pack8(v0, v1);
        else if (col < GN_V) *(u32x4*)(Gk + (size_t)row * 512 + (col - GN_K)) = pack8(v0, v1);
        else if (col < GN_R) *(u32x4*)(Gv + (size_t)row * 1024 + (col - GN_V)) = pack8(v0, v1);
        else { f32x4 a, b;
#pragma unroll
            for (int i = 0; i < 4; ++i) { a[i] = silu(v0[i]); b[i] = silu(v1[i]); }
            *(u32x4*)(Gr + (size_t)row * 1024 + (col - GN_R)) = pack8(a, b); }
    }
    __device__ __forceinline__ void put4(int row, int col, f32x4 v) const {
        u32x2 w; w.x = pk2(v[0], v[1]); w.y = pk2(v[2], v[3]);
        if (col < GN_K) *(u32x2*)(Gq + (size_t)row * 512 + col) = w;
        else if (col < GN_V) *(u32x2*)(Gk + (size_t)row * 512 + (col - GN_K)) = w;
        else if (col < GN_R) *(u32x2*)(Gv + (size_t)row * 1024 + (col - GN_V)) = w;
        else if (col < GN_GD) { u32x2 s; s.x = pk2(silu(v[0]), silu(v[1])); s.y = pk2(silu(v[2]), silu(v[3])); *(u32x2*)(Gr + (size_t)row * 1024 + (col - GN_R)) = s; }
        else if (col < GN_GD + 16) *(f32x4*)(GD + (size_t)row * 16 + (col - GN_GD)) = v;
    }
};

__device__ __forceinline__ float log_sigmoid_f(float x) { return fminf(x, 0.f) - log1pf(__expf(-fabsf(x))); }
__device__ __forceinline__ bf16x8 tr8(LAS unsigned char* a0, LAS unsigned char* a1) { const s16x4 v0 = lds_tr(a0), v1 = lds_tr(a1); bf16x8 r; r[0] = v0[0]; r[1] = v0[1]; r[2] = v0[2]; r[3] = v0[3]; r[4] = v1[0]; r[5] = v1[1]; r[6] = v1[2]; r[7] = v1[3]; return r; }

constexpr int KD_ST = 272, V_ST = 528;
constexpr int GL_LB = 0, GL_TOT = 32768, GL_KD = 36864, GL_V = GL_KD + 64 * KD_ST  , GL_END = GL_V + 64 * V_ST;
static_assert(GL_END <= RING_BYTES, "GLA chunk LDS");

__device__ __forceinline__ void gla_chunk_item(int item, const bf16* __restrict__ Gq, const bf16* __restrict__ Gk, const bf16* __restrict__ Gv, const float* __restrict__ GD,
                                               const float* __restrict__ Wgu, const float* __restrict__ bg, bf16* __restrict__ QT, bf16* __restrict__ KT, float* __restrict__ DEC, float* __restrict__ DS,
                                               LAS unsigned char* lds, int tid, int wave, int lane) {
    const int h = item & 3, bc = item >> 2;
    const size_t tok0 = (size_t)bc * 64;
    LAS float* LB = (LAS float*)(lds + GL_LB);
    LAS float* TOT = (LAS float*)(lds + GL_TOT);
    const int d = tid & 127, tq = tid >> 7;
    float wg[16];
#pragma unroll
    for (int r = 0; r < 16; ++r) wg[r] = Wgu[r * 512 + h * 128 + d];
    const float bgd = bg[h * 128 + d];
    float pre[16]; float run = 0.f;
#pragma unroll
    for (int i = 0; i < 16; ++i) {
        const float* gd = GD + (tok0 + tq * 16 + i) * 16;
        const f32x4 g0 = *(const f32x4*)gd, g1 = *(const f32x4*)(gd + 4), g2 = *(const f32x4*)(gd + 8), g3 = *(const f32x4*)(gd + 12);
        float x = 0.f;
#pragma unroll
        for (int r = 0; r < 4; ++r) { x = fmaf(g0[r], wg[r], x); }
#pragma unroll
        for (int r = 0; r < 4; ++r) { x = fmaf(g1[r], wg[4 + r], x); }
#pragma unroll
        for (int r = 0; r < 4; ++r) { x = fmaf(g2[r], wg[8 + r], x); }
#pragma unroll
        for (int r = 0; r < 4; ++r) { x = fmaf(g3[r], wg[12 + r], x); }
        run += log_sigmoid_f(x + bgd) * (1.f / 16.f); pre[i] = run;
    }
    TOT[tq * 128 + d] = run;
    __syncthreads();
    float off = 0.f;
#pragma unroll
    for (int q = 0; q < 3; ++q) if (q < tq) off += TOT[q * 128 + d];
    const float bC = (TOT[d] + TOT[128 + d]) + (TOT[256 + d] + TOT[384 + d]);
#pragma unroll
    for (int i = 0; i < 16; ++i) {
        const int t = tq * 16 + i; const float b = pre[i] + off; const size_t tok = tok0 + t;
        const float q = bf2f(Gq[tok * 512 + h * 128 + d]), k = bf2f(Gk[tok * 512 + h * 128 + d]);
        QT[tok * 512 + h * 128 + d] = (bf16)f2bf(q * 0.08838834764831845f * __expf(b));
        KT[tok * 512 + h * 128 + d] = (bf16)f2bf(k * __expf(-b));
        *(LAS bf16*)(lds + GL_KD + t * KD_ST + d * 2) = (bf16)f2bf(k * __expf(bC - b));
    }
    if (tq == 0) DEC[(size_t)item * 128 + d] = __expf(bC);
#pragma unroll
    for (int p = 0; p < 4; ++p) { const int e = tid + p * 512, s = e >> 5, ch = e & 31;
        *(LAS u32x4*)(lds + GL_V + s * V_ST + ch * 16) = *(const u32x4*)(Gv + (tok0 + s) * 1024 + h * 256 + ch * 8); }
    __syncthreads();
    const int fr = lane & 15, fq = lane >> 4, dt = wave;
    bf16x8 af[2];
#pragma unroll
    for (int ks = 0; ks < 2; ++ks) { LAS unsigned char* a0 = lds + GL_KD + (ks * 32 + fq * 8 + (fr >> 2)) * KD_ST + (dt * 16 + 4 * (fr & 3)) * 2; af[ks] = tr8(a0, a0 + 4 * KD_ST); }
    float* dsb = DS + (size_t)item * 256 * 128;
#pragma unroll 4
    for (int vt = 0; vt < 16; ++vt) {
        f32x4 acc = (f32x4){0.f, 0.f, 0.f, 0.f};
#pragma unroll
        for (int ks = 0; ks < 2; ++ks) { LAS unsigned char* b0 = lds + GL_V + (ks * 32 + fq * 8 + (fr >> 2)) * V_ST + (vt * 16 + 4 * (fr & 3)) * 2; const bf16x8 bf = tr8(b0, b0 + 4 * V_ST);
            acc = __builtin_amdgcn_mfma_f32_16x16x32_bf16(af[ks], bf, acc, 0, 0, 0); }
        *(f32x4*)(dsb + (size_t)(vt * 16 + fr) * 128 + dt * 16 + fq * 4) = acc;
    }
    __syncthreads();
}

__device__ __forceinline__ void gla_sample_item(int item, const bf16* __restrict__ Gq, const bf16* __restrict__ Gk, const bf16* __restrict__ Gv, const bf16* __restrict__ Gr, const float* __restrict__ GD,
                                                const float* __restrict__ Wgu, const float* __restrict__ bg, const float* __restrict__ ng, const float* __restrict__ S0, float* __restrict__ Sout, bf16* __restrict__ OGb,
                                                LAS unsigned char* lds, int tid, int lane) {
    const int b = item >> 2, h = item & 3;
    LAS float* A = (LAS float*)lds;
    LAS float* Qs = A + 512; LAS float* Ks = Qs + 512;
    LAS float* PO = Ks + 512;
    LAS float* RS = PO + 4096;
    { const int t = tid >> 7, d = tid & 127; const size_t tok = (size_t)TP + b * DS + t;
      float x = bg[h * 128 + d]; const float* gd = GD + tok * 16; float xs = 0.f;
#pragma unroll
      for (int r = 0; r < 16; ++r) xs = fmaf(gd[r], Wgu[r * 512 + h * 128 + d], xs);
      x += xs;
      A[t * 128 + d] = __expf(log_sigmoid_f(x) * (1.f / 16.f));
      Qs[t * 128 + d] = bf2f(Gq[tok * 512 + h * 128 + d]) * 0.08838834764831845f; Ks[t * 128 + d] = bf2f(Gk[tok * 512 + h * 128 + d]); }
    __syncthreads();
    const int dq = tid >> 7, d0 = dq * 32;
#pragma unroll 1
    for (int vhalf = 0; vhalf < 2; ++vhalf) {
        const int v = vhalf * 128 + (tid & 127);
        float S[32];
#pragma unroll
        for (int i = 0; i < 32; ++i) S[i] = S0[(((size_t)b * 4 + h) * 128 + d0 + i) * 256 + v];
#pragma unroll 1
        for (int t = 0; t < 4; ++t) {
            const float vv = bf2f(Gv[((size_t)TP + b * DS + t) * 1024 + h * 256 + v]); float o = 0.f;
#pragma unroll
            for (int i = 0; i < 32; ++i) { S[i] = fmaf(A[t * 128 + d0 + i], S[i], Ks[t * 128 + d0 + i] * vv); o = fmaf(Qs[t * 128 + d0 + i], S[i], o); }
            PO[(dq * 4 + t) * 256 + v] = o;
        }
#pragma unroll
        for (int i = 0; i < 32; ++i) Sout[(((size_t)b * 4 + h) * 128 + d0 + i) * 256 + v] = S[i];
    }
    __syncthreads();
    { const int t = tid >> 7, vl = tid & 127; const float o0 = (PO[t * 256 + vl] + PO[(4 + t) * 256 + vl]) + (PO[(8 + t) * 256 + vl] + PO[(12 + t) * 256 + vl]), o1 = (PO[t * 256 + 128 + vl] + PO[(4 + t) * 256 + 128 + vl]) + (PO[(8 + t) * 256 + 128 + vl] + PO[(12 + t) * 256 + 128 + vl]);
      float ss = o0 * o0 + o1 * o1;
#pragma unroll
      for (int o = 1; o < 64; o <<= 1) ss += __shfl_xor(ss, o);
      if (lane == 0) RS[tid >> 6] = ss;
      __syncthreads();
      const float ms = (RS[2 * t] + RS[2 * t + 1]) * (1.f / 256.f), rstd = rsqrtf(ms + LN_EPS);
      const size_t tok = (size_t)TP + b * DS + t;
      OGb[tok * 1024 + h * 256 + vl] = (bf16)f2bf(o0 * rstd * ng[vl] * bf2f(Gr[tok * 1024 + h * 256 + vl]));
      OGb[tok * 1024 + h * 256 + 128 + vl] = (bf16)f2bf(o1 * rstd * ng[128 + vl] * bf2f(Gr[tok * 1024 + h * 256 + 128 + vl])); }
    __syncthreads();
}

__device__ __forceinline__ void gla_scan(const float* __restrict__ DS, const float* __restrict__ DEC, bf16* __restrict__ SP, float* __restrict__ Sout, int gtid, int gthreads) {
    typedef float f32x2 __attribute__((ext_vector_type(2)));
    for (int e = gtid; e < NBATCH * 4 * 256 * 64; e += gthreads) {
        const int d2 = e & 63, v = (e >> 6) & 255, h = (e >> 14) & 3, b = e >> 16;
        f32x2 S = (f32x2){0.f, 0.f};
        for (int c = 0; c < SEQ / 64; ++c) {
            const size_t item = ((size_t)b * (SEQ / 64) + c) * 4 + h;
            const f32x2 ds = *(const f32x2*)(DS + (item * 256 + v) * 128 + d2 * 2), dc = *(const f32x2*)(DEC + item * 128 + d2 * 2);
            *(unsigned*)(SP + (item * 256 + v) * 128 + d2 * 2) = pk2(S[0], S[1]);
            S = dc * S + ds;
        }
        float* so = Sout + (((size_t)b * 4 + h) * 128 + d2 * 2) * 256 + v; so[0] = S[0]; so[256] = S[1];
    }
}

__device__ __forceinline__ void gla_out_item(int item, const bf16* __restrict__ QT, const bf16* __restrict__ KT, const bf16* __restrict__ Gv, const bf16* __restrict__ Gr, const bf16* __restrict__ SP,
                                             const float* __restrict__ ng, bf16* __restrict__ OGb, LAS unsigned char* lds, int tid, int wave, int lane) {
    const int h = item & 3, bc = item >> 2; const size_t tok0 = (size_t)bc * 64;
    const int fr = lane & 15, fq = lane >> 4, tt = wave & 3, vh = wave >> 2;
    LAS float* RS = (LAS float*)(lds + 64 * V_ST);
#pragma unroll
    for (int p = 0; p < 4; ++p) { const int e = tid + p * 512, s = e >> 5, ch = e & 31;
        *(LAS u32x4*)(lds + s * V_ST + ch * 16) = *(const u32x4*)(Gv + (tok0 + s) * 1024 + h * 256 + ch * 8); }
    bf16x8 qf[4];
#pragma unroll
    for (int ks = 0; ks < 4; ++ks) qf[ks] = *(const bf16x8*)(QT + (tok0 + tt * 16 + fr) * 512 + h * 128 + ks * 32 + fq * 8);
    bf16x8 pf[2];
    {
        f32x4 at[4];
#pragma unroll
        for (int st = 0; st < 4; ++st) {
            f32x4 acc = (f32x4){0.f, 0.f, 0.f, 0.f};
#pragma unroll
            for (int ks = 0; ks < 4; ++ks) { const bf16x8 kf = *(const bf16x8*)(KT + (tok0 + st * 16 + fr) * 512 + h * 128 + ks * 32 + fq * 8); acc = __builtin_amdgcn_mfma_f32_16x16x32_bf16(kf, qf[ks], acc, 0, 0, 0); }
#pragma unroll
            for (int j = 0; j < 4; ++j) { const int s = st * 16 + fq * 4 + j, t = tt * 16 + fr; if (s > t) acc[j] = 0.f; }
            at[st] = acc;
        }
        const u32x4 w0 = pack8(at[0], at[1]), w1 = pack8(at[2], at[3]);
        pf[0] = __builtin_bit_cast(bf16x8, w0); pf[1] = __builtin_bit_cast(bf16x8, w1);
    }
    __syncthreads();
    const bf16* spb = SP + (size_t)item * 256 * 128;
    f32x4 oacc[8]; float ss = 0.f;
#pragma unroll
    for (int i = 0; i < 8; ++i) {
        const int vt = vh * 8 + i;
        f32x4 acc = (f32x4){0.f, 0.f, 0.f, 0.f};
#pragma unroll
        for (int k2 = 0; k2 < 2; ++k2) {
            LAS unsigned char* a0 = lds + (k2 * 32 + fq * 4 + (fr >> 2)) * V_ST + (vt * 16 + 4 * (fr & 3)) * 2;
            const bf16x8 vf = tr8(a0, a0 + 16 * V_ST);
            acc = __builtin_amdgcn_mfma_f32_16x16x32_bf16(vf, pf[k2], acc, 0, 0, 0);
        }
#pragma unroll
        for (int ks = 0; ks < 4; ++ks) { const bf16x8 sf = *(const bf16x8*)(spb + (size_t)(vt * 16 + fr) * 128 + ks * 32 + fq * 8); acc = __builtin_amdgcn_mfma_f32_16x16x32_bf16(sf, qf[ks], acc, 0, 0, 0); }
        oacc[i] = acc; ss += (acc[0] * acc[0] + acc[1] * acc[1]) + (acc[2] * acc[2] + acc[3] * acc[3]);
    }
    ss += __shfl_xor(ss, 16); ss += __shfl_xor(ss, 32);
    if (fq == 0) RS[wave * 16 + fr] = ss;
    __syncthreads();
    const float ms = (RS[tt * 16 + fr] + RS[(tt + 4) * 16 + fr]) * (1.f / 256.f), rstd = rsqrtf(ms + LN_EPS);
    const size_t tok = tok0 + tt * 16 + fr;
#pragma unroll
    for (int i = 0; i < 8; ++i) {
        const int v = (vh * 8 + i) * 16 + fq * 4;
        const u32x2 rw = *(const u32x2*)(Gr + tok * 1024 + h * 256 + v); const f32x4 g = *(const f32x4*)(ng + v);
        u32x2 w; w.x = pk2(oacc[i][0] * rstd * g[0] * bflo(rw.x), oacc[i][1] * rstd * g[1] * bfhi(rw.x)); w.y = pk2(oacc[i][2] * rstd * g[2] * bflo(rw.y), oacc[i][3] * rstd * g[3] * bfhi(rw.y));
        *(u32x2*)(OGb + tok * 1024 + h * 256 + v) = w;
    }
    __syncthreads();
}
}

namespace mk {
#ifndef MIX_V2
#define MIX_V1 1
#endif
#if defined(MIX_V1)
#define MIXSEL(Hf, te, tg, U, V, Us, Vs, g2, b2, of, ob, lds, wave, gw, NGW, lane) phase_peer_mix(Hf, te, tg, U, V, Us, Vs, g2, b2, of, ob, gw, NGW, lane)
#define MIX_FROM_Z 1
#else
#define MIXSEL(Hf, te, tg, U, V, Us, Vs, g2, b2, of, ob, lds, wave, gw, NGW, lane) phase_peer_mix2(Hf, H1b, te, tg, U, V, Us, Vs, g2, b2, of, ob, lds, wave, gw, NGW, lane)
#endif
#define PEER_USLICE(Hb_, U_, Us_) do { if (G % 8 == 0) { const int per_ = G / 8; peer_u_slice(vcu / per_, (vcu % per_) * NWAVES + wave, per_ * NWAVES, Hb_, TEID, U_, HDB, lds + wave * 16384, lane); } \
        else { for (int sl_ = 0; sl_ < 8; ++sl_) peer_u_slice(sl_, gw, NGW, Hb_, TEID, U_, HDB, lds + wave * 16384, lane); } } while (0)
struct Args {
    const float* in[23]; const int* page_table; float* out; unsigned char* ws; int ph_lo, ph_hi;
};
enum Phase { P_PRO = 0, P_AIN = 1, P_SCORE = 2, P_TOPK = 3, P_ATTN = 4, P_AOUT = 5, P_LN1 = 6, P_PQ0 = 7, P_PEER0 = 8, P_GIN = 9, P_GCH = 10, P_GSC = 11, P_GOUT = 12, P_GPRJ = 13, P_LN1B = 14, P_PQ1 = 15, P_PEER1 = 16, P_COUNT = 17 };

#define Wa ((bf16*)(ws + WS_WA))
#define Wo ((bf16*)(ws + WS_WO))
#define Wg ((bf16*)(ws + WS_WG))
#define Wgo ((bf16*)(ws + WS_WGO))
#define Wpq ((bf16*)(ws + WS_WPQ))
#define PK ((bf16*)(ws + WS_PK))
#define Usc ((float*)(ws + WS_USC))
#define Xb ((bf16*)(ws + WS_XB))
#define Qb ((bf16*)(ws + WS_QB))
#define QIb ((bf16*)(ws + WS_QIB))
#define Kb ((bf16*)(ws + WS_KB))
#define Vb ((bf16*)(ws + WS_VB))
#define KIb ((bf16*)(ws + WS_KIB))
#define WIf ((float*)(ws + WS_WIF))
#define SC ((float*)(ws + WS_SC))
#define SCS ((float*)(ws + WS_SCS))
#define IDX ((int*)(ws + WS_IDX))
#define CNT ((int*)(ws + WS_CNT))
#define Ob ((bf16*)(ws + WS_OB))
#define Z ((float*)(ws + WS_Z))
#define H1f ((float*)(ws + WS_H1F))
#define H1b ((bf16*)(ws + WS_H1B))
#define PQb ((bf16*)(ws + WS_PQB))
#define H2f ((float*)(ws + WS_H2F))
#define H2b ((bf16*)(ws + WS_H2B))
#define TEID ((unsigned short*)(ws + WS_TEID))
#define TGATE ((float*)(ws + WS_TGATE))
#define Gq ((bf16*)(ws + WS_GQ))
#define Gk ((bf16*)(ws + WS_GK))
#define Gv ((bf16*)(ws + WS_GV))
#define Gr ((bf16*)(ws + WS_GR))
#define GD ((float*)(ws + WS_GD))
#define QT ((bf16*)(ws + WS_QT))
#define KT ((bf16*)(ws + WS_KT))
#define DEC ((float*)(ws + WS_DEC))
#define DSb ((float*)(ws + WS_DS))
#define SPV ((bf16*)(ws + WS_SPREV))
#define OGb ((bf16*)(ws + WS_OGB))
#define HDB ((float*)(ws + WS_HD))
#define KV8 ((unsigned char*)(ws + WS_KV8))
#define Uq (ws + WS_UB)
#define Vq (ws + WS_VBX)
#define Usc ((float*)(ws + WS_USC))
#define Vsc ((float*)(ws + WS_USC) + 2 * 16384)
#define x_prompt (INP(0))
#define x_sample (INP(1))
#define attn_w_in (INP(7))
#define attn_w_out (INP(8))
#define gla_w_in (INP(9))
#define gla_w_out (INP(13))
#define peer_w_q (INP(14))
#define peer_keys1 (INP(15))
#define peer_keys2 (INP(16))
#define peer_u (INP(17))
#define peer_v (INP(18))
__device__ __forceinline__ unsigned char* launder_ptr(unsigned char* p) { asm volatile("" : "+s"(p)); return p; }
#if defined(LOWSGPR)
#define ws (launder_ptr(args.ws))
#define INP(k) ((const float*)inp_ptr(lds, (k)))
#else
#define ws (args.ws)
#define INP(k) (args.in[k])
#endif
__device__ __forceinline__ const void* inp_ptr(LAS unsigned char* lds, int k) {
    const unsigned long long v = *(LAS unsigned long long*)(lds + INPTAB_OFF + 8 * k);
    const unsigned lo = __builtin_amdgcn_readfirstlane((unsigned)v), hi = __builtin_amdgcn_readfirstlane((unsigned)(v >> 32));
    return (const void*)(((unsigned long long)hi << 32) | lo);
}
__global__ void __launch_bounds__(NTHREADS, 2) mk_fwd(Args args) {
    extern __shared__ __attribute__((aligned(16))) unsigned char lds_raw[];
    LAS unsigned char* lds = (LAS unsigned char*)lds_raw;
    volatile LAS unsigned* MISC = (volatile LAS unsigned*)(lds + MISC_OFF);
    const int tid = threadIdx.x, lane = tid & 63, wave = __builtin_amdgcn_readfirstlane(tid >> 6);
    const int G = gridDim.x, bx = blockIdx.x;
    const int vcu = (G % 8 == 0) ? (bx % 8) * (G / 8) + bx / 8 : bx;
    const int gw = vcu * NWAVES + wave, NGW = G * NWAVES;
    gu32* ctl = (gu32*)(ws + WS_CTL);
    for (int u = tid; u < (LDS_BYTES - LDSCTL_OFF) / 4; u += NTHREADS) ((LAS unsigned*)(lds + LDSCTL_OFF))[u] = 0u;
    __syncthreads();
    if (tid == 0) {
#define PUTIN(k) *(LAS unsigned long long*)(lds + INPTAB_OFF + 8 * (k)) = (unsigned long long)args.in[k]
        PUTIN(0); PUTIN(1); PUTIN(2); PUTIN(3); PUTIN(4); PUTIN(5); PUTIN(6); PUTIN(7); PUTIN(8); PUTIN(9); PUTIN(10); PUTIN(11); PUTIN(12); PUTIN(13); PUTIN(14); PUTIN(15);
        PUTIN(16); PUTIN(17); PUTIN(18); PUTIN(19); PUTIN(20); PUTIN(21); PUTIN(22);
#undef PUTIN
    }
    __syncthreads();
    XcdBarrier bar = xcd_barrier_post((unsigned*)(ctl + CW_BAR), MISC + 8);
    if (tid == 0) { const unsigned xme = xb_xcc_id(); MISC[13] = xme; MISC[12] = __hip_atomic_fetch_add((unsigned*)(ctl + CW_XC + 64 * xme), 1u, __ATOMIC_RELAXED, __HIP_MEMORY_SCOPE_AGENT); }
    const int lo = args.ph_lo, hi = args.ph_hi;
#define IN(k) (lo <= (k) && (k) < hi)
#define SEAM(k) do { if (IN(k) && IN((k) + 1)) xcd_barrier(bar); } while (0)
#ifndef REPEAT_PHASE
#define REPEAT_PHASE -1
#endif
#ifndef REPEAT_N
#define REPEAT_N 2
#endif
#define REP(k) for (int rep_ = 0; rep_ < (REPEAT_PHASE == (k) ? REPEAT_N : 1); ++rep_)


    if (IN(P_PRO)) {
        LAS float* scr = (LAS float*)(lds + wave * 16384);
        constexpr int KB16 = D / 64;
        constexpr int I_WA = (WA_ROWS / 32) * KB16, I_WO = (D / 32) * KB16, I_WG = (WG_ROWS / 32) * KB16, I_WGO = (D / 32) * KB16, I_WPQ = 2 * (PEER_N / 32) * KB16;
        constexpr int NITEMS = I_WA + I_WO + I_WG + I_WGO + I_WPQ;
        for (int it = gw; it < NITEMS; it += NGW) {
            int r = it;
            if (r < I_WA) { const int nb = r / KB16, kb = r % KB16, d0 = nb * 32; const int nv = ATT_N - d0 < 0 ? 0 : (ATT_N - d0 > 32 ? 32 : ATT_N - d0);
                p0_transpose_item(attn_w_in, ATT_N, D, Wa, d0, d0, nv, kb * 64, scr, lane); continue; } r -= I_WA;
            if (r < I_WO) { const int nb = r / KB16, kb = r % KB16; p0_transpose_item(attn_w_out, D, D, Wo, nb * 32, nb * 32, 32, kb * 64, scr, lane); continue; } r -= I_WO;
            if (r < I_WG) { const int nb = r / KB16, kb = r % KB16, d0 = nb * 32; int s0, nv;
                if (d0 < GN_R) { s0 = d0; nv = 32; } else if (d0 < GN_GD) { s0 = GR + (d0 - GN_R); nv = 32; } else if (d0 == GN_GD) { s0 = GGD; nv = 16; } else { s0 = 0; nv = 0; }
                p0_transpose_item(gla_w_in, GLA_N, D, Wg, d0, s0, nv, kb * 64, scr, lane); continue; } r -= I_WG;
            if (r < I_WGO) { const int nb = r / KB16, kb = r % KB16; p0_transpose_item(gla_w_out, D, D, Wgo, nb * 32, nb * 32, 32, kb * 64, scr, lane); continue; } r -= I_WGO;
            { const int l = r / ((PEER_N / 32) * KB16), rr = r % ((PEER_N / 32) * KB16), nb = rr / KB16, kb = rr % KB16;
              p0_transpose_item(peer_w_q + (size_t)l * D * PEER_N, PEER_N, D, Wpq + (size_t)l * PEER_N * D, nb * 32, nb * 32, 32, kb * 64, scr, lane); }
        }
        p0_convert(x_prompt, Xb, (size_t)TP * D / 8, gw, NGW, lane);
        p0_convert(x_sample, Xb + (size_t)TP * D, (size_t)TS * D / 8, gw, NGW, lane);
        p0_convert(peer_keys1, PK, (size_t)2 * 128 * 128 / 8, gw, NGW, lane);
        p0_convert(peer_keys2, PK + 2 * 128 * 128, (size_t)2 * 128 * 128 / 8, gw, NGW, lane);
    }
    SEAM(P_PRO);

    if (IN(P_AIN)) {
        FAttnIn F{Qb, Kb, Vb, QIb, KIb, WIf, args.out};
        { pg8::Gemm g{Xb, Wa, TP, 2048, D}; pg8::StaticOrder S; S.init(TP, 2048, G, bx);
          pg8::EpiRow8<FAttnIn> E{F};
          pg8::gemm_phase<pg8::EpiRow8<FAttnIn>, pg8::StaticOrder, true, true>(lds, g, S, E);
          float km = E.f.kmax, vm = E.f.vmax;
#pragma unroll
          for (int o = 1; o < 64; o <<= 1) { km = fmaxf(km, __shfl_xor(km, o)); vm = fmaxf(vm, __shfl_xor(vm, o)); }
          if (lane == 0) { if (km > 0.f) atomicMax((unsigned*)(ctl + CW_AMAXK), __builtin_bit_cast(unsigned, km)); if (vm > 0.f) atomicMax((unsigned*)(ctl + CW_AMAXV), __builtin_bit_cast(unsigned, vm)); } }
        for (int it = gw; it < TP / 16 + 8 * 34; it += NGW) {
            if (it < TP / 16) {
                f32x4 acc[5]; skinny_tile<5>(Xb, D, Wa, D, it * 16, 2048, acc, lane);
#pragma unroll
                for (int ct = 0; ct < 5; ++ct) F.put4(it * 16 + (lane & 15), 2048 + ct * 16 + 4 * (lane >> 4), acc[ct]);
            } else {
                const int r = it - TP / 16, rt = r % 8, cg = r / 8;
                f32x4 acc[4]; skinny_tile<4>(Xb, D, Wa, D, TP + rt * 16, cg * 64, acc, lane);
#pragma unroll
                for (int ct = 0; ct < 4; ++ct) F.put4(TP + rt * 16 + (lane & 15), cg * 64 + ct * 16 + 4 * (lane >> 4), acc[ct]);
            }
        }
    }
    SEAM(P_AIN);

            if (IN(P_SCORE)) { kv8_convert(Kb, Vb, KV8, (const unsigned*)(ctl + CW_AMAXK), (const unsigned*)(ctl + CW_AMAXV), gw, NGW, lane);
        phase_score(QIb, KIb, WIf, INP(4), args.page_table, SC, SCS, QuantTabs{peer_u, peer_v, Uq, Vq, Usc, Vsc}, lds, vcu, G, wave, lane, gw, NGW); }
    SEAM(P_SCORE);
    if (IN(P_TOPK)) {
        const int jlo_ = 0, jhi_ = TA;
        phase_topk2(SC, SCS, IDX, CNT, peer_u, peer_v, Uq, Vq, Usc, Vsc, lds, (unsigned*)(ctl + CW_Q1), wave, lane, gw, NGW, jlo_, jhi_); }
    SEAM(P_TOPK);
    if (IN(P_ATTN)) {
        LAS unsigned char* wl = lds + wave * 16384;
        {
            if (tid == 0) { unsigned np = 0, mi = 0, mycnt = 1; const unsigned xme = MISC[13];
                for (unsigned j = 0; j < 16; ++j) { const unsigned c = __hip_atomic_load((unsigned*)(ctl + CW_XC + 64 * j), __ATOMIC_RELAXED, __HIP_MEMORY_SCOPE_AGENT); if (c > 0u) { if (j < xme) ++mi; ++np; } if (j == xme) mycnt = c > 0u ? c : 1u; }
                MISC[14] = np > 0u ? np : 1u; MISC[15] = mi; MISC[16] = mycnt; }
            __syncthreads();
            const int np = (int)MISC[14], mi = (int)MISC[15], mycnt = (int)MISC[16], rank = (int)MISC[12];
            for (int u = 0; u < NBATCH * 4; ++u) if (u % np == mi) attn_prompt_stream(u >> 2, u & 3, rank * NWAVES + wave, mycnt * NWAVES, Qb, IDX, KV8, (const unsigned*)(ctl + CW_AMAXK), (const unsigned*)(ctl + CW_AMAXV), Ob, wl, lane);
        }
        {
            const float* ck_ = INP(2); const float* cv_ = INP(3); float* o_ = args.out; const int* pt_ = args.page_table; int gws_ = gw; int lane_s = lane;
            asm volatile("" : "+s"(ck_), "+s"(cv_), "+s"(o_), "+s"(pt_), "+s"(gws_), "+v"(lane_s));
            for (int su = gws_; su < TS * 4 * 4; su += NGW) {
                if ((su & 3) == 0) { const int un = su >> 2, r = un >> 2, n = un & 3; attn_row<true>(TP + r, n, n + 1, Qb, IDX, CNT, nullptr, nullptr, ck_, cv_, o_ + OUT_KS, o_ + OUT_VS, pt_, Ob, wl, lane_s); }
            }
        }
    }
    SEAM(P_ATTN);
    if (IN(P_AOUT)) {
        FResid F{x_prompt, x_sample, Z};
        { pg8::Gemm g{Ob, Wo, TP, D, D}; pg8::StaticOrder S; S.init(TP, D, G, bx);
          pg8::EpiRow8<FResid> E{F};
          pg8::gemm_phase<pg8::EpiRow8<FResid>, pg8::StaticOrder, true, true>(lds, g, S, E); }
        for (int it = gw; it < 8 * 16; it += NGW) {
            const int rt = it % 8, cg = it / 8;
            f32x4 acc[4]; skinny_tile<4>(Ob, D, Wo, D, TP + rt * 16, cg * 64, acc, lane);
#pragma unroll
            for (int ct = 0; ct < 4; ++ct) F.put4(TP + rt * 16 + (lane & 15), cg * 64 + ct * 16 + 4 * (lane >> 4), acc[ct]);
        }
    }
    SEAM(P_AOUT);
    if (IN(P_LN1)) { for (int r = gw; r < TA; r += NGW) ln_row_wave(Z + (size_t)r * D, INP(19), INP(20), (float*)nullptr, H1b + (size_t)r * D, lane); }
    SEAM(P_LN1);

        if (IN(P_PQ0)) {
        FStoreBf16 F{PQb, PEER_N};
        { pg8::Gemm g{H1b, Wpq, TP, PEER_N, D}; pg8::StaticOrder S; S.init(TP, PEER_N, G, bx);
          pg8::EpiRow8<FStoreBf16> E{F};
          pg8::gemm_phase<pg8::EpiRow8<FStoreBf16>, pg8::StaticOrder, true, true>(lds, g, S, E); }
        for (int it = gw; it < 8 * 32; it += NGW) {
            const int rt = it % 8, cg = it / 8;
            f32x4 acc[4]; skinny_tile<4>(H1b, D, Wpq, D, TP + rt * 16, cg * 64, acc, lane);
#pragma unroll
            for (int ct = 0; ct < 4; ++ct) F.put4(TP + rt * 16 + (lane & 15), cg * 64 + ct * 16 + 4 * (lane >> 4), acc[ct]);
        }
#if 0
        for (int it = gw; it < 8 * 16; it += NGW) {
            const int rt = it % 8, cg = it / 8;
            f32x4 acc[8]; skinny_tile<8>(H1b, D, Wpq, D, TP + rt * 16, cg * 128, acc, lane);
#pragma unroll
            for (int ct = 0; ct < 8; ++ct) F.put4(TP + rt * 16 + (lane & 15), cg * 128 + ct * 16 + 4 * (lane >> 4), acc[ct]);
        }
#endif
    }
    SEAM(P_PQ0);
        if (IN(P_PEER0)) {
        phase_peer_select(PQb, PK, PK + 2 * 16384, TEID, TGATE, lds, vcu, G, wave, lane);
        xcd_barrier(bar);
#if defined(U_SLICED)
        PEER_USLICE(H1b, Uq, Usc);
        xcd_barrier(bar);
        phase_peer_mixv(Z, INP(19), INP(20), TEID, TGATE, HDB, Vq, Usc, Vsc, INP(21), INP(22), H2f, H2b, gw, NGW, lane);
#else
#if defined(MIX_FROM_Z)
        phase_peer_mix(Z, INP(19), INP(20), TEID, TGATE, Uq, Vq, Usc, Vsc, INP(21), INP(22), H2f, H2b, gw, NGW, lane);
#else
        MIXSEL(H1f, TEID, TGATE, Uq, Vq, Usc, Vsc, INP(21), INP(22), H2f, H2b, lds, wave, gw, NGW, lane);
#endif
#endif
    }
    SEAM(P_PEER0);

            if (IN(P_GIN)) {
        FGlaIn F{Gq, Gk, Gv, Gr, GD};
        { pg8::Gemm g{H2b, Wg, TP, 3072, D}; pg8::StaticOrder S; S.init(TP, 3072, G, bx);
          pg8::EpiRow8<FGlaIn> E{F};
          pg8::gemm_phase<pg8::EpiRow8<FGlaIn>, pg8::StaticOrder, true, true>(lds, g, S, E); }
        for (int it = gw; it < TP / 16 + 8 * 97; it += NGW) {
            if (it < TP / 16) {
                f32x4 acc[1]; skinny_tile<1>(H2b, D, Wg, D, it * 16, GN_GD, acc, lane);
                F.put4(it * 16 + (lane & 15), GN_GD + 4 * (lane >> 4), acc[0]);
            } else {
                const int r = it - TP / 16, rt = r % 8, cg = r / 8;
                f32x4 acc[2]; skinny_tile<2>(H2b, D, Wg, D, TP + rt * 16, cg * 32, acc, lane);
#pragma unroll
                for (int ct = 0; ct < 2; ++ct) F.put4(TP + rt * 16 + (lane & 15), cg * 32 + ct * 16 + 4 * (lane >> 4), acc[ct]);
            }
        }
    }
    SEAM(P_GIN);
    if (IN(P_GCH)) {
        for (int it = vcu; it < NBATCH * (SEQ / 64) * 4; it += G) gla_chunk_item(it, Gq, Gk, Gv, GD, INP(10), INP(11), QT, KT, DEC, DSb, lds, tid, wave, lane);
        for (int it = vcu; it < DB * 4; it += G) gla_sample_item(it, Gq, Gk, Gv, Gr, GD, INP(10), INP(11), INP(12), INP(5), args.out + OUT_SS, OGb, lds, tid, lane);
    }
    SEAM(P_GCH);
    if (IN(P_GSC)) gla_scan(DSb, DEC, SPV, args.out + OUT_SP, vcu * NTHREADS + tid, G * NTHREADS);
    SEAM(P_GSC);
    if (IN(P_GOUT)) { for (int it = vcu; it < NBATCH * (SEQ / 64) * 4; it += G) gla_out_item(it, QT, KT, Gv, Gr, SPV, INP(12), OGb, lds, tid, wave, lane); }
    SEAM(P_GOUT);
    if (IN(P_GPRJ)) {
        FResid F{H2f, H2f + (size_t)TP * D, Z};
        { pg8::Gemm g{OGb, Wgo, TP, D, D}; pg8::StaticOrder S; S.init(TP, D, G, bx);
          pg8::EpiRow8<FResid> E{F};
          pg8::gemm_phase<pg8::EpiRow8<FResid>, pg8::StaticOrder, true, true>(lds, g, S, E); }
        for (int it = gw; it < 8 * 16; it += NGW) {
            const int rt = it % 8, cg = it / 8;
            f32x4 acc[4]; skinny_tile<4>(OGb, D, Wgo, D, TP + rt * 16, cg * 64, acc, lane);
#pragma unroll
            for (int ct = 0; ct < 4; ++ct) F.put4(TP + rt * 16 + (lane & 15), cg * 64 + ct * 16 + 4 * (lane >> 4), acc[ct]);
        }
    }
    SEAM(P_GPRJ);
    if (IN(P_LN1B)) { for (int r = gw; r < TA; r += NGW) ln_row_wave(Z + (size_t)r * D, INP(19) + D, INP(20) + D, (float*)nullptr, H1b + (size_t)r * D, lane); }
    SEAM(P_LN1B);
    if (IN(P_PQ1)) {
        FStoreBf16 F{PQb, PEER_N}; const bf16* W1 = Wpq + (size_t)PEER_N * D;
        { pg8::Gemm g{H1b, W1, TP, PEER_N, D}; pg8::StaticOrder S; S.init(TP, PEER_N, G, bx);
          pg8::EpiRow8<FStoreBf16> E{F};
          pg8::gemm_phase<pg8::EpiRow8<FStoreBf16>, pg8::StaticOrder, true, true>(lds, g, S, E); }
        for (int it = gw; it < 8 * 32; it += NGW) {
            const int rt = it % 8, cg = it / 8;
            f32x4 acc[4]; skinny_tile<4>(H1b, D, W1, D, TP + rt * 16, cg * 64, acc, lane);
#pragma unroll
            for (int ct = 0; ct < 4; ++ct) F.put4(TP + rt * 16 + (lane & 15), cg * 64 + ct * 16 + 4 * (lane >> 4), acc[ct]);
        }
    }
    SEAM(P_PQ1);
    if (IN(P_PEER1)) {
        phase_peer_select(PQb, PK + 16384, PK + 3 * 16384, TEID, TGATE, lds, vcu, G, wave, lane);
        xcd_barrier(bar);
#if defined(U_SLICED)
        PEER_USLICE(H1b, Uq + (size_t)16384 * D, Usc + 16384);
        xcd_barrier(bar);
        phase_peer_mixv(Z, INP(19) + D, INP(20) + D, TEID, TGATE, HDB, Vq + (size_t)16384 * D, Usc + 16384, Vsc + 16384, INP(21) + D, INP(22) + D, args.out + OUT_Y, nullptr, gw, NGW, lane);
#else
#if defined(MIX_FROM_Z)
        phase_peer_mix(Z, INP(19) + D, INP(20) + D, TEID, TGATE, Uq + (size_t)16384 * D, Vq + (size_t)16384 * D, Usc + 16384, Vsc + 16384, INP(21) + D, INP(22) + D, args.out + OUT_Y, nullptr, gw, NGW, lane);
#else
        MIXSEL(H1f, TEID, TGATE, Uq + (size_t)16384 * D, Vq + (size_t)16384 * D, Usc + 16384, Vsc + 16384, INP(21) + D, INP(22) + D, args.out + OUT_Y, nullptr, lds, wave, gw, NGW, lane);
#endif
#endif
    }
#undef IN
#undef SEAM
}
#undef ws
#undef INP
#undef Wa
#undef Wo
#undef Wg
#undef Wgo
#undef Wpq
#undef PK
#undef Usc
#undef Xb
#undef Qb
#undef QIb
#undef Kb
#undef Vb
#undef KIb
#undef WIf
#undef SC
#undef SCS
#undef IDX
#undef CNT
#undef Ob
#undef Z
#undef H1f
#undef H1b
#undef PQb
#undef H2f
#undef H2b
#undef TEID
#undef TGATE
#undef Gq
#undef Gk
#undef Gv
#undef Gr
#undef GD
#undef QT
#undef KT
#undef DEC
#undef DSb
#undef SPV
#undef OGb
#undef Uq
#undef HDB
#undef KV8
#undef Vq
#undef Usc
#undef Vsc
#undef x_prompt
#undef x_sample
#undef attn_w_in
#undef attn_w_out
#undef gla_w_in
#undef gla_w_out
#undef peer_w_q
#undef peer_keys1
#undef peer_keys2
#undef peer_u
#undef peer_v


}

extern "C" void kernel_launch(void* const* d_in, const int* in_sizes, int n_in, void* d_out, int out_size, void* d_ws, size_t ws_size, hipStream_t stream) {
    if (ws_size < mk::WS_END || n_in != 23 || (size_t)out_size != OUT_TOTAL) { fprintf(stderr, "kernel_launch: unexpected sizes ws %zu n_in %d out %d\n", ws_size, n_in, out_size); return; }
    static int grid = 0;
    if (grid == 0) {
        int dev = 0, cus = 0;
        if (hipGetDevice(&dev) != hipSuccess || hipDeviceGetAttribute(&cus, hipDeviceAttributeMultiprocessorCount, dev) != hipSuccess) { fprintf(stderr, "kernel_launch: device query failed\n"); grid = -1; return; }
        if (hipFuncSetAttribute((const void*)mk::mk_fwd, hipFuncAttributeMaxDynamicSharedMemorySize, mk::LDS_BYTES) != hipSuccess) { fprintf(stderr, "kernel_launch: hipFuncSetAttribute failed\n"); grid = -1; return; }
        int per_cu = 0;
        if (hipOccupancyMaxActiveBlocksPerMultiprocessor(&per_cu, (const void*)mk::mk_fwd, mk::NTHREADS, mk::LDS_BYTES) != hipSuccess || per_cu < 1) fprintf(stderr, "kernel_launch: occupancy query says %d\n", per_cu);
        (void)hipGetLastError();
        grid = cus;
    }
    if (grid < 0) return;
    (void)hipMemsetAsync((char*)d_ws + mk::WS_CTL, 0, mk::CTL_ZERO_BYTES, stream);
    mk::Args a{};
    for (int i = 0; i < 23; ++i) a.in[i] = (const float*)d_in[i];
    a.page_table = (const int*)d_in[6]; a.out = (float*)d_out; a.ws = (unsigned char*)d_ws; a.ph_lo = 0; a.ph_hi = mk::P_COUNT;
    hipLaunchKernelGGL(mk::mk_fwd, dim3(grid), dim3(mk::NTHREADS), mk::LDS_BYTES, stream, a);
}
```

```cpp
#include <hip/hip_runtime.h>
#include <cstdio>
#include <cstdint>
#include <cmath>

constexpr int D = 1024;
constexpr int NBATCH = 2, SEQ = 8192, TP = NBATCH * SEQ;
constexpr int DB = 32, DS = 4, TS = DB * DS;
constexpr int TA = TP + TS;
constexpr int PAST = 8192, PAGE = 128, NPAGES = PAST / PAGE;
constexpr float ALPHA = 1.4142135623730951f;
constexpr float LN_EPS = 1e-5f;
constexpr int ATT_N = 2120;
constexpr int AQ = 0, AK = 1024, AV = 1280, AQI = 1536, AKI = 2048, AWI = 2112;
constexpr int TOPK = 256;
constexpr int GLA_N = 3088;
constexpr int GQ = 0, GK = 512, GV = 1024, GGD = 2048, GR = 2064;
constexpr int PEER_N = 2048;
constexpr int SCS_LD = 8256;

constexpr size_t OUT_Y = 0, OUT_KP = 16908288, OUT_VP = 21102592, OUT_KIP = 25296896, OUT_SP = 26345472,
                 OUT_KS = 26607616, OUT_VS = 26640384, OUT_KIS = 26673152, OUT_SS = 26681344, OUT_TOTAL = 30875648;


namespace pg8 {
#define PG8_LAS __attribute__((address_space(3)))
typedef unsigned short bf16_t;
typedef short bf16x8 __attribute__((ext_vector_type(8)));
typedef float f32x4 __attribute__((ext_vector_type(4)));
typedef unsigned u32x4 __attribute__((ext_vector_type(4)));
constexpr int BM = 256, BK = 64, HALF = 128, HTB = HALF * BK * 2  , STAGE_BYTES = 8 * HTB, NXCD = 8, WGM = 8;

__host__ __device__ __forceinline__ int lds_byte(int r, int c) { const int st = (r >> 4) * 2 + (c >> 5), rr = r & 15, cc = c & 31, ob = rr * 64 + cc * 2; return st * 1024 + (ob ^ (((ob >> 9) & 1) << 5)); }
__host__ __device__ __forceinline__ void stage_rc(int b, int& R, int& C) { const int st = b / 1024, sb = b % 1024, swz = sb ^ (((sb >> 9) & 1) << 5); R = (st >> 1) * 16 + swz / 64; C = (st & 1) * 32 + (swz % 64) / 2; }
__host__ __device__ __forceinline__ int perm32(int rho) { const int n = rho >> 4, i = rho & 15; return 8 * (i >> 2) + 4 * n + (i & 3); }

struct Unit { int pm, pn; };
struct Gemm { const bf16_t* A; const bf16_t* Bt; int M, N, K; };

struct StaticOrder {
    int nM, nN, nwg, G, c;
    __host__ __device__ void init(int M, int N, int G_, int c_) { nM = M / BM; nN = N / BM; nwg = nM * nN; G = G_; c = c_; }
    __host__ __device__ bool next(int i, Unit& u) const {
        const long L = (long)i * G + c; if (L >= nwg) return false;
        int wgid = (int)L; { const int q = nwg / NXCD, r = nwg % NXCD, xcd = wgid % NXCD, off = wgid / NXCD; wgid = (xcd < r ? xcd * (q + 1) : r * (q + 1) + (xcd - r) * q) + off; }
        const int nig = WGM * nN, gid = wgid / nig, fm = gid * WGM, gsz = (nM - fm) < WGM ? (nM - fm) : WGM;
        u.pm = fm + ((wgid % nig) % gsz); u.pn = (wgid % nig) / gsz; return true;
    }
    __device__ __forceinline__ void a_ready(const Unit&) const {}
    __device__ __forceinline__ void done(const Unit&) const {}
};

__device__ __forceinline__ unsigned cvt_pk_bf16(float lo, float hi) { unsigned r; asm volatile("v_cvt_pk_bf16_f32 %0, %1, %2" : "=v"(r) : "v"(lo), "v"(hi)); return r; }
template <class F> struct EpiRow8 {
    static constexpr bool PERM = true, AFTER_DRAIN = false;
    F f;
    __device__ __forceinline__ void operator()(const f32x4 (&acc)[2][2][4][2], const Unit& u, int wr, int wc, int fr, int fq) const {
        const int row0 = u.pm * BM + wr * 64 + fr, col0 = u.pn * BM + wc * 32 + 8 * fq;
#pragma unroll
        for (int ai = 0; ai < 2; ++ai)
#pragma unroll
            for (int m = 0; m < 4; ++m)
#pragma unroll
                for (int bj = 0; bj < 2; ++bj) f.put8(row0 + ai * HALF + m * 16, col0 + bj * HALF, acc[ai][bj][m][0], acc[ai][bj][m][1]);
    }
};


template <class Epi, class Sched, bool ALIGN_EPI = false, bool SP2 = false>
__device__ __forceinline__ void gemm_phase(PG8_LAS unsigned char* lds, const Gemm g, const Sched& S, const Epi& E) {
    const int tid = threadIdx.x, wid = __builtin_amdgcn_readfirstlane(tid >> 6), lane = tid & 63, wr = wid >> 2, wc = wid & 3, fr = lane & 15, fq = lane >> 4;
    const int K = g.K, nt = K / BK;
    unsigned voffA[2], voffB[2];
#pragma unroll
    for (int i = 0; i < 2; ++i) { int R, C; stage_rc(tid * 16 + i * 8192, R, C); const int Rb = Epi::PERM ? ((R & ~31) + perm32(R & 31)) : R;
        voffA[i] = (unsigned)(R * K + C) * 2u; voffB[i] = (unsigned)(Rb * K + C) * 2u; }
    const size_t kstep = (size_t)(BK * 2);
    const size_t hstep = (size_t)HALF * K * 2;
    const size_t tstep = 2 * hstep;
    const unsigned ldsw = (unsigned)wid * 1024u;
    const int aoff = lds_byte(wr * 64 + fr, fq * 8), boff = lds_byte(wc * 32 + fr, fq * 8);
#define PG8_SA(b, h) (((b) * 2 + (h)) * HTB)
#define PG8_SB(b, h) ((4 + (b) * 2 + (h)) * HTB)
#define PG8_STAGE(bufoff, gbase, voff) do { _Pragma("unroll") for (int _i = 0; _i < 2; ++_i) \
        __builtin_amdgcn_global_load_lds((const unsigned*)((const char*)(gbase) + (voff)[_i]), (PG8_LAS unsigned*)(lds + (bufoff) + ldsw + _i * 8192), 16, 0, 0); } while (0)
#define PG8_LDA(dst, b, h) do { _Pragma("unroll") for (int m = 0; m < 4; ++m) _Pragma("unroll") for (int k = 0; k < 2; ++k) dst[m][k] = *(const PG8_LAS bf16x8*)(lds + PG8_SA(b, h) + aoff + m * 2048 + k * 1024); } while (0)
#define PG8_LDB(dst, b, h) do { _Pragma("unroll") for (int n = 0; n < 2; ++n) _Pragma("unroll") for (int k = 0; k < 2; ++k) dst[n][k] = *(const PG8_LAS bf16x8*)(lds + PG8_SB(b, h) + boff + n * 2048 + k * 1024); } while (0)
#define PG8_MMA(ai, bj, At, Bt) do { __builtin_amdgcn_s_setprio(1); _Pragma("unroll") for (int m = 0; m < 4; ++m) _Pragma("unroll") for (int n = 0; n < 2; ++n) _Pragma("unroll") for (int k = 0; k < 2; ++k) \
        acc[ai][bj][m][n] = __builtin_amdgcn_mfma_f32_16x16x32_bf16(Bt[n][k], At[m][k], acc[ai][bj][m][n], 0, 0, 0); __builtin_amdgcn_s_setprio(0); } while (0)
#define PG8_WAIT_V(n) asm volatile("s_waitcnt vmcnt(" #n ")" ::: "memory")
#define PG8_WAIT_L(n) asm volatile("s_waitcnt lgkmcnt(" #n ")" ::: "memory")
#define PG8_BAR __builtin_amdgcn_s_barrier()
#define PG8_SCHED __builtin_amdgcn_sched_barrier(0)
    Unit cur, nxt; int ui = 0;
    if (!S.next(0, cur)) return;
    f32x4 acc[2][2][4][2];
#pragma unroll
    for (int a = 0; a < 2; ++a)
#pragma unroll
        for (int b = 0; b < 2; ++b)
#pragma unroll
            for (int m = 0; m < 4; ++m)
#pragma unroll
                for (int n = 0; n < 2; ++n) acc[a][b][m][n] = (f32x4){0.f, 0.f, 0.f, 0.f};
    bf16x8 At[4][2], B0[2][2], B1[2][2];
    const char* cA = (const char*)g.A + (size_t)cur.pm * tstep; const char* cB = (const char*)g.Bt + (size_t)cur.pn * tstep;
    S.a_ready(cur);
    if constexpr (SP2) {
        PG8_STAGE(PG8_SB(0, 0), cB, voffB); PG8_STAGE(PG8_SB(0, 1), cB + hstep, voffB); PG8_STAGE(PG8_SA(0, 0), cA, voffA); PG8_STAGE(PG8_SA(0, 1), cA + hstep, voffA);
        if (wr == 1) PG8_BAR;
        PG8_WAIT_V(2); PG8_BAR;
        PG8_STAGE(PG8_SB(1, 0), cB + kstep, voffB); PG8_STAGE(PG8_SA(1, 0), cA + kstep, voffA); PG8_STAGE(PG8_SB(1, 1), cB + hstep + kstep, voffB);
        PG8_WAIT_V(6); PG8_BAR;
    } else {
        PG8_STAGE(PG8_SB(0, 0), cB, voffB); PG8_STAGE(PG8_SA(0, 0), cA, voffA); PG8_STAGE(PG8_SB(0, 1), cB + hstep, voffB); PG8_STAGE(PG8_SA(0, 1), cA + hstep, voffA);
        if (wr == 1) PG8_BAR;
        PG8_WAIT_V(4); PG8_BAR;
        PG8_STAGE(PG8_SB(1, 0), cB + kstep, voffB); PG8_STAGE(PG8_SA(1, 0), cA + kstep, voffA); PG8_STAGE(PG8_SB(1, 1), cB + hstep + kstep, voffB);
        PG8_WAIT_V(6); PG8_BAR;
    }
    for (;;) {
        const bool has_next = S.next(ui + 1, nxt);
        const char* nA = has_next ? (const char*)g.A + (size_t)nxt.pm * tstep : cA; const char* nB = has_next ? (const char*)g.Bt + (size_t)nxt.pn * tstep : cB;
        for (int t = 0; t < nt; t += 2) {
            const bool last = (t == nt - 2);
            const char* a1 = cA + (size_t)(t + 1) * kstep;
            const char* a2 = last ? nA : cA + (size_t)(t + 2) * kstep; const char* b2 = last ? nB : cB + (size_t)(t + 2) * kstep;
            const char* a3 = a2 + kstep; const char* b3 = b2 + kstep;
            if (last && has_next) S.a_ready(nxt);
            if constexpr (SP2) {
            PG8_LDB(B0, 0, 0); PG8_LDB(B1, 0, 1); PG8_SCHED; PG8_LDA(At, 0, 0); PG8_STAGE(PG8_SA(1, 1), a1 + hstep, voffA);
            PG8_WAIT_V(8); PG8_WAIT_L(0); PG8_BAR; PG8_MMA(0, 0, At, B0); PG8_MMA(0, 1, At, B1); PG8_BAR; PG8_SCHED;
            PG8_LDA(At, 0, 1); PG8_STAGE(PG8_SB(0, 0), b2, voffB); PG8_STAGE(PG8_SB(0, 1), b2 + hstep, voffB); PG8_STAGE(PG8_SA(0, 0), a2, voffA);
            PG8_WAIT_V(8); PG8_WAIT_L(0); PG8_BAR; PG8_MMA(1, 0, At, B0); PG8_MMA(1, 1, At, B1); PG8_BAR; PG8_SCHED;
            PG8_LDB(B0, 1, 0); PG8_LDB(B1, 1, 1); PG8_SCHED; PG8_LDA(At, 1, 0); PG8_STAGE(PG8_SA(0, 1), a2 + hstep, voffA);
            PG8_WAIT_V(8); PG8_WAIT_L(0); PG8_BAR; PG8_MMA(0, 0, At, B0); PG8_MMA(0, 1, At, B1); PG8_BAR; PG8_SCHED;
            PG8_LDA(At, 1, 1); PG8_STAGE(PG8_SB(1, 0), b3, voffB); PG8_STAGE(PG8_SB(1, 1), b3 + hstep, voffB); PG8_STAGE(PG8_SA(1, 0), a3, voffA);
            PG8_WAIT_V(8); PG8_WAIT_L(0); PG8_BAR; PG8_MMA(1, 0, At, B0); PG8_MMA(1, 1, At, B1); PG8_BAR; PG8_SCHED;
            } else {
            PG8_LDB(B0, 0, 0); PG8_SCHED; PG8_LDA(At, 0, 0); PG8_STAGE(PG8_SA(1, 1), a1 + hstep, voffA);
            PG8_WAIT_L(8); PG8_BAR; PG8_WAIT_L(0); PG8_MMA(0, 0, At, B0); PG8_BAR; PG8_SCHED;
            PG8_LDB(B1, 0, 1); PG8_STAGE(PG8_SB(0, 0), b2, voffB);
            PG8_BAR; PG8_WAIT_L(0); PG8_MMA(0, 1, At, B1); PG8_BAR;
            PG8_LDA(At, 0, 1); PG8_STAGE(PG8_SA(0, 0), a2, voffA);
            PG8_BAR; PG8_WAIT_L(0); PG8_MMA(1, 0, At, B0); PG8_BAR; PG8_SCHED;
            PG8_STAGE(PG8_SB(0, 1), b2 + hstep, voffB);
            PG8_WAIT_V(6); PG8_BAR; PG8_MMA(1, 1, At, B1); PG8_BAR;
            PG8_LDB(B0, 1, 0); PG8_SCHED; PG8_LDA(At, 1, 0); PG8_STAGE(PG8_SA(0, 1), a2 + hstep, voffA);
            PG8_WAIT_L(8); PG8_BAR; PG8_WAIT_L(0); PG8_MMA(0, 0, At, B0); PG8_BAR; PG8_SCHED;
            PG8_LDB(B1, 1, 1); PG8_STAGE(PG8_SB(1, 0), b3, voffB);
            PG8_BAR; PG8_WAIT_L(0); PG8_MMA(0, 1, At, B1); PG8_BAR;
            PG8_LDA(At, 1, 1); PG8_STAGE(PG8_SA(1, 0), a3, voffA);
            PG8_BAR; PG8_WAIT_L(0); PG8_MMA(1, 0, At, B0); PG8_BAR; PG8_SCHED;
            PG8_STAGE(PG8_SB(1, 1), b3 + hstep, voffB);
            PG8_WAIT_V(6); PG8_BAR; PG8_MMA(1, 1, At, B1); PG8_BAR;
            }
        }
        if constexpr (ALIGN_EPI) { if (wr == 0) PG8_BAR; }
        if constexpr (!Epi::AFTER_DRAIN) { E(acc, cur, wr, wc, fr, fq); S.done(cur); }
        if (!has_next) break;
#pragma unroll
        for (int a = 0; a < 2; ++a)
#pragma unroll
            for (int b = 0; b < 2; ++b)
#pragma unroll
                for (int m = 0; m < 4; ++m)
#pragma unroll
                    for (int n = 0; n < 2; ++n) acc[a][b][m][n] = (f32x4){0.f, 0.f, 0.f, 0.f};
        cur = nxt; cA = nA; cB = nB; ++ui;
        if constexpr (ALIGN_EPI) { if (wr == 1) PG8_BAR; }
    }
    PG8_WAIT_V(0);
    if constexpr (!ALIGN_EPI) { if (wr == 0) PG8_BAR; }
    PG8_BAR;
    if constexpr (Epi::AFTER_DRAIN) { E.fused(acc, cur, wr, wc, fr, fq, lds, wid, lane); S.done(cur); }
#undef PG8_SA
#undef PG8_SB
#undef PG8_STAGE
#undef PG8_LDA
#undef PG8_LDB
#undef PG8_MMA
#undef PG8_WAIT_V
#undef PG8_WAIT_L
#undef PG8_BAR
#undef PG8_SCHED
}
}

namespace mk {
#define GAS __attribute__((address_space(1)))
#define LAS __attribute__((address_space(3)))
typedef unsigned short bf16;
typedef unsigned v4u __attribute__((ext_vector_type(4)));
typedef float f32x4 __attribute__((ext_vector_type(4)));
typedef short bf16x8 __attribute__((ext_vector_type(8)));
typedef GAS unsigned gu32;
typedef GAS unsigned long long gu64;
#define RLX_AGENT __ATOMIC_RELAXED, __HIP_MEMORY_SCOPE_AGENT
#define LDS_WAIT() asm volatile("s_waitcnt lgkmcnt(0)" ::: "memory")
#define VM_WAIT() asm volatile("s_waitcnt vmcnt(0)" ::: "memory")
__device__ __forceinline__ unsigned long long rt() { return __builtin_amdgcn_s_memrealtime(); }
__device__ __forceinline__ unsigned f2bf(float f) { unsigned u = __builtin_bit_cast(unsigned, f); return (u + 0x7fffu + ((u >> 16) & 1u)) >> 16; }
__device__ __forceinline__ unsigned pk2(float lo, float hi) {
    typedef __bf16 bf2_t __attribute__((ext_vector_type(2))); typedef float f2_t __attribute__((ext_vector_type(2)));
    const f2_t v = {lo, hi}; const bf2_t b = __builtin_convertvector(v, bf2_t); return __builtin_bit_cast(unsigned, b); }

#define XB_TMO      128
#define XB_XCNT(j)  (256  + 64 * (j))
#define XB_XSUB(j)  (1280 + 64 * (j))
#define XB_XGEN(j)  (2304 + 64 * (j))
#define XB_TOP      3328
#define XB_TOPGEN   3392
#define XCD_BAR_WORDS 3456
#define XB_SPIN_CAP (1u << 18)

__device__ __forceinline__ unsigned xb_ld(unsigned* p)              { return __hip_atomic_load(p, __ATOMIC_RELAXED, __HIP_MEMORY_SCOPE_AGENT); }
__device__ __forceinline__ unsigned xb_add(unsigned* p, unsigned v) { return __hip_atomic_fetch_add(p, v, __ATOMIC_RELAXED, __HIP_MEMORY_SCOPE_AGENT); }
__device__ __forceinline__ unsigned xb_xcc_id() { return (unsigned)__builtin_amdgcn_s_getreg((3 << 11) | 20) & 0xFu; }
#define XB_SPIN(cond, bar) do { unsigned _sp = 0; while (cond) { __builtin_amdgcn_s_sleep(1); \
    if ((++_sp & 255u) == 0u) { if (xb_ld(&(bar)[XB_TMO])) break; if (_sp > XB_SPIN_CAP) { atomicAdd(&(bar)[XB_TMO], 1u); break; } } } } while (0)

struct XcdBarrier {
    unsigned* bar; unsigned x;
    volatile LAS unsigned* st;
};

__device__ __forceinline__ XcdBarrier xcd_barrier_post(unsigned* bar, volatile LAS unsigned* st) {
    XcdBarrier b; b.bar = bar; b.x = xb_xcc_id(); b.st = st;
    if (threadIdx.x == 0) (void)xb_add(&bar[XB_XCNT(b.x)], 1u);
    return b;
}
__device__ __forceinline__ void xcd_barrier_complete(unsigned* bar, unsigned x, unsigned& nloc, unsigned& nx) {
    const unsigned G = gridDim.x * gridDim.y * gridDim.z;
    unsigned sum, cnt, mine, sp = 0u;
    for (;;) {
        sum = 0u; cnt = 0u; mine = 0u;
#pragma unroll
        for (unsigned j = 0; j < 16; ++j) { const unsigned c = xb_ld(&bar[XB_XCNT(j)]); sum += c; cnt += (c > 0u) ? 1u : 0u; mine = (j == x) ? c : mine; }
        if (sum == G) break;
        __builtin_amdgcn_s_sleep(1);
        if ((++sp & 255u) == 0u) { if (xb_ld(&bar[XB_TMO])) break; if (sp > XB_SPIN_CAP) { atomicAdd(&bar[XB_TMO], 1u); break; } }
    }
    nloc = mine > 0u ? mine : 1u; nx = cnt > 0u ? cnt : 1u;
}

__device__ __forceinline__ void xcd_barrier(const XcdBarrier& b) {
    asm volatile("s_waitcnt vmcnt(0)" ::: "memory");
    __syncthreads();
    if (threadIdx.x == 0) {
        unsigned* bar = b.bar;
        __builtin_amdgcn_s_waitcnt(0);
        unsigned nloc = b.st[0], nx = b.st[1];
        if (nloc == 0u) { xcd_barrier_complete(bar, b.x, nloc, nx); b.st[0] = nloc; b.st[1] = nx; }
        const unsigned old = xb_add(&bar[XB_XSUB(b.x)], 1u);
        const unsigned gen = old / nloc;
        if (old + 1u == (gen + 1u) * nloc) {
            __builtin_amdgcn_fence(__ATOMIC_RELEASE, "agent");
            asm volatile("s_waitcnt vmcnt(0)" ::: "memory");
            const unsigned og = xb_add(&bar[XB_TOP], 1u);
            const unsigned tg = og / nx;
            if (og + 1u == (tg + 1u) * nx) xb_add(&bar[XB_TOPGEN], 1u);
            else XB_SPIN(xb_ld(&bar[XB_TOPGEN]) == tg, bar);
            __builtin_amdgcn_fence(__ATOMIC_ACQUIRE, "agent");
            xb_add(&bar[XB_XGEN(b.x)], 1u);
            asm volatile("s_waitcnt vmcnt(0)" ::: "memory");
        } else {
            XB_SPIN(xb_ld(&bar[XB_XGEN(b.x)]) == gen, bar);
            __builtin_amdgcn_fence(__ATOMIC_ACQUIRE, "agent");
            asm volatile("s_waitcnt vmcnt(0)" ::: "memory");
        }
    }
    __syncthreads();
}

}

namespace mk {
constexpr int NWAVES = 8, NTHREADS = 512;
constexpr size_t MiB = 1u << 20;
constexpr size_t WS_QIB = 325 * MiB, WS_KB = 342 * MiB, WS_VB = 351 * MiB, WS_KIB = 360 * MiB, WS_WIF = 363 * MiB;
constexpr size_t WS_OB = 390 * MiB, WS_GD = 423 * MiB;
constexpr size_t WS_IDX = 525 * MiB, WS_CNT = 542 * MiB, WS_SCS = 543 * MiB;
constexpr size_t WS_S = 548 * MiB;
constexpr size_t WS_SC = WS_S;
constexpr size_t WS_Z = WS_S, WS_H1F = WS_S + 65 * MiB, WS_H1B = WS_S + 130 * MiB, WS_PQB = WS_S + 163 * MiB, WS_H2F = WS_S + 228 * MiB, WS_H2B = WS_S + 293 * MiB;
constexpr size_t WS_GQ = WS_S + 326 * MiB, WS_GK = WS_S + 343 * MiB, WS_GV = WS_S + 360 * MiB, WS_GR = WS_S + 393 * MiB, WS_QT = WS_S + 426 * MiB, WS_DEC = WS_S + 442 * MiB,
                 WS_OGB = WS_S + 443 * MiB, WS_KT = WS_S + 476 * MiB;
constexpr size_t WS_DS = WS_S, WS_SPREV = WS_S + 128 * MiB;
constexpr size_t WS_CTL = 1060 * MiB, WS_WA = 1061 * MiB, WS_WO = 1066 * MiB, WS_WG = 1068 * MiB, WS_WGO = 1075 * MiB, WS_WPQ = 1077 * MiB, WS_PK = 1085 * MiB,
                 WS_UB = 1086 * MiB, WS_VBX = 1150 * MiB, WS_USC = 1118 * MiB, WS_TEID = 1120 * MiB, WS_TGATE = 1125 * MiB, WS_HD = 1134 * MiB, WS_KV8 = 1134 * MiB, WS_XB = 1214 * MiB, WS_QB = 1247 * MiB, WS_END = 1280 * MiB;
constexpr size_t CTL_ZERO_BYTES = 1 * MiB;
constexpr int CW_TMO = 0, CW_AMAXK = 256, CW_AMAXV = 320, CW_Q1 = 512, CW_XC = 1024, CW_BAR = 4096;
constexpr int WA_ROWS = 2176, WG_ROWS = 3104;
constexpr int GN_Q = 0, GN_K = 512, GN_V = 1024, GN_R = 2048, GN_GD = 3072;

constexpr int RING_BYTES = 131072, LDSCTL_OFF = RING_BYTES, MISC_OFF = LDSCTL_OFF + 320, INPTAB_OFF = LDSCTL_OFF + 512, LDS_BYTES = 147456;

typedef unsigned u32x4 __attribute__((ext_vector_type(4)));
typedef unsigned u32x2 __attribute__((ext_vector_type(2)));
#define MK_LAS __attribute__((address_space(3)))
__device__ __forceinline__ float bflo(unsigned w) { return __builtin_bit_cast(float, w << 16); }
__device__ __forceinline__ float bfhi(unsigned w) { return __builtin_bit_cast(float, w & 0xffff0000u); }
__device__ __forceinline__ float bf2f(unsigned short b) { return __builtin_bit_cast(float, (unsigned)b << 16); }
__device__ __forceinline__ u32x4 pack8(f32x4 a, f32x4 b) { u32x4 w; w.x = pk2(a[0], a[1]); w.y = pk2(a[2], a[3]); w.z = pk2(b[0], b[1]); w.w = pk2(b[2], b[3]); return w; }

#define TPB(k)
#define TPE(k)
template <int NCT> __device__ __forceinline__ void skinny_tile(const bf16* __restrict__ A, int lda, const bf16* __restrict__ Bt, int K, int row0, int col0, f32x4 (&acc)[NCT], int lane) {
    const int fr = lane & 15, fq = lane >> 4;
    const bf16* ap = A + (size_t)(row0 + fr) * lda + fq * 8;
    const bf16* bp = Bt + (size_t)(col0 + fr) * K + fq * 8;
#pragma unroll
    for (int ct = 0; ct < NCT; ++ct) acc[ct] = (f32x4){0.f, 0.f, 0.f, 0.f};
#pragma unroll 1
    for (int k0 = 0; k0 < K; k0 += 128) {
        bf16x8 a[4], b[NCT][4];
#pragma unroll
        for (int j = 0; j < 4; ++j) a[j] = *(const bf16x8*)(ap + k0 + j * 32);
#pragma unroll
        for (int ct = 0; ct < NCT; ++ct)
#pragma unroll
            for (int j = 0; j < 4; ++j) b[ct][j] = *(const bf16x8*)(bp + (size_t)ct * 16 * K + k0 + j * 32);
        asm volatile("" ::: "memory");
#pragma unroll
        for (int ct = 0; ct < NCT; ++ct)
#pragma unroll
            for (int j = 0; j < 4; ++j) acc[ct] = __builtin_amdgcn_mfma_f32_16x16x32_bf16(b[ct][j], a[j], acc[ct], 0, 0, 0);
    }
}

__device__ __forceinline__ void p0_transpose_item(const float* __restrict__ W, int ldw, int K, bf16* __restrict__ WT, int dst_row0, int src_col0, int nvalid, int k0, MK_LAS float* scr, int lane) {
#pragma unroll 8
    for (int i = 0; i < 32; ++i) { const int kk = 2 * i + (lane >> 5), j = lane & 31; scr[kk * 33 + j] = j < nvalid ? W[(size_t)(k0 + kk) * ldw + src_col0 + j] : 0.f; }
    asm volatile("s_waitcnt lgkmcnt(0)" ::: "memory");
    const int c = lane & 7;
#pragma unroll
    for (int j = 0; j < 4; ++j) { const int n = (lane >> 3) + 8 * j; const MK_LAS float* s = scr + (8 * c) * 33 + n;
        u32x4 o; o.x = pk2(s[0 * 33], s[1 * 33]); o.y = pk2(s[2 * 33], s[3 * 33]); o.z = pk2(s[4 * 33], s[5 * 33]); o.w = pk2(s[6 * 33], s[7 * 33]);
        *(u32x4*)(WT + (size_t)(dst_row0 + n) * K + k0 + 8 * c) = o; }
    asm volatile("s_waitcnt lgkmcnt(0)" ::: "memory");
}
__device__ __forceinline__ void p0_convert(const float* __restrict__ src, bf16* __restrict__ dst, size_t n8, int gw, int ngw, int lane) {
    for (size_t i = (size_t)gw * 64 + lane; i < n8; i += (size_t)ngw * 64) {
        const f32x4 a = *(const f32x4*)(src + i * 8), b = *(const f32x4*)(src + i * 8 + 4);
        *(u32x4*)(dst + i * 8) = pack8(a, b);
    }
}

__device__ __forceinline__ void p0_quant_row(const float* __restrict__ src, unsigned char* __restrict__ dst, float* __restrict__ scale, int lane) {
    f32x4 v[4]; float am = 0.f;
#pragma unroll
    for (int q = 0; q < 4; ++q) { v[q] = *(const f32x4*)(src + lane * 16 + q * 4); am = fmaxf(am, fmaxf(fmaxf(fabsf(v[q][0]), fabsf(v[q][1])), fmaxf(fabsf(v[q][2]), fabsf(v[q][3])))); }
#pragma unroll
    for (int o = 1; o < 64; o <<= 1) am = fmaxf(am, __shfl_xor(am, o));
    const float inv = am > 0.f ? 448.f / am : 0.f;
    u32x4 w;
#pragma unroll
    for (int q = 0; q < 4; ++q) { int x = __builtin_amdgcn_cvt_pk_fp8_f32(v[q][0] * inv, v[q][1] * inv, 0, false); x = __builtin_amdgcn_cvt_pk_fp8_f32(v[q][2] * inv, v[q][3] * inv, x, true); w[q] = (unsigned)x; }
    *(u32x4*)(dst + lane * 16) = w;
    if (lane == 0) *scale = am * (1.f / 448.f);
}

__device__ __forceinline__ void p0_quant_rows4(const float* __restrict__ src, unsigned char* __restrict__ dst, float* __restrict__ scale, int lane) {
    f32x4 v[4][4]; float am[4];
#pragma unroll
    for (int r = 0; r < 4; ++r)
#pragma unroll
        for (int q = 0; q < 4; ++q) v[r][q] = *(const f32x4*)(src + (size_t)r * D + lane * 16 + q * 4);
#pragma unroll
    for (int r = 0; r < 4; ++r) { float a = 0.f;
#pragma unroll
        for (int q = 0; q < 4; ++q) a = fmaxf(a, fmaxf(fmaxf(fabsf(v[r][q][0]), fabsf(v[r][q][1])), fmaxf(fabsf(v[r][q][2]), fabsf(v[r][q][3]))));
        am[r] = a; }
#pragma unroll
    for (int o = 1; o < 64; o <<= 1) {
#pragma unroll
        for (int r = 0; r < 4; ++r) am[r] = fmaxf(am[r], __shfl_xor(am[r], o)); }
#pragma unroll
    for (int r = 0; r < 4; ++r) {
        const float inv = am[r] > 0.f ? 448.f / am[r] : 0.f;
        u32x4 w;
#pragma unroll
        for (int q = 0; q < 4; ++q) { int x = __builtin_amdgcn_cvt_pk_fp8_f32(v[r][q][0] * inv, v[r][q][1] * inv, 0, false); x = __builtin_amdgcn_cvt_pk_fp8_f32(v[r][q][2] * inv, v[r][q][3] * inv, x, true); w[q] = (unsigned)x; }
        *(u32x4*)(dst + (size_t)r * D + lane * 16) = w;
        if (lane == 0) scale[r] = am[r] * (1.f / 448.f);
    }
}

struct FAttnIn {
    bf16 *Qb, *Kb, *Vb, *QIb, *KIb; float* WIf; float* out;
    mutable float kmax = 0.f, vmax = 0.f;
    __device__ __forceinline__ static float amax8(f32x4 a, f32x4 b) { return fmaxf(fmaxf(fmaxf(fabsf(a[0]), fabsf(a[1])), fmaxf(fabsf(a[2]), fabsf(a[3]))), fmaxf(fmaxf(fabsf(b[0]), fabsf(b[1])), fmaxf(fabsf(b[2]), fabsf(b[3])))); }
    __device__ __forceinline__ float* okp(int row, size_t offp, size_t offs, int ld) const { return row < TP ? out + offp + (size_t)row * ld : out + offs + (size_t)(row - TP) * ld; }
    __device__ __forceinline__ void put8(int row, int col, f32x4 v0, f32x4 v1) const {
        const u32x4 w = pack8(v0, v1);
        if (col < AK) *(u32x4*)(Qb + (size_t)row * 1024 + col) = w;
        else if (col < AV) { *(u32x4*)(Kb + (size_t)row * 256 + (col - AK)) = w; float* o = okp(row, OUT_KP, OUT_KS, 256) + (col - AK); *(f32x4*)o = v0; *(f32x4*)(o + 4) = v1; kmax = fmaxf(kmax, amax8(v0, v1)); }
        else if (col < AQI) { *(u32x4*)(Vb + (size_t)row * 256 + (col - AV)) = w; float* o = okp(row, OUT_VP, OUT_VS, 256) + (col - AV); *(f32x4*)o = v0; *(f32x4*)(o + 4) = v1; vmax = fmaxf(vmax, amax8(v0, v1)); }
        else *(u32x4*)(QIb + (size_t)row * 512 + (col - AQI)) = w;
    }
    __device__ __forceinline__ void put4(int row, int col, f32x4 v) const {
        u32x2 w; w.x = pk2(v[0], v[1]); w.y = pk2(v[2], v[3]);
        if (col < AK) *(u32x2*)(Qb + (size_t)row * 1024 + col) = w;
        else if (col < AV) { *(u32x2*)(Kb + (size_t)row * 256 + (col - AK)) = w; *(f32x4*)(okp(row, OUT_KP, OUT_KS, 256) + (col - AK)) = v; }
        else if (col < AQI) { *(u32x2*)(Vb + (size_t)row * 256 + (col - AV)) = w; *(f32x4*)(okp(row, OUT_VP, OUT_VS, 256) + (col - AV)) = v; }
        else if (col < AKI) *(u32x2*)(QIb + (size_t)row * 512 + (col - AQI)) = w;
        else if (col < AWI) { *(u32x2*)(KIb + (size_t)row * 64 + (col - AKI)) = w; *(f32x4*)(okp(row, OUT_KIP, OUT_KIS, 64) + (col - AKI)) = v; }
        else if (col < ATT_N) *(f32x4*)(WIf + (size_t)row * 8 + (col - AWI)) = v * 0.04419417382415922f;
    }
};
}

namespace mk {
typedef float f32x2v __attribute__((ext_vector_type(2)));
typedef float f32x16 __attribute__((ext_vector_type(16)));
typedef short s16x4 __attribute__((ext_vector_type(4)));
typedef short v4i16_t __attribute__((ext_vector_type(4)));

__device__ __forceinline__ void score_load_q(const bf16* __restrict__ QIb, const float* __restrict__ WIf, size_t tok0, int lane, bf16x8 (&afr)[4], f32x4 (&w4)[4]) {
    const int r = lane & 31, kq = lane >> 5;
    const bf16* ap = QIb + (tok0 + (r >> 3)) * 512 + (r & 7) * 64 + kq * 8;
#pragma unroll
    for (int ks = 0; ks < 4; ++ks) afr[ks] = *(const bf16x8*)(ap + ks * 16);
#pragma unroll
    for (int ql = 0; ql < 4; ++ql) w4[ql] = *(const f32x4*)(WIf + (tok0 + ql) * 8 + 4 * kq);
}
__device__ __forceinline__ void score_tile(const bf16x8 (&afr)[4], const bf16x8 (&bfr)[4], const f32x4 (&w4)[4], float (&s)[4]) {
    f32x16 acc;
#pragma unroll
    for (int j = 0; j < 16; ++j) acc[j] = 0.f;
#pragma unroll
    for (int ks = 0; ks < 4; ++ks) acc = __builtin_amdgcn_mfma_f32_32x32x16_bf16(afr[ks], bfr[ks], acc, 0, 0, 0);
#pragma unroll
    for (int ql = 0; ql < 4; ++ql) {
        float p = 0.f;
#pragma unroll
        for (int jj = 0; jj < 4; ++jj) p = fmaf(fmaxf(acc[ql * 4 + jj], 0.f), w4[ql][jj], p);
        s[ql] = p + __shfl_xor(p, 32);
    }
}

__device__ __forceinline__ void quant_issue(const float* __restrict__ src, f32x4 (&v)[4], int lane) {
#pragma unroll
    for (int q = 0; q < 4; ++q) v[q] = *(const f32x4*)(src + lane * 16 + q * 4);
}
#ifndef PEER_FP6
#define PEER_FP6 1
#endif
constexpr int PEER_RB = PEER_FP6 ? 768 : 1024;
#if PEER_FP6
__device__ __forceinline__ unsigned enc_e2m3(float x) {
    const float a = fabsf(x), q = a * 8.f;
    const float c = a < 2.f ? rintf(q) : (a < 4.f ? rintf(q * 0.5f) + 8.f : fminf(rintf(q * 0.25f) + 16.f, 31.f));
    return (unsigned)c | (x < 0.f ? 32u : 0u);
}
__device__ __forceinline__ void quant_finish(const f32x4 (&v)[4], unsigned char* __restrict__ dst, float* __restrict__ scale, int lane) {
    float am = 0.f;
#pragma unroll
    for (int q = 0; q < 4; ++q) am = fmaxf(am, fmaxf(fmaxf(fabsf(v[q][0]), fabsf(v[q][1])), fmaxf(fabsf(v[q][2]), fabsf(v[q][3]))));
#pragma unroll
    for (int o = 1; o < 64; o <<= 1) am = fmaxf(am, __shfl_xor(am, o));
    const float inv = am > 0.f ? 7.5f / am : 0.f;
    unsigned long long lo = 0ull, hi = 0ull;
#pragma unroll
    for (int i = 0; i < 16; ++i) {
        const unsigned long long c = enc_e2m3(v[i >> 2][i & 3] * inv);
        if (i < 10) lo |= c << (6 * i);
        else if (i == 10) { lo |= (c & 15ull) << 60; hi |= c >> 4; }
        else hi |= c << (6 * (i - 11) + 2);
    }
    unsigned* d = (unsigned*)(dst + lane * 12);
    d[0] = (unsigned)lo; d[1] = (unsigned)(lo >> 32); d[2] = (unsigned)hi;
    if (lane == 0) *scale = am * (1.f / 7.5f);
}
#else
__device__ __forceinline__ void quant_finish(const f32x4 (&v)[4], unsigned char* __restrict__ dst, float* __restrict__ scale, int lane) {
    float am = 0.f;
#pragma unroll
    for (int q = 0; q < 4; ++q) am = fmaxf(am, fmaxf(fmaxf(fabsf(v[q][0]), fabsf(v[q][1])), fmaxf(fabsf(v[q][2]), fabsf(v[q][3]))));
#pragma unroll
    for (int o = 1; o < 64; o <<= 1) am = fmaxf(am, __shfl_xor(am, o));
    const float inv = am > 0.f ? 448.f / am : 0.f;
    u32x4 w;
#pragma unroll
    for (int q = 0; q < 4; ++q) { int x = __builtin_amdgcn_cvt_pk_fp8_f32(v[q][0] * inv, v[q][1] * inv, 0, false); x = __builtin_amdgcn_cvt_pk_fp8_f32(v[q][2] * inv, v[q][3] * inv, x, true); w[q] = (unsigned)x; }
    *(u32x4*)(dst + lane * 16) = w;
    if (lane == 0) *scale = am * (1.f / 448.f);
}
#endif
struct QuantTabs { const float* pu; const float* pv; unsigned char* uq; unsigned char* vq; float* us; float* vs;
    __device__ __forceinline__ const float* src(int r) const { return r < 2 * 16384 ? pu + (size_t)r * D : pv + (size_t)(r - 2 * 16384) * D; }
    __device__ __forceinline__ unsigned char* dst(int r) const { return r < 2 * 16384 ? uq + (size_t)r * PEER_RB : vq + (size_t)(r - 2 * 16384) * PEER_RB; }
    __device__ __forceinline__ float* sc(int r) const { return r < 2 * 16384 ? us + r : vs + (r - 2 * 16384); } };

__device__ __forceinline__ void phase_score(const bf16* __restrict__ QIb, const bf16* __restrict__ KIb, const float* __restrict__ WIf, const float* __restrict__ cache_ki, const int* __restrict__ page_table,
                                            float* __restrict__ SC, float* __restrict__ SCS, const QuantTabs QT_, LAS unsigned char* lds, int vcu, int G, int wave, int lane, int gw, int NGW) {
    const int c = lane & 31, kq = lane >> 5;
    int qrow = gw;
    constexpr int KST = 144, KBUF = 256 * KST;
    const int tid = wave * 64 + lane;
    for (int it = vcu; it < 512; it += G) {
        const int b = it >> 8, qt = b == 0 ? (it & 255) : 255 - (it & 255);
        const size_t tok0 = (size_t)b * SEQ + qt * 32 + wave * 4;
        bf16x8 afr[4]; f32x4 w4[4];
        score_load_q(QIb, WIf, tok0, lane, afr, w4);
        const int nc = (qt >> 3) + 1;
        const bf16* kbase = KIb + (size_t)b * SEQ * 64;
        u32x4 st[4];
#pragma unroll
        for (int i = 0; i < 4; ++i) { const int p = tid + i * 512; st[i] = *(const u32x4*)(kbase + (size_t)(p >> 3) * 64 + (p & 7) * 8); }
#pragma unroll
        for (int i = 0; i < 4; ++i) { const int p = tid + i * 512; *(LAS u32x4*)(lds + (p >> 3) * KST + (p & 7) * 16) = st[i]; }
        __syncthreads();
        for (int ch = 0; ch < nc; ++ch) {
            const bool more = ch + 1 < nc;
            f32x4 qv[4]; const bool qdo = qrow < 4 * 16384;
            if (qdo) quant_issue(QT_.src(qrow), qv, lane);
            if (more) {
#pragma unroll
                for (int i = 0; i < 4; ++i) { const int p = tid + i * 512; st[i] = *(const u32x4*)(kbase + ((size_t)(ch + 1) * 256 + (p >> 3)) * 64 + (p & 7) * 8); }
            }
            LAS unsigned char* kb = lds + (ch & 1) * KBUF;
            const int ntile = more ? 8 : (qt & 7) + 1;
            for (int kt8 = 0; kt8 < ntile; ++kt8) {
                bf16x8 bfr[4];
#pragma unroll
                for (int ks = 0; ks < 4; ++ks) bfr[ks] = *(LAS bf16x8*)(kb + (kt8 * 32 + c) * KST + ks * 32 + kq * 16);
                float sv[4]; score_tile(afr, bfr, w4, sv);
                float* o = SC + (tok0 + 2 * kq) * SEQ + (ch * 8 + kt8) * 32 + c;
                o[0] = kq ? sv[2] : sv[0]; o[SEQ] = kq ? sv[3] : sv[1];
            }
            if (qdo) { quant_finish(qv, QT_.dst(qrow), QT_.sc(qrow), lane); qrow += NGW; }
            if (more) {
                LAS unsigned char* nb = lds + ((ch + 1) & 1) * KBUF;
#pragma unroll
                for (int i = 0; i < 4; ++i) { const int p = tid + i * 512; *(LAS u32x4*)(nb + (p >> 3) * KST + (p & 7) * 16) = st[i]; }
            }
            __syncthreads();
        }
    }
    for (; qrow < 4 * 16384; qrow += NGW) { f32x4 qv[4]; quant_issue(QT_.src(qrow), qv, lane); quant_finish(qv, QT_.dst(qrow), QT_.sc(qrow), lane); }
    for (int it = gw; it < DB * NPAGES + DB; it += NGW) {
        const bool isnew = it >= DB * NPAGES;
        const int b = isnew ? it - DB * NPAGES : it / NPAGES, pg = isnew ? 0 : it % NPAGES;
        const size_t tok0 = (size_t)TP + b * DS;
        bf16x8 afr[4]; f32x4 w4[4];
        score_load_q(QIb, WIf, tok0, lane, afr, w4);
        if (!isnew) {
            const int phys = page_table[b * NPAGES + pg];
            for (int j = 0; j < 4; ++j) {
                const float* kp = cache_ki + ((size_t)phys * PAGE + j * 32 + c) * 64 + kq * 8;
                bf16x8 bfr[4];
#pragma unroll
                for (int ks = 0; ks < 4; ++ks) { const f32x4 x0 = *(const f32x4*)(kp + ks * 16), x1 = *(const f32x4*)(kp + ks * 16 + 4); const u32x4 w = pack8(x0, x1); bfr[ks] = __builtin_bit_cast(bf16x8, w); }
                float s[4]; score_tile(afr, bfr, w4, s);
                float* o = SCS + (size_t)(b * DS + 2 * kq) * SCS_LD + pg * PAGE + j * 32 + c;
                o[0] = kq ? s[2] : s[0]; o[SCS_LD] = kq ? s[3] : s[1];
            }
        } else {
            const bf16* kp = KIb + (tok0 + (c & 3)) * 64 + kq * 8;
            bf16x8 bfr[4];
#pragma unroll
            for (int ks = 0; ks < 4; ++ks) bfr[ks] = *(const bf16x8*)(kp + ks * 16);
            float s[4]; score_tile(afr, bfr, w4, s);
            if (c < 4) { float* o = SCS + (size_t)(b * DS + 2 * kq) * SCS_LD + PAST + c; o[0] = kq ? s[2] : s[0]; o[SCS_LD] = kq ? s[3] : s[1]; }
        }
    }
}

constexpr int VST = 144;
__device__ __forceinline__ bf16x8 ld_frag8(const bf16* p) { return *(const bf16x8*)p; }
__device__ __forceinline__ bf16x8 ld_frag8(const float* p) { const f32x4 a = *(const f32x4*)p, b = *(const f32x4*)(p + 4); const u32x4 w = pack8(a, b); return __builtin_bit_cast(bf16x8, w); }
__device__ __forceinline__ s16x4 lds_tr(LAS unsigned char* p) { return __builtin_bit_cast(s16x4, __builtin_amdgcn_ds_read_tr16_b64_v4i16((LAS v4i16_t*)p)); }

template <bool SAMPLE>
__device__ __forceinline__ void attn_row(int row, int n0, int n1, const bf16* __restrict__ Qb, const int* __restrict__ IDX, const int* __restrict__ CNT,
                                         const bf16* __restrict__ Kb, const bf16* __restrict__ Vb, const float* __restrict__ cache_k, const float* __restrict__ cache_v,
                                         const float* __restrict__ newk, const float* __restrict__ newv, const int* __restrict__ page_table,
                                         bf16* __restrict__ Ob, LAS unsigned char* wl, int lane) {
    const int fr = lane & 15, fq = lane >> 4;
    LAS int* rid = (LAS int*)wl;
    LAS unsigned char* vt = wl + 1024;
    const int cnt = CNT[row];
    const int b = SAMPLE ? (row - TP) / DS : row / SEQ;
#pragma unroll
    for (int i = 0; i < 4; ++i) { const int slot = i * 64 + lane; int key = slot < cnt ? IDX[(size_t)row * TOPK + slot] : 0; int id;
        if (!SAMPLE) id = b * SEQ + key;
        else if (key < PAST) id = page_table[b * NPAGES + key / PAGE] * PAGE + (key % PAGE);
        else id = (int)0x80000000 | (b * DS + (key - PAST));
        rid[slot] = id; }
    asm volatile("s_waitcnt lgkmcnt(0)" ::: "memory");
    for (int n = n0; n < n1; ++n) {
        bf16x8 qf[2];
#pragma unroll
        for (int ks = 0; ks < 2; ++ks) qf[ks] = *(const bf16x8*)(Qb + (size_t)row * 1024 + (n * 4 + (fr & 3)) * 64 + ks * 32 + fq * 8);
        f32x4 st[16];
        constexpr int TBN = SAMPLE ? 4 : 8;
#pragma unroll
        for (int tb = 0; tb < 16 / TBN; ++tb) {
            bf16x8 kf[TBN][2];
#pragma unroll
            for (int t = 0; t < TBN; ++t) {
                const int id = rid[(tb * TBN + t) * 16 + fr];
                if (!SAMPLE) { const bf16* kp = Kb + (size_t)id * 256 + n * 64 + fq * 8; kf[t][0] = ld_frag8(kp); kf[t][1] = ld_frag8(kp + 32); }
                else { const float* kp = (id < 0 ? newk + (size_t)(id & 0x7fffffff) * 256 : cache_k + (size_t)id * 256) + n * 64 + fq * 8; kf[t][0] = ld_frag8(kp); kf[t][1] = ld_frag8(kp + 32); }
            }
#pragma unroll
            for (int t = 0; t < TBN; ++t) {
                f32x4 a = (f32x4){0.f, 0.f, 0.f, 0.f};
                a = __builtin_amdgcn_mfma_f32_16x16x32_bf16(kf[t][0], qf[0], a, 0, 0, 0);
                a = __builtin_amdgcn_mfma_f32_16x16x32_bf16(kf[t][1], qf[1], a, 0, 0, 0);
                st[tb * TBN + t] = a;
            }
            asm volatile("" ::: "memory");
        }
        bf16x8 vreg[8];
#define ATT_VLOAD(ch_) do { _Pragma("unroll") for (int i = 0; i < 8; ++i) { const int sl = i * 8 + (lane >> 3), chunk = lane & 7; const int id = rid[(ch_) * 64 + sl]; \
            if (!SAMPLE) vreg[i] = ld_frag8(Vb + (size_t)id * 256 + n * 64 + chunk * 8); \
            else vreg[i] = ld_frag8((id < 0 ? newv + (size_t)(id & 0x7fffffff) * 256 : cache_v + (size_t)id * 256) + n * 64 + chunk * 8); } } while (0)
        ATT_VLOAD(0);
        float mx = -INFINITY;
#pragma unroll
        for (int t = 0; t < 16; ++t)
#pragma unroll
            for (int j = 0; j < 4; ++j) { const int slot = t * 16 + fq * 4 + j; const float v = slot < cnt ? st[t][j] * 0.125f : -INFINITY; st[t][j] = v; mx = fmaxf(mx, v); }
        mx = fmaxf(mx, __shfl_xor(mx, 16)); mx = fmaxf(mx, __shfl_xor(mx, 32));
        float sum = 0.f;
#pragma unroll
        for (int t = 0; t < 16; ++t)
#pragma unroll
            for (int j = 0; j < 4; ++j) { const float e = __expf(st[t][j] - mx); st[t][j] = e; sum += e; }
        sum += __shfl_xor(sum, 16); sum += __shfl_xor(sum, 32);
        f32x4 oacc[4];
#pragma unroll
        for (int dt = 0; dt < 4; ++dt) oacc[dt] = (f32x4){0.f, 0.f, 0.f, 0.f};
#pragma unroll
        for (int ch = 0; ch < 4; ++ch) {
#pragma unroll
            for (int i = 0; i < 8; ++i) { const int sl = i * 8 + (lane >> 3), chunk = lane & 7; *(LAS bf16x8*)(vt + sl * VST + chunk * 16) = vreg[i]; }
            asm volatile("s_waitcnt lgkmcnt(0)" ::: "memory");
            if (ch < 3) ATT_VLOAD(ch + 1);
#pragma unroll
            for (int s2 = 0; s2 < 2; ++s2) {
                const int t0 = ch * 4 + s2 * 2;
                const u32x4 pw = pack8(st[t0], st[t0 + 1]);
                const bf16x8 pf = __builtin_bit_cast(bf16x8, pw);
#pragma unroll
                for (int dt = 0; dt < 4; ++dt) {
                    LAS unsigned char* a0 = vt + (s2 * 32 + fq * 4 + (fr >> 2)) * VST + (dt * 16 + 4 * (fr & 3)) * 2;
                    const s16x4 v0 = lds_tr(a0), v1 = lds_tr(a0 + 16 * VST);
                    bf16x8 vf; vf[0] = v0[0]; vf[1] = v0[1]; vf[2] = v0[2]; vf[3] = v0[3]; vf[4] = v1[0]; vf[5] = v1[1]; vf[6] = v1[2]; vf[7] = v1[3];
                    oacc[dt] = __builtin_amdgcn_mfma_f32_16x16x32_bf16(pf, vf, oacc[dt], 0, 0, 0);
                }
            }
            asm volatile("s_waitcnt lgkmcnt(0)" ::: "memory");
        }
#undef ATT_VLOAD
        const float i0 = 1.f / __shfl(sum, 0), i1 = 1.f / __shfl(sum, 1), i2 = 1.f / __shfl(sum, 2), i3 = 1.f / __shfl(sum, 3);
        if (fq == 0) {
#pragma unroll
            for (int dt = 0; dt < 4; ++dt) {
                bf16* o = Ob + (size_t)row * 1024 + (n * 4) * 64 + dt * 16 + fr;
                o[0] = (bf16)f2bf(oacc[dt][0] * i0); o[64] = (bf16)f2bf(oacc[dt][1] * i1); o[128] = (bf16)f2bf(oacc[dt][2] * i2); o[192] = (bf16)f2bf(oacc[dt][3] * i3);
            }
        }
    }
    asm volatile("s_waitcnt lgkmcnt(0)" ::: "memory");
}

__device__ __forceinline__ void kv8_convert(const bf16* __restrict__ Kb, const bf16* __restrict__ Vb, unsigned char* __restrict__ KV8_, const unsigned* __restrict__ amaxk, const unsigned* __restrict__ amaxv, int gw, int NGW, int lane) {
    const float ak = __builtin_bit_cast(float, __hip_atomic_load(amaxk, __ATOMIC_RELAXED, __HIP_MEMORY_SCOPE_AGENT)), av = __builtin_bit_cast(float, __hip_atomic_load(amaxv, __ATOMIC_RELAXED, __HIP_MEMORY_SCOPE_AGENT));
    const bool isv = lane >= 32; const int l = lane & 31;
    const float sc = isv ? (av > 0.f ? 448.f / av : 0.f) : (ak > 0.f ? 448.f / ak : 0.f);
    for (int t = gw; t < TP; t += NGW) {
        const u32x4 w = *(const u32x4*)((isv ? Vb : Kb) + (size_t)t * 256 + l * 8);
        const float x0 = bflo(w.x) * sc, x1 = bfhi(w.x) * sc, x2 = bflo(w.y) * sc, x3 = bfhi(w.y) * sc, x4 = bflo(w.z) * sc, x5 = bfhi(w.z) * sc, x6 = bflo(w.w) * sc, x7 = bfhi(w.w) * sc;
        int p0 = __builtin_amdgcn_cvt_pk_fp8_f32(x0, x1, 0, false); p0 = __builtin_amdgcn_cvt_pk_fp8_f32(x2, x3, p0, true);
        int p1 = __builtin_amdgcn_cvt_pk_fp8_f32(x4, x5, 0, false); p1 = __builtin_amdgcn_cvt_pk_fp8_f32(x6, x7, p1, true);
        const int n = l >> 3, d0 = (l & 7) * 8;
        const int pos = isv ? 64 + d0 : ((d0 & 31) >> 3) * 16 + (d0 >> 5) * 8;
        u32x2 o; o.x = (unsigned)p0; o.y = (unsigned)p1;
        *(u32x2*)(KV8_ + (size_t)t * 512 + n * 128 + pos) = o;
    }
}
__device__ __forceinline__ void fp8x16_to_bf16(const u32x4 q, bf16x8& lo, bf16x8& hi) {
    u32x4 a, b;
#pragma unroll
    for (int w = 0; w < 4; ++w) { const f32x2v f0 = __builtin_amdgcn_cvt_pk_f32_fp8((int)q[w], false), f1 = __builtin_amdgcn_cvt_pk_f32_fp8((int)q[w], true);
        const unsigned u0 = pk2(f0[0], f0[1]), u1 = pk2(f1[0], f1[1]);
        if (w < 2) { a[2 * w] = u0; a[2 * w + 1] = u1; } else { b[2 * w - 4] = u0; b[2 * w - 3] = u1; } }
    lo = __builtin_bit_cast(bf16x8, a); hi = __builtin_bit_cast(bf16x8, b);
}
#ifndef KF1
#define KF1 10
#endif
__device__ __forceinline__ void attn_prompt_stream(int b, int n, int q0, int qstep, const bf16* __restrict__ Qb, const int* __restrict__ IDX, const unsigned char* __restrict__ KV8_, const unsigned* __restrict__ amaxk, const unsigned* __restrict__ amaxv,
                                                   bf16* __restrict__ Ob, LAS unsigned char* wl, int lane) {
    const float ak_ = __builtin_bit_cast(float, __hip_atomic_load(amaxk, __ATOMIC_RELAXED, __HIP_MEMORY_SCOPE_AGENT)), av_ = __builtin_bit_cast(float, __hip_atomic_load(amaxv, __ATOMIC_RELAXED, __HIP_MEMORY_SCOPE_AGENT));
    const float kinv = ak_ * (1.f / 448.f), vinv = av_ * (1.f / 448.f);
    const int fr = lane & 15, fq = lane >> 4;
    LAS int* ridb = (LAS int*)wl;
    LAS unsigned char* vt = wl + 2048;
    if (q0 >= SEQ) return;
    int vx[4];
    { const int row = b * SEQ + q0, cnt = q0 + 1 < TOPK ? q0 + 1 : TOPK;
#pragma unroll
      for (int i = 0; i < 4; ++i) { const int slot = i * 64 + lane; ridb[slot] = b * SEQ + (slot < cnt ? IDX[(size_t)row * TOPK + slot] : 0); } }
    int buf = 0;

    for (int q = q0; q < SEQ; q += qstep, buf ^= 1) {

        const int row = b * SEQ + q, cnt = q + 1 < TOPK ? q + 1 : TOPK;
        LAS int* rid = ridb + buf * 256;
        asm volatile("s_waitcnt lgkmcnt(0)" ::: "memory");
        int kx[16];
#pragma unroll
        for (int t = 0; t < 16; ++t) kx[t] = rid[t * 16 + fr];
        bf16x8 qf[2];
#pragma unroll
        for (int ks = 0; ks < 2; ++ks) qf[ks] = *(const bf16x8*)(Qb + (size_t)row * 1024 + (n * 4 + (fr & 3)) * 64 + ks * 32 + fq * 8);
        u32x4 kraw[16];
#pragma unroll
        for (int t = 0; t < 16; ++t) kraw[t] = *(const u32x4*)(KV8_ + (size_t)kx[t] * 512 + n * 128 + fq * 16);
        asm volatile("s_waitcnt lgkmcnt(0)" ::: "memory");
        u32x4 vraw[4];
#define ATT_VLOAD2(ch_) do { _Pragma("unroll") for (int i = 0; i < 4; ++i) { const int sl = i * 16 + (lane >> 2), piece = lane & 3; const int id = rid[(ch_) * 64 + sl]; \
            vraw[i] = *(const u32x4*)(KV8_ + (size_t)id * 512 + n * 128 + 64 + piece * 16); } } while (0)
        f32x4 st[16];
#pragma unroll
        for (int t = 0; t < 16; ++t) {
            asm volatile("" : "+v"(kraw[t][0]), "+v"(kraw[t][1]), "+v"(kraw[t][2]), "+v"(kraw[t][3]));
            bf16x8 k0, k1; fp8x16_to_bf16(kraw[t], k0, k1);
            f32x4 a = (f32x4){0.f, 0.f, 0.f, 0.f};
            a = __builtin_amdgcn_mfma_f32_16x16x32_bf16(k0, qf[0], a, 0, 0, 0);
            a = __builtin_amdgcn_mfma_f32_16x16x32_bf16(k1, qf[1], a, 0, 0, 0);
            st[t] = a;
            asm volatile("" : "+v"(st[t][0]), "+v"(st[t][1]), "+v"(st[t][2]), "+v"(st[t][3]));
        }

        const int qn = q + qstep;
        if (qn < SEQ) { const int rown = b * SEQ + qn, cntn = qn + 1 < TOPK ? qn + 1 : TOPK;
#pragma unroll
            for (int i = 0; i < 4; ++i) { const int slot = i * 64 + lane; vx[i] = slot < cntn ? IDX[(size_t)rown * TOPK + slot] : 0; } }
        ATT_VLOAD2(0);
        float mx = -INFINITY;
        if (cnt < TOPK) {
#pragma unroll
            for (int t = 0; t < 16; ++t)
#pragma unroll
                for (int j = 0; j < 4; ++j) { const int slot = t * 16 + fq * 4 + j; st[t][j] = slot < cnt ? st[t][j] : -INFINITY; }
        }
#pragma unroll
        for (int t = 0; t < 16; ++t) mx = fmaxf(mx, fmaxf(fmaxf(st[t][0], st[t][1]), fmaxf(st[t][2], st[t][3])));
        mx = fmaxf(mx, __shfl_xor(mx, 16)); mx = fmaxf(mx, __shfl_xor(mx, 32));
        const float cs = 0.18033688011112042f * kinv, mb = -mx * cs;
        float sum = 0.f;
#pragma unroll
        for (int t = 0; t < 16; ++t)
#pragma unroll
            for (int j = 0; j < 4; ++j) { const float e = __builtin_amdgcn_exp2f(fmaf(st[t][j], cs, mb)); st[t][j] = e; sum += e; }
        sum += __shfl_xor(sum, 16); sum += __shfl_xor(sum, 32);

        f32x4 oacc[4];
#pragma unroll
        for (int dt = 0; dt < 4; ++dt) oacc[dt] = (f32x4){0.f, 0.f, 0.f, 0.f};
#pragma unroll
        for (int ch = 0; ch < 4; ++ch) {
#pragma unroll
            for (int i = 0; i < 4; ++i) { const int sl = i * 16 + (lane >> 2), piece = lane & 3; bf16x8 v0, v1; fp8x16_to_bf16(vraw[i], v0, v1);
                *(LAS bf16x8*)(vt + sl * VST + piece * 32) = v0; *(LAS bf16x8*)(vt + sl * VST + piece * 32 + 16) = v1; }
            asm volatile("s_waitcnt lgkmcnt(0)" ::: "memory");
            if (ch < 3) ATT_VLOAD2(ch + 1);
#pragma unroll
            for (int s2 = 0; s2 < 2; ++s2) {
                const int t0 = ch * 4 + s2 * 2;
                const u32x4 pw = pack8(st[t0], st[t0 + 1]);
                const bf16x8 pf = __builtin_bit_cast(bf16x8, pw);
#pragma unroll
                for (int dt = 0; dt < 4; ++dt) {
                    LAS unsigned char* a0 = vt + (s2 * 32 + fq * 4 + (fr >> 2)) * VST + (dt * 16 + 4 * (fr & 3)) * 2;
                    const s16x4 v0 = lds_tr(a0), v1 = lds_tr(a0 + 16 * VST);
                    bf16x8 vf; vf[0] = v0[0]; vf[1] = v0[1]; vf[2] = v0[2]; vf[3] = v0[3]; vf[4] = v1[0]; vf[5] = v1[1]; vf[6] = v1[2]; vf[7] = v1[3];
                    oacc[dt] = __builtin_amdgcn_mfma_f32_16x16x32_bf16(pf, vf, oacc[dt], 0, 0, 0);
                }
            }
            asm volatile("s_waitcnt lgkmcnt(0)" ::: "memory");
        }
#undef ATT_VLOAD2

        const float i0 = vinv / __shfl(sum, 0), i1 = vinv / __shfl(sum, 1), i2 = vinv / __shfl(sum, 2), i3 = vinv / __shfl(sum, 3);
        if (fq == 0) {
#pragma unroll
            for (int dt = 0; dt < 4; ++dt) {
                bf16* o = Ob + (size_t)row * 1024 + (n * 4) * 64 + dt * 16 + fr;
                o[0] = (bf16)f2bf(oacc[dt][0] * i0); o[64] = (bf16)f2bf(oacc[dt][1] * i1); o[128] = (bf16)f2bf(oacc[dt][2] * i2); o[192] = (bf16)f2bf(oacc[dt][3] * i3);
            }
        }
        if (qn < SEQ) {
#pragma unroll
            for (int i = 0; i < 4; ++i) ridb[(buf ^ 1) * 256 + i * 64 + lane] = vx[i] + b * SEQ;
        }

    }

    asm volatile("s_waitcnt lgkmcnt(0)" ::: "memory");
}

__device__ __forceinline__ void ln_row_wave(const float* __restrict__ zrow, const float* __restrict__ g, const float* __restrict__ bt, float* __restrict__ of, bf16* __restrict__ ob, int lane) {
    f32x4 v[4]; float s = 0.f;
#pragma unroll
    for (int j = 0; j < 4; ++j) { v[j] = *(const f32x4*)(zrow + 256 * j + 4 * lane); s += (v[j][0] + v[j][1]) + (v[j][2] + v[j][3]); }
#pragma unroll
    for (int o = 1; o < 64; o <<= 1) s += __shfl_xor(s, o);
    const float mean = s * (1.f / D); float q = 0.f;
#pragma unroll
    for (int j = 0; j < 4; ++j) { v[j] = v[j] - mean; q += (v[j][0] * v[j][0] + v[j][1] * v[j][1]) + (v[j][2] * v[j][2] + v[j][3] * v[j][3]); }
#pragma unroll
    for (int o = 1; o < 64; o <<= 1) q += __shfl_xor(q, o);
    const float rstd = rsqrtf(q * (1.f / D) + LN_EPS);
#pragma unroll
    for (int j = 0; j < 4; ++j) { const f32x4 gg = *(const f32x4*)(g + 256 * j + 4 * lane), bb = *(const f32x4*)(bt + 256 * j + 4 * lane); const f32x4 o = v[j] * rstd * gg + bb;
        if (of) *(f32x4*)(of + 256 * j + 4 * lane) = o; u32x2 w; w.x = pk2(o[0], o[1]); w.y = pk2(o[2], o[3]); *(u32x2*)(ob + 256 * j + 4 * lane) = w; }
}

struct FResid {
    const float* rp; const float* rs; float* Z;
    __device__ __forceinline__ const float* rrow(int row) const { return row < TP ? rp + (size_t)row * D : rs + (size_t)(row - TP) * D; }
    __device__ __forceinline__ void put8(int row, int col, f32x4 v0, f32x4 v1) const { const float* r = rrow(row) + col; float* z = Z + (size_t)row * D + col;
        *(f32x4*)z = v0 + ALPHA * *(const f32x4*)r; *(f32x4*)(z + 4) = v1 + ALPHA * *(const f32x4*)(r + 4); }
    __device__ __forceinline__ void put4(int row, int col, f32x4 v) const { *(f32x4*)(Z + (size_t)row * D + col) = v + ALPHA * *(const f32x4*)(rrow(row) + col); }
};
}

namespace mk {
template <int CAP>
__device__ __forceinline__ void topk_wave_regs(const float* __restrict__ row, int n, int* __restrict__ out, LAS unsigned* hist, LAS float* cv, LAS int* ci, LAS unsigned char* lst, int lane) {
    if (n <= TOPK) { for (int i = lane; i < TOPK; i += 64) out[i] = i < n ? i : 0; return; }

    constexpr int NCH = 32;
    const int nch = n > 8192 ? 32 : (n + 255) >> 8;
    float vx = (lane < 4 && 8192 + lane < n) ? row[8192 + lane] : -INFINITY;
    f32x4 v[NCH];
#pragma unroll
    for (int j = 0; j < NCH; ++j) {
        if (j < nch) v[j] = *(const f32x4*)(row + j * 256 + lane * 4);
        else v[j] = (f32x4){-INFINITY, -INFINITY, -INFINITY, -INFINITY};
    }
    float mn = INFINITY, mx = -INFINITY;
#pragma unroll
    for (int j = 0; j < NCH; ++j) {
        if (j < nch) {
            const int base = j * 256 + lane * 4;
#pragma unroll
            for (int e = 0; e < 4; ++e) { const bool ok = base + e < n; const float x = v[j][e]; v[j][e] = ok ? x : -INFINITY; mx = fmaxf(mx, ok ? x : -INFINITY); mn = fminf(mn, ok ? x : INFINITY); }
        }
    }
    if (vx != -INFINITY) { mx = fmaxf(mx, vx); mn = fminf(mn, vx); }
#pragma unroll
    for (int o = 1; o < 64; o <<= 1) { mn = fminf(mn, __shfl_xor(mn, o)); mx = fmaxf(mx, __shfl_xor(mx, o)); }
    if (!(mx > mn)) { for (int i = lane; i < TOPK; i += 64) out[i] = i; return; }
    const float scale = 2048.0f / (mx - mn);

#pragma unroll
    for (int i = 0; i < 8; ++i) *(LAS u32x4*)(hist + i * 256 + lane * 4) = (u32x4){0u, 0u, 0u, 0u};
    asm volatile("s_waitcnt lgkmcnt(0)" ::: "memory");
#pragma unroll
    for (int j = 0; j < NCH; ++j) {
        if (j < nch) {
            asm volatile("" : "+v"(v[j][0]), "+v"(v[j][1]), "+v"(v[j][2]), "+v"(v[j][3]));
#pragma unroll
            for (int e = 0; e < 4; ++e) { const float x = v[j][e]; int bn = (int)((x - mn) * scale); bn = bn > 2047 ? 2047 : bn; bn = x != -INFINITY ? bn : 2048;
                __hip_atomic_fetch_add(hist + bn, 1u, __ATOMIC_RELAXED, __HIP_MEMORY_SCOPE_WAVEFRONT); }
        }
    }
    if (vx != -INFINITY) { int bn = (int)((vx - mn) * scale); bn = bn > 2047 ? 2047 : bn; __hip_atomic_fetch_add(hist + bn, 1u, __ATOMIC_RELAXED, __HIP_MEMORY_SCOPE_WAVEFRONT); }
    asm volatile("s_waitcnt lgkmcnt(0)" ::: "memory");

    unsigned mine = 0u;
#pragma unroll
    for (int i = 0; i < 8; ++i) { const u32x4 h4 = *(LAS u32x4*)(hist + lane * 32 + i * 4); mine += (h4.x + h4.y) + (h4.z + h4.w); }
    unsigned suf = mine;
#pragma unroll
    for (int o = 1; o < 64; o <<= 1) { const unsigned t = __shfl_down(suf, o); if (lane + o < 64) suf += t; }
    const unsigned long long bal = __ballot(suf >= (unsigned)TOPK);
    const int Lt = 63 - __builtin_clzll(bal);
    const unsigned above = __shfl(suf, Lt) - __shfl(mine, Lt);
    const unsigned hb = hist[Lt * 32 + (lane & 31)];
    unsigned sfx = hb;
#pragma unroll
    for (int o = 1; o < 32; o <<= 1) { const unsigned t = __shfl_down(sfx, o); if ((lane & 31) + o < 32) sfx += t; }
    const unsigned long long okm = __ballot(above + sfx >= (unsigned)TOPK) & 0xFFFFFFFFull;
    const int jb = 63 - __builtin_clzll(okm);
    const int B = Lt * 32 + jb;
    const unsigned running = above + __shfl(sfx, jb) - __shfl(hb, jb);
    const int cnt_gt = (int)running, r = TOPK - cnt_gt;

    int base_gt = 0, base_eq = 0;
    const unsigned long long below = (1ull << lane) - 1ull;
    int lane4 = lane * 4; asm volatile("" : "+v"(lane4));
#pragma unroll
    for (int j = 0; j < NCH; ++j) {
        if (j < nch) {
#pragma unroll
            for (int e = 0; e < 4; ++e) {
                const float x = v[j][e]; int bn = (int)((x - mn) * scale); bn = bn > 2047 ? 2047 : bn; bn = x != -INFINITY ? bn : -1;
                const bool gt = bn > B, eq = bn == B;
                const unsigned long long mg = __ballot(gt), me = __ballot(eq);
                if (mg | me) {
                    const int idx = lane4 + (j * 256 + e);
                    if (gt) out[base_gt + __builtin_popcountll(mg & below)] = idx;
                    if (eq) { const int p = base_eq + __builtin_popcountll(me & below); if (p < CAP) { cv[p] = x; ci[p] = idx; } }
                    base_gt += __builtin_popcountll(mg); base_eq += __builtin_popcountll(me);
                }
            }
        }
    }
    if (n > 8192) {
        const float x = vx; bool gt = false, eq = false;
        if (x != -INFINITY) { int bn = (int)((x - mn) * scale); bn = bn > 2047 ? 2047 : bn; gt = bn > B; eq = bn == B; }
        const unsigned long long mg = __ballot(gt), me = __ballot(eq);
        const int idx = 8192 + lane;
        if (gt) out[base_gt + __builtin_popcountll(mg & below)] = idx;
        if (eq) { const int p = base_eq + __builtin_popcountll(me & below); if (p < CAP) { cv[p] = x; ci[p] = idx; } }
        base_gt += __builtin_popcountll(mg); base_eq += __builtin_popcountll(me);
    }
    asm volatile("s_waitcnt vmcnt(0) lgkmcnt(0)" ::: "memory");

    const int m = base_eq < CAP ? base_eq : CAP;
    if (m <= 64) {
        const float x = lane < m ? cv[lane] : -INFINITY; const int id = lane < m ? ci[lane] : 0x7fffffff; int rank = 0;
        for (int c2 = 0; c2 < m; ++c2) { const float x2 = __builtin_bit_cast(float, __builtin_amdgcn_readlane(__builtin_bit_cast(int, x), c2)); const int id2 = __builtin_amdgcn_readlane(id, c2);
            rank += (x2 > x || (x2 == x && id2 < id)) ? 1 : 0; }
        if (lane < m && rank < r) out[cnt_gt + rank] = id;
    } else {
        for (int c = lane; c < m; c += 64) {
            const float x = cv[c]; const int id = ci[c]; int rank = 0;
            for (int c2 = 0; c2 < m; ++c2) { const float x2 = cv[c2]; const int id2 = ci[c2]; rank += (x2 > x || (x2 == x && id2 < id)) ? 1 : 0; }
            if (rank < r) out[cnt_gt + rank] = id;
        }
    }
    asm volatile("s_waitcnt lgkmcnt(0)" ::: "memory");

}

__device__ __forceinline__ void phase_topk2(const float* __restrict__ SC, const float* __restrict__ SCS, int* __restrict__ IDX, int* __restrict__ CNT,
                                            const float* __restrict__ peer_u_, const float* __restrict__ peer_v_, unsigned char* __restrict__ Uq_, unsigned char* __restrict__ Vq_, float* __restrict__ Usc_, float* __restrict__ Vsc_,
                                            LAS unsigned char* lds, unsigned* qhead, int wave, int lane, int gw, int NGW, int jlo = 0, int jhi = TA) {
    constexpr int CAP = 1020;
    LAS unsigned* hist = (LAS unsigned*)(lds + wave * 16384);
    LAS float* cv = (LAS float*)(lds + wave * 16384 + 8208);
    LAS int* ci = (LAS int*)(lds + wave * 16384 + 8208 + 4080);
    LAS unsigned char* lst = nullptr;

    for (int j = gw; j < TA; j += NGW) {
        if (j < jlo || j >= jhi) continue;
        int row, n; const float* rp;
        if (j < TP) { const int b = j >> 13, jj = j & 8191, blk = jj >> 11; const int q = blk < 2 ? jj : blk * 2048 + 2047 - (jj & 2047);
            row = b * SEQ + q; n = q + 1; rp = SC + (size_t)row * SEQ; }
        else { const int r = j - TP; row = j; n = PAST + (r % DS) + 1; rp = SCS + (size_t)r * SCS_LD; }

        topk_wave_regs<CAP>(rp, n, IDX + (size_t)row * TOPK, hist, cv, ci, lst, lane);

        if (lane == 0) CNT[row] = n < TOPK ? n : TOPK;
    }

}
}

namespace mk {
using bf16x2_t = __attribute__((ext_vector_type(2))) __bf16;
__device__ __forceinline__ float dot2bf(unsigned a, unsigned b, float acc) { return __builtin_amdgcn_fdot2_f32_bf16(__builtin_bit_cast(bf16x2_t, a), __builtin_bit_cast(bf16x2_t, b), acc, false); }

struct FStoreBf16 {
    bf16* O; int ld;
    __device__ __forceinline__ void put8(int row, int col, f32x4 v0, f32x4 v1) const { *(u32x4*)(O + (size_t)row * ld + col) = pack8(v0, v1); }
    __device__ __forceinline__ void put4(int row, int col, f32x4 v) const { u32x2 w; w.x = pk2(v[0], v[1]); w.y = pk2(v[2], v[3]); *(u32x2*)(O + (size_t)row * ld + col) = w; }
};

#ifndef PGS
#define PGS 8
#endif
constexpr int PEER_TAB_OFF = LDSCTL_OFF + 1024;

__device__ __forceinline__ void ce_desc(unsigned& a, unsigned& b) { const unsigned hi = a > b ? a : b, lo = a > b ? b : a; a = hi; b = lo; }
template <int N> __device__ __forceinline__ void bitonic_sort_desc(unsigned (&k)[N]) {
#pragma unroll
    for (int size = 2; size <= N; size <<= 1)
#pragma unroll
        for (int stride = size >> 1; stride > 0; stride >>= 1)
#pragma unroll
            for (int i = 0; i < N; ++i) { const int j = i ^ stride; if (j > i) { if ((i & size) == 0) ce_desc(k[i], k[j]); else ce_desc(k[j], k[i]); } }
}
template <int N> __device__ __forceinline__ void bitonic_merge_desc(unsigned (&k)[N]) {
#pragma unroll
    for (int stride = N >> 1; stride > 0; stride >>= 1)
#pragma unroll
        for (int i = 0; i < N; ++i) { const int j = i ^ stride; if (j > i) ce_desc(k[i], k[j]); }
}
__device__ __forceinline__ void top16_merge(unsigned (&a)[16], const unsigned (&b)[16]) {
#pragma unroll
    for (int i = 0; i < 16; ++i) a[i] = a[i] > b[15 - i] ? a[i] : b[15 - i];
    bitonic_merge_desc<16>(a);
}
__device__ __forceinline__ void top16_xlane(unsigned (&a)[16], int o) {
    unsigned b[16];
#pragma unroll
    for (int i = 0; i < 16; ++i) b[i] = (unsigned)__shfl_xor((int)a[i], o);
    top16_merge(a, b);
}
__device__ __forceinline__ unsigned f2ord(float f) { const unsigned u = __builtin_bit_cast(unsigned, f); return u ^ ((u >> 31) ? 0xFFFFFFFFu : 0x80000000u); }
__device__ __forceinline__ float ord2f(unsigned o) { const unsigned u = o ^ ((o >> 31) ? 0x80000000u : 0xFFFFFFFFu); return __builtin_bit_cast(float, u); }

__device__ __forceinline__ void phase_peer_select(const bf16* __restrict__ PQb, const bf16* __restrict__ K1, const bf16* __restrict__ K2, unsigned short* __restrict__ teid_g, float* __restrict__ tgate_g,
                                                  LAS unsigned char* lds, int vcu, int G, int wave, int lane) {
    const int fr = lane & 15, fq = lane >> 4, h = wave;
    LAS unsigned char* itab = lds + wave * 1024;
    for (int tile = vcu; tile < TA / 16; tile += G) {
        const int tok0 = tile * 16;
        unsigned tk[2][16];
#pragma unroll
        for (int half = 0; half < 2; ++half) {
            const bf16* ap = PQb + (size_t)(tok0 + fr) * PEER_N + h * 256 + half * 128 + fq * 8;
            bf16x8 a[4];
#pragma unroll
            for (int ks = 0; ks < 4; ++ks) a[ks] = *(const bf16x8*)(ap + ks * 32);
            const bf16* kb = (half ? K2 : K1) + (size_t)fr * 128 + fq * 8;
            unsigned k0[16], k1[16];
#pragma unroll
            for (int ct = 0; ct < 8; ++ct) {
                f32x4 acc = (f32x4){0.f, 0.f, 0.f, 0.f};
#pragma unroll
                for (int ks = 0; ks < 4; ++ks) { const bf16x8 b = *(const bf16x8*)(kb + (size_t)ct * 16 * 128 + ks * 32); acc = __builtin_amdgcn_mfma_f32_16x16x32_bf16(b, a[ks], acc, 0, 0, 0); }
#pragma unroll
                for (int j = 0; j < 4; ++j) { const unsigned key = (f2ord(acc[j]) & 0xFFFFFF80u) | (unsigned)(127 - (ct * 16 + 4 * fq + j));
                    if (ct < 4) k0[ct * 4 + j] = key; else k1[(ct - 4) * 4 + j] = key; }
                if (ct & 1) asm volatile("" ::: "memory");
            }
            bitonic_sort_desc<16>(k0); bitonic_sort_desc<16>(k1);
            top16_merge(k0, k1); top16_xlane(k0, 16); top16_xlane(k0, 32);
#pragma unroll
            for (int i = 0; i < 16; ++i) tk[half][i] = k0[i];
        }
        if (fq == 0) {
#pragma unroll
            for (int i = 0; i < 16; ++i) { itab[fr * 32 + i] = (unsigned char)(127 - (tk[0][i] & 0x7Fu)); itab[fr * 32 + 16 + i] = (unsigned char)(127 - (tk[1][i] & 0x7Fu)); }
        }
        unsigned ck[16];
        {
            float v1[16], v2[16];
#pragma unroll
            for (int i = 0; i < 16; ++i) { v1[i] = ord2f(tk[0][i] & 0xFFFFFF80u); v2[i] = ord2f(tk[1][i] & 0xFFFFFF80u); }
            int c = 0;
#pragma unroll
            for (int i = 0; i < 16; ++i)
#pragma unroll
                for (int j = 0; j < 16; ++j) {
                    if ((i + 1) * (j + 1) <= 16) {
                        const unsigned key = (f2ord(v1[i] + v2[j]) & 0xFFFFFF00u) | (unsigned)(255 - (i * 16 + j));
                        const int m = c >> 2, pt = c & 3;
                        if (pt == 0) ck[m] = key; else ck[m] = fq == pt ? key : ck[m];
                        ++c;
                    }
                }
            ck[12] = fq < 2 ? ck[12] : 0u; ck[13] = 0u; ck[14] = 0u; ck[15] = 0u;
        }
        bitonic_sort_desc<16>(ck); top16_xlane(ck, 16); top16_xlane(ck, 32);
        asm volatile("s_waitcnt lgkmcnt(0)" ::: "memory");
        float ev[16]; float sum = 0.f; const float mxv = ord2f(ck[0] & 0xFFFFFF00u);
#pragma unroll
        for (int k = 0; k < 16; ++k) { ev[k] = __expf(ord2f(ck[k] & 0xFFFFFF00u) - mxv); sum += ev[k]; }
        const float inv = 1.f / sum;
#pragma unroll
        for (int k = 0; k < 16; ++k) {
            if ((k >> 2) == fq) {
                const int f = 255 - (int)(ck[k] & 0xFFu); const int id = (int)itab[fr * 32 + (f >> 4)] * 128 + (int)itab[fr * 32 + 16 + (f & 15)];
                teid_g[(size_t)(tok0 + fr) * 128 + h * 16 + k] = (unsigned short)id; tgate_g[(size_t)(tok0 + fr) * 128 + h * 16 + k] = ev[k] * inv;
            }
        }
        asm volatile("s_waitcnt lgkmcnt(0)" ::: "memory");
    }
}

#if PEER_FP6
typedef unsigned v6u_t __attribute__((ext_vector_type(6)));
typedef float v32f_t __attribute__((ext_vector_type(32)));
__device__ __forceinline__ u32x4 prow_load(const unsigned char* __restrict__ T, int id, int lane) { const unsigned* rp = (const unsigned*)(T + (size_t)id * PEER_RB + lane * 12); u32x4 t; t.x = rp[0]; t.y = rp[1]; t.z = rp[2]; t.w = 0u; return t; }
#define PROW_LOAD(T, id) prow_load(T, id, lane)
#else
#define PROW_LOAD(T, id) (*(const u32x4*)((T) + (size_t)(id) * D + lane * 16))
#endif
__device__ __forceinline__ void phase_peer_mix(const float* __restrict__ Zin, const float* __restrict__ g1, const float* __restrict__ b1, const unsigned short* __restrict__ teid, const float* __restrict__ tgate,
                                               const unsigned char* __restrict__ U, const unsigned char* __restrict__ V, const float* __restrict__ Us, const float* __restrict__ Vs, const float* __restrict__ g2, const float* __restrict__ b2,
                                               float* __restrict__ outf, bf16* __restrict__ outb, int gw, int NGW, int lane) {

    for (int j = gw; j < TP + TS * 16; j += NGW) {
        size_t tok;
        if (j < TP) tok = (size_t)j;
        else { const int s = j - TP; if ((s & 15) != 0) continue; tok = (size_t)TP + (s >> 4); }
        {
            float xf[16];
            { float s1 = 0.f;
#pragma unroll
              for (int q = 0; q < 4; ++q) { const f32x4 r = *(const f32x4*)(Zin + tok * D + lane * 16 + q * 4); xf[q * 4] = r[0]; xf[q * 4 + 1] = r[1]; xf[q * 4 + 2] = r[2]; xf[q * 4 + 3] = r[3]; s1 += (r[0] + r[1]) + (r[2] + r[3]); }
#pragma unroll
              for (int o = 1; o < 64; o <<= 1) s1 += __shfl_xor(s1, o);
              const float mean1 = s1 * (1.f / D); float q1 = 0.f;
#pragma unroll
              for (int i = 0; i < 16; ++i) { xf[i] -= mean1; q1 += xf[i] * xf[i]; }
#pragma unroll
              for (int o = 1; o < 64; o <<= 1) q1 += __shfl_xor(q1, o);
              const float rstd1 = rsqrtf(q1 * (1.f / D) + LN_EPS);
#pragma unroll
              for (int q = 0; q < 4; ++q) { const f32x4 gg = *(const f32x4*)(g1 + lane * 16 + q * 4), bb = *(const f32x4*)(b1 + lane * 16 + q * 4);
#pragma unroll
                  for (int i = 0; i < 4; ++i) xf[q * 4 + i] = xf[q * 4 + i] * rstd1 * gg[i] + bb[i]; } }
            float wv0 = 0.f, wv1 = 0.f;
#pragma unroll 1
            for (int bt = 0; bt < 2; ++bt) {
                const int eidv = (int)teid[tok * 128 + bt * 64 + lane];
                float p[64];

                u32x4 qb[2][PGS];
#pragma unroll
                for (int i = 0; i < PGS; ++i) { const int id = __builtin_amdgcn_readlane(eidv, i); qb[0][i] = PROW_LOAD(U, id); }
#pragma unroll
                for (int g = 0; g < 64 / PGS; ++g) {
                    if (g < 64 / PGS - 1) {
#pragma unroll
                        for (int i = 0; i < PGS; ++i) { const int id = __builtin_amdgcn_readlane(eidv, (g + 1) * PGS + i); qb[(g + 1) & 1][i] = PROW_LOAD(U, id); }
                    }
                    asm volatile("" ::: "memory");
#if PEER_FP6
#pragma unroll
                    for (int i = 0; i < PGS; i += 2) {
                        const v6u_t pk = {qb[g & 1][i][0], qb[g & 1][i][1], qb[g & 1][i][2], qb[g & 1][i + 1][0], qb[g & 1][i + 1][1], qb[g & 1][i + 1][2]};
                        const v32f_t f = __builtin_amdgcn_cvt_scalef32_pk32_f32_fp6(pk, 1.0f);
                        float a0 = 0.f, a1 = 0.f;
#pragma unroll
                        for (int k = 0; k < 16; ++k) { a0 = fmaf(f[k], xf[k], a0); a1 = fmaf(f[16 + k], xf[k], a1); }
                        p[g * PGS + i] = a0; p[g * PGS + i + 1] = a1;
                        __builtin_amdgcn_sched_barrier(0);
                    }
#else
#pragma unroll
                    for (int i = 0; i < PGS; ++i) {
                        float a = 0.f;
#pragma unroll
                        for (int w = 0; w < 4; ++w) { const f32x2v lo = __builtin_amdgcn_cvt_pk_f32_fp8((int)qb[g & 1][i][w], false), hi = __builtin_amdgcn_cvt_pk_f32_fp8((int)qb[g & 1][i][w], true);
                            a = fmaf(lo[0], xf[w * 4], a); a = fmaf(lo[1], xf[w * 4 + 1], a); a = fmaf(hi[0], xf[w * 4 + 2], a); a = fmaf(hi[1], xf[w * 4 + 3], a); }
                        p[g * PGS + i] = a;
                        __builtin_amdgcn_sched_barrier(0);
                    }
#endif
                }

#pragma unroll
                for (int o = 32; o >= 1; o >>= 1) {
                    const bool up = (lane & o) != 0;
#pragma unroll
                    for (int i = 0; i < o; ++i) { const float keep = up ? p[i + o] : p[i], send = up ? p[i] : p[i + o]; p[i] = keep + __shfl_xor(send, o); }
                }
                const float hdot = p[0] * Us[eidv];
                const float wv = 0.5f * hdot * (1.f + erff(hdot * 0.70710678118654752f)) * tgate[tok * 128 + bt * 64 + lane] * Vs[eidv];
                if (bt == 0) wv0 = wv; else wv1 = wv;

            }

            float y[16];
#pragma unroll
            for (int i = 0; i < 16; ++i) y[i] = 0.f;
#pragma unroll 1
            for (int bt = 0; bt < 2; ++bt) {
                const int eidv = (int)teid[tok * 128 + bt * 64 + lane]; const float wvv = bt == 0 ? wv0 : wv1;
                u32x4 qb[2][PGS];
#pragma unroll
                for (int i = 0; i < PGS; ++i) { const int id = __builtin_amdgcn_readlane(eidv, i); qb[0][i] = PROW_LOAD(V, id); }
#pragma unroll
                for (int g = 0; g < 64 / PGS; ++g) {
                    if (g < 64 / PGS - 1) {
#pragma unroll
                        for (int i = 0; i < PGS; ++i) { const int id = __builtin_amdgcn_readlane(eidv, (g + 1) * PGS + i); qb[(g + 1) & 1][i] = PROW_LOAD(V, id); }
                    }
                    asm volatile("" ::: "memory");
#if PEER_FP6
#pragma unroll
                    for (int i = 0; i < PGS; i += 2) {
                        const float w0 = __builtin_bit_cast(float, __builtin_amdgcn_readlane(__builtin_bit_cast(int, wvv), g * PGS + i)), w1 = __builtin_bit_cast(float, __builtin_amdgcn_readlane(__builtin_bit_cast(int, wvv), g * PGS + i + 1));
                        asm volatile("" : "+v"(qb[g & 1][i][0]), "+v"(qb[g & 1][i][1]), "+v"(qb[g & 1][i][2]), "+v"(qb[g & 1][i + 1][0]), "+v"(qb[g & 1][i + 1][1]), "+v"(qb[g & 1][i + 1][2]));
                        const v6u_t pk = {qb[g & 1][i][0], qb[g & 1][i][1], qb[g & 1][i][2], qb[g & 1][i + 1][0], qb[g & 1][i + 1][1], qb[g & 1][i + 1][2]};
                        const v32f_t f = __builtin_amdgcn_cvt_scalef32_pk32_f32_fp6(pk, 1.0f);
#pragma unroll
                        for (int k = 0; k < 16; ++k) { y[k] = fmaf(w0, f[k], y[k]); y[k] = fmaf(w1, f[16 + k], y[k]); }
                        asm volatile("" : "+v"(y[0]), "+v"(y[1]), "+v"(y[2]), "+v"(y[3]), "+v"(y[4]), "+v"(y[5]), "+v"(y[6]), "+v"(y[7]), "+v"(y[8]), "+v"(y[9]), "+v"(y[10]), "+v"(y[11]), "+v"(y[12]), "+v"(y[13]), "+v"(y[14]), "+v"(y[15]));
                    }
#else
#pragma unroll
                    for (int i = 0; i < PGS; ++i) {
                        const float w = __builtin_bit_cast(float, __builtin_amdgcn_readlane(__builtin_bit_cast(int, wvv), g * PGS + i));
                        asm volatile("" : "+v"(qb[g & 1][i][0]), "+v"(qb[g & 1][i][1]), "+v"(qb[g & 1][i][2]), "+v"(qb[g & 1][i][3]));
#pragma unroll
                        for (int k = 0; k < 4; ++k) { const f32x2v lo = __builtin_amdgcn_cvt_pk_f32_fp8((int)qb[g & 1][i][k], false), hi = __builtin_amdgcn_cvt_pk_f32_fp8((int)qb[g & 1][i][k], true);
                            y[k * 4] = fmaf(w, lo[0], y[k * 4]); y[k * 4 + 1] = fmaf(w, lo[1], y[k * 4 + 1]); y[k * 4 + 2] = fmaf(w, hi[0], y[k * 4 + 2]); y[k * 4 + 3] = fmaf(w, hi[1], y[k * 4 + 3]); }
                        asm volatile("" : "+v"(y[0]), "+v"(y[1]), "+v"(y[2]), "+v"(y[3]), "+v"(y[4]), "+v"(y[5]), "+v"(y[6]), "+v"(y[7]), "+v"(y[8]), "+v"(y[9]), "+v"(y[10]), "+v"(y[11]), "+v"(y[12]), "+v"(y[13]), "+v"(y[14]), "+v"(y[15]));
                    }
#endif
                }
            }

            float s = 0.f;
#pragma unroll
            for (int i = 0; i < 16; ++i) { y[i] = ALPHA * xf[i] + y[i]; s += y[i]; }
#pragma unroll
            for (int o = 1; o < 64; o <<= 1) s += __shfl_xor(s, o);
            const float mean = s * (1.f / D); float qq = 0.f;
#pragma unroll
            for (int i = 0; i < 16; ++i) { y[i] -= mean; qq += y[i] * y[i]; }
#pragma unroll
            for (int o = 1; o < 64; o <<= 1) qq += __shfl_xor(qq, o);
            const float rstd = rsqrtf(qq * (1.f / D) + LN_EPS);
            u32x4 ob0, ob1;
#pragma unroll
            for (int q = 0; q < 4; ++q) { const int col = lane * 16 + q * 4; const f32x4 gg = *(const f32x4*)(g2 + col), bb = *(const f32x4*)(b2 + col);
                f32x4 o;
#pragma unroll
                for (int i = 0; i < 4; ++i) o[i] = y[q * 4 + i] * rstd * gg[i] + bb[i];
                *(f32x4*)(outf + tok * D + col) = o;
                const unsigned w0 = pk2(o[0], o[1]), w1 = pk2(o[2], o[3]);
                if (q == 0) { ob0.x = w0; ob0.y = w1; } else if (q == 1) { ob0.z = w0; ob0.w = w1; } else if (q == 2) { ob1.x = w0; ob1.y = w1; } else { ob1.z = w0; ob1.w = w1; } }
            if (outb) { *(u32x4*)(outb + tok * D + lane * 16) = ob0; *(u32x4*)(outb + tok * D + lane * 16 + 8) = ob1; }

        }
    }

}

__device__ __forceinline__ float peer_reduce16(float (&p)[16], int lane) {
#pragma unroll
    for (int o = 8; o >= 1; o >>= 1) { const bool up = (lane & (o * 4)) != 0;
#pragma unroll
        for (int k = 0; k < o; ++k) { const float keep = up ? p[k + o] : p[k], send = up ? p[k] : p[k + o]; p[k] = keep + __shfl_xor(send, o * 4); } }
    float tot = p[0];
    tot += __shfl_xor(tot, 2); tot += __shfl_xor(tot, 1);
    return tot;
}
__device__ __forceinline__ unsigned cvtpk_bf16_(float lo, float hi) { typedef __bf16 bf2 __attribute__((ext_vector_type(2))); f32x2v v = {lo, hi}; bf2 b = __builtin_convertvector(v, bf2); return __builtin_bit_cast(unsigned, b); }
__device__ __forceinline__ float peer_dot16b(const u32x4 q, const u32x4 x0, const u32x4 x1) {
    float a = 0.f;
#pragma unroll
    for (int w = 0; w < 4; ++w) { const f32x2v lo = __builtin_amdgcn_cvt_pk_f32_fp8((int)q[w], false), hi = __builtin_amdgcn_cvt_pk_f32_fp8((int)q[w], true);
        const unsigned xa = w < 2 ? x0[2 * w] : x1[2 * w - 4], xb = w < 2 ? x0[2 * w + 1] : x1[2 * w - 3];
        a = dot2bf(cvtpk_bf16_(lo[0], lo[1]), xa, a); a = dot2bf(cvtpk_bf16_(hi[0], hi[1]), xb, a); }
    return a;
}

__device__ __forceinline__ void peer_u_slice(int sl, int t_first, int t_step, const bf16* __restrict__ Hb, const unsigned short* __restrict__ teid, const unsigned char* __restrict__ U,
                                             float* __restrict__ HD, LAS unsigned char* wl, int lane) {
    LAS unsigned short* lst_e = (LAS unsigned short*)wl;
    LAS unsigned char* lst_s = wl + 512;
    const unsigned long long below = (1ull << lane) - 1ull;
    const int kk = (lane >> 2) & 15;
    if (t_first >= TA) return;
#define PU_BUILD(bsel, e0_, e1_, cnt_) do { const bool a0_ = ((e0_) >> 11) == sl, a1_ = ((e1_) >> 11) == sl; const unsigned long long m0_ = __ballot(a0_), m1_ = __ballot(a1_); \
        const int c0_ = __builtin_popcountll(m0_); cnt_ = c0_ + __builtin_popcountll(m1_); \
        if (a0_) { const int p_ = __builtin_popcountll(m0_ & below); lst_e[(bsel) * 128 + p_] = (unsigned short)(e0_); lst_s[(bsel) * 128 + p_] = (unsigned char)lane; } \
        if (a1_) { const int p_ = c0_ + __builtin_popcountll(m1_ & below); lst_e[(bsel) * 128 + p_] = (unsigned short)(e1_); lst_s[(bsel) * 128 + p_] = (unsigned char)(64 + lane); } } while (0)
#define PU_LOAD(bsel, cnt_, q_) do { _Pragma("unroll") for (int k = 0; k < 16; ++k) { if (k < (cnt_)) { const int id_ = __builtin_amdgcn_readfirstlane((int)lst_e[(bsel) * 128 + k]); q_[k] = *(const u32x4*)(U + (size_t)id_ * D + lane * 16); } } } while (0)
    int e0 = __builtin_nontemporal_load(teid + (size_t)t_first * 128 + lane), e1 = __builtin_nontemporal_load(teid + (size_t)t_first * 128 + 64 + lane);
    u32x4 xa0 = __builtin_nontemporal_load((const u32x4*)(Hb + (size_t)t_first * D + lane * 16)), xa1 = __builtin_nontemporal_load((const u32x4*)(Hb + (size_t)t_first * D + lane * 16 + 8));
    int cnt; PU_BUILD(0, e0, e1, cnt);
    asm volatile("s_waitcnt lgkmcnt(0)" ::: "memory");
    u32x4 q[16];
    PU_LOAD(0, cnt, q);
    int buf = 0;

    for (int t = t_first; t < TA; t += t_step, buf ^= 1) {
        const int tn = t + t_step; const bool hasn = tn < TA;
        u32x4 xb0 = xa0, xb1 = xa1; int f0 = 0, f1 = 0;
        if (hasn) { f0 = __builtin_nontemporal_load(teid + (size_t)tn * 128 + lane); f1 = __builtin_nontemporal_load(teid + (size_t)tn * 128 + 64 + lane);
            xb0 = __builtin_nontemporal_load((const u32x4*)(Hb + (size_t)tn * D + lane * 16)); xb1 = __builtin_nontemporal_load((const u32x4*)(Hb + (size_t)tn * D + lane * 16 + 8)); }

        float pr[16];
#pragma unroll
        for (int k = 0; k < 16; ++k) pr[k] = k < cnt ? peer_dot16b(q[k], xa0, xa1) : 0.f;

#pragma unroll 1
        for (int p0 = 16; p0 < cnt; p0 += 16) {
            u32x4 q2[16];
#pragma unroll
            for (int k = 0; k < 16; ++k) { if (p0 + k < cnt) { const int id_ = __builtin_amdgcn_readfirstlane((int)lst_e[buf * 128 + p0 + k]); q2[k] = *(const u32x4*)(U + (size_t)id_ * D + lane * 16); } }
            float pr2[16];
#pragma unroll
            for (int k = 0; k < 16; ++k) pr2[k] = p0 + k < cnt ? peer_dot16b(q2[k], xa0, xa1) : 0.f;
            const float tot2 = peer_reduce16(pr2, lane);
            if (p0 + kk < cnt && (lane & 3) == 0) __builtin_nontemporal_store(tot2, HD + (size_t)t * 128 + lst_s[buf * 128 + p0 + kk]);
        }

        int cntn = 0;
        if (hasn) { PU_BUILD(buf ^ 1, f0, f1, cntn); }
        asm volatile("s_waitcnt lgkmcnt(0)" ::: "memory");
        if (hasn) PU_LOAD(buf ^ 1, cntn, q);

        const float tot = peer_reduce16(pr, lane);
        if (kk < cnt && (lane & 3) == 0) __builtin_nontemporal_store(tot, HD + (size_t)t * 128 + lst_s[buf * 128 + kk]);
        xa0 = xb0; xa1 = xb1; cnt = cntn;

    }

#undef PU_BUILD
#undef PU_LOAD
}

__device__ __forceinline__ void phase_peer_mixv(const float* __restrict__ Zin, const float* __restrict__ g1, const float* __restrict__ b1, const unsigned short* __restrict__ teid, const float* __restrict__ tgate, const float* __restrict__ HD,
                                                const unsigned char* __restrict__ V, const float* __restrict__ Us, const float* __restrict__ Vs, const float* __restrict__ g2, const float* __restrict__ b2,
                                                float* __restrict__ outf, bf16* __restrict__ outb, int gw, int NGW, int lane) {
    for (int j = gw; j < TP + TS * 16; j += NGW) {
        size_t tok;
        if (j < TP) tok = (size_t)j;
        else { const int s = j - TP; if ((s & 15) != 0) continue; tok = (size_t)TP + (s >> 4); }
        float xf[16];
        { float s1 = 0.f;
#pragma unroll
          for (int q = 0; q < 4; ++q) { const f32x4 r = *(const f32x4*)(Zin + tok * D + lane * 16 + q * 4); xf[q * 4] = r[0]; xf[q * 4 + 1] = r[1]; xf[q * 4 + 2] = r[2]; xf[q * 4 + 3] = r[3]; s1 += (r[0] + r[1]) + (r[2] + r[3]); }
#pragma unroll
          for (int o = 1; o < 64; o <<= 1) s1 += __shfl_xor(s1, o);
          const float mean1 = s1 * (1.f / D); float q1 = 0.f;
#pragma unroll
          for (int i = 0; i < 16; ++i) { xf[i] -= mean1; q1 += xf[i] * xf[i]; }
#pragma unroll
          for (int o = 1; o < 64; o <<= 1) q1 += __shfl_xor(q1, o);
          const float rstd1 = rsqrtf(q1 * (1.f / D) + LN_EPS);
#pragma unroll
          for (int q = 0; q < 4; ++q) { const f32x4 gg = *(const f32x4*)(g1 + lane * 16 + q * 4), bb = *(const f32x4*)(b1 + lane * 16 + q * 4);
#pragma unroll
              for (int i = 0; i < 4; ++i) xf[q * 4 + i] = xf[q * 4 + i] * rstd1 * gg[i] + bb[i]; } }
        float y[16];
#pragma unroll
        for (int i = 0; i < 16; ++i) y[i] = 0.f;
#pragma unroll 1
        for (int bt = 0; bt < 2; ++bt) {
            const int eidv = (int)teid[tok * 128 + bt * 64 + lane];
            const float hd = HD[tok * 128 + bt * 64 + lane] * Us[eidv];
            const float wvv = 0.5f * hd * (1.f + erff(hd * 0.70710678118654752f)) * tgate[tok * 128 + bt * 64 + lane] * Vs[eidv];
            u32x4 qb[2][PGS];
#pragma unroll
            for (int i = 0; i < PGS; ++i) { const int id = __builtin_amdgcn_readlane(eidv, i); qb[0][i] = PROW_LOAD(V, id); }
#pragma unroll
            for (int g = 0; g < 64 / PGS; ++g) {
                if (g < 64 / PGS - 1) {
#pragma unroll
                    for (int i = 0; i < PGS; ++i) { const int id = __builtin_amdgcn_readlane(eidv, (g + 1) * PGS + i); qb[(g + 1) & 1][i] = PROW_LOAD(V, id); }
                }
                asm volatile("" ::: "memory");
#pragma unroll
                for (int i = 0; i < PGS; ++i) {
                    const float w = __builtin_bit_cast(float, __builtin_amdgcn_readlane(__builtin_bit_cast(int, wvv), g * PGS + i));
                    asm volatile("" : "+v"(qb[g & 1][i][0]), "+v"(qb[g & 1][i][1]), "+v"(qb[g & 1][i][2]), "+v"(qb[g & 1][i][3]));
#pragma unroll
                    for (int k = 0; k < 4; ++k) { const f32x2v lo = __builtin_amdgcn_cvt_pk_f32_fp8((int)qb[g & 1][i][k], false), hi = __builtin_amdgcn_cvt_pk_f32_fp8((int)qb[g & 1][i][k], true);
                        y[k * 4] = fmaf(w, lo[0], y[k * 4]); y[k * 4 + 1] = fmaf(w, lo[1], y[k * 4 + 1]); y[k * 4 + 2] = fmaf(w, hi[0], y[k * 4 + 2]); y[k * 4 + 3] = fmaf(w, hi[1], y[k * 4 + 3]); }
                    asm volatile("" : "+v"(y[0]), "+v"(y[1]), "+v"(y[2]), "+v"(y[3]), "+v"(y[4]), "+v"(y[5]), "+v"(y[6]), "+v"(y[7]), "+v"(y[8]), "+v"(y[9]), "+v"(y[10]), "+v"(y[11]), "+v"(y[12]), "+v"(y[13]), "+v"(y[14]), "+v"(y[15]));
                }
            }
        }
        float s = 0.f;
#pragma unroll
        for (int i = 0; i < 16; ++i) { y[i] = ALPHA * xf[i] + y[i]; s += y[i]; }
#pragma unroll
        for (int o = 1; o < 64; o <<= 1) s += __shfl_xor(s, o);
        const float mean = s * (1.f / D); float qq = 0.f;
#pragma unroll
        for (int i = 0; i < 16; ++i) { y[i] -= mean; qq += y[i] * y[i]; }
#pragma unroll
        for (int o = 1; o < 64; o <<= 1) qq += __shfl_xor(qq, o);
        const float rstd = rsqrtf(qq * (1.f / D) + LN_EPS);
        u32x4 ob0, ob1;
#pragma unroll
        for (int q = 0; q < 4; ++q) { const int col = lane * 16 + q * 4; const f32x4 gg = *(const f32x4*)(g2 + col), bb = *(const f32x4*)(b2 + col);
            f32x4 o;
#pragma unroll
            for (int i = 0; i < 4; ++i) o[i] = y[q * 4 + i] * rstd * gg[i] + bb[i];
            *(f32x4*)(outf + tok * D + col) = o;
            const unsigned w0 = pk2(o[0], o[1]), w1 = pk2(o[2], o[3]);
            if (q == 0) { ob0.x = w0; ob0.y = w1; } else if (q == 1) { ob0.z = w0; ob0.w = w1; } else if (q == 2) { ob1.x = w0; ob1.y = w1; } else { ob1.z = w0; ob1.w = w1; } }
        if (outb) { *(u32x4*)(outb + tok * D + lane * 16) = ob0; *(u32x4*)(outb + tok * D + lane * 16 + 8) = ob1; }
    }
}
}

namespace mk {
struct FGlaIn {
    bf16 *Gq, *Gk, *Gv, *Gr; float* GD;
    __device__ __forceinline__ static float silu(float r) { return r / (1.f + __expf(-r)); }
    __device__ __forceinline__ void put8(int row, int col, f32x4 v0, f32x4 v1) const {
        if (col < GN_K) *(u32x4*)(Gq + (size_t)row * 512 + col) = pack8(v0, v1);
        else if (col < GN_V) *(u32x4*)(Gk + (size_t)row * 512 + (col - GN_K)) = pack8(v0, v1);
        else if (col < GN_R) *(u32x4*)(Gv + (size_t)row * 1024 + (col - GN_V)) = pack8(v0, v1);
        else { f32x4 a, b;
#pragma unroll
            for (int i = 0; i < 4; ++i) { a[i] = silu(v0[i]); b[i] = silu(v1[i]); }
            *(u32x4*)(Gr + (size_t)row * 1024 + (col - GN_R)) = pack8(a, b); }
    }
    __device__ __forceinline__ void put4(int row, int col, f32x4 v) const {
        u32x2 w; w.x = pk2(v[0], v[1]); w.y = pk2(v[2], v[3]);
        if (col < GN_K) *(u32x2*)(Gq + (size_t)row * 512 + col) = w;
        else if (col < GN_V) *(u32x2*)(Gk + (size_t)row * 512 + (col - GN_K)) = w;
        else if (col < GN_R) *(u32x2*)(Gv + (size_t)row * 1024 + (col - GN_V)) = w;
        else if (col < GN_GD) { u32x2 s; s.x = pk2(silu(v[0]), silu(v[1])); s.y = pk2(silu(v[2]), silu(v[3])); *(u32x2*)(Gr + (size_t)row * 1024 + (col - GN_R)) = s; }
        else if (col < GN_GD + 16) *(f32x4*)(GD + (size_t)row * 16 + (col - GN_GD)) = v;
    }
};

__device__ __forceinline__ float log_sigmoid_f(float x) { return fminf(x, 0.f) - log1pf(__expf(-fabsf(x))); }
__device__ __forceinline__ bf16x8 tr8(LAS unsigned char* a0, LAS unsigned char* a1) { const s16x4 v0 = lds_tr(a0), v1 = lds_tr(a1); bf16x8 r; r[0] = v0[0]; r[1] = v0[1]; r[2] = v0[2]; r[3] = v0[3]; r[4] = v1[0]; r[5] = v1[1]; r[6] = v1[2]; r[7] = v1[3]; return r; }

constexpr int KD_ST = 272, V_ST = 528;
constexpr int GL_LB = 0, GL_TOT = 32768, GL_KD = 36864, GL_V = GL_KD + 64 * KD_ST  , GL_END = GL_V + 64 * V_ST;
static_assert(GL_END <= RING_BYTES, "GLA chunk LDS");

__device__ __forceinline__ void gla_chunk_item(int item, const bf16* __restrict__ Gq, const bf16* __restrict__ Gk, const bf16* __restrict__ Gv, const float* __restrict__ GD,
                                               const float* __restrict__ Wgu, const float* __restrict__ bg, bf16* __restrict__ QT, bf16* __restrict__ KT, float* __restrict__ DEC, float* __restrict__ DS,
                                               LAS unsigned char* lds, int tid, int wave, int lane) {
    const int h = item & 3, bc = item >> 2;
    const size_t tok0 = (size_t)bc * 64;
    LAS float* LB = (LAS float*)(lds + GL_LB);
    LAS float* TOT = (LAS float*)(lds + GL_TOT);
    const int d = tid & 127, tq = tid >> 7;
    float wg[16];
#pragma unroll
    for (int r = 0; r < 16; ++r) wg[r] = Wgu[r * 512 + h * 128 + d];
    const float bgd = bg[h * 128 + d];
    float pre[16]; float run = 0.f;
#pragma unroll
    for (int i = 0; i < 16; ++i) {
        const float* gd = GD + (tok0 + tq * 16 + i) * 16;
        const f32x4 g0 = *(const f32x4*)gd, g1 = *(const f32x4*)(gd + 4), g2 = *(const f32x4*)(gd + 8), g3 = *(const f32x4*)(gd + 12);
        float x = 0.f;
#pragma unroll
        for (int r = 0; r < 4; ++r) { x = fmaf(g0[r], wg[r], x); }
#pragma unroll
        for (int r = 0; r < 4; ++r) { x = fmaf(g1[r], wg[4 + r], x); }
#pragma unroll
        for (int r = 0; r < 4; ++r) { x = fmaf(g2[r], wg[8 + r], x); }
#pragma unroll
        for (int r = 0; r < 4; ++r) { x = fmaf(g3[r], wg[12 + r], x); }
        run += log_sigmoid_f(x + bgd) * (1.f / 16.f); pre[i] = run;
    }
    TOT[tq * 128 + d] = run;
    __syncthreads();
    float off = 0.f;
#pragma unroll
    for (int q = 0; q < 3; ++q) if (q < tq) off += TOT[q * 128 + d];
    const float bC = (TOT[d] + TOT[128 + d]) + (TOT[256 + d] + TOT[384 + d]);
#pragma unroll
    for (int i = 0; i < 16; ++i) {
        const int t = tq * 16 + i; const float b = pre[i] + off; const size_t tok = tok0 + t;
        const float q = bf2f(Gq[tok * 512 + h * 128 + d]), k = bf2f(Gk[tok * 512 + h * 128 + d]);
        QT[tok * 512 + h * 128 + d] = (bf16)f2bf(q * 0.08838834764831845f * __expf(b));
        KT[tok * 512 + h * 128 + d] = (bf16)f2bf(k * __expf(-b));
        *(LAS bf16*)(lds + GL_KD + t * KD_ST + d * 2) = (bf16)f2bf(k * __expf(bC - b));
    }
    if (tq == 0) DEC[(size_t)item * 128 + d] = __expf(bC);
#pragma unroll
    for (int p = 0; p < 4; ++p) { const int e = tid + p * 512, s = e >> 5, ch = e & 31;
        *(LAS u32x4*)(lds + GL_V + s * V_ST + ch * 16) = *(const u32x4*)(Gv + (tok0 + s) * 1024 + h * 256 + ch * 8); }
    __syncthreads();
    const int fr = lane & 15, fq = lane >> 4, dt = wave;
    bf16x8 af[2];
#pragma unroll
    for (int ks = 0; ks < 2; ++ks) { LAS unsigned char* a0 = lds + GL_KD + (ks * 32 + fq * 8 + (fr >> 2)) * KD_ST + (dt * 16 + 4 * (fr & 3)) * 2; af[ks] = tr8(a0, a0 + 4 * KD_ST); }
    float* dsb = DS + (size_t)item * 256 * 128;
#pragma unroll 4
    for (int vt = 0; vt < 16; ++vt) {
        f32x4 acc = (f32x4){0.f, 0.f, 0.f, 0.f};
#pragma unroll
        for (int ks = 0; ks < 2; ++ks) { LAS unsigned char* b0 = lds + GL_V + (ks * 32 + fq * 8 + (fr >> 2)) * V_ST + (vt * 16 + 4 * (fr & 3)) * 2; const bf16x8 bf = tr8(b0, b0 + 4 * V_ST);
            acc = __builtin_amdgcn_mfma_f32_16x16x32_bf16(af[ks], bf, acc, 0, 0, 0); }
        *(f32x4*)(dsb + (size_t)(vt * 16 + fr) * 128 + dt * 16 + fq * 4) = acc;
    }
    __syncthreads();
}

__device__ __forceinline__ void gla_sample_item(int item, const bf16* __restrict__ Gq, const bf16* __restrict__ Gk, const bf16* __restrict__ Gv, const bf16* __restrict__ Gr, const float* __restrict__ GD,
                                                const float* __restrict__ Wgu, const float* __restrict__ bg, const float* __restrict__ ng, const float* __restrict__ S0, float* __restrict__ Sout, bf16* __restrict__ OGb,
                                                LAS unsigned char* lds, int tid, int lane) {
    const int b = item >> 2, h = item & 3;
    LAS float* A = (LAS float*)lds;
    LAS float* Qs = A + 512; LAS float* Ks = Qs + 512;
    LAS float* PO = Ks + 512;
    LAS float* RS = PO + 4096;
    { const int t = tid >> 7, d = tid & 127; const size_t tok = (size_t)TP + b * DS + t;
      float x = bg[h * 128 + d]; const float* gd = GD + tok * 16; float xs = 0.f;
#pragma unroll
      for (int r = 0; r < 16; ++r) xs = fmaf(gd[r], Wgu[r * 512 + h * 128 + d], xs);
      x += xs;
      A[t * 128 + d] = __expf(log_sigmoid_f(x) * (1.f / 16.f));
      Qs[t * 128 + d] = bf2f(Gq[tok * 512 + h * 128 + d]) * 0.08838834764831845f; Ks[t * 128 + d] = bf2f(Gk[tok * 512 + h * 128 + d]); }
    __syncthreads();
    const int dq = tid >> 7, d0 = dq * 32;
#pragma unroll 1
    for (int vhalf = 0; vhalf < 2; ++vhalf) {
        const int v = vhalf * 128 + (tid & 127);
        float S[32];
#pragma unroll
        for (int i = 0; i < 32; ++i) S[i] = S0[(((size_t)b * 4 + h) * 128 + d0 + i) * 256 + v];
#pragma unroll 1
        for (int t = 0; t < 4; ++t) {
            const float vv = bf2f(Gv[((size_t)TP + b * DS + t) * 1024 + h * 256 + v]); float o = 0.f;
#pragma unroll
            for (int i = 0; i < 32; ++i) { S[i] = fmaf(A[t * 128 + d0 + i], S[i], Ks[t * 128 + d0 + i] * vv); o = fmaf(Qs[t * 128 + d0 + i], S[i], o); }
            PO[(dq * 4 + t) * 256 + v] = o;
        }
#pragma unroll
        for (int i = 0; i < 32; ++i) Sout[(((size_t)b * 4 + h) * 128 + d0 + i) * 256 + v] = S[i];
    }
    __syncthreads();
    { const int t = tid >> 7, vl = tid & 127; const float o0 = (PO[t * 256 + vl] + PO[(4 + t) * 256 + vl]) + (PO[(8 + t) * 256 + vl] + PO[(12 + t) * 256 + vl]), o1 = (PO[t * 256 + 128 + vl] + PO[(4 + t) * 256 + 128 + vl]) + (PO[(8 + t) * 256 + 128 + vl] + PO[(12 + t) * 256 + 128 + vl]);
      float ss = o0 * o0 + o1 * o1;
#pragma unroll
      for (int o = 1; o < 64; o <<= 1) ss += __shfl_xor(ss, o);
      if (lane == 0) RS[tid >> 6] = ss;
      __syncthreads();
      const float ms = (RS[2 * t] + RS[2 * t + 1]) * (1.f / 256.f), rstd = rsqrtf(ms + LN_EPS);
      const size_t tok = (size_t)TP + b * DS + t;
      OGb[tok * 1024 + h * 256 + vl] = (bf16)f2bf(o0 * rstd * ng[vl] * bf2f(Gr[tok * 1024 + h * 256 + vl]));
      OGb[tok * 1024 + h * 256 + 128 + vl] = (bf16)f2bf(o1 * rstd * ng[128 + vl] * bf2f(Gr[tok * 1024 + h * 256 + 128 + vl])); }
    __syncthreads();
}

__device__ __forceinline__ void gla_scan(const float* __restrict__ DS, const float* __restrict__ DEC, bf16* __restrict__ SP, float* __restrict__ Sout, int gtid, int gthreads) {
    typedef float f32x2 __attribute__((ext_vector_type(2)));
    for (int e = gtid; e < NBATCH * 4 * 256 * 64; e += gthreads) {
        const int d2 = e & 63, v = (e >> 6) & 255, h = (e >> 14) & 3, b = e >> 16;
        f32x2 S = (f32x2){0.f, 0.f};
#pragma unroll 8
        for (int c = 0; c < SEQ / 64; ++c) {
            const size_t item = ((size_t)b * (SEQ / 64) + c) * 4 + h;
            const f32x2 ds = *(const f32x2*)(DS + (item * 256 + v) * 128 + d2 * 2), dc = *(const f32x2*)(DEC + item * 128 + d2 * 2);
            *(unsigned*)(SP + (item * 256 + v) * 128 + d2 * 2) = pk2(S[0], S[1]);
            S = dc * S + ds;
        }
        float* so = Sout + (((size_t)b * 4 + h) * 128 + d2 * 2) * 256 + v; so[0] = S[0]; so[256] = S[1];
    }
}

__device__ __forceinline__ void gla_out_item(int item, const bf16* __restrict__ QT, const bf16* __restrict__ KT, const bf16* __restrict__ Gv, const bf16* __restrict__ Gr, const bf16* __restrict__ SP,
                                             const float* __restrict__ ng, bf16* __restrict__ OGb, LAS unsigned char* lds, int tid, int wave, int lane) {
    const int h = item & 3, bc = item >> 2; const size_t tok0 = (size_t)bc * 64;
    const int fr = lane & 15, fq = lane >> 4, tt = wave & 3, vh = wave >> 2;
    LAS float* RS = (LAS float*)(lds + 64 * V_ST);
#pragma unroll
    for (int p = 0; p < 4; ++p) { const int e = tid + p * 512, s = e >> 5, ch = e & 31;
        *(LAS u32x4*)(lds + s * V_ST + ch * 16) = *(const u32x4*)(Gv + (tok0 + s) * 1024 + h * 256 + ch * 8); }
    bf16x8 qf[4];
#pragma unroll
    for (int ks = 0; ks < 4; ++ks) qf[ks] = *(const bf16x8*)(QT + (tok0 + tt * 16 + fr) * 512 + h * 128 + ks * 32 + fq * 8);
    bf16x8 pf[2];
    {
        f32x4 at[4];
#pragma unroll
        for (int st = 0; st < 4; ++st) {
            f32x4 acc = (f32x4){0.f, 0.f, 0.f, 0.f};
#pragma unroll
            for (int ks = 0; ks < 4; ++ks) { const bf16x8 kf = *(const bf16x8*)(KT + (tok0 + st * 16 + fr) * 512 + h * 128 + ks * 32 + fq * 8); acc = __builtin_amdgcn_mfma_f32_16x16x32_bf16(kf, qf[ks], acc, 0, 0, 0); }
#pragma unroll
            for (int j = 0; j < 4; ++j) { const int s = st * 16 + fq * 4 + j, t = tt * 16 + fr; if (s > t) acc[j] = 0.f; }
            at[st] = acc;
        }
        const u32x4 w0 = pack8(at[0], at[1]), w1 = pack8(at[2], at[3]);
        pf[0] = __builtin_bit_cast(bf16x8, w0); pf[1] = __builtin_bit_cast(bf16x8, w1);
    }
    __syncthreads();
    const bf16* spb = SP + (size_t)item * 256 * 128;
    f32x4 oacc[8]; float ss = 0.f;
#pragma unroll
    for (int i = 0; i < 8; ++i) {
        const int vt = vh * 8 + i;
        f32x4 acc = (f32x4){0.f, 0.f, 0.f, 0.f};
#pragma unroll
        for (int k2 = 0; k2 < 2; ++k2) {
            LAS unsigned char* a0 = lds + (k2 * 32 + fq * 4 + (fr >> 2)) * V_ST + (vt * 16 + 4 * (fr & 3)) * 2;
            const bf16x8 vf = tr8(a0, a0 + 16 * V_ST);
            acc = __builtin_amdgcn_mfma_f32_16x16x32_bf16(vf, pf[k2], acc, 0, 0, 0);
        }
#pragma unroll
        for (int ks = 0; ks < 4; ++ks) { const bf16x8 sf = *(const bf16x8*)(spb + (size_t)(vt * 16 + fr) * 128 + ks * 32 + fq * 8); acc = __builtin_amdgcn_mfma_f32_16x16x32_bf16(sf, qf[ks], acc, 0, 0, 0); }
        oacc[i] = acc; ss += (acc[0] * acc[0] + acc[1] * acc[1]) + (acc[2] * acc[2] + acc[3] * acc[3]);
    }
    ss += __shfl_xor(ss, 16); ss += __shfl_xor(ss, 32);
    if (fq == 0) RS[wave * 16 + fr] = ss;
    __syncthreads();
    const float ms = (RS[tt * 16 + fr] + RS[(tt + 4) * 16 + fr]) * (1.f / 256.f), rstd = rsqrtf(ms + LN_EPS);
    const size_t tok = tok0 + tt * 16 + fr;
#pragma unroll
    for (int i = 0; i < 8; ++i) {
        const int v = (vh * 8 + i) * 16 + fq * 4;
        const u32x2 rw = *(const u32x2*)(Gr + tok * 1024 + h * 256 + v); const f32x4 g = *(const f32x4*)(ng + v);
        u32x2 w; w.x = pk2(oacc[i][0] * rstd * g[0] * bflo(rw.x), oacc[i][1] * rstd * g[1] * bfhi(rw.x)); w.y = pk2(oacc[i][2] * rstd * g[2] * bflo(rw.y), oacc[i][3] * rstd * g[3] * bfhi(rw.y));
        *(u32x2*)(OGb + tok * 1024 + h * 256 + v) = w;
    }
    __syncthreads();
}
}

namespace mk {
#ifndef MIX_V2
#define MIX_V1 1
#endif
#if defined(MIX_V1)
#define MIXSEL(Hf, te, tg, U, V, Us, Vs, g2, b2, of, ob, lds, wave, gw, NGW, lane) phase_peer_mix(Hf, te, tg, U, V, Us, Vs, g2, b2, of, ob, gw, NGW, lane)
#define MIX_FROM_Z 1
#else
#define MIXSEL(Hf, te, tg, U, V, Us, Vs, g2, b2, of, ob, lds, wave, gw, NGW, lane) phase_peer_mix2(Hf, H1b, te, tg, U, V, Us, Vs, g2, b2, of, ob, lds, wave, gw, NGW, lane)
#endif
#define PEER_USLICE(Hb_, U_, Us_) do { if (G % 8 == 0) { const int per_ = G / 8; peer_u_slice(vcu / per_, (vcu % per_) * NWAVES + wave, per_ * NWAVES, Hb_, TEID, U_, HDB, lds + wave * 16384, lane); } \
        else { for (int sl_ = 0; sl_ < 8; ++sl_) peer_u_slice(sl_, gw, NGW, Hb_, TEID, U_, HDB, lds + wave * 16384, lane); } } while (0)
struct Args {
    const float* in[23]; const int* page_table; float* out; unsigned char* ws; int ph_lo, ph_hi;
};
enum Phase { P_PRO = 0, P_AIN = 1, P_SCORE = 2, P_TOPK = 3, P_ATTN = 4, P_AOUT = 5, P_LN1 = 6, P_PQ0 = 7, P_PEER0 = 8, P_GIN = 9, P_GCH = 10, P_GSC = 11, P_GOUT = 12, P_GPRJ = 13, P_LN1B = 14, P_PQ1 = 15, P_PEER1 = 16, P_COUNT = 17 };

#define Wa ((bf16*)(ws + WS_WA))
#define Wo ((bf16*)(ws + WS_WO))
#define Wg ((bf16*)(ws + WS_WG))
#define Wgo ((bf16*)(ws + WS_WGO))
#define Wpq ((bf16*)(ws + WS_WPQ))
#define PK ((bf16*)(ws + WS_PK))
#define Usc ((float*)(ws + WS_USC))
#define Xb ((bf16*)(ws + WS_XB))
#define Qb ((bf16*)(ws + WS_QB))
#define QIb ((bf16*)(ws + WS_QIB))
#define Kb ((bf16*)(ws + WS_KB))
#define Vb ((bf16*)(ws + WS_VB))
#define KIb ((bf16*)(ws + WS_KIB))
#define WIf ((float*)(ws + WS_WIF))
#define SC ((float*)(ws + WS_SC))
#define SCS ((float*)(ws + WS_SCS))
#define IDX ((int*)(ws + WS_IDX))
#define CNT ((int*)(ws + WS_CNT))
#define Ob ((bf16*)(ws + WS_OB))
#define Z ((float*)(ws + WS_Z))
#define H1f ((float*)(ws + WS_H1F))
#define H1b ((bf16*)(ws + WS_H1B))
#define PQb ((bf16*)(ws + WS_PQB))
#define H2f ((float*)(ws + WS_H2F))
#define H2b ((bf16*)(ws + WS_H2B))
#define TEID ((unsigned short*)(ws + WS_TEID))
#define TGATE ((float*)(ws + WS_TGATE))
#define Gq ((bf16*)(ws + WS_GQ))
#define Gk ((bf16*)(ws + WS_GK))
#define Gv ((bf16*)(ws + WS_GV))
#define Gr ((bf16*)(ws + WS_GR))
#define GD ((float*)(ws + WS_GD))
#define QT ((bf16*)(ws + WS_QT))
#define KT ((bf16*)(ws + WS_KT))
#define DEC ((float*)(ws + WS_DEC))
#define DSb ((float*)(ws + WS_DS))
#define SPV ((bf16*)(ws + WS_SPREV))
#define OGb ((bf16*)(ws + WS_OGB))
#define HDB ((float*)(ws + WS_HD))
#define KV8 ((unsigned char*)(ws + WS_KV8))
#define Uq (ws + WS_UB)
#define Vq (ws + WS_VBX)
#define Usc ((float*)(ws + WS_USC))
#define Vsc ((float*)(ws + WS_USC) + 2 * 16384)
#define x_prompt (INP(0))
#define x_sample (INP(1))
#define attn_w_in (INP(7))
#define attn_w_out (INP(8))
#define gla_w_in (INP(9))
#define gla_w_out (INP(13))
#define peer_w_q (INP(14))
#define peer_keys1 (INP(15))
#define peer_keys2 (INP(16))
#define peer_u (INP(17))
#define peer_v (INP(18))
__device__ __forceinline__ unsigned char* launder_ptr(unsigned char* p) { asm volatile("" : "+s"(p)); return p; }
#if defined(LOWSGPR)
#define ws (launder_ptr(args.ws))
#define INP(k) ((const float*)inp_ptr(lds, (k)))
#else
#define ws (args.ws)
#define INP(k) (args.in[k])
#endif
__device__ __forceinline__ const void* inp_ptr(LAS unsigned char* lds, int k) {
    const unsigned long long v = *(LAS unsigned long long*)(lds + INPTAB_OFF + 8 * k);
    const unsigned lo = __builtin_amdgcn_readfirstlane((unsigned)v), hi = __builtin_amdgcn_readfirstlane((unsigned)(v >> 32));
    return (const void*)(((unsigned long long)hi << 32) | lo);
}
__global__ void __launch_bounds__(NTHREADS, 2) mk_fwd(Args args) {
    extern __shared__ __attribute__((aligned(16))) unsigned char lds_raw[];
    LAS unsigned char* lds = (LAS unsigned char*)lds_raw;
    volatile LAS unsigned* MISC = (volatile LAS unsigned*)(lds + MISC_OFF);
    const int tid = threadIdx.x, lane = tid & 63, wave = __builtin_amdgcn_readfirstlane(tid >> 6);
    const int G = gridDim.x, bx = blockIdx.x;
    const int vcu = (G % 8 == 0) ? (bx % 8) * (G / 8) + bx / 8 : bx;
    const int gw = vcu * NWAVES + wave, NGW = G * NWAVES;
    gu32* ctl = (gu32*)(ws + WS_CTL);
    for (int u = tid; u < (LDS_BYTES - LDSCTL_OFF) / 4; u += NTHREADS) ((LAS unsigned*)(lds + LDSCTL_OFF))[u] = 0u;
    __syncthreads();
    if (tid == 0) {
#define PUTIN(k) *(LAS unsigned long long*)(lds + INPTAB_OFF + 8 * (k)) = (unsigned long long)args.in[k]
        PUTIN(0); PUTIN(1); PUTIN(2); PUTIN(3); PUTIN(4); PUTIN(5); PUTIN(6); PUTIN(7); PUTIN(8); PUTIN(9); PUTIN(10); PUTIN(11); PUTIN(12); PUTIN(13); PUTIN(14); PUTIN(15);
        PUTIN(16); PUTIN(17); PUTIN(18); PUTIN(19); PUTIN(20); PUTIN(21); PUTIN(22);
#undef PUTIN
    }
    __syncthreads();
    XcdBarrier bar = xcd_barrier_post((unsigned*)(ctl + CW_BAR), MISC + 8);
    if (tid == 0) { const unsigned xme = xb_xcc_id(); MISC[13] = xme; MISC[12] = __hip_atomic_fetch_add((unsigned*)(ctl + CW_XC + 64 * xme), 1u, __ATOMIC_RELAXED, __HIP_MEMORY_SCOPE_AGENT); }
    const int lo = args.ph_lo, hi = args.ph_hi;
#define IN(k) (lo <= (k) && (k) < hi)
#define SEAM(k) do { if (IN(k) && IN((k) + 1)) xcd_barrier(bar); } while (0)
#ifndef REPEAT_PHASE
#define REPEAT_PHASE -1
#endif
#ifndef REPEAT_N
#define REPEAT_N 2
#endif
#define REP(k) for (int rep_ = 0; rep_ < (REPEAT_PHASE == (k) ? REPEAT_N : 1); ++rep_)


    if (IN(P_PRO)) {
        LAS float* scr = (LAS float*)(lds + wave * 16384);
        constexpr int KB16 = D / 64;
        constexpr int I_WA = (WA_ROWS / 32) * KB16, I_WO = (D / 32) * KB16, I_WG = (WG_ROWS / 32) * KB16, I_WGO = (D / 32) * KB16, I_WPQ = 2 * (PEER_N / 32) * KB16;
        constexpr int NITEMS = I_WA + I_WO + I_WG + I_WGO + I_WPQ;
        for (int it = gw; it < NITEMS; it += NGW) {
            int r = it;
            if (r < I_WA) { const int nb = r / KB16, kb = r % KB16, d0 = nb * 32; const int nv = ATT_N - d0 < 0 ? 0 : (ATT_N - d0 > 32 ? 32 : ATT_N - d0);
                p0_transpose_item(attn_w_in, ATT_N, D, Wa, d0, d0, nv, kb * 64, scr, lane); continue; } r -= I_WA;
            if (r < I_WO) { const int nb = r / KB16, kb = r % KB16; p0_transpose_item(attn_w_out, D, D, Wo, nb * 32, nb * 32, 32, kb * 64, scr, lane); continue; } r -= I_WO;
            if (r < I_WG) { const int nb = r / KB16, kb = r % KB16, d0 = nb * 32; int s0, nv;
                if (d0 < GN_R) { s0 = d0; nv = 32; } else if (d0 < GN_GD) { s0 = GR + (d0 - GN_R); nv = 32; } else if (d0 == GN_GD) { s0 = GGD; nv = 16; } else { s0 = 0; nv = 0; }
                p0_transpose_item(gla_w_in, GLA_N, D, Wg, d0, s0, nv, kb * 64, scr, lane); continue; } r -= I_WG;
            if (r < I_WGO) { const int nb = r / KB16, kb = r % KB16; p0_transpose_item(gla_w_out, D, D, Wgo, nb * 32, nb * 32, 32, kb * 64, scr, lane); continue; } r -= I_WGO;
            { const int l = r / ((PEER_N / 32) * KB16), rr = r % ((PEER_N / 32) * KB16), nb = rr / KB16, kb = rr % KB16;
              p0_transpose_item(peer_w_q + (size_t)l * D * PEER_N, PEER_N, D, Wpq + (size_t)l * PEER_N * D, nb * 32, nb * 32, 32, kb * 64, scr, lane); }
        }
        p0_convert(x_prompt, Xb, (size_t)TP * D / 8, gw, NGW, lane);
        p0_convert(x_sample, Xb + (size_t)TP * D, (size_t)TS * D / 8, gw, NGW, lane);
        p0_convert(peer_keys1, PK, (size_t)2 * 128 * 128 / 8, gw, NGW, lane);
        p0_convert(peer_keys2, PK + 2 * 128 * 128, (size_t)2 * 128 * 128 / 8, gw, NGW, lane);
    }
    SEAM(P_PRO);

    if (IN(P_AIN)) {
        FAttnIn F{Qb, Kb, Vb, QIb, KIb, WIf, args.out};
        { pg8::Gemm g{Xb, Wa, TP, 2048, D}; pg8::StaticOrder S; S.init(TP, 2048, G, bx);
          pg8::EpiRow8<FAttnIn> E{F};
          pg8::gemm_phase<pg8::EpiRow8<FAttnIn>, pg8::StaticOrder, true, true>(lds, g, S, E);
          float km = E.f.kmax, vm = E.f.vmax;
#pragma unroll
          for (int o = 1; o < 64; o <<= 1) { km = fmaxf(km, __shfl_xor(km, o)); vm = fmaxf(vm, __shfl_xor(vm, o)); }
          if (lane == 0) { if (km > 0.f) atomicMax((unsigned*)(ctl + CW_AMAXK), __builtin_bit_cast(unsigned, km)); if (vm > 0.f) atomicMax((unsigned*)(ctl + CW_AMAXV), __builtin_bit_cast(unsigned, vm)); } }
        for (int it = gw; it < TP / 16 + 8 * 34; it += NGW) {
            if (it < TP / 16) {
                f32x4 acc[5]; skinny_tile<5>(Xb, D, Wa, D, it * 16, 2048, acc, lane);
#pragma unroll
                for (int ct = 0; ct < 5; ++ct) F.put4(it * 16 + (lane & 15), 2048 + ct * 16 + 4 * (lane >> 4), acc[ct]);
            } else {
                const int r = it - TP / 16, rt = r % 8, cg = r / 8;
                f32x4 acc[4]; skinny_tile<4>(Xb, D, Wa, D, TP + rt * 16, cg * 64, acc, lane);
#pragma unroll
                for (int ct = 0; ct < 4; ++ct) F.put4(TP + rt * 16 + (lane & 15), cg * 64 + ct * 16 + 4 * (lane >> 4), acc[ct]);
            }
        }
    }
    SEAM(P_AIN);

            if (IN(P_SCORE)) { kv8_convert(Kb, Vb, KV8, (const unsigned*)(ctl + CW_AMAXK), (const unsigned*)(ctl + CW_AMAXV), gw, NGW, lane);
        phase_score(QIb, KIb, WIf, INP(4), args.page_table, SC, SCS, QuantTabs{peer_u, peer_v, Uq, Vq, Usc, Vsc}, lds, vcu, G, wave, lane, gw, NGW); }
    SEAM(P_SCORE);
    if (IN(P_TOPK)) {
        const int jlo_ = 0, jhi_ = TA;
        phase_topk2(SC, SCS, IDX, CNT, peer_u, peer_v, Uq, Vq, Usc, Vsc, lds, (unsigned*)(ctl + CW_Q1), wave, lane, gw, NGW, jlo_, jhi_); }
    SEAM(P_TOPK);
    if (IN(P_ATTN)) {
        LAS unsigned char* wl = lds + wave * 16384;
        {
            if (tid == 0) { unsigned np = 0, mi = 0, mycnt = 1; const unsigned xme = MISC[13];
                for (unsigned j = 0; j < 16; ++j) { const unsigned c = __hip_atomic_load((unsigned*)(ctl + CW_XC + 64 * j), __ATOMIC_RELAXED, __HIP_MEMORY_SCOPE_AGENT); if (c > 0u) { if (j < xme) ++mi; ++np; } if (j == xme) mycnt = c > 0u ? c : 1u; }
                MISC[14] = np > 0u ? np : 1u; MISC[15] = mi; MISC[16] = mycnt; }
            __syncthreads();
            const int np = (int)MISC[14], mi = (int)MISC[15], mycnt = (int)MISC[16], rank = (int)MISC[12];
            for (int u = 0; u < NBATCH * 4; ++u) if (u % np == mi) attn_prompt_stream(u >> 2, u & 3, rank * NWAVES + wave, mycnt * NWAVES, Qb, IDX, KV8, (const unsigned*)(ctl + CW_AMAXK), (const unsigned*)(ctl + CW_AMAXV), Ob, wl, lane);
        }
        {
            const float* ck_ = INP(2); const float* cv_ = INP(3); float* o_ = args.out; const int* pt_ = args.page_table; int gws_ = gw; int lane_s = lane;
            asm volatile("" : "+s"(ck_), "+s"(cv_), "+s"(o_), "+s"(pt_), "+s"(gws_), "+v"(lane_s));
            for (int su = gws_; su < TS * 4 * 4; su += NGW) {
                if ((su & 3) == 0) { const int un = su >> 2, r = un >> 2, n = un & 3; attn_row<true>(TP + r, n, n + 1, Qb, IDX, CNT, nullptr, nullptr, ck_, cv_, o_ + OUT_KS, o_ + OUT_VS, pt_, Ob, wl, lane_s); }
            }
        }
    }
    SEAM(P_ATTN);
    if (IN(P_AOUT)) {
        FResid F{x_prompt, x_sample, Z};
        { pg8::Gemm g{Ob, Wo, TP, D, D}; pg8::StaticOrder S; S.init(TP, D, G, bx);
          pg8::EpiRow8<FResid> E{F};
          pg8::gemm_phase<pg8::EpiRow8<FResid>, pg8::StaticOrder, true, true>(lds, g, S, E); }
        for (int it = gw; it < 8 * 16; it += NGW) {
            const int rt = it % 8, cg = it / 8;
            f32x4 acc[4]; skinny_tile<4>(Ob, D, Wo, D, TP + rt * 16, cg * 64, acc, lane);
#pragma unroll
            for (int ct = 0; ct < 4; ++ct) F.put4(TP + rt * 16 + (lane & 15), cg * 64 + ct * 16 + 4 * (lane >> 4), acc[ct]);
        }
    }
    SEAM(P_AOUT);
    if (IN(P_LN1)) { for (int r = gw; r < TA; r += NGW) ln_row_wave(Z + (size_t)r * D, INP(19), INP(20), (float*)nullptr, H1b + (size_t)r * D, lane); }
    SEAM(P_LN1);

        if (IN(P_PQ0)) {
        FStoreBf16 F{PQb, PEER_N};
        { pg8::Gemm g{H1b, Wpq, TP, PEER_N, D}; pg8::StaticOrder S; S.init(TP, PEER_N, G, bx);
          pg8::EpiRow8<FStoreBf16> E{F};
          pg8::gemm_phase<pg8::EpiRow8<FStoreBf16>, pg8::StaticOrder, true, true>(lds, g, S, E); }
        for (int it = gw; it < 8 * 32; it += NGW) {
            const int rt = it % 8, cg = it / 8;
            f32x4 acc[4]; skinny_tile<4>(H1b, D, Wpq, D, TP + rt * 16, cg * 64, acc, lane);
#pragma unroll
            for (int ct = 0; ct < 4; ++ct) F.put4(TP + rt * 16 + (lane & 15), cg * 64 + ct * 16 + 4 * (lane >> 4), acc[ct]);
        }
#if 0
        for (int it = gw; it < 8 * 16; it += NGW) {
            const int rt = it % 8, cg = it / 8;
            f32x4 acc[8]; skinny_tile<8>(H1b, D, Wpq, D, TP + rt * 16, cg * 128, acc, lane);
#pragma unroll
            for (int ct = 0; ct < 8; ++ct) F.put4(TP + rt * 16 + (lane & 15), cg * 128 + ct * 16 + 4 * (lane >> 4), acc[ct]);
        }
#endif
    }
    SEAM(P_PQ0);
        if (IN(P_PEER0)) {
        phase_peer_select(PQb, PK, PK + 2 * 16384, TEID, TGATE, lds, vcu, G, wave, lane);
        xcd_barrier(bar);
#if defined(U_SLICED)
        PEER_USLICE(H1b, Uq, Usc);
        xcd_barrier(bar);
        phase_peer_mixv(Z, INP(19), INP(20), TEID, TGATE, HDB, Vq, Usc, Vsc, INP(21), INP(22), H2f, H2b, gw, NGW, lane);
#else
#if defined(MIX_FROM_Z)
        phase_peer_mix(Z, INP(19), INP(20), TEID, TGATE, Uq, Vq, Usc, Vsc, INP(21), INP(22), H2f, H2b, gw, NGW, lane);
#else
        MIXSEL(H1f, TEID, TGATE, Uq, Vq, Usc, Vsc, INP(21), INP(22), H2f, H2b, lds, wave, gw, NGW, lane);
#endif
#endif
    }
    SEAM(P_PEER0);

            if (IN(P_GIN)) {
        FGlaIn F{Gq, Gk, Gv, Gr, GD};
        { pg8::Gemm g{H2b, Wg, TP, 3072, D}; pg8::StaticOrder S; S.init(TP, 3072, G, bx);
          pg8::EpiRow8<FGlaIn> E{F};
          pg8::gemm_phase<pg8::EpiRow8<FGlaIn>, pg8::StaticOrder, true, true>(lds, g, S, E); }
        for (int it = gw; it < TP / 16 + 8 * 97; it += NGW) {
            if (it < TP / 16) {
                f32x4 acc[1]; skinny_tile<1>(H2b, D, Wg, D, it * 16, GN_GD, acc, lane);
                F.put4(it * 16 + (lane & 15), GN_GD + 4 * (lane >> 4), acc[0]);
            } else {
                const int r = it - TP / 16, rt = r % 8, cg = r / 8;
                f32x4 acc[2]; skinny_tile<2>(H2b, D, Wg, D, TP + rt * 16, cg * 32, acc, lane);
#pragma unroll
                for (int ct = 0; ct < 2; ++ct) F.put4(TP + rt * 16 + (lane & 15), cg * 32 + ct * 16 + 4 * (lane >> 4), acc[ct]);
            }
        }
    }
    SEAM(P_GIN);
    if (IN(P_GCH)) {
        for (int it = vcu; it < NBATCH * (SEQ / 64) * 4; it += G) gla_chunk_item(it, Gq, Gk, Gv, GD, INP(10), INP(11), QT, KT, DEC, DSb, lds, tid, wave, lane);
        for (int it = vcu; it < DB * 4; it += G) gla_sample_item(it, Gq, Gk, Gv, Gr, GD, INP(10), INP(11), INP(12), INP(5), args.out + OUT_SS, OGb, lds, tid, lane);
    }
    SEAM(P_GCH);
    if (IN(P_GSC)) gla_scan(DSb, DEC, SPV, args.out + OUT_SP, vcu * NTHREADS + tid, G * NTHREADS);
    SEAM(P_GSC);
    if (IN(P_GOUT)) { for (int it = vcu; it < NBATCH * (SEQ / 64) * 4; it += G) gla_out_item(it, QT, KT, Gv, Gr, SPV, INP(12), OGb, lds, tid, wave, lane); }
    SEAM(P_GOUT);
    if (IN(P_GPRJ)) {
        FResid F{H2f, H2f + (size_t)TP * D, Z};
        { pg8::Gemm g{OGb, Wgo, TP, D, D}; pg8::StaticOrder S; S.init(TP, D, G, bx);
          pg8::EpiRow8<FResid> E{F};
          pg8::gemm_phase<pg8::EpiRow8<FResid>, pg8::StaticOrder, true, true>(lds, g, S, E); }
        for (int it = gw; it < 8 * 16; it += NGW) {
            const int rt = it % 8, cg = it / 8;
            f32x4 acc[4]; skinny_tile<4>(OGb, D, Wgo, D, TP + rt * 16, cg * 64, acc, lane);
#pragma unroll
            for (int ct = 0; ct < 4; ++ct) F.put4(TP + rt * 16 + (lane & 15), cg * 64 + ct * 16 + 4 * (lane >> 4), acc[ct]);
        }
    }
    SEAM(P_GPRJ);
    if (IN(P_LN1B)) { for (int r = gw; r < TA; r += NGW) ln_row_wave(Z + (size_t)r * D, INP(19) + D, INP(20) + D, (float*)nullptr, H1b + (size_t)r * D, lane); }
    SEAM(P_LN1B);
    if (IN(P_PQ1)) {
        FStoreBf16 F{PQb, PEER_N}; const bf16* W1 = Wpq + (size_t)PEER_N * D;
        { pg8::Gemm g{H1b, W1, TP, PEER_N, D}; pg8::StaticOrder S; S.init(TP, PEER_N, G, bx);
          pg8::EpiRow8<FStoreBf16> E{F};
          pg8::gemm_phase<pg8::EpiRow8<FStoreBf16>, pg8::StaticOrder, true, true>(lds, g, S, E); }
        for (int it = gw; it < 8 * 32; it += NGW) {
            const int rt = it % 8, cg = it / 8;
            f32x4 acc[4]; skinny_tile<4>(H1b, D, W1, D, TP + rt * 16, cg * 64, acc, lane);
#pragma unroll
            for (int ct = 0; ct < 4; ++ct) F.put4(TP + rt * 16 + (lane & 15), cg * 64 + ct * 16 + 4 * (lane >> 4), acc[ct]);
        }
    }
    SEAM(P_PQ1);
    if (IN(P_PEER1)) {
        phase_peer_select(PQb, PK + 16384, PK + 3 * 16384, TEID, TGATE, lds, vcu, G, wave, lane);
        xcd_barrier(bar);
#if defined(U_SLICED)
        PEER_USLICE(H1b, Uq + (size_t)16384 * PEER_RB, Usc + 16384);
        xcd_barrier(bar);
        phase_peer_mixv(Z, INP(19) + D, INP(20) + D, TEID, TGATE, HDB, Vq + (size_t)16384 * PEER_RB, Usc + 16384, Vsc + 16384, INP(21) + D, INP(22) + D, args.out + OUT_Y, nullptr, gw, NGW, lane);
#else
#if defined(MIX_FROM_Z)
        phase_peer_mix(Z, INP(19) + D, INP(20) + D, TEID, TGATE, Uq + (size_t)16384 * PEER_RB, Vq + (size_t)16384 * PEER_RB, Usc + 16384, Vsc + 16384, INP(21) + D, INP(22) + D, args.out + OUT_Y, nullptr, gw, NGW, lane);
#else
        MIXSEL(H1f, TEID, TGATE, Uq + (size_t)16384 * PEER_RB, Vq + (size_t)16384 * PEER_RB, Usc + 16384, Vsc + 16384, INP(21) + D, INP(22) + D, args.out + OUT_Y, nullptr, lds, wave, gw, NGW, lane);
#endif
#endif
    }
#undef IN
#undef SEAM
}
#undef ws
#undef INP
#undef Wa
#undef Wo
#undef Wg
#undef Wgo
#undef Wpq
#undef PK
#undef Usc
#undef Xb
#undef Qb
#undef QIb
#undef Kb
#undef Vb
#undef KIb
#undef WIf
#undef SC
#undef SCS
#undef IDX
#undef CNT
#undef Ob
#undef Z
#undef H1f
#undef H1b
#undef PQb
#undef H2f
#undef H2b
#undef TEID
#undef TGATE
#undef Gq
#undef Gk
#undef Gv
#undef Gr
#undef GD
#undef QT
#undef KT
#undef DEC
#undef DSb
#undef SPV
#undef OGb
#undef Uq
#undef HDB
#undef KV8
#undef Vq
#undef Usc
#undef Vsc
#undef x_prompt
#undef x_sample
#undef attn_w_in
#undef attn_w_out
#undef gla_w_in
#undef gla_w_out
#undef peer_w_q
#undef peer_keys1
#undef peer_keys2
#undef peer_u
#undef peer_v


}

extern "C" void kernel_launch(void* const* d_in, const int* in_sizes, int n_in, void* d_out, int out_size, void* d_ws, size_t ws_size, hipStream_t stream) {
    if (ws_size < mk::WS_END || n_in != 23 || (size_t)out_size != OUT_TOTAL) { fprintf(stderr, "kernel_launch: unexpected sizes ws %zu n_in %d out %d\n", ws_size, n_in, out_size); return; }
    static int grid = 0;
    if (grid == 0) {
        int dev = 0, cus = 0;
        if (hipGetDevice(&dev) != hipSuccess || hipDeviceGetAttribute(&cus, hipDeviceAttributeMultiprocessorCount, dev) != hipSuccess) { fprintf(stderr, "kernel_launch: device query failed\n"); grid = -1; return; }
        if (hipFuncSetAttribute((const void*)mk::mk_fwd, hipFuncAttributeMaxDynamicSharedMemorySize, mk::LDS_BYTES) != hipSuccess) { fprintf(stderr, "kernel_launch: hipFuncSetAttribute failed\n"); grid = -1; return; }
        int per_cu = 0;
        if (hipOccupancyMaxActiveBlocksPerMultiprocessor(&per_cu, (const void*)mk::mk_fwd, mk::NTHREADS, mk::LDS_BYTES) != hipSuccess || per_cu < 1) fprintf(stderr, "kernel_launch: occupancy query says %d\n", per_cu);
        (void)hipGetLastError();
        grid = cus;
    }
    if (grid < 0) return;
    (void)hipMemsetAsync((char*)d_ws + mk::WS_CTL, 0, mk::CTL_ZERO_BYTES, stream);
    mk::Args a{};
    for (int i = 0; i < 23; ++i) a.in[i] = (const float*)d_in[i];
    a.page_table = (const int*)d_in[6]; a.out = (float*)d_out; a.ws = (unsigned char*)d_ws; a.ph_lo = 0; a.ph_hi = mk::P_COUNT;
    hipLaunchKernelGGL(mk::mk_fwd, dim3(grid), dim3(mk::NTHREADS), mk::LDS_BYTES, stream, a);
}
```

```cpp
#include <hip/hip_runtime.h>
#include <cstdio>
#include <cstdint>
#include <cmath>

constexpr int D = 1024;
constexpr int NBATCH = 2, SEQ = 8192, TP = NBATCH * SEQ;
constexpr int DB = 32, DS = 4, TS = DB * DS;
constexpr int TA = TP + TS;
constexpr int PAST = 8192, PAGE = 128, NPAGES = PAST / PAGE;
constexpr float ALPHA = 1.4142135623730951f;
constexpr float LN_EPS = 1e-5f;
constexpr int ATT_N = 2120;
constexpr int AQ = 0, AK = 1024, AV = 1280, AQI = 1536, AKI = 2048, AWI = 2112;
constexpr int TOPK = 256;
constexpr int GLA_N = 3088;
constexpr int GQ = 0, GK = 512, GV = 1024, GGD = 2048, GR = 2064;
constexpr int PEER_N = 2048;
constexpr int SCS_LD = 8256;

constexpr size_t OUT_Y = 0, OUT_KP = 16908288, OUT_VP = 21102592, OUT_KIP = 25296896, OUT_SP = 26345472,
                 OUT_KS = 26607616, OUT_VS = 26640384, OUT_KIS = 26673152, OUT_SS = 26681344, OUT_TOTAL = 30875648;


namespace pg8 {
#define PG8_LAS __attribute__((address_space(3)))
typedef unsigned short bf16_t;
typedef short bf16x8 __attribute__((ext_vector_type(8)));
typedef float f32x4 __attribute__((ext_vector_type(4)));
typedef unsigned u32x4 __attribute__((ext_vector_type(4)));
constexpr int BM = 256, BK = 64, HALF = 128, HTB = HALF * BK * 2  , STAGE_BYTES = 8 * HTB, NXCD = 8, WGM = 8;

__host__ __device__ __forceinline__ int lds_byte(int r, int c) { const int st = (r >> 4) * 2 + (c >> 5), rr = r & 15, cc = c & 31, ob = rr * 64 + cc * 2; return st * 1024 + (ob ^ (((ob >> 9) & 1) << 5)); }
__host__ __device__ __forceinline__ void stage_rc(int b, int& R, int& C) { const int st = b / 1024, sb = b % 1024, swz = sb ^ (((sb >> 9) & 1) << 5); R = (st >> 1) * 16 + swz / 64; C = (st & 1) * 32 + (swz % 64) / 2; }
__host__ __device__ __forceinline__ int perm32(int rho) { const int n = rho >> 4, i = rho & 15; return 8 * (i >> 2) + 4 * n + (i & 3); }

struct Unit { int pm, pn; };
struct Gemm { const bf16_t* A; const bf16_t* Bt; int M, N, K; };

struct StaticOrder {
    int nM, nN, nwg, G, c;
    __host__ __device__ void init(int M, int N, int G_, int c_) { nM = M / BM; nN = N / BM; nwg = nM * nN; G = G_; c = c_; }
    __host__ __device__ bool next(int i, Unit& u) const {
        const long L = (long)i * G + c; if (L >= nwg) return false;
        int wgid = (int)L; { const int q = nwg / NXCD, r = nwg % NXCD, xcd = wgid % NXCD, off = wgid / NXCD; wgid = (xcd < r ? xcd * (q + 1) : r * (q + 1) + (xcd - r) * q) + off; }
        const int nig = WGM * nN, gid = wgid / nig, fm = gid * WGM, gsz = (nM - fm) < WGM ? (nM - fm) : WGM;
        u.pm = fm + ((wgid % nig) % gsz); u.pn = (wgid % nig) / gsz; return true;
    }
    __device__ __forceinline__ void a_ready(const Unit&) const {}
    __device__ __forceinline__ void done(const Unit&) const {}
};

__device__ __forceinline__ unsigned cvt_pk_bf16(float lo, float hi) { unsigned r; asm volatile("v_cvt_pk_bf16_f32 %0, %1, %2" : "=v"(r) : "v"(lo), "v"(hi)); return r; }
template <class F> struct EpiRow8 {
    static constexpr bool PERM = true, AFTER_DRAIN = false;
    F f;
    __device__ __forceinline__ void operator()(const f32x4 (&acc)[2][2][4][2], const Unit& u, int wr, int wc, int fr, int fq) const {
        const int row0 = u.pm * BM + wr * 64 + fr, col0 = u.pn * BM + wc * 32 + 8 * fq;
#pragma unroll
        for (int ai = 0; ai < 2; ++ai)
#pragma unroll
            for (int m = 0; m < 4; ++m)
#pragma unroll
                for (int bj = 0; bj < 2; ++bj) f.put8(row0 + ai * HALF + m * 16, col0 + bj * HALF, acc[ai][bj][m][0], acc[ai][bj][m][1]);
    }
};


template <class Epi, class Sched, bool ALIGN_EPI = false, bool SP2 = false>
__device__ __forceinline__ void gemm_phase(PG8_LAS unsigned char* lds, const Gemm g, const Sched& S, const Epi& E) {
    const int tid = threadIdx.x, wid = __builtin_amdgcn_readfirstlane(tid >> 6), lane = tid & 63, wr = wid >> 2, wc = wid & 3, fr = lane & 15, fq = lane >> 4;
    const int K = g.K, nt = K / BK;
    unsigned voffA[2], voffB[2];
#pragma unroll
    for (int i = 0; i < 2; ++i) { int R, C; stage_rc(tid * 16 + i * 8192, R, C); const int Rb = Epi::PERM ? ((R & ~31) + perm32(R & 31)) : R;
        voffA[i] = (unsigned)(R * K + C) * 2u; voffB[i] = (unsigned)(Rb * K + C) * 2u; }
    const size_t kstep = (size_t)(BK * 2);
    const size_t hstep = (size_t)HALF * K * 2;
    const size_t tstep = 2 * hstep;
    const unsigned ldsw = (unsigned)wid * 1024u;
    const int aoff = lds_byte(wr * 64 + fr, fq * 8), boff = lds_byte(wc * 32 + fr, fq * 8);
#define PG8_SA(b, h) (((b) * 2 + (h)) * HTB)
#define PG8_SB(b, h) ((4 + (b) * 2 + (h)) * HTB)
#define PG8_STAGE(bufoff, gbase, voff) do { _Pragma("unroll") for (int _i = 0; _i < 2; ++_i) \
        __builtin_amdgcn_global_load_lds((const unsigned*)((const char*)(gbase) + (voff)[_i]), (PG8_LAS unsigned*)(lds + (bufoff) + ldsw + _i * 8192), 16, 0, 0); } while (0)
#define PG8_LDA(dst, b, h) do { _Pragma("unroll") for (int m = 0; m < 4; ++m) _Pragma("unroll") for (int k = 0; k < 2; ++k) dst[m][k] = *(const PG8_LAS bf16x8*)(lds + PG8_SA(b, h) + aoff + m * 2048 + k * 1024); } while (0)
#define PG8_LDB(dst, b, h) do { _Pragma("unroll") for (int n = 0; n < 2; ++n) _Pragma("unroll") for (int k = 0; k < 2; ++k) dst[n][k] = *(const PG8_LAS bf16x8*)(lds + PG8_SB(b, h) + boff + n * 2048 + k * 1024); } while (0)
#define PG8_MMA(ai, bj, At, Bt) do { __builtin_amdgcn_s_setprio(1); _Pragma("unroll") for (int m = 0; m < 4; ++m) _Pragma("unroll") for (int n = 0; n < 2; ++n) _Pragma("unroll") for (int k = 0; k < 2; ++k) \
        acc[ai][bj][m][n] = __builtin_amdgcn_mfma_f32_16x16x32_bf16(Bt[n][k], At[m][k], acc[ai][bj][m][n], 0, 0, 0); __builtin_amdgcn_s_setprio(0); } while (0)
#define PG8_WAIT_V(n) asm volatile("s_waitcnt vmcnt(" #n ")" ::: "memory")
#define PG8_WAIT_L(n) asm volatile("s_waitcnt lgkmcnt(" #n ")" ::: "memory")
#define PG8_BAR __builtin_amdgcn_s_barrier()
#define PG8_SCHED __builtin_amdgcn_sched_barrier(0)
    Unit cur, nxt; int ui = 0;
    if (!S.next(0, cur)) return;
    f32x4 acc[2][2][4][2];
#pragma unroll
    for (int a = 0; a < 2; ++a)
#pragma unroll
        for (int b = 0; b < 2; ++b)
#pragma unroll
            for (int m = 0; m < 4; ++m)
#pragma unroll
                for (int n = 0; n < 2; ++n) acc[a][b][m][n] = (f32x4){0.f, 0.f, 0.f, 0.f};
    bf16x8 At[4][2], B0[2][2], B1[2][2];
    const char* cA = (const char*)g.A + (size_t)cur.pm * tstep; const char* cB = (const char*)g.Bt + (size_t)cur.pn * tstep;
    S.a_ready(cur);
    if constexpr (SP2) {
        PG8_STAGE(PG8_SB(0, 0), cB, voffB); PG8_STAGE(PG8_SB(0, 1), cB + hstep, voffB); PG8_STAGE(PG8_SA(0, 0), cA, voffA); PG8_STAGE(PG8_SA(0, 1), cA + hstep, voffA);
        if (wr == 1) PG8_BAR;
        PG8_WAIT_V(2); PG8_BAR;
        PG8_STAGE(PG8_SB(1, 0), cB + kstep, voffB); PG8_STAGE(PG8_SA(1, 0), cA + kstep, voffA); PG8_STAGE(PG8_SB(1, 1), cB + hstep + kstep, voffB);
        PG8_WAIT_V(6); PG8_BAR;
    } else {
        PG8_STAGE(PG8_SB(0, 0), cB, voffB); PG8_STAGE(PG8_SA(0, 0), cA, voffA); PG8_STAGE(PG8_SB(0, 1), cB + hstep, voffB); PG8_STAGE(PG8_SA(0, 1), cA + hstep, voffA);
        if (wr == 1) PG8_BAR;
        PG8_WAIT_V(4); PG8_BAR;
        PG8_STAGE(PG8_SB(1, 0), cB + kstep, voffB); PG8_STAGE(PG8_SA(1, 0), cA + kstep, voffA); PG8_STAGE(PG8_SB(1, 1), cB + hstep + kstep, voffB);
        PG8_WAIT_V(6); PG8_BAR;
    }
    for (;;) {
        const bool has_next = S.next(ui + 1, nxt);
        const char* nA = has_next ? (const char*)g.A + (size_t)nxt.pm * tstep : cA; const char* nB = has_next ? (const char*)g.Bt + (size_t)nxt.pn * tstep : cB;
        for (int t = 0; t < nt; t += 2) {
            const bool last = (t == nt - 2);
            const char* a1 = cA + (size_t)(t + 1) * kstep;
            const char* a2 = last ? nA : cA + (size_t)(t + 2) * kstep; const char* b2 = last ? nB : cB + (size_t)(t + 2) * kstep;
            const char* a3 = a2 + kstep; const char* b3 = b2 + kstep;
            if (last && has_next) S.a_ready(nxt);
            if constexpr (SP2) {
            PG8_LDB(B0, 0, 0); PG8_LDB(B1, 0, 1); PG8_SCHED; PG8_LDA(At, 0, 0); PG8_STAGE(PG8_SA(1, 1), a1 + hstep, voffA);
            PG8_WAIT_V(8); PG8_WAIT_L(0); PG8_BAR; PG8_MMA(0, 0, At, B0); PG8_MMA(0, 1, At, B1); PG8_BAR; PG8_SCHED;
            PG8_LDA(At, 0, 1); PG8_STAGE(PG8_SB(0, 0), b2, voffB); PG8_STAGE(PG8_SB(0, 1), b2 + hstep, voffB); PG8_STAGE(PG8_SA(0, 0), a2, voffA);
            PG8_WAIT_V(8); PG8_WAIT_L(0); PG8_BAR; PG8_MMA(1, 0, At, B0); PG8_MMA(1, 1, At, B1); PG8_BAR; PG8_SCHED;
            PG8_LDB(B0, 1, 0); PG8_LDB(B1, 1, 1); PG8_SCHED; PG8_LDA(At, 1, 0); PG8_STAGE(PG8_SA(0, 1), a2 + hstep, voffA);
            PG8_WAIT_V(8); PG8_WAIT_L(0); PG8_BAR; PG8_MMA(0, 0, At, B0); PG8_MMA(0, 1, At, B1); PG8_BAR; PG8_SCHED;
            PG8_LDA(At, 1, 1); PG8_STAGE(PG8_SB(1, 0), b3, voffB); PG8_STAGE(PG8_SB(1, 1), b3 + hstep, voffB); PG8_STAGE(PG8_SA(1, 0), a3, voffA);
            PG8_WAIT_V(8); PG8_WAIT_L(0); PG8_BAR; PG8_MMA(1, 0, At, B0); PG8_MMA(1, 1, At, B1); PG8_BAR; PG8_SCHED;
            } else {
            PG8_LDB(B0, 0, 0); PG8_SCHED; PG8_LDA(At, 0, 0); PG8_STAGE(PG8_SA(1, 1), a1 + hstep, voffA);
            PG8_WAIT_L(8); PG8_BAR; PG8_WAIT_L(0); PG8_MMA(0, 0, At, B0); PG8_BAR; PG8_SCHED;
            PG8_LDB(B1, 0, 1); PG8_STAGE(PG8_SB(0, 0), b2, voffB);
            PG8_BAR; PG8_WAIT_L(0); PG8_MMA(0, 1, At, B1); PG8_BAR;
            PG8_LDA(At, 0, 1); PG8_STAGE(PG8_SA(0, 0), a2, voffA);
            PG8_BAR; PG8_WAIT_L(0); PG8_MMA(1, 0, At, B0); PG8_BAR; PG8_SCHED;
            PG8_STAGE(PG8_SB(0, 1), b2 + hstep, voffB);
            PG8_WAIT_V(6); PG8_BAR; PG8_MMA(1, 1, At, B1); PG8_BAR;
            PG8_LDB(B0, 1, 0); PG8_SCHED; PG8_LDA(At, 1, 0); PG8_STAGE(PG8_SA(0, 1), a2 + hstep, voffA);
            PG8_WAIT_L(8); PG8_BAR; PG8_WAIT_L(0); PG8_MMA(0, 0, At, B0); PG8_BAR; PG8_SCHED;
            PG8_LDB(B1, 1, 1); PG8_STAGE(PG8_SB(1, 0), b3, voffB);
            PG8_BAR; PG8_WAIT_L(0); PG8_MMA(0, 1, At, B1); PG8_BAR;
            PG8_LDA(At, 1, 1); PG8_STAGE(PG8_SA(1, 0), a3, voffA);
            PG8_BAR; PG8_WAIT_L(0); PG8_MMA(1, 0, At, B0); PG8_BAR; PG8_SCHED;
            PG8_STAGE(PG8_SB(1, 1), b3 + hstep, voffB);
            PG8_WAIT_V(6); PG8_BAR; PG8_MMA(1, 1, At, B1); PG8_BAR;
            }
        }
        if constexpr (ALIGN_EPI) { if (wr == 0) PG8_BAR; }
        if constexpr (!Epi::AFTER_DRAIN) { E(acc, cur, wr, wc, fr, fq); S.done(cur); }
        if (!has_next) break;
#pragma unroll
        for (int a = 0; a < 2; ++a)
#pragma unroll
            for (int b = 0; b < 2; ++b)
#pragma unroll
                for (int m = 0; m < 4; ++m)
#pragma unroll
                    for (int n = 0; n < 2; ++n) acc[a][b][m][n] = (f32x4){0.f, 0.f, 0.f, 0.f};
        cur = nxt; cA = nA; cB = nB; ++ui;
        if constexpr (ALIGN_EPI) { if (wr == 1) PG8_BAR; }
    }
    PG8_WAIT_V(0);
    if constexpr (!ALIGN_EPI) { if (wr == 0) PG8_BAR; }
    PG8_BAR;
    if constexpr (Epi::AFTER_DRAIN) { E.fused(acc, cur, wr, wc, fr, fq, lds, wid, lane); S.done(cur); }
#undef PG8_SA
#undef PG8_SB
#undef PG8_STAGE
#undef PG8_LDA
#undef PG8_LDB
#undef PG8_MMA
#undef PG8_WAIT_V
#undef PG8_WAIT_L
#undef PG8_BAR
#undef PG8_SCHED
}
}

namespace mk {
#define GAS __attribute__((address_space(1)))
#define LAS __attribute__((address_space(3)))
typedef unsigned short bf16;
typedef unsigned v4u __attribute__((ext_vector_type(4)));
typedef float f32x4 __attribute__((ext_vector_type(4)));
typedef short bf16x8 __attribute__((ext_vector_type(8)));
typedef GAS unsigned gu32;
typedef GAS unsigned long long gu64;
#define RLX_AGENT __ATOMIC_RELAXED, __HIP_MEMORY_SCOPE_AGENT
#define LDS_WAIT() asm volatile("s_waitcnt lgkmcnt(0)" ::: "memory")
#define VM_WAIT() asm volatile("s_waitcnt vmcnt(0)" ::: "memory")
__device__ __forceinline__ unsigned long long rt() { return __builtin_amdgcn_s_memrealtime(); }
__device__ __forceinline__ unsigned f2bf(float f) { unsigned u = __builtin_bit_cast(unsigned, f); return (u + 0x7fffu + ((u >> 16) & 1u)) >> 16; }
__device__ __forceinline__ unsigned pk2(float lo, float hi) {
    typedef __bf16 bf2_t __attribute__((ext_vector_type(2))); typedef float f2_t __attribute__((ext_vector_type(2)));
    const f2_t v = {lo, hi}; const bf2_t b = __builtin_convertvector(v, bf2_t); return __builtin_bit_cast(unsigned, b); }

#define XB_TMO      128
#define XB_XCNT(j)  (256  + 64 * (j))
#define XB_XSUB(j)  (1280 + 64 * (j))
#define XB_XGEN(j)  (2304 + 64 * (j))
#define XB_TOP      3328
#define XB_TOPGEN   3392
#define XCD_BAR_WORDS 3456
#define XB_SPIN_CAP (1u << 18)

__device__ __forceinline__ unsigned xb_ld(unsigned* p)              { return __hip_atomic_load(p, __ATOMIC_RELAXED, __HIP_MEMORY_SCOPE_AGENT); }
__device__ __forceinline__ unsigned xb_add(unsigned* p, unsigned v) { return __hip_atomic_fetch_add(p, v, __ATOMIC_RELAXED, __HIP_MEMORY_SCOPE_AGENT); }
__device__ __forceinline__ unsigned xb_xcc_id() { return (unsigned)__builtin_amdgcn_s_getreg((3 << 11) | 20) & 0xFu; }
#define XB_SPIN(cond, bar) do { unsigned _sp = 0; while (cond) { __builtin_amdgcn_s_sleep(1); \
    if ((++_sp & 255u) == 0u) { if (xb_ld(&(bar)[XB_TMO])) break; if (_sp > XB_SPIN_CAP) { atomicAdd(&(bar)[XB_TMO], 1u); break; } } } } while (0)

struct XcdBarrier {
    unsigned* bar; unsigned x;
    volatile LAS unsigned* st;
};

__device__ __forceinline__ XcdBarrier xcd_barrier_post(unsigned* bar, volatile LAS unsigned* st) {
    XcdBarrier b; b.bar = bar; b.x = xb_xcc_id(); b.st = st;
    if (threadIdx.x == 0) (void)xb_add(&bar[XB_XCNT(b.x)], 1u);
    return b;
}
__device__ __forceinline__ void xcd_barrier_complete(unsigned* bar, unsigned x, unsigned& nloc, unsigned& nx) {
    const unsigned G = gridDim.x * gridDim.y * gridDim.z;
    unsigned sum, cnt, mine, sp = 0u;
    for (;;) {
        sum = 0u; cnt = 0u; mine = 0u;
#pragma unroll
        for (unsigned j = 0; j < 16; ++j) { const unsigned c = xb_ld(&bar[XB_XCNT(j)]); sum += c; cnt += (c > 0u) ? 1u : 0u; mine = (j == x) ? c : mine; }
        if (sum == G) break;
        __builtin_amdgcn_s_sleep(1);
        if ((++sp & 255u) == 0u) { if (xb_ld(&bar[XB_TMO])) break; if (sp > XB_SPIN_CAP) { atomicAdd(&bar[XB_TMO], 1u); break; } }
    }
    nloc = mine > 0u ? mine : 1u; nx = cnt > 0u ? cnt : 1u;
}

__device__ __forceinline__ void xcd_barrier(const XcdBarrier& b) {
    asm volatile("s_waitcnt vmcnt(0)" ::: "memory");
    __syncthreads();
    if (threadIdx.x == 0) {
        unsigned* bar = b.bar;
        __builtin_amdgcn_s_waitcnt(0);
        unsigned nloc = b.st[0], nx = b.st[1];
        if (nloc == 0u) { xcd_barrier_complete(bar, b.x, nloc, nx); b.st[0] = nloc; b.st[1] = nx; }
        const unsigned old = xb_add(&bar[XB_XSUB(b.x)], 1u);
        const unsigned gen = old / nloc;
        if (old + 1u == (gen + 1u) * nloc) {
            __builtin_amdgcn_fence(__ATOMIC_RELEASE, "agent");
            asm volatile("s_waitcnt vmcnt(0)" ::: "memory");
            const unsigned og = xb_add(&bar[XB_TOP], 1u);
            const unsigned tg = og / nx;
            if (og + 1u == (tg + 1u) * nx) xb_add(&bar[XB_TOPGEN], 1u);
            else XB_SPIN(xb_ld(&bar[XB_TOPGEN]) == tg, bar);
            __builtin_amdgcn_fence(__ATOMIC_ACQUIRE, "agent");
            xb_add(&bar[XB_XGEN(b.x)], 1u);
            asm volatile("s_waitcnt vmcnt(0)" ::: "memory");
        } else {
            XB_SPIN(xb_ld(&bar[XB_XGEN(b.x)]) == gen, bar);
            __builtin_amdgcn_fence(__ATOMIC_ACQUIRE, "agent");
            asm volatile("s_waitcnt vmcnt(0)" ::: "memory");
        }
    }
    __syncthreads();
}

}

namespace mk {
constexpr int NWAVES = 8, NTHREADS = 512;
constexpr size_t MiB = 1u << 20;
constexpr size_t WS_QIB = 325 * MiB, WS_KB = 342 * MiB, WS_VB = 351 * MiB, WS_KIB = 360 * MiB, WS_WIF = 363 * MiB;
constexpr size_t WS_OB = 390 * MiB, WS_GD = 423 * MiB;
constexpr size_t WS_IDX = 525 * MiB, WS_CNT = 542 * MiB, WS_SCS = 543 * MiB;
constexpr size_t WS_S = 548 * MiB;
constexpr size_t WS_SC = WS_S;
constexpr size_t WS_Z = WS_S, WS_H1F = WS_S + 65 * MiB, WS_H1B = WS_S + 130 * MiB, WS_PQB = WS_S + 163 * MiB, WS_H2F = WS_S + 228 * MiB, WS_H2B = WS_S + 293 * MiB;
constexpr size_t WS_GQ = WS_S + 326 * MiB, WS_GK = WS_S + 343 * MiB, WS_GV = WS_S + 360 * MiB, WS_GR = WS_S + 393 * MiB, WS_QT = WS_S + 426 * MiB, WS_DEC = WS_S + 442 * MiB,
                 WS_OGB = WS_S + 443 * MiB, WS_KT = WS_S + 476 * MiB;
constexpr size_t WS_DS = WS_S, WS_SPREV = WS_S + 128 * MiB;
constexpr size_t WS_CTL = 1060 * MiB, WS_WA = 1061 * MiB, WS_WO = 1066 * MiB, WS_WG = 1068 * MiB, WS_WGO = 1075 * MiB, WS_WPQ = 1077 * MiB, WS_PK = 1085 * MiB,
                 WS_UB = 1086 * MiB, WS_VBX = 1150 * MiB, WS_USC = 1118 * MiB, WS_TEID = 1120 * MiB, WS_TGATE = 1125 * MiB, WS_HD = 1134 * MiB, WS_KV8 = 1134 * MiB, WS_XB = 1214 * MiB, WS_QB = 1247 * MiB, WS_END = 1280 * MiB;
constexpr size_t CTL_ZERO_BYTES = 1 * MiB;
constexpr int CW_TMO = 0, CW_AMAXK = 256, CW_AMAXV = 320, CW_Q1 = 512, CW_XC = 1024, CW_BAR = 4096;
constexpr int WA_ROWS = 2176, WG_ROWS = 3104;
constexpr int GN_Q = 0, GN_K = 512, GN_V = 1024, GN_R = 2048, GN_GD = 3072;

constexpr int RING_BYTES = 131072, LDSCTL_OFF = RING_BYTES, MISC_OFF = LDSCTL_OFF + 320, INPTAB_OFF = LDSCTL_OFF + 512, LDS_BYTES = 147456;

typedef unsigned u32x4 __attribute__((ext_vector_type(4)));
typedef unsigned u32x2 __attribute__((ext_vector_type(2)));
#define MK_LAS __attribute__((address_space(3)))
__device__ __forceinline__ float bflo(unsigned w) { return __builtin_bit_cast(float, w << 16); }
__device__ __forceinline__ float bfhi(unsigned w) { return __builtin_bit_cast(float, w & 0xffff0000u); }
__device__ __forceinline__ float bf2f(unsigned short b) { return __builtin_bit_cast(float, (unsigned)b << 16); }
__device__ __forceinline__ u32x4 pack8(f32x4 a, f32x4 b) { u32x4 w; w.x = pk2(a[0], a[1]); w.y = pk2(a[2], a[3]); w.z = pk2(b[0], b[1]); w.w = pk2(b[2], b[3]); return w; }

#define TPB(k)
#define TPE(k)
template <int NCT> __device__ __forceinline__ void skinny_tile(const bf16* __restrict__ A, int lda, const bf16* __restrict__ Bt, int K, int row0, int col0, f32x4 (&acc)[NCT], int lane) {
    const int fr = lane & 15, fq = lane >> 4;
    const bf16* ap = A + (size_t)(row0 + fr) * lda + fq * 8;
    const bf16* bp = Bt + (size_t)(col0 + fr) * K + fq * 8;
#pragma unroll
    for (int ct = 0; ct < NCT; ++ct) acc[ct] = (f32x4){0.f, 0.f, 0.f, 0.f};
#pragma unroll 1
    for (int k0 = 0; k0 < K; k0 += 128) {
        bf16x8 a[4], b[NCT][4];
#pragma unroll
        for (int j = 0; j < 4; ++j) a[j] = *(const bf16x8*)(ap + k0 + j * 32);
#pragma unroll
        for (int ct = 0; ct < NCT; ++ct)
#pragma unroll
            for (int j = 0; j < 4; ++j) b[ct][j] = *(const bf16x8*)(bp + (size_t)ct * 16 * K + k0 + j * 32);
        asm volatile("" ::: "memory");
#pragma unroll
        for (int ct = 0; ct < NCT; ++ct)
#pragma unroll
            for (int j = 0; j < 4; ++j) acc[ct] = __builtin_amdgcn_mfma_f32_16x16x32_bf16(b[ct][j], a[j], acc[ct], 0, 0, 0);
    }
}

__device__ __forceinline__ void p0_transpose_item(const float* __restrict__ W, int ldw, int K, bf16* __restrict__ WT, int dst_row0, int src_col0, int nvalid, int k0, MK_LAS float* scr, int lane) {
#pragma unroll 8
    for (int i = 0; i < 32; ++i) { const int kk = 2 * i + (lane >> 5), j = lane & 31; scr[kk * 33 + j] = j < nvalid ? W[(size_t)(k0 + kk) * ldw + src_col0 + j] : 0.f; }
    asm volatile("s_waitcnt lgkmcnt(0)" ::: "memory");
    const int c = lane & 7;
#pragma unroll
    for (int j = 0; j < 4; ++j) { const int n = (lane >> 3) + 8 * j; const MK_LAS float* s = scr + (8 * c) * 33 + n;
        u32x4 o; o.x = pk2(s[0 * 33], s[1 * 33]); o.y = pk2(s[2 * 33], s[3 * 33]); o.z = pk2(s[4 * 33], s[5 * 33]); o.w = pk2(s[6 * 33], s[7 * 33]);
        *(u32x4*)(WT + (size_t)(dst_row0 + n) * K + k0 + 8 * c) = o; }
    asm volatile("s_waitcnt lgkmcnt(0)" ::: "memory");
}
__device__ __forceinline__ void p0_convert(const float* __restrict__ src, bf16* __restrict__ dst, size_t n8, int gw, int ngw, int lane) {
    for (size_t i = (size_t)gw * 64 + lane; i < n8; i += (size_t)ngw * 64) {
        const f32x4 a = *(const f32x4*)(src + i * 8), b = *(const f32x4*)(src + i * 8 + 4);
        *(u32x4*)(dst + i * 8) = pack8(a, b);
    }
}

__device__ __forceinline__ void p0_quant_row(const float* __restrict__ src, unsigned char* __restrict__ dst, float* __restrict__ scale, int lane) {
    f32x4 v[4]; float am = 0.f;
#pragma unroll
    for (int q = 0; q < 4; ++q) { v[q] = *(const f32x4*)(src + lane * 16 + q * 4); am = fmaxf(am, fmaxf(fmaxf(fabsf(v[q][0]), fabsf(v[q][1])), fmaxf(fabsf(v[q][2]), fabsf(v[q][3])))); }
#pragma unroll
    for (int o = 1; o < 64; o <<= 1) am = fmaxf(am, __shfl_xor(am, o));
    const float inv = am > 0.f ? 448.f / am : 0.f;
    u32x4 w;
#pragma unroll
    for (int q = 0; q < 4; ++q) { int x = __builtin_amdgcn_cvt_pk_fp8_f32(v[q][0] * inv, v[q][1] * inv, 0, false); x = __builtin_amdgcn_cvt_pk_fp8_f32(v[q][2] * inv, v[q][3] * inv, x, true); w[q] = (unsigned)x; }
    *(u32x4*)(dst + lane * 16) = w;
    if (lane == 0) *scale = am * (1.f / 448.f);
}

__device__ __forceinline__ void p0_quant_rows4(const float* __restrict__ src, unsigned char* __restrict__ dst, float* __restrict__ scale, int lane) {
    f32x4 v[4][4]; float am[4];
#pragma unroll
    for (int r = 0; r < 4; ++r)
#pragma unroll
        for (int q = 0; q < 4; ++q) v[r][q] = *(const f32x4*)(src + (size_t)r * D + lane * 16 + q * 4);
#pragma unroll
    for (int r = 0; r < 4; ++r) { float a = 0.f;
#pragma unroll
        for (int q = 0; q < 4; ++q) a = fmaxf(a, fmaxf(fmaxf(fabsf(v[r][q][0]), fabsf(v[r][q][1])), fmaxf(fabsf(v[r][q][2]), fabsf(v[r][q][3]))));
        am[r] = a; }
#pragma unroll
    for (int o = 1; o < 64; o <<= 1) {
#pragma unroll
        for (int r = 0; r < 4; ++r) am[r] = fmaxf(am[r], __shfl_xor(am[r], o)); }
#pragma unroll
    for (int r = 0; r < 4; ++r) {
        const float inv = am[r] > 0.f ? 448.f / am[r] : 0.f;
        u32x4 w;
#pragma unroll
        for (int q = 0; q < 4; ++q) { int x = __builtin_amdgcn_cvt_pk_fp8_f32(v[r][q][0] * inv, v[r][q][1] * inv, 0, false); x = __builtin_amdgcn_cvt_pk_fp8_f32(v[r][q][2] * inv, v[r][q][3] * inv, x, true); w[q] = (unsigned)x; }
        *(u32x4*)(dst + (size_t)r * D + lane * 16) = w;
        if (lane == 0) scale[r] = am[r] * (1.f / 448.f);
    }
}

struct FAttnIn {
    bf16 *Qb, *Kb, *Vb, *QIb, *KIb; float* WIf; float* out;
    mutable float kmax = 0.f, vmax = 0.f;
    __device__ __forceinline__ static float amax8(f32x4 a, f32x4 b) { return fmaxf(fmaxf(fmaxf(fabsf(a[0]), fabsf(a[1])), fmaxf(fabsf(a[2]), fabsf(a[3]))), fmaxf(fmaxf(fabsf(b[0]), fabsf(b[1])), fmaxf(fabsf(b[2]), fabsf(b[3])))); }
    __device__ __forceinline__ float* okp(int row, size_t offp, size_t offs, int ld) const { return row < TP ? out + offp + (size_t)row * ld : out + offs + (size_t)(row - TP) * ld; }
    __device__ __forceinline__ void put8(int row, int col, f32x4 v0, f32x4 v1) const {
        const u32x4 w = pack8(v0, v1);
        if (col < AK) *(u32x4*)(Qb + (size_t)row * 1024 + col) = w;
        else if (col < AV) { *(u32x4*)(Kb + (size_t)row * 256 + (col - AK)) = w; float* o = okp(row, OUT_KP, OUT_KS, 256) + (col - AK); *(f32x4*)o = v0; *(f32x4*)(o + 4) = v1; kmax = fmaxf(kmax, amax8(v0, v1)); }
        else if (col < AQI) { *(u32x4*)(Vb + (size_t)row * 256 + (col - AV)) = w; float* o = okp(row, OUT_VP, OUT_VS, 256) + (col - AV); *(f32x4*)o = v0; *(f32x4*)(o + 4) = v1; vmax = fmaxf(vmax, amax8(v0, v1)); }
        else *(u32x4*)(QIb + (size_t)row * 512 + (col - AQI)) = w;
    }
    __device__ __forceinline__ void put4(int row, int col, f32x4 v) const {
        u32x2 w; w.x = pk2(v[0], v[1]); w.y = pk2(v[2], v[3]);
        if (col < AK) *(u32x2*)(Qb + (size_t)row * 1024 + col) = w;
        else if (col < AV) { *(u32x2*)(Kb + (size_t)row * 256 + (col - AK)) = w; *(f32x4*)(okp(row, OUT_KP, OUT_KS, 256) + (col - AK)) = v; }
        else if (col < AQI) { *(u32x2*)(Vb + (size_t)row * 256 + (col - AV)) = w; *(f32x4*)(okp(row, OUT_VP, OUT_VS, 256) + (col - AV)) = v; }
        else if (col < AKI) *(u32x2*)(QIb + (size_t)row * 512 + (col - AQI)) = w;
        else if (col < AWI) { *(u32x2*)(KIb + (size_t)row * 64 + (col - AKI)) = w; *(f32x4*)(okp(row, OUT_KIP, OUT_KIS, 64) + (col - AKI)) = v; }
        else if (col < ATT_N) *(f32x4*)(WIf + (size_t)row * 8 + (col - AWI)) = v * 0.04419417382415922f;
    }
};
}

namespace mk {
typedef float f32x2v __attribute__((ext_vector_type(2)));
typedef float f32x16 __attribute__((ext_vector_type(16)));
typedef short s16x4 __attribute__((ext_vector_type(4)));
typedef short v4i16_t __attribute__((ext_vector_type(4)));

__device__ __forceinline__ void score_load_q(const bf16* __restrict__ QIb, const float* __restrict__ WIf, size_t tok0, int lane, bf16x8 (&afr)[4], f32x4 (&w4)[4]) {
    const int r = lane & 31, kq = lane >> 5;
    const bf16* ap = QIb + (tok0 + (r >> 3)) * 512 + (r & 7) * 64 + kq * 8;
#pragma unroll
    for (int ks = 0; ks < 4; ++ks) afr[ks] = *(const bf16x8*)(ap + ks * 16);
#pragma unroll
    for (int ql = 0; ql < 4; ++ql) w4[ql] = *(const f32x4*)(WIf + (tok0 + ql) * 8 + 4 * kq);
}
__device__ __forceinline__ void score_tile(const bf16x8 (&afr)[4], const bf16x8 (&bfr)[4], const f32x4 (&w4)[4], float (&s)[4]) {
    f32x16 acc;
#pragma unroll
    for (int j = 0; j < 16; ++j) acc[j] = 0.f;
#pragma unroll
    for (int ks = 0; ks < 4; ++ks) acc = __builtin_amdgcn_mfma_f32_32x32x16_bf16(afr[ks], bfr[ks], acc, 0, 0, 0);
#pragma unroll
    for (int ql = 0; ql < 4; ++ql) {
        float p = 0.f;
#pragma unroll
        for (int jj = 0; jj < 4; ++jj) p = fmaf(fmaxf(acc[ql * 4 + jj], 0.f), w4[ql][jj], p);
        s[ql] = p + __shfl_xor(p, 32);
    }
}

__device__ __forceinline__ void quant_issue(const float* __restrict__ src, f32x4 (&v)[4], int lane) {
#pragma unroll
    for (int q = 0; q < 4; ++q) v[q] = *(const f32x4*)(src + lane * 16 + q * 4);
}
#ifndef PEER_BITS
#define PEER_BITS 4
#endif
#ifndef PEER_AMAX4
#define PEER_AMAX4 6.0f
#endif
constexpr int PEER_RB = PEER_BITS * 128;
#if PEER_BITS == 4
__device__ __forceinline__ unsigned enc_e2m1(float x) {
    const float a = fabsf(x);
    const float c = a < 2.f ? rintf(a * 2.f) : (a < 4.f ? rintf(a) + 2.f : fminf(rintf(a * 0.5f) + 4.f, 7.f));
    return (unsigned)c | (x < 0.f ? 8u : 0u);
}
__device__ __forceinline__ void quant_finish(const f32x4 (&v)[4], unsigned char* __restrict__ dst, float* __restrict__ scale, int lane) {
    float am = 0.f;
#pragma unroll
    for (int q = 0; q < 4; ++q) am = fmaxf(am, fmaxf(fmaxf(fabsf(v[q][0]), fabsf(v[q][1])), fmaxf(fabsf(v[q][2]), fabsf(v[q][3]))));
#pragma unroll
    for (int o = 1; o < 64; o <<= 1) am = fmaxf(am, __shfl_xor(am, o));
    const float inv = am > 0.f ? PEER_AMAX4 / am : 0.f;
    u32x2 w; w.x = 0u; w.y = 0u;
#pragma unroll
    for (int i = 0; i < 8; ++i) { w.x |= enc_e2m1(v[i >> 2][i & 3] * inv) << (4 * i); w.y |= enc_e2m1(v[2 + (i >> 2)][i & 3] * inv) << (4 * i); }
    *(u32x2*)(dst + lane * 8) = w;
    if (lane == 0) *scale = am * (1.f / PEER_AMAX4);
}
#elif PEER_BITS == 6
__device__ __forceinline__ unsigned enc_e2m3(float x) {
    const float a = fabsf(x), q = a * 8.f;
    const float c = a < 2.f ? rintf(q) : (a < 4.f ? rintf(q * 0.5f) + 8.f : fminf(rintf(q * 0.25f) + 16.f, 31.f));
    return (unsigned)c | (x < 0.f ? 32u : 0u);
}
__device__ __forceinline__ void quant_finish(const f32x4 (&v)[4], unsigned char* __restrict__ dst, float* __restrict__ scale, int lane) {
    float am = 0.f;
#pragma unroll
    for (int q = 0; q < 4; ++q) am = fmaxf(am, fmaxf(fmaxf(fabsf(v[q][0]), fabsf(v[q][1])), fmaxf(fabsf(v[q][2]), fabsf(v[q][3]))));
#pragma unroll
    for (int o = 1; o < 64; o <<= 1) am = fmaxf(am, __shfl_xor(am, o));
    const float inv = am > 0.f ? 7.5f / am : 0.f;
    unsigned long long lo = 0ull, hi = 0ull;
#pragma unroll
    for (int i = 0; i < 16; ++i) {
        const unsigned long long c = enc_e2m3(v[i >> 2][i & 3] * inv);
        if (i < 10) lo |= c << (6 * i);
        else if (i == 10) { lo |= (c & 15ull) << 60; hi |= c >> 4; }
        else hi |= c << (6 * (i - 11) + 2);
    }
    unsigned* d = (unsigned*)(dst + lane * 12);
    d[0] = (unsigned)lo; d[1] = (unsigned)(lo >> 32); d[2] = (unsigned)hi;
    if (lane == 0) *scale = am * (1.f / 7.5f);
}
#else
__device__ __forceinline__ void quant_finish(const f32x4 (&v)[4], unsigned char* __restrict__ dst, float* __restrict__ scale, int lane) {
    float am = 0.f;
#pragma unroll
    for (int q = 0; q < 4; ++q) am = fmaxf(am, fmaxf(fmaxf(fabsf(v[q][0]), fabsf(v[q][1])), fmaxf(fabsf(v[q][2]), fabsf(v[q][3]))));
#pragma unroll
    for (int o = 1; o < 64; o <<= 1) am = fmaxf(am, __shfl_xor(am, o));
    const float inv = am > 0.f ? 448.f / am : 0.f;
    u32x4 w;
#pragma unroll
    for (int q = 0; q < 4; ++q) { int x = __builtin_amdgcn_cvt_pk_fp8_f32(v[q][0] * inv, v[q][1] * inv, 0, false); x = __builtin_amdgcn_cvt_pk_fp8_f32(v[q][2] * inv, v[q][3] * inv, x, true); w[q] = (unsigned)x; }
    *(u32x4*)(dst + lane * 16) = w;
    if (lane == 0) *scale = am * (1.f / 448.f);
}
#endif
struct QuantTabs { const float* pu; const float* pv; unsigned char* uq; unsigned char* vq; float* us; float* vs;
    __device__ __forceinline__ const float* src(int r) const { return r < 2 * 16384 ? pu + (size_t)r * D : pv + (size_t)(r - 2 * 16384) * D; }
    __device__ __forceinline__ unsigned char* dst(int r) const { return r < 2 * 16384 ? uq + (size_t)r * PEER_RB : vq + (size_t)(r - 2 * 16384) * PEER_RB; }
    __device__ __forceinline__ float* sc(int r) const { return r < 2 * 16384 ? us + r : vs + (r - 2 * 16384); } };

__device__ __forceinline__ void phase_score(const bf16* __restrict__ QIb, const bf16* __restrict__ KIb, const float* __restrict__ WIf, const float* __restrict__ cache_ki, const int* __restrict__ page_table,
                                            float* __restrict__ SC, float* __restrict__ SCS, const QuantTabs QT_, LAS unsigned char* lds, int vcu, int G, int wave, int lane, int gw, int NGW) {
    const int c = lane & 31, kq = lane >> 5;
    int qrow = gw;
    constexpr int KST = 144, KBUF = 256 * KST;
    const int tid = wave * 64 + lane;
    for (int it = vcu; it < 512; it += G) {
        const int b = it >> 8, qt = b == 0 ? (it & 255) : 255 - (it & 255);
        const size_t tok0 = (size_t)b * SEQ + qt * 32 + wave * 4;
        bf16x8 afr[4]; f32x4 w4[4];
        score_load_q(QIb, WIf, tok0, lane, afr, w4);
        const int nc = (qt >> 3) + 1;
        const bf16* kbase = KIb + (size_t)b * SEQ * 64;
        u32x4 st[4];
#pragma unroll
        for (int i = 0; i < 4; ++i) { const int p = tid + i * 512; st[i] = *(const u32x4*)(kbase + (size_t)(p >> 3) * 64 + (p & 7) * 8); }
#pragma unroll
        for (int i = 0; i < 4; ++i) { const int p = tid + i * 512; *(LAS u32x4*)(lds + (p >> 3) * KST + (p & 7) * 16) = st[i]; }
        __syncthreads();
        for (int ch = 0; ch < nc; ++ch) {
            const bool more = ch + 1 < nc;
            f32x4 qv[4]; const bool qdo = qrow < 4 * 16384;
            if (qdo) quant_issue(QT_.src(qrow), qv, lane);
            if (more) {
#pragma unroll
                for (int i = 0; i < 4; ++i) { const int p = tid + i * 512; st[i] = *(const u32x4*)(kbase + ((size_t)(ch + 1) * 256 + (p >> 3)) * 64 + (p & 7) * 8); }
            }
            LAS unsigned char* kb = lds + (ch & 1) * KBUF;
            const int ntile = more ? 8 : (qt & 7) + 1;
            for (int kt8 = 0; kt8 < ntile; ++kt8) {
                bf16x8 bfr[4];
#pragma unroll
                for (int ks = 0; ks < 4; ++ks) bfr[ks] = *(LAS bf16x8*)(kb + (kt8 * 32 + c) * KST + ks * 32 + kq * 16);
                float sv[4]; score_tile(afr, bfr, w4, sv);
                float* o = SC + (tok0 + 2 * kq) * SEQ + (ch * 8 + kt8) * 32 + c;
                o[0] = kq ? sv[2] : sv[0]; o[SEQ] = kq ? sv[3] : sv[1];
            }
            if (qdo) { quant_finish(qv, QT_.dst(qrow), QT_.sc(qrow), lane); qrow += NGW; }
            if (more) {
                LAS unsigned char* nb = lds + ((ch + 1) & 1) * KBUF;
#pragma unroll
                for (int i = 0; i < 4; ++i) { const int p = tid + i * 512; *(LAS u32x4*)(nb + (p >> 3) * KST + (p & 7) * 16) = st[i]; }
            }
            __syncthreads();
        }
    }
    for (; qrow < 4 * 16384; qrow += NGW) { f32x4 qv[4]; quant_issue(QT_.src(qrow), qv, lane); quant_finish(qv, QT_.dst(qrow), QT_.sc(qrow), lane); }
    for (int it = gw; it < DB * NPAGES + DB; it += NGW) {
        const bool isnew = it >= DB * NPAGES;
        const int b = isnew ? it - DB * NPAGES : it / NPAGES, pg = isnew ? 0 : it % NPAGES;
        const size_t tok0 = (size_t)TP + b * DS;
        bf16x8 afr[4]; f32x4 w4[4];
        score_load_q(QIb, WIf, tok0, lane, afr, w4);
        if (!isnew) {
            const int phys = page_table[b * NPAGES + pg];
            for (int j = 0; j < 4; ++j) {
                const float* kp = cache_ki + ((size_t)phys * PAGE + j * 32 + c) * 64 + kq * 8;
                bf16x8 bfr[4];
#pragma unroll
                for (int ks = 0; ks < 4; ++ks) { const f32x4 x0 = *(const f32x4*)(kp + ks * 16), x1 = *(const f32x4*)(kp + ks * 16 + 4); const u32x4 w = pack8(x0, x1); bfr[ks] = __builtin_bit_cast(bf16x8, w); }
                float s[4]; score_tile(afr, bfr, w4, s);
                float* o = SCS + (size_t)(b * DS + 2 * kq) * SCS_LD + pg * PAGE + j * 32 + c;
                o[0] = kq ? s[2] : s[0]; o[SCS_LD] = kq ? s[3] : s[1];
            }
        } else {
            const bf16* kp = KIb + (tok0 + (c & 3)) * 64 + kq * 8;
            bf16x8 bfr[4];
#pragma unroll
            for (int ks = 0; ks < 4; ++ks) bfr[ks] = *(const bf16x8*)(kp + ks * 16);
            float s[4]; score_tile(afr, bfr, w4, s);
            if (c < 4) { float* o = SCS + (size_t)(b * DS + 2 * kq) * SCS_LD + PAST + c; o[0] = kq ? s[2] : s[0]; o[SCS_LD] = kq ? s[3] : s[1]; }
        }
    }
}

constexpr int VST = 144;
__device__ __forceinline__ bf16x8 ld_frag8(const bf16* p) { return *(const bf16x8*)p; }
__device__ __forceinline__ bf16x8 ld_frag8(const float* p) { const f32x4 a = *(const f32x4*)p, b = *(const f32x4*)(p + 4); const u32x4 w = pack8(a, b); return __builtin_bit_cast(bf16x8, w); }
__device__ __forceinline__ s16x4 lds_tr(LAS unsigned char* p) { return __builtin_bit_cast(s16x4, __builtin_amdgcn_ds_read_tr16_b64_v4i16((LAS v4i16_t*)p)); }

template <bool SAMPLE>
__device__ __forceinline__ void attn_row(int row, int n0, int n1, const bf16* __restrict__ Qb, const int* __restrict__ IDX, const int* __restrict__ CNT,
                                         const bf16* __restrict__ Kb, const bf16* __restrict__ Vb, const float* __restrict__ cache_k, const float* __restrict__ cache_v,
                                         const float* __restrict__ newk, const float* __restrict__ newv, const int* __restrict__ page_table,
                                         bf16* __restrict__ Ob, LAS unsigned char* wl, int lane) {
    const int fr = lane & 15, fq = lane >> 4;
    LAS int* rid = (LAS int*)wl;
    LAS unsigned char* vt = wl + 1024;
    const int cnt = CNT[row];
    const int b = SAMPLE ? (row - TP) / DS : row / SEQ;
#pragma unroll
    for (int i = 0; i < 4; ++i) { const int slot = i * 64 + lane; int key = slot < cnt ? IDX[(size_t)row * TOPK + slot] : 0; int id;
        if (!SAMPLE) id = b * SEQ + key;
        else if (key < PAST) id = page_table[b * NPAGES + key / PAGE] * PAGE + (key % PAGE);
        else id = (int)0x80000000 | (b * DS + (key - PAST));
        rid[slot] = id; }
    asm volatile("s_waitcnt lgkmcnt(0)" ::: "memory");
    for (int n = n0; n < n1; ++n) {
        bf16x8 qf[2];
#pragma unroll
        for (int ks = 0; ks < 2; ++ks) qf[ks] = *(const bf16x8*)(Qb + (size_t)row * 1024 + (n * 4 + (fr & 3)) * 64 + ks * 32 + fq * 8);
        f32x4 st[16];
        constexpr int TBN = SAMPLE ? 4 : 8;
#pragma unroll
        for (int tb = 0; tb < 16 / TBN; ++tb) {
            bf16x8 kf[TBN][2];
#pragma unroll
            for (int t = 0; t < TBN; ++t) {
                const int id = rid[(tb * TBN + t) * 16 + fr];
                if (!SAMPLE) { const bf16* kp = Kb + (size_t)id * 256 + n * 64 + fq * 8; kf[t][0] = ld_frag8(kp); kf[t][1] = ld_frag8(kp + 32); }
                else { const float* kp = (id < 0 ? newk + (size_t)(id & 0x7fffffff) * 256 : cache_k + (size_t)id * 256) + n * 64 + fq * 8; kf[t][0] = ld_frag8(kp); kf[t][1] = ld_frag8(kp + 32); }
            }
#pragma unroll
            for (int t = 0; t < TBN; ++t) {
                f32x4 a = (f32x4){0.f, 0.f, 0.f, 0.f};
                a = __builtin_amdgcn_mfma_f32_16x16x32_bf16(kf[t][0], qf[0], a, 0, 0, 0);
                a = __builtin_amdgcn_mfma_f32_16x16x32_bf16(kf[t][1], qf[1], a, 0, 0, 0);
                st[tb * TBN + t] = a;
            }
            asm volatile("" ::: "memory");
        }
        bf16x8 vreg[8];
#define ATT_VLOAD(ch_) do { _Pragma("unroll") for (int i = 0; i < 8; ++i) { const int sl = i * 8 + (lane >> 3), chunk = lane & 7; const int id = rid[(ch_) * 64 + sl]; \
            if (!SAMPLE) vreg[i] = ld_frag8(Vb + (size_t)id * 256 + n * 64 + chunk * 8); \
            else vreg[i] = ld_frag8((id < 0 ? newv + (size_t)(id & 0x7fffffff) * 256 : cache_v + (size_t)id * 256) + n * 64 + chunk * 8); } } while (0)
        ATT_VLOAD(0);
        float mx = -INFINITY;
#pragma unroll
        for (int t = 0; t < 16; ++t)
#pragma unroll
            for (int j = 0; j < 4; ++j) { const int slot = t * 16 + fq * 4 + j; const float v = slot < cnt ? st[t][j] * 0.125f : -INFINITY; st[t][j] = v; mx = fmaxf(mx, v); }
        mx = fmaxf(mx, __shfl_xor(mx, 16)); mx = fmaxf(mx, __shfl_xor(mx, 32));
        float sum = 0.f;
#pragma unroll
        for (int t = 0; t < 16; ++t)
#pragma unroll
            for (int j = 0; j < 4; ++j) { const float e = __expf(st[t][j] - mx); st[t][j] = e; sum += e; }
        sum += __shfl_xor(sum, 16); sum += __shfl_xor(sum, 32);
        f32x4 oacc[4];
#pragma unroll
        for (int dt = 0; dt < 4; ++dt) oacc[dt] = (f32x4){0.f, 0.f, 0.f, 0.f};
#pragma unroll
        for (int ch = 0; ch < 4; ++ch) {
#pragma unroll
            for (int i = 0; i < 8; ++i) { const int sl = i * 8 + (lane >> 3), chunk = lane & 7; *(LAS bf16x8*)(vt + sl * VST + chunk * 16) = vreg[i]; }
            asm volatile("s_waitcnt lgkmcnt(0)" ::: "memory");
            if (ch < 3) ATT_VLOAD(ch + 1);
#pragma unroll
            for (int s2 = 0; s2 < 2; ++s2) {
                const int t0 = ch * 4 + s2 * 2;
                const u32x4 pw = pack8(st[t0], st[t0 + 1]);
                const bf16x8 pf = __builtin_bit_cast(bf16x8, pw);
#pragma unroll
                for (int dt = 0; dt < 4; ++dt) {
                    LAS unsigned char* a0 = vt + (s2 * 32 + fq * 4 + (fr >> 2)) * VST + (dt * 16 + 4 * (fr & 3)) * 2;
                    const s16x4 v0 = lds_tr(a0), v1 = lds_tr(a0 + 16 * VST);
                    bf16x8 vf; vf[0] = v0[0]; vf[1] = v0[1]; vf[2] = v0[2]; vf[3] = v0[3]; vf[4] = v1[0]; vf[5] = v1[1]; vf[6] = v1[2]; vf[7] = v1[3];
                    oacc[dt] = __builtin_amdgcn_mfma_f32_16x16x32_bf16(pf, vf, oacc[dt], 0, 0, 0);
                }
            }
            asm volatile("s_waitcnt lgkmcnt(0)" ::: "memory");
        }
#undef ATT_VLOAD
        const float i0 = 1.f / __shfl(sum, 0), i1 = 1.f / __shfl(sum, 1), i2 = 1.f / __shfl(sum, 2), i3 = 1.f / __shfl(sum, 3);
        if (fq == 0) {
#pragma unroll
            for (int dt = 0; dt < 4; ++dt) {
                bf16* o = Ob + (size_t)row * 1024 + (n * 4) * 64 + dt * 16 + fr;
                o[0] = (bf16)f2bf(oacc[dt][0] * i0); o[64] = (bf16)f2bf(oacc[dt][1] * i1); o[128] = (bf16)f2bf(oacc[dt][2] * i2); o[192] = (bf16)f2bf(oacc[dt][3] * i3);
            }
        }
    }
    asm volatile("s_waitcnt lgkmcnt(0)" ::: "memory");
}

__device__ __forceinline__ void kv8_convert(const bf16* __restrict__ Kb, const bf16* __restrict__ Vb, unsigned char* __restrict__ KV8_, const unsigned* __restrict__ amaxk, const unsigned* __restrict__ amaxv, int gw, int NGW, int lane) {
    const float ak = __builtin_bit_cast(float, __hip_atomic_load(amaxk, __ATOMIC_RELAXED, __HIP_MEMORY_SCOPE_AGENT)), av = __builtin_bit_cast(float, __hip_atomic_load(amaxv, __ATOMIC_RELAXED, __HIP_MEMORY_SCOPE_AGENT));
    const bool isv = lane >= 32; const int l = lane & 31;
    const float sc = isv ? (av > 0.f ? 448.f / av : 0.f) : (ak > 0.f ? 448.f / ak : 0.f);
    for (int t = gw; t < TP; t += NGW) {
        const u32x4 w = *(const u32x4*)((isv ? Vb : Kb) + (size_t)t * 256 + l * 8);
        const float x0 = bflo(w.x) * sc, x1 = bfhi(w.x) * sc, x2 = bflo(w.y) * sc, x3 = bfhi(w.y) * sc, x4 = bflo(w.z) * sc, x5 = bfhi(w.z) * sc, x6 = bflo(w.w) * sc, x7 = bfhi(w.w) * sc;
        int p0 = __builtin_amdgcn_cvt_pk_fp8_f32(x0, x1, 0, false); p0 = __builtin_amdgcn_cvt_pk_fp8_f32(x2, x3, p0, true);
        int p1 = __builtin_amdgcn_cvt_pk_fp8_f32(x4, x5, 0, false); p1 = __builtin_amdgcn_cvt_pk_fp8_f32(x6, x7, p1, true);
        const int n = l >> 3, d0 = (l & 7) * 8;
        const int pos = isv ? 64 + d0 : ((d0 & 31) >> 3) * 16 + (d0 >> 5) * 8;
        u32x2 o; o.x = (unsigned)p0; o.y = (unsigned)p1;
        *(u32x2*)(KV8_ + (size_t)t * 512 + n * 128 + pos) = o;
    }
}
__device__ __forceinline__ void fp8x16_to_bf16(const u32x4 q, bf16x8& lo, bf16x8& hi) {
    u32x4 a, b;
#pragma unroll
    for (int w = 0; w < 4; ++w) { const f32x2v f0 = __builtin_amdgcn_cvt_pk_f32_fp8((int)q[w], false), f1 = __builtin_amdgcn_cvt_pk_f32_fp8((int)q[w], true);
        const unsigned u0 = pk2(f0[0], f0[1]), u1 = pk2(f1[0], f1[1]);
        if (w < 2) { a[2 * w] = u0; a[2 * w + 1] = u1; } else { b[2 * w - 4] = u0; b[2 * w - 3] = u1; } }
    lo = __builtin_bit_cast(bf16x8, a); hi = __builtin_bit_cast(bf16x8, b);
}
#ifndef KF1
#define KF1 10
#endif
__device__ __forceinline__ void attn_prompt_stream(int b, int n, int q0, int qstep, const bf16* __restrict__ Qb, const int* __restrict__ IDX, const unsigned char* __restrict__ KV8_, const unsigned* __restrict__ amaxk, const unsigned* __restrict__ amaxv,
                                                   bf16* __restrict__ Ob, LAS unsigned char* wl, int lane) {
    const float ak_ = __builtin_bit_cast(float, __hip_atomic_load(amaxk, __ATOMIC_RELAXED, __HIP_MEMORY_SCOPE_AGENT)), av_ = __builtin_bit_cast(float, __hip_atomic_load(amaxv, __ATOMIC_RELAXED, __HIP_MEMORY_SCOPE_AGENT));
    const float kinv = ak_ * (1.f / 448.f), vinv = av_ * (1.f / 448.f);
    const int fr = lane & 15, fq = lane >> 4;
    LAS int* ridb = (LAS int*)wl;
    LAS unsigned char* vt = wl + 2048;
    if (q0 >= SEQ) return;
    int vx[4];
    { const int row = b * SEQ + q0, cnt = q0 + 1 < TOPK ? q0 + 1 : TOPK;
#pragma unroll
      for (int i = 0; i < 4; ++i) { const int slot = i * 64 + lane; ridb[slot] = b * SEQ + (slot < cnt ? IDX[(size_t)row * TOPK + slot] : 0); } }
    int buf = 0;

    for (int q = q0; q < SEQ; q += qstep, buf ^= 1) {

        const int row = b * SEQ + q, cnt = q + 1 < TOPK ? q + 1 : TOPK;
        LAS int* rid = ridb + buf * 256;
        asm volatile("s_waitcnt lgkmcnt(0)" ::: "memory");
        int kx[16];
#pragma unroll
        for (int t = 0; t < 16; ++t) kx[t] = rid[t * 16 + fr];
        bf16x8 qf[2];
#pragma unroll
        for (int ks = 0; ks < 2; ++ks) qf[ks] = *(const bf16x8*)(Qb + (size_t)row * 1024 + (n * 4 + (fr & 3)) * 64 + ks * 32 + fq * 8);
        u32x4 kraw[16];
#pragma unroll
        for (int t = 0; t < 16; ++t) kraw[t] = *(const u32x4*)(KV8_ + (size_t)kx[t] * 512 + n * 128 + fq * 16);
        asm volatile("s_waitcnt lgkmcnt(0)" ::: "memory");
        u32x4 vraw[4];
#define ATT_VLOAD2(ch_) do { _Pragma("unroll") for (int i = 0; i < 4; ++i) { const int sl = i * 16 + (lane >> 2), piece = lane & 3; const int id = rid[(ch_) * 64 + sl]; \
            vraw[i] = *(const u32x4*)(KV8_ + (size_t)id * 512 + n * 128 + 64 + piece * 16); } } while (0)
        f32x4 st[16];
#pragma unroll
        for (int t = 0; t < 16; ++t) {
            asm volatile("" : "+v"(kraw[t][0]), "+v"(kraw[t][1]), "+v"(kraw[t][2]), "+v"(kraw[t][3]));
            bf16x8 k0, k1; fp8x16_to_bf16(kraw[t], k0, k1);
            f32x4 a = (f32x4){0.f, 0.f, 0.f, 0.f};
            a = __builtin_amdgcn_mfma_f32_16x16x32_bf16(k0, qf[0], a, 0, 0, 0);
            a = __builtin_amdgcn_mfma_f32_16x16x32_bf16(k1, qf[1], a, 0, 0, 0);
            st[t] = a;
            asm volatile("" : "+v"(st[t][0]), "+v"(st[t][1]), "+v"(st[t][2]), "+v"(st[t][3]));
        }

        const int qn = q + qstep;
        if (qn < SEQ) { const int rown = b * SEQ + qn, cntn = qn + 1 < TOPK ? qn + 1 : TOPK;
#pragma unroll
            for (int i = 0; i < 4; ++i) { const int slot = i * 64 + lane; vx[i] = slot < cntn ? IDX[(size_t)rown * TOPK + slot] : 0; } }
        ATT_VLOAD2(0);
        float mx = -INFINITY;
        if (cnt < TOPK) {
#pragma unroll
            for (int t = 0; t < 16; ++t)
#pragma unroll
                for (int j = 0; j < 4; ++j) { const int slot = t * 16 + fq * 4 + j; st[t][j] = slot < cnt ? st[t][j] : -INFINITY; }
        }
#pragma unroll
        for (int t = 0; t < 16; ++t) mx = fmaxf(mx, fmaxf(fmaxf(st[t][0], st[t][1]), fmaxf(st[t][2], st[t][3])));
        mx = fmaxf(mx, __shfl_xor(mx, 16)); mx = fmaxf(mx, __shfl_xor(mx, 32));
        const float cs = 0.18033688011112042f * kinv, mb = -mx * cs;
        float sum = 0.f;
#pragma unroll
        for (int t = 0; t < 16; ++t)
#pragma unroll
            for (int j = 0; j < 4; ++j) { const float e = __builtin_amdgcn_exp2f(fmaf(st[t][j], cs, mb)); st[t][j] = e; sum += e; }
        sum += __shfl_xor(sum, 16); sum += __shfl_xor(sum, 32);

        f32x4 oacc[4];
#pragma unroll
        for (int dt = 0; dt < 4; ++dt) oacc[dt] = (f32x4){0.f, 0.f, 0.f, 0.f};
#pragma unroll
        for (int ch = 0; ch < 4; ++ch) {
#pragma unroll
            for (int i = 0; i < 4; ++i) { const int sl = i * 16 + (lane >> 2), piece = lane & 3; bf16x8 v0, v1; fp8x16_to_bf16(vraw[i], v0, v1);
                *(LAS bf16x8*)(vt + sl * VST + piece * 32) = v0; *(LAS bf16x8*)(vt + sl * VST + piece * 32 + 16) = v1; }
            asm volatile("s_waitcnt lgkmcnt(0)" ::: "memory");
            if (ch < 3) ATT_VLOAD2(ch + 1);
#pragma unroll
            for (int s2 = 0; s2 < 2; ++s2) {
                const int t0 = ch * 4 + s2 * 2;
                const u32x4 pw = pack8(st[t0], st[t0 + 1]);
                const bf16x8 pf = __builtin_bit_cast(bf16x8, pw);
#pragma unroll
                for (int dt = 0; dt < 4; ++dt) {
                    LAS unsigned char* a0 = vt + (s2 * 32 + fq * 4 + (fr >> 2)) * VST + (dt * 16 + 4 * (fr & 3)) * 2;
                    const s16x4 v0 = lds_tr(a0), v1 = lds_tr(a0 + 16 * VST);
                    bf16x8 vf; vf[0] = v0[0]; vf[1] = v0[1]; vf[2] = v0[2]; vf[3] = v0[3]; vf[4] = v1[0]; vf[5] = v1[1]; vf[6] = v1[2]; vf[7] = v1[3];
                    oacc[dt] = __builtin_amdgcn_mfma_f32_16x16x32_bf16(pf, vf, oacc[dt], 0, 0, 0);
                }
            }
            asm volatile("s_waitcnt lgkmcnt(0)" ::: "memory");
        }
#undef ATT_VLOAD2

        const float i0 = vinv / __shfl(sum, 0), i1 = vinv / __shfl(sum, 1), i2 = vinv / __shfl(sum, 2), i3 = vinv / __shfl(sum, 3);
        if (fq == 0) {
#pragma unroll
            for (int dt = 0; dt < 4; ++dt) {
                bf16* o = Ob + (size_t)row * 1024 + (n * 4) * 64 + dt * 16 + fr;
                o[0] = (bf16)f2bf(oacc[dt][0] * i0); o[64] = (bf16)f2bf(oacc[dt][1] * i1); o[128] = (bf16)f2bf(oacc[dt][2] * i2); o[192] = (bf16)f2bf(oacc[dt][3] * i3);
            }
        }
        if (qn < SEQ) {
#pragma unroll
            for (int i = 0; i < 4; ++i) ridb[(buf ^ 1) * 256 + i * 64 + lane] = vx[i] + b * SEQ;
        }

    }

    asm volatile("s_waitcnt lgkmcnt(0)" ::: "memory");
}

__device__ __forceinline__ void ln_row_wave(const float* __restrict__ zrow, const float* __restrict__ g, const float* __restrict__ bt, float* __restrict__ of, bf16* __restrict__ ob, int lane) {
    f32x4 v[4]; float s = 0.f;
#pragma unroll
    for (int j = 0; j < 4; ++j) { v[j] = *(const f32x4*)(zrow + 256 * j + 4 * lane); s += (v[j][0] + v[j][1]) + (v[j][2] + v[j][3]); }
#pragma unroll
    for (int o = 1; o < 64; o <<= 1) s += __shfl_xor(s, o);
    const float mean = s * (1.f / D); float q = 0.f;
#pragma unroll
    for (int j = 0; j < 4; ++j) { v[j] = v[j] - mean; q += (v[j][0] * v[j][0] + v[j][1] * v[j][1]) + (v[j][2] * v[j][2] + v[j][3] * v[j][3]); }
#pragma unroll
    for (int o = 1; o < 64; o <<= 1) q += __shfl_xor(q, o);
    const float rstd = rsqrtf(q * (1.f / D) + LN_EPS);
#pragma unroll
    for (int j = 0; j < 4; ++j) { const f32x4 gg = *(const f32x4*)(g + 256 * j + 4 * lane), bb = *(const f32x4*)(bt + 256 * j + 4 * lane); const f32x4 o = v[j] * rstd * gg + bb;
        if (of) *(f32x4*)(of + 256 * j + 4 * lane) = o; u32x2 w; w.x = pk2(o[0], o[1]); w.y = pk2(o[2], o[3]); *(u32x2*)(ob + 256 * j + 4 * lane) = w; }
}

struct FResid {
    const float* rp; const float* rs; float* Z;
    __device__ __forceinline__ const float* rrow(int row) const { return row < TP ? rp + (size_t)row * D : rs + (size_t)(row - TP) * D; }
    __device__ __forceinline__ void put8(int row, int col, f32x4 v0, f32x4 v1) const { const float* r = rrow(row) + col; float* z = Z + (size_t)row * D + col;
        *(f32x4*)z = v0 + ALPHA * *(const f32x4*)r; *(f32x4*)(z + 4) = v1 + ALPHA * *(const f32x4*)(r + 4); }
    __device__ __forceinline__ void put4(int row, int col, f32x4 v) const { *(f32x4*)(Z + (size_t)row * D + col) = v + ALPHA * *(const f32x4*)(rrow(row) + col); }
};
}

namespace mk {
template <int CAP>
__device__ __forceinline__ void topk_wave_regs(const float* __restrict__ row, int n, int* __restrict__ out, LAS unsigned* hist, LAS float* cv, LAS int* ci, LAS unsigned char* lst, int lane) {
    if (n <= TOPK) { for (int i = lane; i < TOPK; i += 64) out[i] = i < n ? i : 0; return; }

    constexpr int NCH = 32;
    const int nch = n > 8192 ? 32 : (n + 255) >> 8;
    float vx = (lane < 4 && 8192 + lane < n) ? row[8192 + lane] : -INFINITY;
    f32x4 v[NCH];
#pragma unroll
    for (int j = 0; j < NCH; ++j) {
        if (j < nch) v[j] = *(const f32x4*)(row + j * 256 + lane * 4);
        else v[j] = (f32x4){-INFINITY, -INFINITY, -INFINITY, -INFINITY};
    }
    float mn = INFINITY, mx = -INFINITY;
#pragma unroll
    for (int j = 0; j < NCH; ++j) {
        if (j < nch) {
            const int base = j * 256 + lane * 4;
#pragma unroll
            for (int e = 0; e < 4; ++e) { const bool ok = base + e < n; const float x = v[j][e]; v[j][e] = ok ? x : -INFINITY; mx = fmaxf(mx, ok ? x : -INFINITY); mn = fminf(mn, ok ? x : INFINITY); }
        }
    }
    if (vx != -INFINITY) { mx = fmaxf(mx, vx); mn = fminf(mn, vx); }
#pragma unroll
    for (int o = 1; o < 64; o <<= 1) { mn = fminf(mn, __shfl_xor(mn, o)); mx = fmaxf(mx, __shfl_xor(mx, o)); }
    if (!(mx > mn)) { for (int i = lane; i < TOPK; i += 64) out[i] = i; return; }
    const float scale = 2048.0f / (mx - mn);

#pragma unroll
    for (int i = 0; i < 8; ++i) *(LAS u32x4*)(hist + i * 256 + lane * 4) = (u32x4){0u, 0u, 0u, 0u};
    asm volatile("s_waitcnt lgkmcnt(0)" ::: "memory");
#pragma unroll
    for (int j = 0; j < NCH; ++j) {
        if (j < nch) {
            asm volatile("" : "+v"(v[j][0]), "+v"(v[j][1]), "+v"(v[j][2]), "+v"(v[j][3]));
#pragma unroll
            for (int e = 0; e < 4; ++e) { const float x = v[j][e]; int bn = (int)((x - mn) * scale); bn = bn > 2047 ? 2047 : bn; bn = x != -INFINITY ? bn : 2048;
                __hip_atomic_fetch_add(hist + bn, 1u, __ATOMIC_RELAXED, __HIP_MEMORY_SCOPE_WAVEFRONT); }
        }
    }
    if (vx != -INFINITY) { int bn = (int)((vx - mn) * scale); bn = bn > 2047 ? 2047 : bn; __hip_atomic_fetch_add(hist + bn, 1u, __ATOMIC_RELAXED, __HIP_MEMORY_SCOPE_WAVEFRONT); }
    asm volatile("s_waitcnt lgkmcnt(0)" ::: "memory");

    unsigned mine = 0u;
#pragma unroll
    for (int i = 0; i < 8; ++i) { const u32x4 h4 = *(LAS u32x4*)(hist + lane * 32 + i * 4); mine += (h4.x + h4.y) + (h4.z + h4.w); }
    unsigned suf = mine;
#pragma unroll
    for (int o = 1; o < 64; o <<= 1) { const unsigned t = __shfl_down(suf, o); if (lane + o < 64) suf += t; }
    const unsigned long long bal = __ballot(suf >= (unsigned)TOPK);
    const int Lt = 63 - __builtin_clzll(bal);
    const unsigned above = __shfl(suf, Lt) - __shfl(mine, Lt);
    const unsigned hb = hist[Lt * 32 + (lane & 31)];
    unsigned sfx = hb;
#pragma unroll
    for (int o = 1; o < 32; o <<= 1) { const unsigned t = __shfl_down(sfx, o); if ((lane & 31) + o < 32) sfx += t; }
    const unsigned long long okm = __ballot(above + sfx >= (unsigned)TOPK) & 0xFFFFFFFFull;
    const int jb = 63 - __builtin_clzll(okm);
    const int B = Lt * 32 + jb;
    const unsigned running = above + __shfl(sfx, jb) - __shfl(hb, jb);
    const int cnt_gt = (int)running, r = TOPK - cnt_gt;

    int base_gt = 0, base_eq = 0;
    const unsigned long long below = (1ull << lane) - 1ull;
    int lane4 = lane * 4; asm volatile("" : "+v"(lane4));
#pragma unroll
    for (int j = 0; j < NCH; ++j) {
        if (j < nch) {
#pragma unroll
            for (int e = 0; e < 4; ++e) {
                const float x = v[j][e]; int bn = (int)((x - mn) * scale); bn = bn > 2047 ? 2047 : bn; bn = x != -INFINITY ? bn : -1;
                const bool gt = bn > B, eq = bn == B;
                const unsigned long long mg = __ballot(gt), me = __ballot(eq);
                if (mg | me) {
                    const int idx = lane4 + (j * 256 + e);
                    if (gt) out[base_gt + __builtin_popcountll(mg & below)] = idx;
                    if (eq) { const int p = base_eq + __builtin_popcountll(me & below); if (p < CAP) { cv[p] = x; ci[p] = idx; } }
                    base_gt += __builtin_popcountll(mg); base_eq += __builtin_popcountll(me);
                }
            }
        }
    }
    if (n > 8192) {
        const float x = vx; bool gt = false, eq = false;
        if (x != -INFINITY) { int bn = (int)((x - mn) * scale); bn = bn > 2047 ? 2047 : bn; gt = bn > B; eq = bn == B; }
        const unsigned long long mg = __ballot(gt), me = __ballot(eq);
        const int idx = 8192 + lane;
        if (gt) out[base_gt + __builtin_popcountll(mg & below)] = idx;
        if (eq) { const int p = base_eq + __builtin_popcountll(me & below); if (p < CAP) { cv[p] = x; ci[p] = idx; } }
        base_gt += __builtin_popcountll(mg); base_eq += __builtin_popcountll(me);
    }
    asm volatile("s_waitcnt vmcnt(0) lgkmcnt(0)" ::: "memory");

    const int m = base_eq < CAP ? base_eq : CAP;
    if (m <= 64) {
        const float x = lane < m ? cv[lane] : -INFINITY; const int id = lane < m ? ci[lane] : 0x7fffffff; int rank = 0;
        for (int c2 = 0; c2 < m; ++c2) { const float x2 = __builtin_bit_cast(float, __builtin_amdgcn_readlane(__builtin_bit_cast(int, x), c2)); const int id2 = __builtin_amdgcn_readlane(id, c2);
            rank += (x2 > x || (x2 == x && id2 < id)) ? 1 : 0; }
        if (lane < m && rank < r) out[cnt_gt + rank] = id;
    } else {
        for (int c = lane; c < m; c += 64) {
            const float x = cv[c]; const int id = ci[c]; int rank = 0;
            for (int c2 = 0; c2 < m; ++c2) { const float x2 = cv[c2]; const int id2 = ci[c2]; rank += (x2 > x || (x2 == x && id2 < id)) ? 1 : 0; }
            if (rank < r) out[cnt_gt + rank] = id;
        }
    }
    asm volatile("s_waitcnt lgkmcnt(0)" ::: "memory");

}

__device__ __forceinline__ void phase_topk2(const float* __restrict__ SC, const float* __restrict__ SCS, int* __restrict__ IDX, int* __restrict__ CNT,
                                            const float* __restrict__ peer_u_, const float* __restrict__ peer_v_, unsigned char* __restrict__ Uq_, unsigned char* __restrict__ Vq_, float* __restrict__ Usc_, float* __restrict__ Vsc_,
                                            LAS unsigned char* lds, unsigned* qhead, int wave, int lane, int gw, int NGW, int jlo = 0, int jhi = TA) {
    constexpr int CAP = 1020;
    LAS unsigned* hist = (LAS unsigned*)(lds + wave * 16384);
    LAS float* cv = (LAS float*)(lds + wave * 16384 + 8208);
    LAS int* ci = (LAS int*)(lds + wave * 16384 + 8208 + 4080);
    LAS unsigned char* lst = nullptr;

    for (int j = gw; j < TA; j += NGW) {
        if (j < jlo || j >= jhi) continue;
        int row, n; const float* rp;
        if (j < TP) { const int b = j >> 13, jj = j & 8191, blk = jj >> 11; const int q = blk < 2 ? jj : blk * 2048 + 2047 - (jj & 2047);
            row = b * SEQ + q; n = q + 1; rp = SC + (size_t)row * SEQ; }
        else { const int r = j - TP; row = j; n = PAST + (r % DS) + 1; rp = SCS + (size_t)r * SCS_LD; }

        topk_wave_regs<CAP>(rp, n, IDX + (size_t)row * TOPK, hist, cv, ci, lst, lane);

        if (lane == 0) CNT[row] = n < TOPK ? n : TOPK;
    }

}
}

namespace mk {
using bf16x2_t = __attribute__((ext_vector_type(2))) __bf16;
__device__ __forceinline__ float dot2bf(unsigned a, unsigned b, float acc) { return __builtin_amdgcn_fdot2_f32_bf16(__builtin_bit_cast(bf16x2_t, a), __builtin_bit_cast(bf16x2_t, b), acc, false); }

struct FStoreBf16 {
    bf16* O; int ld;
    __device__ __forceinline__ void put8(int row, int col, f32x4 v0, f32x4 v1) const { *(u32x4*)(O + (size_t)row * ld + col) = pack8(v0, v1); }
    __device__ __forceinline__ void put4(int row, int col, f32x4 v) const { u32x2 w; w.x = pk2(v[0], v[1]); w.y = pk2(v[2], v[3]); *(u32x2*)(O + (size_t)row * ld + col) = w; }
};

#ifndef PGS
#define PGS 8
#endif
constexpr int PEER_TAB_OFF = LDSCTL_OFF + 1024;

__device__ __forceinline__ void ce_desc(unsigned& a, unsigned& b) { const unsigned hi = a > b ? a : b, lo = a > b ? b : a; a = hi; b = lo; }
template <int N> __device__ __forceinline__ void bitonic_sort_desc(unsigned (&k)[N]) {
#pragma unroll
    for (int size = 2; size <= N; size <<= 1)
#pragma unroll
        for (int stride = size >> 1; stride > 0; stride >>= 1)
#pragma unroll
            for (int i = 0; i < N; ++i) { const int j = i ^ stride; if (j > i) { if ((i & size) == 0) ce_desc(k[i], k[j]); else ce_desc(k[j], k[i]); } }
}
template <int N> __device__ __forceinline__ void bitonic_merge_desc(unsigned (&k)[N]) {
#pragma unroll
    for (int stride = N >> 1; stride > 0; stride >>= 1)
#pragma unroll
        for (int i = 0; i < N; ++i) { const int j = i ^ stride; if (j > i) ce_desc(k[i], k[j]); }
}
__device__ __forceinline__ void top16_merge(unsigned (&a)[16], const unsigned (&b)[16]) {
#pragma unroll
    for (int i = 0; i < 16; ++i) a[i] = a[i] > b[15 - i] ? a[i] : b[15 - i];
    bitonic_merge_desc<16>(a);
}
__device__ __forceinline__ void top16_xlane(unsigned (&a)[16], int o) {
    unsigned b[16];
#pragma unroll
    for (int i = 0; i < 16; ++i) b[i] = (unsigned)__shfl_xor((int)a[i], o);
    top16_merge(a, b);
}
__device__ __forceinline__ unsigned f2ord(float f) { const unsigned u = __builtin_bit_cast(unsigned, f); return u ^ ((u >> 31) ? 0xFFFFFFFFu : 0x80000000u); }
__device__ __forceinline__ float ord2f(unsigned o) { const unsigned u = o ^ ((o >> 31) ? 0x80000000u : 0xFFFFFFFFu); return __builtin_bit_cast(float, u); }

__device__ __forceinline__ void phase_peer_select(const bf16* __restrict__ PQb, const bf16* __restrict__ K1, const bf16* __restrict__ K2, unsigned short* __restrict__ teid_g, float* __restrict__ tgate_g,
                                                  LAS unsigned char* lds, int vcu, int G, int wave, int lane) {
    const int fr = lane & 15, fq = lane >> 4, h = wave;
    LAS unsigned char* itab = lds + wave * 1024;
    for (int tile = vcu; tile < TA / 16; tile += G) {
        const int tok0 = tile * 16;
        unsigned tk[2][16];
#pragma unroll
        for (int half = 0; half < 2; ++half) {
            const bf16* ap = PQb + (size_t)(tok0 + fr) * PEER_N + h * 256 + half * 128 + fq * 8;
            bf16x8 a[4];
#pragma unroll
            for (int ks = 0; ks < 4; ++ks) a[ks] = *(const bf16x8*)(ap + ks * 32);
            const bf16* kb = (half ? K2 : K1) + (size_t)fr * 128 + fq * 8;
            unsigned k0[16], k1[16];
#pragma unroll
            for (int ct = 0; ct < 8; ++ct) {
                f32x4 acc = (f32x4){0.f, 0.f, 0.f, 0.f};
#pragma unroll
                for (int ks = 0; ks < 4; ++ks) { const bf16x8 b = *(const bf16x8*)(kb + (size_t)ct * 16 * 128 + ks * 32); acc = __builtin_amdgcn_mfma_f32_16x16x32_bf16(b, a[ks], acc, 0, 0, 0); }
#pragma unroll
                for (int j = 0; j < 4; ++j) { const unsigned key = (f2ord(acc[j]) & 0xFFFFFF80u) | (unsigned)(127 - (ct * 16 + 4 * fq + j));
                    if (ct < 4) k0[ct * 4 + j] = key; else k1[(ct - 4) * 4 + j] = key; }
                if (ct & 1) asm volatile("" ::: "memory");
            }
            bitonic_sort_desc<16>(k0); bitonic_sort_desc<16>(k1);
            top16_merge(k0, k1); top16_xlane(k0, 16); top16_xlane(k0, 32);
#pragma unroll
            for (int i = 0; i < 16; ++i) tk[half][i] = k0[i];
        }
        if (fq == 0) {
#pragma unroll
            for (int i = 0; i < 16; ++i) { itab[fr * 32 + i] = (unsigned char)(127 - (tk[0][i] & 0x7Fu)); itab[fr * 32 + 16 + i] = (unsigned char)(127 - (tk[1][i] & 0x7Fu)); }
        }
        unsigned ck[16];
        {
            float v1[16], v2[16];
#pragma unroll
            for (int i = 0; i < 16; ++i) { v1[i] = ord2f(tk[0][i] & 0xFFFFFF80u); v2[i] = ord2f(tk[1][i] & 0xFFFFFF80u); }
            int c = 0;
#pragma unroll
            for (int i = 0; i < 16; ++i)
#pragma unroll
                for (int j = 0; j < 16; ++j) {
                    if ((i + 1) * (j + 1) <= 16) {
                        const unsigned key = (f2ord(v1[i] + v2[j]) & 0xFFFFFF00u) | (unsigned)(255 - (i * 16 + j));
                        const int m = c >> 2, pt = c & 3;
                        if (pt == 0) ck[m] = key; else ck[m] = fq == pt ? key : ck[m];
                        ++c;
                    }
                }
            ck[12] = fq < 2 ? ck[12] : 0u; ck[13] = 0u; ck[14] = 0u; ck[15] = 0u;
        }
        bitonic_sort_desc<16>(ck); top16_xlane(ck, 16); top16_xlane(ck, 32);
        asm volatile("s_waitcnt lgkmcnt(0)" ::: "memory");
        float ev[16]; float sum = 0.f; const float mxv = ord2f(ck[0] & 0xFFFFFF00u);
#pragma unroll
        for (int k = 0; k < 16; ++k) { ev[k] = __expf(ord2f(ck[k] & 0xFFFFFF00u) - mxv); sum += ev[k]; }
        const float inv = 1.f / sum;
#pragma unroll
        for (int k = 0; k < 16; ++k) {
            if ((k >> 2) == fq) {
                const int f = 255 - (int)(ck[k] & 0xFFu); const int id = (int)itab[fr * 32 + (f >> 4)] * 128 + (int)itab[fr * 32 + 16 + (f & 15)];
                teid_g[(size_t)(tok0 + fr) * 128 + h * 16 + k] = (unsigned short)id; tgate_g[(size_t)(tok0 + fr) * 128 + h * 16 + k] = ev[k] * inv;
            }
        }
        asm volatile("s_waitcnt lgkmcnt(0)" ::: "memory");
    }
}

#if PEER_BITS == 4
__device__ __forceinline__ u32x4 prow_load(const unsigned char* __restrict__ T, int id, int lane) { const u32x2 r = *(const u32x2*)(T + (size_t)id * PEER_RB + lane * 8); u32x4 t; t.x = r.x; t.y = r.y; t.z = 0u; t.w = 0u; return t; }
#define PROW_LOAD(T, id) prow_load(T, id, lane)
#elif PEER_BITS == 6
typedef unsigned v6u_t __attribute__((ext_vector_type(6)));
typedef float v32f_t __attribute__((ext_vector_type(32)));
__device__ __forceinline__ u32x4 prow_load(const unsigned char* __restrict__ T, int id, int lane) { const unsigned* rp = (const unsigned*)(T + (size_t)id * PEER_RB + lane * 12); u32x4 t; t.x = rp[0]; t.y = rp[1]; t.z = rp[2]; t.w = 0u; return t; }
#define PROW_LOAD(T, id) prow_load(T, id, lane)
#else
#define PROW_LOAD(T, id) (*(const u32x4*)((T) + (size_t)(id) * D + lane * 16))
#endif
__device__ __forceinline__ void phase_peer_mix(const float* __restrict__ Zin, const float* __restrict__ g1, const float* __restrict__ b1, const unsigned short* __restrict__ teid, const float* __restrict__ tgate,
                                               const unsigned char* __restrict__ U, const unsigned char* __restrict__ V, const float* __restrict__ Us, const float* __restrict__ Vs, const float* __restrict__ g2, const float* __restrict__ b2,
                                               float* __restrict__ outf, bf16* __restrict__ outb, int gw, int NGW, int lane) {

    for (int j = gw; j < TP + TS * 16; j += NGW) {
        size_t tok;
        if (j < TP) tok = (size_t)j;
        else { const int s = j - TP; if ((s & 15) != 0) continue; tok = (size_t)TP + (s >> 4); }
        {
            float xf[16];
            { float s1 = 0.f;
#pragma unroll
              for (int q = 0; q < 4; ++q) { const f32x4 r = *(const f32x4*)(Zin + tok * D + lane * 16 + q * 4); xf[q * 4] = r[0]; xf[q * 4 + 1] = r[1]; xf[q * 4 + 2] = r[2]; xf[q * 4 + 3] = r[3]; s1 += (r[0] + r[1]) + (r[2] + r[3]); }
#pragma unroll
              for (int o = 1; o < 64; o <<= 1) s1 += __shfl_xor(s1, o);
              const float mean1 = s1 * (1.f / D); float q1 = 0.f;
#pragma unroll
              for (int i = 0; i < 16; ++i) { xf[i] -= mean1; q1 += xf[i] * xf[i]; }
#pragma unroll
              for (int o = 1; o < 64; o <<= 1) q1 += __shfl_xor(q1, o);
              const float rstd1 = rsqrtf(q1 * (1.f / D) + LN_EPS);
#pragma unroll
              for (int q = 0; q < 4; ++q) { const f32x4 gg = *(const f32x4*)(g1 + lane * 16 + q * 4), bb = *(const f32x4*)(b1 + lane * 16 + q * 4);
#pragma unroll
                  for (int i = 0; i < 4; ++i) xf[q * 4 + i] = xf[q * 4 + i] * rstd1 * gg[i] + bb[i]; } }
            float wv0 = 0.f, wv1 = 0.f;
#pragma unroll 1
            for (int bt = 0; bt < 2; ++bt) {
                const int eidv = (int)teid[tok * 128 + bt * 64 + lane];
                float p[64];

                u32x4 qb[2][PGS];
#pragma unroll
                for (int i = 0; i < PGS; ++i) { const int id = __builtin_amdgcn_readlane(eidv, i); qb[0][i] = PROW_LOAD(U, id); }
#pragma unroll
                for (int g = 0; g < 64 / PGS; ++g) {
                    if (g < 64 / PGS - 1) {
#pragma unroll
                        for (int i = 0; i < PGS; ++i) { const int id = __builtin_amdgcn_readlane(eidv, (g + 1) * PGS + i); qb[(g + 1) & 1][i] = PROW_LOAD(U, id); }
                    }
                    asm volatile("" ::: "memory");
#if PEER_BITS == 4
#pragma unroll
                    for (int i = 0; i < PGS; ++i) {
                        float a = 0.f;
#pragma unroll
                        for (int w = 0; w < 2; ++w) {
#define PU4(b) { const f32x2v f = __builtin_amdgcn_cvt_scalef32_pk_f32_fp4(qb[g & 1][i][w], 1.0f, b); a = fmaf(f[0], xf[w * 8 + b * 2], a); a = fmaf(f[1], xf[w * 8 + b * 2 + 1], a); }
                            PU4(0) PU4(1) PU4(2) PU4(3)
#undef PU4
                        }
                        p[g * PGS + i] = a;
                        __builtin_amdgcn_sched_barrier(0);
                    }
#elif PEER_BITS == 6
#pragma unroll
                    for (int i = 0; i < PGS; i += 2) {
                        const v6u_t pk = {qb[g & 1][i][0], qb[g & 1][i][1], qb[g & 1][i][2], qb[g & 1][i + 1][0], qb[g & 1][i + 1][1], qb[g & 1][i + 1][2]};
                        const v32f_t f = __builtin_amdgcn_cvt_scalef32_pk32_f32_fp6(pk, 1.0f);
                        float a0 = 0.f, a1 = 0.f;
#pragma unroll
                        for (int k = 0; k < 16; ++k) { a0 = fmaf(f[k], xf[k], a0); a1 = fmaf(f[16 + k], xf[k], a1); }
                        p[g * PGS + i] = a0; p[g * PGS + i + 1] = a1;
                        __builtin_amdgcn_sched_barrier(0);
                    }
#else
#pragma unroll
                    for (int i = 0; i < PGS; ++i) {
                        float a = 0.f;
#pragma unroll
                        for (int w = 0; w < 4; ++w) { const f32x2v lo = __builtin_amdgcn_cvt_pk_f32_fp8((int)qb[g & 1][i][w], false), hi = __builtin_amdgcn_cvt_pk_f32_fp8((int)qb[g & 1][i][w], true);
                            a = fmaf(lo[0], xf[w * 4], a); a = fmaf(lo[1], xf[w * 4 + 1], a); a = fmaf(hi[0], xf[w * 4 + 2], a); a = fmaf(hi[1], xf[w * 4 + 3], a); }
                        p[g * PGS + i] = a;
                        __builtin_amdgcn_sched_barrier(0);
                    }
#endif
                }

#pragma unroll
                for (int o = 32; o >= 1; o >>= 1) {
                    const bool up = (lane & o) != 0;
#pragma unroll
                    for (int i = 0; i < o; ++i) { const float keep = up ? p[i + o] : p[i], send = up ? p[i] : p[i + o]; p[i] = keep + __shfl_xor(send, o); }
                }
                const float hdot = p[0] * Us[eidv];
                const float wv = 0.5f * hdot * (1.f + erff(hdot * 0.70710678118654752f)) * tgate[tok * 128 + bt * 64 + lane] * Vs[eidv];
                if (bt == 0) wv0 = wv; else wv1 = wv;

            }

            float y[16];
#pragma unroll
            for (int i = 0; i < 16; ++i) y[i] = 0.f;
#pragma unroll 1
            for (int bt = 0; bt < 2; ++bt) {
                const int eidv = (int)teid[tok * 128 + bt * 64 + lane]; const float wvv = bt == 0 ? wv0 : wv1;
                u32x4 qb[2][PGS];
#pragma unroll
                for (int i = 0; i < PGS; ++i) { const int id = __builtin_amdgcn_readlane(eidv, i); qb[0][i] = PROW_LOAD(V, id); }
#pragma unroll
                for (int g = 0; g < 64 / PGS; ++g) {
                    if (g < 64 / PGS - 1) {
#pragma unroll
                        for (int i = 0; i < PGS; ++i) { const int id = __builtin_amdgcn_readlane(eidv, (g + 1) * PGS + i); qb[(g + 1) & 1][i] = PROW_LOAD(V, id); }
                    }
                    asm volatile("" ::: "memory");
#if PEER_BITS == 4
#pragma unroll
                    for (int i = 0; i < PGS; ++i) {
                        const float w = __builtin_bit_cast(float, __builtin_amdgcn_readlane(__builtin_bit_cast(int, wvv), g * PGS + i));
                        asm volatile("" : "+v"(qb[g & 1][i][0]), "+v"(qb[g & 1][i][1]));
#pragma unroll
                        for (int k = 0; k < 2; ++k) {
#define PV4(b) { const f32x2v f = __builtin_amdgcn_cvt_scalef32_pk_f32_fp4(qb[g & 1][i][k], 1.0f, b); y[k * 8 + b * 2] = fmaf(w, f[0], y[k * 8 + b * 2]); y[k * 8 + b * 2 + 1] = fmaf(w, f[1], y[k * 8 + b * 2 + 1]); }
                            PV4(0) PV4(1) PV4(2) PV4(3)
#undef PV4
                        }
                        asm volatile("" : "+v"(y[0]), "+v"(y[1]), "+v"(y[2]), "+v"(y[3]), "+v"(y[4]), "+v"(y[5]), "+v"(y[6]), "+v"(y[7]), "+v"(y[8]), "+v"(y[9]), "+v"(y[10]), "+v"(y[11]), "+v"(y[12]), "+v"(y[13]), "+v"(y[14]), "+v"(y[15]));
                    }
#elif PEER_BITS == 6
#pragma unroll
                    for (int i = 0; i < PGS; i += 2) {
                        const float w0 = __builtin_bit_cast(float, __builtin_amdgcn_readlane(__builtin_bit_cast(int, wvv), g * PGS + i)), w1 = __builtin_bit_cast(float, __builtin_amdgcn_readlane(__builtin_bit_cast(int, wvv), g * PGS + i + 1));
                        asm volatile("" : "+v"(qb[g & 1][i][0]), "+v"(qb[g & 1][i][1]), "+v"(qb[g & 1][i][2]), "+v"(qb[g & 1][i + 1][0]), "+v"(qb[g & 1][i + 1][1]), "+v"(qb[g & 1][i + 1][2]));
                        const v6u_t pk = {qb[g & 1][i][0], qb[g & 1][i][1], qb[g & 1][i][2], qb[g & 1][i + 1][0], qb[g & 1][i + 1][1], qb[g & 1][i + 1][2]};
                        const v32f_t f = __builtin_amdgcn_cvt_scalef32_pk32_f32_fp6(pk, 1.0f);
#pragma unroll
                        for (int k = 0; k < 16; ++k) { y[k] = fmaf(w0, f[k], y[k]); y[k] = fmaf(w1, f[16 + k], y[k]); }
                        asm volatile("" : "+v"(y[0]), "+v"(y[1]), "+v"(y[2]), "+v"(y[3]), "+v"(y[4]), "+v"(y[5]), "+v"(y[6]), "+v"(y[7]), "+v"(y[8]), "+v"(y[9]), "+v"(y[10]), "+v"(y[11]), "+v"(y[12]), "+v"(y[13]), "+v"(y[14]), "+v"(y[15]));
                    }
#else
#pragma unroll
                    for (int i = 0; i < PGS; ++i) {
                        const float w = __builtin_bit_cast(float, __builtin_amdgcn_readlane(__builtin_bit_cast(int, wvv), g * PGS + i));
                        asm volatile("" : "+v"(qb[g & 1][i][0]), "+v"(qb[g & 1][i][1]), "+v"(qb[g & 1][i][2]), "+v"(qb[g & 1][i][3]));
#pragma unroll
                        for (int k = 0; k < 4; ++k) { const f32x2v lo = __builtin_amdgcn_cvt_pk_f32_fp8((int)qb[g & 1][i][k], false), hi = __builtin_amdgcn_cvt_pk_f32_fp8((int)qb[g & 1][i][k], true);
                            y[k * 4] = fmaf(w, lo[0], y[k * 4]); y[k * 4 + 1] = fmaf(w, lo[1], y[k * 4 + 1]); y[k * 4 + 2] = fmaf(w, hi[0], y[k * 4 + 2]); y[k * 4 + 3] = fmaf(w, hi[1], y[k * 4 + 3]); }
                        asm volatile("" : "+v"(y[0]), "+v"(y[1]), "+v"(y[2]), "+v"(y[3]), "+v"(y[4]), "+v"(y[5]), "+v"(y[6]), "+v"(y[7]), "+v"(y[8]), "+v"(y[9]), "+v"(y[10]), "+v"(y[11]), "+v"(y[12]), "+v"(y[13]), "+v"(y[14]), "+v"(y[15]));
                    }
#endif
                }
            }

            float s = 0.f;
#pragma unroll
            for (int i = 0; i < 16; ++i) { y[i] = ALPHA * xf[i] + y[i]; s += y[i]; }
#pragma unroll
            for (int o = 1; o < 64; o <<= 1) s += __shfl_xor(s, o);
            const float mean = s * (1.f / D); float qq = 0.f;
#pragma unroll
            for (int i = 0; i < 16; ++i) { y[i] -= mean; qq += y[i] * y[i]; }
#pragma unroll
            for (int o = 1; o < 64; o <<= 1) qq += __shfl_xor(qq, o);
            const float rstd = rsqrtf(qq * (1.f / D) + LN_EPS);
            u32x4 ob0, ob1;
#pragma unroll
            for (int q = 0; q < 4; ++q) { const int col = lane * 16 + q * 4; const f32x4 gg = *(const f32x4*)(g2 + col), bb = *(const f32x4*)(b2 + col);
                f32x4 o;
#pragma unroll
                for (int i = 0; i < 4; ++i) o[i] = y[q * 4 + i] * rstd * gg[i] + bb[i];
                *(f32x4*)(outf + tok * D + col) = o;
                const unsigned w0 = pk2(o[0], o[1]), w1 = pk2(o[2], o[3]);
                if (q == 0) { ob0.x = w0; ob0.y = w1; } else if (q == 1) { ob0.z = w0; ob0.w = w1; } else if (q == 2) { ob1.x = w0; ob1.y = w1; } else { ob1.z = w0; ob1.w = w1; } }
            if (outb) { *(u32x4*)(outb + tok * D + lane * 16) = ob0; *(u32x4*)(outb + tok * D + lane * 16 + 8) = ob1; }

        }
    }

}

__device__ __forceinline__ float peer_reduce16(float (&p)[16], int lane) {
#pragma unroll
    for (int o = 8; o >= 1; o >>= 1) { const bool up = (lane & (o * 4)) != 0;
#pragma unroll
        for (int k = 0; k < o; ++k) { const float keep = up ? p[k + o] : p[k], send = up ? p[k] : p[k + o]; p[k] = keep + __shfl_xor(send, o * 4); } }
    float tot = p[0];
    tot += __shfl_xor(tot, 2); tot += __shfl_xor(tot, 1);
    return tot;
}
__device__ __forceinline__ unsigned cvtpk_bf16_(float lo, float hi) { typedef __bf16 bf2 __attribute__((ext_vector_type(2))); f32x2v v = {lo, hi}; bf2 b = __builtin_convertvector(v, bf2); return __builtin_bit_cast(unsigned, b); }
__device__ __forceinline__ float peer_dot16b(const u32x4 q, const u32x4 x0, const u32x4 x1) {
    float a = 0.f;
#pragma unroll
    for (int w = 0; w < 4; ++w) { const f32x2v lo = __builtin_amdgcn_cvt_pk_f32_fp8((int)q[w], false), hi = __builtin_amdgcn_cvt_pk_f32_fp8((int)q[w], true);
        const unsigned xa = w < 2 ? x0[2 * w] : x1[2 * w - 4], xb = w < 2 ? x0[2 * w + 1] : x1[2 * w - 3];
        a = dot2bf(cvtpk_bf16_(lo[0], lo[1]), xa, a); a = dot2bf(cvtpk_bf16_(hi[0], hi[1]), xb, a); }
    return a;
}

__device__ __forceinline__ void peer_u_slice(int sl, int t_first, int t_step, const bf16* __restrict__ Hb, const unsigned short* __restrict__ teid, const unsigned char* __restrict__ U,
                                             float* __restrict__ HD, LAS unsigned char* wl, int lane) {
    LAS unsigned short* lst_e = (LAS unsigned short*)wl;
    LAS unsigned char* lst_s = wl + 512;
    const unsigned long long below = (1ull << lane) - 1ull;
    const int kk = (lane >> 2) & 15;
    if (t_first >= TA) return;
#define PU_BUILD(bsel, e0_, e1_, cnt_) do { const bool a0_ = ((e0_) >> 11) == sl, a1_ = ((e1_) >> 11) == sl; const unsigned long long m0_ = __ballot(a0_), m1_ = __ballot(a1_); \
        const int c0_ = __builtin_popcountll(m0_); cnt_ = c0_ + __builtin_popcountll(m1_); \
        if (a0_) { const int p_ = __builtin_popcountll(m0_ & below); lst_e[(bsel) * 128 + p_] = (unsigned short)(e0_); lst_s[(bsel) * 128 + p_] = (unsigned char)lane; } \
        if (a1_) { const int p_ = c0_ + __builtin_popcountll(m1_ & below); lst_e[(bsel) * 128 + p_] = (unsigned short)(e1_); lst_s[(bsel) * 128 + p_] = (unsigned char)(64 + lane); } } while (0)
#define PU_LOAD(bsel, cnt_, q_) do { _Pragma("unroll") for (int k = 0; k < 16; ++k) { if (k < (cnt_)) { const int id_ = __builtin_amdgcn_readfirstlane((int)lst_e[(bsel) * 128 + k]); q_[k] = *(const u32x4*)(U + (size_t)id_ * D + lane * 16); } } } while (0)
    int e0 = __builtin_nontemporal_load(teid + (size_t)t_first * 128 + lane), e1 = __builtin_nontemporal_load(teid + (size_t)t_first * 128 + 64 + lane);
    u32x4 xa0 = __builtin_nontemporal_load((const u32x4*)(Hb + (size_t)t_first * D + lane * 16)), xa1 = __builtin_nontemporal_load((const u32x4*)(Hb + (size_t)t_first * D + lane * 16 + 8));
    int cnt; PU_BUILD(0, e0, e1, cnt);
    asm volatile("s_waitcnt lgkmcnt(0)" ::: "memory");
    u32x4 q[16];
    PU_LOAD(0, cnt, q);
    int buf = 0;

    for (int t = t_first; t < TA; t += t_step, buf ^= 1) {
        const int tn = t + t_step; const bool hasn = tn < TA;
        u32x4 xb0 = xa0, xb1 = xa1; int f0 = 0, f1 = 0;
        if (hasn) { f0 = __builtin_nontemporal_load(teid + (size_t)tn * 128 + lane); f1 = __builtin_nontemporal_load(teid + (size_t)tn * 128 + 64 + lane);
            xb0 = __builtin_nontemporal_load((const u32x4*)(Hb + (size_t)tn * D + lane * 16)); xb1 = __builtin_nontemporal_load((const u32x4*)(Hb + (size_t)tn * D + lane * 16 + 8)); }

        float pr[16];
#pragma unroll
        for (int k = 0; k < 16; ++k) pr[k] = k < cnt ? peer_dot16b(q[k], xa0, xa1) : 0.f;

#pragma unroll 1
        for (int p0 = 16; p0 < cnt; p0 += 16) {
            u32x4 q2[16];
#pragma unroll
            for (int k = 0; k < 16; ++k) { if (p0 + k < cnt) { const int id_ = __builtin_amdgcn_readfirstlane((int)lst_e[buf * 128 + p0 + k]); q2[k] = *(const u32x4*)(U + (size_t)id_ * D + lane * 16); } }
            float pr2[16];
#pragma unroll
            for (int k = 0; k < 16; ++k) pr2[k] = p0 + k < cnt ? peer_dot16b(q2[k], xa0, xa1) : 0.f;
            const float tot2 = peer_reduce16(pr2, lane);
            if (p0 + kk < cnt && (lane & 3) == 0) __builtin_nontemporal_store(tot2, HD + (size_t)t * 128 + lst_s[buf * 128 + p0 + kk]);
        }

        int cntn = 0;
        if (hasn) { PU_BUILD(buf ^ 1, f0, f1, cntn); }
        asm volatile("s_waitcnt lgkmcnt(0)" ::: "memory");
        if (hasn) PU_LOAD(buf ^ 1, cntn, q);

        const float tot = peer_reduce16(pr, lane);
        if (kk < cnt && (lane & 3) == 0) __builtin_nontemporal_store(tot, HD + (size_t)t * 128 + lst_s[buf * 128 + kk]);
        xa0 = xb0; xa1 = xb1; cnt = cntn;

    }

#undef PU_BUILD
#undef PU_LOAD
}

__device__ __forceinline__ void phase_peer_mixv(const float* __restrict__ Zin, const float* __restrict__ g1, const float* __restrict__ b1, const unsigned short* __restrict__ teid, const float* __restrict__ tgate, const float* __restrict__ HD,
                                                const unsigned char* __restrict__ V, const float* __restrict__ Us, const float* __restrict__ Vs, const float* __restrict__ g2, const float* __restrict__ b2,
                                                float* __restrict__ outf, bf16* __restrict__ outb, int gw, int NGW, int lane) {
    for (int j = gw; j < TP + TS * 16; j += NGW) {
        size_t tok;
        if (j < TP) tok = (size_t)j;
        else { const int s = j - TP; if ((s & 15) != 0) continue; tok = (size_t)TP + (s >> 4); }
        float xf[16];
        { float s1 = 0.f;
#pragma unroll
          for (int q = 0; q < 4; ++q) { const f32x4 r = *(const f32x4*)(Zin + tok * D + lane * 16 + q * 4); xf[q * 4] = r[0]; xf[q * 4 + 1] = r[1]; xf[q * 4 + 2] = r[2]; xf[q * 4 + 3] = r[3]; s1 += (r[0] + r[1]) + (r[2] + r[3]); }
#pragma unroll
          for (int o = 1; o < 64; o <<= 1) s1 += __shfl_xor(s1, o);
          const float mean1 = s1 * (1.f / D); float q1 = 0.f;
#pragma unroll
          for (int i = 0; i < 16; ++i) { xf[i] -= mean1; q1 += xf[i] * xf[i]; }
#pragma unroll
          for (int o = 1; o < 64; o <<= 1) q1 += __shfl_xor(q1, o);
          const float rstd1 = rsqrtf(q1 * (1.f / D) + LN_EPS);
#pragma unroll
          for (int q = 0; q < 4; ++q) { const f32x4 gg = *(const f32x4*)(g1 + lane * 16 + q * 4), bb = *(const f32x4*)(b1 + lane * 16 + q * 4);
#pragma unroll
              for (int i = 0; i < 4; ++i) xf[q * 4 + i] = xf[q * 4 + i] * rstd1 * gg[i] + bb[i]; } }
        float y[16];
#pragma unroll
        for (int i = 0; i < 16; ++i) y[i] = 0.f;
#pragma unroll 1
        for (int bt = 0; bt < 2; ++bt) {
            const int eidv = (int)teid[tok * 128 + bt * 64 + lane];
            const float hd = HD[tok * 128 + bt * 64 + lane] * Us[eidv];
            const float wvv = 0.5f * hd * (1.f + erff(hd * 0.70710678118654752f)) * tgate[tok * 128 + bt * 64 + lane] * Vs[eidv];
            u32x4 qb[2][PGS];
#pragma unroll
            for (int i = 0; i < PGS; ++i) { const int id = __builtin_amdgcn_readlane(eidv, i); qb[0][i] = PROW_LOAD(V, id); }
#pragma unroll
            for (int g = 0; g < 64 / PGS; ++g) {
                if (g < 64 / PGS - 1) {
#pragma unroll
                    for (int i = 0; i < PGS; ++i) { const int id = __builtin_amdgcn_readlane(eidv, (g + 1) * PGS + i); qb[(g + 1) & 1][i] = PROW_LOAD(V, id); }
                }
                asm volatile("" ::: "memory");
#pragma unroll
                for (int i = 0; i < PGS; ++i) {
                    const float w = __builtin_bit_cast(float, __builtin_amdgcn_readlane(__builtin_bit_cast(int, wvv), g * PGS + i));
                    asm volatile("" : "+v"(qb[g & 1][i][0]), "+v"(qb[g & 1][i][1]), "+v"(qb[g & 1][i][2]), "+v"(qb[g & 1][i][3]));
#pragma unroll
                    for (int k = 0; k < 4; ++k) { const f32x2v lo = __builtin_amdgcn_cvt_pk_f32_fp8((int)qb[g & 1][i][k], false), hi = __builtin_amdgcn_cvt_pk_f32_fp8((int)qb[g & 1][i][k], true);
                        y[k * 4] = fmaf(w, lo[0], y[k * 4]); y[k * 4 + 1] = fmaf(w, lo[1], y[k * 4 + 1]); y[k * 4 + 2] = fmaf(w, hi[0], y[k * 4 + 2]); y[k * 4 + 3] = fmaf(w, hi[1], y[k * 4 + 3]); }
                    asm volatile("" : "+v"(y[0]), "+v"(y[1]), "+v"(y[2]), "+v"(y[3]), "+v"(y[4]), "+v"(y[5]), "+v"(y[6]), "+v"(y[7]), "+v"(y[8]), "+v"(y[9]), "+v"(y[10]), "+v"(y[11]), "+v"(y[12]), "+v"(y[13]), "+v"(y[14]), "+v"(y[15]));
                }
            }
        }
        float s = 0.f;
#pragma unroll
        for (int i = 0; i < 16; ++i) { y[i] = ALPHA * xf[i] + y[i]; s += y[i]; }
#pragma unroll
        for (int o = 1; o < 64; o <<= 1) s += __shfl_xor(s, o);
        const float mean = s * (1.f / D); float qq = 0.f;
#pragma unroll
        for (int i = 0; i < 16; ++i) { y[i] -= mean; qq += y[i] * y[i]; }
#pragma unroll
        for (int o = 1; o < 64; o <<= 1) qq += __shfl_xor(qq, o);
        const float rstd = rsqrtf(qq * (1.f / D) + LN_EPS);
        u32x4 ob0, ob1;
#pragma unroll
        for (int q = 0; q < 4; ++q) { const int col = lane * 16 + q * 4; const f32x4 gg = *(const f32x4*)(g2 + col), bb = *(const f32x4*)(b2 + col);
            f32x4 o;
#pragma unroll
            for (int i = 0; i < 4; ++i) o[i] = y[q * 4 + i] * rstd * gg[i] + bb[i];
            *(f32x4*)(outf + tok * D + col) = o;
            const unsigned w0 = pk2(o[0], o[1]), w1 = pk2(o[2], o[3]);
            if (q == 0) { ob0.x = w0; ob0.y = w1; } else if (q == 1) { ob0.z = w0; ob0.w = w1; } else if (q == 2) { ob1.x = w0; ob1.y = w1; } else { ob1.z = w0; ob1.w = w1; } }
        if (outb) { *(u32x4*)(outb + tok * D + lane * 16) = ob0; *(u32x4*)(outb + tok * D + lane * 16 + 8) = ob1; }
    }
}
}

namespace mk {
struct FGlaIn {
    bf16 *Gq, *Gk, *Gv, *Gr; float* GD;
    __device__ __forceinline__ static float silu(float r) { return r / (1.f + __expf(-r)); }
    __device__ __forceinline__ void put8(int row, int col, f32x4 v0, f32x4 v1) const {
        if (col < GN_K) *(u32x4*)(Gq + (size_t)row * 512 + col) = pack8(v0, v1);
        else if (col < GN_V) *(u32x4*)(Gk + (size_t)row * 512 + (col - GN_K)) = pack8(v0, v1);
        else if (col < GN_R) *(u32x4*)(Gv + (size_t)row * 1024 + (col - GN_V)) = pack8(v0, v1);
        else { f32x4 a, b;
#pragma unroll
            for (int i = 0; i < 4; ++i) { a[i] = silu(v0[i]); b[i] = silu(v1[i]); }
            *(u32x4*)(Gr + (size_t)row * 1024 + (col - GN_R)) = pack8(a, b); }
    }
    __device__ __forceinline__ void put4(int row, int col, f32x4 v) const {
        u32x2 w; w.x = pk2(v[0], v[1]); w.y = pk2(v[2], v[3]);
        if (col < GN_K) *(u32x2*)(Gq + (size_t)row * 512 + col) = w;
        else if (col < GN_V) *(u32x2*)(Gk + (size_t)row * 512 + (col - GN_K)) = w;
        else if (col < GN_R) *(u32x2*)(Gv + (size_t)row * 1024 + (col - GN_V)) = w;
        else if (col < GN_GD) { u32x2 s; s.x = pk2(silu(v[0]), silu(v[1])); s.y = pk2(silu(v[2]), silu(v[3])); *(u32x2*)(Gr + (size_t)row * 1024 + (col - GN_R)) = s; }
        else if (col < GN_GD + 16) *(f32x4*)(GD + (size_t)row * 16 + (col - GN_GD)) = v;
    }
};

__device__ __forceinline__ float log_sigmoid_f(float x) { return fminf(x, 0.f) - log1pf(__expf(-fabsf(x))); }
__device__ __forceinline__ bf16x8 tr8(LAS unsigned char* a0, LAS unsigned char* a1) { const s16x4 v0 = lds_tr(a0), v1 = lds_tr(a1); bf16x8 r; r[0] = v0[0]; r[1] = v0[1]; r[2] = v0[2]; r[3] = v0[3]; r[4] = v1[0]; r[5] = v1[1]; r[6] = v1[2]; r[7] = v1[3]; return r; }

constexpr int KD_ST = 272, V_ST = 528;
constexpr int GL_LB = 0, GL_TOT = 32768, GL_KD = 36864, GL_V = GL_KD + 64 * KD_ST  , GL_END = GL_V + 64 * V_ST;
static_assert(GL_END <= RING_BYTES, "GLA chunk LDS");

__device__ __forceinline__ void gla_chunk_item(int item, const bf16* __restrict__ Gq, const bf16* __restrict__ Gk, const bf16* __restrict__ Gv, const float* __restrict__ GD,
                                               const float* __restrict__ Wgu, const float* __restrict__ bg, bf16* __restrict__ QT, bf16* __restrict__ KT, float* __restrict__ DEC, float* __restrict__ DS,
                                               LAS unsigned char* lds, int tid, int wave, int lane) {
    const int h = item & 3, bc = item >> 2;
    const size_t tok0 = (size_t)bc * 64;
    LAS float* LB = (LAS float*)(lds + GL_LB);
    LAS float* TOT = (LAS float*)(lds + GL_TOT);
    const int d = tid & 127, tq = tid >> 7;
    float wg[16];
#pragma unroll
    for (int r = 0; r < 16; ++r) wg[r] = Wgu[r * 512 + h * 128 + d];
    const float bgd = bg[h * 128 + d];
    float pre[16]; float run = 0.f;
#pragma unroll
    for (int i = 0; i < 16; ++i) {
        const float* gd = GD + (tok0 + tq * 16 + i) * 16;
        const f32x4 g0 = *(const f32x4*)gd, g1 = *(const f32x4*)(gd + 4), g2 = *(const f32x4*)(gd + 8), g3 = *(const f32x4*)(gd + 12);
        float x = 0.f;
#pragma unroll
        for (int r = 0; r < 4; ++r) { x = fmaf(g0[r], wg[r], x); }
#pragma unroll
        for (int r = 0; r < 4; ++r) { x = fmaf(g1[r], wg[4 + r], x); }
#pragma unroll
        for (int r = 0; r < 4; ++r) { x = fmaf(g2[r], wg[8 + r], x); }
#pragma unroll
        for (int r = 0; r < 4; ++r) { x = fmaf(g3[r], wg[12 + r], x); }
        run += log_sigmoid_f(x + bgd) * (1.f / 16.f); pre[i] = run;
    }
    TOT[tq * 128 + d] = run;
    __syncthreads();
    float off = 0.f;
#pragma unroll
    for (int q = 0; q < 3; ++q) if (q < tq) off += TOT[q * 128 + d];
    const float bC = (TOT[d] + TOT[128 + d]) + (TOT[256 + d] + TOT[384 + d]);
#pragma unroll
    for (int i = 0; i < 16; ++i) {
        const int t = tq * 16 + i; const float b = pre[i] + off; const size_t tok = tok0 + t;
        const float q = bf2f(Gq[tok * 512 + h * 128 + d]), k = bf2f(Gk[tok * 512 + h * 128 + d]);
        QT[tok * 512 + h * 128 + d] = (bf16)f2bf(q * 0.08838834764831845f * __expf(b));
        KT[tok * 512 + h * 128 + d] = (bf16)f2bf(k * __expf(-b));
        *(LAS bf16*)(lds + GL_KD + t * KD_ST + d * 2) = (bf16)f2bf(k * __expf(bC - b));
    }
    if (tq == 0) DEC[(size_t)item * 128 + d] = __expf(bC);
#pragma unroll
    for (int p = 0; p < 4; ++p) { const int e = tid + p * 512, s = e >> 5, ch = e & 31;
        *(LAS u32x4*)(lds + GL_V + s * V_ST + ch * 16) = *(const u32x4*)(Gv + (tok0 + s) * 1024 + h * 256 + ch * 8); }
    __syncthreads();
    const int fr = lane & 15, fq = lane >> 4, dt = wave;
    bf16x8 af[2];
#pragma unroll
    for (int ks = 0; ks < 2; ++ks) { LAS unsigned char* a0 = lds + GL_KD + (ks * 32 + fq * 8 + (fr >> 2)) * KD_ST + (dt * 16 + 4 * (fr & 3)) * 2; af[ks] = tr8(a0, a0 + 4 * KD_ST); }
    float* dsb = DS + (size_t)item * 256 * 128;
#pragma unroll 4
    for (int vt = 0; vt < 16; ++vt) {
        f32x4 acc = (f32x4){0.f, 0.f, 0.f, 0.f};
#pragma unroll
        for (int ks = 0; ks < 2; ++ks) { LAS unsigned char* b0 = lds + GL_V + (ks * 32 + fq * 8 + (fr >> 2)) * V_ST + (vt * 16 + 4 * (fr & 3)) * 2; const bf16x8 bf = tr8(b0, b0 + 4 * V_ST);
            acc = __builtin_amdgcn_mfma_f32_16x16x32_bf16(af[ks], bf, acc, 0, 0, 0); }
        *(f32x4*)(dsb + (size_t)(vt * 16 + fr) * 128 + dt * 16 + fq * 4) = acc;
    }
    __syncthreads();
}

__device__ __forceinline__ void gla_sample_item(int item, const bf16* __restrict__ Gq, const bf16* __restrict__ Gk, const bf16* __restrict__ Gv, const bf16* __restrict__ Gr, const float* __restrict__ GD,
                                                const float* __restrict__ Wgu, const float* __restrict__ bg, const float* __restrict__ ng, const float* __restrict__ S0, float* __restrict__ Sout, bf16* __restrict__ OGb,
                                                LAS unsigned char* lds, int tid, int lane) {
    const int b = item >> 2, h = item & 3;
    LAS float* A = (LAS float*)lds;
    LAS float* Qs = A + 512; LAS float* Ks = Qs + 512;
    LAS float* PO = Ks + 512;
    LAS float* RS = PO + 4096;
    { const int t = tid >> 7, d = tid & 127; const size_t tok = (size_t)TP + b * DS + t;
      float x = bg[h * 128 + d]; const float* gd = GD + tok * 16; float xs = 0.f;
#pragma unroll
      for (int r = 0; r < 16; ++r) xs = fmaf(gd[r], Wgu[r * 512 + h * 128 + d], xs);
      x += xs;
      A[t * 128 + d] = __expf(log_sigmoid_f(x) * (1.f / 16.f));
      Qs[t * 128 + d] = bf2f(Gq[tok * 512 + h * 128 + d]) * 0.08838834764831845f; Ks[t * 128 + d] = bf2f(Gk[tok * 512 + h * 128 + d]); }
    __syncthreads();
    const int dq = tid >> 7, d0 = dq * 32;
#pragma unroll 1
    for (int vhalf = 0; vhalf < 2; ++vhalf) {
        const int v = vhalf * 128 + (tid & 127);
        float S[32];
#pragma unroll
        for (int i = 0; i < 32; ++i) S[i] = S0[(((size_t)b * 4 + h) * 128 + d0 + i) * 256 + v];
#pragma unroll 1
        for (int t = 0; t < 4; ++t) {
            const float vv = bf2f(Gv[((size_t)TP + b * DS + t) * 1024 + h * 256 + v]); float o = 0.f;
#pragma unroll
            for (int i = 0; i < 32; ++i) { S[i] = fmaf(A[t * 128 + d0 + i], S[i], Ks[t * 128 + d0 + i] * vv); o = fmaf(Qs[t * 128 + d0 + i], S[i], o); }
            PO[(dq * 4 + t) * 256 + v] = o;
        }
#pragma unroll
        for (int i = 0; i < 32; ++i) Sout[(((size_t)b * 4 + h) * 128 + d0 + i) * 256 + v] = S[i];
    }
    __syncthreads();
    { const int t = tid >> 7, vl = tid & 127; const float o0 = (PO[t * 256 + vl] + PO[(4 + t) * 256 + vl]) + (PO[(8 + t) * 256 + vl] + PO[(12 + t) * 256 + vl]), o1 = (PO[t * 256 + 128 + vl] + PO[(4 + t) * 256 + 128 + vl]) + (PO[(8 + t) * 256 + 128 + vl] + PO[(12 + t) * 256 + 128 + vl]);
      float ss = o0 * o0 + o1 * o1;
#pragma unroll
      for (int o = 1; o < 64; o <<= 1) ss += __shfl_xor(ss, o);
      if (lane == 0) RS[tid >> 6] = ss;
      __syncthreads();
      const float ms = (RS[2 * t] + RS[2 * t + 1]) * (1.f / 256.f), rstd = rsqrtf(ms + LN_EPS);
      const size_t tok = (size_t)TP + b * DS + t;
      OGb[tok * 1024 + h * 256 + vl] = (bf16)f2bf(o0 * rstd * ng[vl] * bf2f(Gr[tok * 1024 + h * 256 + vl]));
      OGb[tok * 1024 + h * 256 + 128 + vl] = (bf16)f2bf(o1 * rstd * ng[128 + vl] * bf2f(Gr[tok * 1024 + h * 256 + 128 + vl])); }
    __syncthreads();
}

__device__ __forceinline__ void gla_scan(const float* __restrict__ DS, const float* __restrict__ DEC, bf16* __restrict__ SP, float* __restrict__ Sout, int gtid, int gthreads) {
    typedef float f32x2 __attribute__((ext_vector_type(2)));
    for (int e = gtid; e < NBATCH * 4 * 256 * 64; e += gthreads) {
        const int d2 = e & 63, v = (e >> 6) & 255, h = (e >> 14) & 3, b = e >> 16;
        f32x2 S = (f32x2){0.f, 0.f};
#pragma unroll 8
        for (int c = 0; c < SEQ / 64; ++c) {
            const size_t item = ((size_t)b * (SEQ / 64) + c) * 4 + h;
            const f32x2 ds = *(const f32x2*)(DS + (item * 256 + v) * 128 + d2 * 2), dc = *(const f32x2*)(DEC + item * 128 + d2 * 2);
            *(unsigned*)(SP + (item * 256 + v) * 128 + d2 * 2) = pk2(S[0], S[1]);
            S = dc * S + ds;
        }
        float* so = Sout + (((size_t)b * 4 + h) * 128 + d2 * 2) * 256 + v; so[0] = S[0]; so[256] = S[1];
    }
}

__device__ __forceinline__ void gla_out_item(int item, const bf16* __restrict__ QT, const bf16* __restrict__ KT, const bf16* __restrict__ Gv, const bf16* __restrict__ Gr, const bf16* __restrict__ SP,
                                             const float* __restrict__ ng, bf16* __restrict__ OGb, LAS unsigned char* lds, int tid, int wave, int lane) {
    const int h = item & 3, bc = item >> 2; const size_t tok0 = (size_t)bc * 64;
    const int fr = lane & 15, fq = lane >> 4, tt = wave & 3, vh = wave >> 2;
    LAS float* RS = (LAS float*)(lds + 64 * V_ST);
#pragma unroll
    for (int p = 0; p < 4; ++p) { const int e = tid + p * 512, s = e >> 5, ch = e & 31;
        *(LAS u32x4*)(lds + s * V_ST + ch * 16) = *(const u32x4*)(Gv + (tok0 + s) * 1024 + h * 256 + ch * 8); }
    bf16x8 qf[4];
#pragma unroll
    for (int ks = 0; ks < 4; ++ks) qf[ks] = *(const bf16x8*)(QT + (tok0 + tt * 16 + fr) * 512 + h * 128 + ks * 32 + fq * 8);
    bf16x8 pf[2];
    {
        f32x4 at[4];
#pragma unroll
        for (int st = 0; st < 4; ++st) {
            f32x4 acc = (f32x4){0.f, 0.f, 0.f, 0.f};
#pragma unroll
            for (int ks = 0; ks < 4; ++ks) { const bf16x8 kf = *(const bf16x8*)(KT + (tok0 + st * 16 + fr) * 512 + h * 128 + ks * 32 + fq * 8); acc = __builtin_amdgcn_mfma_f32_16x16x32_bf16(kf, qf[ks], acc, 0, 0, 0); }
#pragma unroll
            for (int j = 0; j < 4; ++j) { const int s = st * 16 + fq * 4 + j, t = tt * 16 + fr; if (s > t) acc[j] = 0.f; }
            at[st] = acc;
        }
        const u32x4 w0 = pack8(at[0], at[1]), w1 = pack8(at[2], at[3]);
        pf[0] = __builtin_bit_cast(bf16x8, w0); pf[1] = __builtin_bit_cast(bf16x8, w1);
    }
    __syncthreads();
    const bf16* spb = SP + (size_t)item * 256 * 128;
    f32x4 oacc[8]; float ss = 0.f;
#pragma unroll
    for (int i = 0; i < 8; ++i) {
        const int vt = vh * 8 + i;
        f32x4 acc = (f32x4){0.f, 0.f, 0.f, 0.f};
#pragma unroll
        for (int k2 = 0; k2 < 2; ++k2) {
            LAS unsigned char* a0 = lds + (k2 * 32 + fq * 4 + (fr >> 2)) * V_ST + (vt * 16 + 4 * (fr & 3)) * 2;
            const bf16x8 vf = tr8(a0, a0 + 16 * V_ST);
            acc = __builtin_amdgcn_mfma_f32_16x16x32_bf16(vf, pf[k2], acc, 0, 0, 0);
        }
#pragma unroll
        for (int ks = 0; ks < 4; ++ks) { const bf16x8 sf = *(const bf16x8*)(spb + (size_t)(vt * 16 + fr) * 128 + ks * 32 + fq * 8); acc = __builtin_amdgcn_mfma_f32_16x16x32_bf16(sf, qf[ks], acc, 0, 0, 0); }
        oacc[i] = acc; ss += (acc[0] * acc[0] + acc[1] * acc[1]) + (acc[2] * acc[2] + acc[3] * acc[3]);
    }
    ss += __shfl_xor(ss, 16); ss += __shfl_xor(ss, 32);
    if (fq == 0) RS[wave * 16 + fr] = ss;
    __syncthreads();
    const float ms = (RS[tt * 16 + fr] + RS[(tt + 4) * 16 + fr]) * (1.f / 256.f), rstd = rsqrtf(ms + LN_EPS);
    const size_t tok = tok0 + tt * 16 + fr;
#pragma unroll
    for (int i = 0; i < 8; ++i) {
        const int v = (vh * 8 + i) * 16 + fq * 4;
        const u32x2 rw = *(const u32x2*)(Gr + tok * 1024 + h * 256 + v); const f32x4 g = *(const f32x4*)(ng + v);
        u32x2 w; w.x = pk2(oacc[i][0] * rstd * g[0] * bflo(rw.x), oacc[i][1] * rstd * g[1] * bfhi(rw.x)); w.y = pk2(oacc[i][2] * rstd * g[2] * bflo(rw.y), oacc[i][3] * rstd * g[3] * bfhi(rw.y));
        *(u32x2*)(OGb + tok * 1024 + h * 256 + v) = w;
    }
    __syncthreads();
}
}

namespace mk {
#ifndef MIX_V2
#define MIX_V1 1
#endif
#if defined(MIX_V1)
#define MIXSEL(Hf, te, tg, U, V, Us, Vs, g2, b2, of, ob, lds, wave, gw, NGW, lane) phase_peer_mix(Hf, te, tg, U, V, Us, Vs, g2, b2, of, ob, gw, NGW, lane)
#define MIX_FROM_Z 1
#else
#define MIXSEL(Hf, te, tg, U, V, Us, Vs, g2, b2, of, ob, lds, wave, gw, NGW, lane) phase_peer_mix2(Hf, H1b, te, tg, U, V, Us, Vs, g2, b2, of, ob, lds, wave, gw, NGW, lane)
#endif
#define PEER_USLICE(Hb_, U_, Us_) do { if (G % 8 == 0) { const int per_ = G / 8; peer_u_slice(vcu / per_, (vcu % per_) * NWAVES + wave, per_ * NWAVES, Hb_, TEID, U_, HDB, lds + wave * 16384, lane); } \
        else { for (int sl_ = 0; sl_ < 8; ++sl_) peer_u_slice(sl_, gw, NGW, Hb_, TEID, U_, HDB, lds + wave * 16384, lane); } } while (0)
struct Args {
    const float* in[23]; const int* page_table; float* out; unsigned char* ws; int ph_lo, ph_hi;
};
enum Phase { P_PRO = 0, P_AIN = 1, P_SCORE = 2, P_TOPK = 3, P_ATTN = 4, P_AOUT = 5, P_LN1 = 6, P_PQ0 = 7, P_PEER0 = 8, P_GIN = 9, P_GCH = 10, P_GSC = 11, P_GOUT = 12, P_GPRJ = 13, P_LN1B = 14, P_PQ1 = 15, P_PEER1 = 16, P_COUNT = 17 };

#define Wa ((bf16*)(ws + WS_WA))
#define Wo ((bf16*)(ws + WS_WO))
#define Wg ((bf16*)(ws + WS_WG))
#define Wgo ((bf16*)(ws + WS_WGO))
#define Wpq ((bf16*)(ws + WS_WPQ))
#define PK ((bf16*)(ws + WS_PK))
#define Usc ((float*)(ws + WS_USC))
#define Xb ((bf16*)(ws + WS_XB))
#define Qb ((bf16*)(ws + WS_QB))
#define QIb ((bf16*)(ws + WS_QIB))
#define Kb ((bf16*)(ws + WS_KB))
#define Vb ((bf16*)(ws + WS_VB))
#define KIb ((bf16*)(ws + WS_KIB))
#define WIf ((float*)(ws + WS_WIF))
#define SC ((float*)(ws + WS_SC))
#define SCS ((float*)(ws + WS_SCS))
#define IDX ((int*)(ws + WS_IDX))
#define CNT ((int*)(ws + WS_CNT))
#define Ob ((bf16*)(ws + WS_OB))
#define Z ((float*)(ws + WS_Z))
#define H1f ((float*)(ws + WS_H1F))
#define H1b ((bf16*)(ws + WS_H1B))
#define PQb ((bf16*)(ws + WS_PQB))
#define H2f ((float*)(ws + WS_H2F))
#define H2b ((bf16*)(ws + WS_H2B))
#define TEID ((unsigned short*)(ws + WS_TEID))
#define TGATE ((float*)(ws + WS_TGATE))
#define Gq ((bf16*)(ws + WS_GQ))
#define Gk ((bf16*)(ws + WS_GK))
#define Gv ((bf16*)(ws + WS_GV))
#define Gr ((bf16*)(ws + WS_GR))
#define GD ((float*)(ws + WS_GD))
#define QT ((bf16*)(ws + WS_QT))
#define KT ((bf16*)(ws + WS_KT))
#define DEC ((float*)(ws + WS_DEC))
#define DSb ((float*)(ws + WS_DS))
#define SPV ((bf16*)(ws + WS_SPREV))
#define OGb ((bf16*)(ws + WS_OGB))
#define HDB ((float*)(ws + WS_HD))
#define KV8 ((unsigned char*)(ws + WS_KV8))
#define Uq (ws + WS_UB)
#define Vq (ws + WS_VBX)
#define Usc ((float*)(ws + WS_USC))
#define Vsc ((float*)(ws + WS_USC) + 2 * 16384)
#define x_prompt (INP(0))
#define x_sample (INP(1))
#define attn_w_in (INP(7))
#define attn_w_out (INP(8))
#define gla_w_in (INP(9))
#define gla_w_out (INP(13))
#define peer_w_q (INP(14))
#define peer_keys1 (INP(15))
#define peer_keys2 (INP(16))
#define peer_u (INP(17))
#define peer_v (INP(18))
__device__ __forceinline__ unsigned char* launder_ptr(unsigned char* p) { asm volatile("" : "+s"(p)); return p; }
#if defined(LOWSGPR)
#define ws (launder_ptr(args.ws))
#define INP(k) ((const float*)inp_ptr(lds, (k)))
#else
#define ws (args.ws)
#define INP(k) (args.in[k])
#endif
__device__ __forceinline__ const void* inp_ptr(LAS unsigned char* lds, int k) {
    const unsigned long long v = *(LAS unsigned long long*)(lds + INPTAB_OFF + 8 * k);
    const unsigned lo = __builtin_amdgcn_readfirstlane((unsigned)v), hi = __builtin_amdgcn_readfirstlane((unsigned)(v >> 32));
    return (const void*)(((unsigned long long)hi << 32) | lo);
}
__global__ void __launch_bounds__(NTHREADS, 2) mk_fwd(Args args) {
    extern __shared__ __attribute__((aligned(16))) unsigned char lds_raw[];
    LAS unsigned char* lds = (LAS unsigned char*)lds_raw;
    volatile LAS unsigned* MISC = (volatile LAS unsigned*)(lds + MISC_OFF);
    const int tid = threadIdx.x, lane = tid & 63, wave = __builtin_amdgcn_readfirstlane(tid >> 6);
    const int G = gridDim.x, bx = blockIdx.x;
    const int vcu = (G % 8 == 0) ? (bx % 8) * (G / 8) + bx / 8 : bx;
    const int gw = vcu * NWAVES + wave, NGW = G * NWAVES;
    gu32* ctl = (gu32*)(ws + WS_CTL);
    for (int u = tid; u < (LDS_BYTES - LDSCTL_OFF) / 4; u += NTHREADS) ((LAS unsigned*)(lds + LDSCTL_OFF))[u] = 0u;
    __syncthreads();
    if (tid == 0) {
#define PUTIN(k) *(LAS unsigned long long*)(lds + INPTAB_OFF + 8 * (k)) = (unsigned long long)args.in[k]
        PUTIN(0); PUTIN(1); PUTIN(2); PUTIN(3); PUTIN(4); PUTIN(5); PUTIN(6); PUTIN(7); PUTIN(8); PUTIN(9); PUTIN(10); PUTIN(11); PUTIN(12); PUTIN(13); PUTIN(14); PUTIN(15);
        PUTIN(16); PUTIN(17); PUTIN(18); PUTIN(19); PUTIN(20); PUTIN(21); PUTIN(22);
#undef PUTIN
    }
    __syncthreads();
    XcdBarrier bar = xcd_barrier_post((unsigned*)(ctl + CW_BAR), MISC + 8);
    if (tid == 0) { const unsigned xme = xb_xcc_id(); MISC[13] = xme; MISC[12] = __hip_atomic_fetch_add((unsigned*)(ctl + CW_XC + 64 * xme), 1u, __ATOMIC_RELAXED, __HIP_MEMORY_SCOPE_AGENT); }
    const int lo = args.ph_lo, hi = args.ph_hi;
#define IN(k) (lo <= (k) && (k) < hi)
#define SEAM(k) do { if (IN(k) && IN((k) + 1)) xcd_barrier(bar); } while (0)
#ifndef REPEAT_PHASE
#define REPEAT_PHASE -1
#endif
#ifndef REPEAT_N
#define REPEAT_N 2
#endif
#define REP(k) for (int rep_ = 0; rep_ < (REPEAT_PHASE == (k) ? REPEAT_N : 1); ++rep_)


    if (IN(P_PRO)) {
        LAS float* scr = (LAS float*)(lds + wave * 16384);
        constexpr int KB16 = D / 64;
        constexpr int I_WA = (WA_ROWS / 32) * KB16, I_WO = (D / 32) * KB16, I_WG = (WG_ROWS / 32) * KB16, I_WGO = (D / 32) * KB16, I_WPQ = 2 * (PEER_N / 32) * KB16;
        constexpr int NITEMS = I_WA + I_WO + I_WG + I_WGO + I_WPQ;
        for (int it = gw; it < NITEMS; it += NGW) {
            int r = it;
            if (r < I_WA) { const int nb = r / KB16, kb = r % KB16, d0 = nb * 32; const int nv = ATT_N - d0 < 0 ? 0 : (ATT_N - d0 > 32 ? 32 : ATT_N - d0);
                p0_transpose_item(attn_w_in, ATT_N, D, Wa, d0, d0, nv, kb * 64, scr, lane); continue; } r -= I_WA;
            if (r < I_WO) { const int nb = r / KB16, kb = r % KB16; p0_transpose_item(attn_w_out, D, D, Wo, nb * 32, nb * 32, 32, kb * 64, scr, lane); continue; } r -= I_WO;
            if (r < I_WG) { const int nb = r / KB16, kb = r % KB16, d0 = nb * 32; int s0, nv;
                if (d0 < GN_R) { s0 = d0; nv = 32; } else if (d0 < GN_GD) { s0 = GR + (d0 - GN_R); nv = 32; } else if (d0 == GN_GD) { s0 = GGD; nv = 16; } else { s0 = 0; nv = 0; }
                p0_transpose_item(gla_w_in, GLA_N, D, Wg, d0, s0, nv, kb * 64, scr, lane); continue; } r -= I_WG;
            if (r < I_WGO) { const int nb = r / KB16, kb = r % KB16; p0_transpose_item(gla_w_out, D, D, Wgo, nb * 32, nb * 32, 32, kb * 64, scr, lane); continue; } r -= I_WGO;
            { const int l = r / ((PEER_N / 32) * KB16), rr = r % ((PEER_N / 32) * KB16), nb = rr / KB16, kb = rr % KB16;
              p0_transpose_item(peer_w_q + (size_t)l * D * PEER_N, PEER_N, D, Wpq + (size_t)l * PEER_N * D, nb * 32, nb * 32, 32, kb * 64, scr, lane); }
        }
        p0_convert(x_prompt, Xb, (size_t)TP * D / 8, gw, NGW, lane);
        p0_convert(x_sample, Xb + (size_t)TP * D, (size_t)TS * D / 8, gw, NGW, lane);
        p0_convert(peer_keys1, PK, (size_t)2 * 128 * 128 / 8, gw, NGW, lane);
        p0_convert(peer_keys2, PK + 2 * 128 * 128, (size_t)2 * 128 * 128 / 8, gw, NGW, lane);
    }
    SEAM(P_PRO);

    if (IN(P_AIN)) {
        FAttnIn F{Qb, Kb, Vb, QIb, KIb, WIf, args.out};
        { pg8::Gemm g{Xb, Wa, TP, 2048, D}; pg8::StaticOrder S; S.init(TP, 2048, G, bx);
          pg8::EpiRow8<FAttnIn> E{F};
          pg8::gemm_phase<pg8::EpiRow8<FAttnIn>, pg8::StaticOrder, true, true>(lds, g, S, E);
          float km = E.f.kmax, vm = E.f.vmax;
#pragma unroll
          for (int o = 1; o < 64; o <<= 1) { km = fmaxf(km, __shfl_xor(km, o)); vm = fmaxf(vm, __shfl_xor(vm, o)); }
          if (lane == 0) { if (km > 0.f) atomicMax((unsigned*)(ctl + CW_AMAXK), __builtin_bit_cast(unsigned, km)); if (vm > 0.f) atomicMax((unsigned*)(ctl + CW_AMAXV), __builtin_bit_cast(unsigned, vm)); } }
        for (int it = gw; it < TP / 16 + 8 * 34; it += NGW) {
            if (it < TP / 16) {
                f32x4 acc[5]; skinny_tile<5>(Xb, D, Wa, D, it * 16, 2048, acc, lane);
#pragma unroll
                for (int ct = 0; ct < 5; ++ct) F.put4(it * 16 + (lane & 15), 2048 + ct * 16 + 4 * (lane >> 4), acc[ct]);
            } else {
                const int r = it - TP / 16, rt = r % 8, cg = r / 8;
                f32x4 acc[4]; skinny_tile<4>(Xb, D, Wa, D, TP + rt * 16, cg * 64, acc, lane);
#pragma unroll
                for (int ct = 0; ct < 4; ++ct) F.put4(TP + rt * 16 + (lane & 15), cg * 64 + ct * 16 + 4 * (lane >> 4), acc[ct]);
            }
        }
    }
    SEAM(P_AIN);

            if (IN(P_SCORE)) { kv8_convert(Kb, Vb, KV8, (const unsigned*)(ctl + CW_AMAXK), (const unsigned*)(ctl + CW_AMAXV), gw, NGW, lane);
        phase_score(QIb, KIb, WIf, INP(4), args.page_table, SC, SCS, QuantTabs{peer_u, peer_v, Uq, Vq, Usc, Vsc}, lds, vcu, G, wave, lane, gw, NGW); }
    SEAM(P_SCORE);
    if (IN(P_TOPK)) {
        const int jlo_ = 0, jhi_ = TA;
        phase_topk2(SC, SCS, IDX, CNT, peer_u, peer_v, Uq, Vq, Usc, Vsc, lds, (unsigned*)(ctl + CW_Q1), wave, lane, gw, NGW, jlo_, jhi_); }
    SEAM(P_TOPK);
    if (IN(P_ATTN)) {
        LAS unsigned char* wl = lds + wave * 16384;
        {
            if (tid == 0) { unsigned np = 0, mi = 0, mycnt = 1; const unsigned xme = MISC[13];
                for (unsigned j = 0; j < 16; ++j) { const unsigned c = __hip_atomic_load((unsigned*)(ctl + CW_XC + 64 * j), __ATOMIC_RELAXED, __HIP_MEMORY_SCOPE_AGENT); if (c > 0u) { if (j < xme) ++mi; ++np; } if (j == xme) mycnt = c > 0u ? c : 1u; }
                MISC[14] = np > 0u ? np : 1u; MISC[15] = mi; MISC[16] = mycnt; }
            __syncthreads();
            const int np = (int)MISC[14], mi = (int)MISC[15], mycnt = (int)MISC[16], rank = (int)MISC[12];
            for (int u = 0; u < NBATCH * 4; ++u) if (u % np == mi) attn_prompt_stream(u >> 2, u & 3, rank * NWAVES + wave, mycnt * NWAVES, Qb, IDX, KV8, (const unsigned*)(ctl + CW_AMAXK), (const unsigned*)(ctl + CW_AMAXV), Ob, wl, lane);
        }
        {
            const float* ck_ = INP(2); const float* cv_ = INP(3); float* o_ = args.out; const int* pt_ = args.page_table; int gws_ = gw; int lane_s = lane;
            asm volatile("" : "+s"(ck_), "+s"(cv_), "+s"(o_), "+s"(pt_), "+s"(gws_), "+v"(lane_s));
            for (int su = gws_; su < TS * 4 * 4; su += NGW) {
                if ((su & 3) == 0) { const int un = su >> 2, r = un >> 2, n = un & 3; attn_row<true>(TP + r, n, n + 1, Qb, IDX, CNT, nullptr, nullptr, ck_, cv_, o_ + OUT_KS, o_ + OUT_VS, pt_, Ob, wl, lane_s); }
            }
        }
    }
    SEAM(P_ATTN);
    if (IN(P_AOUT)) {
        FResid F{x_prompt, x_sample, Z};
        { pg8::Gemm g{Ob, Wo, TP, D, D}; pg8::StaticOrder S; S.init(TP, D, G, bx);
          pg8::EpiRow8<FResid> E{F};
          pg8::gemm_phase<pg8::EpiRow8<FResid>, pg8::StaticOrder, true, true>(lds, g, S, E); }
        for (int it = gw; it < 8 * 16; it += NGW) {
            const int rt = it % 8, cg = it / 8;
            f32x4 acc[4]; skinny_tile<4>(Ob, D, Wo, D, TP + rt * 16, cg * 64, acc, lane);
#pragma unroll
            for (int ct = 0; ct < 4; ++ct) F.put4(TP + rt * 16 + (lane & 15), cg * 64 + ct * 16 + 4 * (lane >> 4), acc[ct]);
        }
    }
    SEAM(P_AOUT);
    if (IN(P_LN1)) { for (int r = gw; r < TA; r += NGW) ln_row_wave(Z + (size_t)r * D, INP(19), INP(20), (float*)nullptr, H1b + (size_t)r * D, lane); }
    SEAM(P_LN1);

        if (IN(P_PQ0)) {
        FStoreBf16 F{PQb, PEER_N};
        { pg8::Gemm g{H1b, Wpq, TP, PEER_N, D}; pg8::StaticOrder S; S.init(TP, PEER_N, G, bx);
          pg8::EpiRow8<FStoreBf16> E{F};
          pg8::gemm_phase<pg8::EpiRow8<FStoreBf16>, pg8::StaticOrder, true, true>(lds, g, S, E); }
        for (int it = gw; it < 8 * 32; it += NGW) {
            const int rt = it % 8, cg = it / 8;
            f32x4 acc[4]; skinny_tile<4>(H1b, D, Wpq, D, TP + rt * 16, cg * 64, acc, lane);
#pragma unroll
            for (int ct = 0; ct < 4; ++ct) F.put4(TP + rt * 16 + (lane & 15), cg * 64 + ct * 16 + 4 * (lane >> 4), acc[ct]);
        }
#if 0
        for (int it = gw; it < 8 * 16; it += NGW) {
            const int rt = it % 8, cg = it / 8;
            f32x4 acc[8]; skinny_tile<8>(H1b, D, Wpq, D, TP + rt * 16, cg * 128, acc, lane);
#pragma unroll
            for (int ct = 0; ct < 8; ++ct) F.put4(TP + rt * 16 + (lane & 15), cg * 128 + ct * 16 + 4 * (lane >> 4), acc[ct]);
        }
#endif
    }
    SEAM(P_PQ0);
        if (IN(P_PEER0)) {
        phase_peer_select(PQb, PK, PK + 2 * 16384, TEID, TGATE, lds, vcu, G, wave, lane);
        xcd_barrier(bar);
#if defined(U_SLICED)
        PEER_USLICE(H1b, Uq, Usc);
        xcd_barrier(bar);
        phase_peer_mixv(Z, INP(19), INP(20), TEID, TGATE, HDB, Vq, Usc, Vsc, INP(21), INP(22), H2f, H2b, gw, NGW, lane);
#else
#if defined(MIX_FROM_Z)
        phase_peer_mix(Z, INP(19), INP(20), TEID, TGATE, Uq, Vq, Usc, Vsc, INP(21), INP(22), H2f, H2b, gw, NGW, lane);
#else
        MIXSEL(H1f, TEID, TGATE, Uq, Vq, Usc, Vsc, INP(21), INP(22), H2f, H2b, lds, wave, gw, NGW, lane);
#endif
#endif
    }
    SEAM(P_PEER0);

            if (IN(P_GIN)) {
        FGlaIn F{Gq, Gk, Gv, Gr, GD};
        { pg8::Gemm g{H2b, Wg, TP, 3072, D}; pg8::StaticOrder S; S.init(TP, 3072, G, bx);
          pg8::EpiRow8<FGlaIn> E{F};
          pg8::gemm_phase<pg8::EpiRow8<FGlaIn>, pg8::StaticOrder, true, true>(lds, g, S, E); }
        for (int it = gw; it < TP / 16 + 8 * 97; it += NGW) {
            if (it < TP / 16) {
                f32x4 acc[1]; skinny_tile<1>(H2b, D, Wg, D, it * 16, GN_GD, acc, lane);
                F.put4(it * 16 + (lane & 15), GN_GD + 4 * (lane >> 4), acc[0]);
            } else {
                const int r = it - TP / 16, rt = r % 8, cg = r / 8;
                f32x4 acc[2]; skinny_tile<2>(H2b, D, Wg, D, TP + rt * 16, cg * 32, acc, lane);
#pragma unroll
                for (int ct = 0; ct < 2; ++ct) F.put4(TP + rt * 16 + (lane & 15), cg * 32 + ct * 16 + 4 * (lane >> 4), acc[ct]);
            }
        }
    }
    SEAM(P_GIN);
    if (IN(P_GCH)) {
        for (int it = vcu; it < NBATCH * (SEQ / 64) * 4; it += G) gla_chunk_item(it, Gq, Gk, Gv, GD, INP(10), INP(11), QT, KT, DEC, DSb, lds, tid, wave, lane);
        for (int it = vcu; it < DB * 4; it += G) gla_sample_item(it, Gq, Gk, Gv, Gr, GD, INP(10), INP(11), INP(12), INP(5), args.out + OUT_SS, OGb, lds, tid, lane);
    }
    SEAM(P_GCH);
    if (IN(P_GSC)) gla_scan(DSb, DEC, SPV, args.out + OUT_SP, vcu * NTHREADS + tid, G * NTHREADS);
    SEAM(P_GSC);
    if (IN(P_GOUT)) { for (int it = vcu; it < NBATCH * (SEQ / 64) * 4; it += G) gla_out_item(it, QT, KT, Gv, Gr, SPV, INP(12), OGb, lds, tid, wave, lane); }
    SEAM(P_GOUT);
    if (IN(P_GPRJ)) {
        FResid F{H2f, H2f + (size_t)TP * D, Z};
        { pg8::Gemm g{OGb, Wgo, TP, D, D}; pg8::StaticOrder S; S.init(TP, D, G, bx);
          pg8::EpiRow8<FResid> E{F};
          pg8::gemm_phase<pg8::EpiRow8<FResid>, pg8::StaticOrder, true, true>(lds, g, S, E); }
        for (int it = gw; it < 8 * 16; it += NGW) {
            const int rt = it % 8, cg = it / 8;
            f32x4 acc[4]; skinny_tile<4>(OGb, D, Wgo, D, TP + rt * 16, cg * 64, acc, lane);
#pragma unroll
            for (int ct = 0; ct < 4; ++ct) F.put4(TP + rt * 16 + (lane & 15), cg * 64 + ct * 16 + 4 * (lane >> 4), acc[ct]);
        }
    }
    SEAM(P_GPRJ);
    if (IN(P_LN1B)) { for (int r = gw; r < TA; r += NGW) ln_row_wave(Z + (size_t)r * D, INP(19) + D, INP(20) + D, (float*)nullptr, H1b + (size_t)r * D, lane); }
    SEAM(P_LN1B);
    if (IN(P_PQ1)) {
        FStoreBf16 F{PQb, PEER_N}; const bf16* W1 = Wpq + (size_t)PEER_N * D;
        { pg8::Gemm g{H1b, W1, TP, PEER_N, D}; pg8::StaticOrder S; S.init(TP, PEER_N, G, bx);
          pg8::EpiRow8<FStoreBf16> E{F};
          pg8::gemm_phase<pg8::EpiRow8<FStoreBf16>, pg8::StaticOrder, true, true>(lds, g, S, E); }
        for (int it = gw; it < 8 * 32; it += NGW) {
            const int rt = it % 8, cg = it / 8;
            f32x4 acc[4]; skinny_tile<4>(H1b, D, W1, D, TP + rt * 16, cg * 64, acc, lane);
#pragma unroll
            for (int ct = 0; ct < 4; ++ct) F.put4(TP + rt * 16 + (lane & 15), cg * 64 + ct * 16 + 4 * (lane >> 4), acc[ct]);
        }
    }
    SEAM(P_PQ1);
    if (IN(P_PEER1)) {
        phase_peer_select(PQb, PK + 16384, PK + 3 * 16384, TEID, TGATE, lds, vcu, G, wave, lane);
        xcd_barrier(bar);
#if defined(U_SLICED)
        PEER_USLICE(H1b, Uq + (size_t)16384 * PEER_RB, Usc + 16384);
        xcd_barrier(bar);
        phase_peer_mixv(Z, INP(19) + D, INP(20) + D, TEID, TGATE, HDB, Vq + (size_t)16384 * PEER_RB, Usc + 16384, Vsc + 16384, INP(21) + D, INP(22) + D, args.out + OUT_Y, nullptr, gw, NGW, lane);
#else
#if defined(MIX_FROM_Z)
        phase_peer_mix(Z, INP(19) + D, INP(20) + D, TEID, TGATE, Uq + (size_t)16384 * PEER_RB, Vq + (size_t)16384 * PEER_RB, Usc + 16384, Vsc + 16384, INP(21) + D, INP(22) + D, args.out + OUT_Y, nullptr, gw, NGW, lane);
#else
        MIXSEL(H1f, TEID, TGATE, Uq + (size_t)16384 * PEER_RB, Vq + (size_t)16384 * PEER_RB, Usc + 16384, Vsc + 16384, INP(21) + D, INP(22) + D, args.out + OUT_Y, nullptr, lds, wave, gw, NGW, lane);
#endif
#endif
    }
#undef IN
#undef SEAM
}
#undef ws
#undef INP
#undef Wa
#undef Wo
#undef Wg
#undef Wgo
#undef Wpq
#undef PK
#undef Usc
#undef Xb
#undef Qb
#undef QIb
#undef Kb
#undef Vb
#undef KIb
#undef WIf
#undef SC
#undef SCS
#undef IDX
#undef CNT
#undef Ob
#undef Z
#undef H1f
#undef H1b
#undef PQb
#undef H2f
#undef H2b
#undef TEID
#undef TGATE
#undef Gq
#undef Gk
#undef Gv
#undef Gr
#undef GD
#undef QT
#undef KT
#undef DEC
#undef DSb
#undef SPV
#undef OGb
#undef Uq
#undef HDB
#undef KV8
#undef Vq
#undef Usc
#undef Vsc
#undef x_prompt
#undef x_sample
#undef attn_w_in
#undef attn_w_out
#undef gla_w_in
#undef gla_w_out
#undef peer_w_q
#undef peer_keys1
#undef peer_keys2
#undef peer_u
#undef peer_v


}

extern "C" void kernel_launch(void* const* d_in, const int* in_sizes, int n_in, void* d_out, int out_size, void* d_ws, size_t ws_size, hipStream_t stream) {
    if (ws_size < mk::WS_END || n_in != 23 || (size_t)out_size != OUT_TOTAL) { fprintf(stderr, "kernel_launch: unexpected sizes ws %zu n_in %d out %d\n", ws_size, n_in, out_size); return; }
    static int grid = 0;
    if (grid == 0) {
        int dev = 0, cus = 0;
        if (hipGetDevice(&dev) != hipSuccess || hipDeviceGetAttribute(&cus, hipDeviceAttributeMultiprocessorCount, dev) != hipSuccess) { fprintf(stderr, "kernel_launch: device query failed\n"); grid = -1; return; }
        if (hipFuncSetAttribute((const void*)mk::mk_fwd, hipFuncAttributeMaxDynamicSharedMemorySize, mk::LDS_BYTES) != hipSuccess) { fprintf(stderr, "kernel_launch: hipFuncSetAttribute failed\n"); grid = -1; return; }
        int per_cu = 0;
        if (hipOccupancyMaxActiveBlocksPerMultiprocessor(&per_cu, (const void*)mk::mk_fwd, mk::NTHREADS, mk::LDS_BYTES) != hipSuccess || per_cu < 1) fprintf(stderr, "kernel_launch: occupancy query says %d\n", per_cu);
        (void)hipGetLastError();
        grid = cus;
    }
    if (grid < 0) return;
    (void)hipMemsetAsync((char*)d_ws + mk::WS_CTL, 0, mk::CTL_ZERO_BYTES, stream);
    mk::Args a{};
    for (int i = 0; i < 23; ++i) a.in[i] = (const float*)d_in[i];
    a.page_table = (const int*)d_in[6]; a.out = (float*)d_out; a.ws = (unsigned char*)d_ws; a.ph_lo = 0; a.ph_hi = mk::P_COUNT;
    hipLaunchKernelGGL(mk::mk_fwd, dim3(grid), dim3(mk::NTHREADS), mk::LDS_BYTES, stream, a);
}
```

```cpp
#include <hip/hip_runtime.h>
#include <cstdio>
#include <cstdint>
#include <cmath>

constexpr int D = 1024;
constexpr int NBATCH = 2, SEQ = 8192, TP = NBATCH * SEQ;
constexpr int DB = 32, DS = 4, TS = DB * DS;
constexpr int TA = TP + TS;
constexpr int PAST = 8192, PAGE = 128, NPAGES = PAST / PAGE;
constexpr float ALPHA = 1.4142135623730951f;
constexpr float LN_EPS = 1e-5f;
constexpr int ATT_N = 2120;
constexpr int AQ = 0, AK = 1024, AV = 1280, AQI = 1536, AKI = 2048, AWI = 2112;
constexpr int TOPK = 256;
constexpr int GLA_N = 3088;
constexpr int GQ = 0, GK = 512, GV = 1024, GGD = 2048, GR = 2064;
constexpr int PEER_N = 2048;
constexpr int SCS_LD = 8256;

constexpr size_t OUT_Y = 0, OUT_KP = 16908288, OUT_VP = 21102592, OUT_KIP = 25296896, OUT_SP = 26345472,
                 OUT_KS = 26607616, OUT_VS = 26640384, OUT_KIS = 26673152, OUT_SS = 26681344, OUT_TOTAL = 30875648;


namespace pg8 {
#define PG8_LAS __attribute__((address_space(3)))
typedef unsigned short bf16_t;
typedef short bf16x8 __attribute__((ext_vector_type(8)));
typedef float f32x4 __attribute__((ext_vector_type(4)));
typedef unsigned u32x4 __attribute__((ext_vector_type(4)));
constexpr int BM = 256, BK = 64, HALF = 128, HTB = HALF * BK * 2  , STAGE_BYTES = 8 * HTB, NXCD = 8, WGM = 8;

__host__ __device__ __forceinline__ int lds_byte(int r, int c) { const int st = (r >> 4) * 2 + (c >> 5), rr = r & 15, cc = c & 31, ob = rr * 64 + cc * 2; return st * 1024 + (ob ^ (((ob >> 9) & 1) << 5)); }
__host__ __device__ __forceinline__ void stage_rc(int b, int& R, int& C) { const int st = b / 1024, sb = b % 1024, swz = sb ^ (((sb >> 9) & 1) << 5); R = (st >> 1) * 16 + swz / 64; C = (st & 1) * 32 + (swz % 64) / 2; }
__host__ __device__ __forceinline__ int perm32(int rho) { const int n = rho >> 4, i = rho & 15; return 8 * (i >> 2) + 4 * n + (i & 3); }

struct Unit { int pm, pn; };
struct Gemm { const bf16_t* A; const bf16_t* Bt; int M, N, K; };

struct StaticOrder {
    int nM, nN, nwg, G, c;
    __host__ __device__ void init(int M, int N, int G_, int c_) { nM = M / BM; nN = N / BM; nwg = nM * nN; G = G_; c = c_; }
    __host__ __device__ bool next(int i, Unit& u) const {
        const long L = (long)i * G + c; if (L >= nwg) return false;
        int wgid = (int)L; { const int q = nwg / NXCD, r = nwg % NXCD, xcd = wgid % NXCD, off = wgid / NXCD; wgid = (xcd < r ? xcd * (q + 1) : r * (q + 1) + (xcd - r) * q) + off; }
        const int nig = WGM * nN, gid = wgid / nig, fm = gid * WGM, gsz = (nM - fm) < WGM ? (nM - fm) : WGM;
        u.pm = fm + ((wgid % nig) % gsz); u.pn = (wgid % nig) / gsz; return true;
    }
    __device__ __forceinline__ void a_ready(const Unit&) const {}
    __device__ __forceinline__ void done(const Unit&) const {}
};

__device__ __forceinline__ unsigned cvt_pk_bf16(float lo, float hi) { unsigned r; asm volatile("v_cvt_pk_bf16_f32 %0, %1, %2" : "=v"(r) : "v"(lo), "v"(hi)); return r; }
template <class F> struct EpiRow8 {
    static constexpr bool PERM = true, AFTER_DRAIN = false;
    F f;
    __device__ __forceinline__ void operator()(const f32x4 (&acc)[2][2][4][2], const Unit& u, int wr, int wc, int fr, int fq) const {
        const int row0 = u.pm * BM + wr * 64 + fr, col0 = u.pn * BM + wc * 32 + 8 * fq;
#pragma unroll
        for (int ai = 0; ai < 2; ++ai)
#pragma unroll
            for (int m = 0; m < 4; ++m)
#pragma unroll
                for (int bj = 0; bj < 2; ++bj) f.put8(row0 + ai * HALF + m * 16, col0 + bj * HALF, acc[ai][bj][m][0], acc[ai][bj][m][1]);
    }
};


template <class Epi, class Sched, bool ALIGN_EPI = false, bool SP2 = false>
__device__ __forceinline__ void gemm_phase(PG8_LAS unsigned char* lds, const Gemm g, const Sched& S, const Epi& E) {
    const int tid = threadIdx.x, wid = __builtin_amdgcn_readfirstlane(tid >> 6), lane = tid & 63, wr = wid >> 2, wc = wid & 3, fr = lane & 15, fq = lane >> 4;
    const int K = g.K, nt = K / BK;
    unsigned voffA[2], voffB[2];
#pragma unroll
    for (int i = 0; i < 2; ++i) { int R, C; stage_rc(tid * 16 + i * 8192, R, C); const int Rb = Epi::PERM ? ((R & ~31) + perm32(R & 31)) : R;
        voffA[i] = (unsigned)(R * K + C) * 2u; voffB[i] = (unsigned)(Rb * K + C) * 2u; }
    const size_t kstep = (size_t)(BK * 2);
    const size_t hstep = (size_t)HALF * K * 2;
    const size_t tstep = 2 * hstep;
    const unsigned ldsw = (unsigned)wid * 1024u;
    const int aoff = lds_byte(wr * 64 + fr, fq * 8), boff = lds_byte(wc * 32 + fr, fq * 8);
#define PG8_SA(b, h) (((b) * 2 + (h)) * HTB)
#define PG8_SB(b, h) ((4 + (b) * 2 + (h)) * HTB)
#define PG8_STAGE(bufoff, gbase, voff) do { _Pragma("unroll") for (int _i = 0; _i < 2; ++_i) \
        __builtin_amdgcn_global_load_lds((const unsigned*)((const char*)(gbase) + (voff)[_i]), (PG8_LAS unsigned*)(lds + (bufoff) + ldsw + _i * 8192), 16, 0, 0); } while (0)
#define PG8_LDA(dst, b, h) do { _Pragma("unroll") for (int m = 0; m < 4; ++m) _Pragma("unroll") for (int k = 0; k < 2; ++k) dst[m][k] = *(const PG8_LAS bf16x8*)(lds + PG8_SA(b, h) + aoff + m * 2048 + k * 1024); } while (0)
#define PG8_LDB(dst, b, h) do { _Pragma("unroll") for (int n = 0; n < 2; ++n) _Pragma("unroll") for (int k = 0; k < 2; ++k) dst[n][k] = *(const PG8_LAS bf16x8*)(lds + PG8_SB(b, h) + boff + n * 2048 + k * 1024); } while (0)
#define PG8_MMA(ai, bj, At, Bt) do { __builtin_amdgcn_s_setprio(1); _Pragma("unroll") for (int m = 0; m < 4; ++m) _Pragma("unroll") for (int n = 0; n < 2; ++n) _Pragma("unroll") for (int k = 0; k < 2; ++k) \
        acc[ai][bj][m][n] = __builtin_amdgcn_mfma_f32_16x16x32_bf16(Bt[n][k], At[m][k], acc[ai][bj][m][n], 0, 0, 0); __builtin_amdgcn_s_setprio(0); } while (0)
#define PG8_WAIT_V(n) asm volatile("s_waitcnt vmcnt(" #n ")" ::: "memory")
#define PG8_WAIT_L(n) asm volatile("s_waitcnt lgkmcnt(" #n ")" ::: "memory")
#define PG8_BAR __builtin_amdgcn_s_barrier()
#define PG8_SCHED __builtin_amdgcn_sched_barrier(0)
    Unit cur, nxt; int ui = 0;
    if (!S.next(0, cur)) return;
    f32x4 acc[2][2][4][2];
#pragma unroll
    for (int a = 0; a < 2; ++a)
#pragma unroll
        for (int b = 0; b < 2; ++b)
#pragma unroll
            for (int m = 0; m < 4; ++m)
#pragma unroll
                for (int n = 0; n < 2; ++n) acc[a][b][m][n] = (f32x4){0.f, 0.f, 0.f, 0.f};
    bf16x8 At[4][2], B0[2][2], B1[2][2];
    const char* cA = (const char*)g.A + (size_t)cur.pm * tstep; const char* cB = (const char*)g.Bt + (size_t)cur.pn * tstep;
    S.a_ready(cur);
    if constexpr (SP2) {
        PG8_STAGE(PG8_SB(0, 0), cB, voffB); PG8_STAGE(PG8_SB(0, 1), cB + hstep, voffB); PG8_STAGE(PG8_SA(0, 0), cA, voffA); PG8_STAGE(PG8_SA(0, 1), cA + hstep, voffA);
        if (wr == 1) PG8_BAR;
        PG8_WAIT_V(2); PG8_BAR;
        PG8_STAGE(PG8_SB(1, 0), cB + kstep, voffB); PG8_STAGE(PG8_SA(1, 0), cA + kstep, voffA); PG8_STAGE(PG8_SB(1, 1), cB + hstep + kstep, voffB);
        PG8_WAIT_V(6); PG8_BAR;
    } else {
        PG8_STAGE(PG8_SB(0, 0), cB, voffB); PG8_STAGE(PG8_SA(0, 0), cA, voffA); PG8_STAGE(PG8_SB(0, 1), cB + hstep, voffB); PG8_STAGE(PG8_SA(0, 1), cA + hstep, voffA);
        if (wr == 1) PG8_BAR;
        PG8_WAIT_V(4); PG8_BAR;
        PG8_STAGE(PG8_SB(1, 0), cB + kstep, voffB); PG8_STAGE(PG8_SA(1, 0), cA + kstep, voffA); PG8_STAGE(PG8_SB(1, 1), cB + hstep + kstep, voffB);
        PG8_WAIT_V(6); PG8_BAR;
    }
    for (;;) {
        const bool has_next = S.next(ui + 1, nxt);
        const char* nA = has_next ? (const char*)g.A + (size_t)nxt.pm * tstep : cA; const char* nB = has_next ? (const char*)g.Bt + (size_t)nxt.pn * tstep : cB;
        for (int t = 0; t < nt; t += 2) {
            const bool last = (t == nt - 2);
            const char* a1 = cA + (size_t)(t + 1) * kstep;
            const char* a2 = last ? nA : cA + (size_t)(t + 2) * kstep; const char* b2 = last ? nB : cB + (size_t)(t + 2) * kstep;
            const char* a3 = a2 + kstep; const char* b3 = b2 + kstep;
            if (last && has_next) S.a_ready(nxt);
            if constexpr (SP2) {
            PG8_LDB(B0, 0, 0); PG8_LDB(B1, 0, 1); PG8_SCHED; PG8_LDA(At, 0, 0); PG8_STAGE(PG8_SA(1, 1), a1 + hstep, voffA);
            PG8_WAIT_V(8); PG8_WAIT_L(0); PG8_BAR; PG8_MMA(0, 0, At, B0); PG8_MMA(0, 1, At, B1); PG8_BAR; PG8_SCHED;
            PG8_LDA(At, 0, 1); PG8_STAGE(PG8_SB(0, 0), b2, voffB); PG8_STAGE(PG8_SB(0, 1), b2 + hstep, voffB); PG8_STAGE(PG8_SA(0, 0), a2, voffA);
            PG8_WAIT_V(8); PG8_WAIT_L(0); PG8_BAR; PG8_MMA(1, 0, At, B0); PG8_MMA(1, 1, At, B1); PG8_BAR; PG8_SCHED;
            PG8_LDB(B0, 1, 0); PG8_LDB(B1, 1, 1); PG8_SCHED; PG8_LDA(At, 1, 0); PG8_STAGE(PG8_SA(0, 1), a2 + hstep, voffA);
            PG8_WAIT_V(8); PG8_WAIT_L(0); PG8_BAR; PG8_MMA(0, 0, At, B0); PG8_MMA(0, 1, At, B1); PG8_BAR; PG8_SCHED;
            PG8_LDA(At, 1, 1); PG8_STAGE(PG8_SB(1, 0), b3, voffB); PG8_STAGE(PG8_SB(1, 1), b3 + hstep, voffB); PG8_STAGE(PG8_SA(1, 0), a3, voffA);
            PG8_WAIT_V(8); PG8_WAIT_L(0); PG8_BAR; PG8_MMA(1, 0, At, B0); PG8_MMA(1, 1, At, B1); PG8_BAR; PG8_SCHED;
            } else {
            PG8_LDB(B0, 0, 0); PG8_SCHED; PG8_LDA(At, 0, 0); PG8_STAGE(PG8_SA(1, 1), a1 + hstep, voffA);
            PG8_WAIT_L(8); PG8_BAR; PG8_WAIT_L(0); PG8_MMA(0, 0, At, B0); PG8_BAR; PG8_SCHED;
            PG8_LDB(B1, 0, 1); PG8_STAGE(PG8_SB(0, 0), b2, voffB);
            PG8_BAR; PG8_WAIT_L(0); PG8_MMA(0, 1, At, B1); PG8_BAR;
            PG8_LDA(At, 0, 1); PG8_STAGE(PG8_SA(0, 0), a2, voffA);
            PG8_BAR; PG8_WAIT_L(0); PG8_MMA(1, 0, At, B0); PG8_BAR; PG8_SCHED;
            PG8_STAGE(PG8_SB(0, 1), b2 + hstep, voffB);
            PG8_WAIT_V(6); PG8_BAR; PG8_MMA(1, 1, At, B1); PG8_BAR;
            PG8_LDB(B0, 1, 0); PG8_SCHED; PG8_LDA(At, 1, 0); PG8_STAGE(PG8_SA(0, 1), a2 + hstep, voffA);
            PG8_WAIT_L(8); PG8_BAR; PG8_WAIT_L(0); PG8_MMA(0, 0, At, B0); PG8_BAR; PG8_SCHED;
            PG8_LDB(B1, 1, 1); PG8_STAGE(PG8_SB(1, 0), b3, voffB);
            PG8_BAR; PG8_WAIT_L(0); PG8_MMA(0, 1, At, B1); PG8_BAR;
            PG8_LDA(At, 1, 1); PG8_STAGE(PG8_SA(1, 0), a3, voffA);
            PG8_BAR; PG8_WAIT_L(0); PG8_MMA(1, 0, At, B0); PG8_BAR; PG8_SCHED;
            PG8_STAGE(PG8_SB(1, 1), b3 + hstep, voffB);
            PG8_WAIT_V(6); PG8_BAR; PG8_MMA(1, 1, At, B1); PG8_BAR;
            }
        }
        if constexpr (ALIGN_EPI) { if (wr == 0) PG8_BAR; }
        if constexpr (!Epi::AFTER_DRAIN) { E(acc, cur, wr, wc, fr, fq); S.done(cur); }
        if (!has_next) break;
#pragma unroll
        for (int a = 0; a < 2; ++a)
#pragma unroll
            for (int b = 0; b < 2; ++b)
#pragma unroll
                for (int m = 0; m < 4; ++m)
#pragma unroll
                    for (int n = 0; n < 2; ++n) acc[a][b][m][n] = (f32x4){0.f, 0.f, 0.f, 0.f};
        cur = nxt; cA = nA; cB = nB; ++ui;
        if constexpr (ALIGN_EPI) { if (wr == 1) PG8_BAR; }
    }
    PG8_WAIT_V(0);
    if constexpr (!ALIGN_EPI) { if (wr == 0) PG8_BAR; }
    PG8_BAR;
    if constexpr (Epi::AFTER_DRAIN) { E.fused(acc, cur, wr, wc, fr, fq, lds, wid, lane); S.done(cur); }
#undef PG8_SA
#undef PG8_SB
#undef PG8_STAGE
#undef PG8_LDA
#undef PG8_LDB
#undef PG8_MMA
#undef PG8_WAIT_V
#undef PG8_WAIT_L
#undef PG8_BAR
#undef PG8_SCHED
}
}

namespace mk {
#define GAS __attribute__((address_space(1)))
#define LAS __attribute__((address_space(3)))
typedef unsigned short bf16;
typedef unsigned v4u __attribute__((ext_vector_type(4)));
typedef float f32x4 __attribute__((ext_vector_type(4)));
typedef short bf16x8 __attribute__((ext_vector_type(8)));
typedef GAS unsigned gu32;
typedef GAS unsigned long long gu64;
#define RLX_AGENT __ATOMIC_RELAXED, __HIP_MEMORY_SCOPE_AGENT
#define LDS_WAIT() asm volatile("s_waitcnt lgkmcnt(0)" ::: "memory")
#define VM_WAIT() asm volatile("s_waitcnt vmcnt(0)" ::: "memory")
__device__ __forceinline__ unsigned long long rt() { return __builtin_amdgcn_s_memrealtime(); }
__device__ __forceinline__ unsigned f2bf(float f) { unsigned u = __builtin_bit_cast(unsigned, f); return (u + 0x7fffu + ((u >> 16) & 1u)) >> 16; }
__device__ __forceinline__ unsigned pk2(float lo, float hi) {
    typedef __bf16 bf2_t __attribute__((ext_vector_type(2))); typedef float f2_t __attribute__((ext_vector_type(2)));
    const f2_t v = {lo, hi}; const bf2_t b = __builtin_convertvector(v, bf2_t); return __builtin_bit_cast(unsigned, b); }

#define XB_TMO      128
#define XB_XCNT(j)  (256  + 64 * (j))
#define XB_XSUB(j)  (1280 + 64 * (j))
#define XB_XGEN(j)  (2304 + 64 * (j))
#define XB_TOP      3328
#define XB_TOPGEN   3392
#define XCD_BAR_WORDS 3456
#define XB_SPIN_CAP (1u << 18)

__device__ __forceinline__ unsigned xb_ld(unsigned* p)              { return __hip_atomic_load(p, __ATOMIC_RELAXED, __HIP_MEMORY_SCOPE_AGENT); }
__device__ __forceinline__ unsigned xb_add(unsigned* p, unsigned v) { return __hip_atomic_fetch_add(p, v, __ATOMIC_RELAXED, __HIP_MEMORY_SCOPE_AGENT); }
__device__ __forceinline__ unsigned xb_xcc_id() { return (unsigned)__builtin_amdgcn_s_getreg((3 << 11) | 20) & 0xFu; }
#define XB_SPIN(cond, bar) do { unsigned _sp = 0; while (cond) { __builtin_amdgcn_s_sleep(1); \
    if ((++_sp & 255u) == 0u) { if (xb_ld(&(bar)[XB_TMO])) break; if (_sp > XB_SPIN_CAP) { atomicAdd(&(bar)[XB_TMO], 1u); break; } } } } while (0)

struct XcdBarrier {
    unsigned* bar; unsigned x;
    volatile LAS unsigned* st;
};

__device__ __forceinline__ XcdBarrier xcd_barrier_post(unsigned* bar, volatile LAS unsigned* st) {
    XcdBarrier b; b.bar = bar; b.x = xb_xcc_id(); b.st = st;
    if (threadIdx.x == 0) (void)xb_add(&bar[XB_XCNT(b.x)], 1u);
    return b;
}
__device__ __forceinline__ void xcd_barrier_complete(unsigned* bar, unsigned x, unsigned& nloc, unsigned& nx) {
    const unsigned G = gridDim.x * gridDim.y * gridDim.z;
    unsigned sum, cnt, mine, sp = 0u;
    for (;;) {
        sum = 0u; cnt = 0u; mine = 0u;
#pragma unroll
        for (unsigned j = 0; j < 16; ++j) { const unsigned c = xb_ld(&bar[XB_XCNT(j)]); sum += c; cnt += (c > 0u) ? 1u : 0u; mine = (j == x) ? c : mine; }
        if (sum == G) break;
        __builtin_amdgcn_s_sleep(1);
        if ((++sp & 255u) == 0u) { if (xb_ld(&bar[XB_TMO])) break; if (sp > XB_SPIN_CAP) { atomicAdd(&bar[XB_TMO], 1u); break; } }
    }
    nloc = mine > 0u ? mine : 1u; nx = cnt > 0u ? cnt : 1u;
}

__device__ __forceinline__ void xcd_barrier(const XcdBarrier& b) {
    asm volatile("s_waitcnt vmcnt(0)" ::: "memory");
    __syncthreads();
    if (threadIdx.x == 0) {
        unsigned* bar = b.bar;
        __builtin_amdgcn_s_waitcnt(0);
        unsigned nloc = b.st[0], nx = b.st[1];
        if (nloc == 0u) { xcd_barrier_complete(bar, b.x, nloc, nx); b.st[0] = nloc; b.st[1] = nx; }
        const unsigned old = xb_add(&bar[XB_XSUB(b.x)], 1u);
        const unsigned gen = old / nloc;
        if (old + 1u == (gen + 1u) * nloc) {
            __builtin_amdgcn_fence(__ATOMIC_RELEASE, "agent");
            asm volatile("s_waitcnt vmcnt(0)" ::: "memory");
            const unsigned og = xb_add(&bar[XB_TOP], 1u);
            const unsigned tg = og / nx;
            if (og + 1u == (tg + 1u) * nx) xb_add(&bar[XB_TOPGEN], 1u);
            else XB_SPIN(xb_ld(&bar[XB_TOPGEN]) == tg, bar);
            __builtin_amdgcn_fence(__ATOMIC_ACQUIRE, "agent");
            xb_add(&bar[XB_XGEN(b.x)], 1u);
            asm volatile("s_waitcnt vmcnt(0)" ::: "memory");
        } else {
            XB_SPIN(xb_ld(&bar[XB_XGEN(b.x)]) == gen, bar);
            __builtin_amdgcn_fence(__ATOMIC_ACQUIRE, "agent");
            asm volatile("s_waitcnt vmcnt(0)" ::: "memory");
        }
    }
    __syncthreads();
}

}

namespace mk {
constexpr int NWAVES = 8, NTHREADS = 512;
constexpr size_t MiB = 1u << 20;
constexpr size_t WS_QIB = 325 * MiB, WS_KB = 342 * MiB, WS_VB = 351 * MiB, WS_KIB = 360 * MiB, WS_WIF = 363 * MiB;
constexpr size_t WS_OB = 390 * MiB, WS_GD = 423 * MiB;
constexpr size_t WS_IDX = 525 * MiB, WS_CNT = 542 * MiB, WS_SCS = 543 * MiB;
constexpr size_t WS_S = 548 * MiB;
constexpr size_t WS_SC = WS_S;
constexpr size_t WS_Z = WS_S, WS_H1F = WS_S + 65 * MiB, WS_H1B = WS_S + 130 * MiB, WS_PQB = WS_S + 163 * MiB, WS_H2F = WS_S + 228 * MiB, WS_H2B = WS_S + 293 * MiB;
constexpr size_t WS_GQ = WS_S + 326 * MiB, WS_GK = WS_S + 343 * MiB, WS_GV = WS_S + 360 * MiB, WS_GR = WS_S + 393 * MiB, WS_QT = WS_S + 426 * MiB, WS_DEC = WS_S + 442 * MiB,
                 WS_OGB = WS_S + 443 * MiB, WS_KT = WS_S + 476 * MiB;
constexpr size_t WS_DS = WS_S, WS_SPREV = WS_S + 128 * MiB;
constexpr size_t WS_CTL = 1060 * MiB, WS_WA = 1061 * MiB, WS_WO = 1066 * MiB, WS_WG = 1068 * MiB, WS_WGO = 1075 * MiB, WS_WPQ = 1077 * MiB, WS_PK = 1085 * MiB,
                 WS_UB = 1086 * MiB, WS_VBX = 1150 * MiB, WS_USC = 1118 * MiB, WS_TEID = 1120 * MiB, WS_TGATE = 1125 * MiB, WS_HD = 1134 * MiB, WS_KV8 = 1134 * MiB, WS_XB = 1214 * MiB, WS_QB = 1247 * MiB, WS_END = 1280 * MiB;
constexpr size_t CTL_ZERO_BYTES = 1 * MiB;
constexpr int CW_TMO = 0, CW_AMAXK = 256, CW_AMAXV = 320, CW_Q1 = 512, CW_XC = 1024, CW_BAR = 4096;
constexpr int WA_ROWS = 2176, WG_ROWS = 3104;
constexpr int GN_Q = 0, GN_K = 512, GN_V = 1024, GN_R = 2048, GN_GD = 3072;

constexpr int RING_BYTES = 131072, LDSCTL_OFF = RING_BYTES, MISC_OFF = LDSCTL_OFF + 320, INPTAB_OFF = LDSCTL_OFF + 512, LDS_BYTES = 147456;

typedef unsigned u32x4 __attribute__((ext_vector_type(4)));
typedef unsigned u32x2 __attribute__((ext_vector_type(2)));
#define MK_LAS __attribute__((address_space(3)))
__device__ __forceinline__ float bflo(unsigned w) { return __builtin_bit_cast(float, w << 16); }
__device__ __forceinline__ float bfhi(unsigned w) { return __builtin_bit_cast(float, w & 0xffff0000u); }
__device__ __forceinline__ float bf2f(unsigned short b) { return __builtin_bit_cast(float, (unsigned)b << 16); }
__device__ __forceinline__ u32x4 pack8(f32x4 a, f32x4 b) { u32x4 w; w.x = pk2(a[0], a[1]); w.y = pk2(a[2], a[3]); w.z = pk2(b[0], b[1]); w.w = pk2(b[2], b[3]); return w; }

#define TPB(k)
#define TPE(k)
template <int NCT> __device__ __forceinline__ void skinny_tile(const bf16* __restrict__ A, int lda, const bf16* __restrict__ Bt, int K, int row0, int col0, f32x4 (&acc)[NCT], int lane) {
    const int fr = lane & 15, fq = lane >> 4;
    const bf16* ap = A + (size_t)(row0 + fr) * lda + fq * 8;
    const bf16* bp = Bt + (size_t)(col0 + fr) * K + fq * 8;
#pragma unroll
    for (int ct = 0; ct < NCT; ++ct) acc[ct] = (f32x4){0.f, 0.f, 0.f, 0.f};
#pragma unroll 1
    for (int k0 = 0; k0 < K; k0 += 128) {
        bf16x8 a[4], b[NCT][4];
#pragma unroll
        for (int j = 0; j < 4; ++j) a[j] = *(const bf16x8*)(ap + k0 + j * 32);
#pragma unroll
        for (int ct = 0; ct < NCT; ++ct)
#pragma unroll
            for (int j = 0; j < 4; ++j) b[ct][j] = *(const bf16x8*)(bp + (size_t)ct * 16 * K + k0 + j * 32);
        asm volatile("" ::: "memory");
#pragma unroll
        for (int ct = 0; ct < NCT; ++ct)
#pragma unroll
            for (int j = 0; j < 4; ++j) acc[ct] = __builtin_amdgcn_mfma_f32_16x16x32_bf16(b[ct][j], a[j], acc[ct], 0, 0, 0);
    }
}

__device__ __forceinline__ void p0_transpose_item(const float* __restrict__ W, int ldw, int K, bf16* __restrict__ WT, int dst_row0, int src_col0, int nvalid, int k0, MK_LAS float* scr, int lane) {
#pragma unroll 8
    for (int i = 0; i < 32; ++i) { const int kk = 2 * i + (lane >> 5), j = lane & 31; scr[kk * 33 + j] = j < nvalid ? W[(size_t)(k0 + kk) * ldw + src_col0 + j] : 0.f; }
    asm volatile("s_waitcnt lgkmcnt(0)" ::: "memory");
    const int c = lane & 7;
#pragma unroll
    for (int j = 0; j < 4; ++j) { const int n = (lane >> 3) + 8 * j; const MK_LAS float* s = scr + (8 * c) * 33 + n;
        u32x4 o; o.x = pk2(s[0 * 33], s[1 * 33]); o.y = pk2(s[2 * 33], s[3 * 33]); o.z = pk2(s[4 * 33], s[5 * 33]); o.w = pk2(s[6 * 33], s[7 * 33]);
        *(u32x4*)(WT + (size_t)(dst_row0 + n) * K + k0 + 8 * c) = o; }
    asm volatile("s_waitcnt lgkmcnt(0)" ::: "memory");
}
__device__ __forceinline__ void p0_convert(const float* __restrict__ src, bf16* __restrict__ dst, size_t n8, int gw, int ngw, int lane) {
    for (size_t i = (size_t)gw * 64 + lane; i < n8; i += (size_t)ngw * 64) {
        const f32x4 a = *(const f32x4*)(src + i * 8), b = *(const f32x4*)(src + i * 8 + 4);
        *(u32x4*)(dst + i * 8) = pack8(a, b);
    }
}

__device__ __forceinline__ void p0_quant_row(const float* __restrict__ src, unsigned char* __restrict__ dst, float* __restrict__ scale, int lane) {
    f32x4 v[4]; float am = 0.f;
#pragma unroll
    for (int q = 0; q < 4; ++q) { v[q] = *(const f32x4*)(src + lane * 16 + q * 4); am = fmaxf(am, fmaxf(fmaxf(fabsf(v[q][0]), fabsf(v[q][1])), fmaxf(fabsf(v[q][2]), fabsf(v[q][3])))); }
#pragma unroll
    for (int o = 1; o < 64; o <<= 1) am = fmaxf(am, __shfl_xor(am, o));
    const float inv = am > 0.f ? 448.f / am : 0.f;
    u32x4 w;
#pragma unroll
    for (int q = 0; q < 4; ++q) { int x = __builtin_amdgcn_cvt_pk_fp8_f32(v[q][0] * inv, v[q][1] * inv, 0, false); x = __builtin_amdgcn_cvt_pk_fp8_f32(v[q][2] * inv, v[q][3] * inv, x, true); w[q] = (unsigned)x; }
    *(u32x4*)(dst + lane * 16) = w;
    if (lane == 0) *scale = am * (1.f / 448.f);
}

__device__ __forceinline__ void p0_quant_rows4(const float* __restrict__ src, unsigned char* __restrict__ dst, float* __restrict__ scale, int lane) {
    f32x4 v[4][4]; float am[4];
#pragma unroll
    for (int r = 0; r < 4; ++r)
#pragma unroll
        for (int q = 0; q < 4; ++q) v[r][q] = *(const f32x4*)(src + (size_t)r * D + lane * 16 + q * 4);
#pragma unroll
    for (int r = 0; r < 4; ++r) { float a = 0.f;
#pragma unroll
        for (int q = 0; q < 4; ++q) a = fmaxf(a, fmaxf(fmaxf(fabsf(v[r][q][0]), fabsf(v[r][q][1])), fmaxf(fabsf(v[r][q][2]), fabsf(v[r][q][3]))));
        am[r] = a; }
#pragma unroll
    for (int o = 1; o < 64; o <<= 1) {
#pragma unroll
        for (int r = 0; r < 4; ++r) am[r] = fmaxf(am[r], __shfl_xor(am[r], o)); }
#pragma unroll
    for (int r = 0; r < 4; ++r) {
        const float inv = am[r] > 0.f ? 448.f / am[r] : 0.f;
        u32x4 w;
#pragma unroll
        for (int q = 0; q < 4; ++q) { int x = __builtin_amdgcn_cvt_pk_fp8_f32(v[r][q][0] * inv, v[r][q][1] * inv, 0, false); x = __builtin_amdgcn_cvt_pk_fp8_f32(v[r][q][2] * inv, v[r][q][3] * inv, x, true); w[q] = (unsigned)x; }
        *(u32x4*)(dst + (size_t)r * D + lane * 16) = w;
        if (lane == 0) scale[r] = am[r] * (1.f / 448.f);
    }
}

struct FAttnIn {
    bf16 *Qb, *Kb, *Vb, *QIb, *KIb; float* WIf; float* out;
    mutable float kmax = 0.f, vmax = 0.f;
    __device__ __forceinline__ static float amax8(f32x4 a, f32x4 b) { return fmaxf(fmaxf(fmaxf(fabsf(a[0]), fabsf(a[1])), fmaxf(fabsf(a[2]), fabsf(a[3]))), fmaxf(fmaxf(fabsf(b[0]), fabsf(b[1])), fmaxf(fabsf(b[2]), fabsf(b[3])))); }
    __device__ __forceinline__ float* okp(int row, size_t offp, size_t offs, int ld) const { return row < TP ? out + offp + (size_t)row * ld : out + offs + (size_t)(row - TP) * ld; }
    __device__ __forceinline__ void put8(int row, int col, f32x4 v0, f32x4 v1) const {
        const u32x4 w = pack8(v0, v1);
        if (col < AK) *(u32x4*)(Qb + (size_t)row * 1024 + col) = w;
        else if (col < AV) { *(u32x4*)(Kb + (size_t)row * 256 + (col - AK)) = w; float* o = okp(row, OUT_KP, OUT_KS, 256) + (col - AK); *(f32x4*)o = v0; *(f32x4*)(o + 4) = v1; kmax = fmaxf(kmax, amax8(v0, v1)); }
        else if (col < AQI) { *(u32x4*)(Vb + (size_t)row * 256 + (col - AV)) = w; float* o = okp(row, OUT_VP, OUT_VS, 256) + (col - AV); *(f32x4*)o = v0; *(f32x4*)(o + 4) = v1; vmax = fmaxf(vmax, amax8(v0, v1)); }
        else *(u32x4*)(QIb + (size_t)row * 512 + (col - AQI)) = w;
    }
    __device__ __forceinline__ void put4(int row, int col, f32x4 v) const {
        u32x2 w; w.x = pk2(v[0], v[1]); w.y = pk2(v[2], v[3]);
        if (col < AK) *(u32x2*)(Qb + (size_t)row * 1024 + col) = w;
        else if (col < AV) { *(u32x2*)(Kb + (size_t)row * 256 + (col - AK)) = w; *(f32x4*)(okp(row, OUT_KP, OUT_KS, 256) + (col - AK)) = v; }
        else if (col < AQI) { *(u32x2*)(Vb + (size_t)row * 256 + (col - AV)) = w; *(f32x4*)(okp(row, OUT_VP, OUT_VS, 256) + (col - AV)) = v; }
        else if (col < AKI) *(u32x2*)(QIb + (size_t)row * 512 + (col - AQI)) = w;
        else if (col < AWI) { *(u32x2*)(KIb + (size_t)row * 64 + (col - AKI)) = w; *(f32x4*)(okp(row, OUT_KIP, OUT_KIS, 64) + (col - AKI)) = v; }
        else if (col < ATT_N) *(f32x4*)(WIf + (size_t)row * 8 + (col - AWI)) = v * 0.04419417382415922f;
    }
};
}

namespace mk {
typedef float f32x2v __attribute__((ext_vector_type(2)));
typedef float f32x16 __attribute__((ext_vector_type(16)));
typedef short s16x4 __attribute__((ext_vector_type(4)));
typedef short v4i16_t __attribute__((ext_vector_type(4)));

__device__ __forceinline__ void score_load_q(const bf16* __restrict__ QIb, const float* __restrict__ WIf, size_t tok0, int lane, bf16x8 (&afr)[4], f32x4 (&w4)[4]) {
    const int r = lane & 31, kq = lane >> 5;
    const bf16* ap = QIb + (tok0 + (r >> 3)) * 512 + (r & 7) * 64 + kq * 8;
#pragma unroll
    for (int ks = 0; ks < 4; ++ks) afr[ks] = *(const bf16x8*)(ap + ks * 16);
#pragma unroll
    for (int ql = 0; ql < 4; ++ql) w4[ql] = *(const f32x4*)(WIf + (tok0 + ql) * 8 + 4 * kq);
}
__device__ __forceinline__ void score_tile(const bf16x8 (&afr)[4], const bf16x8 (&bfr)[4], const f32x4 (&w4)[4], float (&s)[4]) {
    f32x16 acc;
#pragma unroll
    for (int j = 0; j < 16; ++j) acc[j] = 0.f;
#pragma unroll
    for (int ks = 0; ks < 4; ++ks) acc = __builtin_amdgcn_mfma_f32_32x32x16_bf16(afr[ks], bfr[ks], acc, 0, 0, 0);
#pragma unroll
    for (int ql = 0; ql < 4; ++ql) {
        float p = 0.f;
#pragma unroll
        for (int jj = 0; jj < 4; ++jj) p = fmaf(fmaxf(acc[ql * 4 + jj], 0.f), w4[ql][jj], p);
        s[ql] = p + __shfl_xor(p, 32);
    }
}

__device__ __forceinline__ void quant_issue(const float* __restrict__ src, f32x4 (&v)[4], int lane) {
#pragma unroll
    for (int q = 0; q < 4; ++q) v[q] = *(const f32x4*)(src + lane * 16 + q * 4);
}
#ifndef PEER_BITS
#define PEER_BITS 4
#endif
#ifndef PEER_AMAX4
#define PEER_AMAX4 6.0f
#endif
constexpr int PEER_RB = PEER_BITS * 128;
#if PEER_BITS == 4
__device__ __forceinline__ unsigned enc_e2m1(float x) {
    const float a = fabsf(x);
    const float c = a < 2.f ? rintf(a * 2.f) : (a < 4.f ? rintf(a) + 2.f : fminf(rintf(a * 0.5f) + 4.f, 7.f));
    return (unsigned)c | (x < 0.f ? 8u : 0u);
}
__device__ __forceinline__ void quant_finish(const f32x4 (&v)[4], unsigned char* __restrict__ dst, float* __restrict__ scale, int lane) {
    float am = 0.f;
#pragma unroll
    for (int q = 0; q < 4; ++q) am = fmaxf(am, fmaxf(fmaxf(fabsf(v[q][0]), fabsf(v[q][1])), fmaxf(fabsf(v[q][2]), fabsf(v[q][3]))));
#pragma unroll
    for (int o = 1; o < 64; o <<= 1) am = fmaxf(am, __shfl_xor(am, o));
    const float inv = am > 0.f ? PEER_AMAX4 / am : 0.f;
    u32x2 w; w.x = 0u; w.y = 0u;
#pragma unroll
    for (int i = 0; i < 8; ++i) { w.x |= enc_e2m1(v[i >> 2][i & 3] * inv) << (4 * i); w.y |= enc_e2m1(v[2 + (i >> 2)][i & 3] * inv) << (4 * i); }
    *(u32x2*)(dst + lane * 8) = w;
    if (lane == 0) *scale = am * (1.f / PEER_AMAX4);
}
#elif PEER_BITS == 6
__device__ __forceinline__ unsigned enc_e2m3(float x) {
    const float a = fabsf(x), q = a * 8.f;
    const float c = a < 2.f ? rintf(q) : (a < 4.f ? rintf(q * 0.5f) + 8.f : fminf(rintf(q * 0.25f) + 16.f, 31.f));
    return (unsigned)c | (x < 0.f ? 32u : 0u);
}
__device__ __forceinline__ void quant_finish(const f32x4 (&v)[4], unsigned char* __restrict__ dst, float* __restrict__ scale, int lane) {
    float am = 0.f;
#pragma unroll
    for (int q = 0; q < 4; ++q) am = fmaxf(am, fmaxf(fmaxf(fabsf(v[q][0]), fabsf(v[q][1])), fmaxf(fabsf(v[q][2]), fabsf(v[q][3]))));
#pragma unroll
    for (int o = 1; o < 64; o <<= 1) am = fmaxf(am, __shfl_xor(am, o));
    const float inv = am > 0.f ? 7.5f / am : 0.f;
    unsigned long long lo = 0ull, hi = 0ull;
#pragma unroll
    for (int i = 0; i < 16; ++i) {
        const unsigned long long c = enc_e2m3(v[i >> 2][i & 3] * inv);
        if (i < 10) lo |= c << (6 * i);
        else if (i == 10) { lo |= (c & 15ull) << 60; hi |= c >> 4; }
        else hi |= c << (6 * (i - 11) + 2);
    }
    unsigned* d = (unsigned*)(dst + lane * 12);
    d[0] = (unsigned)lo; d[1] = (unsigned)(lo >> 32); d[2] = (unsigned)hi;
    if (lane == 0) *scale = am * (1.f / 7.5f);
}
#else
__device__ __forceinline__ void quant_finish(const f32x4 (&v)[4], unsigned char* __restrict__ dst, float* __restrict__ scale, int lane) {
    float am = 0.f;
#pragma unroll
    for (int q = 0; q < 4; ++q) am = fmaxf(am, fmaxf(fmaxf(fabsf(v[q][0]), fabsf(v[q][1])), fmaxf(fabsf(v[q][2]), fabsf(v[q][3]))));
#pragma unroll
    for (int o = 1; o < 64; o <<= 1) am = fmaxf(am, __shfl_xor(am, o));
    const float inv = am > 0.f ? 448.f / am : 0.f;
    u32x4 w;
#pragma unroll
    for (int q = 0; q < 4; ++q) { int x = __builtin_amdgcn_cvt_pk_fp8_f32(v[q][0] * inv, v[q][1] * inv, 0, false); x = __builtin_amdgcn_cvt_pk_fp8_f32(v[q][2] * inv, v[q][3] * inv, x, true); w[q] = (unsigned)x; }
    *(u32x4*)(dst + lane * 16) = w;
    if (lane == 0) *scale = am * (1.f / 448.f);
}
#endif
struct QuantTabs { const float* pu; const float* pv; unsigned char* uq; unsigned char* vq; float* us; float* vs;
    __device__ __forceinline__ const float* src(int r) const { return r < 2 * 16384 ? pu + (size_t)r * D : pv + (size_t)(r - 2 * 16384) * D; }
    __device__ __forceinline__ unsigned char* dst(int r) const { return r < 2 * 16384 ? uq + (size_t)r * PEER_RB : vq + (size_t)(r - 2 * 16384) * PEER_RB; }
    __device__ __forceinline__ float* sc(int r) const { return r < 2 * 16384 ? us + r : vs + (r - 2 * 16384); } };

__device__ __forceinline__ void phase_score(const bf16* __restrict__ QIb, const bf16* __restrict__ KIb, const float* __restrict__ WIf, const float* __restrict__ cache_ki, const int* __restrict__ page_table,
                                            float* __restrict__ SC, float* __restrict__ SCS, const QuantTabs QT_, LAS unsigned char* lds, int vcu, int G, int wave, int lane, int gw, int NGW) {
    const int c = lane & 31, kq = lane >> 5;
    int qrow = gw;
    constexpr int KST = 144, KBUF = 256 * KST;
    const int tid = wave * 64 + lane;
    for (int it = vcu; it < 512; it += G) {
        const int b = it >> 8, qt = b == 0 ? (it & 255) : 255 - (it & 255);
        const size_t tok0 = (size_t)b * SEQ + qt * 32 + wave * 4;
        bf16x8 afr[4]; f32x4 w4[4];
        score_load_q(QIb, WIf, tok0, lane, afr, w4);
        const int nc = (qt >> 3) + 1;
        const bf16* kbase = KIb + (size_t)b * SEQ * 64;
        u32x4 st[4];
#pragma unroll
        for (int i = 0; i < 4; ++i) { const int p = tid + i * 512; st[i] = *(const u32x4*)(kbase + (size_t)(p >> 3) * 64 + (p & 7) * 8); }
#pragma unroll
        for (int i = 0; i < 4; ++i) { const int p = tid + i * 512; *(LAS u32x4*)(lds + (p >> 3) * KST + (p & 7) * 16) = st[i]; }
        __syncthreads();
        for (int ch = 0; ch < nc; ++ch) {
            const bool more = ch + 1 < nc;
            f32x4 qv[4]; const bool qdo = qrow < 4 * 16384;
            if (qdo) quant_issue(QT_.src(qrow), qv, lane);
            if (more) {
#pragma unroll
                for (int i = 0; i < 4; ++i) { const int p = tid + i * 512; st[i] = *(const u32x4*)(kbase + ((size_t)(ch + 1) * 256 + (p >> 3)) * 64 + (p & 7) * 8); }
            }
            LAS unsigned char* kb = lds + (ch & 1) * KBUF;
            const int ntile = more ? 8 : (qt & 7) + 1;
            for (int kt8 = 0; kt8 < ntile; ++kt8) {
                bf16x8 bfr[4];
#pragma unroll
                for (int ks = 0; ks < 4; ++ks) bfr[ks] = *(LAS bf16x8*)(kb + (kt8 * 32 + c) * KST + ks * 32 + kq * 16);
                float sv[4]; score_tile(afr, bfr, w4, sv);
                float* o = SC + (tok0 + 2 * kq) * SEQ + (ch * 8 + kt8) * 32 + c;
                o[0] = kq ? sv[2] : sv[0]; o[SEQ] = kq ? sv[3] : sv[1];
            }
            if (qdo) { quant_finish(qv, QT_.dst(qrow), QT_.sc(qrow), lane); qrow += NGW; }
            if (more) {
                LAS unsigned char* nb = lds + ((ch + 1) & 1) * KBUF;
#pragma unroll
                for (int i = 0; i < 4; ++i) { const int p = tid + i * 512; *(LAS u32x4*)(nb + (p >> 3) * KST + (p & 7) * 16) = st[i]; }
            }
            __syncthreads();
        }
    }
    for (; qrow < 4 * 16384; qrow += NGW) { f32x4 qv[4]; quant_issue(QT_.src(qrow), qv, lane); quant_finish(qv, QT_.dst(qrow), QT_.sc(qrow), lane); }
    for (int it = gw; it < DB * NPAGES + DB; it += NGW) {
        const bool isnew = it >= DB * NPAGES;
        const int b = isnew ? it - DB * NPAGES : it / NPAGES, pg = isnew ? 0 : it % NPAGES;
        const size_t tok0 = (size_t)TP + b * DS;
        bf16x8 afr[4]; f32x4 w4[4];
        score_load_q(QIb, WIf, tok0, lane, afr, w4);
        if (!isnew) {
            const int phys = page_table[b * NPAGES + pg];
            for (int j = 0; j < 4; ++j) {
                const float* kp = cache_ki + ((size_t)phys * PAGE + j * 32 + c) * 64 + kq * 8;
                bf16x8 bfr[4];
#pragma unroll
                for (int ks = 0; ks < 4; ++ks) { const f32x4 x0 = *(const f32x4*)(kp + ks * 16), x1 = *(const f32x4*)(kp + ks * 16 + 4); const u32x4 w = pack8(x0, x1); bfr[ks] = __builtin_bit_cast(bf16x8, w); }
                float s[4]; score_tile(afr, bfr, w4, s);
                float* o = SCS + (size_t)(b * DS + 2 * kq) * SCS_LD + pg * PAGE + j * 32 + c;
                o[0] = kq ? s[2] : s[0]; o[SCS_LD] = kq ? s[3] : s[1];
            }
        } else {
            const bf16* kp = KIb + (tok0 + (c & 3)) * 64 + kq * 8;
            bf16x8 bfr[4];
#pragma unroll
            for (int ks = 0; ks < 4; ++ks) bfr[ks] = *(const bf16x8*)(kp + ks * 16);
            float s[4]; score_tile(afr, bfr, w4, s);
            if (c < 4) { float* o = SCS + (size_t)(b * DS + 2 * kq) * SCS_LD + PAST + c; o[0] = kq ? s[2] : s[0]; o[SCS_LD] = kq ? s[3] : s[1]; }
        }
    }
}

constexpr int VST = 144;
__device__ __forceinline__ bf16x8 ld_frag8(const bf16* p) { return *(const bf16x8*)p; }
__device__ __forceinline__ bf16x8 ld_frag8(const float* p) { const f32x4 a = *(const f32x4*)p, b = *(const f32x4*)(p + 4); const u32x4 w = pack8(a, b); return __builtin_bit_cast(bf16x8, w); }
__device__ __forceinline__ s16x4 lds_tr(LAS unsigned char* p) { return __builtin_bit_cast(s16x4, __builtin_amdgcn_ds_read_tr16_b64_v4i16((LAS v4i16_t*)p)); }

template <bool SAMPLE>
__device__ __forceinline__ void attn_row(int row, int n0, int n1, const bf16* __restrict__ Qb, const int* __restrict__ IDX, const int* __restrict__ CNT,
                                         const bf16* __restrict__ Kb, const bf16* __restrict__ Vb, const float* __restrict__ cache_k, const float* __restrict__ cache_v,
                                         const float* __restrict__ newk, const float* __restrict__ newv, const int* __restrict__ page_table,
                                         bf16* __restrict__ Ob, LAS unsigned char* wl, int lane) {
    const int fr = lane & 15, fq = lane >> 4;
    LAS int* rid = (LAS int*)wl;
    LAS unsigned char* vt = wl + 1024;
    const int cnt = CNT[row];
    const int b = SAMPLE ? (row - TP) / DS : row / SEQ;
#pragma unroll
    for (int i = 0; i < 4; ++i) { const int slot = i * 64 + lane; int key = slot < cnt ? IDX[(size_t)row * TOPK + slot] : 0; int id;
        if (!SAMPLE) id = b * SEQ + key;
        else if (key < PAST) id = page_table[b * NPAGES + key / PAGE] * PAGE + (key % PAGE);
        else id = (int)0x80000000 | (b * DS + (key - PAST));
        rid[slot] = id; }
    asm volatile("s_waitcnt lgkmcnt(0)" ::: "memory");
    for (int n = n0; n < n1; ++n) {
        bf16x8 qf[2];
#pragma unroll
        for (int ks = 0; ks < 2; ++ks) qf[ks] = *(const bf16x8*)(Qb + (size_t)row * 1024 + (n * 4 + (fr & 3)) * 64 + ks * 32 + fq * 8);
        f32x4 st[16];
        constexpr int TBN = SAMPLE ? 4 : 8;
#pragma unroll
        for (int tb = 0; tb < 16 / TBN; ++tb) {
            bf16x8 kf[TBN][2];
#pragma unroll
            for (int t = 0; t < TBN; ++t) {
                const int id = rid[(tb * TBN + t) * 16 + fr];
                if (!SAMPLE) { const bf16* kp = Kb + (size_t)id * 256 + n * 64 + fq * 8; kf[t][0] = ld_frag8(kp); kf[t][1] = ld_frag8(kp + 32); }
                else { const float* kp = (id < 0 ? newk + (size_t)(id & 0x7fffffff) * 256 : cache_k + (size_t)id * 256) + n * 64 + fq * 8; kf[t][0] = ld_frag8(kp); kf[t][1] = ld_frag8(kp + 32); }
            }
#pragma unroll
            for (int t = 0; t < TBN; ++t) {
                f32x4 a = (f32x4){0.f, 0.f, 0.f, 0.f};
                a = __builtin_amdgcn_mfma_f32_16x16x32_bf16(kf[t][0], qf[0], a, 0, 0, 0);
                a = __builtin_amdgcn_mfma_f32_16x16x32_bf16(kf[t][1], qf[1], a, 0, 0, 0);
                st[tb * TBN + t] = a;
            }
            asm volatile("" ::: "memory");
        }
        bf16x8 vreg[8];
#define ATT_VLOAD(ch_) do { _Pragma("unroll") for (int i = 0; i < 8; ++i) { const int sl = i * 8 + (lane >> 3), chunk = lane & 7; const int id = rid[(ch_) * 64 + sl]; \
            if (!SAMPLE) vreg[i] = ld_frag8(Vb + (size_t)id * 256 + n * 64 + chunk * 8); \
            else vreg[i] = ld_frag8((id < 0 ? newv + (size_t)(id & 0x7fffffff) * 256 : cache_v + (size_t)id * 256) + n * 64 + chunk * 8); } } while (0)
        ATT_VLOAD(0);
        float mx = -INFINITY;
#pragma unroll
        for (int t = 0; t < 16; ++t)
#pragma unroll
            for (int j = 0; j < 4; ++j) { const int slot = t * 16 + fq * 4 + j; const float v = slot < cnt ? st[t][j] * 0.125f : -INFINITY; st[t][j] = v; mx = fmaxf(mx, v); }
        mx = fmaxf(mx, __shfl_xor(mx, 16)); mx = fmaxf(mx, __shfl_xor(mx, 32));
        float sum = 0.f;
#pragma unroll
        for (int t = 0; t < 16; ++t)
#pragma unroll
            for (int j = 0; j < 4; ++j) { const float e = __expf(st[t][j] - mx); st[t][j] = e; sum += e; }
        sum += __shfl_xor(sum, 16); sum += __shfl_xor(sum, 32);
        f32x4 oacc[4];
#pragma unroll
        for (int dt = 0; dt < 4; ++dt) oacc[dt] = (f32x4){0.f, 0.f, 0.f, 0.f};
#pragma unroll
        for (int ch = 0; ch < 4; ++ch) {
#pragma unroll
            for (int i = 0; i < 8; ++i) { const int sl = i * 8 + (lane >> 3), chunk = lane & 7; *(LAS bf16x8*)(vt + sl * VST + chunk * 16) = vreg[i]; }
            asm volatile("s_waitcnt lgkmcnt(0)" ::: "memory");
            if (ch < 3) ATT_VLOAD(ch + 1);
#pragma unroll
            for (int s2 = 0; s2 < 2; ++s2) {
                const int t0 = ch * 4 + s2 * 2;
                const u32x4 pw = pack8(st[t0], st[t0 + 1]);
                const bf16x8 pf = __builtin_bit_cast(bf16x8, pw);
#pragma unroll
                for (int dt = 0; dt < 4; ++dt) {
                    LAS unsigned char* a0 = vt + (s2 * 32 + fq * 4 + (fr >> 2)) * VST + (dt * 16 + 4 * (fr & 3)) * 2;
                    const s16x4 v0 = lds_tr(a0), v1 = lds_tr(a0 + 16 * VST);
                    bf16x8 vf; vf[0] = v0[0]; vf[1] = v0[1]; vf[2] = v0[2]; vf[3] = v0[3]; vf[4] = v1[0]; vf[5] = v1[1]; vf[6] = v1[2]; vf[7] = v1[3];
                    oacc[dt] = __builtin_amdgcn_mfma_f32_16x16x32_bf16(pf, vf, oacc[dt], 0, 0, 0);
                }
            }
            asm volatile("s_waitcnt lgkmcnt(0)" ::: "memory");
        }
#undef ATT_VLOAD
        const float i0 = 1.f / __shfl(sum, 0), i1 = 1.f / __shfl(sum, 1), i2 = 1.f / __shfl(sum, 2), i3 = 1.f / __shfl(sum, 3);
        if (fq == 0) {
#pragma unroll
            for (int dt = 0; dt < 4; ++dt) {
                bf16* o = Ob + (size_t)row * 1024 + (n * 4) * 64 + dt * 16 + fr;
                o[0] = (bf16)f2bf(oacc[dt][0] * i0); o[64] = (bf16)f2bf(oacc[dt][1] * i1); o[128] = (bf16)f2bf(oacc[dt][2] * i2); o[192] = (bf16)f2bf(oacc[dt][3] * i3);
            }
        }
    }
    asm volatile("s_waitcnt lgkmcnt(0)" ::: "memory");
}

__device__ __forceinline__ void kv8_convert(const bf16* __restrict__ Kb, const bf16* __restrict__ Vb, unsigned char* __restrict__ KV8_, const unsigned* __restrict__ amaxk, const unsigned* __restrict__ amaxv, int gw, int NGW, int lane) {
    const float ak = __builtin_bit_cast(float, __hip_atomic_load(amaxk, __ATOMIC_RELAXED, __HIP_MEMORY_SCOPE_AGENT)), av = __builtin_bit_cast(float, __hip_atomic_load(amaxv, __ATOMIC_RELAXED, __HIP_MEMORY_SCOPE_AGENT));
    const bool isv = lane >= 32; const int l = lane & 31;
    const float sc = isv ? (av > 0.f ? 448.f / av : 0.f) : (ak > 0.f ? 448.f / ak : 0.f);
    for (int t = gw; t < TP; t += NGW) {
        const u32x4 w = *(const u32x4*)((isv ? Vb : Kb) + (size_t)t * 256 + l * 8);
        const float x0 = bflo(w.x) * sc, x1 = bfhi(w.x) * sc, x2 = bflo(w.y) * sc, x3 = bfhi(w.y) * sc, x4 = bflo(w.z) * sc, x5 = bfhi(w.z) * sc, x6 = bflo(w.w) * sc, x7 = bfhi(w.w) * sc;
        int p0 = __builtin_amdgcn_cvt_pk_fp8_f32(x0, x1, 0, false); p0 = __builtin_amdgcn_cvt_pk_fp8_f32(x2, x3, p0, true);
        int p1 = __builtin_amdgcn_cvt_pk_fp8_f32(x4, x5, 0, false); p1 = __builtin_amdgcn_cvt_pk_fp8_f32(x6, x7, p1, true);
        const int n = l >> 3, d0 = (l & 7) * 8;
        const int pos = isv ? 64 + d0 : ((d0 & 31) >> 3) * 16 + (d0 >> 5) * 8;
        u32x2 o; o.x = (unsigned)p0; o.y = (unsigned)p1;
        *(u32x2*)(KV8_ + (size_t)t * 512 + n * 128 + pos) = o;
    }
}
__device__ __forceinline__ void fp8x16_to_bf16(const u32x4 q, bf16x8& lo, bf16x8& hi) {
    u32x4 a, b;
#pragma unroll
    for (int w = 0; w < 4; ++w) { const f32x2v f0 = __builtin_amdgcn_cvt_pk_f32_fp8((int)q[w], false), f1 = __builtin_amdgcn_cvt_pk_f32_fp8((int)q[w], true);
        const unsigned u0 = pk2(f0[0], f0[1]), u1 = pk2(f1[0], f1[1]);
        if (w < 2) { a[2 * w] = u0; a[2 * w + 1] = u1; } else { b[2 * w - 4] = u0; b[2 * w - 3] = u1; } }
    lo = __builtin_bit_cast(bf16x8, a); hi = __builtin_bit_cast(bf16x8, b);
}
#ifndef KF1
#define KF1 10
#endif
__device__ __forceinline__ void attn_prompt_stream(int b, int n, int q0, int qstep, const bf16* __restrict__ Qb, const int* __restrict__ IDX, const unsigned char* __restrict__ KV8_, const unsigned* __restrict__ amaxk, const unsigned* __restrict__ amaxv,
                                                   bf16* __restrict__ Ob, LAS unsigned char* wl, int lane) {
    const float ak_ = __builtin_bit_cast(float, __hip_atomic_load(amaxk, __ATOMIC_RELAXED, __HIP_MEMORY_SCOPE_AGENT)), av_ = __builtin_bit_cast(float, __hip_atomic_load(amaxv, __ATOMIC_RELAXED, __HIP_MEMORY_SCOPE_AGENT));
    const float kinv = ak_ * (1.f / 448.f), vinv = av_ * (1.f / 448.f);
    const int fr = lane & 15, fq = lane >> 4;
    LAS int* ridb = (LAS int*)wl;
    LAS unsigned char* vt = wl + 2048;
    if (q0 >= SEQ) return;
    int vx[4];
    { const int row = b * SEQ + q0, cnt = q0 + 1 < TOPK ? q0 + 1 : TOPK;
#pragma unroll
      for (int i = 0; i < 4; ++i) { const int slot = i * 64 + lane; ridb[slot] = b * SEQ + (slot < cnt ? IDX[(size_t)row * TOPK + slot] : 0); } }
    int buf = 0;

    for (int q = q0; q < SEQ; q += qstep, buf ^= 1) {

        const int row = b * SEQ + q, cnt = q + 1 < TOPK ? q + 1 : TOPK;
        LAS int* rid = ridb + buf * 256;
        asm volatile("s_waitcnt lgkmcnt(0)" ::: "memory");
        int kx[16];
#pragma unroll
        for (int t = 0; t < 16; ++t) kx[t] = rid[t * 16 + fr];
        bf16x8 qf[2];
#pragma unroll
        for (int ks = 0; ks < 2; ++ks) qf[ks] = *(const bf16x8*)(Qb + (size_t)row * 1024 + (n * 4 + (fr & 3)) * 64 + ks * 32 + fq * 8);
        u32x4 kraw[16];
#pragma unroll
        for (int t = 0; t < 16; ++t) kraw[t] = *(const u32x4*)(KV8_ + (size_t)kx[t] * 512 + n * 128 + fq * 16);
        asm volatile("s_waitcnt lgkmcnt(0)" ::: "memory");
        u32x4 vraw[4];
#define ATT_VLOAD2(ch_) do { _Pragma("unroll") for (int i = 0; i < 4; ++i) { const int sl = i * 16 + (lane >> 2), piece = lane & 3; const int id = rid[(ch_) * 64 + sl]; \
            vraw[i] = *(const u32x4*)(KV8_ + (size_t)id * 512 + n * 128 + 64 + piece * 16); } } while (0)
        f32x4 st[16];
#pragma unroll
        for (int t = 0; t < 16; ++t) {
            asm volatile("" : "+v"(kraw[t][0]), "+v"(kraw[t][1]), "+v"(kraw[t][2]), "+v"(kraw[t][3]));
            bf16x8 k0, k1; fp8x16_to_bf16(kraw[t], k0, k1);
            f32x4 a = (f32x4){0.f, 0.f, 0.f, 0.f};
            a = __builtin_amdgcn_mfma_f32_16x16x32_bf16(k0, qf[0], a, 0, 0, 0);
            a = __builtin_amdgcn_mfma_f32_16x16x32_bf16(k1, qf[1], a, 0, 0, 0);
            st[t] = a;
            asm volatile("" : "+v"(st[t][0]), "+v"(st[t][1]), "+v"(st[t][2]), "+v"(st[t][3]));
        }

        const int qn = q + qstep;
        if (qn < SEQ) { const int rown = b * SEQ + qn, cntn = qn + 1 < TOPK ? qn + 1 : TOPK;
#pragma unroll
            for (int i = 0; i < 4; ++i) { const int slot = i * 64 + lane; vx[i] = slot < cntn ? IDX[(size_t)rown * TOPK + slot] : 0; } }
        ATT_VLOAD2(0);
        float mx = -INFINITY;
        if (cnt < TOPK) {
#pragma unroll
            for (int t = 0; t < 16; ++t)
#pragma unroll
                for (int j = 0; j < 4; ++j) { const int slot = t * 16 + fq * 4 + j; st[t][j] = slot < cnt ? st[t][j] : -INFINITY; }
        }
#pragma unroll
        for (int t = 0; t < 16; ++t) mx = fmaxf(mx, fmaxf(fmaxf(st[t][0], st[t][1]), fmaxf(st[t][2], st[t][3])));
        mx = fmaxf(mx, __shfl_xor(mx, 16)); mx = fmaxf(mx, __shfl_xor(mx, 32));
        const float cs = 0.18033688011112042f * kinv, mb = -mx * cs;
        float sum = 0.f;
#pragma unroll
        for (int t = 0; t < 16; ++t)
#pragma unroll
            for (int j = 0; j < 4; ++j) { const float e = __builtin_amdgcn_exp2f(fmaf(st[t][j], cs, mb)); st[t][j] = e; sum += e; }
        sum += __shfl_xor(sum, 16); sum += __shfl_xor(sum, 32);

        f32x4 oacc[4];
#pragma unroll
        for (int dt = 0; dt < 4; ++dt) oacc[dt] = (f32x4){0.f, 0.f, 0.f, 0.f};
#pragma unroll
        for (int ch = 0; ch < 4; ++ch) {
#pragma unroll
            for (int i = 0; i < 4; ++i) { const int sl = i * 16 + (lane >> 2), piece = lane & 3; bf16x8 v0, v1; fp8x16_to_bf16(vraw[i], v0, v1);
                *(LAS bf16x8*)(vt + sl * VST + piece * 32) = v0; *(LAS bf16x8*)(vt + sl * VST + piece * 32 + 16) = v1; }
            asm volatile("s_waitcnt lgkmcnt(0)" ::: "memory");
            if (ch < 3) ATT_VLOAD2(ch + 1);
#pragma unroll
            for (int s2 = 0; s2 < 2; ++s2) {
                const int t0 = ch * 4 + s2 * 2;
                const u32x4 pw = pack8(st[t0], st[t0 + 1]);
                const bf16x8 pf = __builtin_bit_cast(bf16x8, pw);
#pragma unroll
                for (int dt = 0; dt < 4; ++dt) {
                    LAS unsigned char* a0 = vt + (s2 * 32 + fq * 4 + (fr >> 2)) * VST + (dt * 16 + 4 * (fr & 3)) * 2;
                    const s16x4 v0 = lds_tr(a0), v1 = lds_tr(a0 + 16 * VST);
                    bf16x8 vf; vf[0] = v0[0]; vf[1] = v0[1]; vf[2] = v0[2]; vf[3] = v0[3]; vf[4] = v1[0]; vf[5] = v1[1]; vf[6] = v1[2]; vf[7] = v1[3];
                    oacc[dt] = __builtin_amdgcn_mfma_f32_16x16x32_bf16(pf, vf, oacc[dt], 0, 0, 0);
                }
            }
            asm volatile("s_waitcnt lgkmcnt(0)" ::: "memory");
        }
#undef ATT_VLOAD2

        const float i0 = vinv / __shfl(sum, 0), i1 = vinv / __shfl(sum, 1), i2 = vinv / __shfl(sum, 2), i3 = vinv / __shfl(sum, 3);
        if (fq == 0) {
#pragma unroll
            for (int dt = 0; dt < 4; ++dt) {
                bf16* o = Ob + (size_t)row * 1024 + (n * 4) * 64 + dt * 16 + fr;
                o[0] = (bf16)f2bf(oacc[dt][0] * i0); o[64] = (bf16)f2bf(oacc[dt][1] * i1); o[128] = (bf16)f2bf(oacc[dt][2] * i2); o[192] = (bf16)f2bf(oacc[dt][3] * i3);
            }
        }
        if (qn < SEQ) {
#pragma unroll
            for (int i = 0; i < 4; ++i) ridb[(buf ^ 1) * 256 + i * 64 + lane] = vx[i] + b * SEQ;
        }

    }

    asm volatile("s_waitcnt lgkmcnt(0)" ::: "memory");
}

__device__ __forceinline__ void ln_row_wave(const float* __restrict__ zrow, const float* __restrict__ g, const float* __restrict__ bt, float* __restrict__ of, bf16* __restrict__ ob, int lane) {
    f32x4 v[4]; float s = 0.f;
#pragma unroll
    for (int j = 0; j < 4; ++j) { v[j] = *(const f32x4*)(zrow + 256 * j + 4 * lane); s += (v[j][0] + v[j][1]) + (v[j][2] + v[j][3]); }
#pragma unroll
    for (int o = 1; o < 64; o <<= 1) s += __shfl_xor(s, o);
    const float mean = s * (1.f / D); float q = 0.f;
#pragma unroll
    for (int j = 0; j < 4; ++j) { v[j] = v[j] - mean; q += (v[j][0] * v[j][0] + v[j][1] * v[j][1]) + (v[j][2] * v[j][2] + v[j][3] * v[j][3]); }
#pragma unroll
    for (int o = 1; o < 64; o <<= 1) q += __shfl_xor(q, o);
    const float rstd = rsqrtf(q * (1.f / D) + LN_EPS);
#pragma unroll
    for (int j = 0; j < 4; ++j) { const f32x4 gg = *(const f32x4*)(g + 256 * j + 4 * lane), bb = *(const f32x4*)(bt + 256 * j + 4 * lane); const f32x4 o = v[j] * rstd * gg + bb;
        if (of) *(f32x4*)(of + 256 * j + 4 * lane) = o; u32x2 w; w.x = pk2(o[0], o[1]); w.y = pk2(o[2], o[3]); *(u32x2*)(ob + 256 * j + 4 * lane) = w; }
}

struct FResid {
    const float* rp; const float* rs; float* Z;
    __device__ __forceinline__ const float* rrow(int row) const { return row < TP ? rp + (size_t)row * D : rs + (size_t)(row - TP) * D; }
    __device__ __forceinline__ void put8(int row, int col, f32x4 v0, f32x4 v1) const { const float* r = rrow(row) + col; float* z = Z + (size_t)row * D + col;
        *(f32x4*)z = v0 + ALPHA * *(const f32x4*)r; *(f32x4*)(z + 4) = v1 + ALPHA * *(const f32x4*)(r + 4); }
    __device__ __forceinline__ void put4(int row, int col, f32x4 v) const { *(f32x4*)(Z + (size_t)row * D + col) = v + ALPHA * *(const f32x4*)(rrow(row) + col); }
};
}

namespace mk {
template <int CAP>
__device__ __forceinline__ void topk_wave_regs(const float* __restrict__ row, int n, int* __restrict__ out, LAS unsigned* hist, LAS float* cv, LAS int* ci, LAS unsigned char* lst, int lane) {
    if (n <= TOPK) { for (int i = lane; i < TOPK; i += 64) out[i] = i < n ? i : 0; return; }

    constexpr int NCH = 32;
    const int nch = n > 8192 ? 32 : (n + 255) >> 8;
    float vx = (lane < 4 && 8192 + lane < n) ? row[8192 + lane] : -INFINITY;
    f32x4 v[NCH];
#pragma unroll
    for (int j = 0; j < NCH; ++j) {
        if (j < nch) v[j] = *(const f32x4*)(row + j * 256 + lane * 4);
        else v[j] = (f32x4){-INFINITY, -INFINITY, -INFINITY, -INFINITY};
    }
    float mn = INFINITY, mx = -INFINITY;
#pragma unroll
    for (int j = 0; j < NCH; ++j) {
        if (j < nch) {
            const int base = j * 256 + lane * 4;
#pragma unroll
            for (int e = 0; e < 4; ++e) { const bool ok = base + e < n; const float x = v[j][e]; v[j][e] = ok ? x : -INFINITY; mx = fmaxf(mx, ok ? x : -INFINITY); mn = fminf(mn, ok ? x : INFINITY); }
        }
    }
    if (vx != -INFINITY) { mx = fmaxf(mx, vx); mn = fminf(mn, vx); }
#pragma unroll
    for (int o = 1; o < 64; o <<= 1) { mn = fminf(mn, __shfl_xor(mn, o)); mx = fmaxf(mx, __shfl_xor(mx, o)); }
    if (!(mx > mn)) { for (int i = lane; i < TOPK; i += 64) out[i] = i; return; }
    const float scale = 2048.0f / (mx - mn);

#pragma unroll
    for (int i = 0; i < 8; ++i) *(LAS u32x4*)(hist + i * 256 + lane * 4) = (u32x4){0u, 0u, 0u, 0u};
    asm volatile("s_waitcnt lgkmcnt(0)" ::: "memory");
#pragma unroll
    for (int j = 0; j < NCH; ++j) {
        if (j < nch) {
            asm volatile("" : "+v"(v[j][0]), "+v"(v[j][1]), "+v"(v[j][2]), "+v"(v[j][3]));
#pragma unroll
            for (int e = 0; e < 4; ++e) { const float x = v[j][e]; int bn = (int)((x - mn) * scale); bn = bn > 2047 ? 2047 : bn; bn = x != -INFINITY ? bn : 2048;
                __hip_atomic_fetch_add(hist + bn, 1u, __ATOMIC_RELAXED, __HIP_MEMORY_SCOPE_WAVEFRONT); }
        }
    }
    if (vx != -INFINITY) { int bn = (int)((vx - mn) * scale); bn = bn > 2047 ? 2047 : bn; __hip_atomic_fetch_add(hist + bn, 1u, __ATOMIC_RELAXED, __HIP_MEMORY_SCOPE_WAVEFRONT); }
    asm volatile("s_waitcnt lgkmcnt(0)" ::: "memory");

    unsigned mine = 0u;
#pragma unroll
    for (int i = 0; i < 8; ++i) { const u32x4 h4 = *(LAS u32x4*)(hist + lane * 32 + i * 4); mine += (h4.x + h4.y) + (h4.z + h4.w); }
    unsigned suf = mine;
#pragma unroll
    for (int o = 1; o < 64; o <<= 1) { const unsigned t = __shfl_down(suf, o); if (lane + o < 64) suf += t; }
    const unsigned long long bal = __ballot(suf >= (unsigned)TOPK);
    const int Lt = 63 - __builtin_clzll(bal);
    const unsigned above = __shfl(suf, Lt) - __shfl(mine, Lt);
    const unsigned hb = hist[Lt * 32 + (lane & 31)];
    unsigned sfx = hb;
#pragma unroll
    for (int o = 1; o < 32; o <<= 1) { const unsigned t = __shfl_down(sfx, o); if ((lane & 31) + o < 32) sfx += t; }
    const unsigned long long okm = __ballot(above + sfx >= (unsigned)TOPK) & 0xFFFFFFFFull;
    const int jb = 63 - __builtin_clzll(okm);
    const int B = Lt * 32 + jb;
    const unsigned running = above + __shfl(sfx, jb) - __shfl(hb, jb);
    const int cnt_gt = (int)running, r = TOPK - cnt_gt;

    int base_gt = 0, base_eq = 0;
    const unsigned long long below = (1ull << lane) - 1ull;
    int lane4 = lane * 4; asm volatile("" : "+v"(lane4));
#pragma unroll
    for (int j = 0; j < NCH; ++j) {
        if (j < nch) {
#pragma unroll
            for (int e = 0; e < 4; ++e) {
                const float x = v[j][e]; int bn = (int)((x - mn) * scale); bn = bn > 2047 ? 2047 : bn; bn = x != -INFINITY ? bn : -1;
                const bool gt = bn > B, eq = bn == B;
                const unsigned long long mg = __ballot(gt), me = __ballot(eq);
                if (mg | me) {
                    const int idx = lane4 + (j * 256 + e);
                    if (gt) out[base_gt + __builtin_popcountll(mg & below)] = idx;
                    if (eq) { const int p = base_eq + __builtin_popcountll(me & below); if (p < CAP) { cv[p] = x; ci[p] = idx; } }
                    base_gt += __builtin_popcountll(mg); base_eq += __builtin_popcountll(me);
                }
            }
        }
    }
    if (n > 8192) {
        const float x = vx; bool gt = false, eq = false;
        if (x != -INFINITY) { int bn = (int)((x - mn) * scale); bn = bn > 2047 ? 2047 : bn; gt = bn > B; eq = bn == B; }
        const unsigned long long mg = __ballot(gt), me = __ballot(eq);
        const int idx = 8192 + lane;
        if (gt) out[base_gt + __builtin_popcountll(mg & below)] = idx;
        if (eq) { const int p = base_eq + __builtin_popcountll(me & below); if (p < CAP) { cv[p] = x; ci[p] = idx; } }
        base_gt += __builtin_popcountll(mg); base_eq += __builtin_popcountll(me);
    }
    asm volatile("s_waitcnt vmcnt(0) lgkmcnt(0)" ::: "memory");

    const int m = base_eq < CAP ? base_eq : CAP;
    if (m <= 64) {
        const float x = lane < m ? cv[lane] : -INFINITY; const int id = lane < m ? ci[lane] : 0x7fffffff; int rank = 0;
        for (int c2 = 0; c2 < m; ++c2) { const float x2 = __builtin_bit_cast(float, __builtin_amdgcn_readlane(__builtin_bit_cast(int, x), c2)); const int id2 = __builtin_amdgcn_readlane(id, c2);
            rank += (x2 > x || (x2 == x && id2 < id)) ? 1 : 0; }
        if (lane < m && rank < r) out[cnt_gt + rank] = id;
    } else {
        for (int c = lane; c < m; c += 64) {
            const float x = cv[c]; const int id = ci[c]; int rank = 0;
            for (int c2 = 0; c2 < m; ++c2) { const float x2 = cv[c2]; const int id2 = ci[c2]; rank += (x2 > x || (x2 == x && id2 < id)) ? 1 : 0; }
            if (rank < r) out[cnt_gt + rank] = id;
        }
    }
    asm volatile("s_waitcnt lgkmcnt(0)" ::: "memory");

}

__device__ __forceinline__ void phase_topk2(const float* __restrict__ SC, const float* __restrict__ SCS, int* __restrict__ IDX, int* __restrict__ CNT,
                                            const float* __restrict__ peer_u_, const float* __restrict__ peer_v_, unsigned char* __restrict__ Uq_, unsigned char* __restrict__ Vq_, float* __restrict__ Usc_, float* __restrict__ Vsc_,
                                            LAS unsigned char* lds, unsigned* qhead, int wave, int lane, int gw, int NGW, int jlo = 0, int jhi = TA) {
    constexpr int CAP = 1020;
    LAS unsigned* hist = (LAS unsigned*)(lds + wave * 16384);
    LAS float* cv = (LAS float*)(lds + wave * 16384 + 8208);
    LAS int* ci = (LAS int*)(lds + wave * 16384 + 8208 + 4080);
    LAS unsigned char* lst = nullptr;

    for (int j = gw; j < TA; j += NGW) {
        if (j < jlo || j >= jhi) continue;
        int row, n; const float* rp;
        if (j < TP) { const int b = j >> 13, jj = j & 8191, blk = jj >> 11; const int q = blk < 2 ? jj : blk * 2048 + 2047 - (jj & 2047);
            row = b * SEQ + q; n = q + 1; rp = SC + (size_t)row * SEQ; }
        else { const int r = j - TP; row = j; n = PAST + (r % DS) + 1; rp = SCS + (size_t)r * SCS_LD; }

        topk_wave_regs<CAP>(rp, n, IDX + (size_t)row * TOPK, hist, cv, ci, lst, lane);

        if (lane == 0) CNT[row] = n < TOPK ? n : TOPK;
    }

}
}

namespace mk {
using bf16x2_t = __attribute__((ext_vector_type(2))) __bf16;
__device__ __forceinline__ float dot2bf(unsigned a, unsigned b, float acc) { return __builtin_amdgcn_fdot2_f32_bf16(__builtin_bit_cast(bf16x2_t, a), __builtin_bit_cast(bf16x2_t, b), acc, false); }

struct FStoreBf16 {
    bf16* O; int ld;
    __device__ __forceinline__ void put8(int row, int col, f32x4 v0, f32x4 v1) const { *(u32x4*)(O + (size_t)row * ld + col) = pack8(v0, v1); }
    __device__ __forceinline__ void put4(int row, int col, f32x4 v) const { u32x2 w; w.x = pk2(v[0], v[1]); w.y = pk2(v[2], v[3]); *(u32x2*)(O + (size_t)row * ld + col) = w; }
};

#ifndef PGS
#define PGS 8
#endif
constexpr int PEER_TAB_OFF = LDSCTL_OFF + 1024;

__device__ __forceinline__ void ce_desc(unsigned& a, unsigned& b) { const unsigned hi = a > b ? a : b, lo = a > b ? b : a; a = hi; b = lo; }
template <int N> __device__ __forceinline__ void bitonic_sort_desc(unsigned (&k)[N]) {
#pragma unroll
    for (int size = 2; size <= N; size <<= 1)
#pragma unroll
        for (int stride = size >> 1; stride > 0; stride >>= 1)
#pragma unroll
            for (int i = 0; i < N; ++i) { const int j = i ^ stride; if (j > i) { if ((i & size) == 0) ce_desc(k[i], k[j]); else ce_desc(k[j], k[i]); } }
}
template <int N> __device__ __forceinline__ void bitonic_merge_desc(unsigned (&k)[N]) {
#pragma unroll
    for (int stride = N >> 1; stride > 0; stride >>= 1)
#pragma unroll
        for (int i = 0; i < N; ++i) { const int j = i ^ stride; if (j > i) ce_desc(k[i], k[j]); }
}
__device__ __forceinline__ void top16_merge(unsigned (&a)[16], const unsigned (&b)[16]) {
#pragma unroll
    for (int i = 0; i < 16; ++i) a[i] = a[i] > b[15 - i] ? a[i] : b[15 - i];
    bitonic_merge_desc<16>(a);
}
__device__ __forceinline__ void top16_xlane(unsigned (&a)[16], int o) {
    unsigned b[16];
#pragma unroll
    for (int i = 0; i < 16; ++i) b[i] = (unsigned)__shfl_xor((int)a[i], o);
    top16_merge(a, b);
}
__device__ __forceinline__ unsigned f2ord(float f) { const unsigned u = __builtin_bit_cast(unsigned, f); return u ^ ((u >> 31) ? 0xFFFFFFFFu : 0x80000000u); }
__device__ __forceinline__ float ord2f(unsigned o) { const unsigned u = o ^ ((o >> 31) ? 0x80000000u : 0xFFFFFFFFu); return __builtin_bit_cast(float, u); }

__device__ __forceinline__ void phase_peer_select(const bf16* __restrict__ PQb, const bf16* __restrict__ K1, const bf16* __restrict__ K2, unsigned short* __restrict__ teid_g, float* __restrict__ tgate_g,
                                                  LAS unsigned char* lds, int vcu, int G, int wave, int lane) {
    const int fr = lane & 15, fq = lane >> 4, h = wave;
    LAS unsigned char* itab = lds + wave * 1024;
    for (int tile = vcu; tile < TA / 16; tile += G) {
        const int tok0 = tile * 16;
        unsigned tk[2][16];
#pragma unroll
        for (int half = 0; half < 2; ++half) {
            const bf16* ap = PQb + (size_t)(tok0 + fr) * PEER_N + h * 256 + half * 128 + fq * 8;
            bf16x8 a[4];
#pragma unroll
            for (int ks = 0; ks < 4; ++ks) a[ks] = *(const bf16x8*)(ap + ks * 32);
            const bf16* kb = (half ? K2 : K1) + (size_t)fr * 128 + fq * 8;
            unsigned k0[16], k1[16];
#pragma unroll
            for (int ct = 0; ct < 8; ++ct) {
                f32x4 acc = (f32x4){0.f, 0.f, 0.f, 0.f};
#pragma unroll
                for (int ks = 0; ks < 4; ++ks) { const bf16x8 b = *(const bf16x8*)(kb + (size_t)ct * 16 * 128 + ks * 32); acc = __builtin_amdgcn_mfma_f32_16x16x32_bf16(b, a[ks], acc, 0, 0, 0); }
#pragma unroll
                for (int j = 0; j < 4; ++j) { const unsigned key = (f2ord(acc[j]) & 0xFFFFFF80u) | (unsigned)(127 - (ct * 16 + 4 * fq + j));
                    if (ct < 4) k0[ct * 4 + j] = key; else k1[(ct - 4) * 4 + j] = key; }
                if (ct & 1) asm volatile("" ::: "memory");
            }
            bitonic_sort_desc<16>(k0); bitonic_sort_desc<16>(k1);
            top16_merge(k0, k1); top16_xlane(k0, 16); top16_xlane(k0, 32);
#pragma unroll
            for (int i = 0; i < 16; ++i) tk[half][i] = k0[i];
        }
        if (fq == 0) {
#pragma unroll
            for (int i = 0; i < 16; ++i) { itab[fr * 32 + i] = (unsigned char)(127 - (tk[0][i] & 0x7Fu)); itab[fr * 32 + 16 + i] = (unsigned char)(127 - (tk[1][i] & 0x7Fu)); }
        }
        unsigned ck[16];
        {
            float v1[16], v2[16];
#pragma unroll
            for (int i = 0; i < 16; ++i) { v1[i] = ord2f(tk[0][i] & 0xFFFFFF80u); v2[i] = ord2f(tk[1][i] & 0xFFFFFF80u); }
            int c = 0;
#pragma unroll
            for (int i = 0; i < 16; ++i)
#pragma unroll
                for (int j = 0; j < 16; ++j) {
                    if ((i + 1) * (j + 1) <= 16) {
                        const unsigned key = (f2ord(v1[i] + v2[j]) & 0xFFFFFF00u) | (unsigned)(255 - (i * 16 + j));
                        const int m = c >> 2, pt = c & 3;
                        if (pt == 0) ck[m] = key; else ck[m] = fq == pt ? key : ck[m];
                        ++c;
                    }
                }
            ck[12] = fq < 2 ? ck[12] : 0u; ck[13] = 0u; ck[14] = 0u; ck[15] = 0u;
        }
        bitonic_sort_desc<16>(ck); top16_xlane(ck, 16); top16_xlane(ck, 32);
        asm volatile("s_waitcnt lgkmcnt(0)" ::: "memory");
        float ev[16]; float sum = 0.f; const float mxv = ord2f(ck[0] & 0xFFFFFF00u);
#pragma unroll
        for (int k = 0; k < 16; ++k) { ev[k] = __expf(ord2f(ck[k] & 0xFFFFFF00u) - mxv); sum += ev[k]; }
        const float inv = 1.f / sum;
#pragma unroll
        for (int k = 0; k < 16; ++k) {
            if ((k >> 2) == fq) {
                const int f = 255 - (int)(ck[k] & 0xFFu); const int id = (int)itab[fr * 32 + (f >> 4)] * 128 + (int)itab[fr * 32 + 16 + (f & 15)];
                teid_g[(size_t)(tok0 + fr) * 128 + h * 16 + k] = (unsigned short)id; tgate_g[(size_t)(tok0 + fr) * 128 + h * 16 + k] = ev[k] * inv;
            }
        }
        asm volatile("s_waitcnt lgkmcnt(0)" ::: "memory");
    }
}

#if PEER_BITS == 4
__device__ __forceinline__ u32x4 prow_load(const unsigned char* __restrict__ T, int id, int lane) { const u32x2 r = *(const u32x2*)(T + (size_t)id * PEER_RB + lane * 8); u32x4 t; t.x = r.x; t.y = r.y; t.z = 0u; t.w = 0u; return t; }
#define PROW_LOAD(T, id) prow_load(T, id, lane)
#elif PEER_BITS == 6
typedef unsigned v6u_t __attribute__((ext_vector_type(6)));
typedef float v32f_t __attribute__((ext_vector_type(32)));
__device__ __forceinline__ u32x4 prow_load(const unsigned char* __restrict__ T, int id, int lane) { const unsigned* rp = (const unsigned*)(T + (size_t)id * PEER_RB + lane * 12); u32x4 t; t.x = rp[0]; t.y = rp[1]; t.z = rp[2]; t.w = 0u; return t; }
#define PROW_LOAD(T, id) prow_load(T, id, lane)
#else
#define PROW_LOAD(T, id) (*(const u32x4*)((T) + (size_t)(id) * D + lane * 16))
#endif
__device__ __forceinline__ void phase_peer_mix(const float* __restrict__ Zin, const float* __restrict__ g1, const float* __restrict__ b1, const unsigned short* __restrict__ teid, const float* __restrict__ tgate,
                                               const unsigned char* __restrict__ U, const unsigned char* __restrict__ V, const float* __restrict__ Us, const float* __restrict__ Vs, const float* __restrict__ g2, const float* __restrict__ b2,
                                               float* __restrict__ outf, bf16* __restrict__ outb, int gw, int NGW, int lane) {

    for (int j = gw; j < TP + TS * 16; j += NGW) {
        size_t tok;
        if (j < TP) tok = (size_t)j;
        else { const int s = j - TP; if ((s & 15) != 0) continue; tok = (size_t)TP + (s >> 4); }
        {
            float xf[16];
            { float s1 = 0.f;
#pragma unroll
              for (int q = 0; q < 4; ++q) { const f32x4 r = *(const f32x4*)(Zin + tok * D + lane * 16 + q * 4); xf[q * 4] = r[0]; xf[q * 4 + 1] = r[1]; xf[q * 4 + 2] = r[2]; xf[q * 4 + 3] = r[3]; s1 += (r[0] + r[1]) + (r[2] + r[3]); }
#pragma unroll
              for (int o = 1; o < 64; o <<= 1) s1 += __shfl_xor(s1, o);
              const float mean1 = s1 * (1.f / D); float q1 = 0.f;
#pragma unroll
              for (int i = 0; i < 16; ++i) { xf[i] -= mean1; q1 += xf[i] * xf[i]; }
#pragma unroll
              for (int o = 1; o < 64; o <<= 1) q1 += __shfl_xor(q1, o);
              const float rstd1 = rsqrtf(q1 * (1.f / D) + LN_EPS);
#pragma unroll
              for (int q = 0; q < 4; ++q) { const f32x4 gg = *(const f32x4*)(g1 + lane * 16 + q * 4), bb = *(const f32x4*)(b1 + lane * 16 + q * 4);
#pragma unroll
                  for (int i = 0; i < 4; ++i) xf[q * 4 + i] = xf[q * 4 + i] * rstd1 * gg[i] + bb[i]; } }
            float wv0 = 0.f, wv1 = 0.f;
#pragma unroll 1
            for (int bt = 0; bt < 2; ++bt) {
                const int eidv = (int)teid[tok * 128 + bt * 64 + lane];
                float p[64];

                u32x4 qb[2][PGS];
#pragma unroll
                for (int i = 0; i < PGS; ++i) { const int id = __builtin_amdgcn_readlane(eidv, i); qb[0][i] = PROW_LOAD(U, id); }
#pragma unroll
                for (int g = 0; g < 64 / PGS; ++g) {
                    if (g < 64 / PGS - 1) {
#pragma unroll
                        for (int i = 0; i < PGS; ++i) { const int id = __builtin_amdgcn_readlane(eidv, (g + 1) * PGS + i); qb[(g + 1) & 1][i] = PROW_LOAD(U, id); }
                    }
                    asm volatile("" ::: "memory");
#if PEER_BITS == 4
#pragma unroll
                    for (int i = 0; i < PGS; ++i) {
                        f32x2v a2 = {0.f, 0.f};
#pragma unroll
                        for (int w = 0; w < 2; ++w) {
#define PU4(b) { const f32x2v f = __builtin_amdgcn_cvt_scalef32_pk_f32_fp4(qb[g & 1][i][w], 1.0f, b); const f32x2v xx = {xf[w * 8 + b * 2], xf[w * 8 + b * 2 + 1]}; a2 = __builtin_elementwise_fma(f, xx, a2); }
                            PU4(0) PU4(1) PU4(2) PU4(3)
#undef PU4
                        }
                        p[g * PGS + i] = a2[0] + a2[1];
                        __builtin_amdgcn_sched_barrier(0);
                    }
#elif PEER_BITS == 6
#pragma unroll
                    for (int i = 0; i < PGS; i += 2) {
                        const v6u_t pk = {qb[g & 1][i][0], qb[g & 1][i][1], qb[g & 1][i][2], qb[g & 1][i + 1][0], qb[g & 1][i + 1][1], qb[g & 1][i + 1][2]};
                        const v32f_t f = __builtin_amdgcn_cvt_scalef32_pk32_f32_fp6(pk, 1.0f);
                        float a0 = 0.f, a1 = 0.f;
#pragma unroll
                        for (int k = 0; k < 16; ++k) { a0 = fmaf(f[k], xf[k], a0); a1 = fmaf(f[16 + k], xf[k], a1); }
                        p[g * PGS + i] = a0; p[g * PGS + i + 1] = a1;
                        __builtin_amdgcn_sched_barrier(0);
                    }
#else
#pragma unroll
                    for (int i = 0; i < PGS; ++i) {
                        float a = 0.f;
#pragma unroll
                        for (int w = 0; w < 4; ++w) { const f32x2v lo = __builtin_amdgcn_cvt_pk_f32_fp8((int)qb[g & 1][i][w], false), hi = __builtin_amdgcn_cvt_pk_f32_fp8((int)qb[g & 1][i][w], true);
                            a = fmaf(lo[0], xf[w * 4], a); a = fmaf(lo[1], xf[w * 4 + 1], a); a = fmaf(hi[0], xf[w * 4 + 2], a); a = fmaf(hi[1], xf[w * 4 + 3], a); }
                        p[g * PGS + i] = a;
                        __builtin_amdgcn_sched_barrier(0);
                    }
#endif
                }

#pragma unroll
                for (int o = 32; o >= 1; o >>= 1) {
                    const bool up = (lane & o) != 0;
#pragma unroll
                    for (int i = 0; i < o; ++i) { const float keep = up ? p[i + o] : p[i], send = up ? p[i] : p[i + o]; p[i] = keep + __shfl_xor(send, o); }
                }
                const float hdot = p[0] * Us[eidv];
                const float wv = 0.5f * hdot * (1.f + erff(hdot * 0.70710678118654752f)) * tgate[tok * 128 + bt * 64 + lane] * Vs[eidv];
                if (bt == 0) wv0 = wv; else wv1 = wv;

            }

            float y[16];
#pragma unroll
            for (int i = 0; i < 16; ++i) y[i] = 0.f;
#pragma unroll 1
            for (int bt = 0; bt < 2; ++bt) {
                const int eidv = (int)teid[tok * 128 + bt * 64 + lane]; const float wvv = bt == 0 ? wv0 : wv1;
                u32x4 qb[2][PGS];
#pragma unroll
                for (int i = 0; i < PGS; ++i) { const int id = __builtin_amdgcn_readlane(eidv, i); qb[0][i] = PROW_LOAD(V, id); }
#pragma unroll
                for (int g = 0; g < 64 / PGS; ++g) {
                    if (g < 64 / PGS - 1) {
#pragma unroll
                        for (int i = 0; i < PGS; ++i) { const int id = __builtin_amdgcn_readlane(eidv, (g + 1) * PGS + i); qb[(g + 1) & 1][i] = PROW_LOAD(V, id); }
                    }
                    asm volatile("" ::: "memory");
#if PEER_BITS == 4
#pragma unroll
                    for (int i = 0; i < PGS; ++i) {
                        const float w = __builtin_bit_cast(float, __builtin_amdgcn_readlane(__builtin_bit_cast(int, wvv), g * PGS + i));
                        asm volatile("" : "+v"(qb[g & 1][i][0]), "+v"(qb[g & 1][i][1]));
#pragma unroll
                        for (int k = 0; k < 2; ++k) {
#define PV4(b) { const f32x2v f = __builtin_amdgcn_cvt_scalef32_pk_f32_fp4(qb[g & 1][i][k], 1.0f, b); f32x2v yy = {y[k * 8 + b * 2], y[k * 8 + b * 2 + 1]}; const f32x2v ww = {w, w}; yy = __builtin_elementwise_fma(ww, f, yy); y[k * 8 + b * 2] = yy[0]; y[k * 8 + b * 2 + 1] = yy[1]; }
                            PV4(0) PV4(1) PV4(2) PV4(3)
#undef PV4
                        }
                        asm volatile("" : "+v"(y[0]), "+v"(y[1]), "+v"(y[2]), "+v"(y[3]), "+v"(y[4]), "+v"(y[5]), "+v"(y[6]), "+v"(y[7]), "+v"(y[8]), "+v"(y[9]), "+v"(y[10]), "+v"(y[11]), "+v"(y[12]), "+v"(y[13]), "+v"(y[14]), "+v"(y[15]));
                    }
#elif PEER_BITS == 6
#pragma unroll
                    for (int i = 0; i < PGS; i += 2) {
                        const float w0 = __builtin_bit_cast(float, __builtin_amdgcn_readlane(__builtin_bit_cast(int, wvv), g * PGS + i)), w1 = __builtin_bit_cast(float, __builtin_amdgcn_readlane(__builtin_bit_cast(int, wvv), g * PGS + i + 1));
                        asm volatile("" : "+v"(qb[g & 1][i][0]), "+v"(qb[g & 1][i][1]), "+v"(qb[g & 1][i][2]), "+v"(qb[g & 1][i + 1][0]), "+v"(qb[g & 1][i + 1][1]), "+v"(qb[g & 1][i + 1][2]));
                        const v6u_t pk = {qb[g & 1][i][0], qb[g & 1][i][1], qb[g & 1][i][2], qb[g & 1][i + 1][0], qb[g & 1][i + 1][1], qb[g & 1][i + 1][2]};
                        const v32f_t f = __builtin_amdgcn_cvt_scalef32_pk32_f32_fp6(pk, 1.0f);
#pragma unroll
                        for (int k = 0; k < 16; ++k) { y[k] = fmaf(w0, f[k], y[k]); y[k] = fmaf(w1, f[16 + k], y[k]); }
                        asm volatile("" : "+v"(y[0]), "+v"(y[1]), "+v"(y[2]), "+v"(y[3]), "+v"(y[4]), "+v"(y[5]), "+v"(y[6]), "+v"(y[7]), "+v"(y[8]), "+v"(y[9]), "+v"(y[10]), "+v"(y[11]), "+v"(y[12]), "+v"(y[13]), "+v"(y[14]), "+v"(y[15]));
                    }
#else
#pragma unroll
                    for (int i = 0; i < PGS; ++i) {
                        const float w = __builtin_bit_cast(float, __builtin_amdgcn_readlane(__builtin_bit_cast(int, wvv), g * PGS + i));
                        asm volatile("" : "+v"(qb[g & 1][i][0]), "+v"(qb[g & 1][i][1]), "+v"(qb[g & 1][i][2]), "+v"(qb[g & 1][i][3]));
#pragma unroll
                        for (int k = 0; k < 4; ++k) { const f32x2v lo = __builtin_amdgcn_cvt_pk_f32_fp8((int)qb[g & 1][i][k], false), hi = __builtin_amdgcn_cvt_pk_f32_fp8((int)qb[g & 1][i][k], true);
                            y[k * 4] = fmaf(w, lo[0], y[k * 4]); y[k * 4 + 1] = fmaf(w, lo[1], y[k * 4 + 1]); y[k * 4 + 2] = fmaf(w, hi[0], y[k * 4 + 2]); y[k * 4 + 3] = fmaf(w, hi[1], y[k * 4 + 3]); }
                        asm volatile("" : "+v"(y[0]), "+v"(y[1]), "+v"(y[2]), "+v"(y[3]), "+v"(y[4]), "+v"(y[5]), "+v"(y[6]), "+v"(y[7]), "+v"(y[8]), "+v"(y[9]), "+v"(y[10]), "+v"(y[11]), "+v"(y[12]), "+v"(y[13]), "+v"(y[14]), "+v"(y[15]));
                    }
#endif
                }
            }

            float s = 0.f;
#pragma unroll
            for (int i = 0; i < 16; ++i) { y[i] = ALPHA * xf[i] + y[i]; s += y[i]; }
#pragma unroll
            for (int o = 1; o < 64; o <<= 1) s += __shfl_xor(s, o);
            const float mean = s * (1.f / D); float qq = 0.f;
#pragma unroll
            for (int i = 0; i < 16; ++i) { y[i] -= mean; qq += y[i] * y[i]; }
#pragma unroll
            for (int o = 1; o < 64; o <<= 1) qq += __shfl_xor(qq, o);
            const float rstd = rsqrtf(qq * (1.f / D) + LN_EPS);
            u32x4 ob0, ob1;
#pragma unroll
            for (int q = 0; q < 4; ++q) { const int col = lane * 16 + q * 4; const f32x4 gg = *(const f32x4*)(g2 + col), bb = *(const f32x4*)(b2 + col);
                f32x4 o;
#pragma unroll
                for (int i = 0; i < 4; ++i) o[i] = y[q * 4 + i] * rstd * gg[i] + bb[i];
                *(f32x4*)(outf + tok * D + col) = o;
                const unsigned w0 = pk2(o[0], o[1]), w1 = pk2(o[2], o[3]);
                if (q == 0) { ob0.x = w0; ob0.y = w1; } else if (q == 1) { ob0.z = w0; ob0.w = w1; } else if (q == 2) { ob1.x = w0; ob1.y = w1; } else { ob1.z = w0; ob1.w = w1; } }
            if (outb) { *(u32x4*)(outb + tok * D + lane * 16) = ob0; *(u32x4*)(outb + tok * D + lane * 16 + 8) = ob1; }

        }
    }

}

__device__ __forceinline__ float peer_reduce16(float (&p)[16], int lane) {
#pragma unroll
    for (int o = 8; o >= 1; o >>= 1) { const bool up = (lane & (o * 4)) != 0;
#pragma unroll
        for (int k = 0; k < o; ++k) { const float keep = up ? p[k + o] : p[k], send = up ? p[k] : p[k + o]; p[k] = keep + __shfl_xor(send, o * 4); } }
    float tot = p[0];
    tot += __shfl_xor(tot, 2); tot += __shfl_xor(tot, 1);
    return tot;
}
__device__ __forceinline__ unsigned cvtpk_bf16_(float lo, float hi) { typedef __bf16 bf2 __attribute__((ext_vector_type(2))); f32x2v v = {lo, hi}; bf2 b = __builtin_convertvector(v, bf2); return __builtin_bit_cast(unsigned, b); }
__device__ __forceinline__ float peer_dot16b(const u32x4 q, const u32x4 x0, const u32x4 x1) {
    float a = 0.f;
#pragma unroll
    for (int w = 0; w < 4; ++w) { const f32x2v lo = __builtin_amdgcn_cvt_pk_f32_fp8((int)q[w], false), hi = __builtin_amdgcn_cvt_pk_f32_fp8((int)q[w], true);
        const unsigned xa = w < 2 ? x0[2 * w] : x1[2 * w - 4], xb = w < 2 ? x0[2 * w + 1] : x1[2 * w - 3];
        a = dot2bf(cvtpk_bf16_(lo[0], lo[1]), xa, a); a = dot2bf(cvtpk_bf16_(hi[0], hi[1]), xb, a); }
    return a;
}

__device__ __forceinline__ void peer_u_slice(int sl, int t_first, int t_step, const bf16* __restrict__ Hb, const unsigned short* __restrict__ teid, const unsigned char* __restrict__ U,
                                             float* __restrict__ HD, LAS unsigned char* wl, int lane) {
    LAS unsigned short* lst_e = (LAS unsigned short*)wl;
    LAS unsigned char* lst_s = wl + 512;
    const unsigned long long below = (1ull << lane) - 1ull;
    const int kk = (lane >> 2) & 15;
    if (t_first >= TA) return;
#define PU_BUILD(bsel, e0_, e1_, cnt_) do { const bool a0_ = ((e0_) >> 11) == sl, a1_ = ((e1_) >> 11) == sl; const unsigned long long m0_ = __ballot(a0_), m1_ = __ballot(a1_); \
        const int c0_ = __builtin_popcountll(m0_); cnt_ = c0_ + __builtin_popcountll(m1_); \
        if (a0_) { const int p_ = __builtin_popcountll(m0_ & below); lst_e[(bsel) * 128 + p_] = (unsigned short)(e0_); lst_s[(bsel) * 128 + p_] = (unsigned char)lane; } \
        if (a1_) { const int p_ = c0_ + __builtin_popcountll(m1_ & below); lst_e[(bsel) * 128 + p_] = (unsigned short)(e1_); lst_s[(bsel) * 128 + p_] = (unsigned char)(64 + lane); } } while (0)
#define PU_LOAD(bsel, cnt_, q_) do { _Pragma("unroll") for (int k = 0; k < 16; ++k) { if (k < (cnt_)) { const int id_ = __builtin_amdgcn_readfirstlane((int)lst_e[(bsel) * 128 + k]); q_[k] = *(const u32x4*)(U + (size_t)id_ * D + lane * 16); } } } while (0)
    int e0 = __builtin_nontemporal_load(teid + (size_t)t_first * 128 + lane), e1 = __builtin_nontemporal_load(teid + (size_t)t_first * 128 + 64 + lane);
    u32x4 xa0 = __builtin_nontemporal_load((const u32x4*)(Hb + (size_t)t_first * D + lane * 16)), xa1 = __builtin_nontemporal_load((const u32x4*)(Hb + (size_t)t_first * D + lane * 16 + 8));
    int cnt; PU_BUILD(0, e0, e1, cnt);
    asm volatile("s_waitcnt lgkmcnt(0)" ::: "memory");
    u32x4 q[16];
    PU_LOAD(0, cnt, q);
    int buf = 0;

    for (int t = t_first; t < TA; t += t_step, buf ^= 1) {
        const int tn = t + t_step; const bool hasn = tn < TA;
        u32x4 xb0 = xa0, xb1 = xa1; int f0 = 0, f1 = 0;
        if (hasn) { f0 = __builtin_nontemporal_load(teid + (size_t)tn * 128 + lane); f1 = __builtin_nontemporal_load(teid + (size_t)tn * 128 + 64 + lane);
            xb0 = __builtin_nontemporal_load((const u32x4*)(Hb + (size_t)tn * D + lane * 16)); xb1 = __builtin_nontemporal_load((const u32x4*)(Hb + (size_t)tn * D + lane * 16 + 8)); }

        float pr[16];
#pragma unroll
        for (int k = 0; k < 16; ++k) pr[k] = k < cnt ? peer_dot16b(q[k], xa0, xa1) : 0.f;

#pragma unroll 1
        for (int p0 = 16; p0 < cnt; p0 += 16) {
            u32x4 q2[16];
#pragma unroll
            for (int k = 0; k < 16; ++k) { if (p0 + k < cnt) { const int id_ = __builtin_amdgcn_readfirstlane((int)lst_e[buf * 128 + p0 + k]); q2[k] = *(const u32x4*)(U + (size_t)id_ * D + lane * 16); } }
            float pr2[16];
#pragma unroll
            for (int k = 0; k < 16; ++k) pr2[k] = p0 + k < cnt ? peer_dot16b(q2[k], xa0, xa1) : 0.f;
            const float tot2 = peer_reduce16(pr2, lane);
            if (p0 + kk < cnt && (lane & 3) == 0) __builtin_nontemporal_store(tot2, HD + (size_t)t * 128 + lst_s[buf * 128 + p0 + kk]);
        }

        int cntn = 0;
        if (hasn) { PU_BUILD(buf ^ 1, f0, f1, cntn); }
        asm volatile("s_waitcnt lgkmcnt(0)" ::: "memory");
        if (hasn) PU_LOAD(buf ^ 1, cntn, q);

        const float tot = peer_reduce16(pr, lane);
        if (kk < cnt && (lane & 3) == 0) __builtin_nontemporal_store(tot, HD + (size_t)t * 128 + lst_s[buf * 128 + kk]);
        xa0 = xb0; xa1 = xb1; cnt = cntn;

    }

#undef PU_BUILD
#undef PU_LOAD
}

__device__ __forceinline__ void phase_peer_mixv(const float* __restrict__ Zin, const float* __restrict__ g1, const float* __restrict__ b1, const unsigned short* __restrict__ teid, const float* __restrict__ tgate, const float* __restrict__ HD,
                                                const unsigned char* __restrict__ V, const float* __restrict__ Us, const float* __restrict__ Vs, const float* __restrict__ g2, const float* __restrict__ b2,
                                                float* __restrict__ outf, bf16* __restrict__ outb, int gw, int NGW, int lane) {
    for (int j = gw; j < TP + TS * 16; j += NGW) {
        size_t tok;
        if (j < TP) tok = (size_t)j;
        else { const int s = j - TP; if ((s & 15) != 0) continue; tok = (size_t)TP + (s >> 4); }
        float xf[16];
        { float s1 = 0.f;
#pragma unroll
          for (int q = 0; q < 4; ++q) { const f32x4 r = *(const f32x4*)(Zin + tok * D + lane * 16 + q * 4); xf[q * 4] = r[0]; xf[q * 4 + 1] = r[1]; xf[q * 4 + 2] = r[2]; xf[q * 4 + 3] = r[3]; s1 += (r[0] + r[1]) + (r[2] + r[3]); }
#pragma unroll
          for (int o = 1; o < 64; o <<= 1) s1 += __shfl_xor(s1, o);
          const float mean1 = s1 * (1.f / D); float q1 = 0.f;
#pragma unroll
          for (int i = 0; i < 16; ++i) { xf[i] -= mean1; q1 += xf[i] * xf[i]; }
#pragma unroll
          for (int o = 1; o < 64; o <<= 1) q1 += __shfl_xor(q1, o);
          const float rstd1 = rsqrtf(q1 * (1.f / D) + LN_EPS);
#pragma unroll
          for (int q = 0; q < 4; ++q) { const f32x4 gg = *(const f32x4*)(g1 + lane * 16 + q * 4), bb = *(const f32x4*)(b1 + lane * 16 + q * 4);
#pragma unroll
              for (int i = 0; i < 4; ++i) xf[q * 4 + i] = xf[q * 4 + i] * rstd1 * gg[i] + bb[i]; } }
        float y[16];
#pragma unroll
        for (int i = 0; i < 16; ++i) y[i] = 0.f;
#pragma unroll 1
        for (int bt = 0; bt < 2; ++bt) {
            const int eidv = (int)teid[tok * 128 + bt * 64 + lane];
            const float hd = HD[tok * 128 + bt * 64 + lane] * Us[eidv];
            const float wvv = 0.5f * hd * (1.f + erff(hd * 0.70710678118654752f)) * tgate[tok * 128 + bt * 64 + lane] * Vs[eidv];
            u32x4 qb[2][PGS];
#pragma unroll
            for (int i = 0; i < PGS; ++i) { const int id = __builtin_amdgcn_readlane(eidv, i); qb[0][i] = PROW_LOAD(V, id); }
#pragma unroll
            for (int g = 0; g < 64 / PGS; ++g) {
                if (g < 64 / PGS - 1) {
#pragma unroll
                    for (int i = 0; i < PGS; ++i) { const int id = __builtin_amdgcn_readlane(eidv, (g + 1) * PGS + i); qb[(g + 1) & 1][i] = PROW_LOAD(V, id); }
                }
                asm volatile("" ::: "memory");
#pragma unroll
                for (int i = 0; i < PGS; ++i) {
                    const float w = __builtin_bit_cast(float, __builtin_amdgcn_readlane(__builtin_bit_cast(int, wvv), g * PGS + i));
                    asm volatile("" : "+v"(qb[g & 1][i][0]), "+v"(qb[g & 1][i][1]), "+v"(qb[g & 1][i][2]), "+v"(qb[g & 1][i][3]));
#pragma unroll
                    for (int k = 0; k < 4; ++k) { const f32x2v lo = __builtin_amdgcn_cvt_pk_f32_fp8((int)qb[g & 1][i][k], false), hi = __builtin_amdgcn_cvt_pk_f32_fp8((int)qb[g & 1][i][k], true);
                        y[k * 4] = fmaf(w, lo[0], y[k * 4]); y[k * 4 + 1] = fmaf(w, lo[1], y[k * 4 + 1]); y[k * 4 + 2] = fmaf(w, hi[0], y[k * 4 + 2]); y[k * 4 + 3] = fmaf(w, hi[1], y[k * 4 + 3]); }
                    asm volatile("" : "+v"(y[0]), "+v"(y[1]), "+v"(y[2]), "+v"(y[3]), "+v"(y[4]), "+v"(y[5]), "+v"(y[6]), "+v"(y[7]), "+v"(y[8]), "+v"(y[9]), "+v"(y[10]), "+v"(y[11]), "+v"(y[12]), "+v"(y[13]), "+v"(y[14]), "+v"(y[15]));
                }
            }
        }
        float s = 0.f;
#pragma unroll
        for (int i = 0; i < 16; ++i) { y[i] = ALPHA * xf[i] + y[i]; s += y[i]; }
#pragma unroll
        for (int o = 1; o < 64; o <<= 1) s += __shfl_xor(s, o);
        const float mean = s * (1.f / D); float qq = 0.f;
#pragma unroll
        for (int i = 0; i < 16; ++i) { y[i] -= mean; qq += y[i] * y[i]; }
#pragma unroll
        for (int o = 1; o < 64; o <<= 1) qq += __shfl_xor(qq, o);
        const float rstd = rsqrtf(qq * (1.f / D) + LN_EPS);
        u32x4 ob0, ob1;
#pragma unroll
        for (int q = 0; q < 4; ++q) { const int col = lane * 16 + q * 4; const f32x4 gg = *(const f32x4*)(g2 + col), bb = *(const f32x4*)(b2 + col);
            f32x4 o;
#pragma unroll
            for (int i = 0; i < 4; ++i) o[i] = y[q * 4 + i] * rstd * gg[i] + bb[i];
            *(f32x4*)(outf + tok * D + col) = o;
            const unsigned w0 = pk2(o[0], o[1]), w1 = pk2(o[2], o[3]);
            if (q == 0) { ob0.x = w0; ob0.y = w1; } else if (q == 1) { ob0.z = w0; ob0.w = w1; } else if (q == 2) { ob1.x = w0; ob1.y = w1; } else { ob1.z = w0; ob1.w = w1; } }
        if (outb) { *(u32x4*)(outb + tok * D + lane * 16) = ob0; *(u32x4*)(outb + tok * D + lane * 16 + 8) = ob1; }
    }
}
}

namespace mk {
struct FGlaIn {
    bf16 *Gq, *Gk, *Gv, *Gr; float* GD;
    __device__ __forceinline__ static float silu(float r) { return r / (1.f + __expf(-r)); }
    __device__ __forceinline__ void put8(int row, int col, f32x4 v0, f32x4 v1) const {
        if (col < GN_K) *(u32x4*)(Gq + (size_t)row * 512 + col) = pack8(v0, v1);
        else if (col < GN_V) *(u32x4*)(Gk + (size_t)row * 512 + (col - GN_K)) = pack8(v0, v1);
        else if (col < GN_R) *(u32x4*)(Gv + (size_t)row * 1024 + (col - GN_V)) = pack8(v0, v1);
        else { f32x4 a, b;
#pragma unroll
            for (int i = 0; i < 4; ++i) { a[i] = silu(v0[i]); b[i] = silu(v1[i]); }
            *(u32x4*)(Gr + (size_t)row * 1024 + (col - GN_R)) = pack8(a, b); }
    }
    __device__ __forceinline__ void put4(int row, int col, f32x4 v) const {
        u32x2 w; w.x = pk2(v[0], v[1]); w.y = pk2(v[2], v[3]);
        if (col < GN_K) *(u32x2*)(Gq + (size_t)row * 512 + col) = w;
        else if (col < GN_V) *(u32x2*)(Gk + (size_t)row * 512 + (col - GN_K)) = w;
        else if (col < GN_R) *(u32x2*)(Gv + (size_t)row * 1024 + (col - GN_V)) = w;
        else if (col < GN_GD) { u32x2 s; s.x = pk2(silu(v[0]), silu(v[1])); s.y = pk2(silu(v[2]), silu(v[3])); *(u32x2*)(Gr + (size_t)row * 1024 + (col - GN_R)) = s; }
        else if (col < GN_GD + 16) *(f32x4*)(GD + (size_t)row * 16 + (col - GN_GD)) = v;
    }
};

__device__ __forceinline__ float log_sigmoid_f(float x) { return fminf(x, 0.f) - log1pf(__expf(-fabsf(x))); }
__device__ __forceinline__ bf16x8 tr8(LAS unsigned char* a0, LAS unsigned char* a1) { const s16x4 v0 = lds_tr(a0), v1 = lds_tr(a1); bf16x8 r; r[0] = v0[0]; r[1] = v0[1]; r[2] = v0[2]; r[3] = v0[3]; r[4] = v1[0]; r[5] = v1[1]; r[6] = v1[2]; r[7] = v1[3]; return r; }

constexpr int KD_ST = 272, V_ST = 528;
constexpr int GL_LB = 0, GL_TOT = 32768, GL_KD = 36864, GL_V = GL_KD + 64 * KD_ST  , GL_END = GL_V + 64 * V_ST;
static_assert(GL_END <= RING_BYTES, "GLA chunk LDS");

__device__ __forceinline__ void gla_chunk_item(int item, const bf16* __restrict__ Gq, const bf16* __restrict__ Gk, const bf16* __restrict__ Gv, const float* __restrict__ GD,
                                               const float* __restrict__ Wgu, const float* __restrict__ bg, bf16* __restrict__ QT, bf16* __restrict__ KT, float* __restrict__ DEC, float* __restrict__ DS,
                                               LAS unsigned char* lds, int tid, int wave, int lane) {
    const int h = item & 3, bc = item >> 2;
    const size_t tok0 = (size_t)bc * 64;
    LAS float* LB = (LAS float*)(lds + GL_LB);
    LAS float* TOT = (LAS float*)(lds + GL_TOT);
    const int d = tid & 127, tq = tid >> 7;
    float wg[16];
#pragma unroll
    for (int r = 0; r < 16; ++r) wg[r] = Wgu[r * 512 + h * 128 + d];
    const float bgd = bg[h * 128 + d];
    float pre[16]; float run = 0.f;
#pragma unroll
    for (int i = 0; i < 16; ++i) {
        const float* gd = GD + (tok0 + tq * 16 + i) * 16;
        const f32x4 g0 = *(const f32x4*)gd, g1 = *(const f32x4*)(gd + 4), g2 = *(const f32x4*)(gd + 8), g3 = *(const f32x4*)(gd + 12);
        float x = 0.f;
#pragma unroll
        for (int r = 0; r < 4; ++r) { x = fmaf(g0[r], wg[r], x); }
#pragma unroll
        for (int r = 0; r < 4; ++r) { x = fmaf(g1[r], wg[4 + r], x); }
#pragma unroll
        for (int r = 0; r < 4; ++r) { x = fmaf(g2[r], wg[8 + r], x); }
#pragma unroll
        for (int r = 0; r < 4; ++r) { x = fmaf(g3[r], wg[12 + r], x); }
        run += log_sigmoid_f(x + bgd) * (1.f / 16.f); pre[i] = run;
    }
    TOT[tq * 128 + d] = run;
    __syncthreads();
    float off = 0.f;
#pragma unroll
    for (int q = 0; q < 3; ++q) if (q < tq) off += TOT[q * 128 + d];
    const float bC = (TOT[d] + TOT[128 + d]) + (TOT[256 + d] + TOT[384 + d]);
#pragma unroll
    for (int i = 0; i < 16; ++i) {
        const int t = tq * 16 + i; const float b = pre[i] + off; const size_t tok = tok0 + t;
        const float q = bf2f(Gq[tok * 512 + h * 128 + d]), k = bf2f(Gk[tok * 512 + h * 128 + d]);
        QT[tok * 512 + h * 128 + d] = (bf16)f2bf(q * 0.08838834764831845f * __expf(b));
        KT[tok * 512 + h * 128 + d] = (bf16)f2bf(k * __expf(-b));
        *(LAS bf16*)(lds + GL_KD + t * KD_ST + d * 2) = (bf16)f2bf(k * __expf(bC - b));
    }
    if (tq == 0) DEC[(size_t)item * 128 + d] = __expf(bC);
#pragma unroll
    for (int p = 0; p < 4; ++p) { const int e = tid + p * 512, s = e >> 5, ch = e & 31;
        *(LAS u32x4*)(lds + GL_V + s * V_ST + ch * 16) = *(const u32x4*)(Gv + (tok0 + s) * 1024 + h * 256 + ch * 8); }
    __syncthreads();
    const int fr = lane & 15, fq = lane >> 4, dt = wave;
    bf16x8 af[2];
#pragma unroll
    for (int ks = 0; ks < 2; ++ks) { LAS unsigned char* a0 = lds + GL_KD + (ks * 32 + fq * 8 + (fr >> 2)) * KD_ST + (dt * 16 + 4 * (fr & 3)) * 2; af[ks] = tr8(a0, a0 + 4 * KD_ST); }
    float* dsb = DS + (size_t)item * 256 * 128;
#pragma unroll 4
    for (int vt = 0; vt < 16; ++vt) {
        f32x4 acc = (f32x4){0.f, 0.f, 0.f, 0.f};
#pragma unroll
        for (int ks = 0; ks < 2; ++ks) { LAS unsigned char* b0 = lds + GL_V + (ks * 32 + fq * 8 + (fr >> 2)) * V_ST + (vt * 16 + 4 * (fr & 3)) * 2; const bf16x8 bf = tr8(b0, b0 + 4 * V_ST);
            acc = __builtin_amdgcn_mfma_f32_16x16x32_bf16(af[ks], bf, acc, 0, 0, 0); }
        *(f32x4*)(dsb + (size_t)(vt * 16 + fr) * 128 + dt * 16 + fq * 4) = acc;
    }
    __syncthreads();
}

__device__ __forceinline__ void gla_sample_item(int item, const bf16* __restrict__ Gq, const bf16* __restrict__ Gk, const bf16* __restrict__ Gv, const bf16* __restrict__ Gr, const float* __restrict__ GD,
                                                const float* __restrict__ Wgu, const float* __restrict__ bg, const float* __restrict__ ng, const float* __restrict__ S0, float* __restrict__ Sout, bf16* __restrict__ OGb,
                                                LAS unsigned char* lds, int tid, int lane) {
    const int b = item >> 2, h = item & 3;
    LAS float* A = (LAS float*)lds;
    LAS float* Qs = A + 512; LAS float* Ks = Qs + 512;
    LAS float* PO = Ks + 512;
    LAS float* RS = PO + 4096;
    { const int t = tid >> 7, d = tid & 127; const size_t tok = (size_t)TP + b * DS + t;
      float x = bg[h * 128 + d]; const float* gd = GD + tok * 16; float xs = 0.f;
#pragma unroll
      for (int r = 0; r < 16; ++r) xs = fmaf(gd[r], Wgu[r * 512 + h * 128 + d], xs);
      x += xs;
      A[t * 128 + d] = __expf(log_sigmoid_f(x) * (1.f / 16.f));
      Qs[t * 128 + d] = bf2f(Gq[tok * 512 + h * 128 + d]) * 0.08838834764831845f; Ks[t * 128 + d] = bf2f(Gk[tok * 512 + h * 128 + d]); }
    __syncthreads();
    const int dq = tid >> 7, d0 = dq * 32;
#pragma unroll 1
    for (int vhalf = 0; vhalf < 2; ++vhalf) {
        const int v = vhalf * 128 + (tid & 127);
        float S[32];
#pragma unroll
        for (int i = 0; i < 32; ++i) S[i] = S0[(((size_t)b * 4 + h) * 128 + d0 + i) * 256 + v];
#pragma unroll 1
        for (int t = 0; t < 4; ++t) {
            const float vv = bf2f(Gv[((size_t)TP + b * DS + t) * 1024 + h * 256 + v]); float o = 0.f;
#pragma unroll
            for (int i = 0; i < 32; ++i) { S[i] = fmaf(A[t * 128 + d0 + i], S[i], Ks[t * 128 + d0 + i] * vv); o = fmaf(Qs[t * 128 + d0 + i], S[i], o); }
            PO[(dq * 4 + t) * 256 + v] = o;
        }
#pragma unroll
        for (int i = 0; i < 32; ++i) Sout[(((size_t)b * 4 + h) * 128 + d0 + i) * 256 + v] = S[i];
    }
    __syncthreads();
    { const int t = tid >> 7, vl = tid & 127; const float o0 = (PO[t * 256 + vl] + PO[(4 + t) * 256 + vl]) + (PO[(8 + t) * 256 + vl] + PO[(12 + t) * 256 + vl]), o1 = (PO[t * 256 + 128 + vl] + PO[(4 + t) * 256 + 128 + vl]) + (PO[(8 + t) * 256 + 128 + vl] + PO[(12 + t) * 256 + 128 + vl]);
      float ss = o0 * o0 + o1 * o1;
#pragma unroll
      for (int o = 1; o < 64; o <<= 1) ss += __shfl_xor(ss, o);
      if (lane == 0) RS[tid >> 6] = ss;
      __syncthreads();
      const float ms = (RS[2 * t] + RS[2 * t + 1]) * (1.f / 256.f), rstd = rsqrtf(ms + LN_EPS);
      const size_t tok = (size_t)TP + b * DS + t;
      OGb[tok * 1024 + h * 256 + vl] = (bf16)f2bf(o0 * rstd * ng[vl] * bf2f(Gr[tok * 1024 + h * 256 + vl]));
      OGb[tok * 1024 + h * 256 + 128 + vl] = (bf16)f2bf(o1 * rstd * ng[128 + vl] * bf2f(Gr[tok * 1024 + h * 256 + 128 + vl])); }
    __syncthreads();
}

__device__ __forceinline__ void gla_scan(const float* __restrict__ DS, const float* __restrict__ DEC, bf16* __restrict__ SP, float* __restrict__ Sout, int gtid, int gthreads) {
    typedef float f32x2 __attribute__((ext_vector_type(2)));
    for (int e = gtid; e < NBATCH * 4 * 256 * 64; e += gthreads) {
        const int d2 = e & 63, v = (e >> 6) & 255, h = (e >> 14) & 3, b = e >> 16;
        f32x2 S = (f32x2){0.f, 0.f};
#pragma unroll 8
        for (int c = 0; c < SEQ / 64; ++c) {
            const size_t item = ((size_t)b * (SEQ / 64) + c) * 4 + h;
            const f32x2 ds = *(const f32x2*)(DS + (item * 256 + v) * 128 + d2 * 2), dc = *(const f32x2*)(DEC + item * 128 + d2 * 2);
            *(unsigned*)(SP + (item * 256 + v) * 128 + d2 * 2) = pk2(S[0], S[1]);
            S = dc * S + ds;
        }
        float* so = Sout + (((size_t)b * 4 + h) * 128 + d2 * 2) * 256 + v; so[0] = S[0]; so[256] = S[1];
    }
}

__device__ __forceinline__ void gla_out_item(int item, const bf16* __restrict__ QT, const bf16* __restrict__ KT, const bf16* __restrict__ Gv, const bf16* __restrict__ Gr, const bf16* __restrict__ SP,
                                             const float* __restrict__ ng, bf16* __restrict__ OGb, LAS unsigned char* lds, int tid, int wave, int lane) {
    const int h = item & 3, bc = item >> 2; const size_t tok0 = (size_t)bc * 64;
    const int fr = lane & 15, fq = lane >> 4, tt = wave & 3, vh = wave >> 2;
    LAS float* RS = (LAS float*)(lds + 64 * V_ST);
#pragma unroll
    for (int p = 0; p < 4; ++p) { const int e = tid + p * 512, s = e >> 5, ch = e & 31;
        *(LAS u32x4*)(lds + s * V_ST + ch * 16) = *(const u32x4*)(Gv + (tok0 + s) * 1024 + h * 256 + ch * 8); }
    bf16x8 qf[4];
#pragma unroll
    for (int ks = 0; ks < 4; ++ks) qf[ks] = *(const bf16x8*)(QT + (tok0 + tt * 16 + fr) * 512 + h * 128 + ks * 32 + fq * 8);
    bf16x8 pf[2];
    {
        f32x4 at[4];
#pragma unroll
        for (int st = 0; st < 4; ++st) {
            f32x4 acc = (f32x4){0.f, 0.f, 0.f, 0.f};
#pragma unroll
            for (int ks = 0; ks < 4; ++ks) { const bf16x8 kf = *(const bf16x8*)(KT + (tok0 + st * 16 + fr) * 512 + h * 128 + ks * 32 + fq * 8); acc = __builtin_amdgcn_mfma_f32_16x16x32_bf16(kf, qf[ks], acc, 0, 0, 0); }
#pragma unroll
            for (int j = 0; j < 4; ++j) { const int s = st * 16 + fq * 4 + j, t = tt * 16 + fr; if (s > t) acc[j] = 0.f; }
            at[st] = acc;
        }
        const u32x4 w0 = pack8(at[0], at[1]), w1 = pack8(at[2], at[3]);
        pf[0] = __builtin_bit_cast(bf16x8, w0); pf[1] = __builtin_bit_cast(bf16x8, w1);
    }
    __syncthreads();
    const bf16* spb = SP + (size_t)item * 256 * 128;
    f32x4 oacc[8]; float ss = 0.f;
#pragma unroll
    for (int i = 0; i < 8; ++i) {
        const int vt = vh * 8 + i;
        f32x4 acc = (f32x4){0.f, 0.f, 0.f, 0.f};
#pragma unroll
        for (int k2 = 0; k2 < 2; ++k2) {
            LAS unsigned char* a0 = lds + (k2 * 32 + fq * 4 + (fr >> 2)) * V_ST + (vt * 16 + 4 * (fr & 3)) * 2;
            const bf16x8 vf = tr8(a0, a0 + 16 * V_ST);
            acc = __builtin_amdgcn_mfma_f32_16x16x32_bf16(vf, pf[k2], acc, 0, 0, 0);
        }
#pragma unroll
        for (int ks = 0; ks < 4; ++ks) { const bf16x8 sf = *(const bf16x8*)(spb + (size_t)(vt * 16 + fr) * 128 + ks * 32 + fq * 8); acc = __builtin_amdgcn_mfma_f32_16x16x32_bf16(sf, qf[ks], acc, 0, 0, 0); }
        oacc[i] = acc; ss += (acc[0] * acc[0] + acc[1] * acc[1]) + (acc[2] * acc[2] + acc[3] * acc[3]);
    }
    ss += __shfl_xor(ss, 16); ss += __shfl_xor(ss, 32);
    if (fq == 0) RS[wave * 16 + fr] = ss;
    __syncthreads();
    const float ms = (RS[tt * 16 + fr] + RS[(tt + 4) * 16 + fr]) * (1.f / 256.f), rstd = rsqrtf(ms + LN_EPS);
    const size_t tok = tok0 + tt * 16 + fr;
#pragma unroll
    for (int i = 0; i < 8; ++i) {
        const int v = (vh * 8 + i) * 16 + fq * 4;
        const u32x2 rw = *(const u32x2*)(Gr + tok * 1024 + h * 256 + v); const f32x4 g = *(const f32x4*)(ng + v);
        u32x2 w; w.x = pk2(oacc[i][0] * rstd * g[0] * bflo(rw.x), oacc[i][1] * rstd * g[1] * bfhi(rw.x)); w.y = pk2(oacc[i][2] * rstd * g[2] * bflo(rw.y), oacc[i][3] * rstd * g[3] * bfhi(rw.y));
        *(u32x2*)(OGb + tok * 1024 + h * 256 + v) = w;
    }
    __syncthreads();
}
}

namespace mk {
#ifndef MIX_V2
#define MIX_V1 1
#endif
#if defined(MIX_V1)
#define MIXSEL(Hf, te, tg, U, V, Us, Vs, g2, b2, of, ob, lds, wave, gw, NGW, lane) phase_peer_mix(Hf, te, tg, U, V, Us, Vs, g2, b2, of, ob, gw, NGW, lane)
#define MIX_FROM_Z 1
#else
#define MIXSEL(Hf, te, tg, U, V, Us, Vs, g2, b2, of, ob, lds, wave, gw, NGW, lane) phase_peer_mix2(Hf, H1b, te, tg, U, V, Us, Vs, g2, b2, of, ob, lds, wave, gw, NGW, lane)
#endif
#define PEER_USLICE(Hb_, U_, Us_) do { if (G % 8 == 0) { const int per_ = G / 8; peer_u_slice(vcu / per_, (vcu % per_) * NWAVES + wave, per_ * NWAVES, Hb_, TEID, U_, HDB, lds + wave * 16384, lane); } \
        else { for (int sl_ = 0; sl_ < 8; ++sl_) peer_u_slice(sl_, gw, NGW, Hb_, TEID, U_, HDB, lds + wave * 16384, lane); } } while (0)
struct Args {
    const float* in[23]; const int* page_table; float* out; unsigned char* ws; int ph_lo, ph_hi;
};
enum Phase { P_PRO = 0, P_AIN = 1, P_SCORE = 2, P_TOPK = 3, P_ATTN = 4, P_AOUT = 5, P_LN1 = 6, P_PQ0 = 7, P_PEER0 = 8, P_GIN = 9, P_GCH = 10, P_GSC = 11, P_GOUT = 12, P_GPRJ = 13, P_LN1B = 14, P_PQ1 = 15, P_PEER1 = 16, P_COUNT = 17 };

#define Wa ((bf16*)(ws + WS_WA))
#define Wo ((bf16*)(ws + WS_WO))
#define Wg ((bf16*)(ws + WS_WG))
#define Wgo ((bf16*)(ws + WS_WGO))
#define Wpq ((bf16*)(ws + WS_WPQ))
#define PK ((bf16*)(ws + WS_PK))
#define Usc ((float*)(ws + WS_USC))
#define Xb ((bf16*)(ws + WS_XB))
#define Qb ((bf16*)(ws + WS_QB))
#define QIb ((bf16*)(ws + WS_QIB))
#define Kb ((bf16*)(ws + WS_KB))
#define Vb ((bf16*)(ws + WS_VB))
#define KIb ((bf16*)(ws + WS_KIB))
#define WIf ((float*)(ws + WS_WIF))
#define SC ((float*)(ws + WS_SC))
#define SCS ((float*)(ws + WS_SCS))
#define IDX ((int*)(ws + WS_IDX))
#define CNT ((int*)(ws + WS_CNT))
#define Ob ((bf16*)(ws + WS_OB))
#define Z ((float*)(ws + WS_Z))
#define H1f ((float*)(ws + WS_H1F))
#define H1b ((bf16*)(ws + WS_H1B))
#define PQb ((bf16*)(ws + WS_PQB))
#define H2f ((float*)(ws + WS_H2F))
#define H2b ((bf16*)(ws + WS_H2B))
#define TEID ((unsigned short*)(ws + WS_TEID))
#define TGATE ((float*)(ws + WS_TGATE))
#define Gq ((bf16*)(ws + WS_GQ))
#define Gk ((bf16*)(ws + WS_GK))
#define Gv ((bf16*)(ws + WS_GV))
#define Gr ((bf16*)(ws + WS_GR))
#define GD ((float*)(ws + WS_GD))
#define QT ((bf16*)(ws + WS_QT))
#define KT ((bf16*)(ws + WS_KT))
#define DEC ((float*)(ws + WS_DEC))
#define DSb ((float*)(ws + WS_DS))
#define SPV ((bf16*)(ws + WS_SPREV))
#define OGb ((bf16*)(ws + WS_OGB))
#define HDB ((float*)(ws + WS_HD))
#define KV8 ((unsigned char*)(ws + WS_KV8))
#define Uq (ws + WS_UB)
#define Vq (ws + WS_VBX)
#define Usc ((float*)(ws + WS_USC))
#define Vsc ((float*)(ws + WS_USC) + 2 * 16384)
#define x_prompt (INP(0))
#define x_sample (INP(1))
#define attn_w_in (INP(7))
#define attn_w_out (INP(8))
#define gla_w_in (INP(9))
#define gla_w_out (INP(13))
#define peer_w_q (INP(14))
#define peer_keys1 (INP(15))
#define peer_keys2 (INP(16))
#define peer_u (INP(17))
#define peer_v (INP(18))
__device__ __forceinline__ unsigned char* launder_ptr(unsigned char* p) { asm volatile("" : "+s"(p)); return p; }
#if defined(LOWSGPR)
#define ws (launder_ptr(args.ws))
#define INP(k) ((const float*)inp_ptr(lds, (k)))
#else
#define ws (args.ws)
#define INP(k) (args.in[k])
#endif
__device__ __forceinline__ const void* inp_ptr(LAS unsigned char* lds, int k) {
    const unsigned long long v = *(LAS unsigned long long*)(lds + INPTAB_OFF + 8 * k);
    const unsigned lo = __builtin_amdgcn_readfirstlane((unsigned)v), hi = __builtin_amdgcn_readfirstlane((unsigned)(v >> 32));
    return (const void*)(((unsigned long long)hi << 32) | lo);
}
__global__ void __launch_bounds__(NTHREADS, 2) mk_fwd(Args args) {
    extern __shared__ __attribute__((aligned(16))) unsigned char lds_raw[];
    LAS unsigned char* lds = (LAS unsigned char*)lds_raw;
    volatile LAS unsigned* MISC = (volatile LAS unsigned*)(lds + MISC_OFF);
    const int tid = threadIdx.x, lane = tid & 63, wave = __builtin_amdgcn_readfirstlane(tid >> 6);
    const int G = gridDim.x, bx = blockIdx.x;
    const int vcu = (G % 8 == 0) ? (bx % 8) * (G / 8) + bx / 8 : bx;
    const int gw = vcu * NWAVES + wave, NGW = G * NWAVES;
    gu32* ctl = (gu32*)(ws + WS_CTL);
    for (int u = tid; u < (LDS_BYTES - LDSCTL_OFF) / 4; u += NTHREADS) ((LAS unsigned*)(lds + LDSCTL_OFF))[u] = 0u;
    __syncthreads();
    if (tid == 0) {
#define PUTIN(k) *(LAS unsigned long long*)(lds + INPTAB_OFF + 8 * (k)) = (unsigned long long)args.in[k]
        PUTIN(0); PUTIN(1); PUTIN(2); PUTIN(3); PUTIN(4); PUTIN(5); PUTIN(6); PUTIN(7); PUTIN(8); PUTIN(9); PUTIN(10); PUTIN(11); PUTIN(12); PUTIN(13); PUTIN(14); PUTIN(15);
        PUTIN(16); PUTIN(17); PUTIN(18); PUTIN(19); PUTIN(20); PUTIN(21); PUTIN(22);
#undef PUTIN
    }
    __syncthreads();
    XcdBarrier bar = xcd_barrier_post((unsigned*)(ctl + CW_BAR), MISC + 8);
    if (tid == 0) { const unsigned xme = xb_xcc_id(); MISC[13] = xme; MISC[12] = __hip_atomic_fetch_add((unsigned*)(ctl + CW_XC + 64 * xme), 1u, __ATOMIC_RELAXED, __HIP_MEMORY_SCOPE_AGENT); }
    const int lo = args.ph_lo, hi = args.ph_hi;
#define IN(k) (lo <= (k) && (k) < hi)
#define SEAM(k) do { if (IN(k) && IN((k) + 1)) xcd_barrier(bar); } while (0)
#ifndef REPEAT_PHASE
#define REPEAT_PHASE -1
#endif
#ifndef REPEAT_N
#define REPEAT_N 2
#endif
#define REP(k) for (int rep_ = 0; rep_ < (REPEAT_PHASE == (k) ? REPEAT_N : 1); ++rep_)


    if (IN(P_PRO)) {
        LAS float* scr = (LAS float*)(lds + wave * 16384);
        constexpr int KB16 = D / 64;
        constexpr int I_WA = (WA_ROWS / 32) * KB16, I_WO = (D / 32) * KB16, I_WG = (WG_ROWS / 32) * KB16, I_WGO = (D / 32) * KB16, I_WPQ = 2 * (PEER_N / 32) * KB16;
        constexpr int NITEMS = I_WA + I_WO + I_WG + I_WGO + I_WPQ;
        for (int it = gw; it < NITEMS; it += NGW) {
            int r = it;
            if (r < I_WA) { const int nb = r / KB16, kb = r % KB16, d0 = nb * 32; const int nv = ATT_N - d0 < 0 ? 0 : (ATT_N - d0 > 32 ? 32 : ATT_N - d0);
                p0_transpose_item(attn_w_in, ATT_N, D, Wa, d0, d0, nv, kb * 64, scr, lane); continue; } r -= I_WA;
            if (r < I_WO) { const int nb = r / KB16, kb = r % KB16; p0_transpose_item(attn_w_out, D, D, Wo, nb * 32, nb * 32, 32, kb * 64, scr, lane); continue; } r -= I_WO;
            if (r < I_WG) { const int nb = r / KB16, kb = r % KB16, d0 = nb * 32; int s0, nv;
                if (d0 < GN_R) { s0 = d0; nv = 32; } else if (d0 < GN_GD) { s0 = GR + (d0 - GN_R); nv = 32; } else if (d0 == GN_GD) { s0 = GGD; nv = 16; } else { s0 = 0; nv = 0; }
                p0_transpose_item(gla_w_in, GLA_N, D, Wg, d0, s0, nv, kb * 64, scr, lane); continue; } r -= I_WG;
            if (r < I_WGO) { const int nb = r / KB16, kb = r % KB16; p0_transpose_item(gla_w_out, D, D, Wgo, nb * 32, nb * 32, 32, kb * 64, scr, lane); continue; } r -= I_WGO;
            { const int l = r / ((PEER_N / 32) * KB16), rr = r % ((PEER_N / 32) * KB16), nb = rr / KB16, kb = rr % KB16;
              p0_transpose_item(peer_w_q + (size_t)l * D * PEER_N, PEER_N, D, Wpq + (size_t)l * PEER_N * D, nb * 32, nb * 32, 32, kb * 64, scr, lane); }
        }
        p0_convert(x_prompt, Xb, (size_t)TP * D / 8, gw, NGW, lane);
        p0_convert(x_sample, Xb + (size_t)TP * D, (size_t)TS * D / 8, gw, NGW, lane);
        p0_convert(peer_keys1, PK, (size_t)2 * 128 * 128 / 8, gw, NGW, lane);
        p0_convert(peer_keys2, PK + 2 * 128 * 128, (size_t)2 * 128 * 128 / 8, gw, NGW, lane);
    }
    SEAM(P_PRO);

    if (IN(P_AIN)) {
        FAttnIn F{Qb, Kb, Vb, QIb, KIb, WIf, args.out};
        { pg8::Gemm g{Xb, Wa, TP, 2048, D}; pg8::StaticOrder S; S.init(TP, 2048, G, bx);
          pg8::EpiRow8<FAttnIn> E{F};
          pg8::gemm_phase<pg8::EpiRow8<FAttnIn>, pg8::StaticOrder, true, true>(lds, g, S, E);
          float km = E.f.kmax, vm = E.f.vmax;
#pragma unroll
          for (int o = 1; o < 64; o <<= 1) { km = fmaxf(km, __shfl_xor(km, o)); vm = fmaxf(vm, __shfl_xor(vm, o)); }
          if (lane == 0) { if (km > 0.f) atomicMax((unsigned*)(ctl + CW_AMAXK), __builtin_bit_cast(unsigned, km)); if (vm > 0.f) atomicMax((unsigned*)(ctl + CW_AMAXV), __builtin_bit_cast(unsigned, vm)); } }
        for (int it = gw; it < TP / 16 + 8 * 34; it += NGW) {
            if (it < TP / 16) {
                f32x4 acc[5]; skinny_tile<5>(Xb, D, Wa, D, it * 16, 2048, acc, lane);
#pragma unroll
                for (int ct = 0; ct < 5; ++ct) F.put4(it * 16 + (lane & 15), 2048 + ct * 16 + 4 * (lane >> 4), acc[ct]);
            } else {
                const int r = it - TP / 16, rt = r % 8, cg = r / 8;
                f32x4 acc[4]; skinny_tile<4>(Xb, D, Wa, D, TP + rt * 16, cg * 64, acc, lane);
#pragma unroll
                for (int ct = 0; ct < 4; ++ct) F.put4(TP + rt * 16 + (lane & 15), cg * 64 + ct * 16 + 4 * (lane >> 4), acc[ct]);
            }
        }
    }
    SEAM(P_AIN);

            if (IN(P_SCORE)) { kv8_convert(Kb, Vb, KV8, (const unsigned*)(ctl + CW_AMAXK), (const unsigned*)(ctl + CW_AMAXV), gw, NGW, lane);
        phase_score(QIb, KIb, WIf, INP(4), args.page_table, SC, SCS, QuantTabs{peer_u, peer_v, Uq, Vq, Usc, Vsc}, lds, vcu, G, wave, lane, gw, NGW); }
    SEAM(P_SCORE);
    if (IN(P_TOPK)) {
        const int jlo_ = 0, jhi_ = TA;
        phase_topk2(SC, SCS, IDX, CNT, peer_u, peer_v, Uq, Vq, Usc, Vsc, lds, (unsigned*)(ctl + CW_Q1), wave, lane, gw, NGW, jlo_, jhi_); }
    SEAM(P_TOPK);
    if (IN(P_ATTN)) {
        LAS unsigned char* wl = lds + wave * 16384;
        {
            if (tid == 0) { unsigned np = 0, mi = 0, mycnt = 1; const unsigned xme = MISC[13];
                for (unsigned j = 0; j < 16; ++j) { const unsigned c = __hip_atomic_load((unsigned*)(ctl + CW_XC + 64 * j), __ATOMIC_RELAXED, __HIP_MEMORY_SCOPE_AGENT); if (c > 0u) { if (j < xme) ++mi; ++np; } if (j == xme) mycnt = c > 0u ? c : 1u; }
                MISC[14] = np > 0u ? np : 1u; MISC[15] = mi; MISC[16] = mycnt; }
            __syncthreads();
            const int np = (int)MISC[14], mi = (int)MISC[15], mycnt = (int)MISC[16], rank = (int)MISC[12];
            for (int u = 0; u < NBATCH * 4; ++u) if (u % np == mi) attn_prompt_stream(u >> 2, u & 3, rank * NWAVES + wave, mycnt * NWAVES, Qb, IDX, KV8, (const unsigned*)(ctl + CW_AMAXK), (const unsigned*)(ctl + CW_AMAXV), Ob, wl, lane);
        }
        {
            const float* ck_ = INP(2); const float* cv_ = INP(3); float* o_ = args.out; const int* pt_ = args.page_table; int gws_ = gw; int lane_s = lane;
            asm volatile("" : "+s"(ck_), "+s"(cv_), "+s"(o_), "+s"(pt_), "+s"(gws_), "+v"(lane_s));
            for (int su = gws_; su < TS * 4 * 4; su += NGW) {
                if ((su & 3) == 0) { const int un = su >> 2, r = un >> 2, n = un & 3; attn_row<true>(TP + r, n, n + 1, Qb, IDX, CNT, nullptr, nullptr, ck_, cv_, o_ + OUT_KS, o_ + OUT_VS, pt_, Ob, wl, lane_s); }
            }
        }
    }
    SEAM(P_ATTN);
    if (IN(P_AOUT)) {
        FResid F{x_prompt, x_sample, Z};
        { pg8::Gemm g{Ob, Wo, TP, D, D}; pg8::StaticOrder S; S.init(TP, D, G, bx);
          pg8::EpiRow8<FResid> E{F};
          pg8::gemm_phase<pg8::EpiRow8<FResid>, pg8::StaticOrder, true, true>(lds, g, S, E); }
        for (int it = gw; it < 8 * 16; it += NGW) {
            const int rt = it % 8, cg = it / 8;
            f32x4 acc[4]; skinny_tile<4>(Ob, D, Wo, D, TP + rt * 16, cg * 64, acc, lane);
#pragma unroll
            for (int ct = 0; ct < 4; ++ct) F.put4(TP + rt * 16 + (lane & 15), cg * 64 + ct * 16 + 4 * (lane >> 4), acc[ct]);
        }
    }
    SEAM(P_AOUT);
    if (IN(P_LN1)) { for (int r = gw; r < TA; r += NGW) ln_row_wave(Z + (size_t)r * D, INP(19), INP(20), (float*)nullptr, H1b + (size_t)r * D, lane); }
    SEAM(P_LN1);

        if (IN(P_PQ0)) {
        FStoreBf16 F{PQb, PEER_N};
        { pg8::Gemm g{H1b, Wpq, TP, PEER_N, D}; pg8::StaticOrder S; S.init(TP, PEER_N, G, bx);
          pg8::EpiRow8<FStoreBf16> E{F};
          pg8::gemm_phase<pg8::EpiRow8<FStoreBf16>, pg8::StaticOrder, true, true>(lds, g, S, E); }
        for (int it = gw; it < 8 * 32; it += NGW) {
            const int rt = it % 8, cg = it / 8;
            f32x4 acc[4]; skinny_tile<4>(H1b, D, Wpq, D, TP + rt * 16, cg * 64, acc, lane);
#pragma unroll
            for (int ct = 0; ct < 4; ++ct) F.put4(TP + rt * 16 + (lane & 15), cg * 64 + ct * 16 + 4 * (lane >> 4), acc[ct]);
        }
#if 0
        for (int it = gw; it < 8 * 16; it += NGW) {
            const int rt = it % 8, cg = it / 8;
            f32x4 acc[8]; skinny_tile<8>(H1b, D, Wpq, D, TP + rt * 16, cg * 128, acc, lane);
#pragma unroll
            for (int ct = 0; ct < 8; ++ct) F.put4(TP + rt * 16 + (lane & 15), cg * 128 + ct * 16 + 4 * (lane >> 4), acc[ct]);
        }
#endif
    }
    SEAM(P_PQ0);
        if (IN(P_PEER0)) {
        phase_peer_select(PQb, PK, PK + 2 * 16384, TEID, TGATE, lds, vcu, G, wave, lane);
        xcd_barrier(bar);
#if defined(U_SLICED)
        PEER_USLICE(H1b, Uq, Usc);
        xcd_barrier(bar);
        phase_peer_mixv(Z, INP(19), INP(20), TEID, TGATE, HDB, Vq, Usc, Vsc, INP(21), INP(22), H2f, H2b, gw, NGW, lane);
#else
#if defined(MIX_FROM_Z)
        phase_peer_mix(Z, INP(19), INP(20), TEID, TGATE, Uq, Vq, Usc, Vsc, INP(21), INP(22), H2f, H2b, gw, NGW, lane);
#else
        MIXSEL(H1f, TEID, TGATE, Uq, Vq, Usc, Vsc, INP(21), INP(22), H2f, H2b, lds, wave, gw, NGW, lane);
#endif
#endif
    }
    SEAM(P_PEER0);

            if (IN(P_GIN)) {
        FGlaIn F{Gq, Gk, Gv, Gr, GD};
        { pg8::Gemm g{H2b, Wg, TP, 3072, D}; pg8::StaticOrder S; S.init(TP, 3072, G, bx);
          pg8::EpiRow8<FGlaIn> E{F};
          pg8::gemm_phase<pg8::EpiRow8<FGlaIn>, pg8::StaticOrder, true, true>(lds, g, S, E); }
        for (int it = gw; it < TP / 16 + 8 * 97; it += NGW) {
            if (it < TP / 16) {
                f32x4 acc[1]; skinny_tile<1>(H2b, D, Wg, D, it * 16, GN_GD, acc, lane);
                F.put4(it * 16 + (lane & 15), GN_GD + 4 * (lane >> 4), acc[0]);
            } else {
                const int r = it - TP / 16, rt = r % 8, cg = r / 8;
                f32x4 acc[2]; skinny_tile<2>(H2b, D, Wg, D, TP + rt * 16, cg * 32, acc, lane);
#pragma unroll
                for (int ct = 0; ct < 2; ++ct) F.put4(TP + rt * 16 + (lane & 15), cg * 32 + ct * 16 + 4 * (lane >> 4), acc[ct]);
            }
        }
    }
    SEAM(P_GIN);
    if (IN(P_GCH)) {
        for (int it = vcu; it < NBATCH * (SEQ / 64) * 4; it += G) gla_chunk_item(it, Gq, Gk, Gv, GD, INP(10), INP(11), QT, KT, DEC, DSb, lds, tid, wave, lane);
        for (int it = vcu; it < DB * 4; it += G) gla_sample_item(it, Gq, Gk, Gv, Gr, GD, INP(10), INP(11), INP(12), INP(5), args.out + OUT_SS, OGb, lds, tid, lane);
    }
    SEAM(P_GCH);
    if (IN(P_GSC)) gla_scan(DSb, DEC, SPV, args.out + OUT_SP, vcu * NTHREADS + tid, G * NTHREADS);
    SEAM(P_GSC);
    if (IN(P_GOUT)) { for (int it = vcu; it < NBATCH * (SEQ / 64) * 4; it += G) gla_out_item(it, QT, KT, Gv, Gr, SPV, INP(12), OGb, lds, tid, wave, lane); }
    SEAM(P_GOUT);
    if (IN(P_GPRJ)) {
        FResid F{H2f, H2f + (size_t)TP * D, Z};
        { pg8::Gemm g{OGb, Wgo, TP, D, D}; pg8::StaticOrder S; S.init(TP, D, G, bx);
          pg8::EpiRow8<FResid> E{F};
          pg8::gemm_phase<pg8::EpiRow8<FResid>, pg8::StaticOrder, true, true>(lds, g, S, E); }
        for (int it = gw; it < 8 * 16; it += NGW) {
            const int rt = it % 8, cg = it / 8;
            f32x4 acc[4]; skinny_tile<4>(OGb, D, Wgo, D, TP + rt * 16, cg * 64, acc, lane);
#pragma unroll
            for (int ct = 0; ct < 4; ++ct) F.put4(TP + rt * 16 + (lane & 15), cg * 64 + ct * 16 + 4 * (lane >> 4), acc[ct]);
        }
    }
    SEAM(P_GPRJ);
    if (IN(P_LN1B)) { for (int r = gw; r < TA; r += NGW) ln_row_wave(Z + (size_t)r * D, INP(19) + D, INP(20) + D, (float*)nullptr, H1b + (size_t)r * D, lane); }
    SEAM(P_LN1B);
    if (IN(P_PQ1)) {
        FStoreBf16 F{PQb, PEER_N}; const bf16* W1 = Wpq + (size_t)PEER_N * D;
        { pg8::Gemm g{H1b, W1, TP, PEER_N, D}; pg8::StaticOrder S; S.init(TP, PEER_N, G, bx);
          pg8::EpiRow8<FStoreBf16> E{F};
          pg8::gemm_phase<pg8::EpiRow8<FStoreBf16>, pg8::StaticOrder, true, true>(lds, g, S, E); }
        for (int it = gw; it < 8 * 32; it += NGW) {
            const int rt = it % 8, cg = it / 8;
            f32x4 acc[4]; skinny_tile<4>(H1b, D, W1, D, TP + rt * 16, cg * 64, acc, lane);
#pragma unroll
            for (int ct = 0; ct < 4; ++ct) F.put4(TP + rt * 16 + (lane & 15), cg * 64 + ct * 16 + 4 * (lane >> 4), acc[ct]);
        }
    }
    SEAM(P_PQ1);
    if (IN(P_PEER1)) {
        phase_peer_select(PQb, PK + 16384, PK + 3 * 16384, TEID, TGATE, lds, vcu, G, wave, lane);
        xcd_barrier(bar);
#if defined(U_SLICED)
        PEER_USLICE(H1b, Uq + (size_t)16384 * PEER_RB, Usc + 16384);
        xcd_barrier(bar);
        phase_peer_mixv(Z, INP(19) + D, INP(20) + D, TEID, TGATE, HDB, Vq + (size_t)16384 * PEER_RB, Usc + 16384, Vsc + 16384, INP(21) + D, INP(22) + D, args.out + OUT_Y, nullptr, gw, NGW, lane);
#else
#if defined(MIX_FROM_Z)
        phase_peer_mix(Z, INP(19) + D, INP(20) + D, TEID, TGATE, Uq + (size_t)16384 * PEER_RB, Vq + (size_t)16384 * PEER_RB, Usc + 16384, Vsc + 16384, INP(21) + D, INP(22) + D, args.out + OUT_Y, nullptr, gw, NGW, lane);
#else
        MIXSEL(H1f, TEID, TGATE, Uq + (size_t)16384 * PEER_RB, Vq + (size_t)16384 * PEER_RB, Usc + 16384, Vsc + 16384, INP(21) + D, INP(22) + D, args.out + OUT_Y, nullptr, lds, wave, gw, NGW, lane);
#endif
#endif
    }
#undef IN
#undef SEAM
}
#undef ws
#undef INP
#undef Wa
#undef Wo
#undef Wg
#undef Wgo
#undef Wpq
#undef PK
#undef Usc
#undef Xb
#undef Qb
#undef QIb
#undef Kb
#undef Vb
#undef KIb
#undef WIf
#undef SC
#undef SCS
#undef IDX
#undef CNT
#undef Ob
#undef Z
#undef H1f
#undef H1b
#undef PQb
#undef H2f
#undef H2b
#undef TEID
#undef TGATE
#undef Gq
#undef Gk
#undef Gv
#undef Gr
#undef GD
#undef QT
#undef KT
#undef DEC
#undef DSb
#undef SPV
#undef OGb
#undef Uq
#undef HDB
#undef KV8
#undef Vq
#undef Usc
#undef Vsc
#undef x_prompt
#undef x_sample
#undef attn_w_in
#undef attn_w_out
#undef gla_w_in
#undef gla_w_out
#undef peer_w_q
#undef peer_keys1
#undef peer_keys2
#undef peer_u
#undef peer_v


}

extern "C" void kernel_launch(void* const* d_in, const int* in_sizes, int n_in, void* d_out, int out_size, void* d_ws, size_t ws_size, hipStream_t stream) {
    if (ws_size < mk::WS_END || n_in != 23 || (size_t)out_size != OUT_TOTAL) { fprintf(stderr, "kernel_launch: unexpected sizes ws %zu n_in %d out %d\n", ws_size, n_in, out_size); return; }
    static int grid = 0;
    if (grid == 0) {
        int dev = 0, cus = 0;
        if (hipGetDevice(&dev) != hipSuccess || hipDeviceGetAttribute(&cus, hipDeviceAttributeMultiprocessorCount, dev) != hipSuccess) { fprintf(stderr, "kernel_launch: device query failed\n"); grid = -1; return; }
        if (hipFuncSetAttribute((const void*)mk::mk_fwd, hipFuncAttributeMaxDynamicSharedMemorySize, mk::LDS_BYTES) != hipSuccess) { fprintf(stderr, "kernel_launch: hipFuncSetAttribute failed\n"); grid = -1; return; }
        int per_cu = 0;
        if (hipOccupancyMaxActiveBlocksPerMultiprocessor(&per_cu, (const void*)mk::mk_fwd, mk::NTHREADS, mk::LDS_BYTES) != hipSuccess || per_cu < 1) fprintf(stderr, "kernel_launch: occupancy query says %d\n", per_cu);
        (void)hipGetLastError();
        grid = cus;
    }
    if (grid < 0) return;
    (void)hipMemsetAsync((char*)d_ws + mk::WS_CTL, 0, mk::CTL_ZERO_BYTES, stream);
    mk::Args a{};
    for (int i = 0; i < 23; ++i) a.in[i] = (const float*)d_in[i];
    a.page_table = (const int*)d_in[6]; a.out = (float*)d_out; a.ws = (unsigned char*)d_ws; a.ph_lo = 0; a.ph_hi = mk::P_COUNT;
    hipLaunchKernelGGL(mk::mk_fwd, dim3(grid), dim3(mk::NTHREADS), mk::LDS_BYTES, stream, a);
}
```

```cpp
#include <hip/hip_runtime.h>
#include <cstdio>
#include <cstdint>
#include <cmath>

constexpr int D = 1024;
constexpr int NBATCH = 2, SEQ = 8192, TP = NBATCH * SEQ;
constexpr int DB = 32, DS = 4, TS = DB * DS;
constexpr int TA = TP + TS;
constexpr int PAST = 8192, PAGE = 128, NPAGES = PAST / PAGE;
constexpr float ALPHA = 1.4142135623730951f;
constexpr float LN_EPS = 1e-5f;
constexpr int ATT_N = 2120;
constexpr int AQ = 0, AK = 1024, AV = 1280, AQI = 1536, AKI = 2048, AWI = 2112;
constexpr int TOPK = 256;
constexpr int GLA_N = 3088;
constexpr int GQ = 0, GK = 512, GV = 1024, GGD = 2048, GR = 2064;
constexpr int PEER_N = 2048;
constexpr int SCS_LD = 8256;

constexpr size_t OUT_Y = 0, OUT_KP = 16908288, OUT_VP = 21102592, OUT_KIP = 25296896, OUT_SP = 26345472,
                 OUT_KS = 26607616, OUT_VS = 26640384, OUT_KIS = 26673152, OUT_SS = 26681344, OUT_TOTAL = 30875648;


namespace pg8 {
#define PG8_LAS __attribute__((address_space(3)))
typedef unsigned short bf16_t;
typedef short bf16x8 __attribute__((ext_vector_type(8)));
typedef float f32x4 __attribute__((ext_vector_type(4)));
typedef unsigned u32x4 __attribute__((ext_vector_type(4)));
constexpr int BM = 256, BK = 64, HALF = 128, HTB = HALF * BK * 2  , STAGE_BYTES = 8 * HTB, NXCD = 8, WGM = 8;

__host__ __device__ __forceinline__ int lds_byte(int r, int c) { const int st = (r >> 4) * 2 + (c >> 5), rr = r & 15, cc = c & 31, ob = rr * 64 + cc * 2; return st * 1024 + (ob ^ (((ob >> 9) & 1) << 5)); }
__host__ __device__ __forceinline__ void stage_rc(int b, int& R, int& C) { const int st = b / 1024, sb = b % 1024, swz = sb ^ (((sb >> 9) & 1) << 5); R = (st >> 1) * 16 + swz / 64; C = (st & 1) * 32 + (swz % 64) / 2; }
__host__ __device__ __forceinline__ int perm32(int rho) { const int n = rho >> 4, i = rho & 15; return 8 * (i >> 2) + 4 * n + (i & 3); }

struct Unit { int pm, pn; };
struct Gemm { const bf16_t* A; const bf16_t* Bt; int M, N, K; };

struct StaticOrder {
    int nM, nN, nwg, G, c;
    __host__ __device__ void init(int M, int N, int G_, int c_) { nM = M / BM; nN = N / BM; nwg = nM * nN; G = G_; c = c_; }
    __host__ __device__ bool next(int i, Unit& u) const {
        const long L = (long)i * G + c; if (L >= nwg) return false;
        int wgid = (int)L; { const int q = nwg / NXCD, r = nwg % NXCD, xcd = wgid % NXCD, off = wgid / NXCD; wgid = (xcd < r ? xcd * (q + 1) : r * (q + 1) + (xcd - r) * q) + off; }
        const int nig = WGM * nN, gid = wgid / nig, fm = gid * WGM, gsz = (nM - fm) < WGM ? (nM - fm) : WGM;
        u.pm = fm + ((wgid % nig) % gsz); u.pn = (wgid % nig) / gsz; return true;
    }
    __device__ __forceinline__ void a_ready(const Unit&) const {}
    __device__ __forceinline__ void done(const Unit&) const {}
};

__device__ __forceinline__ unsigned cvt_pk_bf16(float lo, float hi) { unsigned r; asm volatile("v_cvt_pk_bf16_f32 %0, %1, %2" : "=v"(r) : "v"(lo), "v"(hi)); return r; }
template <class F> struct EpiRow8 {
    static constexpr bool PERM = true, AFTER_DRAIN = false;
    F f;
    __device__ __forceinline__ void operator()(const f32x4 (&acc)[2][2][4][2], const Unit& u, int wr, int wc, int fr, int fq) const {
        const int row0 = u.pm * BM + wr * 64 + fr, col0 = u.pn * BM + wc * 32 + 8 * fq;
#pragma unroll
        for (int ai = 0; ai < 2; ++ai)
#pragma unroll
            for (int m = 0; m < 4; ++m)
#pragma unroll
                for (int bj = 0; bj < 2; ++bj) f.put8(row0 + ai * HALF + m * 16, col0 + bj * HALF, acc[ai][bj][m][0], acc[ai][bj][m][1]);
    }
};


template <class Epi, class Sched, bool ALIGN_EPI = false, bool SP2 = false>
__device__ __forceinline__ void gemm_phase(PG8_LAS unsigned char* lds, const Gemm g, const Sched& S, const Epi& E) {
    const int tid = threadIdx.x, wid = __builtin_amdgcn_readfirstlane(tid >> 6), lane = tid & 63, wr = wid >> 2, wc = wid & 3, fr = lane & 15, fq = lane >> 4;
    const int K = g.K, nt = K / BK;
    unsigned voffA[2], voffB[2];
#pragma unroll
    for (int i = 0; i < 2; ++i) { int R, C; stage_rc(tid * 16 + i * 8192, R, C); const int Rb = Epi::PERM ? ((R & ~31) + perm32(R & 31)) : R;
        voffA[i] = (unsigned)(R * K + C) * 2u; voffB[i] = (unsigned)(Rb * K + C) * 2u; }
    const size_t kstep = (size_t)(BK * 2);
    const size_t hstep = (size_t)HALF * K * 2;
    const size_t tstep = 2 * hstep;
    const unsigned ldsw = (unsigned)wid * 1024u;
    const int aoff = lds_byte(wr * 64 + fr, fq * 8), boff = lds_byte(wc * 32 + fr, fq * 8);
#define PG8_SA(b, h) (((b) * 2 + (h)) * HTB)
#define PG8_SB(b, h) ((4 + (b) * 2 + (h)) * HTB)
#define PG8_STAGE(bufoff, gbase, voff) do { _Pragma("unroll") for (int _i = 0; _i < 2; ++_i) \
        __builtin_amdgcn_global_load_lds((const unsigned*)((const char*)(gbase) + (voff)[_i]), (PG8_LAS unsigned*)(lds + (bufoff) + ldsw + _i * 8192), 16, 0, 0); } while (0)
#define PG8_LDA(dst, b, h) do { _Pragma("unroll") for (int m = 0; m < 4; ++m) _Pragma("unroll") for (int k = 0; k < 2; ++k) dst[m][k] = *(const PG8_LAS bf16x8*)(lds + PG8_SA(b, h) + aoff + m * 2048 + k * 1024); } while (0)
#define PG8_LDB(dst, b, h) do { _Pragma("unroll") for (int n = 0; n < 2; ++n) _Pragma("unroll") for (int k = 0; k < 2; ++k) dst[n][k] = *(const PG8_LAS bf16x8*)(lds + PG8_SB(b, h) + boff + n * 2048 + k * 1024); } while (0)
#define PG8_MMA(ai, bj, At, Bt) do { __builtin_amdgcn_s_setprio(1); _Pragma("unroll") for (int m = 0; m < 4; ++m) _Pragma("unroll") for (int n = 0; n < 2; ++n) _Pragma("unroll") for (int k = 0; k < 2; ++k) \
        acc[ai][bj][m][n] = __builtin_amdgcn_mfma_f32_16x16x32_bf16(Bt[n][k], At[m][k], acc[ai][bj][m][n], 0, 0, 0); __builtin_amdgcn_s_setprio(0); } while (0)
#define PG8_WAIT_V(n) asm volatile("s_waitcnt vmcnt(" #n ")" ::: "memory")
#define PG8_WAIT_L(n) asm volatile("s_waitcnt lgkmcnt(" #n ")" ::: "memory")
#define PG8_BAR __builtin_amdgcn_s_barrier()
#define PG8_SCHED __builtin_amdgcn_sched_barrier(0)
    Unit cur, nxt; int ui = 0;
    if (!S.next(0, cur)) return;
    f32x4 acc[2][2][4][2];
#pragma unroll
    for (int a = 0; a < 2; ++a)
#pragma unroll
        for (int b = 0; b < 2; ++b)
#pragma unroll
            for (int m = 0; m < 4; ++m)
#pragma unroll
                for (int n = 0; n < 2; ++n) acc[a][b][m][n] = (f32x4){0.f, 0.f, 0.f, 0.f};
    bf16x8 At[4][2], B0[2][2], B1[2][2];
    const char* cA = (const char*)g.A + (size_t)cur.pm * tstep; const char* cB = (const char*)g.Bt + (size_t)cur.pn * tstep;
    S.a_ready(cur);
    if constexpr (SP2) {
        PG8_STAGE(PG8_SB(0, 0), cB, voffB); PG8_STAGE(PG8_SB(0, 1), cB + hstep, voffB); PG8_STAGE(PG8_SA(0, 0), cA, voffA); PG8_STAGE(PG8_SA(0, 1), cA + hstep, voffA);
        if (wr == 1) PG8_BAR;
        PG8_WAIT_V(2); PG8_BAR;
        PG8_STAGE(PG8_SB(1, 0), cB + kstep, voffB); PG8_STAGE(PG8_SA(1, 0), cA + kstep, voffA); PG8_STAGE(PG8_SB(1, 1), cB + hstep + kstep, voffB);
        PG8_WAIT_V(6); PG8_BAR;
    } else {
        PG8_STAGE(PG8_SB(0, 0), cB, voffB); PG8_STAGE(PG8_SA(0, 0), cA, voffA); PG8_STAGE(PG8_SB(0, 1), cB + hstep, voffB); PG8_STAGE(PG8_SA(0, 1), cA + hstep, voffA);
        if (wr == 1) PG8_BAR;
        PG8_WAIT_V(4); PG8_BAR;
        PG8_STAGE(PG8_SB(1, 0), cB + kstep, voffB); PG8_STAGE(PG8_SA(1, 0), cA + kstep, voffA); PG8_STAGE(PG8_SB(1, 1), cB + hstep + kstep, voffB);
        PG8_WAIT_V(6); PG8_BAR;
    }
    for (;;) {
        const bool has_next = S.next(ui + 1, nxt);
        const char* nA = has_next ? (const char*)g.A + (size_t)nxt.pm * tstep : cA; const char* nB = has_next ? (const char*)g.Bt + (size_t)nxt.pn * tstep : cB;
        for (int t = 0; t < nt; t += 2) {
            const bool last = (t == nt - 2);
            const char* a1 = cA + (size_t)(t + 1) * kstep;
            const char* a2 = last ? nA : cA + (size_t)(t + 2) * kstep; const char* b2 = last ? nB : cB + (size_t)(t + 2) * kstep;
            const char* a3 = a2 + kstep; const char* b3 = b2 + kstep;
            if (last && has_next) S.a_ready(nxt);
            if constexpr (SP2) {
            PG8_LDB(B0, 0, 0); PG8_LDB(B1, 0, 1); PG8_SCHED; PG8_LDA(At, 0, 0); PG8_STAGE(PG8_SA(1, 1), a1 + hstep, voffA);
            PG8_WAIT_V(8); PG8_WAIT_L(0); PG8_BAR; PG8_MMA(0, 0, At, B0); PG8_MMA(0, 1, At, B1); PG8_BAR; PG8_SCHED;
            PG8_LDA(At, 0, 1); PG8_STAGE(PG8_SB(0, 0), b2, voffB); PG8_STAGE(PG8_SB(0, 1), b2 + hstep, voffB); PG8_STAGE(PG8_SA(0, 0), a2, voffA);
            PG8_WAIT_V(8); PG8_WAIT_L(0); PG8_BAR; PG8_MMA(1, 0, At, B0); PG8_MMA(1, 1, At, B1); PG8_BAR; PG8_SCHED;
            PG8_LDB(B0, 1, 0); PG8_LDB(B1, 1, 1); PG8_SCHED; PG8_LDA(At, 1, 0); PG8_STAGE(PG8_SA(0, 1), a2 + hstep, voffA);
            PG8_WAIT_V(8); PG8_WAIT_L(0); PG8_BAR; PG8_MMA(0, 0, At, B0); PG8_MMA(0, 1, At, B1); PG8_BAR; PG8_SCHED;
            PG8_LDA(At, 1, 1); PG8_STAGE(PG8_SB(1, 0), b3, voffB); PG8_STAGE(PG8_SB(1, 1), b3 + hstep, voffB); PG8_STAGE(PG8_SA(1, 0), a3, voffA);
            PG8_WAIT_V(8); PG8_WAIT_L(0); PG8_BAR; PG8_MMA(1, 0, At, B0); PG8_MMA(1, 1, At, B1); PG8_BAR; PG8_SCHED;
            } else {
            PG8_LDB(B0, 0, 0); PG8_SCHED; PG8_LDA(At, 0, 0); PG8_STAGE(PG8_SA(1, 1), a1 + hstep, voffA);
            PG8_WAIT_L(8); PG8_BAR; PG8_WAIT_L(0); PG8_MMA(0, 0, At, B0); PG8_BAR; PG8_SCHED;
            PG8_LDB(B1, 0, 1); PG8_STAGE(PG8_SB(0, 0), b2, voffB);
            PG8_BAR; PG8_WAIT_L(0); PG8_MMA(0, 1, At, B1); PG8_BAR;
            PG8_LDA(At, 0, 1); PG8_STAGE(PG8_SA(0, 0), a2, voffA);
            PG8_BAR; PG8_WAIT_L(0); PG8_MMA(1, 0, At, B0); PG8_BAR; PG8_SCHED;
            PG8_STAGE(PG8_SB(0, 1), b2 + hstep, voffB);
            PG8_WAIT_V(6); PG8_BAR; PG8_MMA(1, 1, At, B1); PG8_BAR;
            PG8_LDB(B0, 1, 0); PG8_SCHED; PG8_LDA(At, 1, 0); PG8_STAGE(PG8_SA(0, 1), a2 + hstep, voffA);
            PG8_WAIT_L(8); PG8_BAR; PG8_WAIT_L(0); PG8_MMA(0, 0, At, B0); PG8_BAR; PG8_SCHED;
            PG8_LDB(B1, 1, 1); PG8_STAGE(PG8_SB(1, 0), b3, voffB);
            PG8_BAR; PG8_WAIT_L(0); PG8_MMA(0, 1, At, B1); PG8_BAR;
            PG8_LDA(At, 1, 1); PG8_STAGE(PG8_SA(1, 0), a3, voffA);
            PG8_BAR; PG8_WAIT_L(0); PG8_MMA(1, 0, At, B0); PG8_BAR; PG8_SCHED;
            PG8_STAGE(PG8_SB(1, 1), b3 + hstep, voffB);
            PG8_WAIT_V(6); PG8_BAR; PG8_MMA(1, 1, At, B1); PG8_BAR;
            }
        }
        if constexpr (ALIGN_EPI) { if (wr == 0) PG8_BAR; }
        if constexpr (!Epi::AFTER_DRAIN) { E(acc, cur, wr, wc, fr, fq); S.done(cur); }
        if (!has_next) break;
#pragma unroll
        for (int a = 0; a < 2; ++a)
#pragma unroll
            for (int b = 0; b < 2; ++b)
#pragma unroll
                for (int m = 0; m < 4; ++m)
#pragma unroll
                    for (int n = 0; n < 2; ++n) acc[a][b][m][n] = (f32x4){0.f, 0.f, 0.f, 0.f};
        cur = nxt; cA = nA; cB = nB; ++ui;
        if constexpr (ALIGN_EPI) { if (wr == 1) PG8_BAR; }
    }
    PG8_WAIT_V(0);
    if constexpr (!ALIGN_EPI) { if (wr == 0) PG8_BAR; }
    PG8_BAR;
    if constexpr (Epi::AFTER_DRAIN) { E.fused(acc, cur, wr, wc, fr, fq, lds, wid, lane); S.done(cur); }
#undef PG8_SA
#undef PG8_SB
#undef PG8_STAGE
#undef PG8_LDA
#undef PG8_LDB
#undef PG8_MMA
#undef PG8_WAIT_V
#undef PG8_WAIT_L
#undef PG8_BAR
#undef PG8_SCHED
}
}

namespace mk {
#define GAS __attribute__((address_space(1)))
#define LAS __attribute__((address_space(3)))
typedef unsigned short bf16;
typedef unsigned v4u __attribute__((ext_vector_type(4)));
typedef float f32x4 __attribute__((ext_vector_type(4)));
typedef short bf16x8 __attribute__((ext_vector_type(8)));
typedef GAS unsigned gu32;
typedef GAS unsigned long long gu64;
#define RLX_AGENT __ATOMIC_RELAXED, __HIP_MEMORY_SCOPE_AGENT
#define LDS_WAIT() asm volatile("s_waitcnt lgkmcnt(0)" ::: "memory")
#define VM_WAIT() asm volatile("s_waitcnt vmcnt(0)" ::: "memory")
__device__ __forceinline__ unsigned long long rt() { return __builtin_amdgcn_s_memrealtime(); }
__device__ __forceinline__ unsigned f2bf(float f) { unsigned u = __builtin_bit_cast(unsigned, f); return (u + 0x7fffu + ((u >> 16) & 1u)) >> 16; }
__device__ __forceinline__ unsigned pk2(float lo, float hi) {
    typedef __bf16 bf2_t __attribute__((ext_vector_type(2))); typedef float f2_t __attribute__((ext_vector_type(2)));
    const f2_t v = {lo, hi}; const bf2_t b = __builtin_convertvector(v, bf2_t); return __builtin_bit_cast(unsigned, b); }

#define XB_TMO      128
#define XB_XCNT(j)  (256  + 64 * (j))
#define XB_XSUB(j)  (1280 + 64 * (j))
#define XB_XGEN(j)  (2304 + 64 * (j))
#define XB_TOP      3328
#define XB_TOPGEN   3392
#define XCD_BAR_WORDS 3456
#define XB_SPIN_CAP (1u << 18)

__device__ __forceinline__ unsigned xb_ld(unsigned* p)              { return __hip_atomic_load(p, __ATOMIC_RELAXED, __HIP_MEMORY_SCOPE_AGENT); }
__device__ __forceinline__ unsigned xb_add(unsigned* p, unsigned v) { return __hip_atomic_fetch_add(p, v, __ATOMIC_RELAXED, __HIP_MEMORY_SCOPE_AGENT); }
__device__ __forceinline__ unsigned xb_xcc_id() { return (unsigned)__builtin_amdgcn_s_getreg((3 << 11) | 20) & 0xFu; }
#define XB_SPIN(cond, bar) do { unsigned _sp = 0; while (cond) { __builtin_amdgcn_s_sleep(1); \
    if ((++_sp & 255u) == 0u) { if (xb_ld(&(bar)[XB_TMO])) break; if (_sp > XB_SPIN_CAP) { atomicAdd(&(bar)[XB_TMO], 1u); break; } } } } while (0)

struct XcdBarrier {
    unsigned* bar; unsigned x;
    volatile LAS unsigned* st;
};

__device__ __forceinline__ XcdBarrier xcd_barrier_post(unsigned* bar, volatile LAS unsigned* st) {
    XcdBarrier b; b.bar = bar; b.x = xb_xcc_id(); b.st = st;
    if (threadIdx.x == 0) (void)xb_add(&bar[XB_XCNT(b.x)], 1u);
    return b;
}
__device__ __forceinline__ void xcd_barrier_complete(unsigned* bar, unsigned x, unsigned& nloc, unsigned& nx) {
    const unsigned G = gridDim.x * gridDim.y * gridDim.z;
    unsigned sum, cnt, mine, sp = 0u;
    for (;;) {
        sum = 0u; cnt = 0u; mine = 0u;
#pragma unroll
        for (unsigned j = 0; j < 16; ++j) { const unsigned c = xb_ld(&bar[XB_XCNT(j)]); sum += c; cnt += (c > 0u) ? 1u : 0u; mine = (j == x) ? c : mine; }
        if (sum == G) break;
        __builtin_amdgcn_s_sleep(1);
        if ((++sp & 255u) == 0u) { if (xb_ld(&bar[XB_TMO])) break; if (sp > XB_SPIN_CAP) { atomicAdd(&bar[XB_TMO], 1u); break; } }
    }
    nloc = mine > 0u ? mine : 1u; nx = cnt > 0u ? cnt : 1u;
}

__device__ __forceinline__ void xcd_barrier(const XcdBarrier& b) {
    asm volatile("s_waitcnt vmcnt(0)" ::: "memory");
    __syncthreads();
    if (threadIdx.x == 0) {
        unsigned* bar = b.bar;
        __builtin_amdgcn_s_waitcnt(0);
        unsigned nloc = b.st[0], nx = b.st[1];
        if (nloc == 0u) { xcd_barrier_complete(bar, b.x, nloc, nx); b.st[0] = nloc; b.st[1] = nx; }
        const unsigned old = xb_add(&bar[XB_XSUB(b.x)], 1u);
        const unsigned gen = old / nloc;
        if (old + 1u == (gen + 1u) * nloc) {
            __builtin_amdgcn_fence(__ATOMIC_RELEASE, "agent");
            asm volatile("s_waitcnt vmcnt(0)" ::: "memory");
            const unsigned og = xb_add(&bar[XB_TOP], 1u);
            const unsigned tg = og / nx;
            if (og + 1u == (tg + 1u) * nx) xb_add(&bar[XB_TOPGEN], 1u);
            else XB_SPIN(xb_ld(&bar[XB_TOPGEN]) == tg, bar);
            __builtin_amdgcn_fence(__ATOMIC_ACQUIRE, "agent");
            xb_add(&bar[XB_XGEN(b.x)], 1u);
            asm volatile("s_waitcnt vmcnt(0)" ::: "memory");
        } else {
            XB_SPIN(xb_ld(&bar[XB_XGEN(b.x)]) == gen, bar);
            __builtin_amdgcn_fence(__ATOMIC_ACQUIRE, "agent");
            asm volatile("s_waitcnt vmcnt(0)" ::: "memory");
        }
    }
    __syncthreads();
}

}

namespace mk {
constexpr int NWAVES = 8, NTHREADS = 512;
constexpr size_t MiB = 1u << 20;
constexpr size_t WS_QIB = 325 * MiB, WS_KB = 342 * MiB, WS_VB = 351 * MiB, WS_KIB = 360 * MiB, WS_WIF = 363 * MiB;
constexpr size_t WS_OB = 390 * MiB, WS_GD = 423 * MiB;
constexpr size_t WS_IDX = 525 * MiB, WS_CNT = 542 * MiB, WS_SCS = 543 * MiB;
constexpr size_t WS_S = 548 * MiB;
constexpr size_t WS_SC = WS_S;
constexpr size_t WS_Z = WS_S, WS_H1F = WS_S + 65 * MiB, WS_H1B = WS_S + 130 * MiB, WS_PQB = WS_S + 163 * MiB, WS_H2F = WS_S + 228 * MiB, WS_H2B = WS_S + 293 * MiB;
constexpr size_t WS_GQ = WS_S + 326 * MiB, WS_GK = WS_S + 343 * MiB, WS_GV = WS_S + 360 * MiB, WS_GR = WS_S + 393 * MiB, WS_QT = WS_S + 426 * MiB, WS_DEC = WS_S + 442 * MiB,
                 WS_OGB = WS_S + 443 * MiB, WS_KT = WS_S + 476 * MiB;
constexpr size_t WS_DS = WS_S, WS_SPREV = WS_S + 128 * MiB;
constexpr size_t WS_CTL = 1060 * MiB, WS_WA = 1061 * MiB, WS_WO = 1066 * MiB, WS_WG = 1068 * MiB, WS_WGO = 1075 * MiB, WS_WPQ = 1077 * MiB, WS_PK = 1085 * MiB,
                 WS_UB = 1086 * MiB, WS_VBX = 1150 * MiB, WS_USC = 1118 * MiB, WS_TEID = 1120 * MiB, WS_TGATE = 1125 * MiB, WS_HD = 1134 * MiB, WS_KV8 = 1134 * MiB, WS_XB = 1214 * MiB, WS_QB = 1247 * MiB, WS_END = 1280 * MiB;
constexpr size_t CTL_ZERO_BYTES = 1 * MiB;
constexpr int CW_TMO = 0, CW_AMAXK = 256, CW_AMAXV = 320, CW_Q1 = 512, CW_XC = 1024, CW_BAR = 4096;
constexpr int WA_ROWS = 2176, WG_ROWS = 3104;
constexpr int GN_Q = 0, GN_K = 512, GN_V = 1024, GN_R = 2048, GN_GD = 3072;

constexpr int RING_BYTES = 131072, LDSCTL_OFF = RING_BYTES, MISC_OFF = LDSCTL_OFF + 320, INPTAB_OFF = LDSCTL_OFF + 512, LDS_BYTES = 147456;

typedef unsigned u32x4 __attribute__((ext_vector_type(4)));
typedef unsigned u32x2 __attribute__((ext_vector_type(2)));
#define MK_LAS __attribute__((address_space(3)))
__device__ __forceinline__ float bflo(unsigned w) { return __builtin_bit_cast(float, w << 16); }
__device__ __forceinline__ float bfhi(unsigned w) { return __builtin_bit_cast(float, w & 0xffff0000u); }
__device__ __forceinline__ float bf2f(unsigned short b) { return __builtin_bit_cast(float, (unsigned)b << 16); }
__device__ __forceinline__ u32x4 pack8(f32x4 a, f32x4 b) { u32x4 w; w.x = pk2(a[0], a[1]); w.y = pk2(a[2], a[3]); w.z = pk2(b[0], b[1]); w.w = pk2(b[2], b[3]); return w; }

#define TPB(k)
#define TPE(k)
template <int NCT> __device__ __forceinline__ void skinny_tile(const bf16* __restrict__ A, int lda, const bf16* __restrict__ Bt, int K, int row0, int col0, f32x4 (&acc)[NCT], int lane) {
    const int fr = lane & 15, fq = lane >> 4;
    const bf16* ap = A + (size_t)(row0 + fr) * lda + fq * 8;
    const bf16* bp = Bt + (size_t)(col0 + fr) * K + fq * 8;
#pragma unroll
    for (int ct = 0; ct < NCT; ++ct) acc[ct] = (f32x4){0.f, 0.f, 0.f, 0.f};
#pragma unroll 1
    for (int k0 = 0; k0 < K; k0 += 128) {
        bf16x8 a[4], b[NCT][4];
#pragma unroll
        for (int j = 0; j < 4; ++j) a[j] = *(const bf16x8*)(ap + k0 + j * 32);
#pragma unroll
        for (int ct = 0; ct < NCT; ++ct)
#pragma unroll
            for (int j = 0; j < 4; ++j) b[ct][j] = *(const bf16x8*)(bp + (size_t)ct * 16 * K + k0 + j * 32);
        asm volatile("" ::: "memory");
#pragma unroll
        for (int ct = 0; ct < NCT; ++ct)
#pragma unroll
            for (int j = 0; j < 4; ++j) acc[ct] = __builtin_amdgcn_mfma_f32_16x16x32_bf16(b[ct][j], a[j], acc[ct], 0, 0, 0);
    }
}

__device__ __forceinline__ void p0_transpose_item(const float* __restrict__ W, int ldw, int K, bf16* __restrict__ WT, int dst_row0, int src_col0, int nvalid, int k0, MK_LAS float* scr, int lane) {
#pragma unroll 8
    for (int i = 0; i < 32; ++i) { const int kk = 2 * i + (lane >> 5), j = lane & 31; scr[kk * 33 + j] = j < nvalid ? W[(size_t)(k0 + kk) * ldw + src_col0 + j] : 0.f; }
    asm volatile("s_waitcnt lgkmcnt(0)" ::: "memory");
    const int c = lane & 7;
#pragma unroll
    for (int j = 0; j < 4; ++j) { const int n = (lane >> 3) + 8 * j; const MK_LAS float* s = scr + (8 * c) * 33 + n;
        u32x4 o; o.x = pk2(s[0 * 33], s[1 * 33]); o.y = pk2(s[2 * 33], s[3 * 33]); o.z = pk2(s[4 * 33], s[5 * 33]); o.w = pk2(s[6 * 33], s[7 * 33]);
        *(u32x4*)(WT + (size_t)(dst_row0 + n) * K + k0 + 8 * c) = o; }
    asm volatile("s_waitcnt lgkmcnt(0)" ::: "memory");
}
__device__ __forceinline__ void p0_convert(const float* __restrict__ src, bf16* __restrict__ dst, size_t n8, int gw, int ngw, int lane) {
    for (size_t i = (size_t)gw * 64 + lane; i < n8; i += (size_t)ngw * 64) {
        const f32x4 a = *(const f32x4*)(src + i * 8), b = *(const f32x4*)(src + i * 8 + 4);
        *(u32x4*)(dst + i * 8) = pack8(a, b);
    }
}

__device__ __forceinline__ void p0_quant_row(const float* __restrict__ src, unsigned char* __restrict__ dst, float* __restrict__ scale, int lane) {
    f32x4 v[4]; float am = 0.f;
#pragma unroll
    for (int q = 0; q < 4; ++q) { v[q] = *(const f32x4*)(src + lane * 16 + q * 4); am = fmaxf(am, fmaxf(fmaxf(fabsf(v[q][0]), fabsf(v[q][1])), fmaxf(fabsf(v[q][2]), fabsf(v[q][3])))); }
#pragma unroll
    for (int o = 1; o < 64; o <<= 1) am = fmaxf(am, __shfl_xor(am, o));
    const float inv = am > 0.f ? 448.f / am : 0.f;
    u32x4 w;
#pragma unroll
    for (int q = 0; q < 4; ++q) { int x = __builtin_amdgcn_cvt_pk_fp8_f32(v[q][0] * inv, v[q][1] * inv, 0, false); x = __builtin_amdgcn_cvt_pk_fp8_f32(v[q][2] * inv, v[q][3] * inv, x, true); w[q] = (unsigned)x; }
    *(u32x4*)(dst + lane * 16) = w;
    if (lane == 0) *scale = am * (1.f / 448.f);
}

__device__ __forceinline__ void p0_quant_rows4(const float* __restrict__ src, unsigned char* __restrict__ dst, float* __restrict__ scale, int lane) {
    f32x4 v[4][4]; float am[4];
#pragma unroll
    for (int r = 0; r < 4; ++r)
#pragma unroll
        for (int q = 0; q < 4; ++q) v[r][q] = *(const f32x4*)(src + (size_t)r * D + lane * 16 + q * 4);
#pragma unroll
    for (int r = 0; r < 4; ++r) { float a = 0.f;
#pragma unroll
        for (int q = 0; q < 4; ++q) a = fmaxf(a, fmaxf(fmaxf(fabsf(v[r][q][0]), fabsf(v[r][q][1])), fmaxf(fabsf(v[r][q][2]), fabsf(v[r][q][3]))));
        am[r] = a; }
#pragma unroll
    for (int o = 1; o < 64; o <<= 1) {
#pragma unroll
        for (int r = 0; r < 4; ++r) am[r] = fmaxf(am[r], __shfl_xor(am[r], o)); }
#pragma unroll
    for (int r = 0; r < 4; ++r) {
        const float inv = am[r] > 0.f ? 448.f / am[r] : 0.f;
        u32x4 w;
#pragma unroll
        for (int q = 0; q < 4; ++q) { int x = __builtin_amdgcn_cvt_pk_fp8_f32(v[r][q][0] * inv, v[r][q][1] * inv, 0, false); x = __builtin_amdgcn_cvt_pk_fp8_f32(v[r][q][2] * inv, v[r][q][3] * inv, x, true); w[q] = (unsigned)x; }
        *(u32x4*)(dst + (size_t)r * D + lane * 16) = w;
        if (lane == 0) scale[r] = am[r] * (1.f / 448.f);
    }
}

struct FAttnIn {
    bf16 *Qb, *Kb, *Vb, *QIb, *KIb; float* WIf; float* out;
    mutable float kmax = 0.f, vmax = 0.f;
    __device__ __forceinline__ static float amax8(f32x4 a, f32x4 b) { return fmaxf(fmaxf(fmaxf(fabsf(a[0]), fabsf(a[1])), fmaxf(fabsf(a[2]), fabsf(a[3]))), fmaxf(fmaxf(fabsf(b[0]), fabsf(b[1])), fmaxf(fabsf(b[2]), fabsf(b[3])))); }
    __device__ __forceinline__ float* okp(int row, size_t offp, size_t offs, int ld) const { return row < TP ? out + offp + (size_t)row * ld : out + offs + (size_t)(row - TP) * ld; }
    __device__ __forceinline__ void put8(int row, int col, f32x4 v0, f32x4 v1) const {
        const u32x4 w = pack8(v0, v1);
        if (col < AK) *(u32x4*)(Qb + (size_t)row * 1024 + col) = w;
        else if (col < AV) { *(u32x4*)(Kb + (size_t)row * 256 + (col - AK)) = w; float* o = okp(row, OUT_KP, OUT_KS, 256) + (col - AK); *(f32x4*)o = v0; *(f32x4*)(o + 4) = v1; kmax = fmaxf(kmax, amax8(v0, v1)); }
        else if (col < AQI) { *(u32x4*)(Vb + (size_t)row * 256 + (col - AV)) = w; float* o = okp(row, OUT_VP, OUT_VS, 256) + (col - AV); *(f32x4*)o = v0; *(f32x4*)(o + 4) = v1; vmax = fmaxf(vmax, amax8(v0, v1)); }
        else *(u32x4*)(QIb + (size_t)row * 512 + (col - AQI)) = w;
    }
    __device__ __forceinline__ void put4(int row, int col, f32x4 v) const {
        u32x2 w; w.x = pk2(v[0], v[1]); w.y = pk2(v[2], v[3]);
        if (col < AK) *(u32x2*)(Qb + (size_t)row * 1024 + col) = w;
        else if (col < AV) { *(u32x2*)(Kb + (size_t)row * 256 + (col - AK)) = w; *(f32x4*)(okp(row, OUT_KP, OUT_KS, 256) + (col - AK)) = v; }
        else if (col < AQI) { *(u32x2*)(Vb + (size_t)row * 256 + (col - AV)) = w; *(f32x4*)(okp(row, OUT_VP, OUT_VS, 256) + (col - AV)) = v; }
        else if (col < AKI) *(u32x2*)(QIb + (size_t)row * 512 + (col - AQI)) = w;
        else if (col < AWI) { *(u32x2*)(KIb + (size_t)row * 64 + (col - AKI)) = w; *(f32x4*)(okp(row, OUT_KIP, OUT_KIS, 64) + (col - AKI)) = v; }
        else if (col < ATT_N) *(f32x4*)(WIf + (size_t)row * 8 + (col - AWI)) = v * 0.04419417382415922f;
    }
};
}

namespace mk {
typedef float f32x2v __attribute__((ext_vector_type(2)));
typedef float f32x16 __attribute__((ext_vector_type(16)));
typedef short s16x4 __attribute__((ext_vector_type(4)));
typedef short v4i16_t __attribute__((ext_vector_type(4)));

__device__ __forceinline__ void score_load_q(const bf16* __restrict__ QIb, const float* __restrict__ WIf, size_t tok0, int lane, bf16x8 (&afr)[4], f32x4 (&w4)[4]) {
    const int r = lane & 31, kq = lane >> 5;
    const bf16* ap = QIb + (tok0 + (r >> 3)) * 512 + (r & 7) * 64 + kq * 8;
#pragma unroll
    for (int ks = 0; ks < 4; ++ks) afr[ks] = *(const bf16x8*)(ap + ks * 16);
#pragma unroll
    for (int ql = 0; ql < 4; ++ql) w4[ql] = *(const f32x4*)(WIf + (tok0 + ql) * 8 + 4 * kq);
}
__device__ __forceinline__ void score_tile(const bf16x8 (&afr)[4], const bf16x8 (&bfr)[4], const f32x4 (&w4)[4], float (&s)[4]) {
    f32x16 acc;
#pragma unroll
    for (int j = 0; j < 16; ++j) acc[j] = 0.f;
#pragma unroll
    for (int ks = 0; ks < 4; ++ks) acc = __builtin_amdgcn_mfma_f32_32x32x16_bf16(afr[ks], bfr[ks], acc, 0, 0, 0);
#pragma unroll
    for (int ql = 0; ql < 4; ++ql) {
        float p = 0.f;
#pragma unroll
        for (int jj = 0; jj < 4; ++jj) p = fmaf(fmaxf(acc[ql * 4 + jj], 0.f), w4[ql][jj], p);
        s[ql] = p + __shfl_xor(p, 32);
    }
}

__device__ __forceinline__ void quant_issue(const float* __restrict__ src, f32x4 (&v)[4], int lane) {
#pragma unroll
    for (int q = 0; q < 4; ++q) v[q] = *(const f32x4*)(src + lane * 16 + q * 4);
}
#ifndef PEER_BITS
#define PEER_BITS 4
#endif
#ifndef PEER_AMAX4
#define PEER_AMAX4 6.0f
#endif
constexpr int PEER_RB = PEER_BITS * 128;
#ifndef PEER_UVI
#define PEER_UVI 0
#endif
constexpr int PEER_RS = PEER_UVI ? 2 * PEER_RB : PEER_RB;
#if PEER_BITS == 4
__device__ __forceinline__ unsigned enc_e2m1(float x) {
    const float a = fabsf(x);
    const float c = a < 2.f ? rintf(a * 2.f) : (a < 4.f ? rintf(a) + 2.f : fminf(rintf(a * 0.5f) + 4.f, 7.f));
    return (unsigned)c | (x < 0.f ? 8u : 0u);
}
__device__ __forceinline__ void quant_finish(const f32x4 (&v)[4], unsigned char* __restrict__ dst, float* __restrict__ scale, int lane) {
    float am = 0.f;
#pragma unroll
    for (int q = 0; q < 4; ++q) am = fmaxf(am, fmaxf(fmaxf(fabsf(v[q][0]), fabsf(v[q][1])), fmaxf(fabsf(v[q][2]), fabsf(v[q][3]))));
#pragma unroll
    for (int o = 1; o < 64; o <<= 1) am = fmaxf(am, __shfl_xor(am, o));
    const float inv = am > 0.f ? PEER_AMAX4 / am : 0.f;
    u32x2 w; w.x = 0u; w.y = 0u;
#pragma unroll
    for (int i = 0; i < 8; ++i) { w.x |= enc_e2m1(v[i >> 2][i & 3] * inv) << (4 * i); w.y |= enc_e2m1(v[2 + (i >> 2)][i & 3] * inv) << (4 * i); }
    *(u32x2*)(dst + lane * 8) = w;
    if (lane == 0) *scale = am * (1.f / PEER_AMAX4);
}
#elif PEER_BITS == 6
__device__ __forceinline__ unsigned enc_e2m3(float x) {
    const float a = fabsf(x), q = a * 8.f;
    const float c = a < 2.f ? rintf(q) : (a < 4.f ? rintf(q * 0.5f) + 8.f : fminf(rintf(q * 0.25f) + 16.f, 31.f));
    return (unsigned)c | (x < 0.f ? 32u : 0u);
}
__device__ __forceinline__ void quant_finish(const f32x4 (&v)[4], unsigned char* __restrict__ dst, float* __restrict__ scale, int lane) {
    float am = 0.f;
#pragma unroll
    for (int q = 0; q < 4; ++q) am = fmaxf(am, fmaxf(fmaxf(fabsf(v[q][0]), fabsf(v[q][1])), fmaxf(fabsf(v[q][2]), fabsf(v[q][3]))));
#pragma unroll
    for (int o = 1; o < 64; o <<= 1) am = fmaxf(am, __shfl_xor(am, o));
    const float inv = am > 0.f ? 7.5f / am : 0.f;
    unsigned long long lo = 0ull, hi = 0ull;
#pragma unroll
    for (int i = 0; i < 16; ++i) {
        const unsigned long long c = enc_e2m3(v[i >> 2][i & 3] * inv);
        if (i < 10) lo |= c << (6 * i);
        else if (i == 10) { lo |= (c & 15ull) << 60; hi |= c >> 4; }
        else hi |= c << (6 * (i - 11) + 2);
    }
    unsigned* d = (unsigned*)(dst + lane * 12);
    d[0] = (unsigned)lo; d[1] = (unsigned)(lo >> 32); d[2] = (unsigned)hi;
    if (lane == 0) *scale = am * (1.f / 7.5f);
}
#else
__device__ __forceinline__ void quant_finish(const f32x4 (&v)[4], unsigned char* __restrict__ dst, float* __restrict__ scale, int lane) {
    float am = 0.f;
#pragma unroll
    for (int q = 0; q < 4; ++q) am = fmaxf(am, fmaxf(fmaxf(fabsf(v[q][0]), fabsf(v[q][1])), fmaxf(fabsf(v[q][2]), fabsf(v[q][3]))));
#pragma unroll
    for (int o = 1; o < 64; o <<= 1) am = fmaxf(am, __shfl_xor(am, o));
    const float inv = am > 0.f ? 448.f / am : 0.f;
    u32x4 w;
#pragma unroll
    for (int q = 0; q < 4; ++q) { int x = __builtin_amdgcn_cvt_pk_fp8_f32(v[q][0] * inv, v[q][1] * inv, 0, false); x = __builtin_amdgcn_cvt_pk_fp8_f32(v[q][2] * inv, v[q][3] * inv, x, true); w[q] = (unsigned)x; }
    *(u32x4*)(dst + lane * 16) = w;
    if (lane == 0) *scale = am * (1.f / 448.f);
}
#endif
struct QuantTabs { const float* pu; const float* pv; unsigned char* uq; unsigned char* vq; float* us; float* vs;
    __device__ __forceinline__ const float* src(int r) const { return r < 2 * 16384 ? pu + (size_t)r * D : pv + (size_t)(r - 2 * 16384) * D; }
    __device__ __forceinline__ unsigned char* dst(int r) const {
#if PEER_UVI
        return r < 2 * 16384 ? uq + (size_t)r * PEER_RS : uq + (size_t)(r - 2 * 16384) * PEER_RS + PEER_RB;
#else
        return r < 2 * 16384 ? uq + (size_t)r * PEER_RB : vq + (size_t)(r - 2 * 16384) * PEER_RB;
#endif
    }
    __device__ __forceinline__ float* sc(int r) const { return r < 2 * 16384 ? us + r : vs + (r - 2 * 16384); } };

__device__ __forceinline__ void phase_score(const bf16* __restrict__ QIb, const bf16* __restrict__ KIb, const float* __restrict__ WIf, const float* __restrict__ cache_ki, const int* __restrict__ page_table,
                                            float* __restrict__ SC, float* __restrict__ SCS, const QuantTabs QT_, LAS unsigned char* lds, int vcu, int G, int wave, int lane, int gw, int NGW) {
    const int c = lane & 31, kq = lane >> 5;
    int qrow = gw;
    constexpr int KST = 144, KBUF = 256 * KST;
    const int tid = wave * 64 + lane;
    for (int it = vcu; it < 512; it += G) {
        const int b = it >> 8, qt = b == 0 ? (it & 255) : 255 - (it & 255);
        const size_t tok0 = (size_t)b * SEQ + qt * 32 + wave * 4;
        bf16x8 afr[4]; f32x4 w4[4];
        score_load_q(QIb, WIf, tok0, lane, afr, w4);
        const int nc = (qt >> 3) + 1;
        const bf16* kbase = KIb + (size_t)b * SEQ * 64;
        u32x4 st[4];
#pragma unroll
        for (int i = 0; i < 4; ++i) { const int p = tid + i * 512; st[i] = *(const u32x4*)(kbase + (size_t)(p >> 3) * 64 + (p & 7) * 8); }
#pragma unroll
        for (int i = 0; i < 4; ++i) { const int p = tid + i * 512; *(LAS u32x4*)(lds + (p >> 3) * KST + (p & 7) * 16) = st[i]; }
        __syncthreads();
        for (int ch = 0; ch < nc; ++ch) {
            const bool more = ch + 1 < nc;
            f32x4 qv[4]; const bool qdo = qrow < 4 * 16384;
            if (qdo) quant_issue(QT_.src(qrow), qv, lane);
            if (more) {
#pragma unroll
                for (int i = 0; i < 4; ++i) { const int p = tid + i * 512; st[i] = *(const u32x4*)(kbase + ((size_t)(ch + 1) * 256 + (p >> 3)) * 64 + (p & 7) * 8); }
            }
            LAS unsigned char* kb = lds + (ch & 1) * KBUF;
            const int ntile = more ? 8 : (qt & 7) + 1;
            for (int kt8 = 0; kt8 < ntile; ++kt8) {
                bf16x8 bfr[4];
#pragma unroll
                for (int ks = 0; ks < 4; ++ks) bfr[ks] = *(LAS bf16x8*)(kb + (kt8 * 32 + c) * KST + ks * 32 + kq * 16);
                float sv[4]; score_tile(afr, bfr, w4, sv);
                float* o = SC + (tok0 + 2 * kq) * SEQ + (ch * 8 + kt8) * 32 + c;
                o[0] = kq ? sv[2] : sv[0]; o[SEQ] = kq ? sv[3] : sv[1];
            }
            if (qdo) { quant_finish(qv, QT_.dst(qrow), QT_.sc(qrow), lane); qrow += NGW; }
            if (more) {
                LAS unsigned char* nb = lds + ((ch + 1) & 1) * KBUF;
#pragma unroll
                for (int i = 0; i < 4; ++i) { const int p = tid + i * 512; *(LAS u32x4*)(nb + (p >> 3) * KST + (p & 7) * 16) = st[i]; }
            }
            __syncthreads();
        }
    }
    for (; qrow < 4 * 16384; qrow += NGW) { f32x4 qv[4]; quant_issue(QT_.src(qrow), qv, lane); quant_finish(qv, QT_.dst(qrow), QT_.sc(qrow), lane); }
    for (int it = gw; it < DB * NPAGES + DB; it += NGW) {
        const bool isnew = it >= DB * NPAGES;
        const int b = isnew ? it - DB * NPAGES : it / NPAGES, pg = isnew ? 0 : it % NPAGES;
        const size_t tok0 = (size_t)TP + b * DS;
        bf16x8 afr[4]; f32x4 w4[4];
        score_load_q(QIb, WIf, tok0, lane, afr, w4);
        if (!isnew) {
            const int phys = page_table[b * NPAGES + pg];
            for (int j = 0; j < 4; ++j) {
                const float* kp = cache_ki + ((size_t)phys * PAGE + j * 32 + c) * 64 + kq * 8;
                bf16x8 bfr[4];
#pragma unroll
                for (int ks = 0; ks < 4; ++ks) { const f32x4 x0 = *(const f32x4*)(kp + ks * 16), x1 = *(const f32x4*)(kp + ks * 16 + 4); const u32x4 w = pack8(x0, x1); bfr[ks] = __builtin_bit_cast(bf16x8, w); }
                float s[4]; score_tile(afr, bfr, w4, s);
                float* o = SCS + (size_t)(b * DS + 2 * kq) * SCS_LD + pg * PAGE + j * 32 + c;
                o[0] = kq ? s[2] : s[0]; o[SCS_LD] = kq ? s[3] : s[1];
            }
        } else {
            const bf16* kp = KIb + (tok0 + (c & 3)) * 64 + kq * 8;
            bf16x8 bfr[4];
#pragma unroll
            for (int ks = 0; ks < 4; ++ks) bfr[ks] = *(const bf16x8*)(kp + ks * 16);
            float s[4]; score_tile(afr, bfr, w4, s);
            if (c < 4) { float* o = SCS + (size_t)(b * DS + 2 * kq) * SCS_LD + PAST + c; o[0] = kq ? s[2] : s[0]; o[SCS_LD] = kq ? s[3] : s[1]; }
        }
    }
}

constexpr int VST = 144;
__device__ __forceinline__ bf16x8 ld_frag8(const bf16* p) { return *(const bf16x8*)p; }
__device__ __forceinline__ bf16x8 ld_frag8(const float* p) { const f32x4 a = *(const f32x4*)p, b = *(const f32x4*)(p + 4); const u32x4 w = pack8(a, b); return __builtin_bit_cast(bf16x8, w); }
__device__ __forceinline__ s16x4 lds_tr(LAS unsigned char* p) { return __builtin_bit_cast(s16x4, __builtin_amdgcn_ds_read_tr16_b64_v4i16((LAS v4i16_t*)p)); }

template <bool SAMPLE>
__device__ __forceinline__ void attn_row(int row, int n0, int n1, const bf16* __restrict__ Qb, const int* __restrict__ IDX, const int* __restrict__ CNT,
                                         const bf16* __restrict__ Kb, const bf16* __restrict__ Vb, const float* __restrict__ cache_k, const float* __restrict__ cache_v,
                                         const float* __restrict__ newk, const float* __restrict__ newv, const int* __restrict__ page_table,
                                         bf16* __restrict__ Ob, LAS unsigned char* wl, int lane) {
    const int fr = lane & 15, fq = lane >> 4;
    LAS int* rid = (LAS int*)wl;
    LAS unsigned char* vt = wl + 1024;
    const int cnt = CNT[row];
    const int b = SAMPLE ? (row - TP) / DS : row / SEQ;
#pragma unroll
    for (int i = 0; i < 4; ++i) { const int slot = i * 64 + lane; int key = slot < cnt ? IDX[(size_t)row * TOPK + slot] : 0; int id;
        if (!SAMPLE) id = b * SEQ + key;
        else if (key < PAST) id = page_table[b * NPAGES + key / PAGE] * PAGE + (key % PAGE);
        else id = (int)0x80000000 | (b * DS + (key - PAST));
        rid[slot] = id; }
    asm volatile("s_waitcnt lgkmcnt(0)" ::: "memory");
    for (int n = n0; n < n1; ++n) {
        bf16x8 qf[2];
#pragma unroll
        for (int ks = 0; ks < 2; ++ks) qf[ks] = *(const bf16x8*)(Qb + (size_t)row * 1024 + (n * 4 + (fr & 3)) * 64 + ks * 32 + fq * 8);
        f32x4 st[16];
        constexpr int TBN = SAMPLE ? 4 : 8;
#pragma unroll
        for (int tb = 0; tb < 16 / TBN; ++tb) {
            bf16x8 kf[TBN][2];
#pragma unroll
            for (int t = 0; t < TBN; ++t) {
                const int id = rid[(tb * TBN + t) * 16 + fr];
                if (!SAMPLE) { const bf16* kp = Kb + (size_t)id * 256 + n * 64 + fq * 8; kf[t][0] = ld_frag8(kp); kf[t][1] = ld_frag8(kp + 32); }
                else { const float* kp = (id < 0 ? newk + (size_t)(id & 0x7fffffff) * 256 : cache_k + (size_t)id * 256) + n * 64 + fq * 8; kf[t][0] = ld_frag8(kp); kf[t][1] = ld_frag8(kp + 32); }
            }
#pragma unroll
            for (int t = 0; t < TBN; ++t) {
                f32x4 a = (f32x4){0.f, 0.f, 0.f, 0.f};
                a = __builtin_amdgcn_mfma_f32_16x16x32_bf16(kf[t][0], qf[0], a, 0, 0, 0);
                a = __builtin_amdgcn_mfma_f32_16x16x32_bf16(kf[t][1], qf[1], a, 0, 0, 0);
                st[tb * TBN + t] = a;
            }
            asm volatile("" ::: "memory");
        }
        bf16x8 vreg[8];
#define ATT_VLOAD(ch_) do { _Pragma("unroll") for (int i = 0; i < 8; ++i) { const int sl = i * 8 + (lane >> 3), chunk = lane & 7; const int id = rid[(ch_) * 64 + sl]; \
            if (!SAMPLE) vreg[i] = ld_frag8(Vb + (size_t)id * 256 + n * 64 + chunk * 8); \
            else vreg[i] = ld_frag8((id < 0 ? newv + (size_t)(id & 0x7fffffff) * 256 : cache_v + (size_t)id * 256) + n * 64 + chunk * 8); } } while (0)
        ATT_VLOAD(0);
        float mx = -INFINITY;
#pragma unroll
        for (int t = 0; t < 16; ++t)
#pragma unroll
            for (int j = 0; j < 4; ++j) { const int slot = t * 16 + fq * 4 + j; const float v = slot < cnt ? st[t][j] * 0.125f : -INFINITY; st[t][j] = v; mx = fmaxf(mx, v); }
        mx = fmaxf(mx, __shfl_xor(mx, 16)); mx = fmaxf(mx, __shfl_xor(mx, 32));
        float sum = 0.f;
#pragma unroll
        for (int t = 0; t < 16; ++t)
#pragma unroll
            for (int j = 0; j < 4; ++j) { const float e = __expf(st[t][j] - mx); st[t][j] = e; sum += e; }
        sum += __shfl_xor(sum, 16); sum += __shfl_xor(sum, 32);
        f32x4 oacc[4];
#pragma unroll
        for (int dt = 0; dt < 4; ++dt) oacc[dt] = (f32x4){0.f, 0.f, 0.f, 0.f};
#pragma unroll
        for (int ch = 0; ch < 4; ++ch) {
#pragma unroll
            for (int i = 0; i < 8; ++i) { const int sl = i * 8 + (lane >> 3), chunk = lane & 7; *(LAS bf16x8*)(vt + sl * VST + chunk * 16) = vreg[i]; }
            asm volatile("s_waitcnt lgkmcnt(0)" ::: "memory");
            if (ch < 3) ATT_VLOAD(ch + 1);
#pragma unroll
            for (int s2 = 0; s2 < 2; ++s2) {
                const int t0 = ch * 4 + s2 * 2;
                const u32x4 pw = pack8(st[t0], st[t0 + 1]);
                const bf16x8 pf = __builtin_bit_cast(bf16x8, pw);
#pragma unroll
                for (int dt = 0; dt < 4; ++dt) {
                    LAS unsigned char* a0 = vt + (s2 * 32 + fq * 4 + (fr >> 2)) * VST + (dt * 16 + 4 * (fr & 3)) * 2;
                    const s16x4 v0 = lds_tr(a0), v1 = lds_tr(a0 + 16 * VST);
                    bf16x8 vf; vf[0] = v0[0]; vf[1] = v0[1]; vf[2] = v0[2]; vf[3] = v0[3]; vf[4] = v1[0]; vf[5] = v1[1]; vf[6] = v1[2]; vf[7] = v1[3];
                    oacc[dt] = __builtin_amdgcn_mfma_f32_16x16x32_bf16(pf, vf, oacc[dt], 0, 0, 0);
                }
            }
            asm volatile("s_waitcnt lgkmcnt(0)" ::: "memory");
        }
#undef ATT_VLOAD
        const float i0 = 1.f / __shfl(sum, 0), i1 = 1.f / __shfl(sum, 1), i2 = 1.f / __shfl(sum, 2), i3 = 1.f / __shfl(sum, 3);
        if (fq == 0) {
#pragma unroll
            for (int dt = 0; dt < 4; ++dt) {
                bf16* o = Ob + (size_t)row * 1024 + (n * 4) * 64 + dt * 16 + fr;
                o[0] = (bf16)f2bf(oacc[dt][0] * i0); o[64] = (bf16)f2bf(oacc[dt][1] * i1); o[128] = (bf16)f2bf(oacc[dt][2] * i2); o[192] = (bf16)f2bf(oacc[dt][3] * i3);
            }
        }
    }
    asm volatile("s_waitcnt lgkmcnt(0)" ::: "memory");
}

__device__ __forceinline__ void kv8_convert(const bf16* __restrict__ Kb, const bf16* __restrict__ Vb, unsigned char* __restrict__ KV8_, const unsigned* __restrict__ amaxk, const unsigned* __restrict__ amaxv, int gw, int NGW, int lane) {
    const float ak = __builtin_bit_cast(float, __hip_atomic_load(amaxk, __ATOMIC_RELAXED, __HIP_MEMORY_SCOPE_AGENT)), av = __builtin_bit_cast(float, __hip_atomic_load(amaxv, __ATOMIC_RELAXED, __HIP_MEMORY_SCOPE_AGENT));
    const bool isv = lane >= 32; const int l = lane & 31;
    const float sc = isv ? (av > 0.f ? 448.f / av : 0.f) : (ak > 0.f ? 448.f / ak : 0.f);
    for (int t = gw; t < TP; t += NGW) {
        const u32x4 w = *(const u32x4*)((isv ? Vb : Kb) + (size_t)t * 256 + l * 8);
        const float x0 = bflo(w.x) * sc, x1 = bfhi(w.x) * sc, x2 = bflo(w.y) * sc, x3 = bfhi(w.y) * sc, x4 = bflo(w.z) * sc, x5 = bfhi(w.z) * sc, x6 = bflo(w.w) * sc, x7 = bfhi(w.w) * sc;
        int p0 = __builtin_amdgcn_cvt_pk_fp8_f32(x0, x1, 0, false); p0 = __builtin_amdgcn_cvt_pk_fp8_f32(x2, x3, p0, true);
        int p1 = __builtin_amdgcn_cvt_pk_fp8_f32(x4, x5, 0, false); p1 = __builtin_amdgcn_cvt_pk_fp8_f32(x6, x7, p1, true);
        const int n = l >> 3, d0 = (l & 7) * 8;
        const int pos = isv ? 64 + d0 : ((d0 & 31) >> 3) * 16 + (d0 >> 5) * 8;
        u32x2 o; o.x = (unsigned)p0; o.y = (unsigned)p1;
        *(u32x2*)(KV8_ + (size_t)t * 512 + n * 128 + pos) = o;
    }
}
__device__ __forceinline__ void fp8x16_to_bf16(const u32x4 q, bf16x8& lo, bf16x8& hi) {
    u32x4 a, b;
#pragma unroll
    for (int w = 0; w < 4; ++w) { const f32x2v f0 = __builtin_amdgcn_cvt_pk_f32_fp8((int)q[w], false), f1 = __builtin_amdgcn_cvt_pk_f32_fp8((int)q[w], true);
        const unsigned u0 = pk2(f0[0], f0[1]), u1 = pk2(f1[0], f1[1]);
        if (w < 2) { a[2 * w] = u0; a[2 * w + 1] = u1; } else { b[2 * w - 4] = u0; b[2 * w - 3] = u1; } }
    lo = __builtin_bit_cast(bf16x8, a); hi = __builtin_bit_cast(bf16x8, b);
}
#ifndef KF1
#define KF1 10
#endif
__device__ __forceinline__ void attn_prompt_stream(int b, int n, int q0, int qstep, const bf16* __restrict__ Qb, const int* __restrict__ IDX, const unsigned char* __restrict__ KV8_, const unsigned* __restrict__ amaxk, const unsigned* __restrict__ amaxv,
                                                   bf16* __restrict__ Ob, LAS unsigned char* wl, int lane) {
    const float ak_ = __builtin_bit_cast(float, __hip_atomic_load(amaxk, __ATOMIC_RELAXED, __HIP_MEMORY_SCOPE_AGENT)), av_ = __builtin_bit_cast(float, __hip_atomic_load(amaxv, __ATOMIC_RELAXED, __HIP_MEMORY_SCOPE_AGENT));
    const float kinv = ak_ * (1.f / 448.f), vinv = av_ * (1.f / 448.f);
    const int fr = lane & 15, fq = lane >> 4;
    LAS int* ridb = (LAS int*)wl;
    LAS unsigned char* vt = wl + 2048;
    if (q0 >= SEQ) return;
    int vx[4];
    { const int row = b * SEQ + q0, cnt = q0 + 1 < TOPK ? q0 + 1 : TOPK;
#pragma unroll
      for (int i = 0; i < 4; ++i) { const int slot = i * 64 + lane; ridb[slot] = b * SEQ + (slot < cnt ? IDX[(size_t)row * TOPK + slot] : 0); } }
    int buf = 0;

    for (int q = q0; q < SEQ; q += qstep, buf ^= 1) {

        const int row = b * SEQ + q, cnt = q + 1 < TOPK ? q + 1 : TOPK;
        LAS int* rid = ridb + buf * 256;
        asm volatile("s_waitcnt lgkmcnt(0)" ::: "memory");
        int kx[16];
#pragma unroll
        for (int t = 0; t < 16; ++t) kx[t] = rid[t * 16 + fr];
        bf16x8 qf[2];
#pragma unroll
        for (int ks = 0; ks < 2; ++ks) qf[ks] = *(const bf16x8*)(Qb + (size_t)row * 1024 + (n * 4 + (fr & 3)) * 64 + ks * 32 + fq * 8);
        u32x4 kraw[16];
#pragma unroll
        for (int t = 0; t < 16; ++t) kraw[t] = *(const u32x4*)(KV8_ + (size_t)kx[t] * 512 + n * 128 + fq * 16);
        asm volatile("s_waitcnt lgkmcnt(0)" ::: "memory");
        u32x4 vraw[4];
#define ATT_VLOAD2(ch_) do { _Pragma("unroll") for (int i = 0; i < 4; ++i) { const int sl = i * 16 + (lane >> 2), piece = lane & 3; const int id = rid[(ch_) * 64 + sl]; \
            vraw[i] = *(const u32x4*)(KV8_ + (size_t)id * 512 + n * 128 + 64 + piece * 16); } } while (0)
        f32x4 st[16];
#pragma unroll
        for (int t = 0; t < 16; ++t) {
            asm volatile("" : "+v"(kraw[t][0]), "+v"(kraw[t][1]), "+v"(kraw[t][2]), "+v"(kraw[t][3]));
            bf16x8 k0, k1; fp8x16_to_bf16(kraw[t], k0, k1);
            f32x4 a = (f32x4){0.f, 0.f, 0.f, 0.f};
            a = __builtin_amdgcn_mfma_f32_16x16x32_bf16(k0, qf[0], a, 0, 0, 0);
            a = __builtin_amdgcn_mfma_f32_16x16x32_bf16(k1, qf[1], a, 0, 0, 0);
            st[t] = a;
            asm volatile("" : "+v"(st[t][0]), "+v"(st[t][1]), "+v"(st[t][2]), "+v"(st[t][3]));
        }

        const int qn = q + qstep;
        if (qn < SEQ) { const int rown = b * SEQ + qn, cntn = qn + 1 < TOPK ? qn + 1 : TOPK;
#pragma unroll
            for (int i = 0; i < 4; ++i) { const int slot = i * 64 + lane; vx[i] = slot < cntn ? IDX[(size_t)rown * TOPK + slot] : 0; } }
        ATT_VLOAD2(0);
        float mx = -INFINITY;
        if (cnt < TOPK) {
#pragma unroll
            for (int t = 0; t < 16; ++t)
#pragma unroll
                for (int j = 0; j < 4; ++j) { const int slot = t * 16 + fq * 4 + j; st[t][j] = slot < cnt ? st[t][j] : -INFINITY; }
        }
#pragma unroll
        for (int t = 0; t < 16; ++t) mx = fmaxf(mx, fmaxf(fmaxf(st[t][0], st[t][1]), fmaxf(st[t][2], st[t][3])));
        mx = fmaxf(mx, __shfl_xor(mx, 16)); mx = fmaxf(mx, __shfl_xor(mx, 32));
        const float cs = 0.18033688011112042f * kinv, mb = -mx * cs;
        float sum = 0.f;
#pragma unroll
        for (int t = 0; t < 16; ++t)
#pragma unroll
            for (int j = 0; j < 4; ++j) { const float e = __builtin_amdgcn_exp2f(fmaf(st[t][j], cs, mb)); st[t][j] = e; sum += e; }
        sum += __shfl_xor(sum, 16); sum += __shfl_xor(sum, 32);

        f32x4 oacc[4];
#pragma unroll
        for (int dt = 0; dt < 4; ++dt) oacc[dt] = (f32x4){0.f, 0.f, 0.f, 0.f};
#pragma unroll
        for (int ch = 0; ch < 4; ++ch) {
#pragma unroll
            for (int i = 0; i < 4; ++i) { const int sl = i * 16 + (lane >> 2), piece = lane & 3; bf16x8 v0, v1; fp8x16_to_bf16(vraw[i], v0, v1);
                *(LAS bf16x8*)(vt + sl * VST + piece * 32) = v0; *(LAS bf16x8*)(vt + sl * VST + piece * 32 + 16) = v1; }
            asm volatile("s_waitcnt lgkmcnt(0)" ::: "memory");
            if (ch < 3) ATT_VLOAD2(ch + 1);
#pragma unroll
            for (int s2 = 0; s2 < 2; ++s2) {
                const int t0 = ch * 4 + s2 * 2;
                const u32x4 pw = pack8(st[t0], st[t0 + 1]);
                const bf16x8 pf = __builtin_bit_cast(bf16x8, pw);
#pragma unroll
                for (int dt = 0; dt < 4; ++dt) {
                    LAS unsigned char* a0 = vt + (s2 * 32 + fq * 4 + (fr >> 2)) * VST + (dt * 16 + 4 * (fr & 3)) * 2;
                    const s16x4 v0 = lds_tr(a0), v1 = lds_tr(a0 + 16 * VST);
                    bf16x8 vf; vf[0] = v0[0]; vf[1] = v0[1]; vf[2] = v0[2]; vf[3] = v0[3]; vf[4] = v1[0]; vf[5] = v1[1]; vf[6] = v1[2]; vf[7] = v1[3];
                    oacc[dt] = __builtin_amdgcn_mfma_f32_16x16x32_bf16(pf, vf, oacc[dt], 0, 0, 0);
                }
            }
            asm volatile("s_waitcnt lgkmcnt(0)" ::: "memory");
        }
#undef ATT_VLOAD2

        const float i0 = vinv / __shfl(sum, 0), i1 = vinv / __shfl(sum, 1), i2 = vinv / __shfl(sum, 2), i3 = vinv / __shfl(sum, 3);
        if (fq == 0) {
#pragma unroll
            for (int dt = 0; dt < 4; ++dt) {
                bf16* o = Ob + (size_t)row * 1024 + (n * 4) * 64 + dt * 16 + fr;
                o[0] = (bf16)f2bf(oacc[dt][0] * i0); o[64] = (bf16)f2bf(oacc[dt][1] * i1); o[128] = (bf16)f2bf(oacc[dt][2] * i2); o[192] = (bf16)f2bf(oacc[dt][3] * i3);
            }
        }
        if (qn < SEQ) {
#pragma unroll
            for (int i = 0; i < 4; ++i) ridb[(buf ^ 1) * 256 + i * 64 + lane] = vx[i] + b * SEQ;
        }

    }

    asm volatile("s_waitcnt lgkmcnt(0)" ::: "memory");
}

__device__ __forceinline__ void ln_row_wave(const bf16* __restrict__ zrow, const float* __restrict__ g, const float* __restrict__ bt, float* __restrict__ of, bf16* __restrict__ ob, int lane) {
    f32x4 v[4]; float s = 0.f;
#pragma unroll
    for (int j = 0; j < 4; ++j) { const u32x2 w = *(const u32x2*)(zrow + 256 * j + 4 * lane); v[j] = (f32x4){bflo(w.x), bfhi(w.x), bflo(w.y), bfhi(w.y)}; s += (v[j][0] + v[j][1]) + (v[j][2] + v[j][3]); }
#pragma unroll
    for (int o = 1; o < 64; o <<= 1) s += __shfl_xor(s, o);
    const float mean = s * (1.f / D); float q = 0.f;
#pragma unroll
    for (int j = 0; j < 4; ++j) { v[j] = v[j] - mean; q += (v[j][0] * v[j][0] + v[j][1] * v[j][1]) + (v[j][2] * v[j][2] + v[j][3] * v[j][3]); }
#pragma unroll
    for (int o = 1; o < 64; o <<= 1) q += __shfl_xor(q, o);
    const float rstd = rsqrtf(q * (1.f / D) + LN_EPS);
#pragma unroll
    for (int j = 0; j < 4; ++j) { const f32x4 gg = *(const f32x4*)(g + 256 * j + 4 * lane), bb = *(const f32x4*)(bt + 256 * j + 4 * lane); const f32x4 o = v[j] * rstd * gg + bb;
        if (of) *(f32x4*)(of + 256 * j + 4 * lane) = o; u32x2 w; w.x = pk2(o[0], o[1]); w.y = pk2(o[2], o[3]); *(u32x2*)(ob + 256 * j + 4 * lane) = w; }
}

struct FResid {
    const float* rp; const float* rs; bf16* Z;
    __device__ __forceinline__ const float* rrow(int row) const { return row < TP ? rp + (size_t)row * D : rs + (size_t)(row - TP) * D; }
    __device__ __forceinline__ void put8(int row, int col, f32x4 v0, f32x4 v1) const { const float* r = rrow(row) + col;
        *(u32x4*)(Z + (size_t)row * D + col) = pack8(v0 + ALPHA * *(const f32x4*)r, v1 + ALPHA * *(const f32x4*)(r + 4)); }
    __device__ __forceinline__ void put4(int row, int col, f32x4 v) const { const f32x4 z = v + ALPHA * *(const f32x4*)(rrow(row) + col); u32x2 w; w.x = pk2(z[0], z[1]); w.y = pk2(z[2], z[3]); *(u32x2*)(Z + (size_t)row * D + col) = w; }
};
struct FResidB {
    const bf16* rp; const bf16* rs; bf16* Z;
    __device__ __forceinline__ const bf16* rrow(int row) const { return row < TP ? rp + (size_t)row * D : rs + (size_t)(row - TP) * D; }
    __device__ __forceinline__ void put8(int row, int col, f32x4 v0, f32x4 v1) const { const u32x4 r = *(const u32x4*)(rrow(row) + col);
        const f32x4 r0 = (f32x4){bflo(r.x), bfhi(r.x), bflo(r.y), bfhi(r.y)}, r1 = (f32x4){bflo(r.z), bfhi(r.z), bflo(r.w), bfhi(r.w)};
        *(u32x4*)(Z + (size_t)row * D + col) = pack8(v0 + ALPHA * r0, v1 + ALPHA * r1); }
    __device__ __forceinline__ void put4(int row, int col, f32x4 v) const { const u32x2 r = *(const u32x2*)(rrow(row) + col); const f32x4 z = v + ALPHA * (f32x4){bflo(r.x), bfhi(r.x), bflo(r.y), bfhi(r.y)};
        u32x2 w; w.x = pk2(z[0], z[1]); w.y = pk2(z[2], z[3]); *(u32x2*)(Z + (size_t)row * D + col) = w; }
};
}

namespace mk {
template <int CAP>
__device__ __forceinline__ void topk_wave_regs(const float* __restrict__ row, int n, int* __restrict__ out, LAS unsigned* hist, LAS float* cv, LAS int* ci, LAS unsigned char* lst, int lane) {
    if (n <= TOPK) { for (int i = lane; i < TOPK; i += 64) out[i] = i < n ? i : 0; return; }

    constexpr int NCH = 32;
    const int nch = n > 8192 ? 32 : (n + 255) >> 8;
    float vx = (lane < 4 && 8192 + lane < n) ? row[8192 + lane] : -INFINITY;
    f32x4 v[NCH];
#pragma unroll
    for (int j = 0; j < NCH; ++j) {
        if (j < nch) v[j] = *(const f32x4*)(row + j * 256 + lane * 4);
        else v[j] = (f32x4){-INFINITY, -INFINITY, -INFINITY, -INFINITY};
    }
    float mn = INFINITY, mx = -INFINITY;
#pragma unroll
    for (int j = 0; j < NCH; ++j) {
        if (j < nch) {
            const int base = j * 256 + lane * 4;
#pragma unroll
            for (int e = 0; e < 4; ++e) { const bool ok = base + e < n; const float x = v[j][e]; v[j][e] = ok ? x : -INFINITY; mx = fmaxf(mx, ok ? x : -INFINITY); mn = fminf(mn, ok ? x : INFINITY); }
        }
    }
    if (vx != -INFINITY) { mx = fmaxf(mx, vx); mn = fminf(mn, vx); }
#pragma unroll
    for (int o = 1; o < 64; o <<= 1) { mn = fminf(mn, __shfl_xor(mn, o)); mx = fmaxf(mx, __shfl_xor(mx, o)); }
    if (!(mx > mn)) { for (int i = lane; i < TOPK; i += 64) out[i] = i; return; }
    const float scale = 2048.0f / (mx - mn);

#pragma unroll
    for (int i = 0; i < 8; ++i) *(LAS u32x4*)(hist + i * 256 + lane * 4) = (u32x4){0u, 0u, 0u, 0u};
    asm volatile("s_waitcnt lgkmcnt(0)" ::: "memory");
#pragma unroll
    for (int j = 0; j < NCH; ++j) {
        if (j < nch) {
            asm volatile("" : "+v"(v[j][0]), "+v"(v[j][1]), "+v"(v[j][2]), "+v"(v[j][3]));
#pragma unroll
            for (int e = 0; e < 4; ++e) { const float x = v[j][e]; int bn = (int)((x - mn) * scale); bn = bn > 2047 ? 2047 : bn; bn = x != -INFINITY ? bn : 2048;
                __hip_atomic_fetch_add(hist + bn, 1u, __ATOMIC_RELAXED, __HIP_MEMORY_SCOPE_WAVEFRONT); }
        }
    }
    if (vx != -INFINITY) { int bn = (int)((vx - mn) * scale); bn = bn > 2047 ? 2047 : bn; __hip_atomic_fetch_add(hist + bn, 1u, __ATOMIC_RELAXED, __HIP_MEMORY_SCOPE_WAVEFRONT); }
    asm volatile("s_waitcnt lgkmcnt(0)" ::: "memory");

    unsigned mine = 0u;
#pragma unroll
    for (int i = 0; i < 8; ++i) { const u32x4 h4 = *(LAS u32x4*)(hist + lane * 32 + i * 4); mine += (h4.x + h4.y) + (h4.z + h4.w); }
    unsigned suf = mine;
#pragma unroll
    for (int o = 1; o < 64; o <<= 1) { const unsigned t = __shfl_down(suf, o); if (lane + o < 64) suf += t; }
    const unsigned long long bal = __ballot(suf >= (unsigned)TOPK);
    const int Lt = 63 - __builtin_clzll(bal);
    const unsigned above = __shfl(suf, Lt) - __shfl(mine, Lt);
    const unsigned hb = hist[Lt * 32 + (lane & 31)];
    unsigned sfx = hb;
#pragma unroll
    for (int o = 1; o < 32; o <<= 1) { const unsigned t = __shfl_down(sfx, o); if ((lane & 31) + o < 32) sfx += t; }
    const unsigned long long okm = __ballot(above + sfx >= (unsigned)TOPK) & 0xFFFFFFFFull;
    const int jb = 63 - __builtin_clzll(okm);
    const int B = Lt * 32 + jb;
    const unsigned running = above + __shfl(sfx, jb) - __shfl(hb, jb);
    const int cnt_gt = (int)running, r = TOPK - cnt_gt;

    int base_gt = 0, base_eq = 0;
    const unsigned long long below = (1ull << lane) - 1ull;
    int lane4 = lane * 4; asm volatile("" : "+v"(lane4));
#pragma unroll
    for (int j = 0; j < NCH; ++j) {
        if (j < nch) {
#pragma unroll
            for (int e = 0; e < 4; ++e) {
                const float x = v[j][e]; int bn = (int)((x - mn) * scale); bn = bn > 2047 ? 2047 : bn; bn = x != -INFINITY ? bn : -1;
                const bool gt = bn > B, eq = bn == B;
                const unsigned long long mg = __ballot(gt), me = __ballot(eq);
                if (mg | me) {
                    const int idx = lane4 + (j * 256 + e);
                    if (gt) out[base_gt + __builtin_popcountll(mg & below)] = idx;
                    if (eq) { const int p = base_eq + __builtin_popcountll(me & below); if (p < CAP) { cv[p] = x; ci[p] = idx; } }
                    base_gt += __builtin_popcountll(mg); base_eq += __builtin_popcountll(me);
                }
            }
        }
    }
    if (n > 8192) {
        const float x = vx; bool gt = false, eq = false;
        if (x != -INFINITY) { int bn = (int)((x - mn) * scale); bn = bn > 2047 ? 2047 : bn; gt = bn > B; eq = bn == B; }
        const unsigned long long mg = __ballot(gt), me = __ballot(eq);
        const int idx = 8192 + lane;
        if (gt) out[base_gt + __builtin_popcountll(mg & below)] = idx;
        if (eq) { const int p = base_eq + __builtin_popcountll(me & below); if (p < CAP) { cv[p] = x; ci[p] = idx; } }
        base_gt += __builtin_popcountll(mg); base_eq += __builtin_popcountll(me);
    }
    asm volatile("s_waitcnt vmcnt(0) lgkmcnt(0)" ::: "memory");

    const int m = base_eq < CAP ? base_eq : CAP;
    if (m <= 64) {
        const float x = lane < m ? cv[lane] : -INFINITY; const int id = lane < m ? ci[lane] : 0x7fffffff; int rank = 0;
        for (int c2 = 0; c2 < m; ++c2) { const float x2 = __builtin_bit_cast(float, __builtin_amdgcn_readlane(__builtin_bit_cast(int, x), c2)); const int id2 = __builtin_amdgcn_readlane(id, c2);
            rank += (x2 > x || (x2 == x && id2 < id)) ? 1 : 0; }
        if (lane < m && rank < r) out[cnt_gt + rank] = id;
    } else {
        for (int c = lane; c < m; c += 64) {
            const float x = cv[c]; const int id = ci[c]; int rank = 0;
            for (int c2 = 0; c2 < m; ++c2) { const float x2 = cv[c2]; const int id2 = ci[c2]; rank += (x2 > x || (x2 == x && id2 < id)) ? 1 : 0; }
            if (rank < r) out[cnt_gt + rank] = id;
        }
    }
    asm volatile("s_waitcnt lgkmcnt(0)" ::: "memory");

}

__device__ __forceinline__ void phase_topk2(const float* __restrict__ SC, const float* __restrict__ SCS, int* __restrict__ IDX, int* __restrict__ CNT,
                                            const float* __restrict__ peer_u_, const float* __restrict__ peer_v_, unsigned char* __restrict__ Uq_, unsigned char* __restrict__ Vq_, float* __restrict__ Usc_, float* __restrict__ Vsc_,
                                            LAS unsigned char* lds, unsigned* qhead, int wave, int lane, int gw, int NGW, int jlo = 0, int jhi = TA) {
    constexpr int CAP = 1020;
    LAS unsigned* hist = (LAS unsigned*)(lds + wave * 16384);
    LAS float* cv = (LAS float*)(lds + wave * 16384 + 8208);
    LAS int* ci = (LAS int*)(lds + wave * 16384 + 8208 + 4080);
    LAS unsigned char* lst = nullptr;

    for (int j = gw; j < TA; j += NGW) {
        if (j < jlo || j >= jhi) continue;
        int row, n; const float* rp;
        if (j < TP) { const int b = j >> 13, jj = j & 8191, blk = jj >> 11; const int q = blk < 2 ? jj : blk * 2048 + 2047 - (jj & 2047);
            row = b * SEQ + q; n = q + 1; rp = SC + (size_t)row * SEQ; }
        else { const int r = j - TP; row = j; n = PAST + (r % DS) + 1; rp = SCS + (size_t)r * SCS_LD; }

        topk_wave_regs<CAP>(rp, n, IDX + (size_t)row * TOPK, hist, cv, ci, lst, lane);

        if (lane == 0) CNT[row] = n < TOPK ? n : TOPK;
    }

}
}

namespace mk {
using bf16x2_t = __attribute__((ext_vector_type(2))) __bf16;
__device__ __forceinline__ float dot2bf(unsigned a, unsigned b, float acc) { return __builtin_amdgcn_fdot2_f32_bf16(__builtin_bit_cast(bf16x2_t, a), __builtin_bit_cast(bf16x2_t, b), acc, false); }

struct FStoreBf16 {
    bf16* O; int ld;
    __device__ __forceinline__ void put8(int row, int col, f32x4 v0, f32x4 v1) const { *(u32x4*)(O + (size_t)row * ld + col) = pack8(v0, v1); }
    __device__ __forceinline__ void put4(int row, int col, f32x4 v) const { u32x2 w; w.x = pk2(v[0], v[1]); w.y = pk2(v[2], v[3]); *(u32x2*)(O + (size_t)row * ld + col) = w; }
};

#ifndef PGS
#define PGS 8
#endif
#ifndef PEER_UMFMA
#define PEER_UMFMA 0
#endif
#ifndef PEER_XFMT
#define PEER_XFMT 4
#endif
constexpr int PEER_TAB_OFF = LDSCTL_OFF + 1024;

__device__ __forceinline__ void ce_desc(unsigned& a, unsigned& b) { const unsigned hi = a > b ? a : b, lo = a > b ? b : a; a = hi; b = lo; }
template <int N> __device__ __forceinline__ void bitonic_sort_desc(unsigned (&k)[N]) {
#pragma unroll
    for (int size = 2; size <= N; size <<= 1)
#pragma unroll
        for (int stride = size >> 1; stride > 0; stride >>= 1)
#pragma unroll
            for (int i = 0; i < N; ++i) { const int j = i ^ stride; if (j > i) { if ((i & size) == 0) ce_desc(k[i], k[j]); else ce_desc(k[j], k[i]); } }
}
template <int N> __device__ __forceinline__ void bitonic_merge_desc(unsigned (&k)[N]) {
#pragma unroll
    for (int stride = N >> 1; stride > 0; stride >>= 1)
#pragma unroll
        for (int i = 0; i < N; ++i) { const int j = i ^ stride; if (j > i) ce_desc(k[i], k[j]); }
}
__device__ __forceinline__ void top16_merge(unsigned (&a)[16], const unsigned (&b)[16]) {
#pragma unroll
    for (int i = 0; i < 16; ++i) a[i] = a[i] > b[15 - i] ? a[i] : b[15 - i];
    bitonic_merge_desc<16>(a);
}
__device__ __forceinline__ void top16_xlane(unsigned (&a)[16], int o) {
    unsigned b[16];
#pragma unroll
    for (int i = 0; i < 16; ++i) b[i] = (unsigned)__shfl_xor((int)a[i], o);
    top16_merge(a, b);
}
__device__ __forceinline__ unsigned f2ord(float f) { const unsigned u = __builtin_bit_cast(unsigned, f); return u ^ ((u >> 31) ? 0xFFFFFFFFu : 0x80000000u); }
__device__ __forceinline__ float ord2f(unsigned o) { const unsigned u = o ^ ((o >> 31) ? 0x80000000u : 0xFFFFFFFFu); return __builtin_bit_cast(float, u); }

__device__ __forceinline__ void phase_peer_select(const bf16* __restrict__ PQb, const bf16* __restrict__ K1, const bf16* __restrict__ K2, unsigned short* __restrict__ teid_g, float* __restrict__ tgate_g,
                                                  LAS unsigned char* lds, int vcu, int G, int wave, int lane) {
    const int fr = lane & 15, fq = lane >> 4, h = wave;
    LAS unsigned char* itab = lds + wave * 1024;
    for (int tile = vcu; tile < TA / 16; tile += G) {
        const int tok0 = tile * 16;
        unsigned tk[2][16];
#pragma unroll
        for (int half = 0; half < 2; ++half) {
            const bf16* ap = PQb + (size_t)(tok0 + fr) * PEER_N + h * 256 + half * 128 + fq * 8;
            bf16x8 a[4];
#pragma unroll
            for (int ks = 0; ks < 4; ++ks) a[ks] = *(const bf16x8*)(ap + ks * 32);
            const bf16* kb = (half ? K2 : K1) + (size_t)fr * 128 + fq * 8;
            unsigned k0[16], k1[16];
#pragma unroll
            for (int ct = 0; ct < 8; ++ct) {
                f32x4 acc = (f32x4){0.f, 0.f, 0.f, 0.f};
#pragma unroll
                for (int ks = 0; ks < 4; ++ks) { const bf16x8 b = *(const bf16x8*)(kb + (size_t)ct * 16 * 128 + ks * 32); acc = __builtin_amdgcn_mfma_f32_16x16x32_bf16(b, a[ks], acc, 0, 0, 0); }
#pragma unroll
                for (int j = 0; j < 4; ++j) { const unsigned key = (f2ord(acc[j]) & 0xFFFFFF80u) | (unsigned)(127 - (ct * 16 + 4 * fq + j));
                    if (ct < 4) k0[ct * 4 + j] = key; else k1[(ct - 4) * 4 + j] = key; }
                if (ct & 1) asm volatile("" ::: "memory");
            }
            bitonic_sort_desc<16>(k0); bitonic_sort_desc<16>(k1);
            top16_merge(k0, k1); top16_xlane(k0, 16); top16_xlane(k0, 32);
#pragma unroll
            for (int i = 0; i < 16; ++i) tk[half][i] = k0[i];
        }
        if (fq == 0) {
#pragma unroll
            for (int i = 0; i < 16; ++i) { itab[fr * 32 + i] = (unsigned char)(127 - (tk[0][i] & 0x7Fu)); itab[fr * 32 + 16 + i] = (unsigned char)(127 - (tk[1][i] & 0x7Fu)); }
        }
        unsigned ck[16];
        {
            float v1[16], v2[16];
#pragma unroll
            for (int i = 0; i < 16; ++i) { v1[i] = ord2f(tk[0][i] & 0xFFFFFF80u); v2[i] = ord2f(tk[1][i] & 0xFFFFFF80u); }
            int c = 0;
#pragma unroll
            for (int i = 0; i < 16; ++i)
#pragma unroll
                for (int j = 0; j < 16; ++j) {
                    if ((i + 1) * (j + 1) <= 16) {
                        const unsigned key = (f2ord(v1[i] + v2[j]) & 0xFFFFFF00u) | (unsigned)(255 - (i * 16 + j));
                        const int m = c >> 2, pt = c & 3;
                        if (pt == 0) ck[m] = key; else ck[m] = fq == pt ? key : ck[m];
                        ++c;
                    }
                }
            ck[12] = fq < 2 ? ck[12] : 0u; ck[13] = 0u; ck[14] = 0u; ck[15] = 0u;
        }
        bitonic_sort_desc<16>(ck); top16_xlane(ck, 16); top16_xlane(ck, 32);
        asm volatile("s_waitcnt lgkmcnt(0)" ::: "memory");
        float ev[16]; float sum = 0.f; const float mxv = ord2f(ck[0] & 0xFFFFFF00u);
#pragma unroll
        for (int k = 0; k < 16; ++k) { ev[k] = __expf(ord2f(ck[k] & 0xFFFFFF00u) - mxv); sum += ev[k]; }
        const float inv = 1.f / sum;
#pragma unroll
        for (int k = 0; k < 16; ++k) {
            if ((k >> 2) == fq) {
                const int f = 255 - (int)(ck[k] & 0xFFu); const int id = (int)itab[fr * 32 + (f >> 4)] * 128 + (int)itab[fr * 32 + 16 + (f & 15)];
                teid_g[(size_t)(tok0 + fr) * 128 + h * 16 + k] = (unsigned short)id; tgate_g[(size_t)(tok0 + fr) * 128 + h * 16 + k] = ev[k] * inv;
            }
        }
        asm volatile("s_waitcnt lgkmcnt(0)" ::: "memory");
    }
}

#if PEER_BITS == 4
__device__ __forceinline__ u32x4 prow_load(const unsigned char* __restrict__ T, int id, int lane) { const u32x2 r = *(const u32x2*)(T + (size_t)id * PEER_RS + lane * 8); u32x4 t; t.x = r.x; t.y = r.y; t.z = 0u; t.w = 0u; return t; }
#define PROW_LOAD(T, id) prow_load(T, id, lane)
#elif PEER_BITS == 6
typedef unsigned v6u_t __attribute__((ext_vector_type(6)));
typedef float v32f_t __attribute__((ext_vector_type(32)));
__device__ __forceinline__ u32x4 prow_load(const unsigned char* __restrict__ T, int id, int lane) { const unsigned* rp = (const unsigned*)(T + (size_t)id * PEER_RB + lane * 12); u32x4 t; t.x = rp[0]; t.y = rp[1]; t.z = rp[2]; t.w = 0u; return t; }
#define PROW_LOAD(T, id) prow_load(T, id, lane)
#else
#define PROW_LOAD(T, id) (*(const u32x4*)((T) + (size_t)(id) * D + lane * 16))
#endif
#define SHX_(v_, o_) __builtin_bit_cast(float, __builtin_amdgcn_ds_bpermute((lane ^ (o_)) << 2, __builtin_bit_cast(int, (float)(v_))))
__device__ __forceinline__ void phase_peer_mix(const bf16* __restrict__ Zin, const float* __restrict__ g1, const float* __restrict__ b1, const unsigned short* __restrict__ teid, const float* __restrict__ tgate,
                                               const unsigned char* __restrict__ U, const unsigned char* __restrict__ V, const float* __restrict__ Us, const float* __restrict__ Vs, const float* __restrict__ g2, const float* __restrict__ b2,
                                               float* __restrict__ outf, bf16* __restrict__ outb, LAS unsigned char* wl, int gw, int NGW, int lane_in) {

    for (int j = gw; j < TP + TS * 16; j += NGW) {
        int lane = lane_in; asm volatile("" : "+v"(lane));
        size_t tok;
        if (j < TP) tok = (size_t)j;
        else { const int s = j - TP; if ((s & 15) != 0) continue; tok = (size_t)TP + (s >> 4); }
        {
            float xf[16];
            { float s1 = 0.f;
#pragma unroll
              for (int q = 0; q < 2; ++q) { const u32x4 w = *(const u32x4*)(Zin + tok * D + lane * 16 + q * 8);
#pragma unroll
                  for (int i = 0; i < 4; ++i) { xf[q * 8 + 2 * i] = bflo(w[i]); xf[q * 8 + 2 * i + 1] = bfhi(w[i]); s1 += xf[q * 8 + 2 * i] + xf[q * 8 + 2 * i + 1]; } }
#pragma unroll
              for (int o = 1; o < 64; o <<= 1) s1 += SHX_(s1, o);
              const float mean1 = s1 * (1.f / D); float q1 = 0.f;
#pragma unroll
              for (int i = 0; i < 16; ++i) { xf[i] -= mean1; q1 += xf[i] * xf[i]; }
#pragma unroll
              for (int o = 1; o < 64; o <<= 1) q1 += SHX_(q1, o);
              const float rstd1 = rsqrtf(q1 * (1.f / D) + LN_EPS);
#pragma unroll
              for (int q = 0; q < 4; ++q) { const f32x4 gg = *(const f32x4*)(g1 + lane * 16 + q * 4), bb = *(const f32x4*)(b1 + lane * 16 + q * 4);
#pragma unroll
                  for (int i = 0; i < 4; ++i) xf[q * 4 + i] = xf[q * 4 + i] * rstd1 * gg[i] + bb[i]; } }
            float wv0 = 0.f, wv1 = 0.f;
#if PEER_BITS == 4 && PEER_UMFMA
            {
                typedef int v8i_t __attribute__((ext_vector_type(8)));
                const int n16 = lane & 15, kq = lane >> 4;
                unsigned idp[4];
#pragma unroll
                for (int t = 0; t < 4; ++t) idp[t] = (unsigned)teid[tok * 128 + t * 16 + n16] | ((unsigned)teid[tok * 128 + (t + 4) * 16 + n16] << 16);
                float am = 0.f;
#pragma unroll
                for (int i = 0; i < 16; ++i) am = fmaxf(am, fabsf(xf[i]));
#pragma unroll
                for (int o = 1; o < 64; o <<= 1) am = fmaxf(am, SHX_(am, o));
#if PEER_XFMT == 8
                const float xinv = am > 0.f ? 448.f / am : 0.f, sx = am * (1.f / 448.f);
                { u32x4 w;
#pragma unroll
                  for (int q = 0; q < 4; ++q) { int x = __builtin_amdgcn_cvt_pk_fp8_f32(xf[q * 4] * xinv, xf[q * 4 + 1] * xinv, 0, false); x = __builtin_amdgcn_cvt_pk_fp8_f32(xf[q * 4 + 2] * xinv, xf[q * 4 + 3] * xinv, x, true); w[q] = (unsigned)x; }
                  *(LAS u32x4*)(wl + lane * 16) = w; }
#else
                const float xinv = am > 0.f ? 6.f / am : 0.f, sx = am * (1.f / 6.f);
                { u32x2 whi, wlo; whi.x = 0u; whi.y = 0u; wlo.x = 0u; wlo.y = 0u;
#pragma unroll
                  for (int i = 0; i < 16; ++i) {
                      const float xs = xf[i] * xinv, a = fabsf(xs);
                      const float gq = a < 2.f ? rintf(a * 2.f) * 0.5f : (a < 4.f ? rintf(a) : fminf(6.f, 2.f * rintf(a * 0.5f)));
                      const unsigned chi = (unsigned)(gq < 2.f ? gq * 2.f : (gq < 4.f ? gq + 2.f : gq * 0.5f + 4.f)) | (xs < 0.f ? 8u : 0u);
                      const float r = (xs - (xs < 0.f ? -gq : gq)) * 4.f;
                      const unsigned clo = enc_e2m1(r);
                      if (i < 8) { whi.x |= chi << (4 * i); wlo.x |= clo << (4 * i); } else { whi.y |= chi << (4 * (i - 8)); wlo.y |= clo << (4 * (i - 8)); }
                  }
                  *(LAS u32x2*)(wl + lane * 8) = whi; *(LAS u32x2*)(wl + 512 + lane * 8) = wlo; }
#endif
#pragma unroll
                for (int q = 0; q < 4; ++q) *(LAS f32x4*)(wl + 1024 + q * 1024 + lane * 16) = (f32x4){xf[q * 4], xf[q * 4 + 1], xf[q * 4 + 2], xf[q * 4 + 3]};
                float h0 = 0.f, h1 = 0.f;
                u32x4 qb[3][4];
#define PU_TILE(u_) ((((u_) >> 3) << 2) | ((u_) & 3))
#define PU_HALF(u_) (((u_) >> 2) & 1)
#define PU_LOADU(u_) { const unsigned id_ = ((u_) >> 3) ? (idp[(u_) & 3] >> 16) : (idp[(u_) & 3] & 0xFFFFu); const unsigned char* rp_ = U + (size_t)id_ * PEER_RB + PU_HALF(u_) * 256 + kq * 16; _Pragma("unroll") for (int jj = 0; jj < 4; ++jj) qb[(u_) % 3][jj] = *(const u32x4*)(rp_ + jj * 64); }
                PU_LOADU(0) PU_LOADU(1)
#pragma unroll
                for (int g = 0; g < 2; ++g) {
                    f32x4 acc[4];
#pragma unroll
                    for (int t = 0; t < 4; ++t) acc[t] = (f32x4){0.f, 0.f, 0.f, 0.f};
#pragma unroll
                    for (int ph = 0; ph < 2; ++ph) {
#if PEER_XFMT == 8
                        v8i_t aop[4];
#pragma unroll
                        for (int jj = 0; jj < 4; ++jj) { const int j = ph * 4 + jj; const u32x4 a0 = *(const LAS u32x4*)(wl + j * 128 + kq * 32), a1 = *(const LAS u32x4*)(wl + j * 128 + kq * 32 + 16);
                            aop[jj] = (v8i_t){(int)a0.x, (int)a0.y, (int)a0.z, (int)a0.w, (int)a1.x, (int)a1.y, (int)a1.z, (int)a1.w}; }
#else
                        u32x4 ahi[4], alo[4];
#pragma unroll
                        for (int jj = 0; jj < 4; ++jj) { const int j = ph * 4 + jj; ahi[jj] = *(const LAS u32x4*)(wl + j * 64 + kq * 16); alo[jj] = *(const LAS u32x4*)(wl + 512 + j * 64 + kq * 16); }
#endif
#pragma unroll
                        for (int t = 0; t < 4; ++t) {
                            const int u = g * 8 + ph * 4 + t;
                            if (u + 2 < 16) PU_LOADU(u + 2)
                            asm volatile("" ::: "memory");
#pragma unroll
                            for (int jj = 0; jj < 4; ++jj) { const u32x4 b = qb[u % 3][jj]; const v8i_t bop = (v8i_t){(int)b.x, (int)b.y, (int)b.z, (int)b.w, 0, 0, 0, 0};
#if PEER_XFMT == 8
                                acc[t] = __builtin_amdgcn_mfma_scale_f32_16x16x128_f8f6f4(aop[jj], bop, acc[t], 0, 4, 0, 0x7f7f7f7f, 0, 0x7f7f7f7f); }
#else
                                const v8i_t ah = (v8i_t){(int)ahi[jj].x, (int)ahi[jj].y, (int)ahi[jj].z, (int)ahi[jj].w, 0, 0, 0, 0}, al = (v8i_t){(int)alo[jj].x, (int)alo[jj].y, (int)alo[jj].z, (int)alo[jj].w, 0, 0, 0, 0};
                                acc[t] = __builtin_amdgcn_mfma_scale_f32_16x16x128_f8f6f4(ah, bop, acc[t], 4, 4, 0, 0x7f7f7f7f, 0, 0x7f7f7f7f);
                                acc[t] = __builtin_amdgcn_mfma_scale_f32_16x16x128_f8f6f4(al, bop, acc[t], 4, 4, 0, 0x7d7d7d7d, 0, 0x7f7f7f7f); }
#endif
                        }
                    }
#pragma unroll
                    for (int t = 0; t < 4; ++t) { if (kq == t) { if (g == 0) h0 = acc[t][0]; else h1 = acc[t][0]; } }
                }
#undef PU_LOADU
#undef PU_TILE
#undef PU_HALF
                const int e0 = (int)teid[tok * 128 + lane], e1 = (int)teid[tok * 128 + 64 + lane];
                const float hd0 = h0 * sx * Us[e0], hd1 = h1 * sx * Us[e1];
                wv0 = 0.5f * hd0 * (1.f + erff(hd0 * 0.70710678118654752f)) * tgate[tok * 128 + lane] * Vs[e0];
                wv1 = 0.5f * hd1 * (1.f + erff(hd1 * 0.70710678118654752f)) * tgate[tok * 128 + 64 + lane] * Vs[e1];
            }
#else
#if PEER_UVI
            float y[16];
#pragma unroll
            for (int i = 0; i < 16; ++i) y[i] = 0.f;
#endif
#pragma unroll 1
            for (int bt = 0; bt < 2; ++bt) {
                const int eidv = (int)teid[tok * 128 + bt * 64 + lane];
                {
                float p[64];

                u32x4 qb[2][PGS];
#pragma unroll
                for (int i = 0; i < PGS; ++i) { const int id = __builtin_amdgcn_readlane(eidv, i); qb[0][i] = PROW_LOAD(U, id); }
#pragma unroll
                for (int g = 0; g < 64 / PGS; ++g) {
                    if (g < 64 / PGS - 1) {
#pragma unroll
                        for (int i = 0; i < PGS; ++i) { const int id = __builtin_amdgcn_readlane(eidv, (g + 1) * PGS + i); qb[(g + 1) & 1][i] = PROW_LOAD(U, id); }
                    }
                    asm volatile("" ::: "memory");
#if PEER_BITS == 4
#pragma unroll
                    for (int i = 0; i < PGS; ++i) {
                        f32x2v a2 = {0.f, 0.f};
#pragma unroll
                        for (int w = 0; w < 2; ++w) {
#define PU4(b) { const f32x2v f = __builtin_amdgcn_cvt_scalef32_pk_f32_fp4(qb[g & 1][i][w], 1.0f, b); const f32x2v xx = {xf[w * 8 + b * 2], xf[w * 8 + b * 2 + 1]}; a2 = __builtin_elementwise_fma(f, xx, a2); }
                            PU4(0) PU4(1) PU4(2) PU4(3)
#undef PU4
                        }
                        p[g * PGS + i] = a2[0] + a2[1];
                        __builtin_amdgcn_sched_barrier(0);
                    }
#elif PEER_BITS == 6
#pragma unroll
                    for (int i = 0; i < PGS; i += 2) {
                        const v6u_t pk = {qb[g & 1][i][0], qb[g & 1][i][1], qb[g & 1][i][2], qb[g & 1][i + 1][0], qb[g & 1][i + 1][1], qb[g & 1][i + 1][2]};
                        const v32f_t f = __builtin_amdgcn_cvt_scalef32_pk32_f32_fp6(pk, 1.0f);
                        float a0 = 0.f, a1 = 0.f;
#pragma unroll
                        for (int k = 0; k < 16; ++k) { a0 = fmaf(f[k], xf[k], a0); a1 = fmaf(f[16 + k], xf[k], a1); }
                        p[g * PGS + i] = a0; p[g * PGS + i + 1] = a1;
                        __builtin_amdgcn_sched_barrier(0);
                    }
#else
#pragma unroll
                    for (int i = 0; i < PGS; ++i) {
                        float a = 0.f;
#pragma unroll
                        for (int w = 0; w < 4; ++w) { const f32x2v lo = __builtin_amdgcn_cvt_pk_f32_fp8((int)qb[g & 1][i][w], false), hi = __builtin_amdgcn_cvt_pk_f32_fp8((int)qb[g & 1][i][w], true);
                            a = fmaf(lo[0], xf[w * 4], a); a = fmaf(lo[1], xf[w * 4 + 1], a); a = fmaf(hi[0], xf[w * 4 + 2], a); a = fmaf(hi[1], xf[w * 4 + 3], a); }
                        p[g * PGS + i] = a;
                        __builtin_amdgcn_sched_barrier(0);
                    }
#endif
                }

#pragma unroll
                for (int o = 32; o >= 1; o >>= 1) {
                    const bool up = (lane & o) != 0;
#pragma unroll
                    for (int i = 0; i < o; ++i) { const float keep = up ? p[i + o] : p[i], send = up ? p[i] : p[i + o]; p[i] = keep + SHX_(send, o); }
                }
                const float hdot = p[0] * Us[eidv];
                const float wv = 0.5f * hdot * (1.f + erff(hdot * 0.70710678118654752f)) * tgate[tok * 128 + bt * 64 + lane] * Vs[eidv];
                if (bt == 0) wv0 = wv; else wv1 = wv;

                }
#if PEER_UVI
                {
                const float wvv = bt == 0 ? wv0 : wv1;
                u32x4 qb[2][PGS];
#pragma unroll
                for (int i = 0; i < PGS; ++i) { const int id = __builtin_amdgcn_readlane(eidv, i); qb[0][i] = PROW_LOAD(V, id); }
#pragma unroll
                for (int g = 0; g < 64 / PGS; ++g) {
                    if (g < 64 / PGS - 1) {
#pragma unroll
                        for (int i = 0; i < PGS; ++i) { const int id = __builtin_amdgcn_readlane(eidv, (g + 1) * PGS + i); qb[(g + 1) & 1][i] = PROW_LOAD(V, id); }
                    }
                    asm volatile("" ::: "memory");
#if PEER_BITS == 4
#pragma unroll
                    for (int i = 0; i < PGS; ++i) {
                        const float w = __builtin_bit_cast(float, __builtin_amdgcn_readlane(__builtin_bit_cast(int, wvv), g * PGS + i));
                        asm volatile("" : "+v"(qb[g & 1][i][0]), "+v"(qb[g & 1][i][1]));
#pragma unroll
                        for (int k = 0; k < 2; ++k) {
#define PV4(b) { const f32x2v f = __builtin_amdgcn_cvt_scalef32_pk_f32_fp4(qb[g & 1][i][k], 1.0f, b); f32x2v yy = {y[k * 8 + b * 2], y[k * 8 + b * 2 + 1]}; const f32x2v ww = {w, w}; yy = __builtin_elementwise_fma(ww, f, yy); y[k * 8 + b * 2] = yy[0]; y[k * 8 + b * 2 + 1] = yy[1]; }
                            PV4(0) PV4(1) PV4(2) PV4(3)
#undef PV4
                        }
                        asm volatile("" : "+v"(y[0]), "+v"(y[1]), "+v"(y[2]), "+v"(y[3]), "+v"(y[4]), "+v"(y[5]), "+v"(y[6]), "+v"(y[7]), "+v"(y[8]), "+v"(y[9]), "+v"(y[10]), "+v"(y[11]), "+v"(y[12]), "+v"(y[13]), "+v"(y[14]), "+v"(y[15]));
                    }
#elif PEER_BITS == 6
#pragma unroll
                    for (int i = 0; i < PGS; i += 2) {
                        const float w0 = __builtin_bit_cast(float, __builtin_amdgcn_readlane(__builtin_bit_cast(int, wvv), g * PGS + i)), w1 = __builtin_bit_cast(float, __builtin_amdgcn_readlane(__builtin_bit_cast(int, wvv), g * PGS + i + 1));
                        asm volatile("" : "+v"(qb[g & 1][i][0]), "+v"(qb[g & 1][i][1]), "+v"(qb[g & 1][i][2]), "+v"(qb[g & 1][i + 1][0]), "+v"(qb[g & 1][i + 1][1]), "+v"(qb[g & 1][i + 1][2]));
                        const v6u_t pk = {qb[g & 1][i][0], qb[g & 1][i][1], qb[g & 1][i][2], qb[g & 1][i + 1][0], qb[g & 1][i + 1][1], qb[g & 1][i + 1][2]};
                        const v32f_t f = __builtin_amdgcn_cvt_scalef32_pk32_f32_fp6(pk, 1.0f);
#pragma unroll
                        for (int k = 0; k < 16; ++k) { y[k] = fmaf(w0, f[k], y[k]); y[k] = fmaf(w1, f[16 + k], y[k]); }
                        asm volatile("" : "+v"(y[0]), "+v"(y[1]), "+v"(y[2]), "+v"(y[3]), "+v"(y[4]), "+v"(y[5]), "+v"(y[6]), "+v"(y[7]), "+v"(y[8]), "+v"(y[9]), "+v"(y[10]), "+v"(y[11]), "+v"(y[12]), "+v"(y[13]), "+v"(y[14]), "+v"(y[15]));
                    }
#else
#pragma unroll
                    for (int i = 0; i < PGS; ++i) {
                        const float w = __builtin_bit_cast(float, __builtin_amdgcn_readlane(__builtin_bit_cast(int, wvv), g * PGS + i));
                        asm volatile("" : "+v"(qb[g & 1][i][0]), "+v"(qb[g & 1][i][1]), "+v"(qb[g & 1][i][2]), "+v"(qb[g & 1][i][3]));
#pragma unroll
                        for (int k = 0; k < 4; ++k) { const f32x2v lo = __builtin_amdgcn_cvt_pk_f32_fp8((int)qb[g & 1][i][k], false), hi = __builtin_amdgcn_cvt_pk_f32_fp8((int)qb[g & 1][i][k], true);
                            y[k * 4] = fmaf(w, lo[0], y[k * 4]); y[k * 4 + 1] = fmaf(w, lo[1], y[k * 4 + 1]); y[k * 4 + 2] = fmaf(w, hi[0], y[k * 4 + 2]); y[k * 4 + 3] = fmaf(w, hi[1], y[k * 4 + 3]); }
                        asm volatile("" : "+v"(y[0]), "+v"(y[1]), "+v"(y[2]), "+v"(y[3]), "+v"(y[4]), "+v"(y[5]), "+v"(y[6]), "+v"(y[7]), "+v"(y[8]), "+v"(y[9]), "+v"(y[10]), "+v"(y[11]), "+v"(y[12]), "+v"(y[13]), "+v"(y[14]), "+v"(y[15]));
                    }
#endif
                }
                            }
#endif
            }
#endif

#if !PEER_UVI
            float y[16];
#pragma unroll
            for (int i = 0; i < 16; ++i) y[i] = 0.f;
#endif
#if !PEER_UVI
#pragma unroll 1
            for (int bt = 0; bt < 2; ++bt) {
                const int eidv = (int)teid[tok * 128 + bt * 64 + lane]; const float wvv = bt == 0 ? wv0 : wv1;
                u32x4 qb[2][PGS];
#pragma unroll
                for (int i = 0; i < PGS; ++i) { const int id = __builtin_amdgcn_readlane(eidv, i); qb[0][i] = PROW_LOAD(V, id); }
#pragma unroll
                for (int g = 0; g < 64 / PGS; ++g) {
                    if (g < 64 / PGS - 1) {
#pragma unroll
                        for (int i = 0; i < PGS; ++i) { const int id = __builtin_amdgcn_readlane(eidv, (g + 1) * PGS + i); qb[(g + 1) & 1][i] = PROW_LOAD(V, id); }
                    }
                    asm volatile("" ::: "memory");
#if PEER_BITS == 4
#pragma unroll
                    for (int i = 0; i < PGS; ++i) {
                        const float w = __builtin_bit_cast(float, __builtin_amdgcn_readlane(__builtin_bit_cast(int, wvv), g * PGS + i));
                        asm volatile("" : "+v"(qb[g & 1][i][0]), "+v"(qb[g & 1][i][1]));
#pragma unroll
                        for (int k = 0; k < 2; ++k) {
#define PV4(b) { const f32x2v f = __builtin_amdgcn_cvt_scalef32_pk_f32_fp4(qb[g & 1][i][k], 1.0f, b); f32x2v yy = {y[k * 8 + b * 2], y[k * 8 + b * 2 + 1]}; const f32x2v ww = {w, w}; yy = __builtin_elementwise_fma(ww, f, yy); y[k * 8 + b * 2] = yy[0]; y[k * 8 + b * 2 + 1] = yy[1]; }
                            PV4(0) PV4(1) PV4(2) PV4(3)
#undef PV4
                        }
                        asm volatile("" : "+v"(y[0]), "+v"(y[1]), "+v"(y[2]), "+v"(y[3]), "+v"(y[4]), "+v"(y[5]), "+v"(y[6]), "+v"(y[7]), "+v"(y[8]), "+v"(y[9]), "+v"(y[10]), "+v"(y[11]), "+v"(y[12]), "+v"(y[13]), "+v"(y[14]), "+v"(y[15]));
                    }
#elif PEER_BITS == 6
#pragma unroll
                    for (int i = 0; i < PGS; i += 2) {
                        const float w0 = __builtin_bit_cast(float, __builtin_amdgcn_readlane(__builtin_bit_cast(int, wvv), g * PGS + i)), w1 = __builtin_bit_cast(float, __builtin_amdgcn_readlane(__builtin_bit_cast(int, wvv), g * PGS + i + 1));
                        asm volatile("" : "+v"(qb[g & 1][i][0]), "+v"(qb[g & 1][i][1]), "+v"(qb[g & 1][i][2]), "+v"(qb[g & 1][i + 1][0]), "+v"(qb[g & 1][i + 1][1]), "+v"(qb[g & 1][i + 1][2]));
                        const v6u_t pk = {qb[g & 1][i][0], qb[g & 1][i][1], qb[g & 1][i][2], qb[g & 1][i + 1][0], qb[g & 1][i + 1][1], qb[g & 1][i + 1][2]};
                        const v32f_t f = __builtin_amdgcn_cvt_scalef32_pk32_f32_fp6(pk, 1.0f);
#pragma unroll
                        for (int k = 0; k < 16; ++k) { y[k] = fmaf(w0, f[k], y[k]); y[k] = fmaf(w1, f[16 + k], y[k]); }
                        asm volatile("" : "+v"(y[0]), "+v"(y[1]), "+v"(y[2]), "+v"(y[3]), "+v"(y[4]), "+v"(y[5]), "+v"(y[6]), "+v"(y[7]), "+v"(y[8]), "+v"(y[9]), "+v"(y[10]), "+v"(y[11]), "+v"(y[12]), "+v"(y[13]), "+v"(y[14]), "+v"(y[15]));
                    }
#else
#pragma unroll
                    for (int i = 0; i < PGS; ++i) {
                        const float w = __builtin_bit_cast(float, __builtin_amdgcn_readlane(__builtin_bit_cast(int, wvv), g * PGS + i));
                        asm volatile("" : "+v"(qb[g & 1][i][0]), "+v"(qb[g & 1][i][1]), "+v"(qb[g & 1][i][2]), "+v"(qb[g & 1][i][3]));
#pragma unroll
                        for (int k = 0; k < 4; ++k) { const f32x2v lo = __builtin_amdgcn_cvt_pk_f32_fp8((int)qb[g & 1][i][k], false), hi = __builtin_amdgcn_cvt_pk_f32_fp8((int)qb[g & 1][i][k], true);
                            y[k * 4] = fmaf(w, lo[0], y[k * 4]); y[k * 4 + 1] = fmaf(w, lo[1], y[k * 4 + 1]); y[k * 4 + 2] = fmaf(w, hi[0], y[k * 4 + 2]); y[k * 4 + 3] = fmaf(w, hi[1], y[k * 4 + 3]); }
                        asm volatile("" : "+v"(y[0]), "+v"(y[1]), "+v"(y[2]), "+v"(y[3]), "+v"(y[4]), "+v"(y[5]), "+v"(y[6]), "+v"(y[7]), "+v"(y[8]), "+v"(y[9]), "+v"(y[10]), "+v"(y[11]), "+v"(y[12]), "+v"(y[13]), "+v"(y[14]), "+v"(y[15]));
                    }
#endif
                }
            }
#endif

#if PEER_BITS == 4 && PEER_UMFMA
            asm volatile("" ::: "memory");
#pragma unroll
            for (int q = 0; q < 4; ++q) { const f32x4 r = *(const LAS f32x4*)(wl + 1024 + q * 1024 + lane * 16); xf[q * 4] = r[0]; xf[q * 4 + 1] = r[1]; xf[q * 4 + 2] = r[2]; xf[q * 4 + 3] = r[3]; }
#endif
            float s = 0.f;
#pragma unroll
            for (int i = 0; i < 16; ++i) { y[i] = ALPHA * xf[i] + y[i]; s += y[i]; }
#pragma unroll
            for (int o = 1; o < 64; o <<= 1) s += SHX_(s, o);
            const float mean = s * (1.f / D); float qq = 0.f;
#pragma unroll
            for (int i = 0; i < 16; ++i) { y[i] -= mean; qq += y[i] * y[i]; }
#pragma unroll
            for (int o = 1; o < 64; o <<= 1) qq += SHX_(qq, o);
            const float rstd = rsqrtf(qq * (1.f / D) + LN_EPS);
            u32x4 ob0, ob1;
#pragma unroll
            for (int q = 0; q < 4; ++q) { const int col = lane * 16 + q * 4; const f32x4 gg = *(const f32x4*)(g2 + col), bb = *(const f32x4*)(b2 + col);
                f32x4 o;
#pragma unroll
                for (int i = 0; i < 4; ++i) o[i] = y[q * 4 + i] * rstd * gg[i] + bb[i];
                if (outf) *(f32x4*)(outf + tok * D + col) = o;
                const unsigned w0 = pk2(o[0], o[1]), w1 = pk2(o[2], o[3]);
                if (q == 0) { ob0.x = w0; ob0.y = w1; } else if (q == 1) { ob0.z = w0; ob0.w = w1; } else if (q == 2) { ob1.x = w0; ob1.y = w1; } else { ob1.z = w0; ob1.w = w1; } }
            if (outb) { *(u32x4*)(outb + tok * D + lane * 16) = ob0; *(u32x4*)(outb + tok * D + lane * 16 + 8) = ob1; }

        }
    }

}

#undef SHX_
#if PEER_BITS == 4
template <int MODE>
__device__ __forceinline__ void phase_peer_mix4(const float* __restrict__ Zin, const float* __restrict__ g1, const float* __restrict__ b1, const unsigned short* __restrict__ teid, const float* __restrict__ tgate,
                                                const unsigned char* __restrict__ U, const unsigned char* __restrict__ V, const float* __restrict__ Us, const float* __restrict__ Vs, const float* __restrict__ g2, const float* __restrict__ b2,
                                                float* __restrict__ outf, bf16* __restrict__ outb, float* __restrict__ WV, LAS unsigned char* wl, int gw, int NGW, int lane_in) {
    typedef int v8i_t __attribute__((ext_vector_type(8)));
#define SHX_(v_, o_) __builtin_bit_cast(float, __builtin_amdgcn_ds_bpermute((lane ^ (o_)) << 2, __builtin_bit_cast(int, (float)(v_))))
#define MIX_TOK(j_) ((j_) < TP ? (size_t)(j_) : (size_t)TP + (((j_) - TP) >> 4))
    int j = gw;
    f32x4 zr[4]; int ti0, ti1; float tg0, tg1;
    { const size_t tok = MIX_TOK(j);
#pragma unroll
      for (int q = 0; q < 4; ++q) zr[q] = *(const f32x4*)(Zin + tok * D + lane_in * 16 + q * 4);
      ti0 = (int)teid[tok * 128 + lane_in]; ti1 = (int)teid[tok * 128 + 64 + lane_in];
      const float* gsrc = MODE == 2 ? WV : tgate; tg0 = gsrc[tok * 128 + lane_in]; tg1 = gsrc[tok * 128 + 64 + lane_in]; }
    while (j >= 0) {
        int lane = lane_in; asm volatile("" : "+v"(lane));
        const size_t tok = MIX_TOK(j);
        int jn = -1;
        for (int c = j + NGW; c < TP + TS * 16; c += NGW) { if (c < TP || ((c - TP) & 15) == 0) { jn = c; break; } }
        const int n16 = lane & 15, kq = lane >> 4;
        const int e0 = ti0, e1 = ti1; const float gt0 = tg0, gt1 = tg1;
        float wv0 = gt0, wv1 = gt1;
        unsigned idp[4]; u32x4 qb[3][4]; float us0 = 0.f, us1 = 0.f, vs0 = 0.f, vs1 = 0.f;
#define PU_HALF(u_) (((u_) >> 2) & 1)
#define PU_LOADU(u_) { const unsigned id_ = ((u_) >> 3) ? (idp[(u_) & 3] >> 16) : (idp[(u_) & 3] & 0xFFFFu); const unsigned char* rp_ = U + (size_t)id_ * PEER_RB + PU_HALF(u_) * 256 + kq * 16; _Pragma("unroll") for (int jj = 0; jj < 4; ++jj) qb[(u_) % 3][jj] = *(const u32x4*)(rp_ + jj * 64); }
        if constexpr (MODE != 2) {
#pragma unroll
        for (int t = 0; t < 4; ++t) idp[t] = (unsigned)__builtin_amdgcn_ds_bpermute((t * 16 + n16) << 2, e0) | ((unsigned)__builtin_amdgcn_ds_bpermute((t * 16 + n16) << 2, e1) << 16);
        PU_LOADU(0) PU_LOADU(1)
        us0 = Us[e0]; us1 = Us[e1]; vs0 = Vs[e0]; vs1 = Vs[e1];
        }
        float xf[16];
        { float s1 = 0.f;
#pragma unroll
          for (int q = 0; q < 4; ++q) { const f32x4 r = zr[q]; xf[q * 4] = r[0]; xf[q * 4 + 1] = r[1]; xf[q * 4 + 2] = r[2]; xf[q * 4 + 3] = r[3]; s1 += (r[0] + r[1]) + (r[2] + r[3]); }
#pragma unroll
          for (int o = 1; o < 64; o <<= 1) s1 += SHX_(s1, o);
          const float mean1 = s1 * (1.f / D); float q1 = 0.f;
#pragma unroll
          for (int i = 0; i < 16; ++i) { xf[i] -= mean1; q1 += xf[i] * xf[i]; }
#pragma unroll
          for (int o = 1; o < 64; o <<= 1) q1 += SHX_(q1, o);
          const float rstd1 = rsqrtf(q1 * (1.f / D) + LN_EPS);
#pragma unroll
          for (int q = 0; q < 4; ++q) { const f32x4 gg = *(const f32x4*)(g1 + lane * 16 + q * 4), bb = *(const f32x4*)(b1 + lane * 16 + q * 4);
#pragma unroll
              for (int i = 0; i < 4; ++i) xf[q * 4 + i] = xf[q * 4 + i] * rstd1 * gg[i] + bb[i]; } }
        if constexpr (MODE != 2) {
        float am = 0.f;
#pragma unroll
        for (int i = 0; i < 16; ++i) am = fmaxf(am, fabsf(xf[i]));
#pragma unroll
        for (int o = 1; o < 64; o <<= 1) am = fmaxf(am, SHX_(am, o));
        const float xinv = am > 0.f ? 6.f / am : 0.f, sx = am * (1.f / 6.f);
        { u32x2 whi, wlo; whi.x = 0u; whi.y = 0u; wlo.x = 0u; wlo.y = 0u;
#pragma unroll
          for (int i = 0; i < 16; ++i) {
              const float xs = xf[i] * xinv, a = fabsf(xs);
              const float gq = a < 2.f ? rintf(a * 2.f) * 0.5f : (a < 4.f ? rintf(a) : fminf(6.f, 2.f * rintf(a * 0.5f)));
              const unsigned chi = (unsigned)(gq < 2.f ? gq * 2.f : (gq < 4.f ? gq + 2.f : gq * 0.5f + 4.f)) | (xs < 0.f ? 8u : 0u);
              const float r = (xs - (xs < 0.f ? -gq : gq)) * 4.f;
              const unsigned clo = enc_e2m1(r);
              if (i < 8) { whi.x |= chi << (4 * i); wlo.x |= clo << (4 * i); } else { whi.y |= chi << (4 * (i - 8)); wlo.y |= clo << (4 * (i - 8)); }
          }
          *(LAS u32x2*)(wl + lane * 8) = whi; *(LAS u32x2*)(wl + 512 + lane * 8) = wlo; }
        if constexpr (MODE == 0) {
#pragma unroll
        for (int q = 0; q < 4; ++q) *(LAS f32x4*)(wl + 1024 + q * 1024 + lane * 16) = (f32x4){xf[q * 4], xf[q * 4 + 1], xf[q * 4 + 2], xf[q * 4 + 3]}; }
        float h0 = 0.f, h1 = 0.f;
#pragma unroll
        for (int g = 0; g < 2; ++g) {
            f32x4 acc[4];
#pragma unroll
            for (int t = 0; t < 4; ++t) acc[t] = (f32x4){0.f, 0.f, 0.f, 0.f};
#pragma unroll
            for (int ph = 0; ph < 2; ++ph) {
                u32x4 ahi[4], alo[4];
#pragma unroll
                for (int jj = 0; jj < 4; ++jj) { const int jk = ph * 4 + jj; ahi[jj] = *(const LAS u32x4*)(wl + jk * 64 + kq * 16); alo[jj] = *(const LAS u32x4*)(wl + 512 + jk * 64 + kq * 16); }
#pragma unroll
                for (int t = 0; t < 4; ++t) {
                    const int u = g * 8 + ph * 4 + t;
                    if (u + 2 < 16) PU_LOADU(u + 2)
                    asm volatile("" ::: "memory");
#pragma unroll
                    for (int jj = 0; jj < 4; ++jj) { const u32x4 b = qb[u % 3][jj]; const v8i_t bop = (v8i_t){(int)b.x, (int)b.y, (int)b.z, (int)b.w, 0, 0, 0, 0};
                        const v8i_t ah = (v8i_t){(int)ahi[jj].x, (int)ahi[jj].y, (int)ahi[jj].z, (int)ahi[jj].w, 0, 0, 0, 0}, al = (v8i_t){(int)alo[jj].x, (int)alo[jj].y, (int)alo[jj].z, (int)alo[jj].w, 0, 0, 0, 0};
                        acc[t] = __builtin_amdgcn_mfma_scale_f32_16x16x128_f8f6f4(ah, bop, acc[t], 4, 4, 0, 0x7f7f7f7f, 0, 0x7f7f7f7f);
                        acc[t] = __builtin_amdgcn_mfma_scale_f32_16x16x128_f8f6f4(al, bop, acc[t], 4, 4, 0, 0x7d7d7d7d, 0, 0x7f7f7f7f); }
                }
            }
#pragma unroll
            for (int t = 0; t < 4; ++t) { if (kq == t) { if (g == 0) h0 = acc[t][0]; else h1 = acc[t][0]; } }
        }
        const float hd0 = h0 * sx * us0, hd1 = h1 * sx * us1;
        wv0 = 0.5f * hd0 * (1.f + erff(hd0 * 0.70710678118654752f)) * gt0 * vs0;
        wv1 = 0.5f * hd1 * (1.f + erff(hd1 * 0.70710678118654752f)) * gt1 * vs1;
        if constexpr (MODE == 1) { WV[tok * 128 + lane] = wv0; WV[tok * 128 + 64 + lane] = wv1; }
        }
#undef PU_LOADU
#undef PU_HALF
        if (jn >= 0) { const size_t tn = MIX_TOK(jn);
#pragma unroll
            for (int q = 0; q < 4; ++q) zr[q] = *(const f32x4*)(Zin + tn * D + lane * 16 + q * 4);
            ti0 = (int)teid[tn * 128 + lane]; ti1 = (int)teid[tn * 128 + 64 + lane];
            const float* gsrc = MODE == 2 ? WV : tgate; tg0 = gsrc[tn * 128 + lane]; tg1 = gsrc[tn * 128 + 64 + lane]; }
        if constexpr (MODE != 1) {
        float y[16];
#pragma unroll
        for (int i = 0; i < 16; ++i) y[i] = 0.f;
        {
            u32x2 qa[8], qc[8];
#define PV_LOAD(buf_, g_) { const int src_ = (g_) < 8 ? e0 : e1; _Pragma("unroll") for (int i = 0; i < 8; ++i) { const int id_ = __builtin_amdgcn_readlane(src_, ((g_) & 7) * 8 + i); buf_[i] = *(const u32x2*)(V + (size_t)id_ * PEER_RB + lane * 8); } }
#define PV4(bf_, b) { const f32x2v f = __builtin_amdgcn_cvt_scalef32_pk_f32_fp4(bf_[i][k], 1.0f, b); f32x2v yy = {y[k * 8 + b * 2], y[k * 8 + b * 2 + 1]}; const f32x2v ww = {w, w}; yy = __builtin_elementwise_fma(ww, f, yy); y[k * 8 + b * 2] = yy[0]; y[k * 8 + b * 2 + 1] = yy[1]; }
#define PV_COMP(buf_, g_) { const float wsrc_ = (g_) < 8 ? wv0 : wv1; _Pragma("unroll") for (int i = 0; i < 8; ++i) { \
            const float w = __builtin_bit_cast(float, __builtin_amdgcn_readlane(__builtin_bit_cast(int, wsrc_), ((g_) & 7) * 8 + i)); \
            asm volatile("" : "+v"(buf_[i][0]), "+v"(buf_[i][1])); \
            _Pragma("unroll") for (int k = 0; k < 2; ++k) { PV4(buf_, 0) PV4(buf_, 1) PV4(buf_, 2) PV4(buf_, 3) } \
            asm volatile("" : "+v"(y[0]), "+v"(y[1]), "+v"(y[2]), "+v"(y[3]), "+v"(y[4]), "+v"(y[5]), "+v"(y[6]), "+v"(y[7]), "+v"(y[8]), "+v"(y[9]), "+v"(y[10]), "+v"(y[11]), "+v"(y[12]), "+v"(y[13]), "+v"(y[14]), "+v"(y[15])); } }
            PV_LOAD(qa, 0)
#pragma unroll 1
            for (int p2 = 0; p2 < 8; ++p2) {
                PV_LOAD(qc, 2 * p2 + 1)
                asm volatile("" ::: "memory");
                PV_COMP(qa, 2 * p2)
                if (p2 < 7) PV_LOAD(qa, 2 * p2 + 2)
                asm volatile("" ::: "memory");
                PV_COMP(qc, 2 * p2 + 1)
            }
#undef PV_LOAD
#undef PV4
#undef PV_COMP
        }
        asm volatile("" ::: "memory");
        if constexpr (MODE == 0)
#pragma unroll
        for (int q = 0; q < 4; ++q) { const f32x4 r = *(const LAS f32x4*)(wl + 1024 + q * 1024 + lane * 16); xf[q * 4] = r[0]; xf[q * 4 + 1] = r[1]; xf[q * 4 + 2] = r[2]; xf[q * 4 + 3] = r[3]; }
        float s = 0.f;
#pragma unroll
        for (int i = 0; i < 16; ++i) { y[i] = ALPHA * xf[i] + y[i]; s += y[i]; }
#pragma unroll
        for (int o = 1; o < 64; o <<= 1) s += SHX_(s, o);
        const float mean = s * (1.f / D); float qq = 0.f;
#pragma unroll
        for (int i = 0; i < 16; ++i) { y[i] -= mean; qq += y[i] * y[i]; }
#pragma unroll
        for (int o = 1; o < 64; o <<= 1) qq += SHX_(qq, o);
        const float rstd = rsqrtf(qq * (1.f / D) + LN_EPS);
        u32x4 ob0, ob1;
#pragma unroll
        for (int q = 0; q < 4; ++q) { const int col = lane * 16 + q * 4; const f32x4 gg = *(const f32x4*)(g2 + col), bb = *(const f32x4*)(b2 + col);
            f32x4 o;
#pragma unroll
            for (int i = 0; i < 4; ++i) o[i] = y[q * 4 + i] * rstd * gg[i] + bb[i];
            *(f32x4*)(outf + tok * D + col) = o;
            const unsigned w0 = pk2(o[0], o[1]), w1 = pk2(o[2], o[3]);
            if (q == 0) { ob0.x = w0; ob0.y = w1; } else if (q == 1) { ob0.z = w0; ob0.w = w1; } else if (q == 2) { ob1.x = w0; ob1.y = w1; } else { ob1.z = w0; ob1.w = w1; } }
        if (outb) { *(u32x4*)(outb + tok * D + lane * 16) = ob0; *(u32x4*)(outb + tok * D + lane * 16 + 8) = ob1; }
        }
        j = jn;
    }
#undef SHX_
#undef MIX_TOK
}
#endif

__device__ __forceinline__ float peer_reduce16(float (&p)[16], int lane) {
#pragma unroll
    for (int o = 8; o >= 1; o >>= 1) { const bool up = (lane & (o * 4)) != 0;
#pragma unroll
        for (int k = 0; k < o; ++k) { const float keep = up ? p[k + o] : p[k], send = up ? p[k] : p[k + o]; p[k] = keep + __shfl_xor(send, o * 4); } }
    float tot = p[0];
    tot += __shfl_xor(tot, 2); tot += __shfl_xor(tot, 1);
    return tot;
}
__device__ __forceinline__ unsigned cvtpk_bf16_(float lo, float hi) { typedef __bf16 bf2 __attribute__((ext_vector_type(2))); f32x2v v = {lo, hi}; bf2 b = __builtin_convertvector(v, bf2); return __builtin_bit_cast(unsigned, b); }
__device__ __forceinline__ float peer_dot16b(const u32x4 q, const u32x4 x0, const u32x4 x1) {
    float a = 0.f;
#pragma unroll
    for (int w = 0; w < 4; ++w) { const f32x2v lo = __builtin_amdgcn_cvt_pk_f32_fp8((int)q[w], false), hi = __builtin_amdgcn_cvt_pk_f32_fp8((int)q[w], true);
        const unsigned xa = w < 2 ? x0[2 * w] : x1[2 * w - 4], xb = w < 2 ? x0[2 * w + 1] : x1[2 * w - 3];
        a = dot2bf(cvtpk_bf16_(lo[0], lo[1]), xa, a); a = dot2bf(cvtpk_bf16_(hi[0], hi[1]), xb, a); }
    return a;
}

__device__ __forceinline__ void peer_u_slice(int sl, int t_first, int t_step, const bf16* __restrict__ Hb, const unsigned short* __restrict__ teid, const unsigned char* __restrict__ U,
                                             float* __restrict__ HD, LAS unsigned char* wl, int lane) {
    LAS unsigned short* lst_e = (LAS unsigned short*)wl;
    LAS unsigned char* lst_s = wl + 512;
    const unsigned long long below = (1ull << lane) - 1ull;
    const int kk = (lane >> 2) & 15;
    if (t_first >= TA) return;
#define PU_BUILD(bsel, e0_, e1_, cnt_) do { const bool a0_ = ((e0_) >> 11) == sl, a1_ = ((e1_) >> 11) == sl; const unsigned long long m0_ = __ballot(a0_), m1_ = __ballot(a1_); \
        const int c0_ = __builtin_popcountll(m0_); cnt_ = c0_ + __builtin_popcountll(m1_); \
        if (a0_) { const int p_ = __builtin_popcountll(m0_ & below); lst_e[(bsel) * 128 + p_] = (unsigned short)(e0_); lst_s[(bsel) * 128 + p_] = (unsigned char)lane; } \
        if (a1_) { const int p_ = c0_ + __builtin_popcountll(m1_ & below); lst_e[(bsel) * 128 + p_] = (unsigned short)(e1_); lst_s[(bsel) * 128 + p_] = (unsigned char)(64 + lane); } } while (0)
#define PU_LOAD(bsel, cnt_, q_) do { _Pragma("unroll") for (int k = 0; k < 16; ++k) { if (k < (cnt_)) { const int id_ = __builtin_amdgcn_readfirstlane((int)lst_e[(bsel) * 128 + k]); q_[k] = *(const u32x4*)(U + (size_t)id_ * D + lane * 16); } } } while (0)
    int e0 = __builtin_nontemporal_load(teid + (size_t)t_first * 128 + lane), e1 = __builtin_nontemporal_load(teid + (size_t)t_first * 128 + 64 + lane);
    u32x4 xa0 = __builtin_nontemporal_load((const u32x4*)(Hb + (size_t)t_first * D + lane * 16)), xa1 = __builtin_nontemporal_load((const u32x4*)(Hb + (size_t)t_first * D + lane * 16 + 8));
    int cnt; PU_BUILD(0, e0, e1, cnt);
    asm volatile("s_waitcnt lgkmcnt(0)" ::: "memory");
    u32x4 q[16];
    PU_LOAD(0, cnt, q);
    int buf = 0;

    for (int t = t_first; t < TA; t += t_step, buf ^= 1) {
        const int tn = t + t_step; const bool hasn = tn < TA;
        u32x4 xb0 = xa0, xb1 = xa1; int f0 = 0, f1 = 0;
        if (hasn) { f0 = __builtin_nontemporal_load(teid + (size_t)tn * 128 + lane); f1 = __builtin_nontemporal_load(teid + (size_t)tn * 128 + 64 + lane);
            xb0 = __builtin_nontemporal_load((const u32x4*)(Hb + (size_t)tn * D + lane * 16)); xb1 = __builtin_nontemporal_load((const u32x4*)(Hb + (size_t)tn * D + lane * 16 + 8)); }

        float pr[16];
#pragma unroll
        for (int k = 0; k < 16; ++k) pr[k] = k < cnt ? peer_dot16b(q[k], xa0, xa1) : 0.f;

#pragma unroll 1
        for (int p0 = 16; p0 < cnt; p0 += 16) {
            u32x4 q2[16];
#pragma unroll
            for (int k = 0; k < 16; ++k) { if (p0 + k < cnt) { const int id_ = __builtin_amdgcn_readfirstlane((int)lst_e[buf * 128 + p0 + k]); q2[k] = *(const u32x4*)(U + (size_t)id_ * D + lane * 16); } }
            float pr2[16];
#pragma unroll
            for (int k = 0; k < 16; ++k) pr2[k] = p0 + k < cnt ? peer_dot16b(q2[k], xa0, xa1) : 0.f;
            const float tot2 = peer_reduce16(pr2, lane);
            if (p0 + kk < cnt && (lane & 3) == 0) __builtin_nontemporal_store(tot2, HD + (size_t)t * 128 + lst_s[buf * 128 + p0 + kk]);
        }

        int cntn = 0;
        if (hasn) { PU_BUILD(buf ^ 1, f0, f1, cntn); }
        asm volatile("s_waitcnt lgkmcnt(0)" ::: "memory");
        if (hasn) PU_LOAD(buf ^ 1, cntn, q);

        const float tot = peer_reduce16(pr, lane);
        if (kk < cnt && (lane & 3) == 0) __builtin_nontemporal_store(tot, HD + (size_t)t * 128 + lst_s[buf * 128 + kk]);
        xa0 = xb0; xa1 = xb1; cnt = cntn;

    }

#undef PU_BUILD
#undef PU_LOAD
}

__device__ __forceinline__ void phase_peer_mixv(const float* __restrict__ Zin, const float* __restrict__ g1, const float* __restrict__ b1, const unsigned short* __restrict__ teid, const float* __restrict__ tgate, const float* __restrict__ HD,
                                                const unsigned char* __restrict__ V, const float* __restrict__ Us, const float* __restrict__ Vs, const float* __restrict__ g2, const float* __restrict__ b2,
                                                float* __restrict__ outf, bf16* __restrict__ outb, int gw, int NGW, int lane) {
    for (int j = gw; j < TP + TS * 16; j += NGW) {
        size_t tok;
        if (j < TP) tok = (size_t)j;
        else { const int s = j - TP; if ((s & 15) != 0) continue; tok = (size_t)TP + (s >> 4); }
        float xf[16];
        { float s1 = 0.f;
#pragma unroll
          for (int q = 0; q < 4; ++q) { const f32x4 r = *(const f32x4*)(Zin + tok * D + lane * 16 + q * 4); xf[q * 4] = r[0]; xf[q * 4 + 1] = r[1]; xf[q * 4 + 2] = r[2]; xf[q * 4 + 3] = r[3]; s1 += (r[0] + r[1]) + (r[2] + r[3]); }
#pragma unroll
          for (int o = 1; o < 64; o <<= 1) s1 += __shfl_xor(s1, o);
          const float mean1 = s1 * (1.f / D); float q1 = 0.f;
#pragma unroll
          for (int i = 0; i < 16; ++i) { xf[i] -= mean1; q1 += xf[i] * xf[i]; }
#pragma unroll
          for (int o = 1; o < 64; o <<= 1) q1 += __shfl_xor(q1, o);
          const float rstd1 = rsqrtf(q1 * (1.f / D) + LN_EPS);
#pragma unroll
          for (int q = 0; q < 4; ++q) { const f32x4 gg = *(const f32x4*)(g1 + lane * 16 + q * 4), bb = *(const f32x4*)(b1 + lane * 16 + q * 4);
#pragma unroll
              for (int i = 0; i < 4; ++i) xf[q * 4 + i] = xf[q * 4 + i] * rstd1 * gg[i] + bb[i]; } }
        float y[16];
#pragma unroll
        for (int i = 0; i < 16; ++i) y[i] = 0.f;
#pragma unroll 1
        for (int bt = 0; bt < 2; ++bt) {
            const int eidv = (int)teid[tok * 128 + bt * 64 + lane];
            const float hd = HD[tok * 128 + bt * 64 + lane] * Us[eidv];
            const float wvv = 0.5f * hd * (1.f + erff(hd * 0.70710678118654752f)) * tgate[tok * 128 + bt * 64 + lane] * Vs[eidv];
            u32x4 qb[2][PGS];
#pragma unroll
            for (int i = 0; i < PGS; ++i) { const int id = __builtin_amdgcn_readlane(eidv, i); qb[0][i] = PROW_LOAD(V, id); }
#pragma unroll
            for (int g = 0; g < 64 / PGS; ++g) {
                if (g < 64 / PGS - 1) {
#pragma unroll
                    for (int i = 0; i < PGS; ++i) { const int id = __builtin_amdgcn_readlane(eidv, (g + 1) * PGS + i); qb[(g + 1) & 1][i] = PROW_LOAD(V, id); }
                }
                asm volatile("" ::: "memory");
#pragma unroll
                for (int i = 0; i < PGS; ++i) {
                    const float w = __builtin_bit_cast(float, __builtin_amdgcn_readlane(__builtin_bit_cast(int, wvv), g * PGS + i));
                    asm volatile("" : "+v"(qb[g & 1][i][0]), "+v"(qb[g & 1][i][1]), "+v"(qb[g & 1][i][2]), "+v"(qb[g & 1][i][3]));
#pragma unroll
                    for (int k = 0; k < 4; ++k) { const f32x2v lo = __builtin_amdgcn_cvt_pk_f32_fp8((int)qb[g & 1][i][k], false), hi = __builtin_amdgcn_cvt_pk_f32_fp8((int)qb[g & 1][i][k], true);
                        y[k * 4] = fmaf(w, lo[0], y[k * 4]); y[k * 4 + 1] = fmaf(w, lo[1], y[k * 4 + 1]); y[k * 4 + 2] = fmaf(w, hi[0], y[k * 4 + 2]); y[k * 4 + 3] = fmaf(w, hi[1], y[k * 4 + 3]); }
                    asm volatile("" : "+v"(y[0]), "+v"(y[1]), "+v"(y[2]), "+v"(y[3]), "+v"(y[4]), "+v"(y[5]), "+v"(y[6]), "+v"(y[7]), "+v"(y[8]), "+v"(y[9]), "+v"(y[10]), "+v"(y[11]), "+v"(y[12]), "+v"(y[13]), "+v"(y[14]), "+v"(y[15]));
                }
            }
        }
        float s = 0.f;
#pragma unroll
        for (int i = 0; i < 16; ++i) { y[i] = ALPHA * xf[i] + y[i]; s += y[i]; }
#pragma unroll
        for (int o = 1; o < 64; o <<= 1) s += __shfl_xor(s, o);
        const float mean = s * (1.f / D); float qq = 0.f;
#pragma unroll
        for (int i = 0; i < 16; ++i) { y[i] -= mean; qq += y[i] * y[i]; }
#pragma unroll
        for (int o = 1; o < 64; o <<= 1) qq += __shfl_xor(qq, o);
        const float rstd = rsqrtf(qq * (1.f / D) + LN_EPS);
        u32x4 ob0, ob1;
#pragma unroll
        for (int q = 0; q < 4; ++q) { const int col = lane * 16 + q * 4; const f32x4 gg = *(const f32x4*)(g2 + col), bb = *(const f32x4*)(b2 + col);
            f32x4 o;
#pragma unroll
            for (int i = 0; i < 4; ++i) o[i] = y[q * 4 + i] * rstd * gg[i] + bb[i];
            *(f32x4*)(outf + tok * D + col) = o;
            const unsigned w0 = pk2(o[0], o[1]), w1 = pk2(o[2], o[3]);
            if (q == 0) { ob0.x = w0; ob0.y = w1; } else if (q == 1) { ob0.z = w0; ob0.w = w1; } else if (q == 2) { ob1.x = w0; ob1.y = w1; } else { ob1.z = w0; ob1.w = w1; } }
        if (outb) { *(u32x4*)(outb + tok * D + lane * 16) = ob0; *(u32x4*)(outb + tok * D + lane * 16 + 8) = ob1; }
    }
}
}

namespace mk {
struct FGlaIn {
    bf16 *Gq, *Gk, *Gv, *Gr; float* GD;
    __device__ __forceinline__ static float silu(float r) { return r / (1.f + __expf(-r)); }
    __device__ __forceinline__ void put8(int row, int col, f32x4 v0, f32x4 v1) const {
        if (col < GN_K) *(u32x4*)(Gq + (size_t)row * 512 + col) = pack8(v0, v1);
        else if (col < GN_V) *(u32x4*)(Gk + (size_t)row * 512 + (col - GN_K)) = pack8(v0, v1);
        else if (col < GN_R) *(u32x4*)(Gv + (size_t)row * 1024 + (col - GN_V)) = pack8(v0, v1);
        else { f32x4 a, b;
#pragma unroll
            for (int i = 0; i < 4; ++i) { a[i] = silu(v0[i]); b[i] = silu(v1[i]); }
            *(u32x4*)(Gr + (size_t)row * 1024 + (col - GN_R)) = pack8(a, b); }
    }
    __device__ __forceinline__ void put4(int row, int col, f32x4 v) const {
        u32x2 w; w.x = pk2(v[0], v[1]); w.y = pk2(v[2], v[3]);
        if (col < GN_K) *(u32x2*)(Gq + (size_t)row * 512 + col) = w;
        else if (col < GN_V) *(u32x2*)(Gk + (size_t)row * 512 + (col - GN_K)) = w;
        else if (col < GN_R) *(u32x2*)(Gv + (size_t)row * 1024 + (col - GN_V)) = w;
        else if (col < GN_GD) { u32x2 s; s.x = pk2(silu(v[0]), silu(v[1])); s.y = pk2(silu(v[2]), silu(v[3])); *(u32x2*)(Gr + (size_t)row * 1024 + (col - GN_R)) = s; }
        else if (col < GN_GD + 16) *(f32x4*)(GD + (size_t)row * 16 + (col - GN_GD)) = v;
    }
};

__device__ __forceinline__ float log_sigmoid_f(float x) { return fminf(x, 0.f) - log1pf(__expf(-fabsf(x))); }
__device__ __forceinline__ bf16x8 tr8(LAS unsigned char* a0, LAS unsigned char* a1) { const s16x4 v0 = lds_tr(a0), v1 = lds_tr(a1); bf16x8 r; r[0] = v0[0]; r[1] = v0[1]; r[2] = v0[2]; r[3] = v0[3]; r[4] = v1[0]; r[5] = v1[1]; r[6] = v1[2]; r[7] = v1[3]; return r; }

constexpr int KD_ST = 272, V_ST = 528;
constexpr int GL_LB = 0, GL_TOT = 32768, GL_KD = 36864, GL_V = GL_KD + 64 * KD_ST  , GL_END = GL_V + 64 * V_ST;
static_assert(GL_END <= RING_BYTES, "GLA chunk LDS");

__device__ __forceinline__ void gla_chunk_item(int item, const bf16* __restrict__ Gq, const bf16* __restrict__ Gk, const bf16* __restrict__ Gv, const float* __restrict__ GD,
                                               const float* __restrict__ Wgu, const float* __restrict__ bg, bf16* __restrict__ QT, bf16* __restrict__ KT, float* __restrict__ DEC, float* __restrict__ DS,
                                               LAS unsigned char* lds, int tid, int wave, int lane) {
    const int h = item & 3, bc = item >> 2;
    const size_t tok0 = (size_t)bc * 64;
    LAS float* LB = (LAS float*)(lds + GL_LB);
    LAS float* TOT = (LAS float*)(lds + GL_TOT);
    const int d = tid & 127, tq = tid >> 7;
    float wg[16];
#pragma unroll
    for (int r = 0; r < 16; ++r) wg[r] = Wgu[r * 512 + h * 128 + d];
    const float bgd = bg[h * 128 + d];
    float pre[16]; float run = 0.f;
#pragma unroll
    for (int i = 0; i < 16; ++i) {
        const float* gd = GD + (tok0 + tq * 16 + i) * 16;
        const f32x4 g0 = *(const f32x4*)gd, g1 = *(const f32x4*)(gd + 4), g2 = *(const f32x4*)(gd + 8), g3 = *(const f32x4*)(gd + 12);
        float x = 0.f;
#pragma unroll
        for (int r = 0; r < 4; ++r) { x = fmaf(g0[r], wg[r], x); }
#pragma unroll
        for (int r = 0; r < 4; ++r) { x = fmaf(g1[r], wg[4 + r], x); }
#pragma unroll
        for (int r = 0; r < 4; ++r) { x = fmaf(g2[r], wg[8 + r], x); }
#pragma unroll
        for (int r = 0; r < 4; ++r) { x = fmaf(g3[r], wg[12 + r], x); }
        run += log_sigmoid_f(x + bgd) * (1.f / 16.f); pre[i] = run;
    }
    TOT[tq * 128 + d] = run;
    __syncthreads();
    float off = 0.f;
#pragma unroll
    for (int q = 0; q < 3; ++q) if (q < tq) off += TOT[q * 128 + d];
    const float bC = (TOT[d] + TOT[128 + d]) + (TOT[256 + d] + TOT[384 + d]);
#pragma unroll
    for (int i = 0; i < 16; ++i) {
        const int t = tq * 16 + i; const float b = pre[i] + off; const size_t tok = tok0 + t;
        const float q = bf2f(Gq[tok * 512 + h * 128 + d]), k = bf2f(Gk[tok * 512 + h * 128 + d]);
        QT[tok * 512 + h * 128 + d] = (bf16)f2bf(q * 0.08838834764831845f * __expf(b));
        KT[tok * 512 + h * 128 + d] = (bf16)f2bf(k * __expf(-b));
        *(LAS bf16*)(lds + GL_KD + t * KD_ST + d * 2) = (bf16)f2bf(k * __expf(bC - b));
    }
    if (tq == 0) DEC[(size_t)item * 128 + d] = __expf(bC);
#pragma unroll
    for (int p = 0; p < 4; ++p) { const int e = tid + p * 512, s = e >> 5, ch = e & 31;
        *(LAS u32x4*)(lds + GL_V + s * V_ST + ch * 16) = *(const u32x4*)(Gv + (tok0 + s) * 1024 + h * 256 + ch * 8); }
    __syncthreads();
    const int fr = lane & 15, fq = lane >> 4, dt = wave;
    bf16x8 af[2];
#pragma unroll
    for (int ks = 0; ks < 2; ++ks) { LAS unsigned char* a0 = lds + GL_KD + (ks * 32 + fq * 8 + (fr >> 2)) * KD_ST + (dt * 16 + 4 * (fr & 3)) * 2; af[ks] = tr8(a0, a0 + 4 * KD_ST); }
    bf16* dsb = (bf16*)DS + (size_t)item * 256 * 128;
#pragma unroll 4
    for (int vt = 0; vt < 16; ++vt) {
        f32x4 acc = (f32x4){0.f, 0.f, 0.f, 0.f};
#pragma unroll
        for (int ks = 0; ks < 2; ++ks) { LAS unsigned char* b0 = lds + GL_V + (ks * 32 + fq * 8 + (fr >> 2)) * V_ST + (vt * 16 + 4 * (fr & 3)) * 2; const bf16x8 bf = tr8(b0, b0 + 4 * V_ST);
            acc = __builtin_amdgcn_mfma_f32_16x16x32_bf16(af[ks], bf, acc, 0, 0, 0); }
        { u32x2 w; w.x = pk2(acc[0], acc[1]); w.y = pk2(acc[2], acc[3]); *(u32x2*)(dsb + (size_t)(vt * 16 + fr) * 128 + dt * 16 + fq * 4) = w; }
    }
    __syncthreads();
}

__device__ __forceinline__ void gla_sample_item(int item, const bf16* __restrict__ Gq, const bf16* __restrict__ Gk, const bf16* __restrict__ Gv, const bf16* __restrict__ Gr, const float* __restrict__ GD,
                                                const float* __restrict__ Wgu, const float* __restrict__ bg, const float* __restrict__ ng, const float* __restrict__ S0, float* __restrict__ Sout, bf16* __restrict__ OGb,
                                                LAS unsigned char* lds, int tid, int lane) {
    const int b = item >> 2, h = item & 3;
    LAS float* A = (LAS float*)lds;
    LAS float* Qs = A + 512; LAS float* Ks = Qs + 512;
    LAS float* PO = Ks + 512;
    LAS float* RS = PO + 4096;
    { const int t = tid >> 7, d = tid & 127; const size_t tok = (size_t)TP + b * DS + t;
      float x = bg[h * 128 + d]; const float* gd = GD + tok * 16; float xs = 0.f;
#pragma unroll
      for (int r = 0; r < 16; ++r) xs = fmaf(gd[r], Wgu[r * 512 + h * 128 + d], xs);
      x += xs;
      A[t * 128 + d] = __expf(log_sigmoid_f(x) * (1.f / 16.f));
      Qs[t * 128 + d] = bf2f(Gq[tok * 512 + h * 128 + d]) * 0.08838834764831845f; Ks[t * 128 + d] = bf2f(Gk[tok * 512 + h * 128 + d]); }
    __syncthreads();
    const int dq = tid >> 7, d0 = dq * 32;
#pragma unroll 1
    for (int vhalf = 0; vhalf < 2; ++vhalf) {
        const int v = vhalf * 128 + (tid & 127);
        float S[32];
#pragma unroll
        for (int i = 0; i < 32; ++i) S[i] = S0[(((size_t)b * 4 + h) * 128 + d0 + i) * 256 + v];
#pragma unroll 1
        for (int t = 0; t < 4; ++t) {
            const float vv = bf2f(Gv[((size_t)TP + b * DS + t) * 1024 + h * 256 + v]); float o = 0.f;
#pragma unroll
            for (int i = 0; i < 32; ++i) { S[i] = fmaf(A[t * 128 + d0 + i], S[i], Ks[t * 128 + d0 + i] * vv); o = fmaf(Qs[t * 128 + d0 + i], S[i], o); }
            PO[(dq * 4 + t) * 256 + v] = o;
        }
#pragma unroll
        for (int i = 0; i < 32; ++i) Sout[(((size_t)b * 4 + h) * 128 + d0 + i) * 256 + v] = S[i];
    }
    __syncthreads();
    { const int t = tid >> 7, vl = tid & 127; const float o0 = (PO[t * 256 + vl] + PO[(4 + t) * 256 + vl]) + (PO[(8 + t) * 256 + vl] + PO[(12 + t) * 256 + vl]), o1 = (PO[t * 256 + 128 + vl] + PO[(4 + t) * 256 + 128 + vl]) + (PO[(8 + t) * 256 + 128 + vl] + PO[(12 + t) * 256 + 128 + vl]);
      float ss = o0 * o0 + o1 * o1;
#pragma unroll
      for (int o = 1; o < 64; o <<= 1) ss += __shfl_xor(ss, o);
      if (lane == 0) RS[tid >> 6] = ss;
      __syncthreads();
      const float ms = (RS[2 * t] + RS[2 * t + 1]) * (1.f / 256.f), rstd = rsqrtf(ms + LN_EPS);
      const size_t tok = (size_t)TP + b * DS + t;
      OGb[tok * 1024 + h * 256 + vl] = (bf16)f2bf(o0 * rstd * ng[vl] * bf2f(Gr[tok * 1024 + h * 256 + vl]));
      OGb[tok * 1024 + h * 256 + 128 + vl] = (bf16)f2bf(o1 * rstd * ng[128 + vl] * bf2f(Gr[tok * 1024 + h * 256 + 128 + vl])); }
    __syncthreads();
}

__device__ __forceinline__ void gla_scan(const float* __restrict__ DS, const float* __restrict__ DEC, bf16* __restrict__ SP, float* __restrict__ Sout, int gtid, int gthreads) {
    typedef float f32x2 __attribute__((ext_vector_type(2)));
    for (int e = gtid; e < NBATCH * 4 * 256 * 64; e += gthreads) {
        const int d2 = e & 63, v = (e >> 6) & 255, h = (e >> 14) & 3, b = e >> 16;
        f32x2 S = (f32x2){0.f, 0.f};
        for (int c = 0; c < SEQ / 64; ++c) {
            const size_t item = ((size_t)b * (SEQ / 64) + c) * 4 + h;
            const unsigned dw = *(const unsigned*)((const bf16*)DS + (item * 256 + v) * 128 + d2 * 2); const f32x2 ds = (f32x2){bflo(dw), bfhi(dw)}, dc = *(const f32x2*)(DEC + item * 128 + d2 * 2);
            *(unsigned*)(SP + (item * 256 + v) * 128 + d2 * 2) = pk2(S[0], S[1]);
            S = dc * S + ds;
        }
        float* so = Sout + (((size_t)b * 4 + h) * 128 + d2 * 2) * 256 + v; so[0] = S[0]; so[256] = S[1];
    }
}

__device__ __forceinline__ void gla_out_item(int item, const bf16* __restrict__ QT, const bf16* __restrict__ KT, const bf16* __restrict__ Gv, const bf16* __restrict__ Gr, const bf16* __restrict__ SP,
                                             const float* __restrict__ ng, bf16* __restrict__ OGb, LAS unsigned char* lds, int tid, int wave, int lane) {
    const int h = item & 3, bc = item >> 2; const size_t tok0 = (size_t)bc * 64;
    const int fr = lane & 15, fq = lane >> 4, tt = wave & 3, vh = wave >> 2;
    LAS float* RS = (LAS float*)(lds + 64 * V_ST);
#pragma unroll
    for (int p = 0; p < 4; ++p) { const int e = tid + p * 512, s = e >> 5, ch = e & 31;
        *(LAS u32x4*)(lds + s * V_ST + ch * 16) = *(const u32x4*)(Gv + (tok0 + s) * 1024 + h * 256 + ch * 8); }
    bf16x8 qf[4];
#pragma unroll
    for (int ks = 0; ks < 4; ++ks) qf[ks] = *(const bf16x8*)(QT + (tok0 + tt * 16 + fr) * 512 + h * 128 + ks * 32 + fq * 8);
    const bf16* spb = SP + (size_t)item * 256 * 128;
    bf16x8 sfr[2][4];
#pragma unroll
    for (int ks = 0; ks < 4; ++ks) sfr[0][ks] = *(const bf16x8*)(spb + (size_t)(vh * 8 * 16 + fr) * 128 + ks * 32 + fq * 8);
    bf16x8 pf[2];
    {
        f32x4 at[4];
#pragma unroll
        for (int st = 0; st < 4; ++st) {
            f32x4 acc = (f32x4){0.f, 0.f, 0.f, 0.f};
#pragma unroll
            for (int ks = 0; ks < 4; ++ks) { const bf16x8 kf = *(const bf16x8*)(KT + (tok0 + st * 16 + fr) * 512 + h * 128 + ks * 32 + fq * 8); acc = __builtin_amdgcn_mfma_f32_16x16x32_bf16(kf, qf[ks], acc, 0, 0, 0); }
#pragma unroll
            for (int j = 0; j < 4; ++j) { const int s = st * 16 + fq * 4 + j, t = tt * 16 + fr; if (s > t) acc[j] = 0.f; }
            at[st] = acc;
        }
        const u32x4 w0 = pack8(at[0], at[1]), w1 = pack8(at[2], at[3]);
        pf[0] = __builtin_bit_cast(bf16x8, w0); pf[1] = __builtin_bit_cast(bf16x8, w1);
    }
    __syncthreads();
    f32x4 oacc[8]; float ss = 0.f;
#pragma unroll
    for (int i = 0; i < 8; ++i) {
        const int vt = vh * 8 + i;
        if (i < 7) {
#pragma unroll
            for (int ks = 0; ks < 4; ++ks) sfr[(i + 1) & 1][ks] = *(const bf16x8*)(spb + (size_t)((vt + 1) * 16 + fr) * 128 + ks * 32 + fq * 8);
        }
        f32x4 acc = (f32x4){0.f, 0.f, 0.f, 0.f};
#pragma unroll
        for (int k2 = 0; k2 < 2; ++k2) {
            LAS unsigned char* a0 = lds + (k2 * 32 + fq * 4 + (fr >> 2)) * V_ST + (vt * 16 + 4 * (fr & 3)) * 2;
            const bf16x8 vf = tr8(a0, a0 + 16 * V_ST);
            acc = __builtin_amdgcn_mfma_f32_16x16x32_bf16(vf, pf[k2], acc, 0, 0, 0);
        }
#pragma unroll
        for (int ks = 0; ks < 4; ++ks) acc = __builtin_amdgcn_mfma_f32_16x16x32_bf16(sfr[i & 1][ks], qf[ks], acc, 0, 0, 0);
        oacc[i] = acc; ss += (acc[0] * acc[0] + acc[1] * acc[1]) + (acc[2] * acc[2] + acc[3] * acc[3]);
    }
    ss += __shfl_xor(ss, 16); ss += __shfl_xor(ss, 32);
    if (fq == 0) RS[wave * 16 + fr] = ss;
    __syncthreads();
    const float ms = (RS[tt * 16 + fr] + RS[(tt + 4) * 16 + fr]) * (1.f / 256.f), rstd = rsqrtf(ms + LN_EPS);
    const size_t tok = tok0 + tt * 16 + fr;
#pragma unroll
    for (int i = 0; i < 8; ++i) {
        const int v = (vh * 8 + i) * 16 + fq * 4;
        const u32x2 rw = *(const u32x2*)(Gr + tok * 1024 + h * 256 + v); const f32x4 g = *(const f32x4*)(ng + v);
        u32x2 w; w.x = pk2(oacc[i][0] * rstd * g[0] * bflo(rw.x), oacc[i][1] * rstd * g[1] * bfhi(rw.x)); w.y = pk2(oacc[i][2] * rstd * g[2] * bflo(rw.y), oacc[i][3] * rstd * g[3] * bfhi(rw.y));
        *(u32x2*)(OGb + tok * 1024 + h * 256 + v) = w;
    }
    __syncthreads();
}
}

namespace mk {
#ifndef MIX_V2
#define MIX_V1 1
#endif
#if defined(MIX_V1)
#define MIXSEL(Hf, te, tg, U, V, Us, Vs, g2, b2, of, ob, lds, wave, gw, NGW, lane) phase_peer_mix(Hf, te, tg, U, V, Us, Vs, g2, b2, of, ob, gw, NGW, lane)
#define MIX_FROM_Z 1
#else
#define MIXSEL(Hf, te, tg, U, V, Us, Vs, g2, b2, of, ob, lds, wave, gw, NGW, lane) phase_peer_mix2(Hf, H1b, te, tg, U, V, Us, Vs, g2, b2, of, ob, lds, wave, gw, NGW, lane)
#endif
#define PEER_USLICE(Hb_, U_, Us_) do { if (G % 8 == 0) { const int per_ = G / 8; peer_u_slice(vcu / per_, (vcu % per_) * NWAVES + wave, per_ * NWAVES, Hb_, TEID, U_, HDB, lds + wave * 16384, lane); } \
        else { for (int sl_ = 0; sl_ < 8; ++sl_) peer_u_slice(sl_, gw, NGW, Hb_, TEID, U_, HDB, lds + wave * 16384, lane); } } while (0)
struct Args {
    const float* in[23]; const int* page_table; float* out; unsigned char* ws; int ph_lo, ph_hi;
};
enum Phase { P_PRO = 0, P_AIN = 1, P_SCORE = 2, P_TOPK = 3, P_ATTN = 4, P_AOUT = 5, P_LN1 = 6, P_PQ0 = 7, P_PEER0 = 8, P_GIN = 9, P_GCH = 10, P_GSC = 11, P_GOUT = 12, P_GPRJ = 13, P_LN1B = 14, P_PQ1 = 15, P_PEER1 = 16, P_COUNT = 17 };

#define Wa ((bf16*)(ws + WS_WA))
#define Wo ((bf16*)(ws + WS_WO))
#define Wg ((bf16*)(ws + WS_WG))
#define Wgo ((bf16*)(ws + WS_WGO))
#define Wpq ((bf16*)(ws + WS_WPQ))
#define PK ((bf16*)(ws + WS_PK))
#define Usc ((float*)(ws + WS_USC))
#define Xb ((bf16*)(ws + WS_XB))
#define Qb ((bf16*)(ws + WS_QB))
#define QIb ((bf16*)(ws + WS_QIB))
#define Kb ((bf16*)(ws + WS_KB))
#define Vb ((bf16*)(ws + WS_VB))
#define KIb ((bf16*)(ws + WS_KIB))
#define WIf ((float*)(ws + WS_WIF))
#define SC ((float*)(ws + WS_SC))
#define SCS ((float*)(ws + WS_SCS))
#define IDX ((int*)(ws + WS_IDX))
#define CNT ((int*)(ws + WS_CNT))
#define Ob ((bf16*)(ws + WS_OB))
#define Z ((bf16*)(ws + WS_Z))
#define H1f ((float*)(ws + WS_H1F))
#define H1b ((bf16*)(ws + WS_H1B))
#define PQb ((bf16*)(ws + WS_PQB))
#define H2f ((float*)(ws + WS_H2F))
#define H2b ((bf16*)(ws + WS_H2B))
#define TEID ((unsigned short*)(ws + WS_TEID))
#define TGATE ((float*)(ws + WS_TGATE))
#define Gq ((bf16*)(ws + WS_GQ))
#define Gk ((bf16*)(ws + WS_GK))
#define Gv ((bf16*)(ws + WS_GV))
#define Gr ((bf16*)(ws + WS_GR))
#define GD ((float*)(ws + WS_GD))
#define QT ((bf16*)(ws + WS_QT))
#define KT ((bf16*)(ws + WS_KT))
#define DEC ((float*)(ws + WS_DEC))
#define DSb ((float*)(ws + WS_DS))
#define SPV ((bf16*)(ws + WS_SPREV))
#define OGb ((bf16*)(ws + WS_OGB))
#define HDB ((float*)(ws + WS_HD))
#define KV8 ((unsigned char*)(ws + WS_KV8))
#define Uq (ws + WS_UB)
#define Vq (ws + WS_VBX)
#define Usc ((float*)(ws + WS_USC))
#define Vsc ((float*)(ws + WS_USC) + 2 * 16384)
#define x_prompt (INP(0))
#define x_sample (INP(1))
#define attn_w_in (INP(7))
#define attn_w_out (INP(8))
#define gla_w_in (INP(9))
#define gla_w_out (INP(13))
#define peer_w_q (INP(14))
#define peer_keys1 (INP(15))
#define peer_keys2 (INP(16))
#define peer_u (INP(17))
#define peer_v (INP(18))
__device__ __forceinline__ unsigned char* launder_ptr(unsigned char* p) { asm volatile("" : "+s"(p)); return p; }
#if defined(LOWSGPR)
#define ws (launder_ptr(args.ws))
#define INP(k) ((const float*)inp_ptr(lds, (k)))
#else
#define ws (args.ws)
#define INP(k) (args.in[k])
#endif
__device__ __forceinline__ const void* inp_ptr(LAS unsigned char* lds, int k) {
    const unsigned long long v = *(LAS unsigned long long*)(lds + INPTAB_OFF + 8 * k);
    const unsigned lo = __builtin_amdgcn_readfirstlane((unsigned)v), hi = __builtin_amdgcn_readfirstlane((unsigned)(v >> 32));
    return (const void*)(((unsigned long long)hi << 32) | lo);
}
__global__ void __launch_bounds__(NTHREADS, 2) mk_fwd(Args args) {
    extern __shared__ __attribute__((aligned(16))) unsigned char lds_raw[];
    LAS unsigned char* lds = (LAS unsigned char*)lds_raw;
    volatile LAS unsigned* MISC = (volatile LAS unsigned*)(lds + MISC_OFF);
    const int tid = threadIdx.x, lane = tid & 63, wave = __builtin_amdgcn_readfirstlane(tid >> 6);
    const int G = gridDim.x, bx = blockIdx.x;
    const int vcu = (G % 8 == 0) ? (bx % 8) * (G / 8) + bx / 8 : bx;
    const int gw = vcu * NWAVES + wave, NGW = G * NWAVES;
    gu32* ctl = (gu32*)(ws + WS_CTL);
    for (int u = tid; u < (LDS_BYTES - LDSCTL_OFF) / 4; u += NTHREADS) ((LAS unsigned*)(lds + LDSCTL_OFF))[u] = 0u;
    __syncthreads();
    if (tid == 0) {
#define PUTIN(k) *(LAS unsigned long long*)(lds + INPTAB_OFF + 8 * (k)) = (unsigned long long)args.in[k]
        PUTIN(0); PUTIN(1); PUTIN(2); PUTIN(3); PUTIN(4); PUTIN(5); PUTIN(6); PUTIN(7); PUTIN(8); PUTIN(9); PUTIN(10); PUTIN(11); PUTIN(12); PUTIN(13); PUTIN(14); PUTIN(15);
        PUTIN(16); PUTIN(17); PUTIN(18); PUTIN(19); PUTIN(20); PUTIN(21); PUTIN(22);
#undef PUTIN
    }
    __syncthreads();
    XcdBarrier bar = xcd_barrier_post((unsigned*)(ctl + CW_BAR), MISC + 8);
    if (tid == 0) { const unsigned xme = xb_xcc_id(); MISC[13] = xme; MISC[12] = __hip_atomic_fetch_add((unsigned*)(ctl + CW_XC + 64 * xme), 1u, __ATOMIC_RELAXED, __HIP_MEMORY_SCOPE_AGENT); }
    const int lo = args.ph_lo, hi = args.ph_hi;
#define IN(k) (lo <= (k) && (k) < hi)
#define SEAM(k) do { if (IN(k) && IN((k) + 1)) xcd_barrier(bar); } while (0)
#ifndef REPEAT_PHASE
#define REPEAT_PHASE -1
#endif
#ifndef REPEAT_N
#define REPEAT_N 2
#endif
#define REP(k) for (int rep_ = 0; rep_ < (REPEAT_PHASE == (k) ? REPEAT_N : 1); ++rep_)


    if (IN(P_PRO)) {
        LAS float* scr = (LAS float*)(lds + wave * 16384);
        constexpr int KB16 = D / 64;
        constexpr int I_WA = (WA_ROWS / 32) * KB16, I_WO = (D / 32) * KB16, I_WG = (WG_ROWS / 32) * KB16, I_WGO = (D / 32) * KB16, I_WPQ = 2 * (PEER_N / 32) * KB16;
        constexpr int NITEMS = I_WA + I_WO + I_WG + I_WGO + I_WPQ;
        for (int it = gw; it < NITEMS; it += NGW) {
            int r = it;
            if (r < I_WA) { const int nb = r / KB16, kb = r % KB16, d0 = nb * 32; const int nv = ATT_N - d0 < 0 ? 0 : (ATT_N - d0 > 32 ? 32 : ATT_N - d0);
                p0_transpose_item(attn_w_in, ATT_N, D, Wa, d0, d0, nv, kb * 64, scr, lane); continue; } r -= I_WA;
            if (r < I_WO) { const int nb = r / KB16, kb = r % KB16; p0_transpose_item(attn_w_out, D, D, Wo, nb * 32, nb * 32, 32, kb * 64, scr, lane); continue; } r -= I_WO;
            if (r < I_WG) { const int nb = r / KB16, kb = r % KB16, d0 = nb * 32; int s0, nv;
                if (d0 < GN_R) { s0 = d0; nv = 32; } else if (d0 < GN_GD) { s0 = GR + (d0 - GN_R); nv = 32; } else if (d0 == GN_GD) { s0 = GGD; nv = 16; } else { s0 = 0; nv = 0; }
                p0_transpose_item(gla_w_in, GLA_N, D, Wg, d0, s0, nv, kb * 64, scr, lane); continue; } r -= I_WG;
            if (r < I_WGO) { const int nb = r / KB16, kb = r % KB16; p0_transpose_item(gla_w_out, D, D, Wgo, nb * 32, nb * 32, 32, kb * 64, scr, lane); continue; } r -= I_WGO;
            { const int l = r / ((PEER_N / 32) * KB16), rr = r % ((PEER_N / 32) * KB16), nb = rr / KB16, kb = rr % KB16;
              p0_transpose_item(peer_w_q + (size_t)l * D * PEER_N, PEER_N, D, Wpq + (size_t)l * PEER_N * D, nb * 32, nb * 32, 32, kb * 64, scr, lane); }
        }
        p0_convert(x_prompt, Xb, (size_t)TP * D / 8, gw, NGW, lane);
        p0_convert(x_sample, Xb + (size_t)TP * D, (size_t)TS * D / 8, gw, NGW, lane);
        p0_convert(peer_keys1, PK, (size_t)2 * 128 * 128 / 8, gw, NGW, lane);
        p0_convert(peer_keys2, PK + 2 * 128 * 128, (size_t)2 * 128 * 128 / 8, gw, NGW, lane);
    }
    SEAM(P_PRO);

    if (IN(P_AIN)) {
        FAttnIn F{Qb, Kb, Vb, QIb, KIb, WIf, args.out};
        { pg8::Gemm g{Xb, Wa, TP, 2048, D}; pg8::StaticOrder S; S.init(TP, 2048, G, bx);
          pg8::EpiRow8<FAttnIn> E{F};
          pg8::gemm_phase<pg8::EpiRow8<FAttnIn>, pg8::StaticOrder, true, true>(lds, g, S, E);
          float km = E.f.kmax, vm = E.f.vmax;
#pragma unroll
          for (int o = 1; o < 64; o <<= 1) { km = fmaxf(km, __shfl_xor(km, o)); vm = fmaxf(vm, __shfl_xor(vm, o)); }
          if (lane == 0) { if (km > 0.f) atomicMax((unsigned*)(ctl + CW_AMAXK), __builtin_bit_cast(unsigned, km)); if (vm > 0.f) atomicMax((unsigned*)(ctl + CW_AMAXV), __builtin_bit_cast(unsigned, vm)); } }
        for (int it = gw; it < TP / 16 + 8 * 34; it += NGW) {
            if (it < TP / 16) {
                f32x4 acc[5]; skinny_tile<5>(Xb, D, Wa, D, it * 16, 2048, acc, lane);
#pragma unroll
                for (int ct = 0; ct < 5; ++ct) F.put4(it * 16 + (lane & 15), 2048 + ct * 16 + 4 * (lane >> 4), acc[ct]);
            } else {
                const int r = it - TP / 16, rt = r % 8, cg = r / 8;
                f32x4 acc[4]; skinny_tile<4>(Xb, D, Wa, D, TP + rt * 16, cg * 64, acc, lane);
#pragma unroll
                for (int ct = 0; ct < 4; ++ct) F.put4(TP + rt * 16 + (lane & 15), cg * 64 + ct * 16 + 4 * (lane >> 4), acc[ct]);
            }
        }
    }
    SEAM(P_AIN);

            if (IN(P_SCORE)) { kv8_convert(Kb, Vb, KV8, (const unsigned*)(ctl + CW_AMAXK), (const unsigned*)(ctl + CW_AMAXV), gw, NGW, lane);
        phase_score(QIb, KIb, WIf, INP(4), args.page_table, SC, SCS, QuantTabs{peer_u, peer_v, Uq, Vq, Usc, Vsc}, lds, vcu, G, wave, lane, gw, NGW); }
    SEAM(P_SCORE);
    if (IN(P_TOPK)) {
        const int jlo_ = 0, jhi_ = TA;
        phase_topk2(SC, SCS, IDX, CNT, peer_u, peer_v, Uq, Vq, Usc, Vsc, lds, (unsigned*)(ctl + CW_Q1), wave, lane, gw, NGW, jlo_, jhi_); }
    SEAM(P_TOPK);
    if (IN(P_ATTN)) {
        LAS unsigned char* wl = lds + wave * 16384;
        {
            if (tid == 0) { unsigned np = 0, mi = 0, mycnt = 1; const unsigned xme = MISC[13];
                for (unsigned j = 0; j < 16; ++j) { const unsigned c = __hip_atomic_load((unsigned*)(ctl + CW_XC + 64 * j), __ATOMIC_RELAXED, __HIP_MEMORY_SCOPE_AGENT); if (c > 0u) { if (j < xme) ++mi; ++np; } if (j == xme) mycnt = c > 0u ? c : 1u; }
                MISC[14] = np > 0u ? np : 1u; MISC[15] = mi; MISC[16] = mycnt; }
            __syncthreads();
            const int np = (int)MISC[14], mi = (int)MISC[15], mycnt = (int)MISC[16], rank = (int)MISC[12];
            for (int u = 0; u < NBATCH * 4; ++u) if (u % np == mi) attn_prompt_stream(u >> 2, u & 3, rank * NWAVES + wave, mycnt * NWAVES, Qb, IDX, KV8, (const unsigned*)(ctl + CW_AMAXK), (const unsigned*)(ctl + CW_AMAXV), Ob, wl, lane);
        }
        {
            const float* ck_ = INP(2); const float* cv_ = INP(3); float* o_ = args.out; const int* pt_ = args.page_table; int gws_ = gw; int lane_s = lane;
            asm volatile("" : "+s"(ck_), "+s"(cv_), "+s"(o_), "+s"(pt_), "+s"(gws_), "+v"(lane_s));
            for (int su = gws_; su < TS * 4 * 4; su += NGW) {
                if ((su & 3) == 0) { const int un = su >> 2, r = un >> 2, n = un & 3; attn_row<true>(TP + r, n, n + 1, Qb, IDX, CNT, nullptr, nullptr, ck_, cv_, o_ + OUT_KS, o_ + OUT_VS, pt_, Ob, wl, lane_s); }
            }
        }
    }
    SEAM(P_ATTN);
    if (IN(P_AOUT)) {
        FResid F{x_prompt, x_sample, Z};
        { pg8::Gemm g{Ob, Wo, TP, D, D}; pg8::StaticOrder S; S.init(TP, D, G, bx);
          pg8::EpiRow8<FResid> E{F};
          pg8::gemm_phase<pg8::EpiRow8<FResid>, pg8::StaticOrder, true, true>(lds, g, S, E); }
        for (int it = gw; it < 8 * 16; it += NGW) {
            const int rt = it % 8, cg = it / 8;
            f32x4 acc[4]; skinny_tile<4>(Ob, D, Wo, D, TP + rt * 16, cg * 64, acc, lane);
#pragma unroll
            for (int ct = 0; ct < 4; ++ct) F.put4(TP + rt * 16 + (lane & 15), cg * 64 + ct * 16 + 4 * (lane >> 4), acc[ct]);
        }
    }
    SEAM(P_AOUT);
    if (IN(P_LN1)) { for (int r = gw; r < TA; r += NGW) ln_row_wave(Z + (size_t)r * D, INP(19), INP(20), (float*)nullptr, H1b + (size_t)r * D, lane); }
    SEAM(P_LN1);

        if (IN(P_PQ0)) {
        FStoreBf16 F{PQb, PEER_N};
        { pg8::Gemm g{H1b, Wpq, TP, PEER_N, D}; pg8::StaticOrder S; S.init(TP, PEER_N, G, bx);
          pg8::EpiRow8<FStoreBf16> E{F};
          pg8::gemm_phase<pg8::EpiRow8<FStoreBf16>, pg8::StaticOrder, true, true>(lds, g, S, E); }
        for (int it = gw; it < 8 * 32; it += NGW) {
            const int rt = it % 8, cg = it / 8;
            f32x4 acc[4]; skinny_tile<4>(H1b, D, Wpq, D, TP + rt * 16, cg * 64, acc, lane);
#pragma unroll
            for (int ct = 0; ct < 4; ++ct) F.put4(TP + rt * 16 + (lane & 15), cg * 64 + ct * 16 + 4 * (lane >> 4), acc[ct]);
        }
#if 0
        for (int it = gw; it < 8 * 16; it += NGW) {
            const int rt = it % 8, cg = it / 8;
            f32x4 acc[8]; skinny_tile<8>(H1b, D, Wpq, D, TP + rt * 16, cg * 128, acc, lane);
#pragma unroll
            for (int ct = 0; ct < 8; ++ct) F.put4(TP + rt * 16 + (lane & 15), cg * 128 + ct * 16 + 4 * (lane >> 4), acc[ct]);
        }
#endif
    }
    SEAM(P_PQ0);
        if (IN(P_PEER0)) {
        phase_peer_select(PQb, PK, PK + 2 * 16384, TEID, TGATE, lds, vcu, G, wave, lane);
        xcd_barrier(bar);
#if defined(U_SLICED)
        PEER_USLICE(H1b, Uq, Usc);
        xcd_barrier(bar);
        phase_peer_mixv(Z, INP(19), INP(20), TEID, TGATE, HDB, Vq, Usc, Vsc, INP(21), INP(22), H2f, H2b, gw, NGW, lane);
#else
#if defined(MIX_FROM_Z)
#if PEER_BITS == 4 && PEER_UMFMA == 3
        phase_peer_mix4<1>(Z, INP(19), INP(20), TEID, TGATE, Uq, Vq, Usc, Vsc, INP(21), INP(22), H2f, H2b, (float*)(ws + WS_HD), lds + wave * 5120, gw, NGW, lane);
        xcd_barrier(bar);
        phase_peer_mix4<2>(Z, INP(19), INP(20), TEID, TGATE, Uq, Vq, Usc, Vsc, INP(21), INP(22), H2f, H2b, (float*)(ws + WS_HD), lds + wave * 5120, gw, NGW, lane);
#elif PEER_BITS == 4 && PEER_UMFMA == 2
        phase_peer_mix4<0>(Z, INP(19), INP(20), TEID, TGATE, Uq, Vq, Usc, Vsc, INP(21), INP(22), H2f, H2b, nullptr, lds + wave * 5120, gw, NGW, lane);
#else
#if PEER_UVI
        phase_peer_mix(Z, INP(19), INP(20), TEID, TGATE, Uq, Uq + PEER_RB, Usc, Vsc, INP(21), INP(22), (float*)nullptr, H2b, lds + wave * 5120, gw, NGW, lane);
#else
        phase_peer_mix(Z, INP(19), INP(20), TEID, TGATE, Uq, Vq, Usc, Vsc, INP(21), INP(22), (float*)nullptr, H2b, lds + wave * 5120, gw, NGW, lane);
#endif
#endif
#else
        MIXSEL(H1f, TEID, TGATE, Uq, Vq, Usc, Vsc, INP(21), INP(22), H2f, H2b, lds, wave, gw, NGW, lane);
#endif
#endif
    }
    SEAM(P_PEER0);

            if (IN(P_GIN)) {
        FGlaIn F{Gq, Gk, Gv, Gr, GD};
        { pg8::Gemm g{H2b, Wg, TP, 3072, D}; pg8::StaticOrder S; S.init(TP, 3072, G, bx);
          pg8::EpiRow8<FGlaIn> E{F};
          pg8::gemm_phase<pg8::EpiRow8<FGlaIn>, pg8::StaticOrder, true, true>(lds, g, S, E); }
        for (int it = gw; it < TP / 16 + 8 * 97; it += NGW) {
            if (it < TP / 16) {
                f32x4 acc[1]; skinny_tile<1>(H2b, D, Wg, D, it * 16, GN_GD, acc, lane);
                F.put4(it * 16 + (lane & 15), GN_GD + 4 * (lane >> 4), acc[0]);
            } else {
                const int r = it - TP / 16, rt = r % 8, cg = r / 8;
                f32x4 acc[2]; skinny_tile<2>(H2b, D, Wg, D, TP + rt * 16, cg * 32, acc, lane);
#pragma unroll
                for (int ct = 0; ct < 2; ++ct) F.put4(TP + rt * 16 + (lane & 15), cg * 32 + ct * 16 + 4 * (lane >> 4), acc[ct]);
            }
        }
    }
    SEAM(P_GIN);
    if (IN(P_GCH)) {
        for (int it = vcu; it < NBATCH * (SEQ / 64) * 4; it += G) gla_chunk_item(it, Gq, Gk, Gv, GD, INP(10), INP(11), QT, KT, DEC, DSb, lds, tid, wave, lane);
        for (int it = vcu; it < DB * 4; it += G) gla_sample_item(it, Gq, Gk, Gv, Gr, GD, INP(10), INP(11), INP(12), INP(5), args.out + OUT_SS, OGb, lds, tid, lane);
    }
    SEAM(P_GCH);
    if (IN(P_GSC)) gla_scan(DSb, DEC, SPV, args.out + OUT_SP, vcu * NTHREADS + tid, G * NTHREADS);
    SEAM(P_GSC);
    if (IN(P_GOUT)) { for (int it = vcu; it < NBATCH * (SEQ / 64) * 4; it += G) gla_out_item(it, QT, KT, Gv, Gr, SPV, INP(12), OGb, lds, tid, wave, lane); }
    SEAM(P_GOUT);
    if (IN(P_GPRJ)) {
        FResidB F{H2b, H2b + (size_t)TP * D, Z};
        { pg8::Gemm g{OGb, Wgo, TP, D, D}; pg8::StaticOrder S; S.init(TP, D, G, bx);
          pg8::EpiRow8<FResidB> E{F};
          pg8::gemm_phase<pg8::EpiRow8<FResidB>, pg8::StaticOrder, true, true>(lds, g, S, E); }
        for (int it = gw; it < 8 * 16; it += NGW) {
            const int rt = it % 8, cg = it / 8;
            f32x4 acc[4]; skinny_tile<4>(OGb, D, Wgo, D, TP + rt * 16, cg * 64, acc, lane);
#pragma unroll
            for (int ct = 0; ct < 4; ++ct) F.put4(TP + rt * 16 + (lane & 15), cg * 64 + ct * 16 + 4 * (lane >> 4), acc[ct]);
        }
    }
    SEAM(P_GPRJ);
    if (IN(P_LN1B)) { for (int r = gw; r < TA; r += NGW) ln_row_wave(Z + (size_t)r * D, INP(19) + D, INP(20) + D, (float*)nullptr, H1b + (size_t)r * D, lane); }
    SEAM(P_LN1B);
    if (IN(P_PQ1)) {
        FStoreBf16 F{PQb, PEER_N}; const bf16* W1 = Wpq + (size_t)PEER_N * D;
        { pg8::Gemm g{H1b, W1, TP, PEER_N, D}; pg8::StaticOrder S; S.init(TP, PEER_N, G, bx);
          pg8::EpiRow8<FStoreBf16> E{F};
          pg8::gemm_phase<pg8::EpiRow8<FStoreBf16>, pg8::StaticOrder, true, true>(lds, g, S, E); }
        for (int it = gw; it < 8 * 32; it += NGW) {
            const int rt = it % 8, cg = it / 8;
            f32x4 acc[4]; skinny_tile<4>(H1b, D, W1, D, TP + rt * 16, cg * 64, acc, lane);
#pragma unroll
            for (int ct = 0; ct < 4; ++ct) F.put4(TP + rt * 16 + (lane & 15), cg * 64 + ct * 16 + 4 * (lane >> 4), acc[ct]);
        }
    }
    SEAM(P_PQ1);
    if (IN(P_PEER1)) {
        phase_peer_select(PQb, PK + 16384, PK + 3 * 16384, TEID, TGATE, lds, vcu, G, wave, lane);
        xcd_barrier(bar);
#if defined(U_SLICED)
        PEER_USLICE(H1b, Uq + (size_t)16384 * PEER_RB, Usc + 16384);
        xcd_barrier(bar);
        phase_peer_mixv(Z, INP(19) + D, INP(20) + D, TEID, TGATE, HDB, Vq + (size_t)16384 * PEER_RB, Usc + 16384, Vsc + 16384, INP(21) + D, INP(22) + D, args.out + OUT_Y, nullptr, gw, NGW, lane);
#else
#if defined(MIX_FROM_Z)
#if PEER_BITS == 4 && PEER_UMFMA == 3
        phase_peer_mix4<1>(Z, INP(19) + D, INP(20) + D, TEID, TGATE, Uq + (size_t)16384 * PEER_RB, Vq + (size_t)16384 * PEER_RB, Usc + 16384, Vsc + 16384, INP(21) + D, INP(22) + D, args.out + OUT_Y, nullptr, (float*)(ws + WS_HD), lds + wave * 5120, gw, NGW, lane);
        xcd_barrier(bar);
        phase_peer_mix4<2>(Z, INP(19) + D, INP(20) + D, TEID, TGATE, Uq + (size_t)16384 * PEER_RB, Vq + (size_t)16384 * PEER_RB, Usc + 16384, Vsc + 16384, INP(21) + D, INP(22) + D, args.out + OUT_Y, nullptr, (float*)(ws + WS_HD), lds + wave * 5120, gw, NGW, lane);
#elif PEER_BITS == 4 && PEER_UMFMA == 2
        phase_peer_mix4<0>(Z, INP(19) + D, INP(20) + D, TEID, TGATE, Uq + (size_t)16384 * PEER_RB, Vq + (size_t)16384 * PEER_RB, Usc + 16384, Vsc + 16384, INP(21) + D, INP(22) + D, args.out + OUT_Y, nullptr, nullptr, lds + wave * 5120, gw, NGW, lane);
#else
#if PEER_UVI
        phase_peer_mix(Z, INP(19) + D, INP(20) + D, TEID, TGATE, Uq + (size_t)16384 * PEER_RS, Uq + (size_t)16384 * PEER_RS + PEER_RB, Usc + 16384, Vsc + 16384, INP(21) + D, INP(22) + D, args.out + OUT_Y, nullptr, lds + wave * 5120, gw, NGW, lane);
#else
        phase_peer_mix(Z, INP(19) + D, INP(20) + D, TEID, TGATE, Uq + (size_t)16384 * PEER_RB, Vq + (size_t)16384 * PEER_RB, Usc + 16384, Vsc + 16384, INP(21) + D, INP(22) + D, args.out + OUT_Y, nullptr, lds + wave * 5120, gw, NGW, lane);
#endif
#endif
#else
        MIXSEL(H1f, TEID, TGATE, Uq + (size_t)16384 * PEER_RB, Vq + (size_t)16384 * PEER_RB, Usc + 16384, Vsc + 16384, INP(21) + D, INP(22) + D, args.out + OUT_Y, nullptr, lds, wave, gw, NGW, lane);
#endif
#endif
    }
#undef IN
#undef SEAM
}
#undef ws
#undef INP
#undef Wa
#undef Wo
#undef Wg
#undef Wgo
#undef Wpq
#undef PK
#undef Usc
#undef Xb
#undef Qb
#undef QIb
#undef Kb
#undef Vb
#undef KIb
#undef WIf
#undef SC
#undef SCS
#undef IDX
#undef CNT
#undef Ob
#undef Z
#undef H1f
#undef H1b
#undef PQb
#undef H2f
#undef H2b
#undef TEID
#undef TGATE
#undef Gq
#undef Gk
#undef Gv
#undef Gr
#undef GD
#undef QT
#undef KT
#undef DEC
#undef DSb
#undef SPV
#undef OGb
#undef Uq
#undef HDB
#undef KV8
#undef Vq
#undef Usc
#undef Vsc
#undef x_prompt
#undef x_sample
#undef attn_w_in
#undef attn_w_out
#undef gla_w_in
#undef gla_w_out
#undef peer_w_q
#undef peer_keys1
#undef peer_keys2
#undef peer_u
#undef peer_v


}

extern "C" void kernel_launch(void* const* d_in, const int* in_sizes, int n_in, void* d_out, int out_size, void* d_ws, size_t ws_size, hipStream_t stream) {
    if (ws_size < mk::WS_END || n_in != 23 || (size_t)out_size != OUT_TOTAL) { fprintf(stderr, "kernel_launch: unexpected sizes ws %zu n_in %d out %d\n", ws_size, n_in, out_size); return; }
    static int grid = 0;
    if (grid == 0) {
        int dev = 0, cus = 0;
        if (hipGetDevice(&dev) != hipSuccess || hipDeviceGetAttribute(&cus, hipDeviceAttributeMultiprocessorCount, dev) != hipSuccess) { fprintf(stderr, "kernel_launch: device query failed\n"); grid = -1; return; }
        if (hipFuncSetAttribute((const void*)mk::mk_fwd, hipFuncAttributeMaxDynamicSharedMemorySize, mk::LDS_BYTES) != hipSuccess) { fprintf(stderr, "kernel_launch: hipFuncSetAttribute failed\n"); grid = -1; return; }
        int per_cu = 0;
        if (hipOccupancyMaxActiveBlocksPerMultiprocessor(&per_cu, (const void*)mk::mk_fwd, mk::NTHREADS, mk::LDS_BYTES) != hipSuccess || per_cu < 1) fprintf(stderr, "kernel_launch: occupancy query says %d\n", per_cu);
        (void)hipGetLastError();
        grid = cus;
    }
    if (grid < 0) return;
    (void)hipMemsetAsync((char*)d_ws + mk::WS_CTL, 0, mk::CTL_ZERO_BYTES, stream);
    mk::Args a{};
    for (int i = 0; i < 23; ++i) a.in[i] = (const float*)d_in[i];
    a.page_table = (const int*)d_in[6]; a.out = (float*)d_out; a.ws = (unsigned char*)d_ws; a.ph_lo = 0; a.ph_hi = mk::P_COUNT;
    hipLaunchKernelGGL(mk::mk_fwd, dim3(grid), dim3(mk::NTHREADS), mk::LDS_BYTES, stream, a);
}
```

```cpp
#include <hip/hip_runtime.h>
#include <cstdio>
#include <cstdint>
#include <cmath>

constexpr int D = 1024;
constexpr int NBATCH = 2, SEQ = 8192, TP = NBATCH * SEQ;
constexpr int DB = 32, DS = 4, TS = DB * DS;
constexpr int TA = TP + TS;
constexpr int PAST = 8192, PAGE = 128, NPAGES = PAST / PAGE;
constexpr float ALPHA = 1.4142135623730951f;
constexpr float LN_EPS = 1e-5f;
constexpr int ATT_N = 2120;
constexpr int AQ = 0, AK = 1024, AV = 1280, AQI = 1536, AKI = 2048, AWI = 2112;
constexpr int TOPK = 256;
constexpr int GLA_N = 3088;
constexpr int GQ = 0, GK = 512, GV = 1024, GGD = 2048, GR = 2064;
constexpr int PEER_N = 2048;
constexpr int SCS_LD = 8256;

constexpr size_t OUT_Y = 0, OUT_KP = 16908288, OUT_VP = 21102592, OUT_KIP = 25296896, OUT_SP = 26345472,
                 OUT_KS = 26607616, OUT_VS = 26640384, OUT_KIS = 26673152, OUT_SS = 26681344, OUT_TOTAL = 30875648;


namespace pg8 {
#define PG8_LAS __attribute__((address_space(3)))
typedef unsigned short bf16_t;
typedef short bf16x8 __attribute__((ext_vector_type(8)));
typedef float f32x4 __attribute__((ext_vector_type(4)));
typedef unsigned u32x4 __attribute__((ext_vector_type(4)));
constexpr int BM = 256, BK = 64, HALF = 128, HTB = HALF * BK * 2  , STAGE_BYTES = 8 * HTB, NXCD = 8, WGM = 8;

__host__ __device__ __forceinline__ int lds_byte(int r, int c) { const int st = (r >> 4) * 2 + (c >> 5), rr = r & 15, cc = c & 31, ob = rr * 64 + cc * 2; return st * 1024 + (ob ^ (((ob >> 9) & 1) << 5)); }
__host__ __device__ __forceinline__ void stage_rc(int b, int& R, int& C) { const int st = b / 1024, sb = b % 1024, swz = sb ^ (((sb >> 9) & 1) << 5); R = (st >> 1) * 16 + swz / 64; C = (st & 1) * 32 + (swz % 64) / 2; }
__host__ __device__ __forceinline__ int perm32(int rho) { const int n = rho >> 4, i = rho & 15; return 8 * (i >> 2) + 4 * n + (i & 3); }

struct Unit { int pm, pn; };
struct Gemm { const bf16_t* A; const bf16_t* Bt; int M, N, K; };

struct StaticOrder {
    int nM, nN, nwg, G, c;
    __host__ __device__ void init(int M, int N, int G_, int c_) { nM = M / BM; nN = N / BM; nwg = nM * nN; G = G_; c = c_; }
    __host__ __device__ bool next(int i, Unit& u) const {
        const long L = (long)i * G + c; if (L >= nwg) return false;
        int wgid = (int)L; { const int q = nwg / NXCD, r = nwg % NXCD, xcd = wgid % NXCD, off = wgid / NXCD; wgid = (xcd < r ? xcd * (q + 1) : r * (q + 1) + (xcd - r) * q) + off; }
        const int nig = WGM * nN, gid = wgid / nig, fm = gid * WGM, gsz = (nM - fm) < WGM ? (nM - fm) : WGM;
        u.pm = fm + ((wgid % nig) % gsz); u.pn = (wgid % nig) / gsz; return true;
    }
    __device__ __forceinline__ void a_ready(const Unit&) const {}
    __device__ __forceinline__ void done(const Unit&) const {}
};

__device__ __forceinline__ unsigned cvt_pk_bf16(float lo, float hi) { unsigned r; asm volatile("v_cvt_pk_bf16_f32 %0, %1, %2" : "=v"(r) : "v"(lo), "v"(hi)); return r; }
template <class F> struct EpiRow8 {
    static constexpr bool PERM = true, AFTER_DRAIN = false;
    F f;
    __device__ __forceinline__ void operator()(const f32x4 (&acc)[2][2][4][2], const Unit& u, int wr, int wc, int fr, int fq) const {
        const int row0 = u.pm * BM + wr * 64 + fr, col0 = u.pn * BM + wc * 32 + 8 * fq;
#pragma unroll
        for (int ai = 0; ai < 2; ++ai)
#pragma unroll
            for (int m = 0; m < 4; ++m)
#pragma unroll
                for (int bj = 0; bj < 2; ++bj) f.put8(row0 + ai * HALF + m * 16, col0 + bj * HALF, acc[ai][bj][m][0], acc[ai][bj][m][1]);
    }
};


template <class Epi, class Sched, bool ALIGN_EPI = false, bool SP2 = false>
__device__ __forceinline__ void gemm_phase(PG8_LAS unsigned char* lds, const Gemm g, const Sched& S, const Epi& E) {
    const int tid = threadIdx.x, wid = __builtin_amdgcn_readfirstlane(tid >> 6), lane = tid & 63, wr = wid >> 2, wc = wid & 3, fr = lane & 15, fq = lane >> 4;
    const int K = g.K, nt = K / BK;
    unsigned voffA[2], voffB[2];
#pragma unroll
    for (int i = 0; i < 2; ++i) { int R, C; stage_rc(tid * 16 + i * 8192, R, C); const int Rb = Epi::PERM ? ((R & ~31) + perm32(R & 31)) : R;
        voffA[i] = (unsigned)(R * K + C) * 2u; voffB[i] = (unsigned)(Rb * K + C) * 2u; }
    const size_t kstep = (size_t)(BK * 2);
    const size_t hstep = (size_t)HALF * K * 2;
    const size_t tstep = 2 * hstep;
    const unsigned ldsw = (unsigned)wid * 1024u;
    const int aoff = lds_byte(wr * 64 + fr, fq * 8), boff = lds_byte(wc * 32 + fr, fq * 8);
#define PG8_SA(b, h) (((b) * 2 + (h)) * HTB)
#define PG8_SB(b, h) ((4 + (b) * 2 + (h)) * HTB)
#define PG8_STAGE(bufoff, gbase, voff) do { _Pragma("unroll") for (int _i = 0; _i < 2; ++_i) \
        __builtin_amdgcn_global_load_lds((const unsigned*)((const char*)(gbase) + (voff)[_i]), (PG8_LAS unsigned*)(lds + (bufoff) + ldsw + _i * 8192), 16, 0, 0); } while (0)
#define PG8_LDA(dst, b, h) do { _Pragma("unroll") for (int m = 0; m < 4; ++m) _Pragma("unroll") for (int k = 0; k < 2; ++k) dst[m][k] = *(const PG8_LAS bf16x8*)(lds + PG8_SA(b, h) + aoff + m * 2048 + k * 1024); } while (0)
#define PG8_LDB(dst, b, h) do { _Pragma("unroll") for (int n = 0; n < 2; ++n) _Pragma("unroll") for (int k = 0; k < 2; ++k) dst[n][k] = *(const PG8_LAS bf16x8*)(lds + PG8_SB(b, h) + boff + n * 2048 + k * 1024); } while (0)
#define PG8_MMA(ai, bj, At, Bt) do { __builtin_amdgcn_s_setprio(1); _Pragma("unroll") for (int m = 0; m < 4; ++m) _Pragma("unroll") for (int n = 0; n < 2; ++n) _Pragma("unroll") for (int k = 0; k < 2; ++k) \
        acc[ai][bj][m][n] = __builtin_amdgcn_mfma_f32_16x16x32_bf16(Bt[n][k], At[m][k], acc[ai][bj][m][n], 0, 0, 0); __builtin_amdgcn_s_setprio(0); } while (0)
#define PG8_WAIT_V(n) asm volatile("s_waitcnt vmcnt(" #n ")" ::: "memory")
#define PG8_WAIT_L(n) asm volatile("s_waitcnt lgkmcnt(" #n ")" ::: "memory")
#define PG8_BAR __builtin_amdgcn_s_barrier()
#define PG8_SCHED __builtin_amdgcn_sched_barrier(0)
    Unit cur, nxt; int ui = 0;
    if (!S.next(0, cur)) return;
    f32x4 acc[2][2][4][2];
#pragma unroll
    for (int a = 0; a < 2; ++a)
#pragma unroll
        for (int b = 0; b < 2; ++b)
#pragma unroll
            for (int m = 0; m < 4; ++m)
#pragma unroll
                for (int n = 0; n < 2; ++n) acc[a][b][m][n] = (f32x4){0.f, 0.f, 0.f, 0.f};
    bf16x8 At[4][2], B0[2][2], B1[2][2];
    const char* cA = (const char*)g.A + (size_t)cur.pm * tstep; const char* cB = (const char*)g.Bt + (size_t)cur.pn * tstep;
    S.a_ready(cur);
    if constexpr (SP2) {
        PG8_STAGE(PG8_SB(0, 0), cB, voffB); PG8_STAGE(PG8_SB(0, 1), cB + hstep, voffB); PG8_STAGE(PG8_SA(0, 0), cA, voffA); PG8_STAGE(PG8_SA(0, 1), cA + hstep, voffA);
        if (wr == 1) PG8_BAR;
        PG8_WAIT_V(2); PG8_BAR;
        PG8_STAGE(PG8_SB(1, 0), cB + kstep, voffB); PG8_STAGE(PG8_SA(1, 0), cA + kstep, voffA); PG8_STAGE(PG8_SB(1, 1), cB + hstep + kstep, voffB);
        PG8_WAIT_V(6); PG8_BAR;
    } else {
        PG8_STAGE(PG8_SB(0, 0), cB, voffB); PG8_STAGE(PG8_SA(0, 0), cA, voffA); PG8_STAGE(PG8_SB(0, 1), cB + hstep, voffB); PG8_STAGE(PG8_SA(0, 1), cA + hstep, voffA);
        if (wr == 1) PG8_BAR;
        PG8_WAIT_V(4); PG8_BAR;
        PG8_STAGE(PG8_SB(1, 0), cB + kstep, voffB); PG8_STAGE(PG8_SA(1, 0), cA + kstep, voffA); PG8_STAGE(PG8_SB(1, 1), cB + hstep + kstep, voffB);
        PG8_WAIT_V(6); PG8_BAR;
    }
    for (;;) {
        const bool has_next = S.next(ui + 1, nxt);
        const char* nA = has_next ? (const char*)g.A + (size_t)nxt.pm * tstep : cA; const char* nB = has_next ? (const char*)g.Bt + (size_t)nxt.pn * tstep : cB;
        for (int t = 0; t < nt; t += 2) {
            const bool last = (t == nt - 2);
            const char* a1 = cA + (size_t)(t + 1) * kstep;
            const char* a2 = last ? nA : cA + (size_t)(t + 2) * kstep; const char* b2 = last ? nB : cB + (size_t)(t + 2) * kstep;
            const char* a3 = a2 + kstep; const char* b3 = b2 + kstep;
            if (last && has_next) S.a_ready(nxt);
            if constexpr (SP2) {
            PG8_LDB(B0, 0, 0); PG8_LDB(B1, 0, 1); PG8_SCHED; PG8_LDA(At, 0, 0); PG8_STAGE(PG8_SA(1, 1), a1 + hstep, voffA);
            PG8_WAIT_V(8); PG8_WAIT_L(0); PG8_BAR; PG8_MMA(0, 0, At, B0); PG8_MMA(0, 1, At, B1); PG8_BAR; PG8_SCHED;
            PG8_LDA(At, 0, 1); PG8_STAGE(PG8_SB(0, 0), b2, voffB); PG8_STAGE(PG8_SB(0, 1), b2 + hstep, voffB); PG8_STAGE(PG8_SA(0, 0), a2, voffA);
            PG8_WAIT_V(8); PG8_WAIT_L(0); PG8_BAR; PG8_MMA(1, 0, At, B0); PG8_MMA(1, 1, At, B1); PG8_BAR; PG8_SCHED;
            PG8_LDB(B0, 1, 0); PG8_LDB(B1, 1, 1); PG8_SCHED; PG8_LDA(At, 1, 0); PG8_STAGE(PG8_SA(0, 1), a2 + hstep, voffA);
            PG8_WAIT_V(8); PG8_WAIT_L(0); PG8_BAR; PG8_MMA(0, 0, At, B0); PG8_MMA(0, 1, At, B1); PG8_BAR; PG8_SCHED;
            PG8_LDA(At, 1, 1); PG8_STAGE(PG8_SB(1, 0), b3, voffB); PG8_STAGE(PG8_SB(1, 1), b3 + hstep, voffB); PG8_STAGE(PG8_SA(1, 0), a3, voffA);
            PG8_WAIT_V(8); PG8_WAIT_L(0); PG8_BAR; PG8_MMA(1, 0, At, B0); PG8_MMA(1, 1, At, B1); PG8_BAR; PG8_SCHED;
            } else {
            PG8_LDB(B0, 0, 0); PG8_SCHED; PG8_LDA(At, 0, 0); PG8_STAGE(PG8_SA(1, 1), a1 + hstep, voffA);
            PG8_WAIT_L(8); PG8_BAR; PG8_WAIT_L(0); PG8_MMA(0, 0, At, B0); PG8_BAR; PG8_SCHED;
            PG8_LDB(B1, 0, 1); PG8_STAGE(PG8_SB(0, 0), b2, voffB);
            PG8_BAR; PG8_WAIT_L(0); PG8_MMA(0, 1, At, B1); PG8_BAR;
            PG8_LDA(At, 0, 1); PG8_STAGE(PG8_SA(0, 0), a2, voffA);
            PG8_BAR; PG8_WAIT_L(0); PG8_MMA(1, 0, At, B0); PG8_BAR; PG8_SCHED;
            PG8_STAGE(PG8_SB(0, 1), b2 + hstep, voffB);
            PG8_WAIT_V(6); PG8_BAR; PG8_MMA(1, 1, At, B1); PG8_BAR;
            PG8_LDB(B0, 1, 0); PG8_SCHED; PG8_LDA(At, 1, 0); PG8_STAGE(PG8_SA(0, 1), a2 + hstep, voffA);
            PG8_WAIT_L(8); PG8_BAR; PG8_WAIT_L(0); PG8_MMA(0, 0, At, B0); PG8_BAR; PG8_SCHED;
            PG8_LDB(B1, 1, 1); PG8_STAGE(PG8_SB(1, 0), b3, voffB);
            PG8_BAR; PG8_WAIT_L(0); PG8_MMA(0, 1, At, B1); PG8_BAR;
            PG8_LDA(At, 1, 1); PG8_STAGE(PG8_SA(1, 0), a3, voffA);
            PG8_BAR; PG8_WAIT_L(0); PG8_MMA(1, 0, At, B0); PG8_BAR; PG8_SCHED;
            PG8_STAGE(PG8_SB(1, 1), b3 + hstep, voffB);
            PG8_WAIT_V(6); PG8_BAR; PG8_MMA(1, 1, At, B1); PG8_BAR;
            }
        }
        if constexpr (ALIGN_EPI) { if (wr == 0) PG8_BAR; }
        if constexpr (!Epi::AFTER_DRAIN) { E(acc, cur, wr, wc, fr, fq); S.done(cur); }
        if (!has_next) break;
#pragma unroll
        for (int a = 0; a < 2; ++a)
#pragma unroll
            for (int b = 0; b < 2; ++b)
#pragma unroll
                for (int m = 0; m < 4; ++m)
#pragma unroll
                    for (int n = 0; n < 2; ++n) acc[a][b][m][n] = (f32x4){0.f, 0.f, 0.f, 0.f};
        cur = nxt; cA = nA; cB = nB; ++ui;
        if constexpr (ALIGN_EPI) { if (wr == 1) PG8_BAR; }
    }
    PG8_WAIT_V(0);
    if constexpr (!ALIGN_EPI) { if (wr == 0) PG8_BAR; }
    PG8_BAR;
    if constexpr (Epi::AFTER_DRAIN) { E.fused(acc, cur, wr, wc, fr, fq, lds, wid, lane); S.done(cur); }
#undef PG8_SA
#undef PG8_SB
#undef PG8_STAGE
#undef PG8_LDA
#undef PG8_LDB
#undef PG8_MMA
#undef PG8_WAIT_V
#undef PG8_WAIT_L
#undef PG8_BAR
#undef PG8_SCHED
}
}

namespace mk {
#define GAS __attribute__((address_space(1)))
#define LAS __attribute__((address_space(3)))
typedef unsigned short bf16;
typedef unsigned v4u __attribute__((ext_vector_type(4)));
typedef float f32x4 __attribute__((ext_vector_type(4)));
typedef short bf16x8 __attribute__((ext_vector_type(8)));
typedef GAS unsigned gu32;
typedef GAS unsigned long long gu64;
#define RLX_AGENT __ATOMIC_RELAXED, __HIP_MEMORY_SCOPE_AGENT
#define LDS_WAIT() asm volatile("s_waitcnt lgkmcnt(0)" ::: "memory")
#define VM_WAIT() asm volatile("s_waitcnt vmcnt(0)" ::: "memory")
__device__ __forceinline__ unsigned long long rt() { return __builtin_amdgcn_s_memrealtime(); }
__device__ __forceinline__ unsigned f2bf(float f) { unsigned u = __builtin_bit_cast(unsigned, f); return (u + 0x7fffu + ((u >> 16) & 1u)) >> 16; }
__device__ __forceinline__ unsigned pk2(float lo, float hi) {
    typedef __bf16 bf2_t __attribute__((ext_vector_type(2))); typedef float f2_t __attribute__((ext_vector_type(2)));
    const f2_t v = {lo, hi}; const bf2_t b = __builtin_convertvector(v, bf2_t); return __builtin_bit_cast(unsigned, b); }

#define XB_TMO      128
#define XB_XCNT(j)  (256  + 64 * (j))
#define XB_XSUB(j)  (1280 + 64 * (j))
#define XB_XGEN(j)  (2304 + 64 * (j))
#define XB_TOP      3328
#define XB_TOPGEN   3392
#define XCD_BAR_WORDS 3456
#define XB_SPIN_CAP (1u << 18)

__device__ __forceinline__ unsigned xb_ld(unsigned* p)              { return __hip_atomic_load(p, __ATOMIC_RELAXED, __HIP_MEMORY_SCOPE_AGENT); }
__device__ __forceinline__ unsigned xb_add(unsigned* p, unsigned v) { return __hip_atomic_fetch_add(p, v, __ATOMIC_RELAXED, __HIP_MEMORY_SCOPE_AGENT); }
__device__ __forceinline__ unsigned xb_xcc_id() { return (unsigned)__builtin_amdgcn_s_getreg((3 << 11) | 20) & 0xFu; }
#define XB_SPIN(cond, bar) do { unsigned _sp = 0; while (cond) { __builtin_amdgcn_s_sleep(1); \
    if ((++_sp & 255u) == 0u) { if (xb_ld(&(bar)[XB_TMO])) break; if (_sp > XB_SPIN_CAP) { atomicAdd(&(bar)[XB_TMO], 1u); break; } } } } while (0)

struct XcdBarrier {
    unsigned* bar; unsigned x;
    volatile LAS unsigned* st;
};

__device__ __forceinline__ XcdBarrier xcd_barrier_post(unsigned* bar, volatile LAS unsigned* st) {
    XcdBarrier b; b.bar = bar; b.x = xb_xcc_id(); b.st = st;
    if (threadIdx.x == 0) (void)xb_add(&bar[XB_XCNT(b.x)], 1u);
    return b;
}
__device__ __forceinline__ void xcd_barrier_complete(unsigned* bar, unsigned x, unsigned& nloc, unsigned& nx) {
    const unsigned G = gridDim.x * gridDim.y * gridDim.z;
    unsigned sum, cnt, mine, sp = 0u;
    for (;;) {
        sum = 0u; cnt = 0u; mine = 0u;
#pragma unroll
        for (unsigned j = 0; j < 16; ++j) { const unsigned c = xb_ld(&bar[XB_XCNT(j)]); sum += c; cnt += (c > 0u) ? 1u : 0u; mine = (j == x) ? c : mine; }
        if (sum == G) break;
        __builtin_amdgcn_s_sleep(1);
        if ((++sp & 255u) == 0u) { if (xb_ld(&bar[XB_TMO])) break; if (sp > XB_SPIN_CAP) { atomicAdd(&bar[XB_TMO], 1u); break; } }
    }
    nloc = mine > 0u ? mine : 1u; nx = cnt > 0u ? cnt : 1u;
}

__device__ __forceinline__ void xcd_barrier(const XcdBarrier& b) {
    asm volatile("s_waitcnt vmcnt(0)" ::: "memory");
    __syncthreads();
    if (threadIdx.x == 0) {
        unsigned* bar = b.bar;
        __builtin_amdgcn_s_waitcnt(0);
        unsigned nloc = b.st[0], nx = b.st[1];
        if (nloc == 0u) { xcd_barrier_complete(bar, b.x, nloc, nx); b.st[0] = nloc; b.st[1] = nx; }
        const unsigned old = xb_add(&bar[XB_XSUB(b.x)], 1u);
        const unsigned gen = old / nloc;
        if (old + 1u == (gen + 1u) * nloc) {
            __builtin_amdgcn_fence(__ATOMIC_RELEASE, "agent");
            asm volatile("s_waitcnt vmcnt(0)" ::: "memory");
            const unsigned og = xb_add(&bar[XB_TOP], 1u);
            const unsigned tg = og / nx;
            if (og + 1u == (tg + 1u) * nx) xb_add(&bar[XB_TOPGEN], 1u);
            else XB_SPIN(xb_ld(&bar[XB_TOPGEN]) == tg, bar);
            __builtin_amdgcn_fence(__ATOMIC_ACQUIRE, "agent");
            xb_add(&bar[XB_XGEN(b.x)], 1u);
            asm volatile("s_waitcnt vmcnt(0)" ::: "memory");
        } else {
            XB_SPIN(xb_ld(&bar[XB_XGEN(b.x)]) == gen, bar);
            __builtin_amdgcn_fence(__ATOMIC_ACQUIRE, "agent");
            asm volatile("s_waitcnt vmcnt(0)" ::: "memory");
        }
    }
    __syncthreads();
}

}

namespace mk {
constexpr int NWAVES = 8, NTHREADS = 512;
constexpr size_t MiB = 1u << 20;
constexpr size_t WS_QIB = 325 * MiB, WS_KB = 342 * MiB, WS_VB = 351 * MiB, WS_KIB = 360 * MiB, WS_WIF = 363 * MiB;
constexpr size_t WS_OB = 390 * MiB, WS_GD = 423 * MiB;
constexpr size_t WS_IDX = 525 * MiB, WS_CNT = 542 * MiB, WS_SCS = 543 * MiB;
constexpr size_t WS_S = 548 * MiB;
constexpr size_t WS_SC = WS_S;
constexpr size_t WS_Z = WS_S, WS_H1F = WS_S + 65 * MiB, WS_H1B = WS_S + 130 * MiB, WS_PQB = WS_S + 163 * MiB, WS_H2F = WS_S + 228 * MiB, WS_H2B = WS_S + 293 * MiB;
constexpr size_t WS_GQ = WS_S + 326 * MiB, WS_GK = WS_S + 343 * MiB, WS_GV = WS_S + 360 * MiB, WS_GR = WS_S + 393 * MiB, WS_QT = WS_S + 426 * MiB, WS_DEC = WS_S + 442 * MiB,
                 WS_OGB = WS_S + 443 * MiB, WS_KT = WS_S + 476 * MiB;
constexpr size_t WS_DS = WS_S, WS_SPREV = WS_S + 128 * MiB;
constexpr size_t WS_CTL = 1060 * MiB, WS_WA = 1061 * MiB, WS_WO = 1066 * MiB, WS_WG = 1068 * MiB, WS_WGO = 1075 * MiB, WS_WPQ = 1077 * MiB, WS_PK = 1085 * MiB,
                 WS_UB = 1086 * MiB, WS_VBX = 1150 * MiB, WS_USC = 1118 * MiB, WS_TEID = 1120 * MiB, WS_TGATE = 1125 * MiB, WS_HD = 1134 * MiB, WS_KV8 = 1134 * MiB, WS_XB = 1214 * MiB, WS_QB = 1247 * MiB, WS_END = 1280 * MiB;
constexpr size_t CTL_ZERO_BYTES = 1 * MiB;
constexpr int CW_TMO = 0, CW_AMAXK = 256, CW_AMAXV = 320, CW_Q1 = 512, CW_XC = 1024, CW_BAR = 4096;
constexpr int WA_ROWS = 2176, WG_ROWS = 3104;
constexpr int GN_Q = 0, GN_K = 512, GN_V = 1024, GN_R = 2048, GN_GD = 3072;

constexpr int RING_BYTES = 131072, LDSCTL_OFF = RING_BYTES, MISC_OFF = LDSCTL_OFF + 320, INPTAB_OFF = LDSCTL_OFF + 512, LDS_BYTES = 147456;

typedef unsigned u32x4 __attribute__((ext_vector_type(4)));
typedef unsigned u32x2 __attribute__((ext_vector_type(2)));
#define MK_LAS __attribute__((address_space(3)))
__device__ __forceinline__ float bflo(unsigned w) { return __builtin_bit_cast(float, w << 16); }
__device__ __forceinline__ float bfhi(unsigned w) { return __builtin_bit_cast(float, w & 0xffff0000u); }
__device__ __forceinline__ float bf2f(unsigned short b) { return __builtin_bit_cast(float, (unsigned)b << 16); }
__device__ __forceinline__ u32x4 pack8(f32x4 a, f32x4 b) { u32x4 w; w.x = pk2(a[0], a[1]); w.y = pk2(a[2], a[3]); w.z = pk2(b[0], b[1]); w.w = pk2(b[2], b[3]); return w; }

#define TPB(k)
#define TPE(k)
template <int NCT> __device__ __forceinline__ void skinny_tile(const bf16* __restrict__ A, int lda, const bf16* __restrict__ Bt, int K, int row0, int col0, f32x4 (&acc)[NCT], int lane) {
    const int fr = lane & 15, fq = lane >> 4;
    const bf16* ap = A + (size_t)(row0 + fr) * lda + fq * 8;
    const bf16* bp = Bt + (size_t)(col0 + fr) * K + fq * 8;
#pragma unroll
    for (int ct = 0; ct < NCT; ++ct) acc[ct] = (f32x4){0.f, 0.f, 0.f, 0.f};
#pragma unroll 1
    for (int k0 = 0; k0 < K; k0 += 128) {
        bf16x8 a[4], b[NCT][4];
#pragma unroll
        for (int j = 0; j < 4; ++j) a[j] = *(const bf16x8*)(ap + k0 + j * 32);
#pragma unroll
        for (int ct = 0; ct < NCT; ++ct)
#pragma unroll
            for (int j = 0; j < 4; ++j) b[ct][j] = *(const bf16x8*)(bp + (size_t)ct * 16 * K + k0 + j * 32);
        asm volatile("" ::: "memory");
#pragma unroll
        for (int ct = 0; ct < NCT; ++ct)
#pragma unroll
            for (int j = 0; j < 4; ++j) acc[ct] = __builtin_amdgcn_mfma_f32_16x16x32_bf16(b[ct][j], a[j], acc[ct], 0, 0, 0);
    }
}

__device__ __forceinline__ void p0_transpose_item(const float* __restrict__ W, int ldw, int K, bf16* __restrict__ WT, int dst_row0, int src_col0, int nvalid, int k0, MK_LAS float* scr, int lane) {
#pragma unroll 8
    for (int i = 0; i < 32; ++i) { const int kk = 2 * i + (lane >> 5), j = lane & 31; scr[kk * 33 + j] = j < nvalid ? W[(size_t)(k0 + kk) * ldw + src_col0 + j] : 0.f; }
    asm volatile("s_waitcnt lgkmcnt(0)" ::: "memory");
    const int c = lane & 7;
#pragma unroll
    for (int j = 0; j < 4; ++j) { const int n = (lane >> 3) + 8 * j; const MK_LAS float* s = scr + (8 * c) * 33 + n;
        u32x4 o; o.x = pk2(s[0 * 33], s[1 * 33]); o.y = pk2(s[2 * 33], s[3 * 33]); o.z = pk2(s[4 * 33], s[5 * 33]); o.w = pk2(s[6 * 33], s[7 * 33]);
        *(u32x4*)(WT + (size_t)(dst_row0 + n) * K + k0 + 8 * c) = o; }
    asm volatile("s_waitcnt lgkmcnt(0)" ::: "memory");
}
__device__ __forceinline__ void p0_convert(const float* __restrict__ src, bf16* __restrict__ dst, size_t n8, int gw, int ngw, int lane) {
    for (size_t i = (size_t)gw * 64 + lane; i < n8; i += (size_t)ngw * 64) {
        const f32x4 a = *(const f32x4*)(src + i * 8), b = *(const f32x4*)(src + i * 8 + 4);
        *(u32x4*)(dst + i * 8) = pack8(a, b);
    }
}

__device__ __forceinline__ void p0_quant_row(const float* __restrict__ src, unsigned char* __restrict__ dst, float* __restrict__ scale, int lane) {
    f32x4 v[4]; float am = 0.f;
#pragma unroll
    for (int q = 0; q < 4; ++q) { v[q] = *(const f32x4*)(src + lane * 16 + q * 4); am = fmaxf(am, fmaxf(fmaxf(fabsf(v[q][0]), fabsf(v[q][1])), fmaxf(fabsf(v[q][2]), fabsf(v[q][3])))); }
#pragma unroll
    for (int o = 1; o < 64; o <<= 1) am = fmaxf(am, __shfl_xor(am, o));
    const float inv = am > 0.f ? 448.f / am : 0.f;
    u32x4 w;
#pragma unroll
    for (int q = 0; q < 4; ++q) { int x = __builtin_amdgcn_cvt_pk_fp8_f32(v[q][0] * inv, v[q][1] * inv, 0, false); x = __builtin_amdgcn_cvt_pk_fp8_f32(v[q][2] * inv, v[q][3] * inv, x, true); w[q] = (unsigned)x; }
    *(u32x4*)(dst + lane * 16) = w;
    if (lane == 0) *scale = am * (1.f / 448.f);
}

__device__ __forceinline__ void p0_quant_rows4(const float* __restrict__ src, unsigned char* __restrict__ dst, float* __restrict__ scale, int lane) {
    f32x4 v[4][4]; float am[4];
#pragma unroll
    for (int r = 0; r < 4; ++r)
#pragma unroll
        for (int q = 0; q < 4; ++q) v[r][q] = *(const f32x4*)(src + (size_t)r * D + lane * 16 + q * 4);
#pragma unroll
    for (int r = 0; r < 4; ++r) { float a = 0.f;
#pragma unroll
        for (int q = 0; q < 4; ++q) a = fmaxf(a, fmaxf(fmaxf(fabsf(v[r][q][0]), fabsf(v[r][q][1])), fmaxf(fabsf(v[r][q][2]), fabsf(v[r][q][3]))));
        am[r] = a; }
#pragma unroll
    for (int o = 1; o < 64; o <<= 1) {
#pragma unroll
        for (int r = 0; r < 4; ++r) am[r] = fmaxf(am[r], __shfl_xor(am[r], o)); }
#pragma unroll
    for (int r = 0; r < 4; ++r) {
        const float inv = am[r] > 0.f ? 448.f / am[r] : 0.f;
        u32x4 w;
#pragma unroll
        for (int q = 0; q < 4; ++q) { int x = __builtin_amdgcn_cvt_pk_fp8_f32(v[r][q][0] * inv, v[r][q][1] * inv, 0, false); x = __builtin_amdgcn_cvt_pk_fp8_f32(v[r][q][2] * inv, v[r][q][3] * inv, x, true); w[q] = (unsigned)x; }
        *(u32x4*)(dst + (size_t)r * D + lane * 16) = w;
        if (lane == 0) scale[r] = am[r] * (1.f / 448.f);
    }
}

struct FAttnIn {
    bf16 *Qb, *Kb, *Vb, *QIb, *KIb; float* WIf; float* out;
    mutable float kmax = 0.f, vmax = 0.f;
    __device__ __forceinline__ static float amax8(f32x4 a, f32x4 b) { return fmaxf(fmaxf(fmaxf(fabsf(a[0]), fabsf(a[1])), fmaxf(fabsf(a[2]), fabsf(a[3]))), fmaxf(fmaxf(fabsf(b[0]), fabsf(b[1])), fmaxf(fabsf(b[2]), fabsf(b[3])))); }
    __device__ __forceinline__ float* okp(int row, size_t offp, size_t offs, int ld) const { return row < TP ? out + offp + (size_t)row * ld : out + offs + (size_t)(row - TP) * ld; }
    __device__ __forceinline__ void put8(int row, int col, f32x4 v0, f32x4 v1) const {
        const u32x4 w = pack8(v0, v1);
        if (col < AK) *(u32x4*)(Qb + (size_t)row * 1024 + col) = w;
        else if (col < AV) { *(u32x4*)(Kb + (size_t)row * 256 + (col - AK)) = w; float* o = okp(row, OUT_KP, OUT_KS, 256) + (col - AK); *(f32x4*)o = v0; *(f32x4*)(o + 4) = v1; kmax = fmaxf(kmax, amax8(v0, v1)); }
        else if (col < AQI) { *(u32x4*)(Vb + (size_t)row * 256 + (col - AV)) = w; float* o = okp(row, OUT_VP, OUT_VS, 256) + (col - AV); *(f32x4*)o = v0; *(f32x4*)(o + 4) = v1; vmax = fmaxf(vmax, amax8(v0, v1)); }
        else *(u32x4*)(QIb + (size_t)row * 512 + (col - AQI)) = w;
    }
    __device__ __forceinline__ void put4(int row, int col, f32x4 v) const {
        u32x2 w; w.x = pk2(v[0], v[1]); w.y = pk2(v[2], v[3]);
        if (col < AK) *(u32x2*)(Qb + (size_t)row * 1024 + col) = w;
        else if (col < AV) { *(u32x2*)(Kb + (size_t)row * 256 + (col - AK)) = w; *(f32x4*)(okp(row, OUT_KP, OUT_KS, 256) + (col - AK)) = v; }
        else if (col < AQI) { *(u32x2*)(Vb + (size_t)row * 256 + (col - AV)) = w; *(f32x4*)(okp(row, OUT_VP, OUT_VS, 256) + (col - AV)) = v; }
        else if (col < AKI) *(u32x2*)(QIb + (size_t)row * 512 + (col - AQI)) = w;
        else if (col < AWI) { *(u32x2*)(KIb + (size_t)row * 64 + (col - AKI)) = w; *(f32x4*)(okp(row, OUT_KIP, OUT_KIS, 64) + (col - AKI)) = v; }
        else if (col < ATT_N) *(f32x4*)(WIf + (size_t)row * 8 + (col - AWI)) = v * 0.04419417382415922f;
    }
};
}

namespace mk {
typedef float f32x2v __attribute__((ext_vector_type(2)));
typedef float f32x16 __attribute__((ext_vector_type(16)));
typedef short s16x4 __attribute__((ext_vector_type(4)));
typedef short v4i16_t __attribute__((ext_vector_type(4)));

__device__ __forceinline__ void score_load_q(const bf16* __restrict__ QIb, const float* __restrict__ WIf, size_t tok0, int lane, bf16x8 (&afr)[4], f32x4 (&w4)[4]) {
    const int r = lane & 31, kq = lane >> 5;
    const bf16* ap = QIb + (tok0 + (r >> 3)) * 512 + (r & 7) * 64 + kq * 8;
#pragma unroll
    for (int ks = 0; ks < 4; ++ks) afr[ks] = *(const bf16x8*)(ap + ks * 16);
#pragma unroll
    for (int ql = 0; ql < 4; ++ql) w4[ql] = *(const f32x4*)(WIf + (tok0 + ql) * 8 + 4 * kq);
}
__device__ __forceinline__ void score_tile(const bf16x8 (&afr)[4], const bf16x8 (&bfr)[4], const f32x4 (&w4)[4], float (&s)[4]) {
    f32x16 acc;
#pragma unroll
    for (int j = 0; j < 16; ++j) acc[j] = 0.f;
#pragma unroll
    for (int ks = 0; ks < 4; ++ks) acc = __builtin_amdgcn_mfma_f32_32x32x16_bf16(afr[ks], bfr[ks], acc, 0, 0, 0);
#pragma unroll
    for (int ql = 0; ql < 4; ++ql) {
        float p = 0.f;
#pragma unroll
        for (int jj = 0; jj < 4; ++jj) p = fmaf(fmaxf(acc[ql * 4 + jj], 0.f), w4[ql][jj], p);
        s[ql] = p + __shfl_xor(p, 32);
    }
}

__device__ __forceinline__ void quant_issue(const float* __restrict__ src, f32x4 (&v)[4], int lane) {
#pragma unroll
    for (int q = 0; q < 4; ++q) v[q] = *(const f32x4*)(src + lane * 16 + q * 4);
}
#ifndef PEER_BITS
#define PEER_BITS 4
#endif
#ifndef PEER_AMAX4
#define PEER_AMAX4 6.0f
#endif
constexpr int PEER_RB = PEER_BITS * 128;
#ifndef PEER_UVI
#define PEER_UVI 0
#endif
constexpr int PEER_RS = PEER_UVI ? 2 * PEER_RB : PEER_RB;
#if PEER_BITS == 4
__device__ __forceinline__ unsigned enc_e2m1(float x) {
    const float a = fabsf(x);
    const float c = a < 2.f ? rintf(a * 2.f) : (a < 4.f ? rintf(a) + 2.f : fminf(rintf(a * 0.5f) + 4.f, 7.f));
    return (unsigned)c | (x < 0.f ? 8u : 0u);
}
__device__ __forceinline__ void quant_finish(const f32x4 (&v)[4], unsigned char* __restrict__ dst, float* __restrict__ scale, int lane) {
    float am = 0.f;
#pragma unroll
    for (int q = 0; q < 4; ++q) am = fmaxf(am, fmaxf(fmaxf(fabsf(v[q][0]), fabsf(v[q][1])), fmaxf(fabsf(v[q][2]), fabsf(v[q][3]))));
#pragma unroll
    for (int o = 1; o < 64; o <<= 1) am = fmaxf(am, __shfl_xor(am, o));
    const float inv = am > 0.f ? PEER_AMAX4 / am : 0.f;
    u32x2 w; w.x = 0u; w.y = 0u;
#pragma unroll
    for (int i = 0; i < 8; ++i) { w.x |= enc_e2m1(v[i >> 2][i & 3] * inv) << (4 * i); w.y |= enc_e2m1(v[2 + (i >> 2)][i & 3] * inv) << (4 * i); }
    *(u32x2*)(dst + lane * 8) = w;
    if (lane == 0) *scale = am * (1.f / PEER_AMAX4);
}
#elif PEER_BITS == 6
__device__ __forceinline__ unsigned enc_e2m3(float x) {
    const float a = fabsf(x), q = a * 8.f;
    const float c = a < 2.f ? rintf(q) : (a < 4.f ? rintf(q * 0.5f) + 8.f : fminf(rintf(q * 0.25f) + 16.f, 31.f));
    return (unsigned)c | (x < 0.f ? 32u : 0u);
}
__device__ __forceinline__ void quant_finish(const f32x4 (&v)[4], unsigned char* __restrict__ dst, float* __restrict__ scale, int lane) {
    float am = 0.f;
#pragma unroll
    for (int q = 0; q < 4; ++q) am = fmaxf(am, fmaxf(fmaxf(fabsf(v[q][0]), fabsf(v[q][1])), fmaxf(fabsf(v[q][2]), fabsf(v[q][3]))));
#pragma unroll
    for (int o = 1; o < 64; o <<= 1) am = fmaxf(am, __shfl_xor(am, o));
    const float inv = am > 0.f ? 7.5f / am : 0.f;
    unsigned long long lo = 0ull, hi = 0ull;
#pragma unroll
    for (int i = 0; i < 16; ++i) {
        const unsigned long long c = enc_e2m3(v[i >> 2][i & 3] * inv);
        if (i < 10) lo |= c << (6 * i);
        else if (i == 10) { lo |= (c & 15ull) << 60; hi |= c >> 4; }
        else hi |= c << (6 * (i - 11) + 2);
    }
    unsigned* d = (unsigned*)(dst + lane * 12);
    d[0] = (unsigned)lo; d[1] = (unsigned)(lo >> 32); d[2] = (unsigned)hi;
    if (lane == 0) *scale = am * (1.f / 7.5f);
}
#else
__device__ __forceinline__ void quant_finish(const f32x4 (&v)[4], unsigned char* __restrict__ dst, float* __restrict__ scale, int lane) {
    float am = 0.f;
#pragma unroll
    for (int q = 0; q < 4; ++q) am = fmaxf(am, fmaxf(fmaxf(fabsf(v[q][0]), fabsf(v[q][1])), fmaxf(fabsf(v[q][2]), fabsf(v[q][3]))));
#pragma unroll
    for (int o = 1; o < 64; o <<= 1) am = fmaxf(am, __shfl_xor(am, o));
    const float inv = am > 0.f ? 448.f / am : 0.f;
    u32x4 w;
#pragma unroll
    for (int q = 0; q < 4; ++q) { int x = __builtin_amdgcn_cvt_pk_fp8_f32(v[q][0] * inv, v[q][1] * inv, 0, false); x = __builtin_amdgcn_cvt_pk_fp8_f32(v[q][2] * inv, v[q][3] * inv, x, true); w[q] = (unsigned)x; }
    *(u32x4*)(dst + lane * 16) = w;
    if (lane == 0) *scale = am * (1.f / 448.f);
}
#endif
struct QuantTabs { const float* pu; const float* pv; unsigned char* uq; unsigned char* vq; float* us; float* vs;
    __device__ __forceinline__ const float* src(int r) const { return r < 2 * 16384 ? pu + (size_t)r * D : pv + (size_t)(r - 2 * 16384) * D; }
    __device__ __forceinline__ unsigned char* dst(int r) const {
#if PEER_UVI
        return r < 2 * 16384 ? uq + (size_t)r * PEER_RS : uq + (size_t)(r - 2 * 16384) * PEER_RS + PEER_RB;
#else
        return r < 2 * 16384 ? uq + (size_t)r * PEER_RB : vq + (size_t)(r - 2 * 16384) * PEER_RB;
#endif
    }
    __device__ __forceinline__ float* sc(int r) const { return r < 2 * 16384 ? us + r : vs + (r - 2 * 16384); } };

__device__ __forceinline__ void phase_score(const bf16* __restrict__ QIb, const bf16* __restrict__ KIb, const float* __restrict__ WIf, const float* __restrict__ cache_ki, const int* __restrict__ page_table,
                                            float* __restrict__ SC, float* __restrict__ SCS, const QuantTabs QT_, LAS unsigned char* lds, int vcu, int G, int wave, int lane, int gw, int NGW) {
    const int c = lane & 31, kq = lane >> 5;
    int qrow = gw;
    constexpr int KST = 144, KBUF = 256 * KST;
    const int tid = wave * 64 + lane;
    for (int it = vcu; it < 512; it += G) {
        const int b = it >> 8, qt = b == 0 ? (it & 255) : 255 - (it & 255);
        const size_t tok0 = (size_t)b * SEQ + qt * 32 + wave * 4;
        bf16x8 afr[4]; f32x4 w4[4];
        score_load_q(QIb, WIf, tok0, lane, afr, w4);
        const int nc = (qt >> 3) + 1;
        const bf16* kbase = KIb + (size_t)b * SEQ * 64;
        u32x4 st[4];
#pragma unroll
        for (int i = 0; i < 4; ++i) { const int p = tid + i * 512; st[i] = *(const u32x4*)(kbase + (size_t)(p >> 3) * 64 + (p & 7) * 8); }
#pragma unroll
        for (int i = 0; i < 4; ++i) { const int p = tid + i * 512; *(LAS u32x4*)(lds + (p >> 3) * KST + (p & 7) * 16) = st[i]; }
        __syncthreads();
        for (int ch = 0; ch < nc; ++ch) {
            const bool more = ch + 1 < nc;
            f32x4 qv[4]; const bool qdo = qrow < 4 * 16384;
            if (qdo) quant_issue(QT_.src(qrow), qv, lane);
            if (more) {
#pragma unroll
                for (int i = 0; i < 4; ++i) { const int p = tid + i * 512; st[i] = *(const u32x4*)(kbase + ((size_t)(ch + 1) * 256 + (p >> 3)) * 64 + (p & 7) * 8); }
            }
            LAS unsigned char* kb = lds + (ch & 1) * KBUF;
            const int ntile = more ? 8 : (qt & 7) + 1;
            for (int kt8 = 0; kt8 < ntile; ++kt8) {
                bf16x8 bfr[4];
#pragma unroll
                for (int ks = 0; ks < 4; ++ks) bfr[ks] = *(LAS bf16x8*)(kb + (kt8 * 32 + c) * KST + ks * 32 + kq * 16);
                float sv[4]; score_tile(afr, bfr, w4, sv);
                float* o = SC + (tok0 + 2 * kq) * SEQ + (ch * 8 + kt8) * 32 + c;
                o[0] = kq ? sv[2] : sv[0]; o[SEQ] = kq ? sv[3] : sv[1];
            }
            if (qdo) { quant_finish(qv, QT_.dst(qrow), QT_.sc(qrow), lane); qrow += NGW; }
            if (more) {
                LAS unsigned char* nb = lds + ((ch + 1) & 1) * KBUF;
#pragma unroll
                for (int i = 0; i < 4; ++i) { const int p = tid + i * 512; *(LAS u32x4*)(nb + (p >> 3) * KST + (p & 7) * 16) = st[i]; }
            }
            __syncthreads();
        }
    }
    for (; qrow < 4 * 16384; qrow += NGW) { f32x4 qv[4]; quant_issue(QT_.src(qrow), qv, lane); quant_finish(qv, QT_.dst(qrow), QT_.sc(qrow), lane); }
    for (int it = gw; it < DB * NPAGES + DB; it += NGW) {
        const bool isnew = it >= DB * NPAGES;
        const int b = isnew ? it - DB * NPAGES : it / NPAGES, pg = isnew ? 0 : it % NPAGES;
        const size_t tok0 = (size_t)TP + b * DS;
        bf16x8 afr[4]; f32x4 w4[4];
        score_load_q(QIb, WIf, tok0, lane, afr, w4);
        if (!isnew) {
            const int phys = page_table[b * NPAGES + pg];
            for (int j = 0; j < 4; ++j) {
                const float* kp = cache_ki + ((size_t)phys * PAGE + j * 32 + c) * 64 + kq * 8;
                bf16x8 bfr[4];
#pragma unroll
                for (int ks = 0; ks < 4; ++ks) { const f32x4 x0 = *(const f32x4*)(kp + ks * 16), x1 = *(const f32x4*)(kp + ks * 16 + 4); const u32x4 w = pack8(x0, x1); bfr[ks] = __builtin_bit_cast(bf16x8, w); }
                float s[4]; score_tile(afr, bfr, w4, s);
                float* o = SCS + (size_t)(b * DS + 2 * kq) * SCS_LD + pg * PAGE + j * 32 + c;
                o[0] = kq ? s[2] : s[0]; o[SCS_LD] = kq ? s[3] : s[1];
            }
        } else {
            const bf16* kp = KIb + (tok0 + (c & 3)) * 64 + kq * 8;
            bf16x8 bfr[4];
#pragma unroll
            for (int ks = 0; ks < 4; ++ks) bfr[ks] = *(const bf16x8*)(kp + ks * 16);
            float s[4]; score_tile(afr, bfr, w4, s);
            if (c < 4) { float* o = SCS + (size_t)(b * DS + 2 * kq) * SCS_LD + PAST + c; o[0] = kq ? s[2] : s[0]; o[SCS_LD] = kq ? s[3] : s[1]; }
        }
    }
}

constexpr int VST = 144;
__device__ __forceinline__ bf16x8 ld_frag8(const bf16* p) { return *(const bf16x8*)p; }
__device__ __forceinline__ bf16x8 ld_frag8(const float* p) { const f32x4 a = *(const f32x4*)p, b = *(const f32x4*)(p + 4); const u32x4 w = pack8(a, b); return __builtin_bit_cast(bf16x8, w); }
__device__ __forceinline__ s16x4 lds_tr(LAS unsigned char* p) { return __builtin_bit_cast(s16x4, __builtin_amdgcn_ds_read_tr16_b64_v4i16((LAS v4i16_t*)p)); }

template <bool SAMPLE>
__device__ __forceinline__ void attn_row(int row, int n0, int n1, const bf16* __restrict__ Qb, const int* __restrict__ IDX, const int* __restrict__ CNT,
                                         const bf16* __restrict__ Kb, const bf16* __restrict__ Vb, const float* __restrict__ cache_k, const float* __restrict__ cache_v,
                                         const float* __restrict__ newk, const float* __restrict__ newv, const int* __restrict__ page_table,
                                         bf16* __restrict__ Ob, LAS unsigned char* wl, int lane) {
    const int fr = lane & 15, fq = lane >> 4;
    LAS int* rid = (LAS int*)wl;
    LAS unsigned char* vt = wl + 1024;
    const int cnt = CNT[row];
    const int b = SAMPLE ? (row - TP) / DS : row / SEQ;
#pragma unroll
    for (int i = 0; i < 4; ++i) { const int slot = i * 64 + lane; int key = slot < cnt ? IDX[(size_t)row * TOPK + slot] : 0; int id;
        if (!SAMPLE) id = b * SEQ + key;
        else if (key < PAST) id = page_table[b * NPAGES + key / PAGE] * PAGE + (key % PAGE);
        else id = (int)0x80000000 | (b * DS + (key - PAST));
        rid[slot] = id; }
    asm volatile("s_waitcnt lgkmcnt(0)" ::: "memory");
    for (int n = n0; n < n1; ++n) {
        bf16x8 qf[2];
#pragma unroll
        for (int ks = 0; ks < 2; ++ks) qf[ks] = *(const bf16x8*)(Qb + (size_t)row * 1024 + (n * 4 + (fr & 3)) * 64 + ks * 32 + fq * 8);
        f32x4 st[16];
        constexpr int TBN = SAMPLE ? 4 : 8;
#pragma unroll
        for (int tb = 0; tb < 16 / TBN; ++tb) {
            bf16x8 kf[TBN][2];
#pragma unroll
            for (int t = 0; t < TBN; ++t) {
                const int id = rid[(tb * TBN + t) * 16 + fr];
                if (!SAMPLE) { const bf16* kp = Kb + (size_t)id * 256 + n * 64 + fq * 8; kf[t][0] = ld_frag8(kp); kf[t][1] = ld_frag8(kp + 32); }
                else { const float* kp = (id < 0 ? newk + (size_t)(id & 0x7fffffff) * 256 : cache_k + (size_t)id * 256) + n * 64 + fq * 8; kf[t][0] = ld_frag8(kp); kf[t][1] = ld_frag8(kp + 32); }
            }
#pragma unroll
            for (int t = 0; t < TBN; ++t) {
                f32x4 a = (f32x4){0.f, 0.f, 0.f, 0.f};
                a = __builtin_amdgcn_mfma_f32_16x16x32_bf16(kf[t][0], qf[0], a, 0, 0, 0);
                a = __builtin_amdgcn_mfma_f32_16x16x32_bf16(kf[t][1], qf[1], a, 0, 0, 0);
                st[tb * TBN + t] = a;
            }
            asm volatile("" ::: "memory");
        }
        bf16x8 vreg[8];
#define ATT_VLOAD(ch_) do { _Pragma("unroll") for (int i = 0; i < 8; ++i) { const int sl = i * 8 + (lane >> 3), chunk = lane & 7; const int id = rid[(ch_) * 64 + sl]; \
            if (!SAMPLE) vreg[i] = ld_frag8(Vb + (size_t)id * 256 + n * 64 + chunk * 8); \
            else vreg[i] = ld_frag8((id < 0 ? newv + (size_t)(id & 0x7fffffff) * 256 : cache_v + (size_t)id * 256) + n * 64 + chunk * 8); } } while (0)
        ATT_VLOAD(0);
        float mx = -INFINITY;
#pragma unroll
        for (int t = 0; t < 16; ++t)
#pragma unroll
            for (int j = 0; j < 4; ++j) { const int slot = t * 16 + fq * 4 + j; const float v = slot < cnt ? st[t][j] * 0.125f : -INFINITY; st[t][j] = v; mx = fmaxf(mx, v); }
        mx = fmaxf(mx, __shfl_xor(mx, 16)); mx = fmaxf(mx, __shfl_xor(mx, 32));
        float sum = 0.f;
#pragma unroll
        for (int t = 0; t < 16; ++t)
#pragma unroll
            for (int j = 0; j < 4; ++j) { const float e = __expf(st[t][j] - mx); st[t][j] = e; sum += e; }
        sum += __shfl_xor(sum, 16); sum += __shfl_xor(sum, 32);
        f32x4 oacc[4];
#pragma unroll
        for (int dt = 0; dt < 4; ++dt) oacc[dt] = (f32x4){0.f, 0.f, 0.f, 0.f};
#pragma unroll
        for (int ch = 0; ch < 4; ++ch) {
#pragma unroll
            for (int i = 0; i < 8; ++i) { const int sl = i * 8 + (lane >> 3), chunk = lane & 7; *(LAS bf16x8*)(vt + sl * VST + chunk * 16) = vreg[i]; }
            asm volatile("s_waitcnt lgkmcnt(0)" ::: "memory");
            if (ch < 3) ATT_VLOAD(ch + 1);
#pragma unroll
            for (int s2 = 0; s2 < 2; ++s2) {
                const int t0 = ch * 4 + s2 * 2;
                const u32x4 pw = pack8(st[t0], st[t0 + 1]);
                const bf16x8 pf = __builtin_bit_cast(bf16x8, pw);
#pragma unroll
                for (int dt = 0; dt < 4; ++dt) {
                    LAS unsigned char* a0 = vt + (s2 * 32 + fq * 4 + (fr >> 2)) * VST + (dt * 16 + 4 * (fr & 3)) * 2;
                    const s16x4 v0 = lds_tr(a0), v1 = lds_tr(a0 + 16 * VST);
                    bf16x8 vf; vf[0] = v0[0]; vf[1] = v0[1]; vf[2] = v0[2]; vf[3] = v0[3]; vf[4] = v1[0]; vf[5] = v1[1]; vf[6] = v1[2]; vf[7] = v1[3];
                    oacc[dt] = __builtin_amdgcn_mfma_f32_16x16x32_bf16(pf, vf, oacc[dt], 0, 0, 0);
                }
            }
            asm volatile("s_waitcnt lgkmcnt(0)" ::: "memory");
        }
#undef ATT_VLOAD
        const float i0 = 1.f / __shfl(sum, 0), i1 = 1.f / __shfl(sum, 1), i2 = 1.f / __shfl(sum, 2), i3 = 1.f / __shfl(sum, 3);
        if (fq == 0) {
#pragma unroll
            for (int dt = 0; dt < 4; ++dt) {
                bf16* o = Ob + (size_t)row * 1024 + (n * 4) * 64 + dt * 16 + fr;
                o[0] = (bf16)f2bf(oacc[dt][0] * i0); o[64] = (bf16)f2bf(oacc[dt][1] * i1); o[128] = (bf16)f2bf(oacc[dt][2] * i2); o[192] = (bf16)f2bf(oacc[dt][3] * i3);
            }
        }
    }
    asm volatile("s_waitcnt lgkmcnt(0)" ::: "memory");
}

__device__ __forceinline__ void kv8_convert(const bf16* __restrict__ Kb, const bf16* __restrict__ Vb, unsigned char* __restrict__ KV8_, const unsigned* __restrict__ amaxk, const unsigned* __restrict__ amaxv, int gw, int NGW, int lane) {
    const float ak = __builtin_bit_cast(float, __hip_atomic_load(amaxk, __ATOMIC_RELAXED, __HIP_MEMORY_SCOPE_AGENT)), av = __builtin_bit_cast(float, __hip_atomic_load(amaxv, __ATOMIC_RELAXED, __HIP_MEMORY_SCOPE_AGENT));
    const bool isv = lane >= 32; const int l = lane & 31;
    const float sc = isv ? (av > 0.f ? 448.f / av : 0.f) : (ak > 0.f ? 448.f / ak : 0.f);
    for (int t = gw; t < TP; t += NGW) {
        const u32x4 w = *(const u32x4*)((isv ? Vb : Kb) + (size_t)t * 256 + l * 8);
        const float x0 = bflo(w.x) * sc, x1 = bfhi(w.x) * sc, x2 = bflo(w.y) * sc, x3 = bfhi(w.y) * sc, x4 = bflo(w.z) * sc, x5 = bfhi(w.z) * sc, x6 = bflo(w.w) * sc, x7 = bfhi(w.w) * sc;
        int p0 = __builtin_amdgcn_cvt_pk_fp8_f32(x0, x1, 0, false); p0 = __builtin_amdgcn_cvt_pk_fp8_f32(x2, x3, p0, true);
        int p1 = __builtin_amdgcn_cvt_pk_fp8_f32(x4, x5, 0, false); p1 = __builtin_amdgcn_cvt_pk_fp8_f32(x6, x7, p1, true);
        const int n = l >> 3, d0 = (l & 7) * 8;
        const int pos = isv ? 64 + d0 : ((d0 & 31) >> 3) * 16 + (d0 >> 5) * 8;
        u32x2 o; o.x = (unsigned)p0; o.y = (unsigned)p1;
        *(u32x2*)(KV8_ + (size_t)t * 512 + n * 128 + pos) = o;
    }
}
__device__ __forceinline__ void fp8x16_to_bf16(const u32x4 q, bf16x8& lo, bf16x8& hi) {
    u32x4 a, b;
#pragma unroll
    for (int w = 0; w < 4; ++w) { const f32x2v f0 = __builtin_amdgcn_cvt_pk_f32_fp8((int)q[w], false), f1 = __builtin_amdgcn_cvt_pk_f32_fp8((int)q[w], true);
        const unsigned u0 = pk2(f0[0], f0[1]), u1 = pk2(f1[0], f1[1]);
        if (w < 2) { a[2 * w] = u0; a[2 * w + 1] = u1; } else { b[2 * w - 4] = u0; b[2 * w - 3] = u1; } }
    lo = __builtin_bit_cast(bf16x8, a); hi = __builtin_bit_cast(bf16x8, b);
}
#ifndef KF1
#define KF1 10
#endif
__device__ __forceinline__ void attn_prompt_stream(int b, int n, int q0, int qstep, const bf16* __restrict__ Qb, const int* __restrict__ IDX, const unsigned char* __restrict__ KV8_, const unsigned* __restrict__ amaxk, const unsigned* __restrict__ amaxv,
                                                   bf16* __restrict__ Ob, LAS unsigned char* wl, int lane) {
    const float ak_ = __builtin_bit_cast(float, __hip_atomic_load(amaxk, __ATOMIC_RELAXED, __HIP_MEMORY_SCOPE_AGENT)), av_ = __builtin_bit_cast(float, __hip_atomic_load(amaxv, __ATOMIC_RELAXED, __HIP_MEMORY_SCOPE_AGENT));
    const float kinv = ak_ * (1.f / 448.f), vinv = av_ * (1.f / 448.f);
    const int fr = lane & 15, fq = lane >> 4;
    LAS int* ridb = (LAS int*)wl;
    LAS unsigned char* vt = wl + 2048;
    if (q0 >= SEQ) return;
    int vx[4];
    { const int row = b * SEQ + q0, cnt = q0 + 1 < TOPK ? q0 + 1 : TOPK;
#pragma unroll
      for (int i = 0; i < 4; ++i) { const int slot = i * 64 + lane; ridb[slot] = b * SEQ + (slot < cnt ? IDX[(size_t)row * TOPK + slot] : 0); } }
    int buf = 0;

    for (int q = q0; q < SEQ; q += qstep, buf ^= 1) {

        const int row = b * SEQ + q, cnt = q + 1 < TOPK ? q + 1 : TOPK;
        LAS int* rid = ridb + buf * 256;
        asm volatile("s_waitcnt lgkmcnt(0)" ::: "memory");
        int kx[16];
#pragma unroll
        for (int t = 0; t < 16; ++t) kx[t] = rid[t * 16 + fr];
        bf16x8 qf[2];
#pragma unroll
        for (int ks = 0; ks < 2; ++ks) qf[ks] = *(const bf16x8*)(Qb + (size_t)row * 1024 + (n * 4 + (fr & 3)) * 64 + ks * 32 + fq * 8);
        u32x4 kraw[16];
#pragma unroll
        for (int t = 0; t < 16; ++t) kraw[t] = *(const u32x4*)(KV8_ + (size_t)kx[t] * 512 + n * 128 + fq * 16);
        asm volatile("s_waitcnt lgkmcnt(0)" ::: "memory");
        u32x4 vraw[4];
#define ATT_VLOAD2(ch_) do { _Pragma("unroll") for (int i = 0; i < 4; ++i) { const int sl = i * 16 + (lane >> 2), piece = lane & 3; const int id = rid[(ch_) * 64 + sl]; \
            vraw[i] = *(const u32x4*)(KV8_ + (size_t)id * 512 + n * 128 + 64 + piece * 16); } } while (0)
        f32x4 st[16];
#pragma unroll
        for (int t = 0; t < 16; ++t) {
            asm volatile("" : "+v"(kraw[t][0]), "+v"(kraw[t][1]), "+v"(kraw[t][2]), "+v"(kraw[t][3]));
            bf16x8 k0, k1; fp8x16_to_bf16(kraw[t], k0, k1);
            f32x4 a = (f32x4){0.f, 0.f, 0.f, 0.f};
            a = __builtin_amdgcn_mfma_f32_16x16x32_bf16(k0, qf[0], a, 0, 0, 0);
            a = __builtin_amdgcn_mfma_f32_16x16x32_bf16(k1, qf[1], a, 0, 0, 0);
            st[t] = a;
            asm volatile("" : "+v"(st[t][0]), "+v"(st[t][1]), "+v"(st[t][2]), "+v"(st[t][3]));
        }

        const int qn = q + qstep;
        if (qn < SEQ) { const int rown = b * SEQ + qn, cntn = qn + 1 < TOPK ? qn + 1 : TOPK;
#pragma unroll
            for (int i = 0; i < 4; ++i) { const int slot = i * 64 + lane; vx[i] = slot < cntn ? IDX[(size_t)rown * TOPK + slot] : 0; } }
        ATT_VLOAD2(0);
        float mx = -INFINITY;
        if (cnt < TOPK) {
#pragma unroll
            for (int t = 0; t < 16; ++t)
#pragma unroll
                for (int j = 0; j < 4; ++j) { const int slot = t * 16 + fq * 4 + j; st[t][j] = slot < cnt ? st[t][j] : -INFINITY; }
        }
#pragma unroll
        for (int t = 0; t < 16; ++t) mx = fmaxf(mx, fmaxf(fmaxf(st[t][0], st[t][1]), fmaxf(st[t][2], st[t][3])));
        mx = fmaxf(mx, __shfl_xor(mx, 16)); mx = fmaxf(mx, __shfl_xor(mx, 32));
        const float cs = 0.18033688011112042f * kinv, mb = -mx * cs;
        float sum = 0.f;
#pragma unroll
        for (int t = 0; t < 16; ++t)
#pragma unroll
            for (int j = 0; j < 4; ++j) { const float e = __builtin_amdgcn_exp2f(fmaf(st[t][j], cs, mb)); st[t][j] = e; sum += e; }
        sum += __shfl_xor(sum, 16); sum += __shfl_xor(sum, 32);

        f32x4 oacc[4];
#pragma unroll
        for (int dt = 0; dt < 4; ++dt) oacc[dt] = (f32x4){0.f, 0.f, 0.f, 0.f};
#pragma unroll
        for (int ch = 0; ch < 4; ++ch) {
#pragma unroll
            for (int i = 0; i < 4; ++i) { const int sl = i * 16 + (lane >> 2), piece = lane & 3; bf16x8 v0, v1; fp8x16_to_bf16(vraw[i], v0, v1);
                *(LAS bf16x8*)(vt + sl * VST + piece * 32) = v0; *(LAS bf16x8*)(vt + sl * VST + piece * 32 + 16) = v1; }
            asm volatile("s_waitcnt lgkmcnt(0)" ::: "memory");
            if (ch < 3) ATT_VLOAD2(ch + 1);
#pragma unroll
            for (int s2 = 0; s2 < 2; ++s2) {
                const int t0 = ch * 4 + s2 * 2;
                const u32x4 pw = pack8(st[t0], st[t0 + 1]);
                const bf16x8 pf = __builtin_bit_cast(bf16x8, pw);
#pragma unroll
                for (int dt = 0; dt < 4; ++dt) {
                    LAS unsigned char* a0 = vt + (s2 * 32 + fq * 4 + (fr >> 2)) * VST + (dt * 16 + 4 * (fr & 3)) * 2;
                    const s16x4 v0 = lds_tr(a0), v1 = lds_tr(a0 + 16 * VST);
                    bf16x8 vf; vf[0] = v0[0]; vf[1] = v0[1]; vf[2] = v0[2]; vf[3] = v0[3]; vf[4] = v1[0]; vf[5] = v1[1]; vf[6] = v1[2]; vf[7] = v1[3];
                    oacc[dt] = __builtin_amdgcn_mfma_f32_16x16x32_bf16(pf, vf, oacc[dt], 0, 0, 0);
                }
            }
            asm volatile("s_waitcnt lgkmcnt(0)" ::: "memory");
        }
#undef ATT_VLOAD2

        const float i0 = vinv / __shfl(sum, 0), i1 = vinv / __shfl(sum, 1), i2 = vinv / __shfl(sum, 2), i3 = vinv / __shfl(sum, 3);
        if (fq == 0) {
#pragma unroll
            for (int dt = 0; dt < 4; ++dt) {
                bf16* o = Ob + (size_t)row * 1024 + (n * 4) * 64 + dt * 16 + fr;
                o[0] = (bf16)f2bf(oacc[dt][0] * i0); o[64] = (bf16)f2bf(oacc[dt][1] * i1); o[128] = (bf16)f2bf(oacc[dt][2] * i2); o[192] = (bf16)f2bf(oacc[dt][3] * i3);
            }
        }
        if (qn < SEQ) {
#pragma unroll
            for (int i = 0; i < 4; ++i) ridb[(buf ^ 1) * 256 + i * 64 + lane] = vx[i] + b * SEQ;
        }

    }

    asm volatile("s_waitcnt lgkmcnt(0)" ::: "memory");
}

__device__ __forceinline__ void ln_row_wave(const bf16* __restrict__ zrow, const float* __restrict__ g, const float* __restrict__ bt, float* __restrict__ of, bf16* __restrict__ ob, int lane) {
    f32x4 v[4]; float s = 0.f;
#pragma unroll
    for (int j = 0; j < 4; ++j) { const u32x2 w = *(const u32x2*)(zrow + 256 * j + 4 * lane); v[j] = (f32x4){bflo(w.x), bfhi(w.x), bflo(w.y), bfhi(w.y)}; s += (v[j][0] + v[j][1]) + (v[j][2] + v[j][3]); }
#pragma unroll
    for (int o = 1; o < 64; o <<= 1) s += __shfl_xor(s, o);
    const float mean = s * (1.f / D); float q = 0.f;
#pragma unroll
    for (int j = 0; j < 4; ++j) { v[j] = v[j] - mean; q += (v[j][0] * v[j][0] + v[j][1] * v[j][1]) + (v[j][2] * v[j][2] + v[j][3] * v[j][3]); }
#pragma unroll
    for (int o = 1; o < 64; o <<= 1) q += __shfl_xor(q, o);
    const float rstd = rsqrtf(q * (1.f / D) + LN_EPS);
#pragma unroll
    for (int j = 0; j < 4; ++j) { const f32x4 gg = *(const f32x4*)(g + 256 * j + 4 * lane), bb = *(const f32x4*)(bt + 256 * j + 4 * lane); const f32x4 o = v[j] * rstd * gg + bb;
        if (of) *(f32x4*)(of + 256 * j + 4 * lane) = o; u32x2 w; w.x = pk2(o[0], o[1]); w.y = pk2(o[2], o[3]); *(u32x2*)(ob + 256 * j + 4 * lane) = w; }
}

struct FResid {
    const float* rp; const float* rs; bf16* Z;
    __device__ __forceinline__ const float* rrow(int row) const { return row < TP ? rp + (size_t)row * D : rs + (size_t)(row - TP) * D; }
    __device__ __forceinline__ void put8(int row, int col, f32x4 v0, f32x4 v1) const { const float* r = rrow(row) + col;
        *(u32x4*)(Z + (size_t)row * D + col) = pack8(v0 + ALPHA * *(const f32x4*)r, v1 + ALPHA * *(const f32x4*)(r + 4)); }
    __device__ __forceinline__ void put4(int row, int col, f32x4 v) const { const f32x4 z = v + ALPHA * *(const f32x4*)(rrow(row) + col); u32x2 w; w.x = pk2(z[0], z[1]); w.y = pk2(z[2], z[3]); *(u32x2*)(Z + (size_t)row * D + col) = w; }
};
struct FResidB {
    const bf16* rp; const bf16* rs; bf16* Z;
    __device__ __forceinline__ const bf16* rrow(int row) const { return row < TP ? rp + (size_t)row * D : rs + (size_t)(row - TP) * D; }
    __device__ __forceinline__ void put8(int row, int col, f32x4 v0, f32x4 v1) const { const u32x4 r = *(const u32x4*)(rrow(row) + col);
        const f32x4 r0 = (f32x4){bflo(r.x), bfhi(r.x), bflo(r.y), bfhi(r.y)}, r1 = (f32x4){bflo(r.z), bfhi(r.z), bflo(r.w), bfhi(r.w)};
        *(u32x4*)(Z + (size_t)row * D + col) = pack8(v0 + ALPHA * r0, v1 + ALPHA * r1); }
    __device__ __forceinline__ void put4(int row, int col, f32x4 v) const { const u32x2 r = *(const u32x2*)(rrow(row) + col); const f32x4 z = v + ALPHA * (f32x4){bflo(r.x), bfhi(r.x), bflo(r.y), bfhi(r.y)};
        u32x2 w; w.x = pk2(z[0], z[1]); w.y = pk2(z[2], z[3]); *(u32x2*)(Z + (size_t)row * D + col) = w; }
};
}

namespace mk {
template <int CAP>
__device__ __forceinline__ void topk_wave_regs(const float* __restrict__ row, int n, int* __restrict__ out, LAS unsigned* hist, LAS float* cv, LAS int* ci, LAS unsigned char* lst, int lane) {
    if (n <= TOPK) { for (int i = lane; i < TOPK; i += 64) out[i] = i < n ? i : 0; return; }

    constexpr int NCH = 32;
    const int nch = n > 8192 ? 32 : (n + 255) >> 8;
    float vx = (lane < 4 && 8192 + lane < n) ? row[8192 + lane] : -INFINITY;
    f32x4 v[NCH];
#pragma unroll
    for (int j = 0; j < NCH; ++j) {
        if (j < nch) v[j] = *(const f32x4*)(row + j * 256 + lane * 4);
        else v[j] = (f32x4){-INFINITY, -INFINITY, -INFINITY, -INFINITY};
    }
    float mn = INFINITY, mx = -INFINITY;
#pragma unroll
    for (int j = 0; j < NCH; ++j) {
        if (j < nch) {
            const int base = j * 256 + lane * 4;
#pragma unroll
            for (int e = 0; e < 4; ++e) { const bool ok = base + e < n; const float x = v[j][e]; v[j][e] = ok ? x : -INFINITY; mx = fmaxf(mx, ok ? x : -INFINITY); mn = fminf(mn, ok ? x : INFINITY); }
        }
    }
    if (vx != -INFINITY) { mx = fmaxf(mx, vx); mn = fminf(mn, vx); }
#pragma unroll
    for (int o = 1; o < 64; o <<= 1) { mn = fminf(mn, __shfl_xor(mn, o)); mx = fmaxf(mx, __shfl_xor(mx, o)); }
    if (!(mx > mn)) { for (int i = lane; i < TOPK; i += 64) out[i] = i; return; }
    const float scale = 2048.0f / (mx - mn);

#pragma unroll
    for (int i = 0; i < 8; ++i) *(LAS u32x4*)(hist + i * 256 + lane * 4) = (u32x4){0u, 0u, 0u, 0u};
    asm volatile("s_waitcnt lgkmcnt(0)" ::: "memory");
#pragma unroll
    for (int j = 0; j < NCH; ++j) {
        if (j < nch) {
            asm volatile("" : "+v"(v[j][0]), "+v"(v[j][1]), "+v"(v[j][2]), "+v"(v[j][3]));
#pragma unroll
            for (int e = 0; e < 4; ++e) { const float x = v[j][e]; int bn = (int)((x - mn) * scale); bn = bn > 2047 ? 2047 : bn; bn = x != -INFINITY ? bn : 2048;
                __hip_atomic_fetch_add(hist + bn, 1u, __ATOMIC_RELAXED, __HIP_MEMORY_SCOPE_WAVEFRONT); }
        }
    }
    if (vx != -INFINITY) { int bn = (int)((vx - mn) * scale); bn = bn > 2047 ? 2047 : bn; __hip_atomic_fetch_add(hist + bn, 1u, __ATOMIC_RELAXED, __HIP_MEMORY_SCOPE_WAVEFRONT); }
    asm volatile("s_waitcnt lgkmcnt(0)" ::: "memory");

    unsigned mine = 0u;
#pragma unroll
    for (int i = 0; i < 8; ++i) { const u32x4 h4 = *(LAS u32x4*)(hist + lane * 32 + i * 4); mine += (h4.x + h4.y) + (h4.z + h4.w); }
    unsigned suf = mine;
#pragma unroll
    for (int o = 1; o < 64; o <<= 1) { const unsigned t = __shfl_down(suf, o); if (lane + o < 64) suf += t; }
    const unsigned long long bal = __ballot(suf >= (unsigned)TOPK);
    const int Lt = 63 - __builtin_clzll(bal);
    const unsigned above = __shfl(suf, Lt) - __shfl(mine, Lt);
    const unsigned hb = hist[Lt * 32 + (lane & 31)];
    unsigned sfx = hb;
#pragma unroll
    for (int o = 1; o < 32; o <<= 1) { const unsigned t = __shfl_down(sfx, o); if ((lane & 31) + o < 32) sfx += t; }
    const unsigned long long okm = __ballot(above + sfx >= (unsigned)TOPK) & 0xFFFFFFFFull;
    const int jb = 63 - __builtin_clzll(okm);
    const int B = Lt * 32 + jb;
    const unsigned running = above + __shfl(sfx, jb) - __shfl(hb, jb);
    const int cnt_gt = (int)running, r = TOPK - cnt_gt;

    int base_gt = 0, base_eq = 0;
    const unsigned long long below = (1ull << lane) - 1ull;
    int lane4 = lane * 4; asm volatile("" : "+v"(lane4));
#pragma unroll
    for (int j = 0; j < NCH; ++j) {
        if (j < nch) {
#pragma unroll
            for (int e = 0; e < 4; ++e) {
                const float x = v[j][e]; int bn = (int)((x - mn) * scale); bn = bn > 2047 ? 2047 : bn; bn = x != -INFINITY ? bn : -1;
                const bool gt = bn > B, eq = bn == B;
                const unsigned long long mg = __ballot(gt), me = __ballot(eq);
                if (mg | me) {
                    const int idx = lane4 + (j * 256 + e);
                    if (gt) out[base_gt + __builtin_popcountll(mg & below)] = idx;
                    if (eq) { const int p = base_eq + __builtin_popcountll(me & below); if (p < CAP) { cv[p] = x; ci[p] = idx; } }
                    base_gt += __builtin_popcountll(mg); base_eq += __builtin_popcountll(me);
                }
            }
        }
    }
    if (n > 8192) {
        const float x = vx; bool gt = false, eq = false;
        if (x != -INFINITY) { int bn = (int)((x - mn) * scale); bn = bn > 2047 ? 2047 : bn; gt = bn > B; eq = bn == B; }
        const unsigned long long mg = __ballot(gt), me = __ballot(eq);
        const int idx = 8192 + lane;
        if (gt) out[base_gt + __builtin_popcountll(mg & below)] = idx;
        if (eq) { const int p = base_eq + __builtin_popcountll(me & below); if (p < CAP) { cv[p] = x; ci[p] = idx; } }
        base_gt += __builtin_popcountll(mg); base_eq += __builtin_popcountll(me);
    }
    asm volatile("s_waitcnt vmcnt(0) lgkmcnt(0)" ::: "memory");

    const int m = base_eq < CAP ? base_eq : CAP;
    if (m <= 64) {
        const float x = lane < m ? cv[lane] : -INFINITY; const int id = lane < m ? ci[lane] : 0x7fffffff; int rank = 0;
        for (int c2 = 0; c2 < m; ++c2) { const float x2 = __builtin_bit_cast(float, __builtin_amdgcn_readlane(__builtin_bit_cast(int, x), c2)); const int id2 = __builtin_amdgcn_readlane(id, c2);
            rank += (x2 > x || (x2 == x && id2 < id)) ? 1 : 0; }
        if (lane < m && rank < r) out[cnt_gt + rank] = id;
    } else {
        for (int c = lane; c < m; c += 64) {
            const float x = cv[c]; const int id = ci[c]; int rank = 0;
            for (int c2 = 0; c2 < m; ++c2) { const float x2 = cv[c2]; const int id2 = ci[c2]; rank += (x2 > x || (x2 == x && id2 < id)) ? 1 : 0; }
            if (rank < r) out[cnt_gt + rank] = id;
        }
    }
    asm volatile("s_waitcnt lgkmcnt(0)" ::: "memory");

}

__device__ __forceinline__ void phase_topk2(const float* __restrict__ SC, const float* __restrict__ SCS, int* __restrict__ IDX, int* __restrict__ CNT,
                                            const float* __restrict__ peer_u_, const float* __restrict__ peer_v_, unsigned char* __restrict__ Uq_, unsigned char* __restrict__ Vq_, float* __restrict__ Usc_, float* __restrict__ Vsc_,
                                            LAS unsigned char* lds, unsigned* qhead, int wave, int lane, int gw, int NGW, int jlo = 0, int jhi = TA) {
    constexpr int CAP = 1020;
    LAS unsigned* hist = (LAS unsigned*)(lds + wave * 16384);
    LAS float* cv = (LAS float*)(lds + wave * 16384 + 8208);
    LAS int* ci = (LAS int*)(lds + wave * 16384 + 8208 + 4080);
    LAS unsigned char* lst = nullptr;

    for (int j = gw; j < TA; j += NGW) {
        if (j < jlo || j >= jhi) continue;
        int row, n; const float* rp;
        if (j < TP) { const int b = j >> 13, jj = j & 8191, blk = jj >> 11; const int q = blk < 2 ? jj : blk * 2048 + 2047 - (jj & 2047);
            row = b * SEQ + q; n = q + 1; rp = SC + (size_t)row * SEQ; }
        else { const int r = j - TP; row = j; n = PAST + (r % DS) + 1; rp = SCS + (size_t)r * SCS_LD; }

        topk_wave_regs<CAP>(rp, n, IDX + (size_t)row * TOPK, hist, cv, ci, lst, lane);

        if (lane == 0) CNT[row] = n < TOPK ? n : TOPK;
    }

}
}

namespace mk {
using bf16x2_t = __attribute__((ext_vector_type(2))) __bf16;
__device__ __forceinline__ float dot2bf(unsigned a, unsigned b, float acc) { return __builtin_amdgcn_fdot2_f32_bf16(__builtin_bit_cast(bf16x2_t, a), __builtin_bit_cast(bf16x2_t, b), acc, false); }

struct FStoreBf16 {
    bf16* O; int ld;
    __device__ __forceinline__ void put8(int row, int col, f32x4 v0, f32x4 v1) const { *(u32x4*)(O + (size_t)row * ld + col) = pack8(v0, v1); }
    __device__ __forceinline__ void put4(int row, int col, f32x4 v) const { u32x2 w; w.x = pk2(v[0], v[1]); w.y = pk2(v[2], v[3]); *(u32x2*)(O + (size_t)row * ld + col) = w; }
};

#ifndef PGS
#define PGS 8
#endif
#ifndef PEER_UMFMA
#define PEER_UMFMA 0
#endif
#ifndef PEER_XFMT
#define PEER_XFMT 4
#endif
constexpr int PEER_TAB_OFF = LDSCTL_OFF + 1024;

__device__ __forceinline__ void ce_desc(unsigned& a, unsigned& b) { const unsigned hi = a > b ? a : b, lo = a > b ? b : a; a = hi; b = lo; }
template <int N> __device__ __forceinline__ void bitonic_sort_desc(unsigned (&k)[N]) {
#pragma unroll
    for (int size = 2; size <= N; size <<= 1)
#pragma unroll
        for (int stride = size >> 1; stride > 0; stride >>= 1)
#pragma unroll
            for (int i = 0; i < N; ++i) { const int j = i ^ stride; if (j > i) { if ((i & size) == 0) ce_desc(k[i], k[j]); else ce_desc(k[j], k[i]); } }
}
template <int N> __device__ __forceinline__ void bitonic_merge_desc(unsigned (&k)[N]) {
#pragma unroll
    for (int stride = N >> 1; stride > 0; stride >>= 1)
#pragma unroll
        for (int i = 0; i < N; ++i) { const int j = i ^ stride; if (j > i) ce_desc(k[i], k[j]); }
}
__device__ __forceinline__ void top16_merge(unsigned (&a)[16], const unsigned (&b)[16]) {
#pragma unroll
    for (int i = 0; i < 16; ++i) a[i] = a[i] > b[15 - i] ? a[i] : b[15 - i];
    bitonic_merge_desc<16>(a);
}
__device__ __forceinline__ void top16_xlane(unsigned (&a)[16], int o) {
    unsigned b[16];
#pragma unroll
    for (int i = 0; i < 16; ++i) b[i] = (unsigned)__shfl_xor((int)a[i], o);
    top16_merge(a, b);
}
__device__ __forceinline__ unsigned f2ord(float f) { const unsigned u = __builtin_bit_cast(unsigned, f); return u ^ ((u >> 31) ? 0xFFFFFFFFu : 0x80000000u); }
__device__ __forceinline__ float ord2f(unsigned o) { const unsigned u = o ^ ((o >> 31) ? 0x80000000u : 0xFFFFFFFFu); return __builtin_bit_cast(float, u); }

__device__ __forceinline__ void phase_peer_select(const bf16* __restrict__ PQb, const bf16* __restrict__ K1, const bf16* __restrict__ K2, unsigned short* __restrict__ teid_g, float* __restrict__ tgate_g,
                                                  LAS unsigned char* lds, int vcu, int G, int wave, int lane) {
    const int fr = lane & 15, fq = lane >> 4, h = wave;
    LAS unsigned char* itab = lds + wave * 1024;
    for (int tile = vcu; tile < TA / 16; tile += G) {
        const int tok0 = tile * 16;
        unsigned tk[2][16];
#pragma unroll
        for (int half = 0; half < 2; ++half) {
            const bf16* ap = PQb + (size_t)(tok0 + fr) * PEER_N + h * 256 + half * 128 + fq * 8;
            bf16x8 a[4];
#pragma unroll
            for (int ks = 0; ks < 4; ++ks) a[ks] = *(const bf16x8*)(ap + ks * 32);
            const bf16* kb = (half ? K2 : K1) + (size_t)fr * 128 + fq * 8;
            unsigned k0[16], k1[16];
#pragma unroll
            for (int ct = 0; ct < 8; ++ct) {
                f32x4 acc = (f32x4){0.f, 0.f, 0.f, 0.f};
#pragma unroll
                for (int ks = 0; ks < 4; ++ks) { const bf16x8 b = *(const bf16x8*)(kb + (size_t)ct * 16 * 128 + ks * 32); acc = __builtin_amdgcn_mfma_f32_16x16x32_bf16(b, a[ks], acc, 0, 0, 0); }
#pragma unroll
                for (int j = 0; j < 4; ++j) { const unsigned key = (f2ord(acc[j]) & 0xFFFFFF80u) | (unsigned)(127 - (ct * 16 + 4 * fq + j));
                    if (ct < 4) k0[ct * 4 + j] = key; else k1[(ct - 4) * 4 + j] = key; }
                if (ct & 1) asm volatile("" ::: "memory");
            }
            bitonic_sort_desc<16>(k0); bitonic_sort_desc<16>(k1);
            top16_merge(k0, k1); top16_xlane(k0, 16); top16_xlane(k0, 32);
#pragma unroll
            for (int i = 0; i < 16; ++i) tk[half][i] = k0[i];
        }
        if (fq == 0) {
#pragma unroll
            for (int i = 0; i < 16; ++i) { itab[fr * 32 + i] = (unsigned char)(127 - (tk[0][i] & 0x7Fu)); itab[fr * 32 + 16 + i] = (unsigned char)(127 - (tk[1][i] & 0x7Fu)); }
        }
        unsigned ck[16];
        {
            float v1[16], v2[16];
#pragma unroll
            for (int i = 0; i < 16; ++i) { v1[i] = ord2f(tk[0][i] & 0xFFFFFF80u); v2[i] = ord2f(tk[1][i] & 0xFFFFFF80u); }
            int c = 0;
#pragma unroll
            for (int i = 0; i < 16; ++i)
#pragma unroll
                for (int j = 0; j < 16; ++j) {
                    if ((i + 1) * (j + 1) <= 16) {
                        const unsigned key = (f2ord(v1[i] + v2[j]) & 0xFFFFFF00u) | (unsigned)(255 - (i * 16 + j));
                        const int m = c >> 2, pt = c & 3;
                        if (pt == 0) ck[m] = key; else ck[m] = fq == pt ? key : ck[m];
                        ++c;
                    }
                }
            ck[12] = fq < 2 ? ck[12] : 0u; ck[13] = 0u; ck[14] = 0u; ck[15] = 0u;
        }
        bitonic_sort_desc<16>(ck); top16_xlane(ck, 16); top16_xlane(ck, 32);
        asm volatile("s_waitcnt lgkmcnt(0)" ::: "memory");
        float ev[16]; float sum = 0.f; const float mxv = ord2f(ck[0] & 0xFFFFFF00u);
#pragma unroll
        for (int k = 0; k < 16; ++k) { ev[k] = __expf(ord2f(ck[k] & 0xFFFFFF00u) - mxv); sum += ev[k]; }
        const float inv = 1.f / sum;
#pragma unroll
        for (int k = 0; k < 16; ++k) {
            if ((k >> 2) == fq) {
                const int f = 255 - (int)(ck[k] & 0xFFu); const int id = (int)itab[fr * 32 + (f >> 4)] * 128 + (int)itab[fr * 32 + 16 + (f & 15)];
                teid_g[(size_t)(tok0 + fr) * 128 + h * 16 + k] = (unsigned short)id; tgate_g[(size_t)(tok0 + fr) * 128 + h * 16 + k] = ev[k] * inv;
            }
        }
        asm volatile("s_waitcnt lgkmcnt(0)" ::: "memory");
    }
}

#if PEER_BITS == 4
__device__ __forceinline__ u32x4 prow_load(const unsigned char* __restrict__ T, int id, int lane) { const u32x2 r = *(const u32x2*)(T + (size_t)id * PEER_RS + lane * 8); u32x4 t; t.x = r.x; t.y = r.y; t.z = 0u; t.w = 0u; return t; }
#define PROW_LOAD(T, id) prow_load(T, id, lane)
#elif PEER_BITS == 6
typedef unsigned v6u_t __attribute__((ext_vector_type(6)));
typedef float v32f_t __attribute__((ext_vector_type(32)));
__device__ __forceinline__ u32x4 prow_load(const unsigned char* __restrict__ T, int id, int lane) { const unsigned* rp = (const unsigned*)(T + (size_t)id * PEER_RB + lane * 12); u32x4 t; t.x = rp[0]; t.y = rp[1]; t.z = rp[2]; t.w = 0u; return t; }
#define PROW_LOAD(T, id) prow_load(T, id, lane)
#else
#define PROW_LOAD(T, id) (*(const u32x4*)((T) + (size_t)(id) * D + lane * 16))
#endif
#define SHX_(v_, o_) __builtin_bit_cast(float, __builtin_amdgcn_ds_bpermute((lane ^ (o_)) << 2, __builtin_bit_cast(int, (float)(v_))))
__device__ __forceinline__ void phase_peer_mix(const bf16* __restrict__ Zin, const float* __restrict__ g1, const float* __restrict__ b1, const unsigned short* __restrict__ teid, const float* __restrict__ tgate,
                                               const unsigned char* __restrict__ U, const unsigned char* __restrict__ V, const float* __restrict__ Us, const float* __restrict__ Vs, const float* __restrict__ g2, const float* __restrict__ b2,
                                               float* __restrict__ outf, bf16* __restrict__ outb, LAS unsigned char* wl, int gw, int NGW, int lane_in) {

    for (int j = gw; j < TP + TS * 16; j += NGW) {
        int lane = lane_in; asm volatile("" : "+v"(lane));
        size_t tok;
        if (j < TP) tok = (size_t)j;
        else { const int s = j - TP; if ((s & 15) != 0) continue; tok = (size_t)TP + (s >> 4); }
        {
            float xf[16];
            { float s1 = 0.f;
#pragma unroll
              for (int q = 0; q < 2; ++q) { const u32x4 w = *(const u32x4*)(Zin + tok * D + lane * 16 + q * 8);
#pragma unroll
                  for (int i = 0; i < 4; ++i) { xf[q * 8 + 2 * i] = bflo(w[i]); xf[q * 8 + 2 * i + 1] = bfhi(w[i]); s1 += xf[q * 8 + 2 * i] + xf[q * 8 + 2 * i + 1]; } }
#pragma unroll
              for (int o = 1; o < 64; o <<= 1) s1 += SHX_(s1, o);
              const float mean1 = s1 * (1.f / D); float q1 = 0.f;
#pragma unroll
              for (int i = 0; i < 16; ++i) { xf[i] -= mean1; q1 += xf[i] * xf[i]; }
#pragma unroll
              for (int o = 1; o < 64; o <<= 1) q1 += SHX_(q1, o);
              const float rstd1 = rsqrtf(q1 * (1.f / D) + LN_EPS);
#pragma unroll
              for (int q = 0; q < 4; ++q) { const f32x4 gg = *(const f32x4*)(g1 + lane * 16 + q * 4), bb = *(const f32x4*)(b1 + lane * 16 + q * 4);
#pragma unroll
                  for (int i = 0; i < 4; ++i) xf[q * 4 + i] = xf[q * 4 + i] * rstd1 * gg[i] + bb[i]; } }
            float wv0 = 0.f, wv1 = 0.f;
#if PEER_BITS == 4 && PEER_UMFMA
            {
                typedef int v8i_t __attribute__((ext_vector_type(8)));
                const int n16 = lane & 15, kq = lane >> 4;
                unsigned idp[4];
#pragma unroll
                for (int t = 0; t < 4; ++t) idp[t] = (unsigned)teid[tok * 128 + t * 16 + n16] | ((unsigned)teid[tok * 128 + (t + 4) * 16 + n16] << 16);
                float am = 0.f;
#pragma unroll
                for (int i = 0; i < 16; ++i) am = fmaxf(am, fabsf(xf[i]));
#pragma unroll
                for (int o = 1; o < 64; o <<= 1) am = fmaxf(am, SHX_(am, o));
#if PEER_XFMT == 8
                const float xinv = am > 0.f ? 448.f / am : 0.f, sx = am * (1.f / 448.f);
                { u32x4 w;
#pragma unroll
                  for (int q = 0; q < 4; ++q) { int x = __builtin_amdgcn_cvt_pk_fp8_f32(xf[q * 4] * xinv, xf[q * 4 + 1] * xinv, 0, false); x = __builtin_amdgcn_cvt_pk_fp8_f32(xf[q * 4 + 2] * xinv, xf[q * 4 + 3] * xinv, x, true); w[q] = (unsigned)x; }
                  *(LAS u32x4*)(wl + lane * 16) = w; }
#else
                const float xinv = am > 0.f ? 6.f / am : 0.f, sx = am * (1.f / 6.f);
                { u32x2 whi, wlo; whi.x = 0u; whi.y = 0u; wlo.x = 0u; wlo.y = 0u;
#pragma unroll
                  for (int i = 0; i < 16; ++i) {
                      const float xs = xf[i] * xinv, a = fabsf(xs);
                      const float gq = a < 2.f ? rintf(a * 2.f) * 0.5f : (a < 4.f ? rintf(a) : fminf(6.f, 2.f * rintf(a * 0.5f)));
                      const unsigned chi = (unsigned)(gq < 2.f ? gq * 2.f : (gq < 4.f ? gq + 2.f : gq * 0.5f + 4.f)) | (xs < 0.f ? 8u : 0u);
                      const float r = (xs - (xs < 0.f ? -gq : gq)) * 4.f;
                      const unsigned clo = enc_e2m1(r);
                      if (i < 8) { whi.x |= chi << (4 * i); wlo.x |= clo << (4 * i); } else { whi.y |= chi << (4 * (i - 8)); wlo.y |= clo << (4 * (i - 8)); }
                  }
                  *(LAS u32x2*)(wl + lane * 8) = whi; *(LAS u32x2*)(wl + 512 + lane * 8) = wlo; }
#endif
#pragma unroll
                for (int q = 0; q < 4; ++q) *(LAS f32x4*)(wl + 1024 + q * 1024 + lane * 16) = (f32x4){xf[q * 4], xf[q * 4 + 1], xf[q * 4 + 2], xf[q * 4 + 3]};
                float h0 = 0.f, h1 = 0.f;
                u32x4 qb[3][4];
#define PU_TILE(u_) ((((u_) >> 3) << 2) | ((u_) & 3))
#define PU_HALF(u_) (((u_) >> 2) & 1)
#define PU_LOADU(u_) { const unsigned id_ = ((u_) >> 3) ? (idp[(u_) & 3] >> 16) : (idp[(u_) & 3] & 0xFFFFu); const unsigned char* rp_ = U + (size_t)id_ * PEER_RB + PU_HALF(u_) * 256 + kq * 16; _Pragma("unroll") for (int jj = 0; jj < 4; ++jj) qb[(u_) % 3][jj] = *(const u32x4*)(rp_ + jj * 64); }
                PU_LOADU(0) PU_LOADU(1)
#pragma unroll
                for (int g = 0; g < 2; ++g) {
                    f32x4 acc[4];
#pragma unroll
                    for (int t = 0; t < 4; ++t) acc[t] = (f32x4){0.f, 0.f, 0.f, 0.f};
#pragma unroll
                    for (int ph = 0; ph < 2; ++ph) {
#if PEER_XFMT == 8
                        v8i_t aop[4];
#pragma unroll
                        for (int jj = 0; jj < 4; ++jj) { const int j = ph * 4 + jj; const u32x4 a0 = *(const LAS u32x4*)(wl + j * 128 + kq * 32), a1 = *(const LAS u32x4*)(wl + j * 128 + kq * 32 + 16);
                            aop[jj] = (v8i_t){(int)a0.x, (int)a0.y, (int)a0.z, (int)a0.w, (int)a1.x, (int)a1.y, (int)a1.z, (int)a1.w}; }
#else
                        u32x4 ahi[4], alo[4];
#pragma unroll
                        for (int jj = 0; jj < 4; ++jj) { const int j = ph * 4 + jj; ahi[jj] = *(const LAS u32x4*)(wl + j * 64 + kq * 16); alo[jj] = *(const LAS u32x4*)(wl + 512 + j * 64 + kq * 16); }
#endif
#pragma unroll
                        for (int t = 0; t < 4; ++t) {
                            const int u = g * 8 + ph * 4 + t;
                            if (u + 2 < 16) PU_LOADU(u + 2)
                            asm volatile("" ::: "memory");
#pragma unroll
                            for (int jj = 0; jj < 4; ++jj) { const u32x4 b = qb[u % 3][jj]; const v8i_t bop = (v8i_t){(int)b.x, (int)b.y, (int)b.z, (int)b.w, 0, 0, 0, 0};
#if PEER_XFMT == 8
                                acc[t] = __builtin_amdgcn_mfma_scale_f32_16x16x128_f8f6f4(aop[jj], bop, acc[t], 0, 4, 0, 0x7f7f7f7f, 0, 0x7f7f7f7f); }
#else
                                const v8i_t ah = (v8i_t){(int)ahi[jj].x, (int)ahi[jj].y, (int)ahi[jj].z, (int)ahi[jj].w, 0, 0, 0, 0}, al = (v8i_t){(int)alo[jj].x, (int)alo[jj].y, (int)alo[jj].z, (int)alo[jj].w, 0, 0, 0, 0};
                                acc[t] = __builtin_amdgcn_mfma_scale_f32_16x16x128_f8f6f4(ah, bop, acc[t], 4, 4, 0, 0x7f7f7f7f, 0, 0x7f7f7f7f);
                                acc[t] = __builtin_amdgcn_mfma_scale_f32_16x16x128_f8f6f4(al, bop, acc[t], 4, 4, 0, 0x7d7d7d7d, 0, 0x7f7f7f7f); }
#endif
                        }
                    }
#pragma unroll
                    for (int t = 0; t < 4; ++t) { if (kq == t) { if (g == 0) h0 = acc[t][0]; else h1 = acc[t][0]; } }
                }
#undef PU_LOADU
#undef PU_TILE
#undef PU_HALF
                const int e0 = (int)teid[tok * 128 + lane], e1 = (int)teid[tok * 128 + 64 + lane];
                const float hd0 = h0 * sx * Us[e0], hd1 = h1 * sx * Us[e1];
                wv0 = 0.5f * hd0 * (1.f + erff(hd0 * 0.70710678118654752f)) * tgate[tok * 128 + lane] * Vs[e0];
                wv1 = 0.5f * hd1 * (1.f + erff(hd1 * 0.70710678118654752f)) * tgate[tok * 128 + 64 + lane] * Vs[e1];
            }
#else
#if PEER_UVI
            float y[16];
#pragma unroll
            for (int i = 0; i < 16; ++i) y[i] = 0.f;
#endif
#pragma unroll 1
            for (int bt = 0; bt < 2; ++bt) {
                const int eidv = (int)teid[tok * 128 + bt * 64 + lane];
                {
                float p[64];

                u32x4 qb[2][PGS];
#pragma unroll
                for (int i = 0; i < PGS; ++i) { const int id = __builtin_amdgcn_readlane(eidv, i); qb[0][i] = PROW_LOAD(U, id); }
#pragma unroll
                for (int g = 0; g < 64 / PGS; ++g) {
                    if (g < 64 / PGS - 1) {
#pragma unroll
                        for (int i = 0; i < PGS; ++i) { const int id = __builtin_amdgcn_readlane(eidv, (g + 1) * PGS + i); qb[(g + 1) & 1][i] = PROW_LOAD(U, id); }
                    }
                    asm volatile("" ::: "memory");
#if PEER_BITS == 4
#pragma unroll
                    for (int i = 0; i < PGS; ++i) {
                        f32x2v a2 = {0.f, 0.f};
#pragma unroll
                        for (int w = 0; w < 2; ++w) {
#define PU4(b) { const f32x2v f = __builtin_amdgcn_cvt_scalef32_pk_f32_fp4(qb[g & 1][i][w], 1.0f, b); const f32x2v xx = {xf[w * 8 + b * 2], xf[w * 8 + b * 2 + 1]}; a2 = __builtin_elementwise_fma(f, xx, a2); }
                            PU4(0) PU4(1) PU4(2) PU4(3)
#undef PU4
                        }
                        p[g * PGS + i] = a2[0] + a2[1];
                        __builtin_amdgcn_sched_barrier(0);
                    }
#elif PEER_BITS == 6
#pragma unroll
                    for (int i = 0; i < PGS; i += 2) {
                        const v6u_t pk = {qb[g & 1][i][0], qb[g & 1][i][1], qb[g & 1][i][2], qb[g & 1][i + 1][0], qb[g & 1][i + 1][1], qb[g & 1][i + 1][2]};
                        const v32f_t f = __builtin_amdgcn_cvt_scalef32_pk32_f32_fp6(pk, 1.0f);
                        float a0 = 0.f, a1 = 0.f;
#pragma unroll
                        for (int k = 0; k < 16; ++k) { a0 = fmaf(f[k], xf[k], a0); a1 = fmaf(f[16 + k], xf[k], a1); }
                        p[g * PGS + i] = a0; p[g * PGS + i + 1] = a1;
                        __builtin_amdgcn_sched_barrier(0);
                    }
#else
#pragma unroll
                    for (int i = 0; i < PGS; ++i) {
                        float a = 0.f;
#pragma unroll
                        for (int w = 0; w < 4; ++w) { const f32x2v lo = __builtin_amdgcn_cvt_pk_f32_fp8((int)qb[g & 1][i][w], false), hi = __builtin_amdgcn_cvt_pk_f32_fp8((int)qb[g & 1][i][w], true);
                            a = fmaf(lo[0], xf[w * 4], a); a = fmaf(lo[1], xf[w * 4 + 1], a); a = fmaf(hi[0], xf[w * 4 + 2], a); a = fmaf(hi[1], xf[w * 4 + 3], a); }
                        p[g * PGS + i] = a;
                        __builtin_amdgcn_sched_barrier(0);
                    }
#endif
                }

#pragma unroll
                for (int o = 32; o >= 1; o >>= 1) {
                    const bool up = (lane & o) != 0;
#pragma unroll
                    for (int i = 0; i < o; ++i) { const float keep = up ? p[i + o] : p[i], send = up ? p[i] : p[i + o]; p[i] = keep + SHX_(send, o); }
                }
                const float hdot = p[0] * Us[eidv];
                const float wv = 0.5f * hdot * (1.f + erff(hdot * 0.70710678118654752f)) * tgate[tok * 128 + bt * 64 + lane] * Vs[eidv];
                if (bt == 0) wv0 = wv; else wv1 = wv;

                }
#if PEER_UVI
                {
                const float wvv = bt == 0 ? wv0 : wv1;
                u32x4 qb[2][PGS];
#pragma unroll
                for (int i = 0; i < PGS; ++i) { const int id = __builtin_amdgcn_readlane(eidv, i); qb[0][i] = PROW_LOAD(V, id); }
#pragma unroll
                for (int g = 0; g < 64 / PGS; ++g) {
                    if (g < 64 / PGS - 1) {
#pragma unroll
                        for (int i = 0; i < PGS; ++i) { const int id = __builtin_amdgcn_readlane(eidv, (g + 1) * PGS + i); qb[(g + 1) & 1][i] = PROW_LOAD(V, id); }
                    }
                    asm volatile("" ::: "memory");
#if PEER_BITS == 4
#pragma unroll
                    for (int i = 0; i < PGS; ++i) {
                        const float w = __builtin_bit_cast(float, __builtin_amdgcn_readlane(__builtin_bit_cast(int, wvv), g * PGS + i));
                        asm volatile("" : "+v"(qb[g & 1][i][0]), "+v"(qb[g & 1][i][1]));
#pragma unroll
                        for (int k = 0; k < 2; ++k) {
#define PV4(b) { const f32x2v f = __builtin_amdgcn_cvt_scalef32_pk_f32_fp4(qb[g & 1][i][k], 1.0f, b); f32x2v yy = {y[k * 8 + b * 2], y[k * 8 + b * 2 + 1]}; const f32x2v ww = {w, w}; yy = __builtin_elementwise_fma(ww, f, yy); y[k * 8 + b * 2] = yy[0]; y[k * 8 + b * 2 + 1] = yy[1]; }
                            PV4(0) PV4(1) PV4(2) PV4(3)
#undef PV4
                        }
                        asm volatile("" : "+v"(y[0]), "+v"(y[1]), "+v"(y[2]), "+v"(y[3]), "+v"(y[4]), "+v"(y[5]), "+v"(y[6]), "+v"(y[7]), "+v"(y[8]), "+v"(y[9]), "+v"(y[10]), "+v"(y[11]), "+v"(y[12]), "+v"(y[13]), "+v"(y[14]), "+v"(y[15]));
                    }
#elif PEER_BITS == 6
#pragma unroll
                    for (int i = 0; i < PGS; i += 2) {
                        const float w0 = __builtin_bit_cast(float, __builtin_amdgcn_readlane(__builtin_bit_cast(int, wvv), g * PGS + i)), w1 = __builtin_bit_cast(float, __builtin_amdgcn_readlane(__builtin_bit_cast(int, wvv), g * PGS + i + 1));
                        asm volatile("" : "+v"(qb[g & 1][i][0]), "+v"(qb[g & 1][i][1]), "+v"(qb[g & 1][i][2]), "+v"(qb[g & 1][i + 1][0]), "+v"(qb[g & 1][i + 1][1]), "+v"(qb[g & 1][i + 1][2]));
                        const v6u_t pk = {qb[g & 1][i][0], qb[g & 1][i][1], qb[g & 1][i][2], qb[g & 1][i + 1][0], qb[g & 1][i + 1][1], qb[g & 1][i + 1][2]};
                        const v32f_t f = __builtin_amdgcn_cvt_scalef32_pk32_f32_fp6(pk, 1.0f);
#pragma unroll
                        for (int k = 0; k < 16; ++k) { y[k] = fmaf(w0, f[k], y[k]); y[k] = fmaf(w1, f[16 + k], y[k]); }
                        asm volatile("" : "+v"(y[0]), "+v"(y[1]), "+v"(y[2]), "+v"(y[3]), "+v"(y[4]), "+v"(y[5]), "+v"(y[6]), "+v"(y[7]), "+v"(y[8]), "+v"(y[9]), "+v"(y[10]), "+v"(y[11]), "+v"(y[12]), "+v"(y[13]), "+v"(y[14]), "+v"(y[15]));
                    }
#else
#pragma unroll
                    for (int i = 0; i < PGS; ++i) {
                        const float w = __builtin_bit_cast(float, __builtin_amdgcn_readlane(__builtin_bit_cast(int, wvv), g * PGS + i));
                        asm volatile("" : "+v"(qb[g & 1][i][0]), "+v"(qb[g & 1][i][1]), "+v"(qb[g & 1][i][2]), "+v"(qb[g & 1][i][3]));
#pragma unroll
                        for (int k = 0; k < 4; ++k) { const f32x2v lo = __builtin_amdgcn_cvt_pk_f32_fp8((int)qb[g & 1][i][k], false), hi = __builtin_amdgcn_cvt_pk_f32_fp8((int)qb[g & 1][i][k], true);
                            y[k * 4] = fmaf(w, lo[0], y[k * 4]); y[k * 4 + 1] = fmaf(w, lo[1], y[k * 4 + 1]); y[k * 4 + 2] = fmaf(w, hi[0], y[k * 4 + 2]); y[k * 4 + 3] = fmaf(w, hi[1], y[k * 4 + 3]); }
                        asm volatile("" : "+v"(y[0]), "+v"(y[1]), "+v"(y[2]), "+v"(y[3]), "+v"(y[4]), "+v"(y[5]), "+v"(y[6]), "+v"(y[7]), "+v"(y[8]), "+v"(y[9]), "+v"(y[10]), "+v"(y[11]), "+v"(y[12]), "+v"(y[13]), "+v"(y[14]), "+v"(y[15]));
                    }
#endif
                }
                            }
#endif
            }
#endif

#if !PEER_UVI
            float y[16];
#pragma unroll
            for (int i = 0; i < 16; ++i) y[i] = 0.f;
#endif
#if !PEER_UVI
#pragma unroll 1
            for (int bt = 0; bt < 2; ++bt) {
                const int eidv = (int)teid[tok * 128 + bt * 64 + lane]; const float wvv = bt == 0 ? wv0 : wv1;
                u32x4 qb[2][PGS];
#pragma unroll
                for (int i = 0; i < PGS; ++i) { const int id = __builtin_amdgcn_readlane(eidv, i); qb[0][i] = PROW_LOAD(V, id); }
#pragma unroll
                for (int g = 0; g < 64 / PGS; ++g) {
                    if (g < 64 / PGS - 1) {
#pragma unroll
                        for (int i = 0; i < PGS; ++i) { const int id = __builtin_amdgcn_readlane(eidv, (g + 1) * PGS + i); qb[(g + 1) & 1][i] = PROW_LOAD(V, id); }
                    }
                    asm volatile("" ::: "memory");
#if PEER_BITS == 4
#pragma unroll
                    for (int i = 0; i < PGS; ++i) {
                        const float w = __builtin_bit_cast(float, __builtin_amdgcn_readlane(__builtin_bit_cast(int, wvv), g * PGS + i));
                        asm volatile("" : "+v"(qb[g & 1][i][0]), "+v"(qb[g & 1][i][1]));
#pragma unroll
                        for (int k = 0; k < 2; ++k) {
#define PV4(b) { const f32x2v f = __builtin_amdgcn_cvt_scalef32_pk_f32_fp4(qb[g & 1][i][k], 1.0f, b); f32x2v yy = {y[k * 8 + b * 2], y[k * 8 + b * 2 + 1]}; const f32x2v ww = {w, w}; yy = __builtin_elementwise_fma(ww, f, yy); y[k * 8 + b * 2] = yy[0]; y[k * 8 + b * 2 + 1] = yy[1]; }
                            PV4(0) PV4(1) PV4(2) PV4(3)
#undef PV4
                        }
                        asm volatile("" : "+v"(y[0]), "+v"(y[1]), "+v"(y[2]), "+v"(y[3]), "+v"(y[4]), "+v"(y[5]), "+v"(y[6]), "+v"(y[7]), "+v"(y[8]), "+v"(y[9]), "+v"(y[10]), "+v"(y[11]), "+v"(y[12]), "+v"(y[13]), "+v"(y[14]), "+v"(y[15]));
                    }
#elif PEER_BITS == 6
#pragma unroll
                    for (int i = 0; i < PGS; i += 2) {
                        const float w0 = __builtin_bit_cast(float, __builtin_amdgcn_readlane(__builtin_bit_cast(int, wvv), g * PGS + i)), w1 = __builtin_bit_cast(float, __builtin_amdgcn_readlane(__builtin_bit_cast(int, wvv), g * PGS + i + 1));
                        asm volatile("" : "+v"(qb[g & 1][i][0]), "+v"(qb[g & 1][i][1]), "+v"(qb[g & 1][i][2]), "+v"(qb[g & 1][i + 1][0]), "+v"(qb[g & 1][i + 1][1]), "+v"(qb[g & 1][i + 1][2]));
                        const v6u_t pk = {qb[g & 1][i][0], qb[g & 1][i][1], qb[g & 1][i][2], qb[g & 1][i + 1][0], qb[g & 1][i + 1][1], qb[g & 1][i + 1][2]};
                        const v32f_t f = __builtin_amdgcn_cvt_scalef32_pk32_f32_fp6(pk, 1.0f);
#pragma unroll
                        for (int k = 0; k < 16; ++k) { y[k] = fmaf(w0, f[k], y[k]); y[k] = fmaf(w1, f[16 + k], y[k]); }
                        asm volatile("" : "+v"(y[0]), "+v"(y[1]), "+v"(y[2]), "+v"(y[3]), "+v"(y[4]), "+v"(y[5]), "+v"(y[6]), "+v"(y[7]), "+v"(y[8]), "+v"(y[9]), "+v"(y[10]), "+v"(y[11]), "+v"(y[12]), "+v"(y[13]), "+v"(y[14]), "+v"(y[15]));
                    }
#else
#pragma unroll
                    for (int i = 0; i < PGS; ++i) {
                        const float w = __builtin_bit_cast(float, __builtin_amdgcn_readlane(__builtin_bit_cast(int, wvv), g * PGS + i));
                        asm volatile("" : "+v"(qb[g & 1][i][0]), "+v"(qb[g & 1][i][1]), "+v"(qb[g & 1][i][2]), "+v"(qb[g & 1][i][3]));
#pragma unroll
                        for (int k = 0; k < 4; ++k) { const f32x2v lo = __builtin_amdgcn_cvt_pk_f32_fp8((int)qb[g & 1][i][k], false), hi = __builtin_amdgcn_cvt_pk_f32_fp8((int)qb[g & 1][i][k], true);
                            y[k * 4] = fmaf(w, lo[0], y[k * 4]); y[k * 4 + 1] = fmaf(w, lo[1], y[k * 4 + 1]); y[k * 4 + 2] = fmaf(w, hi[0], y[k * 4 + 2]); y[k * 4 + 3] = fmaf(w, hi[1], y[k * 4 + 3]); }
                        asm volatile("" : "+v"(y[0]), "+v"(y[1]), "+v"(y[2]), "+v"(y[3]), "+v"(y[4]), "+v"(y[5]), "+v"(y[6]), "+v"(y[7]), "+v"(y[8]), "+v"(y[9]), "+v"(y[10]), "+v"(y[11]), "+v"(y[12]), "+v"(y[13]), "+v"(y[14]), "+v"(y[15]));
                    }
#endif
                }
            }
#endif

#if PEER_BITS == 4 && PEER_UMFMA
            asm volatile("" ::: "memory");
#pragma unroll
            for (int q = 0; q < 4; ++q) { const f32x4 r = *(const LAS f32x4*)(wl + 1024 + q * 1024 + lane * 16); xf[q * 4] = r[0]; xf[q * 4 + 1] = r[1]; xf[q * 4 + 2] = r[2]; xf[q * 4 + 3] = r[3]; }
#endif
            float s = 0.f;
#pragma unroll
            for (int i = 0; i < 16; ++i) { y[i] = ALPHA * xf[i] + y[i]; s += y[i]; }
#pragma unroll
            for (int o = 1; o < 64; o <<= 1) s += SHX_(s, o);
            const float mean = s * (1.f / D); float qq = 0.f;
#pragma unroll
            for (int i = 0; i < 16; ++i) { y[i] -= mean; qq += y[i] * y[i]; }
#pragma unroll
            for (int o = 1; o < 64; o <<= 1) qq += SHX_(qq, o);
            const float rstd = rsqrtf(qq * (1.f / D) + LN_EPS);
            u32x4 ob0, ob1;
#pragma unroll
            for (int q = 0; q < 4; ++q) { const int col = lane * 16 + q * 4; const f32x4 gg = *(const f32x4*)(g2 + col), bb = *(const f32x4*)(b2 + col);
                f32x4 o;
#pragma unroll
                for (int i = 0; i < 4; ++i) o[i] = y[q * 4 + i] * rstd * gg[i] + bb[i];
                if (outf) *(f32x4*)(outf + tok * D + col) = o;
                const unsigned w0 = pk2(o[0], o[1]), w1 = pk2(o[2], o[3]);
                if (q == 0) { ob0.x = w0; ob0.y = w1; } else if (q == 1) { ob0.z = w0; ob0.w = w1; } else if (q == 2) { ob1.x = w0; ob1.y = w1; } else { ob1.z = w0; ob1.w = w1; } }
            if (outb) { *(u32x4*)(outb + tok * D + lane * 16) = ob0; *(u32x4*)(outb + tok * D + lane * 16 + 8) = ob1; }

        }
    }

}

#undef SHX_
#if PEER_BITS == 4
template <int MODE>
__device__ __forceinline__ void phase_peer_mix4(const float* __restrict__ Zin, const float* __restrict__ g1, const float* __restrict__ b1, const unsigned short* __restrict__ teid, const float* __restrict__ tgate,
                                                const unsigned char* __restrict__ U, const unsigned char* __restrict__ V, const float* __restrict__ Us, const float* __restrict__ Vs, const float* __restrict__ g2, const float* __restrict__ b2,
                                                float* __restrict__ outf, bf16* __restrict__ outb, float* __restrict__ WV, LAS unsigned char* wl, int gw, int NGW, int lane_in) {
    typedef int v8i_t __attribute__((ext_vector_type(8)));
#define SHX_(v_, o_) __builtin_bit_cast(float, __builtin_amdgcn_ds_bpermute((lane ^ (o_)) << 2, __builtin_bit_cast(int, (float)(v_))))
#define MIX_TOK(j_) ((j_) < TP ? (size_t)(j_) : (size_t)TP + (((j_) - TP) >> 4))
    int j = gw;
    f32x4 zr[4]; int ti0, ti1; float tg0, tg1;
    { const size_t tok = MIX_TOK(j);
#pragma unroll
      for (int q = 0; q < 4; ++q) zr[q] = *(const f32x4*)(Zin + tok * D + lane_in * 16 + q * 4);
      ti0 = (int)teid[tok * 128 + lane_in]; ti1 = (int)teid[tok * 128 + 64 + lane_in];
      const float* gsrc = MODE == 2 ? WV : tgate; tg0 = gsrc[tok * 128 + lane_in]; tg1 = gsrc[tok * 128 + 64 + lane_in]; }
    while (j >= 0) {
        int lane = lane_in; asm volatile("" : "+v"(lane));
        const size_t tok = MIX_TOK(j);
        int jn = -1;
        for (int c = j + NGW; c < TP + TS * 16; c += NGW) { if (c < TP || ((c - TP) & 15) == 0) { jn = c; break; } }
        const int n16 = lane & 15, kq = lane >> 4;
        const int e0 = ti0, e1 = ti1; const float gt0 = tg0, gt1 = tg1;
        float wv0 = gt0, wv1 = gt1;
        unsigned idp[4]; u32x4 qb[3][4]; float us0 = 0.f, us1 = 0.f, vs0 = 0.f, vs1 = 0.f;
#define PU_HALF(u_) (((u_) >> 2) & 1)
#define PU_LOADU(u_) { const unsigned id_ = ((u_) >> 3) ? (idp[(u_) & 3] >> 16) : (idp[(u_) & 3] & 0xFFFFu); const unsigned char* rp_ = U + (size_t)id_ * PEER_RB + PU_HALF(u_) * 256 + kq * 16; _Pragma("unroll") for (int jj = 0; jj < 4; ++jj) qb[(u_) % 3][jj] = *(const u32x4*)(rp_ + jj * 64); }
        if constexpr (MODE != 2) {
#pragma unroll
        for (int t = 0; t < 4; ++t) idp[t] = (unsigned)__builtin_amdgcn_ds_bpermute((t * 16 + n16) << 2, e0) | ((unsigned)__builtin_amdgcn_ds_bpermute((t * 16 + n16) << 2, e1) << 16);
        PU_LOADU(0) PU_LOADU(1)
        us0 = Us[e0]; us1 = Us[e1]; vs0 = Vs[e0]; vs1 = Vs[e1];
        }
        float xf[16];
        { float s1 = 0.f;
#pragma unroll
          for (int q = 0; q < 4; ++q) { const f32x4 r = zr[q]; xf[q * 4] = r[0]; xf[q * 4 + 1] = r[1]; xf[q * 4 + 2] = r[2]; xf[q * 4 + 3] = r[3]; s1 += (r[0] + r[1]) + (r[2] + r[3]); }
#pragma unroll
          for (int o = 1; o < 64; o <<= 1) s1 += SHX_(s1, o);
          const float mean1 = s1 * (1.f / D); float q1 = 0.f;
#pragma unroll
          for (int i = 0; i < 16; ++i) { xf[i] -= mean1; q1 += xf[i] * xf[i]; }
#pragma unroll
          for (int o = 1; o < 64; o <<= 1) q1 += SHX_(q1, o);
          const float rstd1 = rsqrtf(q1 * (1.f / D) + LN_EPS);
#pragma unroll
          for (int q = 0; q < 4; ++q) { const f32x4 gg = *(const f32x4*)(g1 + lane * 16 + q * 4), bb = *(const f32x4*)(b1 + lane * 16 + q * 4);
#pragma unroll
              for (int i = 0; i < 4; ++i) xf[q * 4 + i] = xf[q * 4 + i] * rstd1 * gg[i] + bb[i]; } }
        if constexpr (MODE != 2) {
        float am = 0.f;
#pragma unroll
        for (int i = 0; i < 16; ++i) am = fmaxf(am, fabsf(xf[i]));
#pragma unroll
        for (int o = 1; o < 64; o <<= 1) am = fmaxf(am, SHX_(am, o));
        const float xinv = am > 0.f ? 6.f / am : 0.f, sx = am * (1.f / 6.f);
        { u32x2 whi, wlo; whi.x = 0u; whi.y = 0u; wlo.x = 0u; wlo.y = 0u;
#pragma unroll
          for (int i = 0; i < 16; ++i) {
              const float xs = xf[i] * xinv, a = fabsf(xs);
              const float gq = a < 2.f ? rintf(a * 2.f) * 0.5f : (a < 4.f ? rintf(a) : fminf(6.f, 2.f * rintf(a * 0.5f)));
              const unsigned chi = (unsigned)(gq < 2.f ? gq * 2.f : (gq < 4.f ? gq + 2.f : gq * 0.5f + 4.f)) | (xs < 0.f ? 8u : 0u);
              const float r = (xs - (xs < 0.f ? -gq : gq)) * 4.f;
              const unsigned clo = enc_e2m1(r);
              if (i < 8) { whi.x |= chi << (4 * i); wlo.x |= clo << (4 * i); } else { whi.y |= chi << (4 * (i - 8)); wlo.y |= clo << (4 * (i - 8)); }
          }
          *(LAS u32x2*)(wl + lane * 8) = whi; *(LAS u32x2*)(wl + 512 + lane * 8) = wlo; }
        if constexpr (MODE == 0) {
#pragma unroll
        for (int q = 0; q < 4; ++q) *(LAS f32x4*)(wl + 1024 + q * 1024 + lane * 16) = (f32x4){xf[q * 4], xf[q * 4 + 1], xf[q * 4 + 2], xf[q * 4 + 3]}; }
        float h0 = 0.f, h1 = 0.f;
#pragma unroll
        for (int g = 0; g < 2; ++g) {
            f32x4 acc[4];
#pragma unroll
            for (int t = 0; t < 4; ++t) acc[t] = (f32x4){0.f, 0.f, 0.f, 0.f};
#pragma unroll
            for (int ph = 0; ph < 2; ++ph) {
                u32x4 ahi[4], alo[4];
#pragma unroll
                for (int jj = 0; jj < 4; ++jj) { const int jk = ph * 4 + jj; ahi[jj] = *(const LAS u32x4*)(wl + jk * 64 + kq * 16); alo[jj] = *(const LAS u32x4*)(wl + 512 + jk * 64 + kq * 16); }
#pragma unroll
                for (int t = 0; t < 4; ++t) {
                    const int u = g * 8 + ph * 4 + t;
                    if (u + 2 < 16) PU_LOADU(u + 2)
                    asm volatile("" ::: "memory");
#pragma unroll
                    for (int jj = 0; jj < 4; ++jj) { const u32x4 b = qb[u % 3][jj]; const v8i_t bop = (v8i_t){(int)b.x, (int)b.y, (int)b.z, (int)b.w, 0, 0, 0, 0};
                        const v8i_t ah = (v8i_t){(int)ahi[jj].x, (int)ahi[jj].y, (int)ahi[jj].z, (int)ahi[jj].w, 0, 0, 0, 0}, al = (v8i_t){(int)alo[jj].x, (int)alo[jj].y, (int)alo[jj].z, (int)alo[jj].w, 0, 0, 0, 0};
                        acc[t] = __builtin_amdgcn_mfma_scale_f32_16x16x128_f8f6f4(ah, bop, acc[t], 4, 4, 0, 0x7f7f7f7f, 0, 0x7f7f7f7f);
                        acc[t] = __builtin_amdgcn_mfma_scale_f32_16x16x128_f8f6f4(al, bop, acc[t], 4, 4, 0, 0x7d7d7d7d, 0, 0x7f7f7f7f); }
                }
            }
#pragma unroll
            for (int t = 0; t < 4; ++t) { if (kq == t) { if (g == 0) h0 = acc[t][0]; else h1 = acc[t][0]; } }
        }
        const float hd0 = h0 * sx * us0, hd1 = h1 * sx * us1;
        wv0 = 0.5f * hd0 * (1.f + erff(hd0 * 0.70710678118654752f)) * gt0 * vs0;
        wv1 = 0.5f * hd1 * (1.f + erff(hd1 * 0.70710678118654752f)) * gt1 * vs1;
        if constexpr (MODE == 1) { WV[tok * 128 + lane] = wv0; WV[tok * 128 + 64 + lane] = wv1; }
        }
#undef PU_LOADU
#undef PU_HALF
        if (jn >= 0) { const size_t tn = MIX_TOK(jn);
#pragma unroll
            for (int q = 0; q < 4; ++q) zr[q] = *(const f32x4*)(Zin + tn * D + lane * 16 + q * 4);
            ti0 = (int)teid[tn * 128 + lane]; ti1 = (int)teid[tn * 128 + 64 + lane];
            const float* gsrc = MODE == 2 ? WV : tgate; tg0 = gsrc[tn * 128 + lane]; tg1 = gsrc[tn * 128 + 64 + lane]; }
        if constexpr (MODE != 1) {
        float y[16];
#pragma unroll
        for (int i = 0; i < 16; ++i) y[i] = 0.f;
        {
            u32x2 qa[8], qc[8];
#define PV_LOAD(buf_, g_) { const int src_ = (g_) < 8 ? e0 : e1; _Pragma("unroll") for (int i = 0; i < 8; ++i) { const int id_ = __builtin_amdgcn_readlane(src_, ((g_) & 7) * 8 + i); buf_[i] = *(const u32x2*)(V + (size_t)id_ * PEER_RB + lane * 8); } }
#define PV4(bf_, b) { const f32x2v f = __builtin_amdgcn_cvt_scalef32_pk_f32_fp4(bf_[i][k], 1.0f, b); f32x2v yy = {y[k * 8 + b * 2], y[k * 8 + b * 2 + 1]}; const f32x2v ww = {w, w}; yy = __builtin_elementwise_fma(ww, f, yy); y[k * 8 + b * 2] = yy[0]; y[k * 8 + b * 2 + 1] = yy[1]; }
#define PV_COMP(buf_, g_) { const float wsrc_ = (g_) < 8 ? wv0 : wv1; _Pragma("unroll") for (int i = 0; i < 8; ++i) { \
            const float w = __builtin_bit_cast(float, __builtin_amdgcn_readlane(__builtin_bit_cast(int, wsrc_), ((g_) & 7) * 8 + i)); \
            asm volatile("" : "+v"(buf_[i][0]), "+v"(buf_[i][1])); \
            _Pragma("unroll") for (int k = 0; k < 2; ++k) { PV4(buf_, 0) PV4(buf_, 1) PV4(buf_, 2) PV4(buf_, 3) } \
            asm volatile("" : "+v"(y[0]), "+v"(y[1]), "+v"(y[2]), "+v"(y[3]), "+v"(y[4]), "+v"(y[5]), "+v"(y[6]), "+v"(y[7]), "+v"(y[8]), "+v"(y[9]), "+v"(y[10]), "+v"(y[11]), "+v"(y[12]), "+v"(y[13]), "+v"(y[14]), "+v"(y[15])); } }
            PV_LOAD(qa, 0)
#pragma unroll 1
            for (int p2 = 0; p2 < 8; ++p2) {
                PV_LOAD(qc, 2 * p2 + 1)
                asm volatile("" ::: "memory");
                PV_COMP(qa, 2 * p2)
                if (p2 < 7) PV_LOAD(qa, 2 * p2 + 2)
                asm volatile("" ::: "memory");
                PV_COMP(qc, 2 * p2 + 1)
            }
#undef PV_LOAD
#undef PV4
#undef PV_COMP
        }
        asm volatile("" ::: "memory");
        if constexpr (MODE == 0)
#pragma unroll
        for (int q = 0; q < 4; ++q) { const f32x4 r = *(const LAS f32x4*)(wl + 1024 + q * 1024 + lane * 16); xf[q * 4] = r[0]; xf[q * 4 + 1] = r[1]; xf[q * 4 + 2] = r[2]; xf[q * 4 + 3] = r[3]; }
        float s = 0.f;
#pragma unroll
        for (int i = 0; i < 16; ++i) { y[i] = ALPHA * xf[i] + y[i]; s += y[i]; }
#pragma unroll
        for (int o = 1; o < 64; o <<= 1) s += SHX_(s, o);
        const float mean = s * (1.f / D); float qq = 0.f;
#pragma unroll
        for (int i = 0; i < 16; ++i) { y[i] -= mean; qq += y[i] * y[i]; }
#pragma unroll
        for (int o = 1; o < 64; o <<= 1) qq += SHX_(qq, o);
        const float rstd = rsqrtf(qq * (1.f / D) + LN_EPS);
        u32x4 ob0, ob1;
#pragma unroll
        for (int q = 0; q < 4; ++q) { const int col = lane * 16 + q * 4; const f32x4 gg = *(const f32x4*)(g2 + col), bb = *(const f32x4*)(b2 + col);
            f32x4 o;
#pragma unroll
            for (int i = 0; i < 4; ++i) o[i] = y[q * 4 + i] * rstd * gg[i] + bb[i];
            *(f32x4*)(outf + tok * D + col) = o;
            const unsigned w0 = pk2(o[0], o[1]), w1 = pk2(o[2], o[3]);
            if (q == 0) { ob0.x = w0; ob0.y = w1; } else if (q == 1) { ob0.z = w0; ob0.w = w1; } else if (q == 2) { ob1.x = w0; ob1.y = w1; } else { ob1.z = w0; ob1.w = w1; } }
        if (outb) { *(u32x4*)(outb + tok * D + lane * 16) = ob0; *(u32x4*)(outb + tok * D + lane * 16 + 8) = ob1; }
        }
        j = jn;
    }
#undef SHX_
#undef MIX_TOK
}
#endif

__device__ __forceinline__ float peer_reduce16(float (&p)[16], int lane) {
#pragma unroll
    for (int o = 8; o >= 1; o >>= 1) { const bool up = (lane & (o * 4)) != 0;
#pragma unroll
        for (int k = 0; k < o; ++k) { const float keep = up ? p[k + o] : p[k], send = up ? p[k] : p[k + o]; p[k] = keep + __shfl_xor(send, o * 4); } }
    float tot = p[0];
    tot += __shfl_xor(tot, 2); tot += __shfl_xor(tot, 1);
    return tot;
}
__device__ __forceinline__ unsigned cvtpk_bf16_(float lo, float hi) { typedef __bf16 bf2 __attribute__((ext_vector_type(2))); f32x2v v = {lo, hi}; bf2 b = __builtin_convertvector(v, bf2); return __builtin_bit_cast(unsigned, b); }
__device__ __forceinline__ float peer_dot16b(const u32x4 q, const u32x4 x0, const u32x4 x1) {
    float a = 0.f;
#pragma unroll
    for (int w = 0; w < 4; ++w) { const f32x2v lo = __builtin_amdgcn_cvt_pk_f32_fp8((int)q[w], false), hi = __builtin_amdgcn_cvt_pk_f32_fp8((int)q[w], true);
        const unsigned xa = w < 2 ? x0[2 * w] : x1[2 * w - 4], xb = w < 2 ? x0[2 * w + 1] : x1[2 * w - 3];
        a = dot2bf(cvtpk_bf16_(lo[0], lo[1]), xa, a); a = dot2bf(cvtpk_bf16_(hi[0], hi[1]), xb, a); }
    return a;
}

__device__ __forceinline__ void peer_u_slice(int sl, int t_first, int t_step, const bf16* __restrict__ Hb, const unsigned short* __restrict__ teid, const unsigned char* __restrict__ U,
                                             float* __restrict__ HD, LAS unsigned char* wl, int lane) {
    LAS unsigned short* lst_e = (LAS unsigned short*)wl;
    LAS unsigned char* lst_s = wl + 512;
    const unsigned long long below = (1ull << lane) - 1ull;
    const int kk = (lane >> 2) & 15;
    if (t_first >= TA) return;
#define PU_BUILD(bsel, e0_, e1_, cnt_) do { const bool a0_ = ((e0_) >> 11) == sl, a1_ = ((e1_) >> 11) == sl; const unsigned long long m0_ = __ballot(a0_), m1_ = __ballot(a1_); \
        const int c0_ = __builtin_popcountll(m0_); cnt_ = c0_ + __builtin_popcountll(m1_); \
        if (a0_) { const int p_ = __builtin_popcountll(m0_ & below); lst_e[(bsel) * 128 + p_] = (unsigned short)(e0_); lst_s[(bsel) * 128 + p_] = (unsigned char)lane; } \
        if (a1_) { const int p_ = c0_ + __builtin_popcountll(m1_ & below); lst_e[(bsel) * 128 + p_] = (unsigned short)(e1_); lst_s[(bsel) * 128 + p_] = (unsigned char)(64 + lane); } } while (0)
#define PU_LOAD(bsel, cnt_, q_) do { _Pragma("unroll") for (int k = 0; k < 16; ++k) { if (k < (cnt_)) { const int id_ = __builtin_amdgcn_readfirstlane((int)lst_e[(bsel) * 128 + k]); q_[k] = *(const u32x4*)(U + (size_t)id_ * D + lane * 16); } } } while (0)
    int e0 = __builtin_nontemporal_load(teid + (size_t)t_first * 128 + lane), e1 = __builtin_nontemporal_load(teid + (size_t)t_first * 128 + 64 + lane);
    u32x4 xa0 = __builtin_nontemporal_load((const u32x4*)(Hb + (size_t)t_first * D + lane * 16)), xa1 = __builtin_nontemporal_load((const u32x4*)(Hb + (size_t)t_first * D + lane * 16 + 8));
    int cnt; PU_BUILD(0, e0, e1, cnt);
    asm volatile("s_waitcnt lgkmcnt(0)" ::: "memory");
    u32x4 q[16];
    PU_LOAD(0, cnt, q);
    int buf = 0;

    for (int t = t_first; t < TA; t += t_step, buf ^= 1) {
        const int tn = t + t_step; const bool hasn = tn < TA;
        u32x4 xb0 = xa0, xb1 = xa1; int f0 = 0, f1 = 0;
        if (hasn) { f0 = __builtin_nontemporal_load(teid + (size_t)tn * 128 + lane); f1 = __builtin_nontemporal_load(teid + (size_t)tn * 128 + 64 + lane);
            xb0 = __builtin_nontemporal_load((const u32x4*)(Hb + (size_t)tn * D + lane * 16)); xb1 = __builtin_nontemporal_load((const u32x4*)(Hb + (size_t)tn * D + lane * 16 + 8)); }

        float pr[16];
#pragma unroll
        for (int k = 0; k < 16; ++k) pr[k] = k < cnt ? peer_dot16b(q[k], xa0, xa1) : 0.f;

#pragma unroll 1
        for (int p0 = 16; p0 < cnt; p0 += 16) {
            u32x4 q2[16];
#pragma unroll
            for (int k = 0; k < 16; ++k) { if (p0 + k < cnt) { const int id_ = __builtin_amdgcn_readfirstlane((int)lst_e[buf * 128 + p0 + k]); q2[k] = *(const u32x4*)(U + (size_t)id_ * D + lane * 16); } }
            float pr2[16];
#pragma unroll
            for (int k = 0; k < 16; ++k) pr2[k] = p0 + k < cnt ? peer_dot16b(q2[k], xa0, xa1) : 0.f;
            const float tot2 = peer_reduce16(pr2, lane);
            if (p0 + kk < cnt && (lane & 3) == 0) __builtin_nontemporal_store(tot2, HD + (size_t)t * 128 + lst_s[buf * 128 + p0 + kk]);
        }

        int cntn = 0;
        if (hasn) { PU_BUILD(buf ^ 1, f0, f1, cntn); }
        asm volatile("s_waitcnt lgkmcnt(0)" ::: "memory");
        if (hasn) PU_LOAD(buf ^ 1, cntn, q);

        const float tot = peer_reduce16(pr, lane);
        if (kk < cnt && (lane & 3) == 0) __builtin_nontemporal_store(tot, HD + (size_t)t * 128 + lst_s[buf * 128 + kk]);
        xa0 = xb0; xa1 = xb1; cnt = cntn;

    }

#undef PU_BUILD
#undef PU_LOAD
}

__device__ __forceinline__ void phase_peer_mixv(const float* __restrict__ Zin, const float* __restrict__ g1, const float* __restrict__ b1, const unsigned short* __restrict__ teid, const float* __restrict__ tgate, const float* __restrict__ HD,
                                                const unsigned char* __restrict__ V, const float* __restrict__ Us, const float* __restrict__ Vs, const float* __restrict__ g2, const float* __restrict__ b2,
                                                float* __restrict__ outf, bf16* __restrict__ outb, int gw, int NGW, int lane) {
    for (int j = gw; j < TP + TS * 16; j += NGW) {
        size_t tok;
        if (j < TP) tok = (size_t)j;
        else { const int s = j - TP; if ((s & 15) != 0) continue; tok = (size_t)TP + (s >> 4); }
        float xf[16];
        { float s1 = 0.f;
#pragma unroll
          for (int q = 0; q < 4; ++q) { const f32x4 r = *(const f32x4*)(Zin + tok * D + lane * 16 + q * 4); xf[q * 4] = r[0]; xf[q * 4 + 1] = r[1]; xf[q * 4 + 2] = r[2]; xf[q * 4 + 3] = r[3]; s1 += (r[0] + r[1]) + (r[2] + r[3]); }
#pragma unroll
          for (int o = 1; o < 64; o <<= 1) s1 += __shfl_xor(s1, o);
          const float mean1 = s1 * (1.f / D); float q1 = 0.f;
#pragma unroll
          for (int i = 0; i < 16; ++i) { xf[i] -= mean1; q1 += xf[i] * xf[i]; }
#pragma unroll
          for (int o = 1; o < 64; o <<= 1) q1 += __shfl_xor(q1, o);
          const float rstd1 = rsqrtf(q1 * (1.f / D) + LN_EPS);
#pragma unroll
          for (int q = 0; q < 4; ++q) { const f32x4 gg = *(const f32x4*)(g1 + lane * 16 + q * 4), bb = *(const f32x4*)(b1 + lane * 16 + q * 4);
#pragma unroll
              for (int i = 0; i < 4; ++i) xf[q * 4 + i] = xf[q * 4 + i] * rstd1 * gg[i] + bb[i]; } }
        float y[16];
#pragma unroll
        for (int i = 0; i < 16; ++i) y[i] = 0.f;
#pragma unroll 1
        for (int bt = 0; bt < 2; ++bt) {
            const int eidv = (int)teid[tok * 128 + bt * 64 + lane];
            const float hd = HD[tok * 128 + bt * 64 + lane] * Us[eidv];
            const float wvv = 0.5f * hd * (1.f + erff(hd * 0.70710678118654752f)) * tgate[tok * 128 + bt * 64 + lane] * Vs[eidv];
            u32x4 qb[2][PGS];
#pragma unroll
            for (int i = 0; i < PGS; ++i) { const int id = __builtin_amdgcn_readlane(eidv, i); qb[0][i] = PROW_LOAD(V, id); }
#pragma unroll
            for (int g = 0; g < 64 / PGS; ++g) {
                if (g < 64 / PGS - 1) {
#pragma unroll
                    for (int i = 0; i < PGS; ++i) { const int id = __builtin_amdgcn_readlane(eidv, (g + 1) * PGS + i); qb[(g + 1) & 1][i] = PROW_LOAD(V, id); }
                }
                asm volatile("" ::: "memory");
#pragma unroll
                for (int i = 0; i < PGS; ++i) {
                    const float w = __builtin_bit_cast(float, __builtin_amdgcn_readlane(__builtin_bit_cast(int, wvv), g * PGS + i));
                    asm volatile("" : "+v"(qb[g & 1][i][0]), "+v"(qb[g & 1][i][1]), "+v"(qb[g & 1][i][2]), "+v"(qb[g & 1][i][3]));
#pragma unroll
                    for (int k = 0; k < 4; ++k) { const f32x2v lo = __builtin_amdgcn_cvt_pk_f32_fp8((int)qb[g & 1][i][k], false), hi = __builtin_amdgcn_cvt_pk_f32_fp8((int)qb[g & 1][i][k], true);
                        y[k * 4] = fmaf(w, lo[0], y[k * 4]); y[k * 4 + 1] = fmaf(w, lo[1], y[k * 4 + 1]); y[k * 4 + 2] = fmaf(w, hi[0], y[k * 4 + 2]); y[k * 4 + 3] = fmaf(w, hi[1], y[k * 4 + 3]); }
                    asm volatile("" : "+v"(y[0]), "+v"(y[1]), "+v"(y[2]), "+v"(y[3]), "+v"(y[4]), "+v"(y[5]), "+v"(y[6]), "+v"(y[7]), "+v"(y[8]), "+v"(y[9]), "+v"(y[10]), "+v"(y[11]), "+v"(y[12]), "+v"(y[13]), "+v"(y[14]), "+v"(y[15]));
                }
            }
        }
        float s = 0.f;
#pragma unroll
        for (int i = 0; i < 16; ++i) { y[i] = ALPHA * xf[i] + y[i]; s += y[i]; }
#pragma unroll
        for (int o = 1; o < 64; o <<= 1) s += __shfl_xor(s, o);
        const float mean = s * (1.f / D); float qq = 0.f;
#pragma unroll
        for (int i = 0; i < 16; ++i) { y[i] -= mean; qq += y[i] * y[i]; }
#pragma unroll
        for (int o = 1; o < 64; o <<= 1) qq += __shfl_xor(qq, o);
        const float rstd = rsqrtf(qq * (1.f / D) + LN_EPS);
        u32x4 ob0, ob1;
#pragma unroll
        for (int q = 0; q < 4; ++q) { const int col = lane * 16 + q * 4; const f32x4 gg = *(const f32x4*)(g2 + col), bb = *(const f32x4*)(b2 + col);
            f32x4 o;
#pragma unroll
            for (int i = 0; i < 4; ++i) o[i] = y[q * 4 + i] * rstd * gg[i] + bb[i];
            *(f32x4*)(outf + tok * D + col) = o;
            const unsigned w0 = pk2(o[0], o[1]), w1 = pk2(o[2], o[3]);
            if (q == 0) { ob0.x = w0; ob0.y = w1; } else if (q == 1) { ob0.z = w0; ob0.w = w1; } else if (q == 2) { ob1.x = w0; ob1.y = w1; } else { ob1.z = w0; ob1.w = w1; } }
        if (outb) { *(u32x4*)(outb + tok * D + lane * 16) = ob0; *(u32x4*)(outb + tok * D + lane * 16 + 8) = ob1; }
    }
}
}

namespace mk {
struct FGlaIn {
    bf16 *Gq, *Gk, *Gv, *Gr; float* GD;
    __device__ __forceinline__ static float silu(float r) { return r / (1.f + __expf(-r)); }
    __device__ __forceinline__ void put8(int row, int col, f32x4 v0, f32x4 v1) const {
        if (col < GN_K) *(u32x4*)(Gq + (size_t)row * 512 + col) = pack8(v0, v1);
        else if (col < GN_V) *(u32x4*)(Gk + (size_t)row * 512 + (col - GN_K)) = pack8(v0, v1);
        else if (col < GN_R) *(u32x4*)(Gv + (size_t)row * 1024 + (col - GN_V)) = pack8(v0, v1);
        else { f32x4 a, b;
#pragma unroll
            for (int i = 0; i < 4; ++i) { a[i] = silu(v0[i]); b[i] = silu(v1[i]); }
            *(u32x4*)(Gr + (size_t)row * 1024 + (col - GN_R)) = pack8(a, b); }
    }
    __device__ __forceinline__ void put4(int row, int col, f32x4 v) const {
        u32x2 w; w.x = pk2(v[0], v[1]); w.y = pk2(v[2], v[3]);
        if (col < GN_K) *(u32x2*)(Gq + (size_t)row * 512 + col) = w;
        else if (col < GN_V) *(u32x2*)(Gk + (size_t)row * 512 + (col - GN_K)) = w;
        else if (col < GN_R) *(u32x2*)(Gv + (size_t)row * 1024 + (col - GN_V)) = w;
        else if (col < GN_GD) { u32x2 s; s.x = pk2(silu(v[0]), silu(v[1])); s.y = pk2(silu(v[2]), silu(v[3])); *(u32x2*)(Gr + (size_t)row * 1024 + (col - GN_R)) = s; }
        else if (col < GN_GD + 16) *(f32x4*)(GD + (size_t)row * 16 + (col - GN_GD)) = v;
    }
};

__device__ __forceinline__ float log_sigmoid_f(float x) { return fminf(x, 0.f) - log1pf(__expf(-fabsf(x))); }
__device__ __forceinline__ bf16x8 tr8(LAS unsigned char* a0, LAS unsigned char* a1) { const s16x4 v0 = lds_tr(a0), v1 = lds_tr(a1); bf16x8 r; r[0] = v0[0]; r[1] = v0[1]; r[2] = v0[2]; r[3] = v0[3]; r[4] = v1[0]; r[5] = v1[1]; r[6] = v1[2]; r[7] = v1[3]; return r; }

constexpr int KD_ST = 272, V_ST = 528;
constexpr int GL_LB = 0, GL_TOT = 32768, GL_KD = 36864, GL_V = GL_KD + 64 * KD_ST  , GL_END = GL_V + 64 * V_ST;
static_assert(GL_END <= RING_BYTES, "GLA chunk LDS");

__device__ __forceinline__ void gla_chunk_item(int item, const bf16* __restrict__ Gq, const bf16* __restrict__ Gk, const bf16* __restrict__ Gv, const float* __restrict__ GD,
                                               const float* __restrict__ Wgu, const float* __restrict__ bg, bf16* __restrict__ QT, bf16* __restrict__ KT, float* __restrict__ DEC, float* __restrict__ DS,
                                               LAS unsigned char* lds, int tid, int wave, int lane) {
    const int h = item & 3, bc = item >> 2;
    const size_t tok0 = (size_t)bc * 64;
    LAS float* LB = (LAS float*)(lds + GL_LB);
    LAS float* TOT = (LAS float*)(lds + GL_TOT);
    const int d = tid & 127, tq = tid >> 7;
    float wg[16];
#pragma unroll
    for (int r = 0; r < 16; ++r) wg[r] = Wgu[r * 512 + h * 128 + d];
    const float bgd = bg[h * 128 + d];
    float pre[16]; float run = 0.f;
#pragma unroll
    for (int i = 0; i < 16; ++i) {
        const float* gd = GD + (tok0 + tq * 16 + i) * 16;
        const f32x4 g0 = *(const f32x4*)gd, g1 = *(const f32x4*)(gd + 4), g2 = *(const f32x4*)(gd + 8), g3 = *(const f32x4*)(gd + 12);
        float x = 0.f;
#pragma unroll
        for (int r = 0; r < 4; ++r) { x = fmaf(g0[r], wg[r], x); }
#pragma unroll
        for (int r = 0; r < 4; ++r) { x = fmaf(g1[r], wg[4 + r], x); }
#pragma unroll
        for (int r = 0; r < 4; ++r) { x = fmaf(g2[r], wg[8 + r], x); }
#pragma unroll
        for (int r = 0; r < 4; ++r) { x = fmaf(g3[r], wg[12 + r], x); }
        run += log_sigmoid_f(x + bgd) * (1.f / 16.f); pre[i] = run;
    }
    TOT[tq * 128 + d] = run;
    __syncthreads();
    float off = 0.f;
#pragma unroll
    for (int q = 0; q < 3; ++q) if (q < tq) off += TOT[q * 128 + d];
    const float bC = (TOT[d] + TOT[128 + d]) + (TOT[256 + d] + TOT[384 + d]);
#pragma unroll
    for (int i = 0; i < 16; ++i) {
        const int t = tq * 16 + i; const float b = pre[i] + off; const size_t tok = tok0 + t;
        const float q = bf2f(Gq[tok * 512 + h * 128 + d]), k = bf2f(Gk[tok * 512 + h * 128 + d]);
        QT[tok * 512 + h * 128 + d] = (bf16)f2bf(q * 0.08838834764831845f * __expf(b));
        KT[tok * 512 + h * 128 + d] = (bf16)f2bf(k * __expf(-b));
        *(LAS bf16*)(lds + GL_KD + t * KD_ST + d * 2) = (bf16)f2bf(k * __expf(bC - b));
    }
    if (tq == 0) DEC[(size_t)item * 128 + d] = __expf(bC);
#pragma unroll
    for (int p = 0; p < 4; ++p) { const int e = tid + p * 512, s = e >> 5, ch = e & 31;
        *(LAS u32x4*)(lds + GL_V + s * V_ST + ch * 16) = *(const u32x4*)(Gv + (tok0 + s) * 1024 + h * 256 + ch * 8); }
    __syncthreads();
    const int fr = lane & 15, fq = lane >> 4, dt = wave;
    bf16x8 af[2];
#pragma unroll
    for (int ks = 0; ks < 2; ++ks) { LAS unsigned char* a0 = lds + GL_KD + (ks * 32 + fq * 8 + (fr >> 2)) * KD_ST + (dt * 16 + 4 * (fr & 3)) * 2; af[ks] = tr8(a0, a0 + 4 * KD_ST); }
    bf16* dsb = (bf16*)DS + (size_t)item * 256 * 128;
#pragma unroll 4
    for (int vt = 0; vt < 16; ++vt) {
        f32x4 acc = (f32x4){0.f, 0.f, 0.f, 0.f};
#pragma unroll
        for (int ks = 0; ks < 2; ++ks) { LAS unsigned char* b0 = lds + GL_V + (ks * 32 + fq * 8 + (fr >> 2)) * V_ST + (vt * 16 + 4 * (fr & 3)) * 2; const bf16x8 bf = tr8(b0, b0 + 4 * V_ST);
            acc = __builtin_amdgcn_mfma_f32_16x16x32_bf16(af[ks], bf, acc, 0, 0, 0); }
        { u32x2 w; w.x = pk2(acc[0], acc[1]); w.y = pk2(acc[2], acc[3]); *(u32x2*)(dsb + (size_t)(vt * 16 + fr) * 128 + dt * 16 + fq * 4) = w; }
    }
    __syncthreads();
}

__device__ __forceinline__ void gla_sample_item(int item, const bf16* __restrict__ Gq, const bf16* __restrict__ Gk, const bf16* __restrict__ Gv, const bf16* __restrict__ Gr, const float* __restrict__ GD,
                                                const float* __restrict__ Wgu, const float* __restrict__ bg, const float* __restrict__ ng, const float* __restrict__ S0, float* __restrict__ Sout, bf16* __restrict__ OGb,
                                                LAS unsigned char* lds, int tid, int lane) {
    const int b = item >> 2, h = item & 3;
    LAS float* A = (LAS float*)lds;
    LAS float* Qs = A + 512; LAS float* Ks = Qs + 512;
    LAS float* PO = Ks + 512;
    LAS float* RS = PO + 4096;
    { const int t = tid >> 7, d = tid & 127; const size_t tok = (size_t)TP + b * DS + t;
      float x = bg[h * 128 + d]; const float* gd = GD + tok * 16; float xs = 0.f;
#pragma unroll
      for (int r = 0; r < 16; ++r) xs = fmaf(gd[r], Wgu[r * 512 + h * 128 + d], xs);
      x += xs;
      A[t * 128 + d] = __expf(log_sigmoid_f(x) * (1.f / 16.f));
      Qs[t * 128 + d] = bf2f(Gq[tok * 512 + h * 128 + d]) * 0.08838834764831845f; Ks[t * 128 + d] = bf2f(Gk[tok * 512 + h * 128 + d]); }
    __syncthreads();
    const int dq = tid >> 7, d0 = dq * 32;
#pragma unroll 1
    for (int vhalf = 0; vhalf < 2; ++vhalf) {
        const int v = vhalf * 128 + (tid & 127);
        float S[32];
#pragma unroll
        for (int i = 0; i < 32; ++i) S[i] = S0[(((size_t)b * 4 + h) * 128 + d0 + i) * 256 + v];
#pragma unroll 1
        for (int t = 0; t < 4; ++t) {
            const float vv = bf2f(Gv[((size_t)TP + b * DS + t) * 1024 + h * 256 + v]); float o = 0.f;
#pragma unroll
            for (int i = 0; i < 32; ++i) { S[i] = fmaf(A[t * 128 + d0 + i], S[i], Ks[t * 128 + d0 + i] * vv); o = fmaf(Qs[t * 128 + d0 + i], S[i], o); }
            PO[(dq * 4 + t) * 256 + v] = o;
        }
#pragma unroll
        for (int i = 0; i < 32; ++i) Sout[(((size_t)b * 4 + h) * 128 + d0 + i) * 256 + v] = S[i];
    }
    __syncthreads();
    { const int t = tid >> 7, vl = tid & 127; const float o0 = (PO[t * 256 + vl] + PO[(4 + t) * 256 + vl]) + (PO[(8 + t) * 256 + vl] + PO[(12 + t) * 256 + vl]), o1 = (PO[t * 256 + 128 + vl] + PO[(4 + t) * 256 + 128 + vl]) + (PO[(8 + t) * 256 + 128 + vl] + PO[(12 + t) * 256 + 128 + vl]);
      float ss = o0 * o0 + o1 * o1;
#pragma unroll
      for (int o = 1; o < 64; o <<= 1) ss += __shfl_xor(ss, o);
      if (lane == 0) RS[tid >> 6] = ss;
      __syncthreads();
      const float ms = (RS[2 * t] + RS[2 * t + 1]) * (1.f / 256.f), rstd = rsqrtf(ms + LN_EPS);
      const size_t tok = (size_t)TP + b * DS + t;
      OGb[tok * 1024 + h * 256 + vl] = (bf16)f2bf(o0 * rstd * ng[vl] * bf2f(Gr[tok * 1024 + h * 256 + vl]));
      OGb[tok * 1024 + h * 256 + 128 + vl] = (bf16)f2bf(o1 * rstd * ng[128 + vl] * bf2f(Gr[tok * 1024 + h * 256 + 128 + vl])); }
    __syncthreads();
}

__device__ __forceinline__ void gla_scan(const float* __restrict__ DS, const float* __restrict__ DEC, bf16* __restrict__ SP, float* __restrict__ Sout, int gtid, int gthreads) {
    typedef float f32x2 __attribute__((ext_vector_type(2)));
    for (int e = gtid; e < NBATCH * 4 * 256 * 64; e += gthreads) {
        const int d2 = e & 63, v = (e >> 6) & 255, h = (e >> 14) & 3, b = e >> 16;
        f32x2 S = (f32x2){0.f, 0.f};
        for (int c = 0; c < SEQ / 64; ++c) {
            const size_t item = ((size_t)b * (SEQ / 64) + c) * 4 + h;
            const unsigned dw = *(const unsigned*)((const bf16*)DS + (item * 256 + v) * 128 + d2 * 2); const f32x2 ds = (f32x2){bflo(dw), bfhi(dw)}, dc = *(const f32x2*)(DEC + item * 128 + d2 * 2);
            *(unsigned*)(SP + (item * 256 + v) * 128 + d2 * 2) = pk2(S[0], S[1]);
            S = dc * S + ds;
        }
        float* so = Sout + (((size_t)b * 4 + h) * 128 + d2 * 2) * 256 + v; so[0] = S[0]; so[256] = S[1];
    }
}

__device__ __forceinline__ void gla_out_item(int item, const bf16* __restrict__ QT, const bf16* __restrict__ KT, const bf16* __restrict__ Gv, const bf16* __restrict__ Gr, const bf16* __restrict__ SP,
                                             const float* __restrict__ ng, bf16* __restrict__ OGb, LAS unsigned char* lds, int tid, int wave, int lane) {
    const int h = item & 3, bc = item >> 2; const size_t tok0 = (size_t)bc * 64;
    const int fr = lane & 15, fq = lane >> 4, tt = wave & 3, vh = wave >> 2;
    LAS float* RS = (LAS float*)(lds + 64 * V_ST);
#pragma unroll
    for (int p = 0; p < 4; ++p) { const int e = tid + p * 512, s = e >> 5, ch = e & 31;
        *(LAS u32x4*)(lds + s * V_ST + ch * 16) = *(const u32x4*)(Gv + (tok0 + s) * 1024 + h * 256 + ch * 8); }
    bf16x8 qf[4];
#pragma unroll
    for (int ks = 0; ks < 4; ++ks) qf[ks] = *(const bf16x8*)(QT + (tok0 + tt * 16 + fr) * 512 + h * 128 + ks * 32 + fq * 8);
    const bf16* spb = SP + (size_t)item * 256 * 128;
    bf16x8 sfr[2][4];
#pragma unroll
    for (int ks = 0; ks < 4; ++ks) sfr[0][ks] = *(const bf16x8*)(spb + (size_t)(vh * 8 * 16 + fr) * 128 + ks * 32 + fq * 8);
    bf16x8 pf[2];
    {
        f32x4 at[4];
#pragma unroll
        for (int st = 0; st < 4; ++st) {
            f32x4 acc = (f32x4){0.f, 0.f, 0.f, 0.f};
#pragma unroll
            for (int ks = 0; ks < 4; ++ks) { const bf16x8 kf = *(const bf16x8*)(KT + (tok0 + st * 16 + fr) * 512 + h * 128 + ks * 32 + fq * 8); acc = __builtin_amdgcn_mfma_f32_16x16x32_bf16(kf, qf[ks], acc, 0, 0, 0); }
#pragma unroll
            for (int j = 0; j < 4; ++j) { const int s = st * 16 + fq * 4 + j, t = tt * 16 + fr; if (s > t) acc[j] = 0.f; }
            at[st] = acc;
        }
        const u32x4 w0 = pack8(at[0], at[1]), w1 = pack8(at[2], at[3]);
        pf[0] = __builtin_bit_cast(bf16x8, w0); pf[1] = __builtin_bit_cast(bf16x8, w1);
    }
    __syncthreads();
    f32x4 oacc[8]; float ss = 0.f;
#pragma unroll
    for (int i = 0; i < 8; ++i) {
        const int vt = vh * 8 + i;
        if (i < 7) {
#pragma unroll
            for (int ks = 0; ks < 4; ++ks) sfr[(i + 1) & 1][ks] = *(const bf16x8*)(spb + (size_t)((vt + 1) * 16 + fr) * 128 + ks * 32 + fq * 8);
        }
        f32x4 acc = (f32x4){0.f, 0.f, 0.f, 0.f};
#pragma unroll
        for (int k2 = 0; k2 < 2; ++k2) {
            LAS unsigned char* a0 = lds + (k2 * 32 + fq * 4 + (fr >> 2)) * V_ST + (vt * 16 + 4 * (fr & 3)) * 2;
            const bf16x8 vf = tr8(a0, a0 + 16 * V_ST);
            acc = __builtin_amdgcn_mfma_f32_16x16x32_bf16(vf, pf[k2], acc, 0, 0, 0);
        }
#pragma unroll
        for (int ks = 0; ks < 4; ++ks) acc = __builtin_amdgcn_mfma_f32_16x16x32_bf16(sfr[i & 1][ks], qf[ks], acc, 0, 0, 0);
        oacc[i] = acc; ss += (acc[0] * acc[0] + acc[1] * acc[1]) + (acc[2] * acc[2] + acc[3] * acc[3]);
    }
    ss += __shfl_xor(ss, 16); ss += __shfl_xor(ss, 32);
    if (fq == 0) RS[wave * 16 + fr] = ss;
    __syncthreads();
    const float ms = (RS[tt * 16 + fr] + RS[(tt + 4) * 16 + fr]) * (1.f / 256.f), rstd = rsqrtf(ms + LN_EPS);
    const size_t tok = tok0 + tt * 16 + fr;
#pragma unroll
    for (int i = 0; i < 8; ++i) {
        const int v = (vh * 8 + i) * 16 + fq * 4;
        const u32x2 rw = *(const u32x2*)(Gr + tok * 1024 + h * 256 + v); const f32x4 g = *(const f32x4*)(ng + v);
        u32x2 w; w.x = pk2(oacc[i][0] * rstd * g[0] * bflo(rw.x), oacc[i][1] * rstd * g[1] * bfhi(rw.x)); w.y = pk2(oacc[i][2] * rstd * g[2] * bflo(rw.y), oacc[i][3] * rstd * g[3] * bfhi(rw.y));
        *(u32x2*)(OGb + tok * 1024 + h * 256 + v) = w;
    }
    __syncthreads();
}
}

namespace mk {
#ifndef MIX_V2
#define MIX_V1 1
#endif
#if defined(MIX_V1)
#define MIXSEL(Hf, te, tg, U, V, Us, Vs, g2, b2, of, ob, lds, wave, gw, NGW, lane) phase_peer_mix(Hf, te, tg, U, V, Us, Vs, g2, b2, of, ob, gw, NGW, lane)
#define MIX_FROM_Z 1
#else
#define MIXSEL(Hf, te, tg, U, V, Us, Vs, g2, b2, of, ob, lds, wave, gw, NGW, lane) phase_peer_mix2(Hf, H1b, te, tg, U, V, Us, Vs, g2, b2, of, ob, lds, wave, gw, NGW, lane)
#endif
#define PEER_USLICE(Hb_, U_, Us_) do { if (G % 8 == 0) { const int per_ = G / 8; peer_u_slice(vcu / per_, (vcu % per_) * NWAVES + wave, per_ * NWAVES, Hb_, TEID, U_, HDB, lds + wave * 16384, lane); } \
        else { for (int sl_ = 0; sl_ < 8; ++sl_) peer_u_slice(sl_, gw, NGW, Hb_, TEID, U_, HDB, lds + wave * 16384, lane); } } while (0)
struct Args {
    const float* in[23]; const int* page_table; float* out; unsigned char* ws; int ph_lo, ph_hi;
};
enum Phase { P_PRO = 0, P_AIN = 1, P_SCORE = 2, P_TOPK = 3, P_ATTN = 4, P_AOUT = 5, P_LN1 = 6, P_PQ0 = 7, P_PEER0 = 8, P_GIN = 9, P_GCH = 10, P_GSC = 11, P_GOUT = 12, P_GPRJ = 13, P_LN1B = 14, P_PQ1 = 15, P_PEER1 = 16, P_COUNT = 17 };

#define Wa ((bf16*)(ws + WS_WA))
#define Wo ((bf16*)(ws + WS_WO))
#define Wg ((bf16*)(ws + WS_WG))
#define Wgo ((bf16*)(ws + WS_WGO))
#define Wpq ((bf16*)(ws + WS_WPQ))
#define PK ((bf16*)(ws + WS_PK))
#define Usc ((float*)(ws + WS_USC))
#define Xb ((bf16*)(ws + WS_XB))
#define Qb ((bf16*)(ws + WS_QB))
#define QIb ((bf16*)(ws + WS_QIB))
#define Kb ((bf16*)(ws + WS_KB))
#define Vb ((bf16*)(ws + WS_VB))
#define KIb ((bf16*)(ws + WS_KIB))
#define WIf ((float*)(ws + WS_WIF))
#define SC ((float*)(ws + WS_SC))
#define SCS ((float*)(ws + WS_SCS))
#define IDX ((int*)(ws + WS_IDX))
#define CNT ((int*)(ws + WS_CNT))
#define Ob ((bf16*)(ws + WS_OB))
#define Z ((bf16*)(ws + WS_Z))
#define H1f ((float*)(ws + WS_H1F))
#define H1b ((bf16*)(ws + WS_H1B))
#define PQb ((bf16*)(ws + WS_PQB))
#define H2f ((float*)(ws + WS_H2F))
#define H2b ((bf16*)(ws + WS_H2B))
#define TEID ((unsigned short*)(ws + WS_TEID))
#define TGATE ((float*)(ws + WS_TGATE))
#define Gq ((bf16*)(ws + WS_GQ))
#define Gk ((bf16*)(ws + WS_GK))
#define Gv ((bf16*)(ws + WS_GV))
#define Gr ((bf16*)(ws + WS_GR))
#define GD ((float*)(ws + WS_GD))
#define QT ((bf16*)(ws + WS_QT))
#define KT ((bf16*)(ws + WS_KT))
#define DEC ((float*)(ws + WS_DEC))
#define DSb ((float*)(ws + WS_DS))
#define SPV ((bf16*)(ws + WS_SPREV))
#define OGb ((bf16*)(ws + WS_OGB))
#define HDB ((float*)(ws + WS_HD))
#define KV8 ((unsigned char*)(ws + WS_KV8))
#define Uq (ws + WS_UB)
#define Vq (ws + WS_VBX)
#define Usc ((float*)(ws + WS_USC))
#define Vsc ((float*)(ws + WS_USC) + 2 * 16384)
#define x_prompt (INP(0))
#define x_sample (INP(1))
#define attn_w_in (INP(7))
#define attn_w_out (INP(8))
#define gla_w_in (INP(9))
#define gla_w_out (INP(13))
#define peer_w_q (INP(14))
#define peer_keys1 (INP(15))
#define peer_keys2 (INP(16))
#define peer_u (INP(17))
#define peer_v (INP(18))
__device__ __forceinline__ unsigned char* launder_ptr(unsigned char* p) { asm volatile("" : "+s"(p)); return p; }
#if defined(LOWSGPR)
#define ws (launder_ptr(args.ws))
#define INP(k) ((const float*)inp_ptr(lds, (k)))
#else
#define ws (args.ws)
#define INP(k) (args.in[k])
#endif
__device__ __forceinline__ const void* inp_ptr(LAS unsigned char* lds, int k) {
    const unsigned long long v = *(LAS unsigned long long*)(lds + INPTAB_OFF + 8 * k);
    const unsigned lo = __builtin_amdgcn_readfirstlane((unsigned)v), hi = __builtin_amdgcn_readfirstlane((unsigned)(v >> 32));
    return (const void*)(((unsigned long long)hi << 32) | lo);
}
__global__ void __launch_bounds__(NTHREADS, 2) mk_fwd(Args args) {
    extern __shared__ __attribute__((aligned(16))) unsigned char lds_raw[];
    LAS unsigned char* lds = (LAS unsigned char*)lds_raw;
    volatile LAS unsigned* MISC = (volatile LAS unsigned*)(lds + MISC_OFF);
    const int tid = threadIdx.x, lane = tid & 63, wave = __builtin_amdgcn_readfirstlane(tid >> 6);
    const int G = gridDim.x, bx = blockIdx.x;
    const int vcu = (G % 8 == 0) ? (bx % 8) * (G / 8) + bx / 8 : bx;
    const int gw = vcu * NWAVES + wave, NGW = G * NWAVES;
    gu32* ctl = (gu32*)(ws + WS_CTL);
    for (int u = tid; u < (LDS_BYTES - LDSCTL_OFF) / 4; u += NTHREADS) ((LAS unsigned*)(lds + LDSCTL_OFF))[u] = 0u;
    __syncthreads();
    if (tid == 0) {
#define PUTIN(k) *(LAS unsigned long long*)(lds + INPTAB_OFF + 8 * (k)) = (unsigned long long)args.in[k]
        PUTIN(0); PUTIN(1); PUTIN(2); PUTIN(3); PUTIN(4); PUTIN(5); PUTIN(6); PUTIN(7); PUTIN(8); PUTIN(9); PUTIN(10); PUTIN(11); PUTIN(12); PUTIN(13); PUTIN(14); PUTIN(15);
        PUTIN(16); PUTIN(17); PUTIN(18); PUTIN(19); PUTIN(20); PUTIN(21); PUTIN(22);
#undef PUTIN
    }
    __syncthreads();
    XcdBarrier bar = xcd_barrier_post((unsigned*)(ctl + CW_BAR), MISC + 8);
    if (tid == 0) { const unsigned xme = xb_xcc_id(); MISC[13] = xme; MISC[12] = __hip_atomic_fetch_add((unsigned*)(ctl + CW_XC + 64 * xme), 1u, __ATOMIC_RELAXED, __HIP_MEMORY_SCOPE_AGENT); }
    const int lo = args.ph_lo, hi = args.ph_hi;
#define IN(k) (lo <= (k) && (k) < hi)
#define SEAM(k) do { if (IN(k) && IN((k) + 1)) xcd_barrier(bar); } while (0)
#ifndef REPEAT_PHASE
#define REPEAT_PHASE -1
#endif
#ifndef REPEAT_N
#define REPEAT_N 2
#endif
#define REP(k) for (int rep_ = 0; rep_ < (REPEAT_PHASE == (k) ? REPEAT_N : 1); ++rep_)


    if (IN(P_PRO)) {
        LAS float* scr = (LAS float*)(lds + wave * 16384);
        constexpr int KB16 = D / 64;
        constexpr int I_WA = (WA_ROWS / 32) * KB16, I_WO = (D / 32) * KB16, I_WG = (WG_ROWS / 32) * KB16, I_WGO = (D / 32) * KB16, I_WPQ = 2 * (PEER_N / 32) * KB16;
        constexpr int NITEMS = I_WA + I_WO + I_WG + I_WGO + I_WPQ;
        for (int it = gw; it < I_WA; it += NGW) {
            int r = it;
            if (r < I_WA) { const int nb = r / KB16, kb = r % KB16, d0 = nb * 32; const int nv = ATT_N - d0 < 0 ? 0 : (ATT_N - d0 > 32 ? 32 : ATT_N - d0);
                p0_transpose_item(attn_w_in, ATT_N, D, Wa, d0, d0, nv, kb * 64, scr, lane); continue; } r -= I_WA;
        }
        p0_convert(x_prompt, Xb, (size_t)TP * D / 8, gw, NGW, lane);
        p0_convert(x_sample, Xb + (size_t)TP * D, (size_t)TS * D / 8, gw, NGW, lane);
        p0_convert(peer_keys1, PK, (size_t)2 * 128 * 128 / 8, gw, NGW, lane);
        p0_convert(peer_keys2, PK + 2 * 128 * 128, (size_t)2 * 128 * 128 / 8, gw, NGW, lane);
    }
    SEAM(P_PRO);

    if (IN(P_AIN)) {
        FAttnIn F{Qb, Kb, Vb, QIb, KIb, WIf, args.out};
        { pg8::Gemm g{Xb, Wa, TP, 2048, D}; pg8::StaticOrder S; S.init(TP, 2048, G, bx);
          pg8::EpiRow8<FAttnIn> E{F};
          pg8::gemm_phase<pg8::EpiRow8<FAttnIn>, pg8::StaticOrder, true, true>(lds, g, S, E);
          float km = E.f.kmax, vm = E.f.vmax;
#pragma unroll
          for (int o = 1; o < 64; o <<= 1) { km = fmaxf(km, __shfl_xor(km, o)); vm = fmaxf(vm, __shfl_xor(vm, o)); }
          if (lane == 0) { if (km > 0.f) atomicMax((unsigned*)(ctl + CW_AMAXK), __builtin_bit_cast(unsigned, km)); if (vm > 0.f) atomicMax((unsigned*)(ctl + CW_AMAXV), __builtin_bit_cast(unsigned, vm)); } }
        for (int it = gw; it < TP / 16 + 8 * 34; it += NGW) {
            if (it < TP / 16) {
                f32x4 acc[5]; skinny_tile<5>(Xb, D, Wa, D, it * 16, 2048, acc, lane);
#pragma unroll
                for (int ct = 0; ct < 5; ++ct) F.put4(it * 16 + (lane & 15), 2048 + ct * 16 + 4 * (lane >> 4), acc[ct]);
            } else {
                const int r = it - TP / 16, rt = r % 8, cg = r / 8;
                f32x4 acc[4]; skinny_tile<4>(Xb, D, Wa, D, TP + rt * 16, cg * 64, acc, lane);
#pragma unroll
                for (int ct = 0; ct < 4; ++ct) F.put4(TP + rt * 16 + (lane & 15), cg * 64 + ct * 16 + 4 * (lane >> 4), acc[ct]);
            }
        }
    }
    SEAM(P_AIN);

            if (IN(P_SCORE)) { kv8_convert(Kb, Vb, KV8, (const unsigned*)(ctl + CW_AMAXK), (const unsigned*)(ctl + CW_AMAXV), gw, NGW, lane);
        phase_score(QIb, KIb, WIf, INP(4), args.page_table, SC, SCS, QuantTabs{peer_u, peer_v, Uq, Vq, Usc, Vsc}, lds, vcu, G, wave, lane, gw, NGW); }
    SEAM(P_SCORE);
    if (IN(P_TOPK)) {
        const int jlo_ = 0, jhi_ = TA;
        phase_topk2(SC, SCS, IDX, CNT, peer_u, peer_v, Uq, Vq, Usc, Vsc, lds, (unsigned*)(ctl + CW_Q1), wave, lane, gw, NGW, jlo_, jhi_);
        {
            LAS float* scr = (LAS float*)(lds + wave * 16384);
            constexpr int KB16 = D / 64;
            constexpr int I_WO = (D / 32) * KB16, I_WG = (WG_ROWS / 32) * KB16, I_WGO = (D / 32) * KB16, I_WPQ = 2 * (PEER_N / 32) * KB16;
            constexpr int NDEF = I_WO + I_WG + I_WGO + I_WPQ;
            const int nskip = TS < NGW ? TS : 0;
            if (gw >= nskip) {
                asm volatile("s_waitcnt lgkmcnt(0)" ::: "memory");
                for (int it = gw - nskip; it < NDEF; it += NGW - nskip) {
                    int r = it;
                    if (r < I_WO) { const int nb = r / KB16, kb = r % KB16; p0_transpose_item(attn_w_out, D, D, Wo, nb * 32, nb * 32, 32, kb * 64, scr, lane); continue; } r -= I_WO;
                    if (r < I_WG) { const int nb = r / KB16, kb = r % KB16, d0 = nb * 32; int s0, nv;
                        if (d0 < GN_R) { s0 = d0; nv = 32; } else if (d0 < GN_GD) { s0 = GR + (d0 - GN_R); nv = 32; } else if (d0 == GN_GD) { s0 = GGD; nv = 16; } else { s0 = 0; nv = 0; }
                        p0_transpose_item(gla_w_in, GLA_N, D, Wg, d0, s0, nv, kb * 64, scr, lane); continue; } r -= I_WG;
                    if (r < I_WGO) { const int nb = r / KB16, kb = r % KB16; p0_transpose_item(gla_w_out, D, D, Wgo, nb * 32, nb * 32, 32, kb * 64, scr, lane); continue; } r -= I_WGO;
                    { const int l = r / ((PEER_N / 32) * KB16), rr = r % ((PEER_N / 32) * KB16), nb = rr / KB16, kb = rr % KB16;
                      p0_transpose_item(peer_w_q + (size_t)l * D * PEER_N, PEER_N, D, Wpq + (size_t)l * PEER_N * D, nb * 32, nb * 32, 32, kb * 64, scr, lane); }
                        }
            }
        }
    }
    SEAM(P_TOPK);
    if (IN(P_ATTN)) {
        LAS unsigned char* wl = lds + wave * 16384;
        {
            if (tid == 0) { unsigned np = 0, mi = 0, mycnt = 1; const unsigned xme = MISC[13];
                for (unsigned j = 0; j < 16; ++j) { const unsigned c = __hip_atomic_load((unsigned*)(ctl + CW_XC + 64 * j), __ATOMIC_RELAXED, __HIP_MEMORY_SCOPE_AGENT); if (c > 0u) { if (j < xme) ++mi; ++np; } if (j == xme) mycnt = c > 0u ? c : 1u; }
                MISC[14] = np > 0u ? np : 1u; MISC[15] = mi; MISC[16] = mycnt; }
            __syncthreads();
            const int np = (int)MISC[14], mi = (int)MISC[15], mycnt = (int)MISC[16], rank = (int)MISC[12];
            for (int u = 0; u < NBATCH * 4; ++u) if (u % np == mi) attn_prompt_stream(u >> 2, u & 3, rank * NWAVES + wave, mycnt * NWAVES, Qb, IDX, KV8, (const unsigned*)(ctl + CW_AMAXK), (const unsigned*)(ctl + CW_AMAXV), Ob, wl, lane);
        }
        {
            const float* ck_ = INP(2); const float* cv_ = INP(3); float* o_ = args.out; const int* pt_ = args.page_table; int gws_ = gw; int lane_s = lane;
            asm volatile("" : "+s"(ck_), "+s"(cv_), "+s"(o_), "+s"(pt_), "+s"(gws_), "+v"(lane_s));
            for (int su = gws_; su < TS * 4 * 4; su += NGW) {
                if ((su & 3) == 0) { const int un = su >> 2, r = un >> 2, n = un & 3; attn_row<true>(TP + r, n, n + 1, Qb, IDX, CNT, nullptr, nullptr, ck_, cv_, o_ + OUT_KS, o_ + OUT_VS, pt_, Ob, wl, lane_s); }
            }
        }
    }
    SEAM(P_ATTN);
    if (IN(P_AOUT)) {
        FResid F{x_prompt, x_sample, Z};
        { pg8::Gemm g{Ob, Wo, TP, D, D}; pg8::StaticOrder S; S.init(TP, D, G, bx);
          pg8::EpiRow8<FResid> E{F};
          pg8::gemm_phase<pg8::EpiRow8<FResid>, pg8::StaticOrder, true, true>(lds, g, S, E); }
        for (int it = gw; it < 8 * 16; it += NGW) {
            const int rt = it % 8, cg = it / 8;
            f32x4 acc[4]; skinny_tile<4>(Ob, D, Wo, D, TP + rt * 16, cg * 64, acc, lane);
#pragma unroll
            for (int ct = 0; ct < 4; ++ct) F.put4(TP + rt * 16 + (lane & 15), cg * 64 + ct * 16 + 4 * (lane >> 4), acc[ct]);
        }
    }
    SEAM(P_AOUT);
    if (IN(P_LN1)) { for (int r = gw; r < TA; r += NGW) ln_row_wave(Z + (size_t)r * D, INP(19), INP(20), (float*)nullptr, H1b + (size_t)r * D, lane); }
    SEAM(P_LN1);

        if (IN(P_PQ0)) {
        FStoreBf16 F{PQb, PEER_N};
        { pg8::Gemm g{H1b, Wpq, TP, PEER_N, D}; pg8::StaticOrder S; S.init(TP, PEER_N, G, bx);
          pg8::EpiRow8<FStoreBf16> E{F};
          pg8::gemm_phase<pg8::EpiRow8<FStoreBf16>, pg8::StaticOrder, true, true>(lds, g, S, E); }
        for (int it = gw; it < 8 * 32; it += NGW) {
            const int rt = it % 8, cg = it / 8;
            f32x4 acc[4]; skinny_tile<4>(H1b, D, Wpq, D, TP + rt * 16, cg * 64, acc, lane);
#pragma unroll
            for (int ct = 0; ct < 4; ++ct) F.put4(TP + rt * 16 + (lane & 15), cg * 64 + ct * 16 + 4 * (lane >> 4), acc[ct]);
        }
#if 0
        for (int it = gw; it < 8 * 16; it += NGW) {
            const int rt = it % 8, cg = it / 8;
            f32x4 acc[8]; skinny_tile<8>(H1b, D, Wpq, D, TP + rt * 16, cg * 128, acc, lane);
#pragma unroll
            for (int ct = 0; ct < 8; ++ct) F.put4(TP + rt * 16 + (lane & 15), cg * 128 + ct * 16 + 4 * (lane >> 4), acc[ct]);
        }
#endif
    }
    SEAM(P_PQ0);
        if (IN(P_PEER0)) {
        phase_peer_select(PQb, PK, PK + 2 * 16384, TEID, TGATE, lds, vcu, G, wave, lane);
        xcd_barrier(bar);
#if defined(U_SLICED)
        PEER_USLICE(H1b, Uq, Usc);
        xcd_barrier(bar);
        phase_peer_mixv(Z, INP(19), INP(20), TEID, TGATE, HDB, Vq, Usc, Vsc, INP(21), INP(22), H2f, H2b, gw, NGW, lane);
#else
#if defined(MIX_FROM_Z)
#if PEER_BITS == 4 && PEER_UMFMA == 3
        phase_peer_mix4<1>(Z, INP(19), INP(20), TEID, TGATE, Uq, Vq, Usc, Vsc, INP(21), INP(22), H2f, H2b, (float*)(ws + WS_HD), lds + wave * 5120, gw, NGW, lane);
        xcd_barrier(bar);
        phase_peer_mix4<2>(Z, INP(19), INP(20), TEID, TGATE, Uq, Vq, Usc, Vsc, INP(21), INP(22), H2f, H2b, (float*)(ws + WS_HD), lds + wave * 5120, gw, NGW, lane);
#elif PEER_BITS == 4 && PEER_UMFMA == 2
        phase_peer_mix4<0>(Z, INP(19), INP(20), TEID, TGATE, Uq, Vq, Usc, Vsc, INP(21), INP(22), H2f, H2b, nullptr, lds + wave * 5120, gw, NGW, lane);
#else
#if PEER_UVI
        phase_peer_mix(Z, INP(19), INP(20), TEID, TGATE, Uq, Uq + PEER_RB, Usc, Vsc, INP(21), INP(22), (float*)nullptr, H2b, lds + wave * 5120, gw, NGW, lane);
#else
        phase_peer_mix(Z, INP(19), INP(20), TEID, TGATE, Uq, Vq, Usc, Vsc, INP(21), INP(22), (float*)nullptr, H2b, lds + wave * 5120, gw, NGW, lane);
#endif
#endif
#else
        MIXSEL(H1f, TEID, TGATE, Uq, Vq, Usc, Vsc, INP(21), INP(22), H2f, H2b, lds, wave, gw, NGW, lane);
#endif
#endif
    }
    SEAM(P_PEER0);

            if (IN(P_GIN)) {
        FGlaIn F{Gq, Gk, Gv, Gr, GD};
        { pg8::Gemm g{H2b, Wg, TP, 3072, D}; pg8::StaticOrder S; S.init(TP, 3072, G, bx);
          pg8::EpiRow8<FGlaIn> E{F};
          pg8::gemm_phase<pg8::EpiRow8<FGlaIn>, pg8::StaticOrder, true, true>(lds, g, S, E); }
        for (int it = gw; it < TP / 16 + 8 * 97; it += NGW) {
            if (it < TP / 16) {
                f32x4 acc[1]; skinny_tile<1>(H2b, D, Wg, D, it * 16, GN_GD, acc, lane);
                F.put4(it * 16 + (lane & 15), GN_GD + 4 * (lane >> 4), acc[0]);
            } else {
                const int r = it - TP / 16, rt = r % 8, cg = r / 8;
                f32x4 acc[2]; skinny_tile<2>(H2b, D, Wg, D, TP + rt * 16, cg * 32, acc, lane);
#pragma unroll
                for (int ct = 0; ct < 2; ++ct) F.put4(TP + rt * 16 + (lane & 15), cg * 32 + ct * 16 + 4 * (lane >> 4), acc[ct]);
            }
        }
    }
    SEAM(P_GIN);
    if (IN(P_GCH)) {
        for (int it = vcu; it < NBATCH * (SEQ / 64) * 4; it += G) gla_chunk_item(it, Gq, Gk, Gv, GD, INP(10), INP(11), QT, KT, DEC, DSb, lds, tid, wave, lane);
        for (int it = vcu; it < DB * 4; it += G) gla_sample_item(it, Gq, Gk, Gv, Gr, GD, INP(10), INP(11), INP(12), INP(5), args.out + OUT_SS, OGb, lds, tid, lane);
    }
    SEAM(P_GCH);
    if (IN(P_GSC)) gla_scan(DSb, DEC, SPV, args.out + OUT_SP, vcu * NTHREADS + tid, G * NTHREADS);
    SEAM(P_GSC);
    if (IN(P_GOUT)) { for (int it = vcu; it < NBATCH * (SEQ / 64) * 4; it += G) gla_out_item(it, QT, KT, Gv, Gr, SPV, INP(12), OGb, lds, tid, wave, lane); }
    SEAM(P_GOUT);
    if (IN(P_GPRJ)) {
        FResidB F{H2b, H2b + (size_t)TP * D, Z};
        { pg8::Gemm g{OGb, Wgo, TP, D, D}; pg8::StaticOrder S; S.init(TP, D, G, bx);
          pg8::EpiRow8<FResidB> E{F};
          pg8::gemm_phase<pg8::EpiRow8<FResidB>, pg8::StaticOrder, true, true>(lds, g, S, E); }
        for (int it = gw; it < 8 * 16; it += NGW) {
            const int rt = it % 8, cg = it / 8;
            f32x4 acc[4]; skinny_tile<4>(OGb, D, Wgo, D, TP + rt * 16, cg * 64, acc, lane);
#pragma unroll
            for (int ct = 0; ct < 4; ++ct) F.put4(TP + rt * 16 + (lane & 15), cg * 64 + ct * 16 + 4 * (lane >> 4), acc[ct]);
        }
    }
    SEAM(P_GPRJ);
    if (IN(P_LN1B)) { for (int r = gw; r < TA; r += NGW) ln_row_wave(Z + (size_t)r * D, INP(19) + D, INP(20) + D, (float*)nullptr, H1b + (size_t)r * D, lane); }
    SEAM(P_LN1B);
    if (IN(P_PQ1)) {
        FStoreBf16 F{PQb, PEER_N}; const bf16* W1 = Wpq + (size_t)PEER_N * D;
        { pg8::Gemm g{H1b, W1, TP, PEER_N, D}; pg8::StaticOrder S; S.init(TP, PEER_N, G, bx);
          pg8::EpiRow8<FStoreBf16> E{F};
          pg8::gemm_phase<pg8::EpiRow8<FStoreBf16>, pg8::StaticOrder, true, true>(lds, g, S, E); }
        for (int it = gw; it < 8 * 32; it += NGW) {
            const int rt = it % 8, cg = it / 8;
            f32x4 acc[4]; skinny_tile<4>(H1b, D, W1, D, TP + rt * 16, cg * 64, acc, lane);
#pragma unroll
            for (int ct = 0; ct < 4; ++ct) F.put4(TP + rt * 16 + (lane & 15), cg * 64 + ct * 16 + 4 * (lane >> 4), acc[ct]);
        }
    }
    SEAM(P_PQ1);
    if (IN(P_PEER1)) {
        phase_peer_select(PQb, PK + 16384, PK + 3 * 16384, TEID, TGATE, lds, vcu, G, wave, lane);
        xcd_barrier(bar);
#if defined(U_SLICED)
        PEER_USLICE(H1b, Uq + (size_t)16384 * PEER_RB, Usc + 16384);
        xcd_barrier(bar);
        phase_peer_mixv(Z, INP(19) + D, INP(20) + D, TEID, TGATE, HDB, Vq + (size_t)16384 * PEER_RB, Usc + 16384, Vsc + 16384, INP(21) + D, INP(22) + D, args.out + OUT_Y, nullptr, gw, NGW, lane);
#else
#if defined(MIX_FROM_Z)
#if PEER_BITS == 4 && PEER_UMFMA == 3
        phase_peer_mix4<1>(Z, INP(19) + D, INP(20) + D, TEID, TGATE, Uq + (size_t)16384 * PEER_RB, Vq + (size_t)16384 * PEER_RB, Usc + 16384, Vsc + 16384, INP(21) + D, INP(22) + D, args.out + OUT_Y, nullptr, (float*)(ws + WS_HD), lds + wave * 5120, gw, NGW, lane);
        xcd_barrier(bar);
        phase_peer_mix4<2>(Z, INP(19) + D, INP(20) + D, TEID, TGATE, Uq + (size_t)16384 * PEER_RB, Vq + (size_t)16384 * PEER_RB, Usc + 16384, Vsc + 16384, INP(21) + D, INP(22) + D, args.out + OUT_Y, nullptr, (float*)(ws + WS_HD), lds + wave * 5120, gw, NGW, lane);
#elif PEER_BITS == 4 && PEER_UMFMA == 2
        phase_peer_mix4<0>(Z, INP(19) + D, INP(20) + D, TEID, TGATE, Uq + (size_t)16384 * PEER_RB, Vq + (size_t)16384 * PEER_RB, Usc + 16384, Vsc + 16384, INP(21) + D, INP(22) + D, args.out + OUT_Y, nullptr, nullptr, lds + wave * 5120, gw, NGW, lane);
#else
#if PEER_UVI
        phase_peer_mix(Z, INP(19) + D, INP(20) + D, TEID, TGATE, Uq + (size_t)16384 * PEER_RS, Uq + (size_t)16384 * PEER_RS + PEER_RB, Usc + 16384, Vsc + 16384, INP(21) + D, INP(22) + D, args.out + OUT_Y, nullptr, lds + wave * 5120, gw, NGW, lane);
#else
        phase_peer_mix(Z, INP(19) + D, INP(20) + D, TEID, TGATE, Uq + (size_t)16384 * PEER_RB, Vq + (size_t)16384 * PEER_RB, Usc + 16384, Vsc + 16384, INP(21) + D, INP(22) + D, args.out + OUT_Y, nullptr, lds + wave * 5120, gw, NGW, lane);
#endif
#endif
#else
        MIXSEL(H1f, TEID, TGATE, Uq + (size_t)16384 * PEER_RB, Vq + (size_t)16384 * PEER_RB, Usc + 16384, Vsc + 16384, INP(21) + D, INP(22) + D, args.out + OUT_Y, nullptr, lds, wave, gw, NGW, lane);
#endif
#endif
    }
#undef IN
#undef SEAM
}
#undef ws
#undef INP
#undef Wa
#undef Wo
#undef Wg
#undef Wgo
#undef Wpq
#undef PK
#undef Usc
#undef Xb
#undef Qb
#undef QIb
#undef Kb
#undef Vb
#undef KIb
#undef WIf
#undef SC
#undef SCS
#undef IDX
#undef CNT
#undef Ob
#undef Z
#undef H1f
#undef H1b
#undef PQb
#undef H2f
#undef H2b
#undef TEID
#undef TGATE
#undef Gq
#undef Gk
#undef Gv
#undef Gr
#undef GD
#undef QT
#undef KT
#undef DEC
#undef DSb
#undef SPV
#undef OGb
#undef Uq
#undef HDB
#undef KV8
#undef Vq
#undef Usc
#undef Vsc
#undef x_prompt
#undef x_sample
#undef attn_w_in
#undef attn_w_out
#undef gla_w_in
#undef gla_w_out
#undef peer_w_q
#undef peer_keys1
#undef peer_keys2
#undef peer_u
#undef peer_v


}

extern "C" void kernel_launch(void* const* d_in, const int* in_sizes, int n_in, void* d_out, int out_size, void* d_ws, size_t ws_size, hipStream_t stream) {
    if (ws_size < mk::WS_END || n_in != 23 || (size_t)out_size != OUT_TOTAL) { fprintf(stderr, "kernel_launch: unexpected sizes ws %zu n_in %d out %d\n", ws_size, n_in, out_size); return; }
    static int grid = 0;
    if (grid == 0) {
        int dev = 0, cus = 0;
        if (hipGetDevice(&dev) != hipSuccess || hipDeviceGetAttribute(&cus, hipDeviceAttributeMultiprocessorCount, dev) != hipSuccess) { fprintf(stderr, "kernel_launch: device query failed\n"); grid = -1; return; }
        if (hipFuncSetAttribute((const void*)mk::mk_fwd, hipFuncAttributeMaxDynamicSharedMemorySize, mk::LDS_BYTES) != hipSuccess) { fprintf(stderr, "kernel_launch: hipFuncSetAttribute failed\n"); grid = -1; return; }
        int per_cu = 0;
        if (hipOccupancyMaxActiveBlocksPerMultiprocessor(&per_cu, (const void*)mk::mk_fwd, mk::NTHREADS, mk::LDS_BYTES) != hipSuccess || per_cu < 1) fprintf(stderr, "kernel_launch: occupancy query says %d\n", per_cu);
        (void)hipGetLastError();
        grid = cus;
    }
    if (grid < 0) return;
    (void)hipMemsetAsync((char*)d_ws + mk::WS_CTL, 0, mk::CTL_ZERO_BYTES, stream);
    mk::Args a{};
    for (int i = 0; i < 23; ++i) a.in[i] = (const float*)d_in[i];
    a.page_table = (const int*)d_in[6]; a.out = (float*)d_out; a.ws = (unsigned char*)d_ws; a.ph_lo = 0; a.ph_hi = mk::P_COUNT;
    hipLaunchKernelGGL(mk::mk_fwd, dim3(grid), dim3(mk::NTHREADS), mk::LDS_BYTES, stream, a);
}
```

```cpp
#include <hip/hip_runtime.h>
#include <cstdio>
#include <cstdint>
#include <cmath>

constexpr int D = 1024;
constexpr int NBATCH = 2, SEQ = 8192, TP = NBATCH * SEQ;
constexpr int DB = 32, DS = 4, TS = DB * DS;
constexpr int TA = TP + TS;
constexpr int PAST = 8192, PAGE = 128, NPAGES = PAST / PAGE;
constexpr float ALPHA = 1.4142135623730951f;
constexpr float LN_EPS = 1e-5f;
constexpr int ATT_N = 2120;
constexpr int AQ = 0, AK = 1024, AV = 1280, AQI = 1536, AKI = 2048, AWI = 2112;
constexpr int TOPK = 256;
constexpr int GLA_N = 3088;
constexpr int GQ = 0, GK = 512, GV = 1024, GGD = 2048, GR = 2064;
constexpr int PEER_N = 2048;
constexpr int SCS_LD = 8256;

constexpr size_t OUT_Y = 0, OUT_KP = 16908288, OUT_VP = 21102592, OUT_KIP = 25296896, OUT_SP = 26345472,
                 OUT_KS = 26607616, OUT_VS = 26640384, OUT_KIS = 26673152, OUT_SS = 26681344, OUT_TOTAL = 30875648;


namespace pg8 {
#define PG8_LAS __attribute__((address_space(3)))
typedef unsigned short bf16_t;
typedef short bf16x8 __attribute__((ext_vector_type(8)));
typedef float f32x4 __attribute__((ext_vector_type(4)));
typedef unsigned u32x4 __attribute__((ext_vector_type(4)));
constexpr int BM = 256, BK = 64, HALF = 128, HTB = HALF * BK * 2  , STAGE_BYTES = 8 * HTB, NXCD = 8, WGM = 8;

__host__ __device__ __forceinline__ int lds_byte(int r, int c) { const int st = (r >> 4) * 2 + (c >> 5), rr = r & 15, cc = c & 31, ob = rr * 64 + cc * 2; return st * 1024 + (ob ^ (((ob >> 9) & 1) << 5)); }
__host__ __device__ __forceinline__ void stage_rc(int b, int& R, int& C) { const int st = b / 1024, sb = b % 1024, swz = sb ^ (((sb >> 9) & 1) << 5); R = (st >> 1) * 16 + swz / 64; C = (st & 1) * 32 + (swz % 64) / 2; }
__host__ __device__ __forceinline__ int perm32(int rho) { const int n = rho >> 4, i = rho & 15; return 8 * (i >> 2) + 4 * n + (i & 3); }

struct Unit { int pm, pn; };
struct Gemm { const bf16_t* A; const bf16_t* Bt; int M, N, K; };

struct StaticOrder {
    int nM, nN, nwg, G, c;
    __host__ __device__ void init(int M, int N, int G_, int c_) { nM = M / BM; nN = N / BM; nwg = nM * nN; G = G_; c = c_; }
    __host__ __device__ bool next(int i, Unit& u) const {
        const long L = (long)i * G + c; if (L >= nwg) return false;
        int wgid = (int)L; { const int q = nwg / NXCD, r = nwg % NXCD, xcd = wgid % NXCD, off = wgid / NXCD; wgid = (xcd < r ? xcd * (q + 1) : r * (q + 1) + (xcd - r) * q) + off; }
        const int nig = WGM * nN, gid = wgid / nig, fm = gid * WGM, gsz = (nM - fm) < WGM ? (nM - fm) : WGM;
        u.pm = fm + ((wgid % nig) % gsz); u.pn = (wgid % nig) / gsz; return true;
    }
    __device__ __forceinline__ void a_ready(const Unit&) const {}
    __device__ __forceinline__ void done(const Unit&) const {}
};

__device__ __forceinline__ unsigned cvt_pk_bf16(float lo, float hi) { unsigned r; asm volatile("v_cvt_pk_bf16_f32 %0, %1, %2" : "=v"(r) : "v"(lo), "v"(hi)); return r; }
template <class F> struct EpiRow8 {
    static constexpr bool PERM = true, AFTER_DRAIN = false;
    F f;
    __device__ __forceinline__ void operator()(const f32x4 (&acc)[2][2][4][2], const Unit& u, int wr, int wc, int fr, int fq) const {
        const int row0 = u.pm * BM + wr * 64 + fr, col0 = u.pn * BM + wc * 32 + 8 * fq;
#pragma unroll
        for (int ai = 0; ai < 2; ++ai)
#pragma unroll
            for (int m = 0; m < 4; ++m)
#pragma unroll
                for (int bj = 0; bj < 2; ++bj) f.put8(row0 + ai * HALF + m * 16, col0 + bj * HALF, acc[ai][bj][m][0], acc[ai][bj][m][1]);
    }
};


template <class Epi, class Sched, bool ALIGN_EPI = false, bool SP2 = false>
__device__ __forceinline__ void gemm_phase(PG8_LAS unsigned char* lds, const Gemm g, const Sched& S, const Epi& E) {
    const int tid = threadIdx.x, wid = __builtin_amdgcn_readfirstlane(tid >> 6), lane = tid & 63, wr = wid >> 2, wc = wid & 3, fr = lane & 15, fq = lane >> 4;
    const int K = g.K, nt = K / BK;
    unsigned voffA[2], voffB[2];
#pragma unroll
    for (int i = 0; i < 2; ++i) { int R, C; stage_rc(tid * 16 + i * 8192, R, C); const int Rb = Epi::PERM ? ((R & ~31) + perm32(R & 31)) : R;
        voffA[i] = (unsigned)(R * K + C) * 2u; voffB[i] = (unsigned)(Rb * K + C) * 2u; }
    const size_t kstep = (size_t)(BK * 2);
    const size_t hstep = (size_t)HALF * K * 2;
    const size_t tstep = 2 * hstep;
    const unsigned ldsw = (unsigned)wid * 1024u;
    const int aoff = lds_byte(wr * 64 + fr, fq * 8), boff = lds_byte(wc * 32 + fr, fq * 8);
#define PG8_SA(b, h) (((b) * 2 + (h)) * HTB)
#define PG8_SB(b, h) ((4 + (b) * 2 + (h)) * HTB)
#define PG8_STAGE(bufoff, gbase, voff) do { _Pragma("unroll") for (int _i = 0; _i < 2; ++_i) \
        __builtin_amdgcn_global_load_lds((const unsigned*)((const char*)(gbase) + (voff)[_i]), (PG8_LAS unsigned*)(lds + (bufoff) + ldsw + _i * 8192), 16, 0, 0); } while (0)
#define PG8_LDA(dst, b, h) do { _Pragma("unroll") for (int m = 0; m < 4; ++m) _Pragma("unroll") for (int k = 0; k < 2; ++k) dst[m][k] = *(const PG8_LAS bf16x8*)(lds + PG8_SA(b, h) + aoff + m * 2048 + k * 1024); } while (0)
#define PG8_LDB(dst, b, h) do { _Pragma("unroll") for (int n = 0; n < 2; ++n) _Pragma("unroll") for (int k = 0; k < 2; ++k) dst[n][k] = *(const PG8_LAS bf16x8*)(lds + PG8_SB(b, h) + boff + n * 2048 + k * 1024); } while (0)
#define PG8_MMA(ai, bj, At, Bt) do { __builtin_amdgcn_s_setprio(1); _Pragma("unroll") for (int m = 0; m < 4; ++m) _Pragma("unroll") for (int n = 0; n < 2; ++n) _Pragma("unroll") for (int k = 0; k < 2; ++k) \
        acc[ai][bj][m][n] = __builtin_amdgcn_mfma_f32_16x16x32_bf16(Bt[n][k], At[m][k], acc[ai][bj][m][n], 0, 0, 0); __builtin_amdgcn_s_setprio(0); } while (0)
#define PG8_WAIT_V(n) asm volatile("s_waitcnt vmcnt(" #n ")" ::: "memory")
#define PG8_WAIT_L(n) asm volatile("s_waitcnt lgkmcnt(" #n ")" ::: "memory")
#define PG8_BAR __builtin_amdgcn_s_barrier()
#define PG8_SCHED __builtin_amdgcn_sched_barrier(0)
    Unit cur, nxt; int ui = 0;
    if (!S.next(0, cur)) return;
    f32x4 acc[2][2][4][2];
#pragma unroll
    for (int a = 0; a < 2; ++a)
#pragma unroll
        for (int b = 0; b < 2; ++b)
#pragma unroll
            for (int m = 0; m < 4; ++m)
#pragma unroll
                for (int n = 0; n < 2; ++n) acc[a][b][m][n] = (f32x4){0.f, 0.f, 0.f, 0.f};
    bf16x8 At[4][2], B0[2][2], B1[2][2];
    const char* cA = (const char*)g.A + (size_t)cur.pm * tstep; const char* cB = (const char*)g.Bt + (size_t)cur.pn * tstep;
    S.a_ready(cur);
    if constexpr (SP2) {
        PG8_STAGE(PG8_SB(0, 0), cB, voffB); PG8_STAGE(PG8_SB(0, 1), cB + hstep, voffB); PG8_STAGE(PG8_SA(0, 0), cA, voffA); PG8_STAGE(PG8_SA(0, 1), cA + hstep, voffA);
        if (wr == 1) PG8_BAR;
        PG8_WAIT_V(2); PG8_BAR;
        PG8_STAGE(PG8_SB(1, 0), cB + kstep, voffB); PG8_STAGE(PG8_SA(1, 0), cA + kstep, voffA); PG8_STAGE(PG8_SB(1, 1), cB + hstep + kstep, voffB);
        PG8_WAIT_V(6); PG8_BAR;
    } else {
        PG8_STAGE(PG8_SB(0, 0), cB, voffB); PG8_STAGE(PG8_SA(0, 0), cA, voffA); PG8_STAGE(PG8_SB(0, 1), cB + hstep, voffB); PG8_STAGE(PG8_SA(0, 1), cA + hstep, voffA);
        if (wr == 1) PG8_BAR;
        PG8_WAIT_V(4); PG8_BAR;
        PG8_STAGE(PG8_SB(1, 0), cB + kstep, voffB); PG8_STAGE(PG8_SA(1, 0), cA + kstep, voffA); PG8_STAGE(PG8_SB(1, 1), cB + hstep + kstep, voffB);
        PG8_WAIT_V(6); PG8_BAR;
    }
    for (;;) {
        const bool has_next = S.next(ui + 1, nxt);
        const char* nA = has_next ? (const char*)g.A + (size_t)nxt.pm * tstep : cA; const char* nB = has_next ? (const char*)g.Bt + (size_t)nxt.pn * tstep : cB;
        for (int t = 0; t < nt; t += 2) {
            const bool last = (t == nt - 2);
            const char* a1 = cA + (size_t)(t + 1) * kstep;
            const char* a2 = last ? nA : cA + (size_t)(t + 2) * kstep; const char* b2 = last ? nB : cB + (size_t)(t + 2) * kstep;
            const char* a3 = a2 + kstep; const char* b3 = b2 + kstep;
            if (last && has_next) S.a_ready(nxt);
            if constexpr (SP2) {
            PG8_LDB(B0, 0, 0); PG8_LDB(B1, 0, 1); PG8_SCHED; PG8_LDA(At, 0, 0); PG8_STAGE(PG8_SA(1, 1), a1 + hstep, voffA);
            PG8_WAIT_V(8); PG8_WAIT_L(0); PG8_BAR; PG8_MMA(0, 0, At, B0); PG8_MMA(0, 1, At, B1); PG8_BAR; PG8_SCHED;
            PG8_LDA(At, 0, 1); PG8_STAGE(PG8_SB(0, 0), b2, voffB); PG8_STAGE(PG8_SB(0, 1), b2 + hstep, voffB); PG8_STAGE(PG8_SA(0, 0), a2, voffA);
            PG8_WAIT_V(8); PG8_WAIT_L(0); PG8_BAR; PG8_MMA(1, 0, At, B0); PG8_MMA(1, 1, At, B1); PG8_BAR; PG8_SCHED;
            PG8_LDB(B0, 1, 0); PG8_LDB(B1, 1, 1); PG8_SCHED; PG8_LDA(At, 1, 0); PG8_STAGE(PG8_SA(0, 1), a2 + hstep, voffA);
            PG8_WAIT_V(8); PG8_WAIT_L(0); PG8_BAR; PG8_MMA(0, 0, At, B0); PG8_MMA(0, 1, At, B1); PG8_BAR; PG8_SCHED;
            PG8_LDA(At, 1, 1); PG8_STAGE(PG8_SB(1, 0), b3, voffB); PG8_STAGE(PG8_SB(1, 1), b3 + hstep, voffB); PG8_STAGE(PG8_SA(1, 0), a3, voffA);
            PG8_WAIT_V(8); PG8_WAIT_L(0); PG8_BAR; PG8_MMA(1, 0, At, B0); PG8_MMA(1, 1, At, B1); PG8_BAR; PG8_SCHED;
            } else {
            PG8_LDB(B0, 0, 0); PG8_SCHED; PG8_LDA(At, 0, 0); PG8_STAGE(PG8_SA(1, 1), a1 + hstep, voffA);
            PG8_WAIT_L(8); PG8_BAR; PG8_WAIT_L(0); PG8_MMA(0, 0, At, B0); PG8_BAR; PG8_SCHED;
            PG8_LDB(B1, 0, 1); PG8_STAGE(PG8_SB(0, 0), b2, voffB);
            PG8_BAR; PG8_WAIT_L(0); PG8_MMA(0, 1, At, B1); PG8_BAR;
            PG8_LDA(At, 0, 1); PG8_STAGE(PG8_SA(0, 0), a2, voffA);
            PG8_BAR; PG8_WAIT_L(0); PG8_MMA(1, 0, At, B0); PG8_BAR; PG8_SCHED;
            PG8_STAGE(PG8_SB(0, 1), b2 + hstep, voffB);
            PG8_WAIT_V(6); PG8_BAR; PG8_MMA(1, 1, At, B1); PG8_BAR;
            PG8_LDB(B0, 1, 0); PG8_SCHED; PG8_LDA(At, 1, 0); PG8_STAGE(PG8_SA(0, 1), a2 + hstep, voffA);
            PG8_WAIT_L(8); PG8_BAR; PG8_WAIT_L(0); PG8_MMA(0, 0, At, B0); PG8_BAR; PG8_SCHED;
            PG8_LDB(B1, 1, 1); PG8_STAGE(PG8_SB(1, 0), b3, voffB);
            PG8_BAR; PG8_WAIT_L(0); PG8_MMA(0, 1, At, B1); PG8_BAR;
            PG8_LDA(At, 1, 1); PG8_STAGE(PG8_SA(1, 0), a3, voffA);
            PG8_BAR; PG8_WAIT_L(0); PG8_MMA(1, 0, At, B0); PG8_BAR; PG8_SCHED;
            PG8_STAGE(PG8_SB(1, 1), b3 + hstep, voffB);
            PG8_WAIT_V(6); PG8_BAR; PG8_MMA(1, 1, At, B1); PG8_BAR;
            }
        }
        if constexpr (ALIGN_EPI) { if (wr == 0) PG8_BAR; }
        if constexpr (!Epi::AFTER_DRAIN) { E(acc, cur, wr, wc, fr, fq); S.done(cur); }
        if (!has_next) break;
#pragma unroll
        for (int a = 0; a < 2; ++a)
#pragma unroll
            for (int b = 0; b < 2; ++b)
#pragma unroll
                for (int m = 0; m < 4; ++m)
#pragma unroll
                    for (int n = 0; n < 2; ++n) acc[a][b][m][n] = (f32x4){0.f, 0.f, 0.f, 0.f};
        cur = nxt; cA = nA; cB = nB; ++ui;
        if constexpr (ALIGN_EPI) { if (wr == 1) PG8_BAR; }
    }
    PG8_WAIT_V(0);
    if constexpr (!ALIGN_EPI) { if (wr == 0) PG8_BAR; }
    PG8_BAR;
    if constexpr (Epi::AFTER_DRAIN) { E.fused(acc, cur, wr, wc, fr, fq, lds, wid, lane); S.done(cur); }
#undef PG8_SA
#undef PG8_SB
#undef PG8_STAGE
#undef PG8_LDA
#undef PG8_LDB
#undef PG8_MMA
#undef PG8_WAIT_V
#undef PG8_WAIT_L
#undef PG8_BAR
#undef PG8_SCHED
}
}

namespace mk {
#define GAS __attribute__((address_space(1)))
#define LAS __attribute__((address_space(3)))
typedef unsigned short bf16;
typedef unsigned v4u __attribute__((ext_vector_type(4)));
typedef float f32x4 __attribute__((ext_vector_type(4)));
typedef short bf16x8 __attribute__((ext_vector_type(8)));
typedef GAS unsigned gu32;
typedef GAS unsigned long long gu64;
#define RLX_AGENT __ATOMIC_RELAXED, __HIP_MEMORY_SCOPE_AGENT
#define LDS_WAIT() asm volatile("s_waitcnt lgkmcnt(0)" ::: "memory")
#define VM_WAIT() asm volatile("s_waitcnt vmcnt(0)" ::: "memory")
__device__ __forceinline__ unsigned long long rt() { return __builtin_amdgcn_s_memrealtime(); }
__device__ __forceinline__ unsigned f2bf(float f) { unsigned u = __builtin_bit_cast(unsigned, f); return (u + 0x7fffu + ((u >> 16) & 1u)) >> 16; }
__device__ __forceinline__ unsigned pk2(float lo, float hi) {
    typedef __bf16 bf2_t __attribute__((ext_vector_type(2))); typedef float f2_t __attribute__((ext_vector_type(2)));
    const f2_t v = {lo, hi}; const bf2_t b = __builtin_convertvector(v, bf2_t); return __builtin_bit_cast(unsigned, b); }

#define XB_TMO      128
#define XB_XCNT(j)  (256  + 64 * (j))
#define XB_XSUB(j)  (1280 + 64 * (j))
#define XB_XGEN(j)  (2304 + 64 * (j))
#define XB_TOP      3328
#define XB_TOPGEN   3392
#define XCD_BAR_WORDS 3456
#define XB_SPIN_CAP (1u << 18)

__device__ __forceinline__ unsigned xb_ld(unsigned* p)              { return __hip_atomic_load(p, __ATOMIC_RELAXED, __HIP_MEMORY_SCOPE_AGENT); }
__device__ __forceinline__ unsigned xb_add(unsigned* p, unsigned v) { return __hip_atomic_fetch_add(p, v, __ATOMIC_RELAXED, __HIP_MEMORY_SCOPE_AGENT); }
__device__ __forceinline__ unsigned xb_xcc_id() { return (unsigned)__builtin_amdgcn_s_getreg((3 << 11) | 20) & 0xFu; }
#define XB_SPIN(cond, bar) do { unsigned _sp = 0; while (cond) { __builtin_amdgcn_s_sleep(1); \
    if ((++_sp & 255u) == 0u) { if (xb_ld(&(bar)[XB_TMO])) break; if (_sp > XB_SPIN_CAP) { atomicAdd(&(bar)[XB_TMO], 1u); break; } } } } while (0)

struct XcdBarrier {
    unsigned* bar; unsigned x;
    volatile LAS unsigned* st;
};

__device__ __forceinline__ XcdBarrier xcd_barrier_post(unsigned* bar, volatile LAS unsigned* st) {
    XcdBarrier b; b.bar = bar; b.x = xb_xcc_id(); b.st = st;
    if (threadIdx.x == 0) (void)xb_add(&bar[XB_XCNT(b.x)], 1u);
    return b;
}
__device__ __forceinline__ void xcd_barrier_complete(unsigned* bar, unsigned x, unsigned& nloc, unsigned& nx) {
    const unsigned G = gridDim.x * gridDim.y * gridDim.z;
    unsigned sum, cnt, mine, sp = 0u;
    for (;;) {
        sum = 0u; cnt = 0u; mine = 0u;
#pragma unroll
        for (unsigned j = 0; j < 16; ++j) { const unsigned c = xb_ld(&bar[XB_XCNT(j)]); sum += c; cnt += (c > 0u) ? 1u : 0u; mine = (j == x) ? c : mine; }
        if (sum == G) break;
        __builtin_amdgcn_s_sleep(1);
        if ((++sp & 255u) == 0u) { if (xb_ld(&bar[XB_TMO])) break; if (sp > XB_SPIN_CAP) { atomicAdd(&bar[XB_TMO], 1u); break; } }
    }
    nloc = mine > 0u ? mine : 1u; nx = cnt > 0u ? cnt : 1u;
}

__device__ __forceinline__ void xcd_barrier(const XcdBarrier& b) {
    asm volatile("s_waitcnt vmcnt(0)" ::: "memory");
    __syncthreads();
    if (threadIdx.x == 0) {
        unsigned* bar = b.bar;
        __builtin_amdgcn_s_waitcnt(0);
        unsigned nloc = b.st[0], nx = b.st[1];
        if (nloc == 0u) { xcd_barrier_complete(bar, b.x, nloc, nx); b.st[0] = nloc; b.st[1] = nx; }
        const unsigned old = xb_add(&bar[XB_XSUB(b.x)], 1u);
        const unsigned gen = old / nloc;
        if (old + 1u == (gen + 1u) * nloc) {
            __builtin_amdgcn_fence(__ATOMIC_RELEASE, "agent");
            asm volatile("s_waitcnt vmcnt(0)" ::: "memory");
            const unsigned og = xb_add(&bar[XB_TOP], 1u);
            const unsigned tg = og / nx;
            if (og + 1u == (tg + 1u) * nx) xb_add(&bar[XB_TOPGEN], 1u);
            else XB_SPIN(xb_ld(&bar[XB_TOPGEN]) == tg, bar);
            __builtin_amdgcn_fence(__ATOMIC_ACQUIRE, "agent");
            xb_add(&bar[XB_XGEN(b.x)], 1u);
            asm volatile("s_waitcnt vmcnt(0)" ::: "memory");
        } else {
            XB_SPIN(xb_ld(&bar[XB_XGEN(b.x)]) == gen, bar);
            __builtin_amdgcn_fence(__ATOMIC_ACQUIRE, "agent");
            asm volatile("s_waitcnt vmcnt(0)" ::: "memory");
        }
    }
    __syncthreads();
}

}

namespace mk {
constexpr int NWAVES = 8, NTHREADS = 512;
constexpr size_t MiB = 1u << 20;
constexpr size_t WS_QIB = 325 * MiB, WS_KB = 342 * MiB, WS_VB = 351 * MiB, WS_KIB = 360 * MiB, WS_WIF = 363 * MiB;
constexpr size_t WS_OB = 390 * MiB, WS_GD = 423 * MiB;
constexpr size_t WS_IDX = 525 * MiB, WS_CNT = 542 * MiB, WS_SCS = 543 * MiB;
constexpr size_t WS_S = 548 * MiB;
constexpr size_t WS_SC = WS_S;
constexpr size_t WS_Z = WS_S, WS_H1F = WS_S + 65 * MiB, WS_H1B = WS_S + 130 * MiB, WS_PQB = WS_S + 163 * MiB, WS_H2F = WS_S + 228 * MiB, WS_H2B = WS_S + 293 * MiB;
constexpr size_t WS_GQ = WS_S + 326 * MiB, WS_GK = WS_S + 343 * MiB, WS_GV = WS_S + 360 * MiB, WS_GR = WS_S + 393 * MiB, WS_QT = WS_S + 426 * MiB, WS_DEC = WS_S + 442 * MiB,
                 WS_OGB = WS_S + 443 * MiB, WS_KT = WS_S + 476 * MiB;
constexpr size_t WS_DS = WS_S, WS_SPREV = WS_S + 128 * MiB;
constexpr size_t WS_CTL = 1060 * MiB, WS_WA = 1061 * MiB, WS_WO = 1066 * MiB, WS_WG = 1068 * MiB, WS_WGO = 1075 * MiB, WS_WPQ = 1077 * MiB, WS_PK = 1085 * MiB,
                 WS_UB = 1086 * MiB, WS_VBX = 1150 * MiB, WS_USC = 1118 * MiB, WS_TEID = 1120 * MiB, WS_TGATE = 1125 * MiB, WS_HD = 1134 * MiB, WS_KV8 = 1134 * MiB, WS_XB = 1214 * MiB, WS_QB = 1247 * MiB, WS_END = 1280 * MiB;
constexpr size_t CTL_ZERO_BYTES = 1 * MiB;
constexpr int CW_TMO = 0, CW_AMAXK = 256, CW_AMAXV = 320, CW_Q1 = 512, CW_PFLAG = 768, CW_XC = 1024, CW_BAR = 4096;
constexpr int WA_ROWS = 2176, WG_ROWS = 3104;
constexpr int GN_Q = 0, GN_K = 512, GN_V = 1024, GN_R = 2048, GN_GD = 3072;

constexpr int RING_BYTES = 131072, LDSCTL_OFF = RING_BYTES, MISC_OFF = LDSCTL_OFF + 320, INPTAB_OFF = LDSCTL_OFF + 512, LDS_BYTES = 147456;

typedef unsigned u32x4 __attribute__((ext_vector_type(4)));
typedef unsigned u32x2 __attribute__((ext_vector_type(2)));
#define MK_LAS __attribute__((address_space(3)))
__device__ __forceinline__ float bflo(unsigned w) { return __builtin_bit_cast(float, w << 16); }
__device__ __forceinline__ float bfhi(unsigned w) { return __builtin_bit_cast(float, w & 0xffff0000u); }
__device__ __forceinline__ float bf2f(unsigned short b) { return __builtin_bit_cast(float, (unsigned)b << 16); }
__device__ __forceinline__ u32x4 pack8(f32x4 a, f32x4 b) { u32x4 w; w.x = pk2(a[0], a[1]); w.y = pk2(a[2], a[3]); w.z = pk2(b[0], b[1]); w.w = pk2(b[2], b[3]); return w; }

#define TPB(k)
#define TPE(k)
template <int NCT> __device__ __forceinline__ void skinny_tile(const bf16* __restrict__ A, int lda, const bf16* __restrict__ Bt, int K, int row0, int col0, f32x4 (&acc)[NCT], int lane) {
    const int fr = lane & 15, fq = lane >> 4;
    const bf16* ap = A + (size_t)(row0 + fr) * lda + fq * 8;
    const bf16* bp = Bt + (size_t)(col0 + fr) * K + fq * 8;
#pragma unroll
    for (int ct = 0; ct < NCT; ++ct) acc[ct] = (f32x4){0.f, 0.f, 0.f, 0.f};
#pragma unroll 1
    for (int k0 = 0; k0 < K; k0 += 128) {
        bf16x8 a[4], b[NCT][4];
#pragma unroll
        for (int j = 0; j < 4; ++j) a[j] = *(const bf16x8*)(ap + k0 + j * 32);
#pragma unroll
        for (int ct = 0; ct < NCT; ++ct)
#pragma unroll
            for (int j = 0; j < 4; ++j) b[ct][j] = *(const bf16x8*)(bp + (size_t)ct * 16 * K + k0 + j * 32);
        asm volatile("" ::: "memory");
#pragma unroll
        for (int ct = 0; ct < NCT; ++ct)
#pragma unroll
            for (int j = 0; j < 4; ++j) acc[ct] = __builtin_amdgcn_mfma_f32_16x16x32_bf16(b[ct][j], a[j], acc[ct], 0, 0, 0);
    }
}

__device__ __forceinline__ void p0_transpose_item(const float* __restrict__ W, int ldw, int K, bf16* __restrict__ WT, int dst_row0, int src_col0, int nvalid, int k0, MK_LAS float* scr, int lane) {
#pragma unroll 8
    for (int i = 0; i < 32; ++i) { const int kk = 2 * i + (lane >> 5), j = lane & 31; scr[kk * 33 + j] = j < nvalid ? W[(size_t)(k0 + kk) * ldw + src_col0 + j] : 0.f; }
    asm volatile("s_waitcnt lgkmcnt(0)" ::: "memory");
    const int c = lane & 7;
#pragma unroll
    for (int j = 0; j < 4; ++j) { const int n = (lane >> 3) + 8 * j; const MK_LAS float* s = scr + (8 * c) * 33 + n;
        u32x4 o; o.x = pk2(s[0 * 33], s[1 * 33]); o.y = pk2(s[2 * 33], s[3 * 33]); o.z = pk2(s[4 * 33], s[5 * 33]); o.w = pk2(s[6 * 33], s[7 * 33]);
        *(u32x4*)(WT + (size_t)(dst_row0 + n) * K + k0 + 8 * c) = o; }
    asm volatile("s_waitcnt lgkmcnt(0)" ::: "memory");
}
__device__ __forceinline__ void p0_convert(const float* __restrict__ src, bf16* __restrict__ dst, size_t n8, int gw, int ngw, int lane) {
    for (size_t i = (size_t)gw * 64 + lane; i < n8; i += (size_t)ngw * 64) {
        const f32x4 a = *(const f32x4*)(src + i * 8), b = *(const f32x4*)(src + i * 8 + 4);
        *(u32x4*)(dst + i * 8) = pack8(a, b);
    }
}

__device__ __forceinline__ void p0_quant_row(const float* __restrict__ src, unsigned char* __restrict__ dst, float* __restrict__ scale, int lane) {
    f32x4 v[4]; float am = 0.f;
#pragma unroll
    for (int q = 0; q < 4; ++q) { v[q] = *(const f32x4*)(src + lane * 16 + q * 4); am = fmaxf(am, fmaxf(fmaxf(fabsf(v[q][0]), fabsf(v[q][1])), fmaxf(fabsf(v[q][2]), fabsf(v[q][3])))); }
#pragma unroll
    for (int o = 1; o < 64; o <<= 1) am = fmaxf(am, __shfl_xor(am, o));
    const float inv = am > 0.f ? 448.f / am : 0.f;
    u32x4 w;
#pragma unroll
    for (int q = 0; q < 4; ++q) { int x = __builtin_amdgcn_cvt_pk_fp8_f32(v[q][0] * inv, v[q][1] * inv, 0, false); x = __builtin_amdgcn_cvt_pk_fp8_f32(v[q][2] * inv, v[q][3] * inv, x, true); w[q] = (unsigned)x; }
    *(u32x4*)(dst + lane * 16) = w;
    if (lane == 0) *scale = am * (1.f / 448.f);
}

__device__ __forceinline__ void p0_quant_rows4(const float* __restrict__ src, unsigned char* __restrict__ dst, float* __restrict__ scale, int lane) {
    f32x4 v[4][4]; float am[4];
#pragma unroll
    for (int r = 0; r < 4; ++r)
#pragma unroll
        for (int q = 0; q < 4; ++q) v[r][q] = *(const f32x4*)(src + (size_t)r * D + lane * 16 + q * 4);
#pragma unroll
    for (int r = 0; r < 4; ++r) { float a = 0.f;
#pragma unroll
        for (int q = 0; q < 4; ++q) a = fmaxf(a, fmaxf(fmaxf(fabsf(v[r][q][0]), fabsf(v[r][q][1])), fmaxf(fabsf(v[r][q][2]), fabsf(v[r][q][3]))));
        am[r] = a; }
#pragma unroll
    for (int o = 1; o < 64; o <<= 1) {
#pragma unroll
        for (int r = 0; r < 4; ++r) am[r] = fmaxf(am[r], __shfl_xor(am[r], o)); }
#pragma unroll
    for (int r = 0; r < 4; ++r) {
        const float inv = am[r] > 0.f ? 448.f / am[r] : 0.f;
        u32x4 w;
#pragma unroll
        for (int q = 0; q < 4; ++q) { int x = __builtin_amdgcn_cvt_pk_fp8_f32(v[r][q][0] * inv, v[r][q][1] * inv, 0, false); x = __builtin_amdgcn_cvt_pk_fp8_f32(v[r][q][2] * inv, v[r][q][3] * inv, x, true); w[q] = (unsigned)x; }
        *(u32x4*)(dst + (size_t)r * D + lane * 16) = w;
        if (lane == 0) scale[r] = am[r] * (1.f / 448.f);
    }
}

struct FAttnIn {
    bf16 *Qb, *Kb, *Vb, *QIb, *KIb; float* WIf; float* out;
    mutable float kmax = 0.f, vmax = 0.f;
    __device__ __forceinline__ static float amax8(f32x4 a, f32x4 b) { return fmaxf(fmaxf(fmaxf(fabsf(a[0]), fabsf(a[1])), fmaxf(fabsf(a[2]), fabsf(a[3]))), fmaxf(fmaxf(fabsf(b[0]), fabsf(b[1])), fmaxf(fabsf(b[2]), fabsf(b[3])))); }
    __device__ __forceinline__ float* okp(int row, size_t offp, size_t offs, int ld) const { return row < TP ? out + offp + (size_t)row * ld : out + offs + (size_t)(row - TP) * ld; }
    __device__ __forceinline__ void put8(int row, int col, f32x4 v0, f32x4 v1) const {
        const u32x4 w = pack8(v0, v1);
        if (col < AK) *(u32x4*)(Qb + (size_t)row * 1024 + col) = w;
        else if (col < AV) { *(u32x4*)(Kb + (size_t)row * 256 + (col - AK)) = w; float* o = okp(row, OUT_KP, OUT_KS, 256) + (col - AK); *(f32x4*)o = v0; *(f32x4*)(o + 4) = v1; kmax = fmaxf(kmax, amax8(v0, v1)); }
        else if (col < AQI) { *(u32x4*)(Vb + (size_t)row * 256 + (col - AV)) = w; float* o = okp(row, OUT_VP, OUT_VS, 256) + (col - AV); *(f32x4*)o = v0; *(f32x4*)(o + 4) = v1; vmax = fmaxf(vmax, amax8(v0, v1)); }
        else *(u32x4*)(QIb + (size_t)row * 512 + (col - AQI)) = w;
    }
    __device__ __forceinline__ void put4(int row, int col, f32x4 v) const {
        u32x2 w; w.x = pk2(v[0], v[1]); w.y = pk2(v[2], v[3]);
        if (col < AK) *(u32x2*)(Qb + (size_t)row * 1024 + col) = w;
        else if (col < AV) { *(u32x2*)(Kb + (size_t)row * 256 + (col - AK)) = w; *(f32x4*)(okp(row, OUT_KP, OUT_KS, 256) + (col - AK)) = v; }
        else if (col < AQI) { *(u32x2*)(Vb + (size_t)row * 256 + (col - AV)) = w; *(f32x4*)(okp(row, OUT_VP, OUT_VS, 256) + (col - AV)) = v; }
        else if (col < AKI) *(u32x2*)(QIb + (size_t)row * 512 + (col - AQI)) = w;
        else if (col < AWI) { *(u32x2*)(KIb + (size_t)row * 64 + (col - AKI)) = w; *(f32x4*)(okp(row, OUT_KIP, OUT_KIS, 64) + (col - AKI)) = v; }
        else if (col < ATT_N) *(f32x4*)(WIf + (size_t)row * 8 + (col - AWI)) = v * 0.04419417382415922f;
    }
};
}

namespace mk {
typedef float f32x2v __attribute__((ext_vector_type(2)));
typedef float f32x16 __attribute__((ext_vector_type(16)));
typedef short s16x4 __attribute__((ext_vector_type(4)));
typedef short v4i16_t __attribute__((ext_vector_type(4)));

__device__ __forceinline__ void score_load_q(const bf16* __restrict__ QIb, const float* __restrict__ WIf, size_t tok0, int lane, bf16x8 (&afr)[4], f32x4 (&w4)[4]) {
    const int r = lane & 31, kq = lane >> 5;
    const bf16* ap = QIb + (tok0 + (r >> 3)) * 512 + (r & 7) * 64 + kq * 8;
#pragma unroll
    for (int ks = 0; ks < 4; ++ks) afr[ks] = *(const bf16x8*)(ap + ks * 16);
#pragma unroll
    for (int ql = 0; ql < 4; ++ql) w4[ql] = *(const f32x4*)(WIf + (tok0 + ql) * 8 + 4 * kq);
}
__device__ __forceinline__ void score_tile(const bf16x8 (&afr)[4], const bf16x8 (&bfr)[4], const f32x4 (&w4)[4], float (&s)[4]) {
    f32x16 acc;
#pragma unroll
    for (int j = 0; j < 16; ++j) acc[j] = 0.f;
#pragma unroll
    for (int ks = 0; ks < 4; ++ks) acc = __builtin_amdgcn_mfma_f32_32x32x16_bf16(afr[ks], bfr[ks], acc, 0, 0, 0);
#pragma unroll
    for (int ql = 0; ql < 4; ++ql) {
        float p = 0.f;
#pragma unroll
        for (int jj = 0; jj < 4; ++jj) p = fmaf(fmaxf(acc[ql * 4 + jj], 0.f), w4[ql][jj], p);
        s[ql] = p + __shfl_xor(p, 32);
    }
}

__device__ __forceinline__ void quant_issue(const float* __restrict__ src, f32x4 (&v)[4], int lane) {
#pragma unroll
    for (int q = 0; q < 4; ++q) v[q] = *(const f32x4*)(src + lane * 16 + q * 4);
}
#ifndef PEER_BITS
#define PEER_BITS 4
#endif
#ifndef PEER_AMAX4
#define PEER_AMAX4 6.0f
#endif
constexpr int PEER_RB = PEER_BITS * 128;
#ifndef PEER_UVI
#define PEER_UVI 0
#endif
constexpr int PEER_RS = PEER_UVI ? 2 * PEER_RB : PEER_RB;
#if PEER_BITS == 4
__device__ __forceinline__ unsigned enc_e2m1(float x) {
    const float a = fabsf(x);
    const float c = a < 2.f ? rintf(a * 2.f) : (a < 4.f ? rintf(a) + 2.f : fminf(rintf(a * 0.5f) + 4.f, 7.f));
    return (unsigned)c | (x < 0.f ? 8u : 0u);
}
__device__ __forceinline__ void quant_finish(const f32x4 (&v)[4], unsigned char* __restrict__ dst, float* __restrict__ scale, int lane) {
    float am = 0.f;
#pragma unroll
    for (int q = 0; q < 4; ++q) am = fmaxf(am, fmaxf(fmaxf(fabsf(v[q][0]), fabsf(v[q][1])), fmaxf(fabsf(v[q][2]), fabsf(v[q][3]))));
#pragma unroll
    for (int o = 1; o < 64; o <<= 1) am = fmaxf(am, __shfl_xor(am, o));
    const float inv = am > 0.f ? PEER_AMAX4 / am : 0.f;
    u32x2 w; w.x = 0u; w.y = 0u;
#pragma unroll
    for (int i = 0; i < 8; ++i) { w.x |= enc_e2m1(v[i >> 2][i & 3] * inv) << (4 * i); w.y |= enc_e2m1(v[2 + (i >> 2)][i & 3] * inv) << (4 * i); }
    *(u32x2*)(dst + lane * 8) = w;
    if (lane == 0) *scale = am * (1.f / PEER_AMAX4);
}
#elif PEER_BITS == 6
__device__ __forceinline__ unsigned enc_e2m3(float x) {
    const float a = fabsf(x), q = a * 8.f;
    const float c = a < 2.f ? rintf(q) : (a < 4.f ? rintf(q * 0.5f) + 8.f : fminf(rintf(q * 0.25f) + 16.f, 31.f));
    return (unsigned)c | (x < 0.f ? 32u : 0u);
}
__device__ __forceinline__ void quant_finish(const f32x4 (&v)[4], unsigned char* __restrict__ dst, float* __restrict__ scale, int lane) {
    float am = 0.f;
#pragma unroll
    for (int q = 0; q < 4; ++q) am = fmaxf(am, fmaxf(fmaxf(fabsf(v[q][0]), fabsf(v[q][1])), fmaxf(fabsf(v[q][2]), fabsf(v[q][3]))));
#pragma unroll
    for (int o = 1; o < 64; o <<= 1) am = fmaxf(am, __shfl_xor(am, o));
    const float inv = am > 0.f ? 7.5f / am : 0.f;
    unsigned long long lo = 0ull, hi = 0ull;
#pragma unroll
    for (int i = 0; i < 16; ++i) {
        const unsigned long long c = enc_e2m3(v[i >> 2][i & 3] * inv);
        if (i < 10) lo |= c << (6 * i);
        else if (i == 10) { lo |= (c & 15ull) << 60; hi |= c >> 4; }
        else hi |= c << (6 * (i - 11) + 2);
    }
    unsigned* d = (unsigned*)(dst + lane * 12);
    d[0] = (unsigned)lo; d[1] = (unsigned)(lo >> 32); d[2] = (unsigned)hi;
    if (lane == 0) *scale = am * (1.f / 7.5f);
}
#else
__device__ __forceinline__ void quant_finish(const f32x4 (&v)[4], unsigned char* __restrict__ dst, float* __restrict__ scale, int lane) {
    float am = 0.f;
#pragma unroll
    for (int q = 0; q < 4; ++q) am = fmaxf(am, fmaxf(fmaxf(fabsf(v[q][0]), fabsf(v[q][1])), fmaxf(fabsf(v[q][2]), fabsf(v[q][3]))));
#pragma unroll
    for (int o = 1; o < 64; o <<= 1) am = fmaxf(am, __shfl_xor(am, o));
    const float inv = am > 0.f ? 448.f / am : 0.f;
    u32x4 w;
#pragma unroll
    for (int q = 0; q < 4; ++q) { int x = __builtin_amdgcn_cvt_pk_fp8_f32(v[q][0] * inv, v[q][1] * inv, 0, false); x = __builtin_amdgcn_cvt_pk_fp8_f32(v[q][2] * inv, v[q][3] * inv, x, true); w[q] = (unsigned)x; }
    *(u32x4*)(dst + lane * 16) = w;
    if (lane == 0) *scale = am * (1.f / 448.f);
}
#endif
struct QuantTabs { const float* pu; const float* pv; unsigned char* uq; unsigned char* vq; float* us; float* vs;
    __device__ __forceinline__ const float* src(int r) const { return r < 2 * 16384 ? pu + (size_t)r * D : pv + (size_t)(r - 2 * 16384) * D; }
    __device__ __forceinline__ unsigned char* dst(int r) const {
#if PEER_UVI
        return r < 2 * 16384 ? uq + (size_t)r * PEER_RS : uq + (size_t)(r - 2 * 16384) * PEER_RS + PEER_RB;
#else
        return r < 2 * 16384 ? uq + (size_t)r * PEER_RB : vq + (size_t)(r - 2 * 16384) * PEER_RB;
#endif
    }
    __device__ __forceinline__ float* sc(int r) const { return r < 2 * 16384 ? us + r : vs + (r - 2 * 16384); } };

__device__ __forceinline__ void phase_score(const bf16* __restrict__ QIb, const bf16* __restrict__ KIb, const float* __restrict__ WIf, const float* __restrict__ cache_ki, const int* __restrict__ page_table,
                                            float* __restrict__ SC, float* __restrict__ SCS, const QuantTabs QT_, LAS unsigned char* lds, int vcu, int G, int wave, int lane, int gw, int NGW) {
    const int c = lane & 31, kq = lane >> 5;
    int qrow = gw;
    constexpr int KST = 144, KBUF = 256 * KST;
    const int tid = wave * 64 + lane;
    for (int it = vcu; it < 512; it += G) {
        const int b = it >> 8, qt = b == 0 ? (it & 255) : 255 - (it & 255);
        const size_t tok0 = (size_t)b * SEQ + qt * 32 + wave * 4;
        bf16x8 afr[4]; f32x4 w4[4];
        score_load_q(QIb, WIf, tok0, lane, afr, w4);
        const int nc = (qt >> 3) + 1;
        const bf16* kbase = KIb + (size_t)b * SEQ * 64;
        u32x4 st[4];
#pragma unroll
        for (int i = 0; i < 4; ++i) { const int p = tid + i * 512; st[i] = *(const u32x4*)(kbase + (size_t)(p >> 3) * 64 + (p & 7) * 8); }
#pragma unroll
        for (int i = 0; i < 4; ++i) { const int p = tid + i * 512; *(LAS u32x4*)(lds + (p >> 3) * KST + (p & 7) * 16) = st[i]; }
        __syncthreads();
        for (int ch = 0; ch < nc; ++ch) {
            const bool more = ch + 1 < nc;
            f32x4 qv[4]; const bool qdo = qrow < 4 * 16384;
            if (qdo) quant_issue(QT_.src(qrow), qv, lane);
            if (more) {
#pragma unroll
                for (int i = 0; i < 4; ++i) { const int p = tid + i * 512; st[i] = *(const u32x4*)(kbase + ((size_t)(ch + 1) * 256 + (p >> 3)) * 64 + (p & 7) * 8); }
            }
            LAS unsigned char* kb = lds + (ch & 1) * KBUF;
            const int ntile = more ? 8 : (qt & 7) + 1;
            for (int kt8 = 0; kt8 < ntile; ++kt8) {
                bf16x8 bfr[4];
#pragma unroll
                for (int ks = 0; ks < 4; ++ks) bfr[ks] = *(LAS bf16x8*)(kb + (kt8 * 32 + c) * KST + ks * 32 + kq * 16);
                float sv[4]; score_tile(afr, bfr, w4, sv);
                float* o = SC + (tok0 + 2 * kq) * SEQ + (ch * 8 + kt8) * 32 + c;
                o[0] = kq ? sv[2] : sv[0]; o[SEQ] = kq ? sv[3] : sv[1];
            }
            if (qdo) { quant_finish(qv, QT_.dst(qrow), QT_.sc(qrow), lane); qrow += NGW; }
            if (more) {
                LAS unsigned char* nb = lds + ((ch + 1) & 1) * KBUF;
#pragma unroll
                for (int i = 0; i < 4; ++i) { const int p = tid + i * 512; *(LAS u32x4*)(nb + (p >> 3) * KST + (p & 7) * 16) = st[i]; }
            }
            __syncthreads();
        }
    }
    for (; qrow < 4 * 16384; qrow += NGW) { f32x4 qv[4]; quant_issue(QT_.src(qrow), qv, lane); quant_finish(qv, QT_.dst(qrow), QT_.sc(qrow), lane); }
    for (int it = gw; it < DB * NPAGES + DB; it += NGW) {
        const bool isnew = it >= DB * NPAGES;
        const int b = isnew ? it - DB * NPAGES : it / NPAGES, pg = isnew ? 0 : it % NPAGES;
        const size_t tok0 = (size_t)TP + b * DS;
        bf16x8 afr[4]; f32x4 w4[4];
        score_load_q(QIb, WIf, tok0, lane, afr, w4);
        if (!isnew) {
            const int phys = page_table[b * NPAGES + pg];
            for (int j = 0; j < 4; ++j) {
                const float* kp = cache_ki + ((size_t)phys * PAGE + j * 32 + c) * 64 + kq * 8;
                bf16x8 bfr[4];
#pragma unroll
                for (int ks = 0; ks < 4; ++ks) { const f32x4 x0 = *(const f32x4*)(kp + ks * 16), x1 = *(const f32x4*)(kp + ks * 16 + 4); const u32x4 w = pack8(x0, x1); bfr[ks] = __builtin_bit_cast(bf16x8, w); }
                float s[4]; score_tile(afr, bfr, w4, s);
                float* o = SCS + (size_t)(b * DS + 2 * kq) * SCS_LD + pg * PAGE + j * 32 + c;
                o[0] = kq ? s[2] : s[0]; o[SCS_LD] = kq ? s[3] : s[1];
            }
        } else {
            const bf16* kp = KIb + (tok0 + (c & 3)) * 64 + kq * 8;
            bf16x8 bfr[4];
#pragma unroll
            for (int ks = 0; ks < 4; ++ks) bfr[ks] = *(const bf16x8*)(kp + ks * 16);
            float s[4]; score_tile(afr, bfr, w4, s);
            if (c < 4) { float* o = SCS + (size_t)(b * DS + 2 * kq) * SCS_LD + PAST + c; o[0] = kq ? s[2] : s[0]; o[SCS_LD] = kq ? s[3] : s[1]; }
        }
    }
}

constexpr int VST = 144;
__device__ __forceinline__ bf16x8 ld_frag8(const bf16* p) { return *(const bf16x8*)p; }
__device__ __forceinline__ bf16x8 ld_frag8(const float* p) { const f32x4 a = *(const f32x4*)p, b = *(const f32x4*)(p + 4); const u32x4 w = pack8(a, b); return __builtin_bit_cast(bf16x8, w); }
__device__ __forceinline__ s16x4 lds_tr(LAS unsigned char* p) { return __builtin_bit_cast(s16x4, __builtin_amdgcn_ds_read_tr16_b64_v4i16((LAS v4i16_t*)p)); }

template <bool SAMPLE>
__device__ __forceinline__ void attn_row(int row, int n0, int n1, const bf16* __restrict__ Qb, const int* __restrict__ IDX, const int* __restrict__ CNT,
                                         const bf16* __restrict__ Kb, const bf16* __restrict__ Vb, const float* __restrict__ cache_k, const float* __restrict__ cache_v,
                                         const float* __restrict__ newk, const float* __restrict__ newv, const int* __restrict__ page_table,
                                         bf16* __restrict__ Ob, LAS unsigned char* wl, int lane) {
    const int fr = lane & 15, fq = lane >> 4;
    LAS int* rid = (LAS int*)wl;
    LAS unsigned char* vt = wl + 1024;
    const int cnt = CNT[row];
    const int b = SAMPLE ? (row - TP) / DS : row / SEQ;
#pragma unroll
    for (int i = 0; i < 4; ++i) { const int slot = i * 64 + lane; int key = slot < cnt ? IDX[(size_t)row * TOPK + slot] : 0; int id;
        if (!SAMPLE) id = b * SEQ + key;
        else if (key < PAST) id = page_table[b * NPAGES + key / PAGE] * PAGE + (key % PAGE);
        else id = (int)0x80000000 | (b * DS + (key - PAST));
        rid[slot] = id; }
    asm volatile("s_waitcnt lgkmcnt(0)" ::: "memory");
    for (int n = n0; n < n1; ++n) {
        bf16x8 qf[2];
#pragma unroll
        for (int ks = 0; ks < 2; ++ks) qf[ks] = *(const bf16x8*)(Qb + (size_t)row * 1024 + (n * 4 + (fr & 3)) * 64 + ks * 32 + fq * 8);
        f32x4 st[16];
        constexpr int TBN = SAMPLE ? 4 : 8;
#pragma unroll
        for (int tb = 0; tb < 16 / TBN; ++tb) {
            bf16x8 kf[TBN][2];
#pragma unroll
            for (int t = 0; t < TBN; ++t) {
                const int id = rid[(tb * TBN + t) * 16 + fr];
                if (!SAMPLE) { const bf16* kp = Kb + (size_t)id * 256 + n * 64 + fq * 8; kf[t][0] = ld_frag8(kp); kf[t][1] = ld_frag8(kp + 32); }
                else { const float* kp = (id < 0 ? newk + (size_t)(id & 0x7fffffff) * 256 : cache_k + (size_t)id * 256) + n * 64 + fq * 8; kf[t][0] = ld_frag8(kp); kf[t][1] = ld_frag8(kp + 32); }
            }
#pragma unroll
            for (int t = 0; t < TBN; ++t) {
                f32x4 a = (f32x4){0.f, 0.f, 0.f, 0.f};
                a = __builtin_amdgcn_mfma_f32_16x16x32_bf16(kf[t][0], qf[0], a, 0, 0, 0);
                a = __builtin_amdgcn_mfma_f32_16x16x32_bf16(kf[t][1], qf[1], a, 0, 0, 0);
                st[tb * TBN + t] = a;
            }
            asm volatile("" ::: "memory");
        }
        bf16x8 vreg[8];
#define ATT_VLOAD(ch_) do { _Pragma("unroll") for (int i = 0; i < 8; ++i) { const int sl = i * 8 + (lane >> 3), chunk = lane & 7; const int id = rid[(ch_) * 64 + sl]; \
            if (!SAMPLE) vreg[i] = ld_frag8(Vb + (size_t)id * 256 + n * 64 + chunk * 8); \
            else vreg[i] = ld_frag8((id < 0 ? newv + (size_t)(id & 0x7fffffff) * 256 : cache_v + (size_t)id * 256) + n * 64 + chunk * 8); } } while (0)
        ATT_VLOAD(0);
        float mx = -INFINITY;
#pragma unroll
        for (int t = 0; t < 16; ++t)
#pragma unroll
            for (int j = 0; j < 4; ++j) { const int slot = t * 16 + fq * 4 + j; const float v = slot < cnt ? st[t][j] * 0.125f : -INFINITY; st[t][j] = v; mx = fmaxf(mx, v); }
        mx = fmaxf(mx, __shfl_xor(mx, 16)); mx = fmaxf(mx, __shfl_xor(mx, 32));
        float sum = 0.f;
#pragma unroll
        for (int t = 0; t < 16; ++t)
#pragma unroll
            for (int j = 0; j < 4; ++j) { const float e = __expf(st[t][j] - mx); st[t][j] = e; sum += e; }
        sum += __shfl_xor(sum, 16); sum += __shfl_xor(sum, 32);
        f32x4 oacc[4];
#pragma unroll
        for (int dt = 0; dt < 4; ++dt) oacc[dt] = (f32x4){0.f, 0.f, 0.f, 0.f};
#pragma unroll
        for (int ch = 0; ch < 4; ++ch) {
#pragma unroll
            for (int i = 0; i < 8; ++i) { const int sl = i * 8 + (lane >> 3), chunk = lane & 7; *(LAS bf16x8*)(vt + sl * VST + chunk * 16) = vreg[i]; }
            asm volatile("s_waitcnt lgkmcnt(0)" ::: "memory");
            if (ch < 3) ATT_VLOAD(ch + 1);
#pragma unroll
            for (int s2 = 0; s2 < 2; ++s2) {
                const int t0 = ch * 4 + s2 * 2;
                const u32x4 pw = pack8(st[t0], st[t0 + 1]);
                const bf16x8 pf = __builtin_bit_cast(bf16x8, pw);
#pragma unroll
                for (int dt = 0; dt < 4; ++dt) {
                    LAS unsigned char* a0 = vt + (s2 * 32 + fq * 4 + (fr >> 2)) * VST + (dt * 16 + 4 * (fr & 3)) * 2;
                    const s16x4 v0 = lds_tr(a0), v1 = lds_tr(a0 + 16 * VST);
                    bf16x8 vf; vf[0] = v0[0]; vf[1] = v0[1]; vf[2] = v0[2]; vf[3] = v0[3]; vf[4] = v1[0]; vf[5] = v1[1]; vf[6] = v1[2]; vf[7] = v1[3];
                    oacc[dt] = __builtin_amdgcn_mfma_f32_16x16x32_bf16(pf, vf, oacc[dt], 0, 0, 0);
                }
            }
            asm volatile("s_waitcnt lgkmcnt(0)" ::: "memory");
        }
#undef ATT_VLOAD
        const float i0 = 1.f / __shfl(sum, 0), i1 = 1.f / __shfl(sum, 1), i2 = 1.f / __shfl(sum, 2), i3 = 1.f / __shfl(sum, 3);
        if (fq == 0) {
#pragma unroll
            for (int dt = 0; dt < 4; ++dt) {
                bf16* o = Ob + (size_t)row * 1024 + (n * 4) * 64 + dt * 16 + fr;
                o[0] = (bf16)f2bf(oacc[dt][0] * i0); o[64] = (bf16)f2bf(oacc[dt][1] * i1); o[128] = (bf16)f2bf(oacc[dt][2] * i2); o[192] = (bf16)f2bf(oacc[dt][3] * i3);
            }
        }
    }
    asm volatile("s_waitcnt lgkmcnt(0)" ::: "memory");
}

__device__ __forceinline__ void kv8_convert(const bf16* __restrict__ Kb, const bf16* __restrict__ Vb, unsigned char* __restrict__ KV8_, const unsigned* __restrict__ amaxk, const unsigned* __restrict__ amaxv, int gw, int NGW, int lane) {
    const float ak = __builtin_bit_cast(float, __hip_atomic_load(amaxk, __ATOMIC_RELAXED, __HIP_MEMORY_SCOPE_AGENT)), av = __builtin_bit_cast(float, __hip_atomic_load(amaxv, __ATOMIC_RELAXED, __HIP_MEMORY_SCOPE_AGENT));
    const bool isv = lane >= 32; const int l = lane & 31;
    const float sc = isv ? (av > 0.f ? 448.f / av : 0.f) : (ak > 0.f ? 448.f / ak : 0.f);
    for (int t = gw; t < TP; t += NGW) {
        const u32x4 w = *(const u32x4*)((isv ? Vb : Kb) + (size_t)t * 256 + l * 8);
        const float x0 = bflo(w.x) * sc, x1 = bfhi(w.x) * sc, x2 = bflo(w.y) * sc, x3 = bfhi(w.y) * sc, x4 = bflo(w.z) * sc, x5 = bfhi(w.z) * sc, x6 = bflo(w.w) * sc, x7 = bfhi(w.w) * sc;
        int p0 = __builtin_amdgcn_cvt_pk_fp8_f32(x0, x1, 0, false); p0 = __builtin_amdgcn_cvt_pk_fp8_f32(x2, x3, p0, true);
        int p1 = __builtin_amdgcn_cvt_pk_fp8_f32(x4, x5, 0, false); p1 = __builtin_amdgcn_cvt_pk_fp8_f32(x6, x7, p1, true);
        const int n = l >> 3, d0 = (l & 7) * 8;
        const int pos = isv ? 64 + d0 : ((d0 & 31) >> 3) * 16 + (d0 >> 5) * 8;
        u32x2 o; o.x = (unsigned)p0; o.y = (unsigned)p1;
        *(u32x2*)(KV8_ + (size_t)t * 512 + n * 128 + pos) = o;
    }
}
__device__ __forceinline__ void fp8x16_to_bf16(const u32x4 q, bf16x8& lo, bf16x8& hi) {
    u32x4 a, b;
#pragma unroll
    for (int w = 0; w < 4; ++w) { const f32x2v f0 = __builtin_amdgcn_cvt_pk_f32_fp8((int)q[w], false), f1 = __builtin_amdgcn_cvt_pk_f32_fp8((int)q[w], true);
        const unsigned u0 = pk2(f0[0], f0[1]), u1 = pk2(f1[0], f1[1]);
        if (w < 2) { a[2 * w] = u0; a[2 * w + 1] = u1; } else { b[2 * w - 4] = u0; b[2 * w - 3] = u1; } }
    lo = __builtin_bit_cast(bf16x8, a); hi = __builtin_bit_cast(bf16x8, b);
}
#ifndef KF1
#define KF1 10
#endif
__device__ __forceinline__ void attn_prompt_stream(int b, int n, int q0, int qstep, const bf16* __restrict__ Qb, const int* __restrict__ IDX, const unsigned char* __restrict__ KV8_, const unsigned* __restrict__ amaxk, const unsigned* __restrict__ amaxv,
                                                   bf16* __restrict__ Ob, LAS unsigned char* wl, int lane) {
    const float ak_ = __builtin_bit_cast(float, __hip_atomic_load(amaxk, __ATOMIC_RELAXED, __HIP_MEMORY_SCOPE_AGENT)), av_ = __builtin_bit_cast(float, __hip_atomic_load(amaxv, __ATOMIC_RELAXED, __HIP_MEMORY_SCOPE_AGENT));
    const float kinv = ak_ * (1.f / 448.f), vinv = av_ * (1.f / 448.f);
    const int fr = lane & 15, fq = lane >> 4;
    LAS int* ridb = (LAS int*)wl;
    LAS unsigned char* vt = wl + 2048;
    if (q0 >= SEQ) return;
    int vx[4];
    { const int row = b * SEQ + q0, cnt = q0 + 1 < TOPK ? q0 + 1 : TOPK;
#pragma unroll
      for (int i = 0; i < 4; ++i) { const int slot = i * 64 + lane; ridb[slot] = b * SEQ + (slot < cnt ? IDX[(size_t)row * TOPK + slot] : 0); } }
    int buf = 0;

    for (int q = q0; q < SEQ; q += qstep, buf ^= 1) {

        const int row = b * SEQ + q, cnt = q + 1 < TOPK ? q + 1 : TOPK;
        LAS int* rid = ridb + buf * 256;
        asm volatile("s_waitcnt lgkmcnt(0)" ::: "memory");
        int kx[16];
#pragma unroll
        for (int t = 0; t < 16; ++t) kx[t] = rid[t * 16 + fr];
        bf16x8 qf[2];
#pragma unroll
        for (int ks = 0; ks < 2; ++ks) qf[ks] = *(const bf16x8*)(Qb + (size_t)row * 1024 + (n * 4 + (fr & 3)) * 64 + ks * 32 + fq * 8);
        u32x4 kraw[16];
#pragma unroll
        for (int t = 0; t < 16; ++t) kraw[t] = *(const u32x4*)(KV8_ + (size_t)kx[t] * 512 + n * 128 + fq * 16);
        asm volatile("s_waitcnt lgkmcnt(0)" ::: "memory");
        u32x4 vraw[4];
#define ATT_VLOAD2(ch_) do { _Pragma("unroll") for (int i = 0; i < 4; ++i) { const int sl = i * 16 + (lane >> 2), piece = lane & 3; const int id = rid[(ch_) * 64 + sl]; \
            vraw[i] = *(const u32x4*)(KV8_ + (size_t)id * 512 + n * 128 + 64 + piece * 16); } } while (0)
        f32x4 st[16];
#pragma unroll
        for (int t = 0; t < 16; ++t) {
            asm volatile("" : "+v"(kraw[t][0]), "+v"(kraw[t][1]), "+v"(kraw[t][2]), "+v"(kraw[t][3]));
            bf16x8 k0, k1; fp8x16_to_bf16(kraw[t], k0, k1);
            f32x4 a = (f32x4){0.f, 0.f, 0.f, 0.f};
            a = __builtin_amdgcn_mfma_f32_16x16x32_bf16(k0, qf[0], a, 0, 0, 0);
            a = __builtin_amdgcn_mfma_f32_16x16x32_bf16(k1, qf[1], a, 0, 0, 0);
            st[t] = a;
            asm volatile("" : "+v"(st[t][0]), "+v"(st[t][1]), "+v"(st[t][2]), "+v"(st[t][3]));
        }

        const int qn = q + qstep;
        if (qn < SEQ) { const int rown = b * SEQ + qn, cntn = qn + 1 < TOPK ? qn + 1 : TOPK;
#pragma unroll
            for (int i = 0; i < 4; ++i) { const int slot = i * 64 + lane; vx[i] = slot < cntn ? IDX[(size_t)rown * TOPK + slot] : 0; } }
        ATT_VLOAD2(0);
        float mx = -INFINITY;
        if (cnt < TOPK) {
#pragma unroll
            for (int t = 0; t < 16; ++t)
#pragma unroll
                for (int j = 0; j < 4; ++j) { const int slot = t * 16 + fq * 4 + j; st[t][j] = slot < cnt ? st[t][j] : -INFINITY; }
        }
#pragma unroll
        for (int t = 0; t < 16; ++t) mx = fmaxf(mx, fmaxf(fmaxf(st[t][0], st[t][1]), fmaxf(st[t][2], st[t][3])));
        mx = fmaxf(mx, __shfl_xor(mx, 16)); mx = fmaxf(mx, __shfl_xor(mx, 32));
        const float cs = 0.18033688011112042f * kinv, mb = -mx * cs;
        float sum = 0.f;
#pragma unroll
        for (int t = 0; t < 16; ++t)
#pragma unroll
            for (int j = 0; j < 4; ++j) { const float e = __builtin_amdgcn_exp2f(fmaf(st[t][j], cs, mb)); st[t][j] = e; sum += e; }
        sum += __shfl_xor(sum, 16); sum += __shfl_xor(sum, 32);

        f32x4 oacc[4];
#pragma unroll
        for (int dt = 0; dt < 4; ++dt) oacc[dt] = (f32x4){0.f, 0.f, 0.f, 0.f};
#pragma unroll
        for (int ch = 0; ch < 4; ++ch) {
#pragma unroll
            for (int i = 0; i < 4; ++i) { const int sl = i * 16 + (lane >> 2), piece = lane & 3; bf16x8 v0, v1; fp8x16_to_bf16(vraw[i], v0, v1);
                *(LAS bf16x8*)(vt + sl * VST + piece * 32) = v0; *(LAS bf16x8*)(vt + sl * VST + piece * 32 + 16) = v1; }
            asm volatile("s_waitcnt lgkmcnt(0)" ::: "memory");
            if (ch < 3) ATT_VLOAD2(ch + 1);
#pragma unroll
            for (int s2 = 0; s2 < 2; ++s2) {
                const int t0 = ch * 4 + s2 * 2;
                const u32x4 pw = pack8(st[t0], st[t0 + 1]);
                const bf16x8 pf = __builtin_bit_cast(bf16x8, pw);
#pragma unroll
                for (int dt = 0; dt < 4; ++dt) {
                    LAS unsigned char* a0 = vt + (s2 * 32 + fq * 4 + (fr >> 2)) * VST + (dt * 16 + 4 * (fr & 3)) * 2;
                    const s16x4 v0 = lds_tr(a0), v1 = lds_tr(a0 + 16 * VST);
                    bf16x8 vf; vf[0] = v0[0]; vf[1] = v0[1]; vf[2] = v0[2]; vf[3] = v0[3]; vf[4] = v1[0]; vf[5] = v1[1]; vf[6] = v1[2]; vf[7] = v1[3];
                    oacc[dt] = __builtin_amdgcn_mfma_f32_16x16x32_bf16(pf, vf, oacc[dt], 0, 0, 0);
                }
            }
            asm volatile("s_waitcnt lgkmcnt(0)" ::: "memory");
        }
#undef ATT_VLOAD2

        const float i0 = vinv / __shfl(sum, 0), i1 = vinv / __shfl(sum, 1), i2 = vinv / __shfl(sum, 2), i3 = vinv / __shfl(sum, 3);
        if (fq == 0) {
#pragma unroll
            for (int dt = 0; dt < 4; ++dt) {
                bf16* o = Ob + (size_t)row * 1024 + (n * 4) * 64 + dt * 16 + fr;
                o[0] = (bf16)f2bf(oacc[dt][0] * i0); o[64] = (bf16)f2bf(oacc[dt][1] * i1); o[128] = (bf16)f2bf(oacc[dt][2] * i2); o[192] = (bf16)f2bf(oacc[dt][3] * i3);
            }
        }
        if (qn < SEQ) {
#pragma unroll
            for (int i = 0; i < 4; ++i) ridb[(buf ^ 1) * 256 + i * 64 + lane] = vx[i] + b * SEQ;
        }

    }

    asm volatile("s_waitcnt lgkmcnt(0)" ::: "memory");
}

__device__ __forceinline__ void ln_row_load(const bf16* __restrict__ zrow, u32x2 (&w)[4], int lane) {
#pragma unroll
    for (int j = 0; j < 4; ++j) w[j] = *(const u32x2*)(zrow + 256 * j + 4 * lane);
}
__device__ __forceinline__ void ln_row_finish(const u32x2 (&w)[4], const float* __restrict__ g, const float* __restrict__ bt, float* __restrict__ of, bf16* __restrict__ ob, int lane) {
    f32x4 v[4]; float s = 0.f;
#pragma unroll
    for (int j = 0; j < 4; ++j) { v[j] = (f32x4){bflo(w[j].x), bfhi(w[j].x), bflo(w[j].y), bfhi(w[j].y)}; s += (v[j][0] + v[j][1]) + (v[j][2] + v[j][3]); }
#pragma unroll
    for (int o = 1; o < 64; o <<= 1) s += __shfl_xor(s, o);
    const float mean = s * (1.f / D); float q = 0.f;
#pragma unroll
    for (int j = 0; j < 4; ++j) { v[j] = v[j] - mean; q += (v[j][0] * v[j][0] + v[j][1] * v[j][1]) + (v[j][2] * v[j][2] + v[j][3] * v[j][3]); }
#pragma unroll
    for (int o = 1; o < 64; o <<= 1) q += __shfl_xor(q, o);
    const float rstd = rsqrtf(q * (1.f / D) + LN_EPS);
#pragma unroll
    for (int j = 0; j < 4; ++j) { const f32x4 gg = *(const f32x4*)(g + 256 * j + 4 * lane), bb = *(const f32x4*)(bt + 256 * j + 4 * lane); const f32x4 o = v[j] * rstd * gg + bb;
        if (of) *(f32x4*)(of + 256 * j + 4 * lane) = o; u32x2 wo; wo.x = pk2(o[0], o[1]); wo.y = pk2(o[2], o[3]); *(u32x2*)(ob + 256 * j + 4 * lane) = wo; }
}
__device__ __forceinline__ void ln_rows(const bf16* __restrict__ Zb, const float* __restrict__ g, const float* __restrict__ bt, bf16* __restrict__ Hb, int gw, int NGW, int lane) {
    if (gw >= TA) return;
    u32x2 cur[4], nxt[4];
    ln_row_load(Zb + (size_t)gw * D, cur, lane);
    for (int r = gw; r < TA; r += NGW) {
        const int rn = r + NGW;
        if (rn < TA) ln_row_load(Zb + (size_t)rn * D, nxt, lane);
        ln_row_finish(cur, g, bt, (float*)nullptr, Hb + (size_t)r * D, lane);
#pragma unroll
        for (int j = 0; j < 4; ++j) cur[j] = nxt[j];
    }
}

struct FResid {
    const float* rp; const float* rs; bf16* Z;
    __device__ __forceinline__ const float* rrow(int row) const { return row < TP ? rp + (size_t)row * D : rs + (size_t)(row - TP) * D; }
    __device__ __forceinline__ void put8(int row, int col, f32x4 v0, f32x4 v1) const { const float* r = rrow(row) + col;
        *(u32x4*)(Z + (size_t)row * D + col) = pack8(v0 + ALPHA * *(const f32x4*)r, v1 + ALPHA * *(const f32x4*)(r + 4)); }
    __device__ __forceinline__ void put4(int row, int col, f32x4 v) const { const f32x4 z = v + ALPHA * *(const f32x4*)(rrow(row) + col); u32x2 w; w.x = pk2(z[0], z[1]); w.y = pk2(z[2], z[3]); *(u32x2*)(Z + (size_t)row * D + col) = w; }
};
struct FResidB {
    const bf16* rp; const bf16* rs; bf16* Z;
    __device__ __forceinline__ const bf16* rrow(int row) const { return row < TP ? rp + (size_t)row * D : rs + (size_t)(row - TP) * D; }
    __device__ __forceinline__ void put8(int row, int col, f32x4 v0, f32x4 v1) const { const u32x4 r = *(const u32x4*)(rrow(row) + col);
        const f32x4 r0 = (f32x4){bflo(r.x), bfhi(r.x), bflo(r.y), bfhi(r.y)}, r1 = (f32x4){bflo(r.z), bfhi(r.z), bflo(r.w), bfhi(r.w)};
        *(u32x4*)(Z + (size_t)row * D + col) = pack8(v0 + ALPHA * r0, v1 + ALPHA * r1); }
    __device__ __forceinline__ void put4(int row, int col, f32x4 v) const { const u32x2 r = *(const u32x2*)(rrow(row) + col); const f32x4 z = v + ALPHA * (f32x4){bflo(r.x), bfhi(r.x), bflo(r.y), bfhi(r.y)};
        u32x2 w; w.x = pk2(z[0], z[1]); w.y = pk2(z[2], z[3]); *(u32x2*)(Z + (size_t)row * D + col) = w; }
};
}

namespace mk {
template <int CAP>
__device__ __forceinline__ void topk_wave_regs(const float* __restrict__ row, int n, int* __restrict__ out, LAS unsigned* hist, LAS float* cv, LAS int* ci, LAS unsigned char* lst, int lane) {
    if (n <= TOPK) { for (int i = lane; i < TOPK; i += 64) out[i] = i < n ? i : 0; return; }

    constexpr int NCH = 32;
    const int nch = n > 8192 ? 32 : (n + 255) >> 8;
    float vx = (lane < 4 && 8192 + lane < n) ? row[8192 + lane] : -INFINITY;
    f32x4 v[NCH];
#pragma unroll
    for (int j = 0; j < NCH; ++j) {
        if (j < nch) v[j] = *(const f32x4*)(row + j * 256 + lane * 4);
        else v[j] = (f32x4){-INFINITY, -INFINITY, -INFINITY, -INFINITY};
    }
    float mn = INFINITY, mx = -INFINITY;
#pragma unroll
    for (int j = 0; j < NCH; ++j) {
        if (j < nch) {
            const int base = j * 256 + lane * 4;
#pragma unroll
            for (int e = 0; e < 4; ++e) { const bool ok = base + e < n; const float x = v[j][e]; v[j][e] = ok ? x : -INFINITY; mx = fmaxf(mx, ok ? x : -INFINITY); mn = fminf(mn, ok ? x : INFINITY); }
        }
    }
    if (vx != -INFINITY) { mx = fmaxf(mx, vx); mn = fminf(mn, vx); }
#pragma unroll
    for (int o = 1; o < 64; o <<= 1) { mn = fminf(mn, __shfl_xor(mn, o)); mx = fmaxf(mx, __shfl_xor(mx, o)); }
    if (!(mx > mn)) { for (int i = lane; i < TOPK; i += 64) out[i] = i; return; }
    const float scale = 2048.0f / (mx - mn);

#pragma unroll
    for (int i = 0; i < 8; ++i) *(LAS u32x4*)(hist + i * 256 + lane * 4) = (u32x4){0u, 0u, 0u, 0u};
    asm volatile("s_waitcnt lgkmcnt(0)" ::: "memory");
#pragma unroll
    for (int j = 0; j < NCH; ++j) {
        if (j < nch) {
            asm volatile("" : "+v"(v[j][0]), "+v"(v[j][1]), "+v"(v[j][2]), "+v"(v[j][3]));
#pragma unroll
            for (int e = 0; e < 4; ++e) { const float x = v[j][e]; int bn = (int)((x - mn) * scale); bn = bn > 2047 ? 2047 : bn; bn = x != -INFINITY ? bn : 2048;
                __hip_atomic_fetch_add(hist + bn, 1u, __ATOMIC_RELAXED, __HIP_MEMORY_SCOPE_WAVEFRONT); }
        }
    }
    if (vx != -INFINITY) { int bn = (int)((vx - mn) * scale); bn = bn > 2047 ? 2047 : bn; __hip_atomic_fetch_add(hist + bn, 1u, __ATOMIC_RELAXED, __HIP_MEMORY_SCOPE_WAVEFRONT); }
    asm volatile("s_waitcnt lgkmcnt(0)" ::: "memory");

    unsigned mine = 0u;
#pragma unroll
    for (int i = 0; i < 8; ++i) { const u32x4 h4 = *(LAS u32x4*)(hist + lane * 32 + i * 4); mine += (h4.x + h4.y) + (h4.z + h4.w); }
    unsigned suf = mine;
#pragma unroll
    for (int o = 1; o < 64; o <<= 1) { const unsigned t = __shfl_down(suf, o); if (lane + o < 64) suf += t; }
    const unsigned long long bal = __ballot(suf >= (unsigned)TOPK);
    const int Lt = 63 - __builtin_clzll(bal);
    const unsigned above = __shfl(suf, Lt) - __shfl(mine, Lt);
    const unsigned hb = hist[Lt * 32 + (lane & 31)];
    unsigned sfx = hb;
#pragma unroll
    for (int o = 1; o < 32; o <<= 1) { const unsigned t = __shfl_down(sfx, o); if ((lane & 31) + o < 32) sfx += t; }
    const unsigned long long okm = __ballot(above + sfx >= (unsigned)TOPK) & 0xFFFFFFFFull;
    const int jb = 63 - __builtin_clzll(okm);
    const int B = Lt * 32 + jb;
    const unsigned running = above + __shfl(sfx, jb) - __shfl(hb, jb);
    const int cnt_gt = (int)running, r = TOPK - cnt_gt;

    int base_gt = 0, base_eq = 0;
    const unsigned long long below = (1ull << lane) - 1ull;
    int lane4 = lane * 4; asm volatile("" : "+v"(lane4));
#pragma unroll
    for (int j = 0; j < NCH; ++j) {
        if (j < nch) {
#pragma unroll
            for (int e = 0; e < 4; ++e) {
                const float x = v[j][e]; int bn = (int)((x - mn) * scale); bn = bn > 2047 ? 2047 : bn; bn = x != -INFINITY ? bn : -1;
                const bool gt = bn > B, eq = bn == B;
                const unsigned long long mg = __ballot(gt), me = __ballot(eq);
                if (mg | me) {
                    const int idx = lane4 + (j * 256 + e);
                    if (gt) out[base_gt + __builtin_popcountll(mg & below)] = idx;
                    if (eq) { const int p = base_eq + __builtin_popcountll(me & below); if (p < CAP) { cv[p] = x; ci[p] = idx; } }
                    base_gt += __builtin_popcountll(mg); base_eq += __builtin_popcountll(me);
                }
            }
        }
    }
    if (n > 8192) {
        const float x = vx; bool gt = false, eq = false;
        if (x != -INFINITY) { int bn = (int)((x - mn) * scale); bn = bn > 2047 ? 2047 : bn; gt = bn > B; eq = bn == B; }
        const unsigned long long mg = __ballot(gt), me = __ballot(eq);
        const int idx = 8192 + lane;
        if (gt) out[base_gt + __builtin_popcountll(mg & below)] = idx;
        if (eq) { const int p = base_eq + __builtin_popcountll(me & below); if (p < CAP) { cv[p] = x; ci[p] = idx; } }
        base_gt += __builtin_popcountll(mg); base_eq += __builtin_popcountll(me);
    }
    asm volatile("s_waitcnt vmcnt(0) lgkmcnt(0)" ::: "memory");

    const int m = base_eq < CAP ? base_eq : CAP;
    if (m <= 64) {
        const float x = lane < m ? cv[lane] : -INFINITY; const int id = lane < m ? ci[lane] : 0x7fffffff; int rank = 0;
        for (int c2 = 0; c2 < m; ++c2) { const float x2 = __builtin_bit_cast(float, __builtin_amdgcn_readlane(__builtin_bit_cast(int, x), c2)); const int id2 = __builtin_amdgcn_readlane(id, c2);
            rank += (x2 > x || (x2 == x && id2 < id)) ? 1 : 0; }
        if (lane < m && rank < r) out[cnt_gt + rank] = id;
    } else {
        for (int c = lane; c < m; c += 64) {
            const float x = cv[c]; const int id = ci[c]; int rank = 0;
            for (int c2 = 0; c2 < m; ++c2) { const float x2 = cv[c2]; const int id2 = ci[c2]; rank += (x2 > x || (x2 == x && id2 < id)) ? 1 : 0; }
            if (rank < r) out[cnt_gt + rank] = id;
        }
    }
    asm volatile("s_waitcnt lgkmcnt(0)" ::: "memory");

}

__device__ __forceinline__ void phase_topk2(const float* __restrict__ SC, const float* __restrict__ SCS, int* __restrict__ IDX, int* __restrict__ CNT,
                                            const float* __restrict__ peer_u_, const float* __restrict__ peer_v_, unsigned char* __restrict__ Uq_, unsigned char* __restrict__ Vq_, float* __restrict__ Usc_, float* __restrict__ Vsc_,
                                            LAS unsigned char* lds, unsigned* qhead, int wave, int lane, int gw, int NGW, int jlo = 0, int jhi = TA) {
    constexpr int CAP = 1020;
    LAS unsigned* hist = (LAS unsigned*)(lds + wave * 16384);
    LAS float* cv = (LAS float*)(lds + wave * 16384 + 8208);
    LAS int* ci = (LAS int*)(lds + wave * 16384 + 8208 + 4080);
    LAS unsigned char* lst = nullptr;

    for (int j = gw; j < TA; j += NGW) {
        if (j < jlo || j >= jhi) continue;
        int row, n; const float* rp;
        if (j < TP) { const int b = j >> 13, jj = j & 8191, blk = jj >> 11; const int q = blk < 2 ? jj : blk * 2048 + 2047 - (jj & 2047);
            row = b * SEQ + q; n = q + 1; rp = SC + (size_t)row * SEQ; }
        else { const int r = j - TP; row = j; n = PAST + (r % DS) + 1; rp = SCS + (size_t)r * SCS_LD; }

        topk_wave_regs<CAP>(rp, n, IDX + (size_t)row * TOPK, hist, cv, ci, lst, lane);

        if (lane == 0) CNT[row] = n < TOPK ? n : TOPK;
    }

}
}

namespace mk {
using bf16x2_t = __attribute__((ext_vector_type(2))) __bf16;
__device__ __forceinline__ float dot2bf(unsigned a, unsigned b, float acc) { return __builtin_amdgcn_fdot2_f32_bf16(__builtin_bit_cast(bf16x2_t, a), __builtin_bit_cast(bf16x2_t, b), acc, false); }

struct FStoreBf16 {
    bf16* O; int ld;
    __device__ __forceinline__ void put8(int row, int col, f32x4 v0, f32x4 v1) const { *(u32x4*)(O + (size_t)row * ld + col) = pack8(v0, v1); }
    __device__ __forceinline__ void put4(int row, int col, f32x4 v) const { u32x2 w; w.x = pk2(v[0], v[1]); w.y = pk2(v[2], v[3]); *(u32x2*)(O + (size_t)row * ld + col) = w; }
};

#ifndef PGS
#define PGS 8
#endif
#ifndef PEER_UMFMA
#define PEER_UMFMA 0
#endif
#ifndef PEER_XFMT
#define PEER_XFMT 4
#endif
constexpr int PEER_TAB_OFF = LDSCTL_OFF + 1024;

__device__ __forceinline__ void ce_desc(unsigned& a, unsigned& b) { const unsigned hi = a > b ? a : b, lo = a > b ? b : a; a = hi; b = lo; }
template <int N> __device__ __forceinline__ void bitonic_sort_desc(unsigned (&k)[N]) {
#pragma unroll
    for (int size = 2; size <= N; size <<= 1)
#pragma unroll
        for (int stride = size >> 1; stride > 0; stride >>= 1)
#pragma unroll
            for (int i = 0; i < N; ++i) { const int j = i ^ stride; if (j > i) { if ((i & size) == 0) ce_desc(k[i], k[j]); else ce_desc(k[j], k[i]); } }
}
template <int N> __device__ __forceinline__ void bitonic_merge_desc(unsigned (&k)[N]) {
#pragma unroll
    for (int stride = N >> 1; stride > 0; stride >>= 1)
#pragma unroll
        for (int i = 0; i < N; ++i) { const int j = i ^ stride; if (j > i) ce_desc(k[i], k[j]); }
}
__device__ __forceinline__ void top16_merge(unsigned (&a)[16], const unsigned (&b)[16]) {
#pragma unroll
    for (int i = 0; i < 16; ++i) a[i] = a[i] > b[15 - i] ? a[i] : b[15 - i];
    bitonic_merge_desc<16>(a);
}
__device__ __forceinline__ void top16_xlane(unsigned (&a)[16], int o) {
    unsigned b[16];
#pragma unroll
    for (int i = 0; i < 16; ++i) b[i] = (unsigned)__shfl_xor((int)a[i], o);
    top16_merge(a, b);
}
__device__ __forceinline__ unsigned f2ord(float f) { const unsigned u = __builtin_bit_cast(unsigned, f); return u ^ ((u >> 31) ? 0xFFFFFFFFu : 0x80000000u); }
__device__ __forceinline__ float ord2f(unsigned o) { const unsigned u = o ^ ((o >> 31) ? 0x80000000u : 0xFFFFFFFFu); return __builtin_bit_cast(float, u); }

__device__ __forceinline__ void phase_peer_select(const bf16* __restrict__ PQb, const bf16* __restrict__ K1, const bf16* __restrict__ K2, unsigned short* __restrict__ teid_g, float* __restrict__ tgate_g,
                                                  LAS unsigned char* lds, int vcu, int G, int wave, int lane, unsigned* sflag = nullptr) {
    const int fr = lane & 15, fq = lane >> 4, h = wave;
    LAS unsigned char* itab = lds + wave * 1024;
    const int n_own = vcu < TA / 16 ? (TA / 16 - 1 - vcu) / G + 1 : 0;
    const int n_pr = vcu < TP / 16 ? (TP / 16 - 1 - vcu) / G + 1 : 0;
    const int ns = sflag ? n_own - n_pr : 0;
    for (int q = 0; q < n_own; ++q) {
        const int tile = q < ns ? vcu + (n_pr + q) * G : vcu + (q - ns) * G;
        const int tok0 = tile * 16;
        unsigned tk[2][16];
#pragma unroll
        for (int half = 0; half < 2; ++half) {
            const bf16* ap = PQb + (size_t)(tok0 + fr) * PEER_N + h * 256 + half * 128 + fq * 8;
            bf16x8 a[4];
#pragma unroll
            for (int ks = 0; ks < 4; ++ks) a[ks] = *(const bf16x8*)(ap + ks * 32);
            const bf16* kb = (half ? K2 : K1) + (size_t)fr * 128 + fq * 8;
            unsigned k0[16], k1[16];
#pragma unroll
            for (int ct = 0; ct < 8; ++ct) {
                f32x4 acc = (f32x4){0.f, 0.f, 0.f, 0.f};
#pragma unroll
                for (int ks = 0; ks < 4; ++ks) { const bf16x8 b = *(const bf16x8*)(kb + (size_t)ct * 16 * 128 + ks * 32); acc = __builtin_amdgcn_mfma_f32_16x16x32_bf16(b, a[ks], acc, 0, 0, 0); }
#pragma unroll
                for (int j = 0; j < 4; ++j) { const unsigned key = (f2ord(acc[j]) & 0xFFFFFF80u) | (unsigned)(127 - (ct * 16 + 4 * fq + j));
                    if (ct < 4) k0[ct * 4 + j] = key; else k1[(ct - 4) * 4 + j] = key; }
                if (ct & 1) asm volatile("" ::: "memory");
            }
            bitonic_sort_desc<16>(k0); bitonic_sort_desc<16>(k1);
            top16_merge(k0, k1); top16_xlane(k0, 16); top16_xlane(k0, 32);
#pragma unroll
            for (int i = 0; i < 16; ++i) tk[half][i] = k0[i];
        }
        if (fq == 0) {
#pragma unroll
            for (int i = 0; i < 16; ++i) { itab[fr * 32 + i] = (unsigned char)(127 - (tk[0][i] & 0x7Fu)); itab[fr * 32 + 16 + i] = (unsigned char)(127 - (tk[1][i] & 0x7Fu)); }
        }
        unsigned ck[16];
        {
            float v1[16], v2[16];
#pragma unroll
            for (int i = 0; i < 16; ++i) { v1[i] = ord2f(tk[0][i] & 0xFFFFFF80u); v2[i] = ord2f(tk[1][i] & 0xFFFFFF80u); }
            int c = 0;
#pragma unroll
            for (int i = 0; i < 16; ++i)
#pragma unroll
                for (int j = 0; j < 16; ++j) {
                    if ((i + 1) * (j + 1) <= 16) {
                        const unsigned key = (f2ord(v1[i] + v2[j]) & 0xFFFFFF00u) | (unsigned)(255 - (i * 16 + j));
                        const int m = c >> 2, pt = c & 3;
                        if (pt == 0) ck[m] = key; else ck[m] = fq == pt ? key : ck[m];
                        ++c;
                    }
                }
            ck[12] = fq < 2 ? ck[12] : 0u; ck[13] = 0u; ck[14] = 0u; ck[15] = 0u;
        }
        bitonic_sort_desc<16>(ck); top16_xlane(ck, 16); top16_xlane(ck, 32);
        asm volatile("s_waitcnt lgkmcnt(0)" ::: "memory");
        float ev[16]; float sum = 0.f; const float mxv = ord2f(ck[0] & 0xFFFFFF00u);
#pragma unroll
        for (int k = 0; k < 16; ++k) { ev[k] = __expf(ord2f(ck[k] & 0xFFFFFF00u) - mxv); sum += ev[k]; }
        const float inv = 1.f / sum;
#pragma unroll
        for (int k = 0; k < 16; ++k) {
            if ((k >> 2) == fq) {
                const int f = 255 - (int)(ck[k] & 0xFFu); const int id = (int)itab[fr * 32 + (f >> 4)] * 128 + (int)itab[fr * 32 + 16 + (f & 15)];
                teid_g[(size_t)(tok0 + fr) * 128 + h * 16 + k] = (unsigned short)id; tgate_g[(size_t)(tok0 + fr) * 128 + h * 16 + k] = ev[k] * inv;
            }
        }
        asm volatile("s_waitcnt lgkmcnt(0)" ::: "memory");
        if (ns > 0 && q == ns - 1) {
            asm volatile("s_waitcnt vmcnt(0)" ::: "memory");
            __syncthreads();
            if (threadIdx.x == 0) { __builtin_amdgcn_fence(__ATOMIC_RELEASE, "agent"); asm volatile("s_waitcnt vmcnt(0)" ::: "memory"); __hip_atomic_fetch_add(sflag, (unsigned)ns, __ATOMIC_RELAXED, __HIP_MEMORY_SCOPE_AGENT); }
        }
    }
}

#if PEER_BITS == 4
__device__ __forceinline__ u32x4 prow_load(const unsigned char* __restrict__ T, int id, int lane) { const u32x2 r = *(const u32x2*)(T + (size_t)id * PEER_RS + lane * 8); u32x4 t; t.x = r.x; t.y = r.y; t.z = 0u; t.w = 0u; return t; }
#define PROW_LOAD(T, id) prow_load(T, id, lane)
#elif PEER_BITS == 6
typedef unsigned v6u_t __attribute__((ext_vector_type(6)));
typedef float v32f_t __attribute__((ext_vector_type(32)));
__device__ __forceinline__ u32x4 prow_load(const unsigned char* __restrict__ T, int id, int lane) { const unsigned* rp = (const unsigned*)(T + (size_t)id * PEER_RB + lane * 12); u32x4 t; t.x = rp[0]; t.y = rp[1]; t.z = rp[2]; t.w = 0u; return t; }
#define PROW_LOAD(T, id) prow_load(T, id, lane)
#else
#define PROW_LOAD(T, id) (*(const u32x4*)((T) + (size_t)(id) * D + lane * 16))
#endif
#ifndef PEER_SCOOP
#define PEER_SCOOP 0
#endif
#ifndef PEER_LOCAL
#define PEER_LOCAL 1
#endif
#if PEER_BITS == 4 && PEER_SCOOP
#define MIX_JEND TP
#else
#define MIX_JEND (TP + TS * 16)
#endif
#ifndef PEER_PAIRLD
#define PEER_PAIRLD 0
#endif
#if PEER_BITS == 4 && PEER_PAIRLD
#define PROW_STEP 2
#define PROWS_LOAD(T_, qbuf_, ev_, base_, i_) { const int ida_ = __builtin_amdgcn_readlane(ev_, (base_) + (i_)), idb_ = __builtin_amdgcn_readlane(ev_, (base_) + (i_) + 1); const int idl_ = lane < 32 ? ida_ : idb_; \
    qbuf_[i_] = *(const u32x4*)((T_) + (size_t)idl_ * PEER_RS + (lane & 31) * 16); }
__device__ __forceinline__ u32x2 prow_pair_get(const u32x4 raw, int which, int lane) {
    const int src = ((which ? 32 : 0) + (lane >> 1)) << 2;
    const unsigned a = (unsigned)__builtin_amdgcn_ds_bpermute(src, (int)raw.x), b = (unsigned)__builtin_amdgcn_ds_bpermute(src, (int)raw.y), c = (unsigned)__builtin_amdgcn_ds_bpermute(src, (int)raw.z), d = (unsigned)__builtin_amdgcn_ds_bpermute(src, (int)raw.w);
    u32x2 r; r.x = (lane & 1) ? c : a; r.y = (lane & 1) ? d : b; return r;
}
#define PROW_GET(qbuf_, i_) prow_pair_get(qbuf_[(i_) & ~1], (i_) & 1, lane)
#else
#define PROW_STEP 1
#define PROWS_LOAD(T_, qbuf_, ev_, base_, i_) { const int id_ = __builtin_amdgcn_readlane(ev_, (base_) + (i_)); qbuf_[i_] = PROW_LOAD(T_, id_); }
__device__ __forceinline__ u32x2 prow_plain_get(const u32x4 raw) { u32x2 r; r.x = raw.x; r.y = raw.y; return r; }
#define PROW_GET(qbuf_, i_) prow_plain_get(qbuf_[i_])
#endif
#define SHX_(v_, o_) __builtin_bit_cast(float, __builtin_amdgcn_ds_bpermute((lane ^ (o_)) << 2, __builtin_bit_cast(int, (float)(v_))))
__device__ __forceinline__ void phase_peer_mix(const bf16* __restrict__ Zin, const float* __restrict__ g1, const float* __restrict__ b1, const unsigned short* __restrict__ teid, const float* __restrict__ tgate,
                                               const unsigned char* __restrict__ U, const unsigned char* __restrict__ V, const float* __restrict__ Us, const float* __restrict__ Vs, const float* __restrict__ g2, const float* __restrict__ b2,
                                               float* __restrict__ outf, bf16* __restrict__ outb, LAS unsigned char* wl, int gw, int NGW, int lane_in, unsigned* sflag = nullptr) {

#if PEER_LOCAL
    const int vcu_ = gw >> 3, wave_ = gw & 7, G_ = NGW >> 3;
    const int n_pr_ = vcu_ < TP / 16 ? (TP / 16 - 1 - vcu_) / G_ + 1 : 0;
    int st_ = vcu_ - 8 + wave_ * G_; while (st_ < 0) st_ += 8 * G_;
    bool flag_ok_ = false;
    for (int q_ = 0; ; ++q_) {
#else
    for (int j = gw; j < MIX_JEND; j += NGW) {
#endif
        int lane = lane_in; asm volatile("" : "+v"(lane));
        size_t tok;
#if PEER_LOCAL
        if (q_ < 2 * n_pr_) tok = (size_t)(vcu_ + (q_ >> 1) * G_) * 16 + wave_ + (q_ & 1) * 8;
        else {
            if (st_ >= TS) break;
            if (!flag_ok_) {
                unsigned sp_ = 0u;
                while (__hip_atomic_load(sflag, __ATOMIC_RELAXED, __HIP_MEMORY_SCOPE_AGENT) < (unsigned)(TS / 16)) { __builtin_amdgcn_s_sleep(2); if (++sp_ > (1u << 22)) break; }
                __builtin_amdgcn_fence(__ATOMIC_ACQUIRE, "agent"); asm volatile("s_waitcnt vmcnt(0)" ::: "memory");
                flag_ok_ = true;
            }
            tok = (size_t)TP + st_; st_ += 8 * G_;
        }
#else
        if (j < TP) tok = (size_t)j;
        else { const int s = j - TP; if ((s & 15) != 0) continue; tok = (size_t)TP + (s >> 4); }
#endif
        {
            float xf[16];
            { float s1 = 0.f;
#pragma unroll
              for (int q = 0; q < 2; ++q) { const u32x4 w = *(const u32x4*)(Zin + tok * D + lane * 16 + q * 8);
#pragma unroll
                  for (int i = 0; i < 4; ++i) { xf[q * 8 + 2 * i] = bflo(w[i]); xf[q * 8 + 2 * i + 1] = bfhi(w[i]); s1 += xf[q * 8 + 2 * i] + xf[q * 8 + 2 * i + 1]; } }
#pragma unroll
              for (int o = 1; o < 64; o <<= 1) s1 += SHX_(s1, o);
              const float mean1 = s1 * (1.f / D); float q1 = 0.f;
#pragma unroll
              for (int i = 0; i < 16; ++i) { xf[i] -= mean1; q1 += xf[i] * xf[i]; }
#pragma unroll
              for (int o = 1; o < 64; o <<= 1) q1 += SHX_(q1, o);
              const float rstd1 = rsqrtf(q1 * (1.f / D) + LN_EPS);
#pragma unroll
              for (int q = 0; q < 4; ++q) { const f32x4 gg = *(const f32x4*)(g1 + lane * 16 + q * 4), bb = *(const f32x4*)(b1 + lane * 16 + q * 4);
#pragma unroll
                  for (int i = 0; i < 4; ++i) xf[q * 4 + i] = xf[q * 4 + i] * rstd1 * gg[i] + bb[i]; } }
            float wv0 = 0.f, wv1 = 0.f;
#if PEER_BITS == 4 && PEER_UMFMA
            {
                typedef int v8i_t __attribute__((ext_vector_type(8)));
                const int n16 = lane & 15, kq = lane >> 4;
                unsigned idp[4];
#pragma unroll
                for (int t = 0; t < 4; ++t) idp[t] = (unsigned)teid[tok * 128 + t * 16 + n16] | ((unsigned)teid[tok * 128 + (t + 4) * 16 + n16] << 16);
                float am = 0.f;
#pragma unroll
                for (int i = 0; i < 16; ++i) am = fmaxf(am, fabsf(xf[i]));
#pragma unroll
                for (int o = 1; o < 64; o <<= 1) am = fmaxf(am, SHX_(am, o));
#if PEER_XFMT == 8
                const float xinv = am > 0.f ? 448.f / am : 0.f, sx = am * (1.f / 448.f);
                { u32x4 w;
#pragma unroll
                  for (int q = 0; q < 4; ++q) { int x = __builtin_amdgcn_cvt_pk_fp8_f32(xf[q * 4] * xinv, xf[q * 4 + 1] * xinv, 0, false); x = __builtin_amdgcn_cvt_pk_fp8_f32(xf[q * 4 + 2] * xinv, xf[q * 4 + 3] * xinv, x, true); w[q] = (unsigned)x; }
                  *(LAS u32x4*)(wl + lane * 16) = w; }
#else
                const float xinv = am > 0.f ? 6.f / am : 0.f, sx = am * (1.f / 6.f);
                { u32x2 whi, wlo; whi.x = 0u; whi.y = 0u; wlo.x = 0u; wlo.y = 0u;
#pragma unroll
                  for (int i = 0; i < 16; ++i) {
                      const float xs = xf[i] * xinv, a = fabsf(xs);
                      const float gq = a < 2.f ? rintf(a * 2.f) * 0.5f : (a < 4.f ? rintf(a) : fminf(6.f, 2.f * rintf(a * 0.5f)));
                      const unsigned chi = (unsigned)(gq < 2.f ? gq * 2.f : (gq < 4.f ? gq + 2.f : gq * 0.5f + 4.f)) | (xs < 0.f ? 8u : 0u);
                      const float r = (xs - (xs < 0.f ? -gq : gq)) * 4.f;
                      const unsigned clo = enc_e2m1(r);
                      if (i < 8) { whi.x |= chi << (4 * i); wlo.x |= clo << (4 * i); } else { whi.y |= chi << (4 * (i - 8)); wlo.y |= clo << (4 * (i - 8)); }
                  }
                  *(LAS u32x2*)(wl + lane * 8) = whi; *(LAS u32x2*)(wl + 512 + lane * 8) = wlo; }
#endif
#pragma unroll
                for (int q = 0; q < 4; ++q) *(LAS f32x4*)(wl + 1024 + q * 1024 + lane * 16) = (f32x4){xf[q * 4], xf[q * 4 + 1], xf[q * 4 + 2], xf[q * 4 + 3]};
                float h0 = 0.f, h1 = 0.f;
                u32x4 qb[3][4];
#define PU_TILE(u_) ((((u_) >> 3) << 2) | ((u_) & 3))
#define PU_HALF(u_) (((u_) >> 2) & 1)
#define PU_LOADU(u_) { const unsigned id_ = ((u_) >> 3) ? (idp[(u_) & 3] >> 16) : (idp[(u_) & 3] & 0xFFFFu); const unsigned char* rp_ = U + (size_t)id_ * PEER_RB + PU_HALF(u_) * 256 + kq * 16; _Pragma("unroll") for (int jj = 0; jj < 4; ++jj) qb[(u_) % 3][jj] = *(const u32x4*)(rp_ + jj * 64); }
                PU_LOADU(0) PU_LOADU(1)
#pragma unroll
                for (int g = 0; g < 2; ++g) {
                    f32x4 acc[4];
#pragma unroll
                    for (int t = 0; t < 4; ++t) acc[t] = (f32x4){0.f, 0.f, 0.f, 0.f};
#pragma unroll
                    for (int ph = 0; ph < 2; ++ph) {
#if PEER_XFMT == 8
                        v8i_t aop[4];
#pragma unroll
                        for (int jj = 0; jj < 4; ++jj) { const int j = ph * 4 + jj; const u32x4 a0 = *(const LAS u32x4*)(wl + j * 128 + kq * 32), a1 = *(const LAS u32x4*)(wl + j * 128 + kq * 32 + 16);
                            aop[jj] = (v8i_t){(int)a0.x, (int)a0.y, (int)a0.z, (int)a0.w, (int)a1.x, (int)a1.y, (int)a1.z, (int)a1.w}; }
#else
                        u32x4 ahi[4], alo[4];
#pragma unroll
                        for (int jj = 0; jj < 4; ++jj) { const int j = ph * 4 + jj; ahi[jj] = *(const LAS u32x4*)(wl + j * 64 + kq * 16); alo[jj] = *(const LAS u32x4*)(wl + 512 + j * 64 + kq * 16); }
#endif
#pragma unroll
                        for (int t = 0; t < 4; ++t) {
                            const int u = g * 8 + ph * 4 + t;
                            if (u + 2 < 16) PU_LOADU(u + 2)
                            asm volatile("" ::: "memory");
#pragma unroll
                            for (int jj = 0; jj < 4; ++jj) { const u32x4 b = qb[u % 3][jj]; const v8i_t bop = (v8i_t){(int)b.x, (int)b.y, (int)b.z, (int)b.w, 0, 0, 0, 0};
#if PEER_XFMT == 8
                                acc[t] = __builtin_amdgcn_mfma_scale_f32_16x16x128_f8f6f4(aop[jj], bop, acc[t], 0, 4, 0, 0x7f7f7f7f, 0, 0x7f7f7f7f); }
#else
                                const v8i_t ah = (v8i_t){(int)ahi[jj].x, (int)ahi[jj].y, (int)ahi[jj].z, (int)ahi[jj].w, 0, 0, 0, 0}, al = (v8i_t){(int)alo[jj].x, (int)alo[jj].y, (int)alo[jj].z, (int)alo[jj].w, 0, 0, 0, 0};
                                acc[t] = __builtin_amdgcn_mfma_scale_f32_16x16x128_f8f6f4(ah, bop, acc[t], 4, 4, 0, 0x7f7f7f7f, 0, 0x7f7f7f7f);
                                acc[t] = __builtin_amdgcn_mfma_scale_f32_16x16x128_f8f6f4(al, bop, acc[t], 4, 4, 0, 0x7d7d7d7d, 0, 0x7f7f7f7f); }
#endif
                        }
                    }
#pragma unroll
                    for (int t = 0; t < 4; ++t) { if (kq == t) { if (g == 0) h0 = acc[t][0]; else h1 = acc[t][0]; } }
                }
#undef PU_LOADU
#undef PU_TILE
#undef PU_HALF
                const int e0 = (int)teid[tok * 128 + lane], e1 = (int)teid[tok * 128 + 64 + lane];
                const float hd0 = h0 * sx * Us[e0], hd1 = h1 * sx * Us[e1];
                wv0 = 0.5f * hd0 * (1.f + erff(hd0 * 0.70710678118654752f)) * tgate[tok * 128 + lane] * Vs[e0];
                wv1 = 0.5f * hd1 * (1.f + erff(hd1 * 0.70710678118654752f)) * tgate[tok * 128 + 64 + lane] * Vs[e1];
            }
#else
#if PEER_UVI
            float y[16];
#pragma unroll
            for (int i = 0; i < 16; ++i) y[i] = 0.f;
#endif
#pragma unroll 1
            for (int bt = 0; bt < 2; ++bt) {
                const int eidv = (int)teid[tok * 128 + bt * 64 + lane];
                {
                float p[64];

                u32x4 qb[2][PGS];
#pragma unroll
                for (int i = 0; i < PGS; i += PROW_STEP) PROWS_LOAD(U, qb[0], eidv, 0, i);
#pragma unroll
                for (int g = 0; g < 64 / PGS; ++g) {
                    if (g < 64 / PGS - 1) {
#pragma unroll
                        for (int i = 0; i < PGS; i += PROW_STEP) PROWS_LOAD(U, qb[(g + 1) & 1], eidv, (g + 1) * PGS, i);
                    }
                    asm volatile("" ::: "memory");
#if PEER_BITS == 4
#pragma unroll
                    for (int i = 0; i < PGS; ++i) {
                        f32x2v a2 = {0.f, 0.f};
                        const u32x2 rw_ = PROW_GET(qb[g & 1], i);
#pragma unroll
                        for (int w = 0; w < 2; ++w) {
#define PU4(b) { const f32x2v f = __builtin_amdgcn_cvt_scalef32_pk_f32_fp4(rw_[w], 1.0f, b); const f32x2v xx = {xf[w * 8 + b * 2], xf[w * 8 + b * 2 + 1]}; a2 = __builtin_elementwise_fma(f, xx, a2); }
                            PU4(0) PU4(1) PU4(2) PU4(3)
#undef PU4
                        }
                        p[g * PGS + i] = a2[0] + a2[1];
                        __builtin_amdgcn_sched_barrier(0);
                    }
#elif PEER_BITS == 6
#pragma unroll
                    for (int i = 0; i < PGS; i += 2) {
                        const v6u_t pk = {qb[g & 1][i][0], qb[g & 1][i][1], qb[g & 1][i][2], qb[g & 1][i + 1][0], qb[g & 1][i + 1][1], qb[g & 1][i + 1][2]};
                        const v32f_t f = __builtin_amdgcn_cvt_scalef32_pk32_f32_fp6(pk, 1.0f);
                        float a0 = 0.f, a1 = 0.f;
#pragma unroll
                        for (int k = 0; k < 16; ++k) { a0 = fmaf(f[k], xf[k], a0); a1 = fmaf(f[16 + k], xf[k], a1); }
                        p[g * PGS + i] = a0; p[g * PGS + i + 1] = a1;
                        __builtin_amdgcn_sched_barrier(0);
                    }
#else
#pragma unroll
                    for (int i = 0; i < PGS; ++i) {
                        float a = 0.f;
#pragma unroll
                        for (int w = 0; w < 4; ++w) { const f32x2v lo = __builtin_amdgcn_cvt_pk_f32_fp8((int)qb[g & 1][i][w], false), hi = __builtin_amdgcn_cvt_pk_f32_fp8((int)qb[g & 1][i][w], true);
                            a = fmaf(lo[0], xf[w * 4], a); a = fmaf(lo[1], xf[w * 4 + 1], a); a = fmaf(hi[0], xf[w * 4 + 2], a); a = fmaf(hi[1], xf[w * 4 + 3], a); }
                        p[g * PGS + i] = a;
                        __builtin_amdgcn_sched_barrier(0);
                    }
#endif
                }

#pragma unroll
                for (int o = 32; o >= 1; o >>= 1) {
                    const bool up = (lane & o) != 0;
#pragma unroll
                    for (int i = 0; i < o; ++i) { const float keep = up ? p[i + o] : p[i], send = up ? p[i] : p[i + o]; p[i] = keep + SHX_(send, o); }
                }
                const float hdot = p[0] * Us[eidv];
                const float wv = 0.5f * hdot * (1.f + erff(hdot * 0.70710678118654752f)) * tgate[tok * 128 + bt * 64 + lane] * Vs[eidv];
                if (bt == 0) wv0 = wv; else wv1 = wv;

                }
#if PEER_UVI
                {
                const float wvv = bt == 0 ? wv0 : wv1;
                u32x4 qb[2][PGS];
#pragma unroll
                for (int i = 0; i < PGS; i += PROW_STEP) PROWS_LOAD(V, qb[0], eidv, 0, i);
#pragma unroll
                for (int g = 0; g < 64 / PGS; ++g) {
                    if (g < 64 / PGS - 1) {
#pragma unroll
                        for (int i = 0; i < PGS; i += PROW_STEP) PROWS_LOAD(V, qb[(g + 1) & 1], eidv, (g + 1) * PGS, i);
                    }
                    asm volatile("" ::: "memory");
#if PEER_BITS == 4
#pragma unroll
                    for (int i = 0; i < PGS; ++i) {
                        const float w = __builtin_bit_cast(float, __builtin_amdgcn_readlane(__builtin_bit_cast(int, wvv), g * PGS + i));
                        u32x2 rv_ = PROW_GET(qb[g & 1], i);
                        asm volatile("" : "+v"(rv_[0]), "+v"(rv_[1]));
#pragma unroll
                        for (int k = 0; k < 2; ++k) {
#define PV4(b) { const f32x2v f = __builtin_amdgcn_cvt_scalef32_pk_f32_fp4(rv_[k], 1.0f, b); f32x2v yy = {y[k * 8 + b * 2], y[k * 8 + b * 2 + 1]}; const f32x2v ww = {w, w}; yy = __builtin_elementwise_fma(ww, f, yy); y[k * 8 + b * 2] = yy[0]; y[k * 8 + b * 2 + 1] = yy[1]; }
                            PV4(0) PV4(1) PV4(2) PV4(3)
#undef PV4
                        }
                        asm volatile("" : "+v"(y[0]), "+v"(y[1]), "+v"(y[2]), "+v"(y[3]), "+v"(y[4]), "+v"(y[5]), "+v"(y[6]), "+v"(y[7]), "+v"(y[8]), "+v"(y[9]), "+v"(y[10]), "+v"(y[11]), "+v"(y[12]), "+v"(y[13]), "+v"(y[14]), "+v"(y[15]));
                    }
#elif PEER_BITS == 6
#pragma unroll
                    for (int i = 0; i < PGS; i += 2) {
                        const float w0 = __builtin_bit_cast(float, __builtin_amdgcn_readlane(__builtin_bit_cast(int, wvv), g * PGS + i)), w1 = __builtin_bit_cast(float, __builtin_amdgcn_readlane(__builtin_bit_cast(int, wvv), g * PGS + i + 1));
                        asm volatile("" : "+v"(qb[g & 1][i][0]), "+v"(qb[g & 1][i][1]), "+v"(qb[g & 1][i][2]), "+v"(qb[g & 1][i + 1][0]), "+v"(qb[g & 1][i + 1][1]), "+v"(qb[g & 1][i + 1][2]));
                        const v6u_t pk = {qb[g & 1][i][0], qb[g & 1][i][1], qb[g & 1][i][2], qb[g & 1][i + 1][0], qb[g & 1][i + 1][1], qb[g & 1][i + 1][2]};
                        const v32f_t f = __builtin_amdgcn_cvt_scalef32_pk32_f32_fp6(pk, 1.0f);
#pragma unroll
                        for (int k = 0; k < 16; ++k) { y[k] = fmaf(w0, f[k], y[k]); y[k] = fmaf(w1, f[16 + k], y[k]); }
                        asm volatile("" : "+v"(y[0]), "+v"(y[1]), "+v"(y[2]), "+v"(y[3]), "+v"(y[4]), "+v"(y[5]), "+v"(y[6]), "+v"(y[7]), "+v"(y[8]), "+v"(y[9]), "+v"(y[10]), "+v"(y[11]), "+v"(y[12]), "+v"(y[13]), "+v"(y[14]), "+v"(y[15]));
                    }
#else
#pragma unroll
                    for (int i = 0; i < PGS; ++i) {
                        const float w = __builtin_bit_cast(float, __builtin_amdgcn_readlane(__builtin_bit_cast(int, wvv), g * PGS + i));
                        asm volatile("" : "+v"(qb[g & 1][i][0]), "+v"(qb[g & 1][i][1]), "+v"(qb[g & 1][i][2]), "+v"(qb[g & 1][i][3]));
#pragma unroll
                        for (int k = 0; k < 4; ++k) { const f32x2v lo = __builtin_amdgcn_cvt_pk_f32_fp8((int)qb[g & 1][i][k], false), hi = __builtin_amdgcn_cvt_pk_f32_fp8((int)qb[g & 1][i][k], true);
                            y[k * 4] = fmaf(w, lo[0], y[k * 4]); y[k * 4 + 1] = fmaf(w, lo[1], y[k * 4 + 1]); y[k * 4 + 2] = fmaf(w, hi[0], y[k * 4 + 2]); y[k * 4 + 3] = fmaf(w, hi[1], y[k * 4 + 3]); }
                        asm volatile("" : "+v"(y[0]), "+v"(y[1]), "+v"(y[2]), "+v"(y[3]), "+v"(y[4]), "+v"(y[5]), "+v"(y[6]), "+v"(y[7]), "+v"(y[8]), "+v"(y[9]), "+v"(y[10]), "+v"(y[11]), "+v"(y[12]), "+v"(y[13]), "+v"(y[14]), "+v"(y[15]));
                    }
#endif
                }
                            }
#endif
            }
#endif

#if !PEER_UVI
            float y[16];
#pragma unroll
            for (int i = 0; i < 16; ++i) y[i] = 0.f;
#endif
#if !PEER_UVI
#pragma unroll 1
            for (int bt = 0; bt < 2; ++bt) {
                const int eidv = (int)teid[tok * 128 + bt * 64 + lane]; const float wvv = bt == 0 ? wv0 : wv1;
                u32x4 qb[2][PGS];
#pragma unroll
                for (int i = 0; i < PGS; i += PROW_STEP) PROWS_LOAD(V, qb[0], eidv, 0, i);
#pragma unroll
                for (int g = 0; g < 64 / PGS; ++g) {
                    if (g < 64 / PGS - 1) {
#pragma unroll
                        for (int i = 0; i < PGS; i += PROW_STEP) PROWS_LOAD(V, qb[(g + 1) & 1], eidv, (g + 1) * PGS, i);
                    }
                    asm volatile("" ::: "memory");
#if PEER_BITS == 4
#pragma unroll
                    for (int i = 0; i < PGS; ++i) {
                        const float w = __builtin_bit_cast(float, __builtin_amdgcn_readlane(__builtin_bit_cast(int, wvv), g * PGS + i));
                        u32x2 rv_ = PROW_GET(qb[g & 1], i);
                        asm volatile("" : "+v"(rv_[0]), "+v"(rv_[1]));
#pragma unroll
                        for (int k = 0; k < 2; ++k) {
#define PV4(b) { const f32x2v f = __builtin_amdgcn_cvt_scalef32_pk_f32_fp4(rv_[k], 1.0f, b); f32x2v yy = {y[k * 8 + b * 2], y[k * 8 + b * 2 + 1]}; const f32x2v ww = {w, w}; yy = __builtin_elementwise_fma(ww, f, yy); y[k * 8 + b * 2] = yy[0]; y[k * 8 + b * 2 + 1] = yy[1]; }
                            PV4(0) PV4(1) PV4(2) PV4(3)
#undef PV4
                        }
                        asm volatile("" : "+v"(y[0]), "+v"(y[1]), "+v"(y[2]), "+v"(y[3]), "+v"(y[4]), "+v"(y[5]), "+v"(y[6]), "+v"(y[7]), "+v"(y[8]), "+v"(y[9]), "+v"(y[10]), "+v"(y[11]), "+v"(y[12]), "+v"(y[13]), "+v"(y[14]), "+v"(y[15]));
                    }
#elif PEER_BITS == 6
#pragma unroll
                    for (int i = 0; i < PGS; i += 2) {
                        const float w0 = __builtin_bit_cast(float, __builtin_amdgcn_readlane(__builtin_bit_cast(int, wvv), g * PGS + i)), w1 = __builtin_bit_cast(float, __builtin_amdgcn_readlane(__builtin_bit_cast(int, wvv), g * PGS + i + 1));
                        asm volatile("" : "+v"(qb[g & 1][i][0]), "+v"(qb[g & 1][i][1]), "+v"(qb[g & 1][i][2]), "+v"(qb[g & 1][i + 1][0]), "+v"(qb[g & 1][i + 1][1]), "+v"(qb[g & 1][i + 1][2]));
                        const v6u_t pk = {qb[g & 1][i][0], qb[g & 1][i][1], qb[g & 1][i][2], qb[g & 1][i + 1][0], qb[g & 1][i + 1][1], qb[g & 1][i + 1][2]};
                        const v32f_t f = __builtin_amdgcn_cvt_scalef32_pk32_f32_fp6(pk, 1.0f);
#pragma unroll
                        for (int k = 0; k < 16; ++k) { y[k] = fmaf(w0, f[k], y[k]); y[k] = fmaf(w1, f[16 + k], y[k]); }
                        asm volatile("" : "+v"(y[0]), "+v"(y[1]), "+v"(y[2]), "+v"(y[3]), "+v"(y[4]), "+v"(y[5]), "+v"(y[6]), "+v"(y[7]), "+v"(y[8]), "+v"(y[9]), "+v"(y[10]), "+v"(y[11]), "+v"(y[12]), "+v"(y[13]), "+v"(y[14]), "+v"(y[15]));
                    }
#else
#pragma unroll
                    for (int i = 0; i < PGS; ++i) {
                        const float w = __builtin_bit_cast(float, __builtin_amdgcn_readlane(__builtin_bit_cast(int, wvv), g * PGS + i));
                        asm volatile("" : "+v"(qb[g & 1][i][0]), "+v"(qb[g & 1][i][1]), "+v"(qb[g & 1][i][2]), "+v"(qb[g & 1][i][3]));
#pragma unroll
                        for (int k = 0; k < 4; ++k) { const f32x2v lo = __builtin_amdgcn_cvt_pk_f32_fp8((int)qb[g & 1][i][k], false), hi = __builtin_amdgcn_cvt_pk_f32_fp8((int)qb[g & 1][i][k], true);
                            y[k * 4] = fmaf(w, lo[0], y[k * 4]); y[k * 4 + 1] = fmaf(w, lo[1], y[k * 4 + 1]); y[k * 4 + 2] = fmaf(w, hi[0], y[k * 4 + 2]); y[k * 4 + 3] = fmaf(w, hi[1], y[k * 4 + 3]); }
                        asm volatile("" : "+v"(y[0]), "+v"(y[1]), "+v"(y[2]), "+v"(y[3]), "+v"(y[4]), "+v"(y[5]), "+v"(y[6]), "+v"(y[7]), "+v"(y[8]), "+v"(y[9]), "+v"(y[10]), "+v"(y[11]), "+v"(y[12]), "+v"(y[13]), "+v"(y[14]), "+v"(y[15]));
                    }
#endif
                }
            }
#endif

#if PEER_BITS == 4 && PEER_UMFMA
            asm volatile("" ::: "memory");
#pragma unroll
            for (int q = 0; q < 4; ++q) { const f32x4 r = *(const LAS f32x4*)(wl + 1024 + q * 1024 + lane * 16); xf[q * 4] = r[0]; xf[q * 4 + 1] = r[1]; xf[q * 4 + 2] = r[2]; xf[q * 4 + 3] = r[3]; }
#endif
            float s = 0.f;
#pragma unroll
            for (int i = 0; i < 16; ++i) { y[i] = ALPHA * xf[i] + y[i]; s += y[i]; }
#pragma unroll
            for (int o = 1; o < 64; o <<= 1) s += SHX_(s, o);
            const float mean = s * (1.f / D); float qq = 0.f;
#pragma unroll
            for (int i = 0; i < 16; ++i) { y[i] -= mean; qq += y[i] * y[i]; }
#pragma unroll
            for (int o = 1; o < 64; o <<= 1) qq += SHX_(qq, o);
            const float rstd = rsqrtf(qq * (1.f / D) + LN_EPS);
            u32x4 ob0, ob1;
#pragma unroll
            for (int q = 0; q < 4; ++q) { const int col = lane * 16 + q * 4; const f32x4 gg = *(const f32x4*)(g2 + col), bb = *(const f32x4*)(b2 + col);
                f32x4 o;
#pragma unroll
                for (int i = 0; i < 4; ++i) o[i] = y[q * 4 + i] * rstd * gg[i] + bb[i];
                if (outf) *(f32x4*)(outf + tok * D + col) = o;
                const unsigned w0 = pk2(o[0], o[1]), w1 = pk2(o[2], o[3]);
                if (q == 0) { ob0.x = w0; ob0.y = w1; } else if (q == 1) { ob0.z = w0; ob0.w = w1; } else if (q == 2) { ob1.x = w0; ob1.y = w1; } else { ob1.z = w0; ob1.w = w1; } }
            if (outb) { *(u32x4*)(outb + tok * D + lane * 16) = ob0; *(u32x4*)(outb + tok * D + lane * 16 + 8) = ob1; }

        }
    }

}

#undef SHX_
#if PEER_BITS == 4 && PEER_SCOOP
__device__ __forceinline__ void phase_peer_mix_sample(const bf16* __restrict__ Zin, const float* __restrict__ g1, const float* __restrict__ b1, const unsigned short* __restrict__ teid, const float* __restrict__ tgate,
                                                      const unsigned char* __restrict__ U, const unsigned char* __restrict__ V, const float* __restrict__ Us, const float* __restrict__ Vs, const float* __restrict__ g2, const float* __restrict__ b2,
                                                      float* __restrict__ outf, bf16* __restrict__ outb, LAS unsigned char* lds, int vcu, int G, int wave, int lane) {
    LAS float* ylds = (LAS float*)lds;
    for (int st = vcu; st < TS; st += G) {
        asm volatile("" : "+v"(lane));
        const size_t tok = (size_t)TP + st;
        const int eidv = (int)teid[tok * 128 + wave * 16 + (lane & 15)];
        u32x2 qu[16];
#pragma unroll
        for (int i = 0; i < 16; ++i) { const int id = __builtin_amdgcn_readlane(eidv, i); qu[i] = *(const u32x2*)(U + (size_t)id * PEER_RS + lane * 8); }
        u32x2 qv[16];
#pragma unroll
        for (int i = 0; i < 16; ++i) { const int id = __builtin_amdgcn_readlane(eidv, i); qv[i] = *(const u32x2*)(V + (size_t)id * PEER_RS + lane * 8); }
        asm volatile("" ::: "memory");
        const float usv = Us[eidv], gv = tgate[tok * 128 + wave * 16 + (lane & 15)] * Vs[eidv];
        float xf[16];
        { float s1 = 0.f;
#pragma unroll
          for (int q = 0; q < 2; ++q) { const u32x4 w = *(const u32x4*)(Zin + tok * D + lane * 16 + q * 8);
#pragma unroll
              for (int i = 0; i < 4; ++i) { xf[q * 8 + 2 * i] = bflo(w[i]); xf[q * 8 + 2 * i + 1] = bfhi(w[i]); s1 += xf[q * 8 + 2 * i] + xf[q * 8 + 2 * i + 1]; } }
#pragma unroll
          for (int o = 1; o < 64; o <<= 1) s1 += __shfl_xor(s1, o);
          const float mean1 = s1 * (1.f / D); float q1 = 0.f;
#pragma unroll
          for (int i = 0; i < 16; ++i) { xf[i] -= mean1; q1 += xf[i] * xf[i]; }
#pragma unroll
          for (int o = 1; o < 64; o <<= 1) q1 += __shfl_xor(q1, o);
          const float rstd1 = rsqrtf(q1 * (1.f / D) + LN_EPS);
#pragma unroll
          for (int q = 0; q < 4; ++q) { const f32x4 gg = *(const f32x4*)(g1 + lane * 16 + q * 4), bb = *(const f32x4*)(b1 + lane * 16 + q * 4);
#pragma unroll
              for (int i = 0; i < 4; ++i) xf[q * 4 + i] = xf[q * 4 + i] * rstd1 * gg[i] + bb[i]; } }
        float p[16];
#pragma unroll
        for (int i = 0; i < 16; ++i) {
            f32x2v a2 = {0.f, 0.f};
#pragma unroll
            for (int w = 0; w < 2; ++w) {
#define PU4(b) { const f32x2v f = __builtin_amdgcn_cvt_scalef32_pk_f32_fp4(qu[i][w], 1.0f, b); const f32x2v xx = {xf[w * 8 + b * 2], xf[w * 8 + b * 2 + 1]}; a2 = __builtin_elementwise_fma(f, xx, a2); }
                PU4(0) PU4(1) PU4(2) PU4(3)
#undef PU4
            }
            p[i] = a2[0] + a2[1];
            __builtin_amdgcn_sched_barrier(0);
        }
#pragma unroll
        for (int o = 8; o >= 1; o >>= 1) {
            const bool up = (lane & o) != 0;
#pragma unroll
            for (int i = 0; i < o; ++i) { const float keep = up ? p[i + o] : p[i], send = up ? p[i] : p[i + o]; p[i] = keep + __shfl_xor(send, o); }
        }
        float hs = p[0]; hs += __shfl_xor(hs, 16); hs += __shfl_xor(hs, 32);
        const float hdot = hs * usv;
        const float wvv = 0.5f * hdot * (1.f + erff(hdot * 0.70710678118654752f)) * gv;
        float y[16];
#pragma unroll
        for (int i = 0; i < 16; ++i) y[i] = 0.f;
#pragma unroll
        for (int i = 0; i < 16; ++i) {
            const float w = __builtin_bit_cast(float, __builtin_amdgcn_readlane(__builtin_bit_cast(int, wvv), i));
            asm volatile("" : "+v"(qv[i][0]), "+v"(qv[i][1]));
#pragma unroll
            for (int k = 0; k < 2; ++k) {
#define PV4(b) { const f32x2v f = __builtin_amdgcn_cvt_scalef32_pk_f32_fp4(qv[i][k], 1.0f, b); f32x2v yy = {y[k * 8 + b * 2], y[k * 8 + b * 2 + 1]}; const f32x2v ww = {w, w}; yy = __builtin_elementwise_fma(ww, f, yy); y[k * 8 + b * 2] = yy[0]; y[k * 8 + b * 2 + 1] = yy[1]; }
                PV4(0) PV4(1) PV4(2) PV4(3)
#undef PV4
            }
            asm volatile("" : "+v"(y[0]), "+v"(y[1]), "+v"(y[2]), "+v"(y[3]), "+v"(y[4]), "+v"(y[5]), "+v"(y[6]), "+v"(y[7]), "+v"(y[8]), "+v"(y[9]), "+v"(y[10]), "+v"(y[11]), "+v"(y[12]), "+v"(y[13]), "+v"(y[14]), "+v"(y[15]));
        }
#pragma unroll
        for (int q = 0; q < 4; ++q) *(LAS f32x4*)(ylds + wave * 1024 + q * 256 + lane * 4) = (f32x4){y[q * 4], y[q * 4 + 1], y[q * 4 + 2], y[q * 4 + 3]};
        __syncthreads();
        if (wave == 0) {
#pragma unroll
            for (int q = 0; q < 4; ++q) { f32x4 a = (f32x4){0.f, 0.f, 0.f, 0.f};
#pragma unroll
                for (int w = 0; w < 8; ++w) a = a + *(const LAS f32x4*)(ylds + w * 1024 + q * 256 + lane * 4);
                y[q * 4] = a[0]; y[q * 4 + 1] = a[1]; y[q * 4 + 2] = a[2]; y[q * 4 + 3] = a[3]; }
            float s = 0.f;
#pragma unroll
            for (int i = 0; i < 16; ++i) { y[i] = ALPHA * xf[i] + y[i]; s += y[i]; }
#pragma unroll
            for (int o = 1; o < 64; o <<= 1) s += __shfl_xor(s, o);
            const float mean = s * (1.f / D); float qq = 0.f;
#pragma unroll
            for (int i = 0; i < 16; ++i) { y[i] -= mean; qq += y[i] * y[i]; }
#pragma unroll
            for (int o = 1; o < 64; o <<= 1) qq += __shfl_xor(qq, o);
            const float rstd = rsqrtf(qq * (1.f / D) + LN_EPS);
            u32x4 ob0, ob1;
#pragma unroll
            for (int q = 0; q < 4; ++q) { const int col = lane * 16 + q * 4; const f32x4 gg = *(const f32x4*)(g2 + col), bb = *(const f32x4*)(b2 + col);
                f32x4 o;
#pragma unroll
                for (int i = 0; i < 4; ++i) o[i] = y[q * 4 + i] * rstd * gg[i] + bb[i];
                if (outf) *(f32x4*)(outf + tok * D + col) = o;
                const unsigned w0 = pk2(o[0], o[1]), w1 = pk2(o[2], o[3]);
                if (q == 0) { ob0.x = w0; ob0.y = w1; } else if (q == 1) { ob0.z = w0; ob0.w = w1; } else if (q == 2) { ob1.x = w0; ob1.y = w1; } else { ob1.z = w0; ob1.w = w1; } }
            if (outb) { *(u32x4*)(outb + tok * D + lane * 16) = ob0; *(u32x4*)(outb + tok * D + lane * 16 + 8) = ob1; }
        }
        __syncthreads();
    }
}
#endif

#if PEER_BITS == 4
template <int MODE>
__device__ __forceinline__ void phase_peer_mix4(const float* __restrict__ Zin, const float* __restrict__ g1, const float* __restrict__ b1, const unsigned short* __restrict__ teid, const float* __restrict__ tgate,
                                                const unsigned char* __restrict__ U, const unsigned char* __restrict__ V, const float* __restrict__ Us, const float* __restrict__ Vs, const float* __restrict__ g2, const float* __restrict__ b2,
                                                float* __restrict__ outf, bf16* __restrict__ outb, float* __restrict__ WV, LAS unsigned char* wl, int gw, int NGW, int lane_in) {
    typedef int v8i_t __attribute__((ext_vector_type(8)));
#define SHX_(v_, o_) __builtin_bit_cast(float, __builtin_amdgcn_ds_bpermute((lane ^ (o_)) << 2, __builtin_bit_cast(int, (float)(v_))))
#define MIX_TOK(j_) ((j_) < TP ? (size_t)(j_) : (size_t)TP + (((j_) - TP) >> 4))
    int j = gw;
    f32x4 zr[4]; int ti0, ti1; float tg0, tg1;
    { const size_t tok = MIX_TOK(j);
#pragma unroll
      for (int q = 0; q < 4; ++q) zr[q] = *(const f32x4*)(Zin + tok * D + lane_in * 16 + q * 4);
      ti0 = (int)teid[tok * 128 + lane_in]; ti1 = (int)teid[tok * 128 + 64 + lane_in];
      const float* gsrc = MODE == 2 ? WV : tgate; tg0 = gsrc[tok * 128 + lane_in]; tg1 = gsrc[tok * 128 + 64 + lane_in]; }
    while (j >= 0) {
        int lane = lane_in; asm volatile("" : "+v"(lane));
        const size_t tok = MIX_TOK(j);
        int jn = -1;
        for (int c = j + NGW; c < TP + TS * 16; c += NGW) { if (c < TP || ((c - TP) & 15) == 0) { jn = c; break; } }
        const int n16 = lane & 15, kq = lane >> 4;
        const int e0 = ti0, e1 = ti1; const float gt0 = tg0, gt1 = tg1;
        float wv0 = gt0, wv1 = gt1;
        unsigned idp[4]; u32x4 qb[3][4]; float us0 = 0.f, us1 = 0.f, vs0 = 0.f, vs1 = 0.f;
#define PU_HALF(u_) (((u_) >> 2) & 1)
#define PU_LOADU(u_) { const unsigned id_ = ((u_) >> 3) ? (idp[(u_) & 3] >> 16) : (idp[(u_) & 3] & 0xFFFFu); const unsigned char* rp_ = U + (size_t)id_ * PEER_RB + PU_HALF(u_) * 256 + kq * 16; _Pragma("unroll") for (int jj = 0; jj < 4; ++jj) qb[(u_) % 3][jj] = *(const u32x4*)(rp_ + jj * 64); }
        if constexpr (MODE != 2) {
#pragma unroll
        for (int t = 0; t < 4; ++t) idp[t] = (unsigned)__builtin_amdgcn_ds_bpermute((t * 16 + n16) << 2, e0) | ((unsigned)__builtin_amdgcn_ds_bpermute((t * 16 + n16) << 2, e1) << 16);
        PU_LOADU(0) PU_LOADU(1)
        us0 = Us[e0]; us1 = Us[e1]; vs0 = Vs[e0]; vs1 = Vs[e1];
        }
        float xf[16];
        { float s1 = 0.f;
#pragma unroll
          for (int q = 0; q < 4; ++q) { const f32x4 r = zr[q]; xf[q * 4] = r[0]; xf[q * 4 + 1] = r[1]; xf[q * 4 + 2] = r[2]; xf[q * 4 + 3] = r[3]; s1 += (r[0] + r[1]) + (r[2] + r[3]); }
#pragma unroll
          for (int o = 1; o < 64; o <<= 1) s1 += SHX_(s1, o);
          const float mean1 = s1 * (1.f / D); float q1 = 0.f;
#pragma unroll
          for (int i = 0; i < 16; ++i) { xf[i] -= mean1; q1 += xf[i] * xf[i]; }
#pragma unroll
          for (int o = 1; o < 64; o <<= 1) q1 += SHX_(q1, o);
          const float rstd1 = rsqrtf(q1 * (1.f / D) + LN_EPS);
#pragma unroll
          for (int q = 0; q < 4; ++q) { const f32x4 gg = *(const f32x4*)(g1 + lane * 16 + q * 4), bb = *(const f32x4*)(b1 + lane * 16 + q * 4);
#pragma unroll
              for (int i = 0; i < 4; ++i) xf[q * 4 + i] = xf[q * 4 + i] * rstd1 * gg[i] + bb[i]; } }
        if constexpr (MODE != 2) {
        float am = 0.f;
#pragma unroll
        for (int i = 0; i < 16; ++i) am = fmaxf(am, fabsf(xf[i]));
#pragma unroll
        for (int o = 1; o < 64; o <<= 1) am = fmaxf(am, SHX_(am, o));
        const float xinv = am > 0.f ? 6.f / am : 0.f, sx = am * (1.f / 6.f);
        { u32x2 whi, wlo; whi.x = 0u; whi.y = 0u; wlo.x = 0u; wlo.y = 0u;
#pragma unroll
          for (int i = 0; i < 16; ++i) {
              const float xs = xf[i] * xinv, a = fabsf(xs);
              const float gq = a < 2.f ? rintf(a * 2.f) * 0.5f : (a < 4.f ? rintf(a) : fminf(6.f, 2.f * rintf(a * 0.5f)));
              const unsigned chi = (unsigned)(gq < 2.f ? gq * 2.f : (gq < 4.f ? gq + 2.f : gq * 0.5f + 4.f)) | (xs < 0.f ? 8u : 0u);
              const float r = (xs - (xs < 0.f ? -gq : gq)) * 4.f;
              const unsigned clo = enc_e2m1(r);
              if (i < 8) { whi.x |= chi << (4 * i); wlo.x |= clo << (4 * i); } else { whi.y |= chi << (4 * (i - 8)); wlo.y |= clo << (4 * (i - 8)); }
          }
          *(LAS u32x2*)(wl + lane * 8) = whi; *(LAS u32x2*)(wl + 512 + lane * 8) = wlo; }
        if constexpr (MODE == 0) {
#pragma unroll
        for (int q = 0; q < 4; ++q) *(LAS f32x4*)(wl + 1024 + q * 1024 + lane * 16) = (f32x4){xf[q * 4], xf[q * 4 + 1], xf[q * 4 + 2], xf[q * 4 + 3]}; }
        float h0 = 0.f, h1 = 0.f;
#pragma unroll
        for (int g = 0; g < 2; ++g) {
            f32x4 acc[4];
#pragma unroll
            for (int t = 0; t < 4; ++t) acc[t] = (f32x4){0.f, 0.f, 0.f, 0.f};
#pragma unroll
            for (int ph = 0; ph < 2; ++ph) {
                u32x4 ahi[4], alo[4];
#pragma unroll
                for (int jj = 0; jj < 4; ++jj) { const int jk = ph * 4 + jj; ahi[jj] = *(const LAS u32x4*)(wl + jk * 64 + kq * 16); alo[jj] = *(const LAS u32x4*)(wl + 512 + jk * 64 + kq * 16); }
#pragma unroll
                for (int t = 0; t < 4; ++t) {
                    const int u = g * 8 + ph * 4 + t;
                    if (u + 2 < 16) PU_LOADU(u + 2)
                    asm volatile("" ::: "memory");
#pragma unroll
                    for (int jj = 0; jj < 4; ++jj) { const u32x4 b = qb[u % 3][jj]; const v8i_t bop = (v8i_t){(int)b.x, (int)b.y, (int)b.z, (int)b.w, 0, 0, 0, 0};
                        const v8i_t ah = (v8i_t){(int)ahi[jj].x, (int)ahi[jj].y, (int)ahi[jj].z, (int)ahi[jj].w, 0, 0, 0, 0}, al = (v8i_t){(int)alo[jj].x, (int)alo[jj].y, (int)alo[jj].z, (int)alo[jj].w, 0, 0, 0, 0};
                        acc[t] = __builtin_amdgcn_mfma_scale_f32_16x16x128_f8f6f4(ah, bop, acc[t], 4, 4, 0, 0x7f7f7f7f, 0, 0x7f7f7f7f);
                        acc[t] = __builtin_amdgcn_mfma_scale_f32_16x16x128_f8f6f4(al, bop, acc[t], 4, 4, 0, 0x7d7d7d7d, 0, 0x7f7f7f7f); }
                }
            }
#pragma unroll
            for (int t = 0; t < 4; ++t) { if (kq == t) { if (g == 0) h0 = acc[t][0]; else h1 = acc[t][0]; } }
        }
        const float hd0 = h0 * sx * us0, hd1 = h1 * sx * us1;
        wv0 = 0.5f * hd0 * (1.f + erff(hd0 * 0.70710678118654752f)) * gt0 * vs0;
        wv1 = 0.5f * hd1 * (1.f + erff(hd1 * 0.70710678118654752f)) * gt1 * vs1;
        if constexpr (MODE == 1) { WV[tok * 128 + lane] = wv0; WV[tok * 128 + 64 + lane] = wv1; }
        }
#undef PU_LOADU
#undef PU_HALF
        if (jn >= 0) { const size_t tn = MIX_TOK(jn);
#pragma unroll
            for (int q = 0; q < 4; ++q) zr[q] = *(const f32x4*)(Zin + tn * D + lane * 16 + q * 4);
            ti0 = (int)teid[tn * 128 + lane]; ti1 = (int)teid[tn * 128 + 64 + lane];
            const float* gsrc = MODE == 2 ? WV : tgate; tg0 = gsrc[tn * 128 + lane]; tg1 = gsrc[tn * 128 + 64 + lane]; }
        if constexpr (MODE != 1) {
        float y[16];
#pragma unroll
        for (int i = 0; i < 16; ++i) y[i] = 0.f;
        {
            u32x2 qa[8], qc[8];
#define PV_LOAD(buf_, g_) { const int src_ = (g_) < 8 ? e0 : e1; _Pragma("unroll") for (int i = 0; i < 8; ++i) { const int id_ = __builtin_amdgcn_readlane(src_, ((g_) & 7) * 8 + i); buf_[i] = *(const u32x2*)(V + (size_t)id_ * PEER_RB + lane * 8); } }
#define PV4(bf_, b) { const f32x2v f = __builtin_amdgcn_cvt_scalef32_pk_f32_fp4(bf_[i][k], 1.0f, b); f32x2v yy = {y[k * 8 + b * 2], y[k * 8 + b * 2 + 1]}; const f32x2v ww = {w, w}; yy = __builtin_elementwise_fma(ww, f, yy); y[k * 8 + b * 2] = yy[0]; y[k * 8 + b * 2 + 1] = yy[1]; }
#define PV_COMP(buf_, g_) { const float wsrc_ = (g_) < 8 ? wv0 : wv1; _Pragma("unroll") for (int i = 0; i < 8; ++i) { \
            const float w = __builtin_bit_cast(float, __builtin_amdgcn_readlane(__builtin_bit_cast(int, wsrc_), ((g_) & 7) * 8 + i)); \
            asm volatile("" : "+v"(buf_[i][0]), "+v"(buf_[i][1])); \
            _Pragma("unroll") for (int k = 0; k < 2; ++k) { PV4(buf_, 0) PV4(buf_, 1) PV4(buf_, 2) PV4(buf_, 3) } \
            asm volatile("" : "+v"(y[0]), "+v"(y[1]), "+v"(y[2]), "+v"(y[3]), "+v"(y[4]), "+v"(y[5]), "+v"(y[6]), "+v"(y[7]), "+v"(y[8]), "+v"(y[9]), "+v"(y[10]), "+v"(y[11]), "+v"(y[12]), "+v"(y[13]), "+v"(y[14]), "+v"(y[15])); } }
            PV_LOAD(qa, 0)
#pragma unroll 1
            for (int p2 = 0; p2 < 8; ++p2) {
                PV_LOAD(qc, 2 * p2 + 1)
                asm volatile("" ::: "memory");
                PV_COMP(qa, 2 * p2)
                if (p2 < 7) PV_LOAD(qa, 2 * p2 + 2)
                asm volatile("" ::: "memory");
                PV_COMP(qc, 2 * p2 + 1)
            }
#undef PV_LOAD
#undef PV4
#undef PV_COMP
        }
        asm volatile("" ::: "memory");
        if constexpr (MODE == 0)
#pragma unroll
        for (int q = 0; q < 4; ++q) { const f32x4 r = *(const LAS f32x4*)(wl + 1024 + q * 1024 + lane * 16); xf[q * 4] = r[0]; xf[q * 4 + 1] = r[1]; xf[q * 4 + 2] = r[2]; xf[q * 4 + 3] = r[3]; }
        float s = 0.f;
#pragma unroll
        for (int i = 0; i < 16; ++i) { y[i] = ALPHA * xf[i] + y[i]; s += y[i]; }
#pragma unroll
        for (int o = 1; o < 64; o <<= 1) s += SHX_(s, o);
        const float mean = s * (1.f / D); float qq = 0.f;
#pragma unroll
        for (int i = 0; i < 16; ++i) { y[i] -= mean; qq += y[i] * y[i]; }
#pragma unroll
        for (int o = 1; o < 64; o <<= 1) qq += SHX_(qq, o);
        const float rstd = rsqrtf(qq * (1.f / D) + LN_EPS);
        u32x4 ob0, ob1;
#pragma unroll
        for (int q = 0; q < 4; ++q) { const int col = lane * 16 + q * 4; const f32x4 gg = *(const f32x4*)(g2 + col), bb = *(const f32x4*)(b2 + col);
            f32x4 o;
#pragma unroll
            for (int i = 0; i < 4; ++i) o[i] = y[q * 4 + i] * rstd * gg[i] + bb[i];
            *(f32x4*)(outf + tok * D + col) = o;
            const unsigned w0 = pk2(o[0], o[1]), w1 = pk2(o[2], o[3]);
            if (q == 0) { ob0.x = w0; ob0.y = w1; } else if (q == 1) { ob0.z = w0; ob0.w = w1; } else if (q == 2) { ob1.x = w0; ob1.y = w1; } else { ob1.z = w0; ob1.w = w1; } }
        if (outb) { *(u32x4*)(outb + tok * D + lane * 16) = ob0; *(u32x4*)(outb + tok * D + lane * 16 + 8) = ob1; }
        }
        j = jn;
    }
#undef SHX_
#undef MIX_TOK
}
#endif

__device__ __forceinline__ float peer_reduce16(float (&p)[16], int lane) {
#pragma unroll
    for (int o = 8; o >= 1; o >>= 1) { const bool up = (lane & (o * 4)) != 0;
#pragma unroll
        for (int k = 0; k < o; ++k) { const float keep = up ? p[k + o] : p[k], send = up ? p[k] : p[k + o]; p[k] = keep + __shfl_xor(send, o * 4); } }
    float tot = p[0];
    tot += __shfl_xor(tot, 2); tot += __shfl_xor(tot, 1);
    return tot;
}
__device__ __forceinline__ unsigned cvtpk_bf16_(float lo, float hi) { typedef __bf16 bf2 __attribute__((ext_vector_type(2))); f32x2v v = {lo, hi}; bf2 b = __builtin_convertvector(v, bf2); return __builtin_bit_cast(unsigned, b); }
__device__ __forceinline__ float peer_dot16b(const u32x4 q, const u32x4 x0, const u32x4 x1) {
    float a = 0.f;
#pragma unroll
    for (int w = 0; w < 4; ++w) { const f32x2v lo = __builtin_amdgcn_cvt_pk_f32_fp8((int)q[w], false), hi = __builtin_amdgcn_cvt_pk_f32_fp8((int)q[w], true);
        const unsigned xa = w < 2 ? x0[2 * w] : x1[2 * w - 4], xb = w < 2 ? x0[2 * w + 1] : x1[2 * w - 3];
        a = dot2bf(cvtpk_bf16_(lo[0], lo[1]), xa, a); a = dot2bf(cvtpk_bf16_(hi[0], hi[1]), xb, a); }
    return a;
}

__device__ __forceinline__ void peer_u_slice(int sl, int t_first, int t_step, const bf16* __restrict__ Hb, const unsigned short* __restrict__ teid, const unsigned char* __restrict__ U,
                                             float* __restrict__ HD, LAS unsigned char* wl, int lane) {
    LAS unsigned short* lst_e = (LAS unsigned short*)wl;
    LAS unsigned char* lst_s = wl + 512;
    const unsigned long long below = (1ull << lane) - 1ull;
    const int kk = (lane >> 2) & 15;
    if (t_first >= TA) return;
#define PU_BUILD(bsel, e0_, e1_, cnt_) do { const bool a0_ = ((e0_) >> 11) == sl, a1_ = ((e1_) >> 11) == sl; const unsigned long long m0_ = __ballot(a0_), m1_ = __ballot(a1_); \
        const int c0_ = __builtin_popcountll(m0_); cnt_ = c0_ + __builtin_popcountll(m1_); \
        if (a0_) { const int p_ = __builtin_popcountll(m0_ & below); lst_e[(bsel) * 128 + p_] = (unsigned short)(e0_); lst_s[(bsel) * 128 + p_] = (unsigned char)lane; } \
        if (a1_) { const int p_ = c0_ + __builtin_popcountll(m1_ & below); lst_e[(bsel) * 128 + p_] = (unsigned short)(e1_); lst_s[(bsel) * 128 + p_] = (unsigned char)(64 + lane); } } while (0)
#define PU_LOAD(bsel, cnt_, q_) do { _Pragma("unroll") for (int k = 0; k < 16; ++k) { if (k < (cnt_)) { const int id_ = __builtin_amdgcn_readfirstlane((int)lst_e[(bsel) * 128 + k]); q_[k] = *(const u32x4*)(U + (size_t)id_ * D + lane * 16); } } } while (0)
    int e0 = __builtin_nontemporal_load(teid + (size_t)t_first * 128 + lane), e1 = __builtin_nontemporal_load(teid + (size_t)t_first * 128 + 64 + lane);
    u32x4 xa0 = __builtin_nontemporal_load((const u32x4*)(Hb + (size_t)t_first * D + lane * 16)), xa1 = __builtin_nontemporal_load((const u32x4*)(Hb + (size_t)t_first * D + lane * 16 + 8));
    int cnt; PU_BUILD(0, e0, e1, cnt);
    asm volatile("s_waitcnt lgkmcnt(0)" ::: "memory");
    u32x4 q[16];
    PU_LOAD(0, cnt, q);
    int buf = 0;

    for (int t = t_first; t < TA; t += t_step, buf ^= 1) {
        const int tn = t + t_step; const bool hasn = tn < TA;
        u32x4 xb0 = xa0, xb1 = xa1; int f0 = 0, f1 = 0;
        if (hasn) { f0 = __builtin_nontemporal_load(teid + (size_t)tn * 128 + lane); f1 = __builtin_nontemporal_load(teid + (size_t)tn * 128 + 64 + lane);
            xb0 = __builtin_nontemporal_load((const u32x4*)(Hb + (size_t)tn * D + lane * 16)); xb1 = __builtin_nontemporal_load((const u32x4*)(Hb + (size_t)tn * D + lane * 16 + 8)); }

        float pr[16];
#pragma unroll
        for (int k = 0; k < 16; ++k) pr[k] = k < cnt ? peer_dot16b(q[k], xa0, xa1) : 0.f;

#pragma unroll 1
        for (int p0 = 16; p0 < cnt; p0 += 16) {
            u32x4 q2[16];
#pragma unroll
            for (int k = 0; k < 16; ++k) { if (p0 + k < cnt) { const int id_ = __builtin_amdgcn_readfirstlane((int)lst_e[buf * 128 + p0 + k]); q2[k] = *(const u32x4*)(U + (size_t)id_ * D + lane * 16); } }
            float pr2[16];
#pragma unroll
            for (int k = 0; k < 16; ++k) pr2[k] = p0 + k < cnt ? peer_dot16b(q2[k], xa0, xa1) : 0.f;
            const float tot2 = peer_reduce16(pr2, lane);
            if (p0 + kk < cnt && (lane & 3) == 0) __builtin_nontemporal_store(tot2, HD + (size_t)t * 128 + lst_s[buf * 128 + p0 + kk]);
        }

        int cntn = 0;
        if (hasn) { PU_BUILD(buf ^ 1, f0, f1, cntn); }
        asm volatile("s_waitcnt lgkmcnt(0)" ::: "memory");
        if (hasn) PU_LOAD(buf ^ 1, cntn, q);

        const float tot = peer_reduce16(pr, lane);
        if (kk < cnt && (lane & 3) == 0) __builtin_nontemporal_store(tot, HD + (size_t)t * 128 + lst_s[buf * 128 + kk]);
        xa0 = xb0; xa1 = xb1; cnt = cntn;

    }

#undef PU_BUILD
#undef PU_LOAD
}

__device__ __forceinline__ void phase_peer_mixv(const float* __restrict__ Zin, const float* __restrict__ g1, const float* __restrict__ b1, const unsigned short* __restrict__ teid, const float* __restrict__ tgate, const float* __restrict__ HD,
                                                const unsigned char* __restrict__ V, const float* __restrict__ Us, const float* __restrict__ Vs, const float* __restrict__ g2, const float* __restrict__ b2,
                                                float* __restrict__ outf, bf16* __restrict__ outb, int gw, int NGW, int lane) {
    for (int j = gw; j < TP + TS * 16; j += NGW) {
        size_t tok;
        if (j < TP) tok = (size_t)j;
        else { const int s = j - TP; if ((s & 15) != 0) continue; tok = (size_t)TP + (s >> 4); }
        float xf[16];
        { float s1 = 0.f;
#pragma unroll
          for (int q = 0; q < 4; ++q) { const f32x4 r = *(const f32x4*)(Zin + tok * D + lane * 16 + q * 4); xf[q * 4] = r[0]; xf[q * 4 + 1] = r[1]; xf[q * 4 + 2] = r[2]; xf[q * 4 + 3] = r[3]; s1 += (r[0] + r[1]) + (r[2] + r[3]); }
#pragma unroll
          for (int o = 1; o < 64; o <<= 1) s1 += __shfl_xor(s1, o);
          const float mean1 = s1 * (1.f / D); float q1 = 0.f;
#pragma unroll
          for (int i = 0; i < 16; ++i) { xf[i] -= mean1; q1 += xf[i] * xf[i]; }
#pragma unroll
          for (int o = 1; o < 64; o <<= 1) q1 += __shfl_xor(q1, o);
          const float rstd1 = rsqrtf(q1 * (1.f / D) + LN_EPS);
#pragma unroll
          for (int q = 0; q < 4; ++q) { const f32x4 gg = *(const f32x4*)(g1 + lane * 16 + q * 4), bb = *(const f32x4*)(b1 + lane * 16 + q * 4);
#pragma unroll
              for (int i = 0; i < 4; ++i) xf[q * 4 + i] = xf[q * 4 + i] * rstd1 * gg[i] + bb[i]; } }
        float y[16];
#pragma unroll
        for (int i = 0; i < 16; ++i) y[i] = 0.f;
#pragma unroll 1
        for (int bt = 0; bt < 2; ++bt) {
            const int eidv = (int)teid[tok * 128 + bt * 64 + lane];
            const float hd = HD[tok * 128 + bt * 64 + lane] * Us[eidv];
            const float wvv = 0.5f * hd * (1.f + erff(hd * 0.70710678118654752f)) * tgate[tok * 128 + bt * 64 + lane] * Vs[eidv];
            u32x4 qb[2][PGS];
#pragma unroll
            for (int i = 0; i < PGS; ++i) { const int id = __builtin_amdgcn_readlane(eidv, i); qb[0][i] = PROW_LOAD(V, id); }
#pragma unroll
            for (int g = 0; g < 64 / PGS; ++g) {
                if (g < 64 / PGS - 1) {
#pragma unroll
                    for (int i = 0; i < PGS; ++i) { const int id = __builtin_amdgcn_readlane(eidv, (g + 1) * PGS + i); qb[(g + 1) & 1][i] = PROW_LOAD(V, id); }
                }
                asm volatile("" ::: "memory");
#pragma unroll
                for (int i = 0; i < PGS; ++i) {
                    const float w = __builtin_bit_cast(float, __builtin_amdgcn_readlane(__builtin_bit_cast(int, wvv), g * PGS + i));
                    asm volatile("" : "+v"(qb[g & 1][i][0]), "+v"(qb[g & 1][i][1]), "+v"(qb[g & 1][i][2]), "+v"(qb[g & 1][i][3]));
#pragma unroll
                    for (int k = 0; k < 4; ++k) { const f32x2v lo = __builtin_amdgcn_cvt_pk_f32_fp8((int)qb[g & 1][i][k], false), hi = __builtin_amdgcn_cvt_pk_f32_fp8((int)qb[g & 1][i][k], true);
                        y[k * 4] = fmaf(w, lo[0], y[k * 4]); y[k * 4 + 1] = fmaf(w, lo[1], y[k * 4 + 1]); y[k * 4 + 2] = fmaf(w, hi[0], y[k * 4 + 2]); y[k * 4 + 3] = fmaf(w, hi[1], y[k * 4 + 3]); }
                    asm volatile("" : "+v"(y[0]), "+v"(y[1]), "+v"(y[2]), "+v"(y[3]), "+v"(y[4]), "+v"(y[5]), "+v"(y[6]), "+v"(y[7]), "+v"(y[8]), "+v"(y[9]), "+v"(y[10]), "+v"(y[11]), "+v"(y[12]), "+v"(y[13]), "+v"(y[14]), "+v"(y[15]));
                }
            }
        }
        float s = 0.f;
#pragma unroll
        for (int i = 0; i < 16; ++i) { y[i] = ALPHA * xf[i] + y[i]; s += y[i]; }
#pragma unroll
        for (int o = 1; o < 64; o <<= 1) s += __shfl_xor(s, o);
        const float mean = s * (1.f / D); float qq = 0.f;
#pragma unroll
        for (int i = 0; i < 16; ++i) { y[i] -= mean; qq += y[i] * y[i]; }
#pragma unroll
        for (int o = 1; o < 64; o <<= 1) qq += __shfl_xor(qq, o);
        const float rstd = rsqrtf(qq * (1.f / D) + LN_EPS);
        u32x4 ob0, ob1;
#pragma unroll
        for (int q = 0; q < 4; ++q) { const int col = lane * 16 + q * 4; const f32x4 gg = *(const f32x4*)(g2 + col), bb = *(const f32x4*)(b2 + col);
            f32x4 o;
#pragma unroll
            for (int i = 0; i < 4; ++i) o[i] = y[q * 4 + i] * rstd * gg[i] + bb[i];
            *(f32x4*)(outf + tok * D + col) = o;
            const unsigned w0 = pk2(o[0], o[1]), w1 = pk2(o[2], o[3]);
            if (q == 0) { ob0.x = w0; ob0.y = w1; } else if (q == 1) { ob0.z = w0; ob0.w = w1; } else if (q == 2) { ob1.x = w0; ob1.y = w1; } else { ob1.z = w0; ob1.w = w1; } }
        if (outb) { *(u32x4*)(outb + tok * D + lane * 16) = ob0; *(u32x4*)(outb + tok * D + lane * 16 + 8) = ob1; }
    }
}
}

namespace mk {
struct FGlaIn {
    bf16 *Gq, *Gk, *Gv, *Gr; float* GD;
    __device__ __forceinline__ static float silu(float r) { return r / (1.f + __expf(-r)); }
    __device__ __forceinline__ void put8(int row, int col, f32x4 v0, f32x4 v1) const {
        if (col < GN_K) *(u32x4*)(Gq + (size_t)row * 512 + col) = pack8(v0, v1);
        else if (col < GN_V) *(u32x4*)(Gk + (size_t)row * 512 + (col - GN_K)) = pack8(v0, v1);
        else if (col < GN_R) *(u32x4*)(Gv + (size_t)row * 1024 + (col - GN_V)) = pack8(v0, v1);
        else { f32x4 a, b;
#pragma unroll
            for (int i = 0; i < 4; ++i) { a[i] = silu(v0[i]); b[i] = silu(v1[i]); }
            *(u32x4*)(Gr + (size_t)row * 1024 + (col - GN_R)) = pack8(a, b); }
    }
    __device__ __forceinline__ void put4(int row, int col, f32x4 v) const {
        u32x2 w; w.x = pk2(v[0], v[1]); w.y = pk2(v[2], v[3]);
        if (col < GN_K) *(u32x2*)(Gq + (size_t)row * 512 + col) = w;
        else if (col < GN_V) *(u32x2*)(Gk + (size_t)row * 512 + (col - GN_K)) = w;
        else if (col < GN_R) *(u32x2*)(Gv + (size_t)row * 1024 + (col - GN_V)) = w;
        else if (col < GN_GD) { u32x2 s; s.x = pk2(silu(v[0]), silu(v[1])); s.y = pk2(silu(v[2]), silu(v[3])); *(u32x2*)(Gr + (size_t)row * 1024 + (col - GN_R)) = s; }
        else if (col < GN_GD + 16) *(f32x4*)(GD + (size_t)row * 16 + (col - GN_GD)) = v;
    }
};

__device__ __forceinline__ float log_sigmoid_f(float x) { return fminf(x, 0.f) - log1pf(__expf(-fabsf(x))); }
__device__ __forceinline__ bf16x8 tr8(LAS unsigned char* a0, LAS unsigned char* a1) { const s16x4 v0 = lds_tr(a0), v1 = lds_tr(a1); bf16x8 r; r[0] = v0[0]; r[1] = v0[1]; r[2] = v0[2]; r[3] = v0[3]; r[4] = v1[0]; r[5] = v1[1]; r[6] = v1[2]; r[7] = v1[3]; return r; }

constexpr int KD_ST = 272, V_ST = 528;
constexpr int GL_LB = 0, GL_TOT = 32768, GL_KD = 36864, GL_V = GL_KD + 64 * KD_ST  , GL_END = GL_V + 64 * V_ST;
static_assert(GL_END <= RING_BYTES, "GLA chunk LDS");

__device__ __forceinline__ void gla_chunk_item(int item, const bf16* __restrict__ Gq, const bf16* __restrict__ Gk, const bf16* __restrict__ Gv, const float* __restrict__ GD,
                                               const float* __restrict__ Wgu, const float* __restrict__ bg, bf16* __restrict__ QT, bf16* __restrict__ KT, float* __restrict__ DEC, float* __restrict__ DS,
                                               LAS unsigned char* lds, int tid, int wave, int lane) {
    const int h = item & 3, bc = item >> 2;
    const size_t tok0 = (size_t)bc * 64;
    LAS float* LB = (LAS float*)(lds + GL_LB);
    LAS float* TOT = (LAS float*)(lds + GL_TOT);
    const int d = tid & 127, tq = tid >> 7;
    float wg[16];
#pragma unroll
    for (int r = 0; r < 16; ++r) wg[r] = Wgu[r * 512 + h * 128 + d];
    const float bgd = bg[h * 128 + d];
    float pre[16]; float run = 0.f;
#pragma unroll
    for (int i = 0; i < 16; ++i) {
        const float* gd = GD + (tok0 + tq * 16 + i) * 16;
        const f32x4 g0 = *(const f32x4*)gd, g1 = *(const f32x4*)(gd + 4), g2 = *(const f32x4*)(gd + 8), g3 = *(const f32x4*)(gd + 12);
        float x = 0.f;
#pragma unroll
        for (int r = 0; r < 4; ++r) { x = fmaf(g0[r], wg[r], x); }
#pragma unroll
        for (int r = 0; r < 4; ++r) { x = fmaf(g1[r], wg[4 + r], x); }
#pragma unroll
        for (int r = 0; r < 4; ++r) { x = fmaf(g2[r], wg[8 + r], x); }
#pragma unroll
        for (int r = 0; r < 4; ++r) { x = fmaf(g3[r], wg[12 + r], x); }
        run += log_sigmoid_f(x + bgd) * (1.f / 16.f); pre[i] = run;
    }
    TOT[tq * 128 + d] = run;
    __syncthreads();
    float off = 0.f;
#pragma unroll
    for (int q = 0; q < 3; ++q) if (q < tq) off += TOT[q * 128 + d];
    const float bC = (TOT[d] + TOT[128 + d]) + (TOT[256 + d] + TOT[384 + d]);
#pragma unroll
    for (int i = 0; i < 16; ++i) {
        const int t = tq * 16 + i; const float b = pre[i] + off; const size_t tok = tok0 + t;
        const float q = bf2f(Gq[tok * 512 + h * 128 + d]), k = bf2f(Gk[tok * 512 + h * 128 + d]);
        QT[tok * 512 + h * 128 + d] = (bf16)f2bf(q * 0.08838834764831845f * __expf(b));
        KT[tok * 512 + h * 128 + d] = (bf16)f2bf(k * __expf(-b));
        *(LAS bf16*)(lds + GL_KD + t * KD_ST + d * 2) = (bf16)f2bf(k * __expf(bC - b));
    }
    if (tq == 0) DEC[(size_t)item * 128 + d] = __expf(bC);
#pragma unroll
    for (int p = 0; p < 4; ++p) { const int e = tid + p * 512, s = e >> 5, ch = e & 31;
        *(LAS u32x4*)(lds + GL_V + s * V_ST + ch * 16) = *(const u32x4*)(Gv + (tok0 + s) * 1024 + h * 256 + ch * 8); }
    __syncthreads();
    const int fr = lane & 15, fq = lane >> 4, dt = wave;
    bf16x8 af[2];
#pragma unroll
    for (int ks = 0; ks < 2; ++ks) { LAS unsigned char* a0 = lds + GL_KD + (ks * 32 + fq * 8 + (fr >> 2)) * KD_ST + (dt * 16 + 4 * (fr & 3)) * 2; af[ks] = tr8(a0, a0 + 4 * KD_ST); }
    bf16* dsb = (bf16*)DS + (size_t)item * 256 * 128;
#pragma unroll 4
    for (int vt = 0; vt < 16; ++vt) {
        f32x4 acc = (f32x4){0.f, 0.f, 0.f, 0.f};
#pragma unroll
        for (int ks = 0; ks < 2; ++ks) { LAS unsigned char* b0 = lds + GL_V + (ks * 32 + fq * 8 + (fr >> 2)) * V_ST + (vt * 16 + 4 * (fr & 3)) * 2; const bf16x8 bf = tr8(b0, b0 + 4 * V_ST);
            acc = __builtin_amdgcn_mfma_f32_16x16x32_bf16(af[ks], bf, acc, 0, 0, 0); }
        { u32x2 w; w.x = pk2(acc[0], acc[1]); w.y = pk2(acc[2], acc[3]); *(u32x2*)(dsb + (size_t)(vt * 16 + fr) * 128 + dt * 16 + fq * 4) = w; }
    }
    __syncthreads();
}

__device__ __forceinline__ void gla_sample_item(int item, const bf16* __restrict__ Gq, const bf16* __restrict__ Gk, const bf16* __restrict__ Gv, const bf16* __restrict__ Gr, const float* __restrict__ GD,
                                                const float* __restrict__ Wgu, const float* __restrict__ bg, const float* __restrict__ ng, const float* __restrict__ S0, float* __restrict__ Sout, bf16* __restrict__ OGb,
                                                LAS unsigned char* lds, int tid, int lane) {
    const int b = item >> 2, h = item & 3;
    LAS float* A = (LAS float*)lds;
    LAS float* Qs = A + 512; LAS float* Ks = Qs + 512;
    LAS float* PO = Ks + 512;
    LAS float* RS = PO + 4096;
    { const int t = tid >> 7, d = tid & 127; const size_t tok = (size_t)TP + b * DS + t;
      float x = bg[h * 128 + d]; const float* gd = GD + tok * 16; float xs = 0.f;
#pragma unroll
      for (int r = 0; r < 16; ++r) xs = fmaf(gd[r], Wgu[r * 512 + h * 128 + d], xs);
      x += xs;
      A[t * 128 + d] = __expf(log_sigmoid_f(x) * (1.f / 16.f));
      Qs[t * 128 + d] = bf2f(Gq[tok * 512 + h * 128 + d]) * 0.08838834764831845f; Ks[t * 128 + d] = bf2f(Gk[tok * 512 + h * 128 + d]); }
    __syncthreads();
    const int dq = tid >> 7, d0 = dq * 32;
#pragma unroll 1
    for (int vhalf = 0; vhalf < 2; ++vhalf) {
        const int v = vhalf * 128 + (tid & 127);
        float S[32];
#pragma unroll
        for (int i = 0; i < 32; ++i) S[i] = S0[(((size_t)b * 4 + h) * 128 + d0 + i) * 256 + v];
#pragma unroll 1
        for (int t = 0; t < 4; ++t) {
            const float vv = bf2f(Gv[((size_t)TP + b * DS + t) * 1024 + h * 256 + v]); float o = 0.f;
#pragma unroll
            for (int i = 0; i < 32; ++i) { S[i] = fmaf(A[t * 128 + d0 + i], S[i], Ks[t * 128 + d0 + i] * vv); o = fmaf(Qs[t * 128 + d0 + i], S[i], o); }
            PO[(dq * 4 + t) * 256 + v] = o;
        }
#pragma unroll
        for (int i = 0; i < 32; ++i) Sout[(((size_t)b * 4 + h) * 128 + d0 + i) * 256 + v] = S[i];
    }
    __syncthreads();
    { const int t = tid >> 7, vl = tid & 127; const float o0 = (PO[t * 256 + vl] + PO[(4 + t) * 256 + vl]) + (PO[(8 + t) * 256 + vl] + PO[(12 + t) * 256 + vl]), o1 = (PO[t * 256 + 128 + vl] + PO[(4 + t) * 256 + 128 + vl]) + (PO[(8 + t) * 256 + 128 + vl] + PO[(12 + t) * 256 + 128 + vl]);
      float ss = o0 * o0 + o1 * o1;
#pragma unroll
      for (int o = 1; o < 64; o <<= 1) ss += __shfl_xor(ss, o);
      if (lane == 0) RS[tid >> 6] = ss;
      __syncthreads();
      const float ms = (RS[2 * t] + RS[2 * t + 1]) * (1.f / 256.f), rstd = rsqrtf(ms + LN_EPS);
      const size_t tok = (size_t)TP + b * DS + t;
      OGb[tok * 1024 + h * 256 + vl] = (bf16)f2bf(o0 * rstd * ng[vl] * bf2f(Gr[tok * 1024 + h * 256 + vl]));
      OGb[tok * 1024 + h * 256 + 128 + vl] = (bf16)f2bf(o1 * rstd * ng[128 + vl] * bf2f(Gr[tok * 1024 + h * 256 + 128 + vl])); }
    __syncthreads();
}

__device__ __forceinline__ void gla_scan(const float* __restrict__ DS, const float* __restrict__ DEC, bf16* __restrict__ SP, float* __restrict__ Sout, int gtid, int gthreads) {
    typedef float f32x2 __attribute__((ext_vector_type(2)));
    for (int e = gtid; e < NBATCH * 4 * 256 * 64; e += gthreads) {
        const int d2 = e & 63, v = (e >> 6) & 255, h = (e >> 14) & 3, b = e >> 16;
        f32x2 S = (f32x2){0.f, 0.f};
        for (int c = 0; c < SEQ / 64; ++c) {
            const size_t item = ((size_t)b * (SEQ / 64) + c) * 4 + h;
            const unsigned dw = *(const unsigned*)((const bf16*)DS + (item * 256 + v) * 128 + d2 * 2); const f32x2 ds = (f32x2){bflo(dw), bfhi(dw)}, dc = *(const f32x2*)(DEC + item * 128 + d2 * 2);
            *(unsigned*)(SP + (item * 256 + v) * 128 + d2 * 2) = pk2(S[0], S[1]);
            S = dc * S + ds;
        }
        float* so = Sout + (((size_t)b * 4 + h) * 128 + d2 * 2) * 256 + v; so[0] = S[0]; so[256] = S[1];
    }
}

__device__ __forceinline__ void gla_out_item(int item, const bf16* __restrict__ QT, const bf16* __restrict__ KT, const bf16* __restrict__ Gv, const bf16* __restrict__ Gr, const bf16* __restrict__ SP,
                                             const float* __restrict__ ng, bf16* __restrict__ OGb, LAS unsigned char* lds, int tid, int wave, int lane) {
    const int h = item & 3, bc = item >> 2; const size_t tok0 = (size_t)bc * 64;
    const int fr = lane & 15, fq = lane >> 4, tt = wave & 3, vh = wave >> 2;
    LAS float* RS = (LAS float*)(lds + 64 * V_ST);
#pragma unroll
    for (int p = 0; p < 4; ++p) { const int e = tid + p * 512, s = e >> 5, ch = e & 31;
        *(LAS u32x4*)(lds + s * V_ST + ch * 16) = *(const u32x4*)(Gv + (tok0 + s) * 1024 + h * 256 + ch * 8); }
    bf16x8 qf[4];
#pragma unroll
    for (int ks = 0; ks < 4; ++ks) qf[ks] = *(const bf16x8*)(QT + (tok0 + tt * 16 + fr) * 512 + h * 128 + ks * 32 + fq * 8);
    const bf16* spb = SP + (size_t)item * 256 * 128;
    bf16x8 sfr[2][4];
#pragma unroll
    for (int ks = 0; ks < 4; ++ks) sfr[0][ks] = *(const bf16x8*)(spb + (size_t)(vh * 8 * 16 + fr) * 128 + ks * 32 + fq * 8);
    bf16x8 pf[2];
    {
        f32x4 at[4];
#pragma unroll
        for (int st = 0; st < 4; ++st) {
            f32x4 acc = (f32x4){0.f, 0.f, 0.f, 0.f};
#pragma unroll
            for (int ks = 0; ks < 4; ++ks) { const bf16x8 kf = *(const bf16x8*)(KT + (tok0 + st * 16 + fr) * 512 + h * 128 + ks * 32 + fq * 8); acc = __builtin_amdgcn_mfma_f32_16x16x32_bf16(kf, qf[ks], acc, 0, 0, 0); }
#pragma unroll
            for (int j = 0; j < 4; ++j) { const int s = st * 16 + fq * 4 + j, t = tt * 16 + fr; if (s > t) acc[j] = 0.f; }
            at[st] = acc;
        }
        const u32x4 w0 = pack8(at[0], at[1]), w1 = pack8(at[2], at[3]);
        pf[0] = __builtin_bit_cast(bf16x8, w0); pf[1] = __builtin_bit_cast(bf16x8, w1);
    }
    __syncthreads();
    f32x4 oacc[8]; float ss = 0.f;
#pragma unroll
    for (int i = 0; i < 8; ++i) {
        const int vt = vh * 8 + i;
        if (i < 7) {
#pragma unroll
            for (int ks = 0; ks < 4; ++ks) sfr[(i + 1) & 1][ks] = *(const bf16x8*)(spb + (size_t)((vt + 1) * 16 + fr) * 128 + ks * 32 + fq * 8);
        }
        f32x4 acc = (f32x4){0.f, 0.f, 0.f, 0.f};
#pragma unroll
        for (int k2 = 0; k2 < 2; ++k2) {
            LAS unsigned char* a0 = lds + (k2 * 32 + fq * 4 + (fr >> 2)) * V_ST + (vt * 16 + 4 * (fr & 3)) * 2;
            const bf16x8 vf = tr8(a0, a0 + 16 * V_ST);
            acc = __builtin_amdgcn_mfma_f32_16x16x32_bf16(vf, pf[k2], acc, 0, 0, 0);
        }
#pragma unroll
        for (int ks = 0; ks < 4; ++ks) acc = __builtin_amdgcn_mfma_f32_16x16x32_bf16(sfr[i & 1][ks], qf[ks], acc, 0, 0, 0);
        oacc[i] = acc; ss += (acc[0] * acc[0] + acc[1] * acc[1]) + (acc[2] * acc[2] + acc[3] * acc[3]);
    }
    ss += __shfl_xor(ss, 16); ss += __shfl_xor(ss, 32);
    if (fq == 0) RS[wave * 16 + fr] = ss;
    __syncthreads();
    const float ms = (RS[tt * 16 + fr] + RS[(tt + 4) * 16 + fr]) * (1.f / 256.f), rstd = rsqrtf(ms + LN_EPS);
    const size_t tok = tok0 + tt * 16 + fr;
#pragma unroll
    for (int i = 0; i < 8; ++i) {
        const int v = (vh * 8 + i) * 16 + fq * 4;
        const u32x2 rw = *(const u32x2*)(Gr + tok * 1024 + h * 256 + v); const f32x4 g = *(const f32x4*)(ng + v);
        u32x2 w; w.x = pk2(oacc[i][0] * rstd * g[0] * bflo(rw.x), oacc[i][1] * rstd * g[1] * bfhi(rw.x)); w.y = pk2(oacc[i][2] * rstd * g[2] * bflo(rw.y), oacc[i][3] * rstd * g[3] * bfhi(rw.y));
        *(u32x2*)(OGb + tok * 1024 + h * 256 + v) = w;
    }
    __syncthreads();
}
}

namespace mk {
#ifndef MIX_V2
#define MIX_V1 1
#endif
#if defined(MIX_V1)
#define MIXSEL(Hf, te, tg, U, V, Us, Vs, g2, b2, of, ob, lds, wave, gw, NGW, lane) phase_peer_mix(Hf, te, tg, U, V, Us, Vs, g2, b2, of, ob, gw, NGW, lane)
#define MIX_FROM_Z 1
#else
#define MIXSEL(Hf, te, tg, U, V, Us, Vs, g2, b2, of, ob, lds, wave, gw, NGW, lane) phase_peer_mix2(Hf, H1b, te, tg, U, V, Us, Vs, g2, b2, of, ob, lds, wave, gw, NGW, lane)
#endif
#define PEER_USLICE(Hb_, U_, Us_) do { if (G % 8 == 0) { const int per_ = G / 8; peer_u_slice(vcu / per_, (vcu % per_) * NWAVES + wave, per_ * NWAVES, Hb_, TEID, U_, HDB, lds + wave * 16384, lane); } \
        else { for (int sl_ = 0; sl_ < 8; ++sl_) peer_u_slice(sl_, gw, NGW, Hb_, TEID, U_, HDB, lds + wave * 16384, lane); } } while (0)
struct Args {
    const float* in[23]; const int* page_table; float* out; unsigned char* ws; int ph_lo, ph_hi;
};
enum Phase { P_PRO = 0, P_AIN = 1, P_SCORE = 2, P_TOPK = 3, P_ATTN = 4, P_AOUT = 5, P_LN1 = 6, P_PQ0 = 7, P_PEER0 = 8, P_GIN = 9, P_GCH = 10, P_GSC = 11, P_GOUT = 12, P_GPRJ = 13, P_LN1B = 14, P_PQ1 = 15, P_PEER1 = 16, P_COUNT = 17 };

#define Wa ((bf16*)(ws + WS_WA))
#define Wo ((bf16*)(ws + WS_WO))
#define Wg ((bf16*)(ws + WS_WG))
#define Wgo ((bf16*)(ws + WS_WGO))
#define Wpq ((bf16*)(ws + WS_WPQ))
#define PK ((bf16*)(ws + WS_PK))
#define Usc ((float*)(ws + WS_USC))
#define Xb ((bf16*)(ws + WS_XB))
#define Qb ((bf16*)(ws + WS_QB))
#define QIb ((bf16*)(ws + WS_QIB))
#define Kb ((bf16*)(ws + WS_KB))
#define Vb ((bf16*)(ws + WS_VB))
#define KIb ((bf16*)(ws + WS_KIB))
#define WIf ((float*)(ws + WS_WIF))
#define SC ((float*)(ws + WS_SC))
#define SCS ((float*)(ws + WS_SCS))
#define IDX ((int*)(ws + WS_IDX))
#define CNT ((int*)(ws + WS_CNT))
#define Ob ((bf16*)(ws + WS_OB))
#define Z ((bf16*)(ws + WS_Z))
#define H1f ((float*)(ws + WS_H1F))
#define H1b ((bf16*)(ws + WS_H1B))
#define PQb ((bf16*)(ws + WS_PQB))
#define H2f ((float*)(ws + WS_H2F))
#define H2b ((bf16*)(ws + WS_H2B))
#define TEID ((unsigned short*)(ws + WS_TEID))
#define TGATE ((float*)(ws + WS_TGATE))
#define Gq ((bf16*)(ws + WS_GQ))
#define Gk ((bf16*)(ws + WS_GK))
#define Gv ((bf16*)(ws + WS_GV))
#define Gr ((bf16*)(ws + WS_GR))
#define GD ((float*)(ws + WS_GD))
#define QT ((bf16*)(ws + WS_QT))
#define KT ((bf16*)(ws + WS_KT))
#define DEC ((float*)(ws + WS_DEC))
#define DSb ((float*)(ws + WS_DS))
#define SPV ((bf16*)(ws + WS_SPREV))
#define OGb ((bf16*)(ws + WS_OGB))
#define HDB ((float*)(ws + WS_HD))
#define KV8 ((unsigned char*)(ws + WS_KV8))
#define Uq (ws + WS_UB)
#define Vq (ws + WS_VBX)
#define Usc ((float*)(ws + WS_USC))
#define Vsc ((float*)(ws + WS_USC) + 2 * 16384)
#define x_prompt (INP(0))
#define x_sample (INP(1))
#define attn_w_in (INP(7))
#define attn_w_out (INP(8))
#define gla_w_in (INP(9))
#define gla_w_out (INP(13))
#define peer_w_q (INP(14))
#define peer_keys1 (INP(15))
#define peer_keys2 (INP(16))
#define peer_u (INP(17))
#define peer_v (INP(18))
__device__ __forceinline__ unsigned char* launder_ptr(unsigned char* p) { asm volatile("" : "+s"(p)); return p; }
#if defined(LOWSGPR)
#define ws (launder_ptr(args.ws))
#define INP(k) ((const float*)inp_ptr(lds, (k)))
#else
#define ws (args.ws)
#define INP(k) (args.in[k])
#endif
__device__ __forceinline__ const void* inp_ptr(LAS unsigned char* lds, int k) {
    const unsigned long long v = *(LAS unsigned long long*)(lds + INPTAB_OFF + 8 * k);
    const unsigned lo = __builtin_amdgcn_readfirstlane((unsigned)v), hi = __builtin_amdgcn_readfirstlane((unsigned)(v >> 32));
    return (const void*)(((unsigned long long)hi << 32) | lo);
}
__global__ void __launch_bounds__(NTHREADS, 2) mk_fwd(Args args) {
    extern __shared__ __attribute__((aligned(16))) unsigned char lds_raw[];
    LAS unsigned char* lds = (LAS unsigned char*)lds_raw;
    volatile LAS unsigned* MISC = (volatile LAS unsigned*)(lds + MISC_OFF);
    const int tid = threadIdx.x, lane = tid & 63, wave = __builtin_amdgcn_readfirstlane(tid >> 6);
    const int G = gridDim.x, bx = blockIdx.x;
    const int vcu = (G % 8 == 0) ? (bx % 8) * (G / 8) + bx / 8 : bx;
    const int gw = vcu * NWAVES + wave, NGW = G * NWAVES;
    gu32* ctl = (gu32*)(ws + WS_CTL);
    for (int u = tid; u < (LDS_BYTES - LDSCTL_OFF) / 4; u += NTHREADS) ((LAS unsigned*)(lds + LDSCTL_OFF))[u] = 0u;
    __syncthreads();
    if (tid == 0) {
#define PUTIN(k) *(LAS unsigned long long*)(lds + INPTAB_OFF + 8 * (k)) = (unsigned long long)args.in[k]
        PUTIN(0); PUTIN(1); PUTIN(2); PUTIN(3); PUTIN(4); PUTIN(5); PUTIN(6); PUTIN(7); PUTIN(8); PUTIN(9); PUTIN(10); PUTIN(11); PUTIN(12); PUTIN(13); PUTIN(14); PUTIN(15);
        PUTIN(16); PUTIN(17); PUTIN(18); PUTIN(19); PUTIN(20); PUTIN(21); PUTIN(22);
#undef PUTIN
    }
    __syncthreads();
    XcdBarrier bar = xcd_barrier_post((unsigned*)(ctl + CW_BAR), MISC + 8);
    if (tid == 0) { const unsigned xme = xb_xcc_id(); MISC[13] = xme; MISC[12] = __hip_atomic_fetch_add((unsigned*)(ctl + CW_XC + 64 * xme), 1u, __ATOMIC_RELAXED, __HIP_MEMORY_SCOPE_AGENT); }
    const int lo = args.ph_lo, hi = args.ph_hi;
#define IN(k) (lo <= (k) && (k) < hi)
#define SEAM(k) do { if (IN(k) && IN((k) + 1)) xcd_barrier(bar); } while (0)
#ifndef REPEAT_PHASE
#define REPEAT_PHASE -1
#endif
#ifndef REPEAT_N
#define REPEAT_N 2
#endif
#define REP(k) for (int rep_ = 0; rep_ < (REPEAT_PHASE == (k) ? REPEAT_N : 1); ++rep_)


    if (IN(P_PRO)) {
        LAS float* scr = (LAS float*)(lds + wave * 16384);
        constexpr int KB16 = D / 64;
        constexpr int I_WA = (WA_ROWS / 32) * KB16, I_WO = (D / 32) * KB16, I_WG = (WG_ROWS / 32) * KB16, I_WGO = (D / 32) * KB16, I_WPQ = 2 * (PEER_N / 32) * KB16;
        constexpr int NITEMS = I_WA + I_WO + I_WG + I_WGO + I_WPQ;
        for (int it = gw; it < I_WA; it += NGW) {
            int r = it;
            if (r < I_WA) { const int nb = r / KB16, kb = r % KB16, d0 = nb * 32; const int nv = ATT_N - d0 < 0 ? 0 : (ATT_N - d0 > 32 ? 32 : ATT_N - d0);
                p0_transpose_item(attn_w_in, ATT_N, D, Wa, d0, d0, nv, kb * 64, scr, lane); continue; } r -= I_WA;
        }
        p0_convert(x_prompt, Xb, (size_t)TP * D / 8, gw, NGW, lane);
        p0_convert(x_sample, Xb + (size_t)TP * D, (size_t)TS * D / 8, gw, NGW, lane);
        p0_convert(peer_keys1, PK, (size_t)2 * 128 * 128 / 8, gw, NGW, lane);
        p0_convert(peer_keys2, PK + 2 * 128 * 128, (size_t)2 * 128 * 128 / 8, gw, NGW, lane);
    }
    SEAM(P_PRO);

    if (IN(P_AIN)) {
        FAttnIn F{Qb, Kb, Vb, QIb, KIb, WIf, args.out};
        { pg8::Gemm g{Xb, Wa, TP, 2048, D}; pg8::StaticOrder S; S.init(TP, 2048, G, bx);
          pg8::EpiRow8<FAttnIn> E{F};
          pg8::gemm_phase<pg8::EpiRow8<FAttnIn>, pg8::StaticOrder, true, true>(lds, g, S, E);
          float km = E.f.kmax, vm = E.f.vmax;
#pragma unroll
          for (int o = 1; o < 64; o <<= 1) { km = fmaxf(km, __shfl_xor(km, o)); vm = fmaxf(vm, __shfl_xor(vm, o)); }
          if (lane == 0) { if (km > 0.f) atomicMax((unsigned*)(ctl + CW_AMAXK), __builtin_bit_cast(unsigned, km)); if (vm > 0.f) atomicMax((unsigned*)(ctl + CW_AMAXV), __builtin_bit_cast(unsigned, vm)); } }
        for (int it = gw; it < TP / 16 + 8 * 34; it += NGW) {
            if (it < TP / 16) {
                f32x4 acc[5]; skinny_tile<5>(Xb, D, Wa, D, it * 16, 2048, acc, lane);
#pragma unroll
                for (int ct = 0; ct < 5; ++ct) F.put4(it * 16 + (lane & 15), 2048 + ct * 16 + 4 * (lane >> 4), acc[ct]);
            } else {
                const int r = it - TP / 16, rt = r % 8, cg = r / 8;
                f32x4 acc[4]; skinny_tile<4>(Xb, D, Wa, D, TP + rt * 16, cg * 64, acc, lane);
#pragma unroll
                for (int ct = 0; ct < 4; ++ct) F.put4(TP + rt * 16 + (lane & 15), cg * 64 + ct * 16 + 4 * (lane >> 4), acc[ct]);
            }
        }
    }
    SEAM(P_AIN);

            if (IN(P_SCORE)) { kv8_convert(Kb, Vb, KV8, (const unsigned*)(ctl + CW_AMAXK), (const unsigned*)(ctl + CW_AMAXV), gw, NGW, lane);
        phase_score(QIb, KIb, WIf, INP(4), args.page_table, SC, SCS, QuantTabs{peer_u, peer_v, Uq, Vq, Usc, Vsc}, lds, vcu, G, wave, lane, gw, NGW); }
    SEAM(P_SCORE);
    if (IN(P_TOPK)) {
        const int jlo_ = 0, jhi_ = TA;
        phase_topk2(SC, SCS, IDX, CNT, peer_u, peer_v, Uq, Vq, Usc, Vsc, lds, (unsigned*)(ctl + CW_Q1), wave, lane, gw, NGW, jlo_, jhi_);
        {
            LAS float* scr = (LAS float*)(lds + wave * 16384);
            constexpr int KB16 = D / 64;
            constexpr int I_WO = (D / 32) * KB16, I_WG = (WG_ROWS / 32) * KB16, I_WGO = (D / 32) * KB16, I_WPQ = 2 * (PEER_N / 32) * KB16;
            constexpr int NDEF = I_WO + I_WG + I_WGO + I_WPQ;
            const int nskip = TS < NGW ? TS : 0;
            if (gw >= nskip) {
                asm volatile("s_waitcnt lgkmcnt(0)" ::: "memory");
                for (int it = gw - nskip; it < NDEF; it += NGW - nskip) {
                    int r = it;
                    if (r < I_WO) { const int nb = r / KB16, kb = r % KB16; p0_transpose_item(attn_w_out, D, D, Wo, nb * 32, nb * 32, 32, kb * 64, scr, lane); continue; } r -= I_WO;
                    if (r < I_WG) { const int nb = r / KB16, kb = r % KB16, d0 = nb * 32; int s0, nv;
                        if (d0 < GN_R) { s0 = d0; nv = 32; } else if (d0 < GN_GD) { s0 = GR + (d0 - GN_R); nv = 32; } else if (d0 == GN_GD) { s0 = GGD; nv = 16; } else { s0 = 0; nv = 0; }
                        p0_transpose_item(gla_w_in, GLA_N, D, Wg, d0, s0, nv, kb * 64, scr, lane); continue; } r -= I_WG;
                    if (r < I_WGO) { const int nb = r / KB16, kb = r % KB16; p0_transpose_item(gla_w_out, D, D, Wgo, nb * 32, nb * 32, 32, kb * 64, scr, lane); continue; } r -= I_WGO;
                    { const int l = r / ((PEER_N / 32) * KB16), rr = r % ((PEER_N / 32) * KB16), nb = rr / KB16, kb = rr % KB16;
                      p0_transpose_item(peer_w_q + (size_t)l * D * PEER_N, PEER_N, D, Wpq + (size_t)l * PEER_N * D, nb * 32, nb * 32, 32, kb * 64, scr, lane); }
                        }
            }
        }
    }
    SEAM(P_TOPK);
    if (IN(P_ATTN)) {
        LAS unsigned char* wl = lds + wave * 16384;
        {
            if (tid == 0) { unsigned np = 0, mi = 0, mycnt = 1; const unsigned xme = MISC[13];
                for (unsigned j = 0; j < 16; ++j) { const unsigned c = __hip_atomic_load((unsigned*)(ctl + CW_XC + 64 * j), __ATOMIC_RELAXED, __HIP_MEMORY_SCOPE_AGENT); if (c > 0u) { if (j < xme) ++mi; ++np; } if (j == xme) mycnt = c > 0u ? c : 1u; }
                MISC[14] = np > 0u ? np : 1u; MISC[15] = mi; MISC[16] = mycnt; }
            __syncthreads();
            const int np = (int)MISC[14], mi = (int)MISC[15], mycnt = (int)MISC[16], rank = (int)MISC[12];
            for (int u = 0; u < NBATCH * 4; ++u) if (u % np == mi) attn_prompt_stream(u >> 2, u & 3, rank * NWAVES + wave, mycnt * NWAVES, Qb, IDX, KV8, (const unsigned*)(ctl + CW_AMAXK), (const unsigned*)(ctl + CW_AMAXV), Ob, wl, lane);
        }
        {
            const float* ck_ = INP(2); const float* cv_ = INP(3); float* o_ = args.out; const int* pt_ = args.page_table; int gws_ = gw; int lane_s = lane;
            asm volatile("" : "+s"(ck_), "+s"(cv_), "+s"(o_), "+s"(pt_), "+s"(gws_), "+v"(lane_s));
            for (int su = gws_; su < TS * 4 * 4; su += NGW) {
                if ((su & 3) == 0) { const int un = su >> 2, r = un >> 2, n = un & 3; attn_row<true>(TP + r, n, n + 1, Qb, IDX, CNT, nullptr, nullptr, ck_, cv_, o_ + OUT_KS, o_ + OUT_VS, pt_, Ob, wl, lane_s); }
            }
        }
    }
    SEAM(P_ATTN);
    if (IN(P_AOUT)) {
        FResid F{x_prompt, x_sample, Z};
        { pg8::Gemm g{Ob, Wo, TP, D, D}; pg8::StaticOrder S; S.init(TP, D, G, bx);
          pg8::EpiRow8<FResid> E{F};
          pg8::gemm_phase<pg8::EpiRow8<FResid>, pg8::StaticOrder, true, true>(lds, g, S, E); }
        for (int it = gw; it < 8 * 16; it += NGW) {
            const int rt = it % 8, cg = it / 8;
            f32x4 acc[4]; skinny_tile<4>(Ob, D, Wo, D, TP + rt * 16, cg * 64, acc, lane);
#pragma unroll
            for (int ct = 0; ct < 4; ++ct) F.put4(TP + rt * 16 + (lane & 15), cg * 64 + ct * 16 + 4 * (lane >> 4), acc[ct]);
        }
    }
    SEAM(P_AOUT);
    if (IN(P_LN1)) ln_rows(Z, INP(19), INP(20), H1b, gw, NGW, lane);
    SEAM(P_LN1);

        if (IN(P_PQ0)) {
        FStoreBf16 F{PQb, PEER_N};
        { pg8::Gemm g{H1b, Wpq, TP, PEER_N, D}; pg8::StaticOrder S; S.init(TP, PEER_N, G, bx);
          pg8::EpiRow8<FStoreBf16> E{F};
          pg8::gemm_phase<pg8::EpiRow8<FStoreBf16>, pg8::StaticOrder, true, true>(lds, g, S, E); }
        for (int it = gw; it < 8 * 32; it += NGW) {
            const int rt = it % 8, cg = it / 8;
            f32x4 acc[4]; skinny_tile<4>(H1b, D, Wpq, D, TP + rt * 16, cg * 64, acc, lane);
#pragma unroll
            for (int ct = 0; ct < 4; ++ct) F.put4(TP + rt * 16 + (lane & 15), cg * 64 + ct * 16 + 4 * (lane >> 4), acc[ct]);
        }
#if 0
        for (int it = gw; it < 8 * 16; it += NGW) {
            const int rt = it % 8, cg = it / 8;
            f32x4 acc[8]; skinny_tile<8>(H1b, D, Wpq, D, TP + rt * 16, cg * 128, acc, lane);
#pragma unroll
            for (int ct = 0; ct < 8; ++ct) F.put4(TP + rt * 16 + (lane & 15), cg * 128 + ct * 16 + 4 * (lane >> 4), acc[ct]);
        }
#endif
    }
    SEAM(P_PQ0);
        if (IN(P_PEER0)) {
#if PEER_LOCAL
        phase_peer_select(PQb, PK, PK + 2 * 16384, TEID, TGATE, lds, vcu, G, wave, lane, (unsigned*)(ctl + CW_PFLAG));
#else
        phase_peer_select(PQb, PK, PK + 2 * 16384, TEID, TGATE, lds, vcu, G, wave, lane);
#endif
#if PEER_LOCAL
        asm volatile("s_waitcnt vmcnt(0)" ::: "memory"); __syncthreads();
#else
        xcd_barrier(bar);
#endif
#if defined(U_SLICED)
        PEER_USLICE(H1b, Uq, Usc);
        xcd_barrier(bar);
        phase_peer_mixv(Z, INP(19), INP(20), TEID, TGATE, HDB, Vq, Usc, Vsc, INP(21), INP(22), H2f, H2b, gw, NGW, lane);
#else
#if defined(MIX_FROM_Z)
#if PEER_BITS == 4 && PEER_UMFMA == 3
        phase_peer_mix4<1>(Z, INP(19), INP(20), TEID, TGATE, Uq, Vq, Usc, Vsc, INP(21), INP(22), H2f, H2b, (float*)(ws + WS_HD), lds + wave * 5120, gw, NGW, lane);
        xcd_barrier(bar);
        phase_peer_mix4<2>(Z, INP(19), INP(20), TEID, TGATE, Uq, Vq, Usc, Vsc, INP(21), INP(22), H2f, H2b, (float*)(ws + WS_HD), lds + wave * 5120, gw, NGW, lane);
#elif PEER_BITS == 4 && PEER_UMFMA == 2
        phase_peer_mix4<0>(Z, INP(19), INP(20), TEID, TGATE, Uq, Vq, Usc, Vsc, INP(21), INP(22), H2f, H2b, nullptr, lds + wave * 5120, gw, NGW, lane);
#else
#if PEER_UVI
        phase_peer_mix(Z, INP(19), INP(20), TEID, TGATE, Uq, Uq + PEER_RB, Usc, Vsc, INP(21), INP(22), (float*)nullptr, H2b, lds + wave * 5120, gw, NGW, lane);
#else
        phase_peer_mix(Z, INP(19), INP(20), TEID, TGATE, Uq, Vq, Usc, Vsc, INP(21), INP(22), (float*)nullptr, H2b, lds + wave * 5120, gw, NGW, lane, (unsigned*)(ctl + CW_PFLAG));
#endif
#if PEER_BITS == 4 && PEER_SCOOP
        phase_peer_mix_sample(Z, INP(19), INP(20), TEID, TGATE, Uq, Vq, Usc, Vsc, INP(21), INP(22), (float*)nullptr, H2b, lds, vcu, G, wave, lane);
#endif
#endif
#else
        MIXSEL(H1f, TEID, TGATE, Uq, Vq, Usc, Vsc, INP(21), INP(22), H2f, H2b, lds, wave, gw, NGW, lane);
#endif
#endif
    }
    SEAM(P_PEER0);

            if (IN(P_GIN)) {
        FGlaIn F{Gq, Gk, Gv, Gr, GD};
        { pg8::Gemm g{H2b, Wg, TP, 3072, D}; pg8::StaticOrder S; S.init(TP, 3072, G, bx);
          pg8::EpiRow8<FGlaIn> E{F};
          pg8::gemm_phase<pg8::EpiRow8<FGlaIn>, pg8::StaticOrder, true, true>(lds, g, S, E); }
        for (int it = gw; it < TP / 16 + 8 * 97; it += NGW) {
            if (it < TP / 16) {
                f32x4 acc[1]; skinny_tile<1>(H2b, D, Wg, D, it * 16, GN_GD, acc, lane);
                F.put4(it * 16 + (lane & 15), GN_GD + 4 * (lane >> 4), acc[0]);
            } else {
                const int r = it - TP / 16, rt = r % 8, cg = r / 8;
                f32x4 acc[2]; skinny_tile<2>(H2b, D, Wg, D, TP + rt * 16, cg * 32, acc, lane);
#pragma unroll
                for (int ct = 0; ct < 2; ++ct) F.put4(TP + rt * 16 + (lane & 15), cg * 32 + ct * 16 + 4 * (lane >> 4), acc[ct]);
            }
        }
    }
    SEAM(P_GIN);
    if (IN(P_GCH)) {
        for (int it = vcu; it < NBATCH * (SEQ / 64) * 4; it += G) gla_chunk_item(it, Gq, Gk, Gv, GD, INP(10), INP(11), QT, KT, DEC, DSb, lds, tid, wave, lane);
        for (int it = vcu; it < DB * 4; it += G) gla_sample_item(it, Gq, Gk, Gv, Gr, GD, INP(10), INP(11), INP(12), INP(5), args.out + OUT_SS, OGb, lds, tid, lane);
    }
    SEAM(P_GCH);
    if (IN(P_GSC)) gla_scan(DSb, DEC, SPV, args.out + OUT_SP, vcu * NTHREADS + tid, G * NTHREADS);
    SEAM(P_GSC);
    if (IN(P_GOUT)) { for (int it = vcu; it < NBATCH * (SEQ / 64) * 4; it += G) gla_out_item(it, QT, KT, Gv, Gr, SPV, INP(12), OGb, lds, tid, wave, lane); }
    SEAM(P_GOUT);
    if (IN(P_GPRJ)) {
        FResidB F{H2b, H2b + (size_t)TP * D, Z};
        { pg8::Gemm g{OGb, Wgo, TP, D, D}; pg8::StaticOrder S; S.init(TP, D, G, bx);
          pg8::EpiRow8<FResidB> E{F};
          pg8::gemm_phase<pg8::EpiRow8<FResidB>, pg8::StaticOrder, true, true>(lds, g, S, E); }
        for (int it = gw; it < 8 * 16; it += NGW) {
            const int rt = it % 8, cg = it / 8;
            f32x4 acc[4]; skinny_tile<4>(OGb, D, Wgo, D, TP + rt * 16, cg * 64, acc, lane);
#pragma unroll
            for (int ct = 0; ct < 4; ++ct) F.put4(TP + rt * 16 + (lane & 15), cg * 64 + ct * 16 + 4 * (lane >> 4), acc[ct]);
        }
    }
    SEAM(P_GPRJ);
    if (IN(P_LN1B)) ln_rows(Z, INP(19) + D, INP(20) + D, H1b, gw, NGW, lane);
    SEAM(P_LN1B);
    if (IN(P_PQ1)) {
        FStoreBf16 F{PQb, PEER_N}; const bf16* W1 = Wpq + (size_t)PEER_N * D;
        { pg8::Gemm g{H1b, W1, TP, PEER_N, D}; pg8::StaticOrder S; S.init(TP, PEER_N, G, bx);
          pg8::EpiRow8<FStoreBf16> E{F};
          pg8::gemm_phase<pg8::EpiRow8<FStoreBf16>, pg8::StaticOrder, true, true>(lds, g, S, E); }
        for (int it = gw; it < 8 * 32; it += NGW) {
            const int rt = it % 8, cg = it / 8;
            f32x4 acc[4]; skinny_tile<4>(H1b, D, W1, D, TP + rt * 16, cg * 64, acc, lane);
#pragma unroll
            for (int ct = 0; ct < 4; ++ct) F.put4(TP + rt * 16 + (lane & 15), cg * 64 + ct * 16 + 4 * (lane >> 4), acc[ct]);
        }
    }
    SEAM(P_PQ1);
    if (IN(P_PEER1)) {
#if PEER_LOCAL
        phase_peer_select(PQb, PK + 16384, PK + 3 * 16384, TEID, TGATE, lds, vcu, G, wave, lane, (unsigned*)(ctl + CW_PFLAG + 64));
        asm volatile("s_waitcnt vmcnt(0)" ::: "memory"); __syncthreads();
#else
        phase_peer_select(PQb, PK + 16384, PK + 3 * 16384, TEID, TGATE, lds, vcu, G, wave, lane);
        xcd_barrier(bar);
#endif
#if defined(U_SLICED)
        PEER_USLICE(H1b, Uq + (size_t)16384 * PEER_RB, Usc + 16384);
        xcd_barrier(bar);
        phase_peer_mixv(Z, INP(19) + D, INP(20) + D, TEID, TGATE, HDB, Vq + (size_t)16384 * PEER_RB, Usc + 16384, Vsc + 16384, INP(21) + D, INP(22) + D, args.out + OUT_Y, nullptr, gw, NGW, lane);
#else
#if defined(MIX_FROM_Z)
#if PEER_BITS == 4 && PEER_UMFMA == 3
        phase_peer_mix4<1>(Z, INP(19) + D, INP(20) + D, TEID, TGATE, Uq + (size_t)16384 * PEER_RB, Vq + (size_t)16384 * PEER_RB, Usc + 16384, Vsc + 16384, INP(21) + D, INP(22) + D, args.out + OUT_Y, nullptr, (float*)(ws + WS_HD), lds + wave * 5120, gw, NGW, lane);
        xcd_barrier(bar);
        phase_peer_mix4<2>(Z, INP(19) + D, INP(20) + D, TEID, TGATE, Uq + (size_t)16384 * PEER_RB, Vq + (size_t)16384 * PEER_RB, Usc + 16384, Vsc + 16384, INP(21) + D, INP(22) + D, args.out + OUT_Y, nullptr, (float*)(ws + WS_HD), lds + wave * 5120, gw, NGW, lane);
#elif PEER_BITS == 4 && PEER_UMFMA == 2
        phase_peer_mix4<0>(Z, INP(19) + D, INP(20) + D, TEID, TGATE, Uq + (size_t)16384 * PEER_RB, Vq + (size_t)16384 * PEER_RB, Usc + 16384, Vsc + 16384, INP(21) + D, INP(22) + D, args.out + OUT_Y, nullptr, nullptr, lds + wave * 5120, gw, NGW, lane);
#else
#if PEER_UVI
        phase_peer_mix(Z, INP(19) + D, INP(20) + D, TEID, TGATE, Uq + (size_t)16384 * PEER_RS, Uq + (size_t)16384 * PEER_RS + PEER_RB, Usc + 16384, Vsc + 16384, INP(21) + D, INP(22) + D, args.out + OUT_Y, nullptr, lds + wave * 5120, gw, NGW, lane);
#else
        phase_peer_mix(Z, INP(19) + D, INP(20) + D, TEID, TGATE, Uq + (size_t)16384 * PEER_RB, Vq + (size_t)16384 * PEER_RB, Usc + 16384, Vsc + 16384, INP(21) + D, INP(22) + D, args.out + OUT_Y, nullptr, lds + wave * 5120, gw, NGW, lane, (unsigned*)(ctl + CW_PFLAG + 64));
#endif
#if PEER_BITS == 4 && PEER_SCOOP
        phase_peer_mix_sample(Z, INP(19) + D, INP(20) + D, TEID, TGATE, Uq + (size_t)16384 * PEER_RB, Vq + (size_t)16384 * PEER_RB, Usc + 16384, Vsc + 16384, INP(21) + D, INP(22) + D, args.out + OUT_Y, nullptr, lds, vcu, G, wave, lane);
#endif
#endif
#else
        MIXSEL(H1f, TEID, TGATE, Uq + (size_t)16384 * PEER_RB, Vq + (size_t)16384 * PEER_RB, Usc + 16384, Vsc + 16384, INP(21) + D, INP(22) + D, args.out + OUT_Y, nullptr, lds, wave, gw, NGW, lane);
#endif
#endif
    }
#undef IN
#undef SEAM
}
#undef ws
#undef INP
#undef Wa
#undef Wo
#undef Wg
#undef Wgo
#undef Wpq
#undef PK
#undef Usc
#undef Xb
#undef Qb
#undef QIb
#undef Kb
#undef Vb
#undef KIb
#undef WIf
#undef SC
#undef SCS
#undef IDX
#undef CNT
#undef Ob
#undef Z
#undef H1f
#undef H1b
#undef PQb
#undef H2f
#undef H2b
#undef TEID
#undef TGATE
#undef Gq
#undef Gk
#undef Gv
#undef Gr
#undef GD
#undef QT
#undef KT
#undef DEC
#undef DSb
#undef SPV
#undef OGb
#undef Uq
#undef HDB
#undef KV8
#undef Vq
#undef Usc
#undef Vsc
#undef x_prompt
#undef x_sample
#undef attn_w_in
#undef attn_w_out
#undef gla_w_in
#undef gla_w_out
#undef peer_w_q
#undef peer_keys1
#undef peer_keys2
#undef peer_u
#undef peer_v


}

extern "C" void kernel_launch(void* const* d_in, const int* in_sizes, int n_in, void* d_out, int out_size, void* d_ws, size_t ws_size, hipStream_t stream) {
    if (ws_size < mk::WS_END || n_in != 23 || (size_t)out_size != OUT_TOTAL) { fprintf(stderr, "kernel_launch: unexpected sizes ws %zu n_in %d out %d\n", ws_size, n_in, out_size); return; }
    static int grid = 0;
    if (grid == 0) {
        int dev = 0, cus = 0;
        if (hipGetDevice(&dev) != hipSuccess || hipDeviceGetAttribute(&cus, hipDeviceAttributeMultiprocessorCount, dev) != hipSuccess) { fprintf(stderr, "kernel_launch: device query failed\n"); grid = -1; return; }
        if (hipFuncSetAttribute((const void*)mk::mk_fwd, hipFuncAttributeMaxDynamicSharedMemorySize, mk::LDS_BYTES) != hipSuccess) { fprintf(stderr, "kernel_launch: hipFuncSetAttribute failed\n"); grid = -1; return; }
        int per_cu = 0;
        if (hipOccupancyMaxActiveBlocksPerMultiprocessor(&per_cu, (const void*)mk::mk_fwd, mk::NTHREADS, mk::LDS_BYTES) != hipSuccess || per_cu < 1) fprintf(stderr, "kernel_launch: occupancy query says %d\n", per_cu);
        (void)hipGetLastError();
        grid = cus;
    }
    if (grid < 0) return;
    (void)hipMemsetAsync((char*)d_ws + mk::WS_CTL, 0, mk::CTL_ZERO_BYTES, stream);
    mk::Args a{};
    for (int i = 0; i < 23; ++i) a.in[i] = (const float*)d_in[i];
    a.page_table = (const int*)d_in[6]; a.out = (float*)d_out; a.ws = (unsigned char*)d_ws; a.ph_lo = 0; a.ph_hi = mk::P_COUNT;
    hipLaunchKernelGGL(mk::mk_fwd, dim3(grid), dim3(mk::NTHREADS), mk::LDS_BYTES, stream, a);
}
```
